# Optimizing an MI355X kernel written in HIP

```python
import jax, jax.numpy as jnp
from jax import lax
import numpy as np

D_MODEL = 1024
BATCH = 2
SEQ = 8192
DEPTH = 2

F32 = jnp.float32
EPS = 1e-6
NEG = -1e30
FORCE = 1e9
D_MIX = D_MODEL
D_LRU = D_MIX // 4
D_ATT = D_MIX // 2
D_CONV = D_MIX - D_LRU - D_ATT
LRU_BLOCKS = 4
LRU_BW = D_LRU // LRU_BLOCKS
LRU_CONV_W = 4
LRU_C = 8.0
HEAD_DIM = 64
N_HEADS = D_ATT // HEAD_DIM
N_KV = 2
GQA = N_HEADS // N_KV
KV_W = N_KV * HEAD_DIM
ROPE_THETA = 10000.0
CMP_LEN = 32
CMP_STRIDE = 16
CMP_HID = 256
SLC_LEN = 64
SLC_TOPN = 16
WINDOW = 512
Q_BLOCK = 128
CONV_K = 31
MOE_GROUPS = 4
MOE_EXPERTS = 4
MOE_TOPK = 2
MOE_HID = 512
IN_SIZES = [D_LRU, D_LRU, D_ATT, KV_W, KV_W, KV_W, KV_W, KV_W, KV_W, 3 * N_HEADS, 2 * D_CONV]
IN_COLS = sum(IN_SIZES)

kernel_name = 'hybrid_rglru_nsa_conformer_hmoe_adaln'


def _rmsnorm(x, g):
    xf = x.astype(F32)
    y = xf * lax.rsqrt(jnp.mean(xf * xf, axis=-1, keepdims=True) + EPS)
    return (y * g.astype(F32)).astype(x.dtype)


def _layernorm(x, g, b):
    xf = x.astype(F32)
    mu = jnp.mean(xf, axis=-1, keepdims=True)
    var = jnp.mean(jnp.square(xf - mu), axis=-1, keepdims=True)
    return ((xf - mu) * lax.rsqrt(var + EPS) * g.astype(F32) + b.astype(F32)).astype(x.dtype)


def _rope_tables(positions):
    inv = ROPE_THETA ** (-jnp.arange(0, HEAD_DIM, 2, dtype=F32) / HEAD_DIM)
    ang = positions.astype(F32)[..., None] * inv
    ang = jnp.concatenate([ang, ang], axis=-1)[:, :, None, :]
    return jnp.cos(ang), jnp.sin(ang)


def _rope(x, cos, sin):
    half = x.shape[-1] // 2
    rot = jnp.concatenate([-x[..., half:], x[..., :half]], axis=-1)
    return (x * cos + rot * sin).astype(x.dtype)


def _causal_dwconv(x, w, b):
    k = w.shape[0]
    y = lax.conv_general_dilated(x, w[:, None, :].astype(x.dtype), window_strides=(1,),
                                 padding=[(k - 1, 0)], dimension_numbers=('NWC', 'WIO', 'NWC'),
                                 feature_group_count=x.shape[-1])
    return y + b


def _rglru(xl, gl, conv_w, conv_b, wa, ba, wx, bx, lam):
    B_, S_, _ = xl.shape
    xc = _causal_dwconv(xl, conv_w, conv_b)
    xb = xc.reshape(B_, S_, LRU_BLOCKS, LRU_BW)
    r = jax.nn.sigmoid(jnp.einsum('bsnd,nde->bsne', xb, wa).reshape(B_, S_, D_LRU) + ba)
    i = jax.nn.sigmoid(jnp.einsum('bsnd,nde->bsne', xb, wx).reshape(B_, S_, D_LRU) + bx)
    log_a = LRU_C * r.astype(F32) * jax.nn.log_sigmoid(lam.astype(F32))
    a = jnp.exp(log_a)
    u = jnp.sqrt(-jnp.expm1(2.0 * log_a)) * (i * xc).astype(F32)

    def combine(left, right):
        a1, b1 = left
        a2, b2 = right
        return a1 * a2, a2 * b1 + b2

    _, h = lax.associative_scan(combine, (a, u), axis=1)
    return h.astype(xl.dtype) * jax.nn.gelu(gl)


def _nsa(q, kc, vc, ks, vs, kw, vw, gate_logits, cos, sin, cmp_k_w1, cmp_k_w2, cmp_v_w1, cmp_v_w2,
         cmp_pos_k, cmp_pos_v):
    B_, S_ = q.shape[:2]
    dt = q.dtype
    q = _rope(q.reshape(B_, S_, N_HEADS, HEAD_DIM), cos, sin)
    kv_shape = (B_, S_, N_KV, HEAD_DIM)
    kc = _rope(kc.reshape(kv_shape), cos, sin)
    ks = _rope(ks.reshape(kv_shape), cos, sin)
    kw = _rope(kw.reshape(kv_shape), cos, sin)
    vc, vs, vw = vc.reshape(kv_shape), vs.reshape(kv_shape), vw.reshape(kv_shape)

    n_cmp = (S_ - CMP_LEN) // CMP_STRIDE + 1
    idx = jnp.arange(n_cmp)[:, None] * CMP_STRIDE + jnp.arange(CMP_LEN)[None, :]

    def compress(t, pos, w1, w2):
        blk = t[:, idx] + pos[None, None, :, None, :]
        blk = jnp.transpose(blk, (0, 1, 3, 2, 4)).reshape(B_, n_cmp, N_KV, CMP_LEN * HEAD_DIM)
        return jax.nn.gelu(blk @ w1) @ w2

    kcmp = compress(kc, cmp_pos_k, cmp_k_w1, cmp_k_w2)
    vcmp = compress(vc, cmp_pos_v, cmp_v_w1, cmp_v_w2)
    cmp_end = jnp.arange(n_cmp) * CMP_STRIDE + CMP_LEN - 1

    n_slc = S_ // SLC_LEN
    n_top = min(SLC_TOPN, n_slc)
    ratio = SLC_LEN // CMP_STRIDE
    pad_cmp = n_slc * ratio - n_cmp
    ks_blk = jnp.transpose(ks.reshape(B_, n_slc, SLC_LEN, N_KV, HEAD_DIM), (0, 3, 1, 2, 4))
    vs_blk = jnp.transpose(vs.reshape(B_, n_slc, SLC_LEN, N_KV, HEAD_DIM), (0, 3, 1, 2, 4))
    kw_pad = jnp.pad(kw, ((0, 0), (WINDOW, 0), (0, 0), (0, 0)))
    vw_pad = jnp.pad(vw, ((0, 0), (WINDOW, 0), (0, 0), (0, 0)))
    gates = jax.nn.sigmoid(gate_logits.astype(F32)).reshape(B_, S_, N_HEADS, 3)
    scale = HEAD_DIM ** -0.5
    bi = jnp.arange(B_)[:, None, None, None]
    ki = jnp.arange(N_KV)[None, :, None, None]
    jsl = jnp.arange(n_slc)

    def block(qb):
        s0 = qb * Q_BLOCK
        t = s0 + jnp.arange(Q_BLOCK)
        qg = lax.dynamic_slice_in_dim(q, s0, Q_BLOCK, axis=1).reshape(B_, Q_BLOCK, N_KV, GQA, HEAD_DIM) * scale
        sc = jnp.einsum('bqkgd,bnkd->bkgqn', qg, kcmp).astype(F32)
        valid_c = cmp_end[None, :] <= t[:, None]
        pc = jax.nn.softmax(jnp.where(valid_c, sc, NEG), axis=-1) * jnp.any(valid_c, axis=-1)[:, None].astype(F32)
        o_cmp = jnp.einsum('bkgqn,bnkd->bqkgd', pc.astype(dt), vcmp)
        imp = jnp.pad(pc.sum(axis=2), ((0, 0), (0, 0), (0, 0), (0, pad_cmp)))
        imp = imp.reshape(B_, N_KV, Q_BLOCK, n_slc, ratio).sum(-1)
        forced = (jsl[None, :] == 0) | (jsl[None, :] == (t // SLC_LEN)[:, None])
        causal_s = (jsl[None, :] * SLC_LEN) <= t[:, None]
        imp = jnp.where(forced, FORCE, jnp.where(causal_s, imp, -1.0))
        _, sel = lax.top_k(imp, n_top)
        ksel = ks_blk[bi, ki, sel]
        vsel = vs_blk[bi, ki, sel]
        ss = jnp.einsum('bqkgd,bkqnld->bkgqnl', qg, ksel).astype(F32).reshape(B_, N_KV, GQA, Q_BLOCK, n_top * SLC_LEN)
        pos_s = (sel[..., None] * SLC_LEN + jnp.arange(SLC_LEN)).reshape(B_, N_KV, Q_BLOCK, n_top * SLC_LEN)
        mask_s = pos_s <= t[None, None, :, None]
        ps = jax.nn.softmax(jnp.where(mask_s[:, :, None], ss, NEG), axis=-1)
        ps = ps.reshape(B_, N_KV, GQA, Q_BLOCK, n_top, SLC_LEN)
        o_slc = jnp.einsum('bkgqnl,bkqnld->bqkgd', ps.astype(dt), vsel)
        kwin = lax.dynamic_slice_in_dim(kw_pad, s0, WINDOW + Q_BLOCK, axis=1)
        vwin = lax.dynamic_slice_in_dim(vw_pad, s0, WINDOW + Q_BLOCK, axis=1)
        pos_w = s0 - WINDOW + jnp.arange(WINDOW + Q_BLOCK)
        dist = t[:, None] - pos_w[None, :]
        mask_w = (pos_w[None, :] >= 0) & (dist >= 0) & (dist < WINDOW)
        sw = jnp.einsum('bqkgd,bwkd->bkgqw', qg, kwin).astype(F32)
        pw = jax.nn.softmax(jnp.where(mask_w, sw, NEG), axis=-1)
        o_win = jnp.einsum('bkgqw,bwkd->bqkgd', pw.astype(dt), vwin)
        g = lax.dynamic_slice_in_dim(gates, s0, Q_BLOCK, axis=1).reshape(B_, Q_BLOCK, N_KV, GQA, 3)
        o = g[..., 0:1] * o_cmp + g[..., 1:2] * o_slc + g[..., 2:3] * o_win
        return o.reshape(B_, Q_BLOCK, D_ATT).astype(dt)

    out = lax.map(block, jnp.arange(S_ // Q_BLOCK))
    return jnp.transpose(out, (1, 0, 2, 3)).reshape(B_, S_, D_ATT)


def _conformer_conv(u, dw_w, dw_b, ln_g, ln_b):
    v = u[..., :D_CONV] * jax.nn.sigmoid(u[..., D_CONV:])
    v = _causal_dwconv(v, dw_w, dw_b)
    v = _layernorm(v, ln_g, ln_b)
    return jax.nn.silu(v)


def _hier_moe(h, rg_w, rg_b, re_w, re_b, w_gate, w_up, w_down):
    B_, S_, D_ = h.shape
    t = h.reshape(B_ * S_, D_)
    lg = (t @ rg_w + rg_b).astype(F32)
    pg = jax.nn.softmax(lg, axis=-1)
    g_star = jnp.argmax(lg, axis=-1)
    pg_star = jnp.take_along_axis(pg, g_star[:, None], axis=1)
    le = (jnp.einsum('td,gde->tge', t, re_w) + re_b).astype(F32)
    le_star = jnp.take_along_axis(le, g_star[:, None, None], axis=1)[:, 0]
    top_v, top_i = lax.top_k(le_star, MOE_TOPK)
    pe = jax.nn.softmax(top_v, axis=-1)
    w_e = jnp.einsum('tk,tke->te', pe, jax.nn.one_hot(top_i, MOE_EXPERTS, dtype=F32))
    comb = (jax.nn.one_hot(g_star, MOE_GROUPS, dtype=F32)[:, :, None] * w_e[:, None, :]
            * pg_star[:, :, None]).astype(t.dtype)
    y = jnp.zeros_like(t)
    for g in range(MOE_GROUPS):
        hid = jax.nn.silu(jnp.einsum('td,edf->tef', t, w_gate[g])) * jnp.einsum('td,edf->tef', t, w_up[g])
        y = y + jnp.einsum('tef,efd->td', hid * comb[:, g, :, None], w_down[g])
    return y.reshape(B_, S_, D_)


def setup_inputs(seed: int = 0) -> dict:
    key = jax.random.key(seed)
    ks = iter(jax.random.split(key, 48))
    L = DEPTH

    def nrm(shape, s):
        return jax.random.normal(next(ks), shape, F32) * s

    def gain(shape):
        return 1.0 + nrm(shape, 0.02)

    x = nrm((BATCH, SEQ, D_MODEL), 1.0)
    c = nrm((BATCH, D_MODEL), 1.0)
    start = jax.random.randint(next(ks), (BATCH, 1), 0, 1024, dtype=jnp.int32)
    positions = start + jnp.arange(SEQ, dtype=jnp.int32)[None, :]
    a0 = jax.random.uniform(next(ks), (L, D_LRU), F32, 0.9, 0.999)
    lru_lambda = jnp.log(a0) - jnp.log1p(-a0)
    return {
        'x': x, 'c': c, 'positions': positions,
        'ada_w': nrm((L, D_MODEL, 6 * D_MODEL), 0.5 * D_MODEL ** -0.5),
        'ada_b': nrm((L, 6 * D_MODEL), 0.02),
        'norm1_g': gain((L, D_MODEL)),
        'norm2_g': gain((L, D_MODEL)),
        'w_in': nrm((L, D_MODEL, IN_COLS), D_MODEL ** -0.5),
        'lru_conv_w': nrm((L, LRU_CONV_W, D_LRU), LRU_CONV_W ** -0.5),
        'lru_conv_b': nrm((L, D_LRU), 0.02),
        'lru_wa': nrm((L, LRU_BLOCKS, LRU_BW, LRU_BW), LRU_BW ** -0.5),
        'lru_ba': nrm((L, D_LRU), 0.02),
        'lru_wx': nrm((L, LRU_BLOCKS, LRU_BW, LRU_BW), LRU_BW ** -0.5),
        'lru_bx': nrm((L, D_LRU), 0.02),
        'lru_lambda': lru_lambda,
        'cmp_k_w1': nrm((L, CMP_LEN * HEAD_DIM, CMP_HID), (CMP_LEN * HEAD_DIM) ** -0.5),
        'cmp_k_w2': nrm((L, CMP_HID, HEAD_DIM), CMP_HID ** -0.5),
        'cmp_v_w1': nrm((L, CMP_LEN * HEAD_DIM, CMP_HID), (CMP_LEN * HEAD_DIM) ** -0.5),
        'cmp_v_w2': nrm((L, CMP_HID, HEAD_DIM), CMP_HID ** -0.5),
        'cmp_pos_k': nrm((L, CMP_LEN, HEAD_DIM), 0.02),
        'cmp_pos_v': nrm((L, CMP_LEN, HEAD_DIM), 0.02),
        'cnv_dw_w': nrm((L, CONV_K, D_CONV), CONV_K ** -0.5),
        'cnv_dw_b': nrm((L, D_CONV), 0.02),
        'cnv_ln_g': gain((L, D_CONV)),
        'cnv_ln_b': nrm((L, D_CONV), 0.02),
        'out_norm_g': gain((L, D_MIX)),
        'w_out': nrm((L, D_MIX, D_MODEL), D_MIX ** -0.5),
        'moe_rg_w': nrm((L, D_MODEL, MOE_GROUPS), D_MODEL ** -0.5),
        'moe_rg_b': nrm((L, MOE_GROUPS), 0.01),
        'moe_re_w': nrm((L, MOE_GROUPS, D_MODEL, MOE_EXPERTS), D_MODEL ** -0.5),
        'moe_re_b': nrm((L, MOE_GROUPS, MOE_EXPERTS), 0.01),
        'moe_w_gate': nrm((L, MOE_GROUPS, MOE_EXPERTS, D_MODEL, MOE_HID), D_MODEL ** -0.5),
        'moe_w_up': nrm((L, MOE_GROUPS, MOE_EXPERTS, D_MODEL, MOE_HID), D_MODEL ** -0.5),
        'moe_w_down': nrm((L, MOE_GROUPS, MOE_EXPERTS, MOE_HID, D_MODEL), MOE_HID ** -0.5),
        'final_norm_g': gain((D_MODEL,)),
    }


def reference(x, c, positions, ada_w, ada_b, norm1_g, norm2_g, w_in, lru_conv_w, lru_conv_b, lru_wa, lru_ba,
              lru_wx, lru_bx, lru_lambda, cmp_k_w1, cmp_k_w2, cmp_v_w1, cmp_v_w2, cmp_pos_k, cmp_pos_v,
              cnv_dw_w, cnv_dw_b, cnv_ln_g, cnv_ln_b, out_norm_g, w_out, moe_rg_w, moe_rg_b, moe_re_w,
              moe_re_b, moe_w_gate, moe_w_up, moe_w_down, final_norm_g):
    cos, sin = _rope_tables(positions)
    split_pts = [int(v) for v in np.cumsum(IN_SIZES)[:-1]]
    sc = jax.nn.silu(c)
    for l in range(DEPTH):
        mod = sc @ ada_w[l] + ada_b[l]
        sh1, sc1, g1, sh2, sc2, g2 = [m[:, None, :] for m in jnp.split(mod, 6, axis=-1)]
        h = _rmsnorm(x, norm1_g[l]) * (1.0 + sc1) + sh1
        p = h @ w_in[l]
        (xl, gl, qa, kc, vc, ksl, vsl, kwn, vwn, gate_lg, cv) = jnp.split(p, split_pts, axis=-1)
        y_lru = _rglru(xl, gl, lru_conv_w[l], lru_conv_b[l], lru_wa[l], lru_ba[l], lru_wx[l], lru_bx[l],
                       lru_lambda[l])
        y_att = _nsa(qa, kc, vc, ksl, vsl, kwn, vwn, gate_lg, cos, sin, cmp_k_w1[l], cmp_k_w2[l],
                     cmp_v_w1[l], cmp_v_w2[l], cmp_pos_k[l], cmp_pos_v[l])
        y_cnv = _conformer_conv(cv, cnv_dw_w[l], cnv_dw_b[l], cnv_ln_g[l], cnv_ln_b[l])
        gn = out_norm_g[l]
        y = jnp.concatenate([_rmsnorm(y_lru, gn[:D_LRU]),
                             _rmsnorm(y_att, gn[D_LRU:D_LRU + D_ATT]),
                             _rmsnorm(y_cnv, gn[D_LRU + D_ATT:])], axis=-1)
        x = x + g1 * (y @ w_out[l])
        h2 = _rmsnorm(x, norm2_g[l]) * (1.0 + sc2) + sh2
        x = x + g2 * _hier_moe(h2, moe_rg_w[l], moe_rg_b[l], moe_re_w[l], moe_re_b[l], moe_w_gate[l],
                               moe_w_up[l], moe_w_down[l])
    return _rmsnorm(x, final_norm_g)
```

```cpp
#include <hip/hip_runtime.h>
#include <hip/hip_cooperative_groups.h>
#include <cstdio>
#include <cstdint>
#include <cmath>
namespace cg = cooperative_groups;

#ifndef MEGA
#define MEGA 1
#endif

typedef _Float16 h16;
typedef _Float16 h16x8 __attribute__((ext_vector_type(8)));
typedef _Float16 h16x4 __attribute__((ext_vector_type(4)));
typedef float f32x4 __attribute__((ext_vector_type(4)));

constexpr int NB = 2, S = 8192, T = NB * S, D = 1024;
constexpr int NIN = 2432;
constexpr int NINSRC = 2328;
constexpr int C_XL = 0, C_GL = 256, C_Q = 512, C_KC = 1024, C_VC = 1152, C_KS = 1280, C_VS = 1408, C_KW = 1536, C_VW = 1664,
              C_CVA = 1792, C_CVB = 2048, C_GATE = 2304;
constexpr float EPS = 1e-6f;
constexpr int NTHREADS = 256;

constexpr size_t al256(size_t x) { return (x + 255) & ~(size_t)255; }
constexpr size_t OFF_CTL = 0;
constexpr size_t OFF_MOD = 4096;
constexpr size_t OFF_ROPE = al256(OFF_MOD + 2 * 2 * 6144 * 4);
constexpr size_t OFF_PB = al256(OFF_ROPE + (size_t)T * 64 * 4);
constexpr size_t OFF_GATES = al256(OFF_PB + 2 * 256 * 4);
constexpr size_t OFF_WIN = al256(OFF_GATES + (size_t)T * 24 * 4);
constexpr size_t OFF_WOUT = al256(OFF_WIN + (size_t)NIN * 1024 * 2);
constexpr size_t OFF_WGU = al256(OFF_WOUT + (size_t)1024 * 1024 * 2);
constexpr size_t OFF_WDN = al256(OFF_WGU + (size_t)16 * 1024 * 1024 * 2);
constexpr size_t OFF_W1K = al256(OFF_WDN + (size_t)16 * 1024 * 512 * 2);
constexpr size_t OFF_W1V = al256(OFF_W1K + (size_t)256 * 2048 * 2);
constexpr size_t OFF_H16 = al256(OFF_W1V + (size_t)256 * 2048 * 2);
constexpr size_t OFF_Q16 = al256(OFF_H16 + (size_t)T * 1024 * 2);
constexpr size_t KVSZ = (size_t)T * 128 * 2;
constexpr size_t OFF_KC = al256(OFF_Q16 + (size_t)T * 512 * 2);
constexpr size_t OFF_VC = al256(OFF_KC + KVSZ + 4096);
constexpr size_t OFF_KS = al256(OFF_VC + KVSZ + 4096);
constexpr size_t OFF_VST = al256(OFF_KS + KVSZ);
constexpr size_t OFF_KW = al256(OFF_VST + KVSZ);
constexpr size_t OFF_VWT = al256(OFF_KW + KVSZ);
constexpr size_t OFF_HIDC = al256(OFF_VWT + KVSZ);
constexpr size_t OFF_KCMP = al256(OFF_HIDC + (size_t)2 * 2048 * 256 * 2);
constexpr size_t OFF_VCMPT = al256(OFF_KCMP + (size_t)4 * 512 * 64 * 2);
constexpr size_t OFF_LRUH = al256(OFF_VCMPT + (size_t)4 * 512 * 64 * 2);
constexpr size_t OFF_LRUA = al256(OFF_LRUH + (size_t)T * 256 * 4);
constexpr size_t OFF_HEND = al256(OFF_LRUA + (size_t)T * 256 * 4);
constexpr size_t OFF_AEND = al256(OFF_HEND + 2 * 128 * 256 * 4);
constexpr size_t OFF_CARRY = al256(OFF_AEND + 2 * 128 * 256 * 4);
constexpr size_t OFF_XA = al256(OFF_CARRY + 2 * 128 * 256 * 4);
constexpr size_t OFF_LIST = al256(OFF_XA + (size_t)T * 1024 * 4);
constexpr size_t OFF_WPAIR = al256(OFF_LIST + (size_t)16 * 16384 * 4);
constexpr size_t OFF_R = al256(OFF_WPAIR + 32768 * 4);
constexpr size_t OFF_P16 = OFF_R;
constexpr size_t OFF_HID = OFF_R;
constexpr size_t OFF_YPAIR = al256(OFF_HID + (size_t)(32768 + 256) * 512 * 2);
constexpr size_t R_END1 = OFF_P16 + (size_t)T * NIN * 2;
constexpr size_t R_END2 = OFF_YPAIR + (size_t)32768 * 1024 * 2;
constexpr size_t WS_TOTAL = al256(R_END1 > R_END2 ? R_END1 : R_END2);

struct Params {
  const float* in[35];
  float* out;
  unsigned char* ws;
  double inv_freq[32];
};
enum { I_X = 0, I_C, I_POS, I_ADAW, I_ADAB, I_N1G, I_N2G, I_WIN, I_LCW, I_LCB, I_LWA, I_LBA, I_LWX, I_LBX, I_LLAM, I_CKW1, I_CKW2,
       I_CVW1, I_CVW2, I_CPK, I_CPV, I_DWW, I_DWB, I_LNG, I_LNB, I_ONG, I_WOUT, I_RGW, I_RGB, I_REW, I_REB, I_MG, I_MU, I_MD, I_FNG };

__device__ __forceinline__ float wsum(float v) {
#pragma unroll
  for (int o = 32; o > 0; o >>= 1) v += __shfl_xor(v, o);
  return v;
}
__device__ __forceinline__ float sigm(float x) { return 1.f / (1.f + __expf(-x)); }
__device__ __forceinline__ float silu_f(float x) { return x / (1.f + __expf(-x)); }
__device__ __forceinline__ float gelu_tanh(float x) {
  float u = 0.7978845608028654f * (x + 0.044715f * x * x * x);
  float e = __expf(2.f * u);
  float t = 1.f - 2.f / (e + 1.f);
  return 0.5f * x * (1.f + t);
}
__device__ __forceinline__ void glds16(const h16* g, h16* l) {
  __builtin_amdgcn_global_load_lds((const unsigned*)g, (unsigned*)l, 16, 0, 0);
}
__device__ __forceinline__ h16x4 pack4(float a, float b, float c, float d) {
  h16x4 r; r[0] = (h16)a; r[1] = (h16)b; r[2] = (h16)c; r[3] = (h16)d; return r;
}

template <class ARowFn>
__device__ __forceinline__ void gemm_mainloop(f32x4 (&acc)[4][4], ARowFn arow, const h16* __restrict__ Bt, int ldb, int nk, h16* sm) {
  const int tid = threadIdx.x, lane = tid & 63, wave = tid >> 6;
  const int wr = wave >> 1, wc = wave & 1, fr = lane & 15, fq = lane >> 4;
  h16* sA = sm;
  h16* sB = sm + 2 * 8192;
  const h16* ap[4];
  const h16* bp[4];
#pragma unroll
  for (int i = 0; i < 4; ++i) {
    const int r = (i * 4 + wave) * 8 + (lane >> 3);
    const int c = (lane & 7) ^ ((r >> 1) & 7);
    ap[i] = arow(r) + c * 8;
    bp[i] = Bt + (size_t)r * ldb + c * 8;
  }
#pragma unroll
  for (int m = 0; m < 4; ++m)
#pragma unroll
    for (int n = 0; n < 4; ++n) acc[m][n] = (f32x4){0.f, 0.f, 0.f, 0.f};
#pragma unroll
  for (int i = 0; i < 4; ++i) {
    glds16(ap[i], sA + ((i * 4 + wave) * 64 + lane) * 8);
    glds16(bp[i], sB + ((i * 4 + wave) * 64 + lane) * 8);
    ap[i] += 64; bp[i] += 64;
  }
  asm volatile("s_waitcnt vmcnt(0)" ::: "memory");
  __syncthreads();
  for (int kt = 0; kt < nk; ++kt) {
    const int cur = kt & 1;
    if (kt + 1 < nk) {
#pragma unroll
      for (int i = 0; i < 4; ++i) {
        glds16(ap[i], sA + (cur ^ 1) * 8192 + ((i * 4 + wave) * 64 + lane) * 8);
        glds16(bp[i], sB + (cur ^ 1) * 8192 + ((i * 4 + wave) * 64 + lane) * 8);
        ap[i] += 64; bp[i] += 64;
      }
    }
    const h16* cA = sA + cur * 8192;
    const h16* cB = sB + cur * 8192;
#pragma unroll
    for (int ks = 0; ks < 2; ++ks) {
      h16x8 af[4], bf[4];
#pragma unroll
      for (int m = 0; m < 4; ++m) {
        const int row = wr * 64 + m * 16 + fr;
        const int pch = (ks * 4 + fq) ^ ((row >> 1) & 7);
        af[m] = *(const h16x8*)(cA + row * 64 + pch * 8);
      }
#pragma unroll
      for (int n = 0; n < 4; ++n) {
        const int row = wc * 64 + n * 16 + fr;
        const int pch = (ks * 4 + fq) ^ ((row >> 1) & 7);
        bf[n] = *(const h16x8*)(cB + row * 64 + pch * 8);
      }
#pragma unroll
      for (int m = 0; m < 4; ++m)
#pragma unroll
        for (int n = 0; n < 4; ++n) acc[m][n] = __builtin_amdgcn_mfma_f32_16x16x32_f16(bf[n], af[m], acc[m][n], 0, 0, 0);
    }
    asm volatile("s_waitcnt vmcnt(0)" ::: "memory");
    __syncthreads();
  }
}

__device__ __forceinline__ int map_row(int mode, int n) {
  if (mode == 1) return n < 1792 ? n : (n < 1816 ? n + 512 : n - 24);
  if (mode == 2) return 32 * (n >> 4) + (n & 15);
  if (mode == 3) return 32 * (n >> 4) + 16 + (n & 15);
  return n;
}
__device__ __forceinline__ void conv_tile(const float* __restrict__ src, int K, int N, h16* __restrict__ dst, int mode, int tk, int tn, float* sm) {
  const int tid = threadIdx.x;
  const int k0 = tk * 64, n0 = tn * 64;
#pragma unroll
  for (int i = 0; i < 4; ++i) {
    const int idx = i * 256 + tid;
    const int r = idx >> 4, c4 = (idx & 15) * 4;
    float4 v = make_float4(0.f, 0.f, 0.f, 0.f);
    if (n0 + c4 < N) v = *(const float4*)(src + (size_t)(k0 + r) * N + n0 + c4);
    float* d = sm + r * 65 + c4;
    d[0] = v.x; d[1] = v.y; d[2] = v.z; d[3] = v.w;
  }
  __syncthreads();
#pragma unroll
  for (int i = 0; i < 2; ++i) {
    const int idx = i * 256 + tid;
    const int n = idx >> 3, kc = idx & 7;
    if (n0 + n < N) {
      h16x8 o;
#pragma unroll
      for (int j = 0; j < 8; ++j) o[j] = (h16)sm[(kc * 8 + j) * 65 + n];
      *(h16x8*)(dst + (size_t)map_row(mode, n0 + n) * K + k0 + kc * 8) = o;
    }
  }
  __syncthreads();
}

__device__ __forceinline__ void phase_convert(const Params& p, int l, float* sm) {
  unsigned char* ws = p.ws;
  constexpr int T_WIN = 16 * 37, T_WOUT = 256, T_G = 16 * 128, T_W1 = 128;
  constexpr int E0 = T_WIN, E1 = E0 + T_WOUT, E2 = E1 + T_G, E3 = E2 + T_G, E4 = E3 + T_G, E5 = E4 + T_W1, E6 = E5 + T_W1;
  for (int t = blockIdx.x; t < E6; t += gridDim.x) {
    if (t < E0) {
      conv_tile(p.in[I_WIN] + (size_t)l * 1024 * NINSRC, 1024, NINSRC, (h16*)(ws + OFF_WIN), 1, t / 37, t % 37, sm);
    } else if (t < E1) {
      const int u = t - E0;
      conv_tile(p.in[I_WOUT] + (size_t)l * 1024 * 1024, 1024, 1024, (h16*)(ws + OFF_WOUT), 0, u >> 4, u & 15, sm);
    } else if (t < E3) {
      const int up = t >= E2;
      const int u = t - (up ? E2 : E1);
      const int e = u >> 7, v = u & 127;
      conv_tile(p.in[up ? I_MU : I_MG] + ((size_t)l * 16 + e) * 1024 * 512, 1024, 512, (h16*)(ws + OFF_WGU) + (size_t)e * 1024 * 1024, up ? 3 : 2,
                v >> 3, v & 7, sm);
    } else if (t < E4) {
      const int u = t - E3;
      const int e = u >> 7, v = u & 127;
      conv_tile(p.in[I_MD] + ((size_t)l * 16 + e) * 512 * 1024, 512, 1024, (h16*)(ws + OFF_WDN) + (size_t)e * 1024 * 512, 0, v >> 4, v & 15, sm);
    } else {
      const int vv = t >= E5;
      const int u = t - (vv ? E5 : E4);
      conv_tile(p.in[vv ? I_CVW1 : I_CKW1] + (size_t)l * 2048 * 256, 2048, 256, (h16*)(ws + (vv ? OFF_W1V : OFF_W1K)), 0, u >> 2, u & 3, sm);
    }
  }
  {
    h16x8 z = {0, 0, 0, 0, 0, 0, 0, 0};
    h16* w = (h16*)(ws + OFF_WIN) + (size_t)NINSRC * 1024;
    for (int i = blockIdx.x * NTHREADS + threadIdx.x; i < (NIN - NINSRC) * 1024 / 8; i += gridDim.x * NTHREADS) *(h16x8*)(w + (size_t)i * 8) = z;
  }
  for (int t = blockIdx.x; t < 8; t += gridDim.x) {
    const int kv = t >> 2, nt = t & 3;
    const float* w1 = p.in[kv ? I_CVW1 : I_CKW1] + (size_t)l * 2048 * 256;
    const float* pos = p.in[kv ? I_CPV : I_CPK] + (size_t)l * 2048;
    const int n = nt * 64 + (threadIdx.x & 63), kg = threadIdx.x >> 6;
    float s = 0.f;
    for (int k = kg * 512; k < kg * 512 + 512; ++k) s += pos[k] * w1[(size_t)k * 256 + n];
    sm[kg * 64 + (threadIdx.x & 63)] = s;
    __syncthreads();
    if (threadIdx.x < 64) ((float*)(ws + OFF_PB))[kv * 256 + n] = sm[threadIdx.x] + sm[64 + threadIdx.x] + sm[128 + threadIdx.x] + sm[192 + threadIdx.x];
    __syncthreads();
  }
}

__device__ __forceinline__ void phase_prep(const Params& p, float* sm) {
  unsigned char* ws = p.ws;
  const int tid = threadIdx.x;
  if (blockIdx.x == 0) {
    for (int i = tid; i < 1024; i += NTHREADS) ((unsigned*)(ws + OFF_CTL))[i] = 0u;
  }
  float* mod = (float*)(ws + OFF_MOD);
  for (int t = blockIdx.x; t < 384; t += gridDim.x) {
    const int l = t / 192, j0 = (t % 192) * 32;
    const int kg = tid >> 3, cq = tid & 7;
    const float* w = p.in[I_ADAW] + (size_t)l * 1024 * 6144 + j0 + 4 * cq;
    const float* c = p.in[I_C];
    float a0[4] = {0, 0, 0, 0}, a1[4] = {0, 0, 0, 0};
#pragma unroll 8
    for (int k = kg * 32; k < kg * 32 + 32; ++k) {
      const float4 wv = *(const float4*)(w + (size_t)k * 6144);
      const float s0 = silu_f(c[k]), s1 = silu_f(c[1024 + k]);
      a0[0] += s0 * wv.x; a0[1] += s0 * wv.y; a0[2] += s0 * wv.z; a0[3] += s0 * wv.w;
      a1[0] += s1 * wv.x; a1[1] += s1 * wv.y; a1[2] += s1 * wv.z; a1[3] += s1 * wv.w;
    }
    float* r = sm + (kg * 8 + cq) * 8;
#pragma unroll
    for (int i = 0; i < 4; ++i) { r[i] = a0[i]; r[4 + i] = a1[i]; }
    __syncthreads();
    if (tid < 64) {
      const int bb = tid >> 5, col = tid & 31, q = col >> 2, ci = col & 3;
      float s = 0.f;
      for (int g = 0; g < 32; ++g) s += sm[(g * 8 + q) * 8 + bb * 4 + ci];
      mod[(size_t)(l * 2 + bb) * 6144 + j0 + col] = s + p.in[I_ADAB][l * 6144 + j0 + col];
    }
    __syncthreads();
  }
  float* rc = (float*)(ws + OFF_ROPE);
  float* rs = rc + (size_t)T * 32;
  const int* pos = (const int*)p.in[I_POS];
  for (int i = blockIdx.x * NTHREADS + tid; i < T * 32; i += gridDim.x * NTHREADS) {
    const int t = i >> 5, f = i & 31;
    const double a = (double)pos[t] * p.inv_freq[f];
    const double n = rint(a * 0.15915494309189535);
    double r = fma(-n, 6.283185307179586, a);
    r = fma(-n, 2.4492935982947064e-16, r);
    const float rf = (float)r;
    rc[i] = cosf(rf);
    rs[i] = sinf(rf);
  }
}

__device__ __forceinline__ void phase_norm1(const Params& p, int mode) {
  unsigned char* ws = p.ws;
  const int lane = threadIdx.x & 63, wave = threadIdx.x >> 6;
  const float* mod = (const float*)(ws + OFF_MOD);
  float* xa = (float*)(ws + OFF_XA);
  const h16* yp = (const h16*)(ws + OFF_YPAIR);
  h16* hout = (h16*)(ws + OFF_H16);
  const int l = (mode == 0) ? 0 : 1;
  for (int row = blockIdx.x * 4 + wave; row < T; row += gridDim.x * 4) {
    const int b = row >> 13;
    float4 x[4];
    float ss = 0.f;
#pragma unroll
    for (int i = 0; i < 4; ++i) {
      const int col = lane * 4 + 256 * i;
      if (mode == 0) {
        x[i] = *(const float4*)(p.in[I_X] + (size_t)row * D + col);
      } else {
        const int lp = mode == 1 ? 0 : 1;
        const float4 xv = *(const float4*)(xa + (size_t)row * D + col);
        const float4 g2 = *(const float4*)(mod + (size_t)(lp * 2 + b) * 6144 + 5120 + col);
        const h16x4 y0 = *(const h16x4*)(yp + (size_t)(row * 2) * D + col);
        const h16x4 y1 = *(const h16x4*)(yp + (size_t)(row * 2 + 1) * D + col);
        x[i].x = xv.x + g2.x * ((float)y0[0] + (float)y1[0]);
        x[i].y = xv.y + g2.y * ((float)y0[1] + (float)y1[1]);
        x[i].z = xv.z + g2.z * ((float)y0[2] + (float)y1[2]);
        x[i].w = xv.w + g2.w * ((float)y0[3] + (float)y1[3]);
        if (mode == 1) *(float4*)(xa + (size_t)row * D + col) = x[i];
      }
      ss += x[i].x * x[i].x + x[i].y * x[i].y + x[i].z * x[i].z + x[i].w * x[i].w;
    }
    ss = wsum(ss);
    const float rstd = rsqrtf(ss * (1.f / D) + EPS);
#pragma unroll
    for (int i = 0; i < 4; ++i) {
      const int col = lane * 4 + 256 * i;
      if (mode == 2) {
        const float4 g = *(const float4*)(p.in[I_FNG] + col);
        float4 o;
        o.x = x[i].x * rstd * g.x; o.y = x[i].y * rstd * g.y; o.z = x[i].z * rstd * g.z; o.w = x[i].w * rstd * g.w;
        *(float4*)(p.out + (size_t)row * D + col) = o;
      } else {
        const float4 g = *(const float4*)(p.in[I_N1G] + l * D + col);
        const float4 sh = *(const float4*)(mod + (size_t)(l * 2 + b) * 6144 + col);
        const float4 sc = *(const float4*)(mod + (size_t)(l * 2 + b) * 6144 + 1024 + col);
        *(h16x4*)(hout + (size_t)row * D + col) = pack4(x[i].x * rstd * g.x * (1.f + sc.x) + sh.x, x[i].y * rstd * g.y * (1.f + sc.y) + sh.y,
                                                        x[i].z * rstd * g.z * (1.f + sc.z) + sh.z, x[i].w * rstd * g.w * (1.f + sc.w) + sh.w);
      }
    }
  }
}

__device__ __forceinline__ void phase_inproj(const Params& p, h16* sm) {
  unsigned char* ws = p.ws;
  const h16* A = (const h16*)(ws + OFF_H16);
  const h16* W = (const h16*)(ws + OFF_WIN);
  h16* P = (h16*)(ws + OFF_P16);
  const int lane = threadIdx.x & 63, wave = threadIdx.x >> 6, wr = wave >> 1, wc = wave & 1, fr = lane & 15, fq = lane >> 4;
  for (int t = blockIdx.x; t < 128 * 19; t += gridDim.x) {
    const int mt = t / 19, nt = t % 19;
    f32x4 acc[4][4];
    const h16* Ab = A + (size_t)mt * 128 * D;
    gemm_mainloop(acc, [&](int r) { return Ab + (size_t)r * D; }, W + (size_t)nt * 128 * D, D, D / 64, sm);
#pragma unroll
    for (int m = 0; m < 4; ++m)
#pragma unroll
      for (int n = 0; n < 4; ++n) {
        const int row = mt * 128 + wr * 64 + m * 16 + fr, col = nt * 128 + wc * 64 + n * 16 + 4 * fq;
        *(h16x4*)(P + (size_t)row * NIN + col) = pack4(acc[m][n][0], acc[m][n][1], acc[m][n][2], acc[m][n][3]);
      }
  }
}

__device__ __forceinline__ int perm_key(int pos) {
  return 32 * (pos >> 5) + 16 * ((pos >> 2) & 1) + 4 * ((pos >> 3) & 3) + (pos & 3);
}
__device__ __forceinline__ void phase_post(const Params& p) {
  unsigned char* ws = p.ws;
  const h16* P = (const h16*)(ws + OFF_P16);
  const float* rc = (const float*)(ws + OFF_ROPE);
  const float* rs = rc + (size_t)T * 32;
  h16* q16 = (h16*)(ws + OFF_Q16);
  float* gates = (float*)(ws + OFF_GATES);
  const int lane = threadIdx.x & 63, wave = threadIdx.x >> 6;
  for (int row = blockIdx.x * 4 + wave; row < T; row += gridDim.x * 4) {
    const int b = row >> 13, s = row & (S - 1);
    const h16* pr = P + (size_t)row * NIN;
    const int d = (lane & 7) * 4;
    const float4 cs = *(const float4*)(rc + (size_t)row * 32 + d);
    const float4 sn = *(const float4*)(rs + (size_t)row * 32 + d);
    {
      const int hd = lane >> 3;
      const h16x4 a = *(const h16x4*)(pr + C_Q + 64 * hd + d);
      const h16x4 bb = *(const h16x4*)(pr + C_Q + 64 * hd + 32 + d);
      const float a0 = a[0], a1 = a[1], a2 = a[2], a3 = a[3], b0 = bb[0], b1 = bb[1], b2 = bb[2], b3 = bb[3];
      h16* qo = q16 + (size_t)row * 512 + 64 * hd + d;
      *(h16x4*)qo = pack4((a0 * cs.x - b0 * sn.x) * 0.125f, (a1 * cs.y - b1 * sn.y) * 0.125f, (a2 * cs.z - b2 * sn.z) * 0.125f, (a3 * cs.w - b3 * sn.w) * 0.125f);
      *(h16x4*)(qo + 32) = pack4((b0 * cs.x + a0 * sn.x) * 0.125f, (b1 * cs.y + a1 * sn.y) * 0.125f, (b2 * cs.z + a2 * sn.z) * 0.125f, (b3 * cs.w + a3 * sn.w) * 0.125f);
    }
    if (lane < 48) {
      const int tn = lane >> 4, hd = (lane >> 3) & 1;
      const int cb = (tn == 0 ? C_KC : (tn == 1 ? C_KS : C_KW)) + 64 * hd;
      const size_t off = tn == 0 ? OFF_KC : (tn == 1 ? OFF_KS : OFF_KW);
      const h16x4 a = *(const h16x4*)(pr + cb + d);
      const h16x4 bb = *(const h16x4*)(pr + cb + 32 + d);
      const float a0 = a[0], a1 = a[1], a2 = a[2], a3 = a[3], b0 = bb[0], b1 = bb[1], b2 = bb[2], b3 = bb[3];
      h16* ko = (h16*)(ws + off) + ((size_t)(b * 2 + hd) * S + s) * 64 + d;
      *(h16x4*)ko = pack4(a0 * cs.x - b0 * sn.x, a1 * cs.y - b1 * sn.y, a2 * cs.z - b2 * sn.z, a3 * cs.w - b3 * sn.w);
      *(h16x4*)(ko + 32) = pack4(b0 * cs.x + a0 * sn.x, b1 * cs.y + a1 * sn.y, b2 * cs.z + a2 * sn.z, b3 * cs.w + a3 * sn.w);
    }
    if (lane < 32) {
      const int hd = lane >> 4, dd = (lane & 15) * 4;
      *(h16x4*)((h16*)(ws + OFF_VC) + ((size_t)(b * 2 + hd) * S + s) * 64 + dd) = *(const h16x4*)(pr + C_VC + 64 * hd + dd);
    }
    if (lane < 24) gates[(size_t)row * 24 + lane] = sigm((float)pr[C_GATE + lane]);
  }
  for (int task = blockIdx.x; task < 1024; task += gridDim.x) {
    const int tensor = task & 1, kv = (task >> 1) & 1, blk = (task >> 2) & 127, b = task >> 9;
    const int srccol = (tensor ? C_VW : C_VS) + 64 * kv;
    h16* dst = (h16*)(ws + (tensor ? OFF_VWT : OFF_VST)) + ((size_t)((b * 2 + kv) * 128 + blk)) * 4096;
    const int dim = threadIdx.x & 63, kg = threadIdx.x >> 6;
#pragma unroll
    for (int hf = 0; hf < 2; ++hf) {
      const int p0 = kg * 16 + hf * 8;
      h16x8 v;
#pragma unroll
      for (int j = 0; j < 8; ++j) v[j] = P[(size_t)(b * S + blk * 64 + perm_key(p0 + j)) * NIN + srccol + dim];
      *(h16x8*)(dst + dim * 64 + p0) = v;
    }
  }
}

__device__ __forceinline__ void mixa_compress1(const Params& p, int item, h16* sm) {
  unsigned char* ws = p.ws;
  const int which = item >> 5, mt = (item >> 1) & 15, nt = item & 1;
  const h16* A = (const h16*)(ws + (which ? OFF_VC : OFF_KC)) + (size_t)mt * 128 * 1024;
  const h16* W = (const h16*)(ws + (which ? OFF_W1V : OFF_W1K)) + (size_t)nt * 128 * 2048;
  const float* pb = (const float*)(ws + OFF_PB) + which * 256;
  h16* hid = (h16*)(ws + OFF_HIDC) + (size_t)which * 2048 * 256;
  const int lane = threadIdx.x & 63, wave = threadIdx.x >> 6, wr = wave >> 1, wc = wave & 1, fr = lane & 15, fq = lane >> 4;
  f32x4 acc[4][4];
  gemm_mainloop(acc, [&](int r) { return A + (size_t)r * 1024; }, W, 2048, 32, sm);
#pragma unroll
  for (int m = 0; m < 4; ++m)
#pragma unroll
    for (int n = 0; n < 4; ++n) {
      const int row = mt * 128 + wr * 64 + m * 16 + fr, col = nt * 128 + wc * 64 + n * 16 + 4 * fq;
      const float4 bias = *(const float4*)(pb + col);
      *(h16x4*)(hid + (size_t)row * 256 + col) =
          pack4(gelu_tanh(acc[m][n][0] + bias.x), gelu_tanh(acc[m][n][1] + bias.y), gelu_tanh(acc[m][n][2] + bias.z), gelu_tanh(acc[m][n][3] + bias.w));
    }
}

__device__ __forceinline__ void mixa_lru(const Params& p, int l, int item, float* sm) {
  unsigned char* ws = p.ws;
  const int b = item >> 7, ck = item & 127;
  const int c = threadIdx.x;
  const int nb = c >> 6, e = c & 63;
  const h16* P = (const h16*)(ws + OFF_P16);
  const float* cw = p.in[I_LCW] + l * 4 * 256;
  const float w0 = cw[c], w1 = cw[256 + c], w2 = cw[512 + c], w3 = cw[768 + c], cb = p.in[I_LCB][l * 256 + c];
  const float ba = p.in[I_LBA][l * 256 + c], bx = p.in[I_LBX][l * 256 + c];
  const float lam = p.in[I_LLAM][l * 256 + c];
  const float ls = -log1pf(expf(-lam));
  const float* pa = p.in[I_LWA] + ((size_t)(l * 4 + nb) * 64) * 64 + e;
  const float* px = p.in[I_LWX] + ((size_t)(l * 4 + nb) * 64) * 64 + e;
  const int t0 = ck * 64;
  float x0 = 0.f, x1 = 0.f, x2 = 0.f;
  if (t0 >= 3) {
    x0 = (float)P[(size_t)(b * S + t0 - 3) * NIN + C_XL + c];
    x1 = (float)P[(size_t)(b * S + t0 - 2) * NIN + C_XL + c];
    x2 = (float)P[(size_t)(b * S + t0 - 1) * NIN + C_XL + c];
  }
  float h = 0.f, ap = 1.f;
  float* lh = (float*)(ws + OFF_LRUH);
  float* la = (float*)(ws + OFF_LRUA);
  float* sr = sm + 4096;
  float* si = sm + 8192;
#pragma unroll 1
  for (int sub = 0; sub < 4; ++sub) {
    const int tb = t0 + sub * 16;
#pragma unroll 1
    for (int tt = 0; tt < 16; ++tt) {
      const float x3 = (float)P[(size_t)(b * S + tb + tt) * NIN + C_XL + c];
      sm[tt * 256 + c] = w0 * x0 + w1 * x1 + w2 * x2 + w3 * x3 + cb;
      x0 = x1; x1 = x2; x2 = x3;
    }
    __syncthreads();
    {
      float accr[16], acci[16];
#pragma unroll
      for (int tt = 0; tt < 16; ++tt) { accr[tt] = 0.f; acci[tt] = 0.f; }
#pragma unroll 1
      for (int d8 = 0; d8 < 8; ++d8) {
        float wa8[8], wx8[8];
        const float* pa8 = pa + d8 * 512;
        const float* px8 = px + d8 * 512;
#pragma unroll
        for (int j = 0; j < 8; ++j) { wa8[j] = pa8[j * 64]; wx8[j] = px8[j * 64]; }
        const float* xr = sm + nb * 64 + d8 * 8;
#pragma unroll
        for (int tt = 0; tt < 16; ++tt) {
          const float4 xa = *(const float4*)(xr + tt * 256), xb = *(const float4*)(xr + tt * 256 + 4);
          accr[tt] += xa.x * wa8[0] + xa.y * wa8[1] + xa.z * wa8[2] + xa.w * wa8[3] + xb.x * wa8[4] + xb.y * wa8[5] + xb.z * wa8[6] + xb.w * wa8[7];
          acci[tt] += xa.x * wx8[0] + xa.y * wx8[1] + xa.z * wx8[2] + xa.w * wx8[3] + xb.x * wx8[4] + xb.y * wx8[5] + xb.z * wx8[6] + xb.w * wx8[7];
        }
      }
#pragma unroll
      for (int tt = 0; tt < 16; ++tt) { sr[tt * 256 + c] = accr[tt]; si[tt * 256 + c] = acci[tt]; }
    }
    float* lhp = lh + (size_t)(b * S + tb) * 256 + c;
    float* lap = la + (size_t)(b * S + tb) * 256 + c;
#pragma unroll 1
    for (int tt = 0; tt < 16; ++tt) {
      const float r = sigm(sr[tt * 256 + c] + ba), ig = sigm(si[tt * 256 + c] + bx);
      const float log_a = 8.f * r * ls;
      const float a = __expf(log_a);
      const float mult = sqrtf(-expm1f(2.f * log_a));
      const float u = mult * ig * sm[tt * 256 + c];
      h = a * h + u;
      ap *= a;
      lhp[tt * 256] = h;
      lap[tt * 256] = ap;
    }
    __syncthreads();
  }
  ((float*)(ws + OFF_HEND))[(size_t)(b * 128 + ck) * 256 + c] = h;
  ((float*)(ws + OFF_AEND))[(size_t)(b * 128 + ck) * 256 + c] = ap;
}

__device__ __forceinline__ void mixa_conv(const Params& p, int l, int item, float* sm) {
  unsigned char* ws = p.ws;
  const int b = item >> 8, ck = item & 255;
  const int c = threadIdx.x;
  const h16* P = (const h16*)(ws + OFF_P16);
  const int t0 = ck * 32;
  for (int r = 0; r < 62; ++r) {
    const int t = t0 - 30 + r;
    float v = 0.f;
    if (t >= 0) {
      const h16* pr = P + (size_t)(b * S + t) * NIN;
      v = (float)pr[C_CVA + c] * sigm((float)pr[C_CVB + c]);
    }
    sm[r * 256 + c] = v;
  }
  float w[31];
#pragma unroll
  for (int j = 0; j < 31; ++j) w[j] = p.in[I_DWW][(size_t)(l * 31 + j) * 256 + c];
  const float bias = p.in[I_DWB][l * 256 + c];
  for (int i = 0; i < 32; ++i) {
    float z = bias;
#pragma unroll
    for (int j = 0; j < 31; ++j) z += w[j] * sm[(i + j) * 256 + c];
    sm[i * 256 + c] = z;
  }
  __syncthreads();
  const int lane = threadIdx.x & 63, wave = threadIdx.x >> 6;
  const float4 lg = *(const float4*)(p.in[I_LNG] + l * 256 + lane * 4);
  const float4 lb = *(const float4*)(p.in[I_LNB] + l * 256 + lane * 4);
  const float4 gn = *(const float4*)(p.in[I_ONG] + l * 1024 + 768 + lane * 4);
  h16* yc = (h16*)(ws + OFF_H16);
  for (int i = wave * 8; i < wave * 8 + 8; ++i) {
    const float4 z = *(const float4*)(sm + i * 256 + lane * 4);
    const float mu = wsum(z.x + z.y + z.z + z.w) * (1.f / 256.f);
    const float dx = z.x - mu, dy = z.y - mu, dz = z.z - mu, dw = z.w - mu;
    const float var = wsum(dx * dx + dy * dy + dz * dz + dw * dw) * (1.f / 256.f);
    const float rs = rsqrtf(var + EPS);
    const float y0 = silu_f(dx * rs * lg.x + lb.x), y1 = silu_f(dy * rs * lg.y + lb.y), y2 = silu_f(dz * rs * lg.z + lb.z), y3 = silu_f(dw * rs * lg.w + lb.w);
    const float r2 = rsqrtf(wsum(y0 * y0 + y1 * y1 + y2 * y2 + y3 * y3) * (1.f / 256.f) + EPS);
    *(h16x4*)(yc + (size_t)(b * S + t0 + i) * D + 768 + lane * 4) = pack4(y0 * r2 * gn.x, y1 * r2 * gn.y, y2 * r2 * gn.z, y3 * r2 * gn.w);
  }
  __syncthreads();
}

__device__ __forceinline__ void phase_mixa(const Params& p, int l, void* sm) {
  const int G = gridDim.x;
  for (int it = blockIdx.x; it < 64; it += G) mixa_compress1(p, it, (h16*)sm);
  for (int it = (blockIdx.x + G - 64 % G) % G; it < 256; it += G) mixa_lru(p, l, it, (float*)sm);
  for (int it = (blockIdx.x + G - 320 % G) % G; it < 512; it += G) mixa_conv(p, l, it, (float*)sm);
}

__device__ __forceinline__ void phase_mixb(const Params& p, int l) {
  unsigned char* ws = p.ws;
  const int tid = threadIdx.x;
  for (int it = blockIdx.x; it < 1024; it += gridDim.x) {
    const int which = it >> 9;
    const int row = (it & 511) * 4 + (tid >> 6), d = tid & 63;
    const h16* hr = (const h16*)(ws + OFF_HIDC) + ((size_t)which * 2048 + row) * 256;
    const float* w2 = p.in[which ? I_CVW2 : I_CKW2] + (size_t)l * 256 * 64 + d;
    float s = 0.f;
#pragma unroll 4
    for (int j8 = 0; j8 < 32; ++j8) {
      const h16x8 hv = *(const h16x8*)(hr + j8 * 8);
#pragma unroll
      for (int j = 0; j < 8; ++j) s += (float)hv[j] * w2[(size_t)(j8 * 8 + j) * 64];
    }
    const int bkv = row >> 9, n = row & 511;
    if (n == 511) s = 0.f;
    if (which == 0) {
      ((h16*)(ws + OFF_KCMP))[((size_t)bkv * 512 + n) * 64 + d] = (h16)s;
    } else {
      const int blk = n >> 6, key = n & 63;
      const int pos = 32 * (key >> 5) + 8 * ((key >> 2) & 3) + 4 * ((key >> 4) & 1) + (key & 3);
      ((h16*)(ws + OFF_VCMPT))[((size_t)(bkv * 8 + blk) * 64 + d) * 64 + pos] = (h16)s;
    }
  }
  const int g = blockIdx.x * NTHREADS + tid;
  if (g < 512) {
    const int b = g >> 8, c = g & 255;
    const float* he = (const float*)(ws + OFF_HEND) + (size_t)b * 128 * 256 + c;
    const float* ae = (const float*)(ws + OFF_AEND) + (size_t)b * 128 * 256 + c;
    float* cy = (float*)(ws + OFF_CARRY) + (size_t)b * 128 * 256 + c;
    float carry = 0.f;
#pragma unroll 8
    for (int k = 0; k < 128; ++k) {
      cy[k * 256] = carry;
      carry = he[k * 256] + ae[k * 256] * carry;
    }
  }
}

struct AttnState { float m, l; f32x4 o[4]; };

__device__ __forceinline__ void attn_scores(f32x4 (&s)[4], const h16* __restrict__ Kb, const h16x8 (&qf)[2], int h, int c) {
#pragma unroll
  for (int kt = 0; kt < 4; ++kt) {
    s[kt] = (f32x4){0.f, 0.f, 0.f, 0.f};
#pragma unroll
    for (int ks = 0; ks < 2; ++ks) {
      const h16x8 a = *(const h16x8*)(Kb + (16 * kt + c) * 64 + 32 * ks + 8 * h);
      s[kt] = __builtin_amdgcn_mfma_f32_16x16x32_f16(a, qf[ks], s[kt], 0, 0, 0);
    }
  }
}
__device__ __forceinline__ void attn_pv(f32x4 (&o)[4], const h16* __restrict__ Vt, const f32x4 (&pr)[4], int h, int c) {
#pragma unroll
  for (int s2 = 0; s2 < 2; ++s2) {
    h16x8 pf;
#pragma unroll
    for (int i = 0; i < 4; ++i) { pf[i] = (h16)pr[2 * s2][i]; pf[4 + i] = (h16)pr[2 * s2 + 1][i]; }
#pragma unroll
    for (int mt = 0; mt < 4; ++mt) {
      const h16x8 a = *(const h16x8*)(Vt + (16 * mt + c) * 64 + 32 * s2 + 8 * h);
      o[mt] = __builtin_amdgcn_mfma_f32_16x16x32_f16(a, pf, o[mt], 0, 0, 0);
    }
  }
}
template <bool PV>
__device__ __forceinline__ void attn_update(AttnState& st, f32x4 (&s)[4], unsigned vm, const h16* __restrict__ Vt, int h, int c) {
  float bm = -1e30f;
#pragma unroll
  for (int kt = 0; kt < 4; ++kt)
#pragma unroll
    for (int i = 0; i < 4; ++i) {
      const bool v = (vm >> (kt * 4 + i)) & 1u;
      bm = fmaxf(bm, v ? s[kt][i] : -1e30f);
    }
  bm = fmaxf(bm, __shfl_xor(bm, 16));
  bm = fmaxf(bm, __shfl_xor(bm, 32));
  const float mn = fmaxf(st.m, bm);
  const float alpha = __expf(st.m - mn);
  float ps = 0.f;
#pragma unroll
  for (int kt = 0; kt < 4; ++kt)
#pragma unroll
    for (int i = 0; i < 4; ++i) {
      const bool v = (vm >> (kt * 4 + i)) & 1u;
      const float pv = v ? __expf(s[kt][i] - mn) : 0.f;
      s[kt][i] = pv;
      ps += pv;
    }
  st.l = st.l * alpha + ps;
  st.m = mn;
  if (PV) {
#pragma unroll
    for (int mt = 0; mt < 4; ++mt) st.o[mt] *= alpha;
    attn_pv(st.o, Vt, s, h, c);
  }
}

__device__ __forceinline__ void attn_item(const Params& p, int l, int item, float* sm) {
  unsigned char* ws = p.ws;
  const int tid = threadIdx.x, lane = tid & 63, wave = tid >> 6;
  const int b = item >> 10, t0 = (item & 1023) * 8;
  const int qsub = wave & 1, kv = wave >> 1;
  const int h = lane >> 4, c = lane & 15, qi = c >> 2, g = c & 3;
  const int tw0 = t0 + 4 * qsub;
  const int tq = tw0 + qi;
  const int head = kv * 4 + g;
  const int bkv = b * 2 + kv;
  float* imp = sm + wave * 512;
  float* val = sm + 2048 + wave * 128;
  unsigned long long* selm = (unsigned long long*)(sm + 2560) + wave * 8;
  float* obuf = sm + 2560 + 64;

  h16x8 qf[2];
  {
    const h16* qrow = (const h16*)(ws + OFF_Q16) + (size_t)(b * S + tq) * 512 + head * 64;
    qf[0] = *(const h16x8*)(qrow + 8 * h);
    qf[1] = *(const h16x8*)(qrow + 32 + 8 * h);
  }
  for (int i = lane; i < 512; i += 64) imp[i] = 0.f;

  const int nmax = tq >= 31 ? ((tq - 31) >> 4) : -1;
  const int nmax_w = (tw0 + 3) >= 31 ? ((tw0 + 3 - 31) >> 4) : -1;
  const int nkb = nmax_w >= 0 ? (nmax_w >> 6) + 1 : 0;
  const h16* Kc = (const h16*)(ws + OFF_KCMP) + (size_t)bkv * 512 * 64;
  const h16* Vc = (const h16*)(ws + OFF_VCMPT) + (size_t)bkv * 8 * 4096;
  f32x4 ocmp[4];
#pragma unroll
  for (int mt = 0; mt < 4; ++mt) ocmp[mt] = (f32x4){0.f, 0.f, 0.f, 0.f};
  {
    AttnState st; st.m = -1e30f; st.l = 0.f;
    for (int kb = 0; kb < nkb; ++kb) {
      f32x4 s[4];
      attn_scores(s, Kc + kb * 4096, qf, h, c);
      unsigned vm = 0;
#pragma unroll
      for (int kt = 0; kt < 4; ++kt)
#pragma unroll
        for (int i = 0; i < 4; ++i) vm |= ((kb * 64 + 16 * kt + 4 * h + i) <= nmax ? 1u : 0u) << (kt * 4 + i);
      attn_update<false>(st, s, vm, nullptr, h, c);
    }
    float lt = st.l;
    lt += __shfl_xor(lt, 16);
    lt += __shfl_xor(lt, 32);
    const float inv = lt > 0.f ? 1.f / lt : 0.f;
    for (int kb = 0; kb < nkb; ++kb) {
      f32x4 s[4];
      attn_scores(s, Kc + kb * 4096, qf, h, c);
#pragma unroll
      for (int kt = 0; kt < 4; ++kt) {
        float ps = 0.f;
#pragma unroll
        for (int i = 0; i < 4; ++i) {
          const bool v = (kb * 64 + 16 * kt + 4 * h + i) <= nmax;
          const float pv = v ? __expf(s[kt][i] - st.m) * inv : 0.f;
          s[kt][i] = pv;
          ps += pv;
        }
        ps += __shfl_xor(ps, 1);
        ps += __shfl_xor(ps, 2);
        if (g == 0) imp[qi * 128 + kb * 16 + kt * 4 + h] = ps;
      }
      attn_pv(ocmp, Vc + kb * 4096, s, h, c);
    }
  }
  for (int q = 0; q < 4; ++q) {
    const int t = tw0 + q;
    const int own = t >> 6;
    float v0, v1;
    {
      const int j0 = lane, j1 = lane + 64;
      v0 = (j0 == 0 || j0 == own) ? 1e9f : (j0 <= own ? imp[q * 128 + j0] : -1.f);
      v1 = (j1 == own) ? 1e9f : (j1 <= own ? imp[q * 128 + j1] : -1.f);
    }
    val[lane] = v0;
    val[lane + 64] = v1;
    int r0 = 0, r1 = 0;
    for (int i = 0; i < 128; ++i) {
      const float vi = val[i];
      r0 += (vi > v0 || (vi == v0 && i < lane)) ? 1 : 0;
      r1 += (vi > v1 || (vi == v1 && i < lane + 64)) ? 1 : 0;
    }
    const unsigned long long mlo = __ballot(r0 < 16 && lane <= own);
    const unsigned long long mhi = __ballot(r1 < 16 && (lane + 64) <= own);
    if (lane == 0) { selm[q * 2] = mlo; selm[q * 2 + 1] = mhi; }
  }
  const unsigned long long mylo = selm[qi * 2], myhi = selm[qi * 2 + 1];
  unsigned long long ulo = selm[0] | selm[2] | selm[4] | selm[6];
  unsigned long long uhi = selm[1] | selm[3] | selm[5] | selm[7];
  ulo = __builtin_amdgcn_readfirstlane((unsigned)ulo) | ((unsigned long long)__builtin_amdgcn_readfirstlane((unsigned)(ulo >> 32)) << 32);
  uhi = __builtin_amdgcn_readfirstlane((unsigned)uhi) | ((unsigned long long)__builtin_amdgcn_readfirstlane((unsigned)(uhi >> 32)) << 32);

  AttnState ss; ss.m = -1e30f; ss.l = 0.f;
#pragma unroll
  for (int mt = 0; mt < 4; ++mt) ss.o[mt] = (f32x4){0.f, 0.f, 0.f, 0.f};
  {
    const h16* Ks = (const h16*)(ws + OFF_KS) + (size_t)bkv * S * 64;
    const h16* Vs = (const h16*)(ws + OFF_VST) + (size_t)bkv * 128 * 4096;
    for (int w = 0; w < 2; ++w) {
      unsigned long long u = w ? uhi : ulo;
      const unsigned long long mine = w ? myhi : mylo;
      while (u) {
        const int jb = __builtin_ctzll(u);
        u &= u - 1;
        const int j = w * 64 + jb;
        f32x4 s[4];
        attn_scores(s, Ks + (size_t)j * 4096, qf, h, c);
        const bool sel = (mine >> jb) & 1ull;
        unsigned vm = 0;
#pragma unroll
        for (int kt = 0; kt < 4; ++kt)
#pragma unroll
          for (int i = 0; i < 4; ++i) vm |= ((sel && (j * 64 + 16 * kt + 4 * h + i) <= tq) ? 1u : 0u) << (kt * 4 + i);
        attn_update<true>(ss, s, vm, Vs + (size_t)j * 4096, h, c);
      }
    }
  }
  AttnState sw; sw.m = -1e30f; sw.l = 0.f;
#pragma unroll
  for (int mt = 0; mt < 4; ++mt) sw.o[mt] = (f32x4){0.f, 0.f, 0.f, 0.f};
  {
    const h16* Kw = (const h16*)(ws + OFF_KW) + (size_t)bkv * S * 64;
    const h16* Vw = (const h16*)(ws + OFF_VWT) + (size_t)bkv * 128 * 4096;
    const int jlo = tw0 >= 511 ? ((tw0 - 511) >> 6) : 0, jhi = (tw0 + 3) >> 6;
    for (int j = jlo; j <= jhi; ++j) {
      f32x4 s[4];
      attn_scores(s, Kw + (size_t)j * 4096, qf, h, c);
      unsigned vm = 0;
#pragma unroll
      for (int kt = 0; kt < 4; ++kt)
#pragma unroll
        for (int i = 0; i < 4; ++i) {
          const int pos = j * 64 + 16 * kt + 4 * h + i;
          vm |= ((pos <= tq && pos > tq - 512) ? 1u : 0u) << (kt * 4 + i);
        }
      attn_update<true>(sw, s, vm, Vw + (size_t)j * 4096, h, c);
    }
  }
  {
    float ls = ss.l; ls += __shfl_xor(ls, 16); ls += __shfl_xor(ls, 32);
    float lw = sw.l; lw += __shfl_xor(lw, 16); lw += __shfl_xor(lw, 32);
    const float is = ls > 0.f ? 1.f / ls : 0.f, iw = lw > 0.f ? 1.f / lw : 0.f;
    const float* gt = (const float*)(ws + OFF_GATES) + (size_t)(b * S + tq) * 24 + head * 3;
    const float g0 = gt[0], g1 = gt[1] * is, g2 = gt[2] * iw;
    float* orow = obuf + (4 * qsub + qi) * 512 + head * 64;
#pragma unroll
    for (int mt = 0; mt < 4; ++mt) {
      float4 o;
      o.x = g0 * ocmp[mt][0] + g1 * ss.o[mt][0] + g2 * sw.o[mt][0];
      o.y = g0 * ocmp[mt][1] + g1 * ss.o[mt][1] + g2 * sw.o[mt][1];
      o.z = g0 * ocmp[mt][2] + g1 * ss.o[mt][2] + g2 * sw.o[mt][2];
      o.w = g0 * ocmp[mt][3] + g1 * ss.o[mt][3] + g2 * sw.o[mt][3];
      *(float4*)(orow + 16 * mt + 4 * h) = o;
    }
  }
  __syncthreads();
  {
    h16* yc = (h16*)(ws + OFF_H16);
    const float* gn = p.in[I_ONG] + l * 1024 + 256;
#pragma unroll
    for (int qq = 0; qq < 2; ++qq) {
      const int ql = wave * 2 + qq;
      const float4 a = *(const float4*)(obuf + ql * 512 + lane * 4);
      const float4 bq = *(const float4*)(obuf + ql * 512 + 256 + lane * 4);
      const float ssq = wsum(a.x * a.x + a.y * a.y + a.z * a.z + a.w * a.w + bq.x * bq.x + bq.y * bq.y + bq.z * bq.z + bq.w * bq.w);
      const float rstd = rsqrtf(ssq * (1.f / 512.f) + EPS);
      const float4 ga = *(const float4*)(gn + lane * 4), gb = *(const float4*)(gn + 256 + lane * 4);
      h16* yr = yc + (size_t)(b * S + t0 + ql) * D + 256;
      *(h16x4*)(yr + lane * 4) = pack4(a.x * rstd * ga.x, a.y * rstd * ga.y, a.z * rstd * ga.z, a.w * rstd * ga.w);
      *(h16x4*)(yr + 256 + lane * 4) = pack4(bq.x * rstd * gb.x, bq.y * rstd * gb.y, bq.z * rstd * gb.z, bq.w * rstd * gb.w);
    }
  }
  __syncthreads();
}

__device__ __forceinline__ void lrufix_item(const Params& p, int l, int item) {
  unsigned char* ws = p.ws;
  const int lane = threadIdx.x & 63, wave = threadIdx.x >> 6;
  const int b = item >> 7, ck = item & 127;
  const h16* P = (const h16*)(ws + OFF_P16);
  const float4 cy = *(const float4*)((const float*)(ws + OFF_CARRY) + (size_t)(b * 128 + ck) * 256 + lane * 4);
  const float4 gn = *(const float4*)(p.in[I_ONG] + l * 1024 + lane * 4);
  h16* yc = (h16*)(ws + OFF_H16);
  for (int tt = wave * 16; tt < wave * 16 + 16; ++tt) {
    const size_t row = (size_t)(b * S + ck * 64 + tt);
    const float4 hl = *(const float4*)((const float*)(ws + OFF_LRUH) + row * 256 + lane * 4);
    const float4 al = *(const float4*)((const float*)(ws + OFF_LRUA) + row * 256 + lane * 4);
    const h16x4 gl = *(const h16x4*)(P + row * NIN + C_GL + lane * 4);
    const float y0 = (hl.x + al.x * cy.x) * gelu_tanh((float)gl[0]);
    const float y1 = (hl.y + al.y * cy.y) * gelu_tanh((float)gl[1]);
    const float y2 = (hl.z + al.z * cy.z) * gelu_tanh((float)gl[2]);
    const float y3 = (hl.w + al.w * cy.w) * gelu_tanh((float)gl[3]);
    const float rstd = rsqrtf(wsum(y0 * y0 + y1 * y1 + y2 * y2 + y3 * y3) * (1.f / 256.f) + EPS);
    *(h16x4*)(yc + row * D + lane * 4) = pack4(y0 * rstd * gn.x, y1 * rstd * gn.y, y2 * rstd * gn.z, y3 * rstd * gn.w);
  }
}

__device__ __forceinline__ void phase_attn(const Params& p, int l, float* sm) {
  for (int it = blockIdx.x; it < 2048 + 256; it += gridDim.x) {
    if (it < 2048) attn_item(p, l, it, sm);
    else lrufix_item(p, l, it - 2048);
  }
}

__device__ __forceinline__ void phase_outproj(const Params& p, int l, h16* sm) {
  unsigned char* ws = p.ws;
  const h16* A = (const h16*)(ws + OFF_H16);
  const h16* W = (const h16*)(ws + OFF_WOUT);
  const float* mod = (const float*)(ws + OFF_MOD);
  float* xa = (float*)(ws + OFF_XA);
  const float* xin = l == 0 ? p.in[I_X] : (const float*)xa;
  const int lane = threadIdx.x & 63, wave = threadIdx.x >> 6, wr = wave >> 1, wc = wave & 1, fr = lane & 15, fq = lane >> 4;
  for (int t = blockIdx.x; t < 128 * 8; t += gridDim.x) {
    const int mt = t >> 3, nt = t & 7;
    f32x4 acc[4][4];
    const h16* Ab = A + (size_t)mt * 128 * D;
    gemm_mainloop(acc, [&](int r) { return Ab + (size_t)r * D; }, W + (size_t)nt * 128 * D, D, D / 64, sm);
#pragma unroll
    for (int m = 0; m < 4; ++m)
#pragma unroll
      for (int n = 0; n < 4; ++n) {
        const int row = mt * 128 + wr * 64 + m * 16 + fr, col = nt * 128 + wc * 64 + n * 16 + 4 * fq;
        const int b = row >> 13;
        const float4 g1 = *(const float4*)(mod + (size_t)(l * 2 + b) * 6144 + 2048 + col);
        const float4 xv = *(const float4*)(xin + (size_t)row * D + col);
        float4 o;
        o.x = xv.x + g1.x * acc[m][n][0]; o.y = xv.y + g1.y * acc[m][n][1]; o.z = xv.z + g1.z * acc[m][n][2]; o.w = xv.w + g1.w * acc[m][n][3];
        *(float4*)(xa + (size_t)row * D + col) = o;
      }
  }
}

__device__ __forceinline__ void phase_router(const Params& p, int l) {
  unsigned char* ws = p.ws;
  const int lane = threadIdx.x & 63, wave = threadIdx.x >> 6;
  const float* mod = (const float*)(ws + OFF_MOD);
  const float* xa = (const float*)(ws + OFF_XA);
  h16* hout = (h16*)(ws + OFF_H16);
  unsigned* cnt = (unsigned*)(ws + OFF_CTL) + 64 + l * 16;
  int* list = (int*)(ws + OFF_LIST);
  float* wpair = (float*)(ws + OFF_WPAIR);
  const float* rgw = p.in[I_RGW] + (size_t)l * 1024 * 4;
  const float* rgb = p.in[I_RGB] + l * 4;
  for (int row = blockIdx.x * 4 + wave; row < T; row += gridDim.x * 4) {
    const int b = row >> 13;
    float4 x[4];
    float ss = 0.f;
#pragma unroll
    for (int i = 0; i < 4; ++i) {
      x[i] = *(const float4*)(xa + (size_t)row * D + lane * 4 + 256 * i);
      ss += x[i].x * x[i].x + x[i].y * x[i].y + x[i].z * x[i].z + x[i].w * x[i].w;
    }
    ss = wsum(ss);
    const float rstd = rsqrtf(ss * (1.f / D) + EPS);
    float lg0 = 0.f, lg1 = 0.f, lg2 = 0.f, lg3 = 0.f;
#pragma unroll
    for (int i = 0; i < 4; ++i) {
      const int col = lane * 4 + 256 * i;
      const float4 g = *(const float4*)(p.in[I_N2G] + l * D + col);
      const float4 sh = *(const float4*)(mod + (size_t)(l * 2 + b) * 6144 + 3072 + col);
      const float4 sc = *(const float4*)(mod + (size_t)(l * 2 + b) * 6144 + 4096 + col);
      x[i].x = x[i].x * rstd * g.x * (1.f + sc.x) + sh.x;
      x[i].y = x[i].y * rstd * g.y * (1.f + sc.y) + sh.y;
      x[i].z = x[i].z * rstd * g.z * (1.f + sc.z) + sh.z;
      x[i].w = x[i].w * rstd * g.w * (1.f + sc.w) + sh.w;
      *(h16x4*)(hout + (size_t)row * D + col) = pack4(x[i].x, x[i].y, x[i].z, x[i].w);
      const float4 w0 = *(const float4*)(rgw + (size_t)(col + 0) * 4), w1 = *(const float4*)(rgw + (size_t)(col + 1) * 4);
      const float4 w2 = *(const float4*)(rgw + (size_t)(col + 2) * 4), w3 = *(const float4*)(rgw + (size_t)(col + 3) * 4);
      lg0 += x[i].x * w0.x + x[i].y * w1.x + x[i].z * w2.x + x[i].w * w3.x;
      lg1 += x[i].x * w0.y + x[i].y * w1.y + x[i].z * w2.y + x[i].w * w3.y;
      lg2 += x[i].x * w0.z + x[i].y * w1.z + x[i].z * w2.z + x[i].w * w3.z;
      lg3 += x[i].x * w0.w + x[i].y * w1.w + x[i].z * w2.w + x[i].w * w3.w;
    }
    lg0 = wsum(lg0) + rgb[0]; lg1 = wsum(lg1) + rgb[1]; lg2 = wsum(lg2) + rgb[2]; lg3 = wsum(lg3) + rgb[3];
    int gs = 0; float gm = lg0;
    if (lg1 > gm) { gm = lg1; gs = 1; }
    if (lg2 > gm) { gm = lg2; gs = 2; }
    if (lg3 > gm) { gm = lg3; gs = 3; }
    const float pg = 1.f / (__expf(lg0 - gm) + __expf(lg1 - gm) + __expf(lg2 - gm) + __expf(lg3 - gm));
    const float* rew = p.in[I_REW] + ((size_t)(l * 4 + gs) * 1024) * 4;
    const float* reb = p.in[I_REB] + (l * 4 + gs) * 4;
    float e0 = 0.f, e1 = 0.f, e2 = 0.f, e3 = 0.f;
#pragma unroll
    for (int i = 0; i < 4; ++i) {
      const int col = lane * 4 + 256 * i;
      const float4 w0 = *(const float4*)(rew + (size_t)(col + 0) * 4), w1 = *(const float4*)(rew + (size_t)(col + 1) * 4);
      const float4 w2 = *(const float4*)(rew + (size_t)(col + 2) * 4), w3 = *(const float4*)(rew + (size_t)(col + 3) * 4);
      e0 += x[i].x * w0.x + x[i].y * w1.x + x[i].z * w2.x + x[i].w * w3.x;
      e1 += x[i].x * w0.y + x[i].y * w1.y + x[i].z * w2.y + x[i].w * w3.y;
      e2 += x[i].x * w0.z + x[i].y * w1.z + x[i].z * w2.z + x[i].w * w3.z;
      e3 += x[i].x * w0.w + x[i].y * w1.w + x[i].z * w2.w + x[i].w * w3.w;
    }
    float le[4];
    le[0] = wsum(e0) + reb[0]; le[1] = wsum(e1) + reb[1]; le[2] = wsum(e2) + reb[2]; le[3] = wsum(e3) + reb[3];
    int i0 = 0; float v0 = le[0];
    if (le[1] > v0) { v0 = le[1]; i0 = 1; }
    if (le[2] > v0) { v0 = le[2]; i0 = 2; }
    if (le[3] > v0) { v0 = le[3]; i0 = 3; }
    int i1 = -1; float v1 = -3.0e38f;
#pragma unroll
    for (int j = 0; j < 4; ++j) {
      const float vj = (j == 0 ? le[0] : j == 1 ? le[1] : j == 2 ? le[2] : le[3]);
      if (j != i0 && vj > v1) { v1 = vj; i1 = j; }
    }
    const float p0 = 1.f / (1.f + __expf(v1 - v0));
    const float p1 = 1.f - p0;
    if (lane == 0) {
      const int ea = gs * 4 + i0, eb = gs * 4 + i1;
      const unsigned sa = atomicAdd(&cnt[ea], 1u);
      list[(size_t)ea * 16384 + sa] = row * 2;
      wpair[row * 2] = pg * p0;
      const unsigned sb = atomicAdd(&cnt[eb], 1u);
      list[(size_t)eb * 16384 + sb] = row * 2 + 1;
      wpair[row * 2 + 1] = pg * p1;
    }
  }
}

struct MoeSched { int cnt[16]; int toff[17]; int roff[17]; };
__device__ __forceinline__ void moe_sched(const Params& p, int l, MoeSched& s) {
  const unsigned* cnt = (const unsigned*)(p.ws + OFF_CTL) + 64 + l * 16;
  s.toff[0] = 0; s.roff[0] = 0;
#pragma unroll
  for (int e = 0; e < 16; ++e) {
    const int c = (int)__hip_atomic_load(&cnt[e], __ATOMIC_RELAXED, __HIP_MEMORY_SCOPE_AGENT);
    s.cnt[e] = c;
    s.toff[e + 1] = s.toff[e] + ((c + 127) >> 7);
    s.roff[e + 1] = s.roff[e] + c;
  }
}

__device__ __forceinline__ void phase_moe1(const Params& p, int l, h16* sm) {
  unsigned char* ws = p.ws;
  MoeSched sc;
  moe_sched(p, l, sc);
  const int lane = threadIdx.x & 63, wave = threadIdx.x >> 6, wr = wave >> 1, wc = wave & 1, fr = lane & 15, fq = lane >> 4;
  const h16* H = (const h16*)(ws + OFF_H16);
  const int* list = (const int*)(ws + OFF_LIST);
  h16* hid = (h16*)(ws + OFF_HID);
  const int total = sc.toff[16] * 8;
  for (int t = blockIdx.x; t < total; t += gridDim.x) {
    int e = 0, rem = t;
#pragma unroll
    for (int k = 0; k < 16; ++k) {
      const int ne = (sc.toff[k + 1] - sc.toff[k]) * 8;
      if (e == k && rem >= ne) { rem -= ne; e = k + 1; }
    }
    int cnt_e = 0, roff_e = 0, nte = 1;
#pragma unroll
    for (int k = 0; k < 16; ++k) if (k == e) { cnt_e = sc.cnt[k]; roff_e = sc.roff[k]; nte = sc.toff[k + 1] - sc.toff[k]; }
    const int nt = rem / nte, mt = rem % nte;
    const int* le = list + (size_t)e * 16384;
    f32x4 acc[4][4];
    gemm_mainloop(acc, [&](int r) { int sl = mt * 128 + r; sl = sl < cnt_e ? sl : 0; return H + (size_t)(le[sl] >> 1) * D; },
                  (const h16*)(ws + OFF_WGU) + ((size_t)e * 1024 + nt * 128) * 1024, 1024, 16, sm);
#pragma unroll
    for (int m = 0; m < 4; ++m) {
      const int sl = mt * 128 + wr * 64 + m * 16 + fr;
      if (sl < cnt_e) {
#pragma unroll
        for (int n2 = 0; n2 < 2; ++n2) {
          const f32x4 gt = acc[m][2 * n2], up = acc[m][2 * n2 + 1];
          const int col = nt * 64 + wc * 32 + n2 * 16 + 4 * fq;
          *(h16x4*)(hid + (size_t)(roff_e + sl) * 512 + col) = pack4(silu_f(gt[0]) * up[0], silu_f(gt[1]) * up[1], silu_f(gt[2]) * up[2], silu_f(gt[3]) * up[3]);
        }
      }
    }
  }
}

__device__ __forceinline__ void phase_moe2(const Params& p, int l, h16* sm) {
  unsigned char* ws = p.ws;
  MoeSched sc;
  moe_sched(p, l, sc);
  const int lane = threadIdx.x & 63, wave = threadIdx.x >> 6, wr = wave >> 1, wc = wave & 1, fr = lane & 15, fq = lane >> 4;
  const int* list = (const int*)(ws + OFF_LIST);
  const float* wpair = (const float*)(ws + OFF_WPAIR);
  const h16* hid = (const h16*)(ws + OFF_HID);
  h16* yp = (h16*)(ws + OFF_YPAIR);
  const int total = sc.toff[16] * 8;
  for (int t = blockIdx.x; t < total; t += gridDim.x) {
    int e = 0, rem = t;
#pragma unroll
    for (int k = 0; k < 16; ++k) {
      const int ne = (sc.toff[k + 1] - sc.toff[k]) * 8;
      if (e == k && rem >= ne) { rem -= ne; e = k + 1; }
    }
    int cnt_e = 0, roff_e = 0, nte = 1;
#pragma unroll
    for (int k = 0; k < 16; ++k) if (k == e) { cnt_e = sc.cnt[k]; roff_e = sc.roff[k]; nte = sc.toff[k + 1] - sc.toff[k]; }
    const int nt = rem / nte, mt = rem % nte;
    const int* le = list + (size_t)e * 16384;
    const h16* Ab = hid + (size_t)(roff_e + mt * 128) * 512;
    f32x4 acc[4][4];
    gemm_mainloop(acc, [&](int r) { return Ab + (size_t)r * 512; }, (const h16*)(ws + OFF_WDN) + ((size_t)e * 1024 + nt * 128) * 512, 512, 8, sm);
#pragma unroll
    for (int m = 0; m < 4; ++m) {
      const int sl = mt * 128 + wr * 64 + m * 16 + fr;
      if (sl < cnt_e) {
        const int pair = le[sl];
        const float w = wpair[pair];
#pragma unroll
        for (int n = 0; n < 4; ++n) {
          const int col = nt * 128 + wc * 64 + n * 16 + 4 * fq;
          *(h16x4*)(yp + (size_t)pair * D + col) = pack4(acc[m][n][0] * w, acc[m][n][1] * w, acc[m][n][2] * w, acc[m][n][3] * w);
        }
      }
    }
  }
}

constexpr int NSTEPS = 22;
#define STEP(k, body) do { if (s_lo <= (k) && (k) < s_hi) { body; if ((k) + 1 < s_hi) grid.sync(); } } while (0)
#define LAYER_STEPS(l, base) \
  STEP(base + 0, phase_norm1(p, l); if (l == 1) phase_convert(p, 1, (float*)smem)); \
  STEP(base + 1, phase_inproj(p, (h16*)smem)); \
  STEP(base + 2, phase_post(p)); \
  STEP(base + 3, phase_mixa(p, l, smem)); \
  STEP(base + 4, phase_mixb(p, l)); \
  STEP(base + 5, phase_attn(p, l, (float*)smem)); \
  STEP(base + 6, phase_outproj(p, l, (h16*)smem)); \
  STEP(base + 7, phase_router(p, l)); \
  STEP(base + 8, phase_moe1(p, l, (h16*)smem)); \
  STEP(base + 9, phase_moe2(p, l, (h16*)smem))

__global__ void __launch_bounds__(NTHREADS, 2) mega(Params p, int s_lo, int s_hi) {
  __shared__ __attribute__((aligned(16))) unsigned char smem[65536];
  cg::grid_group grid = cg::this_grid();
  STEP(0, phase_prep(p, (float*)smem); phase_convert(p, 0, (float*)smem));
  LAYER_STEPS(0, 1);
  LAYER_STEPS(1, 11);
  STEP(21, phase_norm1(p, 2));
}

extern "C" void kernel_launch(void* const* d_in, const int* in_sizes, int n_in, void* d_out, int out_size, void* d_ws, size_t ws_size,
                              hipStream_t stream) {
  static int grid_blocks = 0;
  if (!grid_blocks) {
    if (n_in != 35 || out_size != T * D || ws_size < WS_TOTAL) {
      fprintf(stderr, "kernel_launch: unexpected problem (n_in %d, out %d, ws %zu < %zu)\n", n_in, out_size, ws_size, (size_t)WS_TOTAL);
      grid_blocks = -1;
      return;
    }
    int dev = 0, cus = 0, per_cu = 0;
    hipGetDevice(&dev);
    hipDeviceGetAttribute(&cus, hipDeviceAttributeMultiprocessorCount, dev);
    hipOccupancyMaxActiveBlocksPerMultiprocessor(&per_cu, mega, NTHREADS, 0);
    if (per_cu > 2) per_cu = 2;
    if (per_cu < 1) { fprintf(stderr, "kernel_launch: occupancy query returned %d\n", per_cu); grid_blocks = -1; return; }
    grid_blocks = cus * per_cu;
  }
  if (grid_blocks < 0) return;
  Params p{};
  for (int i = 0; i < 35; ++i) p.in[i] = (const float*)d_in[i];
  p.out = (float*)d_out;
  p.ws = (unsigned char*)d_ws;
  for (int i = 0; i < 32; ++i) p.inv_freq[i] = std::pow(10000.0, -(double)(2 * i) / 64.0);
#if MEGA
  int lo = 0, hi = NSTEPS;
  void* args[] = {&p, &lo, &hi};
  hipError_t e = hipLaunchCooperativeKernel((void*)mega, dim3(grid_blocks), dim3(NTHREADS), args, 0, stream);
  if (e != hipSuccess) fprintf(stderr, "cooperative launch failed: %s (grid %d)\n", hipGetErrorString(e), grid_blocks);
#else
  for (int s = 0; s < NSTEPS; ++s) {
    int lo = s, hi = s + 1;
    void* args[] = {&p, &lo, &hi};
    hipError_t e = hipLaunchCooperativeKernel((void*)mega, dim3(grid_blocks), dim3(NTHREADS), args, 0, stream);
    if (e != hipSuccess) { fprintf(stderr, "launch %d failed: %s (grid %d)\n", s, hipGetErrorString(e), grid_blocks); break; }
  }
#endif
}
```

```cpp
#include <hip/hip_runtime.h>
#include <hip/hip_cooperative_groups.h>
#include <cstdio>
#include <cstdint>
#include <cmath>
namespace cg = cooperative_groups;

#ifndef MEGA
#define MEGA 1
#endif

typedef _Float16 h16;
typedef _Float16 h16x8 __attribute__((ext_vector_type(8)));
typedef _Float16 h16x4 __attribute__((ext_vector_type(4)));
typedef float f32x4 __attribute__((ext_vector_type(4)));

constexpr int NB = 2, S = 8192, T = NB * S, D = 1024;
constexpr int NIN = 2432;
constexpr int NINSRC = 2328;
constexpr int C_XL = 0, C_GL = 256, C_Q = 512, C_KC = 1024, C_VC = 1152, C_KS = 1280, C_VS = 1408, C_KW = 1536, C_VW = 1664,
              C_CVA = 1792, C_CVB = 2048, C_GATE = 2304;
constexpr float EPS = 1e-6f;
constexpr int NTHREADS = 256;
constexpr float ASCALE = 16.f;

constexpr size_t al256(size_t x) { return (x + 255) & ~(size_t)255; }
constexpr size_t OFF_CTL = 0;
constexpr size_t OFF_MOD = 4096;
constexpr size_t OFF_ROPE = al256(OFF_MOD + 2 * 2 * 6144 * 4);
constexpr size_t OFF_PB = al256(OFF_ROPE + (size_t)T * 64 * 4);
constexpr size_t OFF_GATES = al256(OFF_PB + 2 * 256 * 4);
constexpr size_t OFF_WIN = al256(OFF_GATES + (size_t)T * 24 * 4);
constexpr size_t OFF_WOUT = al256(OFF_WIN + (size_t)NIN * 1024 * 2);
constexpr size_t OFF_WGU = al256(OFF_WOUT + (size_t)1024 * 1024 * 2);
constexpr size_t OFF_WDN = al256(OFF_WGU + (size_t)16 * 1024 * 1024 * 2);
constexpr size_t OFF_W1K = al256(OFF_WDN + (size_t)16 * 1024 * 512 * 2);
constexpr size_t OFF_W1V = al256(OFF_W1K + (size_t)256 * 2048 * 2);
constexpr size_t OFF_H16 = al256(OFF_W1V + (size_t)256 * 2048 * 2);
constexpr size_t OFF_Q16 = al256(OFF_H16 + (size_t)T * 1024 * 2);
constexpr size_t KVSZ = (size_t)T * 128 * 2;
constexpr size_t OFF_KC = al256(OFF_Q16 + (size_t)T * 512 * 2);
constexpr size_t OFF_VC = al256(OFF_KC + KVSZ + 4096);
constexpr size_t OFF_KS = al256(OFF_VC + KVSZ + 4096);
constexpr size_t OFF_VST = al256(OFF_KS + KVSZ);
constexpr size_t OFF_KW = al256(OFF_VST + KVSZ);
constexpr size_t OFF_VWT = al256(OFF_KW + KVSZ);
constexpr size_t OFF_HIDC = al256(OFF_VWT + KVSZ);
constexpr size_t OFF_KCMP = al256(OFF_HIDC + (size_t)2 * 2048 * 256 * 2);
constexpr size_t OFF_VCMPT = al256(OFF_KCMP + (size_t)4 * 512 * 64 * 2);
constexpr size_t OFF_LRUH = al256(OFF_VCMPT + (size_t)4 * 512 * 64 * 2);
constexpr size_t OFF_LRUA = al256(OFF_LRUH + (size_t)T * 256 * 4);
constexpr size_t OFF_HEND = al256(OFF_LRUA + (size_t)T * 256 * 4);
constexpr size_t OFF_AEND = al256(OFF_HEND + 2 * 128 * 256 * 4);
constexpr size_t OFF_CARRY = al256(OFF_AEND + 2 * 128 * 256 * 4);
constexpr size_t OFF_XA = al256(OFF_CARRY + 2 * 128 * 256 * 4);
constexpr size_t OFF_LIST = al256(OFF_XA + (size_t)T * 1024 * 4);
constexpr size_t OFF_WPAIR = al256(OFF_LIST + (size_t)16 * 16384 * 4);
constexpr size_t OFF_SSQ = al256(OFF_WPAIR + 32768 * 4);
constexpr size_t OFF_R = al256(OFF_SSQ + (size_t)T * 2 * 4);
constexpr size_t OFF_P16 = OFF_R;
constexpr size_t OFF_HID = OFF_R;
constexpr size_t OFF_YPAIR = al256(OFF_HID + (size_t)(32768 + 256) * 512 * 2);
constexpr size_t R_END1 = OFF_P16 + (size_t)T * NIN * 2;
constexpr size_t R_END2 = OFF_YPAIR + (size_t)32768 * 1024 * 2;
constexpr size_t WS_TOTAL = al256(R_END1 > R_END2 ? R_END1 : R_END2);

struct Params {
  const float* in[35];
  float* out;
  unsigned char* ws;
  double inv_freq[32];
};
enum { I_X = 0, I_C, I_POS, I_ADAW, I_ADAB, I_N1G, I_N2G, I_WIN, I_LCW, I_LCB, I_LWA, I_LBA, I_LWX, I_LBX, I_LLAM, I_CKW1, I_CKW2,
       I_CVW1, I_CVW2, I_CPK, I_CPV, I_DWW, I_DWB, I_LNG, I_LNB, I_ONG, I_WOUT, I_RGW, I_RGB, I_REW, I_REB, I_MG, I_MU, I_MD, I_FNG };

__device__ __forceinline__ float wsum(float v) {
#pragma unroll
  for (int o = 32; o > 0; o >>= 1) v += __shfl_xor(v, o);
  return v;
}
__device__ __forceinline__ float sigm(float x) { return 1.f / (1.f + __expf(-x)); }
__device__ __forceinline__ float silu_f(float x) { return x / (1.f + __expf(-x)); }
__device__ __forceinline__ float gelu_tanh(float x) {
  float u = 0.7978845608028654f * (x + 0.044715f * x * x * x);
  float e = __expf(2.f * u);
  float t = 1.f - 2.f / (e + 1.f);
  return 0.5f * x * (1.f + t);
}
__device__ __forceinline__ void glds16(const h16* g, h16* l) {
  __builtin_amdgcn_global_load_lds((const unsigned*)g, (unsigned*)l, 16, 0, 0);
}
__device__ __forceinline__ h16x4 pack4(float a, float b, float c, float d) {
  h16x4 r; r[0] = (h16)a; r[1] = (h16)b; r[2] = (h16)c; r[3] = (h16)d; return r;
}

template <class ARowFn>
__device__ __forceinline__ void gemm_mainloop(f32x4 (&acc)[4][4], ARowFn arow, const h16* __restrict__ Bt, int ldb, int nk, h16* sm, bool zero_init = true) {
  const int tid = threadIdx.x, lane = tid & 63, wave = tid >> 6;
  const int wr = wave >> 1, wc = wave & 1, fr = lane & 15, fq = lane >> 4;
  h16* sA = sm;
  h16* sB = sm + 2 * 8192;
  const h16* ap[4];
  const h16* bp[4];
#pragma unroll
  for (int i = 0; i < 4; ++i) {
    const int r = (i * 4 + wave) * 8 + (lane >> 3);
    const int c = (lane & 7) ^ ((r >> 1) & 7);
    ap[i] = arow(r) + c * 8;
    bp[i] = Bt + (size_t)r * ldb + c * 8;
  }
  if (zero_init) {
#pragma unroll
    for (int m = 0; m < 4; ++m)
#pragma unroll
      for (int n = 0; n < 4; ++n) acc[m][n] = (f32x4){0.f, 0.f, 0.f, 0.f};
  }
#pragma unroll
  for (int i = 0; i < 4; ++i) {
    glds16(ap[i], sA + ((i * 4 + wave) * 64 + lane) * 8);
    glds16(bp[i], sB + ((i * 4 + wave) * 64 + lane) * 8);
    ap[i] += 64; bp[i] += 64;
  }
  asm volatile("s_waitcnt vmcnt(0)" ::: "memory");
  __syncthreads();
  for (int kt = 0; kt < nk; ++kt) {
    const int cur = kt & 1;
    if (kt + 1 < nk) {
#pragma unroll
      for (int i = 0; i < 4; ++i) {
        glds16(ap[i], sA + (cur ^ 1) * 8192 + ((i * 4 + wave) * 64 + lane) * 8);
        glds16(bp[i], sB + (cur ^ 1) * 8192 + ((i * 4 + wave) * 64 + lane) * 8);
        ap[i] += 64; bp[i] += 64;
      }
    }
    const h16* cA = sA + cur * 8192;
    const h16* cB = sB + cur * 8192;
#pragma unroll
    for (int ks = 0; ks < 2; ++ks) {
      h16x8 af[4], bf[4];
#pragma unroll
      for (int m = 0; m < 4; ++m) {
        const int row = wr * 64 + m * 16 + fr;
        const int pch = (ks * 4 + fq) ^ ((row >> 1) & 7);
        af[m] = *(const h16x8*)(cA + row * 64 + pch * 8);
      }
#pragma unroll
      for (int n = 0; n < 4; ++n) {
        const int row = wc * 64 + n * 16 + fr;
        const int pch = (ks * 4 + fq) ^ ((row >> 1) & 7);
        bf[n] = *(const h16x8*)(cB + row * 64 + pch * 8);
      }
#pragma unroll
      for (int m = 0; m < 4; ++m)
#pragma unroll
        for (int n = 0; n < 4; ++n) acc[m][n] = __builtin_amdgcn_mfma_f32_16x16x32_f16(bf[n], af[m], acc[m][n], 0, 0, 0);
    }
    asm volatile("s_waitcnt vmcnt(0)" ::: "memory");
    __syncthreads();
  }
}

__device__ __forceinline__ int map_row(int mode, int n) {
  if (mode == 1) return n < 1792 ? n : (n < 1816 ? n + 512 : n - 24);
  if (mode == 2) return 32 * (n >> 4) + (n & 15);
  if (mode == 3) return 32 * (n >> 4) + 16 + (n & 15);
  return n;
}
__device__ __forceinline__ void conv_tile(const float* __restrict__ src, int K, int N, h16* __restrict__ dst, int mode, int tk, int tn, float* sm) {
  const int tid = threadIdx.x;
  const int k0 = tk * 64, n0 = tn * 64;
  const int k0d = mode == 4 ? (k0 < 256 ? k0 + 512 : (k0 < 768 ? k0 - 256 : k0)) : k0;
#pragma unroll
  for (int i = 0; i < 4; ++i) {
    const int idx = i * 256 + tid;
    const int r = idx >> 4, c4 = (idx & 15) * 4;
    float4 v = make_float4(0.f, 0.f, 0.f, 0.f);
    if (n0 + c4 < N) v = *(const float4*)(src + (size_t)(k0 + r) * N + n0 + c4);
    float* d = sm + r * 65 + c4;
    d[0] = v.x; d[1] = v.y; d[2] = v.z; d[3] = v.w;
  }
  __syncthreads();
#pragma unroll
  for (int i = 0; i < 2; ++i) {
    const int idx = i * 256 + tid;
    const int n = idx >> 3, kc = idx & 7;
    if (n0 + n < N) {
      h16x8 o;
#pragma unroll
      for (int j = 0; j < 8; ++j) o[j] = (h16)sm[(kc * 8 + j) * 65 + n];
      *(h16x8*)(dst + (size_t)map_row(mode, n0 + n) * K + k0d + kc * 8) = o;
    }
  }
  __syncthreads();
}

__device__ __forceinline__ void phase_convert(const Params& p, int l, float* sm) {
  unsigned char* ws = p.ws;
  constexpr int T_WIN = 16 * 37, T_WOUT = 256, T_G = 16 * 128, T_W1 = 128;
  constexpr int E0 = T_WIN, E1 = E0 + T_WOUT, E2 = E1 + T_G, E3 = E2 + T_G, E4 = E3 + T_G, E5 = E4 + T_W1, E6 = E5 + T_W1;
  for (int t = blockIdx.x; t < E6; t += gridDim.x) {
    if (t < E0) {
      conv_tile(p.in[I_WIN] + (size_t)l * 1024 * NINSRC, 1024, NINSRC, (h16*)(ws + OFF_WIN), 1, t / 37, t % 37, sm);
    } else if (t < E1) {
      const int u = t - E0;
      conv_tile(p.in[I_WOUT] + (size_t)l * 1024 * 1024, 1024, 1024, (h16*)(ws + OFF_WOUT), 4, u >> 4, u & 15, sm);
    } else if (t < E3) {
      const int up = t >= E2;
      const int u = t - (up ? E2 : E1);
      const int e = u >> 7, v = u & 127;
      conv_tile(p.in[up ? I_MU : I_MG] + ((size_t)l * 16 + e) * 1024 * 512, 1024, 512, (h16*)(ws + OFF_WGU) + (size_t)e * 1024 * 1024, up ? 3 : 2,
                v >> 3, v & 7, sm);
    } else if (t < E4) {
      const int u = t - E3;
      const int e = u >> 7, v = u & 127;
      conv_tile(p.in[I_MD] + ((size_t)l * 16 + e) * 512 * 1024, 512, 1024, (h16*)(ws + OFF_WDN) + (size_t)e * 1024 * 512, 0, v >> 4, v & 15, sm);
    } else {
      const int vv = t >= E5;
      const int u = t - (vv ? E5 : E4);
      conv_tile(p.in[vv ? I_CVW1 : I_CKW1] + (size_t)l * 2048 * 256, 2048, 256, (h16*)(ws + (vv ? OFF_W1V : OFF_W1K)), 0, u >> 2, u & 3, sm);
    }
  }
  {
    h16x8 z = {0, 0, 0, 0, 0, 0, 0, 0};
    h16* w = (h16*)(ws + OFF_WIN) + (size_t)NINSRC * 1024;
    for (int i = blockIdx.x * NTHREADS + threadIdx.x; i < (NIN - NINSRC) * 1024 / 8; i += gridDim.x * NTHREADS) *(h16x8*)(w + (size_t)i * 8) = z;
  }
  for (int t = blockIdx.x; t < 8; t += gridDim.x) {
    const int kv = t >> 2, nt = t & 3;
    const float* w1 = p.in[kv ? I_CVW1 : I_CKW1] + (size_t)l * 2048 * 256;
    const float* pos = p.in[kv ? I_CPV : I_CPK] + (size_t)l * 2048;
    const int n = nt * 64 + (threadIdx.x & 63), kg = threadIdx.x >> 6;
    float s = 0.f;
    for (int k = kg * 512; k < kg * 512 + 512; ++k) s += pos[k] * w1[(size_t)k * 256 + n];
    sm[kg * 64 + (threadIdx.x & 63)] = s;
    __syncthreads();
    if (threadIdx.x < 64) ((float*)(ws + OFF_PB))[kv * 256 + n] = sm[threadIdx.x] + sm[64 + threadIdx.x] + sm[128 + threadIdx.x] + sm[192 + threadIdx.x];
    __syncthreads();
  }
}

__device__ __forceinline__ void phase_prep(const Params& p, float* sm) {
  unsigned char* ws = p.ws;
  const int tid = threadIdx.x;
  if (blockIdx.x == 0) {
    for (int i = tid; i < 1024; i += NTHREADS) ((unsigned*)(ws + OFF_CTL))[i] = 0u;
  }
  float* mod = (float*)(ws + OFF_MOD);
  for (int t = blockIdx.x; t < 384; t += gridDim.x) {
    const int l = t / 192, j0 = (t % 192) * 32;
    const int kg = tid >> 3, cq = tid & 7;
    const float* w = p.in[I_ADAW] + (size_t)l * 1024 * 6144 + j0 + 4 * cq;
    const float* c = p.in[I_C];
    float a0[4] = {0, 0, 0, 0}, a1[4] = {0, 0, 0, 0};
#pragma unroll 8
    for (int k = kg * 32; k < kg * 32 + 32; ++k) {
      const float4 wv = *(const float4*)(w + (size_t)k * 6144);
      const float s0 = silu_f(c[k]), s1 = silu_f(c[1024 + k]);
      a0[0] += s0 * wv.x; a0[1] += s0 * wv.y; a0[2] += s0 * wv.z; a0[3] += s0 * wv.w;
      a1[0] += s1 * wv.x; a1[1] += s1 * wv.y; a1[2] += s1 * wv.z; a1[3] += s1 * wv.w;
    }
    float* r = sm + (kg * 8 + cq) * 8;
#pragma unroll
    for (int i = 0; i < 4; ++i) { r[i] = a0[i]; r[4 + i] = a1[i]; }
    __syncthreads();
    if (tid < 64) {
      const int bb = tid >> 5, col = tid & 31, q = col >> 2, ci = col & 3;
      float s = 0.f;
      for (int g = 0; g < 32; ++g) s += sm[(g * 8 + q) * 8 + bb * 4 + ci];
      mod[(size_t)(l * 2 + bb) * 6144 + j0 + col] = s + p.in[I_ADAB][l * 6144 + j0 + col];
    }
    __syncthreads();
  }
  float* rc = (float*)(ws + OFF_ROPE);
  float* rs = rc + (size_t)T * 32;
  const int* pos = (const int*)p.in[I_POS];
  for (int i = blockIdx.x * NTHREADS + tid; i < T * 32; i += gridDim.x * NTHREADS) {
    const int t = i >> 5, f = i & 31;
    const double a = (double)pos[t] * p.inv_freq[f];
    const double n = rint(a * 0.15915494309189535);
    double r = fma(-n, 6.283185307179586, a);
    r = fma(-n, 2.4492935982947064e-16, r);
    const float rf = (float)r;
    rc[i] = cosf(rf);
    rs[i] = sinf(rf);
  }
}

__device__ __forceinline__ void phase_norm1(const Params& p, int mode) {
  unsigned char* ws = p.ws;
  const int lane = threadIdx.x & 63, wave = threadIdx.x >> 6;
  const float* mod = (const float*)(ws + OFF_MOD);
  float* xa = (float*)(ws + OFF_XA);
  const h16* yp = (const h16*)(ws + OFF_YPAIR);
  h16* hout = (h16*)(ws + OFF_H16);
  const int l = (mode == 0) ? 0 : 1;
  for (int row = blockIdx.x * 4 + wave; row < T; row += gridDim.x * 4) {
    const int b = row >> 13;
    float4 x[4];
    float ss = 0.f;
#pragma unroll
    for (int i = 0; i < 4; ++i) {
      const int col = lane * 4 + 256 * i;
      if (mode == 0) {
        x[i] = *(const float4*)(p.in[I_X] + (size_t)row * D + col);
      } else {
        const int lp = mode == 1 ? 0 : 1;
        const float4 xv = *(const float4*)(xa + (size_t)row * D + col);
        const float4 g2 = *(const float4*)(mod + (size_t)(lp * 2 + b) * 6144 + 5120 + col);
        const h16x4 y0 = *(const h16x4*)(yp + (size_t)(row * 2) * D + col);
        const h16x4 y1 = *(const h16x4*)(yp + (size_t)(row * 2 + 1) * D + col);
        x[i].x = xv.x + g2.x * ((float)y0[0] + (float)y1[0]);
        x[i].y = xv.y + g2.y * ((float)y0[1] + (float)y1[1]);
        x[i].z = xv.z + g2.z * ((float)y0[2] + (float)y1[2]);
        x[i].w = xv.w + g2.w * ((float)y0[3] + (float)y1[3]);
        if (mode == 1) *(float4*)(xa + (size_t)row * D + col) = x[i];
      }
      ss += x[i].x * x[i].x + x[i].y * x[i].y + x[i].z * x[i].z + x[i].w * x[i].w;
    }
    ss = wsum(ss);
    const float rstd = rsqrtf(ss * (1.f / D) + EPS);
#pragma unroll
    for (int i = 0; i < 4; ++i) {
      const int col = lane * 4 + 256 * i;
      if (mode == 2) {
        const float4 g = *(const float4*)(p.in[I_FNG] + col);
        float4 o;
        o.x = x[i].x * rstd * g.x; o.y = x[i].y * rstd * g.y; o.z = x[i].z * rstd * g.z; o.w = x[i].w * rstd * g.w;
        *(float4*)(p.out + (size_t)row * D + col) = o;
      } else {
        const float4 g = *(const float4*)(p.in[I_N1G] + l * D + col);
        const float4 sh = *(const float4*)(mod + (size_t)(l * 2 + b) * 6144 + col);
        const float4 sc = *(const float4*)(mod + (size_t)(l * 2 + b) * 6144 + 1024 + col);
        *(h16x4*)(hout + (size_t)row * D + col) = pack4(x[i].x * rstd * g.x * (1.f + sc.x) + sh.x, x[i].y * rstd * g.y * (1.f + sc.y) + sh.y,
                                                        x[i].z * rstd * g.z * (1.f + sc.z) + sh.z, x[i].w * rstd * g.w * (1.f + sc.w) + sh.w);
      }
    }
  }
}

__device__ __forceinline__ void phase_inproj(const Params& p, h16* sm) {
  unsigned char* ws = p.ws;
  const h16* A = (const h16*)(ws + OFF_H16);
  const h16* W = (const h16*)(ws + OFF_WIN);
  h16* P = (h16*)(ws + OFF_P16);
  const int lane = threadIdx.x & 63, wave = threadIdx.x >> 6, wr = wave >> 1, wc = wave & 1, fr = lane & 15, fq = lane >> 4;
  for (int t = blockIdx.x; t < 128 * 19; t += gridDim.x) {
    const int mt = t / 19, nt = t % 19;
    f32x4 acc[4][4];
    const h16* Ab = A + (size_t)mt * 128 * D;
    gemm_mainloop(acc, [&](int r) { return Ab + (size_t)r * D; }, W + (size_t)nt * 128 * D, D, D / 64, sm);
#pragma unroll
    for (int m = 0; m < 4; ++m)
#pragma unroll
      for (int n = 0; n < 4; ++n) {
        const int row = mt * 128 + wr * 64 + m * 16 + fr, col = nt * 128 + wc * 64 + n * 16 + 4 * fq;
        *(h16x4*)(P + (size_t)row * NIN + col) = pack4(acc[m][n][0], acc[m][n][1], acc[m][n][2], acc[m][n][3]);
      }
  }
}

__device__ __forceinline__ int perm_key(int pos) {
  return 32 * (pos >> 5) + 16 * ((pos >> 2) & 1) + 4 * ((pos >> 3) & 3) + (pos & 3);
}
__device__ __forceinline__ void phase_post(const Params& p) {
  unsigned char* ws = p.ws;
  const h16* P = (const h16*)(ws + OFF_P16);
  const float* rc = (const float*)(ws + OFF_ROPE);
  const float* rs = rc + (size_t)T * 32;
  h16* q16 = (h16*)(ws + OFF_Q16);
  float* gates = (float*)(ws + OFF_GATES);
  const int lane = threadIdx.x & 63, wave = threadIdx.x >> 6;
  for (int row = blockIdx.x * 4 + wave; row < T; row += gridDim.x * 4) {
    const int b = row >> 13, s = row & (S - 1);
    const h16* pr = P + (size_t)row * NIN;
    const int d = (lane & 7) * 4;
    const float4 cs = *(const float4*)(rc + (size_t)row * 32 + d);
    const float4 sn = *(const float4*)(rs + (size_t)row * 32 + d);
    {
      const int hd = lane >> 3;
      const h16x4 a = *(const h16x4*)(pr + C_Q + 64 * hd + d);
      const h16x4 bb = *(const h16x4*)(pr + C_Q + 64 * hd + 32 + d);
      const float a0 = a[0], a1 = a[1], a2 = a[2], a3 = a[3], b0 = bb[0], b1 = bb[1], b2 = bb[2], b3 = bb[3];
      h16* qo = q16 + (size_t)row * 512 + 64 * hd + d;
      *(h16x4*)qo = pack4((a0 * cs.x - b0 * sn.x) * 0.125f, (a1 * cs.y - b1 * sn.y) * 0.125f, (a2 * cs.z - b2 * sn.z) * 0.125f, (a3 * cs.w - b3 * sn.w) * 0.125f);
      *(h16x4*)(qo + 32) = pack4((b0 * cs.x + a0 * sn.x) * 0.125f, (b1 * cs.y + a1 * sn.y) * 0.125f, (b2 * cs.z + a2 * sn.z) * 0.125f, (b3 * cs.w + a3 * sn.w) * 0.125f);
    }
    if (lane < 48) {
      const int tn = lane >> 4, hd = (lane >> 3) & 1;
      const int cb = (tn == 0 ? C_KC : (tn == 1 ? C_KS : C_KW)) + 64 * hd;
      const size_t off = tn == 0 ? OFF_KC : (tn == 1 ? OFF_KS : OFF_KW);
      const h16x4 a = *(const h16x4*)(pr + cb + d);
      const h16x4 bb = *(const h16x4*)(pr + cb + 32 + d);
      const float a0 = a[0], a1 = a[1], a2 = a[2], a3 = a[3], b0 = bb[0], b1 = bb[1], b2 = bb[2], b3 = bb[3];
      h16* ko = (h16*)(ws + off) + ((size_t)(b * 2 + hd) * S + s) * 64 + d;
      *(h16x4*)ko = pack4(a0 * cs.x - b0 * sn.x, a1 * cs.y - b1 * sn.y, a2 * cs.z - b2 * sn.z, a3 * cs.w - b3 * sn.w);
      *(h16x4*)(ko + 32) = pack4(b0 * cs.x + a0 * sn.x, b1 * cs.y + a1 * sn.y, b2 * cs.z + a2 * sn.z, b3 * cs.w + a3 * sn.w);
    }
    if (lane < 32) {
      const int hd = lane >> 4, dd = (lane & 15) * 4;
      *(h16x4*)((h16*)(ws + OFF_VC) + ((size_t)(b * 2 + hd) * S + s) * 64 + dd) = *(const h16x4*)(pr + C_VC + 64 * hd + dd);
    }
    if (lane < 24) gates[(size_t)row * 24 + lane] = sigm((float)pr[C_GATE + lane]);
  }
  for (int task = blockIdx.x; task < 1024; task += gridDim.x) {
    const int tensor = task & 1, kv = (task >> 1) & 1, blk = (task >> 2) & 127, b = task >> 9;
    const int srccol = (tensor ? C_VW : C_VS) + 64 * kv;
    h16* dst = (h16*)(ws + (tensor ? OFF_VWT : OFF_VST)) + ((size_t)((b * 2 + kv) * 128 + blk)) * 4096;
    const int dim = threadIdx.x & 63, kg = threadIdx.x >> 6;
#pragma unroll
    for (int hf = 0; hf < 2; ++hf) {
      const int p0 = kg * 16 + hf * 8;
      h16x8 v;
#pragma unroll
      for (int j = 0; j < 8; ++j) v[j] = P[(size_t)(b * S + blk * 64 + perm_key(p0 + j)) * NIN + srccol + dim];
      *(h16x8*)(dst + dim * 64 + p0) = v;
    }
  }
}

__device__ __forceinline__ void mixa_compress1(const Params& p, int item, h16* sm) {
  unsigned char* ws = p.ws;
  const int which = item >> 5, mt = (item >> 1) & 15, nt = item & 1;
  const h16* A = (const h16*)(ws + (which ? OFF_VC : OFF_KC)) + (size_t)mt * 128 * 1024;
  const h16* W = (const h16*)(ws + (which ? OFF_W1V : OFF_W1K)) + (size_t)nt * 128 * 2048;
  const float* pb = (const float*)(ws + OFF_PB) + which * 256;
  h16* hid = (h16*)(ws + OFF_HIDC) + (size_t)which * 2048 * 256;
  const int lane = threadIdx.x & 63, wave = threadIdx.x >> 6, wr = wave >> 1, wc = wave & 1, fr = lane & 15, fq = lane >> 4;
  f32x4 acc[4][4];
  gemm_mainloop(acc, [&](int r) { return A + (size_t)r * 1024; }, W, 2048, 32, sm);
#pragma unroll
  for (int m = 0; m < 4; ++m)
#pragma unroll
    for (int n = 0; n < 4; ++n) {
      const int row = mt * 128 + wr * 64 + m * 16 + fr, col = nt * 128 + wc * 64 + n * 16 + 4 * fq;
      const float4 bias = *(const float4*)(pb + col);
      *(h16x4*)(hid + (size_t)row * 256 + col) =
          pack4(gelu_tanh(acc[m][n][0] + bias.x), gelu_tanh(acc[m][n][1] + bias.y), gelu_tanh(acc[m][n][2] + bias.z), gelu_tanh(acc[m][n][3] + bias.w));
    }
}

__device__ __forceinline__ void mixa_lru(const Params& p, int l, int item, float* sm) {
  unsigned char* ws = p.ws;
  const int b = item >> 7, ck = item & 127;
  const int c = threadIdx.x;
  const int nb = c >> 6, e = c & 63;
  const h16* P = (const h16*)(ws + OFF_P16);
  const float* cw = p.in[I_LCW] + l * 4 * 256;
  const float w0 = cw[c], w1 = cw[256 + c], w2 = cw[512 + c], w3 = cw[768 + c], cb = p.in[I_LCB][l * 256 + c];
  const float ba = p.in[I_LBA][l * 256 + c], bx = p.in[I_LBX][l * 256 + c];
  const float lam = p.in[I_LLAM][l * 256 + c];
  const float ls = -log1pf(expf(-lam));
  const float* pa = p.in[I_LWA] + ((size_t)(l * 4 + nb) * 64) * 64 + e;
  const float* px = p.in[I_LWX] + ((size_t)(l * 4 + nb) * 64) * 64 + e;
  const int t0 = ck * 64;
  float x0 = 0.f, x1 = 0.f, x2 = 0.f;
  if (t0 >= 3) {
    x0 = (float)P[(size_t)(b * S + t0 - 3) * NIN + C_XL + c];
    x1 = (float)P[(size_t)(b * S + t0 - 2) * NIN + C_XL + c];
    x2 = (float)P[(size_t)(b * S + t0 - 1) * NIN + C_XL + c];
  }
  float h = 0.f, ap = 1.f;
  float* lh = (float*)(ws + OFF_LRUH);
  float* la = (float*)(ws + OFF_LRUA);
  float* sr = sm + 4096;
  float* si = sm + 8192;
#pragma unroll 1
  for (int sub = 0; sub < 4; ++sub) {
    const int tb = t0 + sub * 16;
#pragma unroll 1
    for (int tt = 0; tt < 16; ++tt) {
      const float x3 = (float)P[(size_t)(b * S + tb + tt) * NIN + C_XL + c];
      sm[tt * 256 + c] = w0 * x0 + w1 * x1 + w2 * x2 + w3 * x3 + cb;
      x0 = x1; x1 = x2; x2 = x3;
    }
    __syncthreads();
    {
      float accr[16], acci[16];
#pragma unroll
      for (int tt = 0; tt < 16; ++tt) { accr[tt] = 0.f; acci[tt] = 0.f; }
#pragma unroll 1
      for (int d8 = 0; d8 < 8; ++d8) {
        float wa8[8], wx8[8];
        const float* pa8 = pa + d8 * 512;
        const float* px8 = px + d8 * 512;
#pragma unroll
        for (int j = 0; j < 8; ++j) { wa8[j] = pa8[j * 64]; wx8[j] = px8[j * 64]; }
        const float* xr = sm + nb * 64 + d8 * 8;
#pragma unroll
        for (int tt = 0; tt < 16; ++tt) {
          const float4 xa = *(const float4*)(xr + tt * 256), xb = *(const float4*)(xr + tt * 256 + 4);
          accr[tt] += xa.x * wa8[0] + xa.y * wa8[1] + xa.z * wa8[2] + xa.w * wa8[3] + xb.x * wa8[4] + xb.y * wa8[5] + xb.z * wa8[6] + xb.w * wa8[7];
          acci[tt] += xa.x * wx8[0] + xa.y * wx8[1] + xa.z * wx8[2] + xa.w * wx8[3] + xb.x * wx8[4] + xb.y * wx8[5] + xb.z * wx8[6] + xb.w * wx8[7];
        }
      }
#pragma unroll
      for (int tt = 0; tt < 16; ++tt) { sr[tt * 256 + c] = accr[tt]; si[tt * 256 + c] = acci[tt]; }
    }
    float* lhp = lh + (size_t)(b * S + tb) * 256 + c;
    float* lap = la + (size_t)(b * S + tb) * 256 + c;
#pragma unroll 1
    for (int tt = 0; tt < 16; ++tt) {
      const float r = sigm(sr[tt * 256 + c] + ba), ig = sigm(si[tt * 256 + c] + bx);
      const float log_a = 8.f * r * ls;
      const float a = __expf(log_a);
      const float mult = sqrtf(-expm1f(2.f * log_a));
      const float u = mult * ig * sm[tt * 256 + c];
      h = a * h + u;
      ap *= a;
      lhp[tt * 256] = h;
      lap[tt * 256] = ap;
    }
    __syncthreads();
  }
  ((float*)(ws + OFF_HEND))[(size_t)(b * 128 + ck) * 256 + c] = h;
  ((float*)(ws + OFF_AEND))[(size_t)(b * 128 + ck) * 256 + c] = ap;
}

__device__ __forceinline__ void mixa_conv(const Params& p, int l, int item, float* sm) {
  unsigned char* ws = p.ws;
  const int b = item >> 8, ck = item & 255;
  const int c = threadIdx.x;
  const h16* P = (const h16*)(ws + OFF_P16);
  const int t0 = ck * 32;
  for (int r = 0; r < 62; ++r) {
    const int t = t0 - 30 + r;
    float v = 0.f;
    if (t >= 0) {
      const h16* pr = P + (size_t)(b * S + t) * NIN;
      v = (float)pr[C_CVA + c] * sigm((float)pr[C_CVB + c]);
    }
    sm[r * 256 + c] = v;
  }
  float w[31];
#pragma unroll
  for (int j = 0; j < 31; ++j) w[j] = p.in[I_DWW][(size_t)(l * 31 + j) * 256 + c];
  const float bias = p.in[I_DWB][l * 256 + c];
  for (int i = 0; i < 32; ++i) {
    float z = bias;
#pragma unroll
    for (int j = 0; j < 31; ++j) z += w[j] * sm[(i + j) * 256 + c];
    sm[i * 256 + c] = z;
  }
  __syncthreads();
  const int lane = threadIdx.x & 63, wave = threadIdx.x >> 6;
  const float4 lg = *(const float4*)(p.in[I_LNG] + l * 256 + lane * 4);
  const float4 lb = *(const float4*)(p.in[I_LNB] + l * 256 + lane * 4);
  const float4 gn = *(const float4*)(p.in[I_ONG] + l * 1024 + 768 + lane * 4);
  h16* yc = (h16*)(ws + OFF_H16);
  for (int i = wave * 8; i < wave * 8 + 8; ++i) {
    const float4 z = *(const float4*)(sm + i * 256 + lane * 4);
    const float mu = wsum(z.x + z.y + z.z + z.w) * (1.f / 256.f);
    const float dx = z.x - mu, dy = z.y - mu, dz = z.z - mu, dw = z.w - mu;
    const float var = wsum(dx * dx + dy * dy + dz * dz + dw * dw) * (1.f / 256.f);
    const float rs = rsqrtf(var + EPS);
    const float y0 = silu_f(dx * rs * lg.x + lb.x), y1 = silu_f(dy * rs * lg.y + lb.y), y2 = silu_f(dz * rs * lg.z + lb.z), y3 = silu_f(dw * rs * lg.w + lb.w);
    const float r2 = rsqrtf(wsum(y0 * y0 + y1 * y1 + y2 * y2 + y3 * y3) * (1.f / 256.f) + EPS);
    *(h16x4*)(yc + (size_t)(b * S + t0 + i) * D + 768 + lane * 4) = pack4(y0 * r2 * gn.x, y1 * r2 * gn.y, y2 * r2 * gn.z, y3 * r2 * gn.w);
  }
  __syncthreads();
}

__device__ __forceinline__ void phase_mixa(const Params& p, int l, void* sm) {
  const int G = gridDim.x;
  for (int it = blockIdx.x; it < 64; it += G) mixa_compress1(p, it, (h16*)sm);
  for (int it = (blockIdx.x + G - 64 % G) % G; it < 256; it += G) mixa_lru(p, l, it, (float*)sm);
  for (int it = (blockIdx.x + G - 320 % G) % G; it < 512; it += G) mixa_conv(p, l, it, (float*)sm);
}

__device__ __forceinline__ void phase_mixb(const Params& p, int l) {
  unsigned char* ws = p.ws;
  const int tid = threadIdx.x;
  for (int it = blockIdx.x; it < 1024; it += gridDim.x) {
    const int which = it >> 9;
    const int row = (it & 511) * 4 + (tid >> 6), d = tid & 63;
    const h16* hr = (const h16*)(ws + OFF_HIDC) + ((size_t)which * 2048 + row) * 256;
    const float* w2 = p.in[which ? I_CVW2 : I_CKW2] + (size_t)l * 256 * 64 + d;
    float s = 0.f;
#pragma unroll 4
    for (int j8 = 0; j8 < 32; ++j8) {
      const h16x8 hv = *(const h16x8*)(hr + j8 * 8);
#pragma unroll
      for (int j = 0; j < 8; ++j) s += (float)hv[j] * w2[(size_t)(j8 * 8 + j) * 64];
    }
    const int bkv = row >> 9, n = row & 511;
    if (n == 511) s = 0.f;
    if (which == 0) {
      ((h16*)(ws + OFF_KCMP))[((size_t)bkv * 512 + n) * 64 + d] = (h16)s;
    } else {
      const int blk = n >> 6, key = n & 63;
      const int pos = 32 * (key >> 5) + 8 * ((key >> 2) & 3) + 4 * ((key >> 4) & 1) + (key & 3);
      ((h16*)(ws + OFF_VCMPT))[((size_t)(bkv * 8 + blk) * 64 + d) * 64 + pos] = (h16)s;
    }
  }
  const int g = blockIdx.x * NTHREADS + tid;
  if (g < 512) {
    const int b = g >> 8, c = g & 255;
    const float* he = (const float*)(ws + OFF_HEND) + (size_t)b * 128 * 256 + c;
    const float* ae = (const float*)(ws + OFF_AEND) + (size_t)b * 128 * 256 + c;
    float* cy = (float*)(ws + OFF_CARRY) + (size_t)b * 128 * 256 + c;
    float carry = 0.f;
#pragma unroll 8
    for (int k = 0; k < 128; ++k) {
      cy[k * 256] = carry;
      carry = he[k * 256] + ae[k * 256] * carry;
    }
  }
}

__device__ __forceinline__ void stage8k(const h16* __restrict__ g, h16* l, int tid) {
  const int lane = tid & 63, wave = tid >> 6;
#pragma unroll
  for (int i = 0; i < 2; ++i) {
    const int pz = (i * 4 + wave) * 64 + lane;
    const int r = pz >> 3, cl = (pz & 7) ^ ((r >> 1) & 7);
    glds16(g + r * 64 + cl * 8, l + pz * 8);
  }
}
__device__ __forceinline__ h16x8 ldfrag(const h16* l, int row, int chunk) {
  return *(const h16x8*)(l + row * 64 + ((chunk ^ ((row >> 1) & 7)) * 8));
}

template <int MODE>
__device__ __forceinline__ void attn_branch(const h16* __restrict__ Kg, const h16* __restrict__ Vg, int j0, int j1, h16* ring,
                                            const h16x8 (&qf)[2][2], float (&m)[2], float (&l)[2], f32x4 (&o)[2][4],
                                            const int (&tq)[2], const int (&lim)[2], const int (&tlim)[2],
                                            const unsigned long long (&mylo)[2], const unsigned long long (&myhi)[2],
                                            const unsigned long long (&ulo)[2], const unsigned long long (&uhi)[2],
                                            const float (&inv)[2], float* impw) {
  int tid = threadIdx.x;
  asm volatile("" : "+v"(tid));
  const int lane = tid & 63;
  const int h = lane >> 4, c = lane & 15, qi = c >> 2, g = c & 3;
  constexpr bool PV = MODE != 0;
  const int n = j1 - j0 + 1;
  if (n <= 0) return;
  stage8k(Kg + (size_t)j0 * 4096, ring, tid);
  if (PV) stage8k(Vg + (size_t)j0 * 4096, ring + 4096, tid);
  asm volatile("s_waitcnt vmcnt(0)" ::: "memory");
  __syncthreads();
  for (int it = 0; it < n; ++it) {
    const int j = j0 + it;
    const h16* cK = ring + (it & 1) * 8192;
    const h16* cV = cK + 4096;
    if (it + 1 < n) {
      h16* nb = ring + ((it + 1) & 1) * 8192;
      stage8k(Kg + (size_t)(j + 1) * 4096, nb, tid);
      if (PV) stage8k(Vg + (size_t)(j + 1) * 4096, nb + 4096, tid);
    }
    bool act[2];
#pragma unroll
    for (int mq = 0; mq < 2; ++mq) {
      if (MODE <= 1) act[mq] = j * 64 <= tlim[mq];
      else if (MODE == 2) act[mq] = ((j < 64 ? (ulo[mq] >> j) : (uhi[mq] >> (j - 64))) & 1ull) != 0ull;
      else act[mq] = (j * 64 <= tlim[mq] + 3) && (j * 64 + 63 > tlim[mq] - 512);
    }
    if (act[0] || act[1]) {
      h16x8 pf[2][2];
      h16x8 kf[4][2];
#pragma unroll
      for (int kt = 0; kt < 4; ++kt)
#pragma unroll
        for (int ks = 0; ks < 2; ++ks) kf[kt][ks] = ldfrag(cK, 16 * kt + c, 4 * ks + h);
#pragma unroll
      for (int mq = 0; mq < 2; ++mq)
        if (act[mq]) {
          f32x4 s[1][4];
          {
#pragma unroll
            for (int kt = 0; kt < 4; ++kt) {
              s[0][kt] = (f32x4){0.f, 0.f, 0.f, 0.f};
#pragma unroll
              for (int ks = 0; ks < 2; ++ks) s[0][kt] = __builtin_amdgcn_mfma_f32_16x16x32_f16(kf[kt][ks], qf[mq][ks], s[0][kt], 0, 0, 0);
            }
          }
          const bool selbit = MODE == 2 ? (((j < 64 ? (mylo[mq] >> j) : (myhi[mq] >> (j - 64))) & 1ull) != 0ull) : true;
          const int pbase = j * 64 + 4 * h;
#pragma unroll
          for (int kt = 0; kt < 4; ++kt)
#pragma unroll
            for (int i = 0; i < 4; ++i) {
              const int pos = pbase + 16 * kt + i;
              bool v;
              if (MODE <= 1) v = pos <= lim[mq];
              else if (MODE == 2) v = selbit && pos <= tq[mq];
              else v = pos <= tq[mq] && pos > tq[mq] - 512;
              s[0][kt][i] = v ? s[0][kt][i] : -1e30f;
            }
          if (MODE == 1) {
#pragma unroll
            for (int kt = 0; kt < 4; ++kt) {
              float ps = 0.f;
#pragma unroll
              for (int i = 0; i < 4; ++i) {
                const float pv = __expf(s[0][kt][i] - m[mq]) * inv[mq];
                s[0][kt][i] = pv;
                ps += pv;
              }
              ps += __shfl_xor(ps, 1);
              ps += __shfl_xor(ps, 2);
              if (g == 0) impw[(4 * mq + qi) * 128 + j * 16 + kt * 4 + h] = ps;
            }
          } else {
            float bm = fmaxf(fmaxf(fmaxf(s[0][0][0], s[0][0][1]), fmaxf(s[0][0][2], s[0][0][3])), fmaxf(fmaxf(s[0][1][0], s[0][1][1]), fmaxf(s[0][1][2], s[0][1][3])));
            bm = fmaxf(bm, fmaxf(fmaxf(fmaxf(s[0][2][0], s[0][2][1]), fmaxf(s[0][2][2], s[0][2][3])), fmaxf(fmaxf(s[0][3][0], s[0][3][1]), fmaxf(s[0][3][2], s[0][3][3]))));
            bm = fmaxf(bm, __shfl_xor(bm, 16));
            bm = fmaxf(bm, __shfl_xor(bm, 32));
            const float mn = fmaxf(m[mq], bm);
            const float alpha = __expf(m[mq] - mn);
            const float mref = mn > -1e29f ? mn : 1e30f;
            float ps = 0.f;
#pragma unroll
            for (int kt = 0; kt < 4; ++kt)
#pragma unroll
              for (int i = 0; i < 4; ++i) {
                const float pv = __expf(s[0][kt][i] - mref);
                s[0][kt][i] = pv;
                ps += pv;
              }
            l[mq] = l[mq] * alpha + ps;
            m[mq] = mn;
            if (PV) {
#pragma unroll
              for (int mt = 0; mt < 4; ++mt) o[mq][mt] *= alpha;
            }
          }
          if (PV) {
#pragma unroll
            for (int s2 = 0; s2 < 2; ++s2)
#pragma unroll
              for (int i = 0; i < 4; ++i) { pf[mq][s2][i] = (h16)s[0][2 * s2][i]; pf[mq][s2][4 + i] = (h16)s[0][2 * s2 + 1][i]; }
          }
        }
      if (PV) {
        h16x8 vf[4][2];
#pragma unroll
        for (int mt = 0; mt < 4; ++mt)
#pragma unroll
          for (int s2 = 0; s2 < 2; ++s2) vf[mt][s2] = ldfrag(cV, 16 * mt + c, 4 * s2 + h);
#pragma unroll
        for (int mq = 0; mq < 2; ++mq)
          if (act[mq]) {
#pragma unroll
            for (int s2 = 0; s2 < 2; ++s2) {
#pragma unroll
              for (int mt = 0; mt < 4; ++mt) o[mq][mt] = __builtin_amdgcn_mfma_f32_16x16x32_f16(vf[mt][s2], pf[mq][s2], o[mq][mt], 0, 0, 0);
            }
          }
      }
    }
    asm volatile("s_waitcnt vmcnt(0)" ::: "memory");
    __syncthreads();
  }
}

__device__ __forceinline__ void attn_item(const Params& p, int l, int item, float* sm) {
  unsigned char* ws = p.ws;
  int tid = threadIdx.x;
  asm volatile("" : "+v"(tid));
  const int lane = tid & 63, wave = tid >> 6;
  const int combo = item & 3, qt = item >> 2;
  const int b = combo >> 1, kv = combo & 1;
  const int t0 = qt * 32, tw0 = t0 + 8 * wave;
  const int h = lane >> 4, c = lane & 15, qi = c >> 2, g = c & 3;
  const int head = kv * 4 + g, bkv = b * 2 + kv;
  h16* ring = (h16*)sm;
  float* impw = sm + 8192 + wave * 1024;
  unsigned long long* selm = (unsigned long long*)(sm + 8192 + 4096) + wave * 16;

  h16x8 qf[2][2];
  int tq[2];
#pragma unroll
  for (int mq = 0; mq < 2; ++mq) {
    tq[mq] = tw0 + 4 * mq + qi;
    const h16* qrow = (const h16*)(ws + OFF_Q16) + (size_t)(b * S + tq[mq]) * 512 + head * 64;
    qf[mq][0] = *(const h16x8*)(qrow + 8 * h);
    qf[mq][1] = *(const h16x8*)(qrow + 32 + 8 * h);
  }
  for (int i = lane; i < 1024; i += 64) impw[i] = 0.f;

  h16x4 ofin[2][4];
  float m[2], ll[2], inv[2];
  f32x4 o[2][4];
  const unsigned long long z2[2] = {0ull, 0ull};
  {
    int lim[2], tlim[2];
#pragma unroll
    for (int mq = 0; mq < 2; ++mq) {
      lim[mq] = tq[mq] >= 31 ? ((tq[mq] - 31) >> 4) : -1;
      const int tl = tw0 + 4 * mq + 3;
      tlim[mq] = tl >= 31 ? ((tl - 31) >> 4) : -1;
      m[mq] = -1e30f; ll[mq] = 0.f; inv[mq] = 0.f;
#pragma unroll
      for (int mt = 0; mt < 4; ++mt) o[mq][mt] = (f32x4){0.f, 0.f, 0.f, 0.f};
    }
    const int nl = (t0 + 31 - 31) >> 4;
    const int jl = nl >> 6;
    const h16* Kc = (const h16*)(ws + OFF_KCMP) + (size_t)bkv * 512 * 64;
    const h16* Vc = (const h16*)(ws + OFF_VCMPT) + (size_t)bkv * 8 * 4096;
    attn_branch<0>(Kc, Vc, 0, jl, ring, qf, m, ll, o, tq, lim, tlim, z2, z2, z2, z2, inv, impw);
#pragma unroll
    for (int mq = 0; mq < 2; ++mq) {
      float lt = ll[mq];
      lt += __shfl_xor(lt, 16);
      lt += __shfl_xor(lt, 32);
      inv[mq] = lt > 0.f ? 1.f / lt : 0.f;
    }
    attn_branch<1>(Kc, Vc, 0, jl, ring, qf, m, ll, o, tq, lim, tlim, z2, z2, z2, z2, inv, impw);
    const float* gt0 = (const float*)(ws + OFF_GATES) + (size_t)(b * S) * 24 + head * 3;
#pragma unroll
    for (int mq = 0; mq < 2; ++mq) {
      const float g0 = gt0[(size_t)tq[mq] * 24] * ASCALE;
#pragma unroll
      for (int mt = 0; mt < 4; ++mt) ofin[mq][mt] = pack4(o[mq][mt][0] * g0, o[mq][mt][1] * g0, o[mq][mt][2] * g0, o[mq][mt][3] * g0);
    }
  }
  for (int q = 0; q < 8; ++q) {
    const int t = tw0 + q, own = t >> 6;
    const float* ir = impw + q * 128;
    const int ja = lane, jb = lane + 64;
    unsigned k0 = 0u, k1 = 0u;
    if (ja <= own) k0 = (ja == 0 || ja == own) ? (0xFFFFFF80u | (unsigned)(127 - ja)) : (((__float_as_uint(ir[ja]) & ~127u) | (unsigned)(127 - ja)) + 1u);
    if (jb <= own) k1 = (jb == own) ? (0xFFFFFF80u | (unsigned)(127 - jb)) : (((__float_as_uint(ir[jb]) & ~127u) | (unsigned)(127 - jb)) + 1u);
    unsigned thr = 0u;
    for (int bit = 31; bit >= 0; --bit) {
      const unsigned cand = thr | (1u << bit);
      const int cnt = __popcll(__ballot(k0 >= cand)) + __popcll(__ballot(k1 >= cand));
      if (cnt >= 16) thr = cand;
    }
    const unsigned long long mlo = __ballot(k0 >= thr && ja <= own);
    const unsigned long long mhi = __ballot(k1 >= thr && jb <= own);
    if (lane == 0) { selm[q * 2] = mlo; selm[q * 2 + 1] = mhi; }
  }
  unsigned long long mylo[2], myhi[2], ulo[2], uhi[2];
#pragma unroll
  for (int mq = 0; mq < 2; ++mq) {
    mylo[mq] = selm[(4 * mq + qi) * 2];
    myhi[mq] = selm[(4 * mq + qi) * 2 + 1];
    unsigned long long a = selm[(4 * mq) * 2] | selm[(4 * mq + 1) * 2] | selm[(4 * mq + 2) * 2] | selm[(4 * mq + 3) * 2];
    unsigned long long bb = selm[(4 * mq) * 2 + 1] | selm[(4 * mq + 1) * 2 + 1] | selm[(4 * mq + 2) * 2 + 1] | selm[(4 * mq + 3) * 2 + 1];
    ulo[mq] = (unsigned long long)__builtin_amdgcn_readfirstlane((unsigned)a) | ((unsigned long long)__builtin_amdgcn_readfirstlane((unsigned)(a >> 32)) << 32);
    uhi[mq] = (unsigned long long)__builtin_amdgcn_readfirstlane((unsigned)bb) | ((unsigned long long)__builtin_amdgcn_readfirstlane((unsigned)(bb >> 32)) << 32);
  }
  const float* gtb = (const float*)(ws + OFF_GATES) + (size_t)(b * S) * 24 + head * 3;
  {
    int tl0[2] = {0, 0};
#pragma unroll
    for (int mq = 0; mq < 2; ++mq) {
      m[mq] = -1e30f; ll[mq] = 0.f;
#pragma unroll
      for (int mt = 0; mt < 4; ++mt) o[mq][mt] = (f32x4){0.f, 0.f, 0.f, 0.f};
    }
    attn_branch<2>((const h16*)(ws + OFF_KS) + (size_t)bkv * S * 64, (const h16*)(ws + OFF_VST) + (size_t)bkv * 128 * 4096, 0, (t0 + 31) >> 6, ring, qf, m, ll, o,
                   tq, tl0, tl0, mylo, myhi, ulo, uhi, inv, impw);
#pragma unroll
    for (int mq = 0; mq < 2; ++mq) {
      float lt = ll[mq];
      lt += __shfl_xor(lt, 16);
      lt += __shfl_xor(lt, 32);
      const float sc = lt > 0.f ? gtb[(size_t)tq[mq] * 24 + 1] * ASCALE / lt : 0.f;
#pragma unroll
      for (int mt = 0; mt < 4; ++mt)
        ofin[mq][mt] = pack4((float)ofin[mq][mt][0] + o[mq][mt][0] * sc, (float)ofin[mq][mt][1] + o[mq][mt][1] * sc, (float)ofin[mq][mt][2] + o[mq][mt][2] * sc,
                             (float)ofin[mq][mt][3] + o[mq][mt][3] * sc);
    }
  }
  {
    int tl0[2] = {0, 0}, tf[2];
#pragma unroll
    for (int mq = 0; mq < 2; ++mq) {
      tf[mq] = tw0 + 4 * mq;
      m[mq] = -1e30f; ll[mq] = 0.f;
#pragma unroll
      for (int mt = 0; mt < 4; ++mt) o[mq][mt] = (f32x4){0.f, 0.f, 0.f, 0.f};
    }
    const int jlo = t0 >= 511 ? ((t0 - 511) >> 6) : 0;
    attn_branch<3>((const h16*)(ws + OFF_KW) + (size_t)bkv * S * 64, (const h16*)(ws + OFF_VWT) + (size_t)bkv * 128 * 4096, jlo, (t0 + 31) >> 6, ring, qf, m, ll, o,
                   tq, tl0, tf, z2, z2, z2, z2, inv, impw);
#pragma unroll
    for (int mq = 0; mq < 2; ++mq) {
      float lt = ll[mq];
      lt += __shfl_xor(lt, 16);
      lt += __shfl_xor(lt, 32);
      const float sc = lt > 0.f ? gtb[(size_t)tq[mq] * 24 + 2] * ASCALE / lt : 0.f;
#pragma unroll
      for (int mt = 0; mt < 4; ++mt)
        ofin[mq][mt] = pack4((float)ofin[mq][mt][0] + o[mq][mt][0] * sc, (float)ofin[mq][mt][1] + o[mq][mt][1] * sc, (float)ofin[mq][mt][2] + o[mq][mt][2] * sc,
                             (float)ofin[mq][mt][3] + o[mq][mt][3] * sc);
    }
  }
  {
    h16* yc = (h16*)(ws + OFF_H16);
    const float* gn = p.in[I_ONG] + l * 1024 + 256 + head * 64;
    float* ssq = (float*)(ws + OFF_SSQ);
#pragma unroll
    for (int mq = 0; mq < 2; ++mq) {
      float sq = 0.f;
      h16* yr = yc + (size_t)(b * S + tq[mq]) * D + head * 64;
#pragma unroll
      for (int mt = 0; mt < 4; ++mt) {
        const float v[4] = {(float)ofin[mq][mt][0], (float)ofin[mq][mt][1], (float)ofin[mq][mt][2], (float)ofin[mq][mt][3]};
        sq += v[0] * v[0] + v[1] * v[1] + v[2] * v[2] + v[3] * v[3];
        const float4 gg = *(const float4*)(gn + 16 * mt + 4 * h);
        *(h16x4*)(yr + 16 * mt + 4 * h) = pack4(v[0] * gg.x, v[1] * gg.y, v[2] * gg.z, v[3] * gg.w);
      }
      sq += __shfl_xor(sq, 16);
      sq += __shfl_xor(sq, 32);
      sq += __shfl_xor(sq, 1);
      sq += __shfl_xor(sq, 2);
      if (h == 0 && g == 0) ssq[(size_t)(b * S + tq[mq]) * 2 + kv] = sq * (1.f / (ASCALE * ASCALE));
    }
  }
}

__device__ __forceinline__ void lrufix_item(const Params& p, int l, int item) {
  unsigned char* ws = p.ws;
  const int lane = threadIdx.x & 63, wave = threadIdx.x >> 6;
  const int b = item >> 7, ck = item & 127;
  const h16* P = (const h16*)(ws + OFF_P16);
  const float4 cy = *(const float4*)((const float*)(ws + OFF_CARRY) + (size_t)(b * 128 + ck) * 256 + lane * 4);
  const float4 gn = *(const float4*)(p.in[I_ONG] + l * 1024 + lane * 4);
  h16* yc = (h16*)(ws + OFF_H16);
  for (int tt = wave * 16; tt < wave * 16 + 16; ++tt) {
    const size_t row = (size_t)(b * S + ck * 64 + tt);
    const float4 hl = *(const float4*)((const float*)(ws + OFF_LRUH) + row * 256 + lane * 4);
    const float4 al = *(const float4*)((const float*)(ws + OFF_LRUA) + row * 256 + lane * 4);
    const h16x4 gl = *(const h16x4*)(P + row * NIN + C_GL + lane * 4);
    const float y0 = (hl.x + al.x * cy.x) * gelu_tanh((float)gl[0]);
    const float y1 = (hl.y + al.y * cy.y) * gelu_tanh((float)gl[1]);
    const float y2 = (hl.z + al.z * cy.z) * gelu_tanh((float)gl[2]);
    const float y3 = (hl.w + al.w * cy.w) * gelu_tanh((float)gl[3]);
    const float rstd = rsqrtf(wsum(y0 * y0 + y1 * y1 + y2 * y2 + y3 * y3) * (1.f / 256.f) + EPS);
    *(h16x4*)(yc + row * D + 512 + lane * 4) = pack4(y0 * rstd * gn.x, y1 * rstd * gn.y, y2 * rstd * gn.z, y3 * rstd * gn.w);
  }
}

__device__ __forceinline__ void phase_attn(const Params& p, int l, float* sm) {
  for (int it = blockIdx.x; it < 512; it += gridDim.x) {
#pragma unroll 1
    for (int rep = 0; rep < 2; ++rep) attn_item(p, l, rep ? 1023 - it : it, sm);
  }
  for (int it = blockIdx.x; it < 256; it += gridDim.x) lrufix_item(p, l, it);
}

__device__ __forceinline__ void phase_outproj(const Params& p, int l, h16* sm) {
  unsigned char* ws = p.ws;
  const h16* A = (const h16*)(ws + OFF_H16);
  const h16* W = (const h16*)(ws + OFF_WOUT);
  const float* mod = (const float*)(ws + OFF_MOD);
  float* xa = (float*)(ws + OFF_XA);
  const float* xin = l == 0 ? p.in[I_X] : (const float*)xa;
  const int lane = threadIdx.x & 63, wave = threadIdx.x >> 6, wr = wave >> 1, wc = wave & 1, fr = lane & 15, fq = lane >> 4;
  for (int t = blockIdx.x; t < 128 * 8; t += gridDim.x) {
    const int mt = t >> 3, nt = t & 7;
    f32x4 acc[4][4];
    const h16* Ab = A + (size_t)mt * 128 * D;
    gemm_mainloop(acc, [&](int r) { return Ab + (size_t)r * D; }, W + (size_t)nt * 128 * D, D, 8, sm);
    {
      const float* ssq = (const float*)(ws + OFF_SSQ);
#pragma unroll
      for (int m = 0; m < 4; ++m) {
        const int row = mt * 128 + wr * 64 + m * 16 + fr;
        const float2 q2 = *(const float2*)(ssq + (size_t)row * 2);
        const float sc = rsqrtf((q2.x + q2.y) * (1.f / 512.f) + EPS) * (1.f / ASCALE);
#pragma unroll
        for (int n = 0; n < 4; ++n) acc[m][n] *= sc;
      }
    }
    gemm_mainloop(acc, [&](int r) { return Ab + (size_t)r * D + 512; }, W + (size_t)nt * 128 * D + 512, D, 8, sm, false);
#pragma unroll
    for (int m = 0; m < 4; ++m)
#pragma unroll
      for (int n = 0; n < 4; ++n) {
        const int row = mt * 128 + wr * 64 + m * 16 + fr, col = nt * 128 + wc * 64 + n * 16 + 4 * fq;
        const int b = row >> 13;
        const float4 g1 = *(const float4*)(mod + (size_t)(l * 2 + b) * 6144 + 2048 + col);
        const float4 xv = *(const float4*)(xin + (size_t)row * D + col);
        float4 o;
        o.x = xv.x + g1.x * acc[m][n][0]; o.y = xv.y + g1.y * acc[m][n][1]; o.z = xv.z + g1.z * acc[m][n][2]; o.w = xv.w + g1.w * acc[m][n][3];
        *(float4*)(xa + (size_t)row * D + col) = o;
      }
  }
}

__device__ __forceinline__ void phase_router(const Params& p, int l) {
  unsigned char* ws = p.ws;
  const int lane = threadIdx.x & 63, wave = threadIdx.x >> 6;
  const float* mod = (const float*)(ws + OFF_MOD);
  const float* xa = (const float*)(ws + OFF_XA);
  h16* hout = (h16*)(ws + OFF_H16);
  unsigned* cnt = (unsigned*)(ws + OFF_CTL) + 64 + l * 16;
  int* list = (int*)(ws + OFF_LIST);
  float* wpair = (float*)(ws + OFF_WPAIR);
  const float* rgw = p.in[I_RGW] + (size_t)l * 1024 * 4;
  const float* rgb = p.in[I_RGB] + l * 4;
  for (int row = blockIdx.x * 4 + wave; row < T; row += gridDim.x * 4) {
    const int b = row >> 13;
    float4 x[4];
    float ss = 0.f;
#pragma unroll
    for (int i = 0; i < 4; ++i) {
      x[i] = *(const float4*)(xa + (size_t)row * D + lane * 4 + 256 * i);
      ss += x[i].x * x[i].x + x[i].y * x[i].y + x[i].z * x[i].z + x[i].w * x[i].w;
    }
    ss = wsum(ss);
    const float rstd = rsqrtf(ss * (1.f / D) + EPS);
    float lg0 = 0.f, lg1 = 0.f, lg2 = 0.f, lg3 = 0.f;
#pragma unroll
    for (int i = 0; i < 4; ++i) {
      const int col = lane * 4 + 256 * i;
      const float4 g = *(const float4*)(p.in[I_N2G] + l * D + col);
      const float4 sh = *(const float4*)(mod + (size_t)(l * 2 + b) * 6144 + 3072 + col);
      const float4 sc = *(const float4*)(mod + (size_t)(l * 2 + b) * 6144 + 4096 + col);
      x[i].x = x[i].x * rstd * g.x * (1.f + sc.x) + sh.x;
      x[i].y = x[i].y * rstd * g.y * (1.f + sc.y) + sh.y;
      x[i].z = x[i].z * rstd * g.z * (1.f + sc.z) + sh.z;
      x[i].w = x[i].w * rstd * g.w * (1.f + sc.w) + sh.w;
      *(h16x4*)(hout + (size_t)row * D + col) = pack4(x[i].x, x[i].y, x[i].z, x[i].w);
      const float4 w0 = *(const float4*)(rgw + (size_t)(col + 0) * 4), w1 = *(const float4*)(rgw + (size_t)(col + 1) * 4);
      const float4 w2 = *(const float4*)(rgw + (size_t)(col + 2) * 4), w3 = *(const float4*)(rgw + (size_t)(col + 3) * 4);
      lg0 += x[i].x * w0.x + x[i].y * w1.x + x[i].z * w2.x + x[i].w * w3.x;
      lg1 += x[i].x * w0.y + x[i].y * w1.y + x[i].z * w2.y + x[i].w * w3.y;
      lg2 += x[i].x * w0.z + x[i].y * w1.z + x[i].z * w2.z + x[i].w * w3.z;
      lg3 += x[i].x * w0.w + x[i].y * w1.w + x[i].z * w2.w + x[i].w * w3.w;
    }
    lg0 = wsum(lg0) + rgb[0]; lg1 = wsum(lg1) + rgb[1]; lg2 = wsum(lg2) + rgb[2]; lg3 = wsum(lg3) + rgb[3];
    int gs = 0; float gm = lg0;
    if (lg1 > gm) { gm = lg1; gs = 1; }
    if (lg2 > gm) { gm = lg2; gs = 2; }
    if (lg3 > gm) { gm = lg3; gs = 3; }
    const float pg = 1.f / (__expf(lg0 - gm) + __expf(lg1 - gm) + __expf(lg2 - gm) + __expf(lg3 - gm));
    const float* rew = p.in[I_REW] + ((size_t)(l * 4 + gs) * 1024) * 4;
    const float* reb = p.in[I_REB] + (l * 4 + gs) * 4;
    float e0 = 0.f, e1 = 0.f, e2 = 0.f, e3 = 0.f;
#pragma unroll
    for (int i = 0; i < 4; ++i) {
      const int col = lane * 4 + 256 * i;
      const float4 w0 = *(const float4*)(rew + (size_t)(col + 0) * 4), w1 = *(const float4*)(rew + (size_t)(col + 1) * 4);
      const float4 w2 = *(const float4*)(rew + (size_t)(col + 2) * 4), w3 = *(const float4*)(rew + (size_t)(col + 3) * 4);
      e0 += x[i].x * w0.x + x[i].y * w1.x + x[i].z * w2.x + x[i].w * w3.x;
      e1 += x[i].x * w0.y + x[i].y * w1.y + x[i].z * w2.y + x[i].w * w3.y;
      e2 += x[i].x * w0.z + x[i].y * w1.z + x[i].z * w2.z + x[i].w * w3.z;
      e3 += x[i].x * w0.w + x[i].y * w1.w + x[i].z * w2.w + x[i].w * w3.w;
    }
    float le[4];
    le[0] = wsum(e0) + reb[0]; le[1] = wsum(e1) + reb[1]; le[2] = wsum(e2) + reb[2]; le[3] = wsum(e3) + reb[3];
    int i0 = 0; float v0 = le[0];
    if (le[1] > v0) { v0 = le[1]; i0 = 1; }
    if (le[2] > v0) { v0 = le[2]; i0 = 2; }
    if (le[3] > v0) { v0 = le[3]; i0 = 3; }
    int i1 = -1; float v1 = -3.0e38f;
#pragma unroll
    for (int j = 0; j < 4; ++j) {
      const float vj = (j == 0 ? le[0] : j == 1 ? le[1] : j == 2 ? le[2] : le[3]);
      if (j != i0 && vj > v1) { v1 = vj; i1 = j; }
    }
    const float p0 = 1.f / (1.f + __expf(v1 - v0));
    const float p1 = 1.f - p0;
    if (lane == 0) {
      const int ea = gs * 4 + i0, eb = gs * 4 + i1;
      const unsigned sa = atomicAdd(&cnt[ea], 1u);
      list[(size_t)ea * 16384 + sa] = row * 2;
      wpair[row * 2] = pg * p0;
      const unsigned sb = atomicAdd(&cnt[eb], 1u);
      list[(size_t)eb * 16384 + sb] = row * 2 + 1;
      wpair[row * 2 + 1] = pg * p1;
    }
  }
}

struct MoeSched { int cnt[16]; int toff[17]; int roff[17]; };
__device__ __forceinline__ void moe_sched(const Params& p, int l, MoeSched& s) {
  const unsigned* cnt = (const unsigned*)(p.ws + OFF_CTL) + 64 + l * 16;
  s.toff[0] = 0; s.roff[0] = 0;
#pragma unroll
  for (int e = 0; e < 16; ++e) {
    const int c = (int)__hip_atomic_load(&cnt[e], __ATOMIC_RELAXED, __HIP_MEMORY_SCOPE_AGENT);
    s.cnt[e] = c;
    s.toff[e + 1] = s.toff[e] + ((c + 127) >> 7);
    s.roff[e + 1] = s.roff[e] + c;
  }
}

__device__ __forceinline__ void phase_moe1(const Params& p, int l, h16* sm) {
  unsigned char* ws = p.ws;
  MoeSched sc;
  moe_sched(p, l, sc);
  const int lane = threadIdx.x & 63, wave = threadIdx.x >> 6, wr = wave >> 1, wc = wave & 1, fr = lane & 15, fq = lane >> 4;
  const h16* H = (const h16*)(ws + OFF_H16);
  const int* list = (const int*)(ws + OFF_LIST);
  h16* hid = (h16*)(ws + OFF_HID);
  const int total = sc.toff[16] * 8;
  for (int t = blockIdx.x; t < total; t += gridDim.x) {
    int e = 0, rem = t;
#pragma unroll
    for (int k = 0; k < 16; ++k) {
      const int ne = (sc.toff[k + 1] - sc.toff[k]) * 8;
      if (e == k && rem >= ne) { rem -= ne; e = k + 1; }
    }
    int cnt_e = 0, roff_e = 0, nte = 1;
#pragma unroll
    for (int k = 0; k < 16; ++k) if (k == e) { cnt_e = sc.cnt[k]; roff_e = sc.roff[k]; nte = sc.toff[k + 1] - sc.toff[k]; }
    const int nt = rem / nte, mt = rem % nte;
    const int* le = list + (size_t)e * 16384;
    f32x4 acc[4][4];
    gemm_mainloop(acc, [&](int r) { int sl = mt * 128 + r; sl = sl < cnt_e ? sl : 0; return H + (size_t)(le[sl] >> 1) * D; },
                  (const h16*)(ws + OFF_WGU) + ((size_t)e * 1024 + nt * 128) * 1024, 1024, 16, sm);
#pragma unroll
    for (int m = 0; m < 4; ++m) {
      const int sl = mt * 128 + wr * 64 + m * 16 + fr;
      if (sl < cnt_e) {
#pragma unroll
        for (int n2 = 0; n2 < 2; ++n2) {
          const f32x4 gt = acc[m][2 * n2], up = acc[m][2 * n2 + 1];
          const int col = nt * 64 + wc * 32 + n2 * 16 + 4 * fq;
          *(h16x4*)(hid + (size_t)(roff_e + sl) * 512 + col) = pack4(silu_f(gt[0]) * up[0], silu_f(gt[1]) * up[1], silu_f(gt[2]) * up[2], silu_f(gt[3]) * up[3]);
        }
      }
    }
  }
}

__device__ __forceinline__ void phase_moe2(const Params& p, int l, h16* sm) {
  unsigned char* ws = p.ws;
  MoeSched sc;
  moe_sched(p, l, sc);
  const int lane = threadIdx.x & 63, wave = threadIdx.x >> 6, wr = wave >> 1, wc = wave & 1, fr = lane & 15, fq = lane >> 4;
  const int* list = (const int*)(ws + OFF_LIST);
  const float* wpair = (const float*)(ws + OFF_WPAIR);
  const h16* hid = (const h16*)(ws + OFF_HID);
  h16* yp = (h16*)(ws + OFF_YPAIR);
  const int total = sc.toff[16] * 8;
  for (int t = blockIdx.x; t < total; t += gridDim.x) {
    int e = 0, rem = t;
#pragma unroll
    for (int k = 0; k < 16; ++k) {
      const int ne = (sc.toff[k + 1] - sc.toff[k]) * 8;
      if (e == k && rem >= ne) { rem -= ne; e = k + 1; }
    }
    int cnt_e = 0, roff_e = 0, nte = 1;
#pragma unroll
    for (int k = 0; k < 16; ++k) if (k == e) { cnt_e = sc.cnt[k]; roff_e = sc.roff[k]; nte = sc.toff[k + 1] - sc.toff[k]; }
    const int nt = rem / nte, mt = rem % nte;
    const int* le = list + (size_t)e * 16384;
    const h16* Ab = hid + (size_t)(roff_e + mt * 128) * 512;
    f32x4 acc[4][4];
    gemm_mainloop(acc, [&](int r) { return Ab + (size_t)r * 512; }, (const h16*)(ws + OFF_WDN) + ((size_t)e * 1024 + nt * 128) * 512, 512, 8, sm);
#pragma unroll
    for (int m = 0; m < 4; ++m) {
      const int sl = mt * 128 + wr * 64 + m * 16 + fr;
      if (sl < cnt_e) {
        const int pair = le[sl];
        const float w = wpair[pair];
#pragma unroll
        for (int n = 0; n < 4; ++n) {
          const int col = nt * 128 + wc * 64 + n * 16 + 4 * fq;
          *(h16x4*)(yp + (size_t)pair * D + col) = pack4(acc[m][n][0] * w, acc[m][n][1] * w, acc[m][n][2] * w, acc[m][n][3] * w);
        }
      }
    }
  }
}

constexpr int NSTEPS = 22;
#define STEP(k, body) do { if (s_lo <= (k) && (k) < s_hi) { body; if ((k) + 1 < s_hi) grid.sync(); } } while (0)
#define LAYER_STEPS(l, base) \
  STEP(base + 0, phase_norm1(p, l); if (l == 1) phase_convert(p, 1, (float*)smem)); \
  STEP(base + 1, phase_inproj(p, (h16*)smem)); \
  STEP(base + 2, phase_post(p)); \
  STEP(base + 3, phase_mixa(p, l, smem)); \
  STEP(base + 4, phase_mixb(p, l)); \
  STEP(base + 5, phase_attn(p, l, (float*)smem)); \
  STEP(base + 6, phase_outproj(p, l, (h16*)smem)); \
  STEP(base + 7, phase_router(p, l)); \
  STEP(base + 8, phase_moe1(p, l, (h16*)smem)); \
  STEP(base + 9, phase_moe2(p, l, (h16*)smem))

__global__ void __launch_bounds__(NTHREADS, 2) mega(Params p, int s_lo, int s_hi) {
  __shared__ __attribute__((aligned(16))) unsigned char smem[65536];
  cg::grid_group grid = cg::this_grid();
  STEP(0, phase_prep(p, (float*)smem); phase_convert(p, 0, (float*)smem));
  LAYER_STEPS(0, 1);
  LAYER_STEPS(1, 11);
  STEP(21, phase_norm1(p, 2));
}

extern "C" void kernel_launch(void* const* d_in, const int* in_sizes, int n_in, void* d_out, int out_size, void* d_ws, size_t ws_size,
                              hipStream_t stream) {
  static int grid_blocks = 0;
  if (!grid_blocks) {
    if (n_in != 35 || out_size != T * D || ws_size < WS_TOTAL) {
      fprintf(stderr, "kernel_launch: unexpected problem (n_in %d, out %d, ws %zu < %zu)\n", n_in, out_size, ws_size, (size_t)WS_TOTAL);
      grid_blocks = -1;
      return;
    }
    int dev = 0, cus = 0, per_cu = 0;
    hipGetDevice(&dev);
    hipDeviceGetAttribute(&cus, hipDeviceAttributeMultiprocessorCount, dev);
    hipOccupancyMaxActiveBlocksPerMultiprocessor(&per_cu, mega, NTHREADS, 0);
    if (per_cu > 2) per_cu = 2;
    if (per_cu < 1) { fprintf(stderr, "kernel_launch: occupancy query returned %d\n", per_cu); grid_blocks = -1; return; }
    grid_blocks = cus * per_cu;
  }
  if (grid_blocks < 0) return;
  Params p{};
  for (int i = 0; i < 35; ++i) p.in[i] = (const float*)d_in[i];
  p.out = (float*)d_out;
  p.ws = (unsigned char*)d_ws;
  for (int i = 0; i < 32; ++i) p.inv_freq[i] = std::pow(10000.0, -(double)(2 * i) / 64.0);
#if MEGA
  int lo = 0, hi = NSTEPS;
  void* args[] = {&p, &lo, &hi};
  hipError_t e = hipLaunchCooperativeKernel((void*)mega, dim3(grid_blocks), dim3(NTHREADS), args, 0, stream);
  if (e != hipSuccess) fprintf(stderr, "cooperative launch failed: %s (grid %d)\n", hipGetErrorString(e), grid_blocks);
#else
  for (int s = 0; s < NSTEPS; ++s) {
    int lo = s, hi = s + 1;
    void* args[] = {&p, &lo, &hi};
    hipError_t e = hipLaunchCooperativeKernel((void*)mega, dim3(grid_blocks), dim3(NTHREADS), args, 0, stream);
    if (e != hipSuccess) { fprintf(stderr, "launch %d failed: %s (grid %d)\n", s, hipGetErrorString(e), grid_blocks); break; }
  }
#endif
}
```

```cpp
#include <hip/hip_runtime.h>
#include <hip/hip_cooperative_groups.h>
#include <cstdio>
#include <cstdint>
#include <cmath>
namespace cg = cooperative_groups;

#ifndef MEGA
#define MEGA 1
#endif

typedef _Float16 h16;
typedef _Float16 h16x8 __attribute__((ext_vector_type(8)));
typedef _Float16 h16x4 __attribute__((ext_vector_type(4)));
typedef float f32x4 __attribute__((ext_vector_type(4)));

constexpr int NB = 2, S = 8192, T = NB * S, D = 1024;
constexpr int NIN = 2432;
constexpr int NINSRC = 2328;
constexpr int C_XL = 0, C_GL = 256, C_Q = 512, C_KC = 1024, C_VC = 1152, C_KS = 1280, C_VS = 1408, C_KW = 1536, C_VW = 1664,
              C_CVA = 1792, C_CVB = 2048, C_GATE = 2304;
constexpr float EPS = 1e-6f;
constexpr int NTHREADS = 256;
constexpr float ASCALE = 16.f;

constexpr size_t al256(size_t x) { return (x + 255) & ~(size_t)255; }
constexpr size_t OFF_CTL = 0;
constexpr size_t OFF_BAR = 4096;
constexpr size_t OFF_MOD = 4096 + 16384;
constexpr size_t OFF_ROPE = al256(OFF_MOD + 2 * 2 * 6144 * 4);
constexpr size_t OFF_PB = al256(OFF_ROPE + (size_t)T * 64 * 4);
constexpr size_t OFF_GATES = al256(OFF_PB + 2 * 256 * 4);
constexpr size_t OFF_WIN = al256(OFF_GATES + (size_t)T * 24 * 4);
constexpr size_t OFF_WOUT = al256(OFF_WIN + (size_t)NIN * 1024 * 2);
constexpr size_t OFF_WGU = al256(OFF_WOUT + (size_t)1024 * 1024 * 2);
constexpr size_t OFF_WDN = al256(OFF_WGU + (size_t)16 * 1024 * 1024 * 2);
constexpr size_t OFF_W1K = al256(OFF_WDN + (size_t)16 * 1024 * 512 * 2);
constexpr size_t OFF_W1V = al256(OFF_W1K + (size_t)256 * 2048 * 2);
constexpr size_t OFF_H16 = al256(OFF_W1V + (size_t)256 * 2048 * 2);
constexpr size_t OFF_Q16 = al256(OFF_H16 + (size_t)T * 1024 * 2);
constexpr size_t KVSZ = (size_t)T * 128 * 2;
constexpr size_t OFF_KC = al256(OFF_Q16 + (size_t)T * 512 * 2);
constexpr size_t OFF_VC = al256(OFF_KC + KVSZ + 4096);
constexpr size_t OFF_KS = al256(OFF_VC + KVSZ + 4096);
constexpr size_t OFF_VST = al256(OFF_KS + KVSZ);
constexpr size_t OFF_KW = al256(OFF_VST + KVSZ);
constexpr size_t OFF_VWT = al256(OFF_KW + KVSZ);
constexpr size_t OFF_HIDC = al256(OFF_VWT + KVSZ);
constexpr size_t OFF_KCMP = al256(OFF_HIDC + (size_t)2 * 2048 * 256 * 2);
constexpr size_t OFF_VCMPT = al256(OFF_KCMP + (size_t)4 * 512 * 64 * 2);
constexpr size_t OFF_LRUH = al256(OFF_VCMPT + (size_t)4 * 512 * 64 * 2);
constexpr size_t OFF_LRUA = al256(OFF_LRUH + (size_t)T * 256 * 4);
constexpr size_t OFF_HEND = al256(OFF_LRUA + (size_t)T * 256 * 4);
constexpr size_t OFF_AEND = al256(OFF_HEND + 2 * 128 * 256 * 4);
constexpr size_t OFF_CARRY = al256(OFF_AEND + 2 * 128 * 256 * 4);
constexpr size_t OFF_XA = al256(OFF_CARRY + 2 * 128 * 256 * 4);
constexpr size_t OFF_LIST = al256(OFF_XA + (size_t)T * 1024 * 4);
constexpr size_t OFF_WPAIR = al256(OFF_LIST + (size_t)16 * 16384 * 4);
constexpr size_t OFF_SSQ = al256(OFF_WPAIR + 32768 * 4);
constexpr size_t OFF_R = al256(OFF_SSQ + (size_t)T * 2 * 4);
constexpr size_t OFF_P16 = OFF_R;
constexpr size_t OFF_HID = OFF_R;
constexpr size_t OFF_YPAIR = al256(OFF_HID + (size_t)(32768 + 256) * 512 * 2);
constexpr size_t R_END1 = OFF_P16 + (size_t)T * NIN * 2;
constexpr size_t R_END2 = OFF_YPAIR + (size_t)32768 * 1024 * 2;
constexpr size_t WS_TOTAL = al256(R_END1 > R_END2 ? R_END1 : R_END2);

struct Params {
  const float* in[35];
  float* out;
  unsigned char* ws;
  double inv_freq[32];
};
enum { I_X = 0, I_C, I_POS, I_ADAW, I_ADAB, I_N1G, I_N2G, I_WIN, I_LCW, I_LCB, I_LWA, I_LBA, I_LWX, I_LBX, I_LLAM, I_CKW1, I_CKW2,
       I_CVW1, I_CVW2, I_CPK, I_CPV, I_DWW, I_DWB, I_LNG, I_LNB, I_ONG, I_WOUT, I_RGW, I_RGB, I_REW, I_REB, I_MG, I_MU, I_MD, I_FNG };

__device__ __forceinline__ float wsum(float v) {
#pragma unroll
  for (int o = 32; o > 0; o >>= 1) v += __shfl_xor(v, o);
  return v;
}
__device__ __forceinline__ float sigm(float x) { return 1.f / (1.f + __expf(-x)); }
__device__ __forceinline__ float silu_f(float x) { return x / (1.f + __expf(-x)); }
__device__ __forceinline__ float gelu_tanh(float x) {
  float u = 0.7978845608028654f * (x + 0.044715f * x * x * x);
  float e = __expf(2.f * u);
  float t = 1.f - 2.f / (e + 1.f);
  return 0.5f * x * (1.f + t);
}
__device__ __forceinline__ void glds16(const h16* g, h16* l) {
  __builtin_amdgcn_global_load_lds((const unsigned*)g, (unsigned*)l, 16, 0, 0);
}
__device__ __forceinline__ h16x4 pack4(float a, float b, float c, float d) {
  h16x4 r; r[0] = (h16)a; r[1] = (h16)b; r[2] = (h16)c; r[3] = (h16)d; return r;
}

template <class ARowFn>
__device__ __forceinline__ void gemm_mainloop(f32x4 (&acc)[4][4], ARowFn arow, const h16* __restrict__ Bt, int ldb, int nk, h16* sm, bool zero_init = true) {
  const int tid = threadIdx.x, lane = tid & 63, wave = tid >> 6;
  const int wr = wave >> 1, wc = wave & 1, fr = lane & 15, fq = lane >> 4;
  h16* sA = sm;
  h16* sB = sm + 2 * 8192;
  const h16* ap[4];
  const h16* bp[4];
#pragma unroll
  for (int i = 0; i < 4; ++i) {
    const int r = (i * 4 + wave) * 8 + (lane >> 3);
    const int c = (lane & 7) ^ ((r >> 1) & 7);
    ap[i] = arow(r) + c * 8;
    bp[i] = Bt + (size_t)r * ldb + c * 8;
  }
  if (zero_init) {
#pragma unroll
    for (int m = 0; m < 4; ++m)
#pragma unroll
      for (int n = 0; n < 4; ++n) acc[m][n] = (f32x4){0.f, 0.f, 0.f, 0.f};
  }
#pragma unroll
  for (int i = 0; i < 4; ++i) {
    glds16(ap[i], sA + ((i * 4 + wave) * 64 + lane) * 8);
    glds16(bp[i], sB + ((i * 4 + wave) * 64 + lane) * 8);
    ap[i] += 64; bp[i] += 64;
  }
  asm volatile("s_waitcnt vmcnt(0)" ::: "memory");
  __syncthreads();
  for (int kt = 0; kt < nk; ++kt) {
    const int cur = kt & 1;
    if (kt + 1 < nk) {
#pragma unroll
      for (int i = 0; i < 4; ++i) {
        glds16(ap[i], sA + (cur ^ 1) * 8192 + ((i * 4 + wave) * 64 + lane) * 8);
        glds16(bp[i], sB + (cur ^ 1) * 8192 + ((i * 4 + wave) * 64 + lane) * 8);
        ap[i] += 64; bp[i] += 64;
      }
    }
    const h16* cA = sA + cur * 8192;
    const h16* cB = sB + cur * 8192;
#pragma unroll
    for (int ks = 0; ks < 2; ++ks) {
      h16x8 af[4], bf[4];
#pragma unroll
      for (int m = 0; m < 4; ++m) {
        const int row = wr * 64 + m * 16 + fr;
        const int pch = (ks * 4 + fq) ^ ((row >> 1) & 7);
        af[m] = *(const h16x8*)(cA + row * 64 + pch * 8);
      }
#pragma unroll
      for (int n = 0; n < 4; ++n) {
        const int row = wc * 64 + n * 16 + fr;
        const int pch = (ks * 4 + fq) ^ ((row >> 1) & 7);
        bf[n] = *(const h16x8*)(cB + row * 64 + pch * 8);
      }
#pragma unroll
      for (int m = 0; m < 4; ++m)
#pragma unroll
        for (int n = 0; n < 4; ++n) acc[m][n] = __builtin_amdgcn_mfma_f32_16x16x32_f16(bf[n], af[m], acc[m][n], 0, 0, 0);
    }
    asm volatile("s_waitcnt vmcnt(0)" ::: "memory");
    __syncthreads();
  }
}

__device__ __forceinline__ int map_row(int mode, int n) {
  if (mode == 1) return n < 1792 ? n : (n < 1816 ? n + 512 : n - 24);
  if (mode == 2) return 32 * (n >> 4) + (n & 15);
  if (mode == 3) return 32 * (n >> 4) + 16 + (n & 15);
  return n;
}
__device__ __forceinline__ void conv_tile(const float* __restrict__ src, int K, int N, h16* __restrict__ dst, int mode, int tk, int tn, float* sm) {
  const int tid = threadIdx.x;
  const int k0 = tk * 64, n0 = tn * 64;
  const int k0d = mode == 4 ? (k0 < 256 ? k0 + 512 : (k0 < 768 ? k0 - 256 : k0)) : k0;
#pragma unroll
  for (int i = 0; i < 4; ++i) {
    const int idx = i * 256 + tid;
    const int r = idx >> 4, c4 = (idx & 15) * 4;
    float4 v = make_float4(0.f, 0.f, 0.f, 0.f);
    if (n0 + c4 < N) v = *(const float4*)(src + (size_t)(k0 + r) * N + n0 + c4);
    float* d = sm + r * 65 + c4;
    d[0] = v.x; d[1] = v.y; d[2] = v.z; d[3] = v.w;
  }
  __syncthreads();
#pragma unroll
  for (int i = 0; i < 2; ++i) {
    const int idx = i * 256 + tid;
    const int n = idx >> 3, kc = idx & 7;
    if (n0 + n < N) {
      h16x8 o;
#pragma unroll
      for (int j = 0; j < 8; ++j) o[j] = (h16)sm[(kc * 8 + j) * 65 + n];
      *(h16x8*)(dst + (size_t)map_row(mode, n0 + n) * K + k0d + kc * 8) = o;
    }
  }
  __syncthreads();
}

__device__ __forceinline__ void phase_convert(const Params& p, int l, float* sm) {
  unsigned char* ws = p.ws;
  constexpr int T_WIN = 16 * 37, T_WOUT = 256, T_G = 16 * 128, T_W1 = 128;
  constexpr int E0 = T_WIN, E1 = E0 + T_WOUT, E2 = E1 + T_G, E3 = E2 + T_G, E4 = E3 + T_G, E5 = E4 + T_W1, E6 = E5 + T_W1;
  for (int t = blockIdx.x; t < E6; t += gridDim.x) {
    if (t < E0) {
      conv_tile(p.in[I_WIN] + (size_t)l * 1024 * NINSRC, 1024, NINSRC, (h16*)(ws + OFF_WIN), 1, t / 37, t % 37, sm);
    } else if (t < E1) {
      const int u = t - E0;
      conv_tile(p.in[I_WOUT] + (size_t)l * 1024 * 1024, 1024, 1024, (h16*)(ws + OFF_WOUT), 4, u >> 4, u & 15, sm);
    } else if (t < E3) {
      const int up = t >= E2;
      const int u = t - (up ? E2 : E1);
      const int e = u >> 7, v = u & 127;
      conv_tile(p.in[up ? I_MU : I_MG] + ((size_t)l * 16 + e) * 1024 * 512, 1024, 512, (h16*)(ws + OFF_WGU) + (size_t)e * 1024 * 1024, up ? 3 : 2,
                v >> 3, v & 7, sm);
    } else if (t < E4) {
      const int u = t - E3;
      const int e = u >> 7, v = u & 127;
      conv_tile(p.in[I_MD] + ((size_t)l * 16 + e) * 512 * 1024, 512, 1024, (h16*)(ws + OFF_WDN) + (size_t)e * 1024 * 512, 0, v >> 4, v & 15, sm);
    } else {
      const int vv = t >= E5;
      const int u = t - (vv ? E5 : E4);
      conv_tile(p.in[vv ? I_CVW1 : I_CKW1] + (size_t)l * 2048 * 256, 2048, 256, (h16*)(ws + (vv ? OFF_W1V : OFF_W1K)), 0, u >> 2, u & 3, sm);
    }
  }
  {
    h16x8 z = {0, 0, 0, 0, 0, 0, 0, 0};
    h16* w = (h16*)(ws + OFF_WIN) + (size_t)NINSRC * 1024;
    for (int i = blockIdx.x * NTHREADS + threadIdx.x; i < (NIN - NINSRC) * 1024 / 8; i += gridDim.x * NTHREADS) *(h16x8*)(w + (size_t)i * 8) = z;
  }
  for (int t = blockIdx.x; t < 8; t += gridDim.x) {
    const int kv = t >> 2, nt = t & 3;
    const float* w1 = p.in[kv ? I_CVW1 : I_CKW1] + (size_t)l * 2048 * 256;
    const float* pos = p.in[kv ? I_CPV : I_CPK] + (size_t)l * 2048;
    const int n = nt * 64 + (threadIdx.x & 63), kg = threadIdx.x >> 6;
    float s = 0.f;
    for (int k = kg * 512; k < kg * 512 + 512; ++k) s += pos[k] * w1[(size_t)k * 256 + n];
    sm[kg * 64 + (threadIdx.x & 63)] = s;
    __syncthreads();
    if (threadIdx.x < 64) ((float*)(ws + OFF_PB))[kv * 256 + n] = sm[threadIdx.x] + sm[64 + threadIdx.x] + sm[128 + threadIdx.x] + sm[192 + threadIdx.x];
    __syncthreads();
  }
}

__device__ __forceinline__ void phase_prep(const Params& p, float* sm) {
  unsigned char* ws = p.ws;
  const int tid = threadIdx.x;
  if (blockIdx.x == 0) {
    for (int i = tid; i < 1024; i += NTHREADS) ((unsigned*)(ws + OFF_CTL))[i] = 0u;
  }
  float* mod = (float*)(ws + OFF_MOD);
  for (int t = blockIdx.x; t < 384; t += gridDim.x) {
    const int l = t / 192, j0 = (t % 192) * 32;
    const int kg = tid >> 3, cq = tid & 7;
    const float* w = p.in[I_ADAW] + (size_t)l * 1024 * 6144 + j0 + 4 * cq;
    const float* c = p.in[I_C];
    float a0[4] = {0, 0, 0, 0}, a1[4] = {0, 0, 0, 0};
#pragma unroll 8
    for (int k = kg * 32; k < kg * 32 + 32; ++k) {
      const float4 wv = *(const float4*)(w + (size_t)k * 6144);
      const float s0 = silu_f(c[k]), s1 = silu_f(c[1024 + k]);
      a0[0] += s0 * wv.x; a0[1] += s0 * wv.y; a0[2] += s0 * wv.z; a0[3] += s0 * wv.w;
      a1[0] += s1 * wv.x; a1[1] += s1 * wv.y; a1[2] += s1 * wv.z; a1[3] += s1 * wv.w;
    }
    float* r = sm + (kg * 8 + cq) * 8;
#pragma unroll
    for (int i = 0; i < 4; ++i) { r[i] = a0[i]; r[4 + i] = a1[i]; }
    __syncthreads();
    if (tid < 64) {
      const int bb = tid >> 5, col = tid & 31, q = col >> 2, ci = col & 3;
      float s = 0.f;
      for (int g = 0; g < 32; ++g) s += sm[(g * 8 + q) * 8 + bb * 4 + ci];
      mod[(size_t)(l * 2 + bb) * 6144 + j0 + col] = s + p.in[I_ADAB][l * 6144 + j0 + col];
    }
    __syncthreads();
  }
  float* rc = (float*)(ws + OFF_ROPE);
  float* rs = rc + (size_t)T * 32;
  const int* pos = (const int*)p.in[I_POS];
  for (int i = blockIdx.x * NTHREADS + tid; i < T * 32; i += gridDim.x * NTHREADS) {
    const int t = i >> 5, f = i & 31;
    const double a = (double)pos[t] * p.inv_freq[f];
    const double n = rint(a * 0.15915494309189535);
    double r = fma(-n, 6.283185307179586, a);
    r = fma(-n, 2.4492935982947064e-16, r);
    const float rf = (float)r;
    rc[i] = cosf(rf);
    rs[i] = sinf(rf);
  }
}

__device__ __forceinline__ void phase_norm1(const Params& p, int mode) {
  unsigned char* ws = p.ws;
  const int lane = threadIdx.x & 63, wave = threadIdx.x >> 6;
  const float* mod = (const float*)(ws + OFF_MOD);
  float* xa = (float*)(ws + OFF_XA);
  const h16* yp = (const h16*)(ws + OFF_YPAIR);
  h16* hout = (h16*)(ws + OFF_H16);
  const int l = (mode == 0) ? 0 : 1;
  for (int row = blockIdx.x * 4 + wave; row < T; row += gridDim.x * 4) {
    const int b = row >> 13;
    float4 x[4];
    float ss = 0.f;
#pragma unroll
    for (int i = 0; i < 4; ++i) {
      const int col = lane * 4 + 256 * i;
      if (mode == 0) {
        x[i] = *(const float4*)(p.in[I_X] + (size_t)row * D + col);
      } else {
        const int lp = mode == 1 ? 0 : 1;
        const float4 xv = *(const float4*)(xa + (size_t)row * D + col);
        const float4 g2 = *(const float4*)(mod + (size_t)(lp * 2 + b) * 6144 + 5120 + col);
        const h16x4 y0 = *(const h16x4*)(yp + (size_t)(row * 2) * D + col);
        const h16x4 y1 = *(const h16x4*)(yp + (size_t)(row * 2 + 1) * D + col);
        x[i].x = xv.x + g2.x * ((float)y0[0] + (float)y1[0]);
        x[i].y = xv.y + g2.y * ((float)y0[1] + (float)y1[1]);
        x[i].z = xv.z + g2.z * ((float)y0[2] + (float)y1[2]);
        x[i].w = xv.w + g2.w * ((float)y0[3] + (float)y1[3]);
        if (mode == 1) *(float4*)(xa + (size_t)row * D + col) = x[i];
      }
      ss += x[i].x * x[i].x + x[i].y * x[i].y + x[i].z * x[i].z + x[i].w * x[i].w;
    }
    ss = wsum(ss);
    const float rstd = rsqrtf(ss * (1.f / D) + EPS);
#pragma unroll
    for (int i = 0; i < 4; ++i) {
      const int col = lane * 4 + 256 * i;
      if (mode == 2) {
        const float4 g = *(const float4*)(p.in[I_FNG] + col);
        float4 o;
        o.x = x[i].x * rstd * g.x; o.y = x[i].y * rstd * g.y; o.z = x[i].z * rstd * g.z; o.w = x[i].w * rstd * g.w;
        *(float4*)(p.out + (size_t)row * D + col) = o;
      } else {
        const float4 g = *(const float4*)(p.in[I_N1G] + l * D + col);
        const float4 sh = *(const float4*)(mod + (size_t)(l * 2 + b) * 6144 + col);
        const float4 sc = *(const float4*)(mod + (size_t)(l * 2 + b) * 6144 + 1024 + col);
        *(h16x4*)(hout + (size_t)row * D + col) = pack4(x[i].x * rstd * g.x * (1.f + sc.x) + sh.x, x[i].y * rstd * g.y * (1.f + sc.y) + sh.y,
                                                        x[i].z * rstd * g.z * (1.f + sc.z) + sh.z, x[i].w * rstd * g.w * (1.f + sc.w) + sh.w);
      }
    }
  }
}

__device__ __forceinline__ void phase_inproj(const Params& p, h16* sm) {
  unsigned char* ws = p.ws;
  const h16* A = (const h16*)(ws + OFF_H16);
  const h16* W = (const h16*)(ws + OFF_WIN);
  h16* P = (h16*)(ws + OFF_P16);
  const int lane = threadIdx.x & 63, wave = threadIdx.x >> 6, wr = wave >> 1, wc = wave & 1, fr = lane & 15, fq = lane >> 4;
  for (int t = blockIdx.x; t < 128 * 19; t += gridDim.x) {
    const int mt = t / 19, nt = t % 19;
    f32x4 acc[4][4];
    const h16* Ab = A + (size_t)mt * 128 * D;
    gemm_mainloop(acc, [&](int r) { return Ab + (size_t)r * D; }, W + (size_t)nt * 128 * D, D, D / 64, sm);
#pragma unroll
    for (int m = 0; m < 4; ++m)
#pragma unroll
      for (int n = 0; n < 4; ++n) {
        const int row = mt * 128 + wr * 64 + m * 16 + fr, col = nt * 128 + wc * 64 + n * 16 + 4 * fq;
        *(h16x4*)(P + (size_t)row * NIN + col) = pack4(acc[m][n][0], acc[m][n][1], acc[m][n][2], acc[m][n][3]);
      }
  }
}

__device__ __forceinline__ int perm_key(int pos) {
  return 32 * (pos >> 5) + 16 * ((pos >> 2) & 1) + 4 * ((pos >> 3) & 3) + (pos & 3);
}
__device__ __forceinline__ void phase_post(const Params& p) {
  unsigned char* ws = p.ws;
  const h16* P = (const h16*)(ws + OFF_P16);
  const float* rc = (const float*)(ws + OFF_ROPE);
  const float* rs = rc + (size_t)T * 32;
  h16* q16 = (h16*)(ws + OFF_Q16);
  float* gates = (float*)(ws + OFF_GATES);
  const int lane = threadIdx.x & 63, wave = threadIdx.x >> 6;
  for (int row = blockIdx.x * 4 + wave; row < T; row += gridDim.x * 4) {
    const int b = row >> 13, s = row & (S - 1);
    const h16* pr = P + (size_t)row * NIN;
    const int d = (lane & 7) * 4;
    const float4 cs = *(const float4*)(rc + (size_t)row * 32 + d);
    const float4 sn = *(const float4*)(rs + (size_t)row * 32 + d);
    {
      const int hd = lane >> 3;
      const h16x4 a = *(const h16x4*)(pr + C_Q + 64 * hd + d);
      const h16x4 bb = *(const h16x4*)(pr + C_Q + 64 * hd + 32 + d);
      const float a0 = a[0], a1 = a[1], a2 = a[2], a3 = a[3], b0 = bb[0], b1 = bb[1], b2 = bb[2], b3 = bb[3];
      h16* qo = q16 + (size_t)row * 512 + 64 * hd + d;
      *(h16x4*)qo = pack4((a0 * cs.x - b0 * sn.x) * 0.125f, (a1 * cs.y - b1 * sn.y) * 0.125f, (a2 * cs.z - b2 * sn.z) * 0.125f, (a3 * cs.w - b3 * sn.w) * 0.125f);
      *(h16x4*)(qo + 32) = pack4((b0 * cs.x + a0 * sn.x) * 0.125f, (b1 * cs.y + a1 * sn.y) * 0.125f, (b2 * cs.z + a2 * sn.z) * 0.125f, (b3 * cs.w + a3 * sn.w) * 0.125f);
    }
    if (lane < 48) {
      const int tn = lane >> 4, hd = (lane >> 3) & 1;
      const int cb = (tn == 0 ? C_KC : (tn == 1 ? C_KS : C_KW)) + 64 * hd;
      const size_t off = tn == 0 ? OFF_KC : (tn == 1 ? OFF_KS : OFF_KW);
      const h16x4 a = *(const h16x4*)(pr + cb + d);
      const h16x4 bb = *(const h16x4*)(pr + cb + 32 + d);
      const float a0 = a[0], a1 = a[1], a2 = a[2], a3 = a[3], b0 = bb[0], b1 = bb[1], b2 = bb[2], b3 = bb[3];
      h16* ko = (h16*)(ws + off) + ((size_t)(b * 2 + hd) * S + s) * 64 + d;
      *(h16x4*)ko = pack4(a0 * cs.x - b0 * sn.x, a1 * cs.y - b1 * sn.y, a2 * cs.z - b2 * sn.z, a3 * cs.w - b3 * sn.w);
      *(h16x4*)(ko + 32) = pack4(b0 * cs.x + a0 * sn.x, b1 * cs.y + a1 * sn.y, b2 * cs.z + a2 * sn.z, b3 * cs.w + a3 * sn.w);
    }
    if (lane < 32) {
      const int hd = lane >> 4, dd = (lane & 15) * 4;
      *(h16x4*)((h16*)(ws + OFF_VC) + ((size_t)(b * 2 + hd) * S + s) * 64 + dd) = *(const h16x4*)(pr + C_VC + 64 * hd + dd);
    }
    if (lane < 24) gates[(size_t)row * 24 + lane] = sigm((float)pr[C_GATE + lane]);
  }
  for (int task = blockIdx.x; task < 1024; task += gridDim.x) {
    const int tensor = task & 1, kv = (task >> 1) & 1, blk = (task >> 2) & 127, b = task >> 9;
    const int srccol = (tensor ? C_VW : C_VS) + 64 * kv;
    h16* dst = (h16*)(ws + (tensor ? OFF_VWT : OFF_VST)) + ((size_t)((b * 2 + kv) * 128 + blk)) * 4096;
    const int dim = threadIdx.x & 63, kg = threadIdx.x >> 6;
#pragma unroll
    for (int hf = 0; hf < 2; ++hf) {
      const int p0 = kg * 16 + hf * 8;
      h16x8 v;
#pragma unroll
      for (int j = 0; j < 8; ++j) v[j] = P[(size_t)(b * S + blk * 64 + perm_key(p0 + j)) * NIN + srccol + dim];
      *(h16x8*)(dst + dim * 64 + p0) = v;
    }
  }
}

__device__ __forceinline__ void mixa_compress1(const Params& p, int item, h16* sm) {
  unsigned char* ws = p.ws;
  const int which = item >> 5, mt = (item >> 1) & 15, nt = item & 1;
  const h16* A = (const h16*)(ws + (which ? OFF_VC : OFF_KC)) + (size_t)mt * 128 * 1024;
  const h16* W = (const h16*)(ws + (which ? OFF_W1V : OFF_W1K)) + (size_t)nt * 128 * 2048;
  const float* pb = (const float*)(ws + OFF_PB) + which * 256;
  h16* hid = (h16*)(ws + OFF_HIDC) + (size_t)which * 2048 * 256;
  const int lane = threadIdx.x & 63, wave = threadIdx.x >> 6, wr = wave >> 1, wc = wave & 1, fr = lane & 15, fq = lane >> 4;
  f32x4 acc[4][4];
  gemm_mainloop(acc, [&](int r) { return A + (size_t)r * 1024; }, W, 2048, 32, sm);
#pragma unroll
  for (int m = 0; m < 4; ++m)
#pragma unroll
    for (int n = 0; n < 4; ++n) {
      const int row = mt * 128 + wr * 64 + m * 16 + fr, col = nt * 128 + wc * 64 + n * 16 + 4 * fq;
      const float4 bias = *(const float4*)(pb + col);
      *(h16x4*)(hid + (size_t)row * 256 + col) =
          pack4(gelu_tanh(acc[m][n][0] + bias.x), gelu_tanh(acc[m][n][1] + bias.y), gelu_tanh(acc[m][n][2] + bias.z), gelu_tanh(acc[m][n][3] + bias.w));
    }
}

__device__ __forceinline__ void mixa_lru(const Params& p, int l, int item, float* sm) {
  unsigned char* ws = p.ws;
  const int b = item >> 7, ck = item & 127;
  const int c = threadIdx.x;
  const int nb = c >> 6, e = c & 63;
  const h16* P = (const h16*)(ws + OFF_P16);
  const float* cw = p.in[I_LCW] + l * 4 * 256;
  const float w0 = cw[c], w1 = cw[256 + c], w2 = cw[512 + c], w3 = cw[768 + c], cb = p.in[I_LCB][l * 256 + c];
  const float ba = p.in[I_LBA][l * 256 + c], bx = p.in[I_LBX][l * 256 + c];
  const float lam = p.in[I_LLAM][l * 256 + c];
  const float ls = -log1pf(expf(-lam));
  const float* pa = p.in[I_LWA] + ((size_t)(l * 4 + nb) * 64) * 64 + e;
  const float* px = p.in[I_LWX] + ((size_t)(l * 4 + nb) * 64) * 64 + e;
  const int t0 = ck * 64;
  float x0 = 0.f, x1 = 0.f, x2 = 0.f;
  if (t0 >= 3) {
    x0 = (float)P[(size_t)(b * S + t0 - 3) * NIN + C_XL + c];
    x1 = (float)P[(size_t)(b * S + t0 - 2) * NIN + C_XL + c];
    x2 = (float)P[(size_t)(b * S + t0 - 1) * NIN + C_XL + c];
  }
  float h = 0.f, ap = 1.f;
  float* lh = (float*)(ws + OFF_LRUH);
  float* la = (float*)(ws + OFF_LRUA);
  float* sr = sm + 4096;
  float* si = sm + 8192;
#pragma unroll 1
  for (int sub = 0; sub < 4; ++sub) {
    const int tb = t0 + sub * 16;
#pragma unroll 1
    for (int tt = 0; tt < 16; ++tt) {
      const float x3 = (float)P[(size_t)(b * S + tb + tt) * NIN + C_XL + c];
      sm[tt * 256 + c] = w0 * x0 + w1 * x1 + w2 * x2 + w3 * x3 + cb;
      x0 = x1; x1 = x2; x2 = x3;
    }
    __syncthreads();
    {
      float accr[16], acci[16];
#pragma unroll
      for (int tt = 0; tt < 16; ++tt) { accr[tt] = 0.f; acci[tt] = 0.f; }
#pragma unroll 1
      for (int d8 = 0; d8 < 8; ++d8) {
        float wa8[8], wx8[8];
        const float* pa8 = pa + d8 * 512;
        const float* px8 = px + d8 * 512;
#pragma unroll
        for (int j = 0; j < 8; ++j) { wa8[j] = pa8[j * 64]; wx8[j] = px8[j * 64]; }
        const float* xr = sm + nb * 64 + d8 * 8;
#pragma unroll
        for (int tt = 0; tt < 16; ++tt) {
          const float4 xa = *(const float4*)(xr + tt * 256), xb = *(const float4*)(xr + tt * 256 + 4);
          accr[tt] += xa.x * wa8[0] + xa.y * wa8[1] + xa.z * wa8[2] + xa.w * wa8[3] + xb.x * wa8[4] + xb.y * wa8[5] + xb.z * wa8[6] + xb.w * wa8[7];
          acci[tt] += xa.x * wx8[0] + xa.y * wx8[1] + xa.z * wx8[2] + xa.w * wx8[3] + xb.x * wx8[4] + xb.y * wx8[5] + xb.z * wx8[6] + xb.w * wx8[7];
        }
      }
#pragma unroll
      for (int tt = 0; tt < 16; ++tt) { sr[tt * 256 + c] = accr[tt]; si[tt * 256 + c] = acci[tt]; }
    }
    float* lhp = lh + (size_t)(b * S + tb) * 256 + c;
    float* lap = la + (size_t)(b * S + tb) * 256 + c;
#pragma unroll 1
    for (int tt = 0; tt < 16; ++tt) {
      const float r = sigm(sr[tt * 256 + c] + ba), ig = sigm(si[tt * 256 + c] + bx);
      const float log_a = 8.f * r * ls;
      const float a = __expf(log_a);
      const float mult = sqrtf(-expm1f(2.f * log_a));
      const float u = mult * ig * sm[tt * 256 + c];
      h = a * h + u;
      ap *= a;
      lhp[tt * 256] = h;
      lap[tt * 256] = ap;
    }
    __syncthreads();
  }
  ((float*)(ws + OFF_HEND))[(size_t)(b * 128 + ck) * 256 + c] = h;
  ((float*)(ws + OFF_AEND))[(size_t)(b * 128 + ck) * 256 + c] = ap;
}

__device__ __forceinline__ void mixa_conv(const Params& p, int l, int item, float* sm) {
  unsigned char* ws = p.ws;
  const int b = item >> 8, ck = item & 255;
  const int c = threadIdx.x;
  const h16* P = (const h16*)(ws + OFF_P16);
  const int t0 = ck * 32;
  for (int r = 0; r < 62; ++r) {
    const int t = t0 - 30 + r;
    float v = 0.f;
    if (t >= 0) {
      const h16* pr = P + (size_t)(b * S + t) * NIN;
      v = (float)pr[C_CVA + c] * sigm((float)pr[C_CVB + c]);
    }
    sm[r * 256 + c] = v;
  }
  float w[31];
#pragma unroll
  for (int j = 0; j < 31; ++j) w[j] = p.in[I_DWW][(size_t)(l * 31 + j) * 256 + c];
  const float bias = p.in[I_DWB][l * 256 + c];
  for (int i = 0; i < 32; ++i) {
    float z = bias;
#pragma unroll
    for (int j = 0; j < 31; ++j) z += w[j] * sm[(i + j) * 256 + c];
    sm[i * 256 + c] = z;
  }
  __syncthreads();
  const int lane = threadIdx.x & 63, wave = threadIdx.x >> 6;
  const float4 lg = *(const float4*)(p.in[I_LNG] + l * 256 + lane * 4);
  const float4 lb = *(const float4*)(p.in[I_LNB] + l * 256 + lane * 4);
  const float4 gn = *(const float4*)(p.in[I_ONG] + l * 1024 + 768 + lane * 4);
  h16* yc = (h16*)(ws + OFF_H16);
  for (int i = wave * 8; i < wave * 8 + 8; ++i) {
    const float4 z = *(const float4*)(sm + i * 256 + lane * 4);
    const float mu = wsum(z.x + z.y + z.z + z.w) * (1.f / 256.f);
    const float dx = z.x - mu, dy = z.y - mu, dz = z.z - mu, dw = z.w - mu;
    const float var = wsum(dx * dx + dy * dy + dz * dz + dw * dw) * (1.f / 256.f);
    const float rs = rsqrtf(var + EPS);
    const float y0 = silu_f(dx * rs * lg.x + lb.x), y1 = silu_f(dy * rs * lg.y + lb.y), y2 = silu_f(dz * rs * lg.z + lb.z), y3 = silu_f(dw * rs * lg.w + lb.w);
    const float r2 = rsqrtf(wsum(y0 * y0 + y1 * y1 + y2 * y2 + y3 * y3) * (1.f / 256.f) + EPS);
    *(h16x4*)(yc + (size_t)(b * S + t0 + i) * D + 768 + lane * 4) = pack4(y0 * r2 * gn.x, y1 * r2 * gn.y, y2 * r2 * gn.z, y3 * r2 * gn.w);
  }
  __syncthreads();
}

__device__ __forceinline__ void phase_mixa(const Params& p, int l, void* sm) {
  const int G = gridDim.x;
  for (int it = blockIdx.x; it < 64; it += G) mixa_compress1(p, it, (h16*)sm);
  for (int it = (blockIdx.x + G - 64 % G) % G; it < 256; it += G) mixa_lru(p, l, it, (float*)sm);
  for (int it = (blockIdx.x + G - 320 % G) % G; it < 512; it += G) mixa_conv(p, l, it, (float*)sm);
}

__device__ __forceinline__ void phase_mixb(const Params& p, int l) {
  unsigned char* ws = p.ws;
  const int tid = threadIdx.x;
  for (int it = blockIdx.x; it < 1024; it += gridDim.x) {
    const int which = it >> 9;
    const int row = (it & 511) * 4 + (tid >> 6), d = tid & 63;
    const h16* hr = (const h16*)(ws + OFF_HIDC) + ((size_t)which * 2048 + row) * 256;
    const float* w2 = p.in[which ? I_CVW2 : I_CKW2] + (size_t)l * 256 * 64 + d;
    float s = 0.f;
#pragma unroll 4
    for (int j8 = 0; j8 < 32; ++j8) {
      const h16x8 hv = *(const h16x8*)(hr + j8 * 8);
#pragma unroll
      for (int j = 0; j < 8; ++j) s += (float)hv[j] * w2[(size_t)(j8 * 8 + j) * 64];
    }
    const int bkv = row >> 9, n = row & 511;
    if (n == 511) s = 0.f;
    if (which == 0) {
      ((h16*)(ws + OFF_KCMP))[((size_t)bkv * 512 + n) * 64 + d] = (h16)s;
    } else {
      const int blk = n >> 6, key = n & 63;
      const int pos = 32 * (key >> 5) + 8 * ((key >> 2) & 3) + 4 * ((key >> 4) & 1) + (key & 3);
      ((h16*)(ws + OFF_VCMPT))[((size_t)(bkv * 8 + blk) * 64 + d) * 64 + pos] = (h16)s;
    }
  }
  const int g = blockIdx.x * NTHREADS + tid;
  if (g < 512) {
    const int b = g >> 8, c = g & 255;
    const float* he = (const float*)(ws + OFF_HEND) + (size_t)b * 128 * 256 + c;
    const float* ae = (const float*)(ws + OFF_AEND) + (size_t)b * 128 * 256 + c;
    float* cy = (float*)(ws + OFF_CARRY) + (size_t)b * 128 * 256 + c;
    float carry = 0.f;
#pragma unroll 8
    for (int k = 0; k < 128; ++k) {
      cy[k * 256] = carry;
      carry = he[k * 256] + ae[k * 256] * carry;
    }
  }
}

__device__ __forceinline__ void stage8k(const h16* __restrict__ g, h16* l, int tid) {
  const int lane = tid & 63, wave = tid >> 6;
#pragma unroll
  for (int i = 0; i < 2; ++i) {
    const int pz = (i * 4 + wave) * 64 + lane;
    const int r = pz >> 3, cl = (pz & 7) ^ ((r >> 1) & 7);
    glds16(g + r * 64 + cl * 8, l + pz * 8);
  }
}
__device__ __forceinline__ h16x8 ldfrag(const h16* l, int row, int chunk) {
  return *(const h16x8*)(l + row * 64 + ((chunk ^ ((row >> 1) & 7)) * 8));
}

template <int MODE>
__device__ __forceinline__ void attn_branch(const h16* __restrict__ Kg, const h16* __restrict__ Vg, int j0, int j1, h16* ring,
                                            const h16x8 (&qf)[2][2], float (&m)[2], float (&l)[2], f32x4 (&o)[2][4],
                                            const int (&tq)[2], const int (&lim)[2], const int (&tlim)[2],
                                            const unsigned long long (&mylo)[2], const unsigned long long (&myhi)[2],
                                            const unsigned long long (&ulo)[2], const unsigned long long (&uhi)[2],
                                            const float (&inv)[2], float* impw) {
  int tid = threadIdx.x;
  asm volatile("" : "+v"(tid));
  const int lane = tid & 63;
  const int h = lane >> 4, c = lane & 15, qi = c >> 2, g = c & 3;
  constexpr bool PV = MODE != 0;
  const int n = j1 - j0 + 1;
  if (n <= 0) return;
  stage8k(Kg + (size_t)j0 * 4096, ring, tid);
  if (PV) stage8k(Vg + (size_t)j0 * 4096, ring + 4096, tid);
  asm volatile("s_waitcnt vmcnt(0)" ::: "memory");
  __syncthreads();
  for (int it = 0; it < n; ++it) {
    const int j = j0 + it;
    const h16* cK = ring + (it & 1) * 8192;
    const h16* cV = cK + 4096;
    if (it + 1 < n) {
      h16* nb = ring + ((it + 1) & 1) * 8192;
      stage8k(Kg + (size_t)(j + 1) * 4096, nb, tid);
      if (PV) stage8k(Vg + (size_t)(j + 1) * 4096, nb + 4096, tid);
    }
    bool act[2];
#pragma unroll
    for (int mq = 0; mq < 2; ++mq) {
      if (MODE <= 1) act[mq] = j * 64 <= tlim[mq];
      else if (MODE == 2) act[mq] = ((j < 64 ? (ulo[mq] >> j) : (uhi[mq] >> (j - 64))) & 1ull) != 0ull;
      else act[mq] = (j * 64 <= tlim[mq] + 3) && (j * 64 + 63 > tlim[mq] - 512);
    }
    if (act[0] || act[1]) {
      h16x8 pf[2][2];
      h16x8 kf[4][2];
#pragma unroll
      for (int kt = 0; kt < 4; ++kt)
#pragma unroll
        for (int ks = 0; ks < 2; ++ks) kf[kt][ks] = ldfrag(cK, 16 * kt + c, 4 * ks + h);
#pragma unroll
      for (int mq = 0; mq < 2; ++mq)
        if (act[mq]) {
          f32x4 s[1][4];
          {
#pragma unroll
            for (int kt = 0; kt < 4; ++kt) {
              s[0][kt] = (f32x4){0.f, 0.f, 0.f, 0.f};
#pragma unroll
              for (int ks = 0; ks < 2; ++ks) s[0][kt] = __builtin_amdgcn_mfma_f32_16x16x32_f16(kf[kt][ks], qf[mq][ks], s[0][kt], 0, 0, 0);
            }
          }
          const bool selbit = MODE == 2 ? (((j < 64 ? (mylo[mq] >> j) : (myhi[mq] >> (j - 64))) & 1ull) != 0ull) : true;
          const int pbase = j * 64 + 4 * h;
#pragma unroll
          for (int kt = 0; kt < 4; ++kt)
#pragma unroll
            for (int i = 0; i < 4; ++i) {
              const int pos = pbase + 16 * kt + i;
              bool v;
              if (MODE <= 1) v = pos <= lim[mq];
              else if (MODE == 2) v = selbit && pos <= tq[mq];
              else v = pos <= tq[mq] && pos > tq[mq] - 512;
              s[0][kt][i] = v ? s[0][kt][i] : -1e30f;
            }
          if (MODE == 1) {
#pragma unroll
            for (int kt = 0; kt < 4; ++kt) {
              float ps = 0.f;
#pragma unroll
              for (int i = 0; i < 4; ++i) {
                const float pv = __expf(s[0][kt][i] - m[mq]) * inv[mq];
                s[0][kt][i] = pv;
                ps += pv;
              }
              ps += __shfl_xor(ps, 1);
              ps += __shfl_xor(ps, 2);
              if (g == 0) impw[(4 * mq + qi) * 128 + j * 16 + kt * 4 + h] = ps;
            }
          } else {
            float bm = fmaxf(fmaxf(fmaxf(s[0][0][0], s[0][0][1]), fmaxf(s[0][0][2], s[0][0][3])), fmaxf(fmaxf(s[0][1][0], s[0][1][1]), fmaxf(s[0][1][2], s[0][1][3])));
            bm = fmaxf(bm, fmaxf(fmaxf(fmaxf(s[0][2][0], s[0][2][1]), fmaxf(s[0][2][2], s[0][2][3])), fmaxf(fmaxf(s[0][3][0], s[0][3][1]), fmaxf(s[0][3][2], s[0][3][3]))));
            bm = fmaxf(bm, __shfl_xor(bm, 16));
            bm = fmaxf(bm, __shfl_xor(bm, 32));
            const float mn = fmaxf(m[mq], bm);
            const float alpha = __expf(m[mq] - mn);
            const float mref = mn > -1e29f ? mn : 1e30f;
            float ps = 0.f;
#pragma unroll
            for (int kt = 0; kt < 4; ++kt)
#pragma unroll
              for (int i = 0; i < 4; ++i) {
                const float pv = __expf(s[0][kt][i] - mref);
                s[0][kt][i] = pv;
                ps += pv;
              }
            l[mq] = l[mq] * alpha + ps;
            m[mq] = mn;
            if (PV) {
#pragma unroll
              for (int mt = 0; mt < 4; ++mt) o[mq][mt] *= alpha;
            }
          }
          if (PV) {
#pragma unroll
            for (int s2 = 0; s2 < 2; ++s2)
#pragma unroll
              for (int i = 0; i < 4; ++i) { pf[mq][s2][i] = (h16)s[0][2 * s2][i]; pf[mq][s2][4 + i] = (h16)s[0][2 * s2 + 1][i]; }
          }
        }
      if (PV) {
        h16x8 vf[4][2];
#pragma unroll
        for (int mt = 0; mt < 4; ++mt)
#pragma unroll
          for (int s2 = 0; s2 < 2; ++s2) vf[mt][s2] = ldfrag(cV, 16 * mt + c, 4 * s2 + h);
#pragma unroll
        for (int mq = 0; mq < 2; ++mq)
          if (act[mq]) {
#pragma unroll
            for (int s2 = 0; s2 < 2; ++s2) {
#pragma unroll
              for (int mt = 0; mt < 4; ++mt) o[mq][mt] = __builtin_amdgcn_mfma_f32_16x16x32_f16(vf[mt][s2], pf[mq][s2], o[mq][mt], 0, 0, 0);
            }
          }
      }
    }
    asm volatile("s_waitcnt vmcnt(0)" ::: "memory");
    __syncthreads();
  }
}

__device__ __forceinline__ void attn_item(const Params& p, int l, int item, float* sm) {
  unsigned char* ws = p.ws;
  int tid = threadIdx.x;
  asm volatile("" : "+v"(tid));
  const int lane = tid & 63, wave = tid >> 6;
  const int combo = item & 3, qt = item >> 2;
  const int b = combo >> 1, kv = combo & 1;
  const int t0 = qt * 32, tw0 = t0 + 8 * wave;
  const int h = lane >> 4, c = lane & 15, qi = c >> 2, g = c & 3;
  const int head = kv * 4 + g, bkv = b * 2 + kv;
  h16* ring = (h16*)sm;
  float* impw = sm + 8192 + wave * 1024;
  unsigned long long* selm = (unsigned long long*)(sm + 8192 + 4096) + wave * 16;

  h16x8 qf[2][2];
  int tq[2];
#pragma unroll
  for (int mq = 0; mq < 2; ++mq) {
    tq[mq] = tw0 + 4 * mq + qi;
    const h16* qrow = (const h16*)(ws + OFF_Q16) + (size_t)(b * S + tq[mq]) * 512 + head * 64;
    qf[mq][0] = *(const h16x8*)(qrow + 8 * h);
    qf[mq][1] = *(const h16x8*)(qrow + 32 + 8 * h);
  }
  for (int i = lane; i < 1024; i += 64) impw[i] = 0.f;

  h16x4 ofin[2][4];
  float m[2], ll[2], inv[2];
  f32x4 o[2][4];
  const unsigned long long z2[2] = {0ull, 0ull};
  {
    int lim[2], tlim[2];
#pragma unroll
    for (int mq = 0; mq < 2; ++mq) {
      lim[mq] = tq[mq] >= 31 ? ((tq[mq] - 31) >> 4) : -1;
      const int tl = tw0 + 4 * mq + 3;
      tlim[mq] = tl >= 31 ? ((tl - 31) >> 4) : -1;
      m[mq] = -1e30f; ll[mq] = 0.f; inv[mq] = 0.f;
#pragma unroll
      for (int mt = 0; mt < 4; ++mt) o[mq][mt] = (f32x4){0.f, 0.f, 0.f, 0.f};
    }
    const int nl = (t0 + 31 - 31) >> 4;
    const int jl = nl >> 6;
    const h16* Kc = (const h16*)(ws + OFF_KCMP) + (size_t)bkv * 512 * 64;
    const h16* Vc = (const h16*)(ws + OFF_VCMPT) + (size_t)bkv * 8 * 4096;
    attn_branch<0>(Kc, Vc, 0, jl, ring, qf, m, ll, o, tq, lim, tlim, z2, z2, z2, z2, inv, impw);
#pragma unroll
    for (int mq = 0; mq < 2; ++mq) {
      float lt = ll[mq];
      lt += __shfl_xor(lt, 16);
      lt += __shfl_xor(lt, 32);
      inv[mq] = lt > 0.f ? 1.f / lt : 0.f;
    }
    attn_branch<1>(Kc, Vc, 0, jl, ring, qf, m, ll, o, tq, lim, tlim, z2, z2, z2, z2, inv, impw);
    const float* gt0 = (const float*)(ws + OFF_GATES) + (size_t)(b * S) * 24 + head * 3;
#pragma unroll
    for (int mq = 0; mq < 2; ++mq) {
      const float g0 = gt0[(size_t)tq[mq] * 24] * ASCALE;
#pragma unroll
      for (int mt = 0; mt < 4; ++mt) ofin[mq][mt] = pack4(o[mq][mt][0] * g0, o[mq][mt][1] * g0, o[mq][mt][2] * g0, o[mq][mt][3] * g0);
    }
  }
  for (int q = 0; q < 8; ++q) {
    const int t = tw0 + q, own = t >> 6;
    const float* ir = impw + q * 128;
    const int ja = lane, jb = lane + 64;
    unsigned k0 = 0u, k1 = 0u;
    if (ja <= own) k0 = (ja == 0 || ja == own) ? (0xFFFFFF80u | (unsigned)(127 - ja)) : (((__float_as_uint(ir[ja]) & ~127u) | (unsigned)(127 - ja)) + 1u);
    if (jb <= own) k1 = (jb == own) ? (0xFFFFFF80u | (unsigned)(127 - jb)) : (((__float_as_uint(ir[jb]) & ~127u) | (unsigned)(127 - jb)) + 1u);
    unsigned thr = 0u;
    for (int bit = 31; bit >= 0; --bit) {
      const unsigned cand = thr | (1u << bit);
      const int cnt = __popcll(__ballot(k0 >= cand)) + __popcll(__ballot(k1 >= cand));
      if (cnt >= 16) thr = cand;
    }
    const unsigned long long mlo = __ballot(k0 >= thr && ja <= own);
    const unsigned long long mhi = __ballot(k1 >= thr && jb <= own);
    if (lane == 0) { selm[q * 2] = mlo; selm[q * 2 + 1] = mhi; }
  }
  unsigned long long mylo[2], myhi[2], ulo[2], uhi[2];
#pragma unroll
  for (int mq = 0; mq < 2; ++mq) {
    mylo[mq] = selm[(4 * mq + qi) * 2];
    myhi[mq] = selm[(4 * mq + qi) * 2 + 1];
    unsigned long long a = selm[(4 * mq) * 2] | selm[(4 * mq + 1) * 2] | selm[(4 * mq + 2) * 2] | selm[(4 * mq + 3) * 2];
    unsigned long long bb = selm[(4 * mq) * 2 + 1] | selm[(4 * mq + 1) * 2 + 1] | selm[(4 * mq + 2) * 2 + 1] | selm[(4 * mq + 3) * 2 + 1];
    ulo[mq] = (unsigned long long)__builtin_amdgcn_readfirstlane((unsigned)a) | ((unsigned long long)__builtin_amdgcn_readfirstlane((unsigned)(a >> 32)) << 32);
    uhi[mq] = (unsigned long long)__builtin_amdgcn_readfirstlane((unsigned)bb) | ((unsigned long long)__builtin_amdgcn_readfirstlane((unsigned)(bb >> 32)) << 32);
  }
  const float* gtb = (const float*)(ws + OFF_GATES) + (size_t)(b * S) * 24 + head * 3;
  {
    int tl0[2] = {0, 0};
#pragma unroll
    for (int mq = 0; mq < 2; ++mq) {
      m[mq] = -1e30f; ll[mq] = 0.f;
#pragma unroll
      for (int mt = 0; mt < 4; ++mt) o[mq][mt] = (f32x4){0.f, 0.f, 0.f, 0.f};
    }
    attn_branch<2>((const h16*)(ws + OFF_KS) + (size_t)bkv * S * 64, (const h16*)(ws + OFF_VST) + (size_t)bkv * 128 * 4096, 0, (t0 + 31) >> 6, ring, qf, m, ll, o,
                   tq, tl0, tl0, mylo, myhi, ulo, uhi, inv, impw);
#pragma unroll
    for (int mq = 0; mq < 2; ++mq) {
      float lt = ll[mq];
      lt += __shfl_xor(lt, 16);
      lt += __shfl_xor(lt, 32);
      const float sc = lt > 0.f ? gtb[(size_t)tq[mq] * 24 + 1] * ASCALE / lt : 0.f;
#pragma unroll
      for (int mt = 0; mt < 4; ++mt)
        ofin[mq][mt] = pack4((float)ofin[mq][mt][0] + o[mq][mt][0] * sc, (float)ofin[mq][mt][1] + o[mq][mt][1] * sc, (float)ofin[mq][mt][2] + o[mq][mt][2] * sc,
                             (float)ofin[mq][mt][3] + o[mq][mt][3] * sc);
    }
  }
  {
    int tl0[2] = {0, 0}, tf[2];
#pragma unroll
    for (int mq = 0; mq < 2; ++mq) {
      tf[mq] = tw0 + 4 * mq;
      m[mq] = -1e30f; ll[mq] = 0.f;
#pragma unroll
      for (int mt = 0; mt < 4; ++mt) o[mq][mt] = (f32x4){0.f, 0.f, 0.f, 0.f};
    }
    const int jlo = t0 >= 511 ? ((t0 - 511) >> 6) : 0;
    attn_branch<3>((const h16*)(ws + OFF_KW) + (size_t)bkv * S * 64, (const h16*)(ws + OFF_VWT) + (size_t)bkv * 128 * 4096, jlo, (t0 + 31) >> 6, ring, qf, m, ll, o,
                   tq, tl0, tf, z2, z2, z2, z2, inv, impw);
#pragma unroll
    for (int mq = 0; mq < 2; ++mq) {
      float lt = ll[mq];
      lt += __shfl_xor(lt, 16);
      lt += __shfl_xor(lt, 32);
      const float sc = lt > 0.f ? gtb[(size_t)tq[mq] * 24 + 2] * ASCALE / lt : 0.f;
#pragma unroll
      for (int mt = 0; mt < 4; ++mt)
        ofin[mq][mt] = pack4((float)ofin[mq][mt][0] + o[mq][mt][0] * sc, (float)ofin[mq][mt][1] + o[mq][mt][1] * sc, (float)ofin[mq][mt][2] + o[mq][mt][2] * sc,
                             (float)ofin[mq][mt][3] + o[mq][mt][3] * sc);
    }
  }
  {
    h16* yc = (h16*)(ws + OFF_H16);
    const float* gn = p.in[I_ONG] + l * 1024 + 256 + head * 64;
    float* ssq = (float*)(ws + OFF_SSQ);
#pragma unroll
    for (int mq = 0; mq < 2; ++mq) {
      float sq = 0.f;
      h16* yr = yc + (size_t)(b * S + tq[mq]) * D + head * 64;
#pragma unroll
      for (int mt = 0; mt < 4; ++mt) {
        const float v[4] = {(float)ofin[mq][mt][0], (float)ofin[mq][mt][1], (float)ofin[mq][mt][2], (float)ofin[mq][mt][3]};
        sq += v[0] * v[0] + v[1] * v[1] + v[2] * v[2] + v[3] * v[3];
        const float4 gg = *(const float4*)(gn + 16 * mt + 4 * h);
        *(h16x4*)(yr + 16 * mt + 4 * h) = pack4(v[0] * gg.x, v[1] * gg.y, v[2] * gg.z, v[3] * gg.w);
      }
      sq += __shfl_xor(sq, 16);
      sq += __shfl_xor(sq, 32);
      sq += __shfl_xor(sq, 1);
      sq += __shfl_xor(sq, 2);
      if (h == 0 && g == 0) ssq[(size_t)(b * S + tq[mq]) * 2 + kv] = sq * (1.f / (ASCALE * ASCALE));
    }
  }
}

__device__ __forceinline__ void lrufix_item(const Params& p, int l, int item) {
  unsigned char* ws = p.ws;
  const int lane = threadIdx.x & 63, wave = threadIdx.x >> 6;
  const int b = item >> 7, ck = item & 127;
  const h16* P = (const h16*)(ws + OFF_P16);
  const float4 cy = *(const float4*)((const float*)(ws + OFF_CARRY) + (size_t)(b * 128 + ck) * 256 + lane * 4);
  const float4 gn = *(const float4*)(p.in[I_ONG] + l * 1024 + lane * 4);
  h16* yc = (h16*)(ws + OFF_H16);
  for (int tt = wave * 16; tt < wave * 16 + 16; ++tt) {
    const size_t row = (size_t)(b * S + ck * 64 + tt);
    const float4 hl = *(const float4*)((const float*)(ws + OFF_LRUH) + row * 256 + lane * 4);
    const float4 al = *(const float4*)((const float*)(ws + OFF_LRUA) + row * 256 + lane * 4);
    const h16x4 gl = *(const h16x4*)(P + row * NIN + C_GL + lane * 4);
    const float y0 = (hl.x + al.x * cy.x) * gelu_tanh((float)gl[0]);
    const float y1 = (hl.y + al.y * cy.y) * gelu_tanh((float)gl[1]);
    const float y2 = (hl.z + al.z * cy.z) * gelu_tanh((float)gl[2]);
    const float y3 = (hl.w + al.w * cy.w) * gelu_tanh((float)gl[3]);
    const float rstd = rsqrtf(wsum(y0 * y0 + y1 * y1 + y2 * y2 + y3 * y3) * (1.f / 256.f) + EPS);
    *(h16x4*)(yc + row * D + 512 + lane * 4) = pack4(y0 * rstd * gn.x, y1 * rstd * gn.y, y2 * rstd * gn.z, y3 * rstd * gn.w);
  }
}

__device__ __forceinline__ void phase_attn(const Params& p, int l, float* sm) {
  for (int it = blockIdx.x; it < 512; it += gridDim.x) {
#pragma unroll 1
    for (int rep = 0; rep < 2; ++rep) attn_item(p, l, rep ? 1023 - it : it, sm);
  }
  for (int it = blockIdx.x; it < 256; it += gridDim.x) lrufix_item(p, l, it);
}

__device__ __forceinline__ void phase_outproj(const Params& p, int l, h16* sm) {
  unsigned char* ws = p.ws;
  const h16* A = (const h16*)(ws + OFF_H16);
  const h16* W = (const h16*)(ws + OFF_WOUT);
  const float* mod = (const float*)(ws + OFF_MOD);
  float* xa = (float*)(ws + OFF_XA);
  const float* xin = l == 0 ? p.in[I_X] : (const float*)xa;
  const int lane = threadIdx.x & 63, wave = threadIdx.x >> 6, wr = wave >> 1, wc = wave & 1, fr = lane & 15, fq = lane >> 4;
  for (int t = blockIdx.x; t < 128 * 8; t += gridDim.x) {
    const int mt = t >> 3, nt = t & 7;
    f32x4 acc[4][4];
    const h16* Ab = A + (size_t)mt * 128 * D;
    gemm_mainloop(acc, [&](int r) { return Ab + (size_t)r * D; }, W + (size_t)nt * 128 * D, D, 8, sm);
    {
      const float* ssq = (const float*)(ws + OFF_SSQ);
#pragma unroll
      for (int m = 0; m < 4; ++m) {
        const int row = mt * 128 + wr * 64 + m * 16 + fr;
        const float2 q2 = *(const float2*)(ssq + (size_t)row * 2);
        const float sc = rsqrtf((q2.x + q2.y) * (1.f / 512.f) + EPS) * (1.f / ASCALE);
#pragma unroll
        for (int n = 0; n < 4; ++n) acc[m][n] *= sc;
      }
    }
    gemm_mainloop(acc, [&](int r) { return Ab + (size_t)r * D + 512; }, W + (size_t)nt * 128 * D + 512, D, 8, sm, false);
#pragma unroll
    for (int m = 0; m < 4; ++m)
#pragma unroll
      for (int n = 0; n < 4; ++n) {
        const int row = mt * 128 + wr * 64 + m * 16 + fr, col = nt * 128 + wc * 64 + n * 16 + 4 * fq;
        const int b = row >> 13;
        const float4 g1 = *(const float4*)(mod + (size_t)(l * 2 + b) * 6144 + 2048 + col);
        const float4 xv = *(const float4*)(xin + (size_t)row * D + col);
        float4 o;
        o.x = xv.x + g1.x * acc[m][n][0]; o.y = xv.y + g1.y * acc[m][n][1]; o.z = xv.z + g1.z * acc[m][n][2]; o.w = xv.w + g1.w * acc[m][n][3];
        *(float4*)(xa + (size_t)row * D + col) = o;
      }
  }
}

__device__ __forceinline__ void phase_router(const Params& p, int l) {
  unsigned char* ws = p.ws;
  const int lane = threadIdx.x & 63, wave = threadIdx.x >> 6;
  const float* mod = (const float*)(ws + OFF_MOD);
  const float* xa = (const float*)(ws + OFF_XA);
  h16* hout = (h16*)(ws + OFF_H16);
  unsigned* cnt = (unsigned*)(ws + OFF_CTL) + 64 + l * 16;
  int* list = (int*)(ws + OFF_LIST);
  float* wpair = (float*)(ws + OFF_WPAIR);
  const float* rgw = p.in[I_RGW] + (size_t)l * 1024 * 4;
  const float* rgb = p.in[I_RGB] + l * 4;
  for (int row = blockIdx.x * 4 + wave; row < T; row += gridDim.x * 4) {
    const int b = row >> 13;
    float4 x[4];
    float ss = 0.f;
#pragma unroll
    for (int i = 0; i < 4; ++i) {
      x[i] = *(const float4*)(xa + (size_t)row * D + lane * 4 + 256 * i);
      ss += x[i].x * x[i].x + x[i].y * x[i].y + x[i].z * x[i].z + x[i].w * x[i].w;
    }
    ss = wsum(ss);
    const float rstd = rsqrtf(ss * (1.f / D) + EPS);
    float lg0 = 0.f, lg1 = 0.f, lg2 = 0.f, lg3 = 0.f;
#pragma unroll
    for (int i = 0; i < 4; ++i) {
      const int col = lane * 4 + 256 * i;
      const float4 g = *(const float4*)(p.in[I_N2G] + l * D + col);
      const float4 sh = *(const float4*)(mod + (size_t)(l * 2 + b) * 6144 + 3072 + col);
      const float4 sc = *(const float4*)(mod + (size_t)(l * 2 + b) * 6144 + 4096 + col);
      x[i].x = x[i].x * rstd * g.x * (1.f + sc.x) + sh.x;
      x[i].y = x[i].y * rstd * g.y * (1.f + sc.y) + sh.y;
      x[i].z = x[i].z * rstd * g.z * (1.f + sc.z) + sh.z;
      x[i].w = x[i].w * rstd * g.w * (1.f + sc.w) + sh.w;
      *(h16x4*)(hout + (size_t)row * D + col) = pack4(x[i].x, x[i].y, x[i].z, x[i].w);
      const float4 w0 = *(const float4*)(rgw + (size_t)(col + 0) * 4), w1 = *(const float4*)(rgw + (size_t)(col + 1) * 4);
      const float4 w2 = *(const float4*)(rgw + (size_t)(col + 2) * 4), w3 = *(const float4*)(rgw + (size_t)(col + 3) * 4);
      lg0 += x[i].x * w0.x + x[i].y * w1.x + x[i].z * w2.x + x[i].w * w3.x;
      lg1 += x[i].x * w0.y + x[i].y * w1.y + x[i].z * w2.y + x[i].w * w3.y;
      lg2 += x[i].x * w0.z + x[i].y * w1.z + x[i].z * w2.z + x[i].w * w3.z;
      lg3 += x[i].x * w0.w + x[i].y * w1.w + x[i].z * w2.w + x[i].w * w3.w;
    }
    lg0 = wsum(lg0) + rgb[0]; lg1 = wsum(lg1) + rgb[1]; lg2 = wsum(lg2) + rgb[2]; lg3 = wsum(lg3) + rgb[3];
    int gs = 0; float gm = lg0;
    if (lg1 > gm) { gm = lg1; gs = 1; }
    if (lg2 > gm) { gm = lg2; gs = 2; }
    if (lg3 > gm) { gm = lg3; gs = 3; }
    const float pg = 1.f / (__expf(lg0 - gm) + __expf(lg1 - gm) + __expf(lg2 - gm) + __expf(lg3 - gm));
    const float* rew = p.in[I_REW] + ((size_t)(l * 4 + gs) * 1024) * 4;
    const float* reb = p.in[I_REB] + (l * 4 + gs) * 4;
    float e0 = 0.f, e1 = 0.f, e2 = 0.f, e3 = 0.f;
#pragma unroll
    for (int i = 0; i < 4; ++i) {
      const int col = lane * 4 + 256 * i;
      const float4 w0 = *(const float4*)(rew + (size_t)(col + 0) * 4), w1 = *(const float4*)(rew + (size_t)(col + 1) * 4);
      const float4 w2 = *(const float4*)(rew + (size_t)(col + 2) * 4), w3 = *(const float4*)(rew + (size_t)(col + 3) * 4);
      e0 += x[i].x * w0.x + x[i].y * w1.x + x[i].z * w2.x + x[i].w * w3.x;
      e1 += x[i].x * w0.y + x[i].y * w1.y + x[i].z * w2.y + x[i].w * w3.y;
      e2 += x[i].x * w0.z + x[i].y * w1.z + x[i].z * w2.z + x[i].w * w3.z;
      e3 += x[i].x * w0.w + x[i].y * w1.w + x[i].z * w2.w + x[i].w * w3.w;
    }
    float le[4];
    le[0] = wsum(e0) + reb[0]; le[1] = wsum(e1) + reb[1]; le[2] = wsum(e2) + reb[2]; le[3] = wsum(e3) + reb[3];
    int i0 = 0; float v0 = le[0];
    if (le[1] > v0) { v0 = le[1]; i0 = 1; }
    if (le[2] > v0) { v0 = le[2]; i0 = 2; }
    if (le[3] > v0) { v0 = le[3]; i0 = 3; }
    int i1 = -1; float v1 = -3.0e38f;
#pragma unroll
    for (int j = 0; j < 4; ++j) {
      const float vj = (j == 0 ? le[0] : j == 1 ? le[1] : j == 2 ? le[2] : le[3]);
      if (j != i0 && vj > v1) { v1 = vj; i1 = j; }
    }
    const float p0 = 1.f / (1.f + __expf(v1 - v0));
    const float p1 = 1.f - p0;
    if (lane == 0) {
      const int ea = gs * 4 + i0, eb = gs * 4 + i1;
      const unsigned sa = atomicAdd(&cnt[ea], 1u);
      list[(size_t)ea * 16384 + sa] = row * 2;
      wpair[row * 2] = pg * p0;
      const unsigned sb = atomicAdd(&cnt[eb], 1u);
      list[(size_t)eb * 16384 + sb] = row * 2 + 1;
      wpair[row * 2 + 1] = pg * p1;
    }
  }
}

struct MoeSched { int cnt[16]; int toff[17]; int roff[17]; };
__device__ __forceinline__ void moe_sched(const Params& p, int l, MoeSched& s) {
  const unsigned* cnt = (const unsigned*)(p.ws + OFF_CTL) + 64 + l * 16;
  s.toff[0] = 0; s.roff[0] = 0;
#pragma unroll
  for (int e = 0; e < 16; ++e) {
    const int c = (int)__hip_atomic_load(&cnt[e], __ATOMIC_RELAXED, __HIP_MEMORY_SCOPE_AGENT);
    s.cnt[e] = c;
    s.toff[e + 1] = s.toff[e] + ((c + 127) >> 7);
    s.roff[e + 1] = s.roff[e] + c;
  }
}

__device__ __forceinline__ void phase_moe1(const Params& p, int l, h16* sm) {
  unsigned char* ws = p.ws;
  MoeSched sc;
  moe_sched(p, l, sc);
  const int lane = threadIdx.x & 63, wave = threadIdx.x >> 6, wr = wave >> 1, wc = wave & 1, fr = lane & 15, fq = lane >> 4;
  const h16* H = (const h16*)(ws + OFF_H16);
  const int* list = (const int*)(ws + OFF_LIST);
  h16* hid = (h16*)(ws + OFF_HID);
  const int total = sc.toff[16] * 8;
  for (int t = blockIdx.x; t < total; t += gridDim.x) {
    int e = 0, rem = t;
#pragma unroll
    for (int k = 0; k < 16; ++k) {
      const int ne = (sc.toff[k + 1] - sc.toff[k]) * 8;
      if (e == k && rem >= ne) { rem -= ne; e = k + 1; }
    }
    int cnt_e = 0, roff_e = 0, nte = 1;
#pragma unroll
    for (int k = 0; k < 16; ++k) if (k == e) { cnt_e = sc.cnt[k]; roff_e = sc.roff[k]; nte = sc.toff[k + 1] - sc.toff[k]; }
    const int nt = rem / nte, mt = rem % nte;
    const int* le = list + (size_t)e * 16384;
    f32x4 acc[4][4];
    gemm_mainloop(acc, [&](int r) { int sl = mt * 128 + r; sl = sl < cnt_e ? sl : 0; return H + (size_t)(le[sl] >> 1) * D; },
                  (const h16*)(ws + OFF_WGU) + ((size_t)e * 1024 + nt * 128) * 1024, 1024, 16, sm);
#pragma unroll
    for (int m = 0; m < 4; ++m) {
      const int sl = mt * 128 + wr * 64 + m * 16 + fr;
      if (sl < cnt_e) {
#pragma unroll
        for (int n2 = 0; n2 < 2; ++n2) {
          const f32x4 gt = acc[m][2 * n2], up = acc[m][2 * n2 + 1];
          const int col = nt * 64 + wc * 32 + n2 * 16 + 4 * fq;
          *(h16x4*)(hid + (size_t)(roff_e + sl) * 512 + col) = pack4(silu_f(gt[0]) * up[0], silu_f(gt[1]) * up[1], silu_f(gt[2]) * up[2], silu_f(gt[3]) * up[3]);
        }
      }
    }
  }
}

__device__ __forceinline__ void phase_moe2(const Params& p, int l, h16* sm) {
  unsigned char* ws = p.ws;
  MoeSched sc;
  moe_sched(p, l, sc);
  const int lane = threadIdx.x & 63, wave = threadIdx.x >> 6, wr = wave >> 1, wc = wave & 1, fr = lane & 15, fq = lane >> 4;
  const int* list = (const int*)(ws + OFF_LIST);
  const float* wpair = (const float*)(ws + OFF_WPAIR);
  const h16* hid = (const h16*)(ws + OFF_HID);
  h16* yp = (h16*)(ws + OFF_YPAIR);
  const int total = sc.toff[16] * 8;
  for (int t = blockIdx.x; t < total; t += gridDim.x) {
    int e = 0, rem = t;
#pragma unroll
    for (int k = 0; k < 16; ++k) {
      const int ne = (sc.toff[k + 1] - sc.toff[k]) * 8;
      if (e == k && rem >= ne) { rem -= ne; e = k + 1; }
    }
    int cnt_e = 0, roff_e = 0, nte = 1;
#pragma unroll
    for (int k = 0; k < 16; ++k) if (k == e) { cnt_e = sc.cnt[k]; roff_e = sc.roff[k]; nte = sc.toff[k + 1] - sc.toff[k]; }
    const int nt = rem / nte, mt = rem % nte;
    const int* le = list + (size_t)e * 16384;
    const h16* Ab = hid + (size_t)(roff_e + mt * 128) * 512;
    f32x4 acc[4][4];
    gemm_mainloop(acc, [&](int r) { return Ab + (size_t)r * 512; }, (const h16*)(ws + OFF_WDN) + ((size_t)e * 1024 + nt * 128) * 512, 512, 8, sm);
#pragma unroll
    for (int m = 0; m < 4; ++m) {
      const int sl = mt * 128 + wr * 64 + m * 16 + fr;
      if (sl < cnt_e) {
        const int pair = le[sl];
        const float w = wpair[pair];
#pragma unroll
        for (int n = 0; n < 4; ++n) {
          const int col = nt * 128 + wc * 64 + n * 16 + 4 * fq;
          *(h16x4*)(yp + (size_t)pair * D + col) = pack4(acc[m][n][0] * w, acc[m][n][1] * w, acc[m][n][2] * w, acc[m][n][3] * w);
        }
      }
    }
  }
}

#define XB_TMO      128
#define XB_XCNT(j)  (256  + 64 * (j))
#define XB_XSUB(j)  (1280 + 64 * (j))
#define XB_XGEN(j)  (2304 + 64 * (j))
#define XB_TOP      3328
#define XB_TOPGEN   3392
#define XCD_BAR_WORDS 3456
#define XB_SPIN_CAP (1u << 20)
__device__ __forceinline__ unsigned xb_ld(unsigned* p) { return __hip_atomic_load(p, __ATOMIC_RELAXED, __HIP_MEMORY_SCOPE_AGENT); }
__device__ __forceinline__ unsigned xb_add(unsigned* p, unsigned v) { return __hip_atomic_fetch_add(p, v, __ATOMIC_RELAXED, __HIP_MEMORY_SCOPE_AGENT); }
__device__ __forceinline__ unsigned xb_xcc_id() { return (unsigned)__builtin_amdgcn_s_getreg((3 << 11) | 20) & 0xFu; }
#define XB_SPIN(cond, bar) do { unsigned _sp = 0; while (cond) { __builtin_amdgcn_s_sleep(1); \
    if ((++_sp & 255u) == 0u) { if (xb_ld(&(bar)[XB_TMO])) break; if (_sp > XB_SPIN_CAP) { atomicAdd(&(bar)[XB_TMO], 1u); break; } } } } while (0)
struct XBar { unsigned* bar; unsigned x; unsigned nloc, nx; };
__device__ __forceinline__ void xbar_post(XBar& b, unsigned* bar) {
  b.bar = bar; b.x = xb_xcc_id(); b.nloc = 0u; b.nx = 0u;
  if (threadIdx.x == 0) (void)xb_add(&bar[XB_XCNT(b.x)], 1u);
}
__device__ __forceinline__ void xbar_census(unsigned* bar, unsigned x, unsigned& nloc, unsigned& nx) {
  const unsigned G = gridDim.x;
  unsigned sum, cnt, mine, sp = 0u;
  for (;;) {
    sum = 0u; cnt = 0u; mine = 0u;
#pragma unroll
    for (unsigned j = 0; j < 16; ++j) { const unsigned c = xb_ld(&bar[XB_XCNT(j)]); sum += c; cnt += (c > 0u) ? 1u : 0u; mine = (j == x) ? c : mine; }
    if (sum == G) break;
    __builtin_amdgcn_s_sleep(1);
    if ((++sp & 255u) == 0u) { if (xb_ld(&bar[XB_TMO])) break; if (sp > XB_SPIN_CAP) { atomicAdd(&bar[XB_TMO], 1u); break; } }
  }
  nloc = mine > 0u ? mine : 1u; nx = cnt > 0u ? cnt : 1u;
}
__device__ __forceinline__ void xbar_sync(XBar& b) {
  asm volatile("s_waitcnt vmcnt(0)" ::: "memory");
  __syncthreads();
  if (threadIdx.x == 0) {
    unsigned* bar = b.bar;
    __builtin_amdgcn_s_waitcnt(0);
    if (b.nloc == 0u) xbar_census(bar, b.x, b.nloc, b.nx);
    const unsigned nloc = b.nloc, nx = b.nx;
    const unsigned old = xb_add(&bar[XB_XSUB(b.x)], 1u);
    const unsigned gen = old / nloc;
    if (old + 1u == (gen + 1u) * nloc) {
      __builtin_amdgcn_fence(__ATOMIC_RELEASE, "agent");
      asm volatile("s_waitcnt vmcnt(0)" ::: "memory");
      const unsigned og = xb_add(&bar[XB_TOP], 1u);
      const unsigned tg = og / nx;
      if (og + 1u == (tg + 1u) * nx) xb_add(&bar[XB_TOPGEN], 1u);
      else XB_SPIN(xb_ld(&bar[XB_TOPGEN]) == tg, bar);
      __builtin_amdgcn_fence(__ATOMIC_ACQUIRE, "agent");
      xb_add(&bar[XB_XGEN(b.x)], 1u);
      asm volatile("s_waitcnt vmcnt(0)" ::: "memory");
    } else {
      XB_SPIN(xb_ld(&bar[XB_XGEN(b.x)]) == gen, bar);
      __builtin_amdgcn_fence(__ATOMIC_ACQUIRE, "agent");
      asm volatile("s_waitcnt vmcnt(0)" ::: "memory");
    }
  }
  __syncthreads();
}

constexpr int NSTEPS = 22;
#define STEP(k, body) do { if (s_lo <= (k) && (k) < s_hi) { body; if ((k) + 1 < s_hi) { if ((k) == 0) grid.sync(); else xbar_sync(xb); } } } while (0)
#define LAYER_STEPS(l, base) \
  STEP(base + 0, phase_norm1(p, l); if (l == 1) phase_convert(p, 1, (float*)smem)); \
  STEP(base + 1, phase_inproj(p, (h16*)smem)); \
  STEP(base + 2, phase_post(p)); \
  STEP(base + 3, phase_mixa(p, l, smem)); \
  STEP(base + 4, phase_mixb(p, l)); \
  STEP(base + 5, phase_attn(p, l, (float*)smem)); \
  STEP(base + 6, phase_outproj(p, l, (h16*)smem)); \
  STEP(base + 7, phase_router(p, l)); \
  STEP(base + 8, phase_moe1(p, l, (h16*)smem)); \
  STEP(base + 9, phase_moe2(p, l, (h16*)smem))

__global__ void __launch_bounds__(NTHREADS, 2) mega(Params p, int s_lo, int s_hi) {
  __shared__ __attribute__((aligned(16))) unsigned char smem[65536];
  cg::grid_group grid = cg::this_grid();
  XBar xb;
  xbar_post(xb, (unsigned*)(p.ws + OFF_BAR));
  STEP(0, phase_prep(p, (float*)smem); phase_convert(p, 0, (float*)smem));
  LAYER_STEPS(0, 1);
  LAYER_STEPS(1, 11);
  STEP(21, phase_norm1(p, 2));
}

extern "C" void kernel_launch(void* const* d_in, const int* in_sizes, int n_in, void* d_out, int out_size, void* d_ws, size_t ws_size,
                              hipStream_t stream) {
  static int grid_blocks = 0;
  if (!grid_blocks) {
    if (n_in != 35 || out_size != T * D || ws_size < WS_TOTAL) {
      fprintf(stderr, "kernel_launch: unexpected problem (n_in %d, out %d, ws %zu < %zu)\n", n_in, out_size, ws_size, (size_t)WS_TOTAL);
      grid_blocks = -1;
      return;
    }
    int dev = 0, cus = 0, per_cu = 0;
    hipGetDevice(&dev);
    hipDeviceGetAttribute(&cus, hipDeviceAttributeMultiprocessorCount, dev);
    hipOccupancyMaxActiveBlocksPerMultiprocessor(&per_cu, mega, NTHREADS, 0);
    if (per_cu > 2) per_cu = 2;
    if (per_cu < 1) { fprintf(stderr, "kernel_launch: occupancy query returned %d\n", per_cu); grid_blocks = -1; return; }
    grid_blocks = cus * per_cu;
  }
  if (grid_blocks < 0) return;
  Params p{};
  for (int i = 0; i < 35; ++i) p.in[i] = (const float*)d_in[i];
  p.out = (float*)d_out;
  p.ws = (unsigned char*)d_ws;
  for (int i = 0; i < 32; ++i) p.inv_freq[i] = std::pow(10000.0, -(double)(2 * i) / 64.0);
  if (hipMemsetAsync((char*)d_ws + OFF_BAR, 0, 16384, stream) != hipSuccess) { fprintf(stderr, "kernel_launch: memset of barrier words failed\n"); return; }
#if MEGA
  int lo = 0, hi = NSTEPS;
  void* args[] = {&p, &lo, &hi};
  hipError_t e = hipLaunchCooperativeKernel((void*)mega, dim3(grid_blocks), dim3(NTHREADS), args, 0, stream);
  if (e != hipSuccess) fprintf(stderr, "cooperative launch failed: %s (grid %d)\n", hipGetErrorString(e), grid_blocks);
#else
  for (int s = 0; s < NSTEPS; ++s) {
    int lo = s, hi = s + 1;
    void* args[] = {&p, &lo, &hi};
    hipError_t e = hipLaunchCooperativeKernel((void*)mega, dim3(grid_blocks), dim3(NTHREADS), args, 0, stream);
    if (e != hipSuccess) { fprintf(stderr, "launch %d failed: %s (grid %d)\n", s, hipGetErrorString(e), grid_blocks); break; }
  }
#endif
}
```

```cpp
#include <hip/hip_runtime.h>
#include <hip/hip_cooperative_groups.h>
#include <cstdio>
#include <cstdint>
#include <cmath>
namespace cg = cooperative_groups;

#ifndef MEGA
#define MEGA 1
#endif

typedef _Float16 h16;
typedef _Float16 h16x8 __attribute__((ext_vector_type(8)));
typedef _Float16 h16x4 __attribute__((ext_vector_type(4)));
typedef float f32x4 __attribute__((ext_vector_type(4)));

constexpr int NB = 2, S = 8192, T = NB * S, D = 1024;
constexpr int NIN = 2432;
constexpr int NINSRC = 2328;
constexpr int C_XL = 0, C_GL = 256, C_Q = 512, C_KC = 1024, C_VC = 1152, C_KS = 1280, C_VS = 1408, C_KW = 1536, C_VW = 1664,
              C_CVA = 1792, C_CVB = 2048, C_GATE = 2304;
constexpr float EPS = 1e-6f;
constexpr int NTHREADS = 512, NW = 8;
constexpr int LDS_BYTES = 147456;
constexpr int NINP = 2560;
constexpr int SCHED_OFF = LDS_BYTES - 1024;
constexpr float ASCALE = 16.f;

constexpr size_t al256(size_t x) { return (x + 255) & ~(size_t)255; }
constexpr size_t OFF_CTL = 0;
constexpr size_t OFF_BAR = 4096;
constexpr size_t OFF_MOD = 4096 + 16384;
constexpr size_t OFF_ROPE = al256(OFF_MOD + 2 * 2 * 6144 * 4);
constexpr size_t OFF_PB = al256(OFF_ROPE + (size_t)T * 64 * 4);
constexpr size_t OFF_GATES = al256(OFF_PB + 2 * 256 * 4);
constexpr size_t OFF_WIN = al256(OFF_GATES + (size_t)T * 24 * 4);
constexpr size_t OFF_WOUT = al256(OFF_WIN + (size_t)NINP * 1024 * 2);
constexpr size_t OFF_WGU = al256(OFF_WOUT + (size_t)1024 * 1024 * 2);
constexpr size_t OFF_WDN = al256(OFF_WGU + (size_t)16 * 1024 * 1024 * 2);
constexpr size_t OFF_W1K = al256(OFF_WDN + (size_t)16 * 1024 * 512 * 2);
constexpr size_t OFF_W1V = al256(OFF_W1K + (size_t)256 * 2048 * 2);
constexpr size_t OFF_H16 = al256(OFF_W1V + (size_t)256 * 2048 * 2);
constexpr size_t OFF_Q16 = al256(OFF_H16 + (size_t)T * 1024 * 2);
constexpr size_t KVSZ = (size_t)T * 128 * 2;
constexpr size_t OFF_KC = al256(OFF_Q16 + (size_t)T * 512 * 2);
constexpr size_t OFF_VC = al256(OFF_KC + KVSZ + 4096);
constexpr size_t OFF_KS = al256(OFF_VC + KVSZ + 4096);
constexpr size_t OFF_VST = al256(OFF_KS + KVSZ);
constexpr size_t OFF_KW = al256(OFF_VST + KVSZ);
constexpr size_t OFF_VWT = al256(OFF_KW + KVSZ);
constexpr size_t OFF_HIDC = al256(OFF_VWT + KVSZ);
constexpr size_t OFF_KCMP = al256(OFF_HIDC + (size_t)2 * 2048 * 256 * 2);
constexpr size_t OFF_VCMPT = al256(OFF_KCMP + (size_t)4 * 512 * 64 * 2);
constexpr size_t OFF_LRUH = al256(OFF_VCMPT + (size_t)4 * 512 * 64 * 2);
constexpr size_t OFF_LRUA = al256(OFF_LRUH + (size_t)T * 256 * 4);
constexpr size_t OFF_HEND = al256(OFF_LRUA + (size_t)T * 256 * 4);
constexpr size_t OFF_AEND = al256(OFF_HEND + 2 * 128 * 256 * 4);
constexpr size_t OFF_CARRY = al256(OFF_AEND + 2 * 128 * 256 * 4);
constexpr size_t OFF_XA = al256(OFF_CARRY + 2 * 128 * 256 * 4);
constexpr size_t OFF_LIST = al256(OFF_XA + (size_t)T * 1024 * 4);
constexpr size_t OFF_WPAIR = al256(OFF_LIST + (size_t)16 * 16384 * 4);
constexpr size_t OFF_SSQ = al256(OFF_WPAIR + 32768 * 4);
constexpr size_t OFF_R = al256(OFF_SSQ + (size_t)T * 2 * 4);
constexpr size_t OFF_P16 = OFF_R;
constexpr size_t OFF_HID = OFF_R;
constexpr size_t OFF_YPAIR = al256(OFF_HID + (size_t)(32768 + 512) * 512 * 2);
constexpr size_t R_END1 = OFF_P16 + (size_t)T * NIN * 2;
constexpr size_t R_END2 = OFF_YPAIR + (size_t)32768 * 1024 * 2;
constexpr size_t WS_TOTAL = al256(R_END1 > R_END2 ? R_END1 : R_END2);

struct Params {
  const float* in[35];
  float* out;
  unsigned char* ws;
  double inv_freq[32];
};
enum { I_X = 0, I_C, I_POS, I_ADAW, I_ADAB, I_N1G, I_N2G, I_WIN, I_LCW, I_LCB, I_LWA, I_LBA, I_LWX, I_LBX, I_LLAM, I_CKW1, I_CKW2,
       I_CVW1, I_CVW2, I_CPK, I_CPV, I_DWW, I_DWB, I_LNG, I_LNB, I_ONG, I_WOUT, I_RGW, I_RGB, I_REW, I_REB, I_MG, I_MU, I_MD, I_FNG };

__device__ __forceinline__ int tidx() { int t = threadIdx.x; asm volatile("" : "+v"(t)); return t; }
__device__ __forceinline__ float wsum(float v) {
#pragma unroll
  for (int o = 32; o > 0; o >>= 1) v += __shfl_xor(v, o);
  return v;
}
__device__ __forceinline__ float sigm(float x) { return 1.f / (1.f + __expf(-x)); }
__device__ __forceinline__ float silu_f(float x) { return x / (1.f + __expf(-x)); }
__device__ __forceinline__ float gelu_tanh(float x) {
  float u = 0.7978845608028654f * (x + 0.044715f * x * x * x);
  float e = __expf(2.f * u);
  float t = 1.f - 2.f / (e + 1.f);
  return 0.5f * x * (1.f + t);
}
__device__ __forceinline__ void glds16(const h16* g, h16* l) {
  __builtin_amdgcn_global_load_lds((const unsigned*)g, (unsigned*)l, 16, 0, 0);
}
__device__ __forceinline__ h16x4 pack4(float a, float b, float c, float d) {
  h16x4 r; r[0] = (h16)a; r[1] = (h16)b; r[2] = (h16)c; r[3] = (h16)d; return r;
}

__device__ __forceinline__ int swz32(int row) { return (0x78 >> (((row >> 2) & 3) * 2)) & 3; }
#define VMCNT(n) asm volatile("s_waitcnt vmcnt(" #n ")" ::: "memory")
template <class ARowFn>
__device__ __forceinline__ void gemm_mainloop(f32x4 (&acc)[8][4], ARowFn arow, const h16* __restrict__ Bt, int ldb, int nk, h16* sm, bool zero_init = true) {
  const int tid = tidx(), lane = tid & 63, wave = tid >> 6;
  const int wr = wave >> 2, wc = wave & 3, fr = lane & 15, fq = lane >> 4;
  const h16* ap[2];
  const h16* bp[2];
#pragma unroll
  for (int i = 0; i < 2; ++i) {
    const int r = (i * 8 + wave) * 16 + (lane >> 2);
    const int c = (lane & 3) ^ swz32(r);
    ap[i] = arow(r) + c * 8;
    bp[i] = Bt + (size_t)r * ldb + c * 8;
  }
  if (zero_init) {
#pragma unroll
    for (int m = 0; m < 8; ++m)
#pragma unroll
      for (int n = 0; n < 4; ++n) acc[m][n] = (f32x4){0.f, 0.f, 0.f, 0.f};
  }
  h16* const dA = sm + wave * 512 + lane * 8;
#define GEMM_ISSUE(st) do { h16* d_ = dA + (st) * 16384; \
    glds16(ap[0], d_); glds16(ap[1], d_ + 4096); glds16(bp[0], d_ + 8192); glds16(bp[1], d_ + 12288); \
    ap[0] += 32; ap[1] += 32; bp[0] += 32; bp[1] += 32; } while (0)
  GEMM_ISSUE(0); GEMM_ISSUE(1); GEMM_ISSUE(2);
  const int aoff = (wr * 128 + fr) * 32 + ((fq ^ swz32(fr)) * 8);
  const int boff = 8192 + (wc * 64 + fr) * 32 + ((fq ^ swz32(fr)) * 8);
  for (int kt = 0; kt < nk; ++kt) {
    if (kt + 2 < nk) VMCNT(8); else if (kt + 1 < nk) VMCNT(4); else VMCNT(0);
    __builtin_amdgcn_s_barrier();
    if (kt + 3 < nk) GEMM_ISSUE((kt + 3) & 3);
    const h16* st = sm + (kt & 3) * 16384;
    h16x8 bf[4];
#pragma unroll
    for (int n = 0; n < 4; ++n) bf[n] = *(const h16x8*)(st + boff + n * 512);
#pragma unroll
    for (int mh = 0; mh < 2; ++mh) {
      h16x8 af[4];
#pragma unroll
      for (int m = 0; m < 4; ++m) af[m] = *(const h16x8*)(st + aoff + (mh * 4 + m) * 512);
#pragma unroll
      for (int m = 0; m < 4; ++m)
#pragma unroll
        for (int n = 0; n < 4; ++n) acc[mh * 4 + m][n] = __builtin_amdgcn_mfma_f32_16x16x32_f16(bf[n], af[m], acc[mh * 4 + m][n], 0, 0, 0);
    }
  }
#undef GEMM_ISSUE
  __builtin_amdgcn_s_barrier();
}

__device__ __forceinline__ int map_row(int mode, int n) {
  if (mode == 1) return n < 1792 ? n : (n < 1816 ? n + 512 : n - 24);
  if (mode == 2) return 32 * (n >> 4) + (n & 15);
  if (mode == 3) return 32 * (n >> 4) + 16 + (n & 15);
  return n;
}
__device__ __forceinline__ void conv_tile(const float* __restrict__ src, int K, int N, h16* __restrict__ dst, int mode, int tk, int tn, float* sm) {
  const int tid = tidx();
  const int k0 = tk * 64, n0 = tn * 64;
  const int k0d = mode == 4 ? (k0 < 256 ? k0 + 512 : (k0 < 768 ? k0 - 256 : k0)) : k0;
#pragma unroll
  for (int i = 0; i < 2; ++i) {
    const int idx = i * NTHREADS + tid;
    const int r = idx >> 4, c4 = (idx & 15) * 4;
    float4 v = make_float4(0.f, 0.f, 0.f, 0.f);
    if (n0 + c4 < N) v = *(const float4*)(src + (size_t)(k0 + r) * N + n0 + c4);
    float* d = sm + r * 65 + c4;
    d[0] = v.x; d[1] = v.y; d[2] = v.z; d[3] = v.w;
  }
  __syncthreads();
  {
    const int idx = tid;
    const int n = idx >> 3, kc = idx & 7;
    if (n0 + n < N) {
      h16x8 o;
#pragma unroll
      for (int j = 0; j < 8; ++j) o[j] = (h16)sm[(kc * 8 + j) * 65 + n];
      *(h16x8*)(dst + (size_t)map_row(mode, n0 + n) * K + k0d + kc * 8) = o;
    }
  }
  __syncthreads();
}

__device__ __forceinline__ void phase_convert(const Params& p, int l, float* sm) {
  unsigned char* ws = p.ws;
  constexpr int T_WIN = 16 * 37, T_WOUT = 256, T_G = 16 * 128, T_W1 = 128;
  constexpr int E0 = T_WIN, E1 = E0 + T_WOUT, E2 = E1 + T_G, E3 = E2 + T_G, E4 = E3 + T_G, E5 = E4 + T_W1, E6 = E5 + T_W1;
  for (int t = blockIdx.x; t < E6; t += gridDim.x) {
    if (t < E0) {
      conv_tile(p.in[I_WIN] + (size_t)l * 1024 * NINSRC, 1024, NINSRC, (h16*)(ws + OFF_WIN), 1, t / 37, t % 37, sm);
    } else if (t < E1) {
      const int u = t - E0;
      conv_tile(p.in[I_WOUT] + (size_t)l * 1024 * 1024, 1024, 1024, (h16*)(ws + OFF_WOUT), 4, u >> 4, u & 15, sm);
    } else if (t < E3) {
      const int up = t >= E2;
      const int u = t - (up ? E2 : E1);
      const int e = u >> 7, v = u & 127;
      conv_tile(p.in[up ? I_MU : I_MG] + ((size_t)l * 16 + e) * 1024 * 512, 1024, 512, (h16*)(ws + OFF_WGU) + (size_t)e * 1024 * 1024, up ? 3 : 2,
                v >> 3, v & 7, sm);
    } else if (t < E4) {
      const int u = t - E3;
      const int e = u >> 7, v = u & 127;
      conv_tile(p.in[I_MD] + ((size_t)l * 16 + e) * 512 * 1024, 512, 1024, (h16*)(ws + OFF_WDN) + (size_t)e * 1024 * 512, 0, v >> 4, v & 15, sm);
    } else {
      const int vv = t >= E5;
      const int u = t - (vv ? E5 : E4);
      conv_tile(p.in[vv ? I_CVW1 : I_CKW1] + (size_t)l * 2048 * 256, 2048, 256, (h16*)(ws + (vv ? OFF_W1V : OFF_W1K)), 0, u >> 2, u & 3, sm);
    }
  }
  {
    h16x8 z = {0, 0, 0, 0, 0, 0, 0, 0};
    h16* w = (h16*)(ws + OFF_WIN) + (size_t)NINSRC * 1024;
    for (int i = blockIdx.x * NTHREADS + tidx(); i < (NINP - NINSRC) * 1024 / 8; i += gridDim.x * NTHREADS) *(h16x8*)(w + (size_t)i * 8) = z;
  }
  for (int t = blockIdx.x; t < 8; t += gridDim.x) {
    const int kv = t >> 2, nt = t & 3;
    const float* w1 = p.in[kv ? I_CVW1 : I_CKW1] + (size_t)l * 2048 * 256;
    const float* pos = p.in[kv ? I_CPV : I_CPK] + (size_t)l * 2048;
    const int n = nt * 64 + (tidx() & 63), kg = tidx() >> 6;
    float s = 0.f;
    for (int k = kg * 256; k < kg * 256 + 256; ++k) s += pos[k] * w1[(size_t)k * 256 + n];
    sm[kg * 64 + (tidx() & 63)] = s;
    __syncthreads();
    if (tidx() < 64) {
      float t8 = 0.f;
      for (int q = 0; q < 8; ++q) t8 += sm[q * 64 + tidx()];
      ((float*)(ws + OFF_PB))[kv * 256 + n] = t8;
    }
    __syncthreads();
  }
}

__device__ __forceinline__ void phase_prep(const Params& p, float* sm) {
  unsigned char* ws = p.ws;
  const int tid = tidx();
  if (blockIdx.x == 0) {
    for (int i = tid; i < 1024; i += NTHREADS) ((unsigned*)(ws + OFF_CTL))[i] = 0u;
  }
  float* mod = (float*)(ws + OFF_MOD);
  for (int t = blockIdx.x; t < 384; t += gridDim.x) {
    const int l = t / 192, j0 = (t % 192) * 32;
    const int kg = tid >> 3, cq = tid & 7;
    const float* w = p.in[I_ADAW] + (size_t)l * 1024 * 6144 + j0 + 4 * cq;
    const float* c = p.in[I_C];
    float a0[4] = {0, 0, 0, 0}, a1[4] = {0, 0, 0, 0};
#pragma unroll 8
    for (int k = kg * 16; k < kg * 16 + 16; ++k) {
      const float4 wv = *(const float4*)(w + (size_t)k * 6144);
      const float s0 = silu_f(c[k]), s1 = silu_f(c[1024 + k]);
      a0[0] += s0 * wv.x; a0[1] += s0 * wv.y; a0[2] += s0 * wv.z; a0[3] += s0 * wv.w;
      a1[0] += s1 * wv.x; a1[1] += s1 * wv.y; a1[2] += s1 * wv.z; a1[3] += s1 * wv.w;
    }
    float* r = sm + (kg * 8 + cq) * 8;
#pragma unroll
    for (int i = 0; i < 4; ++i) { r[i] = a0[i]; r[4 + i] = a1[i]; }
    __syncthreads();
    if (tid < 64) {
      const int bb = tid >> 5, col = tid & 31, q = col >> 2, ci = col & 3;
      float s = 0.f;
      for (int g = 0; g < 64; ++g) s += sm[(g * 8 + q) * 8 + bb * 4 + ci];
      mod[(size_t)(l * 2 + bb) * 6144 + j0 + col] = s + p.in[I_ADAB][l * 6144 + j0 + col];
    }
    __syncthreads();
  }
  float* rc = (float*)(ws + OFF_ROPE);
  float* rs = rc + (size_t)T * 32;
  const int* pos = (const int*)p.in[I_POS];
  for (int i = blockIdx.x * NTHREADS + tid; i < T * 32; i += gridDim.x * NTHREADS) {
    const int t = i >> 5, f = i & 31;
    const double a = (double)pos[t] * p.inv_freq[f];
    const double n = rint(a * 0.15915494309189535);
    double r = fma(-n, 6.283185307179586, a);
    r = fma(-n, 2.4492935982947064e-16, r);
    const float rf = (float)r;
    rc[i] = cosf(rf);
    rs[i] = sinf(rf);
  }
}

__device__ __forceinline__ void phase_norm1(const Params& p, int mode) {
  unsigned char* ws = p.ws;
  const int lane = tidx() & 63, wave = tidx() >> 6;
  const float* mod = (const float*)(ws + OFF_MOD);
  float* xa = (float*)(ws + OFF_XA);
  const h16* yp = (const h16*)(ws + OFF_YPAIR);
  h16* hout = (h16*)(ws + OFF_H16);
  const int l = (mode == 0) ? 0 : 1;
  for (int row = blockIdx.x * NW + wave; row < T; row += gridDim.x * NW) {
    const int b = row >> 13;
    float4 x[4];
    float ss = 0.f;
#pragma unroll
    for (int i = 0; i < 4; ++i) {
      const int col = lane * 4 + 256 * i;
      if (mode == 0) {
        x[i] = *(const float4*)(p.in[I_X] + (size_t)row * D + col);
      } else {
        const int lp = mode == 1 ? 0 : 1;
        const float4 xv = *(const float4*)(xa + (size_t)row * D + col);
        const float4 g2 = *(const float4*)(mod + (size_t)(lp * 2 + b) * 6144 + 5120 + col);
        const h16x4 y0 = *(const h16x4*)(yp + (size_t)(row * 2) * D + col);
        const h16x4 y1 = *(const h16x4*)(yp + (size_t)(row * 2 + 1) * D + col);
        x[i].x = xv.x + g2.x * ((float)y0[0] + (float)y1[0]);
        x[i].y = xv.y + g2.y * ((float)y0[1] + (float)y1[1]);
        x[i].z = xv.z + g2.z * ((float)y0[2] + (float)y1[2]);
        x[i].w = xv.w + g2.w * ((float)y0[3] + (float)y1[3]);
        if (mode == 1) *(float4*)(xa + (size_t)row * D + col) = x[i];
      }
      ss += x[i].x * x[i].x + x[i].y * x[i].y + x[i].z * x[i].z + x[i].w * x[i].w;
    }
    ss = wsum(ss);
    const float rstd = rsqrtf(ss * (1.f / D) + EPS);
#pragma unroll
    for (int i = 0; i < 4; ++i) {
      const int col = lane * 4 + 256 * i;
      if (mode == 2) {
        const float4 g = *(const float4*)(p.in[I_FNG] + col);
        float4 o;
        o.x = x[i].x * rstd * g.x; o.y = x[i].y * rstd * g.y; o.z = x[i].z * rstd * g.z; o.w = x[i].w * rstd * g.w;
        *(float4*)(p.out + (size_t)row * D + col) = o;
      } else {
        const float4 g = *(const float4*)(p.in[I_N1G] + l * D + col);
        const float4 sh = *(const float4*)(mod + (size_t)(l * 2 + b) * 6144 + col);
        const float4 sc = *(const float4*)(mod + (size_t)(l * 2 + b) * 6144 + 1024 + col);
        *(h16x4*)(hout + (size_t)row * D + col) = pack4(x[i].x * rstd * g.x * (1.f + sc.x) + sh.x, x[i].y * rstd * g.y * (1.f + sc.y) + sh.y,
                                                        x[i].z * rstd * g.z * (1.f + sc.z) + sh.z, x[i].w * rstd * g.w * (1.f + sc.w) + sh.w);
      }
    }
  }
}

__device__ __forceinline__ void phase_inproj(const Params& p, h16* sm) {
  unsigned char* ws = p.ws;
  const h16* A = (const h16*)(ws + OFF_H16);
  const h16* W = (const h16*)(ws + OFF_WIN);
  h16* P = (h16*)(ws + OFF_P16);
  for (int t = blockIdx.x; t < 64 * 10; t += gridDim.x) {
    const int mt = t / 10, nt = t % 10;
    f32x4 acc[8][4];
    const h16* Ab = A + (size_t)mt * 256 * D;
    gemm_mainloop(acc, [&](int r) { return Ab + (size_t)r * D; }, W + (size_t)nt * 256 * D, D, D / 32, sm);
    const int tid_e = tidx(), lane = tid_e & 63, wave = tid_e >> 6, wr = wave >> 2, wc = wave & 3, fr = lane & 15, fq = lane >> 4;
    if (nt * 256 + wc * 64 < NIN) {
#pragma unroll
      for (int m = 0; m < 8; ++m)
#pragma unroll
        for (int n = 0; n < 4; ++n) {
          const int row = mt * 256 + wr * 128 + m * 16 + fr, col = nt * 256 + wc * 64 + n * 16 + 4 * fq;
          *(h16x4*)(P + (size_t)row * NIN + col) = pack4(acc[m][n][0], acc[m][n][1], acc[m][n][2], acc[m][n][3]);
        }
    }
  }
}

__device__ __forceinline__ int perm_key(int pos) {
  return 32 * (pos >> 5) + 16 * ((pos >> 2) & 1) + 4 * ((pos >> 3) & 3) + (pos & 3);
}
__device__ __forceinline__ void phase_post(const Params& p) {
  unsigned char* ws = p.ws;
  const h16* P = (const h16*)(ws + OFF_P16);
  const float* rc = (const float*)(ws + OFF_ROPE);
  const float* rs = rc + (size_t)T * 32;
  h16* q16 = (h16*)(ws + OFF_Q16);
  float* gates = (float*)(ws + OFF_GATES);
  const int lane = tidx() & 63, wave = tidx() >> 6;
  for (int row = blockIdx.x * NW + wave; row < T; row += gridDim.x * NW) {
    const int b = row >> 13, s = row & (S - 1);
    const h16* pr = P + (size_t)row * NIN;
    const int d = (lane & 7) * 4;
    const float4 cs = *(const float4*)(rc + (size_t)row * 32 + d);
    const float4 sn = *(const float4*)(rs + (size_t)row * 32 + d);
    {
      const int hd = lane >> 3;
      const h16x4 a = *(const h16x4*)(pr + C_Q + 64 * hd + d);
      const h16x4 bb = *(const h16x4*)(pr + C_Q + 64 * hd + 32 + d);
      const float a0 = a[0], a1 = a[1], a2 = a[2], a3 = a[3], b0 = bb[0], b1 = bb[1], b2 = bb[2], b3 = bb[3];
      h16* qo = q16 + (size_t)row * 512 + 64 * hd + d;
      *(h16x4*)qo = pack4((a0 * cs.x - b0 * sn.x) * 0.125f, (a1 * cs.y - b1 * sn.y) * 0.125f, (a2 * cs.z - b2 * sn.z) * 0.125f, (a3 * cs.w - b3 * sn.w) * 0.125f);
      *(h16x4*)(qo + 32) = pack4((b0 * cs.x + a0 * sn.x) * 0.125f, (b1 * cs.y + a1 * sn.y) * 0.125f, (b2 * cs.z + a2 * sn.z) * 0.125f, (b3 * cs.w + a3 * sn.w) * 0.125f);
    }
    if (lane < 48) {
      const int tn = lane >> 4, hd = (lane >> 3) & 1;
      const int cb = (tn == 0 ? C_KC : (tn == 1 ? C_KS : C_KW)) + 64 * hd;
      const size_t off = tn == 0 ? OFF_KC : (tn == 1 ? OFF_KS : OFF_KW);
      const h16x4 a = *(const h16x4*)(pr + cb + d);
      const h16x4 bb = *(const h16x4*)(pr + cb + 32 + d);
      const float a0 = a[0], a1 = a[1], a2 = a[2], a3 = a[3], b0 = bb[0], b1 = bb[1], b2 = bb[2], b3 = bb[3];
      h16* ko = (h16*)(ws + off) + ((size_t)(b * 2 + hd) * S + s) * 64 + d;
      *(h16x4*)ko = pack4(a0 * cs.x - b0 * sn.x, a1 * cs.y - b1 * sn.y, a2 * cs.z - b2 * sn.z, a3 * cs.w - b3 * sn.w);
      *(h16x4*)(ko + 32) = pack4(b0 * cs.x + a0 * sn.x, b1 * cs.y + a1 * sn.y, b2 * cs.z + a2 * sn.z, b3 * cs.w + a3 * sn.w);
    }
    if (lane < 32) {
      const int hd = lane >> 4, dd = (lane & 15) * 4;
      *(h16x4*)((h16*)(ws + OFF_VC) + ((size_t)(b * 2 + hd) * S + s) * 64 + dd) = *(const h16x4*)(pr + C_VC + 64 * hd + dd);
    }
    if (lane < 24) gates[(size_t)row * 24 + lane] = sigm((float)pr[C_GATE + lane]);
  }
  for (int task = blockIdx.x; task < 1024; task += gridDim.x) {
    const int tensor = task & 1, kv = (task >> 1) & 1, blk = (task >> 2) & 127, b = task >> 9;
    const int srccol = (tensor ? C_VW : C_VS) + 64 * kv;
    h16* dst = (h16*)(ws + (tensor ? OFF_VWT : OFF_VST)) + ((size_t)((b * 2 + kv) * 128 + blk)) * 4096;
    const int dim = tidx() & 63, kg = tidx() >> 6;
    {
      const int p0 = kg * 8;
      h16x8 v;
#pragma unroll
      for (int j = 0; j < 8; ++j) v[j] = P[(size_t)(b * S + blk * 64 + perm_key(p0 + j)) * NIN + srccol + dim];
      *(h16x8*)(dst + dim * 64 + p0) = v;
    }
  }
}

__device__ __forceinline__ void mixa_compress1(const Params& p, int item, h16* sm) {
  unsigned char* ws = p.ws;
  const int which = item >> 3, mt = item & 7;
  const h16* A = (const h16*)(ws + (which ? OFF_VC : OFF_KC)) + (size_t)mt * 256 * 1024;
  const h16* W = (const h16*)(ws + (which ? OFF_W1V : OFF_W1K));
  const float* pb = (const float*)(ws + OFF_PB) + which * 256;
  h16* hid = (h16*)(ws + OFF_HIDC) + (size_t)which * 2048 * 256;
  f32x4 acc[8][4];
  gemm_mainloop(acc, [&](int r) { return A + (size_t)r * 1024; }, W, 2048, 64, sm);
  const int tid_e = tidx(), lane = tid_e & 63, wave = tid_e >> 6, wr = wave >> 2, wc = wave & 3, fr = lane & 15, fq = lane >> 4;
#pragma unroll
  for (int m = 0; m < 8; ++m)
#pragma unroll
    for (int n = 0; n < 4; ++n) {
      const int row = mt * 256 + wr * 128 + m * 16 + fr, col = wc * 64 + n * 16 + 4 * fq;
      const float4 bias = *(const float4*)(pb + col);
      *(h16x4*)(hid + (size_t)row * 256 + col) =
          pack4(gelu_tanh(acc[m][n][0] + bias.x), gelu_tanh(acc[m][n][1] + bias.y), gelu_tanh(acc[m][n][2] + bias.z), gelu_tanh(acc[m][n][3] + bias.w));
    }
}

__device__ __forceinline__ void mixa_lru(const Params& p, int l, int item, float* sm) {
  unsigned char* ws = p.ws;
  const int half = tidx() >> 8;
  item = item * 2 + half;
  sm += half * 12288;
  const int b = item >> 7, ck = item & 127;
  const int c = tidx() & 255;
  const int nb = c >> 6, e = c & 63;
  const h16* P = (const h16*)(ws + OFF_P16);
  const float* cw = p.in[I_LCW] + l * 4 * 256;
  const float w0 = cw[c], w1 = cw[256 + c], w2 = cw[512 + c], w3 = cw[768 + c], cb = p.in[I_LCB][l * 256 + c];
  const float ba = p.in[I_LBA][l * 256 + c], bx = p.in[I_LBX][l * 256 + c];
  const float lam = p.in[I_LLAM][l * 256 + c];
  const float ls = -log1pf(expf(-lam));
  const float* pa = p.in[I_LWA] + ((size_t)(l * 4 + nb) * 64) * 64 + e;
  const float* px = p.in[I_LWX] + ((size_t)(l * 4 + nb) * 64) * 64 + e;
  const int t0 = ck * 64;
  float x0 = 0.f, x1 = 0.f, x2 = 0.f;
  if (t0 >= 3) {
    x0 = (float)P[(size_t)(b * S + t0 - 3) * NIN + C_XL + c];
    x1 = (float)P[(size_t)(b * S + t0 - 2) * NIN + C_XL + c];
    x2 = (float)P[(size_t)(b * S + t0 - 1) * NIN + C_XL + c];
  }
  float h = 0.f, ap = 1.f;
  float* lh = (float*)(ws + OFF_LRUH);
  float* la = (float*)(ws + OFF_LRUA);
  float* sr = sm + 4096;
  float* si = sm + 8192;
#pragma unroll 1
  for (int sub = 0; sub < 4; ++sub) {
    const int tb = t0 + sub * 16;
#pragma unroll 1
    for (int tt = 0; tt < 16; ++tt) {
      const float x3 = (float)P[(size_t)(b * S + tb + tt) * NIN + C_XL + c];
      sm[tt * 256 + c] = w0 * x0 + w1 * x1 + w2 * x2 + w3 * x3 + cb;
      x0 = x1; x1 = x2; x2 = x3;
    }
    __syncthreads();
    {
      float accr[16], acci[16];
#pragma unroll
      for (int tt = 0; tt < 16; ++tt) { accr[tt] = 0.f; acci[tt] = 0.f; }
#pragma unroll 1
      for (int d8 = 0; d8 < 8; ++d8) {
        float wa8[8], wx8[8];
        const float* pa8 = pa + d8 * 512;
        const float* px8 = px + d8 * 512;
#pragma unroll
        for (int j = 0; j < 8; ++j) { wa8[j] = pa8[j * 64]; wx8[j] = px8[j * 64]; }
        const float* xr = sm + nb * 64 + d8 * 8;
#pragma unroll
        for (int tt = 0; tt < 16; ++tt) {
          const float4 xa = *(const float4*)(xr + tt * 256), xb = *(const float4*)(xr + tt * 256 + 4);
          accr[tt] += xa.x * wa8[0] + xa.y * wa8[1] + xa.z * wa8[2] + xa.w * wa8[3] + xb.x * wa8[4] + xb.y * wa8[5] + xb.z * wa8[6] + xb.w * wa8[7];
          acci[tt] += xa.x * wx8[0] + xa.y * wx8[1] + xa.z * wx8[2] + xa.w * wx8[3] + xb.x * wx8[4] + xb.y * wx8[5] + xb.z * wx8[6] + xb.w * wx8[7];
        }
      }
#pragma unroll
      for (int tt = 0; tt < 16; ++tt) { sr[tt * 256 + c] = accr[tt]; si[tt * 256 + c] = acci[tt]; }
    }
    float* lhp = lh + (size_t)(b * S + tb) * 256 + c;
    float* lap = la + (size_t)(b * S + tb) * 256 + c;
#pragma unroll 1
    for (int tt = 0; tt < 16; ++tt) {
      const float r = sigm(sr[tt * 256 + c] + ba), ig = sigm(si[tt * 256 + c] + bx);
      const float log_a = 8.f * r * ls;
      const float a = __expf(log_a);
      const float mult = sqrtf(-expm1f(2.f * log_a));
      const float u = mult * ig * sm[tt * 256 + c];
      h = a * h + u;
      ap *= a;
      lhp[tt * 256] = h;
      lap[tt * 256] = ap;
    }
    __syncthreads();
  }
  ((float*)(ws + OFF_HEND))[(size_t)(b * 128 + ck) * 256 + c] = h;
  ((float*)(ws + OFF_AEND))[(size_t)(b * 128 + ck) * 256 + c] = ap;
}

__device__ __forceinline__ void mixa_conv(const Params& p, int l, int item, float* sm) {
  unsigned char* ws = p.ws;
  const int half = tidx() >> 8;
  item = item * 2 + half;
  sm += half * 15872;
  const int b = item >> 8, ck = item & 255;
  const int c = tidx() & 255;
  const h16* P = (const h16*)(ws + OFF_P16);
  const int t0 = ck * 32;
  for (int r = 0; r < 62; ++r) {
    const int t = t0 - 30 + r;
    float v = 0.f;
    if (t >= 0) {
      const h16* pr = P + (size_t)(b * S + t) * NIN;
      v = (float)pr[C_CVA + c] * sigm((float)pr[C_CVB + c]);
    }
    sm[r * 256 + c] = v;
  }
  float w[31];
#pragma unroll
  for (int j = 0; j < 31; ++j) w[j] = p.in[I_DWW][(size_t)(l * 31 + j) * 256 + c];
  const float bias = p.in[I_DWB][l * 256 + c];
  for (int i = 0; i < 32; ++i) {
    float z = bias;
#pragma unroll
    for (int j = 0; j < 31; ++j) z += w[j] * sm[(i + j) * 256 + c];
    sm[i * 256 + c] = z;
  }
  __syncthreads();
  const int lane = tidx() & 63, wave = (tidx() >> 6) & 3;
  const float4 lg = *(const float4*)(p.in[I_LNG] + l * 256 + lane * 4);
  const float4 lb = *(const float4*)(p.in[I_LNB] + l * 256 + lane * 4);
  const float4 gn = *(const float4*)(p.in[I_ONG] + l * 1024 + 768 + lane * 4);
  h16* yc = (h16*)(ws + OFF_H16);
  for (int i = wave * 8; i < wave * 8 + 8; ++i) {
    const float4 z = *(const float4*)(sm + i * 256 + lane * 4);
    const float mu = wsum(z.x + z.y + z.z + z.w) * (1.f / 256.f);
    const float dx = z.x - mu, dy = z.y - mu, dz = z.z - mu, dw = z.w - mu;
    const float var = wsum(dx * dx + dy * dy + dz * dz + dw * dw) * (1.f / 256.f);
    const float rs = rsqrtf(var + EPS);
    const float y0 = silu_f(dx * rs * lg.x + lb.x), y1 = silu_f(dy * rs * lg.y + lb.y), y2 = silu_f(dz * rs * lg.z + lb.z), y3 = silu_f(dw * rs * lg.w + lb.w);
    const float r2 = rsqrtf(wsum(y0 * y0 + y1 * y1 + y2 * y2 + y3 * y3) * (1.f / 256.f) + EPS);
    *(h16x4*)(yc + (size_t)(b * S + t0 + i) * D + 768 + lane * 4) = pack4(y0 * r2 * gn.x, y1 * r2 * gn.y, y2 * r2 * gn.z, y3 * r2 * gn.w);
  }
  __syncthreads();
}

__device__ __forceinline__ void phase_mixa(const Params& p, int l, void* sm) {
  const int G = gridDim.x;
  for (int it = blockIdx.x; it < 16; it += G) mixa_compress1(p, it, (h16*)sm);
  for (int it = (blockIdx.x + G - 16 % G) % G; it < 128; it += G) mixa_lru(p, l, it, (float*)sm);
  for (int it = (blockIdx.x + G - 144 % G) % G; it < 256; it += G) mixa_conv(p, l, it, (float*)sm);
}

__device__ __forceinline__ void phase_mixb(const Params& p, int l) {
  unsigned char* ws = p.ws;
  const int tid = tidx();
  for (int it = blockIdx.x; it < 512; it += gridDim.x) {
    const int which = it >> 8;
    const int row = (it & 255) * 8 + (tid >> 6), d = tid & 63;
    const h16* hr = (const h16*)(ws + OFF_HIDC) + ((size_t)which * 2048 + row) * 256;
    const float* w2 = p.in[which ? I_CVW2 : I_CKW2] + (size_t)l * 256 * 64 + d;
    float s = 0.f;
#pragma unroll 4
    for (int j8 = 0; j8 < 32; ++j8) {
      const h16x8 hv = *(const h16x8*)(hr + j8 * 8);
#pragma unroll
      for (int j = 0; j < 8; ++j) s += (float)hv[j] * w2[(size_t)(j8 * 8 + j) * 64];
    }
    const int bkv = row >> 9, n = row & 511;
    if (n == 511) s = 0.f;
    if (which == 0) {
      ((h16*)(ws + OFF_KCMP))[((size_t)bkv * 512 + n) * 64 + d] = (h16)s;
    } else {
      const int blk = n >> 6, key = n & 63;
      const int pos = 32 * (key >> 5) + 8 * ((key >> 2) & 3) + 4 * ((key >> 4) & 1) + (key & 3);
      ((h16*)(ws + OFF_VCMPT))[((size_t)(bkv * 8 + blk) * 64 + d) * 64 + pos] = (h16)s;
    }
  }
  const int g = blockIdx.x * NTHREADS + tid;
  if (g < 512) {
    const int b = g >> 8, c = g & 255;
    const float* he = (const float*)(ws + OFF_HEND) + (size_t)b * 128 * 256 + c;
    const float* ae = (const float*)(ws + OFF_AEND) + (size_t)b * 128 * 256 + c;
    float* cy = (float*)(ws + OFF_CARRY) + (size_t)b * 128 * 256 + c;
    float carry = 0.f;
#pragma unroll 8
    for (int k = 0; k < 128; ++k) {
      cy[k * 256] = carry;
      carry = he[k * 256] + ae[k * 256] * carry;
    }
  }
}

__device__ __forceinline__ void stage8k(const h16* __restrict__ g, h16* l, int tid) {
  const int r = tid >> 3, cl = (tid & 7) ^ ((r >> 1) & 7);
  glds16(g + r * 64 + cl * 8, l + tid * 8);
}
__device__ __forceinline__ h16x8 ldfrag(const h16* l, int row, int chunk) {
  return *(const h16x8*)(l + row * 64 + ((chunk ^ ((row >> 1) & 7)) * 8));
}

template <int MODE>
__device__ __forceinline__ void attn_branch(const h16* __restrict__ Kg, const h16* __restrict__ Vg, int j0, int j1, h16* ring,
                                            const h16x8 (&qf)[2][2], float (&m)[2], float (&l)[2], f32x4 (&o)[2][4],
                                            const int (&tq)[2], const int (&lim)[2], const int (&tlim)[2],
                                            const unsigned long long (&mylo)[2], const unsigned long long (&myhi)[2],
                                            const unsigned long long (&ulo)[2], const unsigned long long (&uhi)[2],
                                            const float (&inv)[2], float* impw) {
  int tid = tidx();
  asm volatile("" : "+v"(tid));
  const int lane = tid & 63;
  const int h = lane >> 4, c = lane & 15, qi = c >> 2, g = c & 3;
  constexpr bool PV = MODE != 0;
  constexpr int NST = 5;
  const int n = j1 - j0 + 1;
  if (n <= 0) return;
#pragma unroll
  for (int q = 0; q < NST - 1; ++q)
    if (q < n) {
      stage8k(Kg + (size_t)(j0 + q) * 4096, ring + q * 8192, tid);
      if (PV) stage8k(Vg + (size_t)(j0 + q) * 4096, ring + q * 8192 + 4096, tid);
    }
  int cur = 0, nxt = NST - 1;
  for (int it = 0; it < n; ++it) {
    const int j = j0 + it;
    {
      const int rem = n - 1 - it;
      if (PV) { if (rem >= 3) VMCNT(6); else if (rem == 2) VMCNT(4); else if (rem == 1) VMCNT(2); else VMCNT(0); }
      else    { if (rem >= 3) VMCNT(3); else if (rem == 2) VMCNT(2); else if (rem == 1) VMCNT(1); else VMCNT(0); }
    }
    __builtin_amdgcn_s_barrier();
    if (it + NST - 1 < n) {
      stage8k(Kg + (size_t)(j + NST - 1) * 4096, ring + nxt * 8192, tid);
      if (PV) stage8k(Vg + (size_t)(j + NST - 1) * 4096, ring + nxt * 8192 + 4096, tid);
    }
    const h16* cK = ring + cur * 8192;
    const h16* cV = cK + 4096;
    nxt = cur;
    cur = cur + 1 == NST ? 0 : cur + 1;
    bool act[2];
#pragma unroll
    for (int mq = 0; mq < 2; ++mq) {
      if (MODE <= 1) act[mq] = j * 64 <= tlim[mq];
      else if (MODE == 2) act[mq] = ((j < 64 ? (ulo[mq] >> j) : (uhi[mq] >> (j - 64))) & 1ull) != 0ull;
      else act[mq] = (j * 64 <= tlim[mq] + 3) && (j * 64 + 63 > tlim[mq] - 512);
    }
    if (act[0] || act[1]) {
      h16x8 pf[2][2];
      h16x8 kf[4][2];
#pragma unroll
      for (int kt = 0; kt < 4; ++kt)
#pragma unroll
        for (int ks = 0; ks < 2; ++ks) kf[kt][ks] = ldfrag(cK, 16 * kt + c, 4 * ks + h);
#pragma unroll
      for (int mq = 0; mq < 2; ++mq)
        if (act[mq]) {
          f32x4 s[1][4];
          {
#pragma unroll
            for (int kt = 0; kt < 4; ++kt) {
              s[0][kt] = (f32x4){0.f, 0.f, 0.f, 0.f};
#pragma unroll
              for (int ks = 0; ks < 2; ++ks) s[0][kt] = __builtin_amdgcn_mfma_f32_16x16x32_f16(kf[kt][ks], qf[mq][ks], s[0][kt], 0, 0, 0);
            }
          }
          const bool selbit = MODE == 2 ? (((j < 64 ? (mylo[mq] >> j) : (myhi[mq] >> (j - 64))) & 1ull) != 0ull) : true;
          const int pbase = j * 64 + 4 * h;
#pragma unroll
          for (int kt = 0; kt < 4; ++kt)
#pragma unroll
            for (int i = 0; i < 4; ++i) {
              const int pos = pbase + 16 * kt + i;
              bool v;
              if (MODE <= 1) v = pos <= lim[mq];
              else if (MODE == 2) v = selbit && pos <= tq[mq];
              else v = pos <= tq[mq] && pos > tq[mq] - 512;
              s[0][kt][i] = v ? s[0][kt][i] : -1e30f;
            }
          if (MODE == 1) {
#pragma unroll
            for (int kt = 0; kt < 4; ++kt) {
              float ps = 0.f;
#pragma unroll
              for (int i = 0; i < 4; ++i) {
                const float pv = __expf(s[0][kt][i] - m[mq]) * inv[mq];
                s[0][kt][i] = pv;
                ps += pv;
              }
              ps += __shfl_xor(ps, 1);
              ps += __shfl_xor(ps, 2);
              if (g == 0) impw[(4 * mq + qi) * 128 + j * 16 + kt * 4 + h] = ps;
            }
          } else {
            float bm = fmaxf(fmaxf(fmaxf(s[0][0][0], s[0][0][1]), fmaxf(s[0][0][2], s[0][0][3])), fmaxf(fmaxf(s[0][1][0], s[0][1][1]), fmaxf(s[0][1][2], s[0][1][3])));
            bm = fmaxf(bm, fmaxf(fmaxf(fmaxf(s[0][2][0], s[0][2][1]), fmaxf(s[0][2][2], s[0][2][3])), fmaxf(fmaxf(s[0][3][0], s[0][3][1]), fmaxf(s[0][3][2], s[0][3][3]))));
            bm = fmaxf(bm, __shfl_xor(bm, 16));
            bm = fmaxf(bm, __shfl_xor(bm, 32));
            const float mn = fmaxf(m[mq], bm);
            const float alpha = __expf(m[mq] - mn);
            const float mref = mn > -1e29f ? mn : 1e30f;
            float ps = 0.f;
#pragma unroll
            for (int kt = 0; kt < 4; ++kt)
#pragma unroll
              for (int i = 0; i < 4; ++i) {
                const float pv = __expf(s[0][kt][i] - mref);
                s[0][kt][i] = pv;
                ps += pv;
              }
            l[mq] = l[mq] * alpha + ps;
            m[mq] = mn;
            if (PV) {
#pragma unroll
              for (int mt = 0; mt < 4; ++mt) o[mq][mt] *= alpha;
            }
          }
          if (PV) {
#pragma unroll
            for (int s2 = 0; s2 < 2; ++s2)
#pragma unroll
              for (int i = 0; i < 4; ++i) { pf[mq][s2][i] = (h16)s[0][2 * s2][i]; pf[mq][s2][4 + i] = (h16)s[0][2 * s2 + 1][i]; }
          }
        }
      if (PV) {
        h16x8 vf[4][2];
#pragma unroll
        for (int mt = 0; mt < 4; ++mt)
#pragma unroll
          for (int s2 = 0; s2 < 2; ++s2) vf[mt][s2] = ldfrag(cV, 16 * mt + c, 4 * s2 + h);
#pragma unroll
        for (int mq = 0; mq < 2; ++mq)
          if (act[mq]) {
#pragma unroll
            for (int s2 = 0; s2 < 2; ++s2) {
#pragma unroll
              for (int mt = 0; mt < 4; ++mt) o[mq][mt] = __builtin_amdgcn_mfma_f32_16x16x32_f16(vf[mt][s2], pf[mq][s2], o[mq][mt], 0, 0, 0);
            }
          }
      }
    }
  }
  __builtin_amdgcn_s_barrier();
}

__device__ __forceinline__ void attn_item(const Params& p, int l, int item, float* sm) {
  unsigned char* ws = p.ws;
  int tid = tidx();
  asm volatile("" : "+v"(tid));
  const int lane = tid & 63, wave = tid >> 6;
  const int combo = item & 3, qt = item >> 2;
  const int b = combo >> 1, kv = combo & 1;
  const int t0 = qt * 64, tw0 = t0 + 8 * wave;
  const int h = lane >> 4, c = lane & 15, qi = c >> 2, g = c & 3;
  const int head = kv * 4 + g, bkv = b * 2 + kv;
  h16* ring = (h16*)sm;
  float* impw = sm + 20480 + wave * 1024;
  unsigned long long* selm = (unsigned long long*)(sm + 20480 + 8192) + wave * 16;

  h16x8 qf[2][2];
  int tq[2];
#pragma unroll
  for (int mq = 0; mq < 2; ++mq) {
    tq[mq] = tw0 + 4 * mq + qi;
    const h16* qrow = (const h16*)(ws + OFF_Q16) + (size_t)(b * S + tq[mq]) * 512 + head * 64;
    qf[mq][0] = *(const h16x8*)(qrow + 8 * h);
    qf[mq][1] = *(const h16x8*)(qrow + 32 + 8 * h);
  }
  for (int i = lane; i < 1024; i += 64) impw[i] = 0.f;

  h16x4 ofin[2][4];
  float m[2], ll[2], inv[2];
  f32x4 o[2][4];
  const unsigned long long z2[2] = {0ull, 0ull};
  {
    int lim[2], tlim[2];
#pragma unroll
    for (int mq = 0; mq < 2; ++mq) {
      lim[mq] = tq[mq] >= 31 ? ((tq[mq] - 31) >> 4) : -1;
      const int tl = tw0 + 4 * mq + 3;
      tlim[mq] = tl >= 31 ? ((tl - 31) >> 4) : -1;
      m[mq] = -1e30f; ll[mq] = 0.f; inv[mq] = 0.f;
#pragma unroll
      for (int mt = 0; mt < 4; ++mt) o[mq][mt] = (f32x4){0.f, 0.f, 0.f, 0.f};
    }
    const int nl = (t0 + 63 - 31) >> 4;
    const int jl = nl >> 6;
    const h16* Kc = (const h16*)(ws + OFF_KCMP) + (size_t)bkv * 512 * 64;
    const h16* Vc = (const h16*)(ws + OFF_VCMPT) + (size_t)bkv * 8 * 4096;
    attn_branch<0>(Kc, Vc, 0, jl, ring, qf, m, ll, o, tq, lim, tlim, z2, z2, z2, z2, inv, impw);
#pragma unroll
    for (int mq = 0; mq < 2; ++mq) {
      float lt = ll[mq];
      lt += __shfl_xor(lt, 16);
      lt += __shfl_xor(lt, 32);
      inv[mq] = lt > 0.f ? 1.f / lt : 0.f;
    }
    attn_branch<1>(Kc, Vc, 0, jl, ring, qf, m, ll, o, tq, lim, tlim, z2, z2, z2, z2, inv, impw);
    const float* gt0 = (const float*)(ws + OFF_GATES) + (size_t)(b * S) * 24 + head * 3;
#pragma unroll
    for (int mq = 0; mq < 2; ++mq) {
      const float g0 = gt0[(size_t)tq[mq] * 24] * ASCALE;
#pragma unroll
      for (int mt = 0; mt < 4; ++mt) ofin[mq][mt] = pack4(o[mq][mt][0] * g0, o[mq][mt][1] * g0, o[mq][mt][2] * g0, o[mq][mt][3] * g0);
    }
  }
  for (int q = 0; q < 8; ++q) {
    const int t = tw0 + q, own = t >> 6;
    const float* ir = impw + q * 128;
    const int ja = lane, jb = lane + 64;
    unsigned k0 = 0u, k1 = 0u;
    if (ja <= own) k0 = (ja == 0 || ja == own) ? (0xFFFFFF80u | (unsigned)(127 - ja)) : (((__float_as_uint(ir[ja]) & ~127u) | (unsigned)(127 - ja)) + 1u);
    if (jb <= own) k1 = (jb == own) ? (0xFFFFFF80u | (unsigned)(127 - jb)) : (((__float_as_uint(ir[jb]) & ~127u) | (unsigned)(127 - jb)) + 1u);
    unsigned thr = 0u;
    for (int bit = 31; bit >= 0; --bit) {
      const unsigned cand = thr | (1u << bit);
      const int cnt = __popcll(__ballot(k0 >= cand)) + __popcll(__ballot(k1 >= cand));
      if (cnt >= 16) thr = cand;
    }
    const unsigned long long mlo = __ballot(k0 >= thr && ja <= own);
    const unsigned long long mhi = __ballot(k1 >= thr && jb <= own);
    if (lane == 0) { selm[q * 2] = mlo; selm[q * 2 + 1] = mhi; }
  }
  unsigned long long mylo[2], myhi[2], ulo[2], uhi[2];
#pragma unroll
  for (int mq = 0; mq < 2; ++mq) {
    mylo[mq] = selm[(4 * mq + qi) * 2];
    myhi[mq] = selm[(4 * mq + qi) * 2 + 1];
    unsigned long long a = selm[(4 * mq) * 2] | selm[(4 * mq + 1) * 2] | selm[(4 * mq + 2) * 2] | selm[(4 * mq + 3) * 2];
    unsigned long long bb = selm[(4 * mq) * 2 + 1] | selm[(4 * mq + 1) * 2 + 1] | selm[(4 * mq + 2) * 2 + 1] | selm[(4 * mq + 3) * 2 + 1];
    ulo[mq] = (unsigned long long)__builtin_amdgcn_readfirstlane((unsigned)a) | ((unsigned long long)__builtin_amdgcn_readfirstlane((unsigned)(a >> 32)) << 32);
    uhi[mq] = (unsigned long long)__builtin_amdgcn_readfirstlane((unsigned)bb) | ((unsigned long long)__builtin_amdgcn_readfirstlane((unsigned)(bb >> 32)) << 32);
  }
  const float* gtb = (const float*)(ws + OFF_GATES) + (size_t)(b * S) * 24 + head * 3;
  {
    int tl0[2] = {0, 0};
#pragma unroll
    for (int mq = 0; mq < 2; ++mq) {
      m[mq] = -1e30f; ll[mq] = 0.f;
#pragma unroll
      for (int mt = 0; mt < 4; ++mt) o[mq][mt] = (f32x4){0.f, 0.f, 0.f, 0.f};
    }
    attn_branch<2>((const h16*)(ws + OFF_KS) + (size_t)bkv * S * 64, (const h16*)(ws + OFF_VST) + (size_t)bkv * 128 * 4096, 0, (t0 + 63) >> 6, ring, qf, m, ll, o,
                   tq, tl0, tl0, mylo, myhi, ulo, uhi, inv, impw);
#pragma unroll
    for (int mq = 0; mq < 2; ++mq) {
      float lt = ll[mq];
      lt += __shfl_xor(lt, 16);
      lt += __shfl_xor(lt, 32);
      const float sc = lt > 0.f ? gtb[(size_t)tq[mq] * 24 + 1] * ASCALE / lt : 0.f;
#pragma unroll
      for (int mt = 0; mt < 4; ++mt)
        ofin[mq][mt] = pack4((float)ofin[mq][mt][0] + o[mq][mt][0] * sc, (float)ofin[mq][mt][1] + o[mq][mt][1] * sc, (float)ofin[mq][mt][2] + o[mq][mt][2] * sc,
                             (float)ofin[mq][mt][3] + o[mq][mt][3] * sc);
    }
  }
  {
    int tl0[2] = {0, 0}, tf[2];
#pragma unroll
    for (int mq = 0; mq < 2; ++mq) {
      tf[mq] = tw0 + 4 * mq;
      m[mq] = -1e30f; ll[mq] = 0.f;
#pragma unroll
      for (int mt = 0; mt < 4; ++mt) o[mq][mt] = (f32x4){0.f, 0.f, 0.f, 0.f};
    }
    const int jlo = t0 >= 511 ? ((t0 - 511) >> 6) : 0;
    attn_branch<3>((const h16*)(ws + OFF_KW) + (size_t)bkv * S * 64, (const h16*)(ws + OFF_VWT) + (size_t)bkv * 128 * 4096, jlo, (t0 + 63) >> 6, ring, qf, m, ll, o,
                   tq, tl0, tf, z2, z2, z2, z2, inv, impw);
#pragma unroll
    for (int mq = 0; mq < 2; ++mq) {
      float lt = ll[mq];
      lt += __shfl_xor(lt, 16);
      lt += __shfl_xor(lt, 32);
      const float sc = lt > 0.f ? gtb[(size_t)tq[mq] * 24 + 2] * ASCALE / lt : 0.f;
#pragma unroll
      for (int mt = 0; mt < 4; ++mt)
        ofin[mq][mt] = pack4((float)ofin[mq][mt][0] + o[mq][mt][0] * sc, (float)ofin[mq][mt][1] + o[mq][mt][1] * sc, (float)ofin[mq][mt][2] + o[mq][mt][2] * sc,
                             (float)ofin[mq][mt][3] + o[mq][mt][3] * sc);
    }
  }
  {
    h16* yc = (h16*)(ws + OFF_H16);
    const float* gn = p.in[I_ONG] + l * 1024 + 256 + head * 64;
    float* ssq = (float*)(ws + OFF_SSQ);
#pragma unroll
    for (int mq = 0; mq < 2; ++mq) {
      float sq = 0.f;
      h16* yr = yc + (size_t)(b * S + tq[mq]) * D + head * 64;
#pragma unroll
      for (int mt = 0; mt < 4; ++mt) {
        const float v[4] = {(float)ofin[mq][mt][0], (float)ofin[mq][mt][1], (float)ofin[mq][mt][2], (float)ofin[mq][mt][3]};
        sq += v[0] * v[0] + v[1] * v[1] + v[2] * v[2] + v[3] * v[3];
        const float4 gg = *(const float4*)(gn + 16 * mt + 4 * h);
        *(h16x4*)(yr + 16 * mt + 4 * h) = pack4(v[0] * gg.x, v[1] * gg.y, v[2] * gg.z, v[3] * gg.w);
      }
      sq += __shfl_xor(sq, 16);
      sq += __shfl_xor(sq, 32);
      sq += __shfl_xor(sq, 1);
      sq += __shfl_xor(sq, 2);
      if (h == 0 && g == 0) ssq[(size_t)(b * S + tq[mq]) * 2 + kv] = sq * (1.f / (ASCALE * ASCALE));
    }
  }
}

__device__ __forceinline__ void lrufix_item(const Params& p, int l, int item) {
  unsigned char* ws = p.ws;
  const int lane = tidx() & 63, wave = tidx() >> 6;
  const int b = item >> 7, ck = item & 127;
  const h16* P = (const h16*)(ws + OFF_P16);
  const float4 cy = *(const float4*)((const float*)(ws + OFF_CARRY) + (size_t)(b * 128 + ck) * 256 + lane * 4);
  const float4 gn = *(const float4*)(p.in[I_ONG] + l * 1024 + lane * 4);
  h16* yc = (h16*)(ws + OFF_H16);
  for (int tt = wave * 8; tt < wave * 8 + 8; ++tt) {
    const size_t row = (size_t)(b * S + ck * 64 + tt);
    const float4 hl = *(const float4*)((const float*)(ws + OFF_LRUH) + row * 256 + lane * 4);
    const float4 al = *(const float4*)((const float*)(ws + OFF_LRUA) + row * 256 + lane * 4);
    const h16x4 gl = *(const h16x4*)(P + row * NIN + C_GL + lane * 4);
    const float y0 = (hl.x + al.x * cy.x) * gelu_tanh((float)gl[0]);
    const float y1 = (hl.y + al.y * cy.y) * gelu_tanh((float)gl[1]);
    const float y2 = (hl.z + al.z * cy.z) * gelu_tanh((float)gl[2]);
    const float y3 = (hl.w + al.w * cy.w) * gelu_tanh((float)gl[3]);
    const float rstd = rsqrtf(wsum(y0 * y0 + y1 * y1 + y2 * y2 + y3 * y3) * (1.f / 256.f) + EPS);
    *(h16x4*)(yc + row * D + 512 + lane * 4) = pack4(y0 * rstd * gn.x, y1 * rstd * gn.y, y2 * rstd * gn.z, y3 * rstd * gn.w);
  }
}

__device__ __forceinline__ void phase_attn(const Params& p, int l, float* sm) {
  for (int it = blockIdx.x; it < 256; it += gridDim.x) {
#pragma unroll 1
    for (int rep = 0; rep < 2; ++rep) attn_item(p, l, rep ? 511 - it : it, sm);
  }
  for (int it = blockIdx.x; it < 256; it += gridDim.x) lrufix_item(p, l, it);
}

__device__ __forceinline__ void phase_outproj(const Params& p, int l, h16* sm) {
  unsigned char* ws = p.ws;
  const h16* A = (const h16*)(ws + OFF_H16);
  const h16* W = (const h16*)(ws + OFF_WOUT);
  const float* mod = (const float*)(ws + OFF_MOD);
  float* xa = (float*)(ws + OFF_XA);
  const float* xin = l == 0 ? p.in[I_X] : (const float*)xa;
  for (int t = blockIdx.x; t < 64 * 4; t += gridDim.x) {
    const int mt = t >> 2, nt = t & 3;
    f32x4 acc[8][4];
    const h16* Ab = A + (size_t)mt * 256 * D;
    {
      float* sct = (float*)((unsigned char*)sm + SCHED_OFF - 1024);
      const int tq_ = tidx();
      if (tq_ < 256) {
        const float2 q2 = *(const float2*)((const float*)(ws + OFF_SSQ) + (size_t)(mt * 256 + tq_) * 2);
        sct[tq_] = rsqrtf((q2.x + q2.y) * (1.f / 512.f) + EPS) * (1.f / ASCALE);
      }
    }
    gemm_mainloop(acc, [&](int r) { return Ab + (size_t)r * D; }, W + (size_t)nt * 256 * D, D, 16, sm);
    const int tid_e = tidx(), lane = tid_e & 63, wave = tid_e >> 6, wr = wave >> 2, wc = wave & 3, fr = lane & 15, fq = lane >> 4;
    {
      const float* sct = (const float*)((const unsigned char*)sm + SCHED_OFF - 1024) + wr * 128 + fr;
#pragma unroll
      for (int m = 0; m < 8; ++m) {
        const float sc = sct[m * 16];
#pragma unroll
        for (int n = 0; n < 4; ++n) acc[m][n] *= sc;
      }
    }
    gemm_mainloop(acc, [&](int r) { return Ab + (size_t)r * D + 512; }, W + (size_t)nt * 256 * D + 512, D, 16, sm, false);
#pragma unroll
    for (int m = 0; m < 8; ++m)
#pragma unroll
      for (int n = 0; n < 4; ++n) {
        const int row = mt * 256 + wr * 128 + m * 16 + fr, col = nt * 256 + wc * 64 + n * 16 + 4 * fq;
        const int b = row >> 13;
        const float4 g1 = *(const float4*)(mod + (size_t)(l * 2 + b) * 6144 + 2048 + col);
        const float4 xv = *(const float4*)(xin + (size_t)row * D + col);
        float4 o;
        o.x = xv.x + g1.x * acc[m][n][0]; o.y = xv.y + g1.y * acc[m][n][1]; o.z = xv.z + g1.z * acc[m][n][2]; o.w = xv.w + g1.w * acc[m][n][3];
        *(float4*)(xa + (size_t)row * D + col) = o;
      }
  }
}

__device__ __forceinline__ void phase_router(const Params& p, int l) {
  unsigned char* ws = p.ws;
  const int lane = tidx() & 63, wave = tidx() >> 6;
  const float* mod = (const float*)(ws + OFF_MOD);
  const float* xa = (const float*)(ws + OFF_XA);
  h16* hout = (h16*)(ws + OFF_H16);
  unsigned* cnt = (unsigned*)(ws + OFF_CTL) + 64 + l * 16;
  int* list = (int*)(ws + OFF_LIST);
  float* wpair = (float*)(ws + OFF_WPAIR);
  const float* rgw = p.in[I_RGW] + (size_t)l * 1024 * 4;
  const float* rgb = p.in[I_RGB] + l * 4;
  for (int row = blockIdx.x * NW + wave; row < T; row += gridDim.x * NW) {
    const int b = row >> 13;
    float4 x[4];
    float ss = 0.f;
#pragma unroll
    for (int i = 0; i < 4; ++i) {
      x[i] = *(const float4*)(xa + (size_t)row * D + lane * 4 + 256 * i);
      ss += x[i].x * x[i].x + x[i].y * x[i].y + x[i].z * x[i].z + x[i].w * x[i].w;
    }
    ss = wsum(ss);
    const float rstd = rsqrtf(ss * (1.f / D) + EPS);
    float lg0 = 0.f, lg1 = 0.f, lg2 = 0.f, lg3 = 0.f;
#pragma unroll
    for (int i = 0; i < 4; ++i) {
      const int col = lane * 4 + 256 * i;
      const float4 g = *(const float4*)(p.in[I_N2G] + l * D + col);
      const float4 sh = *(const float4*)(mod + (size_t)(l * 2 + b) * 6144 + 3072 + col);
      const float4 sc = *(const float4*)(mod + (size_t)(l * 2 + b) * 6144 + 4096 + col);
      x[i].x = x[i].x * rstd * g.x * (1.f + sc.x) + sh.x;
      x[i].y = x[i].y * rstd * g.y * (1.f + sc.y) + sh.y;
      x[i].z = x[i].z * rstd * g.z * (1.f + sc.z) + sh.z;
      x[i].w = x[i].w * rstd * g.w * (1.f + sc.w) + sh.w;
      *(h16x4*)(hout + (size_t)row * D + col) = pack4(x[i].x, x[i].y, x[i].z, x[i].w);
      const float4 w0 = *(const float4*)(rgw + (size_t)(col + 0) * 4), w1 = *(const float4*)(rgw + (size_t)(col + 1) * 4);
      const float4 w2 = *(const float4*)(rgw + (size_t)(col + 2) * 4), w3 = *(const float4*)(rgw + (size_t)(col + 3) * 4);
      lg0 += x[i].x * w0.x + x[i].y * w1.x + x[i].z * w2.x + x[i].w * w3.x;
      lg1 += x[i].x * w0.y + x[i].y * w1.y + x[i].z * w2.y + x[i].w * w3.y;
      lg2 += x[i].x * w0.z + x[i].y * w1.z + x[i].z * w2.z + x[i].w * w3.z;
      lg3 += x[i].x * w0.w + x[i].y * w1.w + x[i].z * w2.w + x[i].w * w3.w;
    }
    lg0 = wsum(lg0) + rgb[0]; lg1 = wsum(lg1) + rgb[1]; lg2 = wsum(lg2) + rgb[2]; lg3 = wsum(lg3) + rgb[3];
    int gs = 0; float gm = lg0;
    if (lg1 > gm) { gm = lg1; gs = 1; }
    if (lg2 > gm) { gm = lg2; gs = 2; }
    if (lg3 > gm) { gm = lg3; gs = 3; }
    const float pg = 1.f / (__expf(lg0 - gm) + __expf(lg1 - gm) + __expf(lg2 - gm) + __expf(lg3 - gm));
    const float* rew = p.in[I_REW] + ((size_t)(l * 4 + gs) * 1024) * 4;
    const float* reb = p.in[I_REB] + (l * 4 + gs) * 4;
    float e0 = 0.f, e1 = 0.f, e2 = 0.f, e3 = 0.f;
#pragma unroll
    for (int i = 0; i < 4; ++i) {
      const int col = lane * 4 + 256 * i;
      const float4 w0 = *(const float4*)(rew + (size_t)(col + 0) * 4), w1 = *(const float4*)(rew + (size_t)(col + 1) * 4);
      const float4 w2 = *(const float4*)(rew + (size_t)(col + 2) * 4), w3 = *(const float4*)(rew + (size_t)(col + 3) * 4);
      e0 += x[i].x * w0.x + x[i].y * w1.x + x[i].z * w2.x + x[i].w * w3.x;
      e1 += x[i].x * w0.y + x[i].y * w1.y + x[i].z * w2.y + x[i].w * w3.y;
      e2 += x[i].x * w0.z + x[i].y * w1.z + x[i].z * w2.z + x[i].w * w3.z;
      e3 += x[i].x * w0.w + x[i].y * w1.w + x[i].z * w2.w + x[i].w * w3.w;
    }
    float le[4];
    le[0] = wsum(e0) + reb[0]; le[1] = wsum(e1) + reb[1]; le[2] = wsum(e2) + reb[2]; le[3] = wsum(e3) + reb[3];
    int i0 = 0; float v0 = le[0];
    if (le[1] > v0) { v0 = le[1]; i0 = 1; }
    if (le[2] > v0) { v0 = le[2]; i0 = 2; }
    if (le[3] > v0) { v0 = le[3]; i0 = 3; }
    int i1 = -1; float v1 = -3.0e38f;
#pragma unroll
    for (int j = 0; j < 4; ++j) {
      const float vj = (j == 0 ? le[0] : j == 1 ? le[1] : j == 2 ? le[2] : le[3]);
      if (j != i0 && vj > v1) { v1 = vj; i1 = j; }
    }
    const float p0 = 1.f / (1.f + __expf(v1 - v0));
    const float p1 = 1.f - p0;
    if (lane == 0) {
      const int ea = gs * 4 + i0, eb = gs * 4 + i1;
      const unsigned sa = atomicAdd(&cnt[ea], 1u);
      list[(size_t)ea * 16384 + sa] = row * 2;
      wpair[row * 2] = pg * p0;
      const unsigned sb = atomicAdd(&cnt[eb], 1u);
      list[(size_t)eb * 16384 + sb] = row * 2 + 1;
      wpair[row * 2 + 1] = pg * p1;
    }
  }
}

__device__ __forceinline__ void moe_sched(const Params& p, int l, int* sl) {
  if (tidx() == 0) {
    const unsigned* cnt = (const unsigned*)(p.ws + OFF_CTL) + 64 + l * 16;
    int to = 0, ro = 0;
    sl[16] = 0; sl[33] = 0;
    for (int e = 0; e < 16; ++e) {
      const int c = (int)__hip_atomic_load(&cnt[e], __ATOMIC_RELAXED, __HIP_MEMORY_SCOPE_AGENT);
      sl[e] = c;
      to += (c + 255) >> 8; ro += c;
      sl[17 + e] = to; sl[34 + e] = ro;
    }
  }
  __syncthreads();
}
__device__ __forceinline__ void moe_tile(const int* sl, int t, int& e, int& nt, int& mt, int& cnt_e, int& roff_e) {
  int ee = 0;
  for (int k = 0; k < 15; ++k) ee += (t >= sl[17 + k] * 4) ? 1 : 0;
  ee = __builtin_amdgcn_readfirstlane(ee);
  const int t0 = __builtin_amdgcn_readfirstlane(sl[16 + ee]), t1 = __builtin_amdgcn_readfirstlane(sl[17 + ee]);
  const int nte = t1 - t0, rem = t - t0 * 4;
  e = ee; nt = rem / nte; mt = rem % nte;
  cnt_e = __builtin_amdgcn_readfirstlane(sl[ee]);
  roff_e = __builtin_amdgcn_readfirstlane(sl[33 + ee]);
}

__device__ __forceinline__ void phase_moe1(const Params& p, int l, h16* sm) {
  unsigned char* ws = p.ws;
  int* sl = (int*)((unsigned char*)sm + SCHED_OFF);
  moe_sched(p, l, sl);
  const h16* H = (const h16*)(ws + OFF_H16);
  const int* list = (const int*)(ws + OFF_LIST);
  h16* hid = (h16*)(ws + OFF_HID);
  const int total = __builtin_amdgcn_readfirstlane(sl[32]) * 4;
  for (int t = blockIdx.x; t < total; t += gridDim.x) {
    int e, nt, mt, cnt_e, roff_e;
    moe_tile(sl, t, e, nt, mt, cnt_e, roff_e);
    const int* le = list + (size_t)e * 16384;
    f32x4 acc[8][4];
    gemm_mainloop(acc, [&](int r) { int so = mt * 256 + r; so = so < cnt_e ? so : 0; return H + (size_t)(le[so] >> 1) * D; },
                  (const h16*)(ws + OFF_WGU) + ((size_t)e * 1024 + nt * 256) * 1024, 1024, 32, sm);
    const int tid_e = tidx(), lane = tid_e & 63, wave = tid_e >> 6, wr = wave >> 2, wc = wave & 3, fr = lane & 15, fq = lane >> 4;
#pragma unroll
    for (int m = 0; m < 8; ++m) {
      const int so = mt * 256 + wr * 128 + m * 16 + fr;
      if (so < cnt_e) {
#pragma unroll
        for (int n2 = 0; n2 < 2; ++n2) {
          const f32x4 gt = acc[m][2 * n2], up = acc[m][2 * n2 + 1];
          const int col = nt * 128 + wc * 32 + n2 * 16 + 4 * fq;
          *(h16x4*)(hid + (size_t)(roff_e + so) * 512 + col) = pack4(silu_f(gt[0]) * up[0], silu_f(gt[1]) * up[1], silu_f(gt[2]) * up[2], silu_f(gt[3]) * up[3]);
        }
      }
    }
  }
}

__device__ __forceinline__ void phase_moe2(const Params& p, int l, h16* sm) {
  unsigned char* ws = p.ws;
  int* sl = (int*)((unsigned char*)sm + SCHED_OFF);
  moe_sched(p, l, sl);
  const int* list = (const int*)(ws + OFF_LIST);
  const float* wpair = (const float*)(ws + OFF_WPAIR);
  const h16* hid = (const h16*)(ws + OFF_HID);
  h16* yp = (h16*)(ws + OFF_YPAIR);
  const int total = __builtin_amdgcn_readfirstlane(sl[32]) * 4;
  for (int t = blockIdx.x; t < total; t += gridDim.x) {
    int e, nt, mt, cnt_e, roff_e;
    moe_tile(sl, t, e, nt, mt, cnt_e, roff_e);
    const int* le = list + (size_t)e * 16384;
    const h16* Ab = hid + (size_t)(roff_e + mt * 256) * 512;
    f32x4 acc[8][4];
    gemm_mainloop(acc, [&](int r) { return Ab + (size_t)r * 512; }, (const h16*)(ws + OFF_WDN) + ((size_t)e * 1024 + nt * 256) * 512, 512, 16, sm);
    const int tid_e = tidx(), lane = tid_e & 63, wave = tid_e >> 6, wr = wave >> 2, wc = wave & 3, fr = lane & 15, fq = lane >> 4;
#pragma unroll
    for (int m = 0; m < 8; ++m) {
      const int so = mt * 256 + wr * 128 + m * 16 + fr;
      if (so < cnt_e) {
        const int pair = le[so];
        const float w = wpair[pair];
#pragma unroll
        for (int n = 0; n < 4; ++n) {
          const int col = nt * 256 + wc * 64 + n * 16 + 4 * fq;
          *(h16x4*)(yp + (size_t)pair * D + col) = pack4(acc[m][n][0] * w, acc[m][n][1] * w, acc[m][n][2] * w, acc[m][n][3] * w);
        }
      }
    }
  }
}

#define XB_TMO      128
#define XB_XCNT(j)  (256  + 64 * (j))
#define XB_XSUB(j)  (1280 + 64 * (j))
#define XB_XGEN(j)  (2304 + 64 * (j))
#define XB_TOP      3328
#define XB_TOPGEN   3392
#define XCD_BAR_WORDS 3456
#define XB_SPIN_CAP (1u << 20)
__device__ __forceinline__ unsigned xb_ld(unsigned* p) { return __hip_atomic_load(p, __ATOMIC_RELAXED, __HIP_MEMORY_SCOPE_AGENT); }
__device__ __forceinline__ unsigned xb_add(unsigned* p, unsigned v) { return __hip_atomic_fetch_add(p, v, __ATOMIC_RELAXED, __HIP_MEMORY_SCOPE_AGENT); }
__device__ __forceinline__ unsigned xb_xcc_id() { return (unsigned)__builtin_amdgcn_s_getreg((3 << 11) | 20) & 0xFu; }
#define XB_SPIN(cond, bar) do { unsigned _sp = 0; while (cond) { __builtin_amdgcn_s_sleep(1); \
    if ((++_sp & 255u) == 0u) { if (xb_ld(&(bar)[XB_TMO])) break; if (_sp > XB_SPIN_CAP) { atomicAdd(&(bar)[XB_TMO], 1u); break; } } } } while (0)
struct XBar { unsigned* bar; unsigned x; volatile unsigned* st; };
__device__ __forceinline__ void xbar_post(XBar& b, unsigned* bar, volatile unsigned* st) {
  b.bar = bar; b.x = xb_xcc_id(); b.st = st;
  if (tidx() == 0) { st[0] = 0u; st[1] = 0u; (void)xb_add(&bar[XB_XCNT(b.x)], 1u); }
}
__device__ __forceinline__ void xbar_census(unsigned* bar, unsigned x, unsigned& nloc, unsigned& nx) {
  const unsigned G = gridDim.x;
  unsigned sum, cnt, mine, sp = 0u;
  for (;;) {
    sum = 0u; cnt = 0u; mine = 0u;
#pragma unroll
    for (unsigned j = 0; j < 16; ++j) { const unsigned c = xb_ld(&bar[XB_XCNT(j)]); sum += c; cnt += (c > 0u) ? 1u : 0u; mine = (j == x) ? c : mine; }
    if (sum == G) break;
    __builtin_amdgcn_s_sleep(1);
    if ((++sp & 255u) == 0u) { if (xb_ld(&bar[XB_TMO])) break; if (sp > XB_SPIN_CAP) { atomicAdd(&bar[XB_TMO], 1u); break; } }
  }
  nloc = mine > 0u ? mine : 1u; nx = cnt > 0u ? cnt : 1u;
}
__device__ __forceinline__ void xbar_sync(XBar& b) {
  asm volatile("s_waitcnt vmcnt(0)" ::: "memory");
  __syncthreads();
  if (tidx() == 0) {
    unsigned* bar = b.bar;
    __builtin_amdgcn_s_waitcnt(0);
    unsigned nloc = b.st[0], nx = b.st[1];
    if (nloc == 0u) { xbar_census(bar, b.x, nloc, nx); b.st[0] = nloc; b.st[1] = nx; }
    const unsigned old = xb_add(&bar[XB_XSUB(b.x)], 1u);
    const unsigned gen = old / nloc;
    if (old + 1u == (gen + 1u) * nloc) {
      __builtin_amdgcn_fence(__ATOMIC_RELEASE, "agent");
      asm volatile("s_waitcnt vmcnt(0)" ::: "memory");
      const unsigned og = xb_add(&bar[XB_TOP], 1u);
      const unsigned tg = og / nx;
      if (og + 1u == (tg + 1u) * nx) xb_add(&bar[XB_TOPGEN], 1u);
      else XB_SPIN(xb_ld(&bar[XB_TOPGEN]) == tg, bar);
      __builtin_amdgcn_fence(__ATOMIC_ACQUIRE, "agent");
      xb_add(&bar[XB_XGEN(b.x)], 1u);
      asm volatile("s_waitcnt vmcnt(0)" ::: "memory");
    } else {
      XB_SPIN(xb_ld(&bar[XB_XGEN(b.x)]) == gen, bar);
      __builtin_amdgcn_fence(__ATOMIC_ACQUIRE, "agent");
      asm volatile("s_waitcnt vmcnt(0)" ::: "memory");
    }
  }
  __syncthreads();
}

constexpr int NSTEPS = 22;
#define STEP(k, body) do { if (s_lo <= (k) && (k) < s_hi) { body; if ((k) + 1 < s_hi) { if ((k) == 0) grid.sync(); else xbar_sync(xb); } } } while (0)
#define LAYER_STEPS(l, base) \
  STEP(base + 0, phase_norm1(p, l); if (l == 1) phase_convert(p, 1, (float*)smem)); \
  STEP(base + 1, phase_inproj(p, (h16*)smem)); \
  STEP(base + 2, phase_post(p)); \
  STEP(base + 3, phase_mixa(p, l, smem)); \
  STEP(base + 4, phase_mixb(p, l)); \
  STEP(base + 5, phase_attn(p, l, (float*)smem)); \
  STEP(base + 6, phase_outproj(p, l, (h16*)smem)); \
  STEP(base + 7, phase_router(p, l)); \
  STEP(base + 8, phase_moe1(p, l, (h16*)smem)); \
  STEP(base + 9, phase_moe2(p, l, (h16*)smem))

__global__ void __launch_bounds__(NTHREADS, 2) mega(Params p, int s_lo, int s_hi) {
  extern __shared__ __attribute__((aligned(16))) unsigned char smem[];
  cg::grid_group grid = cg::this_grid();
  XBar xb;
  xbar_post(xb, (unsigned*)(p.ws + OFF_BAR), (volatile unsigned*)(smem + LDS_BYTES - 16));
  STEP(0, phase_prep(p, (float*)smem); phase_convert(p, 0, (float*)smem));
  LAYER_STEPS(0, 1);
  LAYER_STEPS(1, 11);
  STEP(21, phase_norm1(p, 2));
}

extern "C" void kernel_launch(void* const* d_in, const int* in_sizes, int n_in, void* d_out, int out_size, void* d_ws, size_t ws_size,
                              hipStream_t stream) {
  static int grid_blocks = 0;
  if (!grid_blocks) {
    if (n_in != 35 || out_size != T * D || ws_size < WS_TOTAL) {
      fprintf(stderr, "kernel_launch: unexpected problem (n_in %d, out %d, ws %zu < %zu)\n", n_in, out_size, ws_size, (size_t)WS_TOTAL);
      grid_blocks = -1;
      return;
    }
    int dev = 0, cus = 0, per_cu = 0;
    hipGetDevice(&dev);
    hipDeviceGetAttribute(&cus, hipDeviceAttributeMultiprocessorCount, dev);
    if (hipFuncSetAttribute((const void*)mega, hipFuncAttributeMaxDynamicSharedMemorySize, LDS_BYTES) != hipSuccess) {
      fprintf(stderr, "kernel_launch: hipFuncSetAttribute(%d B dynamic LDS) failed\n", LDS_BYTES);
      grid_blocks = -1;
      return;
    }
    hipOccupancyMaxActiveBlocksPerMultiprocessor(&per_cu, mega, NTHREADS, LDS_BYTES);
    if (per_cu > 1) per_cu = 1;
    if (per_cu < 1) { fprintf(stderr, "kernel_launch: occupancy query returned %d\n", per_cu); grid_blocks = -1; return; }
    grid_blocks = cus * per_cu;
  }
  if (grid_blocks < 0) return;
  Params p{};
  for (int i = 0; i < 35; ++i) p.in[i] = (const float*)d_in[i];
  p.out = (float*)d_out;
  p.ws = (unsigned char*)d_ws;
  for (int i = 0; i < 32; ++i) p.inv_freq[i] = std::pow(10000.0, -(double)(2 * i) / 64.0);
  if (hipMemsetAsync((char*)d_ws + OFF_BAR, 0, 16384, stream) != hipSuccess) { fprintf(stderr, "kernel_launch: memset of barrier words failed\n"); return; }
#if MEGA
  int lo = 0, hi = NSTEPS;
  void* args[] = {&p, &lo, &hi};
  hipError_t e = hipLaunchCooperativeKernel((void*)mega, dim3(grid_blocks), dim3(NTHREADS), args, LDS_BYTES, stream);
  if (e != hipSuccess) fprintf(stderr, "cooperative launch failed: %s (grid %d)\n", hipGetErrorString(e), grid_blocks);
#else
  for (int s = 0; s < NSTEPS; ++s) {
    int lo = s, hi = s + 1;
    void* args[] = {&p, &lo, &hi};
    hipError_t e = hipLaunchCooperativeKernel((void*)mega, dim3(grid_blocks), dim3(NTHREADS), args, LDS_BYTES, stream);
    if (e != hipSuccess) { fprintf(stderr, "launch %d failed: %s (grid %d)\n", s, hipGetErrorString(e), grid_blocks); break; }
  }
#endif
}
```

```cpp
#include <hip/hip_runtime.h>
#include <hip/hip_cooperative_groups.h>
#include <cstdio>
#include <cstdint>
#include <cmath>
namespace cg = cooperative_groups;

#ifndef MEGA
#define MEGA 1
#endif
#ifndef PROBE_MASK
#define PROBE_MASK 0u
#define PROBE_AMP 3
#endif

typedef _Float16 h16;
typedef _Float16 h16x8 __attribute__((ext_vector_type(8)));
typedef _Float16 h16x4 __attribute__((ext_vector_type(4)));
typedef float f32x4 __attribute__((ext_vector_type(4)));

constexpr int NB = 2, S = 8192, T = NB * S, D = 1024;
constexpr int NIN = 2432;
constexpr int NINSRC = 2328;
constexpr int C_XL = 0, C_GL = 256, C_Q = 512, C_KC = 1024, C_VC = 1152, C_KS = 1280, C_VS = 1408, C_KW = 1536, C_VW = 1664,
              C_CVA = 1792, C_CVB = 2048, C_GATE = 2304;
constexpr float EPS = 1e-6f;
constexpr int NTHREADS = 512, NW = 8;
constexpr int LDS_BYTES = 147456;
constexpr int NINP = 2560;
constexpr int SCHED_OFF = LDS_BYTES - 1024;
constexpr float ASCALE = 16.f;

constexpr size_t al256(size_t x) { return (x + 255) & ~(size_t)255; }
constexpr size_t OFF_CTL = 0;
constexpr size_t OFF_BAR = 4096;
constexpr size_t OFF_MOD = 4096 + 16384;
constexpr size_t OFF_ROPE = al256(OFF_MOD + 2 * 2 * 6144 * 4);
constexpr size_t OFF_PB = al256(OFF_ROPE + (size_t)T * 64 * 4);
constexpr size_t OFF_GATES = al256(OFF_PB + 2 * 256 * 4);
constexpr size_t OFF_WIN = al256(OFF_GATES + (size_t)T * 24 * 4);
constexpr size_t OFF_WOUT = al256(OFF_WIN + (size_t)NINP * 1024 * 2);
constexpr size_t OFF_WGU = al256(OFF_WOUT + (size_t)1024 * 1024 * 2);
constexpr size_t OFF_WDN = al256(OFF_WGU + (size_t)16 * 1024 * 1024 * 2);
constexpr size_t OFF_W1K = al256(OFF_WDN + (size_t)16 * 1024 * 512 * 2);
constexpr size_t OFF_W1V = al256(OFF_W1K + (size_t)256 * 2048 * 2);
constexpr size_t OFF_H16 = al256(OFF_W1V + (size_t)256 * 2048 * 2);
constexpr size_t OFF_Q16 = al256(OFF_H16 + (size_t)T * 1024 * 2);
constexpr size_t KVSZ = (size_t)T * 128 * 2;
constexpr size_t OFF_KC = al256(OFF_Q16 + (size_t)T * 512 * 2);
constexpr size_t OFF_VC = al256(OFF_KC + KVSZ + 4096);
constexpr size_t OFF_KS = al256(OFF_VC + KVSZ + 4096);
constexpr size_t OFF_VST = al256(OFF_KS + KVSZ);
constexpr size_t OFF_KW = al256(OFF_VST + KVSZ);
constexpr size_t OFF_VWT = al256(OFF_KW + KVSZ);
constexpr size_t OFF_HIDC = al256(OFF_VWT + KVSZ);
constexpr size_t OFF_KCMP = al256(OFF_HIDC + (size_t)2 * 2048 * 256 * 2);
constexpr size_t OFF_VCMPT = al256(OFF_KCMP + (size_t)4 * 512 * 64 * 2);
constexpr size_t OFF_LRUH = al256(OFF_VCMPT + (size_t)4 * 512 * 64 * 2);
constexpr size_t OFF_LRUA = al256(OFF_LRUH + (size_t)T * 256 * 4);
constexpr size_t OFF_HEND = al256(OFF_LRUA + (size_t)T * 256 * 4);
constexpr size_t OFF_AEND = al256(OFF_HEND + 2 * 128 * 256 * 4);
constexpr size_t OFF_CARRY = al256(OFF_AEND + 2 * 128 * 256 * 4);
constexpr size_t OFF_XA = al256(OFF_CARRY + 2 * 128 * 256 * 4);
constexpr size_t OFF_LIST = al256(OFF_XA + (size_t)T * 1024 * 4);
constexpr size_t OFF_WPAIR = al256(OFF_LIST + (size_t)16 * 16384 * 4);
constexpr size_t OFF_SSQ = al256(OFF_WPAIR + 32768 * 4);
constexpr size_t OFF_R = al256(OFF_SSQ + (size_t)T * 2 * 4);
constexpr size_t OFF_P16 = OFF_R;
constexpr size_t OFF_HID = OFF_R;
constexpr size_t OFF_YPAIR = al256(OFF_HID + (size_t)(32768 + 512) * 512 * 2);
constexpr size_t R_END1 = OFF_P16 + (size_t)T * NIN * 2;
constexpr size_t R_END2 = OFF_YPAIR + (size_t)32768 * 1024 * 2;
constexpr size_t WS_TOTAL = al256(R_END1 > R_END2 ? R_END1 : R_END2);

struct Params {
  const float* in[35];
  float* out;
  unsigned char* ws;
  double inv_freq[32];
};
enum { I_X = 0, I_C, I_POS, I_ADAW, I_ADAB, I_N1G, I_N2G, I_WIN, I_LCW, I_LCB, I_LWA, I_LBA, I_LWX, I_LBX, I_LLAM, I_CKW1, I_CKW2,
       I_CVW1, I_CVW2, I_CPK, I_CPV, I_DWW, I_DWB, I_LNG, I_LNB, I_ONG, I_WOUT, I_RGW, I_RGB, I_REW, I_REB, I_MG, I_MU, I_MD, I_FNG };

__device__ __forceinline__ int tidx() { int t = threadIdx.x; asm volatile("" : "+v"(t)); return t; }
__device__ __forceinline__ float wsum(float v) {
#pragma unroll
  for (int o = 32; o > 0; o >>= 1) v += __shfl_xor(v, o);
  return v;
}
__device__ __forceinline__ float sigm(float x) { return 1.f / (1.f + __expf(-x)); }
__device__ __forceinline__ float silu_f(float x) { return x / (1.f + __expf(-x)); }
__device__ __forceinline__ float gelu_tanh(float x) {
  float u = 0.7978845608028654f * (x + 0.044715f * x * x * x);
  float e = __expf(2.f * u);
  float t = 1.f - 2.f / (e + 1.f);
  return 0.5f * x * (1.f + t);
}
__device__ __forceinline__ void glds16(const h16* g, h16* l) {
  __builtin_amdgcn_global_load_lds((const unsigned*)g, (unsigned*)l, 16, 0, 0);
}
__device__ __forceinline__ h16x4 pack4(float a, float b, float c, float d) {
  h16x4 r; r[0] = (h16)a; r[1] = (h16)b; r[2] = (h16)c; r[3] = (h16)d; return r;
}

__device__ __forceinline__ int swz32(int row) { return (0x78 >> (((row >> 2) & 3) * 2)) & 3; }
#define VMCNT(n) asm volatile("s_waitcnt vmcnt(" #n ")" ::: "memory")
template <class ARowFn>
__device__ __forceinline__ void gemm_mainloop(f32x4 (&acc)[8][4], ARowFn arow, const h16* __restrict__ Bt, int ldb, int nk, h16* sm, bool zero_init = true) {
  const int tid = tidx(), lane = tid & 63, wave = tid >> 6;
  const int wr = wave >> 2, wc = wave & 3, fr = lane & 15, fq = lane >> 4;
  const h16* ap[2];
  const h16* bp[2];
#pragma unroll
  for (int i = 0; i < 2; ++i) {
    const int r = (i * 8 + wave) * 16 + (lane >> 2);
    const int c = (lane & 3) ^ swz32(r);
    ap[i] = arow(r) + c * 8;
    bp[i] = Bt + (size_t)r * ldb + c * 8;
  }
  if (zero_init) {
#pragma unroll
    for (int m = 0; m < 8; ++m)
#pragma unroll
      for (int n = 0; n < 4; ++n) acc[m][n] = (f32x4){0.f, 0.f, 0.f, 0.f};
  }
  h16* const dA = sm + wave * 512 + lane * 8;
#define GEMM_ISSUE(st) do { h16* d_ = dA + (st) * 16384; \
    glds16(ap[0], d_); glds16(ap[1], d_ + 4096); glds16(bp[0], d_ + 8192); glds16(bp[1], d_ + 12288); \
    ap[0] += 32; ap[1] += 32; bp[0] += 32; bp[1] += 32; } while (0)
  GEMM_ISSUE(0); GEMM_ISSUE(1); GEMM_ISSUE(2);
  const int aoff = (wr * 128 + fr) * 32 + ((fq ^ swz32(fr)) * 8);
  const int boff = 8192 + (wc * 64 + fr) * 32 + ((fq ^ swz32(fr)) * 8);
  for (int kt = 0; kt < nk; ++kt) {
    if (kt + 2 < nk) VMCNT(8); else if (kt + 1 < nk) VMCNT(4); else VMCNT(0);
    __builtin_amdgcn_s_barrier();
    if (kt + 3 < nk) GEMM_ISSUE((kt + 3) & 3);
    const h16* st = sm + (kt & 3) * 16384;
    h16x8 bf[4];
#pragma unroll
    for (int n = 0; n < 4; ++n) bf[n] = *(const h16x8*)(st + boff + n * 512);
#pragma unroll
    for (int mh = 0; mh < 2; ++mh) {
      h16x8 af[4];
#pragma unroll
      for (int m = 0; m < 4; ++m) af[m] = *(const h16x8*)(st + aoff + (mh * 4 + m) * 512);
#pragma unroll
      for (int m = 0; m < 4; ++m)
#pragma unroll
        for (int n = 0; n < 4; ++n) acc[mh * 4 + m][n] = __builtin_amdgcn_mfma_f32_16x16x32_f16(bf[n], af[m], acc[mh * 4 + m][n], 0, 0, 0);
    }
  }
#undef GEMM_ISSUE
  __builtin_amdgcn_s_barrier();
}

__device__ __forceinline__ int map_row(int mode, int n) {
  if (mode == 1) return n < 1792 ? n : (n < 1816 ? n + 512 : n - 24);
  if (mode == 2) return 32 * (n >> 4) + (n & 15);
  if (mode == 3) return 32 * (n >> 4) + 16 + (n & 15);
  return n;
}
__device__ __forceinline__ void conv_tile(const float* __restrict__ src, int K, int N, h16* __restrict__ dst, int mode, int tk, int tn, float* sm) {
  const int tid = tidx();
  const int k0 = tk * 64, n0 = tn * 64;
  const int k0d = mode == 4 ? (k0 < 256 ? k0 + 512 : (k0 < 768 ? k0 - 256 : k0)) : k0;
#pragma unroll
  for (int i = 0; i < 2; ++i) {
    const int idx = i * NTHREADS + tid;
    const int r = idx >> 4, c4 = (idx & 15) * 4;
    float4 v = make_float4(0.f, 0.f, 0.f, 0.f);
    if (n0 + c4 < N) v = *(const float4*)(src + (size_t)(k0 + r) * N + n0 + c4);
    float* d = sm + r * 65 + c4;
    d[0] = v.x; d[1] = v.y; d[2] = v.z; d[3] = v.w;
  }
  __syncthreads();
  {
    const int idx = tid;
    const int n = idx >> 3, kc = idx & 7;
    if (n0 + n < N) {
      h16x8 o;
#pragma unroll
      for (int j = 0; j < 8; ++j) o[j] = (h16)sm[(kc * 8 + j) * 65 + n];
      *(h16x8*)(dst + (size_t)map_row(mode, n0 + n) * K + k0d + kc * 8) = o;
    }
  }
  __syncthreads();
}

__device__ __forceinline__ void phase_convert(const Params& p, int l, float* sm) {
  unsigned char* ws = p.ws;
  constexpr int T_WIN = 16 * 37, T_WOUT = 256, T_G = 16 * 128, T_W1 = 128;
  constexpr int E0 = T_WIN, E1 = E0 + T_WOUT, E2 = E1 + T_G, E3 = E2 + T_G, E4 = E3 + T_G, E5 = E4 + T_W1, E6 = E5 + T_W1;
  for (int t = blockIdx.x; t < E6; t += gridDim.x) {
    if (t < E0) {
      conv_tile(p.in[I_WIN] + (size_t)l * 1024 * NINSRC, 1024, NINSRC, (h16*)(ws + OFF_WIN), 1, t / 37, t % 37, sm);
    } else if (t < E1) {
      const int u = t - E0;
      conv_tile(p.in[I_WOUT] + (size_t)l * 1024 * 1024, 1024, 1024, (h16*)(ws + OFF_WOUT), 4, u >> 4, u & 15, sm);
    } else if (t < E3) {
      const int up = t >= E2;
      const int u = t - (up ? E2 : E1);
      const int e = u >> 7, v = u & 127;
      conv_tile(p.in[up ? I_MU : I_MG] + ((size_t)l * 16 + e) * 1024 * 512, 1024, 512, (h16*)(ws + OFF_WGU) + (size_t)e * 1024 * 1024, up ? 3 : 2,
                v >> 3, v & 7, sm);
    } else if (t < E4) {
      const int u = t - E3;
      const int e = u >> 7, v = u & 127;
      conv_tile(p.in[I_MD] + ((size_t)l * 16 + e) * 512 * 1024, 512, 1024, (h16*)(ws + OFF_WDN) + (size_t)e * 1024 * 512, 0, v >> 4, v & 15, sm);
    } else {
      const int vv = t >= E5;
      const int u = t - (vv ? E5 : E4);
      conv_tile(p.in[vv ? I_CVW1 : I_CKW1] + (size_t)l * 2048 * 256, 2048, 256, (h16*)(ws + (vv ? OFF_W1V : OFF_W1K)), 0, u >> 2, u & 3, sm);
    }
  }
  {
    h16x8 z = {0, 0, 0, 0, 0, 0, 0, 0};
    h16* w = (h16*)(ws + OFF_WIN) + (size_t)NINSRC * 1024;
    for (int i = blockIdx.x * NTHREADS + tidx(); i < (NINP - NINSRC) * 1024 / 8; i += gridDim.x * NTHREADS) *(h16x8*)(w + (size_t)i * 8) = z;
  }
  for (int t = blockIdx.x; t < 8; t += gridDim.x) {
    const int kv = t >> 2, nt = t & 3;
    const float* w1 = p.in[kv ? I_CVW1 : I_CKW1] + (size_t)l * 2048 * 256;
    const float* pos = p.in[kv ? I_CPV : I_CPK] + (size_t)l * 2048;
    const int n = nt * 64 + (tidx() & 63), kg = tidx() >> 6;
    float s = 0.f;
    for (int k = kg * 256; k < kg * 256 + 256; ++k) s += pos[k] * w1[(size_t)k * 256 + n];
    sm[kg * 64 + (tidx() & 63)] = s;
    __syncthreads();
    if (tidx() < 64) {
      float t8 = 0.f;
      for (int q = 0; q < 8; ++q) t8 += sm[q * 64 + tidx()];
      ((float*)(ws + OFF_PB))[kv * 256 + n] = t8;
    }
    __syncthreads();
  }
}

__device__ __forceinline__ void phase_prep(const Params& p, float* sm) {
  unsigned char* ws = p.ws;
  const int tid = tidx();
  if (blockIdx.x == 0) {
    for (int i = tid; i < 1024; i += NTHREADS) ((unsigned*)(ws + OFF_CTL))[i] = 0u;
  }
  float* mod = (float*)(ws + OFF_MOD);
  for (int t = blockIdx.x; t < 384; t += gridDim.x) {
    const int l = t / 192, j0 = (t % 192) * 32;
    const int kg = tid >> 3, cq = tid & 7;
    const float* w = p.in[I_ADAW] + (size_t)l * 1024 * 6144 + j0 + 4 * cq;
    const float* c = p.in[I_C];
    float a0[4] = {0, 0, 0, 0}, a1[4] = {0, 0, 0, 0};
#pragma unroll 8
    for (int k = kg * 16; k < kg * 16 + 16; ++k) {
      const float4 wv = *(const float4*)(w + (size_t)k * 6144);
      const float s0 = silu_f(c[k]), s1 = silu_f(c[1024 + k]);
      a0[0] += s0 * wv.x; a0[1] += s0 * wv.y; a0[2] += s0 * wv.z; a0[3] += s0 * wv.w;
      a1[0] += s1 * wv.x; a1[1] += s1 * wv.y; a1[2] += s1 * wv.z; a1[3] += s1 * wv.w;
    }
    float* r = sm + (kg * 8 + cq) * 8;
#pragma unroll
    for (int i = 0; i < 4; ++i) { r[i] = a0[i]; r[4 + i] = a1[i]; }
    __syncthreads();
    if (tid < 64) {
      const int bb = tid >> 5, col = tid & 31, q = col >> 2, ci = col & 3;
      float s = 0.f;
      for (int g = 0; g < 64; ++g) s += sm[(g * 8 + q) * 8 + bb * 4 + ci];
      mod[(size_t)(l * 2 + bb) * 6144 + j0 + col] = s + p.in[I_ADAB][l * 6144 + j0 + col];
    }
    __syncthreads();
  }
  float* rc = (float*)(ws + OFF_ROPE);
  float* rs = rc + (size_t)T * 32;
  const int* pos = (const int*)p.in[I_POS];
  for (int i = blockIdx.x * NTHREADS + tid; i < T * 32; i += gridDim.x * NTHREADS) {
    const int t = i >> 5, f = i & 31;
    const double a = (double)pos[t] * p.inv_freq[f];
    const double n = rint(a * 0.15915494309189535);
    double r = fma(-n, 6.283185307179586, a);
    r = fma(-n, 2.4492935982947064e-16, r);
    const float rf = (float)r;
    rc[i] = cosf(rf);
    rs[i] = sinf(rf);
  }
}

__device__ __forceinline__ void phase_norm1(const Params& p, int mode) {
  unsigned char* ws = p.ws;
  const int lane = tidx() & 63, wave = tidx() >> 6;
  const float* mod = (const float*)(ws + OFF_MOD);
  float* xa = (float*)(ws + OFF_XA);
  const h16* yp = (const h16*)(ws + OFF_YPAIR);
  h16* hout = (h16*)(ws + OFF_H16);
  const int l = (mode == 0) ? 0 : 1;
  for (int row = blockIdx.x * NW + wave; row < T; row += gridDim.x * NW) {
    const int b = row >> 13;
    float4 x[4];
    float ss = 0.f;
#pragma unroll
    for (int i = 0; i < 4; ++i) {
      const int col = lane * 4 + 256 * i;
      if (mode == 0) {
        x[i] = *(const float4*)(p.in[I_X] + (size_t)row * D + col);
      } else {
        const int lp = mode == 1 ? 0 : 1;
        const float4 xv = *(const float4*)(xa + (size_t)row * D + col);
        const float4 g2 = *(const float4*)(mod + (size_t)(lp * 2 + b) * 6144 + 5120 + col);
        const h16x4 y0 = *(const h16x4*)(yp + (size_t)(row * 2) * D + col);
        const h16x4 y1 = *(const h16x4*)(yp + (size_t)(row * 2 + 1) * D + col);
        x[i].x = xv.x + g2.x * ((float)y0[0] + (float)y1[0]);
        x[i].y = xv.y + g2.y * ((float)y0[1] + (float)y1[1]);
        x[i].z = xv.z + g2.z * ((float)y0[2] + (float)y1[2]);
        x[i].w = xv.w + g2.w * ((float)y0[3] + (float)y1[3]);
        if (mode == 1) *(float4*)(xa + (size_t)row * D + col) = x[i];
      }
      ss += x[i].x * x[i].x + x[i].y * x[i].y + x[i].z * x[i].z + x[i].w * x[i].w;
    }
    ss = wsum(ss);
    const float rstd = rsqrtf(ss * (1.f / D) + EPS);
#pragma unroll
    for (int i = 0; i < 4; ++i) {
      const int col = lane * 4 + 256 * i;
      if (mode == 2) {
        const float4 g = *(const float4*)(p.in[I_FNG] + col);
        float4 o;
        o.x = x[i].x * rstd * g.x; o.y = x[i].y * rstd * g.y; o.z = x[i].z * rstd * g.z; o.w = x[i].w * rstd * g.w;
        *(float4*)(p.out + (size_t)row * D + col) = o;
      } else {
        const float4 g = *(const float4*)(p.in[I_N1G] + l * D + col);
        const float4 sh = *(const float4*)(mod + (size_t)(l * 2 + b) * 6144 + col);
        const float4 sc = *(const float4*)(mod + (size_t)(l * 2 + b) * 6144 + 1024 + col);
        *(h16x4*)(hout + (size_t)row * D + col) = pack4(x[i].x * rstd * g.x * (1.f + sc.x) + sh.x, x[i].y * rstd * g.y * (1.f + sc.y) + sh.y,
                                                        x[i].z * rstd * g.z * (1.f + sc.z) + sh.z, x[i].w * rstd * g.w * (1.f + sc.w) + sh.w);
      }
    }
  }
}

__device__ __forceinline__ void phase_inproj(const Params& p, h16* sm) {
  unsigned char* ws = p.ws;
  const h16* A = (const h16*)(ws + OFF_H16);
  const h16* W = (const h16*)(ws + OFF_WIN);
  h16* P = (h16*)(ws + OFF_P16);
  for (int t = blockIdx.x; t < 64 * 10; t += gridDim.x) {
    const int mt = t / 10, nt = t % 10;
    f32x4 acc[8][4];
    const h16* Ab = A + (size_t)mt * 256 * D;
    gemm_mainloop(acc, [&](int r) { return Ab + (size_t)r * D; }, W + (size_t)nt * 256 * D, D, D / 32, sm);
    const int tid_e = tidx(), lane = tid_e & 63, wave = tid_e >> 6, wr = wave >> 2, wc = wave & 3, fr = lane & 15, fq = lane >> 4;
    if (nt * 256 + wc * 64 < NIN) {
#pragma unroll
      for (int m = 0; m < 8; ++m)
#pragma unroll
        for (int n = 0; n < 4; ++n) {
          const int row = mt * 256 + wr * 128 + m * 16 + fr, col = nt * 256 + wc * 64 + n * 16 + 4 * fq;
          *(h16x4*)(P + (size_t)row * NIN + col) = pack4(acc[m][n][0], acc[m][n][1], acc[m][n][2], acc[m][n][3]);
        }
    }
  }
}

__device__ __forceinline__ int perm_key(int pos) {
  return 32 * (pos >> 5) + 16 * ((pos >> 2) & 1) + 4 * ((pos >> 3) & 3) + (pos & 3);
}
__device__ __forceinline__ void phase_post(const Params& p) {
  unsigned char* ws = p.ws;
  const h16* P = (const h16*)(ws + OFF_P16);
  const float* rc = (const float*)(ws + OFF_ROPE);
  const float* rs = rc + (size_t)T * 32;
  h16* q16 = (h16*)(ws + OFF_Q16);
  float* gates = (float*)(ws + OFF_GATES);
  const int lane = tidx() & 63, wave = tidx() >> 6;
  for (int row = blockIdx.x * NW + wave; row < T; row += gridDim.x * NW) {
    const int b = row >> 13, s = row & (S - 1);
    const h16* pr = P + (size_t)row * NIN;
    const int d = (lane & 7) * 4;
    const float4 cs = *(const float4*)(rc + (size_t)row * 32 + d);
    const float4 sn = *(const float4*)(rs + (size_t)row * 32 + d);
    {
      const int hd = lane >> 3;
      const h16x4 a = *(const h16x4*)(pr + C_Q + 64 * hd + d);
      const h16x4 bb = *(const h16x4*)(pr + C_Q + 64 * hd + 32 + d);
      const float a0 = a[0], a1 = a[1], a2 = a[2], a3 = a[3], b0 = bb[0], b1 = bb[1], b2 = bb[2], b3 = bb[3];
      h16* qo = q16 + (size_t)row * 512 + 64 * hd + d;
      *(h16x4*)qo = pack4((a0 * cs.x - b0 * sn.x) * 0.125f, (a1 * cs.y - b1 * sn.y) * 0.125f, (a2 * cs.z - b2 * sn.z) * 0.125f, (a3 * cs.w - b3 * sn.w) * 0.125f);
      *(h16x4*)(qo + 32) = pack4((b0 * cs.x + a0 * sn.x) * 0.125f, (b1 * cs.y + a1 * sn.y) * 0.125f, (b2 * cs.z + a2 * sn.z) * 0.125f, (b3 * cs.w + a3 * sn.w) * 0.125f);
    }
    if (lane < 48) {
      const int tn = lane >> 4, hd = (lane >> 3) & 1;
      const int cb = (tn == 0 ? C_KC : (tn == 1 ? C_KS : C_KW)) + 64 * hd;
      const size_t off = tn == 0 ? OFF_KC : (tn == 1 ? OFF_KS : OFF_KW);
      const h16x4 a = *(const h16x4*)(pr + cb + d);
      const h16x4 bb = *(const h16x4*)(pr + cb + 32 + d);
      const float a0 = a[0], a1 = a[1], a2 = a[2], a3 = a[3], b0 = bb[0], b1 = bb[1], b2 = bb[2], b3 = bb[3];
      h16* ko = (h16*)(ws + off) + ((size_t)(b * 2 + hd) * S + s) * 64 + d;
      *(h16x4*)ko = pack4(a0 * cs.x - b0 * sn.x, a1 * cs.y - b1 * sn.y, a2 * cs.z - b2 * sn.z, a3 * cs.w - b3 * sn.w);
      *(h16x4*)(ko + 32) = pack4(b0 * cs.x + a0 * sn.x, b1 * cs.y + a1 * sn.y, b2 * cs.z + a2 * sn.z, b3 * cs.w + a3 * sn.w);
    }
    if (lane < 32) {
      const int hd = lane >> 4, dd = (lane & 15) * 4;
      *(h16x4*)((h16*)(ws + OFF_VC) + ((size_t)(b * 2 + hd) * S + s) * 64 + dd) = *(const h16x4*)(pr + C_VC + 64 * hd + dd);
    }
    if (lane < 24) gates[(size_t)row * 24 + lane] = sigm((float)pr[C_GATE + lane]);
  }
  for (int task = blockIdx.x; task < 1024; task += gridDim.x) {
    const int tensor = task & 1, kv = (task >> 1) & 1, blk = (task >> 2) & 127, b = task >> 9;
    const int srccol = (tensor ? C_VW : C_VS) + 64 * kv;
    h16* dst = (h16*)(ws + (tensor ? OFF_VWT : OFF_VST)) + ((size_t)((b * 2 + kv) * 128 + blk)) * 4096;
    const int dim = tidx() & 63, kg = tidx() >> 6;
    {
      const int p0 = kg * 8;
      h16x8 v;
#pragma unroll
      for (int j = 0; j < 8; ++j) v[j] = P[(size_t)(b * S + blk * 64 + perm_key(p0 + j)) * NIN + srccol + dim];
      *(h16x8*)(dst + dim * 64 + p0) = v;
    }
  }
}

__device__ __forceinline__ void mixa_compress1(const Params& p, int item, h16* sm) {
  unsigned char* ws = p.ws;
  const int which = item >> 3, mt = item & 7;
  const h16* A = (const h16*)(ws + (which ? OFF_VC : OFF_KC)) + (size_t)mt * 256 * 1024;
  const h16* W = (const h16*)(ws + (which ? OFF_W1V : OFF_W1K));
  const float* pb = (const float*)(ws + OFF_PB) + which * 256;
  h16* hid = (h16*)(ws + OFF_HIDC) + (size_t)which * 2048 * 256;
  f32x4 acc[8][4];
  gemm_mainloop(acc, [&](int r) { return A + (size_t)r * 1024; }, W, 2048, 64, sm);
  const int tid_e = tidx(), lane = tid_e & 63, wave = tid_e >> 6, wr = wave >> 2, wc = wave & 3, fr = lane & 15, fq = lane >> 4;
#pragma unroll
  for (int m = 0; m < 8; ++m)
#pragma unroll
    for (int n = 0; n < 4; ++n) {
      const int row = mt * 256 + wr * 128 + m * 16 + fr, col = wc * 64 + n * 16 + 4 * fq;
      const float4 bias = *(const float4*)(pb + col);
      *(h16x4*)(hid + (size_t)row * 256 + col) =
          pack4(gelu_tanh(acc[m][n][0] + bias.x), gelu_tanh(acc[m][n][1] + bias.y), gelu_tanh(acc[m][n][2] + bias.z), gelu_tanh(acc[m][n][3] + bias.w));
    }
}

__device__ __forceinline__ void mixa_lru(const Params& p, int l, int item, float* sm) {
  unsigned char* ws = p.ws;
  const int half = tidx() >> 8;
  item = item * 2 + half;
  sm += half * 12288;
  const int b = item >> 7, ck = item & 127;
  const int c = tidx() & 255;
  const int nb = c >> 6, e = c & 63;
  const h16* P = (const h16*)(ws + OFF_P16);
  const float* cw = p.in[I_LCW] + l * 4 * 256;
  const float w0 = cw[c], w1 = cw[256 + c], w2 = cw[512 + c], w3 = cw[768 + c], cb = p.in[I_LCB][l * 256 + c];
  const float ba = p.in[I_LBA][l * 256 + c], bx = p.in[I_LBX][l * 256 + c];
  const float lam = p.in[I_LLAM][l * 256 + c];
  const float ls = -log1pf(expf(-lam));
  const float* pa = p.in[I_LWA] + ((size_t)(l * 4 + nb) * 64) * 64 + e;
  const float* px = p.in[I_LWX] + ((size_t)(l * 4 + nb) * 64) * 64 + e;
  const int t0 = ck * 64;
  float x0 = 0.f, x1 = 0.f, x2 = 0.f;
  if (t0 >= 3) {
    x0 = (float)P[(size_t)(b * S + t0 - 3) * NIN + C_XL + c];
    x1 = (float)P[(size_t)(b * S + t0 - 2) * NIN + C_XL + c];
    x2 = (float)P[(size_t)(b * S + t0 - 1) * NIN + C_XL + c];
  }
  float h = 0.f, ap = 1.f;
  float* lh = (float*)(ws + OFF_LRUH);
  float* la = (float*)(ws + OFF_LRUA);
  float* sr = sm + 4096;
  float* si = sm + 8192;
#pragma unroll 1
  for (int sub = 0; sub < 4; ++sub) {
    const int tb = t0 + sub * 16;
#pragma unroll 1
    for (int tt = 0; tt < 16; ++tt) {
      const float x3 = (float)P[(size_t)(b * S + tb + tt) * NIN + C_XL + c];
      sm[tt * 256 + c] = w0 * x0 + w1 * x1 + w2 * x2 + w3 * x3 + cb;
      x0 = x1; x1 = x2; x2 = x3;
    }
    __syncthreads();
    {
      float accr[16], acci[16];
#pragma unroll
      for (int tt = 0; tt < 16; ++tt) { accr[tt] = 0.f; acci[tt] = 0.f; }
#pragma unroll 1
      for (int d8 = 0; d8 < 8; ++d8) {
        float wa8[8], wx8[8];
        const float* pa8 = pa + d8 * 512;
        const float* px8 = px + d8 * 512;
#pragma unroll
        for (int j = 0; j < 8; ++j) { wa8[j] = pa8[j * 64]; wx8[j] = px8[j * 64]; }
        const float* xr = sm + nb * 64 + d8 * 8;
#pragma unroll
        for (int tt = 0; tt < 16; ++tt) {
          const float4 xa = *(const float4*)(xr + tt * 256), xb = *(const float4*)(xr + tt * 256 + 4);
          accr[tt] += xa.x * wa8[0] + xa.y * wa8[1] + xa.z * wa8[2] + xa.w * wa8[3] + xb.x * wa8[4] + xb.y * wa8[5] + xb.z * wa8[6] + xb.w * wa8[7];
          acci[tt] += xa.x * wx8[0] + xa.y * wx8[1] + xa.z * wx8[2] + xa.w * wx8[3] + xb.x * wx8[4] + xb.y * wx8[5] + xb.z * wx8[6] + xb.w * wx8[7];
        }
      }
#pragma unroll
      for (int tt = 0; tt < 16; ++tt) { sr[tt * 256 + c] = accr[tt]; si[tt * 256 + c] = acci[tt]; }
    }
    float* lhp = lh + (size_t)(b * S + tb) * 256 + c;
    float* lap = la + (size_t)(b * S + tb) * 256 + c;
#pragma unroll 1
    for (int tt = 0; tt < 16; ++tt) {
      const float r = sigm(sr[tt * 256 + c] + ba), ig = sigm(si[tt * 256 + c] + bx);
      const float log_a = 8.f * r * ls;
      const float a = __expf(log_a);
      const float mult = sqrtf(-expm1f(2.f * log_a));
      const float u = mult * ig * sm[tt * 256 + c];
      h = a * h + u;
      ap *= a;
      lhp[tt * 256] = h;
      lap[tt * 256] = ap;
    }
    __syncthreads();
  }
  ((float*)(ws + OFF_HEND))[(size_t)(b * 128 + ck) * 256 + c] = h;
  ((float*)(ws + OFF_AEND))[(size_t)(b * 128 + ck) * 256 + c] = ap;
}

__device__ __forceinline__ void mixa_conv(const Params& p, int l, int item, float* sm) {
  unsigned char* ws = p.ws;
  const int half = tidx() >> 8;
  item = item * 2 + half;
  sm += half * 15872;
  const int b = item >> 8, ck = item & 255;
  const int c = tidx() & 255;
  const h16* P = (const h16*)(ws + OFF_P16);
  const int t0 = ck * 32;
  for (int r = 0; r < 62; ++r) {
    const int t = t0 - 30 + r;
    float v = 0.f;
    if (t >= 0) {
      const h16* pr = P + (size_t)(b * S + t) * NIN;
      v = (float)pr[C_CVA + c] * sigm((float)pr[C_CVB + c]);
    }
    sm[r * 256 + c] = v;
  }
  float w[31];
#pragma unroll
  for (int j = 0; j < 31; ++j) w[j] = p.in[I_DWW][(size_t)(l * 31 + j) * 256 + c];
  const float bias = p.in[I_DWB][l * 256 + c];
  for (int i = 0; i < 32; ++i) {
    float z = bias;
#pragma unroll
    for (int j = 0; j < 31; ++j) z += w[j] * sm[(i + j) * 256 + c];
    sm[i * 256 + c] = z;
  }
  __syncthreads();
  const int lane = tidx() & 63, wave = (tidx() >> 6) & 3;
  const float4 lg = *(const float4*)(p.in[I_LNG] + l * 256 + lane * 4);
  const float4 lb = *(const float4*)(p.in[I_LNB] + l * 256 + lane * 4);
  const float4 gn = *(const float4*)(p.in[I_ONG] + l * 1024 + 768 + lane * 4);
  h16* yc = (h16*)(ws + OFF_H16);
  for (int i = wave * 8; i < wave * 8 + 8; ++i) {
    const float4 z = *(const float4*)(sm + i * 256 + lane * 4);
    const float mu = wsum(z.x + z.y + z.z + z.w) * (1.f / 256.f);
    const float dx = z.x - mu, dy = z.y - mu, dz = z.z - mu, dw = z.w - mu;
    const float var = wsum(dx * dx + dy * dy + dz * dz + dw * dw) * (1.f / 256.f);
    const float rs = rsqrtf(var + EPS);
    const float y0 = silu_f(dx * rs * lg.x + lb.x), y1 = silu_f(dy * rs * lg.y + lb.y), y2 = silu_f(dz * rs * lg.z + lb.z), y3 = silu_f(dw * rs * lg.w + lb.w);
    const float r2 = rsqrtf(wsum(y0 * y0 + y1 * y1 + y2 * y2 + y3 * y3) * (1.f / 256.f) + EPS);
    *(h16x4*)(yc + (size_t)(b * S + t0 + i) * D + 768 + lane * 4) = pack4(y0 * r2 * gn.x, y1 * r2 * gn.y, y2 * r2 * gn.z, y3 * r2 * gn.w);
  }
  __syncthreads();
}

__device__ __forceinline__ void phase_mixa(const Params& p, int l, void* sm) {
  const int G = gridDim.x;
  for (int it = blockIdx.x; it < 16; it += G) mixa_compress1(p, it, (h16*)sm);
  for (int it = (blockIdx.x + G - 16 % G) % G; it < 128; it += G) mixa_lru(p, l, it, (float*)sm);
  for (int it = (blockIdx.x + G - 144 % G) % G; it < 256; it += G) mixa_conv(p, l, it, (float*)sm);
}

__device__ __forceinline__ void phase_mixb(const Params& p, int l) {
  unsigned char* ws = p.ws;
  const int tid = tidx();
  for (int it = blockIdx.x; it < 512; it += gridDim.x) {
    const int which = it >> 8;
    const int row = (it & 255) * 8 + (tid >> 6), d = tid & 63;
    const h16* hr = (const h16*)(ws + OFF_HIDC) + ((size_t)which * 2048 + row) * 256;
    const float* w2 = p.in[which ? I_CVW2 : I_CKW2] + (size_t)l * 256 * 64 + d;
    float s = 0.f;
#pragma unroll 4
    for (int j8 = 0; j8 < 32; ++j8) {
      const h16x8 hv = *(const h16x8*)(hr + j8 * 8);
#pragma unroll
      for (int j = 0; j < 8; ++j) s += (float)hv[j] * w2[(size_t)(j8 * 8 + j) * 64];
    }
    const int bkv = row >> 9, n = row & 511;
    if (n == 511) s = 0.f;
    if (which == 0) {
      ((h16*)(ws + OFF_KCMP))[((size_t)bkv * 512 + n) * 64 + d] = (h16)s;
    } else {
      const int blk = n >> 6, key = n & 63;
      const int pos = 32 * (key >> 5) + 8 * ((key >> 2) & 3) + 4 * ((key >> 4) & 1) + (key & 3);
      ((h16*)(ws + OFF_VCMPT))[((size_t)(bkv * 8 + blk) * 64 + d) * 64 + pos] = (h16)s;
    }
  }
  const int g = blockIdx.x * NTHREADS + tid;
  if (g < 512) {
    const int b = g >> 8, c = g & 255;
    const float* he = (const float*)(ws + OFF_HEND) + (size_t)b * 128 * 256 + c;
    const float* ae = (const float*)(ws + OFF_AEND) + (size_t)b * 128 * 256 + c;
    float* cy = (float*)(ws + OFF_CARRY) + (size_t)b * 128 * 256 + c;
    float carry = 0.f;
#pragma unroll 8
    for (int k = 0; k < 128; ++k) {
      cy[k * 256] = carry;
      carry = he[k * 256] + ae[k * 256] * carry;
    }
  }
}

__device__ __forceinline__ void stage8k(const h16* __restrict__ g, h16* l, int tid) {
  const int r = tid >> 3, cl = (tid & 7) ^ ((r >> 1) & 7);
  glds16(g + r * 64 + cl * 8, l + tid * 8);
}
__device__ __forceinline__ h16x8 ldfrag(const h16* l, int row, int chunk) {
  return *(const h16x8*)(l + row * 64 + ((chunk ^ ((row >> 1) & 7)) * 8));
}

template <int MODE>
__device__ __forceinline__ void attn_branch(const h16* __restrict__ Kg, const h16* __restrict__ Vg, int j0, int j1, h16* ring,
                                            const h16x8 (&qf)[2][2], float (&m)[2], float (&l)[2], f32x4 (&o)[2][4],
                                            const int (&tq)[2], const int (&lim)[2], const int (&tlim)[2],
                                            const unsigned long long (&mylo)[2], const unsigned long long (&myhi)[2],
                                            const unsigned long long (&ulo)[2], const unsigned long long (&uhi)[2],
                                            const float (&inv)[2], float* impw) {
  int tid = tidx();
  asm volatile("" : "+v"(tid));
  const int lane = tid & 63;
  const int h = lane >> 4, c = lane & 15, qi = c >> 2, g = c & 3;
  constexpr bool PV = MODE != 0;
  constexpr int NST = 5;
  const int n = j1 - j0 + 1;
  if (n <= 0) return;
#pragma unroll
  for (int q = 0; q < NST - 1; ++q)
    if (q < n) {
      stage8k(Kg + (size_t)(j0 + q) * 4096, ring + q * 8192, tid);
      if (PV) stage8k(Vg + (size_t)(j0 + q) * 4096, ring + q * 8192 + 4096, tid);
    }
  int cur = 0, nxt = NST - 1;
  for (int it = 0; it < n; ++it) {
    const int j = j0 + it;
    {
      const int rem = n - 1 - it;
      if (PV) { if (rem >= 3) VMCNT(6); else if (rem == 2) VMCNT(4); else if (rem == 1) VMCNT(2); else VMCNT(0); }
      else    { if (rem >= 3) VMCNT(3); else if (rem == 2) VMCNT(2); else if (rem == 1) VMCNT(1); else VMCNT(0); }
    }
    __builtin_amdgcn_s_barrier();
    if (it + NST - 1 < n) {
      stage8k(Kg + (size_t)(j + NST - 1) * 4096, ring + nxt * 8192, tid);
      if (PV) stage8k(Vg + (size_t)(j + NST - 1) * 4096, ring + nxt * 8192 + 4096, tid);
    }
    const h16* cK = ring + cur * 8192;
    const h16* cV = cK + 4096;
    nxt = cur;
    cur = cur + 1 == NST ? 0 : cur + 1;
    bool act[2];
#pragma unroll
    for (int mq = 0; mq < 2; ++mq) {
      if (MODE <= 1) act[mq] = j * 64 <= tlim[mq];
      else if (MODE == 2) act[mq] = ((j < 64 ? (ulo[mq] >> j) : (uhi[mq] >> (j - 64))) & 1ull) != 0ull;
      else act[mq] = (j * 64 <= tlim[mq] + 3) && (j * 64 + 63 > tlim[mq] - 512);
    }
    if (act[0] || act[1]) {
      h16x8 pf[2][2];
      h16x8 kf[4][2];
#pragma unroll
      for (int kt = 0; kt < 4; ++kt)
#pragma unroll
        for (int ks = 0; ks < 2; ++ks) kf[kt][ks] = ldfrag(cK, 16 * kt + c, 4 * ks + h);
#pragma unroll
      for (int mq = 0; mq < 2; ++mq)
        if (act[mq]) {
          f32x4 s[1][4];
          {
#pragma unroll
            for (int kt = 0; kt < 4; ++kt) {
              s[0][kt] = (f32x4){0.f, 0.f, 0.f, 0.f};
#pragma unroll
              for (int ks = 0; ks < 2; ++ks) s[0][kt] = __builtin_amdgcn_mfma_f32_16x16x32_f16(kf[kt][ks], qf[mq][ks], s[0][kt], 0, 0, 0);
            }
          }
          const bool selbit = MODE == 2 ? (((j < 64 ? (mylo[mq] >> j) : (myhi[mq] >> (j - 64))) & 1ull) != 0ull) : true;
          const int pbase = j * 64 + 4 * h;
#pragma unroll
          for (int kt = 0; kt < 4; ++kt)
#pragma unroll
            for (int i = 0; i < 4; ++i) {
              const int pos = pbase + 16 * kt + i;
              bool v;
              if (MODE <= 1) v = pos <= lim[mq];
              else if (MODE == 2) v = selbit && pos <= tq[mq];
              else v = pos <= tq[mq] && pos > tq[mq] - 512;
              s[0][kt][i] = v ? s[0][kt][i] : -1e30f;
            }
          if (MODE == 1) {
#pragma unroll
            for (int kt = 0; kt < 4; ++kt) {
              float ps = 0.f;
#pragma unroll
              for (int i = 0; i < 4; ++i) {
                const float pv = __expf(s[0][kt][i] - m[mq]) * inv[mq];
                s[0][kt][i] = pv;
                ps += pv;
              }
              ps += __shfl_xor(ps, 1);
              ps += __shfl_xor(ps, 2);
              if (g == 0) impw[(4 * mq + qi) * 128 + j * 16 + kt * 4 + h] = ps;
            }
          } else {
            float bm = fmaxf(fmaxf(fmaxf(s[0][0][0], s[0][0][1]), fmaxf(s[0][0][2], s[0][0][3])), fmaxf(fmaxf(s[0][1][0], s[0][1][1]), fmaxf(s[0][1][2], s[0][1][3])));
            bm = fmaxf(bm, fmaxf(fmaxf(fmaxf(s[0][2][0], s[0][2][1]), fmaxf(s[0][2][2], s[0][2][3])), fmaxf(fmaxf(s[0][3][0], s[0][3][1]), fmaxf(s[0][3][2], s[0][3][3]))));
            bm = fmaxf(bm, __shfl_xor(bm, 16));
            bm = fmaxf(bm, __shfl_xor(bm, 32));
            const float mn = fmaxf(m[mq], bm);
            const float alpha = __expf(m[mq] - mn);
            const float mref = mn > -1e29f ? mn : 1e30f;
            float ps = 0.f;
#pragma unroll
            for (int kt = 0; kt < 4; ++kt)
#pragma unroll
              for (int i = 0; i < 4; ++i) {
                const float pv = __expf(s[0][kt][i] - mref);
                s[0][kt][i] = pv;
                ps += pv;
              }
            l[mq] = l[mq] * alpha + ps;
            m[mq] = mn;
            if (PV) {
#pragma unroll
              for (int mt = 0; mt < 4; ++mt) o[mq][mt] *= alpha;
            }
          }
          if (PV) {
#pragma unroll
            for (int s2 = 0; s2 < 2; ++s2)
#pragma unroll
              for (int i = 0; i < 4; ++i) { pf[mq][s2][i] = (h16)s[0][2 * s2][i]; pf[mq][s2][4 + i] = (h16)s[0][2 * s2 + 1][i]; }
          }
        }
      if (PV) {
        h16x8 vf[4][2];
#pragma unroll
        for (int mt = 0; mt < 4; ++mt)
#pragma unroll
          for (int s2 = 0; s2 < 2; ++s2) vf[mt][s2] = ldfrag(cV, 16 * mt + c, 4 * s2 + h);
#pragma unroll
        for (int mq = 0; mq < 2; ++mq)
          if (act[mq]) {
#pragma unroll
            for (int s2 = 0; s2 < 2; ++s2) {
#pragma unroll
              for (int mt = 0; mt < 4; ++mt) o[mq][mt] = __builtin_amdgcn_mfma_f32_16x16x32_f16(vf[mt][s2], pf[mq][s2], o[mq][mt], 0, 0, 0);
            }
          }
      }
    }
  }
  __builtin_amdgcn_s_barrier();
}

__device__ __forceinline__ void attn_item(const Params& p, int l, int item, float* sm) {
  unsigned char* ws = p.ws;
  int tid = tidx();
  asm volatile("" : "+v"(tid));
  const int lane = tid & 63, wave = tid >> 6;
  const int combo = item & 3, qt = item >> 2;
  const int b = combo >> 1, kv = combo & 1;
  const int t0 = qt * 64, tw0 = t0 + 8 * wave;
  const int h = lane >> 4, c = lane & 15, qi = c >> 2, g = c & 3;
  const int head = kv * 4 + g, bkv = b * 2 + kv;
  h16* ring = (h16*)sm;
  float* impw = sm + 20480 + wave * 1024;
  unsigned long long* selm = (unsigned long long*)(sm + 20480 + 8192) + wave * 16;

  h16x8 qf[2][2];
  int tq[2];
#pragma unroll
  for (int mq = 0; mq < 2; ++mq) {
    tq[mq] = tw0 + 4 * mq + qi;
    const h16* qrow = (const h16*)(ws + OFF_Q16) + (size_t)(b * S + tq[mq]) * 512 + head * 64;
    qf[mq][0] = *(const h16x8*)(qrow + 8 * h);
    qf[mq][1] = *(const h16x8*)(qrow + 32 + 8 * h);
  }
  for (int i = lane; i < 1024; i += 64) impw[i] = 0.f;

  h16x4 ofin[2][4];
  float m[2], ll[2], inv[2];
  f32x4 o[2][4];
  const unsigned long long z2[2] = {0ull, 0ull};
  {
    int lim[2], tlim[2];
#pragma unroll
    for (int mq = 0; mq < 2; ++mq) {
      lim[mq] = tq[mq] >= 31 ? ((tq[mq] - 31) >> 4) : -1;
      const int tl = tw0 + 4 * mq + 3;
      tlim[mq] = tl >= 31 ? ((tl - 31) >> 4) : -1;
      m[mq] = -1e30f; ll[mq] = 0.f; inv[mq] = 0.f;
#pragma unroll
      for (int mt = 0; mt < 4; ++mt) o[mq][mt] = (f32x4){0.f, 0.f, 0.f, 0.f};
    }
    const int nl = (t0 + 63 - 31) >> 4;
    const int jl = nl >> 6;
    const h16* Kc = (const h16*)(ws + OFF_KCMP) + (size_t)bkv * 512 * 64;
    const h16* Vc = (const h16*)(ws + OFF_VCMPT) + (size_t)bkv * 8 * 4096;
    attn_branch<0>(Kc, Vc, 0, jl, ring, qf, m, ll, o, tq, lim, tlim, z2, z2, z2, z2, inv, impw);
#pragma unroll
    for (int mq = 0; mq < 2; ++mq) {
      float lt = ll[mq];
      lt += __shfl_xor(lt, 16);
      lt += __shfl_xor(lt, 32);
      inv[mq] = lt > 0.f ? 1.f / lt : 0.f;
    }
    attn_branch<1>(Kc, Vc, 0, jl, ring, qf, m, ll, o, tq, lim, tlim, z2, z2, z2, z2, inv, impw);
    const float* gt0 = (const float*)(ws + OFF_GATES) + (size_t)(b * S) * 24 + head * 3;
#pragma unroll
    for (int mq = 0; mq < 2; ++mq) {
      const float g0 = gt0[(size_t)tq[mq] * 24] * ASCALE;
#pragma unroll
      for (int mt = 0; mt < 4; ++mt) ofin[mq][mt] = pack4(o[mq][mt][0] * g0, o[mq][mt][1] * g0, o[mq][mt][2] * g0, o[mq][mt][3] * g0);
    }
  }
  for (int q = 0; q < 8; ++q) {
    const int t = tw0 + q, own = t >> 6;
    const float* ir = impw + q * 128;
    const int ja = lane, jb = lane + 64;
    unsigned k0 = 0u, k1 = 0u;
    if (ja <= own) k0 = (ja == 0 || ja == own) ? (0xFFFFFF80u | (unsigned)(127 - ja)) : (((__float_as_uint(ir[ja]) & ~127u) | (unsigned)(127 - ja)) + 1u);
    if (jb <= own) k1 = (jb == own) ? (0xFFFFFF80u | (unsigned)(127 - jb)) : (((__float_as_uint(ir[jb]) & ~127u) | (unsigned)(127 - jb)) + 1u);
    unsigned thr = 0u;
    for (int bit = 31; bit >= 0; --bit) {
      const unsigned cand = thr | (1u << bit);
      const int cnt = __popcll(__ballot(k0 >= cand)) + __popcll(__ballot(k1 >= cand));
      if (cnt >= 16) thr = cand;
    }
    const unsigned long long mlo = __ballot(k0 >= thr && ja <= own);
    const unsigned long long mhi = __ballot(k1 >= thr && jb <= own);
    if (lane == 0) { selm[q * 2] = mlo; selm[q * 2 + 1] = mhi; }
  }
  unsigned long long mylo[2], myhi[2], ulo[2], uhi[2];
#pragma unroll
  for (int mq = 0; mq < 2; ++mq) {
    mylo[mq] = selm[(4 * mq + qi) * 2];
    myhi[mq] = selm[(4 * mq + qi) * 2 + 1];
    unsigned long long a = selm[(4 * mq) * 2] | selm[(4 * mq + 1) * 2] | selm[(4 * mq + 2) * 2] | selm[(4 * mq + 3) * 2];
    unsigned long long bb = selm[(4 * mq) * 2 + 1] | selm[(4 * mq + 1) * 2 + 1] | selm[(4 * mq + 2) * 2 + 1] | selm[(4 * mq + 3) * 2 + 1];
    ulo[mq] = (unsigned long long)__builtin_amdgcn_readfirstlane((unsigned)a) | ((unsigned long long)__builtin_amdgcn_readfirstlane((unsigned)(a >> 32)) << 32);
    uhi[mq] = (unsigned long long)__builtin_amdgcn_readfirstlane((unsigned)bb) | ((unsigned long long)__builtin_amdgcn_readfirstlane((unsigned)(bb >> 32)) << 32);
  }
  const float* gtb = (const float*)(ws + OFF_GATES) + (size_t)(b * S) * 24 + head * 3;
  {
    int tl0[2] = {0, 0};
#pragma unroll
    for (int mq = 0; mq < 2; ++mq) {
      m[mq] = -1e30f; ll[mq] = 0.f;
#pragma unroll
      for (int mt = 0; mt < 4; ++mt) o[mq][mt] = (f32x4){0.f, 0.f, 0.f, 0.f};
    }
    attn_branch<2>((const h16*)(ws + OFF_KS) + (size_t)bkv * S * 64, (const h16*)(ws + OFF_VST) + (size_t)bkv * 128 * 4096, 0, (t0 + 63) >> 6, ring, qf, m, ll, o,
                   tq, tl0, tl0, mylo, myhi, ulo, uhi, inv, impw);
#pragma unroll
    for (int mq = 0; mq < 2; ++mq) {
      float lt = ll[mq];
      lt += __shfl_xor(lt, 16);
      lt += __shfl_xor(lt, 32);
      const float sc = lt > 0.f ? gtb[(size_t)tq[mq] * 24 + 1] * ASCALE / lt : 0.f;
#pragma unroll
      for (int mt = 0; mt < 4; ++mt)
        ofin[mq][mt] = pack4((float)ofin[mq][mt][0] + o[mq][mt][0] * sc, (float)ofin[mq][mt][1] + o[mq][mt][1] * sc, (float)ofin[mq][mt][2] + o[mq][mt][2] * sc,
                             (float)ofin[mq][mt][3] + o[mq][mt][3] * sc);
    }
  }
  {
    int tl0[2] = {0, 0}, tf[2];
#pragma unroll
    for (int mq = 0; mq < 2; ++mq) {
      tf[mq] = tw0 + 4 * mq;
      m[mq] = -1e30f; ll[mq] = 0.f;
#pragma unroll
      for (int mt = 0; mt < 4; ++mt) o[mq][mt] = (f32x4){0.f, 0.f, 0.f, 0.f};
    }
    const int jlo = t0 >= 511 ? ((t0 - 511) >> 6) : 0;
    attn_branch<3>((const h16*)(ws + OFF_KW) + (size_t)bkv * S * 64, (const h16*)(ws + OFF_VWT) + (size_t)bkv * 128 * 4096, jlo, (t0 + 63) >> 6, ring, qf, m, ll, o,
                   tq, tl0, tf, z2, z2, z2, z2, inv, impw);
#pragma unroll
    for (int mq = 0; mq < 2; ++mq) {
      float lt = ll[mq];
      lt += __shfl_xor(lt, 16);
      lt += __shfl_xor(lt, 32);
      const float sc = lt > 0.f ? gtb[(size_t)tq[mq] * 24 + 2] * ASCALE / lt : 0.f;
#pragma unroll
      for (int mt = 0; mt < 4; ++mt)
        ofin[mq][mt] = pack4((float)ofin[mq][mt][0] + o[mq][mt][0] * sc, (float)ofin[mq][mt][1] + o[mq][mt][1] * sc, (float)ofin[mq][mt][2] + o[mq][mt][2] * sc,
                             (float)ofin[mq][mt][3] + o[mq][mt][3] * sc);
    }
  }
  {
    h16* yc = (h16*)(ws + OFF_H16);
    const float* gn = p.in[I_ONG] + l * 1024 + 256 + head * 64;
    float* ssq = (float*)(ws + OFF_SSQ);
#pragma unroll
    for (int mq = 0; mq < 2; ++mq) {
      float sq = 0.f;
      h16* yr = yc + (size_t)(b * S + tq[mq]) * D + head * 64;
#pragma unroll
      for (int mt = 0; mt < 4; ++mt) {
        const float v[4] = {(float)ofin[mq][mt][0], (float)ofin[mq][mt][1], (float)ofin[mq][mt][2], (float)ofin[mq][mt][3]};
        sq += v[0] * v[0] + v[1] * v[1] + v[2] * v[2] + v[3] * v[3];
        const float4 gg = *(const float4*)(gn + 16 * mt + 4 * h);
        *(h16x4*)(yr + 16 * mt + 4 * h) = pack4(v[0] * gg.x, v[1] * gg.y, v[2] * gg.z, v[3] * gg.w);
      }
      sq += __shfl_xor(sq, 16);
      sq += __shfl_xor(sq, 32);
      sq += __shfl_xor(sq, 1);
      sq += __shfl_xor(sq, 2);
      if (h == 0 && g == 0) ssq[(size_t)(b * S + tq[mq]) * 2 + kv] = sq * (1.f / (ASCALE * ASCALE));
    }
  }
}

__device__ __forceinline__ void lrufix_item(const Params& p, int l, int item) {
  unsigned char* ws = p.ws;
  const int lane = tidx() & 63, wave = tidx() >> 6;
  const int b = item >> 7, ck = item & 127;
  const h16* P = (const h16*)(ws + OFF_P16);
  const float4 cy = *(const float4*)((const float*)(ws + OFF_CARRY) + (size_t)(b * 128 + ck) * 256 + lane * 4);
  const float4 gn = *(const float4*)(p.in[I_ONG] + l * 1024 + lane * 4);
  h16* yc = (h16*)(ws + OFF_H16);
  for (int tt = wave * 8; tt < wave * 8 + 8; ++tt) {
    const size_t row = (size_t)(b * S + ck * 64 + tt);
    const float4 hl = *(const float4*)((const float*)(ws + OFF_LRUH) + row * 256 + lane * 4);
    const float4 al = *(const float4*)((const float*)(ws + OFF_LRUA) + row * 256 + lane * 4);
    const h16x4 gl = *(const h16x4*)(P + row * NIN + C_GL + lane * 4);
    const float y0 = (hl.x + al.x * cy.x) * gelu_tanh((float)gl[0]);
    const float y1 = (hl.y + al.y * cy.y) * gelu_tanh((float)gl[1]);
    const float y2 = (hl.z + al.z * cy.z) * gelu_tanh((float)gl[2]);
    const float y3 = (hl.w + al.w * cy.w) * gelu_tanh((float)gl[3]);
    const float rstd = rsqrtf(wsum(y0 * y0 + y1 * y1 + y2 * y2 + y3 * y3) * (1.f / 256.f) + EPS);
    *(h16x4*)(yc + row * D + 512 + lane * 4) = pack4(y0 * rstd * gn.x, y1 * rstd * gn.y, y2 * rstd * gn.z, y3 * rstd * gn.w);
  }
}

__device__ __forceinline__ void phase_attn(const Params& p, int l, float* sm) {
  for (int it = blockIdx.x; it < 256; it += gridDim.x) {
#pragma unroll 1
    for (int rep = 0; rep < 2; ++rep) attn_item(p, l, rep ? 511 - it : it, sm);
  }
  for (int it = blockIdx.x; it < 256; it += gridDim.x) lrufix_item(p, l, it);
}

__device__ __forceinline__ void phase_outproj(const Params& p, int l, h16* sm) {
  unsigned char* ws = p.ws;
  const h16* A = (const h16*)(ws + OFF_H16);
  const h16* W = (const h16*)(ws + OFF_WOUT);
  const float* mod = (const float*)(ws + OFF_MOD);
  float* xa = (float*)(ws + OFF_XA);
  const float* xin = l == 0 ? p.in[I_X] : (const float*)xa;
  for (int t = blockIdx.x; t < 64 * 4; t += gridDim.x) {
    const int mt = t >> 2, nt = t & 3;
    f32x4 acc[8][4];
    const h16* Ab = A + (size_t)mt * 256 * D;
    {
      float* sct = (float*)((unsigned char*)sm + SCHED_OFF - 1024);
      const int tq_ = tidx();
      if (tq_ < 256) {
        const float2 q2 = *(const float2*)((const float*)(ws + OFF_SSQ) + (size_t)(mt * 256 + tq_) * 2);
        sct[tq_] = rsqrtf((q2.x + q2.y) * (1.f / 512.f) + EPS) * (1.f / ASCALE);
      }
    }
    gemm_mainloop(acc, [&](int r) { return Ab + (size_t)r * D; }, W + (size_t)nt * 256 * D, D, 16, sm);
    const int tid_e = tidx(), lane = tid_e & 63, wave = tid_e >> 6, wr = wave >> 2, wc = wave & 3, fr = lane & 15, fq = lane >> 4;
    {
      const float* sct = (const float*)((const unsigned char*)sm + SCHED_OFF - 1024) + wr * 128 + fr;
#pragma unroll
      for (int m = 0; m < 8; ++m) {
        const float sc = sct[m * 16];
#pragma unroll
        for (int n = 0; n < 4; ++n) acc[m][n] *= sc;
      }
    }
    gemm_mainloop(acc, [&](int r) { return Ab + (size_t)r * D + 512; }, W + (size_t)nt * 256 * D + 512, D, 16, sm, false);
#pragma unroll
    for (int m = 0; m < 8; ++m)
#pragma unroll
      for (int n = 0; n < 4; ++n) {
        const int row = mt * 256 + wr * 128 + m * 16 + fr, col = nt * 256 + wc * 64 + n * 16 + 4 * fq;
        const int b = row >> 13;
        const float4 g1 = *(const float4*)(mod + (size_t)(l * 2 + b) * 6144 + 2048 + col);
        const float4 xv = *(const float4*)(xin + (size_t)row * D + col);
        float4 o;
        o.x = xv.x + g1.x * acc[m][n][0]; o.y = xv.y + g1.y * acc[m][n][1]; o.z = xv.z + g1.z * acc[m][n][2]; o.w = xv.w + g1.w * acc[m][n][3];
        *(float4*)(xa + (size_t)row * D + col) = o;
      }
  }
}

__device__ __forceinline__ void phase_router(const Params& p, int l, int* smi) {
  unsigned char* ws = p.ws;
  const int tid = tidx(), lane = tid & 63, wave = tid >> 6;
  const float* mod = (const float*)(ws + OFF_MOD);
  const float* xa = (const float*)(ws + OFF_XA);
  h16* hout = (h16*)(ws + OFF_H16);
  unsigned* cnt = (unsigned*)(ws + OFF_CTL) + 64 + l * 16;
  int* list = (int*)(ws + OFF_LIST);
  float* wpair = (float*)(ws + OFF_WPAIR);
  const float* rgw = p.in[I_RGW] + (size_t)l * 1024 * 4;
  const float* rgb = p.in[I_RGB] + l * 4;
  int* cntl = smi;
  int* basel = smi + 16;
  int* tok = smi + 32;
  for (int chunk = blockIdx.x; chunk < T / 64; chunk += gridDim.x) {
    if (tid < 16) cntl[tid] = 0;
    __syncthreads();
    for (int ti = wave; ti < 64; ti += NW) {
      const int row = chunk * 64 + ti;
      const int b = row >> 13;
      float4 x[4];
      float ss = 0.f;
#pragma unroll
      for (int i = 0; i < 4; ++i) {
        x[i] = *(const float4*)(xa + (size_t)row * D + lane * 4 + 256 * i);
        ss += x[i].x * x[i].x + x[i].y * x[i].y + x[i].z * x[i].z + x[i].w * x[i].w;
      }
      ss = wsum(ss);
      const float rstd = rsqrtf(ss * (1.f / D) + EPS);
      float lg0 = 0.f, lg1 = 0.f, lg2 = 0.f, lg3 = 0.f;
#pragma unroll
      for (int i = 0; i < 4; ++i) {
        const int col = lane * 4 + 256 * i;
        const float4 g = *(const float4*)(p.in[I_N2G] + l * D + col);
        const float4 sh = *(const float4*)(mod + (size_t)(l * 2 + b) * 6144 + 3072 + col);
        const float4 sc = *(const float4*)(mod + (size_t)(l * 2 + b) * 6144 + 4096 + col);
        x[i].x = x[i].x * rstd * g.x * (1.f + sc.x) + sh.x;
        x[i].y = x[i].y * rstd * g.y * (1.f + sc.y) + sh.y;
        x[i].z = x[i].z * rstd * g.z * (1.f + sc.z) + sh.z;
        x[i].w = x[i].w * rstd * g.w * (1.f + sc.w) + sh.w;
        *(h16x4*)(hout + (size_t)row * D + col) = pack4(x[i].x, x[i].y, x[i].z, x[i].w);
        const float4 w0 = *(const float4*)(rgw + (size_t)(col + 0) * 4), w1 = *(const float4*)(rgw + (size_t)(col + 1) * 4);
        const float4 w2 = *(const float4*)(rgw + (size_t)(col + 2) * 4), w3 = *(const float4*)(rgw + (size_t)(col + 3) * 4);
        lg0 += x[i].x * w0.x + x[i].y * w1.x + x[i].z * w2.x + x[i].w * w3.x;
        lg1 += x[i].x * w0.y + x[i].y * w1.y + x[i].z * w2.y + x[i].w * w3.y;
        lg2 += x[i].x * w0.z + x[i].y * w1.z + x[i].z * w2.z + x[i].w * w3.z;
        lg3 += x[i].x * w0.w + x[i].y * w1.w + x[i].z * w2.w + x[i].w * w3.w;
      }
      lg0 = wsum(lg0) + rgb[0]; lg1 = wsum(lg1) + rgb[1]; lg2 = wsum(lg2) + rgb[2]; lg3 = wsum(lg3) + rgb[3];
      int gs = 0; float gm = lg0;
      if (lg1 > gm) { gm = lg1; gs = 1; }
      if (lg2 > gm) { gm = lg2; gs = 2; }
      if (lg3 > gm) { gm = lg3; gs = 3; }
      const float pg = 1.f / (__expf(lg0 - gm) + __expf(lg1 - gm) + __expf(lg2 - gm) + __expf(lg3 - gm));
      const float* rew = p.in[I_REW] + ((size_t)(l * 4 + gs) * 1024) * 4;
      const float* reb = p.in[I_REB] + (l * 4 + gs) * 4;
      float e0 = 0.f, e1 = 0.f, e2 = 0.f, e3 = 0.f;
#pragma unroll
      for (int i = 0; i < 4; ++i) {
        const int col = lane * 4 + 256 * i;
        const float4 w0 = *(const float4*)(rew + (size_t)(col + 0) * 4), w1 = *(const float4*)(rew + (size_t)(col + 1) * 4);
        const float4 w2 = *(const float4*)(rew + (size_t)(col + 2) * 4), w3 = *(const float4*)(rew + (size_t)(col + 3) * 4);
        e0 += x[i].x * w0.x + x[i].y * w1.x + x[i].z * w2.x + x[i].w * w3.x;
        e1 += x[i].x * w0.y + x[i].y * w1.y + x[i].z * w2.y + x[i].w * w3.y;
        e2 += x[i].x * w0.z + x[i].y * w1.z + x[i].z * w2.z + x[i].w * w3.z;
        e3 += x[i].x * w0.w + x[i].y * w1.w + x[i].z * w2.w + x[i].w * w3.w;
      }
      float le[4];
      le[0] = wsum(e0) + reb[0]; le[1] = wsum(e1) + reb[1]; le[2] = wsum(e2) + reb[2]; le[3] = wsum(e3) + reb[3];
      int i0 = 0; float v0 = le[0];
      if (le[1] > v0) { v0 = le[1]; i0 = 1; }
      if (le[2] > v0) { v0 = le[2]; i0 = 2; }
      if (le[3] > v0) { v0 = le[3]; i0 = 3; }
      int i1 = -1; float v1 = -3.0e38f;
#pragma unroll
      for (int j = 0; j < 4; ++j) {
        const float vj = (j == 0 ? le[0] : j == 1 ? le[1] : j == 2 ? le[2] : le[3]);
        if (j != i0 && vj > v1) { v1 = vj; i1 = j; }
      }
      const float p0 = 1.f / (1.f + __expf(v1 - v0));
      const float p1 = 1.f - p0;
      if (lane == 0) {
        const int ea = gs * 4 + i0, eb = gs * 4 + i1;
        const int ra = atomicAdd(&cntl[ea], 1);
        const int rb = atomicAdd(&cntl[eb], 1);
        tok[ti * 2] = ea | (ra << 8);
        tok[ti * 2 + 1] = eb | (rb << 8);
        wpair[row * 2] = pg * p0;
        wpair[row * 2 + 1] = pg * p1;
      }
    }
    __syncthreads();
    if (tid < 16) basel[tid] = (int)atomicAdd(&cnt[tid], (unsigned)cntl[tid]);
    __syncthreads();
    if (tid < 128) {
      const int v = tok[tid], e = v & 255, r = v >> 8;
      list[(size_t)e * 16384 + basel[e] + r] = (chunk * 64 + (tid >> 1)) * 2 + (tid & 1);
    }
    __syncthreads();
  }
}

__device__ __forceinline__ void moe_sched(const Params& p, int l, int* sl) {
  if (tidx() == 0) {
    const unsigned* cnt = (const unsigned*)(p.ws + OFF_CTL) + 64 + l * 16;
    int to = 0, ro = 0;
    sl[16] = 0; sl[33] = 0;
    for (int e = 0; e < 16; ++e) {
      const int c = (int)__hip_atomic_load(&cnt[e], __ATOMIC_RELAXED, __HIP_MEMORY_SCOPE_AGENT);
      sl[e] = c;
      to += (c + 255) >> 8; ro += c;
      sl[17 + e] = to; sl[34 + e] = ro;
    }
  }
  __syncthreads();
}
__device__ __forceinline__ void moe_tile(const int* sl, int t, int& e, int& nt, int& mt, int& cnt_e, int& roff_e) {
  int ee = 0;
  for (int k = 0; k < 15; ++k) ee += (t >= sl[17 + k] * 4) ? 1 : 0;
  ee = __builtin_amdgcn_readfirstlane(ee);
  const int t0 = __builtin_amdgcn_readfirstlane(sl[16 + ee]), t1 = __builtin_amdgcn_readfirstlane(sl[17 + ee]);
  const int nte = t1 - t0, rem = t - t0 * 4;
  e = ee; nt = rem / nte; mt = rem % nte;
  cnt_e = __builtin_amdgcn_readfirstlane(sl[ee]);
  roff_e = __builtin_amdgcn_readfirstlane(sl[33 + ee]);
}

__device__ __forceinline__ void phase_moe1(const Params& p, int l, h16* sm) {
  unsigned char* ws = p.ws;
  int* sl = (int*)((unsigned char*)sm + SCHED_OFF);
  moe_sched(p, l, sl);
  const h16* H = (const h16*)(ws + OFF_H16);
  const int* list = (const int*)(ws + OFF_LIST);
  h16* hid = (h16*)(ws + OFF_HID);
  const int total = __builtin_amdgcn_readfirstlane(sl[32]) * 4;
  for (int t = blockIdx.x; t < total; t += gridDim.x) {
    int e, nt, mt, cnt_e, roff_e;
    moe_tile(sl, t, e, nt, mt, cnt_e, roff_e);
    const int* le = list + (size_t)e * 16384;
    f32x4 acc[8][4];
    gemm_mainloop(acc, [&](int r) { int so = mt * 256 + r; so = so < cnt_e ? so : 0; return H + (size_t)(le[so] >> 1) * D; },
                  (const h16*)(ws + OFF_WGU) + ((size_t)e * 1024 + nt * 256) * 1024, 1024, 32, sm);
    const int tid_e = tidx(), lane = tid_e & 63, wave = tid_e >> 6, wr = wave >> 2, wc = wave & 3, fr = lane & 15, fq = lane >> 4;
#pragma unroll
    for (int m = 0; m < 8; ++m) {
      const int so = mt * 256 + wr * 128 + m * 16 + fr;
      if (so < cnt_e) {
#pragma unroll
        for (int n2 = 0; n2 < 2; ++n2) {
          const f32x4 gt = acc[m][2 * n2], up = acc[m][2 * n2 + 1];
          const int col = nt * 128 + wc * 32 + n2 * 16 + 4 * fq;
          *(h16x4*)(hid + (size_t)(roff_e + so) * 512 + col) = pack4(silu_f(gt[0]) * up[0], silu_f(gt[1]) * up[1], silu_f(gt[2]) * up[2], silu_f(gt[3]) * up[3]);
        }
      }
    }
  }
}

__device__ __forceinline__ void phase_moe2(const Params& p, int l, h16* sm) {
  unsigned char* ws = p.ws;
  int* sl = (int*)((unsigned char*)sm + SCHED_OFF);
  moe_sched(p, l, sl);
  const int* list = (const int*)(ws + OFF_LIST);
  const float* wpair = (const float*)(ws + OFF_WPAIR);
  const h16* hid = (const h16*)(ws + OFF_HID);
  h16* yp = (h16*)(ws + OFF_YPAIR);
  const int total = __builtin_amdgcn_readfirstlane(sl[32]) * 4;
  for (int t = blockIdx.x; t < total; t += gridDim.x) {
    int e, nt, mt, cnt_e, roff_e;
    moe_tile(sl, t, e, nt, mt, cnt_e, roff_e);
    const int* le = list + (size_t)e * 16384;
    const h16* Ab = hid + (size_t)(roff_e + mt * 256) * 512;
    f32x4 acc[8][4];
    gemm_mainloop(acc, [&](int r) { return Ab + (size_t)r * 512; }, (const h16*)(ws + OFF_WDN) + ((size_t)e * 1024 + nt * 256) * 512, 512, 16, sm);
    const int tid_e = tidx(), lane = tid_e & 63, wave = tid_e >> 6, wr = wave >> 2, wc = wave & 3, fr = lane & 15, fq = lane >> 4;
#pragma unroll
    for (int m = 0; m < 8; ++m) {
      const int so = mt * 256 + wr * 128 + m * 16 + fr;
      if (so < cnt_e) {
        const int pair = le[so];
        const float w = wpair[pair];
#pragma unroll
        for (int n = 0; n < 4; ++n) {
          const int col = nt * 256 + wc * 64 + n * 16 + 4 * fq;
          *(h16x4*)(yp + (size_t)pair * D + col) = pack4(acc[m][n][0] * w, acc[m][n][1] * w, acc[m][n][2] * w, acc[m][n][3] * w);
        }
      }
    }
  }
}

#define XB_TMO      128
#define XB_XCNT(j)  (256  + 64 * (j))
#define XB_XSUB(j)  (1280 + 64 * (j))
#define XB_XGEN(j)  (2304 + 64 * (j))
#define XB_TOP      3328
#define XB_TOPGEN   3392
#define XCD_BAR_WORDS 3456
#define XB_SPIN_CAP (1u << 20)
__device__ __forceinline__ unsigned xb_ld(unsigned* p) { return __hip_atomic_load(p, __ATOMIC_RELAXED, __HIP_MEMORY_SCOPE_AGENT); }
__device__ __forceinline__ unsigned xb_add(unsigned* p, unsigned v) { return __hip_atomic_fetch_add(p, v, __ATOMIC_RELAXED, __HIP_MEMORY_SCOPE_AGENT); }
__device__ __forceinline__ unsigned xb_xcc_id() { return (unsigned)__builtin_amdgcn_s_getreg((3 << 11) | 20) & 0xFu; }
#define XB_SPIN(cond, bar) do { unsigned _sp = 0; while (cond) { __builtin_amdgcn_s_sleep(1); \
    if ((++_sp & 255u) == 0u) { if (xb_ld(&(bar)[XB_TMO])) break; if (_sp > XB_SPIN_CAP) { atomicAdd(&(bar)[XB_TMO], 1u); break; } } } } while (0)
struct XBar { unsigned* bar; unsigned x; volatile unsigned* st; };
__device__ __forceinline__ void xbar_post(XBar& b, unsigned* bar, volatile unsigned* st) {
  b.bar = bar; b.x = xb_xcc_id(); b.st = st;
  if (tidx() == 0) { st[0] = 0u; st[1] = 0u; (void)xb_add(&bar[XB_XCNT(b.x)], 1u); }
}
__device__ __forceinline__ void xbar_census(unsigned* bar, unsigned x, unsigned& nloc, unsigned& nx) {
  const unsigned G = gridDim.x;
  unsigned sum, cnt, mine, sp = 0u;
  for (;;) {
    sum = 0u; cnt = 0u; mine = 0u;
#pragma unroll
    for (unsigned j = 0; j < 16; ++j) { const unsigned c = xb_ld(&bar[XB_XCNT(j)]); sum += c; cnt += (c > 0u) ? 1u : 0u; mine = (j == x) ? c : mine; }
    if (sum == G) break;
    __builtin_amdgcn_s_sleep(1);
    if ((++sp & 255u) == 0u) { if (xb_ld(&bar[XB_TMO])) break; if (sp > XB_SPIN_CAP) { atomicAdd(&bar[XB_TMO], 1u); break; } }
  }
  nloc = mine > 0u ? mine : 1u; nx = cnt > 0u ? cnt : 1u;
}
__device__ __forceinline__ void xbar_sync(XBar& b) {
  asm volatile("s_waitcnt vmcnt(0)" ::: "memory");
  __syncthreads();
  if (tidx() == 0) {
    unsigned* bar = b.bar;
    __builtin_amdgcn_s_waitcnt(0);
    unsigned nloc = b.st[0], nx = b.st[1];
    if (nloc == 0u) { xbar_census(bar, b.x, nloc, nx); b.st[0] = nloc; b.st[1] = nx; }
    const unsigned old = xb_add(&bar[XB_XSUB(b.x)], 1u);
    const unsigned gen = old / nloc;
    if (old + 1u == (gen + 1u) * nloc) {
      __builtin_amdgcn_fence(__ATOMIC_RELEASE, "agent");
      asm volatile("s_waitcnt vmcnt(0)" ::: "memory");
      const unsigned og = xb_add(&bar[XB_TOP], 1u);
      const unsigned tg = og / nx;
      if (og + 1u == (tg + 1u) * nx) xb_add(&bar[XB_TOPGEN], 1u);
      else XB_SPIN(xb_ld(&bar[XB_TOPGEN]) == tg, bar);
      __builtin_amdgcn_fence(__ATOMIC_ACQUIRE, "agent");
      xb_add(&bar[XB_XGEN(b.x)], 1u);
      asm volatile("s_waitcnt vmcnt(0)" ::: "memory");
    } else {
      XB_SPIN(xb_ld(&bar[XB_XGEN(b.x)]) == gen, bar);
      __builtin_amdgcn_fence(__ATOMIC_ACQUIRE, "agent");
      asm volatile("s_waitcnt vmcnt(0)" ::: "memory");
    }
  }
  __syncthreads();
}

constexpr int NSTEPS = 22;
#define STEP(k, body) do { if (s_lo <= (k) && (k) < s_hi) { body; if ((k) + 1 < s_hi) { if ((k) == 0) grid.sync(); else xbar_sync(xb); } \
    if (PROBE_MASK != 0u) { unsigned long long now_ = __builtin_amdgcn_s_memrealtime(); \
      if ((PROBE_MASK >> (k)) & 1u) { const unsigned long long w_ = (now_ - pt_prev) * PROBE_AMP; \
        while (__builtin_amdgcn_s_memrealtime() - now_ < w_) __builtin_amdgcn_s_sleep(8); now_ = __builtin_amdgcn_s_memrealtime(); } \
      pt_prev = now_; } } } while (0)
#define LAYER_STEPS(l, base) \
  STEP(base + 0, phase_norm1(p, l); if (l == 1) phase_convert(p, 1, (float*)smem)); \
  STEP(base + 1, phase_inproj(p, (h16*)smem)); \
  STEP(base + 2, phase_post(p)); \
  STEP(base + 3, phase_mixa(p, l, smem)); \
  STEP(base + 4, phase_mixb(p, l)); \
  STEP(base + 5, phase_attn(p, l, (float*)smem)); \
  STEP(base + 6, phase_outproj(p, l, (h16*)smem)); \
  STEP(base + 7, phase_router(p, l, (int*)smem)); \
  STEP(base + 8, phase_moe1(p, l, (h16*)smem)); \
  STEP(base + 9, phase_moe2(p, l, (h16*)smem))

__global__ void __launch_bounds__(NTHREADS, 2) mega(Params p, int s_lo, int s_hi) {
  extern __shared__ __attribute__((aligned(16))) unsigned char smem[];
  cg::grid_group grid = cg::this_grid();
  unsigned long long pt_prev = PROBE_MASK != 0u ? __builtin_amdgcn_s_memrealtime() : 0ull;
  XBar xb;
  xbar_post(xb, (unsigned*)(p.ws + OFF_BAR), (volatile unsigned*)(smem + LDS_BYTES - 16));
  STEP(0, phase_prep(p, (float*)smem); phase_convert(p, 0, (float*)smem));
  LAYER_STEPS(0, 1);
  LAYER_STEPS(1, 11);
  STEP(21, phase_norm1(p, 2));
}

extern "C" void kernel_launch(void* const* d_in, const int* in_sizes, int n_in, void* d_out, int out_size, void* d_ws, size_t ws_size,
                              hipStream_t stream) {
  static int grid_blocks = 0;
  if (!grid_blocks) {
    if (n_in != 35 || out_size != T * D || ws_size < WS_TOTAL) {
      fprintf(stderr, "kernel_launch: unexpected problem (n_in %d, out %d, ws %zu < %zu)\n", n_in, out_size, ws_size, (size_t)WS_TOTAL);
      grid_blocks = -1;
      return;
    }
    int dev = 0, cus = 0, per_cu = 0;
    hipGetDevice(&dev);
    hipDeviceGetAttribute(&cus, hipDeviceAttributeMultiprocessorCount, dev);
    if (hipFuncSetAttribute((const void*)mega, hipFuncAttributeMaxDynamicSharedMemorySize, LDS_BYTES) != hipSuccess) {
      fprintf(stderr, "kernel_launch: hipFuncSetAttribute(%d B dynamic LDS) failed\n", LDS_BYTES);
      grid_blocks = -1;
      return;
    }
    hipOccupancyMaxActiveBlocksPerMultiprocessor(&per_cu, mega, NTHREADS, LDS_BYTES);
    if (per_cu > 1) per_cu = 1;
    if (per_cu < 1) { fprintf(stderr, "kernel_launch: occupancy query returned %d\n", per_cu); grid_blocks = -1; return; }
    grid_blocks = cus * per_cu;
  }
  if (grid_blocks < 0) return;
  Params p{};
  for (int i = 0; i < 35; ++i) p.in[i] = (const float*)d_in[i];
  p.out = (float*)d_out;
  p.ws = (unsigned char*)d_ws;
  for (int i = 0; i < 32; ++i) p.inv_freq[i] = std::pow(10000.0, -(double)(2 * i) / 64.0);
  if (hipMemsetAsync((char*)d_ws + OFF_BAR, 0, 16384, stream) != hipSuccess) { fprintf(stderr, "kernel_launch: memset of barrier words failed\n"); return; }
#if MEGA
  int lo = 0, hi = NSTEPS;
  void* args[] = {&p, &lo, &hi};
  hipError_t e = hipLaunchCooperativeKernel((void*)mega, dim3(grid_blocks), dim3(NTHREADS), args, LDS_BYTES, stream);
  if (e != hipSuccess) fprintf(stderr, "cooperative launch failed: %s (grid %d)\n", hipGetErrorString(e), grid_blocks);
#else
  for (int s = 0; s < NSTEPS; ++s) {
    int lo = s, hi = s + 1;
    void* args[] = {&p, &lo, &hi};
    hipError_t e = hipLaunchCooperativeKernel((void*)mega, dim3(grid_blocks), dim3(NTHREADS), args, LDS_BYTES, stream);
    if (e != hipSuccess) { fprintf(stderr, "launch %d failed: %s (grid %d)\n", s, hipGetErrorString(e), grid_blocks); break; }
  }
#endif
}
```

```cpp
#include <hip/hip_runtime.h>
#include <hip/hip_cooperative_groups.h>
#include <cstdio>
#include <cstdint>
#include <cmath>
namespace cg = cooperative_groups;

#ifndef MEGA
#define MEGA 1
#endif
#ifndef PROBE_MASK
#define PROBE_MASK 0u
#define PROBE_AMP 3
#endif

typedef _Float16 h16;
typedef _Float16 h16x8 __attribute__((ext_vector_type(8)));
typedef _Float16 h16x4 __attribute__((ext_vector_type(4)));
typedef float f32x4 __attribute__((ext_vector_type(4)));

constexpr int NB = 2, S = 8192, T = NB * S, D = 1024;
constexpr int NIN = 2432;
constexpr int NINSRC = 2328;
constexpr int C_XL = 0, C_GL = 256, C_Q = 512, C_KC = 1024, C_VC = 1152, C_KS = 1280, C_VS = 1408, C_KW = 1536, C_VW = 1664,
              C_CVA = 1792, C_CVB = 2048, C_GATE = 2304;
constexpr float EPS = 1e-6f;
constexpr int NTHREADS = 512, NW = 8;
constexpr int LDS_BYTES = 147456;
constexpr int NINP = 2560;
constexpr int SCHED_OFF = LDS_BYTES - 1024;
constexpr float ASCALE = 16.f;

constexpr size_t al256(size_t x) { return (x + 255) & ~(size_t)255; }
constexpr size_t OFF_CTL = 0;
constexpr size_t OFF_BAR = 4096;
constexpr size_t OFF_MOD = 4096 + 16384;
constexpr size_t OFF_ROPE = al256(OFF_MOD + 2 * 2 * 6144 * 4);
constexpr size_t OFF_PB = al256(OFF_ROPE + (size_t)T * 64 * 4);
constexpr size_t OFF_PBPART = al256(OFF_PB + 2 * 256 * 4);
constexpr size_t OFF_GATES = al256(OFF_PBPART + 2 * 32 * 256 * 4);
constexpr size_t OFF_WIN = al256(OFF_GATES + (size_t)T * 24 * 4);
constexpr size_t OFF_WOUT = al256(OFF_WIN + (size_t)NINP * 1024 * 2);
constexpr size_t OFF_WGU = al256(OFF_WOUT + (size_t)1024 * 1024 * 2);
constexpr size_t OFF_WDN = al256(OFF_WGU + (size_t)16 * 1024 * 1024 * 2);
constexpr size_t OFF_W1K = al256(OFF_WDN + (size_t)16 * 1024 * 512 * 2);
constexpr size_t OFF_W1V = al256(OFF_W1K + (size_t)256 * 2048 * 2);
constexpr size_t OFF_H16 = al256(OFF_W1V + (size_t)256 * 2048 * 2);
constexpr size_t OFF_Q16 = al256(OFF_H16 + (size_t)T * 1024 * 2);
constexpr size_t KVSZ = (size_t)T * 128 * 2;
constexpr size_t OFF_KC = al256(OFF_Q16 + (size_t)T * 512 * 2);
constexpr size_t OFF_VC = al256(OFF_KC + KVSZ + 4096);
constexpr size_t OFF_KS = al256(OFF_VC + KVSZ + 4096);
constexpr size_t OFF_VST = al256(OFF_KS + KVSZ);
constexpr size_t OFF_KW = al256(OFF_VST + KVSZ);
constexpr size_t OFF_VWT = al256(OFF_KW + KVSZ);
constexpr size_t OFF_HIDC = al256(OFF_VWT + KVSZ);
constexpr size_t OFF_KCMP = al256(OFF_HIDC + (size_t)2 * 2048 * 256 * 2);
constexpr size_t OFF_VCMPT = al256(OFF_KCMP + (size_t)4 * 512 * 64 * 2);
constexpr size_t OFF_LRUH = al256(OFF_VCMPT + (size_t)4 * 512 * 64 * 2);
constexpr size_t OFF_LRUA = al256(OFF_LRUH + (size_t)T * 256 * 4);
constexpr size_t OFF_HEND = al256(OFF_LRUA + (size_t)T * 256 * 4);
constexpr size_t OFF_AEND = al256(OFF_HEND + 2 * 128 * 256 * 4);
constexpr size_t OFF_CARRY = al256(OFF_AEND + 2 * 128 * 256 * 4);
constexpr size_t OFF_XA = al256(OFF_CARRY + 2 * 128 * 256 * 4);
constexpr size_t OFF_LIST = al256(OFF_XA + (size_t)T * 1024 * 4);
constexpr size_t OFF_WPAIR = al256(OFF_LIST + (size_t)16 * 16384 * 4);
constexpr size_t OFF_SSQ = al256(OFF_WPAIR + 32768 * 4);
constexpr size_t OFF_R = al256(OFF_SSQ + (size_t)T * 2 * 4);
constexpr size_t OFF_P16 = OFF_R;
constexpr size_t OFF_HID = OFF_R;
constexpr size_t OFF_YPAIR = al256(OFF_HID + (size_t)(32768 + 512) * 512 * 2);
constexpr size_t OFF_HIDP = al256(OFF_P16 + (size_t)T * NIN * 2);
constexpr size_t R_END1 = OFF_HIDP + (size_t)4 * 2 * 2048 * 256 * 4;
constexpr size_t R_END2 = OFF_YPAIR + (size_t)32768 * 1024 * 2;
constexpr size_t WS_TOTAL = al256(R_END1 > R_END2 ? R_END1 : R_END2);

struct Params {
  const float* in[35];
  float* out;
  unsigned char* ws;
  double inv_freq[32];
};
enum { I_X = 0, I_C, I_POS, I_ADAW, I_ADAB, I_N1G, I_N2G, I_WIN, I_LCW, I_LCB, I_LWA, I_LBA, I_LWX, I_LBX, I_LLAM, I_CKW1, I_CKW2,
       I_CVW1, I_CVW2, I_CPK, I_CPV, I_DWW, I_DWB, I_LNG, I_LNB, I_ONG, I_WOUT, I_RGW, I_RGB, I_REW, I_REB, I_MG, I_MU, I_MD, I_FNG };

__device__ __forceinline__ int tidx() { int t = threadIdx.x; asm volatile("" : "+v"(t)); return t; }
__device__ __forceinline__ float wsum(float v) {
#pragma unroll
  for (int o = 32; o > 0; o >>= 1) v += __shfl_xor(v, o);
  return v;
}
__device__ __forceinline__ float sigm(float x) { return 1.f / (1.f + __expf(-x)); }
__device__ __forceinline__ float silu_f(float x) { return x / (1.f + __expf(-x)); }
__device__ __forceinline__ float gelu_tanh(float x) {
  float u = 0.7978845608028654f * (x + 0.044715f * x * x * x);
  float e = __expf(2.f * u);
  float t = 1.f - 2.f / (e + 1.f);
  return 0.5f * x * (1.f + t);
}
__device__ __forceinline__ void glds16(const h16* g, h16* l) {
  __builtin_amdgcn_global_load_lds((const unsigned*)g, (unsigned*)l, 16, 0, 0);
}
__device__ __forceinline__ h16x4 pack4(float a, float b, float c, float d) {
  h16x4 r; r[0] = (h16)a; r[1] = (h16)b; r[2] = (h16)c; r[3] = (h16)d; return r;
}

struct TileIter { int cur, end, step; };
__device__ __forceinline__ TileIter xcd_tiles(int ntiles) {
  const int G = gridDim.x, b = blockIdx.x;
  TileIter it;
  if ((G & 7) == 0) {
    const int x = b & 7;
    it.cur = (int)(((long)ntiles * x) >> 3) + (b >> 3);
    it.end = (int)(((long)ntiles * (x + 1)) >> 3);
    it.step = G >> 3;
  } else { it.cur = b; it.end = ntiles; it.step = G; }
  return it;
}

#define VMCNT(n) asm volatile("s_waitcnt vmcnt(" #n ")" ::: "memory")
template <class ARowFn>
__device__ __forceinline__ void gemm_mainloop(f32x4 (&acc)[8][4], ARowFn arow, const h16* __restrict__ Bt, int ldb, int nk, h16* sm, bool zero_init = true) {
  const int tid = tidx(), lane = tid & 63, wave = tid >> 6;
  const int wr = wave >> 2, wc = wave & 3, fr = lane & 15, fq = lane >> 4;
  const h16* ap[4];
  const h16* bp[4];
#pragma unroll
  for (int i = 0; i < 4; ++i) {
    const int r = (i * 8 + wave) * 8 + (lane >> 3);
    const int c = (lane & 7) ^ ((r >> 1) & 7);
    ap[i] = arow(r) + c * 8;
    bp[i] = Bt + (size_t)r * ldb + c * 8;
  }
  if (zero_init) {
#pragma unroll
    for (int m = 0; m < 8; ++m)
#pragma unroll
      for (int n = 0; n < 4; ++n) acc[m][n] = (f32x4){0.f, 0.f, 0.f, 0.f};
  }
  h16* const dA = sm + wave * 512 + lane * 8;
#pragma unroll
  for (int i = 0; i < 4; ++i) { glds16(ap[i], dA + i * 4096); glds16(bp[i], dA + 16384 + i * 4096); ap[i] += 64; bp[i] += 64; }
  const int sw = (fr >> 1) & 7;
  const int aoff = (wr * 128 + fr) * 64, boff = 16384 + (wc * 64 + fr) * 64;
#define SCHED_FENCE() __builtin_amdgcn_sched_barrier(0)
  for (int kt = 0; kt < nk; ++kt) {
    VMCNT(0);
    __builtin_amdgcn_s_barrier();
    const h16* st = sm + (kt & 1) * 32768;
    const bool more = kt + 1 < nk;
    h16* const dn = dA + ((kt + 1) & 1) * 32768;
#pragma unroll
    for (int ks = 0; ks < 2; ++ks) {
      const int ch = ((ks * 4 + fq) ^ sw) * 8;
      h16x8 bf[4];
#pragma unroll
      for (int n = 0; n < 4; ++n) bf[n] = *(const h16x8*)(st + boff + n * 1024 + ch);
#pragma unroll
      for (int mh = 0; mh < 2; ++mh) {
        h16x8 af[4];
#pragma unroll
        for (int m = 0; m < 4; ++m) af[m] = *(const h16x8*)(st + aoff + (mh * 4 + m) * 1024 + ch);
#pragma unroll
        for (int m = 0; m < 4; ++m) {
#pragma unroll
          for (int n = 0; n < 4; ++n) acc[mh * 4 + m][n] = __builtin_amdgcn_mfma_f32_16x16x32_f16(bf[n], af[m], acc[mh * 4 + m][n], 0, 0, 0);
          if (m == 1 || m == 3) {
            const int q = ks * 4 + mh * 2 + (m >> 1);
            SCHED_FENCE();
            if (more) {
              if (q < 4) { glds16(ap[q & 3], dn + (q & 3) * 4096); ap[q & 3] += 64; }
              else { glds16(bp[q & 3], dn + 16384 + (q & 3) * 4096); bp[q & 3] += 64; }
            }
            SCHED_FENCE();
          }
        }
      }
    }
  }
#undef SCHED_FENCE
  __builtin_amdgcn_s_barrier();
}

__device__ __forceinline__ int map_row(int mode, int n) {
  if (mode == 1) return n < 1792 ? n : (n < 1816 ? n + 512 : n - 24);
  if (mode == 2) return 32 * (n >> 4) + (n & 15);
  if (mode == 3) return 32 * (n >> 4) + 16 + (n & 15);
  return n;
}
struct ConvTile { const float* src; h16* dst; int K, N, mode, k0, n0; const float* pos; float* pbp; };
__device__ __forceinline__ ConvTile conv_decode(const Params& p, int l, int t) {
  unsigned char* ws = p.ws;
  constexpr int T_WIN = 16 * 37, T_WOUT = 256, T_G = 16 * 128, T_W1 = 128;
  constexpr int E0 = T_WIN, E1 = E0 + T_WOUT, E2 = E1 + T_G, E3 = E2 + T_G, E4 = E3 + T_G, E5 = E4 + T_W1;
  ConvTile c;
  c.pos = nullptr; c.pbp = nullptr;
  int tk, tn;
  if (t < E0) {
    c.src = p.in[I_WIN] + (size_t)l * 1024 * NINSRC; c.K = 1024; c.N = NINSRC; c.dst = (h16*)(ws + OFF_WIN); c.mode = 1; tk = t / 37; tn = t % 37;
  } else if (t < E1) {
    const int u = t - E0;
    c.src = p.in[I_WOUT] + (size_t)l * 1024 * 1024; c.K = 1024; c.N = 1024; c.dst = (h16*)(ws + OFF_WOUT); c.mode = 4; tk = u >> 4; tn = u & 15;
  } else if (t < E3) {
    const int up = t >= E2;
    const int u = t - (up ? E2 : E1);
    const int e = u >> 7, v = u & 127;
    c.src = p.in[up ? I_MU : I_MG] + ((size_t)l * 16 + e) * 1024 * 512; c.K = 1024; c.N = 512; c.dst = (h16*)(ws + OFF_WGU) + (size_t)e * 1024 * 1024;
    c.mode = up ? 3 : 2; tk = v >> 3; tn = v & 7;
  } else if (t < E4) {
    const int u = t - E3;
    const int e = u >> 7, v = u & 127;
    c.src = p.in[I_MD] + ((size_t)l * 16 + e) * 512 * 1024; c.K = 512; c.N = 1024; c.dst = (h16*)(ws + OFF_WDN) + (size_t)e * 1024 * 512; c.mode = 0; tk = v >> 4; tn = v & 15;
  } else {
    const int vv = t >= E5;
    const int u = t - (vv ? E5 : E4);
    c.src = p.in[vv ? I_CVW1 : I_CKW1] + (size_t)l * 2048 * 256; c.K = 2048; c.N = 256; c.dst = (h16*)(ws + (vv ? OFF_W1V : OFF_W1K)); c.mode = 5; tk = u >> 2; tn = u & 3;
    c.pos = p.in[vv ? I_CPV : I_CPK] + (size_t)l * 2048 + tk * 64;
    c.pbp = (float*)(ws + OFF_PBPART) + (size_t)(vv * 32 + tk) * 256 + tn * 64;
  }
  c.k0 = tk * 64; c.n0 = tn * 64;
  return c;
}
__device__ __forceinline__ void conv_wave_tile(const ConvTile& c, float* smw, int lane) {
  float4 v[16];
#pragma unroll
  for (int i = 0; i < 16; ++i) {
    const int idx = i * 64 + lane;
    const int r = idx >> 4, c4 = (idx & 15) * 4;
    v[i] = make_float4(0.f, 0.f, 0.f, 0.f);
    if (c.n0 + c4 < c.N) v[i] = *(const float4*)(c.src + (size_t)(c.k0 + r) * c.N + c.n0 + c4);
  }
#pragma unroll
  for (int i = 0; i < 16; ++i) {
    const int idx = i * 64 + lane;
    const int r = idx >> 4, c4 = (idx & 15) * 4;
    float* d = smw + r * 65 + c4;
    d[0] = v[i].x; d[1] = v[i].y; d[2] = v[i].z; d[3] = v[i].w;
  }
  if (c.mode == 5) {
    float sacc = 0.f;
    for (int k = 0; k < 64; ++k) sacc += c.pos[k] * smw[k * 65 + lane];
    c.pbp[lane] = sacc;
  }
  const int k0d = c.mode == 4 ? (c.k0 < 256 ? c.k0 + 512 : (c.k0 < 768 ? c.k0 - 256 : c.k0)) : c.k0;
#pragma unroll
  for (int j = 0; j < 8; ++j) {
    const int ch = j * 64 + lane;
    const int n = ch >> 3, kc = ch & 7;
    if (c.n0 + n < c.N) {
      h16x8 o;
#pragma unroll
      for (int q = 0; q < 8; ++q) o[q] = (h16)smw[(kc * 8 + q) * 65 + n];
      *(h16x8*)(c.dst + (size_t)map_row(c.mode, c.n0 + n) * c.K + k0d + kc * 8) = o;
    }
  }
}

__device__ __forceinline__ void phase_convert(const Params& p, int l, float* sm) {
  unsigned char* ws = p.ws;
  constexpr int NT_CONV = 16 * 37 + 256 + 3 * 16 * 128 + 2 * 128;
  {
    const int tid = tidx(), lane = tid & 63, wave = tid >> 6;
    float* smw = sm + wave * 4160;
    for (int t = blockIdx.x * NW + wave; t < NT_CONV; t += gridDim.x * NW) {
      const ConvTile c = conv_decode(p, l, t);
      conv_wave_tile(c, smw, lane);
    }
    __syncthreads();
  }
  {
    h16x8 z = {0, 0, 0, 0, 0, 0, 0, 0};
    h16* w = (h16*)(ws + OFF_WIN) + (size_t)NINSRC * 1024;
    for (int i = blockIdx.x * NTHREADS + tidx(); i < (NINP - NINSRC) * 1024 / 8; i += gridDim.x * NTHREADS) *(h16x8*)(w + (size_t)i * 8) = z;
  }
}

__device__ __forceinline__ void phase_prep(const Params& p, float* sm) {
  unsigned char* ws = p.ws;
  const int tid = tidx();
  if (blockIdx.x == 0) {
    for (int i = tid; i < 1024; i += NTHREADS) ((unsigned*)(ws + OFF_CTL))[i] = 0u;
  }
  float* mod = (float*)(ws + OFF_MOD);
  for (int t = blockIdx.x; t < 384; t += gridDim.x) {
    const int l = t / 192, j0 = (t % 192) * 32;
    const int kg = tid >> 3, cq = tid & 7;
    const float* w = p.in[I_ADAW] + (size_t)l * 1024 * 6144 + j0 + 4 * cq;
    const float* c = p.in[I_C];
    float a0[4] = {0, 0, 0, 0}, a1[4] = {0, 0, 0, 0};
#pragma unroll 8
    for (int k = kg * 16; k < kg * 16 + 16; ++k) {
      const float4 wv = *(const float4*)(w + (size_t)k * 6144);
      const float s0 = silu_f(c[k]), s1 = silu_f(c[1024 + k]);
      a0[0] += s0 * wv.x; a0[1] += s0 * wv.y; a0[2] += s0 * wv.z; a0[3] += s0 * wv.w;
      a1[0] += s1 * wv.x; a1[1] += s1 * wv.y; a1[2] += s1 * wv.z; a1[3] += s1 * wv.w;
    }
    float* r = sm + (kg * 8 + cq) * 8;
#pragma unroll
    for (int i = 0; i < 4; ++i) { r[i] = a0[i]; r[4 + i] = a1[i]; }
    __syncthreads();
    if (tid < 64) {
      const int bb = tid >> 5, col = tid & 31, q = col >> 2, ci = col & 3;
      float s = 0.f;
      for (int g = 0; g < 64; ++g) s += sm[(g * 8 + q) * 8 + bb * 4 + ci];
      mod[(size_t)(l * 2 + bb) * 6144 + j0 + col] = s + p.in[I_ADAB][l * 6144 + j0 + col];
    }
    __syncthreads();
  }
  float* rc = (float*)(ws + OFF_ROPE);
  float* rs = rc + (size_t)T * 32;
  const int* pos = (const int*)p.in[I_POS];
  for (int i = blockIdx.x * NTHREADS + tid; i < T * 32; i += gridDim.x * NTHREADS) {
    const int t = i >> 5, f = i & 31;
    const double a = (double)pos[t] * p.inv_freq[f];
    const double n = rint(a * 0.15915494309189535);
    double r = fma(-n, 6.283185307179586, a);
    r = fma(-n, 2.4492935982947064e-16, r);
    const float rf = (float)r;
    rc[i] = cosf(rf);
    rs[i] = sinf(rf);
  }
}

__device__ __forceinline__ void phase_norm1(const Params& p, int mode) {
  unsigned char* ws = p.ws;
  const int lane = tidx() & 63, wave = tidx() >> 6;
  const float* mod = (const float*)(ws + OFF_MOD);
  float* xa = (float*)(ws + OFF_XA);
  const h16* yp = (const h16*)(ws + OFF_YPAIR);
  h16* hout = (h16*)(ws + OFF_H16);
  const int l = (mode == 0) ? 0 : 1;
  for (int row = blockIdx.x * NW + wave; row < T; row += gridDim.x * NW) {
    const int b = row >> 13;
    float4 x[4];
    float ss = 0.f;
#pragma unroll
    for (int i = 0; i < 4; ++i) {
      const int col = lane * 4 + 256 * i;
      if (mode == 0) {
        x[i] = *(const float4*)(p.in[I_X] + (size_t)row * D + col);
      } else {
        const int lp = mode == 1 ? 0 : 1;
        const float4 xv = *(const float4*)(xa + (size_t)row * D + col);
        const float4 g2 = *(const float4*)(mod + (size_t)(lp * 2 + b) * 6144 + 5120 + col);
        const h16x4 y0 = *(const h16x4*)(yp + (size_t)(row * 2) * D + col);
        const h16x4 y1 = *(const h16x4*)(yp + (size_t)(row * 2 + 1) * D + col);
        x[i].x = xv.x + g2.x * ((float)y0[0] + (float)y1[0]);
        x[i].y = xv.y + g2.y * ((float)y0[1] + (float)y1[1]);
        x[i].z = xv.z + g2.z * ((float)y0[2] + (float)y1[2]);
        x[i].w = xv.w + g2.w * ((float)y0[3] + (float)y1[3]);
        if (mode == 1) *(float4*)(xa + (size_t)row * D + col) = x[i];
      }
      ss += x[i].x * x[i].x + x[i].y * x[i].y + x[i].z * x[i].z + x[i].w * x[i].w;
    }
    ss = wsum(ss);
    const float rstd = rsqrtf(ss * (1.f / D) + EPS);
#pragma unroll
    for (int i = 0; i < 4; ++i) {
      const int col = lane * 4 + 256 * i;
      if (mode == 2) {
        const float4 g = *(const float4*)(p.in[I_FNG] + col);
        float4 o;
        o.x = x[i].x * rstd * g.x; o.y = x[i].y * rstd * g.y; o.z = x[i].z * rstd * g.z; o.w = x[i].w * rstd * g.w;
        *(float4*)(p.out + (size_t)row * D + col) = o;
      } else {
        const float4 g = *(const float4*)(p.in[I_N1G] + l * D + col);
        const float4 sh = *(const float4*)(mod + (size_t)(l * 2 + b) * 6144 + col);
        const float4 sc = *(const float4*)(mod + (size_t)(l * 2 + b) * 6144 + 1024 + col);
        *(h16x4*)(hout + (size_t)row * D + col) = pack4(x[i].x * rstd * g.x * (1.f + sc.x) + sh.x, x[i].y * rstd * g.y * (1.f + sc.y) + sh.y,
                                                        x[i].z * rstd * g.z * (1.f + sc.z) + sh.z, x[i].w * rstd * g.w * (1.f + sc.w) + sh.w);
      }
    }
  }
}

__device__ __forceinline__ void phase_inproj(const Params& p, h16* sm) {
  unsigned char* ws = p.ws;
  const h16* A = (const h16*)(ws + OFF_H16);
  const h16* W = (const h16*)(ws + OFF_WIN);
  h16* P = (h16*)(ws + OFF_P16);
  const TileIter ti = xcd_tiles(64 * 10);
  for (int t = ti.cur; t < ti.end; t += ti.step) {
    const int mt = t / 10, nt = t % 10;
    f32x4 acc[8][4];
    const h16* Ab = A + (size_t)mt * 256 * D;
    gemm_mainloop(acc, [&](int r) { return Ab + (size_t)r * D; }, W + (size_t)nt * 256 * D, D, D / 64, sm);
    const int tid_e = tidx(), lane = tid_e & 63, wave = tid_e >> 6, wr = wave >> 2, wc = wave & 3, fr = lane & 15, fq = lane >> 4;
    if (nt * 256 + wc * 64 < NIN) {
#pragma unroll
      for (int m = 0; m < 8; ++m)
#pragma unroll
        for (int n = 0; n < 4; ++n) {
          const int row = mt * 256 + wr * 128 + m * 16 + fr, col = nt * 256 + wc * 64 + n * 16 + 4 * fq;
          *(h16x4*)(P + (size_t)row * NIN + col) = pack4(acc[m][n][0], acc[m][n][1], acc[m][n][2], acc[m][n][3]);
        }
    }
  }
}

__device__ __forceinline__ int perm_key(int pos) {
  return 32 * (pos >> 5) + 16 * ((pos >> 2) & 1) + 4 * ((pos >> 3) & 3) + (pos & 3);
}
__device__ __forceinline__ void phase_post(const Params& p) {
  unsigned char* ws = p.ws;
  const h16* P = (const h16*)(ws + OFF_P16);
  const float* rc = (const float*)(ws + OFF_ROPE);
  const float* rs = rc + (size_t)T * 32;
  h16* q16 = (h16*)(ws + OFF_Q16);
  float* gates = (float*)(ws + OFF_GATES);
  const int lane = tidx() & 63, wave = tidx() >> 6;
  if (blockIdx.x == 0) {
    const int o = tidx();
    const float* pp = (const float*)(ws + OFF_PBPART) + (size_t)(o >> 8) * 32 * 256 + (o & 255);
    float acc = 0.f;
    for (int k = 0; k < 32; ++k) acc += pp[k * 256];
    ((float*)(ws + OFF_PB))[o] = acc;
  }
  for (int row = blockIdx.x * NW + wave; row < T; row += gridDim.x * NW) {
    const int b = row >> 13, s = row & (S - 1);
    const h16* pr = P + (size_t)row * NIN;
    const int d = (lane & 7) * 4;
    const float4 cs = *(const float4*)(rc + (size_t)row * 32 + d);
    const float4 sn = *(const float4*)(rs + (size_t)row * 32 + d);
    {
      const int hd = lane >> 3;
      const h16x4 a = *(const h16x4*)(pr + C_Q + 64 * hd + d);
      const h16x4 bb = *(const h16x4*)(pr + C_Q + 64 * hd + 32 + d);
      const float a0 = a[0], a1 = a[1], a2 = a[2], a3 = a[3], b0 = bb[0], b1 = bb[1], b2 = bb[2], b3 = bb[3];
      h16* qo = q16 + (size_t)row * 512 + 64 * hd + d;
      constexpr float QS = 0.125f * 1.4426950408889634f;
      *(h16x4*)qo = pack4((a0 * cs.x - b0 * sn.x) * QS, (a1 * cs.y - b1 * sn.y) * QS, (a2 * cs.z - b2 * sn.z) * QS, (a3 * cs.w - b3 * sn.w) * QS);
      *(h16x4*)(qo + 32) = pack4((b0 * cs.x + a0 * sn.x) * QS, (b1 * cs.y + a1 * sn.y) * QS, (b2 * cs.z + a2 * sn.z) * QS, (b3 * cs.w + a3 * sn.w) * QS);
    }
    if (lane < 48) {
      const int tn = lane >> 4, hd = (lane >> 3) & 1;
      const int cb = (tn == 0 ? C_KC : (tn == 1 ? C_KS : C_KW)) + 64 * hd;
      const size_t off = tn == 0 ? OFF_KC : (tn == 1 ? OFF_KS : OFF_KW);
      const h16x4 a = *(const h16x4*)(pr + cb + d);
      const h16x4 bb = *(const h16x4*)(pr + cb + 32 + d);
      const float a0 = a[0], a1 = a[1], a2 = a[2], a3 = a[3], b0 = bb[0], b1 = bb[1], b2 = bb[2], b3 = bb[3];
      h16* ko = (h16*)(ws + off) + ((size_t)(b * 2 + hd) * S + s) * 64 + d;
      *(h16x4*)ko = pack4(a0 * cs.x - b0 * sn.x, a1 * cs.y - b1 * sn.y, a2 * cs.z - b2 * sn.z, a3 * cs.w - b3 * sn.w);
      *(h16x4*)(ko + 32) = pack4(b0 * cs.x + a0 * sn.x, b1 * cs.y + a1 * sn.y, b2 * cs.z + a2 * sn.z, b3 * cs.w + a3 * sn.w);
    }
    if (lane < 32) {
      const int hd = lane >> 4, dd = (lane & 15) * 4;
      *(h16x4*)((h16*)(ws + OFF_VC) + ((size_t)(b * 2 + hd) * S + s) * 64 + dd) = *(const h16x4*)(pr + C_VC + 64 * hd + dd);
    }
    if (lane < 24) gates[(size_t)row * 24 + lane] = sigm((float)pr[C_GATE + lane]);
  }
  for (int task = blockIdx.x; task < 1024; task += gridDim.x) {
    const int tensor = task & 1, kv = (task >> 1) & 1, blk = (task >> 2) & 127, b = task >> 9;
    const int srccol = (tensor ? C_VW : C_VS) + 64 * kv;
    h16* dst = (h16*)(ws + (tensor ? OFF_VWT : OFF_VST)) + ((size_t)((b * 2 + kv) * 128 + blk)) * 4096;
    const int dim = tidx() & 63, kg = tidx() >> 6;
    {
      const int p0 = kg * 8;
      h16x8 v;
#pragma unroll
      for (int j = 0; j < 8; ++j) v[j] = P[(size_t)(b * S + blk * 64 + perm_key(p0 + j)) * NIN + srccol + dim];
      *(h16x8*)(dst + dim * 64 + p0) = v;
    }
  }
}

__device__ __forceinline__ void mixa_compress1(const Params& p, int item, h16* sm) {
  unsigned char* ws = p.ws;
  const int which = item >> 5, mt = (item >> 2) & 7, ks = item & 3;
  const h16* A = (const h16*)(ws + (which ? OFF_VC : OFF_KC)) + (size_t)mt * 256 * 1024 + ks * 512;
  const h16* W = (const h16*)(ws + (which ? OFF_W1V : OFF_W1K)) + ks * 512;
  float* hp = (float*)(ws + OFF_HIDP) + ((size_t)(ks * 2 + which) * 2048) * 256;
  f32x4 acc[8][4];
  gemm_mainloop(acc, [&](int r) { return A + (size_t)r * 1024; }, W, 2048, 8, sm);
  const int tid_e = tidx(), lane = tid_e & 63, wave = tid_e >> 6, wr = wave >> 2, wc = wave & 3, fr = lane & 15, fq = lane >> 4;
#pragma unroll
  for (int m = 0; m < 8; ++m)
#pragma unroll
    for (int n = 0; n < 4; ++n) {
      const int row = mt * 256 + wr * 128 + m * 16 + fr, col = wc * 64 + n * 16 + 4 * fq;
      *(f32x4*)(hp + (size_t)row * 256 + col) = acc[m][n];
    }
}

__device__ __forceinline__ void mixa_lru(const Params& p, int l, int item, float* sm) {
  unsigned char* ws = p.ws;
  const int half = tidx() >> 8;
  item = item * 2 + half;
  sm += half * 12288;
  const int b = item >> 7, ck = item & 127;
  const int c = tidx() & 255;
  const int nb = c >> 6, e = c & 63;
  const h16* P = (const h16*)(ws + OFF_P16);
  const float* cw = p.in[I_LCW] + l * 4 * 256;
  const float w0 = cw[c], w1 = cw[256 + c], w2 = cw[512 + c], w3 = cw[768 + c], cb = p.in[I_LCB][l * 256 + c];
  const float ba = p.in[I_LBA][l * 256 + c], bx = p.in[I_LBX][l * 256 + c];
  const float lam = p.in[I_LLAM][l * 256 + c];
  const float ls = -log1pf(expf(-lam));
  const float* pa = p.in[I_LWA] + ((size_t)(l * 4 + nb) * 64) * 64 + e;
  const float* px = p.in[I_LWX] + ((size_t)(l * 4 + nb) * 64) * 64 + e;
  const int t0 = ck * 64;
  float x0 = 0.f, x1 = 0.f, x2 = 0.f;
  if (t0 >= 3) {
    x0 = (float)P[(size_t)(b * S + t0 - 3) * NIN + C_XL + c];
    x1 = (float)P[(size_t)(b * S + t0 - 2) * NIN + C_XL + c];
    x2 = (float)P[(size_t)(b * S + t0 - 1) * NIN + C_XL + c];
  }
  float h = 0.f, ap = 1.f;
  float* lh = (float*)(ws + OFF_LRUH);
  float* la = (float*)(ws + OFF_LRUA);
  float* sr = sm + 4096;
  float* si = sm + 8192;
#pragma unroll 1
  for (int sub = 0; sub < 4; ++sub) {
    const int tb = t0 + sub * 16;
    {
      h16 xv[16];
      const h16* xp = P + (size_t)(b * S + tb) * NIN + C_XL + c;
#pragma unroll
      for (int tt = 0; tt < 16; ++tt) { xv[tt] = *xp; xp += NIN; asm volatile("" : "+v"(xp)); }
#pragma unroll
      for (int tt = 0; tt < 16; ++tt) {
        const float x3 = (float)xv[tt];
        sm[tt * 256 + c] = w0 * x0 + w1 * x1 + w2 * x2 + w3 * x3 + cb;
        x0 = x1; x1 = x2; x2 = x3;
      }
    }
    __syncthreads();
    {
      float accr[16], acci[16];
#pragma unroll
      for (int tt = 0; tt < 16; ++tt) { accr[tt] = 0.f; acci[tt] = 0.f; }
#pragma unroll 1
      for (int d8 = 0; d8 < 8; ++d8) {
        float wa8[8], wx8[8];
        const float* pa8 = pa + d8 * 512;
        const float* px8 = px + d8 * 512;
#pragma unroll
        for (int j = 0; j < 8; ++j) { wa8[j] = pa8[j * 64]; wx8[j] = px8[j * 64]; }
        const float* xr = sm + nb * 64 + d8 * 8;
#pragma unroll
        for (int tt = 0; tt < 16; ++tt) {
          const float4 xa = *(const float4*)(xr + tt * 256), xb = *(const float4*)(xr + tt * 256 + 4);
          accr[tt] += xa.x * wa8[0] + xa.y * wa8[1] + xa.z * wa8[2] + xa.w * wa8[3] + xb.x * wa8[4] + xb.y * wa8[5] + xb.z * wa8[6] + xb.w * wa8[7];
          acci[tt] += xa.x * wx8[0] + xa.y * wx8[1] + xa.z * wx8[2] + xa.w * wx8[3] + xb.x * wx8[4] + xb.y * wx8[5] + xb.z * wx8[6] + xb.w * wx8[7];
        }
      }
#pragma unroll
      for (int tt = 0; tt < 16; ++tt) { sr[tt * 256 + c] = accr[tt]; si[tt * 256 + c] = acci[tt]; }
    }
#pragma unroll 4
    for (int tt = 0; tt < 16; ++tt) {
      const float r = sigm(sr[tt * 256 + c] + ba), ig = sigm(si[tt * 256 + c] + bx);
      const float log_a = 8.f * r * ls;
      const float a = __expf(log_a);
      const float mult = sqrtf(-expm1f(2.f * log_a));
      sr[tt * 256 + c] = a;
      si[tt * 256 + c] = mult * ig * sm[tt * 256 + c];
    }
    float* lhp = lh + (size_t)(b * S + tb) * 256 + c;
    float* lap = la + (size_t)(b * S + tb) * 256 + c;
#pragma unroll 4
    for (int tt = 0; tt < 16; ++tt) {
      const float a = sr[tt * 256 + c];
      h = a * h + si[tt * 256 + c];
      ap *= a;
      lhp[tt * 256] = h;
      lap[tt * 256] = ap;
    }
    __syncthreads();
  }
  ((float*)(ws + OFF_HEND))[(size_t)(b * 128 + ck) * 256 + c] = h;
  ((float*)(ws + OFF_AEND))[(size_t)(b * 128 + ck) * 256 + c] = ap;
}

__device__ __forceinline__ void mixa_conv(const Params& p, int l, int item, float* sm) {
  unsigned char* ws = p.ws;
  const int half = tidx() >> 8;
  item = item * 2 + half;
  sm += half * 15872;
  const int b = item >> 8, ck = item & 255;
  const int c = tidx() & 255;
  const h16* P = (const h16*)(ws + OFF_P16);
  const int t0 = ck * 32;
#pragma unroll 1
  for (int r0 = 0; r0 < 64; r0 += 16) {
    h16 va[16], vb[16];
#pragma unroll
    for (int q = 0; q < 16; ++q) {
      const int t = t0 - 30 + r0 + q;
      va[q] = (h16)0.f; vb[q] = (h16)0.f;
      if (t >= 0 && r0 + q < 62) {
        const h16* pr = P + (size_t)(b * S + t) * NIN;
        va[q] = pr[C_CVA + c]; vb[q] = pr[C_CVB + c];
      }
    }
#pragma unroll
    for (int q = 0; q < 16; ++q)
      if (r0 + q < 62) sm[(r0 + q) * 256 + c] = (float)va[q] * sigm((float)vb[q]);
  }
  float w[31];
#pragma unroll
  for (int j = 0; j < 31; ++j) w[j] = p.in[I_DWW][(size_t)(l * 31 + j) * 256 + c];
  const float bias = p.in[I_DWB][l * 256 + c];
  for (int i = 0; i < 32; ++i) {
    float z = bias;
#pragma unroll
    for (int j = 0; j < 31; ++j) z += w[j] * sm[(i + j) * 256 + c];
    sm[i * 256 + c] = z;
  }
  __syncthreads();
  const int lane = tidx() & 63, wave = (tidx() >> 6) & 3;
  const float4 lg = *(const float4*)(p.in[I_LNG] + l * 256 + lane * 4);
  const float4 lb = *(const float4*)(p.in[I_LNB] + l * 256 + lane * 4);
  const float4 gn = *(const float4*)(p.in[I_ONG] + l * 1024 + 768 + lane * 4);
  h16* yc = (h16*)(ws + OFF_H16);
  for (int i = wave * 8; i < wave * 8 + 8; ++i) {
    const float4 z = *(const float4*)(sm + i * 256 + lane * 4);
    const float mu = wsum(z.x + z.y + z.z + z.w) * (1.f / 256.f);
    const float dx = z.x - mu, dy = z.y - mu, dz = z.z - mu, dw = z.w - mu;
    const float var = wsum(dx * dx + dy * dy + dz * dz + dw * dw) * (1.f / 256.f);
    const float rs = rsqrtf(var + EPS);
    const float y0 = silu_f(dx * rs * lg.x + lb.x), y1 = silu_f(dy * rs * lg.y + lb.y), y2 = silu_f(dz * rs * lg.z + lb.z), y3 = silu_f(dw * rs * lg.w + lb.w);
    const float r2 = rsqrtf(wsum(y0 * y0 + y1 * y1 + y2 * y2 + y3 * y3) * (1.f / 256.f) + EPS);
    *(h16x4*)(yc + (size_t)(b * S + t0 + i) * D + 768 + lane * 4) = pack4(y0 * r2 * gn.x, y1 * r2 * gn.y, y2 * r2 * gn.z, y3 * r2 * gn.w);
  }
  __syncthreads();
}

__device__ __forceinline__ void phase_mixa(const Params& p, int l, void* sm) {
  const int G = gridDim.x;
  for (int it = blockIdx.x; it < 64; it += G) mixa_compress1(p, it, (h16*)sm);
  for (int it = (blockIdx.x + G - 64 % G) % G; it < 128; it += G) mixa_lru(p, l, it, (float*)sm);
  for (int it = (blockIdx.x + G - 192 % G) % G; it < 256; it += G) mixa_conv(p, l, it, (float*)sm);
}

__device__ __forceinline__ void phase_mixb(const Params& p, int l, float* sm) {
  unsigned char* ws = p.ws;
  const int tid = tidx();
  for (int it = blockIdx.x; it < 512; it += gridDim.x) {
    const int which = it >> 8;
    const int row0 = (it & 255) * 8;
    {
      const float* hp = (const float*)(ws + OFF_HIDP) + ((size_t)which * 2048 + row0) * 256;
      const float* pb = (const float*)(ws + OFF_PB) + which * 256;
      const int r = tid >> 6, c4 = (tid & 63) * 4;
      const size_t o = (size_t)r * 256 + c4;
      const float4 a0 = *(const float4*)(hp + o), a1 = *(const float4*)(hp + (size_t)2 * 2048 * 256 + o);
      const float4 a2 = *(const float4*)(hp + (size_t)4 * 2048 * 256 + o), a3 = *(const float4*)(hp + (size_t)6 * 2048 * 256 + o);
      const float4 bb = *(const float4*)(pb + c4);
      float* d = sm + r * 256 + c4;
      d[0] = gelu_tanh(a0.x + a1.x + a2.x + a3.x + bb.x); d[1] = gelu_tanh(a0.y + a1.y + a2.y + a3.y + bb.y);
      d[2] = gelu_tanh(a0.z + a1.z + a2.z + a3.z + bb.z); d[3] = gelu_tanh(a0.w + a1.w + a2.w + a3.w + bb.w);
      const float4* wsrc = (const float4*)(p.in[which ? I_CVW2 : I_CKW2] + (size_t)l * 256 * 64);
      float4* wdst = (float4*)(sm + 2048);
#pragma unroll
      for (int q = 0; q < 8; ++q) wdst[q * NTHREADS + tid] = wsrc[q * NTHREADS + tid];
    }
    __syncthreads();
    const int row = row0 + (tid >> 6), d = tid & 63;
    const float* hr = sm + (tid >> 6) * 256;
    const float* w2 = sm + 2048 + d;
    float s = 0.f;
#pragma unroll 8
    for (int j = 0; j < 256; ++j) s += (float)(h16)hr[j] * w2[j * 64];
    const int bkv = row >> 9, n = row & 511;
    if (n == 511) s = 0.f;
    if (which == 0) {
      ((h16*)(ws + OFF_KCMP))[((size_t)bkv * 512 + n) * 64 + d] = (h16)s;
    } else {
      const int blk = n >> 6, key = n & 63;
      const int pos = 32 * (key >> 5) + 8 * ((key >> 2) & 3) + 4 * ((key >> 4) & 1) + (key & 3);
      ((h16*)(ws + OFF_VCMPT))[((size_t)(bkv * 8 + blk) * 64 + d) * 64 + pos] = (h16)s;
    }
    __syncthreads();
  }
  const int g = blockIdx.x * NTHREADS + tid;
  if (g < 512) {
    const int b = g >> 8, c = g & 255;
    const float* he = (const float*)(ws + OFF_HEND) + (size_t)b * 128 * 256 + c;
    const float* ae = (const float*)(ws + OFF_AEND) + (size_t)b * 128 * 256 + c;
    float* cy = (float*)(ws + OFF_CARRY) + (size_t)b * 128 * 256 + c;
    float carry = 0.f;
#pragma unroll 1
    for (int k0 = 0; k0 < 128; k0 += 32) {
      float hv[32], av[32];
#pragma unroll
      for (int k = 0; k < 32; ++k) { hv[k] = he[(k0 + k) * 256]; av[k] = ae[(k0 + k) * 256]; }
#pragma unroll
      for (int k = 0; k < 32; ++k) {
        cy[(k0 + k) * 256] = carry;
        carry = hv[k] + av[k] * carry;
      }
    }
  }
}

__device__ __forceinline__ void stage8k(const h16* __restrict__ g, h16* l, int tid) {
  const int r = tid >> 3, cl = (tid & 7) ^ ((r >> 1) & 7);
  glds16(g + r * 64 + cl * 8, l + tid * 8);
}
__device__ __forceinline__ h16x8 ldfrag(const h16* l, int row, int chunk) {
  return *(const h16x8*)(l + row * 64 + ((chunk ^ ((row >> 1) & 7)) * 8));
}

template <int MODE>
__device__ __forceinline__ void attn_branch(const h16* __restrict__ Kg, const h16* __restrict__ Vg, int j0, int j1, h16* ring,
                                            const h16x8 (&qf)[2][2], float (&m)[2], float (&l)[2], f32x4 (&o)[2][4],
                                            const int (&tq)[2], const int (&lim)[2], const int (&tlim)[2], const int (&tfl)[2],
                                            const unsigned long long (&mylo)[2], const unsigned long long (&myhi)[2],
                                            const unsigned long long (&ulo)[2], const unsigned long long (&uhi)[2],
                                            const float (&inv)[2], float* impw) {
  int tid = tidx();
  asm volatile("" : "+v"(tid));
  const int lane = tid & 63;
  const int h = lane >> 4, c = lane & 15, qi = c >> 2, g = c & 3;
  constexpr bool PV = MODE != 0;
  constexpr int NST = 5;
  const int n = j1 - j0 + 1;
  if (n <= 0) return;
#pragma unroll
  for (int q = 0; q < NST - 1; ++q)
    if (q < n) {
      stage8k(Kg + (size_t)(j0 + q) * 4096, ring + q * 8192, tid);
      if (PV) stage8k(Vg + (size_t)(j0 + q) * 4096, ring + q * 8192 + 4096, tid);
    }
  int cur = 0, nxt = NST - 1;
  for (int it = 0; it < n; ++it) {
    const int j = j0 + it;
    {
      const int rem = n - 1 - it;
      if (PV) { if (rem >= 3) VMCNT(6); else if (rem == 2) VMCNT(4); else if (rem == 1) VMCNT(2); else VMCNT(0); }
      else    { if (rem >= 3) VMCNT(3); else if (rem == 2) VMCNT(2); else if (rem == 1) VMCNT(1); else VMCNT(0); }
    }
    __builtin_amdgcn_s_barrier();
    if (it + NST - 1 < n) {
      stage8k(Kg + (size_t)(j + NST - 1) * 4096, ring + nxt * 8192, tid);
      if (PV) stage8k(Vg + (size_t)(j + NST - 1) * 4096, ring + nxt * 8192 + 4096, tid);
    }
    const h16* cK = ring + cur * 8192;
    const h16* cV = cK + 4096;
    nxt = cur;
    cur = cur + 1 == NST ? 0 : cur + 1;
    bool act[2];
#pragma unroll
    for (int mq = 0; mq < 2; ++mq) {
      if (MODE <= 1) act[mq] = j * 64 <= tlim[mq];
      else if (MODE == 2) act[mq] = ((j < 64 ? (ulo[mq] >> j) : (uhi[mq] >> (j - 64))) & 1ull) != 0ull;
      else act[mq] = (j * 64 <= tlim[mq] + 3) && (j * 64 + 63 > tlim[mq] - 512);
    }
    if (act[0] || act[1]) {
      h16x8 pf[2][2];
      h16x8 kf[4][2];
#pragma unroll
      for (int kt = 0; kt < 4; ++kt)
#pragma unroll
        for (int ks = 0; ks < 2; ++ks) kf[kt][ks] = ldfrag(cK, 16 * kt + c, 4 * ks + h);
#pragma unroll
      for (int mq = 0; mq < 2; ++mq)
        if (act[mq]) {
          f32x4 s[1][4];
          {
#pragma unroll
            for (int kt = 0; kt < 4; ++kt) {
              s[0][kt] = (f32x4){0.f, 0.f, 0.f, 0.f};
#pragma unroll
              for (int ks = 0; ks < 2; ++ks) s[0][kt] = __builtin_amdgcn_mfma_f32_16x16x32_f16(kf[kt][ks], qf[mq][ks], s[0][kt], 0, 0, 0);
            }
          }
          const bool selbit = MODE == 2 ? (((j < 64 ? (mylo[mq] >> j) : (myhi[mq] >> (j - 64))) & 1ull) != 0ull) : true;
          bool interior;
          if (MODE <= 1) interior = j * 64 + 63 <= tfl[mq];
          else if (MODE == 2) interior = j * 64 + 63 <= tfl[mq];
          else interior = (j * 64 + 63 <= tfl[mq]) && (j * 64 > tfl[mq] + 3 - 512);
          if (!interior) {
            const int pbase = j * 64 + 4 * h;
#pragma unroll
            for (int kt = 0; kt < 4; ++kt)
#pragma unroll
              for (int i = 0; i < 4; ++i) {
                const int pos = pbase + 16 * kt + i;
                bool v;
                if (MODE <= 1) v = pos <= lim[mq];
                else if (MODE == 2) v = selbit && pos <= tq[mq];
                else v = pos <= tq[mq] && pos > tq[mq] - 512;
                s[0][kt][i] = v ? s[0][kt][i] : -1e30f;
              }
          } else if (MODE == 2) {
#pragma unroll
            for (int kt = 0; kt < 4; ++kt)
#pragma unroll
              for (int i = 0; i < 4; ++i) s[0][kt][i] = selbit ? s[0][kt][i] : -1e30f;
          }
          if (MODE == 1) {
#pragma unroll
            for (int kt = 0; kt < 4; ++kt) {
              float ps = 0.f;
#pragma unroll
              for (int i = 0; i < 4; ++i) {
                const float pv = __builtin_amdgcn_exp2f(s[0][kt][i] - m[mq]) * inv[mq];
                s[0][kt][i] = pv;
                ps += pv;
              }
              ps += __shfl_xor(ps, 1);
              ps += __shfl_xor(ps, 2);
              if (g == 0) impw[(4 * mq + qi) * 128 + j * 16 + kt * 4 + h] = ps;
            }
          } else {
            float bm = fmaxf(fmaxf(fmaxf(s[0][0][0], s[0][0][1]), fmaxf(s[0][0][2], s[0][0][3])), fmaxf(fmaxf(s[0][1][0], s[0][1][1]), fmaxf(s[0][1][2], s[0][1][3])));
            bm = fmaxf(bm, fmaxf(fmaxf(fmaxf(s[0][2][0], s[0][2][1]), fmaxf(s[0][2][2], s[0][2][3])), fmaxf(fmaxf(s[0][3][0], s[0][3][1]), fmaxf(s[0][3][2], s[0][3][3]))));
            if (__any(bm > m[mq] + 8.f)) {
              bm = fmaxf(bm, __shfl_xor(bm, 16));
              bm = fmaxf(bm, __shfl_xor(bm, 32));
              const float mn = fmaxf(m[mq], bm);
              const float alpha = __builtin_amdgcn_exp2f(m[mq] - mn);
              l[mq] *= alpha;
              m[mq] = mn;
              if (PV) {
#pragma unroll
                for (int mt = 0; mt < 4; ++mt) o[mq][mt] *= alpha;
              }
            }
            const float mref = m[mq] > -1e29f ? m[mq] : 1e30f;
            float ps = 0.f;
#pragma unroll
            for (int kt = 0; kt < 4; ++kt)
#pragma unroll
              for (int i = 0; i < 4; ++i) {
                const float pv = __builtin_amdgcn_exp2f(s[0][kt][i] - mref);
                s[0][kt][i] = pv;
                ps += pv;
              }
            l[mq] += ps;
          }
          if (PV) {
#pragma unroll
            for (int s2 = 0; s2 < 2; ++s2)
#pragma unroll
              for (int i = 0; i < 4; ++i) { pf[mq][s2][i] = (h16)s[0][2 * s2][i]; pf[mq][s2][4 + i] = (h16)s[0][2 * s2 + 1][i]; }
          }
        }
      if (PV) {
        h16x8 vf[4][2];
#pragma unroll
        for (int mt = 0; mt < 4; ++mt)
#pragma unroll
          for (int s2 = 0; s2 < 2; ++s2) vf[mt][s2] = ldfrag(cV, 16 * mt + c, 4 * s2 + h);
#pragma unroll
        for (int mq = 0; mq < 2; ++mq)
          if (act[mq]) {
#pragma unroll
            for (int s2 = 0; s2 < 2; ++s2) {
#pragma unroll
              for (int mt = 0; mt < 4; ++mt) o[mq][mt] = __builtin_amdgcn_mfma_f32_16x16x32_f16(vf[mt][s2], pf[mq][s2], o[mq][mt], 0, 0, 0);
            }
          }
      }
    }
  }
  __builtin_amdgcn_s_barrier();
}

__device__ __forceinline__ void attn_item(const Params& p, int l, int item, float* sm) {
  unsigned char* ws = p.ws;
  int tid = tidx();
  asm volatile("" : "+v"(tid));
  const int lane = tid & 63, wave = tid >> 6;
  const int combo = item & 3, qt = item >> 2;
  const int b = combo >> 1, kv = combo & 1;
  const int t0 = qt * 64, tw0 = t0 + 8 * wave;
  const int h = lane >> 4, c = lane & 15, qi = c >> 2, g = c & 3;
  const int head = kv * 4 + g, bkv = b * 2 + kv;
  h16* ring = (h16*)sm;
  float* impw = sm + 20480 + wave * 1024;
  unsigned long long* selm = (unsigned long long*)(sm + 20480 + 8192) + wave * 16;

  h16x8 qf[2][2];
  int tq[2];
#pragma unroll
  for (int mq = 0; mq < 2; ++mq) {
    tq[mq] = tw0 + 4 * mq + qi;
    const h16* qrow = (const h16*)(ws + OFF_Q16) + (size_t)(b * S + tq[mq]) * 512 + head * 64;
    qf[mq][0] = *(const h16x8*)(qrow + 8 * h);
    qf[mq][1] = *(const h16x8*)(qrow + 32 + 8 * h);
  }
  for (int i = lane; i < 1024; i += 64) impw[i] = 0.f;

  h16x4 ofin[2][4];
  float m[2], ll[2], inv[2];
  f32x4 o[2][4];
  const unsigned long long z2[2] = {0ull, 0ull};
  {
    int lim[2], tlim[2], tflc[2];
#pragma unroll
    for (int mq = 0; mq < 2; ++mq) {
      lim[mq] = tq[mq] >= 31 ? ((tq[mq] - 31) >> 4) : -1;
      const int tl = tw0 + 4 * mq + 3;
      tlim[mq] = tl >= 31 ? ((tl - 31) >> 4) : -1;
      const int tf0 = tw0 + 4 * mq;
      tflc[mq] = tf0 >= 31 ? ((tf0 - 31) >> 4) : -1;
      m[mq] = -1e30f; ll[mq] = 0.f; inv[mq] = 0.f;
#pragma unroll
      for (int mt = 0; mt < 4; ++mt) o[mq][mt] = (f32x4){0.f, 0.f, 0.f, 0.f};
    }
    const int nl = (t0 + 63 - 31) >> 4;
    const int jl = nl >> 6;
    const h16* Kc = (const h16*)(ws + OFF_KCMP) + (size_t)bkv * 512 * 64;
    const h16* Vc = (const h16*)(ws + OFF_VCMPT) + (size_t)bkv * 8 * 4096;
    attn_branch<0>(Kc, Vc, 0, jl, ring, qf, m, ll, o, tq, lim, tlim, tflc, z2, z2, z2, z2, inv, impw);
#pragma unroll
    for (int mq = 0; mq < 2; ++mq) {
      float lt = ll[mq];
      lt += __shfl_xor(lt, 16);
      lt += __shfl_xor(lt, 32);
      inv[mq] = lt > 0.f ? 1.f / lt : 0.f;
    }
    attn_branch<1>(Kc, Vc, 0, jl, ring, qf, m, ll, o, tq, lim, tlim, tflc, z2, z2, z2, z2, inv, impw);
    const float* gt0 = (const float*)(ws + OFF_GATES) + (size_t)(b * S) * 24 + head * 3;
#pragma unroll
    for (int mq = 0; mq < 2; ++mq) {
      const float g0 = gt0[(size_t)tq[mq] * 24] * ASCALE;
#pragma unroll
      for (int mt = 0; mt < 4; ++mt) ofin[mq][mt] = pack4(o[mq][mt][0] * g0, o[mq][mt][1] * g0, o[mq][mt][2] * g0, o[mq][mt][3] * g0);
    }
  }
  for (int q = 0; q < 8; ++q) {
    const int t = tw0 + q, own = t >> 6;
    const float* ir = impw + q * 128;
    const int ja = lane, jb = lane + 64;
    unsigned k0 = 0u, k1 = 0u;
    if (ja <= own) k0 = (ja == 0 || ja == own) ? (0xFFFFFF80u | (unsigned)(127 - ja)) : (((__float_as_uint(ir[ja]) & ~127u) | (unsigned)(127 - ja)) + 1u);
    if (jb <= own) k1 = (jb == own) ? (0xFFFFFF80u | (unsigned)(127 - jb)) : (((__float_as_uint(ir[jb]) & ~127u) | (unsigned)(127 - jb)) + 1u);
    unsigned thr = 0u;
    for (int bit = 31; bit >= 0; --bit) {
      const unsigned cand = thr | (1u << bit);
      const int cnt = __popcll(__ballot(k0 >= cand)) + __popcll(__ballot(k1 >= cand));
      if (cnt >= 16) thr = cand;
    }
    const unsigned long long mlo = __ballot(k0 >= thr && ja <= own);
    const unsigned long long mhi = __ballot(k1 >= thr && jb <= own);
    if (lane == 0) { selm[q * 2] = mlo; selm[q * 2 + 1] = mhi; }
  }
  unsigned long long mylo[2], myhi[2], ulo[2], uhi[2];
#pragma unroll
  for (int mq = 0; mq < 2; ++mq) {
    mylo[mq] = selm[(4 * mq + qi) * 2];
    myhi[mq] = selm[(4 * mq + qi) * 2 + 1];
    unsigned long long a = selm[(4 * mq) * 2] | selm[(4 * mq + 1) * 2] | selm[(4 * mq + 2) * 2] | selm[(4 * mq + 3) * 2];
    unsigned long long bb = selm[(4 * mq) * 2 + 1] | selm[(4 * mq + 1) * 2 + 1] | selm[(4 * mq + 2) * 2 + 1] | selm[(4 * mq + 3) * 2 + 1];
    ulo[mq] = (unsigned long long)__builtin_amdgcn_readfirstlane((unsigned)a) | ((unsigned long long)__builtin_amdgcn_readfirstlane((unsigned)(a >> 32)) << 32);
    uhi[mq] = (unsigned long long)__builtin_amdgcn_readfirstlane((unsigned)bb) | ((unsigned long long)__builtin_amdgcn_readfirstlane((unsigned)(bb >> 32)) << 32);
  }
  const float* gtb = (const float*)(ws + OFF_GATES) + (size_t)(b * S) * 24 + head * 3;
  {
    int tl0[2] = {0, 0};
    const int tfs[2] = {tw0, tw0 + 4};
#pragma unroll
    for (int mq = 0; mq < 2; ++mq) {
      m[mq] = -1e30f; ll[mq] = 0.f;
#pragma unroll
      for (int mt = 0; mt < 4; ++mt) o[mq][mt] = (f32x4){0.f, 0.f, 0.f, 0.f};
    }
    attn_branch<2>((const h16*)(ws + OFF_KS) + (size_t)bkv * S * 64, (const h16*)(ws + OFF_VST) + (size_t)bkv * 128 * 4096, 0, (t0 + 63) >> 6, ring, qf, m, ll, o,
                   tq, tl0, tl0, tfs, mylo, myhi, ulo, uhi, inv, impw);
#pragma unroll
    for (int mq = 0; mq < 2; ++mq) {
      float lt = ll[mq];
      lt += __shfl_xor(lt, 16);
      lt += __shfl_xor(lt, 32);
      const float sc = lt > 0.f ? gtb[(size_t)tq[mq] * 24 + 1] * ASCALE / lt : 0.f;
#pragma unroll
      for (int mt = 0; mt < 4; ++mt)
        ofin[mq][mt] = pack4((float)ofin[mq][mt][0] + o[mq][mt][0] * sc, (float)ofin[mq][mt][1] + o[mq][mt][1] * sc, (float)ofin[mq][mt][2] + o[mq][mt][2] * sc,
                             (float)ofin[mq][mt][3] + o[mq][mt][3] * sc);
    }
  }
  {
    int tl0[2] = {0, 0}, tf[2];
#pragma unroll
    for (int mq = 0; mq < 2; ++mq) {
      tf[mq] = tw0 + 4 * mq;
      m[mq] = -1e30f; ll[mq] = 0.f;
#pragma unroll
      for (int mt = 0; mt < 4; ++mt) o[mq][mt] = (f32x4){0.f, 0.f, 0.f, 0.f};
    }
    const int jlo = t0 >= 511 ? ((t0 - 511) >> 6) : 0;
    attn_branch<3>((const h16*)(ws + OFF_KW) + (size_t)bkv * S * 64, (const h16*)(ws + OFF_VWT) + (size_t)bkv * 128 * 4096, jlo, (t0 + 63) >> 6, ring, qf, m, ll, o,
                   tq, tl0, tf, tf, z2, z2, z2, z2, inv, impw);
#pragma unroll
    for (int mq = 0; mq < 2; ++mq) {
      float lt = ll[mq];
      lt += __shfl_xor(lt, 16);
      lt += __shfl_xor(lt, 32);
      const float sc = lt > 0.f ? gtb[(size_t)tq[mq] * 24 + 2] * ASCALE / lt : 0.f;
#pragma unroll
      for (int mt = 0; mt < 4; ++mt)
        ofin[mq][mt] = pack4((float)ofin[mq][mt][0] + o[mq][mt][0] * sc, (float)ofin[mq][mt][1] + o[mq][mt][1] * sc, (float)ofin[mq][mt][2] + o[mq][mt][2] * sc,
                             (float)ofin[mq][mt][3] + o[mq][mt][3] * sc);
    }
  }
  {
    h16* yc = (h16*)(ws + OFF_H16);
    const float* gn = p.in[I_ONG] + l * 1024 + 256 + head * 64;
    float* ssq = (float*)(ws + OFF_SSQ);
#pragma unroll
    for (int mq = 0; mq < 2; ++mq) {
      float sq = 0.f;
      h16* yr = yc + (size_t)(b * S + tq[mq]) * D + head * 64;
#pragma unroll
      for (int mt = 0; mt < 4; ++mt) {
        const float v[4] = {(float)ofin[mq][mt][0], (float)ofin[mq][mt][1], (float)ofin[mq][mt][2], (float)ofin[mq][mt][3]};
        sq += v[0] * v[0] + v[1] * v[1] + v[2] * v[2] + v[3] * v[3];
        const float4 gg = *(const float4*)(gn + 16 * mt + 4 * h);
        *(h16x4*)(yr + 16 * mt + 4 * h) = pack4(v[0] * gg.x, v[1] * gg.y, v[2] * gg.z, v[3] * gg.w);
      }
      sq += __shfl_xor(sq, 16);
      sq += __shfl_xor(sq, 32);
      sq += __shfl_xor(sq, 1);
      sq += __shfl_xor(sq, 2);
      if (h == 0 && g == 0) ssq[(size_t)(b * S + tq[mq]) * 2 + kv] = sq * (1.f / (ASCALE * ASCALE));
    }
  }
}

__device__ __forceinline__ void lrufix_item(const Params& p, int l, int item) {
  unsigned char* ws = p.ws;
  const int lane = tidx() & 63, wave = tidx() >> 6;
  const int b = item >> 7, ck = item & 127;
  const h16* P = (const h16*)(ws + OFF_P16);
  const float4 cy = *(const float4*)((const float*)(ws + OFF_CARRY) + (size_t)(b * 128 + ck) * 256 + lane * 4);
  const float4 gn = *(const float4*)(p.in[I_ONG] + l * 1024 + lane * 4);
  h16* yc = (h16*)(ws + OFF_H16);
  for (int tt = wave * 8; tt < wave * 8 + 8; ++tt) {
    const size_t row = (size_t)(b * S + ck * 64 + tt);
    const float4 hl = *(const float4*)((const float*)(ws + OFF_LRUH) + row * 256 + lane * 4);
    const float4 al = *(const float4*)((const float*)(ws + OFF_LRUA) + row * 256 + lane * 4);
    const h16x4 gl = *(const h16x4*)(P + row * NIN + C_GL + lane * 4);
    const float y0 = (hl.x + al.x * cy.x) * gelu_tanh((float)gl[0]);
    const float y1 = (hl.y + al.y * cy.y) * gelu_tanh((float)gl[1]);
    const float y2 = (hl.z + al.z * cy.z) * gelu_tanh((float)gl[2]);
    const float y3 = (hl.w + al.w * cy.w) * gelu_tanh((float)gl[3]);
    const float rstd = rsqrtf(wsum(y0 * y0 + y1 * y1 + y2 * y2 + y3 * y3) * (1.f / 256.f) + EPS);
    *(h16x4*)(yc + row * D + 512 + lane * 4) = pack4(y0 * rstd * gn.x, y1 * rstd * gn.y, y2 * rstd * gn.z, y3 * rstd * gn.w);
  }
}

__device__ __forceinline__ void phase_attn(const Params& p, int l, float* sm) {
  for (int it = blockIdx.x; it < 256; it += gridDim.x) {
#pragma unroll 1
    for (int rep = 0; rep < 2; ++rep) attn_item(p, l, rep ? (127 - (it >> 2)) * 4 + (it & 3) : it, sm);
  }
  for (int it = blockIdx.x; it < 256; it += gridDim.x) lrufix_item(p, l, it);
}

__device__ __forceinline__ void phase_outproj(const Params& p, int l, h16* sm) {
  unsigned char* ws = p.ws;
  const h16* A = (const h16*)(ws + OFF_H16);
  const h16* W = (const h16*)(ws + OFF_WOUT);
  const float* mod = (const float*)(ws + OFF_MOD);
  float* xa = (float*)(ws + OFF_XA);
  const float* xin = l == 0 ? p.in[I_X] : (const float*)xa;
  const TileIter ti = xcd_tiles(64 * 4);
  for (int t = ti.cur; t < ti.end; t += ti.step) {
    const int mt = t >> 2, nt = t & 3;
    f32x4 acc[8][4];
    const h16* Ab = A + (size_t)mt * 256 * D;
    {
      float* sct = (float*)((unsigned char*)sm + SCHED_OFF - 1024);
      const int tq_ = tidx();
      if (tq_ < 256) {
        const float2 q2 = *(const float2*)((const float*)(ws + OFF_SSQ) + (size_t)(mt * 256 + tq_) * 2);
        sct[tq_] = rsqrtf((q2.x + q2.y) * (1.f / 512.f) + EPS) * (1.f / ASCALE);
      }
    }
    gemm_mainloop(acc, [&](int r) { return Ab + (size_t)r * D; }, W + (size_t)nt * 256 * D, D, 8, sm);
    const int tid_e = tidx(), lane = tid_e & 63, wave = tid_e >> 6, wr = wave >> 2, wc = wave & 3, fr = lane & 15, fq = lane >> 4;
    {
      const float* sct = (const float*)((const unsigned char*)sm + SCHED_OFF - 1024) + wr * 128 + fr;
#pragma unroll
      for (int m = 0; m < 8; ++m) {
        const float sc = sct[m * 16];
#pragma unroll
        for (int n = 0; n < 4; ++n) acc[m][n] *= sc;
      }
    }
    gemm_mainloop(acc, [&](int r) { return Ab + (size_t)r * D + 512; }, W + (size_t)nt * 256 * D + 512, D, 8, sm, false);
#pragma unroll
    for (int m = 0; m < 8; ++m)
#pragma unroll
      for (int n = 0; n < 4; ++n) {
        const int row = mt * 256 + wr * 128 + m * 16 + fr, col = nt * 256 + wc * 64 + n * 16 + 4 * fq;
        const int b = row >> 13;
        const float4 g1 = *(const float4*)(mod + (size_t)(l * 2 + b) * 6144 + 2048 + col);
        const float4 xv = *(const float4*)(xin + (size_t)row * D + col);
        float4 o;
        o.x = xv.x + g1.x * acc[m][n][0]; o.y = xv.y + g1.y * acc[m][n][1]; o.z = xv.z + g1.z * acc[m][n][2]; o.w = xv.w + g1.w * acc[m][n][3];
        *(float4*)(xa + (size_t)row * D + col) = o;
      }
  }
}

__device__ __forceinline__ void phase_router(const Params& p, int l, int* smi) {
  unsigned char* ws = p.ws;
  const int tid = tidx(), lane = tid & 63, wave = tid >> 6;
  const float* mod = (const float*)(ws + OFF_MOD);
  const float* xa = (const float*)(ws + OFF_XA);
  h16* hout = (h16*)(ws + OFF_H16);
  unsigned* cnt = (unsigned*)(ws + OFF_CTL) + 64 + l * 16;
  int* list = (int*)(ws + OFF_LIST);
  float* wpair = (float*)(ws + OFF_WPAIR);
  const float* rgw = p.in[I_RGW] + (size_t)l * 1024 * 4;
  const float* rgb = p.in[I_RGB] + l * 4;
  int* cntl = smi;
  int* basel = smi + 16;
  int* tok = smi + 32;
  for (int chunk = blockIdx.x; chunk < T / 64; chunk += gridDim.x) {
    if (tid < 16) cntl[tid] = 0;
    __syncthreads();
    for (int ti = wave; ti < 64; ti += NW) {
      const int row = chunk * 64 + ti;
      const int b = row >> 13;
      float4 x[4];
      float ss = 0.f;
#pragma unroll
      for (int i = 0; i < 4; ++i) {
        x[i] = *(const float4*)(xa + (size_t)row * D + lane * 4 + 256 * i);
        ss += x[i].x * x[i].x + x[i].y * x[i].y + x[i].z * x[i].z + x[i].w * x[i].w;
      }
      ss = wsum(ss);
      const float rstd = rsqrtf(ss * (1.f / D) + EPS);
      float lg0 = 0.f, lg1 = 0.f, lg2 = 0.f, lg3 = 0.f;
#pragma unroll
      for (int i = 0; i < 4; ++i) {
        const int col = lane * 4 + 256 * i;
        const float4 g = *(const float4*)(p.in[I_N2G] + l * D + col);
        const float4 sh = *(const float4*)(mod + (size_t)(l * 2 + b) * 6144 + 3072 + col);
        const float4 sc = *(const float4*)(mod + (size_t)(l * 2 + b) * 6144 + 4096 + col);
        x[i].x = x[i].x * rstd * g.x * (1.f + sc.x) + sh.x;
        x[i].y = x[i].y * rstd * g.y * (1.f + sc.y) + sh.y;
        x[i].z = x[i].z * rstd * g.z * (1.f + sc.z) + sh.z;
        x[i].w = x[i].w * rstd * g.w * (1.f + sc.w) + sh.w;
        *(h16x4*)(hout + (size_t)row * D + col) = pack4(x[i].x, x[i].y, x[i].z, x[i].w);
        const float4 w0 = *(const float4*)(rgw + (size_t)(col + 0) * 4), w1 = *(const float4*)(rgw + (size_t)(col + 1) * 4);
        const float4 w2 = *(const float4*)(rgw + (size_t)(col + 2) * 4), w3 = *(const float4*)(rgw + (size_t)(col + 3) * 4);
        lg0 += x[i].x * w0.x + x[i].y * w1.x + x[i].z * w2.x + x[i].w * w3.x;
        lg1 += x[i].x * w0.y + x[i].y * w1.y + x[i].z * w2.y + x[i].w * w3.y;
        lg2 += x[i].x * w0.z + x[i].y * w1.z + x[i].z * w2.z + x[i].w * w3.z;
        lg3 += x[i].x * w0.w + x[i].y * w1.w + x[i].z * w2.w + x[i].w * w3.w;
      }
      lg0 = wsum(lg0) + rgb[0]; lg1 = wsum(lg1) + rgb[1]; lg2 = wsum(lg2) + rgb[2]; lg3 = wsum(lg3) + rgb[3];
      int gs = 0; float gm = lg0;
      if (lg1 > gm) { gm = lg1; gs = 1; }
      if (lg2 > gm) { gm = lg2; gs = 2; }
      if (lg3 > gm) { gm = lg3; gs = 3; }
      const float pg = 1.f / (__expf(lg0 - gm) + __expf(lg1 - gm) + __expf(lg2 - gm) + __expf(lg3 - gm));
      const float* rew = p.in[I_REW] + ((size_t)(l * 4 + gs) * 1024) * 4;
      const float* reb = p.in[I_REB] + (l * 4 + gs) * 4;
      float e0 = 0.f, e1 = 0.f, e2 = 0.f, e3 = 0.f;
#pragma unroll
      for (int i = 0; i < 4; ++i) {
        const int col = lane * 4 + 256 * i;
        const float4 w0 = *(const float4*)(rew + (size_t)(col + 0) * 4), w1 = *(const float4*)(rew + (size_t)(col + 1) * 4);
        const float4 w2 = *(const float4*)(rew + (size_t)(col + 2) * 4), w3 = *(const float4*)(rew + (size_t)(col + 3) * 4);
        e0 += x[i].x * w0.x + x[i].y * w1.x + x[i].z * w2.x + x[i].w * w3.x;
        e1 += x[i].x * w0.y + x[i].y * w1.y + x[i].z * w2.y + x[i].w * w3.y;
        e2 += x[i].x * w0.z + x[i].y * w1.z + x[i].z * w2.z + x[i].w * w3.z;
        e3 += x[i].x * w0.w + x[i].y * w1.w + x[i].z * w2.w + x[i].w * w3.w;
      }
      float le[4];
      le[0] = wsum(e0) + reb[0]; le[1] = wsum(e1) + reb[1]; le[2] = wsum(e2) + reb[2]; le[3] = wsum(e3) + reb[3];
      int i0 = 0; float v0 = le[0];
      if (le[1] > v0) { v0 = le[1]; i0 = 1; }
      if (le[2] > v0) { v0 = le[2]; i0 = 2; }
      if (le[3] > v0) { v0 = le[3]; i0 = 3; }
      int i1 = -1; float v1 = -3.0e38f;
#pragma unroll
      for (int j = 0; j < 4; ++j) {
        const float vj = (j == 0 ? le[0] : j == 1 ? le[1] : j == 2 ? le[2] : le[3]);
        if (j != i0 && vj > v1) { v1 = vj; i1 = j; }
      }
      const float p0 = 1.f / (1.f + __expf(v1 - v0));
      const float p1 = 1.f - p0;
      if (lane == 0) {
        const int ea = gs * 4 + i0, eb = gs * 4 + i1;
        const int ra = atomicAdd(&cntl[ea], 1);
        const int rb = atomicAdd(&cntl[eb], 1);
        tok[ti * 2] = ea | (ra << 8);
        tok[ti * 2 + 1] = eb | (rb << 8);
        wpair[row * 2] = pg * p0;
        wpair[row * 2 + 1] = pg * p1;
      }
    }
    __syncthreads();
    if (tid < 16) basel[tid] = (int)atomicAdd(&cnt[tid], (unsigned)cntl[tid]);
    __syncthreads();
    if (tid < 128) {
      const int v = tok[tid], e = v & 255, r = v >> 8;
      list[(size_t)e * 16384 + basel[e] + r] = (chunk * 64 + (tid >> 1)) * 2 + (tid & 1);
    }
    __syncthreads();
  }
}

__device__ __forceinline__ void moe_sched(const Params& p, int l, int* sl) {
  if (tidx() == 0) {
    const unsigned* cnt = (const unsigned*)(p.ws + OFF_CTL) + 64 + l * 16;
    int to = 0, ro = 0;
    sl[16] = 0; sl[33] = 0;
    for (int e = 0; e < 16; ++e) {
      const int c = (int)__hip_atomic_load(&cnt[e], __ATOMIC_RELAXED, __HIP_MEMORY_SCOPE_AGENT);
      sl[e] = c;
      to += (c + 255) >> 8; ro += c;
      sl[17 + e] = to; sl[34 + e] = ro;
    }
  }
  __syncthreads();
}
__device__ __forceinline__ void moe_tile(const int* sl, int t, int& e, int& nt, int& mt, int& cnt_e, int& roff_e) {
  int ee = 0;
  for (int k = 0; k < 15; ++k) ee += (t >= sl[17 + k] * 4) ? 1 : 0;
  ee = __builtin_amdgcn_readfirstlane(ee);
  const int t0 = __builtin_amdgcn_readfirstlane(sl[16 + ee]), t1 = __builtin_amdgcn_readfirstlane(sl[17 + ee]);
  const int nte = t1 - t0, rem = t - t0 * 4;
  e = ee; nt = rem / nte; mt = rem % nte;
  cnt_e = __builtin_amdgcn_readfirstlane(sl[ee]);
  roff_e = __builtin_amdgcn_readfirstlane(sl[33 + ee]);
}

__device__ __forceinline__ void phase_moe1(const Params& p, int l, h16* sm) {
  unsigned char* ws = p.ws;
  int* sl = (int*)((unsigned char*)sm + SCHED_OFF);
  moe_sched(p, l, sl);
  const h16* H = (const h16*)(ws + OFF_H16);
  const int* list = (const int*)(ws + OFF_LIST);
  h16* hid = (h16*)(ws + OFF_HID);
  const int total = __builtin_amdgcn_readfirstlane(sl[32]) * 4;
  const TileIter ti = xcd_tiles(total);
  for (int t = ti.cur; t < ti.end; t += ti.step) {
    int e, nt, mt, cnt_e, roff_e;
    moe_tile(sl, t, e, nt, mt, cnt_e, roff_e);
    const int* le = list + (size_t)e * 16384;
    f32x4 acc[8][4];
    gemm_mainloop(acc, [&](int r) { int so = mt * 256 + r; so = so < cnt_e ? so : 0; return H + (size_t)(le[so] >> 1) * D; },
                  (const h16*)(ws + OFF_WGU) + ((size_t)e * 1024 + nt * 256) * 1024, 1024, 16, sm);
    const int tid_e = tidx(), lane = tid_e & 63, wave = tid_e >> 6, wr = wave >> 2, wc = wave & 3, fr = lane & 15, fq = lane >> 4;
#pragma unroll
    for (int m = 0; m < 8; ++m) {
      const int so = mt * 256 + wr * 128 + m * 16 + fr;
      if (so < cnt_e) {
#pragma unroll
        for (int n2 = 0; n2 < 2; ++n2) {
          const f32x4 gt = acc[m][2 * n2], up = acc[m][2 * n2 + 1];
          const int col = nt * 128 + wc * 32 + n2 * 16 + 4 * fq;
          *(h16x4*)(hid + (size_t)(roff_e + so) * 512 + col) = pack4(silu_f(gt[0]) * up[0], silu_f(gt[1]) * up[1], silu_f(gt[2]) * up[2], silu_f(gt[3]) * up[3]);
        }
      }
    }
  }
}

__device__ __forceinline__ void phase_moe2(const Params& p, int l, h16* sm) {
  unsigned char* ws = p.ws;
  int* sl = (int*)((unsigned char*)sm + SCHED_OFF);
  moe_sched(p, l, sl);
  const int* list = (const int*)(ws + OFF_LIST);
  const float* wpair = (const float*)(ws + OFF_WPAIR);
  const h16* hid = (const h16*)(ws + OFF_HID);
  h16* yp = (h16*)(ws + OFF_YPAIR);
  const int total = __builtin_amdgcn_readfirstlane(sl[32]) * 4;
  const TileIter ti = xcd_tiles(total);
  for (int t = ti.cur; t < ti.end; t += ti.step) {
    int e, nt, mt, cnt_e, roff_e;
    moe_tile(sl, t, e, nt, mt, cnt_e, roff_e);
    const int* le = list + (size_t)e * 16384;
    const h16* Ab = hid + (size_t)(roff_e + mt * 256) * 512;
    f32x4 acc[8][4];
    gemm_mainloop(acc, [&](int r) { return Ab + (size_t)r * 512; }, (const h16*)(ws + OFF_WDN) + ((size_t)e * 1024 + nt * 256) * 512, 512, 8, sm);
    const int tid_e = tidx(), lane = tid_e & 63, wave = tid_e >> 6, wr = wave >> 2, wc = wave & 3, fr = lane & 15, fq = lane >> 4;
#pragma unroll
    for (int m = 0; m < 8; ++m) {
      const int so = mt * 256 + wr * 128 + m * 16 + fr;
      if (so < cnt_e) {
        const int pair = le[so];
        const float w = wpair[pair];
#pragma unroll
        for (int n = 0; n < 4; ++n) {
          const int col = nt * 256 + wc * 64 + n * 16 + 4 * fq;
          *(h16x4*)(yp + (size_t)pair * D + col) = pack4(acc[m][n][0] * w, acc[m][n][1] * w, acc[m][n][2] * w, acc[m][n][3] * w);
        }
      }
    }
  }
}

#define XB_TMO      128
#define XB_XCNT(j)  (256  + 64 * (j))
#define XB_XSUB(j)  (1280 + 64 * (j))
#define XB_XGEN(j)  (2304 + 64 * (j))
#define XB_TOP      3328
#define XB_TOPGEN   3392
#define XCD_BAR_WORDS 3456
#define XB_SPIN_CAP (1u << 20)
__device__ __forceinline__ unsigned xb_ld(unsigned* p) { return __hip_atomic_load(p, __ATOMIC_RELAXED, __HIP_MEMORY_SCOPE_AGENT); }
__device__ __forceinline__ unsigned xb_add(unsigned* p, unsigned v) { return __hip_atomic_fetch_add(p, v, __ATOMIC_RELAXED, __HIP_MEMORY_SCOPE_AGENT); }
__device__ __forceinline__ unsigned xb_xcc_id() { return (unsigned)__builtin_amdgcn_s_getreg((3 << 11) | 20) & 0xFu; }
#define XB_SPIN(cond, bar) do { unsigned _sp = 0; while (cond) { __builtin_amdgcn_s_sleep(1); \
    if ((++_sp & 255u) == 0u) { if (xb_ld(&(bar)[XB_TMO])) break; if (_sp > XB_SPIN_CAP) { atomicAdd(&(bar)[XB_TMO], 1u); break; } } } } while (0)
struct XBar { unsigned* bar; unsigned x; volatile unsigned* st; };
__device__ __forceinline__ void xbar_post(XBar& b, unsigned* bar, volatile unsigned* st) {
  b.bar = bar; b.x = xb_xcc_id(); b.st = st;
  if (tidx() == 0) { st[0] = 0u; st[1] = 0u; (void)xb_add(&bar[XB_XCNT(b.x)], 1u); }
}
__device__ __forceinline__ void xbar_census(unsigned* bar, unsigned x, unsigned& nloc, unsigned& nx) {
  const unsigned G = gridDim.x;
  unsigned sum, cnt, mine, sp = 0u;
  for (;;) {
    sum = 0u; cnt = 0u; mine = 0u;
#pragma unroll
    for (unsigned j = 0; j < 16; ++j) { const unsigned c = xb_ld(&bar[XB_XCNT(j)]); sum += c; cnt += (c > 0u) ? 1u : 0u; mine = (j == x) ? c : mine; }
    if (sum == G) break;
    __builtin_amdgcn_s_sleep(1);
    if ((++sp & 255u) == 0u) { if (xb_ld(&bar[XB_TMO])) break; if (sp > XB_SPIN_CAP) { atomicAdd(&bar[XB_TMO], 1u); break; } }
  }
  nloc = mine > 0u ? mine : 1u; nx = cnt > 0u ? cnt : 1u;
}
__device__ __forceinline__ void xbar_sync(XBar& b) {
  asm volatile("s_waitcnt vmcnt(0)" ::: "memory");
  __syncthreads();
  if (tidx() == 0) {
    unsigned* bar = b.bar;
    __builtin_amdgcn_s_waitcnt(0);
    unsigned nloc = b.st[0], nx = b.st[1];
    if (nloc == 0u) { xbar_census(bar, b.x, nloc, nx); b.st[0] = nloc; b.st[1] = nx; }
    const unsigned old = xb_add(&bar[XB_XSUB(b.x)], 1u);
    const unsigned gen = old / nloc;
    if (old + 1u == (gen + 1u) * nloc) {
      __builtin_amdgcn_fence(__ATOMIC_RELEASE, "agent");
      asm volatile("s_waitcnt vmcnt(0)" ::: "memory");
      const unsigned og = xb_add(&bar[XB_TOP], 1u);
      const unsigned tg = og / nx;
      if (og + 1u == (tg + 1u) * nx) xb_add(&bar[XB_TOPGEN], 1u);
      else XB_SPIN(xb_ld(&bar[XB_TOPGEN]) == tg, bar);
      __builtin_amdgcn_fence(__ATOMIC_ACQUIRE, "agent");
      xb_add(&bar[XB_XGEN(b.x)], 1u);
      asm volatile("s_waitcnt vmcnt(0)" ::: "memory");
    } else {
      XB_SPIN(xb_ld(&bar[XB_XGEN(b.x)]) == gen, bar);
      __builtin_amdgcn_fence(__ATOMIC_ACQUIRE, "agent");
      asm volatile("s_waitcnt vmcnt(0)" ::: "memory");
    }
  }
  __syncthreads();
}

constexpr int NSTEPS = 22;
#define STEP(k, body) do { if (s_lo <= (k) && (k) < s_hi) { body; if ((k) + 1 < s_hi) { if ((k) == 0) grid.sync(); else xbar_sync(xb); } \
    if (PROBE_MASK != 0u) { unsigned long long now_ = __builtin_amdgcn_s_memrealtime(); \
      if ((PROBE_MASK >> (k)) & 1u) { const unsigned long long w_ = (now_ - pt_prev) * PROBE_AMP; \
        while (__builtin_amdgcn_s_memrealtime() - now_ < w_) __builtin_amdgcn_s_sleep(8); now_ = __builtin_amdgcn_s_memrealtime(); } \
      pt_prev = now_; } } } while (0)
#define LAYER_STEPS(l, base) \
  STEP(base + 0, phase_norm1(p, l); if (l == 1) phase_convert(p, 1, (float*)smem)); \
  STEP(base + 1, phase_inproj(p, (h16*)smem)); \
  STEP(base + 2, phase_post(p)); \
  STEP(base + 3, phase_mixa(p, l, smem)); \
  STEP(base + 4, phase_mixb(p, l, (float*)smem)); \
  STEP(base + 5, phase_attn(p, l, (float*)smem)); \
  STEP(base + 6, phase_outproj(p, l, (h16*)smem)); \
  STEP(base + 7, phase_router(p, l, (int*)smem)); \
  STEP(base + 8, phase_moe1(p, l, (h16*)smem)); \
  STEP(base + 9, phase_moe2(p, l, (h16*)smem))

__global__ void __launch_bounds__(NTHREADS, 2) mega(Params p, int s_lo, int s_hi) {
  extern __shared__ __attribute__((aligned(16))) unsigned char smem[];
  cg::grid_group grid = cg::this_grid();
  unsigned long long pt_prev = PROBE_MASK != 0u ? __builtin_amdgcn_s_memrealtime() : 0ull;
  XBar xb;
  xbar_post(xb, (unsigned*)(p.ws + OFF_BAR), (volatile unsigned*)(smem + LDS_BYTES - 16));
  STEP(0, phase_prep(p, (float*)smem); phase_convert(p, 0, (float*)smem));
  LAYER_STEPS(0, 1);
  LAYER_STEPS(1, 11);
  STEP(21, phase_norm1(p, 2));
}

extern "C" void kernel_launch(void* const* d_in, const int* in_sizes, int n_in, void* d_out, int out_size, void* d_ws, size_t ws_size,
                              hipStream_t stream) {
  static int grid_blocks = 0;
  if (!grid_blocks) {
    if (n_in != 35 || out_size != T * D || ws_size < WS_TOTAL) {
      fprintf(stderr, "kernel_launch: unexpected problem (n_in %d, out %d, ws %zu < %zu)\n", n_in, out_size, ws_size, (size_t)WS_TOTAL);
      grid_blocks = -1;
      return;
    }
    int dev = 0, cus = 0, per_cu = 0;
    hipGetDevice(&dev);
    hipDeviceGetAttribute(&cus, hipDeviceAttributeMultiprocessorCount, dev);
    if (hipFuncSetAttribute((const void*)mega, hipFuncAttributeMaxDynamicSharedMemorySize, LDS_BYTES) != hipSuccess) {
      fprintf(stderr, "kernel_launch: hipFuncSetAttribute(%d B dynamic LDS) failed\n", LDS_BYTES);
      grid_blocks = -1;
      return;
    }
    hipOccupancyMaxActiveBlocksPerMultiprocessor(&per_cu, mega, NTHREADS, LDS_BYTES);
    if (per_cu > 1) per_cu = 1;
    if (per_cu < 1) { fprintf(stderr, "kernel_launch: occupancy query returned %d\n", per_cu); grid_blocks = -1; return; }
    grid_blocks = cus * per_cu;
  }
  if (grid_blocks < 0) return;
  Params p{};
  for (int i = 0; i < 35; ++i) p.in[i] = (const float*)d_in[i];
  p.out = (float*)d_out;
  p.ws = (unsigned char*)d_ws;
  for (int i = 0; i < 32; ++i) p.inv_freq[i] = std::pow(10000.0, -(double)(2 * i) / 64.0);
  if (hipMemsetAsync((char*)d_ws + OFF_BAR, 0, 16384, stream) != hipSuccess) { fprintf(stderr, "kernel_launch: memset of barrier words failed\n"); return; }
#if MEGA
  int lo = 0, hi = NSTEPS;
  void* args[] = {&p, &lo, &hi};
  hipError_t e = hipLaunchCooperativeKernel((void*)mega, dim3(grid_blocks), dim3(NTHREADS), args, LDS_BYTES, stream);
  if (e != hipSuccess) fprintf(stderr, "cooperative launch failed: %s (grid %d)\n", hipGetErrorString(e), grid_blocks);
#else
  for (int s = 0; s < NSTEPS; ++s) {
    int lo = s, hi = s + 1;
    void* args[] = {&p, &lo, &hi};
    hipError_t e = hipLaunchCooperativeKernel((void*)mega, dim3(grid_blocks), dim3(NTHREADS), args, LDS_BYTES, stream);
    if (e != hipSuccess) { fprintf(stderr, "launch %d failed: %s (grid %d)\n", s, hipGetErrorString(e), grid_blocks); break; }
  }
#endif
}
```

```cpp
#include <hip/hip_runtime.h>
#include <hip/hip_cooperative_groups.h>
#include <cstdio>
#include <cstdint>
#include <cmath>
namespace cg = cooperative_groups;

#ifndef MEGA
#define MEGA 1
#endif
#ifndef PROBE_MASK
#define PROBE_MASK 0u
#define PROBE_AMP 3
#endif

typedef _Float16 h16;
typedef _Float16 h16x8 __attribute__((ext_vector_type(8)));
typedef _Float16 h16x4 __attribute__((ext_vector_type(4)));
typedef float f32x4 __attribute__((ext_vector_type(4)));

constexpr int NB = 2, S = 8192, T = NB * S, D = 1024;
constexpr int NIN = 2432;
constexpr int NINSRC = 2328;
constexpr int C_XL = 0, C_GL = 256, C_Q = 512, C_KC = 1024, C_VC = 1152, C_KS = 1280, C_VS = 1408, C_KW = 1536, C_VW = 1664,
              C_CVA = 1792, C_CVB = 2048, C_GATE = 2304;
constexpr float EPS = 1e-6f;
constexpr int NTHREADS = 512, NW = 8;
constexpr int LDS_BYTES = 147456;
constexpr int NINP = 2560;
constexpr int SCHED_OFF = LDS_BYTES - 1024;
constexpr float ASCALE = 16.f;

constexpr size_t al256(size_t x) { return (x + 255) & ~(size_t)255; }
constexpr size_t OFF_CTL = 0;
constexpr size_t OFF_BAR = 4096;
constexpr size_t OFF_MOD = 4096 + 16384;
constexpr size_t OFF_ROPE = al256(OFF_MOD + 2 * 2 * 6144 * 4);
constexpr size_t OFF_PB = al256(OFF_ROPE + (size_t)T * 64 * 4);
constexpr size_t OFF_PBPART = al256(OFF_PB + 2 * 256 * 4);
constexpr size_t OFF_GATES = al256(OFF_PBPART + 2 * 32 * 256 * 4);
constexpr size_t OFF_WIN = al256(OFF_GATES + (size_t)T * 24 * 4);
constexpr size_t OFF_WOUT = al256(OFF_WIN + (size_t)NINP * 1024 * 2);
constexpr size_t OFF_WGU = al256(OFF_WOUT + (size_t)1024 * 1024 * 2);
constexpr size_t OFF_WDN = al256(OFF_WGU + (size_t)16 * 1024 * 1024 * 2);
constexpr size_t OFF_W1K = al256(OFF_WDN + (size_t)16 * 1024 * 512 * 2);
constexpr size_t OFF_W1V = al256(OFF_W1K + (size_t)256 * 2048 * 2);
constexpr size_t OFF_H16 = al256(OFF_W1V + (size_t)256 * 2048 * 2);
constexpr size_t OFF_Q16 = al256(OFF_H16 + (size_t)T * 1024 * 2);
constexpr size_t KVSZ = (size_t)T * 128 * 2;
constexpr size_t OFF_KC = al256(OFF_Q16 + (size_t)T * 512 * 2);
constexpr size_t OFF_VC = al256(OFF_KC + KVSZ + 4096);
constexpr size_t OFF_KS = al256(OFF_VC + KVSZ + 4096);
constexpr size_t OFF_VST = al256(OFF_KS + KVSZ);
constexpr size_t OFF_KW = al256(OFF_VST + KVSZ);
constexpr size_t OFF_VWT = al256(OFF_KW + KVSZ);
constexpr size_t OFF_HIDC = al256(OFF_VWT + KVSZ);
constexpr size_t OFF_KCMP = al256(OFF_HIDC + (size_t)2 * 2048 * 256 * 2);
constexpr size_t OFF_VCMPT = al256(OFF_KCMP + (size_t)4 * 512 * 64 * 2);
constexpr size_t OFF_LRUH = al256(OFF_VCMPT + (size_t)4 * 512 * 64 * 2);
constexpr size_t OFF_LRUA = al256(OFF_LRUH + (size_t)T * 256 * 4);
constexpr size_t OFF_HEND = al256(OFF_LRUA + (size_t)T * 256 * 4);
constexpr size_t OFF_AEND = al256(OFF_HEND + 2 * 256 * 256 * 4);
constexpr size_t OFF_CARRY = al256(OFF_AEND + 2 * 256 * 256 * 4);
constexpr size_t OFF_XA = al256(OFF_CARRY + 2 * 256 * 256 * 4);
constexpr size_t OFF_LIST = al256(OFF_XA + (size_t)T * 1024 * 4);
constexpr size_t OFF_WPAIR = al256(OFF_LIST + (size_t)16 * 16384 * 4);
constexpr size_t OFF_SSQ = al256(OFF_WPAIR + 32768 * 4);
constexpr size_t OFF_R = al256(OFF_SSQ + (size_t)T * 2 * 4);
constexpr size_t OFF_P16 = OFF_R;
constexpr size_t OFF_HID = OFF_R;
constexpr size_t OFF_YPAIR = al256(OFF_HID + (size_t)(32768 + 512) * 512 * 2);
constexpr size_t OFF_HIDP = al256(OFF_P16 + (size_t)T * NIN * 2);
constexpr size_t R_END1 = OFF_HIDP + (size_t)4 * 2 * 2048 * 256 * 4;
constexpr size_t R_END2 = OFF_YPAIR + (size_t)32768 * 1024 * 2;
constexpr size_t WS_TOTAL = al256(R_END1 > R_END2 ? R_END1 : R_END2);

struct Params {
  const float* in[35];
  float* out;
  unsigned char* ws;
  double inv_freq[32];
};
enum { I_X = 0, I_C, I_POS, I_ADAW, I_ADAB, I_N1G, I_N2G, I_WIN, I_LCW, I_LCB, I_LWA, I_LBA, I_LWX, I_LBX, I_LLAM, I_CKW1, I_CKW2,
       I_CVW1, I_CVW2, I_CPK, I_CPV, I_DWW, I_DWB, I_LNG, I_LNB, I_ONG, I_WOUT, I_RGW, I_RGB, I_REW, I_REB, I_MG, I_MU, I_MD, I_FNG };

__device__ __forceinline__ int tidx() { int t = threadIdx.x; asm volatile("" : "+v"(t)); return t; }
__device__ __forceinline__ float wsum(float v) {
#pragma unroll
  for (int o = 32; o > 0; o >>= 1) v += __shfl_xor(v, o);
  return v;
}
__device__ __forceinline__ float sigm(float x) { return 1.f / (1.f + __expf(-x)); }
__device__ __forceinline__ float silu_f(float x) { return x / (1.f + __expf(-x)); }
__device__ __forceinline__ float gelu_tanh(float x) {
  float u = 0.7978845608028654f * (x + 0.044715f * x * x * x);
  float e = __expf(2.f * u);
  float t = 1.f - 2.f / (e + 1.f);
  return 0.5f * x * (1.f + t);
}
__device__ __forceinline__ void glds16(const h16* g, h16* l) {
  __builtin_amdgcn_global_load_lds((const unsigned*)g, (unsigned*)l, 16, 0, 0);
}
__device__ __forceinline__ h16x4 pack4(float a, float b, float c, float d) {
  h16x4 r; r[0] = (h16)a; r[1] = (h16)b; r[2] = (h16)c; r[3] = (h16)d; return r;
}

struct TileIter { int cur, end, step; };
__device__ __forceinline__ TileIter xcd_tiles(int ntiles) {
  const int G = gridDim.x, b = blockIdx.x;
  TileIter it;
  if ((G & 7) == 0) {
    const int x = b & 7;
    it.cur = (int)(((long)ntiles * x) >> 3) + (b >> 3);
    it.end = (int)(((long)ntiles * (x + 1)) >> 3);
    it.step = G >> 3;
  } else { it.cur = b; it.end = ntiles; it.step = G; }
  return it;
}

#define VMCNT(n) asm volatile("s_waitcnt vmcnt(" #n ")" ::: "memory")
template <class ARowFn>
__device__ __forceinline__ void gemm_mainloop(f32x4 (&acc)[8][4], ARowFn arow, const h16* __restrict__ Bt, int ldb, int nk, h16* sm, bool zero_init = true) {
  const int tid = tidx(), lane = tid & 63, wave = tid >> 6;
  const int wr = wave >> 2, wc = wave & 3, fr = lane & 15, fq = lane >> 4;
  const h16* ap[4];
  const h16* bp[4];
#pragma unroll
  for (int i = 0; i < 4; ++i) {
    const int r = (i * 8 + wave) * 8 + (lane >> 3);
    const int c = (lane & 7) ^ ((r >> 1) & 7);
    ap[i] = arow(r) + c * 8;
    bp[i] = Bt + (size_t)r * ldb + c * 8;
  }
  if (zero_init) {
#pragma unroll
    for (int m = 0; m < 8; ++m)
#pragma unroll
      for (int n = 0; n < 4; ++n) acc[m][n] = (f32x4){0.f, 0.f, 0.f, 0.f};
  }
  h16* const dA = sm + wave * 512 + lane * 8;
#pragma unroll
  for (int i = 0; i < 4; ++i) { glds16(ap[i], dA + i * 4096); glds16(bp[i], dA + 16384 + i * 4096); ap[i] += 64; bp[i] += 64; }
  const int sw = (fr >> 1) & 7;
  const int aoff = (wr * 128 + fr) * 64, boff = 16384 + (wc * 64 + fr) * 64;
#define SCHED_FENCE() __builtin_amdgcn_sched_barrier(0)
  for (int kt = 0; kt < nk; ++kt) {
    VMCNT(0);
    __builtin_amdgcn_s_barrier();
    const h16* st = sm + (kt & 1) * 32768;
    const bool more = kt + 1 < nk;
    h16* const dn = dA + ((kt + 1) & 1) * 32768;
#pragma unroll
    for (int ks = 0; ks < 2; ++ks) {
      const int ch = ((ks * 4 + fq) ^ sw) * 8;
      h16x8 bf[4];
#pragma unroll
      for (int n = 0; n < 4; ++n) bf[n] = *(const h16x8*)(st + boff + n * 1024 + ch);
#pragma unroll
      for (int mh = 0; mh < 2; ++mh) {
        h16x8 af[4];
#pragma unroll
        for (int m = 0; m < 4; ++m) af[m] = *(const h16x8*)(st + aoff + (mh * 4 + m) * 1024 + ch);
#pragma unroll
        for (int m = 0; m < 4; ++m) {
#pragma unroll
          for (int n = 0; n < 4; ++n) acc[mh * 4 + m][n] = __builtin_amdgcn_mfma_f32_16x16x32_f16(bf[n], af[m], acc[mh * 4 + m][n], 0, 0, 0);
          if (m == 1 || m == 3) {
            const int q = ks * 4 + mh * 2 + (m >> 1);
            SCHED_FENCE();
            if (more) {
              if (q < 4) { glds16(ap[q & 3], dn + (q & 3) * 4096); ap[q & 3] += 64; }
              else { glds16(bp[q & 3], dn + 16384 + (q & 3) * 4096); bp[q & 3] += 64; }
            }
            SCHED_FENCE();
          }
        }
      }
    }
  }
#undef SCHED_FENCE
  __builtin_amdgcn_s_barrier();
}

__device__ __forceinline__ int map_row(int mode, int n) {
  if (mode == 1) return n < 1792 ? n : (n < 1816 ? n + 512 : n - 24);
  if (mode == 2) return 32 * (n >> 4) + (n & 15);
  if (mode == 3) return 32 * (n >> 4) + 16 + (n & 15);
  return n;
}
struct ConvTile { const float* src; h16* dst; int K, N, mode, k0, n0; const float* pos; float* pbp; };
__device__ __forceinline__ ConvTile conv_decode(const Params& p, int l, int t) {
  unsigned char* ws = p.ws;
  constexpr int T_WIN = 16 * 37, T_WOUT = 256, T_G = 16 * 128, T_W1 = 128;
  constexpr int E0 = T_WIN, E1 = E0 + T_WOUT, E2 = E1 + T_G, E3 = E2 + T_G, E4 = E3 + T_G, E5 = E4 + T_W1;
  ConvTile c;
  c.pos = nullptr; c.pbp = nullptr;
  int tk, tn;
  if (t < E0) {
    c.src = p.in[I_WIN] + (size_t)l * 1024 * NINSRC; c.K = 1024; c.N = NINSRC; c.dst = (h16*)(ws + OFF_WIN); c.mode = 1; tk = t / 37; tn = t % 37;
  } else if (t < E1) {
    const int u = t - E0;
    c.src = p.in[I_WOUT] + (size_t)l * 1024 * 1024; c.K = 1024; c.N = 1024; c.dst = (h16*)(ws + OFF_WOUT); c.mode = 4; tk = u >> 4; tn = u & 15;
  } else if (t < E3) {
    const int up = t >= E2;
    const int u = t - (up ? E2 : E1);
    const int e = u >> 7, v = u & 127;
    c.src = p.in[up ? I_MU : I_MG] + ((size_t)l * 16 + e) * 1024 * 512; c.K = 1024; c.N = 512; c.dst = (h16*)(ws + OFF_WGU) + (size_t)e * 1024 * 1024;
    c.mode = up ? 3 : 2; tk = v >> 3; tn = v & 7;
  } else if (t < E4) {
    const int u = t - E3;
    const int e = u >> 7, v = u & 127;
    c.src = p.in[I_MD] + ((size_t)l * 16 + e) * 512 * 1024; c.K = 512; c.N = 1024; c.dst = (h16*)(ws + OFF_WDN) + (size_t)e * 1024 * 512; c.mode = 0; tk = v >> 4; tn = v & 15;
  } else {
    const int vv = t >= E5;
    const int u = t - (vv ? E5 : E4);
    c.src = p.in[vv ? I_CVW1 : I_CKW1] + (size_t)l * 2048 * 256; c.K = 2048; c.N = 256; c.dst = (h16*)(ws + (vv ? OFF_W1V : OFF_W1K)); c.mode = 5; tk = u >> 2; tn = u & 3;
    c.pos = p.in[vv ? I_CPV : I_CPK] + (size_t)l * 2048 + tk * 64;
    c.pbp = (float*)(ws + OFF_PBPART) + (size_t)(vv * 32 + tk) * 256 + tn * 64;
  }
  c.k0 = tk * 64; c.n0 = tn * 64;
  return c;
}
__device__ __forceinline__ void conv_wave_tile(const ConvTile& c, float* smw, int lane) {
  float4 v[16];
#pragma unroll
  for (int i = 0; i < 16; ++i) {
    const int idx = i * 64 + lane;
    const int r = idx >> 4, c4 = (idx & 15) * 4;
    v[i] = make_float4(0.f, 0.f, 0.f, 0.f);
    if (c.n0 + c4 < c.N) v[i] = *(const float4*)(c.src + (size_t)(c.k0 + r) * c.N + c.n0 + c4);
  }
#pragma unroll
  for (int i = 0; i < 16; ++i) {
    const int idx = i * 64 + lane;
    const int r = idx >> 4, c4 = (idx & 15) * 4;
    float* d = smw + r * 65 + c4;
    d[0] = v[i].x; d[1] = v[i].y; d[2] = v[i].z; d[3] = v[i].w;
  }
  if (c.mode == 5) {
    float sacc = 0.f;
    for (int k = 0; k < 64; ++k) sacc += c.pos[k] * smw[k * 65 + lane];
    c.pbp[lane] = sacc;
  }
  const int k0d = c.mode == 4 ? (c.k0 < 256 ? c.k0 + 512 : (c.k0 < 768 ? c.k0 - 256 : c.k0)) : c.k0;
#pragma unroll
  for (int j = 0; j < 8; ++j) {
    const int ch = j * 64 + lane;
    const int n = ch >> 3, kc = ch & 7;
    if (c.n0 + n < c.N) {
      h16x8 o;
#pragma unroll
      for (int q = 0; q < 8; ++q) o[q] = (h16)smw[(kc * 8 + q) * 65 + n];
      *(h16x8*)(c.dst + (size_t)map_row(c.mode, c.n0 + n) * c.K + k0d + kc * 8) = o;
    }
  }
}

__device__ __forceinline__ void phase_convert(const Params& p, int l, float* sm) {
  unsigned char* ws = p.ws;
  constexpr int NT_CONV = 16 * 37 + 256 + 3 * 16 * 128 + 2 * 128;
  {
    const int tid = tidx(), lane = tid & 63, wave = tid >> 6;
    float* smw = sm + wave * 4160;
    for (int t = blockIdx.x * NW + wave; t < NT_CONV; t += gridDim.x * NW) {
      const ConvTile c = conv_decode(p, l, t);
      conv_wave_tile(c, smw, lane);
    }
    __syncthreads();
  }
  {
    h16x8 z = {0, 0, 0, 0, 0, 0, 0, 0};
    h16* w = (h16*)(ws + OFF_WIN) + (size_t)NINSRC * 1024;
    for (int i = blockIdx.x * NTHREADS + tidx(); i < (NINP - NINSRC) * 1024 / 8; i += gridDim.x * NTHREADS) *(h16x8*)(w + (size_t)i * 8) = z;
  }
}

__device__ __forceinline__ void phase_prep(const Params& p, float* sm) {
  unsigned char* ws = p.ws;
  const int tid = tidx();
  if (blockIdx.x == 0) {
    for (int i = tid; i < 1024; i += NTHREADS) ((unsigned*)(ws + OFF_CTL))[i] = 0u;
  }
  float* mod = (float*)(ws + OFF_MOD);
  for (int t = blockIdx.x; t < 384; t += gridDim.x) {
    const int l = t / 192, j0 = (t % 192) * 32;
    const int kg = tid >> 3, cq = tid & 7;
    const float* w = p.in[I_ADAW] + (size_t)l * 1024 * 6144 + j0 + 4 * cq;
    const float* c = p.in[I_C];
    float a0[4] = {0, 0, 0, 0}, a1[4] = {0, 0, 0, 0};
#pragma unroll 8
    for (int k = kg * 16; k < kg * 16 + 16; ++k) {
      const float4 wv = *(const float4*)(w + (size_t)k * 6144);
      const float s0 = silu_f(c[k]), s1 = silu_f(c[1024 + k]);
      a0[0] += s0 * wv.x; a0[1] += s0 * wv.y; a0[2] += s0 * wv.z; a0[3] += s0 * wv.w;
      a1[0] += s1 * wv.x; a1[1] += s1 * wv.y; a1[2] += s1 * wv.z; a1[3] += s1 * wv.w;
    }
    float* r = sm + (kg * 8 + cq) * 8;
#pragma unroll
    for (int i = 0; i < 4; ++i) { r[i] = a0[i]; r[4 + i] = a1[i]; }
    __syncthreads();
    if (tid < 64) {
      const int bb = tid >> 5, col = tid & 31, q = col >> 2, ci = col & 3;
      float s = 0.f;
      for (int g = 0; g < 64; ++g) s += sm[(g * 8 + q) * 8 + bb * 4 + ci];
      mod[(size_t)(l * 2 + bb) * 6144 + j0 + col] = s + p.in[I_ADAB][l * 6144 + j0 + col];
    }
    __syncthreads();
  }
  float* rc = (float*)(ws + OFF_ROPE);
  float* rs = rc + (size_t)T * 32;
  const int* pos = (const int*)p.in[I_POS];
  for (int i = blockIdx.x * NTHREADS + tid; i < T * 32; i += gridDim.x * NTHREADS) {
    const int t = i >> 5, f = i & 31;
    const double a = (double)pos[t] * p.inv_freq[f];
    const double n = rint(a * 0.15915494309189535);
    double r = fma(-n, 6.283185307179586, a);
    r = fma(-n, 2.4492935982947064e-16, r);
    const float rf = (float)r;
    rc[i] = cosf(rf);
    rs[i] = sinf(rf);
  }
}

__device__ __forceinline__ void phase_norm1(const Params& p, int mode) {
  unsigned char* ws = p.ws;
  const int lane = tidx() & 63, wave = tidx() >> 6;
  const float* mod = (const float*)(ws + OFF_MOD);
  float* xa = (float*)(ws + OFF_XA);
  const h16* yp = (const h16*)(ws + OFF_YPAIR);
  h16* hout = (h16*)(ws + OFF_H16);
  const int l = (mode == 0) ? 0 : 1;
  for (int row = blockIdx.x * NW + wave; row < T; row += gridDim.x * NW) {
    const int b = row >> 13;
    float4 x[4];
    float ss = 0.f;
#pragma unroll
    for (int i = 0; i < 4; ++i) {
      const int col = lane * 4 + 256 * i;
      if (mode == 0) {
        x[i] = *(const float4*)(p.in[I_X] + (size_t)row * D + col);
      } else {
        const int lp = mode == 1 ? 0 : 1;
        const float4 xv = *(const float4*)(xa + (size_t)row * D + col);
        const float4 g2 = *(const float4*)(mod + (size_t)(lp * 2 + b) * 6144 + 5120 + col);
        const h16x4 y0 = *(const h16x4*)(yp + (size_t)(row * 2) * D + col);
        const h16x4 y1 = *(const h16x4*)(yp + (size_t)(row * 2 + 1) * D + col);
        x[i].x = xv.x + g2.x * ((float)y0[0] + (float)y1[0]);
        x[i].y = xv.y + g2.y * ((float)y0[1] + (float)y1[1]);
        x[i].z = xv.z + g2.z * ((float)y0[2] + (float)y1[2]);
        x[i].w = xv.w + g2.w * ((float)y0[3] + (float)y1[3]);
        if (mode == 1) *(float4*)(xa + (size_t)row * D + col) = x[i];
      }
      ss += x[i].x * x[i].x + x[i].y * x[i].y + x[i].z * x[i].z + x[i].w * x[i].w;
    }
    ss = wsum(ss);
    const float rstd = rsqrtf(ss * (1.f / D) + EPS);
#pragma unroll
    for (int i = 0; i < 4; ++i) {
      const int col = lane * 4 + 256 * i;
      if (mode == 2) {
        const float4 g = *(const float4*)(p.in[I_FNG] + col);
        float4 o;
        o.x = x[i].x * rstd * g.x; o.y = x[i].y * rstd * g.y; o.z = x[i].z * rstd * g.z; o.w = x[i].w * rstd * g.w;
        *(float4*)(p.out + (size_t)row * D + col) = o;
      } else {
        const float4 g = *(const float4*)(p.in[I_N1G] + l * D + col);
        const float4 sh = *(const float4*)(mod + (size_t)(l * 2 + b) * 6144 + col);
        const float4 sc = *(const float4*)(mod + (size_t)(l * 2 + b) * 6144 + 1024 + col);
        *(h16x4*)(hout + (size_t)row * D + col) = pack4(x[i].x * rstd * g.x * (1.f + sc.x) + sh.x, x[i].y * rstd * g.y * (1.f + sc.y) + sh.y,
                                                        x[i].z * rstd * g.z * (1.f + sc.z) + sh.z, x[i].w * rstd * g.w * (1.f + sc.w) + sh.w);
      }
    }
  }
}

__device__ __forceinline__ void phase_inproj(const Params& p, h16* sm) {
  unsigned char* ws = p.ws;
  const h16* A = (const h16*)(ws + OFF_H16);
  const h16* W = (const h16*)(ws + OFF_WIN);
  h16* P = (h16*)(ws + OFF_P16);
  const TileIter ti = xcd_tiles(64 * 10);
  for (int t = ti.cur; t < ti.end; t += ti.step) {
    const int mt = t / 10, nt = t % 10;
    f32x4 acc[8][4];
    const h16* Ab = A + (size_t)mt * 256 * D;
    gemm_mainloop(acc, [&](int r) { return Ab + (size_t)r * D; }, W + (size_t)nt * 256 * D, D, D / 64, sm);
    const int tid_e = tidx(), lane = tid_e & 63, wave = tid_e >> 6, wr = wave >> 2, wc = wave & 3, fr = lane & 15, fq = lane >> 4;
    if (nt * 256 + wc * 64 < NIN) {
#pragma unroll
      for (int m = 0; m < 8; ++m)
#pragma unroll
        for (int n = 0; n < 4; ++n) {
          const int row = mt * 256 + wr * 128 + m * 16 + fr, col = nt * 256 + wc * 64 + n * 16 + 4 * fq;
          *(h16x4*)(P + (size_t)row * NIN + col) = pack4(acc[m][n][0], acc[m][n][1], acc[m][n][2], acc[m][n][3]);
        }
    }
  }
}

__device__ __forceinline__ int perm_key(int pos) {
  return 32 * (pos >> 5) + 16 * ((pos >> 2) & 1) + 4 * ((pos >> 3) & 3) + (pos & 3);
}
__device__ __forceinline__ void phase_post(const Params& p) {
  unsigned char* ws = p.ws;
  const h16* P = (const h16*)(ws + OFF_P16);
  const float* rc = (const float*)(ws + OFF_ROPE);
  const float* rs = rc + (size_t)T * 32;
  h16* q16 = (h16*)(ws + OFF_Q16);
  float* gates = (float*)(ws + OFF_GATES);
  const int lane = tidx() & 63, wave = tidx() >> 6;
  if (blockIdx.x == 0) {
    const int o = tidx();
    const float* pp = (const float*)(ws + OFF_PBPART) + (size_t)(o >> 8) * 32 * 256 + (o & 255);
    float acc = 0.f;
    for (int k = 0; k < 32; ++k) acc += pp[k * 256];
    ((float*)(ws + OFF_PB))[o] = acc;
  }
  for (int row = blockIdx.x * NW + wave; row < T; row += gridDim.x * NW) {
    const int b = row >> 13, s = row & (S - 1);
    const h16* pr = P + (size_t)row * NIN;
    const int d = (lane & 7) * 4;
    const float4 cs = *(const float4*)(rc + (size_t)row * 32 + d);
    const float4 sn = *(const float4*)(rs + (size_t)row * 32 + d);
    {
      const int hd = lane >> 3;
      const h16x4 a = *(const h16x4*)(pr + C_Q + 64 * hd + d);
      const h16x4 bb = *(const h16x4*)(pr + C_Q + 64 * hd + 32 + d);
      const float a0 = a[0], a1 = a[1], a2 = a[2], a3 = a[3], b0 = bb[0], b1 = bb[1], b2 = bb[2], b3 = bb[3];
      h16* qo = q16 + (size_t)row * 512 + 64 * hd + d;
      constexpr float QS = 0.125f * 1.4426950408889634f;
      *(h16x4*)qo = pack4((a0 * cs.x - b0 * sn.x) * QS, (a1 * cs.y - b1 * sn.y) * QS, (a2 * cs.z - b2 * sn.z) * QS, (a3 * cs.w - b3 * sn.w) * QS);
      *(h16x4*)(qo + 32) = pack4((b0 * cs.x + a0 * sn.x) * QS, (b1 * cs.y + a1 * sn.y) * QS, (b2 * cs.z + a2 * sn.z) * QS, (b3 * cs.w + a3 * sn.w) * QS);
    }
    if (lane < 48) {
      const int tn = lane >> 4, hd = (lane >> 3) & 1;
      const int cb = (tn == 0 ? C_KC : (tn == 1 ? C_KS : C_KW)) + 64 * hd;
      const size_t off = tn == 0 ? OFF_KC : (tn == 1 ? OFF_KS : OFF_KW);
      const h16x4 a = *(const h16x4*)(pr + cb + d);
      const h16x4 bb = *(const h16x4*)(pr + cb + 32 + d);
      const float a0 = a[0], a1 = a[1], a2 = a[2], a3 = a[3], b0 = bb[0], b1 = bb[1], b2 = bb[2], b3 = bb[3];
      h16* ko = (h16*)(ws + off) + ((size_t)(b * 2 + hd) * S + s) * 64 + d;
      *(h16x4*)ko = pack4(a0 * cs.x - b0 * sn.x, a1 * cs.y - b1 * sn.y, a2 * cs.z - b2 * sn.z, a3 * cs.w - b3 * sn.w);
      *(h16x4*)(ko + 32) = pack4(b0 * cs.x + a0 * sn.x, b1 * cs.y + a1 * sn.y, b2 * cs.z + a2 * sn.z, b3 * cs.w + a3 * sn.w);
    }
    if (lane < 32) {
      const int hd = lane >> 4, dd = (lane & 15) * 4;
      *(h16x4*)((h16*)(ws + OFF_VC) + ((size_t)(b * 2 + hd) * S + s) * 64 + dd) = *(const h16x4*)(pr + C_VC + 64 * hd + dd);
    }
    if (lane < 24) gates[(size_t)row * 24 + lane] = sigm((float)pr[C_GATE + lane]);
  }
  for (int task = blockIdx.x; task < 1024; task += gridDim.x) {
    const int tensor = task & 1, kv = (task >> 1) & 1, blk = (task >> 2) & 127, b = task >> 9;
    const int srccol = (tensor ? C_VW : C_VS) + 64 * kv;
    h16* dst = (h16*)(ws + (tensor ? OFF_VWT : OFF_VST)) + ((size_t)((b * 2 + kv) * 128 + blk)) * 4096;
    const int dim = tidx() & 63, kg = tidx() >> 6;
    {
      const int p0 = kg * 8;
      h16x8 v;
#pragma unroll
      for (int j = 0; j < 8; ++j) v[j] = P[(size_t)(b * S + blk * 64 + perm_key(p0 + j)) * NIN + srccol + dim];
      *(h16x8*)(dst + dim * 64 + p0) = v;
    }
  }
}

__device__ __forceinline__ void mixa_compress1(const Params& p, int item, h16* sm) {
  unsigned char* ws = p.ws;
  const int which = item >> 5, mt = (item >> 2) & 7, ks = item & 3;
  const h16* A = (const h16*)(ws + (which ? OFF_VC : OFF_KC)) + (size_t)mt * 256 * 1024 + ks * 512;
  const h16* W = (const h16*)(ws + (which ? OFF_W1V : OFF_W1K)) + ks * 512;
  float* hp = (float*)(ws + OFF_HIDP) + ((size_t)(ks * 2 + which) * 2048) * 256;
  f32x4 acc[8][4];
  gemm_mainloop(acc, [&](int r) { return A + (size_t)r * 1024; }, W, 2048, 8, sm);
  const int tid_e = tidx(), lane = tid_e & 63, wave = tid_e >> 6, wr = wave >> 2, wc = wave & 3, fr = lane & 15, fq = lane >> 4;
#pragma unroll
  for (int m = 0; m < 8; ++m)
#pragma unroll
    for (int n = 0; n < 4; ++n) {
      const int row = mt * 256 + wr * 128 + m * 16 + fr, col = wc * 64 + n * 16 + 4 * fq;
      *(f32x4*)(hp + (size_t)row * 256 + col) = acc[m][n];
    }
}

__device__ __forceinline__ void mixa_lru(const Params& p, int l, int item, float* sm) {
  unsigned char* ws = p.ws;
  const int half = tidx() >> 8;
  item = item * 2 + half;
  sm += half * 12288;
  const int b = item >> 8, ck = item & 255;
  const int c = tidx() & 255;
  const int nb = c >> 6, e = c & 63;
  const h16* P = (const h16*)(ws + OFF_P16);
  const float* cw = p.in[I_LCW] + l * 4 * 256;
  const float w0 = cw[c], w1 = cw[256 + c], w2 = cw[512 + c], w3 = cw[768 + c], cb = p.in[I_LCB][l * 256 + c];
  const float ba = p.in[I_LBA][l * 256 + c], bx = p.in[I_LBX][l * 256 + c];
  const float lam = p.in[I_LLAM][l * 256 + c];
  const float ls = -log1pf(expf(-lam));
  const float* pa = p.in[I_LWA] + ((size_t)(l * 4 + nb) * 64) * 64 + e;
  const float* px = p.in[I_LWX] + ((size_t)(l * 4 + nb) * 64) * 64 + e;
  const int t0 = ck * 32;
  float x0 = 0.f, x1 = 0.f, x2 = 0.f;
  if (t0 >= 3) {
    x0 = (float)P[(size_t)(b * S + t0 - 3) * NIN + C_XL + c];
    x1 = (float)P[(size_t)(b * S + t0 - 2) * NIN + C_XL + c];
    x2 = (float)P[(size_t)(b * S + t0 - 1) * NIN + C_XL + c];
  }
  float h = 0.f, ap = 1.f;
  float* lh = (float*)(ws + OFF_LRUH);
  float* la = (float*)(ws + OFF_LRUA);
  float* sr = sm + 4096;
  float* si = sm + 8192;
#pragma unroll 1
  for (int sub = 0; sub < 2; ++sub) {
    const int tb = t0 + sub * 16;
    {
      h16 xv[16];
      const h16* xp = P + (size_t)(b * S + tb) * NIN + C_XL + c;
#pragma unroll
      for (int tt = 0; tt < 16; ++tt) { xv[tt] = *xp; xp += NIN; asm volatile("" : "+v"(xp)); }
#pragma unroll
      for (int tt = 0; tt < 16; ++tt) {
        const float x3 = (float)xv[tt];
        sm[tt * 256 + c] = w0 * x0 + w1 * x1 + w2 * x2 + w3 * x3 + cb;
        x0 = x1; x1 = x2; x2 = x3;
      }
    }
    __syncthreads();
    {
      float accr[16], acci[16];
#pragma unroll
      for (int tt = 0; tt < 16; ++tt) { accr[tt] = 0.f; acci[tt] = 0.f; }
#pragma unroll 1
      for (int d8 = 0; d8 < 8; ++d8) {
        float wa8[8], wx8[8];
        const float* pa8 = pa + d8 * 512;
        const float* px8 = px + d8 * 512;
#pragma unroll
        for (int j = 0; j < 8; ++j) { wa8[j] = pa8[j * 64]; wx8[j] = px8[j * 64]; }
        const float* xr = sm + nb * 64 + d8 * 8;
#pragma unroll
        for (int tt = 0; tt < 16; ++tt) {
          const float4 xa = *(const float4*)(xr + tt * 256), xb = *(const float4*)(xr + tt * 256 + 4);
          accr[tt] += xa.x * wa8[0] + xa.y * wa8[1] + xa.z * wa8[2] + xa.w * wa8[3] + xb.x * wa8[4] + xb.y * wa8[5] + xb.z * wa8[6] + xb.w * wa8[7];
          acci[tt] += xa.x * wx8[0] + xa.y * wx8[1] + xa.z * wx8[2] + xa.w * wx8[3] + xb.x * wx8[4] + xb.y * wx8[5] + xb.z * wx8[6] + xb.w * wx8[7];
        }
      }
#pragma unroll
      for (int tt = 0; tt < 16; ++tt) { sr[tt * 256 + c] = accr[tt]; si[tt * 256 + c] = acci[tt]; }
    }
#pragma unroll 4
    for (int tt = 0; tt < 16; ++tt) {
      const float r = sigm(sr[tt * 256 + c] + ba), ig = sigm(si[tt * 256 + c] + bx);
      const float log_a = 8.f * r * ls;
      const float a = __expf(log_a);
      const float mult = sqrtf(-expm1f(2.f * log_a));
      sr[tt * 256 + c] = a;
      si[tt * 256 + c] = mult * ig * sm[tt * 256 + c];
    }
    float* lhp = lh + (size_t)(b * S + tb) * 256 + c;
    float* lap = la + (size_t)(b * S + tb) * 256 + c;
#pragma unroll 4
    for (int tt = 0; tt < 16; ++tt) {
      const float a = sr[tt * 256 + c];
      h = a * h + si[tt * 256 + c];
      ap *= a;
      lhp[tt * 256] = h;
      lap[tt * 256] = ap;
    }
    __syncthreads();
  }
  ((float*)(ws + OFF_HEND))[(size_t)(b * 256 + ck) * 256 + c] = h;
  ((float*)(ws + OFF_AEND))[(size_t)(b * 256 + ck) * 256 + c] = ap;
}

__device__ __forceinline__ void mixa_conv(const Params& p, int l, int item, float* sm) {
  unsigned char* ws = p.ws;
  const int half = tidx() >> 8;
  item = item * 2 + half;
  sm += half * 15872;
  const int b = item >> 8, ck = item & 255;
  const int c = tidx() & 255;
  const h16* P = (const h16*)(ws + OFF_P16);
  const int t0 = ck * 32;
#pragma unroll 1
  for (int r0 = 0; r0 < 64; r0 += 16) {
    h16 va[16], vb[16];
#pragma unroll
    for (int q = 0; q < 16; ++q) {
      const int t = t0 - 30 + r0 + q;
      va[q] = (h16)0.f; vb[q] = (h16)0.f;
      if (t >= 0 && r0 + q < 62) {
        const h16* pr = P + (size_t)(b * S + t) * NIN;
        va[q] = pr[C_CVA + c]; vb[q] = pr[C_CVB + c];
      }
    }
#pragma unroll
    for (int q = 0; q < 16; ++q)
      if (r0 + q < 62) sm[(r0 + q) * 256 + c] = (float)va[q] * sigm((float)vb[q]);
  }
  float w[31];
#pragma unroll
  for (int j = 0; j < 31; ++j) w[j] = p.in[I_DWW][(size_t)(l * 31 + j) * 256 + c];
  const float bias = p.in[I_DWB][l * 256 + c];
  for (int i = 0; i < 32; ++i) {
    float z = bias;
#pragma unroll
    for (int j = 0; j < 31; ++j) z += w[j] * sm[(i + j) * 256 + c];
    sm[i * 256 + c] = z;
  }
  __syncthreads();
  const int lane = tidx() & 63, wave = (tidx() >> 6) & 3;
  const float4 lg = *(const float4*)(p.in[I_LNG] + l * 256 + lane * 4);
  const float4 lb = *(const float4*)(p.in[I_LNB] + l * 256 + lane * 4);
  const float4 gn = *(const float4*)(p.in[I_ONG] + l * 1024 + 768 + lane * 4);
  h16* yc = (h16*)(ws + OFF_H16);
  for (int i = wave * 8; i < wave * 8 + 8; ++i) {
    const float4 z = *(const float4*)(sm + i * 256 + lane * 4);
    const float mu = wsum(z.x + z.y + z.z + z.w) * (1.f / 256.f);
    const float dx = z.x - mu, dy = z.y - mu, dz = z.z - mu, dw = z.w - mu;
    const float var = wsum(dx * dx + dy * dy + dz * dz + dw * dw) * (1.f / 256.f);
    const float rs = rsqrtf(var + EPS);
    const float y0 = silu_f(dx * rs * lg.x + lb.x), y1 = silu_f(dy * rs * lg.y + lb.y), y2 = silu_f(dz * rs * lg.z + lb.z), y3 = silu_f(dw * rs * lg.w + lb.w);
    const float r2 = rsqrtf(wsum(y0 * y0 + y1 * y1 + y2 * y2 + y3 * y3) * (1.f / 256.f) + EPS);
    *(h16x4*)(yc + (size_t)(b * S + t0 + i) * D + 768 + lane * 4) = pack4(y0 * r2 * gn.x, y1 * r2 * gn.y, y2 * r2 * gn.z, y3 * r2 * gn.w);
  }
  __syncthreads();
}

__device__ __forceinline__ void phase_mixa(const Params& p, int l, void* sm) {
  const int G = gridDim.x;
  for (int it = blockIdx.x; it < 64; it += G) mixa_compress1(p, it, (h16*)sm);
  for (int it = blockIdx.x; it < 256; it += G) mixa_lru(p, l, it, (float*)sm);
  for (int it = (blockIdx.x + G - 64 % G) % G; it < 256; it += G) mixa_conv(p, l, it, (float*)sm);
}

__device__ __forceinline__ void phase_mixb(const Params& p, int l, float* sm) {
  unsigned char* ws = p.ws;
  const int tid = tidx();
  for (int it = blockIdx.x; it < 512; it += gridDim.x) {
    const int which = it >> 8;
    const int row0 = (it & 255) * 8;
    {
      const float* hp = (const float*)(ws + OFF_HIDP) + ((size_t)which * 2048 + row0) * 256;
      const float* pb = (const float*)(ws + OFF_PB) + which * 256;
      const int r = tid >> 6, c4 = (tid & 63) * 4;
      const size_t o = (size_t)r * 256 + c4;
      const float4 a0 = *(const float4*)(hp + o), a1 = *(const float4*)(hp + (size_t)2 * 2048 * 256 + o);
      const float4 a2 = *(const float4*)(hp + (size_t)4 * 2048 * 256 + o), a3 = *(const float4*)(hp + (size_t)6 * 2048 * 256 + o);
      const float4 bb = *(const float4*)(pb + c4);
      float* d = sm + r * 256 + c4;
      d[0] = gelu_tanh(a0.x + a1.x + a2.x + a3.x + bb.x); d[1] = gelu_tanh(a0.y + a1.y + a2.y + a3.y + bb.y);
      d[2] = gelu_tanh(a0.z + a1.z + a2.z + a3.z + bb.z); d[3] = gelu_tanh(a0.w + a1.w + a2.w + a3.w + bb.w);
      const float4* wsrc = (const float4*)(p.in[which ? I_CVW2 : I_CKW2] + (size_t)l * 256 * 64);
      float4* wdst = (float4*)(sm + 2048);
#pragma unroll
      for (int q = 0; q < 8; ++q) wdst[q * NTHREADS + tid] = wsrc[q * NTHREADS + tid];
    }
    __syncthreads();
    const int row = row0 + (tid >> 6), d = tid & 63;
    const float* hr = sm + (tid >> 6) * 256;
    const float* w2 = sm + 2048 + d;
    float s = 0.f;
#pragma unroll 8
    for (int j = 0; j < 256; ++j) s += (float)(h16)hr[j] * w2[j * 64];
    const int bkv = row >> 9, n = row & 511;
    if (n == 511) s = 0.f;
    if (which == 0) {
      ((h16*)(ws + OFF_KCMP))[((size_t)bkv * 512 + n) * 64 + d] = (h16)s;
    } else {
      const int blk = n >> 6, key = n & 63;
      const int pos = 32 * (key >> 5) + 8 * ((key >> 2) & 3) + 4 * ((key >> 4) & 1) + (key & 3);
      ((h16*)(ws + OFF_VCMPT))[((size_t)(bkv * 8 + blk) * 64 + d) * 64 + pos] = (h16)s;
    }
    __syncthreads();
  }
  const int g = blockIdx.x * NTHREADS + tid;
  if (g < 512) {
    const int b = g >> 8, c = g & 255;
    const float* he = (const float*)(ws + OFF_HEND) + (size_t)b * 256 * 256 + c;
    const float* ae = (const float*)(ws + OFF_AEND) + (size_t)b * 256 * 256 + c;
    float* cy = (float*)(ws + OFF_CARRY) + (size_t)b * 256 * 256 + c;
    float carry = 0.f;
#pragma unroll 1
    for (int k0 = 0; k0 < 256; k0 += 32) {
      float hv[32], av[32];
#pragma unroll
      for (int k = 0; k < 32; ++k) { hv[k] = he[(k0 + k) * 256]; av[k] = ae[(k0 + k) * 256]; }
#pragma unroll
      for (int k = 0; k < 32; ++k) {
        cy[(k0 + k) * 256] = carry;
        carry = hv[k] + av[k] * carry;
      }
    }
  }
}

__device__ __forceinline__ void stage8k(const h16* __restrict__ g, h16* l, int tid) {
  const int r = tid >> 3, cl = (tid & 7) ^ ((r >> 1) & 7);
  glds16(g + r * 64 + cl * 8, l + tid * 8);
}
__device__ __forceinline__ h16x8 ldfrag(const h16* l, int row, int chunk) {
  return *(const h16x8*)(l + row * 64 + ((chunk ^ ((row >> 1) & 7)) * 8));
}

template <int MODE>
__device__ __forceinline__ void attn_branch(const h16* __restrict__ Kg, const h16* __restrict__ Vg, int j0, int j1, h16* ring,
                                            const h16x8 (&qf)[2][2], float (&m)[2], float (&l)[2], f32x4 (&o)[2][4],
                                            const int (&tq)[2], const int (&lim)[2], const int (&tlim)[2], const int (&tfl)[2],
                                            const unsigned long long (&mylo)[2], const unsigned long long (&myhi)[2],
                                            const unsigned long long (&ulo)[2], const unsigned long long (&uhi)[2],
                                            const float (&inv)[2], float* impw) {
  int tid = tidx();
  asm volatile("" : "+v"(tid));
  const int lane = tid & 63;
  const int h = lane >> 4, c = lane & 15, qi = c >> 2, g = c & 3;
  constexpr bool PV = MODE != 0;
  constexpr int NSLOT = 6;
  const int n = j1 - j0 + 1;
  if (n <= 0) return;
  const int nss = (n + 1) >> 1;
#pragma unroll
  for (int q = 0; q < 4; ++q)
    if (q < n) {
      stage8k(Kg + (size_t)(j0 + q) * 4096, ring + q * 8192, tid);
      if (PV) stage8k(Vg + (size_t)(j0 + q) * 4096, ring + q * 8192 + 4096, tid);
    }
  int sbase = 0;
  for (int ss = 0; ss < nss; ++ss) {
    {
      const int nb1 = n - 2 * (ss + 1);
      if (PV) { if (nb1 >= 2) VMCNT(4); else if (nb1 == 1) VMCNT(2); else VMCNT(0); }
      else    { if (nb1 >= 2) VMCNT(2); else if (nb1 == 1) VMCNT(1); else VMCNT(0); }
    }
    __builtin_amdgcn_s_barrier();
    {
      const int sn = sbase >= 2 ? sbase - 2 : sbase + 4;
#pragma unroll
      for (int q = 0; q < 2; ++q) {
        const int jb = 2 * (ss + 2) + q;
        if (jb < n) {
          stage8k(Kg + (size_t)(j0 + jb) * 4096, ring + (sn + q) * 8192, tid);
          if (PV) stage8k(Vg + (size_t)(j0 + jb) * 4096, ring + (sn + q) * 8192 + 4096, tid);
        }
      }
    }
#pragma unroll 1
   for (int sub = 0; sub < 2; ++sub) {
    const int it = 2 * ss + sub;
    if (it >= n) break;
    const int j = j0 + it;
    const h16* cK = ring + (sbase + sub) * 8192;
    const h16* cV = cK + 4096;
    bool act[2];
#pragma unroll
    for (int mq = 0; mq < 2; ++mq) {
      if (MODE <= 1) act[mq] = j * 64 <= tlim[mq];
      else if (MODE == 2) act[mq] = ((j < 64 ? (ulo[mq] >> j) : (uhi[mq] >> (j - 64))) & 1ull) != 0ull;
      else act[mq] = (j * 64 <= tlim[mq] + 3) && (j * 64 + 63 > tlim[mq] - 512);
    }
    if (act[0] || act[1]) {
      h16x8 pf[2][2];
      h16x8 kf[4][2];
#pragma unroll
      for (int kt = 0; kt < 4; ++kt)
#pragma unroll
        for (int ks = 0; ks < 2; ++ks) kf[kt][ks] = ldfrag(cK, 16 * kt + c, 4 * ks + h);
#pragma unroll
      for (int mq = 0; mq < 2; ++mq)
        if (act[mq]) {
          f32x4 s[1][4];
          {
#pragma unroll
            for (int kt = 0; kt < 4; ++kt) {
              s[0][kt] = (f32x4){0.f, 0.f, 0.f, 0.f};
#pragma unroll
              for (int ks = 0; ks < 2; ++ks) s[0][kt] = __builtin_amdgcn_mfma_f32_16x16x32_f16(kf[kt][ks], qf[mq][ks], s[0][kt], 0, 0, 0);
            }
          }
          const bool selbit = MODE == 2 ? (((j < 64 ? (mylo[mq] >> j) : (myhi[mq] >> (j - 64))) & 1ull) != 0ull) : true;
          bool interior;
          if (MODE <= 1) interior = j * 64 + 63 <= tfl[mq];
          else if (MODE == 2) interior = j * 64 + 63 <= tfl[mq];
          else interior = (j * 64 + 63 <= tfl[mq]) && (j * 64 > tfl[mq] + 3 - 512);
          if (!interior) {
            const int pbase = j * 64 + 4 * h;
#pragma unroll
            for (int kt = 0; kt < 4; ++kt)
#pragma unroll
              for (int i = 0; i < 4; ++i) {
                const int pos = pbase + 16 * kt + i;
                bool v;
                if (MODE <= 1) v = pos <= lim[mq];
                else if (MODE == 2) v = selbit && pos <= tq[mq];
                else v = pos <= tq[mq] && pos > tq[mq] - 512;
                s[0][kt][i] = v ? s[0][kt][i] : -1e30f;
              }
          }
          const bool rowoff = MODE == 2 && interior && !selbit;
          if (MODE == 1) {
#pragma unroll
            for (int kt = 0; kt < 4; ++kt) {
              float ps = 0.f;
#pragma unroll
              for (int i = 0; i < 4; ++i) {
                const float pv = __builtin_amdgcn_exp2f(s[0][kt][i] - m[mq]) * inv[mq];
                s[0][kt][i] = pv;
                ps += pv;
              }
              ps += __shfl_xor(ps, 1);
              ps += __shfl_xor(ps, 2);
              if (g == 0) impw[(4 * mq + qi) * 128 + j * 16 + kt * 4 + h] = ps;
            }
          } else {
            float bm = fmaxf(fmaxf(fmaxf(s[0][0][0], s[0][0][1]), fmaxf(s[0][0][2], s[0][0][3])), fmaxf(fmaxf(s[0][1][0], s[0][1][1]), fmaxf(s[0][1][2], s[0][1][3])));
            bm = fmaxf(bm, fmaxf(fmaxf(fmaxf(s[0][2][0], s[0][2][1]), fmaxf(s[0][2][2], s[0][2][3])), fmaxf(fmaxf(s[0][3][0], s[0][3][1]), fmaxf(s[0][3][2], s[0][3][3]))));
            bm = rowoff ? -1e30f : bm;
            if (__any(bm > m[mq] + 8.f)) {
              bm = fmaxf(bm, __shfl_xor(bm, 16));
              bm = fmaxf(bm, __shfl_xor(bm, 32));
              const float mn = fmaxf(m[mq], bm);
              const float alpha = __builtin_amdgcn_exp2f(m[mq] - mn);
              l[mq] *= alpha;
              m[mq] = mn;
              if (PV) {
#pragma unroll
                for (int mt = 0; mt < 4; ++mt) o[mq][mt] *= alpha;
              }
            }
            const float mref = (m[mq] > -1e29f && !rowoff) ? m[mq] : 1e30f;
            float ps = 0.f;
#pragma unroll
            for (int kt = 0; kt < 4; ++kt)
#pragma unroll
              for (int i = 0; i < 4; ++i) {
                const float pv = __builtin_amdgcn_exp2f(s[0][kt][i] - mref);
                s[0][kt][i] = pv;
                ps += pv;
              }
            l[mq] += ps;
          }
          if (PV) {
#pragma unroll
            for (int s2 = 0; s2 < 2; ++s2)
#pragma unroll
              for (int i = 0; i < 4; ++i) { pf[mq][s2][i] = (h16)s[0][2 * s2][i]; pf[mq][s2][4 + i] = (h16)s[0][2 * s2 + 1][i]; }
          }
        }
      if (PV) {
        h16x8 vf[4][2];
#pragma unroll
        for (int mt = 0; mt < 4; ++mt)
#pragma unroll
          for (int s2 = 0; s2 < 2; ++s2) vf[mt][s2] = ldfrag(cV, 16 * mt + c, 4 * s2 + h);
#pragma unroll
        for (int mq = 0; mq < 2; ++mq)
          if (act[mq]) {
#pragma unroll
            for (int s2 = 0; s2 < 2; ++s2) {
#pragma unroll
              for (int mt = 0; mt < 4; ++mt) o[mq][mt] = __builtin_amdgcn_mfma_f32_16x16x32_f16(vf[mt][s2], pf[mq][s2], o[mq][mt], 0, 0, 0);
            }
          }
      }
    }
   }
    sbase = sbase + 2 == NSLOT ? 0 : sbase + 2;
  }
  __builtin_amdgcn_s_barrier();
}

__device__ __forceinline__ void attn_item(const Params& p, int l, int item, float* sm) {
  unsigned char* ws = p.ws;
  int tid = tidx();
  asm volatile("" : "+v"(tid));
  const int lane = tid & 63, wave = tid >> 6;
  const int combo = item & 3, qt = item >> 2;
  const int b = combo >> 1, kv = combo & 1;
  const int t0 = qt * 64, tw0 = t0 + 8 * wave;
  const int h = lane >> 4, c = lane & 15, qi = c >> 2, g = c & 3;
  const int head = kv * 4 + g, bkv = b * 2 + kv;
  h16* ring = (h16*)sm;
  float* impw = sm + 24576 + wave * 1024;
  unsigned long long* selm = (unsigned long long*)(sm + 24576 + 8192) + wave * 16;

  h16x8 qf[2][2];
  int tq[2];
#pragma unroll
  for (int mq = 0; mq < 2; ++mq) {
    tq[mq] = tw0 + 4 * mq + qi;
    const h16* qrow = (const h16*)(ws + OFF_Q16) + (size_t)(b * S + tq[mq]) * 512 + head * 64;
    qf[mq][0] = *(const h16x8*)(qrow + 8 * h);
    qf[mq][1] = *(const h16x8*)(qrow + 32 + 8 * h);
  }
  for (int i = lane; i < 1024; i += 64) impw[i] = 0.f;

  h16x4 ofin[2][4];
  float m[2], ll[2], inv[2];
  f32x4 o[2][4];
  const unsigned long long z2[2] = {0ull, 0ull};
  {
    int lim[2], tlim[2], tflc[2];
#pragma unroll
    for (int mq = 0; mq < 2; ++mq) {
      lim[mq] = tq[mq] >= 31 ? ((tq[mq] - 31) >> 4) : -1;
      const int tl = tw0 + 4 * mq + 3;
      tlim[mq] = tl >= 31 ? ((tl - 31) >> 4) : -1;
      const int tf0 = tw0 + 4 * mq;
      tflc[mq] = tf0 >= 31 ? ((tf0 - 31) >> 4) : -1;
      m[mq] = -1e30f; ll[mq] = 0.f; inv[mq] = 0.f;
#pragma unroll
      for (int mt = 0; mt < 4; ++mt) o[mq][mt] = (f32x4){0.f, 0.f, 0.f, 0.f};
    }
    const int nl = (t0 + 63 - 31) >> 4;
    const int jl = nl >> 6;
    const h16* Kc = (const h16*)(ws + OFF_KCMP) + (size_t)bkv * 512 * 64;
    const h16* Vc = (const h16*)(ws + OFF_VCMPT) + (size_t)bkv * 8 * 4096;
    attn_branch<0>(Kc, Vc, 0, jl, ring, qf, m, ll, o, tq, lim, tlim, tflc, z2, z2, z2, z2, inv, impw);
#pragma unroll
    for (int mq = 0; mq < 2; ++mq) {
      float lt = ll[mq];
      lt += __shfl_xor(lt, 16);
      lt += __shfl_xor(lt, 32);
      inv[mq] = lt > 0.f ? 1.f / lt : 0.f;
    }
    attn_branch<1>(Kc, Vc, 0, jl, ring, qf, m, ll, o, tq, lim, tlim, tflc, z2, z2, z2, z2, inv, impw);
    const float* gt0 = (const float*)(ws + OFF_GATES) + (size_t)(b * S) * 24 + head * 3;
#pragma unroll
    for (int mq = 0; mq < 2; ++mq) {
      const float g0 = gt0[(size_t)tq[mq] * 24] * ASCALE;
#pragma unroll
      for (int mt = 0; mt < 4; ++mt) ofin[mq][mt] = pack4(o[mq][mt][0] * g0, o[mq][mt][1] * g0, o[mq][mt][2] * g0, o[mq][mt][3] * g0);
    }
  }
  for (int q = 0; q < 8; ++q) {
    const int t = tw0 + q, own = t >> 6;
    const float* ir = impw + q * 128;
    const int ja = lane, jb = lane + 64;
    unsigned k0 = 0u, k1 = 0u;
    if (ja <= own) k0 = (ja == 0 || ja == own) ? (0xFFFFFF80u | (unsigned)(127 - ja)) : (((__float_as_uint(ir[ja]) & ~127u) | (unsigned)(127 - ja)) + 1u);
    if (jb <= own) k1 = (jb == own) ? (0xFFFFFF80u | (unsigned)(127 - jb)) : (((__float_as_uint(ir[jb]) & ~127u) | (unsigned)(127 - jb)) + 1u);
    unsigned thr = 0u;
    for (int bit = 31; bit >= 0; --bit) {
      const unsigned cand = thr | (1u << bit);
      const int cnt = __popcll(__ballot(k0 >= cand)) + __popcll(__ballot(k1 >= cand));
      if (cnt >= 16) thr = cand;
    }
    const unsigned long long mlo = __ballot(k0 >= thr && ja <= own);
    const unsigned long long mhi = __ballot(k1 >= thr && jb <= own);
    if (lane == 0) { selm[q * 2] = mlo; selm[q * 2 + 1] = mhi; }
  }
  unsigned long long mylo[2], myhi[2], ulo[2], uhi[2];
#pragma unroll
  for (int mq = 0; mq < 2; ++mq) {
    mylo[mq] = selm[(4 * mq + qi) * 2];
    myhi[mq] = selm[(4 * mq + qi) * 2 + 1];
    unsigned long long a = selm[(4 * mq) * 2] | selm[(4 * mq + 1) * 2] | selm[(4 * mq + 2) * 2] | selm[(4 * mq + 3) * 2];
    unsigned long long bb = selm[(4 * mq) * 2 + 1] | selm[(4 * mq + 1) * 2 + 1] | selm[(4 * mq + 2) * 2 + 1] | selm[(4 * mq + 3) * 2 + 1];
    ulo[mq] = (unsigned long long)__builtin_amdgcn_readfirstlane((unsigned)a) | ((unsigned long long)__builtin_amdgcn_readfirstlane((unsigned)(a >> 32)) << 32);
    uhi[mq] = (unsigned long long)__builtin_amdgcn_readfirstlane((unsigned)bb) | ((unsigned long long)__builtin_amdgcn_readfirstlane((unsigned)(bb >> 32)) << 32);
  }
  const float* gtb = (const float*)(ws + OFF_GATES) + (size_t)(b * S) * 24 + head * 3;
  {
    int tl0[2] = {0, 0};
    const int tfs[2] = {tw0, tw0 + 4};
#pragma unroll
    for (int mq = 0; mq < 2; ++mq) {
      m[mq] = -1e30f; ll[mq] = 0.f;
#pragma unroll
      for (int mt = 0; mt < 4; ++mt) o[mq][mt] = (f32x4){0.f, 0.f, 0.f, 0.f};
    }
    attn_branch<2>((const h16*)(ws + OFF_KS) + (size_t)bkv * S * 64, (const h16*)(ws + OFF_VST) + (size_t)bkv * 128 * 4096, 0, (t0 + 63) >> 6, ring, qf, m, ll, o,
                   tq, tl0, tl0, tfs, mylo, myhi, ulo, uhi, inv, impw);
#pragma unroll
    for (int mq = 0; mq < 2; ++mq) {
      float lt = ll[mq];
      lt += __shfl_xor(lt, 16);
      lt += __shfl_xor(lt, 32);
      const float sc = lt > 0.f ? gtb[(size_t)tq[mq] * 24 + 1] * ASCALE / lt : 0.f;
#pragma unroll
      for (int mt = 0; mt < 4; ++mt)
        ofin[mq][mt] = pack4((float)ofin[mq][mt][0] + o[mq][mt][0] * sc, (float)ofin[mq][mt][1] + o[mq][mt][1] * sc, (float)ofin[mq][mt][2] + o[mq][mt][2] * sc,
                             (float)ofin[mq][mt][3] + o[mq][mt][3] * sc);
    }
  }
  {
    int tl0[2] = {0, 0}, tf[2];
#pragma unroll
    for (int mq = 0; mq < 2; ++mq) {
      tf[mq] = tw0 + 4 * mq;
      m[mq] = -1e30f; ll[mq] = 0.f;
#pragma unroll
      for (int mt = 0; mt < 4; ++mt) o[mq][mt] = (f32x4){0.f, 0.f, 0.f, 0.f};
    }
    const int jlo = t0 >= 511 ? ((t0 - 511) >> 6) : 0;
    attn_branch<3>((const h16*)(ws + OFF_KW) + (size_t)bkv * S * 64, (const h16*)(ws + OFF_VWT) + (size_t)bkv * 128 * 4096, jlo, (t0 + 63) >> 6, ring, qf, m, ll, o,
                   tq, tl0, tf, tf, z2, z2, z2, z2, inv, impw);
#pragma unroll
    for (int mq = 0; mq < 2; ++mq) {
      float lt = ll[mq];
      lt += __shfl_xor(lt, 16);
      lt += __shfl_xor(lt, 32);
      const float sc = lt > 0.f ? gtb[(size_t)tq[mq] * 24 + 2] * ASCALE / lt : 0.f;
#pragma unroll
      for (int mt = 0; mt < 4; ++mt)
        ofin[mq][mt] = pack4((float)ofin[mq][mt][0] + o[mq][mt][0] * sc, (float)ofin[mq][mt][1] + o[mq][mt][1] * sc, (float)ofin[mq][mt][2] + o[mq][mt][2] * sc,
                             (float)ofin[mq][mt][3] + o[mq][mt][3] * sc);
    }
  }
  {
    h16* yc = (h16*)(ws + OFF_H16);
    const float* gn = p.in[I_ONG] + l * 1024 + 256 + head * 64;
    float* ssq = (float*)(ws + OFF_SSQ);
#pragma unroll
    for (int mq = 0; mq < 2; ++mq) {
      float sq = 0.f;
      h16* yr = yc + (size_t)(b * S + tq[mq]) * D + head * 64;
#pragma unroll
      for (int mt = 0; mt < 4; ++mt) {
        const float v[4] = {(float)ofin[mq][mt][0], (float)ofin[mq][mt][1], (float)ofin[mq][mt][2], (float)ofin[mq][mt][3]};
        sq += v[0] * v[0] + v[1] * v[1] + v[2] * v[2] + v[3] * v[3];
        const float4 gg = *(const float4*)(gn + 16 * mt + 4 * h);
        *(h16x4*)(yr + 16 * mt + 4 * h) = pack4(v[0] * gg.x, v[1] * gg.y, v[2] * gg.z, v[3] * gg.w);
      }
      sq += __shfl_xor(sq, 16);
      sq += __shfl_xor(sq, 32);
      sq += __shfl_xor(sq, 1);
      sq += __shfl_xor(sq, 2);
      if (h == 0 && g == 0) ssq[(size_t)(b * S + tq[mq]) * 2 + kv] = sq * (1.f / (ASCALE * ASCALE));
    }
  }
}

__device__ __forceinline__ void lrufix_item(const Params& p, int l, int item) {
  unsigned char* ws = p.ws;
  const int lane = tidx() & 63, wave = tidx() >> 6;
  const int b = item >> 7, ck = item & 127;
  const h16* P = (const h16*)(ws + OFF_P16);
  const float4 cy = *(const float4*)((const float*)(ws + OFF_CARRY) + (size_t)(b * 256 + ck * 2 + (wave >> 2)) * 256 + lane * 4);
  const float4 gn = *(const float4*)(p.in[I_ONG] + l * 1024 + lane * 4);
  h16* yc = (h16*)(ws + OFF_H16);
  for (int tt = wave * 8; tt < wave * 8 + 8; ++tt) {
    const size_t row = (size_t)(b * S + ck * 64 + tt);
    const float4 hl = *(const float4*)((const float*)(ws + OFF_LRUH) + row * 256 + lane * 4);
    const float4 al = *(const float4*)((const float*)(ws + OFF_LRUA) + row * 256 + lane * 4);
    const h16x4 gl = *(const h16x4*)(P + row * NIN + C_GL + lane * 4);
    const float y0 = (hl.x + al.x * cy.x) * gelu_tanh((float)gl[0]);
    const float y1 = (hl.y + al.y * cy.y) * gelu_tanh((float)gl[1]);
    const float y2 = (hl.z + al.z * cy.z) * gelu_tanh((float)gl[2]);
    const float y3 = (hl.w + al.w * cy.w) * gelu_tanh((float)gl[3]);
    const float rstd = rsqrtf(wsum(y0 * y0 + y1 * y1 + y2 * y2 + y3 * y3) * (1.f / 256.f) + EPS);
    *(h16x4*)(yc + row * D + 512 + lane * 4) = pack4(y0 * rstd * gn.x, y1 * rstd * gn.y, y2 * rstd * gn.z, y3 * rstd * gn.w);
  }
}

__device__ __forceinline__ void phase_attn(const Params& p, int l, float* sm) {
  for (int it = blockIdx.x; it < 256; it += gridDim.x) {
#pragma unroll 1
    for (int rep = 0; rep < 2; ++rep) attn_item(p, l, rep ? (127 - (it >> 2)) * 4 + (it & 3) : it, sm);
  }
  for (int it = blockIdx.x; it < 256; it += gridDim.x) lrufix_item(p, l, it);
}

__device__ __forceinline__ void phase_outproj(const Params& p, int l, h16* sm) {
  unsigned char* ws = p.ws;
  const h16* A = (const h16*)(ws + OFF_H16);
  const h16* W = (const h16*)(ws + OFF_WOUT);
  const float* mod = (const float*)(ws + OFF_MOD);
  float* xa = (float*)(ws + OFF_XA);
  const float* xin = l == 0 ? p.in[I_X] : (const float*)xa;
  const TileIter ti = xcd_tiles(64 * 4);
  for (int t = ti.cur; t < ti.end; t += ti.step) {
    const int mt = t >> 2, nt = t & 3;
    f32x4 acc[8][4];
    const h16* Ab = A + (size_t)mt * 256 * D;
    {
      float* sct = (float*)((unsigned char*)sm + SCHED_OFF - 1024);
      const int tq_ = tidx();
      if (tq_ < 256) {
        const float2 q2 = *(const float2*)((const float*)(ws + OFF_SSQ) + (size_t)(mt * 256 + tq_) * 2);
        sct[tq_] = rsqrtf((q2.x + q2.y) * (1.f / 512.f) + EPS) * (1.f / ASCALE);
      }
    }
    gemm_mainloop(acc, [&](int r) { return Ab + (size_t)r * D; }, W + (size_t)nt * 256 * D, D, 8, sm);
    const int tid_e = tidx(), lane = tid_e & 63, wave = tid_e >> 6, wr = wave >> 2, wc = wave & 3, fr = lane & 15, fq = lane >> 4;
    {
      const float* sct = (const float*)((const unsigned char*)sm + SCHED_OFF - 1024) + wr * 128 + fr;
#pragma unroll
      for (int m = 0; m < 8; ++m) {
        const float sc = sct[m * 16];
#pragma unroll
        for (int n = 0; n < 4; ++n) acc[m][n] *= sc;
      }
    }
    gemm_mainloop(acc, [&](int r) { return Ab + (size_t)r * D + 512; }, W + (size_t)nt * 256 * D + 512, D, 8, sm, false);
#pragma unroll
    for (int m = 0; m < 8; ++m)
#pragma unroll
      for (int n = 0; n < 4; ++n) {
        const int row = mt * 256 + wr * 128 + m * 16 + fr, col = nt * 256 + wc * 64 + n * 16 + 4 * fq;
        const int b = row >> 13;
        const float4 g1 = *(const float4*)(mod + (size_t)(l * 2 + b) * 6144 + 2048 + col);
        const float4 xv = *(const float4*)(xin + (size_t)row * D + col);
        float4 o;
        o.x = xv.x + g1.x * acc[m][n][0]; o.y = xv.y + g1.y * acc[m][n][1]; o.z = xv.z + g1.z * acc[m][n][2]; o.w = xv.w + g1.w * acc[m][n][3];
        *(float4*)(xa + (size_t)row * D + col) = o;
      }
  }
}

__device__ __forceinline__ void phase_router(const Params& p, int l, int* smi) {
  unsigned char* ws = p.ws;
  const int tid = tidx(), lane = tid & 63, wave = tid >> 6;
  const float* mod = (const float*)(ws + OFF_MOD);
  const float* xa = (const float*)(ws + OFF_XA);
  h16* hout = (h16*)(ws + OFF_H16);
  unsigned* cnt = (unsigned*)(ws + OFF_CTL) + 64 + l * 16;
  int* list = (int*)(ws + OFF_LIST);
  float* wpair = (float*)(ws + OFF_WPAIR);
  const float* rgb = p.in[I_RGB] + l * 4;
  int* cntl = smi;
  int* basel = smi + 16;
  int* tok = smi + 32;
  float* wl = (float*)smi + 256;
  {
    const float4* s0 = (const float4*)(p.in[I_RGW] + (size_t)l * 1024 * 4);
    const float4* s1 = (const float4*)(p.in[I_REW] + (size_t)l * 4 * 1024 * 4);
    float4* d = (float4*)wl;
#pragma unroll
    for (int q = 0; q < 2; ++q) d[q * NTHREADS + tid] = s0[q * NTHREADS + tid];
#pragma unroll
    for (int q = 0; q < 8; ++q) d[1024 + q * NTHREADS + tid] = s1[q * NTHREADS + tid];
  }
  const float* rgw = wl;
  for (int chunk = blockIdx.x; chunk < T / 64; chunk += gridDim.x) {
    if (tid < 16) cntl[tid] = 0;
    __syncthreads();
    float4 xn[4];
#pragma unroll
    for (int i = 0; i < 4; ++i) xn[i] = *(const float4*)(xa + (size_t)(chunk * 64 + wave) * D + lane * 4 + 256 * i);
    for (int ti = wave; ti < 64; ti += NW) {
      const int row = chunk * 64 + ti;
      const int b = row >> 13;
      float4 x[4];
      float ss = 0.f;
#pragma unroll
      for (int i = 0; i < 4; ++i) x[i] = xn[i];
      if (ti + NW < 64) {
#pragma unroll
        for (int i = 0; i < 4; ++i) xn[i] = *(const float4*)(xa + (size_t)(row + NW) * D + lane * 4 + 256 * i);
      }
#pragma unroll
      for (int i = 0; i < 4; ++i) ss += x[i].x * x[i].x + x[i].y * x[i].y + x[i].z * x[i].z + x[i].w * x[i].w;
      ss = wsum(ss);
      const float rstd = rsqrtf(ss * (1.f / D) + EPS);
      float lg0 = 0.f, lg1 = 0.f, lg2 = 0.f, lg3 = 0.f;
#pragma unroll
      for (int i = 0; i < 4; ++i) {
        const int col = lane * 4 + 256 * i;
        const float4 g = *(const float4*)(p.in[I_N2G] + l * D + col);
        const float4 sh = *(const float4*)(mod + (size_t)(l * 2 + b) * 6144 + 3072 + col);
        const float4 sc = *(const float4*)(mod + (size_t)(l * 2 + b) * 6144 + 4096 + col);
        x[i].x = x[i].x * rstd * g.x * (1.f + sc.x) + sh.x;
        x[i].y = x[i].y * rstd * g.y * (1.f + sc.y) + sh.y;
        x[i].z = x[i].z * rstd * g.z * (1.f + sc.z) + sh.z;
        x[i].w = x[i].w * rstd * g.w * (1.f + sc.w) + sh.w;
        *(h16x4*)(hout + (size_t)row * D + col) = pack4(x[i].x, x[i].y, x[i].z, x[i].w);
        const float4 w0 = *(const float4*)(rgw + (size_t)(col + 0) * 4), w1 = *(const float4*)(rgw + (size_t)(col + 1) * 4);
        const float4 w2 = *(const float4*)(rgw + (size_t)(col + 2) * 4), w3 = *(const float4*)(rgw + (size_t)(col + 3) * 4);
        lg0 += x[i].x * w0.x + x[i].y * w1.x + x[i].z * w2.x + x[i].w * w3.x;
        lg1 += x[i].x * w0.y + x[i].y * w1.y + x[i].z * w2.y + x[i].w * w3.y;
        lg2 += x[i].x * w0.z + x[i].y * w1.z + x[i].z * w2.z + x[i].w * w3.z;
        lg3 += x[i].x * w0.w + x[i].y * w1.w + x[i].z * w2.w + x[i].w * w3.w;
      }
      lg0 = wsum(lg0) + rgb[0]; lg1 = wsum(lg1) + rgb[1]; lg2 = wsum(lg2) + rgb[2]; lg3 = wsum(lg3) + rgb[3];
      int gs = 0; float gm = lg0;
      if (lg1 > gm) { gm = lg1; gs = 1; }
      if (lg2 > gm) { gm = lg2; gs = 2; }
      if (lg3 > gm) { gm = lg3; gs = 3; }
      const float pg = 1.f / (__expf(lg0 - gm) + __expf(lg1 - gm) + __expf(lg2 - gm) + __expf(lg3 - gm));
      const float* rew = wl + 4096 + gs * 4096;
      const float* reb = p.in[I_REB] + (l * 4 + gs) * 4;
      float e0 = 0.f, e1 = 0.f, e2 = 0.f, e3 = 0.f;
#pragma unroll
      for (int i = 0; i < 4; ++i) {
        const int col = lane * 4 + 256 * i;
        const float4 w0 = *(const float4*)(rew + (size_t)(col + 0) * 4), w1 = *(const float4*)(rew + (size_t)(col + 1) * 4);
        const float4 w2 = *(const float4*)(rew + (size_t)(col + 2) * 4), w3 = *(const float4*)(rew + (size_t)(col + 3) * 4);
        e0 += x[i].x * w0.x + x[i].y * w1.x + x[i].z * w2.x + x[i].w * w3.x;
        e1 += x[i].x * w0.y + x[i].y * w1.y + x[i].z * w2.y + x[i].w * w3.y;
        e2 += x[i].x * w0.z + x[i].y * w1.z + x[i].z * w2.z + x[i].w * w3.z;
        e3 += x[i].x * w0.w + x[i].y * w1.w + x[i].z * w2.w + x[i].w * w3.w;
      }
      float le[4];
      le[0] = wsum(e0) + reb[0]; le[1] = wsum(e1) + reb[1]; le[2] = wsum(e2) + reb[2]; le[3] = wsum(e3) + reb[3];
      int i0 = 0; float v0 = le[0];
      if (le[1] > v0) { v0 = le[1]; i0 = 1; }
      if (le[2] > v0) { v0 = le[2]; i0 = 2; }
      if (le[3] > v0) { v0 = le[3]; i0 = 3; }
      int i1 = -1; float v1 = -3.0e38f;
#pragma unroll
      for (int j = 0; j < 4; ++j) {
        const float vj = (j == 0 ? le[0] : j == 1 ? le[1] : j == 2 ? le[2] : le[3]);
        if (j != i0 && vj > v1) { v1 = vj; i1 = j; }
      }
      const float p0 = 1.f / (1.f + __expf(v1 - v0));
      const float p1 = 1.f - p0;
      if (lane == 0) {
        const int ea = gs * 4 + i0, eb = gs * 4 + i1;
        const int ra = atomicAdd(&cntl[ea], 1);
        const int rb = atomicAdd(&cntl[eb], 1);
        tok[ti * 2] = ea | (ra << 8);
        tok[ti * 2 + 1] = eb | (rb << 8);
        wpair[row * 2] = pg * p0;
        wpair[row * 2 + 1] = pg * p1;
      }
    }
    __syncthreads();
    if (tid < 16) basel[tid] = (int)atomicAdd(&cnt[tid], (unsigned)cntl[tid]);
    __syncthreads();
    if (tid < 128) {
      const int v = tok[tid], e = v & 255, r = v >> 8;
      list[(size_t)e * 16384 + basel[e] + r] = (chunk * 64 + (tid >> 1)) * 2 + (tid & 1);
    }
    __syncthreads();
  }
}

__device__ __forceinline__ void moe_sched(const Params& p, int l, int* sl) {
  if (tidx() == 0) {
    const unsigned* cnt = (const unsigned*)(p.ws + OFF_CTL) + 64 + l * 16;
    int to = 0, ro = 0;
    sl[16] = 0; sl[33] = 0;
    for (int e = 0; e < 16; ++e) {
      const int c = (int)__hip_atomic_load(&cnt[e], __ATOMIC_RELAXED, __HIP_MEMORY_SCOPE_AGENT);
      sl[e] = c;
      to += (c + 255) >> 8; ro += c;
      sl[17 + e] = to; sl[34 + e] = ro;
    }
  }
  __syncthreads();
}
__device__ __forceinline__ void moe_tile(const int* sl, int t, int& e, int& nt, int& mt, int& cnt_e, int& roff_e) {
  int ee = 0;
  for (int k = 0; k < 15; ++k) ee += (t >= sl[17 + k] * 4) ? 1 : 0;
  ee = __builtin_amdgcn_readfirstlane(ee);
  const int t0 = __builtin_amdgcn_readfirstlane(sl[16 + ee]), t1 = __builtin_amdgcn_readfirstlane(sl[17 + ee]);
  const int nte = t1 - t0, rem = t - t0 * 4;
  e = ee; nt = rem / nte; mt = rem % nte;
  cnt_e = __builtin_amdgcn_readfirstlane(sl[ee]);
  roff_e = __builtin_amdgcn_readfirstlane(sl[33 + ee]);
}

__device__ __forceinline__ void phase_moe1(const Params& p, int l, h16* sm) {
  unsigned char* ws = p.ws;
  int* sl = (int*)((unsigned char*)sm + SCHED_OFF);
  moe_sched(p, l, sl);
  const h16* H = (const h16*)(ws + OFF_H16);
  const int* list = (const int*)(ws + OFF_LIST);
  h16* hid = (h16*)(ws + OFF_HID);
  const int total = __builtin_amdgcn_readfirstlane(sl[32]) * 4;
  const TileIter ti = xcd_tiles(total);
  for (int t = ti.cur; t < ti.end; t += ti.step) {
    int e, nt, mt, cnt_e, roff_e;
    moe_tile(sl, t, e, nt, mt, cnt_e, roff_e);
    const int* le = list + (size_t)e * 16384;
    f32x4 acc[8][4];
    gemm_mainloop(acc, [&](int r) { int so = mt * 256 + r; so = so < cnt_e ? so : 0; return H + (size_t)(le[so] >> 1) * D; },
                  (const h16*)(ws + OFF_WGU) + ((size_t)e * 1024 + nt * 256) * 1024, 1024, 16, sm);
    const int tid_e = tidx(), lane = tid_e & 63, wave = tid_e >> 6, wr = wave >> 2, wc = wave & 3, fr = lane & 15, fq = lane >> 4;
#pragma unroll
    for (int m = 0; m < 8; ++m) {
      const int so = mt * 256 + wr * 128 + m * 16 + fr;
      if (so < cnt_e) {
#pragma unroll
        for (int n2 = 0; n2 < 2; ++n2) {
          const f32x4 gt = acc[m][2 * n2], up = acc[m][2 * n2 + 1];
          const int col = nt * 128 + wc * 32 + n2 * 16 + 4 * fq;
          *(h16x4*)(hid + (size_t)(roff_e + so) * 512 + col) = pack4(silu_f(gt[0]) * up[0], silu_f(gt[1]) * up[1], silu_f(gt[2]) * up[2], silu_f(gt[3]) * up[3]);
        }
      }
    }
  }
}

__device__ __forceinline__ void phase_moe2(const Params& p, int l, h16* sm) {
  unsigned char* ws = p.ws;
  int* sl = (int*)((unsigned char*)sm + SCHED_OFF);
  moe_sched(p, l, sl);
  const int* list = (const int*)(ws + OFF_LIST);
  const float* wpair = (const float*)(ws + OFF_WPAIR);
  const h16* hid = (const h16*)(ws + OFF_HID);
  h16* yp = (h16*)(ws + OFF_YPAIR);
  const int total = __builtin_amdgcn_readfirstlane(sl[32]) * 4;
  const TileIter ti = xcd_tiles(total);
  for (int t = ti.cur; t < ti.end; t += ti.step) {
    int e, nt, mt, cnt_e, roff_e;
    moe_tile(sl, t, e, nt, mt, cnt_e, roff_e);
    const int* le = list + (size_t)e * 16384;
    const h16* Ab = hid + (size_t)(roff_e + mt * 256) * 512;
    f32x4 acc[8][4];
    gemm_mainloop(acc, [&](int r) { return Ab + (size_t)r * 512; }, (const h16*)(ws + OFF_WDN) + ((size_t)e * 1024 + nt * 256) * 512, 512, 8, sm);
    const int tid_e = tidx(), lane = tid_e & 63, wave = tid_e >> 6, wr = wave >> 2, wc = wave & 3, fr = lane & 15, fq = lane >> 4;
#pragma unroll
    for (int m = 0; m < 8; ++m) {
      const int so = mt * 256 + wr * 128 + m * 16 + fr;
      if (so < cnt_e) {
        const int pair = le[so];
        const float w = wpair[pair];
#pragma unroll
        for (int n = 0; n < 4; ++n) {
          const int col = nt * 256 + wc * 64 + n * 16 + 4 * fq;
          *(h16x4*)(yp + (size_t)pair * D + col) = pack4(acc[m][n][0] * w, acc[m][n][1] * w, acc[m][n][2] * w, acc[m][n][3] * w);
        }
      }
    }
  }
}

#define XB_TMO      128
#define XB_XCNT(j)  (256  + 64 * (j))
#define XB_XSUB(j)  (1280 + 64 * (j))
#define XB_XGEN(j)  (2304 + 64 * (j))
#define XB_TOP      3328
#define XB_TOPGEN   3392
#define XCD_BAR_WORDS 3456
#define XB_SPIN_CAP (1u << 20)
__device__ __forceinline__ unsigned xb_ld(unsigned* p) { return __hip_atomic_load(p, __ATOMIC_RELAXED, __HIP_MEMORY_SCOPE_AGENT); }
__device__ __forceinline__ unsigned xb_add(unsigned* p, unsigned v) { return __hip_atomic_fetch_add(p, v, __ATOMIC_RELAXED, __HIP_MEMORY_SCOPE_AGENT); }
__device__ __forceinline__ unsigned xb_xcc_id() { return (unsigned)__builtin_amdgcn_s_getreg((3 << 11) | 20) & 0xFu; }
#define XB_SPIN(cond, bar) do { unsigned _sp = 0; while (cond) { __builtin_amdgcn_s_sleep(1); \
    if ((++_sp & 255u) == 0u) { if (xb_ld(&(bar)[XB_TMO])) break; if (_sp > XB_SPIN_CAP) { atomicAdd(&(bar)[XB_TMO], 1u); break; } } } } while (0)
struct XBar { unsigned* bar; unsigned x; volatile unsigned* st; };
__device__ __forceinline__ void xbar_post(XBar& b, unsigned* bar, volatile unsigned* st) {
  b.bar = bar; b.x = xb_xcc_id(); b.st = st;
  if (tidx() == 0) { st[0] = 0u; st[1] = 0u; (void)xb_add(&bar[XB_XCNT(b.x)], 1u); }
}
__device__ __forceinline__ void xbar_census(unsigned* bar, unsigned x, unsigned& nloc, unsigned& nx) {
  const unsigned G = gridDim.x;
  unsigned sum, cnt, mine, sp = 0u;
  for (;;) {
    sum = 0u; cnt = 0u; mine = 0u;
#pragma unroll
    for (unsigned j = 0; j < 16; ++j) { const unsigned c = xb_ld(&bar[XB_XCNT(j)]); sum += c; cnt += (c > 0u) ? 1u : 0u; mine = (j == x) ? c : mine; }
    if (sum == G) break;
    __builtin_amdgcn_s_sleep(1);
    if ((++sp & 255u) == 0u) { if (xb_ld(&bar[XB_TMO])) break; if (sp > XB_SPIN_CAP) { atomicAdd(&bar[XB_TMO], 1u); break; } }
  }
  nloc = mine > 0u ? mine : 1u; nx = cnt > 0u ? cnt : 1u;
}
__device__ __forceinline__ void xbar_sync(XBar& b) {
  asm volatile("s_waitcnt vmcnt(0)" ::: "memory");
  __syncthreads();
  if (tidx() == 0) {
    unsigned* bar = b.bar;
    __builtin_amdgcn_s_waitcnt(0);
    unsigned nloc = b.st[0], nx = b.st[1];
    if (nloc == 0u) { xbar_census(bar, b.x, nloc, nx); b.st[0] = nloc; b.st[1] = nx; }
    const unsigned old = xb_add(&bar[XB_XSUB(b.x)], 1u);
    const unsigned gen = old / nloc;
    if (old + 1u == (gen + 1u) * nloc) {
      __builtin_amdgcn_fence(__ATOMIC_RELEASE, "agent");
      asm volatile("s_waitcnt vmcnt(0)" ::: "memory");
      const unsigned og = xb_add(&bar[XB_TOP], 1u);
      const unsigned tg = og / nx;
      if (og + 1u == (tg + 1u) * nx) xb_add(&bar[XB_TOPGEN], 1u);
      else XB_SPIN(xb_ld(&bar[XB_TOPGEN]) == tg, bar);
      __builtin_amdgcn_fence(__ATOMIC_ACQUIRE, "agent");
      xb_add(&bar[XB_XGEN(b.x)], 1u);
      asm volatile("s_waitcnt vmcnt(0)" ::: "memory");
    } else {
      XB_SPIN(xb_ld(&bar[XB_XGEN(b.x)]) == gen, bar);
      __builtin_amdgcn_fence(__ATOMIC_ACQUIRE, "agent");
      asm volatile("s_waitcnt vmcnt(0)" ::: "memory");
    }
  }
  __syncthreads();
}

constexpr int NSTEPS = 22;
#define STEP(k, body) do { if (s_lo <= (k) && (k) < s_hi) { body; if ((k) + 1 < s_hi) { if ((k) == 0) grid.sync(); else xbar_sync(xb); } \
    if (PROBE_MASK != 0u) { unsigned long long now_ = __builtin_amdgcn_s_memrealtime(); \
      if ((PROBE_MASK >> (k)) & 1u) { const unsigned long long w_ = (now_ - pt_prev) * PROBE_AMP; \
        while (__builtin_amdgcn_s_memrealtime() - now_ < w_) __builtin_amdgcn_s_sleep(8); now_ = __builtin_amdgcn_s_memrealtime(); } \
      pt_prev = now_; } } } while (0)
#define LAYER_STEPS(l, base) \
  STEP(base + 0, phase_norm1(p, l); if (l == 1) phase_convert(p, 1, (float*)smem)); \
  STEP(base + 1, phase_inproj(p, (h16*)smem)); \
  STEP(base + 2, phase_post(p)); \
  STEP(base + 3, phase_mixa(p, l, smem)); \
  STEP(base + 4, phase_mixb(p, l, (float*)smem)); \
  STEP(base + 5, phase_attn(p, l, (float*)smem)); \
  STEP(base + 6, phase_outproj(p, l, (h16*)smem)); \
  STEP(base + 7, phase_router(p, l, (int*)smem)); \
  STEP(base + 8, phase_moe1(p, l, (h16*)smem)); \
  STEP(base + 9, phase_moe2(p, l, (h16*)smem))

__global__ void __launch_bounds__(NTHREADS, 2) mega(Params p, int s_lo, int s_hi) {
  extern __shared__ __attribute__((aligned(16))) unsigned char smem[];
  cg::grid_group grid = cg::this_grid();
  unsigned long long pt_prev = PROBE_MASK != 0u ? __builtin_amdgcn_s_memrealtime() : 0ull;
  XBar xb;
  xbar_post(xb, (unsigned*)(p.ws + OFF_BAR), (volatile unsigned*)(smem + LDS_BYTES - 16));
  STEP(0, phase_prep(p, (float*)smem); phase_convert(p, 0, (float*)smem));
  LAYER_STEPS(0, 1);
  LAYER_STEPS(1, 11);
  STEP(21, phase_norm1(p, 2));
}

extern "C" void kernel_launch(void* const* d_in, const int* in_sizes, int n_in, void* d_out, int out_size, void* d_ws, size_t ws_size,
                              hipStream_t stream) {
  static int grid_blocks = 0;
  if (!grid_blocks) {
    if (n_in != 35 || out_size != T * D || ws_size < WS_TOTAL) {
      fprintf(stderr, "kernel_launch: unexpected problem (n_in %d, out %d, ws %zu < %zu)\n", n_in, out_size, ws_size, (size_t)WS_TOTAL);
      grid_blocks = -1;
      return;
    }
    int dev = 0, cus = 0, per_cu = 0;
    hipGetDevice(&dev);
    hipDeviceGetAttribute(&cus, hipDeviceAttributeMultiprocessorCount, dev);
    if (hipFuncSetAttribute((const void*)mega, hipFuncAttributeMaxDynamicSharedMemorySize, LDS_BYTES) != hipSuccess) {
      fprintf(stderr, "kernel_launch: hipFuncSetAttribute(%d B dynamic LDS) failed\n", LDS_BYTES);
      grid_blocks = -1;
      return;
    }
    hipOccupancyMaxActiveBlocksPerMultiprocessor(&per_cu, mega, NTHREADS, LDS_BYTES);
    if (per_cu > 1) per_cu = 1;
    if (per_cu < 1) { fprintf(stderr, "kernel_launch: occupancy query returned %d\n", per_cu); grid_blocks = -1; return; }
    grid_blocks = cus * per_cu;
  }
  if (grid_blocks < 0) return;
  Params p{};
  for (int i = 0; i < 35; ++i) p.in[i] = (const float*)d_in[i];
  p.out = (float*)d_out;
  p.ws = (unsigned char*)d_ws;
  for (int i = 0; i < 32; ++i) p.inv_freq[i] = std::pow(10000.0, -(double)(2 * i) / 64.0);
  if (hipMemsetAsync((char*)d_ws + OFF_BAR, 0, 16384, stream) != hipSuccess) { fprintf(stderr, "kernel_launch: memset of barrier words failed\n"); return; }
#if MEGA
  int lo = 0, hi = NSTEPS;
  void* args[] = {&p, &lo, &hi};
  hipError_t e = hipLaunchCooperativeKernel((void*)mega, dim3(grid_blocks), dim3(NTHREADS), args, LDS_BYTES, stream);
  if (e != hipSuccess) fprintf(stderr, "cooperative launch failed: %s (grid %d)\n", hipGetErrorString(e), grid_blocks);
#else
  for (int s = 0; s < NSTEPS; ++s) {
    int lo = s, hi = s + 1;
    void* args[] = {&p, &lo, &hi};
    hipError_t e = hipLaunchCooperativeKernel((void*)mega, dim3(grid_blocks), dim3(NTHREADS), args, LDS_BYTES, stream);
    if (e != hipSuccess) { fprintf(stderr, "launch %d failed: %s (grid %d)\n", s, hipGetErrorString(e), grid_blocks); break; }
  }
#endif
}
```

```cpp
#include <hip/hip_runtime.h>
#include <hip/hip_cooperative_groups.h>
#include <cstdio>
#include <cstdint>
#include <cmath>
namespace cg = cooperative_groups;

#ifndef MEGA
#define MEGA 1
#endif
#ifndef PROBE_MASK
#define PROBE_MASK 0u
#define PROBE_AMP 3
#endif

typedef _Float16 h16;
typedef _Float16 h16x8 __attribute__((ext_vector_type(8)));
typedef _Float16 h16x4 __attribute__((ext_vector_type(4)));
typedef float f32x4 __attribute__((ext_vector_type(4)));

constexpr int NB = 2, S = 8192, T = NB * S, D = 1024;
constexpr int NIN = 2432;
constexpr int NINSRC = 2328;
constexpr int C_XL = 0, C_GL = 256, C_Q = 512, C_KC = 1024, C_VC = 1152, C_KS = 1280, C_VS = 1408, C_KW = 1536, C_VW = 1664,
              C_CVA = 1792, C_CVB = 2048, C_GATE = 2304;
constexpr float EPS = 1e-6f;
constexpr int NTHREADS = 512, NW = 8;
constexpr int LDS_BYTES = 147456;
constexpr int NINP = 2560;
constexpr int SCHED_OFF = LDS_BYTES - 1024;
constexpr float ASCALE = 16.f;

constexpr size_t al256(size_t x) { return (x + 255) & ~(size_t)255; }
constexpr size_t OFF_CTL = 0;
constexpr size_t OFF_BAR = 4096;
constexpr size_t OFF_MOD = 4096 + 16384;
constexpr size_t OFF_ROPE = al256(OFF_MOD + 2 * 2 * 6144 * 4);
constexpr size_t OFF_PB = al256(OFF_ROPE + (size_t)T * 64 * 4);
constexpr size_t OFF_PBPART = al256(OFF_PB + 2 * 256 * 4);
constexpr size_t OFF_GATES = al256(OFF_PBPART + 2 * 32 * 256 * 4);
constexpr size_t OFF_WIN = al256(OFF_GATES + (size_t)T * 24 * 4);
constexpr size_t OFF_WOUT = al256(OFF_WIN + (size_t)NINP * 1024 * 2);
constexpr size_t OFF_WGU = al256(OFF_WOUT + (size_t)1024 * 1024 * 2);
constexpr size_t OFF_WDN = al256(OFF_WGU + (size_t)16 * 1024 * 1024 * 2);
constexpr size_t OFF_W1K = al256(OFF_WDN + (size_t)16 * 1024 * 512 * 2);
constexpr size_t OFF_W1V = al256(OFF_W1K + (size_t)256 * 2048 * 2);
constexpr size_t OFF_H16 = al256(OFF_W1V + (size_t)256 * 2048 * 2);
constexpr size_t OFF_Q16 = al256(OFF_H16 + (size_t)T * 1024 * 2);
constexpr size_t KVSZ = (size_t)T * 128 * 2;
constexpr size_t OFF_KC = al256(OFF_Q16 + (size_t)T * 512 * 2);
constexpr size_t OFF_VC = al256(OFF_KC + KVSZ + 4096);
constexpr size_t OFF_KS = al256(OFF_VC + KVSZ + 4096);
constexpr size_t OFF_VST = al256(OFF_KS + KVSZ);
constexpr size_t OFF_KW = al256(OFF_VST + KVSZ);
constexpr size_t OFF_VWT = al256(OFF_KW + KVSZ);
constexpr size_t OFF_HIDC = al256(OFF_VWT + KVSZ);
constexpr size_t OFF_KCMP = al256(OFF_HIDC + (size_t)2 * 2048 * 256 * 2);
constexpr size_t OFF_VCMPT = al256(OFF_KCMP + (size_t)4 * 512 * 64 * 2);
constexpr size_t OFF_LRUH = al256(OFF_VCMPT + (size_t)4 * 512 * 64 * 2);
constexpr size_t OFF_LRUA = al256(OFF_LRUH + (size_t)T * 256 * 4);
constexpr size_t OFF_HEND = al256(OFF_LRUA + (size_t)T * 256 * 4);
constexpr size_t OFF_AEND = al256(OFF_HEND + 2 * 256 * 256 * 4);
constexpr size_t OFF_CARRY = al256(OFF_AEND + 2 * 256 * 256 * 4);
constexpr size_t OFF_XA = al256(OFF_CARRY + 2 * 256 * 256 * 4);
constexpr size_t OFF_LIST = al256(OFF_XA + (size_t)T * 1024 * 4);
constexpr size_t OFF_WPAIR = al256(OFF_LIST + (size_t)16 * 16384 * 4);
constexpr size_t OFF_SSQ = al256(OFF_WPAIR + 32768 * 4);
constexpr size_t OFF_R = al256(OFF_SSQ + (size_t)T * 2 * 4);
constexpr size_t OFF_P16 = OFF_R;
constexpr size_t OFF_HID = OFF_R;
constexpr size_t OFF_YPAIR = al256(OFF_HID + (size_t)(32768 + 512) * 512 * 2);
constexpr size_t OFF_HIDP = al256(OFF_P16 + (size_t)T * NIN * 2);
constexpr size_t R_END1 = OFF_HIDP + (size_t)4 * 2 * 2048 * 256 * 4;
constexpr size_t R_END2 = OFF_YPAIR + (size_t)32768 * 1024 * 2;
constexpr size_t WS_TOTAL = al256(R_END1 > R_END2 ? R_END1 : R_END2);

struct Params {
  const float* in[35];
  float* out;
  unsigned char* ws;
  double inv_freq[32];
};
enum { I_X = 0, I_C, I_POS, I_ADAW, I_ADAB, I_N1G, I_N2G, I_WIN, I_LCW, I_LCB, I_LWA, I_LBA, I_LWX, I_LBX, I_LLAM, I_CKW1, I_CKW2,
       I_CVW1, I_CVW2, I_CPK, I_CPV, I_DWW, I_DWB, I_LNG, I_LNB, I_ONG, I_WOUT, I_RGW, I_RGB, I_REW, I_REB, I_MG, I_MU, I_MD, I_FNG };

__device__ __forceinline__ int tidx() { int t = threadIdx.x; asm volatile("" : "+v"(t)); return t; }
__device__ __forceinline__ float wsum(float v) {
#pragma unroll
  for (int o = 32; o > 0; o >>= 1) v += __shfl_xor(v, o);
  return v;
}
__device__ __forceinline__ float sigm(float x) { return 1.f / (1.f + __expf(-x)); }
__device__ __forceinline__ float silu_f(float x) { return x / (1.f + __expf(-x)); }
__device__ __forceinline__ float gelu_tanh(float x) {
  float u = 0.7978845608028654f * (x + 0.044715f * x * x * x);
  float e = __expf(2.f * u);
  float t = 1.f - 2.f / (e + 1.f);
  return 0.5f * x * (1.f + t);
}
__device__ __forceinline__ void glds16(const h16* g, h16* l) {
  __builtin_amdgcn_global_load_lds((const unsigned*)g, (unsigned*)l, 16, 0, 0);
}
__device__ __forceinline__ h16x4 pack4(float a, float b, float c, float d) {
  h16x4 r; r[0] = (h16)a; r[1] = (h16)b; r[2] = (h16)c; r[3] = (h16)d; return r;
}

struct TileIter { int cur, end, step; };
__device__ __forceinline__ TileIter xcd_tiles(int ntiles) {
  const int G = gridDim.x, b = blockIdx.x;
  TileIter it;
  if ((G & 7) == 0) {
    const int x = b & 7;
    it.cur = (int)(((long)ntiles * x) >> 3) + (b >> 3);
    it.end = (int)(((long)ntiles * (x + 1)) >> 3);
    it.step = G >> 3;
  } else { it.cur = b; it.end = ntiles; it.step = G; }
  return it;
}

#define VMCNT(n) asm volatile("s_waitcnt vmcnt(" #n ")" ::: "memory")
template <class ARowFn>
__device__ __forceinline__ void gemm_mainloop(f32x4 (&acc)[8][4], ARowFn arow, const h16* __restrict__ Bt, int ldb, int nk, h16* sm, bool zero_init = true) {
  const int tid = tidx(), lane = tid & 63, wave = tid >> 6;
  const int wr = wave >> 2, wc = wave & 3, fr = lane & 15, fq = lane >> 4;
  const h16* ap[4];
  const h16* bp[4];
#pragma unroll
  for (int i = 0; i < 4; ++i) {
    const int r = (i * 8 + wave) * 8 + (lane >> 3);
    const int c = (lane & 7) ^ ((r >> 1) & 7);
    ap[i] = arow(r) + c * 8;
    bp[i] = Bt + (size_t)r * ldb + c * 8;
  }
  if (zero_init) {
#pragma unroll
    for (int m = 0; m < 8; ++m)
#pragma unroll
      for (int n = 0; n < 4; ++n) acc[m][n] = (f32x4){0.f, 0.f, 0.f, 0.f};
  }
  h16* const dA = sm + wave * 512 + lane * 8;
#pragma unroll
  for (int i = 0; i < 4; ++i) { glds16(ap[i], dA + i * 4096); glds16(bp[i], dA + 16384 + i * 4096); ap[i] += 64; bp[i] += 64; }
  const int sw = (fr >> 1) & 7;
  const int aoff = (wr * 128 + fr) * 64, boff = 16384 + (wc * 64 + fr) * 64;
#define SCHED_FENCE() __builtin_amdgcn_sched_barrier(0)
  for (int kt = 0; kt < nk; ++kt) {
    VMCNT(0);
    __builtin_amdgcn_s_barrier();
    const h16* st = sm + (kt & 1) * 32768;
    const bool more = kt + 1 < nk;
    h16* const dn = dA + ((kt + 1) & 1) * 32768;
#pragma unroll
    for (int ks = 0; ks < 2; ++ks) {
      const int ch = ((ks * 4 + fq) ^ sw) * 8;
      h16x8 bf[4];
#pragma unroll
      for (int n = 0; n < 4; ++n) bf[n] = *(const h16x8*)(st + boff + n * 1024 + ch);
#pragma unroll
      for (int mh = 0; mh < 2; ++mh) {
        h16x8 af[4];
#pragma unroll
        for (int m = 0; m < 4; ++m) af[m] = *(const h16x8*)(st + aoff + (mh * 4 + m) * 1024 + ch);
#pragma unroll
        for (int m = 0; m < 4; ++m) {
#pragma unroll
          for (int n = 0; n < 4; ++n) acc[mh * 4 + m][n] = __builtin_amdgcn_mfma_f32_16x16x32_f16(bf[n], af[m], acc[mh * 4 + m][n], 0, 0, 0);
          if (m == 1 || m == 3) {
            const int q = ks * 4 + mh * 2 + (m >> 1);
            SCHED_FENCE();
            if (more) {
              if (q < 4) { glds16(ap[q & 3], dn + (q & 3) * 4096); ap[q & 3] += 64; }
              else { glds16(bp[q & 3], dn + 16384 + (q & 3) * 4096); bp[q & 3] += 64; }
            }
            SCHED_FENCE();
          }
        }
      }
    }
  }
#undef SCHED_FENCE
  __builtin_amdgcn_s_barrier();
}

__device__ __forceinline__ int map_row(int mode, int n) {
  if (mode == 1) return n < 1792 ? n : (n < 1816 ? n + 512 : n - 24);
  if (mode == 2) return 32 * (n >> 4) + (n & 15);
  if (mode == 3) return 32 * (n >> 4) + 16 + (n & 15);
  return n;
}
struct ConvTile { const float* src; h16* dst; int K, N, mode, k0, n0; const float* pos; float* pbp; };
__device__ __forceinline__ ConvTile conv_decode(const Params& p, int l, int t) {
  unsigned char* ws = p.ws;
  constexpr int T_WIN = 16 * 37, T_WOUT = 256, T_G = 16 * 128, T_W1 = 128;
  constexpr int E0 = T_WIN, E1 = E0 + T_WOUT, E2 = E1 + T_G, E3 = E2 + T_G, E4 = E3 + T_G, E5 = E4 + T_W1;
  ConvTile c;
  c.pos = nullptr; c.pbp = nullptr;
  int tk, tn;
  if (t < E0) {
    c.src = p.in[I_WIN] + (size_t)l * 1024 * NINSRC; c.K = 1024; c.N = NINSRC; c.dst = (h16*)(ws + OFF_WIN); c.mode = 1; tk = t / 37; tn = t % 37;
  } else if (t < E1) {
    const int u = t - E0;
    c.src = p.in[I_WOUT] + (size_t)l * 1024 * 1024; c.K = 1024; c.N = 1024; c.dst = (h16*)(ws + OFF_WOUT); c.mode = 4; tk = u >> 4; tn = u & 15;
  } else if (t < E3) {
    const int up = t >= E2;
    const int u = t - (up ? E2 : E1);
    const int e = u >> 7, v = u & 127;
    c.src = p.in[up ? I_MU : I_MG] + ((size_t)l * 16 + e) * 1024 * 512; c.K = 1024; c.N = 512; c.dst = (h16*)(ws + OFF_WGU) + (size_t)e * 1024 * 1024;
    c.mode = up ? 3 : 2; tk = v >> 3; tn = v & 7;
  } else if (t < E4) {
    const int u = t - E3;
    const int e = u >> 7, v = u & 127;
    c.src = p.in[I_MD] + ((size_t)l * 16 + e) * 512 * 1024; c.K = 512; c.N = 1024; c.dst = (h16*)(ws + OFF_WDN) + (size_t)e * 1024 * 512; c.mode = 0; tk = v >> 4; tn = v & 15;
  } else {
    const int vv = t >= E5;
    const int u = t - (vv ? E5 : E4);
    c.src = p.in[vv ? I_CVW1 : I_CKW1] + (size_t)l * 2048 * 256; c.K = 2048; c.N = 256; c.dst = (h16*)(ws + (vv ? OFF_W1V : OFF_W1K)); c.mode = 5; tk = u >> 2; tn = u & 3;
    c.pos = p.in[vv ? I_CPV : I_CPK] + (size_t)l * 2048 + tk * 64;
    c.pbp = (float*)(ws + OFF_PBPART) + (size_t)(vv * 32 + tk) * 256 + tn * 64;
  }
  c.k0 = tk * 64; c.n0 = tn * 64;
  return c;
}
__device__ __forceinline__ void conv_wave_tile(const ConvTile& c, float* smw, int lane) {
  float4 v[16];
#pragma unroll
  for (int i = 0; i < 16; ++i) {
    const int idx = i * 64 + lane;
    const int r = idx >> 4, c4 = (idx & 15) * 4;
    v[i] = make_float4(0.f, 0.f, 0.f, 0.f);
    if (c.n0 + c4 < c.N) v[i] = *(const float4*)(c.src + (size_t)(c.k0 + r) * c.N + c.n0 + c4);
  }
#pragma unroll
  for (int i = 0; i < 16; ++i) {
    const int idx = i * 64 + lane;
    const int r = idx >> 4, c4 = (idx & 15) * 4;
    float* d = smw + r * 65 + c4;
    d[0] = v[i].x; d[1] = v[i].y; d[2] = v[i].z; d[3] = v[i].w;
  }
  if (c.mode == 5) {
    float sacc = 0.f;
    for (int k = 0; k < 64; ++k) sacc += c.pos[k] * smw[k * 65 + lane];
    c.pbp[lane] = sacc;
  }
  const int k0d = c.mode == 4 ? (c.k0 < 256 ? c.k0 + 512 : (c.k0 < 768 ? c.k0 - 256 : c.k0)) : c.k0;
#pragma unroll
  for (int j = 0; j < 8; ++j) {
    const int ch = j * 64 + lane;
    const int n = ch >> 3, kc = ch & 7;
    if (c.n0 + n < c.N) {
      h16x8 o;
#pragma unroll
      for (int q = 0; q < 8; ++q) o[q] = (h16)smw[(kc * 8 + q) * 65 + n];
      *(h16x8*)(c.dst + (size_t)map_row(c.mode, c.n0 + n) * c.K + k0d + kc * 8) = o;
    }
  }
}

__device__ __forceinline__ void phase_convert(const Params& p, int l, float* sm) {
  unsigned char* ws = p.ws;
  constexpr int NT_CONV = 16 * 37 + 256 + 3 * 16 * 128 + 2 * 128;
  {
    const int tid = tidx(), lane = tid & 63, wave = tid >> 6;
    float* smw = sm + wave * 4160;
    for (int t = blockIdx.x * NW + wave; t < NT_CONV; t += gridDim.x * NW) {
      const ConvTile c = conv_decode(p, l, t);
      conv_wave_tile(c, smw, lane);
    }
    __syncthreads();
  }
  {
    h16x8 z = {0, 0, 0, 0, 0, 0, 0, 0};
    h16* w = (h16*)(ws + OFF_WIN) + (size_t)NINSRC * 1024;
    for (int i = blockIdx.x * NTHREADS + tidx(); i < (NINP - NINSRC) * 1024 / 8; i += gridDim.x * NTHREADS) *(h16x8*)(w + (size_t)i * 8) = z;
  }
}

__device__ __forceinline__ void phase_prep(const Params& p, float* sm) {
  unsigned char* ws = p.ws;
  const int tid = tidx();
  if (blockIdx.x == 0) {
    for (int i = tid; i < 1024; i += NTHREADS) ((unsigned*)(ws + OFF_CTL))[i] = 0u;
  }
  float* mod = (float*)(ws + OFF_MOD);
  for (int t = blockIdx.x; t < 384; t += gridDim.x) {
    const int l = t / 192, j0 = (t % 192) * 32;
    const int kg = tid >> 3, cq = tid & 7;
    const float* w = p.in[I_ADAW] + (size_t)l * 1024 * 6144 + j0 + 4 * cq;
    const float* c = p.in[I_C];
    float a0[4] = {0, 0, 0, 0}, a1[4] = {0, 0, 0, 0};
#pragma unroll 8
    for (int k = kg * 16; k < kg * 16 + 16; ++k) {
      const float4 wv = *(const float4*)(w + (size_t)k * 6144);
      const float s0 = silu_f(c[k]), s1 = silu_f(c[1024 + k]);
      a0[0] += s0 * wv.x; a0[1] += s0 * wv.y; a0[2] += s0 * wv.z; a0[3] += s0 * wv.w;
      a1[0] += s1 * wv.x; a1[1] += s1 * wv.y; a1[2] += s1 * wv.z; a1[3] += s1 * wv.w;
    }
    float* r = sm + (kg * 8 + cq) * 8;
#pragma unroll
    for (int i = 0; i < 4; ++i) { r[i] = a0[i]; r[4 + i] = a1[i]; }
    __syncthreads();
    if (tid < 64) {
      const int bb = tid >> 5, col = tid & 31, q = col >> 2, ci = col & 3;
      float s = 0.f;
      for (int g = 0; g < 64; ++g) s += sm[(g * 8 + q) * 8 + bb * 4 + ci];
      mod[(size_t)(l * 2 + bb) * 6144 + j0 + col] = s + p.in[I_ADAB][l * 6144 + j0 + col];
    }
    __syncthreads();
  }
  float* rc = (float*)(ws + OFF_ROPE);
  float* rs = rc + (size_t)T * 32;
  const int* pos = (const int*)p.in[I_POS];
  for (int i = blockIdx.x * NTHREADS + tid; i < T * 32; i += gridDim.x * NTHREADS) {
    const int t = i >> 5, f = i & 31;
    const double a = (double)pos[t] * p.inv_freq[f];
    const double n = rint(a * 0.15915494309189535);
    double r = fma(-n, 6.283185307179586, a);
    r = fma(-n, 2.4492935982947064e-16, r);
    const float rf = (float)r;
    rc[i] = cosf(rf);
    rs[i] = sinf(rf);
  }
}

__device__ __forceinline__ void phase_norm1(const Params& p, int mode) {
  unsigned char* ws = p.ws;
  const int lane = tidx() & 63, wave = tidx() >> 6;
  const float* mod = (const float*)(ws + OFF_MOD);
  float* xa = (float*)(ws + OFF_XA);
  const h16* yp = (const h16*)(ws + OFF_YPAIR);
  h16* hout = (h16*)(ws + OFF_H16);
  const int l = (mode == 0) ? 0 : 1;
  for (int row = blockIdx.x * NW + wave; row < T; row += gridDim.x * NW) {
    const int b = row >> 13;
    float4 x[4];
    float ss = 0.f;
#pragma unroll
    for (int i = 0; i < 4; ++i) {
      const int col = lane * 4 + 256 * i;
      if (mode == 0) {
        x[i] = *(const float4*)(p.in[I_X] + (size_t)row * D + col);
      } else {
        const int lp = mode == 1 ? 0 : 1;
        const float4 xv = *(const float4*)(xa + (size_t)row * D + col);
        const float4 g2 = *(const float4*)(mod + (size_t)(lp * 2 + b) * 6144 + 5120 + col);
        const h16x4 y0 = *(const h16x4*)(yp + (size_t)(row * 2) * D + col);
        const h16x4 y1 = *(const h16x4*)(yp + (size_t)(row * 2 + 1) * D + col);
        x[i].x = xv.x + g2.x * ((float)y0[0] + (float)y1[0]);
        x[i].y = xv.y + g2.y * ((float)y0[1] + (float)y1[1]);
        x[i].z = xv.z + g2.z * ((float)y0[2] + (float)y1[2]);
        x[i].w = xv.w + g2.w * ((float)y0[3] + (float)y1[3]);
        if (mode == 1) *(float4*)(xa + (size_t)row * D + col) = x[i];
      }
      ss += x[i].x * x[i].x + x[i].y * x[i].y + x[i].z * x[i].z + x[i].w * x[i].w;
    }
    ss = wsum(ss);
    const float rstd = rsqrtf(ss * (1.f / D) + EPS);
#pragma unroll
    for (int i = 0; i < 4; ++i) {
      const int col = lane * 4 + 256 * i;
      if (mode == 2) {
        const float4 g = *(const float4*)(p.in[I_FNG] + col);
        float4 o;
        o.x = x[i].x * rstd * g.x; o.y = x[i].y * rstd * g.y; o.z = x[i].z * rstd * g.z; o.w = x[i].w * rstd * g.w;
        *(float4*)(p.out + (size_t)row * D + col) = o;
      } else {
        const float4 g = *(const float4*)(p.in[I_N1G] + l * D + col);
        const float4 sh = *(const float4*)(mod + (size_t)(l * 2 + b) * 6144 + col);
        const float4 sc = *(const float4*)(mod + (size_t)(l * 2 + b) * 6144 + 1024 + col);
        *(h16x4*)(hout + (size_t)row * D + col) = pack4(x[i].x * rstd * g.x * (1.f + sc.x) + sh.x, x[i].y * rstd * g.y * (1.f + sc.y) + sh.y,
                                                        x[i].z * rstd * g.z * (1.f + sc.z) + sh.z, x[i].w * rstd * g.w * (1.f + sc.w) + sh.w);
      }
    }
  }
}

__device__ __forceinline__ void phase_inproj(const Params& p, h16* sm) {
  unsigned char* ws = p.ws;
  const h16* A = (const h16*)(ws + OFF_H16);
  const h16* W = (const h16*)(ws + OFF_WIN);
  h16* P = (h16*)(ws + OFF_P16);
  const TileIter ti = xcd_tiles(64 * 10);
  for (int t = ti.cur; t < ti.end; t += ti.step) {
    const int mt = t / 10, nt = t % 10;
    f32x4 acc[8][4];
    const h16* Ab = A + (size_t)mt * 256 * D;
    gemm_mainloop(acc, [&](int r) { return Ab + (size_t)r * D; }, W + (size_t)nt * 256 * D, D, D / 64, sm);
    const int tid_e = tidx(), lane = tid_e & 63, wave = tid_e >> 6, wr = wave >> 2, wc = wave & 3, fr = lane & 15, fq = lane >> 4;
    if (nt * 256 + wc * 64 < NIN) {
#pragma unroll
      for (int m = 0; m < 8; ++m)
#pragma unroll
        for (int n = 0; n < 4; ++n) {
          const int row = mt * 256 + wr * 128 + m * 16 + fr, col = nt * 256 + wc * 64 + n * 16 + 4 * fq;
          *(h16x4*)(P + (size_t)row * NIN + col) = pack4(acc[m][n][0], acc[m][n][1], acc[m][n][2], acc[m][n][3]);
        }
    }
  }
}

__device__ __forceinline__ int perm_key(int pos) {
  return 32 * (pos >> 5) + 16 * ((pos >> 2) & 1) + 4 * ((pos >> 3) & 3) + (pos & 3);
}
__device__ __forceinline__ void phase_post(const Params& p) {
  unsigned char* ws = p.ws;
  const h16* P = (const h16*)(ws + OFF_P16);
  const float* rc = (const float*)(ws + OFF_ROPE);
  const float* rs = rc + (size_t)T * 32;
  h16* q16 = (h16*)(ws + OFF_Q16);
  float* gates = (float*)(ws + OFF_GATES);
  const int lane = tidx() & 63, wave = tidx() >> 6;
  if (blockIdx.x == 0) {
    const int o = tidx();
    const float* pp = (const float*)(ws + OFF_PBPART) + (size_t)(o >> 8) * 32 * 256 + (o & 255);
    float acc = 0.f;
    for (int k = 0; k < 32; ++k) acc += pp[k * 256];
    ((float*)(ws + OFF_PB))[o] = acc;
  }
  for (int row = blockIdx.x * NW + wave; row < T; row += gridDim.x * NW) {
    const int b = row >> 13, s = row & (S - 1);
    const h16* pr = P + (size_t)row * NIN;
    const int d = (lane & 7) * 4;
    const float4 cs = *(const float4*)(rc + (size_t)row * 32 + d);
    const float4 sn = *(const float4*)(rs + (size_t)row * 32 + d);
    {
      const int hd = lane >> 3;
      const h16x4 a = *(const h16x4*)(pr + C_Q + 64 * hd + d);
      const h16x4 bb = *(const h16x4*)(pr + C_Q + 64 * hd + 32 + d);
      const float a0 = a[0], a1 = a[1], a2 = a[2], a3 = a[3], b0 = bb[0], b1 = bb[1], b2 = bb[2], b3 = bb[3];
      h16* qo = q16 + (size_t)row * 512 + 64 * hd + d;
      constexpr float QS = 0.125f * 1.4426950408889634f;
      *(h16x4*)qo = pack4((a0 * cs.x - b0 * sn.x) * QS, (a1 * cs.y - b1 * sn.y) * QS, (a2 * cs.z - b2 * sn.z) * QS, (a3 * cs.w - b3 * sn.w) * QS);
      *(h16x4*)(qo + 32) = pack4((b0 * cs.x + a0 * sn.x) * QS, (b1 * cs.y + a1 * sn.y) * QS, (b2 * cs.z + a2 * sn.z) * QS, (b3 * cs.w + a3 * sn.w) * QS);
    }
    if (lane < 48) {
      const int tn = lane >> 4, hd = (lane >> 3) & 1;
      const int cb = (tn == 0 ? C_KC : (tn == 1 ? C_KS : C_KW)) + 64 * hd;
      const size_t off = tn == 0 ? OFF_KC : (tn == 1 ? OFF_KS : OFF_KW);
      const h16x4 a = *(const h16x4*)(pr + cb + d);
      const h16x4 bb = *(const h16x4*)(pr + cb + 32 + d);
      const float a0 = a[0], a1 = a[1], a2 = a[2], a3 = a[3], b0 = bb[0], b1 = bb[1], b2 = bb[2], b3 = bb[3];
      h16* ko = (h16*)(ws + off) + ((size_t)(b * 2 + hd) * S + s) * 64 + d;
      *(h16x4*)ko = pack4(a0 * cs.x - b0 * sn.x, a1 * cs.y - b1 * sn.y, a2 * cs.z - b2 * sn.z, a3 * cs.w - b3 * sn.w);
      *(h16x4*)(ko + 32) = pack4(b0 * cs.x + a0 * sn.x, b1 * cs.y + a1 * sn.y, b2 * cs.z + a2 * sn.z, b3 * cs.w + a3 * sn.w);
    }
    if (lane < 32) {
      const int hd = lane >> 4, dd = (lane & 15) * 4;
      *(h16x4*)((h16*)(ws + OFF_VC) + ((size_t)(b * 2 + hd) * S + s) * 64 + dd) = *(const h16x4*)(pr + C_VC + 64 * hd + dd);
    }
    if (lane < 24) gates[(size_t)row * 24 + lane] = sigm((float)pr[C_GATE + lane]);
  }
  for (int task = blockIdx.x; task < 1024; task += gridDim.x) {
    const int tensor = task & 1, kv = (task >> 1) & 1, blk = (task >> 2) & 127, b = task >> 9;
    const int srccol = (tensor ? C_VW : C_VS) + 64 * kv;
    h16* dst = (h16*)(ws + (tensor ? OFF_VWT : OFF_VST)) + ((size_t)((b * 2 + kv) * 128 + blk)) * 4096;
    const int dim = tidx() & 63, kg = tidx() >> 6;
    {
      const int p0 = kg * 8;
      h16x8 v;
#pragma unroll
      for (int j = 0; j < 8; ++j) v[j] = P[(size_t)(b * S + blk * 64 + perm_key(p0 + j)) * NIN + srccol + dim];
      *(h16x8*)(dst + dim * 64 + p0) = v;
    }
  }
}

__device__ __forceinline__ void mixa_compress1(const Params& p, int item, h16* sm) {
  unsigned char* ws = p.ws;
  const int which = item >> 5, mt = (item >> 2) & 7, ks = item & 3;
  const h16* A = (const h16*)(ws + (which ? OFF_VC : OFF_KC)) + (size_t)mt * 256 * 1024 + ks * 512;
  const h16* W = (const h16*)(ws + (which ? OFF_W1V : OFF_W1K)) + ks * 512;
  float* hp = (float*)(ws + OFF_HIDP) + ((size_t)(ks * 2 + which) * 2048) * 256;
  f32x4 acc[8][4];
  gemm_mainloop(acc, [&](int r) { return A + (size_t)r * 1024; }, W, 2048, 8, sm);
  const int tid_e = tidx(), lane = tid_e & 63, wave = tid_e >> 6, wr = wave >> 2, wc = wave & 3, fr = lane & 15, fq = lane >> 4;
#pragma unroll
  for (int m = 0; m < 8; ++m)
#pragma unroll
    for (int n = 0; n < 4; ++n) {
      const int row = mt * 256 + wr * 128 + m * 16 + fr, col = wc * 64 + n * 16 + 4 * fq;
      *(f32x4*)(hp + (size_t)row * 256 + col) = acc[m][n];
    }
}

__device__ __forceinline__ void mixa_lru(const Params& p, int l, int item, float* sm) {
  unsigned char* ws = p.ws;
  const int half = tidx() >> 8;
  item = item * 2 + half;
  sm += half * 12288;
  const int b = item >> 8, ck = item & 255;
  const int c = tidx() & 255;
  const int nb = c >> 6, e = c & 63;
  const h16* P = (const h16*)(ws + OFF_P16);
  const float* cw = p.in[I_LCW] + l * 4 * 256;
  const float w0 = cw[c], w1 = cw[256 + c], w2 = cw[512 + c], w3 = cw[768 + c], cb = p.in[I_LCB][l * 256 + c];
  const float ba = p.in[I_LBA][l * 256 + c], bx = p.in[I_LBX][l * 256 + c];
  const float lam = p.in[I_LLAM][l * 256 + c];
  const float ls = -log1pf(expf(-lam));
  const float* pa = p.in[I_LWA] + ((size_t)(l * 4 + nb) * 64) * 64 + e;
  const float* px = p.in[I_LWX] + ((size_t)(l * 4 + nb) * 64) * 64 + e;
  const int t0 = ck * 32;
  float x0 = 0.f, x1 = 0.f, x2 = 0.f;
  if (t0 >= 3) {
    x0 = (float)P[(size_t)(b * S + t0 - 3) * NIN + C_XL + c];
    x1 = (float)P[(size_t)(b * S + t0 - 2) * NIN + C_XL + c];
    x2 = (float)P[(size_t)(b * S + t0 - 1) * NIN + C_XL + c];
  }
  float h = 0.f, ap = 1.f;
  float* lh = (float*)(ws + OFF_LRUH);
  float* la = (float*)(ws + OFF_LRUA);
  float* sr = sm + 4096;
  float* si = sm + 8192;
#pragma unroll 1
  for (int sub = 0; sub < 2; ++sub) {
    const int tb = t0 + sub * 16;
    {
      h16 xv[16];
      const h16* xp = P + (size_t)(b * S + tb) * NIN + C_XL + c;
#pragma unroll
      for (int tt = 0; tt < 16; ++tt) { xv[tt] = *xp; xp += NIN; asm volatile("" : "+v"(xp)); }
#pragma unroll
      for (int tt = 0; tt < 16; ++tt) {
        const float x3 = (float)xv[tt];
        sm[tt * 256 + c] = w0 * x0 + w1 * x1 + w2 * x2 + w3 * x3 + cb;
        x0 = x1; x1 = x2; x2 = x3;
      }
    }
    __syncthreads();
    {
      float accr[16], acci[16];
#pragma unroll
      for (int tt = 0; tt < 16; ++tt) { accr[tt] = 0.f; acci[tt] = 0.f; }
#pragma unroll 1
      for (int d8 = 0; d8 < 8; ++d8) {
        float wa8[8], wx8[8];
        const float* pa8 = pa + d8 * 512;
        const float* px8 = px + d8 * 512;
#pragma unroll
        for (int j = 0; j < 8; ++j) { wa8[j] = pa8[j * 64]; wx8[j] = px8[j * 64]; }
        const float* xr = sm + nb * 64 + d8 * 8;
#pragma unroll
        for (int tt = 0; tt < 16; ++tt) {
          const float4 xa = *(const float4*)(xr + tt * 256), xb = *(const float4*)(xr + tt * 256 + 4);
          accr[tt] += xa.x * wa8[0] + xa.y * wa8[1] + xa.z * wa8[2] + xa.w * wa8[3] + xb.x * wa8[4] + xb.y * wa8[5] + xb.z * wa8[6] + xb.w * wa8[7];
          acci[tt] += xa.x * wx8[0] + xa.y * wx8[1] + xa.z * wx8[2] + xa.w * wx8[3] + xb.x * wx8[4] + xb.y * wx8[5] + xb.z * wx8[6] + xb.w * wx8[7];
        }
      }
#pragma unroll
      for (int tt = 0; tt < 16; ++tt) { sr[tt * 256 + c] = accr[tt]; si[tt * 256 + c] = acci[tt]; }
    }
#pragma unroll 4
    for (int tt = 0; tt < 16; ++tt) {
      const float r = sigm(sr[tt * 256 + c] + ba), ig = sigm(si[tt * 256 + c] + bx);
      const float log_a = 8.f * r * ls;
      const float a = __expf(log_a);
      const float mult = sqrtf(-expm1f(2.f * log_a));
      sr[tt * 256 + c] = a;
      si[tt * 256 + c] = mult * ig * sm[tt * 256 + c];
    }
    float* lhp = lh + (size_t)(b * S + tb) * 256 + c;
    float* lap = la + (size_t)(b * S + tb) * 256 + c;
#pragma unroll 4
    for (int tt = 0; tt < 16; ++tt) {
      const float a = sr[tt * 256 + c];
      h = a * h + si[tt * 256 + c];
      ap *= a;
      lhp[tt * 256] = h;
      lap[tt * 256] = ap;
    }
    __syncthreads();
  }
  ((float*)(ws + OFF_HEND))[(size_t)(b * 256 + ck) * 256 + c] = h;
  ((float*)(ws + OFF_AEND))[(size_t)(b * 256 + ck) * 256 + c] = ap;
}

__device__ __forceinline__ void mixa_conv(const Params& p, int l, int item, float* sm) {
  unsigned char* ws = p.ws;
  const int half = tidx() >> 8;
  item = item * 2 + half;
  sm += half * 15872;
  const int b = item >> 8, ck = item & 255;
  const int c = tidx() & 255;
  const h16* P = (const h16*)(ws + OFF_P16);
  const int t0 = ck * 32;
#pragma unroll 1
  for (int r0 = 0; r0 < 64; r0 += 16) {
    h16 va[16], vb[16];
#pragma unroll
    for (int q = 0; q < 16; ++q) {
      const int t = t0 - 30 + r0 + q;
      va[q] = (h16)0.f; vb[q] = (h16)0.f;
      if (t >= 0 && r0 + q < 62) {
        const h16* pr = P + (size_t)(b * S + t) * NIN;
        va[q] = pr[C_CVA + c]; vb[q] = pr[C_CVB + c];
      }
    }
#pragma unroll
    for (int q = 0; q < 16; ++q)
      if (r0 + q < 62) sm[(r0 + q) * 256 + c] = (float)va[q] * sigm((float)vb[q]);
  }
  float w[31];
#pragma unroll
  for (int j = 0; j < 31; ++j) w[j] = p.in[I_DWW][(size_t)(l * 31 + j) * 256 + c];
  const float bias = p.in[I_DWB][l * 256 + c];
  for (int i = 0; i < 32; ++i) {
    float z = bias;
#pragma unroll
    for (int j = 0; j < 31; ++j) z += w[j] * sm[(i + j) * 256 + c];
    sm[i * 256 + c] = z;
  }
  __syncthreads();
  const int lane = tidx() & 63, wave = (tidx() >> 6) & 3;
  const float4 lg = *(const float4*)(p.in[I_LNG] + l * 256 + lane * 4);
  const float4 lb = *(const float4*)(p.in[I_LNB] + l * 256 + lane * 4);
  const float4 gn = *(const float4*)(p.in[I_ONG] + l * 1024 + 768 + lane * 4);
  h16* yc = (h16*)(ws + OFF_H16);
  for (int i = wave * 8; i < wave * 8 + 8; ++i) {
    const float4 z = *(const float4*)(sm + i * 256 + lane * 4);
    const float mu = wsum(z.x + z.y + z.z + z.w) * (1.f / 256.f);
    const float dx = z.x - mu, dy = z.y - mu, dz = z.z - mu, dw = z.w - mu;
    const float var = wsum(dx * dx + dy * dy + dz * dz + dw * dw) * (1.f / 256.f);
    const float rs = rsqrtf(var + EPS);
    const float y0 = silu_f(dx * rs * lg.x + lb.x), y1 = silu_f(dy * rs * lg.y + lb.y), y2 = silu_f(dz * rs * lg.z + lb.z), y3 = silu_f(dw * rs * lg.w + lb.w);
    const float r2 = rsqrtf(wsum(y0 * y0 + y1 * y1 + y2 * y2 + y3 * y3) * (1.f / 256.f) + EPS);
    *(h16x4*)(yc + (size_t)(b * S + t0 + i) * D + 768 + lane * 4) = pack4(y0 * r2 * gn.x, y1 * r2 * gn.y, y2 * r2 * gn.z, y3 * r2 * gn.w);
  }
  __syncthreads();
}

__device__ __forceinline__ void phase_mixa(const Params& p, int l, void* sm) {
  const int G = gridDim.x;
  for (int it = blockIdx.x; it < 64; it += G) mixa_compress1(p, it, (h16*)sm);
  for (int it = blockIdx.x; it < 256; it += G) mixa_lru(p, l, it, (float*)sm);
  for (int it = (blockIdx.x + G - 64 % G) % G; it < 256; it += G) mixa_conv(p, l, it, (float*)sm);
}

__device__ __forceinline__ void phase_mixb(const Params& p, int l, float* sm) {
  unsigned char* ws = p.ws;
  const int tid = tidx();
  for (int it = blockIdx.x; it < 512; it += gridDim.x) {
    const int which = it >> 8;
    const int row0 = (it & 255) * 8;
    {
      const float* hp = (const float*)(ws + OFF_HIDP) + ((size_t)which * 2048 + row0) * 256;
      const float* pb = (const float*)(ws + OFF_PB) + which * 256;
      const int r = tid >> 6, c4 = (tid & 63) * 4;
      const size_t o = (size_t)r * 256 + c4;
      const float4 a0 = *(const float4*)(hp + o), a1 = *(const float4*)(hp + (size_t)2 * 2048 * 256 + o);
      const float4 a2 = *(const float4*)(hp + (size_t)4 * 2048 * 256 + o), a3 = *(const float4*)(hp + (size_t)6 * 2048 * 256 + o);
      const float4 bb = *(const float4*)(pb + c4);
      float* d = sm + r * 256 + c4;
      d[0] = gelu_tanh(a0.x + a1.x + a2.x + a3.x + bb.x); d[1] = gelu_tanh(a0.y + a1.y + a2.y + a3.y + bb.y);
      d[2] = gelu_tanh(a0.z + a1.z + a2.z + a3.z + bb.z); d[3] = gelu_tanh(a0.w + a1.w + a2.w + a3.w + bb.w);
      const float4* wsrc = (const float4*)(p.in[which ? I_CVW2 : I_CKW2] + (size_t)l * 256 * 64);
      float4* wdst = (float4*)(sm + 2048);
#pragma unroll
      for (int q = 0; q < 8; ++q) wdst[q * NTHREADS + tid] = wsrc[q * NTHREADS + tid];
    }
    __syncthreads();
    const int row = row0 + (tid >> 6), d = tid & 63;
    const float* hr = sm + (tid >> 6) * 256;
    const float* w2 = sm + 2048 + d;
    float s = 0.f;
#pragma unroll 8
    for (int j = 0; j < 256; ++j) s += (float)(h16)hr[j] * w2[j * 64];
    const int bkv = row >> 9, n = row & 511;
    if (n == 511) s = 0.f;
    if (which == 0) {
      ((h16*)(ws + OFF_KCMP))[((size_t)bkv * 512 + n) * 64 + d] = (h16)s;
    } else {
      const int blk = n >> 6, key = n & 63;
      const int pos = 32 * (key >> 5) + 8 * ((key >> 2) & 3) + 4 * ((key >> 4) & 1) + (key & 3);
      ((h16*)(ws + OFF_VCMPT))[((size_t)(bkv * 8 + blk) * 64 + d) * 64 + pos] = (h16)s;
    }
    __syncthreads();
  }
  const int g = blockIdx.x * NTHREADS + tid;
  if (g < 512) {
    const int b = g >> 8, c = g & 255;
    const float* he = (const float*)(ws + OFF_HEND) + (size_t)b * 256 * 256 + c;
    const float* ae = (const float*)(ws + OFF_AEND) + (size_t)b * 256 * 256 + c;
    float* cy = (float*)(ws + OFF_CARRY) + (size_t)b * 256 * 256 + c;
    float carry = 0.f;
#pragma unroll 1
    for (int k0 = 0; k0 < 256; k0 += 32) {
      float hv[32], av[32];
#pragma unroll
      for (int k = 0; k < 32; ++k) { hv[k] = he[(k0 + k) * 256]; av[k] = ae[(k0 + k) * 256]; }
#pragma unroll
      for (int k = 0; k < 32; ++k) {
        cy[(k0 + k) * 256] = carry;
        carry = hv[k] + av[k] * carry;
      }
    }
  }
}

__device__ __forceinline__ void stage8k(const h16* __restrict__ g, h16* l, int tid) {
  const int r = tid >> 3, cl = (tid & 7) ^ ((r >> 1) & 7);
  glds16(g + r * 64 + cl * 8, l + tid * 8);
}
__device__ __forceinline__ h16x8 ldfrag(const h16* l, int row, int chunk) {
  return *(const h16x8*)(l + row * 64 + ((chunk ^ ((row >> 1) & 7)) * 8));
}

template <int MODE>
__device__ __forceinline__ void attn_branch(const h16* __restrict__ Kg, const h16* __restrict__ Vg, int j0, int j1, h16* ring,
                                            const h16x8 (&qf)[2][2], float (&m)[2], float (&l)[2], f32x4 (&o)[2][4],
                                            const int (&tq)[2], const int (&lim)[2], const int (&tlim)[2], const int (&tfl)[2],
                                            const unsigned long long (&mylo)[2], const unsigned long long (&myhi)[2],
                                            const unsigned long long (&ulo)[2], const unsigned long long (&uhi)[2],
                                            const float (&inv)[2], float* impw) {
  int tid = tidx();
  asm volatile("" : "+v"(tid));
  const int lane = tid & 63;
  const int h = lane >> 4, c = lane & 15, qi = c >> 2, g = c & 3;
  constexpr bool PV = MODE != 0;
  constexpr int NSLOT = 6;
  const int n = j1 - j0 + 1;
  if (n <= 0) return;
  const int nss = (n + 1) >> 1;
#pragma unroll
  for (int q = 0; q < 4; ++q)
    if (q < n) {
      stage8k(Kg + (size_t)(j0 + q) * 4096, ring + q * 8192, tid);
      if (PV) stage8k(Vg + (size_t)(j0 + q) * 4096, ring + q * 8192 + 4096, tid);
    }
  int sbase = 0;
  for (int ss = 0; ss < nss; ++ss) {
    {
      const int nb1 = n - 2 * (ss + 1);
      if (PV) { if (nb1 >= 2) VMCNT(4); else if (nb1 == 1) VMCNT(2); else VMCNT(0); }
      else    { if (nb1 >= 2) VMCNT(2); else if (nb1 == 1) VMCNT(1); else VMCNT(0); }
    }
    __builtin_amdgcn_s_barrier();
    {
      const int sn = sbase >= 2 ? sbase - 2 : sbase + 4;
#pragma unroll
      for (int q = 0; q < 2; ++q) {
        const int jb = 2 * (ss + 2) + q;
        if (jb < n) {
          stage8k(Kg + (size_t)(j0 + jb) * 4096, ring + (sn + q) * 8192, tid);
          if (PV) stage8k(Vg + (size_t)(j0 + jb) * 4096, ring + (sn + q) * 8192 + 4096, tid);
        }
      }
    }
#pragma unroll 1
   for (int sub = 0; sub < 2; ++sub) {
    const int it = 2 * ss + sub;
    if (it >= n) break;
    const int j = j0 + it;
    const h16* cK = ring + (sbase + sub) * 8192;
    const h16* cV = cK + 4096;
    bool act[2];
#pragma unroll
    for (int mq = 0; mq < 2; ++mq) {
      if (MODE <= 1) act[mq] = j * 64 <= tlim[mq];
      else if (MODE == 2) act[mq] = ((j < 64 ? (ulo[mq] >> j) : (uhi[mq] >> (j - 64))) & 1ull) != 0ull;
      else act[mq] = (j * 64 <= tlim[mq] + 3) && (j * 64 + 63 > tlim[mq] - 512);
    }
    if (act[0] || act[1]) {
      h16x8 pf[2][2];
      h16x8 kf[4][2];
#pragma unroll
      for (int kt = 0; kt < 4; ++kt)
#pragma unroll
        for (int ks = 0; ks < 2; ++ks) kf[kt][ks] = ldfrag(cK, 16 * kt + c, 4 * ks + h);
#pragma unroll
      for (int mq = 0; mq < 2; ++mq)
        if (act[mq]) {
          f32x4 s[1][4];
          {
#pragma unroll
            for (int kt = 0; kt < 4; ++kt) {
              s[0][kt] = (f32x4){0.f, 0.f, 0.f, 0.f};
#pragma unroll
              for (int ks = 0; ks < 2; ++ks) s[0][kt] = __builtin_amdgcn_mfma_f32_16x16x32_f16(kf[kt][ks], qf[mq][ks], s[0][kt], 0, 0, 0);
            }
          }
          const bool selbit = MODE == 2 ? (((j < 64 ? (mylo[mq] >> j) : (myhi[mq] >> (j - 64))) & 1ull) != 0ull) : true;
          bool interior;
          if (MODE <= 1) interior = j * 64 + 63 <= tfl[mq];
          else if (MODE == 2) interior = j * 64 + 63 <= tfl[mq];
          else interior = (j * 64 + 63 <= tfl[mq]) && (j * 64 > tfl[mq] + 3 - 512);
          if (!interior) {
            const int pbase = j * 64 + 4 * h;
#pragma unroll
            for (int kt = 0; kt < 4; ++kt)
#pragma unroll
              for (int i = 0; i < 4; ++i) {
                const int pos = pbase + 16 * kt + i;
                bool v;
                if (MODE <= 1) v = pos <= lim[mq];
                else if (MODE == 2) v = selbit && pos <= tq[mq];
                else v = pos <= tq[mq] && pos > tq[mq] - 512;
                s[0][kt][i] = v ? s[0][kt][i] : -1e30f;
              }
          }
          const bool rowoff = MODE == 2 && interior && !selbit;
          if (MODE == 1) {
#pragma unroll
            for (int kt = 0; kt < 4; ++kt) {
              float ps = 0.f;
#pragma unroll
              for (int i = 0; i < 4; ++i) {
                const float pv = __builtin_amdgcn_exp2f(s[0][kt][i] - m[mq]) * inv[mq];
                s[0][kt][i] = pv;
                ps += pv;
              }
              ps += __shfl_xor(ps, 1);
              ps += __shfl_xor(ps, 2);
              if (g == 0) impw[(4 * mq + qi) * 128 + j * 16 + kt * 4 + h] = ps;
            }
          } else {
            float bm = fmaxf(fmaxf(fmaxf(s[0][0][0], s[0][0][1]), fmaxf(s[0][0][2], s[0][0][3])), fmaxf(fmaxf(s[0][1][0], s[0][1][1]), fmaxf(s[0][1][2], s[0][1][3])));
            bm = fmaxf(bm, fmaxf(fmaxf(fmaxf(s[0][2][0], s[0][2][1]), fmaxf(s[0][2][2], s[0][2][3])), fmaxf(fmaxf(s[0][3][0], s[0][3][1]), fmaxf(s[0][3][2], s[0][3][3]))));
            bm = rowoff ? -1e30f : bm;
            if (__any(bm > m[mq] + 8.f)) {
              bm = fmaxf(bm, __shfl_xor(bm, 16));
              bm = fmaxf(bm, __shfl_xor(bm, 32));
              const float mn = fmaxf(m[mq], bm);
              const float alpha = __builtin_amdgcn_exp2f(m[mq] - mn);
              l[mq] *= alpha;
              m[mq] = mn;
              if (PV) {
#pragma unroll
                for (int mt = 0; mt < 4; ++mt) o[mq][mt] *= alpha;
              }
            }
            const float mref = (m[mq] > -1e29f && !rowoff) ? m[mq] : 1e30f;
            float ps = 0.f;
#pragma unroll
            for (int kt = 0; kt < 4; ++kt)
#pragma unroll
              for (int i = 0; i < 4; ++i) {
                const float pv = __builtin_amdgcn_exp2f(s[0][kt][i] - mref);
                s[0][kt][i] = pv;
                ps += pv;
              }
            l[mq] += ps;
          }
          if (PV) {
#pragma unroll
            for (int s2 = 0; s2 < 2; ++s2)
#pragma unroll
              for (int i = 0; i < 4; ++i) { pf[mq][s2][i] = (h16)s[0][2 * s2][i]; pf[mq][s2][4 + i] = (h16)s[0][2 * s2 + 1][i]; }
          }
        }
      if (PV) {
        h16x8 vf[4][2];
#pragma unroll
        for (int mt = 0; mt < 4; ++mt)
#pragma unroll
          for (int s2 = 0; s2 < 2; ++s2) vf[mt][s2] = ldfrag(cV, 16 * mt + c, 4 * s2 + h);
#pragma unroll
        for (int mq = 0; mq < 2; ++mq)
          if (act[mq]) {
#pragma unroll
            for (int s2 = 0; s2 < 2; ++s2) {
#pragma unroll
              for (int mt = 0; mt < 4; ++mt) o[mq][mt] = __builtin_amdgcn_mfma_f32_16x16x32_f16(vf[mt][s2], pf[mq][s2], o[mq][mt], 0, 0, 0);
            }
          }
      }
    }
   }
    sbase = sbase + 2 == NSLOT ? 0 : sbase + 2;
  }
  __builtin_amdgcn_s_barrier();
}

__device__ __forceinline__ void attn_item(const Params& p, int l, int item, float* sm) {
  unsigned char* ws = p.ws;
  int tid = tidx();
  asm volatile("" : "+v"(tid));
  const int lane = tid & 63, wave = tid >> 6;
  const int combo = item & 3, qt = item >> 2;
  const int b = combo >> 1, kv = combo & 1;
  const int t0 = qt * 64, tw0 = t0 + 8 * wave;
  const int h = lane >> 4, c = lane & 15, qi = c >> 2, g = c & 3;
  const int head = kv * 4 + g, bkv = b * 2 + kv;
  h16* ring = (h16*)sm;
  float* impw = sm + 24576 + wave * 1024;
  unsigned long long* selm = (unsigned long long*)(sm + 24576 + 8192) + wave * 16;

  h16x8 qf[2][2];
  int tq[2];
#pragma unroll
  for (int mq = 0; mq < 2; ++mq) {
    tq[mq] = tw0 + 4 * mq + qi;
    const h16* qrow = (const h16*)(ws + OFF_Q16) + (size_t)(b * S + tq[mq]) * 512 + head * 64;
    qf[mq][0] = *(const h16x8*)(qrow + 8 * h);
    qf[mq][1] = *(const h16x8*)(qrow + 32 + 8 * h);
  }
  for (int i = lane; i < 1024; i += 64) impw[i] = 0.f;

  h16x4 ofin[2][4];
  float m[2], ll[2], inv[2];
  f32x4 o[2][4];
  const unsigned long long z2[2] = {0ull, 0ull};
  {
    int lim[2], tlim[2], tflc[2];
#pragma unroll
    for (int mq = 0; mq < 2; ++mq) {
      lim[mq] = tq[mq] >= 31 ? ((tq[mq] - 31) >> 4) : -1;
      const int tl = tw0 + 4 * mq + 3;
      tlim[mq] = tl >= 31 ? ((tl - 31) >> 4) : -1;
      const int tf0 = tw0 + 4 * mq;
      tflc[mq] = tf0 >= 31 ? ((tf0 - 31) >> 4) : -1;
      m[mq] = -1e30f; ll[mq] = 0.f; inv[mq] = 0.f;
#pragma unroll
      for (int mt = 0; mt < 4; ++mt) o[mq][mt] = (f32x4){0.f, 0.f, 0.f, 0.f};
    }
    const int nl = (t0 + 63 - 31) >> 4;
    const int jl = nl >> 6;
    const h16* Kc = (const h16*)(ws + OFF_KCMP) + (size_t)bkv * 512 * 64;
    const h16* Vc = (const h16*)(ws + OFF_VCMPT) + (size_t)bkv * 8 * 4096;
    attn_branch<0>(Kc, Vc, 0, jl, ring, qf, m, ll, o, tq, lim, tlim, tflc, z2, z2, z2, z2, inv, impw);
#pragma unroll
    for (int mq = 0; mq < 2; ++mq) {
      float lt = ll[mq];
      lt += __shfl_xor(lt, 16);
      lt += __shfl_xor(lt, 32);
      inv[mq] = lt > 0.f ? 1.f / lt : 0.f;
    }
    attn_branch<1>(Kc, Vc, 0, jl, ring, qf, m, ll, o, tq, lim, tlim, tflc, z2, z2, z2, z2, inv, impw);
    const float* gt0 = (const float*)(ws + OFF_GATES) + (size_t)(b * S) * 24 + head * 3;
#pragma unroll
    for (int mq = 0; mq < 2; ++mq) {
      const float g0 = gt0[(size_t)tq[mq] * 24] * ASCALE;
#pragma unroll
      for (int mt = 0; mt < 4; ++mt) ofin[mq][mt] = pack4(o[mq][mt][0] * g0, o[mq][mt][1] * g0, o[mq][mt][2] * g0, o[mq][mt][3] * g0);
    }
  }
  for (int q = 0; q < 8; ++q) {
    const int t = tw0 + q, own = t >> 6;
    const float* ir = impw + q * 128;
    const int ja = lane, jb = lane + 64;
    unsigned k0 = 0u, k1 = 0u;
    if (ja <= own) k0 = (ja == 0 || ja == own) ? (0xFFFFFF80u | (unsigned)(127 - ja)) : (((__float_as_uint(ir[ja]) & ~127u) | (unsigned)(127 - ja)) + 1u);
    if (jb <= own) k1 = (jb == own) ? (0xFFFFFF80u | (unsigned)(127 - jb)) : (((__float_as_uint(ir[jb]) & ~127u) | (unsigned)(127 - jb)) + 1u);
    unsigned thr = 0u;
    for (int bit = 31; bit >= 0; --bit) {
      const unsigned cand = thr | (1u << bit);
      const int cnt = __popcll(__ballot(k0 >= cand)) + __popcll(__ballot(k1 >= cand));
      if (cnt >= 16) thr = cand;
    }
    const unsigned long long mlo = __ballot(k0 >= thr && ja <= own);
    const unsigned long long mhi = __ballot(k1 >= thr && jb <= own);
    if (lane == 0) { selm[q * 2] = mlo; selm[q * 2 + 1] = mhi; }
  }
  unsigned long long mylo[2], myhi[2], ulo[2], uhi[2];
#pragma unroll
  for (int mq = 0; mq < 2; ++mq) {
    mylo[mq] = selm[(4 * mq + qi) * 2];
    myhi[mq] = selm[(4 * mq + qi) * 2 + 1];
    unsigned long long a = selm[(4 * mq) * 2] | selm[(4 * mq + 1) * 2] | selm[(4 * mq + 2) * 2] | selm[(4 * mq + 3) * 2];
    unsigned long long bb = selm[(4 * mq) * 2 + 1] | selm[(4 * mq + 1) * 2 + 1] | selm[(4 * mq + 2) * 2 + 1] | selm[(4 * mq + 3) * 2 + 1];
    ulo[mq] = (unsigned long long)__builtin_amdgcn_readfirstlane((unsigned)a) | ((unsigned long long)__builtin_amdgcn_readfirstlane((unsigned)(a >> 32)) << 32);
    uhi[mq] = (unsigned long long)__builtin_amdgcn_readfirstlane((unsigned)bb) | ((unsigned long long)__builtin_amdgcn_readfirstlane((unsigned)(bb >> 32)) << 32);
  }
  const float* gtb = (const float*)(ws + OFF_GATES) + (size_t)(b * S) * 24 + head * 3;
  {
    int tl0[2] = {0, 0};
    const int tfs[2] = {tw0, tw0 + 4};
#pragma unroll
    for (int mq = 0; mq < 2; ++mq) {
      m[mq] = -1e30f; ll[mq] = 0.f;
#pragma unroll
      for (int mt = 0; mt < 4; ++mt) o[mq][mt] = (f32x4){0.f, 0.f, 0.f, 0.f};
    }
    attn_branch<2>((const h16*)(ws + OFF_KS) + (size_t)bkv * S * 64, (const h16*)(ws + OFF_VST) + (size_t)bkv * 128 * 4096, 0, (t0 + 63) >> 6, ring, qf, m, ll, o,
                   tq, tl0, tl0, tfs, mylo, myhi, ulo, uhi, inv, impw);
#pragma unroll
    for (int mq = 0; mq < 2; ++mq) {
      float lt = ll[mq];
      lt += __shfl_xor(lt, 16);
      lt += __shfl_xor(lt, 32);
      const float sc = lt > 0.f ? gtb[(size_t)tq[mq] * 24 + 1] * ASCALE / lt : 0.f;
#pragma unroll
      for (int mt = 0; mt < 4; ++mt)
        ofin[mq][mt] = pack4((float)ofin[mq][mt][0] + o[mq][mt][0] * sc, (float)ofin[mq][mt][1] + o[mq][mt][1] * sc, (float)ofin[mq][mt][2] + o[mq][mt][2] * sc,
                             (float)ofin[mq][mt][3] + o[mq][mt][3] * sc);
    }
  }
  {
    int tl0[2] = {0, 0}, tf[2];
#pragma unroll
    for (int mq = 0; mq < 2; ++mq) {
      tf[mq] = tw0 + 4 * mq;
      m[mq] = -1e30f; ll[mq] = 0.f;
#pragma unroll
      for (int mt = 0; mt < 4; ++mt) o[mq][mt] = (f32x4){0.f, 0.f, 0.f, 0.f};
    }
    const int jlo = t0 >= 511 ? ((t0 - 511) >> 6) : 0;
    attn_branch<3>((const h16*)(ws + OFF_KW) + (size_t)bkv * S * 64, (const h16*)(ws + OFF_VWT) + (size_t)bkv * 128 * 4096, jlo, (t0 + 63) >> 6, ring, qf, m, ll, o,
                   tq, tl0, tf, tf, z2, z2, z2, z2, inv, impw);
#pragma unroll
    for (int mq = 0; mq < 2; ++mq) {
      float lt = ll[mq];
      lt += __shfl_xor(lt, 16);
      lt += __shfl_xor(lt, 32);
      const float sc = lt > 0.f ? gtb[(size_t)tq[mq] * 24 + 2] * ASCALE / lt : 0.f;
#pragma unroll
      for (int mt = 0; mt < 4; ++mt)
        ofin[mq][mt] = pack4((float)ofin[mq][mt][0] + o[mq][mt][0] * sc, (float)ofin[mq][mt][1] + o[mq][mt][1] * sc, (float)ofin[mq][mt][2] + o[mq][mt][2] * sc,
                             (float)ofin[mq][mt][3] + o[mq][mt][3] * sc);
    }
  }
  {
    h16* yc = (h16*)(ws + OFF_H16);
    const float* gn = p.in[I_ONG] + l * 1024 + 256 + head * 64;
    float* ssq = (float*)(ws + OFF_SSQ);
#pragma unroll
    for (int mq = 0; mq < 2; ++mq) {
      float sq = 0.f;
      h16* yr = yc + (size_t)(b * S + tq[mq]) * D + head * 64;
#pragma unroll
      for (int mt = 0; mt < 4; ++mt) {
        const float v[4] = {(float)ofin[mq][mt][0], (float)ofin[mq][mt][1], (float)ofin[mq][mt][2], (float)ofin[mq][mt][3]};
        sq += v[0] * v[0] + v[1] * v[1] + v[2] * v[2] + v[3] * v[3];
        const float4 gg = *(const float4*)(gn + 16 * mt + 4 * h);
        *(h16x4*)(yr + 16 * mt + 4 * h) = pack4(v[0] * gg.x, v[1] * gg.y, v[2] * gg.z, v[3] * gg.w);
      }
      sq += __shfl_xor(sq, 16);
      sq += __shfl_xor(sq, 32);
      sq += __shfl_xor(sq, 1);
      sq += __shfl_xor(sq, 2);
      if (h == 0 && g == 0) ssq[(size_t)(b * S + tq[mq]) * 2 + kv] = sq * (1.f / (ASCALE * ASCALE));
    }
  }
}

__device__ __forceinline__ void lrufix_item(const Params& p, int l, int item) {
  unsigned char* ws = p.ws;
  const int lane = tidx() & 63, wave = tidx() >> 6;
  const int b = item >> 7, ck = item & 127;
  const h16* P = (const h16*)(ws + OFF_P16);
  const float4 cy = *(const float4*)((const float*)(ws + OFF_CARRY) + (size_t)(b * 256 + ck * 2 + (wave >> 2)) * 256 + lane * 4);
  const float4 gn = *(const float4*)(p.in[I_ONG] + l * 1024 + lane * 4);
  h16* yc = (h16*)(ws + OFF_H16);
  for (int tt = wave * 8; tt < wave * 8 + 8; ++tt) {
    const size_t row = (size_t)(b * S + ck * 64 + tt);
    const float4 hl = *(const float4*)((const float*)(ws + OFF_LRUH) + row * 256 + lane * 4);
    const float4 al = *(const float4*)((const float*)(ws + OFF_LRUA) + row * 256 + lane * 4);
    const h16x4 gl = *(const h16x4*)(P + row * NIN + C_GL + lane * 4);
    const float y0 = (hl.x + al.x * cy.x) * gelu_tanh((float)gl[0]);
    const float y1 = (hl.y + al.y * cy.y) * gelu_tanh((float)gl[1]);
    const float y2 = (hl.z + al.z * cy.z) * gelu_tanh((float)gl[2]);
    const float y3 = (hl.w + al.w * cy.w) * gelu_tanh((float)gl[3]);
    const float rstd = rsqrtf(wsum(y0 * y0 + y1 * y1 + y2 * y2 + y3 * y3) * (1.f / 256.f) + EPS);
    *(h16x4*)(yc + row * D + 512 + lane * 4) = pack4(y0 * rstd * gn.x, y1 * rstd * gn.y, y2 * rstd * gn.z, y3 * rstd * gn.w);
  }
}

__device__ __forceinline__ void phase_attn(const Params& p, int l, float* sm) {
  for (int it = blockIdx.x; it < 256; it += gridDim.x) {
#pragma unroll 1
    for (int rep = 0; rep < 2; ++rep) attn_item(p, l, rep ? (127 - (it >> 2)) * 4 + (it & 3) : it, sm);
  }
  for (int it = blockIdx.x; it < 256; it += gridDim.x) lrufix_item(p, l, it);
}

__device__ __forceinline__ void phase_outproj(const Params& p, int l, h16* sm) {
  unsigned char* ws = p.ws;
  const h16* A = (const h16*)(ws + OFF_H16);
  const h16* W = (const h16*)(ws + OFF_WOUT);
  const float* mod = (const float*)(ws + OFF_MOD);
  float* xa = (float*)(ws + OFF_XA);
  const float* xin = l == 0 ? p.in[I_X] : (const float*)xa;
  const TileIter ti = xcd_tiles(64 * 4);
  for (int t = ti.cur; t < ti.end; t += ti.step) {
    const int mt = t >> 2, nt = t & 3;
    f32x4 acc[8][4];
    const h16* Ab = A + (size_t)mt * 256 * D;
    {
      float* sct = (float*)((unsigned char*)sm + SCHED_OFF - 1024);
      const int tq_ = tidx();
      if (tq_ < 256) {
        const float2 q2 = *(const float2*)((const float*)(ws + OFF_SSQ) + (size_t)(mt * 256 + tq_) * 2);
        sct[tq_] = rsqrtf((q2.x + q2.y) * (1.f / 512.f) + EPS) * (1.f / ASCALE);
      }
    }
    gemm_mainloop(acc, [&](int r) { return Ab + (size_t)r * D; }, W + (size_t)nt * 256 * D, D, 8, sm);
    const int tid_e = tidx(), lane = tid_e & 63, wave = tid_e >> 6, wr = wave >> 2, wc = wave & 3, fr = lane & 15, fq = lane >> 4;
    {
      const float* sct = (const float*)((const unsigned char*)sm + SCHED_OFF - 1024) + wr * 128 + fr;
#pragma unroll
      for (int m = 0; m < 8; ++m) {
        const float sc = sct[m * 16];
#pragma unroll
        for (int n = 0; n < 4; ++n) acc[m][n] *= sc;
      }
    }
    gemm_mainloop(acc, [&](int r) { return Ab + (size_t)r * D + 512; }, W + (size_t)nt * 256 * D + 512, D, 8, sm, false);
#pragma unroll
    for (int m = 0; m < 8; ++m)
#pragma unroll
      for (int n = 0; n < 4; ++n) {
        const int row = mt * 256 + wr * 128 + m * 16 + fr, col = nt * 256 + wc * 64 + n * 16 + 4 * fq;
        const int b = row >> 13;
        const float4 g1 = *(const float4*)(mod + (size_t)(l * 2 + b) * 6144 + 2048 + col);
        const float4 xv = *(const float4*)(xin + (size_t)row * D + col);
        float4 o;
        o.x = xv.x + g1.x * acc[m][n][0]; o.y = xv.y + g1.y * acc[m][n][1]; o.z = xv.z + g1.z * acc[m][n][2]; o.w = xv.w + g1.w * acc[m][n][3];
        *(float4*)(xa + (size_t)row * D + col) = o;
      }
  }
}

__device__ __forceinline__ void phase_router(const Params& p, int l, int* smi) {
  unsigned char* ws = p.ws;
  const int tid = tidx(), lane = tid & 63, wave = tid >> 6;
  const float* mod = (const float*)(ws + OFF_MOD);
  const float* xa = (const float*)(ws + OFF_XA);
  h16* hout = (h16*)(ws + OFF_H16);
  unsigned* cnt = (unsigned*)(ws + OFF_CTL) + 64 + l * 16;
  int* list = (int*)(ws + OFF_LIST);
  float* wpair = (float*)(ws + OFF_WPAIR);
  const float* rgb = p.in[I_RGB] + l * 4;
  int* cntl = smi;
  int* basel = smi + 16;
  int* tok = smi + 32;
  float* wl = (float*)smi + 256;
  {
    const float4* s0 = (const float4*)(p.in[I_RGW] + (size_t)l * 1024 * 4);
    const float4* s1 = (const float4*)(p.in[I_REW] + (size_t)l * 4 * 1024 * 4);
    float4* d = (float4*)wl;
#pragma unroll
    for (int q = 0; q < 2; ++q) d[q * NTHREADS + tid] = s0[q * NTHREADS + tid];
#pragma unroll
    for (int q = 0; q < 8; ++q) d[1024 + q * NTHREADS + tid] = s1[q * NTHREADS + tid];
  }
  const float* rgw = wl;
  for (int chunk = blockIdx.x; chunk < T / 64; chunk += gridDim.x) {
    if (tid < 16) cntl[tid] = 0;
    __syncthreads();
    float4 xn[4];
#pragma unroll
    for (int i = 0; i < 4; ++i) xn[i] = *(const float4*)(xa + (size_t)(chunk * 64 + wave) * D + lane * 4 + 256 * i);
    for (int ti = wave; ti < 64; ti += NW) {
      const int row = chunk * 64 + ti;
      const int b = row >> 13;
      float4 x[4];
      float ss = 0.f;
#pragma unroll
      for (int i = 0; i < 4; ++i) x[i] = xn[i];
      if (ti + NW < 64) {
#pragma unroll
        for (int i = 0; i < 4; ++i) xn[i] = *(const float4*)(xa + (size_t)(row + NW) * D + lane * 4 + 256 * i);
      }
#pragma unroll
      for (int i = 0; i < 4; ++i) ss += x[i].x * x[i].x + x[i].y * x[i].y + x[i].z * x[i].z + x[i].w * x[i].w;
      ss = wsum(ss);
      const float rstd = rsqrtf(ss * (1.f / D) + EPS);
      float lg0 = 0.f, lg1 = 0.f, lg2 = 0.f, lg3 = 0.f;
#pragma unroll
      for (int i = 0; i < 4; ++i) {
        const int col = lane * 4 + 256 * i;
        const float4 g = *(const float4*)(p.in[I_N2G] + l * D + col);
        const float4 sh = *(const float4*)(mod + (size_t)(l * 2 + b) * 6144 + 3072 + col);
        const float4 sc = *(const float4*)(mod + (size_t)(l * 2 + b) * 6144 + 4096 + col);
        x[i].x = x[i].x * rstd * g.x * (1.f + sc.x) + sh.x;
        x[i].y = x[i].y * rstd * g.y * (1.f + sc.y) + sh.y;
        x[i].z = x[i].z * rstd * g.z * (1.f + sc.z) + sh.z;
        x[i].w = x[i].w * rstd * g.w * (1.f + sc.w) + sh.w;
        *(h16x4*)(hout + (size_t)row * D + col) = pack4(x[i].x, x[i].y, x[i].z, x[i].w);
        const float4 w0 = *(const float4*)(rgw + (size_t)(col + 0) * 4), w1 = *(const float4*)(rgw + (size_t)(col + 1) * 4);
        const float4 w2 = *(const float4*)(rgw + (size_t)(col + 2) * 4), w3 = *(const float4*)(rgw + (size_t)(col + 3) * 4);
        lg0 += x[i].x * w0.x + x[i].y * w1.x + x[i].z * w2.x + x[i].w * w3.x;
        lg1 += x[i].x * w0.y + x[i].y * w1.y + x[i].z * w2.y + x[i].w * w3.y;
        lg2 += x[i].x * w0.z + x[i].y * w1.z + x[i].z * w2.z + x[i].w * w3.z;
        lg3 += x[i].x * w0.w + x[i].y * w1.w + x[i].z * w2.w + x[i].w * w3.w;
      }
      lg0 = wsum(lg0) + rgb[0]; lg1 = wsum(lg1) + rgb[1]; lg2 = wsum(lg2) + rgb[2]; lg3 = wsum(lg3) + rgb[3];
      int gs = 0; float gm = lg0;
      if (lg1 > gm) { gm = lg1; gs = 1; }
      if (lg2 > gm) { gm = lg2; gs = 2; }
      if (lg3 > gm) { gm = lg3; gs = 3; }
      const float pg = 1.f / (__expf(lg0 - gm) + __expf(lg1 - gm) + __expf(lg2 - gm) + __expf(lg3 - gm));
      const float* rew = wl + 4096 + gs * 4096;
      const float* reb = p.in[I_REB] + (l * 4 + gs) * 4;
      float e0 = 0.f, e1 = 0.f, e2 = 0.f, e3 = 0.f;
#pragma unroll
      for (int i = 0; i < 4; ++i) {
        const int col = lane * 4 + 256 * i;
        const float4 w0 = *(const float4*)(rew + (size_t)(col + 0) * 4), w1 = *(const float4*)(rew + (size_t)(col + 1) * 4);
        const float4 w2 = *(const float4*)(rew + (size_t)(col + 2) * 4), w3 = *(const float4*)(rew + (size_t)(col + 3) * 4);
        e0 += x[i].x * w0.x + x[i].y * w1.x + x[i].z * w2.x + x[i].w * w3.x;
        e1 += x[i].x * w0.y + x[i].y * w1.y + x[i].z * w2.y + x[i].w * w3.y;
        e2 += x[i].x * w0.z + x[i].y * w1.z + x[i].z * w2.z + x[i].w * w3.z;
        e3 += x[i].x * w0.w + x[i].y * w1.w + x[i].z * w2.w + x[i].w * w3.w;
      }
      float le[4];
      le[0] = wsum(e0) + reb[0]; le[1] = wsum(e1) + reb[1]; le[2] = wsum(e2) + reb[2]; le[3] = wsum(e3) + reb[3];
      int i0 = 0; float v0 = le[0];
      if (le[1] > v0) { v0 = le[1]; i0 = 1; }
      if (le[2] > v0) { v0 = le[2]; i0 = 2; }
      if (le[3] > v0) { v0 = le[3]; i0 = 3; }
      int i1 = -1; float v1 = -3.0e38f;
#pragma unroll
      for (int j = 0; j < 4; ++j) {
        const float vj = (j == 0 ? le[0] : j == 1 ? le[1] : j == 2 ? le[2] : le[3]);
        if (j != i0 && vj > v1) { v1 = vj; i1 = j; }
      }
      const float p0 = 1.f / (1.f + __expf(v1 - v0));
      const float p1 = 1.f - p0;
      if (lane == 0) {
        const int ea = gs * 4 + i0, eb = gs * 4 + i1;
        const int ra = atomicAdd(&cntl[ea], 1);
        const int rb = atomicAdd(&cntl[eb], 1);
        tok[ti * 2] = ea | (ra << 8);
        tok[ti * 2 + 1] = eb | (rb << 8);
        wpair[row * 2] = pg * p0;
        wpair[row * 2 + 1] = pg * p1;
      }
    }
    __syncthreads();
    if (tid < 16) basel[tid] = (int)atomicAdd(&cnt[tid], (unsigned)cntl[tid]);
    __syncthreads();
    if (tid < 128) {
      const int v = tok[tid], e = v & 255, r = v >> 8;
      list[(size_t)e * 16384 + basel[e] + r] = (chunk * 64 + (tid >> 1)) * 2 + (tid & 1);
    }
    __syncthreads();
  }
}

__device__ __forceinline__ void moe_sched(const Params& p, int l, int* sl) {
  if (tidx() == 0) {
    const unsigned* cnt = (const unsigned*)(p.ws + OFF_CTL) + 64 + l * 16;
    int to = 0, ro = 0;
    sl[16] = 0; sl[33] = 0;
    for (int e = 0; e < 16; ++e) {
      const int c = (int)__hip_atomic_load(&cnt[e], __ATOMIC_RELAXED, __HIP_MEMORY_SCOPE_AGENT);
      sl[e] = c;
      to += (c + 255) >> 8; ro += c;
      sl[17 + e] = to; sl[34 + e] = ro;
    }
  }
  __syncthreads();
}
__device__ __forceinline__ void moe_tile(const int* sl, int t, int& e, int& nt, int& mt, int& cnt_e, int& roff_e) {
  int ee = 0;
  for (int k = 0; k < 15; ++k) ee += (t >= sl[17 + k] * 4) ? 1 : 0;
  ee = __builtin_amdgcn_readfirstlane(ee);
  const int t0 = __builtin_amdgcn_readfirstlane(sl[16 + ee]), t1 = __builtin_amdgcn_readfirstlane(sl[17 + ee]);
  const int nte = t1 - t0, rem = t - t0 * 4;
  e = ee; nt = rem / nte; mt = rem % nte;
  cnt_e = __builtin_amdgcn_readfirstlane(sl[ee]);
  roff_e = __builtin_amdgcn_readfirstlane(sl[33 + ee]);
}

__device__ __forceinline__ void phase_moe1(const Params& p, int l, h16* sm) {
  unsigned char* ws = p.ws;
  int* sl = (int*)((unsigned char*)sm + SCHED_OFF);
  moe_sched(p, l, sl);
  const h16* H = (const h16*)(ws + OFF_H16);
  const int* list = (const int*)(ws + OFF_LIST);
  h16* hid = (h16*)(ws + OFF_HID);
  const int total = __builtin_amdgcn_readfirstlane(sl[32]) * 4;
  const TileIter ti = xcd_tiles(total);
  for (int t = ti.cur; t < ti.end; t += ti.step) {
    int e, nt, mt, cnt_e, roff_e;
    moe_tile(sl, t, e, nt, mt, cnt_e, roff_e);
    const int* le = list + (size_t)e * 16384;
    f32x4 acc[8][4];
    gemm_mainloop(acc, [&](int r) { int so = mt * 256 + r; so = so < cnt_e ? so : 0; return H + (size_t)(le[so] >> 1) * D; },
                  (const h16*)(ws + OFF_WGU) + ((size_t)e * 1024 + nt * 256) * 1024, 1024, 16, sm);
    const int tid_e = tidx(), lane = tid_e & 63, wave = tid_e >> 6, wr = wave >> 2, wc = wave & 3, fr = lane & 15, fq = lane >> 4;
#pragma unroll
    for (int m = 0; m < 8; ++m) {
      const int so = mt * 256 + wr * 128 + m * 16 + fr;
      if (so < cnt_e) {
#pragma unroll
        for (int n2 = 0; n2 < 2; ++n2) {
          const f32x4 gt = acc[m][2 * n2], up = acc[m][2 * n2 + 1];
          const int col = nt * 128 + wc * 32 + n2 * 16 + 4 * fq;
          *(h16x4*)(hid + (size_t)(roff_e + so) * 512 + col) = pack4(silu_f(gt[0]) * up[0], silu_f(gt[1]) * up[1], silu_f(gt[2]) * up[2], silu_f(gt[3]) * up[3]);
        }
      }
    }
  }
}

__device__ __forceinline__ void phase_moe2(const Params& p, int l, h16* sm) {
  unsigned char* ws = p.ws;
  int* sl = (int*)((unsigned char*)sm + SCHED_OFF);
  moe_sched(p, l, sl);
  const int* list = (const int*)(ws + OFF_LIST);
  const float* wpair = (const float*)(ws + OFF_WPAIR);
  const h16* hid = (const h16*)(ws + OFF_HID);
  h16* yp = (h16*)(ws + OFF_YPAIR);
  const int total = __builtin_amdgcn_readfirstlane(sl[32]) * 4;
  const TileIter ti = xcd_tiles(total);
  for (int t = ti.cur; t < ti.end; t += ti.step) {
    int e, nt, mt, cnt_e, roff_e;
    moe_tile(sl, t, e, nt, mt, cnt_e, roff_e);
    const int* le = list + (size_t)e * 16384;
    const h16* Ab = hid + (size_t)(roff_e + mt * 256) * 512;
    f32x4 acc[8][4];
    gemm_mainloop(acc, [&](int r) { return Ab + (size_t)r * 512; }, (const h16*)(ws + OFF_WDN) + ((size_t)e * 1024 + nt * 256) * 512, 512, 8, sm);
    const int tid_e = tidx(), lane = tid_e & 63, wave = tid_e >> 6, wr = wave >> 2, wc = wave & 3, fr = lane & 15, fq = lane >> 4;
#pragma unroll
    for (int m = 0; m < 8; ++m) {
      const int so = mt * 256 + wr * 128 + m * 16 + fr;
      if (so < cnt_e) {
        const int pair = le[so];
        const float w = wpair[pair];
#pragma unroll
        for (int n = 0; n < 4; ++n) {
          const int col = nt * 256 + wc * 64 + n * 16 + 4 * fq;
          *(h16x4*)(yp + (size_t)pair * D + col) = pack4(acc[m][n][0] * w, acc[m][n][1] * w, acc[m][n][2] * w, acc[m][n][3] * w);
        }
      }
    }
  }
}

#define XB_TMO      128
#define XB_XCNT(j)  (256  + 64 * (j))
#define XB_XSUB(j)  (1280 + 64 * (j))
#define XB_XGEN(j)  (2304 + 64 * (j))
#define XB_TOP      3328
#define XB_TOPGEN   3392
#define XCD_BAR_WORDS 3456
#define XB_SPIN_CAP (1u << 20)
__device__ __forceinline__ unsigned xb_ld(unsigned* p) { return __hip_atomic_load(p, __ATOMIC_RELAXED, __HIP_MEMORY_SCOPE_AGENT); }
__device__ __forceinline__ unsigned xb_add(unsigned* p, unsigned v) { return __hip_atomic_fetch_add(p, v, __ATOMIC_RELAXED, __HIP_MEMORY_SCOPE_AGENT); }
__device__ __forceinline__ unsigned xb_xcc_id() { return (unsigned)__builtin_amdgcn_s_getreg((3 << 11) | 20) & 0xFu; }
#define XB_SPIN(cond, bar) do { unsigned _sp = 0; while (cond) { __builtin_amdgcn_s_sleep(1); \
    if ((++_sp & 255u) == 0u) { if (xb_ld(&(bar)[XB_TMO])) break; if (_sp > XB_SPIN_CAP) { atomicAdd(&(bar)[XB_TMO], 1u); break; } } } } while (0)
struct XBar { unsigned* bar; unsigned x; volatile unsigned* st; };
__device__ __forceinline__ void xbar_post(XBar& b, unsigned* bar, volatile unsigned* st) {
  b.bar = bar; b.x = xb_xcc_id(); b.st = st;
  if (tidx() == 0) { st[0] = 0u; st[1] = 0u; (void)xb_add(&bar[XB_XCNT(b.x)], 1u); }
}
__device__ __forceinline__ void xbar_census(unsigned* bar, unsigned x, unsigned& nloc, unsigned& nx) {
  const unsigned G = gridDim.x;
  unsigned sum, cnt, mine, sp = 0u;
  for (;;) {
    sum = 0u; cnt = 0u; mine = 0u;
#pragma unroll
    for (unsigned j = 0; j < 16; ++j) { const unsigned c = xb_ld(&bar[XB_XCNT(j)]); sum += c; cnt += (c > 0u) ? 1u : 0u; mine = (j == x) ? c : mine; }
    if (sum == G) break;
    __builtin_amdgcn_s_sleep(1);
    if ((++sp & 255u) == 0u) { if (xb_ld(&bar[XB_TMO])) break; if (sp > XB_SPIN_CAP) { atomicAdd(&bar[XB_TMO], 1u); break; } }
  }
  nloc = mine > 0u ? mine : 1u; nx = cnt > 0u ? cnt : 1u;
}
__device__ __forceinline__ void xbar_sync(XBar& b) {
  asm volatile("s_waitcnt vmcnt(0)" ::: "memory");
  __syncthreads();
  if (tidx() == 0) {
    unsigned* bar = b.bar;
    __builtin_amdgcn_s_waitcnt(0);
    unsigned nloc = b.st[0], nx = b.st[1];
    if (nloc == 0u) { xbar_census(bar, b.x, nloc, nx); b.st[0] = nloc; b.st[1] = nx; }
    const unsigned old = xb_add(&bar[XB_XSUB(b.x)], 1u);
    const unsigned gen = old / nloc;
    if (old + 1u == (gen + 1u) * nloc) {
      __builtin_amdgcn_fence(__ATOMIC_RELEASE, "agent");
      asm volatile("s_waitcnt vmcnt(0)" ::: "memory");
      const unsigned og = xb_add(&bar[XB_TOP], 1u);
      const unsigned tg = og / nx;
      if (og + 1u == (tg + 1u) * nx) xb_add(&bar[XB_TOPGEN], 1u);
      else XB_SPIN(xb_ld(&bar[XB_TOPGEN]) == tg, bar);
      __builtin_amdgcn_fence(__ATOMIC_ACQUIRE, "agent");
      xb_add(&bar[XB_XGEN(b.x)], 1u);
      asm volatile("s_waitcnt vmcnt(0)" ::: "memory");
    } else {
      XB_SPIN(xb_ld(&bar[XB_XGEN(b.x)]) == gen, bar);
      __builtin_amdgcn_fence(__ATOMIC_ACQUIRE, "agent");
      asm volatile("s_waitcnt vmcnt(0)" ::: "memory");
    }
  }
  __syncthreads();
}

constexpr int NSTEPS = 22;
#define STEP(k, body) do { if (s_lo <= (k) && (k) < s_hi) { body; if ((k) + 1 < s_hi) { xbar_sync(xb); } \
    if (PROBE_MASK != 0u) { unsigned long long now_ = __builtin_amdgcn_s_memrealtime(); \
      if ((PROBE_MASK >> (k)) & 1u) { const unsigned long long w_ = (now_ - pt_prev) * PROBE_AMP; \
        while (__builtin_amdgcn_s_memrealtime() - now_ < w_) __builtin_amdgcn_s_sleep(8); now_ = __builtin_amdgcn_s_memrealtime(); } \
      pt_prev = now_; } } } while (0)
#define LAYER_STEPS(l, base) \
  STEP(base + 0, phase_norm1(p, l); if (l == 1) phase_convert(p, 1, (float*)smem)); \
  STEP(base + 1, phase_inproj(p, (h16*)smem)); \
  STEP(base + 2, phase_post(p)); \
  STEP(base + 3, phase_mixa(p, l, smem)); \
  STEP(base + 4, phase_mixb(p, l, (float*)smem)); \
  STEP(base + 5, phase_attn(p, l, (float*)smem)); \
  STEP(base + 6, phase_outproj(p, l, (h16*)smem)); \
  STEP(base + 7, phase_router(p, l, (int*)smem)); \
  STEP(base + 8, phase_moe1(p, l, (h16*)smem)); \
  STEP(base + 9, phase_moe2(p, l, (h16*)smem))

__global__ void __launch_bounds__(NTHREADS, 2) mega(Params p, int s_lo, int s_hi) {
  extern __shared__ __attribute__((aligned(16))) unsigned char smem[];
  unsigned long long pt_prev = PROBE_MASK != 0u ? __builtin_amdgcn_s_memrealtime() : 0ull;
  XBar xb;
  xbar_post(xb, (unsigned*)(p.ws + OFF_BAR), (volatile unsigned*)(smem + LDS_BYTES - 16));
  STEP(0, phase_prep(p, (float*)smem); phase_convert(p, 0, (float*)smem));
  LAYER_STEPS(0, 1);
  LAYER_STEPS(1, 11);
  STEP(21, phase_norm1(p, 2));
}

extern "C" void kernel_launch(void* const* d_in, const int* in_sizes, int n_in, void* d_out, int out_size, void* d_ws, size_t ws_size,
                              hipStream_t stream) {
  static int grid_blocks = 0;
  if (!grid_blocks) {
    if (n_in != 35 || out_size != T * D || ws_size < WS_TOTAL) {
      fprintf(stderr, "kernel_launch: unexpected problem (n_in %d, out %d, ws %zu < %zu)\n", n_in, out_size, ws_size, (size_t)WS_TOTAL);
      grid_blocks = -1;
      return;
    }
    int dev = 0, cus = 0, per_cu = 0;
    hipGetDevice(&dev);
    hipDeviceGetAttribute(&cus, hipDeviceAttributeMultiprocessorCount, dev);
    if (hipFuncSetAttribute((const void*)mega, hipFuncAttributeMaxDynamicSharedMemorySize, LDS_BYTES) != hipSuccess) {
      fprintf(stderr, "kernel_launch: hipFuncSetAttribute(%d B dynamic LDS) failed\n", LDS_BYTES);
      grid_blocks = -1;
      return;
    }
    hipOccupancyMaxActiveBlocksPerMultiprocessor(&per_cu, mega, NTHREADS, LDS_BYTES);
    if (per_cu > 1) per_cu = 1;
    if (per_cu < 1) { fprintf(stderr, "kernel_launch: occupancy query returned %d\n", per_cu); grid_blocks = -1; return; }
    grid_blocks = cus * per_cu;
  }
  if (grid_blocks < 0) return;
  Params p{};
  for (int i = 0; i < 35; ++i) p.in[i] = (const float*)d_in[i];
  p.out = (float*)d_out;
  p.ws = (unsigned char*)d_ws;
  for (int i = 0; i < 32; ++i) p.inv_freq[i] = std::pow(10000.0, -(double)(2 * i) / 64.0);
  if (hipMemsetAsync((char*)d_ws + OFF_BAR, 0, 16384, stream) != hipSuccess) { fprintf(stderr, "kernel_launch: memset of barrier words failed\n"); return; }
#if MEGA
  int lo = 0, hi = NSTEPS;
  void* args[] = {&p, &lo, &hi};
  hipError_t e = hipLaunchCooperativeKernel((void*)mega, dim3(grid_blocks), dim3(NTHREADS), args, LDS_BYTES, stream);
  if (e != hipSuccess) fprintf(stderr, "cooperative launch failed: %s (grid %d)\n", hipGetErrorString(e), grid_blocks);
#else
  for (int s = 0; s < NSTEPS; ++s) {
    int lo = s, hi = s + 1;
    void* args[] = {&p, &lo, &hi};
    hipError_t e = hipLaunchCooperativeKernel((void*)mega, dim3(grid_blocks), dim3(NTHREADS), args, LDS_BYTES, stream);
    if (e != hipSuccess) { fprintf(stderr, "launch %d failed: %s (grid %d)\n", s, hipGetErrorString(e), grid_blocks); break; }
  }
#endif
}
```

```cpp
#include <hip/hip_runtime.h>
#include <hip/hip_cooperative_groups.h>
#include <cstdio>
#include <cstdint>
#include <cmath>
namespace cg = cooperative_groups;

#ifndef MEGA
#define MEGA 1
#endif
#ifndef PROBE_MASK
#define PROBE_MASK 0u
#define PROBE_AMP 3
#endif

typedef _Float16 h16;
typedef _Float16 h16x8 __attribute__((ext_vector_type(8)));
typedef _Float16 h16x4 __attribute__((ext_vector_type(4)));
typedef float f32x4 __attribute__((ext_vector_type(4)));

constexpr int NB = 2, S = 8192, T = NB * S, D = 1024;
constexpr int NIN = 2432;
constexpr int NINSRC = 2328;
constexpr int C_XL = 0, C_GL = 256, C_Q = 512, C_KC = 1024, C_VC = 1152, C_KS = 1280, C_VS = 1408, C_KW = 1536, C_VW = 1664,
              C_CVA = 1792, C_CVB = 2048, C_GATE = 2304;
constexpr float EPS = 1e-6f;
constexpr int NTHREADS = 512, NW = 8;
constexpr int LDS_BYTES = 147456;
constexpr int NINP = 2560;
constexpr int SCHED_OFF = LDS_BYTES - 1024;
constexpr float ASCALE = 16.f;

constexpr size_t al256(size_t x) { return (x + 255) & ~(size_t)255; }
constexpr size_t OFF_CTL = 0;
constexpr size_t OFF_BAR = 4096;
constexpr size_t OFF_MOD = 4096 + 16384;
constexpr size_t OFF_ROPE = al256(OFF_MOD + 2 * 2 * 6144 * 4);
constexpr size_t OFF_PB = al256(OFF_ROPE + (size_t)T * 64 * 4);
constexpr size_t OFF_PBPART = al256(OFF_PB + 2 * 256 * 4);
constexpr size_t OFF_GATES = al256(OFF_PBPART + 2 * 32 * 256 * 4);
constexpr size_t OFF_WIN = al256(OFF_GATES + (size_t)T * 24 * 4);
constexpr size_t OFF_WOUT = al256(OFF_WIN + (size_t)NINP * 1024 * 2);
constexpr size_t OFF_WGU = al256(OFF_WOUT + (size_t)1024 * 1024 * 2);
constexpr size_t OFF_WDN = al256(OFF_WGU + (size_t)16 * 1024 * 1024 * 2);
constexpr size_t OFF_W1K = al256(OFF_WDN + (size_t)16 * 1024 * 512 * 2);
constexpr size_t OFF_W1V = al256(OFF_W1K + (size_t)256 * 2048 * 2);
constexpr size_t OFF_H16 = al256(OFF_W1V + (size_t)256 * 2048 * 2);
constexpr size_t OFF_Q16 = al256(OFF_H16 + (size_t)T * 1024 * 2);
constexpr size_t KVSZ = (size_t)T * 128 * 2;
constexpr size_t OFF_KC = al256(OFF_Q16 + (size_t)T * 512 * 2);
constexpr size_t OFF_VC = al256(OFF_KC + KVSZ + 4096);
constexpr size_t OFF_KS = al256(OFF_VC + KVSZ + 4096);
constexpr size_t OFF_VST = al256(OFF_KS + KVSZ);
constexpr size_t OFF_KW = al256(OFF_VST + KVSZ);
constexpr size_t OFF_VWT = al256(OFF_KW + KVSZ);
constexpr size_t OFF_HIDC = al256(OFF_VWT + KVSZ);
constexpr size_t OFF_KCMP = al256(OFF_HIDC + (size_t)2 * 2048 * 256 * 2);
constexpr size_t OFF_VCMPT = al256(OFF_KCMP + (size_t)4 * 512 * 64 * 2);
constexpr size_t OFF_LRUH = al256(OFF_VCMPT + (size_t)4 * 512 * 64 * 2);
constexpr size_t OFF_LRUA = al256(OFF_LRUH + (size_t)T * 256 * 4);
constexpr size_t OFF_HEND = al256(OFF_LRUA + (size_t)T * 256 * 4);
constexpr size_t OFF_AEND = al256(OFF_HEND + 2 * 256 * 256 * 4);
constexpr size_t OFF_CARRY = al256(OFF_AEND + 2 * 256 * 256 * 4);
constexpr size_t OFF_XA = al256(OFF_CARRY + 2 * 256 * 256 * 4);
constexpr size_t OFF_LIST = al256(OFF_XA + (size_t)T * 1024 * 4);
constexpr size_t OFF_WPAIR = al256(OFF_LIST + (size_t)16 * 16384 * 4);
constexpr size_t OFF_SSQ = al256(OFF_WPAIR + 32768 * 4);
constexpr size_t OFF_R = al256(OFF_SSQ + (size_t)T * 2 * 4);
constexpr size_t OFF_P16 = OFF_R;
constexpr size_t OFF_HID = OFF_R;
constexpr size_t OFF_YPAIR = al256(OFF_HID + (size_t)(32768 + 512) * 512 * 2);
constexpr size_t OFF_HIDP = al256(OFF_P16 + (size_t)T * NIN * 2);
constexpr size_t R_END1 = OFF_HIDP + (size_t)4 * 2 * 2048 * 256 * 4;
constexpr size_t R_END2 = OFF_YPAIR + (size_t)32768 * 1024 * 2;
constexpr size_t WS_TOTAL = al256(R_END1 > R_END2 ? R_END1 : R_END2);

struct Params {
  const float* in[35];
  float* out;
  unsigned char* ws;
  double inv_freq[32];
};
enum { I_X = 0, I_C, I_POS, I_ADAW, I_ADAB, I_N1G, I_N2G, I_WIN, I_LCW, I_LCB, I_LWA, I_LBA, I_LWX, I_LBX, I_LLAM, I_CKW1, I_CKW2,
       I_CVW1, I_CVW2, I_CPK, I_CPV, I_DWW, I_DWB, I_LNG, I_LNB, I_ONG, I_WOUT, I_RGW, I_RGB, I_REW, I_REB, I_MG, I_MU, I_MD, I_FNG };

__device__ __forceinline__ int tidx() { int t = threadIdx.x; asm volatile("" : "+v"(t)); return t; }
__device__ __forceinline__ float wsum(float v) {
#pragma unroll
  for (int o = 32; o > 0; o >>= 1) v += __shfl_xor(v, o);
  return v;
}
__device__ __forceinline__ float sigm(float x) { return 1.f / (1.f + __expf(-x)); }
__device__ __forceinline__ float silu_f(float x) { return x / (1.f + __expf(-x)); }
__device__ __forceinline__ float gelu_tanh(float x) {
  float u = 0.7978845608028654f * (x + 0.044715f * x * x * x);
  float e = __expf(2.f * u);
  float t = 1.f - 2.f / (e + 1.f);
  return 0.5f * x * (1.f + t);
}
__device__ __forceinline__ void glds16(const h16* g, h16* l) {
  __builtin_amdgcn_global_load_lds((const unsigned*)g, (unsigned*)l, 16, 0, 0);
}
__device__ __forceinline__ h16x4 pack4(float a, float b, float c, float d) {
  h16x4 r; r[0] = (h16)a; r[1] = (h16)b; r[2] = (h16)c; r[3] = (h16)d; return r;
}

struct TileIter { int cur, end, step; };
__device__ __forceinline__ TileIter xcd_tiles(int ntiles) {
  const int G = gridDim.x, b = blockIdx.x;
  TileIter it;
  if ((G & 7) == 0) {
    const int x = b & 7;
    it.cur = (int)(((long)ntiles * x) >> 3) + (b >> 3);
    it.end = (int)(((long)ntiles * (x + 1)) >> 3);
    it.step = G >> 3;
  } else { it.cur = b; it.end = ntiles; it.step = G; }
  return it;
}

#define VMCNT(n) asm volatile("s_waitcnt vmcnt(" #n ")" ::: "memory")
template <int BN, class ARowFn>
__device__ __forceinline__ void gemm_mainloop(f32x4 (&acc)[8][BN / 64], ARowFn arow, const h16* __restrict__ Bt, int ldb, int nk, h16* sm, bool zero_init = true) {
  constexpr int NF = BN / 64, NBP = BN / 64;
  constexpr int STAGE = 16384 + BN * 64;
  const int tid = tidx(), lane = tid & 63, wave = tid >> 6;
  const int wr = wave >> 2, wc = wave & 3, fr = lane & 15, fq = lane >> 4;
  const h16* ap[4];
  const h16* bp[NBP];
#pragma unroll
  for (int i = 0; i < 4; ++i) {
    const int r = (i * 8 + wave) * 8 + (lane >> 3);
    const int c = (lane & 7) ^ ((r >> 1) & 7);
    ap[i] = arow(r) + c * 8;
    if (i < NBP) bp[i] = Bt + (size_t)r * ldb + c * 8;
  }
  if (zero_init) {
#pragma unroll
    for (int m = 0; m < 8; ++m)
#pragma unroll
      for (int n = 0; n < NF; ++n) acc[m][n] = (f32x4){0.f, 0.f, 0.f, 0.f};
  }
  h16* const dA = sm + wave * 512 + lane * 8;
#pragma unroll
  for (int i = 0; i < 4; ++i) { glds16(ap[i], dA + i * 4096); ap[i] += 64; }
#pragma unroll
  for (int i = 0; i < NBP; ++i) { glds16(bp[i], dA + 16384 + i * 4096); bp[i] += 64; }
  const int sw = (fr >> 1) & 7;
  const int aoff = (wr * 128 + fr) * 64, boff = 16384 + (wc * (BN / 4) + fr) * 64;
#define SCHED_FENCE() __builtin_amdgcn_sched_barrier(0)
  for (int kt = 0; kt < nk; ++kt) {
    VMCNT(0);
    __builtin_amdgcn_s_barrier();
    const h16* st = sm + (kt & 1) * STAGE;
    const bool more = kt + 1 < nk;
    h16* const dn = dA + ((kt + 1) & 1) * STAGE;
#pragma unroll
    for (int ks = 0; ks < 2; ++ks) {
      const int ch = ((ks * 4 + fq) ^ sw) * 8;
      h16x8 bf[NF];
#pragma unroll
      for (int n = 0; n < NF; ++n) bf[n] = *(const h16x8*)(st + boff + n * 1024 + ch);
#pragma unroll
      for (int mh = 0; mh < 2; ++mh) {
        h16x8 af[4];
#pragma unroll
        for (int m = 0; m < 4; ++m) af[m] = *(const h16x8*)(st + aoff + (mh * 4 + m) * 1024 + ch);
#pragma unroll
        for (int m = 0; m < 4; ++m) {
#pragma unroll
          for (int n = 0; n < NF; ++n) acc[mh * 4 + m][n] = __builtin_amdgcn_mfma_f32_16x16x32_f16(bf[n], af[m], acc[mh * 4 + m][n], 0, 0, 0);
          if (m == 1 || m == 3) {
            const int q = ks * 4 + mh * 2 + (m >> 1);
            SCHED_FENCE();
            if (more) {
              if (q < 4) { glds16(ap[q & 3], dn + (q & 3) * 4096); ap[q & 3] += 64; }
              else if ((q & 3) < NBP) { glds16(bp[(q & 3) < NBP ? (q & 3) : 0], dn + 16384 + (q & 3) * 4096); bp[(q & 3) < NBP ? (q & 3) : 0] += 64; }
            }
            SCHED_FENCE();
          }
        }
      }
    }
  }
#undef SCHED_FENCE
  __builtin_amdgcn_s_barrier();
}

struct TileSched { int cur, end, step, tail_tile, tail_half; };
__device__ __forceinline__ TileSched xcd_sched(int ntiles) {
  const int G = gridDim.x, b = blockIdx.x;
  TileSched s;
  s.tail_tile = -1; s.tail_half = -1;
  if ((G & 7) == 0) {
    const int x = b & 7, nb = G >> 3, si = b >> 3;
    const int lo = (int)(((long)ntiles * x) >> 3), hi = (int)(((long)ntiles * (x + 1)) >> 3);
    const int n = hi - lo, R = n / nb, rem = n - R * nb;
    s.cur = lo + si; s.end = lo + R * nb; s.step = nb;
    if (rem * 2 <= nb) { if (si < 2 * rem) { s.tail_tile = lo + R * nb + (si >> 1); s.tail_half = si & 1; } }
    else if (si < rem) s.tail_tile = lo + R * nb + si;
  } else { s.cur = b; s.end = ntiles; s.step = G; }
  return s;
}

__device__ __forceinline__ int map_row(int mode, int n) {
  if (mode == 1) return n < 1792 ? n : (n < 1816 ? n + 512 : n - 24);
  if (mode == 2) return 32 * (n >> 4) + (n & 15);
  if (mode == 3) return 32 * (n >> 4) + 16 + (n & 15);
  return n;
}
struct ConvTile { const float* src; h16* dst; int K, N, mode, k0, n0; const float* pos; float* pbp; };
__device__ __forceinline__ ConvTile conv_decode(const Params& p, int l, int t) {
  unsigned char* ws = p.ws;
  constexpr int T_WIN = 16 * 37, T_WOUT = 256, T_G = 16 * 128, T_W1 = 128;
  constexpr int E0 = T_WIN, E1 = E0 + T_WOUT, E2 = E1 + T_G, E3 = E2 + T_G, E4 = E3 + T_G, E5 = E4 + T_W1;
  ConvTile c;
  c.pos = nullptr; c.pbp = nullptr;
  int tk, tn;
  if (t < E0) {
    c.src = p.in[I_WIN] + (size_t)l * 1024 * NINSRC; c.K = 1024; c.N = NINSRC; c.dst = (h16*)(ws + OFF_WIN); c.mode = 1; tk = t / 37; tn = t % 37;
  } else if (t < E1) {
    const int u = t - E0;
    c.src = p.in[I_WOUT] + (size_t)l * 1024 * 1024; c.K = 1024; c.N = 1024; c.dst = (h16*)(ws + OFF_WOUT); c.mode = 4; tk = u >> 4; tn = u & 15;
  } else if (t < E3) {
    const int up = t >= E2;
    const int u = t - (up ? E2 : E1);
    const int e = u >> 7, v = u & 127;
    c.src = p.in[up ? I_MU : I_MG] + ((size_t)l * 16 + e) * 1024 * 512; c.K = 1024; c.N = 512; c.dst = (h16*)(ws + OFF_WGU) + (size_t)e * 1024 * 1024;
    c.mode = up ? 3 : 2; tk = v >> 3; tn = v & 7;
  } else if (t < E4) {
    const int u = t - E3;
    const int e = u >> 7, v = u & 127;
    c.src = p.in[I_MD] + ((size_t)l * 16 + e) * 512 * 1024; c.K = 512; c.N = 1024; c.dst = (h16*)(ws + OFF_WDN) + (size_t)e * 1024 * 512; c.mode = 0; tk = v >> 4; tn = v & 15;
  } else {
    const int vv = t >= E5;
    const int u = t - (vv ? E5 : E4);
    c.src = p.in[vv ? I_CVW1 : I_CKW1] + (size_t)l * 2048 * 256; c.K = 2048; c.N = 256; c.dst = (h16*)(ws + (vv ? OFF_W1V : OFF_W1K)); c.mode = 5; tk = u >> 2; tn = u & 3;
    c.pos = p.in[vv ? I_CPV : I_CPK] + (size_t)l * 2048 + tk * 64;
    c.pbp = (float*)(ws + OFF_PBPART) + (size_t)(vv * 32 + tk) * 256 + tn * 64;
  }
  c.k0 = tk * 64; c.n0 = tn * 64;
  return c;
}
__device__ __forceinline__ void conv_wave_tile(const ConvTile& c, float* smw, int lane) {
  float4 v[16];
#pragma unroll
  for (int i = 0; i < 16; ++i) {
    const int idx = i * 64 + lane;
    const int r = idx >> 4, c4 = (idx & 15) * 4;
    v[i] = make_float4(0.f, 0.f, 0.f, 0.f);
    if (c.n0 + c4 < c.N) v[i] = *(const float4*)(c.src + (size_t)(c.k0 + r) * c.N + c.n0 + c4);
  }
#pragma unroll
  for (int i = 0; i < 16; ++i) {
    const int idx = i * 64 + lane;
    const int r = idx >> 4, c4 = (idx & 15) * 4;
    float* d = smw + r * 65 + c4;
    d[0] = v[i].x; d[1] = v[i].y; d[2] = v[i].z; d[3] = v[i].w;
  }
  if (c.mode == 5) {
    float sacc = 0.f;
    for (int k = 0; k < 64; ++k) sacc += c.pos[k] * smw[k * 65 + lane];
    c.pbp[lane] = sacc;
  }
  const int k0d = c.mode == 4 ? (c.k0 < 256 ? c.k0 + 512 : (c.k0 < 768 ? c.k0 - 256 : c.k0)) : c.k0;
#pragma unroll
  for (int j = 0; j < 8; ++j) {
    const int ch = j * 64 + lane;
    const int n = ch >> 3, kc = ch & 7;
    if (c.n0 + n < c.N) {
      h16x8 o;
#pragma unroll
      for (int q = 0; q < 8; ++q) o[q] = (h16)smw[(kc * 8 + q) * 65 + n];
      *(h16x8*)(c.dst + (size_t)map_row(c.mode, c.n0 + n) * c.K + k0d + kc * 8) = o;
    }
  }
}

__device__ __forceinline__ void phase_convert(const Params& p, int l, float* sm) {
  unsigned char* ws = p.ws;
  constexpr int NT_CONV = 16 * 37 + 256 + 3 * 16 * 128 + 2 * 128;
  {
    const int tid = tidx(), lane = tid & 63, wave = tid >> 6;
    float* smw = sm + wave * 4160;
    for (int t = blockIdx.x * NW + wave; t < NT_CONV; t += gridDim.x * NW) {
      const ConvTile c = conv_decode(p, l, t);
      conv_wave_tile(c, smw, lane);
    }
    __syncthreads();
  }
  {
    h16x8 z = {0, 0, 0, 0, 0, 0, 0, 0};
    h16* w = (h16*)(ws + OFF_WIN) + (size_t)NINSRC * 1024;
    for (int i = blockIdx.x * NTHREADS + tidx(); i < (NINP - NINSRC) * 1024 / 8; i += gridDim.x * NTHREADS) *(h16x8*)(w + (size_t)i * 8) = z;
  }
}

__device__ __forceinline__ void phase_prep(const Params& p, float* sm) {
  unsigned char* ws = p.ws;
  const int tid = tidx();
  if (blockIdx.x == 0) {
    for (int i = tid; i < 1024; i += NTHREADS) ((unsigned*)(ws + OFF_CTL))[i] = 0u;
  }
  float* mod = (float*)(ws + OFF_MOD);
  for (int t = blockIdx.x; t < 384; t += gridDim.x) {
    const int l = t / 192, j0 = (t % 192) * 32;
    const int kg = tid >> 3, cq = tid & 7;
    const float* w = p.in[I_ADAW] + (size_t)l * 1024 * 6144 + j0 + 4 * cq;
    const float* c = p.in[I_C];
    float a0[4] = {0, 0, 0, 0}, a1[4] = {0, 0, 0, 0};
#pragma unroll 8
    for (int k = kg * 16; k < kg * 16 + 16; ++k) {
      const float4 wv = *(const float4*)(w + (size_t)k * 6144);
      const float s0 = silu_f(c[k]), s1 = silu_f(c[1024 + k]);
      a0[0] += s0 * wv.x; a0[1] += s0 * wv.y; a0[2] += s0 * wv.z; a0[3] += s0 * wv.w;
      a1[0] += s1 * wv.x; a1[1] += s1 * wv.y; a1[2] += s1 * wv.z; a1[3] += s1 * wv.w;
    }
    float* r = sm + (kg * 8 + cq) * 8;
#pragma unroll
    for (int i = 0; i < 4; ++i) { r[i] = a0[i]; r[4 + i] = a1[i]; }
    __syncthreads();
    if (tid < 64) {
      const int bb = tid >> 5, col = tid & 31, q = col >> 2, ci = col & 3;
      float s = 0.f;
      for (int g = 0; g < 64; ++g) s += sm[(g * 8 + q) * 8 + bb * 4 + ci];
      mod[(size_t)(l * 2 + bb) * 6144 + j0 + col] = s + p.in[I_ADAB][l * 6144 + j0 + col];
    }
    __syncthreads();
  }
  float* rc = (float*)(ws + OFF_ROPE);
  float* rs = rc + (size_t)T * 32;
  const int* pos = (const int*)p.in[I_POS];
  for (int i = blockIdx.x * NTHREADS + tid; i < T * 32; i += gridDim.x * NTHREADS) {
    const int t = i >> 5, f = i & 31;
    const double a = (double)pos[t] * p.inv_freq[f];
    const double n = rint(a * 0.15915494309189535);
    double r = fma(-n, 6.283185307179586, a);
    r = fma(-n, 2.4492935982947064e-16, r);
    const float rf = (float)r;
    rc[i] = cosf(rf);
    rs[i] = sinf(rf);
  }
}

__device__ __forceinline__ void phase_norm1(const Params& p, int mode) {
  unsigned char* ws = p.ws;
  const int lane = tidx() & 63, wave = tidx() >> 6;
  const float* mod = (const float*)(ws + OFF_MOD);
  float* xa = (float*)(ws + OFF_XA);
  const h16* yp = (const h16*)(ws + OFF_YPAIR);
  h16* hout = (h16*)(ws + OFF_H16);
  const int l = (mode == 0) ? 0 : 1;
  for (int row = blockIdx.x * NW + wave; row < T; row += gridDim.x * NW) {
    const int b = row >> 13;
    float4 x[4];
    float ss = 0.f;
#pragma unroll
    for (int i = 0; i < 4; ++i) {
      const int col = lane * 4 + 256 * i;
      if (mode == 0) {
        x[i] = *(const float4*)(p.in[I_X] + (size_t)row * D + col);
      } else {
        const int lp = mode == 1 ? 0 : 1;
        const float4 xv = *(const float4*)(xa + (size_t)row * D + col);
        const float4 g2 = *(const float4*)(mod + (size_t)(lp * 2 + b) * 6144 + 5120 + col);
        const h16x4 y0 = *(const h16x4*)(yp + (size_t)(row * 2) * D + col);
        const h16x4 y1 = *(const h16x4*)(yp + (size_t)(row * 2 + 1) * D + col);
        x[i].x = xv.x + g2.x * ((float)y0[0] + (float)y1[0]);
        x[i].y = xv.y + g2.y * ((float)y0[1] + (float)y1[1]);
        x[i].z = xv.z + g2.z * ((float)y0[2] + (float)y1[2]);
        x[i].w = xv.w + g2.w * ((float)y0[3] + (float)y1[3]);
        if (mode == 1) *(float4*)(xa + (size_t)row * D + col) = x[i];
      }
      ss += x[i].x * x[i].x + x[i].y * x[i].y + x[i].z * x[i].z + x[i].w * x[i].w;
    }
    ss = wsum(ss);
    const float rstd = rsqrtf(ss * (1.f / D) + EPS);
#pragma unroll
    for (int i = 0; i < 4; ++i) {
      const int col = lane * 4 + 256 * i;
      if (mode == 2) {
        const float4 g = *(const float4*)(p.in[I_FNG] + col);
        float4 o;
        o.x = x[i].x * rstd * g.x; o.y = x[i].y * rstd * g.y; o.z = x[i].z * rstd * g.z; o.w = x[i].w * rstd * g.w;
        *(float4*)(p.out + (size_t)row * D + col) = o;
      } else {
        const float4 g = *(const float4*)(p.in[I_N1G] + l * D + col);
        const float4 sh = *(const float4*)(mod + (size_t)(l * 2 + b) * 6144 + col);
        const float4 sc = *(const float4*)(mod + (size_t)(l * 2 + b) * 6144 + 1024 + col);
        *(h16x4*)(hout + (size_t)row * D + col) = pack4(x[i].x * rstd * g.x * (1.f + sc.x) + sh.x, x[i].y * rstd * g.y * (1.f + sc.y) + sh.y,
                                                        x[i].z * rstd * g.z * (1.f + sc.z) + sh.z, x[i].w * rstd * g.w * (1.f + sc.w) + sh.w);
      }
    }
  }
}

template <int BN>
__device__ __forceinline__ void inproj_tile(const Params& p, h16* sm, int mt, int col0) {
  unsigned char* ws = p.ws;
  const h16* Ab = (const h16*)(ws + OFF_H16) + (size_t)mt * 256 * D;
  h16* P = (h16*)(ws + OFF_P16);
  f32x4 acc[8][BN / 64];
  gemm_mainloop<BN>(acc, [&](int r) { return Ab + (size_t)r * D; }, (const h16*)(ws + OFF_WIN) + (size_t)col0 * D, D, D / 64, sm);
  const int tid_e = tidx(), lane = tid_e & 63, wave = tid_e >> 6, wr = wave >> 2, wc = wave & 3, fr = lane & 15, fq = lane >> 4;
#pragma unroll
  for (int m = 0; m < 8; ++m)
#pragma unroll
    for (int n = 0; n < BN / 64; ++n) {
      const int row = mt * 256 + wr * 128 + m * 16 + fr, col = col0 + wc * (BN / 4) + n * 16 + 4 * fq;
      *(h16x4*)(P + (size_t)row * NIN + col) = pack4(acc[m][n][0], acc[m][n][1], acc[m][n][2], acc[m][n][3]);
    }
}
__device__ __forceinline__ void phase_inproj(const Params& p, h16* sm) {
  const TileIter tf = xcd_tiles(64 * 8);
  for (int t = tf.cur; t < tf.end; t += tf.step) inproj_tile<256>(p, sm, t >> 3, (t & 7) * 256);
  const TileIter th = xcd_tiles(64 * 3);
  for (int t = th.cur; t < th.end; t += th.step) inproj_tile<128>(p, sm, t / 3, 2048 + (t % 3) * 128);
}

__device__ __forceinline__ int perm_key(int pos) {
  return 32 * (pos >> 5) + 16 * ((pos >> 2) & 1) + 4 * ((pos >> 3) & 3) + (pos & 3);
}
__device__ __forceinline__ void phase_post(const Params& p) {
  unsigned char* ws = p.ws;
  const h16* P = (const h16*)(ws + OFF_P16);
  const float* rc = (const float*)(ws + OFF_ROPE);
  const float* rs = rc + (size_t)T * 32;
  h16* q16 = (h16*)(ws + OFF_Q16);
  float* gates = (float*)(ws + OFF_GATES);
  const int lane = tidx() & 63, wave = tidx() >> 6;
  if (blockIdx.x == 0) {
    const int o = tidx();
    const float* pp = (const float*)(ws + OFF_PBPART) + (size_t)(o >> 8) * 32 * 256 + (o & 255);
    float acc = 0.f;
    for (int k = 0; k < 32; ++k) acc += pp[k * 256];
    ((float*)(ws + OFF_PB))[o] = acc;
  }
  for (int row = blockIdx.x * NW + wave; row < T; row += gridDim.x * NW) {
    const int b = row >> 13, s = row & (S - 1);
    const h16* pr = P + (size_t)row * NIN;
    const int d = (lane & 7) * 4;
    const float4 cs = *(const float4*)(rc + (size_t)row * 32 + d);
    const float4 sn = *(const float4*)(rs + (size_t)row * 32 + d);
    {
      const int hd = lane >> 3;
      const h16x4 a = *(const h16x4*)(pr + C_Q + 64 * hd + d);
      const h16x4 bb = *(const h16x4*)(pr + C_Q + 64 * hd + 32 + d);
      const float a0 = a[0], a1 = a[1], a2 = a[2], a3 = a[3], b0 = bb[0], b1 = bb[1], b2 = bb[2], b3 = bb[3];
      h16* qo = q16 + (size_t)row * 512 + 64 * hd + d;
      constexpr float QS = 0.125f * 1.4426950408889634f;
      *(h16x4*)qo = pack4((a0 * cs.x - b0 * sn.x) * QS, (a1 * cs.y - b1 * sn.y) * QS, (a2 * cs.z - b2 * sn.z) * QS, (a3 * cs.w - b3 * sn.w) * QS);
      *(h16x4*)(qo + 32) = pack4((b0 * cs.x + a0 * sn.x) * QS, (b1 * cs.y + a1 * sn.y) * QS, (b2 * cs.z + a2 * sn.z) * QS, (b3 * cs.w + a3 * sn.w) * QS);
    }
    if (lane < 48) {
      const int tn = lane >> 4, hd = (lane >> 3) & 1;
      const int cb = (tn == 0 ? C_KC : (tn == 1 ? C_KS : C_KW)) + 64 * hd;
      const size_t off = tn == 0 ? OFF_KC : (tn == 1 ? OFF_KS : OFF_KW);
      const h16x4 a = *(const h16x4*)(pr + cb + d);
      const h16x4 bb = *(const h16x4*)(pr + cb + 32 + d);
      const float a0 = a[0], a1 = a[1], a2 = a[2], a3 = a[3], b0 = bb[0], b1 = bb[1], b2 = bb[2], b3 = bb[3];
      h16* ko = (h16*)(ws + off) + ((size_t)(b * 2 + hd) * S + s) * 64 + d;
      *(h16x4*)ko = pack4(a0 * cs.x - b0 * sn.x, a1 * cs.y - b1 * sn.y, a2 * cs.z - b2 * sn.z, a3 * cs.w - b3 * sn.w);
      *(h16x4*)(ko + 32) = pack4(b0 * cs.x + a0 * sn.x, b1 * cs.y + a1 * sn.y, b2 * cs.z + a2 * sn.z, b3 * cs.w + a3 * sn.w);
    }
    if (lane < 32) {
      const int hd = lane >> 4, dd = (lane & 15) * 4;
      *(h16x4*)((h16*)(ws + OFF_VC) + ((size_t)(b * 2 + hd) * S + s) * 64 + dd) = *(const h16x4*)(pr + C_VC + 64 * hd + dd);
    }
    if (lane < 24) gates[(size_t)row * 24 + lane] = sigm((float)pr[C_GATE + lane]);
  }
  for (int task = blockIdx.x; task < 1024; task += gridDim.x) {
    const int tensor = task & 1, kv = (task >> 1) & 1, blk = (task >> 2) & 127, b = task >> 9;
    const int srccol = (tensor ? C_VW : C_VS) + 64 * kv;
    h16* dst = (h16*)(ws + (tensor ? OFF_VWT : OFF_VST)) + ((size_t)((b * 2 + kv) * 128 + blk)) * 4096;
    const int dim = tidx() & 63, kg = tidx() >> 6;
    {
      const int p0 = kg * 8;
      h16x8 v;
#pragma unroll
      for (int j = 0; j < 8; ++j) v[j] = P[(size_t)(b * S + blk * 64 + perm_key(p0 + j)) * NIN + srccol + dim];
      *(h16x8*)(dst + dim * 64 + p0) = v;
    }
  }
}

__device__ __forceinline__ void mixa_compress1(const Params& p, int item, h16* sm) {
  unsigned char* ws = p.ws;
  const int which = item >> 5, mt = (item >> 2) & 7, ks = item & 3;
  const h16* A = (const h16*)(ws + (which ? OFF_VC : OFF_KC)) + (size_t)mt * 256 * 1024 + ks * 512;
  const h16* W = (const h16*)(ws + (which ? OFF_W1V : OFF_W1K)) + ks * 512;
  float* hp = (float*)(ws + OFF_HIDP) + ((size_t)(ks * 2 + which) * 2048) * 256;
  f32x4 acc[8][4];
  gemm_mainloop<256>(acc, [&](int r) { return A + (size_t)r * 1024; }, W, 2048, 8, sm);
  const int tid_e = tidx(), lane = tid_e & 63, wave = tid_e >> 6, wr = wave >> 2, wc = wave & 3, fr = lane & 15, fq = lane >> 4;
#pragma unroll
  for (int m = 0; m < 8; ++m)
#pragma unroll
    for (int n = 0; n < 4; ++n) {
      const int row = mt * 256 + wr * 128 + m * 16 + fr, col = wc * 64 + n * 16 + 4 * fq;
      *(f32x4*)(hp + (size_t)row * 256 + col) = acc[m][n];
    }
}

__device__ __forceinline__ void mixa_lru(const Params& p, int l, int item, float* sm) {
  unsigned char* ws = p.ws;
  const int half = tidx() >> 8;
  item = item * 2 + half;
  sm += half * 12288;
  const int b = item >> 8, ck = item & 255;
  const int c = tidx() & 255;
  const int nb = c >> 6, e = c & 63;
  const h16* P = (const h16*)(ws + OFF_P16);
  const float* cw = p.in[I_LCW] + l * 4 * 256;
  const float w0 = cw[c], w1 = cw[256 + c], w2 = cw[512 + c], w3 = cw[768 + c], cb = p.in[I_LCB][l * 256 + c];
  const float ba = p.in[I_LBA][l * 256 + c], bx = p.in[I_LBX][l * 256 + c];
  const float lam = p.in[I_LLAM][l * 256 + c];
  const float ls = -log1pf(expf(-lam));
  const float* pa = p.in[I_LWA] + ((size_t)(l * 4 + nb) * 64) * 64 + e;
  const float* px = p.in[I_LWX] + ((size_t)(l * 4 + nb) * 64) * 64 + e;
  const int t0 = ck * 32;
  float x0 = 0.f, x1 = 0.f, x2 = 0.f;
  if (t0 >= 3) {
    x0 = (float)P[(size_t)(b * S + t0 - 3) * NIN + C_XL + c];
    x1 = (float)P[(size_t)(b * S + t0 - 2) * NIN + C_XL + c];
    x2 = (float)P[(size_t)(b * S + t0 - 1) * NIN + C_XL + c];
  }
  float h = 0.f, ap = 1.f;
  float* lh = (float*)(ws + OFF_LRUH);
  float* la = (float*)(ws + OFF_LRUA);
  float* sr = sm + 4096;
  float* si = sm + 8192;
#pragma unroll 1
  for (int sub = 0; sub < 2; ++sub) {
    const int tb = t0 + sub * 16;
    {
      h16 xv[16];
      const h16* xp = P + (size_t)(b * S + tb) * NIN + C_XL + c;
#pragma unroll
      for (int tt = 0; tt < 16; ++tt) { xv[tt] = *xp; xp += NIN; asm volatile("" : "+v"(xp)); }
#pragma unroll
      for (int tt = 0; tt < 16; ++tt) {
        const float x3 = (float)xv[tt];
        sm[tt * 256 + c] = w0 * x0 + w1 * x1 + w2 * x2 + w3 * x3 + cb;
        x0 = x1; x1 = x2; x2 = x3;
      }
    }
    __syncthreads();
    {
      float accr[16], acci[16];
#pragma unroll
      for (int tt = 0; tt < 16; ++tt) { accr[tt] = 0.f; acci[tt] = 0.f; }
#pragma unroll 1
      for (int d8 = 0; d8 < 8; ++d8) {
        float wa8[8], wx8[8];
        const float* pa8 = pa + d8 * 512;
        const float* px8 = px + d8 * 512;
#pragma unroll
        for (int j = 0; j < 8; ++j) { wa8[j] = pa8[j * 64]; wx8[j] = px8[j * 64]; }
        const float* xr = sm + nb * 64 + d8 * 8;
#pragma unroll
        for (int tt = 0; tt < 16; ++tt) {
          const float4 xa = *(const float4*)(xr + tt * 256), xb = *(const float4*)(xr + tt * 256 + 4);
          accr[tt] += xa.x * wa8[0] + xa.y * wa8[1] + xa.z * wa8[2] + xa.w * wa8[3] + xb.x * wa8[4] + xb.y * wa8[5] + xb.z * wa8[6] + xb.w * wa8[7];
          acci[tt] += xa.x * wx8[0] + xa.y * wx8[1] + xa.z * wx8[2] + xa.w * wx8[3] + xb.x * wx8[4] + xb.y * wx8[5] + xb.z * wx8[6] + xb.w * wx8[7];
        }
      }
#pragma unroll
      for (int tt = 0; tt < 16; ++tt) { sr[tt * 256 + c] = accr[tt]; si[tt * 256 + c] = acci[tt]; }
    }
#pragma unroll 4
    for (int tt = 0; tt < 16; ++tt) {
      const float r = sigm(sr[tt * 256 + c] + ba), ig = sigm(si[tt * 256 + c] + bx);
      const float log_a = 8.f * r * ls;
      const float a = __expf(log_a);
      const float mult = sqrtf(-expm1f(2.f * log_a));
      sr[tt * 256 + c] = a;
      si[tt * 256 + c] = mult * ig * sm[tt * 256 + c];
    }
    float* lhp = lh + (size_t)(b * S + tb) * 256 + c;
    float* lap = la + (size_t)(b * S + tb) * 256 + c;
#pragma unroll 4
    for (int tt = 0; tt < 16; ++tt) {
      const float a = sr[tt * 256 + c];
      h = a * h + si[tt * 256 + c];
      ap *= a;
      lhp[tt * 256] = h;
      lap[tt * 256] = ap;
    }
    __syncthreads();
  }
  ((float*)(ws + OFF_HEND))[(size_t)(b * 256 + ck) * 256 + c] = h;
  ((float*)(ws + OFF_AEND))[(size_t)(b * 256 + ck) * 256 + c] = ap;
}

__device__ __forceinline__ void mixa_conv(const Params& p, int l, int item, float* sm) {
  unsigned char* ws = p.ws;
  const int half = tidx() >> 8;
  item = item * 2 + half;
  sm += half * 15872;
  const int b = item >> 8, ck = item & 255;
  const int c = tidx() & 255;
  const h16* P = (const h16*)(ws + OFF_P16);
  const int t0 = ck * 32;
#pragma unroll 1
  for (int r0 = 0; r0 < 64; r0 += 16) {
    h16 va[16], vb[16];
#pragma unroll
    for (int q = 0; q < 16; ++q) {
      const int t = t0 - 30 + r0 + q;
      va[q] = (h16)0.f; vb[q] = (h16)0.f;
      if (t >= 0 && r0 + q < 62) {
        const h16* pr = P + (size_t)(b * S + t) * NIN;
        va[q] = pr[C_CVA + c]; vb[q] = pr[C_CVB + c];
      }
    }
#pragma unroll
    for (int q = 0; q < 16; ++q)
      if (r0 + q < 62) sm[(r0 + q) * 256 + c] = (float)va[q] * sigm((float)vb[q]);
  }
  float w[31];
#pragma unroll
  for (int j = 0; j < 31; ++j) w[j] = p.in[I_DWW][(size_t)(l * 31 + j) * 256 + c];
  const float bias = p.in[I_DWB][l * 256 + c];
  for (int i = 0; i < 32; ++i) {
    float z = bias;
#pragma unroll
    for (int j = 0; j < 31; ++j) z += w[j] * sm[(i + j) * 256 + c];
    sm[i * 256 + c] = z;
  }
  __syncthreads();
  const int lane = tidx() & 63, wave = (tidx() >> 6) & 3;
  const float4 lg = *(const float4*)(p.in[I_LNG] + l * 256 + lane * 4);
  const float4 lb = *(const float4*)(p.in[I_LNB] + l * 256 + lane * 4);
  const float4 gn = *(const float4*)(p.in[I_ONG] + l * 1024 + 768 + lane * 4);
  h16* yc = (h16*)(ws + OFF_H16);
  for (int i = wave * 8; i < wave * 8 + 8; ++i) {
    const float4 z = *(const float4*)(sm + i * 256 + lane * 4);
    const float mu = wsum(z.x + z.y + z.z + z.w) * (1.f / 256.f);
    const float dx = z.x - mu, dy = z.y - mu, dz = z.z - mu, dw = z.w - mu;
    const float var = wsum(dx * dx + dy * dy + dz * dz + dw * dw) * (1.f / 256.f);
    const float rs = rsqrtf(var + EPS);
    const float y0 = silu_f(dx * rs * lg.x + lb.x), y1 = silu_f(dy * rs * lg.y + lb.y), y2 = silu_f(dz * rs * lg.z + lb.z), y3 = silu_f(dw * rs * lg.w + lb.w);
    const float r2 = rsqrtf(wsum(y0 * y0 + y1 * y1 + y2 * y2 + y3 * y3) * (1.f / 256.f) + EPS);
    *(h16x4*)(yc + (size_t)(b * S + t0 + i) * D + 768 + lane * 4) = pack4(y0 * r2 * gn.x, y1 * r2 * gn.y, y2 * r2 * gn.z, y3 * r2 * gn.w);
  }
  __syncthreads();
}

__device__ __forceinline__ void phase_mixa(const Params& p, int l, void* sm) {
  const int G = gridDim.x;
  for (int it = blockIdx.x; it < 64; it += G) mixa_compress1(p, it, (h16*)sm);
  for (int it = blockIdx.x; it < 256; it += G) mixa_lru(p, l, it, (float*)sm);
  for (int it = (blockIdx.x + G - 64 % G) % G; it < 256; it += G) mixa_conv(p, l, it, (float*)sm);
}

__device__ __forceinline__ void phase_mixb(const Params& p, int l, float* sm) {
  unsigned char* ws = p.ws;
  const int tid = tidx();
  for (int it = blockIdx.x; it < 512; it += gridDim.x) {
    const int which = it >> 8;
    const int row0 = (it & 255) * 8;
    {
      const float* hp = (const float*)(ws + OFF_HIDP) + ((size_t)which * 2048 + row0) * 256;
      const float* pb = (const float*)(ws + OFF_PB) + which * 256;
      const int r = tid >> 6, c4 = (tid & 63) * 4;
      const size_t o = (size_t)r * 256 + c4;
      const float4 a0 = *(const float4*)(hp + o), a1 = *(const float4*)(hp + (size_t)2 * 2048 * 256 + o);
      const float4 a2 = *(const float4*)(hp + (size_t)4 * 2048 * 256 + o), a3 = *(const float4*)(hp + (size_t)6 * 2048 * 256 + o);
      const float4 bb = *(const float4*)(pb + c4);
      float* d = sm + r * 256 + c4;
      d[0] = gelu_tanh(a0.x + a1.x + a2.x + a3.x + bb.x); d[1] = gelu_tanh(a0.y + a1.y + a2.y + a3.y + bb.y);
      d[2] = gelu_tanh(a0.z + a1.z + a2.z + a3.z + bb.z); d[3] = gelu_tanh(a0.w + a1.w + a2.w + a3.w + bb.w);
      const float4* wsrc = (const float4*)(p.in[which ? I_CVW2 : I_CKW2] + (size_t)l * 256 * 64);
      float4* wdst = (float4*)(sm + 2048);
#pragma unroll
      for (int q = 0; q < 8; ++q) wdst[q * NTHREADS + tid] = wsrc[q * NTHREADS + tid];
    }
    __syncthreads();
    const int row = row0 + (tid >> 6), d = tid & 63;
    const float* hr = sm + (tid >> 6) * 256;
    const float* w2 = sm + 2048 + d;
    float s = 0.f;
#pragma unroll 8
    for (int j = 0; j < 256; ++j) s += (float)(h16)hr[j] * w2[j * 64];
    const int bkv = row >> 9, n = row & 511;
    if (n == 511) s = 0.f;
    if (which == 0) {
      ((h16*)(ws + OFF_KCMP))[((size_t)bkv * 512 + n) * 64 + d] = (h16)s;
    } else {
      const int blk = n >> 6, key = n & 63;
      const int pos = 32 * (key >> 5) + 8 * ((key >> 2) & 3) + 4 * ((key >> 4) & 1) + (key & 3);
      ((h16*)(ws + OFF_VCMPT))[((size_t)(bkv * 8 + blk) * 64 + d) * 64 + pos] = (h16)s;
    }
    __syncthreads();
  }
  const int g = blockIdx.x * NTHREADS + tid;
  if (g < 512) {
    const int b = g >> 8, c = g & 255;
    const float* he = (const float*)(ws + OFF_HEND) + (size_t)b * 256 * 256 + c;
    const float* ae = (const float*)(ws + OFF_AEND) + (size_t)b * 256 * 256 + c;
    float* cy = (float*)(ws + OFF_CARRY) + (size_t)b * 256 * 256 + c;
    float carry = 0.f;
#pragma unroll 1
    for (int k0 = 0; k0 < 256; k0 += 32) {
      float hv[32], av[32];
#pragma unroll
      for (int k = 0; k < 32; ++k) { hv[k] = he[(k0 + k) * 256]; av[k] = ae[(k0 + k) * 256]; }
#pragma unroll
      for (int k = 0; k < 32; ++k) {
        cy[(k0 + k) * 256] = carry;
        carry = hv[k] + av[k] * carry;
      }
    }
  }
}

__device__ __forceinline__ void stage8k(const h16* __restrict__ g, h16* l, int tid) {
  const int r = tid >> 3, cl = (tid & 7) ^ ((r >> 1) & 7);
  glds16(g + r * 64 + cl * 8, l + tid * 8);
}
__device__ __forceinline__ h16x8 ldfrag(const h16* l, int row, int chunk) {
  return *(const h16x8*)(l + row * 64 + ((chunk ^ ((row >> 1) & 7)) * 8));
}

template <int MODE>
__device__ __forceinline__ void attn_branch(const h16* __restrict__ Kg, const h16* __restrict__ Vg, int j0, int j1, h16* ring,
                                            const h16x8 (&qf)[2][2], float (&m)[2], float (&l)[2], f32x4 (&o)[2][4],
                                            const int (&tq)[2], const int (&lim)[2], const int (&tlim)[2], const int (&tfl)[2],
                                            const unsigned long long (&mylo)[2], const unsigned long long (&myhi)[2],
                                            const unsigned long long (&ulo)[2], const unsigned long long (&uhi)[2],
                                            const float (&inv)[2], float* impw) {
  int tid = tidx();
  asm volatile("" : "+v"(tid));
  const int lane = tid & 63;
  const int h = lane >> 4, c = lane & 15, qi = c >> 2, g = c & 3;
  constexpr bool PV = MODE != 0;
  constexpr int NSLOT = 6;
  const int n = j1 - j0 + 1;
  if (n <= 0) return;
  const int nss = (n + 1) >> 1;
#pragma unroll
  for (int q = 0; q < 4; ++q)
    if (q < n) {
      stage8k(Kg + (size_t)(j0 + q) * 4096, ring + q * 8192, tid);
      if (PV) stage8k(Vg + (size_t)(j0 + q) * 4096, ring + q * 8192 + 4096, tid);
    }
  int sbase = 0;
  for (int ss = 0; ss < nss; ++ss) {
    {
      const int nb1 = n - 2 * (ss + 1);
      if (PV) { if (nb1 >= 2) VMCNT(4); else if (nb1 == 1) VMCNT(2); else VMCNT(0); }
      else    { if (nb1 >= 2) VMCNT(2); else if (nb1 == 1) VMCNT(1); else VMCNT(0); }
    }
    __builtin_amdgcn_s_barrier();
    {
      const int sn = sbase >= 2 ? sbase - 2 : sbase + 4;
#pragma unroll
      for (int q = 0; q < 2; ++q) {
        const int jb = 2 * (ss + 2) + q;
        if (jb < n) {
          stage8k(Kg + (size_t)(j0 + jb) * 4096, ring + (sn + q) * 8192, tid);
          if (PV) stage8k(Vg + (size_t)(j0 + jb) * 4096, ring + (sn + q) * 8192 + 4096, tid);
        }
      }
    }
#pragma unroll 1
   for (int sub = 0; sub < 2; ++sub) {
    const int it = 2 * ss + sub;
    if (it >= n) break;
    const int j = j0 + it;
    const h16* cK = ring + (sbase + sub) * 8192;
    const h16* cV = cK + 4096;
    bool act[2];
#pragma unroll
    for (int mq = 0; mq < 2; ++mq) {
      if (MODE <= 1) act[mq] = j * 64 <= tlim[mq];
      else if (MODE == 2) act[mq] = ((j < 64 ? (ulo[mq] >> j) : (uhi[mq] >> (j - 64))) & 1ull) != 0ull;
      else act[mq] = (j * 64 <= tlim[mq] + 3) && (j * 64 + 63 > tlim[mq] - 512);
    }
    if (act[0] || act[1]) {
      h16x8 pf[2][2];
      h16x8 kf[4][2];
#pragma unroll
      for (int kt = 0; kt < 4; ++kt)
#pragma unroll
        for (int ks = 0; ks < 2; ++ks) kf[kt][ks] = ldfrag(cK, 16 * kt + c, 4 * ks + h);
#pragma unroll
      for (int mq = 0; mq < 2; ++mq)
        if (act[mq]) {
          f32x4 s[1][4];
          {
#pragma unroll
            for (int kt = 0; kt < 4; ++kt) {
              s[0][kt] = (f32x4){0.f, 0.f, 0.f, 0.f};
#pragma unroll
              for (int ks = 0; ks < 2; ++ks) s[0][kt] = __builtin_amdgcn_mfma_f32_16x16x32_f16(kf[kt][ks], qf[mq][ks], s[0][kt], 0, 0, 0);
            }
          }
          const bool selbit = MODE == 2 ? (((j < 64 ? (mylo[mq] >> j) : (myhi[mq] >> (j - 64))) & 1ull) != 0ull) : true;
          bool interior;
          if (MODE <= 1) interior = j * 64 + 63 <= tfl[mq];
          else if (MODE == 2) interior = j * 64 + 63 <= tfl[mq];
          else interior = (j * 64 + 63 <= tfl[mq]) && (j * 64 > tfl[mq] + 3 - 512);
          if (!interior) {
            const int pbase = j * 64 + 4 * h;
#pragma unroll
            for (int kt = 0; kt < 4; ++kt)
#pragma unroll
              for (int i = 0; i < 4; ++i) {
                const int pos = pbase + 16 * kt + i;
                bool v;
                if (MODE <= 1) v = pos <= lim[mq];
                else if (MODE == 2) v = selbit && pos <= tq[mq];
                else v = pos <= tq[mq] && pos > tq[mq] - 512;
                s[0][kt][i] = v ? s[0][kt][i] : -1e30f;
              }
          }
          const bool rowoff = MODE == 2 && interior && !selbit;
          if (MODE == 1) {
#pragma unroll
            for (int kt = 0; kt < 4; ++kt) {
              float ps = 0.f;
#pragma unroll
              for (int i = 0; i < 4; ++i) {
                const float pv = __builtin_amdgcn_exp2f(s[0][kt][i] - m[mq]) * inv[mq];
                s[0][kt][i] = pv;
                ps += pv;
              }
              ps += __shfl_xor(ps, 1);
              ps += __shfl_xor(ps, 2);
              if (g == 0) impw[(4 * mq + qi) * 128 + j * 16 + kt * 4 + h] = ps;
            }
          } else {
            float bm = fmaxf(fmaxf(fmaxf(s[0][0][0], s[0][0][1]), fmaxf(s[0][0][2], s[0][0][3])), fmaxf(fmaxf(s[0][1][0], s[0][1][1]), fmaxf(s[0][1][2], s[0][1][3])));
            bm = fmaxf(bm, fmaxf(fmaxf(fmaxf(s[0][2][0], s[0][2][1]), fmaxf(s[0][2][2], s[0][2][3])), fmaxf(fmaxf(s[0][3][0], s[0][3][1]), fmaxf(s[0][3][2], s[0][3][3]))));
            bm = rowoff ? -1e30f : bm;
            if (__any(bm > m[mq] + 8.f)) {
              bm = fmaxf(bm, __shfl_xor(bm, 16));
              bm = fmaxf(bm, __shfl_xor(bm, 32));
              const float mn = fmaxf(m[mq], bm);
              const float alpha = __builtin_amdgcn_exp2f(m[mq] - mn);
              l[mq] *= alpha;
              m[mq] = mn;
              if (PV) {
#pragma unroll
                for (int mt = 0; mt < 4; ++mt) o[mq][mt] *= alpha;
              }
            }
            const float mref = (m[mq] > -1e29f && !rowoff) ? m[mq] : 1e30f;
            float ps = 0.f;
#pragma unroll
            for (int kt = 0; kt < 4; ++kt)
#pragma unroll
              for (int i = 0; i < 4; ++i) {
                const float pv = __builtin_amdgcn_exp2f(s[0][kt][i] - mref);
                s[0][kt][i] = pv;
                ps += pv;
              }
            l[mq] += ps;
          }
          if (PV) {
#pragma unroll
            for (int s2 = 0; s2 < 2; ++s2)
#pragma unroll
              for (int i = 0; i < 4; ++i) { pf[mq][s2][i] = (h16)s[0][2 * s2][i]; pf[mq][s2][4 + i] = (h16)s[0][2 * s2 + 1][i]; }
          }
        }
      if (PV) {
        h16x8 vf[4][2];
#pragma unroll
        for (int mt = 0; mt < 4; ++mt)
#pragma unroll
          for (int s2 = 0; s2 < 2; ++s2) vf[mt][s2] = ldfrag(cV, 16 * mt + c, 4 * s2 + h);
#pragma unroll
        for (int mq = 0; mq < 2; ++mq)
          if (act[mq]) {
#pragma unroll
            for (int s2 = 0; s2 < 2; ++s2) {
#pragma unroll
              for (int mt = 0; mt < 4; ++mt) o[mq][mt] = __builtin_amdgcn_mfma_f32_16x16x32_f16(vf[mt][s2], pf[mq][s2], o[mq][mt], 0, 0, 0);
            }
          }
      }
    }
   }
    sbase = sbase + 2 == NSLOT ? 0 : sbase + 2;
  }
  __builtin_amdgcn_s_barrier();
}

__device__ __forceinline__ void attn_item(const Params& p, int l, int item, float* sm) {
  unsigned char* ws = p.ws;
  int tid = tidx();
  asm volatile("" : "+v"(tid));
  const int lane = tid & 63, wave = tid >> 6;
  const int combo = item & 3, qt = item >> 2;
  const int b = combo >> 1, kv = combo & 1;
  const int t0 = qt * 64, tw0 = t0 + 8 * wave;
  const int h = lane >> 4, c = lane & 15, qi = c >> 2, g = c & 3;
  const int head = kv * 4 + g, bkv = b * 2 + kv;
  h16* ring = (h16*)sm;
  float* impw = sm + 24576 + wave * 1024;
  unsigned long long* selm = (unsigned long long*)(sm + 24576 + 8192) + wave * 16;

  h16x8 qf[2][2];
  int tq[2];
#pragma unroll
  for (int mq = 0; mq < 2; ++mq) {
    tq[mq] = tw0 + 4 * mq + qi;
    const h16* qrow = (const h16*)(ws + OFF_Q16) + (size_t)(b * S + tq[mq]) * 512 + head * 64;
    qf[mq][0] = *(const h16x8*)(qrow + 8 * h);
    qf[mq][1] = *(const h16x8*)(qrow + 32 + 8 * h);
  }
  for (int i = lane; i < 1024; i += 64) impw[i] = 0.f;

  h16x4 ofin[2][4];
  float m[2], ll[2], inv[2];
  f32x4 o[2][4];
  const unsigned long long z2[2] = {0ull, 0ull};
  {
    int lim[2], tlim[2], tflc[2];
#pragma unroll
    for (int mq = 0; mq < 2; ++mq) {
      lim[mq] = tq[mq] >= 31 ? ((tq[mq] - 31) >> 4) : -1;
      const int tl = tw0 + 4 * mq + 3;
      tlim[mq] = tl >= 31 ? ((tl - 31) >> 4) : -1;
      const int tf0 = tw0 + 4 * mq;
      tflc[mq] = tf0 >= 31 ? ((tf0 - 31) >> 4) : -1;
      m[mq] = -1e30f; ll[mq] = 0.f; inv[mq] = 0.f;
#pragma unroll
      for (int mt = 0; mt < 4; ++mt) o[mq][mt] = (f32x4){0.f, 0.f, 0.f, 0.f};
    }
    const int nl = (t0 + 63 - 31) >> 4;
    const int jl = nl >> 6;
    const h16* Kc = (const h16*)(ws + OFF_KCMP) + (size_t)bkv * 512 * 64;
    const h16* Vc = (const h16*)(ws + OFF_VCMPT) + (size_t)bkv * 8 * 4096;
    attn_branch<0>(Kc, Vc, 0, jl, ring, qf, m, ll, o, tq, lim, tlim, tflc, z2, z2, z2, z2, inv, impw);
#pragma unroll
    for (int mq = 0; mq < 2; ++mq) {
      float lt = ll[mq];
      lt += __shfl_xor(lt, 16);
      lt += __shfl_xor(lt, 32);
      inv[mq] = lt > 0.f ? 1.f / lt : 0.f;
    }
    attn_branch<1>(Kc, Vc, 0, jl, ring, qf, m, ll, o, tq, lim, tlim, tflc, z2, z2, z2, z2, inv, impw);
    const float* gt0 = (const float*)(ws + OFF_GATES) + (size_t)(b * S) * 24 + head * 3;
#pragma unroll
    for (int mq = 0; mq < 2; ++mq) {
      const float g0 = gt0[(size_t)tq[mq] * 24] * ASCALE;
#pragma unroll
      for (int mt = 0; mt < 4; ++mt) ofin[mq][mt] = pack4(o[mq][mt][0] * g0, o[mq][mt][1] * g0, o[mq][mt][2] * g0, o[mq][mt][3] * g0);
    }
  }
  for (int q = 0; q < 8; ++q) {
    const int t = tw0 + q, own = t >> 6;
    const float* ir = impw + q * 128;
    const int ja = lane, jb = lane + 64;
    unsigned k0 = 0u, k1 = 0u;
    if (ja <= own) k0 = (ja == 0 || ja == own) ? (0xFFFFFF80u | (unsigned)(127 - ja)) : (((__float_as_uint(ir[ja]) & ~127u) | (unsigned)(127 - ja)) + 1u);
    if (jb <= own) k1 = (jb == own) ? (0xFFFFFF80u | (unsigned)(127 - jb)) : (((__float_as_uint(ir[jb]) & ~127u) | (unsigned)(127 - jb)) + 1u);
    unsigned thr = 0u;
    for (int bit = 31; bit >= 0; --bit) {
      const unsigned cand = thr | (1u << bit);
      const int cnt = __popcll(__ballot(k0 >= cand)) + __popcll(__ballot(k1 >= cand));
      if (cnt >= 16) thr = cand;
    }
    const unsigned long long mlo = __ballot(k0 >= thr && ja <= own);
    const unsigned long long mhi = __ballot(k1 >= thr && jb <= own);
    if (lane == 0) { selm[q * 2] = mlo; selm[q * 2 + 1] = mhi; }
  }
  unsigned long long mylo[2], myhi[2], ulo[2], uhi[2];
#pragma unroll
  for (int mq = 0; mq < 2; ++mq) {
    mylo[mq] = selm[(4 * mq + qi) * 2];
    myhi[mq] = selm[(4 * mq + qi) * 2 + 1];
    unsigned long long a = selm[(4 * mq) * 2] | selm[(4 * mq + 1) * 2] | selm[(4 * mq + 2) * 2] | selm[(4 * mq + 3) * 2];
    unsigned long long bb = selm[(4 * mq) * 2 + 1] | selm[(4 * mq + 1) * 2 + 1] | selm[(4 * mq + 2) * 2 + 1] | selm[(4 * mq + 3) * 2 + 1];
    ulo[mq] = (unsigned long long)__builtin_amdgcn_readfirstlane((unsigned)a) | ((unsigned long long)__builtin_amdgcn_readfirstlane((unsigned)(a >> 32)) << 32);
    uhi[mq] = (unsigned long long)__builtin_amdgcn_readfirstlane((unsigned)bb) | ((unsigned long long)__builtin_amdgcn_readfirstlane((unsigned)(bb >> 32)) << 32);
  }
  const float* gtb = (const float*)(ws + OFF_GATES) + (size_t)(b * S) * 24 + head * 3;
  {
    int tl0[2] = {0, 0};
    const int tfs[2] = {tw0, tw0 + 4};
#pragma unroll
    for (int mq = 0; mq < 2; ++mq) {
      m[mq] = -1e30f; ll[mq] = 0.f;
#pragma unroll
      for (int mt = 0; mt < 4; ++mt) o[mq][mt] = (f32x4){0.f, 0.f, 0.f, 0.f};
    }
    attn_branch<2>((const h16*)(ws + OFF_KS) + (size_t)bkv * S * 64, (const h16*)(ws + OFF_VST) + (size_t)bkv * 128 * 4096, 0, (t0 + 63) >> 6, ring, qf, m, ll, o,
                   tq, tl0, tl0, tfs, mylo, myhi, ulo, uhi, inv, impw);
#pragma unroll
    for (int mq = 0; mq < 2; ++mq) {
      float lt = ll[mq];
      lt += __shfl_xor(lt, 16);
      lt += __shfl_xor(lt, 32);
      const float sc = lt > 0.f ? gtb[(size_t)tq[mq] * 24 + 1] * ASCALE / lt : 0.f;
#pragma unroll
      for (int mt = 0; mt < 4; ++mt)
        ofin[mq][mt] = pack4((float)ofin[mq][mt][0] + o[mq][mt][0] * sc, (float)ofin[mq][mt][1] + o[mq][mt][1] * sc, (float)ofin[mq][mt][2] + o[mq][mt][2] * sc,
                             (float)ofin[mq][mt][3] + o[mq][mt][3] * sc);
    }
  }
  {
    int tl0[2] = {0, 0}, tf[2];
#pragma unroll
    for (int mq = 0; mq < 2; ++mq) {
      tf[mq] = tw0 + 4 * mq;
      m[mq] = -1e30f; ll[mq] = 0.f;
#pragma unroll
      for (int mt = 0; mt < 4; ++mt) o[mq][mt] = (f32x4){0.f, 0.f, 0.f, 0.f};
    }
    const int jlo = t0 >= 511 ? ((t0 - 511) >> 6) : 0;
    attn_branch<3>((const h16*)(ws + OFF_KW) + (size_t)bkv * S * 64, (const h16*)(ws + OFF_VWT) + (size_t)bkv * 128 * 4096, jlo, (t0 + 63) >> 6, ring, qf, m, ll, o,
                   tq, tl0, tf, tf, z2, z2, z2, z2, inv, impw);
#pragma unroll
    for (int mq = 0; mq < 2; ++mq) {
      float lt = ll[mq];
      lt += __shfl_xor(lt, 16);
      lt += __shfl_xor(lt, 32);
      const float sc = lt > 0.f ? gtb[(size_t)tq[mq] * 24 + 2] * ASCALE / lt : 0.f;
#pragma unroll
      for (int mt = 0; mt < 4; ++mt)
        ofin[mq][mt] = pack4((float)ofin[mq][mt][0] + o[mq][mt][0] * sc, (float)ofin[mq][mt][1] + o[mq][mt][1] * sc, (float)ofin[mq][mt][2] + o[mq][mt][2] * sc,
                             (float)ofin[mq][mt][3] + o[mq][mt][3] * sc);
    }
  }
  {
    h16* yc = (h16*)(ws + OFF_H16);
    const float* gn = p.in[I_ONG] + l * 1024 + 256 + head * 64;
    float* ssq = (float*)(ws + OFF_SSQ);
#pragma unroll
    for (int mq = 0; mq < 2; ++mq) {
      float sq = 0.f;
      h16* yr = yc + (size_t)(b * S + tq[mq]) * D + head * 64;
#pragma unroll
      for (int mt = 0; mt < 4; ++mt) {
        const float v[4] = {(float)ofin[mq][mt][0], (float)ofin[mq][mt][1], (float)ofin[mq][mt][2], (float)ofin[mq][mt][3]};
        sq += v[0] * v[0] + v[1] * v[1] + v[2] * v[2] + v[3] * v[3];
        const float4 gg = *(const float4*)(gn + 16 * mt + 4 * h);
        *(h16x4*)(yr + 16 * mt + 4 * h) = pack4(v[0] * gg.x, v[1] * gg.y, v[2] * gg.z, v[3] * gg.w);
      }
      sq += __shfl_xor(sq, 16);
      sq += __shfl_xor(sq, 32);
      sq += __shfl_xor(sq, 1);
      sq += __shfl_xor(sq, 2);
      if (h == 0 && g == 0) ssq[(size_t)(b * S + tq[mq]) * 2 + kv] = sq * (1.f / (ASCALE * ASCALE));
    }
  }
}

__device__ __forceinline__ void lrufix_item(const Params& p, int l, int item) {
  unsigned char* ws = p.ws;
  const int lane = tidx() & 63, wave = tidx() >> 6;
  const int b = item >> 7, ck = item & 127;
  const h16* P = (const h16*)(ws + OFF_P16);
  const float4 cy = *(const float4*)((const float*)(ws + OFF_CARRY) + (size_t)(b * 256 + ck * 2 + (wave >> 2)) * 256 + lane * 4);
  const float4 gn = *(const float4*)(p.in[I_ONG] + l * 1024 + lane * 4);
  h16* yc = (h16*)(ws + OFF_H16);
  for (int tt = wave * 8; tt < wave * 8 + 8; ++tt) {
    const size_t row = (size_t)(b * S + ck * 64 + tt);
    const float4 hl = *(const float4*)((const float*)(ws + OFF_LRUH) + row * 256 + lane * 4);
    const float4 al = *(const float4*)((const float*)(ws + OFF_LRUA) + row * 256 + lane * 4);
    const h16x4 gl = *(const h16x4*)(P + row * NIN + C_GL + lane * 4);
    const float y0 = (hl.x + al.x * cy.x) * gelu_tanh((float)gl[0]);
    const float y1 = (hl.y + al.y * cy.y) * gelu_tanh((float)gl[1]);
    const float y2 = (hl.z + al.z * cy.z) * gelu_tanh((float)gl[2]);
    const float y3 = (hl.w + al.w * cy.w) * gelu_tanh((float)gl[3]);
    const float rstd = rsqrtf(wsum(y0 * y0 + y1 * y1 + y2 * y2 + y3 * y3) * (1.f / 256.f) + EPS);
    *(h16x4*)(yc + row * D + 512 + lane * 4) = pack4(y0 * rstd * gn.x, y1 * rstd * gn.y, y2 * rstd * gn.z, y3 * rstd * gn.w);
  }
}

__device__ __forceinline__ void phase_attn(const Params& p, int l, float* sm) {
  for (int it = blockIdx.x; it < 256; it += gridDim.x) {
#pragma unroll 1
    for (int rep = 0; rep < 2; ++rep) attn_item(p, l, rep ? (127 - (it >> 2)) * 4 + (it & 3) : it, sm);
  }
  for (int it = blockIdx.x; it < 256; it += gridDim.x) lrufix_item(p, l, it);
}

__device__ __forceinline__ void phase_outproj(const Params& p, int l, h16* sm) {
  unsigned char* ws = p.ws;
  const h16* A = (const h16*)(ws + OFF_H16);
  const h16* W = (const h16*)(ws + OFF_WOUT);
  const float* mod = (const float*)(ws + OFF_MOD);
  float* xa = (float*)(ws + OFF_XA);
  const float* xin = l == 0 ? p.in[I_X] : (const float*)xa;
  const TileIter ti = xcd_tiles(64 * 4);
  for (int t = ti.cur; t < ti.end; t += ti.step) {
    const int mt = t >> 2, nt = t & 3;
    f32x4 acc[8][4];
    const h16* Ab = A + (size_t)mt * 256 * D;
    {
      float* sct = (float*)((unsigned char*)sm + SCHED_OFF - 1024);
      const int tq_ = tidx();
      if (tq_ < 256) {
        const float2 q2 = *(const float2*)((const float*)(ws + OFF_SSQ) + (size_t)(mt * 256 + tq_) * 2);
        sct[tq_] = rsqrtf((q2.x + q2.y) * (1.f / 512.f) + EPS) * (1.f / ASCALE);
      }
    }
    gemm_mainloop<256>(acc, [&](int r) { return Ab + (size_t)r * D; }, W + (size_t)nt * 256 * D, D, 8, sm);
    const int tid_e = tidx(), lane = tid_e & 63, wave = tid_e >> 6, wr = wave >> 2, wc = wave & 3, fr = lane & 15, fq = lane >> 4;
    {
      const float* sct = (const float*)((const unsigned char*)sm + SCHED_OFF - 1024) + wr * 128 + fr;
#pragma unroll
      for (int m = 0; m < 8; ++m) {
        const float sc = sct[m * 16];
#pragma unroll
        for (int n = 0; n < 4; ++n) acc[m][n] *= sc;
      }
    }
    gemm_mainloop<256>(acc, [&](int r) { return Ab + (size_t)r * D + 512; }, W + (size_t)nt * 256 * D + 512, D, 8, sm, false);
#pragma unroll
    for (int m = 0; m < 8; ++m)
#pragma unroll
      for (int n = 0; n < 4; ++n) {
        const int row = mt * 256 + wr * 128 + m * 16 + fr, col = nt * 256 + wc * 64 + n * 16 + 4 * fq;
        const int b = row >> 13;
        const float4 g1 = *(const float4*)(mod + (size_t)(l * 2 + b) * 6144 + 2048 + col);
        const float4 xv = *(const float4*)(xin + (size_t)row * D + col);
        float4 o;
        o.x = xv.x + g1.x * acc[m][n][0]; o.y = xv.y + g1.y * acc[m][n][1]; o.z = xv.z + g1.z * acc[m][n][2]; o.w = xv.w + g1.w * acc[m][n][3];
        *(float4*)(xa + (size_t)row * D + col) = o;
      }
  }
}

__device__ __forceinline__ void phase_router(const Params& p, int l, int* smi) {
  unsigned char* ws = p.ws;
  const int tid = tidx(), lane = tid & 63, wave = tid >> 6;
  const float* mod = (const float*)(ws + OFF_MOD);
  const float* xa = (const float*)(ws + OFF_XA);
  h16* hout = (h16*)(ws + OFF_H16);
  unsigned* cnt = (unsigned*)(ws + OFF_CTL) + 64 + l * 16;
  int* list = (int*)(ws + OFF_LIST);
  float* wpair = (float*)(ws + OFF_WPAIR);
  const float* rgb = p.in[I_RGB] + l * 4;
  int* cntl = smi;
  int* basel = smi + 16;
  int* tok = smi + 32;
  float* wl = (float*)smi + 256;
  {
    const float4* s0 = (const float4*)(p.in[I_RGW] + (size_t)l * 1024 * 4);
    const float4* s1 = (const float4*)(p.in[I_REW] + (size_t)l * 4 * 1024 * 4);
    float4* d = (float4*)wl;
#pragma unroll
    for (int q = 0; q < 2; ++q) d[q * NTHREADS + tid] = s0[q * NTHREADS + tid];
#pragma unroll
    for (int q = 0; q < 8; ++q) d[1024 + q * NTHREADS + tid] = s1[q * NTHREADS + tid];
  }
  const float* rgw = wl;
  for (int chunk = blockIdx.x; chunk < T / 64; chunk += gridDim.x) {
    if (tid < 16) cntl[tid] = 0;
    __syncthreads();
    float4 xn[4];
#pragma unroll
    for (int i = 0; i < 4; ++i) xn[i] = *(const float4*)(xa + (size_t)(chunk * 64 + wave) * D + lane * 4 + 256 * i);
    for (int ti = wave; ti < 64; ti += NW) {
      const int row = chunk * 64 + ti;
      const int b = row >> 13;
      float4 x[4];
      float ss = 0.f;
#pragma unroll
      for (int i = 0; i < 4; ++i) x[i] = xn[i];
      if (ti + NW < 64) {
#pragma unroll
        for (int i = 0; i < 4; ++i) xn[i] = *(const float4*)(xa + (size_t)(row + NW) * D + lane * 4 + 256 * i);
      }
#pragma unroll
      for (int i = 0; i < 4; ++i) ss += x[i].x * x[i].x + x[i].y * x[i].y + x[i].z * x[i].z + x[i].w * x[i].w;
      ss = wsum(ss);
      const float rstd = rsqrtf(ss * (1.f / D) + EPS);
      float lg0 = 0.f, lg1 = 0.f, lg2 = 0.f, lg3 = 0.f;
#pragma unroll
      for (int i = 0; i < 4; ++i) {
        const int col = lane * 4 + 256 * i;
        const float4 g = *(const float4*)(p.in[I_N2G] + l * D + col);
        const float4 sh = *(const float4*)(mod + (size_t)(l * 2 + b) * 6144 + 3072 + col);
        const float4 sc = *(const float4*)(mod + (size_t)(l * 2 + b) * 6144 + 4096 + col);
        x[i].x = x[i].x * rstd * g.x * (1.f + sc.x) + sh.x;
        x[i].y = x[i].y * rstd * g.y * (1.f + sc.y) + sh.y;
        x[i].z = x[i].z * rstd * g.z * (1.f + sc.z) + sh.z;
        x[i].w = x[i].w * rstd * g.w * (1.f + sc.w) + sh.w;
        *(h16x4*)(hout + (size_t)row * D + col) = pack4(x[i].x, x[i].y, x[i].z, x[i].w);
        const float4 w0 = *(const float4*)(rgw + (size_t)(col + 0) * 4), w1 = *(const float4*)(rgw + (size_t)(col + 1) * 4);
        const float4 w2 = *(const float4*)(rgw + (size_t)(col + 2) * 4), w3 = *(const float4*)(rgw + (size_t)(col + 3) * 4);
        lg0 += x[i].x * w0.x + x[i].y * w1.x + x[i].z * w2.x + x[i].w * w3.x;
        lg1 += x[i].x * w0.y + x[i].y * w1.y + x[i].z * w2.y + x[i].w * w3.y;
        lg2 += x[i].x * w0.z + x[i].y * w1.z + x[i].z * w2.z + x[i].w * w3.z;
        lg3 += x[i].x * w0.w + x[i].y * w1.w + x[i].z * w2.w + x[i].w * w3.w;
      }
      lg0 = wsum(lg0) + rgb[0]; lg1 = wsum(lg1) + rgb[1]; lg2 = wsum(lg2) + rgb[2]; lg3 = wsum(lg3) + rgb[3];
      int gs = 0; float gm = lg0;
      if (lg1 > gm) { gm = lg1; gs = 1; }
      if (lg2 > gm) { gm = lg2; gs = 2; }
      if (lg3 > gm) { gm = lg3; gs = 3; }
      const float pg = 1.f / (__expf(lg0 - gm) + __expf(lg1 - gm) + __expf(lg2 - gm) + __expf(lg3 - gm));
      const float* rew = wl + 4096 + gs * 4096;
      const float* reb = p.in[I_REB] + (l * 4 + gs) * 4;
      float e0 = 0.f, e1 = 0.f, e2 = 0.f, e3 = 0.f;
#pragma unroll
      for (int i = 0; i < 4; ++i) {
        const int col = lane * 4 + 256 * i;
        const float4 w0 = *(const float4*)(rew + (size_t)(col + 0) * 4), w1 = *(const float4*)(rew + (size_t)(col + 1) * 4);
        const float4 w2 = *(const float4*)(rew + (size_t)(col + 2) * 4), w3 = *(const float4*)(rew + (size_t)(col + 3) * 4);
        e0 += x[i].x * w0.x + x[i].y * w1.x + x[i].z * w2.x + x[i].w * w3.x;
        e1 += x[i].x * w0.y + x[i].y * w1.y + x[i].z * w2.y + x[i].w * w3.y;
        e2 += x[i].x * w0.z + x[i].y * w1.z + x[i].z * w2.z + x[i].w * w3.z;
        e3 += x[i].x * w0.w + x[i].y * w1.w + x[i].z * w2.w + x[i].w * w3.w;
      }
      float le[4];
      le[0] = wsum(e0) + reb[0]; le[1] = wsum(e1) + reb[1]; le[2] = wsum(e2) + reb[2]; le[3] = wsum(e3) + reb[3];
      int i0 = 0; float v0 = le[0];
      if (le[1] > v0) { v0 = le[1]; i0 = 1; }
      if (le[2] > v0) { v0 = le[2]; i0 = 2; }
      if (le[3] > v0) { v0 = le[3]; i0 = 3; }
      int i1 = -1; float v1 = -3.0e38f;
#pragma unroll
      for (int j = 0; j < 4; ++j) {
        const float vj = (j == 0 ? le[0] : j == 1 ? le[1] : j == 2 ? le[2] : le[3]);
        if (j != i0 && vj > v1) { v1 = vj; i1 = j; }
      }
      const float p0 = 1.f / (1.f + __expf(v1 - v0));
      const float p1 = 1.f - p0;
      if (lane == 0) {
        const int ea = gs * 4 + i0, eb = gs * 4 + i1;
        const int ra = atomicAdd(&cntl[ea], 1);
        const int rb = atomicAdd(&cntl[eb], 1);
        tok[ti * 2] = ea | (ra << 8);
        tok[ti * 2 + 1] = eb | (rb << 8);
        wpair[row * 2] = pg * p0;
        wpair[row * 2 + 1] = pg * p1;
      }
    }
    __syncthreads();
    if (tid < 16) basel[tid] = (int)atomicAdd(&cnt[tid], (unsigned)cntl[tid]);
    __syncthreads();
    if (tid < 128) {
      const int v = tok[tid], e = v & 255, r = v >> 8;
      list[(size_t)e * 16384 + basel[e] + r] = (chunk * 64 + (tid >> 1)) * 2 + (tid & 1);
    }
    __syncthreads();
  }
}

__device__ __forceinline__ void moe_sched(const Params& p, int l, int* sl) {
  if (tidx() == 0) {
    const unsigned* cnt = (const unsigned*)(p.ws + OFF_CTL) + 64 + l * 16;
    int to = 0, ro = 0;
    sl[16] = 0; sl[33] = 0;
    for (int e = 0; e < 16; ++e) {
      const int c = (int)__hip_atomic_load(&cnt[e], __ATOMIC_RELAXED, __HIP_MEMORY_SCOPE_AGENT);
      sl[e] = c;
      to += (c + 255) >> 8; ro += c;
      sl[17 + e] = to; sl[34 + e] = ro;
    }
  }
  __syncthreads();
}
__device__ __forceinline__ void moe_tile(const int* sl, int t, int& e, int& nt, int& mt, int& cnt_e, int& roff_e) {
  int ee = 0;
  for (int k = 0; k < 15; ++k) ee += (t >= sl[17 + k] * 4) ? 1 : 0;
  ee = __builtin_amdgcn_readfirstlane(ee);
  const int t0 = __builtin_amdgcn_readfirstlane(sl[16 + ee]), t1 = __builtin_amdgcn_readfirstlane(sl[17 + ee]);
  const int nte = t1 - t0, rem = t - t0 * 4;
  e = ee; nt = rem / nte; mt = rem % nte;
  cnt_e = __builtin_amdgcn_readfirstlane(sl[ee]);
  roff_e = __builtin_amdgcn_readfirstlane(sl[33 + ee]);
}

template <int BN>
__device__ __forceinline__ void moe1_tile(const Params& p, h16* sm, const int* sl, int t, int half) {
  unsigned char* ws = p.ws;
  const h16* H = (const h16*)(ws + OFF_H16);
  h16* hid = (h16*)(ws + OFF_HID);
  int e, nt, mt, cnt_e, roff_e;
  moe_tile(sl, t, e, nt, mt, cnt_e, roff_e);
  const int* le = (const int*)(ws + OFF_LIST) + (size_t)e * 16384;
  f32x4 acc[8][BN / 64];
  gemm_mainloop<BN>(acc, [&](int r) { int so = mt * 256 + r; so = so < cnt_e ? so : 0; return H + (size_t)(le[so] >> 1) * D; },
                    (const h16*)(ws + OFF_WGU) + ((size_t)e * 1024 + nt * 256 + half * 128) * 1024, 1024, 16, sm);
  const int tid_e = tidx(), lane = tid_e & 63, wave = tid_e >> 6, wr = wave >> 2, wc = wave & 3, fr = lane & 15, fq = lane >> 4;
#pragma unroll
  for (int m = 0; m < 8; ++m) {
    const int so = mt * 256 + wr * 128 + m * 16 + fr;
    if (so < cnt_e) {
#pragma unroll
      for (int n2 = 0; n2 < BN / 128; ++n2) {
        const f32x4 gt = acc[m][2 * n2], up = acc[m][2 * n2 + 1];
        const int col = nt * 128 + half * 64 + wc * (BN / 8) + n2 * 16 + 4 * fq;
        *(h16x4*)(hid + (size_t)(roff_e + so) * 512 + col) = pack4(silu_f(gt[0]) * up[0], silu_f(gt[1]) * up[1], silu_f(gt[2]) * up[2], silu_f(gt[3]) * up[3]);
      }
    }
  }
}
__device__ __forceinline__ void phase_moe1(const Params& p, int l, h16* sm) {
  int* sl = (int*)((unsigned char*)sm + SCHED_OFF);
  moe_sched(p, l, sl);
  const int total = __builtin_amdgcn_readfirstlane(sl[32]) * 4;
  const TileSched ts = xcd_sched(total);
  for (int t = ts.cur; t < ts.end; t += ts.step) moe1_tile<256>(p, sm, sl, t, 0);
  if (ts.tail_tile >= 0) {
    if (ts.tail_half < 0) moe1_tile<256>(p, sm, sl, ts.tail_tile, 0);
    else moe1_tile<128>(p, sm, sl, ts.tail_tile, ts.tail_half);
  }
}

template <int BN>
__device__ __forceinline__ void moe2_tile(const Params& p, h16* sm, const int* sl, int t, int half) {
  unsigned char* ws = p.ws;
  const float* wpair = (const float*)(ws + OFF_WPAIR);
  h16* yp = (h16*)(ws + OFF_YPAIR);
  int e, nt, mt, cnt_e, roff_e;
  moe_tile(sl, t, e, nt, mt, cnt_e, roff_e);
  const int* le = (const int*)(ws + OFF_LIST) + (size_t)e * 16384;
  const h16* Ab = (const h16*)(ws + OFF_HID) + (size_t)(roff_e + mt * 256) * 512;
  f32x4 acc[8][BN / 64];
  gemm_mainloop<BN>(acc, [&](int r) { return Ab + (size_t)r * 512; }, (const h16*)(ws + OFF_WDN) + ((size_t)e * 1024 + nt * 256 + half * 128) * 512, 512, 8, sm);
  const int tid_e = tidx(), lane = tid_e & 63, wave = tid_e >> 6, wr = wave >> 2, wc = wave & 3, fr = lane & 15, fq = lane >> 4;
#pragma unroll
  for (int m = 0; m < 8; ++m) {
    const int so = mt * 256 + wr * 128 + m * 16 + fr;
    if (so < cnt_e) {
      const int pair = le[so];
      const float w = wpair[pair];
#pragma unroll
      for (int n = 0; n < BN / 64; ++n) {
        const int col = nt * 256 + half * 128 + wc * (BN / 4) + n * 16 + 4 * fq;
        *(h16x4*)(yp + (size_t)pair * D + col) = pack4(acc[m][n][0] * w, acc[m][n][1] * w, acc[m][n][2] * w, acc[m][n][3] * w);
      }
    }
  }
}
__device__ __forceinline__ void phase_moe2(const Params& p, int l, h16* sm) {
  int* sl = (int*)((unsigned char*)sm + SCHED_OFF);
  moe_sched(p, l, sl);
  const int total = __builtin_amdgcn_readfirstlane(sl[32]) * 4;
  const TileSched ts = xcd_sched(total);
  for (int t = ts.cur; t < ts.end; t += ts.step) moe2_tile<256>(p, sm, sl, t, 0);
  if (ts.tail_tile >= 0) {
    if (ts.tail_half < 0) moe2_tile<256>(p, sm, sl, ts.tail_tile, 0);
    else moe2_tile<128>(p, sm, sl, ts.tail_tile, ts.tail_half);
  }
}

#define XB_TMO      128
#define XB_XCNT(j)  (256  + 64 * (j))
#define XB_XSUB(j)  (1280 + 64 * (j))
#define XB_XGEN(j)  (2304 + 64 * (j))
#define XB_TOP      3328
#define XB_TOPGEN   3392
#define XCD_BAR_WORDS 3456
#define XB_SPIN_CAP (1u << 20)
__device__ __forceinline__ unsigned xb_ld(unsigned* p) { return __hip_atomic_load(p, __ATOMIC_RELAXED, __HIP_MEMORY_SCOPE_AGENT); }
__device__ __forceinline__ unsigned xb_add(unsigned* p, unsigned v) { return __hip_atomic_fetch_add(p, v, __ATOMIC_RELAXED, __HIP_MEMORY_SCOPE_AGENT); }
__device__ __forceinline__ unsigned xb_xcc_id() { return (unsigned)__builtin_amdgcn_s_getreg((3 << 11) | 20) & 0xFu; }
#define XB_SPIN(cond, bar) do { unsigned _sp = 0; while (cond) { __builtin_amdgcn_s_sleep(1); \
    if ((++_sp & 255u) == 0u) { if (xb_ld(&(bar)[XB_TMO])) break; if (_sp > XB_SPIN_CAP) { atomicAdd(&(bar)[XB_TMO], 1u); break; } } } } while (0)
struct XBar { unsigned* bar; unsigned x; volatile unsigned* st; };
__device__ __forceinline__ void xbar_post(XBar& b, unsigned* bar, volatile unsigned* st) {
  b.bar = bar; b.x = xb_xcc_id(); b.st = st;
  if (tidx() == 0) { st[0] = 0u; st[1] = 0u; (void)xb_add(&bar[XB_XCNT(b.x)], 1u); }
}
__device__ __forceinline__ void xbar_census(unsigned* bar, unsigned x, unsigned& nloc, unsigned& nx) {
  const unsigned G = gridDim.x;
  unsigned sum, cnt, mine, sp = 0u;
  for (;;) {
    sum = 0u; cnt = 0u; mine = 0u;
#pragma unroll
    for (unsigned j = 0; j < 16; ++j) { const unsigned c = xb_ld(&bar[XB_XCNT(j)]); sum += c; cnt += (c > 0u) ? 1u : 0u; mine = (j == x) ? c : mine; }
    if (sum == G) break;
    __builtin_amdgcn_s_sleep(1);
    if ((++sp & 255u) == 0u) { if (xb_ld(&bar[XB_TMO])) break; if (sp > XB_SPIN_CAP) { atomicAdd(&bar[XB_TMO], 1u); break; } }
  }
  nloc = mine > 0u ? mine : 1u; nx = cnt > 0u ? cnt : 1u;
}
__device__ __forceinline__ void xbar_sync(XBar& b) {
  asm volatile("s_waitcnt vmcnt(0)" ::: "memory");
  __syncthreads();
  if (tidx() == 0) {
    unsigned* bar = b.bar;
    __builtin_amdgcn_s_waitcnt(0);
    unsigned nloc = b.st[0], nx = b.st[1];
    if (nloc == 0u) { xbar_census(bar, b.x, nloc, nx); b.st[0] = nloc; b.st[1] = nx; }
    const unsigned old = xb_add(&bar[XB_XSUB(b.x)], 1u);
    const unsigned gen = old / nloc;
    if (old + 1u == (gen + 1u) * nloc) {
      __builtin_amdgcn_fence(__ATOMIC_RELEASE, "agent");
      asm volatile("s_waitcnt vmcnt(0)" ::: "memory");
      const unsigned og = xb_add(&bar[XB_TOP], 1u);
      const unsigned tg = og / nx;
      if (og + 1u == (tg + 1u) * nx) xb_add(&bar[XB_TOPGEN], 1u);
      else XB_SPIN(xb_ld(&bar[XB_TOPGEN]) == tg, bar);
      __builtin_amdgcn_fence(__ATOMIC_ACQUIRE, "agent");
      xb_add(&bar[XB_XGEN(b.x)], 1u);
      asm volatile("s_waitcnt vmcnt(0)" ::: "memory");
    } else {
      XB_SPIN(xb_ld(&bar[XB_XGEN(b.x)]) == gen, bar);
      __builtin_amdgcn_fence(__ATOMIC_ACQUIRE, "agent");
      asm volatile("s_waitcnt vmcnt(0)" ::: "memory");
    }
  }
  __syncthreads();
}

constexpr int NSTEPS = 22;
#define STEP(k, body) do { if (s_lo <= (k) && (k) < s_hi) { body; if ((k) + 1 < s_hi) { xbar_sync(xb); } \
    if (PROBE_MASK != 0u) { unsigned long long now_ = __builtin_amdgcn_s_memrealtime(); \
      if ((PROBE_MASK >> (k)) & 1u) { const unsigned long long w_ = (now_ - pt_prev) * PROBE_AMP; \
        while (__builtin_amdgcn_s_memrealtime() - now_ < w_) __builtin_amdgcn_s_sleep(8); now_ = __builtin_amdgcn_s_memrealtime(); } \
      pt_prev = now_; } } } while (0)
#define LAYER_STEPS(l, base) \
  STEP(base + 0, phase_norm1(p, l); if (l == 1) phase_convert(p, 1, (float*)smem)); \
  STEP(base + 1, phase_inproj(p, (h16*)smem)); \
  STEP(base + 2, phase_post(p)); \
  STEP(base + 3, phase_mixa(p, l, smem)); \
  STEP(base + 4, phase_mixb(p, l, (float*)smem)); \
  STEP(base + 5, phase_attn(p, l, (float*)smem)); \
  STEP(base + 6, phase_outproj(p, l, (h16*)smem)); \
  STEP(base + 7, phase_router(p, l, (int*)smem)); \
  STEP(base + 8, phase_moe1(p, l, (h16*)smem)); \
  STEP(base + 9, phase_moe2(p, l, (h16*)smem))

__global__ void __launch_bounds__(NTHREADS, 2) mega(Params p, int s_lo, int s_hi) {
  extern __shared__ __attribute__((aligned(16))) unsigned char smem[];
  unsigned long long pt_prev = PROBE_MASK != 0u ? __builtin_amdgcn_s_memrealtime() : 0ull;
  XBar xb;
  xbar_post(xb, (unsigned*)(p.ws + OFF_BAR), (volatile unsigned*)(smem + LDS_BYTES - 16));
  STEP(0, phase_prep(p, (float*)smem); phase_convert(p, 0, (float*)smem));
  LAYER_STEPS(0, 1);
  LAYER_STEPS(1, 11);
  STEP(21, phase_norm1(p, 2));
}

extern "C" void kernel_launch(void* const* d_in, const int* in_sizes, int n_in, void* d_out, int out_size, void* d_ws, size_t ws_size,
                              hipStream_t stream) {
  static int grid_blocks = 0;
  if (!grid_blocks) {
    if (n_in != 35 || out_size != T * D || ws_size < WS_TOTAL) {
      fprintf(stderr, "kernel_launch: unexpected problem (n_in %d, out %d, ws %zu < %zu)\n", n_in, out_size, ws_size, (size_t)WS_TOTAL);
      grid_blocks = -1;
      return;
    }
    int dev = 0, cus = 0, per_cu = 0;
    hipGetDevice(&dev);
    hipDeviceGetAttribute(&cus, hipDeviceAttributeMultiprocessorCount, dev);
    if (hipFuncSetAttribute((const void*)mega, hipFuncAttributeMaxDynamicSharedMemorySize, LDS_BYTES) != hipSuccess) {
      fprintf(stderr, "kernel_launch: hipFuncSetAttribute(%d B dynamic LDS) failed\n", LDS_BYTES);
      grid_blocks = -1;
      return;
    }
    hipOccupancyMaxActiveBlocksPerMultiprocessor(&per_cu, mega, NTHREADS, LDS_BYTES);
    if (per_cu > 1) per_cu = 1;
    if (per_cu < 1) { fprintf(stderr, "kernel_launch: occupancy query returned %d\n", per_cu); grid_blocks = -1; return; }
    grid_blocks = cus * per_cu;
  }
  if (grid_blocks < 0) return;
  Params p{};
  for (int i = 0; i < 35; ++i) p.in[i] = (const float*)d_in[i];
  p.out = (float*)d_out;
  p.ws = (unsigned char*)d_ws;
  for (int i = 0; i < 32; ++i) p.inv_freq[i] = std::pow(10000.0, -(double)(2 * i) / 64.0);
  if (hipMemsetAsync((char*)d_ws + OFF_BAR, 0, 16384, stream) != hipSuccess) { fprintf(stderr, "kernel_launch: memset of barrier words failed\n"); return; }
#if MEGA
  int lo = 0, hi = NSTEPS;
  void* args[] = {&p, &lo, &hi};
  hipError_t e = hipLaunchCooperativeKernel((void*)mega, dim3(grid_blocks), dim3(NTHREADS), args, LDS_BYTES, stream);
  if (e != hipSuccess) fprintf(stderr, "cooperative launch failed: %s (grid %d)\n", hipGetErrorString(e), grid_blocks);
#else
  for (int s = 0; s < NSTEPS; ++s) {
    int lo = s, hi = s + 1;
    void* args[] = {&p, &lo, &hi};
    hipError_t e = hipLaunchCooperativeKernel((void*)mega, dim3(grid_blocks), dim3(NTHREADS), args, LDS_BYTES, stream);
    if (e != hipSuccess) { fprintf(stderr, "launch %d failed: %s (grid %d)\n", s, hipGetErrorString(e), grid_blocks); break; }
  }
#endif
}
```

```cpp
#include <hip/hip_runtime.h>
#include <hip/hip_cooperative_groups.h>
#include <cstdio>
#include <cstdint>
#include <cmath>
namespace cg = cooperative_groups;

#ifndef MEGA
#define MEGA 1
#endif
#ifndef PROBE_MASK
#define PROBE_MASK 0u
#define PROBE_AMP 3
#endif

typedef _Float16 h16;
typedef _Float16 h16x8 __attribute__((ext_vector_type(8)));
typedef _Float16 h16x4 __attribute__((ext_vector_type(4)));
typedef float f32x4 __attribute__((ext_vector_type(4)));

constexpr int NB = 2, S = 8192, T = NB * S, D = 1024;
constexpr int NIN = 2432;
constexpr int NINSRC = 2328;
constexpr int C_XL = 0, C_GL = 256, C_Q = 512, C_KC = 1024, C_VC = 1152, C_KS = 1280, C_VS = 1408, C_KW = 1536, C_VW = 1664,
              C_CVA = 1792, C_CVB = 2048, C_GATE = 2304;
constexpr float EPS = 1e-6f;
constexpr int NTHREADS = 512, NW = 8;
constexpr int LDS_BYTES = 147456;
constexpr int NINP = 2560;
constexpr int SCHED_OFF = LDS_BYTES - 1024;
constexpr float ASCALE = 16.f;

constexpr size_t al256(size_t x) { return (x + 255) & ~(size_t)255; }
constexpr size_t OFF_CTL = 0;
constexpr size_t OFF_BAR = 4096;
constexpr size_t OFF_MOD = 4096 + 16384;
constexpr size_t OFF_ROPE = al256(OFF_MOD + 2 * 2 * 6144 * 4);
constexpr size_t OFF_PB = al256(OFF_ROPE + (size_t)T * 64 * 4);
constexpr size_t OFF_PBPART = al256(OFF_PB + 2 * 256 * 4);
constexpr size_t OFF_GATES = al256(OFF_PBPART + 2 * 32 * 256 * 4);
constexpr size_t OFF_WIN = al256(OFF_GATES + (size_t)T * 24 * 4);
constexpr size_t OFF_WOUT = al256(OFF_WIN + (size_t)NINP * 1024 * 2);
constexpr size_t OFF_WGU = al256(OFF_WOUT + (size_t)1024 * 1024 * 2);
constexpr size_t OFF_WDN = al256(OFF_WGU + (size_t)16 * 1024 * 1024 * 2);
constexpr size_t OFF_W1K = al256(OFF_WDN + (size_t)16 * 1024 * 512 * 2);
constexpr size_t OFF_W1V = al256(OFF_W1K + (size_t)256 * 2048 * 2);
constexpr size_t OFF_H16 = al256(OFF_W1V + (size_t)256 * 2048 * 2);
constexpr size_t OFF_Q16 = al256(OFF_H16 + (size_t)T * 1024 * 2);
constexpr size_t KVSZ = (size_t)T * 128 * 2;
constexpr size_t OFF_KC = al256(OFF_Q16 + (size_t)T * 512 * 2);
constexpr size_t OFF_VC = al256(OFF_KC + KVSZ + 4096);
constexpr size_t OFF_KS = al256(OFF_VC + KVSZ + 4096);
constexpr size_t OFF_VST = al256(OFF_KS + KVSZ);
constexpr size_t OFF_KW = al256(OFF_VST + KVSZ);
constexpr size_t OFF_VWT = al256(OFF_KW + KVSZ);
constexpr size_t OFF_HIDC = al256(OFF_VWT + KVSZ);
constexpr size_t OFF_KCMP = al256(OFF_HIDC + (size_t)2 * 2048 * 256 * 2);
constexpr size_t OFF_VCMPT = al256(OFF_KCMP + (size_t)4 * 512 * 64 * 2);
constexpr size_t OFF_LRUH = al256(OFF_VCMPT + (size_t)4 * 512 * 64 * 2);
constexpr size_t OFF_LRUA = al256(OFF_LRUH + (size_t)T * 256 * 4);
constexpr size_t OFF_HEND = al256(OFF_LRUA + (size_t)T * 256 * 4);
constexpr size_t OFF_AEND = al256(OFF_HEND + 2 * 256 * 256 * 4);
constexpr size_t OFF_CARRY = al256(OFF_AEND + 2 * 256 * 256 * 4);
constexpr size_t OFF_XA = al256(OFF_CARRY + 2 * 256 * 256 * 4);
constexpr size_t OFF_LIST = al256(OFF_XA + (size_t)T * 1024 * 4);
constexpr size_t OFF_WPAIR = al256(OFF_LIST + (size_t)16 * 16384 * 4);
constexpr size_t OFF_SSQ = al256(OFF_WPAIR + 32768 * 4);
constexpr size_t OFF_R = al256(OFF_SSQ + (size_t)T * 2 * 4);
constexpr size_t OFF_P16 = OFF_R;
constexpr size_t OFF_HID = OFF_R;
constexpr size_t OFF_YPAIR = al256(OFF_HID + (size_t)(32768 + 512) * 512 * 2);
constexpr size_t OFF_HIDP = al256(OFF_P16 + (size_t)T * NIN * 2);
constexpr size_t R_END1 = OFF_HIDP + (size_t)4 * 2 * 2048 * 256 * 4;
constexpr size_t R_END2 = OFF_YPAIR + (size_t)32768 * 1024 * 2;
constexpr size_t WS_TOTAL = al256(R_END1 > R_END2 ? R_END1 : R_END2);

struct Params {
  const float* in[35];
  float* out;
  unsigned char* ws;
  double inv_freq[32];
};
enum { I_X = 0, I_C, I_POS, I_ADAW, I_ADAB, I_N1G, I_N2G, I_WIN, I_LCW, I_LCB, I_LWA, I_LBA, I_LWX, I_LBX, I_LLAM, I_CKW1, I_CKW2,
       I_CVW1, I_CVW2, I_CPK, I_CPV, I_DWW, I_DWB, I_LNG, I_LNB, I_ONG, I_WOUT, I_RGW, I_RGB, I_REW, I_REB, I_MG, I_MU, I_MD, I_FNG };

__device__ __forceinline__ int tidx() { int t = threadIdx.x; asm volatile("" : "+v"(t)); return t; }
__device__ __forceinline__ float wsum(float v) {
#pragma unroll
  for (int o = 32; o > 0; o >>= 1) v += __shfl_xor(v, o);
  return v;
}
__device__ __forceinline__ float sigm(float x) { return 1.f / (1.f + __expf(-x)); }
__device__ __forceinline__ float silu_f(float x) { return x / (1.f + __expf(-x)); }
__device__ __forceinline__ float gelu_tanh(float x) {
  float u = 0.7978845608028654f * (x + 0.044715f * x * x * x);
  float e = __expf(2.f * u);
  float t = 1.f - 2.f / (e + 1.f);
  return 0.5f * x * (1.f + t);
}
__device__ __forceinline__ void glds16(const h16* g, h16* l) {
  __builtin_amdgcn_global_load_lds((const unsigned*)g, (unsigned*)l, 16, 0, 0);
}
__device__ __forceinline__ h16x4 pack4(float a, float b, float c, float d) {
  h16x4 r; r[0] = (h16)a; r[1] = (h16)b; r[2] = (h16)c; r[3] = (h16)d; return r;
}

struct TileIter { int cur, end, step; };
__device__ __forceinline__ TileIter xcd_tiles(int ntiles) {
  const int G = gridDim.x, b = blockIdx.x;
  TileIter it;
  if ((G & 7) == 0) {
    const int x = b & 7;
    it.cur = (int)(((long)ntiles * x) >> 3) + (b >> 3);
    it.end = (int)(((long)ntiles * (x + 1)) >> 3);
    it.step = G >> 3;
  } else { it.cur = b; it.end = ntiles; it.step = G; }
  return it;
}

#define VMCNT(n) asm volatile("s_waitcnt vmcnt(" #n ")" ::: "memory")
template <int BN, class ARowFn>
__device__ __forceinline__ void gemm_mainloop(f32x4 (&acc)[8][BN / 64], ARowFn arow, const h16* __restrict__ Bt, int ldb, int nk, h16* sm, bool zero_init = true) {
  constexpr int NF = BN / 64, NBP = BN / 64;
  constexpr int STAGE = 16384 + BN * 64;
  const int tid = tidx(), lane = tid & 63, wave = tid >> 6;
  const int wr = wave >> 2, wc = wave & 3, fr = lane & 15, fq = lane >> 4;
  const h16* ap[4];
  const h16* bp[NBP];
#pragma unroll
  for (int i = 0; i < 4; ++i) {
    const int r = (i * 8 + wave) * 8 + (lane >> 3);
    const int c = (lane & 7) ^ ((r >> 1) & 7);
    ap[i] = arow(r) + c * 8;
    if (i < NBP) bp[i] = Bt + (size_t)r * ldb + c * 8;
  }
  if (zero_init) {
#pragma unroll
    for (int m = 0; m < 8; ++m)
#pragma unroll
      for (int n = 0; n < NF; ++n) acc[m][n] = (f32x4){0.f, 0.f, 0.f, 0.f};
  }
  h16* const dA = sm + wave * 512 + lane * 8;
#pragma unroll
  for (int i = 0; i < 4; ++i) { glds16(ap[i], dA + i * 4096); ap[i] += 64; }
#pragma unroll
  for (int i = 0; i < NBP; ++i) { glds16(bp[i], dA + 16384 + i * 4096); bp[i] += 64; }
  const int sw = (fr >> 1) & 7;
  const int aoff = (wr * 128 + fr) * 64, boff = 16384 + (wc * (BN / 4) + fr) * 64;
#define SCHED_FENCE() __builtin_amdgcn_sched_barrier(0)
  for (int kt = 0; kt < nk; ++kt) {
    VMCNT(0);
    __builtin_amdgcn_s_barrier();
    const h16* st = sm + (kt & 1) * STAGE;
    const bool more = kt + 1 < nk;
    h16* const dn = dA + ((kt + 1) & 1) * STAGE;
#pragma unroll
    for (int ks = 0; ks < 2; ++ks) {
      const int ch = ((ks * 4 + fq) ^ sw) * 8;
      h16x8 bf[NF];
#pragma unroll
      for (int n = 0; n < NF; ++n) bf[n] = *(const h16x8*)(st + boff + n * 1024 + ch);
#pragma unroll
      for (int mh = 0; mh < 2; ++mh) {
        h16x8 af[4];
#pragma unroll
        for (int m = 0; m < 4; ++m) af[m] = *(const h16x8*)(st + aoff + (mh * 4 + m) * 1024 + ch);
#pragma unroll
        for (int m = 0; m < 4; ++m) {
#pragma unroll
          for (int n = 0; n < NF; ++n) acc[mh * 4 + m][n] = __builtin_amdgcn_mfma_f32_16x16x32_f16(bf[n], af[m], acc[mh * 4 + m][n], 0, 0, 0);
          if (m == 1 || m == 3) {
            const int q = ks * 4 + mh * 2 + (m >> 1);
            SCHED_FENCE();
            if (more) {
              if (q < 4) { glds16(ap[q & 3], dn + (q & 3) * 4096); ap[q & 3] += 64; }
              else if ((q & 3) < NBP) { glds16(bp[(q & 3) < NBP ? (q & 3) : 0], dn + 16384 + (q & 3) * 4096); bp[(q & 3) < NBP ? (q & 3) : 0] += 64; }
            }
            SCHED_FENCE();
          }
        }
      }
    }
  }
#undef SCHED_FENCE
  __builtin_amdgcn_s_barrier();
}

struct TileSched { int cur, end, step, tail_tile, tail_half; };
__device__ __forceinline__ TileSched xcd_sched(int ntiles) {
  const int G = gridDim.x, b = blockIdx.x;
  TileSched s;
  s.tail_tile = -1; s.tail_half = -1;
  if ((G & 7) == 0) {
    const int x = b & 7, nb = G >> 3, si = b >> 3;
    const int lo = (int)(((long)ntiles * x) >> 3), hi = (int)(((long)ntiles * (x + 1)) >> 3);
    const int n = hi - lo, R = n / nb, rem = n - R * nb;
    s.cur = lo + si; s.end = lo + R * nb; s.step = nb;
    if (rem * 2 <= nb) { if (si < 2 * rem) { s.tail_tile = lo + R * nb + (si >> 1); s.tail_half = si & 1; } }
    else if (si < rem) s.tail_tile = lo + R * nb + si;
  } else { s.cur = b; s.end = ntiles; s.step = G; }
  return s;
}

__device__ __forceinline__ int map_row(int mode, int n) {
  if (mode == 1) return n < 1792 ? n : (n < 1816 ? n + 512 : n - 24);
  if (mode == 2) return 32 * (n >> 4) + (n & 15);
  if (mode == 3) return 32 * (n >> 4) + 16 + (n & 15);
  return n;
}
struct ConvTile { const float* src; h16* dst; int K, N, mode, k0, n0; const float* pos; float* pbp; };
__device__ __forceinline__ ConvTile conv_decode(const Params& p, int l, int t) {
  unsigned char* ws = p.ws;
  constexpr int T_WIN = 16 * 37, T_WOUT = 256, T_G = 16 * 128, T_W1 = 128;
  constexpr int E0 = T_WIN, E1 = E0 + T_WOUT, E2 = E1 + T_G, E3 = E2 + T_G, E4 = E3 + T_G, E5 = E4 + T_W1;
  ConvTile c;
  c.pos = nullptr; c.pbp = nullptr;
  int tk, tn;
  if (t < E0) {
    c.src = p.in[I_WIN] + (size_t)l * 1024 * NINSRC; c.K = 1024; c.N = NINSRC; c.dst = (h16*)(ws + OFF_WIN); c.mode = 1; tk = t / 37; tn = t % 37;
  } else if (t < E1) {
    const int u = t - E0;
    c.src = p.in[I_WOUT] + (size_t)l * 1024 * 1024; c.K = 1024; c.N = 1024; c.dst = (h16*)(ws + OFF_WOUT); c.mode = 4; tk = u >> 4; tn = u & 15;
  } else if (t < E3) {
    const int up = t >= E2;
    const int u = t - (up ? E2 : E1);
    const int e = u >> 7, v = u & 127;
    c.src = p.in[up ? I_MU : I_MG] + ((size_t)l * 16 + e) * 1024 * 512; c.K = 1024; c.N = 512; c.dst = (h16*)(ws + OFF_WGU) + (size_t)e * 1024 * 1024;
    c.mode = up ? 3 : 2; tk = v >> 3; tn = v & 7;
  } else if (t < E4) {
    const int u = t - E3;
    const int e = u >> 7, v = u & 127;
    c.src = p.in[I_MD] + ((size_t)l * 16 + e) * 512 * 1024; c.K = 512; c.N = 1024; c.dst = (h16*)(ws + OFF_WDN) + (size_t)e * 1024 * 512; c.mode = 0; tk = v >> 4; tn = v & 15;
  } else {
    const int vv = t >= E5;
    const int u = t - (vv ? E5 : E4);
    c.src = p.in[vv ? I_CVW1 : I_CKW1] + (size_t)l * 2048 * 256; c.K = 2048; c.N = 256; c.dst = (h16*)(ws + (vv ? OFF_W1V : OFF_W1K)); c.mode = 5; tk = u >> 2; tn = u & 3;
    c.pos = p.in[vv ? I_CPV : I_CPK] + (size_t)l * 2048 + tk * 64;
    c.pbp = (float*)(ws + OFF_PBPART) + (size_t)(vv * 32 + tk) * 256 + tn * 64;
  }
  c.k0 = tk * 64; c.n0 = tn * 64;
  return c;
}
__device__ __forceinline__ void conv_wave_tile(const ConvTile& c, float* smw, int lane) {
  float4 v[16];
#pragma unroll
  for (int i = 0; i < 16; ++i) {
    const int idx = i * 64 + lane;
    const int r = idx >> 4, c4 = (idx & 15) * 4;
    v[i] = make_float4(0.f, 0.f, 0.f, 0.f);
    if (c.n0 + c4 < c.N) v[i] = *(const float4*)(c.src + (size_t)(c.k0 + r) * c.N + c.n0 + c4);
  }
#pragma unroll
  for (int i = 0; i < 16; ++i) {
    const int idx = i * 64 + lane;
    const int r = idx >> 4, c4 = (idx & 15) * 4;
    float* d = smw + r * 65 + c4;
    d[0] = v[i].x; d[1] = v[i].y; d[2] = v[i].z; d[3] = v[i].w;
  }
  if (c.mode == 5) {
    float sacc = 0.f;
    for (int k = 0; k < 64; ++k) sacc += c.pos[k] * smw[k * 65 + lane];
    c.pbp[lane] = sacc;
  }
  const int k0d = c.mode == 4 ? (c.k0 < 256 ? c.k0 + 512 : (c.k0 < 768 ? c.k0 - 256 : c.k0)) : c.k0;
#pragma unroll
  for (int j = 0; j < 8; ++j) {
    const int ch = j * 64 + lane;
    const int n = ch >> 3, kc = ch & 7;
    if (c.n0 + n < c.N) {
      h16x8 o;
#pragma unroll
      for (int q = 0; q < 8; ++q) o[q] = (h16)smw[(kc * 8 + q) * 65 + n];
      *(h16x8*)(c.dst + (size_t)map_row(c.mode, c.n0 + n) * c.K + k0d + kc * 8) = o;
    }
  }
}

__device__ __forceinline__ void phase_convert(const Params& p, int l, float* sm) {
  unsigned char* ws = p.ws;
  constexpr int NT_CONV = 16 * 37 + 256 + 3 * 16 * 128 + 2 * 128;
  {
    const int tid = tidx(), lane = tid & 63, wave = tid >> 6;
    float* smw = sm + wave * 4160;
    for (int t = blockIdx.x * NW + wave; t < NT_CONV; t += gridDim.x * NW) {
      const ConvTile c = conv_decode(p, l, t);
      conv_wave_tile(c, smw, lane);
    }
    __syncthreads();
  }
  {
    h16x8 z = {0, 0, 0, 0, 0, 0, 0, 0};
    h16* w = (h16*)(ws + OFF_WIN) + (size_t)NINSRC * 1024;
    for (int i = blockIdx.x * NTHREADS + tidx(); i < (NINP - NINSRC) * 1024 / 8; i += gridDim.x * NTHREADS) *(h16x8*)(w + (size_t)i * 8) = z;
  }
}

__device__ __forceinline__ void phase_prep(const Params& p, float* sm) {
  unsigned char* ws = p.ws;
  const int tid = tidx();
  if (blockIdx.x == 0) {
    for (int i = tid; i < 1024; i += NTHREADS) ((unsigned*)(ws + OFF_CTL))[i] = 0u;
  }
  float* mod = (float*)(ws + OFF_MOD);
  for (int t = blockIdx.x; t < 384; t += gridDim.x) {
    const int l = t / 192, j0 = (t % 192) * 32;
    const int kg = tid >> 3, cq = tid & 7;
    const float* w = p.in[I_ADAW] + (size_t)l * 1024 * 6144 + j0 + 4 * cq;
    const float* c = p.in[I_C];
    float a0[4] = {0, 0, 0, 0}, a1[4] = {0, 0, 0, 0};
#pragma unroll 8
    for (int k = kg * 16; k < kg * 16 + 16; ++k) {
      const float4 wv = *(const float4*)(w + (size_t)k * 6144);
      const float s0 = silu_f(c[k]), s1 = silu_f(c[1024 + k]);
      a0[0] += s0 * wv.x; a0[1] += s0 * wv.y; a0[2] += s0 * wv.z; a0[3] += s0 * wv.w;
      a1[0] += s1 * wv.x; a1[1] += s1 * wv.y; a1[2] += s1 * wv.z; a1[3] += s1 * wv.w;
    }
    float* r = sm + (kg * 8 + cq) * 8;
#pragma unroll
    for (int i = 0; i < 4; ++i) { r[i] = a0[i]; r[4 + i] = a1[i]; }
    __syncthreads();
    if (tid < 64) {
      const int bb = tid >> 5, col = tid & 31, q = col >> 2, ci = col & 3;
      float s = 0.f;
      for (int g = 0; g < 64; ++g) s += sm[(g * 8 + q) * 8 + bb * 4 + ci];
      mod[(size_t)(l * 2 + bb) * 6144 + j0 + col] = s + p.in[I_ADAB][l * 6144 + j0 + col];
    }
    __syncthreads();
  }
  float* rc = (float*)(ws + OFF_ROPE);
  float* rs = rc + (size_t)T * 32;
  const int* pos = (const int*)p.in[I_POS];
  for (int i = blockIdx.x * NTHREADS + tid; i < T * 32; i += gridDim.x * NTHREADS) {
    const int t = i >> 5, f = i & 31;
    const double a = (double)pos[t] * p.inv_freq[f];
    const double n = rint(a * 0.15915494309189535);
    double r = fma(-n, 6.283185307179586, a);
    r = fma(-n, 2.4492935982947064e-16, r);
    const float rf = (float)r;
    rc[i] = cosf(rf);
    rs[i] = sinf(rf);
  }
}

__device__ __forceinline__ void phase_norm1(const Params& p, int mode) {
  unsigned char* ws = p.ws;
  const int lane = tidx() & 63, wave = tidx() >> 6;
  const float* mod = (const float*)(ws + OFF_MOD);
  float* xa = (float*)(ws + OFF_XA);
  const h16* yp = (const h16*)(ws + OFF_YPAIR);
  h16* hout = (h16*)(ws + OFF_H16);
  const int l = (mode == 0) ? 0 : 1;
  for (int row = blockIdx.x * NW + wave; row < T; row += gridDim.x * NW) {
    const int b = row >> 13;
    float4 x[4];
    float ss = 0.f;
#pragma unroll
    for (int i = 0; i < 4; ++i) {
      const int col = lane * 4 + 256 * i;
      if (mode == 0) {
        x[i] = *(const float4*)(p.in[I_X] + (size_t)row * D + col);
      } else {
        const int lp = mode == 1 ? 0 : 1;
        const float4 xv = *(const float4*)(xa + (size_t)row * D + col);
        const float4 g2 = *(const float4*)(mod + (size_t)(lp * 2 + b) * 6144 + 5120 + col);
        const h16x4 y0 = *(const h16x4*)(yp + (size_t)(row * 2) * D + col);
        const h16x4 y1 = *(const h16x4*)(yp + (size_t)(row * 2 + 1) * D + col);
        x[i].x = xv.x + g2.x * ((float)y0[0] + (float)y1[0]);
        x[i].y = xv.y + g2.y * ((float)y0[1] + (float)y1[1]);
        x[i].z = xv.z + g2.z * ((float)y0[2] + (float)y1[2]);
        x[i].w = xv.w + g2.w * ((float)y0[3] + (float)y1[3]);
        if (mode == 1) *(float4*)(xa + (size_t)row * D + col) = x[i];
      }
      ss += x[i].x * x[i].x + x[i].y * x[i].y + x[i].z * x[i].z + x[i].w * x[i].w;
    }
    ss = wsum(ss);
    const float rstd = rsqrtf(ss * (1.f / D) + EPS);
#pragma unroll
    for (int i = 0; i < 4; ++i) {
      const int col = lane * 4 + 256 * i;
      if (mode == 2) {
        const float4 g = *(const float4*)(p.in[I_FNG] + col);
        float4 o;
        o.x = x[i].x * rstd * g.x; o.y = x[i].y * rstd * g.y; o.z = x[i].z * rstd * g.z; o.w = x[i].w * rstd * g.w;
        *(float4*)(p.out + (size_t)row * D + col) = o;
      } else {
        const float4 g = *(const float4*)(p.in[I_N1G] + l * D + col);
        const float4 sh = *(const float4*)(mod + (size_t)(l * 2 + b) * 6144 + col);
        const float4 sc = *(const float4*)(mod + (size_t)(l * 2 + b) * 6144 + 1024 + col);
        *(h16x4*)(hout + (size_t)row * D + col) = pack4(x[i].x * rstd * g.x * (1.f + sc.x) + sh.x, x[i].y * rstd * g.y * (1.f + sc.y) + sh.y,
                                                        x[i].z * rstd * g.z * (1.f + sc.z) + sh.z, x[i].w * rstd * g.w * (1.f + sc.w) + sh.w);
      }
    }
  }
}

template <int BN>
__device__ __forceinline__ void inproj_tile(const Params& p, h16* sm, int mt, int col0) {
  unsigned char* ws = p.ws;
  const h16* Ab = (const h16*)(ws + OFF_H16) + (size_t)mt * 256 * D;
  h16* P = (h16*)(ws + OFF_P16);
  f32x4 acc[8][BN / 64];
  gemm_mainloop<BN>(acc, [&](int r) { return Ab + (size_t)r * D; }, (const h16*)(ws + OFF_WIN) + (size_t)col0 * D, D, D / 64, sm);
  const int tid_e = tidx(), lane = tid_e & 63, wave = tid_e >> 6, wr = wave >> 2, wc = wave & 3, fr = lane & 15, fq = lane >> 4;
  constexpr int LDR = BN + 8;
#pragma unroll
  for (int m = 0; m < 8; ++m)
#pragma unroll
    for (int n = 0; n < BN / 64; ++n)
      *(h16x4*)(sm + (wr * 128 + m * 16 + fr) * LDR + wc * (BN / 4) + n * 16 + 4 * fq) = pack4(acc[m][n][0], acc[m][n][1], acc[m][n][2], acc[m][n][3]);
  __syncthreads();
  constexpr int CH = BN / 8;
#pragma unroll
  for (int i = 0; i < CH / 2; ++i) {
    const int idx = i * NTHREADS + tid_e;
    const int r = idx / CH, c8 = idx % CH;
    *(h16x8*)(P + (size_t)(mt * 256 + r) * NIN + col0 + c8 * 8) = *(const h16x8*)(sm + r * LDR + c8 * 8);
  }
  __syncthreads();
}
__device__ __forceinline__ void phase_inproj(const Params& p, h16* sm) {
  const TileIter tf = xcd_tiles(64 * 8);
  for (int t = tf.cur; t < tf.end; t += tf.step) inproj_tile<256>(p, sm, t >> 3, (t & 7) * 256);
  const TileIter th = xcd_tiles(64 * 3);
  for (int t = th.cur; t < th.end; t += th.step) inproj_tile<128>(p, sm, t / 3, 2048 + (t % 3) * 128);
}

__device__ __forceinline__ int perm_key(int pos) {
  return 32 * (pos >> 5) + 16 * ((pos >> 2) & 1) + 4 * ((pos >> 3) & 3) + (pos & 3);
}
__device__ __forceinline__ void phase_post(const Params& p) {
  unsigned char* ws = p.ws;
  const h16* P = (const h16*)(ws + OFF_P16);
  const float* rc = (const float*)(ws + OFF_ROPE);
  const float* rs = rc + (size_t)T * 32;
  h16* q16 = (h16*)(ws + OFF_Q16);
  float* gates = (float*)(ws + OFF_GATES);
  const int lane = tidx() & 63, wave = tidx() >> 6;
  if (blockIdx.x == 0) {
    const int o = tidx();
    const float* pp = (const float*)(ws + OFF_PBPART) + (size_t)(o >> 8) * 32 * 256 + (o & 255);
    float acc = 0.f;
    for (int k = 0; k < 32; ++k) acc += pp[k * 256];
    ((float*)(ws + OFF_PB))[o] = acc;
  }
  for (int row = blockIdx.x * NW + wave; row < T; row += gridDim.x * NW) {
    const int b = row >> 13, s = row & (S - 1);
    const h16* pr = P + (size_t)row * NIN;
    const int d = (lane & 7) * 4;
    const float4 cs = *(const float4*)(rc + (size_t)row * 32 + d);
    const float4 sn = *(const float4*)(rs + (size_t)row * 32 + d);
    {
      const int hd = lane >> 3;
      const h16x4 a = *(const h16x4*)(pr + C_Q + 64 * hd + d);
      const h16x4 bb = *(const h16x4*)(pr + C_Q + 64 * hd + 32 + d);
      const float a0 = a[0], a1 = a[1], a2 = a[2], a3 = a[3], b0 = bb[0], b1 = bb[1], b2 = bb[2], b3 = bb[3];
      h16* qo = q16 + (size_t)row * 512 + 64 * hd + d;
      constexpr float QS = 0.125f * 1.4426950408889634f;
      *(h16x4*)qo = pack4((a0 * cs.x - b0 * sn.x) * QS, (a1 * cs.y - b1 * sn.y) * QS, (a2 * cs.z - b2 * sn.z) * QS, (a3 * cs.w - b3 * sn.w) * QS);
      *(h16x4*)(qo + 32) = pack4((b0 * cs.x + a0 * sn.x) * QS, (b1 * cs.y + a1 * sn.y) * QS, (b2 * cs.z + a2 * sn.z) * QS, (b3 * cs.w + a3 * sn.w) * QS);
    }
    if (lane < 48) {
      const int tn = lane >> 4, hd = (lane >> 3) & 1;
      const int cb = (tn == 0 ? C_KC : (tn == 1 ? C_KS : C_KW)) + 64 * hd;
      const size_t off = tn == 0 ? OFF_KC : (tn == 1 ? OFF_KS : OFF_KW);
      const h16x4 a = *(const h16x4*)(pr + cb + d);
      const h16x4 bb = *(const h16x4*)(pr + cb + 32 + d);
      const float a0 = a[0], a1 = a[1], a2 = a[2], a3 = a[3], b0 = bb[0], b1 = bb[1], b2 = bb[2], b3 = bb[3];
      h16* ko = (h16*)(ws + off) + ((size_t)(b * 2 + hd) * S + s) * 64 + d;
      *(h16x4*)ko = pack4(a0 * cs.x - b0 * sn.x, a1 * cs.y - b1 * sn.y, a2 * cs.z - b2 * sn.z, a3 * cs.w - b3 * sn.w);
      *(h16x4*)(ko + 32) = pack4(b0 * cs.x + a0 * sn.x, b1 * cs.y + a1 * sn.y, b2 * cs.z + a2 * sn.z, b3 * cs.w + a3 * sn.w);
    }
    if (lane < 32) {
      const int hd = lane >> 4, dd = (lane & 15) * 4;
      *(h16x4*)((h16*)(ws + OFF_VC) + ((size_t)(b * 2 + hd) * S + s) * 64 + dd) = *(const h16x4*)(pr + C_VC + 64 * hd + dd);
    }
    if (lane < 24) gates[(size_t)row * 24 + lane] = sigm((float)pr[C_GATE + lane]);
  }
  for (int task = blockIdx.x; task < 1024; task += gridDim.x) {
    const int tensor = task & 1, kv = (task >> 1) & 1, blk = (task >> 2) & 127, b = task >> 9;
    const int srccol = (tensor ? C_VW : C_VS) + 64 * kv;
    h16* dst = (h16*)(ws + (tensor ? OFF_VWT : OFF_VST)) + ((size_t)((b * 2 + kv) * 128 + blk)) * 4096;
    const int dim = tidx() & 63, kg = tidx() >> 6;
    {
      const int p0 = kg * 8;
      h16x8 v;
#pragma unroll
      for (int j = 0; j < 8; ++j) v[j] = P[(size_t)(b * S + blk * 64 + perm_key(p0 + j)) * NIN + srccol + dim];
      *(h16x8*)(dst + dim * 64 + p0) = v;
    }
  }
}

__device__ __forceinline__ void mixa_compress1(const Params& p, int item, h16* sm) {
  unsigned char* ws = p.ws;
  const int which = item >> 5, mt = (item >> 2) & 7, ks = item & 3;
  const h16* A = (const h16*)(ws + (which ? OFF_VC : OFF_KC)) + (size_t)mt * 256 * 1024 + ks * 512;
  const h16* W = (const h16*)(ws + (which ? OFF_W1V : OFF_W1K)) + ks * 512;
  float* hp = (float*)(ws + OFF_HIDP) + ((size_t)(ks * 2 + which) * 2048) * 256;
  f32x4 acc[8][4];
  gemm_mainloop<256>(acc, [&](int r) { return A + (size_t)r * 1024; }, W, 2048, 8, sm);
  const int tid_e = tidx(), lane = tid_e & 63, wave = tid_e >> 6, wr = wave >> 2, wc = wave & 3, fr = lane & 15, fq = lane >> 4;
#pragma unroll
  for (int m = 0; m < 8; ++m)
#pragma unroll
    for (int n = 0; n < 4; ++n) {
      const int row = mt * 256 + wr * 128 + m * 16 + fr, col = wc * 64 + n * 16 + 4 * fq;
      *(f32x4*)(hp + (size_t)row * 256 + col) = acc[m][n];
    }
}

__device__ __forceinline__ void mixa_lru(const Params& p, int l, int item, float* sm) {
  unsigned char* ws = p.ws;
  const int half = tidx() >> 8;
  item = item * 2 + half;
  sm += half * 12288;
  const int b = item >> 8, ck = item & 255;
  const int c = tidx() & 255;
  const int nb = c >> 6, e = c & 63;
  const h16* P = (const h16*)(ws + OFF_P16);
  const float* cw = p.in[I_LCW] + l * 4 * 256;
  const float w0 = cw[c], w1 = cw[256 + c], w2 = cw[512 + c], w3 = cw[768 + c], cb = p.in[I_LCB][l * 256 + c];
  const float ba = p.in[I_LBA][l * 256 + c], bx = p.in[I_LBX][l * 256 + c];
  const float lam = p.in[I_LLAM][l * 256 + c];
  const float ls = -log1pf(expf(-lam));
  const float* pa = p.in[I_LWA] + ((size_t)(l * 4 + nb) * 64) * 64 + e;
  const float* px = p.in[I_LWX] + ((size_t)(l * 4 + nb) * 64) * 64 + e;
  const int t0 = ck * 32;
  float x0 = 0.f, x1 = 0.f, x2 = 0.f;
  if (t0 >= 3) {
    x0 = (float)P[(size_t)(b * S + t0 - 3) * NIN + C_XL + c];
    x1 = (float)P[(size_t)(b * S + t0 - 2) * NIN + C_XL + c];
    x2 = (float)P[(size_t)(b * S + t0 - 1) * NIN + C_XL + c];
  }
  float h = 0.f, ap = 1.f;
  float* lh = (float*)(ws + OFF_LRUH);
  float* la = (float*)(ws + OFF_LRUA);
  float* sr = sm + 4096;
  float* si = sm + 8192;
#pragma unroll 1
  for (int sub = 0; sub < 2; ++sub) {
    const int tb = t0 + sub * 16;
    {
      h16 xv[16];
      const h16* xp = P + (size_t)(b * S + tb) * NIN + C_XL + c;
#pragma unroll
      for (int tt = 0; tt < 16; ++tt) { xv[tt] = *xp; xp += NIN; asm volatile("" : "+v"(xp)); }
#pragma unroll
      for (int tt = 0; tt < 16; ++tt) {
        const float x3 = (float)xv[tt];
        sm[tt * 256 + c] = w0 * x0 + w1 * x1 + w2 * x2 + w3 * x3 + cb;
        x0 = x1; x1 = x2; x2 = x3;
      }
    }
    __syncthreads();
    {
      float accr[16], acci[16];
#pragma unroll
      for (int tt = 0; tt < 16; ++tt) { accr[tt] = 0.f; acci[tt] = 0.f; }
      float wan[8], wxn[8];
#pragma unroll
      for (int j = 0; j < 8; ++j) { wan[j] = pa[j * 64]; wxn[j] = px[j * 64]; }
#pragma unroll 1
      for (int d8 = 0; d8 < 8; ++d8) {
        float wa8[8], wx8[8];
#pragma unroll
        for (int j = 0; j < 8; ++j) { wa8[j] = wan[j]; wx8[j] = wxn[j]; }
        if (d8 < 7) {
          const float* pa8 = pa + (d8 + 1) * 512;
          const float* px8 = px + (d8 + 1) * 512;
#pragma unroll
          for (int j = 0; j < 8; ++j) { wan[j] = pa8[j * 64]; wxn[j] = px8[j * 64]; }
        }
        const float* xr = sm + nb * 64 + d8 * 8;
#pragma unroll
        for (int tt = 0; tt < 16; ++tt) {
          const float4 xa = *(const float4*)(xr + tt * 256), xb = *(const float4*)(xr + tt * 256 + 4);
          accr[tt] += xa.x * wa8[0] + xa.y * wa8[1] + xa.z * wa8[2] + xa.w * wa8[3] + xb.x * wa8[4] + xb.y * wa8[5] + xb.z * wa8[6] + xb.w * wa8[7];
          acci[tt] += xa.x * wx8[0] + xa.y * wx8[1] + xa.z * wx8[2] + xa.w * wx8[3] + xb.x * wx8[4] + xb.y * wx8[5] + xb.z * wx8[6] + xb.w * wx8[7];
        }
      }
#pragma unroll
      for (int tt = 0; tt < 16; ++tt) { sr[tt * 256 + c] = accr[tt]; si[tt * 256 + c] = acci[tt]; }
    }
#pragma unroll 4
    for (int tt = 0; tt < 16; ++tt) {
      const float r = sigm(sr[tt * 256 + c] + ba), ig = sigm(si[tt * 256 + c] + bx);
      const float log_a = 8.f * r * ls;
      const float a = __expf(log_a);
      const float mult = sqrtf(-expm1f(2.f * log_a));
      sr[tt * 256 + c] = a;
      si[tt * 256 + c] = mult * ig * sm[tt * 256 + c];
    }
    float* lhp = lh + (size_t)(b * S + tb) * 256 + c;
    float* lap = la + (size_t)(b * S + tb) * 256 + c;
#pragma unroll 4
    for (int tt = 0; tt < 16; ++tt) {
      const float a = sr[tt * 256 + c];
      h = a * h + si[tt * 256 + c];
      ap *= a;
      lhp[tt * 256] = h;
      lap[tt * 256] = ap;
    }
    __syncthreads();
  }
  ((float*)(ws + OFF_HEND))[(size_t)(b * 256 + ck) * 256 + c] = h;
  ((float*)(ws + OFF_AEND))[(size_t)(b * 256 + ck) * 256 + c] = ap;
}

__device__ __forceinline__ void mixa_conv(const Params& p, int l, int item, float* sm) {
  unsigned char* ws = p.ws;
  const int half = tidx() >> 8;
  item = item * 2 + half;
  sm += half * 15872;
  const int b = item >> 8, ck = item & 255;
  const int c = tidx() & 255;
  const h16* P = (const h16*)(ws + OFF_P16);
  const int t0 = ck * 32;
  float col[64];
#pragma unroll
  for (int r0 = 0; r0 < 64; r0 += 16) {
    h16 va[16], vb[16];
#pragma unroll
    for (int q = 0; q < 16; ++q) {
      const int t = t0 - 30 + r0 + q;
      va[q] = (h16)0.f; vb[q] = (h16)0.f;
      if (t >= 0 && r0 + q < 62) {
        const h16* pr = P + (size_t)(b * S + t) * NIN;
        va[q] = pr[C_CVA + c]; vb[q] = pr[C_CVB + c];
      }
    }
#pragma unroll
    for (int q = 0; q < 16; ++q) col[r0 + q] = (float)va[q] * sigm((float)vb[q]);
    asm volatile("" ::: "memory");
  }
  float w[31];
#pragma unroll
  for (int j = 0; j < 31; ++j) w[j] = p.in[I_DWW][(size_t)(l * 31 + j) * 256 + c];
  const float bias = p.in[I_DWB][l * 256 + c];
#pragma unroll
  for (int i = 0; i < 32; ++i) {
    float z = bias;
#pragma unroll
    for (int j = 0; j < 31; ++j) z += w[j] * col[i + j];
    sm[i * 256 + c] = z;
  }
  __syncthreads();
  const int lane = tidx() & 63, wave = (tidx() >> 6) & 3;
  const float4 lg = *(const float4*)(p.in[I_LNG] + l * 256 + lane * 4);
  const float4 lb = *(const float4*)(p.in[I_LNB] + l * 256 + lane * 4);
  const float4 gn = *(const float4*)(p.in[I_ONG] + l * 1024 + 768 + lane * 4);
  h16* yc = (h16*)(ws + OFF_H16);
  for (int i = wave * 8; i < wave * 8 + 8; ++i) {
    const float4 z = *(const float4*)(sm + i * 256 + lane * 4);
    const float mu = wsum(z.x + z.y + z.z + z.w) * (1.f / 256.f);
    const float dx = z.x - mu, dy = z.y - mu, dz = z.z - mu, dw = z.w - mu;
    const float var = wsum(dx * dx + dy * dy + dz * dz + dw * dw) * (1.f / 256.f);
    const float rs = rsqrtf(var + EPS);
    const float y0 = silu_f(dx * rs * lg.x + lb.x), y1 = silu_f(dy * rs * lg.y + lb.y), y2 = silu_f(dz * rs * lg.z + lb.z), y3 = silu_f(dw * rs * lg.w + lb.w);
    const float r2 = rsqrtf(wsum(y0 * y0 + y1 * y1 + y2 * y2 + y3 * y3) * (1.f / 256.f) + EPS);
    *(h16x4*)(yc + (size_t)(b * S + t0 + i) * D + 768 + lane * 4) = pack4(y0 * r2 * gn.x, y1 * r2 * gn.y, y2 * r2 * gn.z, y3 * r2 * gn.w);
  }
  __syncthreads();
}

__device__ __forceinline__ void phase_mixa(const Params& p, int l, void* sm) {
  const int G = gridDim.x;
  for (int it = blockIdx.x; it < 64; it += G) mixa_compress1(p, it, (h16*)sm);
  for (int it = blockIdx.x; it < 256; it += G) mixa_lru(p, l, it, (float*)sm);
  for (int it = (blockIdx.x + G - 64 % G) % G; it < 256; it += G) mixa_conv(p, l, it, (float*)sm);
}

__device__ __forceinline__ void phase_mixb(const Params& p, int l, float* sm) {
  unsigned char* ws = p.ws;
  const int tid = tidx();
  for (int it = blockIdx.x; it < 512; it += gridDim.x) {
    const int which = it >> 8;
    const int row0 = (it & 255) * 8;
    {
      const float* hp = (const float*)(ws + OFF_HIDP) + ((size_t)which * 2048 + row0) * 256;
      const float* pb = (const float*)(ws + OFF_PB) + which * 256;
      const int r = tid >> 6, c4 = (tid & 63) * 4;
      const size_t o = (size_t)r * 256 + c4;
      const float4 a0 = *(const float4*)(hp + o), a1 = *(const float4*)(hp + (size_t)2 * 2048 * 256 + o);
      const float4 a2 = *(const float4*)(hp + (size_t)4 * 2048 * 256 + o), a3 = *(const float4*)(hp + (size_t)6 * 2048 * 256 + o);
      const float4 bb = *(const float4*)(pb + c4);
      float* d = sm + r * 256 + c4;
      d[0] = gelu_tanh(a0.x + a1.x + a2.x + a3.x + bb.x); d[1] = gelu_tanh(a0.y + a1.y + a2.y + a3.y + bb.y);
      d[2] = gelu_tanh(a0.z + a1.z + a2.z + a3.z + bb.z); d[3] = gelu_tanh(a0.w + a1.w + a2.w + a3.w + bb.w);
      const float4* wsrc = (const float4*)(p.in[which ? I_CVW2 : I_CKW2] + (size_t)l * 256 * 64);
      float4* wdst = (float4*)(sm + 2048);
#pragma unroll
      for (int q = 0; q < 8; ++q) wdst[q * NTHREADS + tid] = wsrc[q * NTHREADS + tid];
    }
    __syncthreads();
    const int row = row0 + (tid >> 6), d = tid & 63;
    const float* hr = sm + (tid >> 6) * 256;
    const float* w2 = sm + 2048 + d;
    float s = 0.f;
#pragma unroll 8
    for (int j = 0; j < 256; ++j) s += (float)(h16)hr[j] * w2[j * 64];
    const int bkv = row >> 9, n = row & 511;
    if (n == 511) s = 0.f;
    if (which == 0) {
      ((h16*)(ws + OFF_KCMP))[((size_t)bkv * 512 + n) * 64 + d] = (h16)s;
    } else {
      const int blk = n >> 6, key = n & 63;
      const int pos = 32 * (key >> 5) + 8 * ((key >> 2) & 3) + 4 * ((key >> 4) & 1) + (key & 3);
      ((h16*)(ws + OFF_VCMPT))[((size_t)(bkv * 8 + blk) * 64 + d) * 64 + pos] = (h16)s;
    }
    __syncthreads();
  }
  const int g = blockIdx.x * NTHREADS + tid;
  if (g < 512) {
    const int b = g >> 8, c = g & 255;
    const float* he = (const float*)(ws + OFF_HEND) + (size_t)b * 256 * 256 + c;
    const float* ae = (const float*)(ws + OFF_AEND) + (size_t)b * 256 * 256 + c;
    float* cy = (float*)(ws + OFF_CARRY) + (size_t)b * 256 * 256 + c;
    float carry = 0.f;
#pragma unroll 1
    for (int k0 = 0; k0 < 256; k0 += 32) {
      float hv[32], av[32];
#pragma unroll
      for (int k = 0; k < 32; ++k) { hv[k] = he[(k0 + k) * 256]; av[k] = ae[(k0 + k) * 256]; }
#pragma unroll
      for (int k = 0; k < 32; ++k) {
        cy[(k0 + k) * 256] = carry;
        carry = hv[k] + av[k] * carry;
      }
    }
  }
}

__device__ __forceinline__ void stage8k(const h16* __restrict__ g, h16* l, int tid) {
  const int r = tid >> 3, cl = (tid & 7) ^ ((r >> 1) & 7);
  glds16(g + r * 64 + cl * 8, l + tid * 8);
}
__device__ __forceinline__ h16x8 ldfrag(const h16* l, int row, int chunk) {
  return *(const h16x8*)(l + row * 64 + ((chunk ^ ((row >> 1) & 7)) * 8));
}

template <int MODE>
__device__ __forceinline__ void attn_branch(const h16* __restrict__ Kg, const h16* __restrict__ Vg, int j0, int j1, h16* ring,
                                            const h16x8 (&qf)[2][2], float (&m)[2], float (&l)[2], f32x4 (&o)[2][4],
                                            const int (&tq)[2], const int (&lim)[2], const int (&tlim)[2], const int (&tfl)[2],
                                            const unsigned long long (&mylo)[2], const unsigned long long (&myhi)[2],
                                            const unsigned long long (&ulo)[2], const unsigned long long (&uhi)[2],
                                            const float (&inv)[2], float* impw) {
  int tid = tidx();
  asm volatile("" : "+v"(tid));
  const int lane = tid & 63;
  const int h = lane >> 4, c = lane & 15, qi = c >> 2, g = c & 3;
  constexpr bool PV = MODE != 0;
  constexpr int SS = 3;
  const int n = j1 - j0 + 1;
  if (n <= 0) return;
  const int nss = (n + SS - 1) / SS;
#pragma unroll
  for (int q = 0; q < SS; ++q)
    if (q < n) {
      stage8k(Kg + (size_t)(j0 + q) * 4096, ring + q * 8192, tid);
      if (PV) stage8k(Vg + (size_t)(j0 + q) * 4096, ring + q * 8192 + 4096, tid);
    }
  int sbase = 0;
  for (int ss = 0; ss < nss; ++ss) {
    VMCNT(0);
    __builtin_amdgcn_s_barrier();
    {
      const int sn = SS - sbase;
#pragma unroll
      for (int q = 0; q < SS; ++q) {
        const int jb = SS * (ss + 1) + q;
        if (jb < n) {
          stage8k(Kg + (size_t)(j0 + jb) * 4096, ring + (sn + q) * 8192, tid);
          if (PV) stage8k(Vg + (size_t)(j0 + jb) * 4096, ring + (sn + q) * 8192 + 4096, tid);
        }
      }
    }
#pragma unroll 1
   for (int sub = 0; sub < SS; ++sub) {
    const int it = SS * ss + sub;
    if (it >= n) break;
    const int j = j0 + it;
    const h16* cK = ring + (sbase + sub) * 8192;
    const h16* cV = cK + 4096;
    bool act[2];
#pragma unroll
    for (int mq = 0; mq < 2; ++mq) {
      if (MODE <= 1) act[mq] = j * 64 <= tlim[mq];
      else if (MODE == 2) act[mq] = ((j < 64 ? (ulo[mq] >> j) : (uhi[mq] >> (j - 64))) & 1ull) != 0ull;
      else act[mq] = (j * 64 <= tlim[mq] + 3) && (j * 64 + 63 > tlim[mq] - 512);
    }
    if (act[0] || act[1]) {
      h16x8 pf[2][2];
      h16x8 kf[4][2];
#pragma unroll
      for (int kt = 0; kt < 4; ++kt)
#pragma unroll
        for (int ks = 0; ks < 2; ++ks) kf[kt][ks] = ldfrag(cK, 16 * kt + c, 4 * ks + h);
#pragma unroll
      for (int mq = 0; mq < 2; ++mq)
        if (act[mq]) {
          f32x4 s[1][4];
          {
#pragma unroll
            for (int kt = 0; kt < 4; ++kt) {
              s[0][kt] = (f32x4){0.f, 0.f, 0.f, 0.f};
#pragma unroll
              for (int ks = 0; ks < 2; ++ks) s[0][kt] = __builtin_amdgcn_mfma_f32_16x16x32_f16(kf[kt][ks], qf[mq][ks], s[0][kt], 0, 0, 0);
            }
          }
          const bool selbit = MODE == 2 ? (((j < 64 ? (mylo[mq] >> j) : (myhi[mq] >> (j - 64))) & 1ull) != 0ull) : true;
          bool interior;
          if (MODE <= 1) interior = j * 64 + 63 <= tfl[mq];
          else if (MODE == 2) interior = j * 64 + 63 <= tfl[mq];
          else interior = (j * 64 + 63 <= tfl[mq]) && (j * 64 > tfl[mq] + 3 - 512);
          if (!interior) {
            const int pbase = j * 64 + 4 * h;
#pragma unroll
            for (int kt = 0; kt < 4; ++kt)
#pragma unroll
              for (int i = 0; i < 4; ++i) {
                const int pos = pbase + 16 * kt + i;
                bool v;
                if (MODE <= 1) v = pos <= lim[mq];
                else if (MODE == 2) v = selbit && pos <= tq[mq];
                else v = pos <= tq[mq] && pos > tq[mq] - 512;
                s[0][kt][i] = v ? s[0][kt][i] : -1e30f;
              }
          }
          const bool rowoff = MODE == 2 && interior && !selbit;
          if (MODE == 1) {
#pragma unroll
            for (int kt = 0; kt < 4; ++kt) {
              float ps = 0.f;
#pragma unroll
              for (int i = 0; i < 4; ++i) {
                const float pv = __builtin_amdgcn_exp2f(s[0][kt][i] - m[mq]) * inv[mq];
                s[0][kt][i] = pv;
                ps += pv;
              }
              ps += __shfl_xor(ps, 1);
              ps += __shfl_xor(ps, 2);
              if (g == 0) impw[(4 * mq + qi) * 128 + j * 16 + kt * 4 + h] = ps;
            }
          } else {
            float bm = fmaxf(fmaxf(fmaxf(s[0][0][0], s[0][0][1]), fmaxf(s[0][0][2], s[0][0][3])), fmaxf(fmaxf(s[0][1][0], s[0][1][1]), fmaxf(s[0][1][2], s[0][1][3])));
            bm = fmaxf(bm, fmaxf(fmaxf(fmaxf(s[0][2][0], s[0][2][1]), fmaxf(s[0][2][2], s[0][2][3])), fmaxf(fmaxf(s[0][3][0], s[0][3][1]), fmaxf(s[0][3][2], s[0][3][3]))));
            bm = rowoff ? -1e30f : bm;
            if (__any(bm > m[mq] + 8.f)) {
              bm = fmaxf(bm, __shfl_xor(bm, 16));
              bm = fmaxf(bm, __shfl_xor(bm, 32));
              const float mn = fmaxf(m[mq], bm);
              const float alpha = __builtin_amdgcn_exp2f(m[mq] - mn);
              l[mq] *= alpha;
              m[mq] = mn;
              if (PV) {
#pragma unroll
                for (int mt = 0; mt < 4; ++mt) o[mq][mt] *= alpha;
              }
            }
            const float mref = (m[mq] > -1e29f && !rowoff) ? m[mq] : 1e30f;
            float ps = 0.f;
#pragma unroll
            for (int kt = 0; kt < 4; ++kt)
#pragma unroll
              for (int i = 0; i < 4; ++i) {
                const float pv = __builtin_amdgcn_exp2f(s[0][kt][i] - mref);
                s[0][kt][i] = pv;
                ps += pv;
              }
            l[mq] += ps;
          }
          if (PV) {
#pragma unroll
            for (int s2 = 0; s2 < 2; ++s2)
#pragma unroll
              for (int i = 0; i < 4; ++i) { pf[mq][s2][i] = (h16)s[0][2 * s2][i]; pf[mq][s2][4 + i] = (h16)s[0][2 * s2 + 1][i]; }
          }
        }
      if (PV) {
        h16x8 vf[4][2];
#pragma unroll
        for (int mt = 0; mt < 4; ++mt)
#pragma unroll
          for (int s2 = 0; s2 < 2; ++s2) vf[mt][s2] = ldfrag(cV, 16 * mt + c, 4 * s2 + h);
#pragma unroll
        for (int mq = 0; mq < 2; ++mq)
          if (act[mq]) {
#pragma unroll
            for (int s2 = 0; s2 < 2; ++s2) {
#pragma unroll
              for (int mt = 0; mt < 4; ++mt) o[mq][mt] = __builtin_amdgcn_mfma_f32_16x16x32_f16(vf[mt][s2], pf[mq][s2], o[mq][mt], 0, 0, 0);
            }
          }
      }
    }
   }
    sbase = SS - sbase;
  }
  __builtin_amdgcn_s_barrier();
}

__device__ __forceinline__ void attn_item(const Params& p, int l, int item, float* sm) {
  unsigned char* ws = p.ws;
  int tid = tidx();
  asm volatile("" : "+v"(tid));
  const int lane = tid & 63, wave = tid >> 6;
  const int combo = item & 3, qt = item >> 2;
  const int b = combo >> 1, kv = combo & 1;
  const int t0 = qt * 64, tw0 = t0 + 8 * wave;
  const int h = lane >> 4, c = lane & 15, qi = c >> 2, g = c & 3;
  const int head = kv * 4 + g, bkv = b * 2 + kv;
  h16* ring = (h16*)sm;
  float* impw = sm + 24576 + wave * 1024;
  unsigned long long* selm = (unsigned long long*)(sm + 24576 + 8192) + wave * 16;

  h16x8 qf[2][2];
  int tq[2];
#pragma unroll
  for (int mq = 0; mq < 2; ++mq) {
    tq[mq] = tw0 + 4 * mq + qi;
    const h16* qrow = (const h16*)(ws + OFF_Q16) + (size_t)(b * S + tq[mq]) * 512 + head * 64;
    qf[mq][0] = *(const h16x8*)(qrow + 8 * h);
    qf[mq][1] = *(const h16x8*)(qrow + 32 + 8 * h);
  }
  for (int i = lane; i < 1024; i += 64) impw[i] = 0.f;

  h16x4 ofin[2][4];
  float m[2], ll[2], inv[2];
  f32x4 o[2][4];
  const unsigned long long z2[2] = {0ull, 0ull};
  {
    int lim[2], tlim[2], tflc[2];
#pragma unroll
    for (int mq = 0; mq < 2; ++mq) {
      lim[mq] = tq[mq] >= 31 ? ((tq[mq] - 31) >> 4) : -1;
      const int tl = tw0 + 4 * mq + 3;
      tlim[mq] = tl >= 31 ? ((tl - 31) >> 4) : -1;
      const int tf0 = tw0 + 4 * mq;
      tflc[mq] = tf0 >= 31 ? ((tf0 - 31) >> 4) : -1;
      m[mq] = -1e30f; ll[mq] = 0.f; inv[mq] = 0.f;
#pragma unroll
      for (int mt = 0; mt < 4; ++mt) o[mq][mt] = (f32x4){0.f, 0.f, 0.f, 0.f};
    }
    const int nl = (t0 + 63 - 31) >> 4;
    const int jl = nl >> 6;
    const h16* Kc = (const h16*)(ws + OFF_KCMP) + (size_t)bkv * 512 * 64;
    const h16* Vc = (const h16*)(ws + OFF_VCMPT) + (size_t)bkv * 8 * 4096;
    attn_branch<0>(Kc, Vc, 0, jl, ring, qf, m, ll, o, tq, lim, tlim, tflc, z2, z2, z2, z2, inv, impw);
#pragma unroll
    for (int mq = 0; mq < 2; ++mq) {
      float lt = ll[mq];
      lt += __shfl_xor(lt, 16);
      lt += __shfl_xor(lt, 32);
      inv[mq] = lt > 0.f ? 1.f / lt : 0.f;
    }
    attn_branch<1>(Kc, Vc, 0, jl, ring, qf, m, ll, o, tq, lim, tlim, tflc, z2, z2, z2, z2, inv, impw);
    const float* gt0 = (const float*)(ws + OFF_GATES) + (size_t)(b * S) * 24 + head * 3;
#pragma unroll
    for (int mq = 0; mq < 2; ++mq) {
      const float g0 = gt0[(size_t)tq[mq] * 24] * ASCALE;
#pragma unroll
      for (int mt = 0; mt < 4; ++mt) ofin[mq][mt] = pack4(o[mq][mt][0] * g0, o[mq][mt][1] * g0, o[mq][mt][2] * g0, o[mq][mt][3] * g0);
    }
  }
  for (int q = 0; q < 8; ++q) {
    const int t = tw0 + q, own = t >> 6;
    const float* ir = impw + q * 128;
    const int ja = lane, jb = lane + 64;
    unsigned k0 = 0u, k1 = 0u;
    if (ja <= own) k0 = (ja == 0 || ja == own) ? (0xFFFFFF80u | (unsigned)(127 - ja)) : (((__float_as_uint(ir[ja]) & ~127u) | (unsigned)(127 - ja)) + 1u);
    if (jb <= own) k1 = (jb == own) ? (0xFFFFFF80u | (unsigned)(127 - jb)) : (((__float_as_uint(ir[jb]) & ~127u) | (unsigned)(127 - jb)) + 1u);
    unsigned thr = 0u;
    for (int bit = 31; bit >= 0; --bit) {
      const unsigned cand = thr | (1u << bit);
      const int cnt = __popcll(__ballot(k0 >= cand)) + __popcll(__ballot(k1 >= cand));
      if (cnt >= 16) thr = cand;
    }
    const unsigned long long mlo = __ballot(k0 >= thr && ja <= own);
    const unsigned long long mhi = __ballot(k1 >= thr && jb <= own);
    if (lane == 0) { selm[q * 2] = mlo; selm[q * 2 + 1] = mhi; }
  }
  unsigned long long mylo[2], myhi[2], ulo[2], uhi[2];
#pragma unroll
  for (int mq = 0; mq < 2; ++mq) {
    mylo[mq] = selm[(4 * mq + qi) * 2];
    myhi[mq] = selm[(4 * mq + qi) * 2 + 1];
    unsigned long long a = selm[(4 * mq) * 2] | selm[(4 * mq + 1) * 2] | selm[(4 * mq + 2) * 2] | selm[(4 * mq + 3) * 2];
    unsigned long long bb = selm[(4 * mq) * 2 + 1] | selm[(4 * mq + 1) * 2 + 1] | selm[(4 * mq + 2) * 2 + 1] | selm[(4 * mq + 3) * 2 + 1];
    ulo[mq] = (unsigned long long)__builtin_amdgcn_readfirstlane((unsigned)a) | ((unsigned long long)__builtin_amdgcn_readfirstlane((unsigned)(a >> 32)) << 32);
    uhi[mq] = (unsigned long long)__builtin_amdgcn_readfirstlane((unsigned)bb) | ((unsigned long long)__builtin_amdgcn_readfirstlane((unsigned)(bb >> 32)) << 32);
  }
  const float* gtb = (const float*)(ws + OFF_GATES) + (size_t)(b * S) * 24 + head * 3;
  {
    int tl0[2] = {0, 0};
    const int tfs[2] = {tw0, tw0 + 4};
#pragma unroll
    for (int mq = 0; mq < 2; ++mq) {
      m[mq] = -1e30f; ll[mq] = 0.f;
#pragma unroll
      for (int mt = 0; mt < 4; ++mt) o[mq][mt] = (f32x4){0.f, 0.f, 0.f, 0.f};
    }
    attn_branch<2>((const h16*)(ws + OFF_KS) + (size_t)bkv * S * 64, (const h16*)(ws + OFF_VST) + (size_t)bkv * 128 * 4096, 0, (t0 + 63) >> 6, ring, qf, m, ll, o,
                   tq, tl0, tl0, tfs, mylo, myhi, ulo, uhi, inv, impw);
#pragma unroll
    for (int mq = 0; mq < 2; ++mq) {
      float lt = ll[mq];
      lt += __shfl_xor(lt, 16);
      lt += __shfl_xor(lt, 32);
      const float sc = lt > 0.f ? gtb[(size_t)tq[mq] * 24 + 1] * ASCALE / lt : 0.f;
#pragma unroll
      for (int mt = 0; mt < 4; ++mt)
        ofin[mq][mt] = pack4((float)ofin[mq][mt][0] + o[mq][mt][0] * sc, (float)ofin[mq][mt][1] + o[mq][mt][1] * sc, (float)ofin[mq][mt][2] + o[mq][mt][2] * sc,
                             (float)ofin[mq][mt][3] + o[mq][mt][3] * sc);
    }
  }
  {
    int tl0[2] = {0, 0}, tf[2];
#pragma unroll
    for (int mq = 0; mq < 2; ++mq) {
      tf[mq] = tw0 + 4 * mq;
      m[mq] = -1e30f; ll[mq] = 0.f;
#pragma unroll
      for (int mt = 0; mt < 4; ++mt) o[mq][mt] = (f32x4){0.f, 0.f, 0.f, 0.f};
    }
    const int jlo = t0 >= 511 ? ((t0 - 511) >> 6) : 0;
    attn_branch<3>((const h16*)(ws + OFF_KW) + (size_t)bkv * S * 64, (const h16*)(ws + OFF_VWT) + (size_t)bkv * 128 * 4096, jlo, (t0 + 63) >> 6, ring, qf, m, ll, o,
                   tq, tl0, tf, tf, z2, z2, z2, z2, inv, impw);
#pragma unroll
    for (int mq = 0; mq < 2; ++mq) {
      float lt = ll[mq];
      lt += __shfl_xor(lt, 16);
      lt += __shfl_xor(lt, 32);
      const float sc = lt > 0.f ? gtb[(size_t)tq[mq] * 24 + 2] * ASCALE / lt : 0.f;
#pragma unroll
      for (int mt = 0; mt < 4; ++mt)
        ofin[mq][mt] = pack4((float)ofin[mq][mt][0] + o[mq][mt][0] * sc, (float)ofin[mq][mt][1] + o[mq][mt][1] * sc, (float)ofin[mq][mt][2] + o[mq][mt][2] * sc,
                             (float)ofin[mq][mt][3] + o[mq][mt][3] * sc);
    }
  }
  {
    h16* yc = (h16*)(ws + OFF_H16);
    const float* gn = p.in[I_ONG] + l * 1024 + 256 + head * 64;
    float* ssq = (float*)(ws + OFF_SSQ);
#pragma unroll
    for (int mq = 0; mq < 2; ++mq) {
      float sq = 0.f;
      h16* yr = yc + (size_t)(b * S + tq[mq]) * D + head * 64;
#pragma unroll
      for (int mt = 0; mt < 4; ++mt) {
        const float v[4] = {(float)ofin[mq][mt][0], (float)ofin[mq][mt][1], (float)ofin[mq][mt][2], (float)ofin[mq][mt][3]};
        sq += v[0] * v[0] + v[1] * v[1] + v[2] * v[2] + v[3] * v[3];
        const float4 gg = *(const float4*)(gn + 16 * mt + 4 * h);
        *(h16x4*)(yr + 16 * mt + 4 * h) = pack4(v[0] * gg.x, v[1] * gg.y, v[2] * gg.z, v[3] * gg.w);
      }
      sq += __shfl_xor(sq, 16);
      sq += __shfl_xor(sq, 32);
      sq += __shfl_xor(sq, 1);
      sq += __shfl_xor(sq, 2);
      if (h == 0 && g == 0) ssq[(size_t)(b * S + tq[mq]) * 2 + kv] = sq * (1.f / (ASCALE * ASCALE));
    }
  }
}

__device__ __forceinline__ void lrufix_item(const Params& p, int l, int item) {
  unsigned char* ws = p.ws;
  const int lane = tidx() & 63, wave = tidx() >> 6;
  const int b = item >> 7, ck = item & 127;
  const h16* P = (const h16*)(ws + OFF_P16);
  const float4 cy = *(const float4*)((const float*)(ws + OFF_CARRY) + (size_t)(b * 256 + ck * 2 + (wave >> 2)) * 256 + lane * 4);
  const float4 gn = *(const float4*)(p.in[I_ONG] + l * 1024 + lane * 4);
  h16* yc = (h16*)(ws + OFF_H16);
  for (int tt = wave * 8; tt < wave * 8 + 8; ++tt) {
    const size_t row = (size_t)(b * S + ck * 64 + tt);
    const float4 hl = *(const float4*)((const float*)(ws + OFF_LRUH) + row * 256 + lane * 4);
    const float4 al = *(const float4*)((const float*)(ws + OFF_LRUA) + row * 256 + lane * 4);
    const h16x4 gl = *(const h16x4*)(P + row * NIN + C_GL + lane * 4);
    const float y0 = (hl.x + al.x * cy.x) * gelu_tanh((float)gl[0]);
    const float y1 = (hl.y + al.y * cy.y) * gelu_tanh((float)gl[1]);
    const float y2 = (hl.z + al.z * cy.z) * gelu_tanh((float)gl[2]);
    const float y3 = (hl.w + al.w * cy.w) * gelu_tanh((float)gl[3]);
    const float rstd = rsqrtf(wsum(y0 * y0 + y1 * y1 + y2 * y2 + y3 * y3) * (1.f / 256.f) + EPS);
    *(h16x4*)(yc + row * D + 512 + lane * 4) = pack4(y0 * rstd * gn.x, y1 * rstd * gn.y, y2 * rstd * gn.z, y3 * rstd * gn.w);
  }
}

__device__ __forceinline__ void phase_attn(const Params& p, int l, float* sm) {
  for (int it = blockIdx.x; it < 256; it += gridDim.x) {
#pragma unroll 1
    for (int rep = 0; rep < 2; ++rep) attn_item(p, l, rep ? (127 - (it >> 2)) * 4 + (it & 3) : it, sm);
  }
  for (int it = blockIdx.x; it < 256; it += gridDim.x) lrufix_item(p, l, it);
}

__device__ __forceinline__ void phase_outproj(const Params& p, int l, h16* sm) {
  unsigned char* ws = p.ws;
  const h16* A = (const h16*)(ws + OFF_H16);
  const h16* W = (const h16*)(ws + OFF_WOUT);
  const float* mod = (const float*)(ws + OFF_MOD);
  float* xa = (float*)(ws + OFF_XA);
  const float* xin = l == 0 ? p.in[I_X] : (const float*)xa;
  const TileIter ti = xcd_tiles(64 * 4);
  for (int t = ti.cur; t < ti.end; t += ti.step) {
    const int mt = t >> 2, nt = t & 3;
    f32x4 acc[8][4];
    const h16* Ab = A + (size_t)mt * 256 * D;
    {
      float* sct = (float*)((unsigned char*)sm + SCHED_OFF - 1024);
      const int tq_ = tidx();
      if (tq_ < 256) {
        const float2 q2 = *(const float2*)((const float*)(ws + OFF_SSQ) + (size_t)(mt * 256 + tq_) * 2);
        sct[tq_] = rsqrtf((q2.x + q2.y) * (1.f / 512.f) + EPS) * (1.f / ASCALE);
      }
    }
    gemm_mainloop<256>(acc, [&](int r) { return Ab + (size_t)r * D; }, W + (size_t)nt * 256 * D, D, 8, sm);
    const int tid_e = tidx(), lane = tid_e & 63, wave = tid_e >> 6, wr = wave >> 2, wc = wave & 3, fr = lane & 15, fq = lane >> 4;
    {
      const float* sct = (const float*)((const unsigned char*)sm + SCHED_OFF - 1024) + wr * 128 + fr;
#pragma unroll
      for (int m = 0; m < 8; ++m) {
        const float sc = sct[m * 16];
#pragma unroll
        for (int n = 0; n < 4; ++n) acc[m][n] *= sc;
      }
    }
    gemm_mainloop<256>(acc, [&](int r) { return Ab + (size_t)r * D + 512; }, W + (size_t)nt * 256 * D + 512, D, 8, sm, false);
    {
      float* stf = (float*)sm;
      constexpr int LDF = 260;
#pragma unroll 1
      for (int pass = 0; pass < 2; ++pass) {
        if (wr == pass) {
#pragma unroll
          for (int m = 0; m < 8; ++m)
#pragma unroll
            for (int n = 0; n < 4; ++n) *(f32x4*)(stf + (m * 16 + fr) * LDF + wc * 64 + n * 16 + 4 * fq) = acc[m][n];
        }
        __syncthreads();
#pragma unroll 4
        for (int i = 0; i < 16; ++i) {
          const int idx = i * NTHREADS + tid_e;
          const int r = idx >> 6, c4 = (idx & 63) * 4;
          const int row = mt * 256 + pass * 128 + r, col = nt * 256 + c4;
          const int b = row >> 13;
          const f32x4 a = *(const f32x4*)(stf + r * LDF + c4);
          const float4 g1 = *(const float4*)(mod + (size_t)(l * 2 + b) * 6144 + 2048 + col);
          const float4 xv = *(const float4*)(xin + (size_t)row * D + col);
          float4 o;
          o.x = xv.x + g1.x * a[0]; o.y = xv.y + g1.y * a[1]; o.z = xv.z + g1.z * a[2]; o.w = xv.w + g1.w * a[3];
          *(float4*)(xa + (size_t)row * D + col) = o;
        }
        __syncthreads();
      }
    }
  }
}

__device__ __forceinline__ void phase_router(const Params& p, int l, int* smi) {
  unsigned char* ws = p.ws;
  const int tid = tidx(), lane = tid & 63, wave = tid >> 6;
  const float* mod = (const float*)(ws + OFF_MOD);
  const float* xa = (const float*)(ws + OFF_XA);
  h16* hout = (h16*)(ws + OFF_H16);
  unsigned* cnt = (unsigned*)(ws + OFF_CTL) + 64 + l * 16;
  int* list = (int*)(ws + OFF_LIST);
  float* wpair = (float*)(ws + OFF_WPAIR);
  const float* rgb = p.in[I_RGB] + l * 4;
  int* cntl = smi;
  int* basel = smi + 16;
  int* tok = smi + 32;
  float* wl = (float*)smi + 256;
  {
    const float4* s0 = (const float4*)(p.in[I_RGW] + (size_t)l * 1024 * 4);
    const float4* s1 = (const float4*)(p.in[I_REW] + (size_t)l * 4 * 1024 * 4);
    float4* d = (float4*)wl;
#pragma unroll
    for (int q = 0; q < 2; ++q) d[q * NTHREADS + tid] = s0[q * NTHREADS + tid];
#pragma unroll
    for (int q = 0; q < 8; ++q) d[1024 + q * NTHREADS + tid] = s1[q * NTHREADS + tid];
  }
  const float* rgw = wl;
  for (int chunk = blockIdx.x; chunk < T / 64; chunk += gridDim.x) {
    if (tid < 16) cntl[tid] = 0;
    __syncthreads();
    float4 xn[4];
#pragma unroll
    for (int i = 0; i < 4; ++i) xn[i] = *(const float4*)(xa + (size_t)(chunk * 64 + wave) * D + lane * 4 + 256 * i);
    for (int ti = wave; ti < 64; ti += NW) {
      const int row = chunk * 64 + ti;
      const int b = row >> 13;
      float4 x[4];
      float ss = 0.f;
#pragma unroll
      for (int i = 0; i < 4; ++i) x[i] = xn[i];
      if (ti + NW < 64) {
#pragma unroll
        for (int i = 0; i < 4; ++i) xn[i] = *(const float4*)(xa + (size_t)(row + NW) * D + lane * 4 + 256 * i);
      }
#pragma unroll
      for (int i = 0; i < 4; ++i) ss += x[i].x * x[i].x + x[i].y * x[i].y + x[i].z * x[i].z + x[i].w * x[i].w;
      ss = wsum(ss);
      const float rstd = rsqrtf(ss * (1.f / D) + EPS);
      float lg0 = 0.f, lg1 = 0.f, lg2 = 0.f, lg3 = 0.f;
#pragma unroll
      for (int i = 0; i < 4; ++i) {
        const int col = lane * 4 + 256 * i;
        const float4 g = *(const float4*)(p.in[I_N2G] + l * D + col);
        const float4 sh = *(const float4*)(mod + (size_t)(l * 2 + b) * 6144 + 3072 + col);
        const float4 sc = *(const float4*)(mod + (size_t)(l * 2 + b) * 6144 + 4096 + col);
        x[i].x = x[i].x * rstd * g.x * (1.f + sc.x) + sh.x;
        x[i].y = x[i].y * rstd * g.y * (1.f + sc.y) + sh.y;
        x[i].z = x[i].z * rstd * g.z * (1.f + sc.z) + sh.z;
        x[i].w = x[i].w * rstd * g.w * (1.f + sc.w) + sh.w;
        *(h16x4*)(hout + (size_t)row * D + col) = pack4(x[i].x, x[i].y, x[i].z, x[i].w);
        const float4 w0 = *(const float4*)(rgw + (size_t)(col + 0) * 4), w1 = *(const float4*)(rgw + (size_t)(col + 1) * 4);
        const float4 w2 = *(const float4*)(rgw + (size_t)(col + 2) * 4), w3 = *(const float4*)(rgw + (size_t)(col + 3) * 4);
        lg0 += x[i].x * w0.x + x[i].y * w1.x + x[i].z * w2.x + x[i].w * w3.x;
        lg1 += x[i].x * w0.y + x[i].y * w1.y + x[i].z * w2.y + x[i].w * w3.y;
        lg2 += x[i].x * w0.z + x[i].y * w1.z + x[i].z * w2.z + x[i].w * w3.z;
        lg3 += x[i].x * w0.w + x[i].y * w1.w + x[i].z * w2.w + x[i].w * w3.w;
      }
      lg0 = wsum(lg0) + rgb[0]; lg1 = wsum(lg1) + rgb[1]; lg2 = wsum(lg2) + rgb[2]; lg3 = wsum(lg3) + rgb[3];
      int gs = 0; float gm = lg0;
      if (lg1 > gm) { gm = lg1; gs = 1; }
      if (lg2 > gm) { gm = lg2; gs = 2; }
      if (lg3 > gm) { gm = lg3; gs = 3; }
      const float pg = 1.f / (__expf(lg0 - gm) + __expf(lg1 - gm) + __expf(lg2 - gm) + __expf(lg3 - gm));
      const float* rew = wl + 4096 + gs * 4096;
      const float* reb = p.in[I_REB] + (l * 4 + gs) * 4;
      float e0 = 0.f, e1 = 0.f, e2 = 0.f, e3 = 0.f;
#pragma unroll
      for (int i = 0; i < 4; ++i) {
        const int col = lane * 4 + 256 * i;
        const float4 w0 = *(const float4*)(rew + (size_t)(col + 0) * 4), w1 = *(const float4*)(rew + (size_t)(col + 1) * 4);
        const float4 w2 = *(const float4*)(rew + (size_t)(col + 2) * 4), w3 = *(const float4*)(rew + (size_t)(col + 3) * 4);
        e0 += x[i].x * w0.x + x[i].y * w1.x + x[i].z * w2.x + x[i].w * w3.x;
        e1 += x[i].x * w0.y + x[i].y * w1.y + x[i].z * w2.y + x[i].w * w3.y;
        e2 += x[i].x * w0.z + x[i].y * w1.z + x[i].z * w2.z + x[i].w * w3.z;
        e3 += x[i].x * w0.w + x[i].y * w1.w + x[i].z * w2.w + x[i].w * w3.w;
      }
      float le[4];
      le[0] = wsum(e0) + reb[0]; le[1] = wsum(e1) + reb[1]; le[2] = wsum(e2) + reb[2]; le[3] = wsum(e3) + reb[3];
      int i0 = 0; float v0 = le[0];
      if (le[1] > v0) { v0 = le[1]; i0 = 1; }
      if (le[2] > v0) { v0 = le[2]; i0 = 2; }
      if (le[3] > v0) { v0 = le[3]; i0 = 3; }
      int i1 = -1; float v1 = -3.0e38f;
#pragma unroll
      for (int j = 0; j < 4; ++j) {
        const float vj = (j == 0 ? le[0] : j == 1 ? le[1] : j == 2 ? le[2] : le[3]);
        if (j != i0 && vj > v1) { v1 = vj; i1 = j; }
      }
      const float p0 = 1.f / (1.f + __expf(v1 - v0));
      const float p1 = 1.f - p0;
      if (lane == 0) {
        const int ea = gs * 4 + i0, eb = gs * 4 + i1;
        const int ra = atomicAdd(&cntl[ea], 1);
        const int rb = atomicAdd(&cntl[eb], 1);
        tok[ti * 2] = ea | (ra << 8);
        tok[ti * 2 + 1] = eb | (rb << 8);
        wpair[row * 2] = pg * p0;
        wpair[row * 2 + 1] = pg * p1;
      }
    }
    __syncthreads();
    if (tid < 16) basel[tid] = (int)atomicAdd(&cnt[tid], (unsigned)cntl[tid]);
    __syncthreads();
    if (tid < 128) {
      const int v = tok[tid], e = v & 255, r = v >> 8;
      list[(size_t)e * 16384 + basel[e] + r] = (chunk * 64 + (tid >> 1)) * 2 + (tid & 1);
    }
    __syncthreads();
  }
}

__device__ __forceinline__ void moe_sched(const Params& p, int l, int* sl) {
  if (tidx() == 0) {
    const unsigned* cnt = (const unsigned*)(p.ws + OFF_CTL) + 64 + l * 16;
    int to = 0, ro = 0;
    sl[16] = 0; sl[33] = 0;
    for (int e = 0; e < 16; ++e) {
      const int c = (int)__hip_atomic_load(&cnt[e], __ATOMIC_RELAXED, __HIP_MEMORY_SCOPE_AGENT);
      sl[e] = c;
      to += (c + 255) >> 8; ro += c;
      sl[17 + e] = to; sl[34 + e] = ro;
    }
  }
  __syncthreads();
}
__device__ __forceinline__ void moe_tile(const int* sl, int t, int& e, int& nt, int& mt, int& cnt_e, int& roff_e) {
  int ee = 0;
  for (int k = 0; k < 15; ++k) ee += (t >= sl[17 + k] * 4) ? 1 : 0;
  ee = __builtin_amdgcn_readfirstlane(ee);
  const int t0 = __builtin_amdgcn_readfirstlane(sl[16 + ee]), t1 = __builtin_amdgcn_readfirstlane(sl[17 + ee]);
  const int nte = t1 - t0, rem = t - t0 * 4;
  e = ee; nt = rem / nte; mt = rem % nte;
  cnt_e = __builtin_amdgcn_readfirstlane(sl[ee]);
  roff_e = __builtin_amdgcn_readfirstlane(sl[33 + ee]);
}

template <int BN>
__device__ __forceinline__ void moe1_tile(const Params& p, h16* sm, const int* sl, int t, int half) {
  unsigned char* ws = p.ws;
  const h16* H = (const h16*)(ws + OFF_H16);
  h16* hid = (h16*)(ws + OFF_HID);
  int e, nt, mt, cnt_e, roff_e;
  moe_tile(sl, t, e, nt, mt, cnt_e, roff_e);
  const int* le = (const int*)(ws + OFF_LIST) + (size_t)e * 16384;
  f32x4 acc[8][BN / 64];
  gemm_mainloop<BN>(acc, [&](int r) { int so = mt * 256 + r; so = so < cnt_e ? so : 0; return H + (size_t)(le[so] >> 1) * D; },
                    (const h16*)(ws + OFF_WGU) + ((size_t)e * 1024 + nt * 256 + half * 128) * 1024, 1024, 16, sm);
  const int tid_e = tidx(), lane = tid_e & 63, wave = tid_e >> 6, wr = wave >> 2, wc = wave & 3, fr = lane & 15, fq = lane >> 4;
  constexpr int NC = BN / 2, LDR = NC + 8;
#pragma unroll
  for (int m = 0; m < 8; ++m)
#pragma unroll
    for (int n2 = 0; n2 < BN / 128; ++n2) {
      const f32x4 gt = acc[m][2 * n2], up = acc[m][2 * n2 + 1];
      *(h16x4*)(sm + (wr * 128 + m * 16 + fr) * LDR + wc * (BN / 8) + n2 * 16 + 4 * fq) =
          pack4(silu_f(gt[0]) * up[0], silu_f(gt[1]) * up[1], silu_f(gt[2]) * up[2], silu_f(gt[3]) * up[3]);
    }
  __syncthreads();
  constexpr int CH = NC / 8;
#pragma unroll
  for (int i = 0; i < CH / 2; ++i) {
    const int idx = i * NTHREADS + tid_e;
    const int r = idx / CH, c8 = idx % CH;
    const int so = mt * 256 + r;
    if (so < cnt_e) *(h16x8*)(hid + (size_t)(roff_e + so) * 512 + nt * 128 + half * 64 + c8 * 8) = *(const h16x8*)(sm + r * LDR + c8 * 8);
  }
  __syncthreads();
}
__device__ __forceinline__ void phase_moe1(const Params& p, int l, h16* sm) {
  int* sl = (int*)((unsigned char*)sm + SCHED_OFF);
  moe_sched(p, l, sl);
  const int total = __builtin_amdgcn_readfirstlane(sl[32]) * 4;
  const TileSched ts = xcd_sched(total);
  for (int t = ts.cur; t < ts.end; t += ts.step) moe1_tile<256>(p, sm, sl, t, 0);
  if (ts.tail_tile >= 0) {
    if (ts.tail_half < 0) moe1_tile<256>(p, sm, sl, ts.tail_tile, 0);
    else moe1_tile<128>(p, sm, sl, ts.tail_tile, ts.tail_half);
  }
}

template <int BN>
__device__ __forceinline__ void moe2_tile(const Params& p, h16* sm, const int* sl, int t, int half) {
  unsigned char* ws = p.ws;
  const float* wpair = (const float*)(ws + OFF_WPAIR);
  h16* yp = (h16*)(ws + OFF_YPAIR);
  int e, nt, mt, cnt_e, roff_e;
  moe_tile(sl, t, e, nt, mt, cnt_e, roff_e);
  const int* le = (const int*)(ws + OFF_LIST) + (size_t)e * 16384;
  const h16* Ab = (const h16*)(ws + OFF_HID) + (size_t)(roff_e + mt * 256) * 512;
  f32x4 acc[8][BN / 64];
  gemm_mainloop<BN>(acc, [&](int r) { return Ab + (size_t)r * 512; }, (const h16*)(ws + OFF_WDN) + ((size_t)e * 1024 + nt * 256 + half * 128) * 512, 512, 8, sm);
  const int tid_e = tidx(), lane = tid_e & 63, wave = tid_e >> 6, wr = wave >> 2, wc = wave & 3, fr = lane & 15, fq = lane >> 4;
  constexpr int LDR = BN + 8;
#pragma unroll
  for (int m = 0; m < 8; ++m) {
    const int so = mt * 256 + wr * 128 + m * 16 + fr;
    const float w = so < cnt_e ? wpair[le[so]] : 0.f;
#pragma unroll
    for (int n = 0; n < BN / 64; ++n)
      *(h16x4*)(sm + (wr * 128 + m * 16 + fr) * LDR + wc * (BN / 4) + n * 16 + 4 * fq) = pack4(acc[m][n][0] * w, acc[m][n][1] * w, acc[m][n][2] * w, acc[m][n][3] * w);
  }
  __syncthreads();
  constexpr int CH = BN / 8;
#pragma unroll
  for (int i = 0; i < CH / 2; ++i) {
    const int idx = i * NTHREADS + tid_e;
    const int r = idx / CH, c8 = idx % CH;
    const int so = mt * 256 + r;
    if (so < cnt_e) *(h16x8*)(yp + (size_t)le[so] * D + nt * 256 + half * 128 + c8 * 8) = *(const h16x8*)(sm + r * LDR + c8 * 8);
  }
  __syncthreads();
}
__device__ __forceinline__ void phase_moe2(const Params& p, int l, h16* sm) {
  int* sl = (int*)((unsigned char*)sm + SCHED_OFF);
  moe_sched(p, l, sl);
  const int total = __builtin_amdgcn_readfirstlane(sl[32]) * 4;
  const TileSched ts = xcd_sched(total);
  for (int t = ts.cur; t < ts.end; t += ts.step) moe2_tile<256>(p, sm, sl, t, 0);
  if (ts.tail_tile >= 0) {
    if (ts.tail_half < 0) moe2_tile<256>(p, sm, sl, ts.tail_tile, 0);
    else moe2_tile<128>(p, sm, sl, ts.tail_tile, ts.tail_half);
  }
}

#define XB_TMO      128
#define XB_XCNT(j)  (256  + 64 * (j))
#define XB_XSUB(j)  (1280 + 64 * (j))
#define XB_XGEN(j)  (2304 + 64 * (j))
#define XB_TOP      3328
#define XB_TOPGEN   3392
#define XCD_BAR_WORDS 3456
#define XB_SPIN_CAP (1u << 20)
__device__ __forceinline__ unsigned xb_ld(unsigned* p) { return __hip_atomic_load(p, __ATOMIC_RELAXED, __HIP_MEMORY_SCOPE_AGENT); }
__device__ __forceinline__ unsigned xb_add(unsigned* p, unsigned v) { return __hip_atomic_fetch_add(p, v, __ATOMIC_RELAXED, __HIP_MEMORY_SCOPE_AGENT); }
__device__ __forceinline__ unsigned xb_xcc_id() { return (unsigned)__builtin_amdgcn_s_getreg((3 << 11) | 20) & 0xFu; }
#define XB_SPIN(cond, bar) do { unsigned _sp = 0; while (cond) { __builtin_amdgcn_s_sleep(1); \
    if ((++_sp & 255u) == 0u) { if (xb_ld(&(bar)[XB_TMO])) break; if (_sp > XB_SPIN_CAP) { atomicAdd(&(bar)[XB_TMO], 1u); break; } } } } while (0)
struct XBar { unsigned* bar; unsigned x; volatile unsigned* st; };
__device__ __forceinline__ void xbar_post(XBar& b, unsigned* bar, volatile unsigned* st) {
  b.bar = bar; b.x = xb_xcc_id(); b.st = st;
  if (tidx() == 0) { st[0] = 0u; st[1] = 0u; (void)xb_add(&bar[XB_XCNT(b.x)], 1u); }
}
__device__ __forceinline__ void xbar_census(unsigned* bar, unsigned x, unsigned& nloc, unsigned& nx) {
  const unsigned G = gridDim.x;
  unsigned sum, cnt, mine, sp = 0u;
  for (;;) {
    sum = 0u; cnt = 0u; mine = 0u;
#pragma unroll
    for (unsigned j = 0; j < 16; ++j) { const unsigned c = xb_ld(&bar[XB_XCNT(j)]); sum += c; cnt += (c > 0u) ? 1u : 0u; mine = (j == x) ? c : mine; }
    if (sum == G) break;
    __builtin_amdgcn_s_sleep(1);
    if ((++sp & 255u) == 0u) { if (xb_ld(&bar[XB_TMO])) break; if (sp > XB_SPIN_CAP) { atomicAdd(&bar[XB_TMO], 1u); break; } }
  }
  nloc = mine > 0u ? mine : 1u; nx = cnt > 0u ? cnt : 1u;
}
__device__ __forceinline__ void xbar_sync(XBar& b) {
  asm volatile("s_waitcnt vmcnt(0)" ::: "memory");
  __syncthreads();
  if (tidx() == 0) {
    unsigned* bar = b.bar;
    __builtin_amdgcn_s_waitcnt(0);
    unsigned nloc = b.st[0], nx = b.st[1];
    if (nloc == 0u) { xbar_census(bar, b.x, nloc, nx); b.st[0] = nloc; b.st[1] = nx; }
    const unsigned old = xb_add(&bar[XB_XSUB(b.x)], 1u);
    const unsigned gen = old / nloc;
    if (old + 1u == (gen + 1u) * nloc) {
      __builtin_amdgcn_fence(__ATOMIC_RELEASE, "agent");
      asm volatile("s_waitcnt vmcnt(0)" ::: "memory");
      const unsigned og = xb_add(&bar[XB_TOP], 1u);
      const unsigned tg = og / nx;
      if (og + 1u == (tg + 1u) * nx) xb_add(&bar[XB_TOPGEN], 1u);
      else XB_SPIN(xb_ld(&bar[XB_TOPGEN]) == tg, bar);
      __builtin_amdgcn_fence(__ATOMIC_ACQUIRE, "agent");
      xb_add(&bar[XB_XGEN(b.x)], 1u);
      asm volatile("s_waitcnt vmcnt(0)" ::: "memory");
    } else {
      XB_SPIN(xb_ld(&bar[XB_XGEN(b.x)]) == gen, bar);
      __builtin_amdgcn_fence(__ATOMIC_ACQUIRE, "agent");
      asm volatile("s_waitcnt vmcnt(0)" ::: "memory");
    }
  }
  __syncthreads();
}

constexpr int NSTEPS = 22;
#define STEP(k, body) do { if (s_lo <= (k) && (k) < s_hi) { body; if ((k) + 1 < s_hi) { xbar_sync(xb); } \
    if (PROBE_MASK != 0u) { unsigned long long now_ = __builtin_amdgcn_s_memrealtime(); \
      if ((PROBE_MASK >> (k)) & 1u) { const unsigned long long w_ = (now_ - pt_prev) * PROBE_AMP; \
        while (__builtin_amdgcn_s_memrealtime() - now_ < w_) __builtin_amdgcn_s_sleep(8); now_ = __builtin_amdgcn_s_memrealtime(); } \
      pt_prev = now_; } } } while (0)
#define LAYER_STEPS(l, base) \
  STEP(base + 0, phase_norm1(p, l); if (l == 1) phase_convert(p, 1, (float*)smem)); \
  STEP(base + 1, phase_inproj(p, (h16*)smem)); \
  STEP(base + 2, phase_post(p)); \
  STEP(base + 3, phase_mixa(p, l, smem)); \
  STEP(base + 4, phase_mixb(p, l, (float*)smem)); \
  STEP(base + 5, phase_attn(p, l, (float*)smem)); \
  STEP(base + 6, phase_outproj(p, l, (h16*)smem)); \
  STEP(base + 7, phase_router(p, l, (int*)smem)); \
  STEP(base + 8, phase_moe1(p, l, (h16*)smem)); \
  STEP(base + 9, phase_moe2(p, l, (h16*)smem))

__global__ void __launch_bounds__(NTHREADS, 2) mega(Params p, int s_lo, int s_hi) {
  extern __shared__ __attribute__((aligned(16))) unsigned char smem[];
  unsigned long long pt_prev = PROBE_MASK != 0u ? __builtin_amdgcn_s_memrealtime() : 0ull;
  XBar xb;
  xbar_post(xb, (unsigned*)(p.ws + OFF_BAR), (volatile unsigned*)(smem + LDS_BYTES - 16));
  STEP(0, phase_prep(p, (float*)smem); phase_convert(p, 0, (float*)smem));
  LAYER_STEPS(0, 1);
  LAYER_STEPS(1, 11);
  STEP(21, phase_norm1(p, 2));
}

extern "C" void kernel_launch(void* const* d_in, const int* in_sizes, int n_in, void* d_out, int out_size, void* d_ws, size_t ws_size,
                              hipStream_t stream) {
  static int grid_blocks = 0;
  if (!grid_blocks) {
    if (n_in != 35 || out_size != T * D || ws_size < WS_TOTAL) {
      fprintf(stderr, "kernel_launch: unexpected problem (n_in %d, out %d, ws %zu < %zu)\n", n_in, out_size, ws_size, (size_t)WS_TOTAL);
      grid_blocks = -1;
      return;
    }
    int dev = 0, cus = 0, per_cu = 0;
    hipGetDevice(&dev);
    hipDeviceGetAttribute(&cus, hipDeviceAttributeMultiprocessorCount, dev);
    if (hipFuncSetAttribute((const void*)mega, hipFuncAttributeMaxDynamicSharedMemorySize, LDS_BYTES) != hipSuccess) {
      fprintf(stderr, "kernel_launch: hipFuncSetAttribute(%d B dynamic LDS) failed\n", LDS_BYTES);
      grid_blocks = -1;
      return;
    }
    hipOccupancyMaxActiveBlocksPerMultiprocessor(&per_cu, mega, NTHREADS, LDS_BYTES);
    if (per_cu > 1) per_cu = 1;
    if (per_cu < 1) { fprintf(stderr, "kernel_launch: occupancy query returned %d\n", per_cu); grid_blocks = -1; return; }
    grid_blocks = cus * per_cu;
  }
  if (grid_blocks < 0) return;
  Params p{};
  for (int i = 0; i < 35; ++i) p.in[i] = (const float*)d_in[i];
  p.out = (float*)d_out;
  p.ws = (unsigned char*)d_ws;
  for (int i = 0; i < 32; ++i) p.inv_freq[i] = std::pow(10000.0, -(double)(2 * i) / 64.0);
  if (hipMemsetAsync((char*)d_ws + OFF_BAR, 0, 16384, stream) != hipSuccess) { fprintf(stderr, "kernel_launch: memset of barrier words failed\n"); return; }
#if MEGA
  int lo = 0, hi = NSTEPS;
  void* args[] = {&p, &lo, &hi};
  hipError_t e = hipLaunchCooperativeKernel((void*)mega, dim3(grid_blocks), dim3(NTHREADS), args, LDS_BYTES, stream);
  if (e != hipSuccess) fprintf(stderr, "cooperative launch failed: %s (grid %d)\n", hipGetErrorString(e), grid_blocks);
#else
  for (int s = 0; s < NSTEPS; ++s) {
    int lo = s, hi = s + 1;
    void* args[] = {&p, &lo, &hi};
    hipError_t e = hipLaunchCooperativeKernel((void*)mega, dim3(grid_blocks), dim3(NTHREADS), args, LDS_BYTES, stream);
    if (e != hipSuccess) { fprintf(stderr, "launch %d failed: %s (grid %d)\n", s, hipGetErrorString(e), grid_blocks); break; }
  }
#endif
}
```

```cpp
#include <hip/hip_runtime.h>
#include <hip/hip_cooperative_groups.h>
#include <cstdio>
#include <cstdint>
#include <cmath>
namespace cg = cooperative_groups;

#ifndef MEGA
#define MEGA 1
#endif
#ifndef PROBE_MASK
#define PROBE_MASK 0u
#define PROBE_AMP 3
#endif

typedef _Float16 h16;
typedef _Float16 h16x8 __attribute__((ext_vector_type(8)));
typedef _Float16 h16x4 __attribute__((ext_vector_type(4)));
typedef float f32x4 __attribute__((ext_vector_type(4)));

constexpr int NB = 2, S = 8192, T = NB * S, D = 1024;
constexpr int NIN = 2432;
constexpr int NINSRC = 2328;
constexpr int C_XL = 0, C_GL = 256, C_Q = 512, C_KC = 1024, C_VC = 1152, C_KS = 1280, C_VS = 1408, C_KW = 1536, C_VW = 1664,
              C_CVA = 1792, C_CVB = 2048, C_GATE = 2304;
constexpr float EPS = 1e-6f;
constexpr int NTHREADS = 512, NW = 8;
constexpr int LDS_BYTES = 147456;
constexpr int NINP = 2560;
constexpr int SCHED_OFF = LDS_BYTES - 1024;
constexpr float ASCALE = 16.f;

constexpr size_t al256(size_t x) { return (x + 255) & ~(size_t)255; }
constexpr size_t OFF_CTL = 0;
constexpr size_t OFF_BAR = 4096;
constexpr size_t OFF_MOD = 4096 + 16384;
constexpr size_t OFF_ROPE = al256(OFF_MOD + 2 * 2 * 6144 * 4);
constexpr size_t OFF_PB = al256(OFF_ROPE + (size_t)T * 64 * 4);
constexpr size_t OFF_PBPART = al256(OFF_PB + 2 * 256 * 4);
constexpr size_t OFF_LRUW = al256(OFF_PBPART + 2 * 32 * 256 * 4);
constexpr size_t OFF_GATES = al256(OFF_LRUW + 2 * 4 * 64 * 64 * 2);
constexpr size_t OFF_WIN = al256(OFF_GATES + (size_t)T * 24 * 4);
constexpr size_t OFF_WOUT = al256(OFF_WIN + (size_t)NINP * 1024 * 2);
constexpr size_t OFF_WGU = al256(OFF_WOUT + (size_t)1024 * 1024 * 2);
constexpr size_t OFF_WDN = al256(OFF_WGU + (size_t)16 * 1024 * 1024 * 2);
constexpr size_t OFF_W1K = al256(OFF_WDN + (size_t)16 * 1024 * 512 * 2);
constexpr size_t OFF_W1V = al256(OFF_W1K + (size_t)256 * 2048 * 2);
constexpr size_t OFF_H16 = al256(OFF_W1V + (size_t)256 * 2048 * 2);
constexpr size_t OFF_Q16 = al256(OFF_H16 + (size_t)T * 1024 * 2);
constexpr size_t KVSZ = (size_t)T * 128 * 2;
constexpr size_t OFF_KC = al256(OFF_Q16 + (size_t)T * 512 * 2);
constexpr size_t OFF_VC = al256(OFF_KC + KVSZ + 4096);
constexpr size_t OFF_KS = al256(OFF_VC + KVSZ + 4096);
constexpr size_t OFF_VST = al256(OFF_KS + KVSZ);
constexpr size_t OFF_KW = al256(OFF_VST + KVSZ);
constexpr size_t OFF_VWT = al256(OFF_KW + KVSZ);
constexpr size_t OFF_HIDC = al256(OFF_VWT + KVSZ);
constexpr size_t OFF_KCMP = al256(OFF_HIDC + (size_t)2 * 2048 * 256 * 2);
constexpr size_t OFF_VCMPT = al256(OFF_KCMP + (size_t)4 * 512 * 64 * 2);
constexpr size_t OFF_LRUH = al256(OFF_VCMPT + (size_t)4 * 512 * 64 * 2);
constexpr size_t OFF_LRUA = al256(OFF_LRUH + (size_t)T * 256 * 4);
constexpr size_t OFF_HEND = al256(OFF_LRUA + (size_t)T * 256 * 4);
constexpr size_t OFF_AEND = al256(OFF_HEND + 2 * 256 * 256 * 4);
constexpr size_t OFF_CARRY = al256(OFF_AEND + 2 * 256 * 256 * 4);
constexpr size_t OFF_XA = al256(OFF_CARRY + 2 * 256 * 256 * 4);
constexpr size_t OFF_LIST = al256(OFF_XA + (size_t)T * 1024 * 4);
constexpr size_t OFF_WPAIR = al256(OFF_LIST + (size_t)16 * 16384 * 4);
constexpr size_t OFF_SSQ = al256(OFF_WPAIR + 32768 * 4);
constexpr size_t OFF_R = al256(OFF_SSQ + (size_t)T * 2 * 4);
constexpr size_t OFF_P16 = OFF_R;
constexpr size_t OFF_HID = OFF_R;
constexpr size_t OFF_YPAIR = al256(OFF_HID + (size_t)(32768 + 512) * 512 * 2);
constexpr size_t OFF_HIDP = al256(OFF_P16 + (size_t)T * NIN * 2);
constexpr size_t R_END1 = OFF_HIDP + (size_t)4 * 2 * 2048 * 256 * 4;
constexpr size_t R_END2 = OFF_YPAIR + (size_t)32768 * 1024 * 2;
constexpr size_t WS_TOTAL = al256(R_END1 > R_END2 ? R_END1 : R_END2);

struct Params {
  const float* in[35];
  float* out;
  unsigned char* ws;
  double inv_freq[32];
};
enum { I_X = 0, I_C, I_POS, I_ADAW, I_ADAB, I_N1G, I_N2G, I_WIN, I_LCW, I_LCB, I_LWA, I_LBA, I_LWX, I_LBX, I_LLAM, I_CKW1, I_CKW2,
       I_CVW1, I_CVW2, I_CPK, I_CPV, I_DWW, I_DWB, I_LNG, I_LNB, I_ONG, I_WOUT, I_RGW, I_RGB, I_REW, I_REB, I_MG, I_MU, I_MD, I_FNG };

__device__ __forceinline__ int tidx() { int t = threadIdx.x; asm volatile("" : "+v"(t)); return t; }
__device__ __forceinline__ float wsum(float v) {
#pragma unroll
  for (int o = 32; o > 0; o >>= 1) v += __shfl_xor(v, o);
  return v;
}
__device__ __forceinline__ float sigm(float x) { return 1.f / (1.f + __expf(-x)); }
__device__ __forceinline__ float silu_f(float x) { return x / (1.f + __expf(-x)); }
__device__ __forceinline__ float gelu_tanh(float x) {
  float u = 0.7978845608028654f * (x + 0.044715f * x * x * x);
  float e = __expf(2.f * u);
  float t = 1.f - 2.f / (e + 1.f);
  return 0.5f * x * (1.f + t);
}
__device__ __forceinline__ void glds16(const h16* g, h16* l) {
  __builtin_amdgcn_global_load_lds((const unsigned*)g, (unsigned*)l, 16, 0, 0);
}
__device__ __forceinline__ h16x4 pack4(float a, float b, float c, float d) {
  h16x4 r; r[0] = (h16)a; r[1] = (h16)b; r[2] = (h16)c; r[3] = (h16)d; return r;
}

struct TileIter { int cur, end, step; };
__device__ __forceinline__ TileIter xcd_tiles(int ntiles) {
  const int G = gridDim.x, b = blockIdx.x;
  TileIter it;
  if ((G & 7) == 0) {
    const int x = b & 7;
    it.cur = (int)(((long)ntiles * x) >> 3) + (b >> 3);
    it.end = (int)(((long)ntiles * (x + 1)) >> 3);
    it.step = G >> 3;
  } else { it.cur = b; it.end = ntiles; it.step = G; }
  return it;
}

#define VMCNT(n) asm volatile("s_waitcnt vmcnt(" #n ")" ::: "memory")
template <int BN, class ARowFn>
__device__ __forceinline__ void gemm_mainloop(f32x4 (&acc)[8][BN / 64], ARowFn arow, const h16* __restrict__ Bt, int ldb, int nk, h16* sm, bool zero_init = true) {
  constexpr int NF = BN / 64, NBP = BN / 64;
  constexpr int STAGE = 16384 + BN * 64;
  const int tid = tidx(), lane = tid & 63, wave = tid >> 6;
  const int wr = wave >> 2, wc = wave & 3, fr = lane & 15, fq = lane >> 4;
  const h16* ap[4];
  const h16* bp[NBP];
#pragma unroll
  for (int i = 0; i < 4; ++i) {
    const int r = (i * 8 + wave) * 8 + (lane >> 3);
    const int c = (lane & 7) ^ ((r >> 1) & 7);
    ap[i] = arow(r) + c * 8;
    if (i < NBP) bp[i] = Bt + (size_t)r * ldb + c * 8;
  }
  if (zero_init) {
#pragma unroll
    for (int m = 0; m < 8; ++m)
#pragma unroll
      for (int n = 0; n < NF; ++n) acc[m][n] = (f32x4){0.f, 0.f, 0.f, 0.f};
  }
  h16* const dA = sm + wave * 512 + lane * 8;
#pragma unroll
  for (int i = 0; i < 4; ++i) { glds16(ap[i], dA + i * 4096); ap[i] += 64; }
#pragma unroll
  for (int i = 0; i < NBP; ++i) { glds16(bp[i], dA + 16384 + i * 4096); bp[i] += 64; }
  const int sw = (fr >> 1) & 7;
  const int aoff = (wr * 128 + fr) * 64, boff = 16384 + (wc * (BN / 4) + fr) * 64;
#define SCHED_FENCE() __builtin_amdgcn_sched_barrier(0)
  for (int kt = 0; kt < nk; ++kt) {
    VMCNT(0);
    __builtin_amdgcn_s_barrier();
    const h16* st = sm + (kt & 1) * STAGE;
    const bool more = kt + 1 < nk;
    h16* const dn = dA + ((kt + 1) & 1) * STAGE;
#pragma unroll
    for (int ks = 0; ks < 2; ++ks) {
      const int ch = ((ks * 4 + fq) ^ sw) * 8;
      h16x8 bf[NF];
#pragma unroll
      for (int n = 0; n < NF; ++n) bf[n] = *(const h16x8*)(st + boff + n * 1024 + ch);
#pragma unroll
      for (int mh = 0; mh < 2; ++mh) {
        h16x8 af[4];
#pragma unroll
        for (int m = 0; m < 4; ++m) af[m] = *(const h16x8*)(st + aoff + (mh * 4 + m) * 1024 + ch);
#pragma unroll
        for (int m = 0; m < 4; ++m) {
#pragma unroll
          for (int n = 0; n < NF; ++n) acc[mh * 4 + m][n] = __builtin_amdgcn_mfma_f32_16x16x32_f16(bf[n], af[m], acc[mh * 4 + m][n], 0, 0, 0);
          if (m == 1 || m == 3) {
            const int q = ks * 4 + mh * 2 + (m >> 1);
            SCHED_FENCE();
            if (more) {
              if (q < 4) { glds16(ap[q & 3], dn + (q & 3) * 4096); ap[q & 3] += 64; }
              else if ((q & 3) < NBP) { glds16(bp[(q & 3) < NBP ? (q & 3) : 0], dn + 16384 + (q & 3) * 4096); bp[(q & 3) < NBP ? (q & 3) : 0] += 64; }
            }
            SCHED_FENCE();
          }
        }
      }
    }
  }
#undef SCHED_FENCE
  __builtin_amdgcn_s_barrier();
}

struct TileSched { int cur, end, step, tail_tile, tail_half; };
__device__ __forceinline__ TileSched xcd_sched(int ntiles) {
  const int G = gridDim.x, b = blockIdx.x;
  TileSched s;
  s.tail_tile = -1; s.tail_half = -1;
  if ((G & 7) == 0) {
    const int x = b & 7, nb = G >> 3, si = b >> 3;
    const int lo = (int)(((long)ntiles * x) >> 3), hi = (int)(((long)ntiles * (x + 1)) >> 3);
    const int n = hi - lo, R = n / nb, rem = n - R * nb;
    s.cur = lo + si; s.end = lo + R * nb; s.step = nb;
    if (rem * 2 <= nb) { if (si < 2 * rem) { s.tail_tile = lo + R * nb + (si >> 1); s.tail_half = si & 1; } }
    else if (si < rem) s.tail_tile = lo + R * nb + si;
  } else { s.cur = b; s.end = ntiles; s.step = G; }
  return s;
}

__device__ __forceinline__ int map_row(int mode, int n) {
  if (mode == 1) return n < 1792 ? n : (n < 1816 ? n + 512 : n - 24);
  if (mode == 2) return 32 * (n >> 4) + (n & 15);
  if (mode == 3) return 32 * (n >> 4) + 16 + (n & 15);
  return n;
}
struct ConvTile { const float* src; h16* dst; int K, N, mode, k0, n0; const float* pos; float* pbp; };
__device__ __forceinline__ ConvTile conv_decode(const Params& p, int l, int t) {
  unsigned char* ws = p.ws;
  constexpr int T_WIN = 16 * 37, T_WOUT = 256, T_G = 16 * 128, T_W1 = 128;
  constexpr int E0 = T_WIN, E1 = E0 + T_WOUT, E2 = E1 + T_G, E3 = E2 + T_G, E4 = E3 + T_G, E5 = E4 + T_W1;
  ConvTile c;
  c.pos = nullptr; c.pbp = nullptr;
  int tk, tn;
  if (t < E0) {
    c.src = p.in[I_WIN] + (size_t)l * 1024 * NINSRC; c.K = 1024; c.N = NINSRC; c.dst = (h16*)(ws + OFF_WIN); c.mode = 1; tk = t / 37; tn = t % 37;
  } else if (t < E1) {
    const int u = t - E0;
    c.src = p.in[I_WOUT] + (size_t)l * 1024 * 1024; c.K = 1024; c.N = 1024; c.dst = (h16*)(ws + OFF_WOUT); c.mode = 4; tk = u >> 4; tn = u & 15;
  } else if (t < E3) {
    const int up = t >= E2;
    const int u = t - (up ? E2 : E1);
    const int e = u >> 7, v = u & 127;
    c.src = p.in[up ? I_MU : I_MG] + ((size_t)l * 16 + e) * 1024 * 512; c.K = 1024; c.N = 512; c.dst = (h16*)(ws + OFF_WGU) + (size_t)e * 1024 * 1024;
    c.mode = up ? 3 : 2; tk = v >> 3; tn = v & 7;
  } else if (t < E4) {
    const int u = t - E3;
    const int e = u >> 7, v = u & 127;
    c.src = p.in[I_MD] + ((size_t)l * 16 + e) * 512 * 1024; c.K = 512; c.N = 1024; c.dst = (h16*)(ws + OFF_WDN) + (size_t)e * 1024 * 512; c.mode = 0; tk = v >> 4; tn = v & 15;
  } else {
    const int vv = t >= E5;
    const int u = t - (vv ? E5 : E4);
    c.src = p.in[vv ? I_CVW1 : I_CKW1] + (size_t)l * 2048 * 256; c.K = 2048; c.N = 256; c.dst = (h16*)(ws + (vv ? OFF_W1V : OFF_W1K)); c.mode = 5; tk = u >> 2; tn = u & 3;
    c.pos = p.in[vv ? I_CPV : I_CPK] + (size_t)l * 2048 + tk * 64;
    c.pbp = (float*)(ws + OFF_PBPART) + (size_t)(vv * 32 + tk) * 256 + tn * 64;
  }
  c.k0 = tk * 64; c.n0 = tn * 64;
  return c;
}
__device__ __forceinline__ void conv_wave_tile(const ConvTile& c, float* smw, int lane) {
  float4 v[16];
#pragma unroll
  for (int i = 0; i < 16; ++i) {
    const int idx = i * 64 + lane;
    const int r = idx >> 4, c4 = (idx & 15) * 4;
    v[i] = make_float4(0.f, 0.f, 0.f, 0.f);
    if (c.n0 + c4 < c.N) v[i] = *(const float4*)(c.src + (size_t)(c.k0 + r) * c.N + c.n0 + c4);
  }
#pragma unroll
  for (int i = 0; i < 16; ++i) {
    const int idx = i * 64 + lane;
    const int r = idx >> 4, c4 = (idx & 15) * 4;
    float* d = smw + r * 65 + c4;
    d[0] = v[i].x; d[1] = v[i].y; d[2] = v[i].z; d[3] = v[i].w;
  }
  if (c.mode == 5) {
    float sacc = 0.f;
    for (int k = 0; k < 64; ++k) sacc += c.pos[k] * smw[k * 65 + lane];
    c.pbp[lane] = sacc;
  }
  const int k0d = c.mode == 4 ? (c.k0 < 256 ? c.k0 + 512 : (c.k0 < 768 ? c.k0 - 256 : c.k0)) : c.k0;
#pragma unroll
  for (int j = 0; j < 8; ++j) {
    const int ch = j * 64 + lane;
    const int n = ch >> 3, kc = ch & 7;
    if (c.n0 + n < c.N) {
      h16x8 o;
#pragma unroll
      for (int q = 0; q < 8; ++q) o[q] = (h16)smw[(kc * 8 + q) * 65 + n];
      *(h16x8*)(c.dst + (size_t)map_row(c.mode, c.n0 + n) * c.K + k0d + kc * 8) = o;
    }
  }
}

__device__ __forceinline__ void phase_convert(const Params& p, int l, float* sm) {
  unsigned char* ws = p.ws;
  constexpr int NT_CONV = 16 * 37 + 256 + 3 * 16 * 128 + 2 * 128;
  {
    const int tid = tidx(), lane = tid & 63, wave = tid >> 6;
    float* smw = sm + wave * 4160;
    for (int t = blockIdx.x * NW + wave; t < NT_CONV; t += gridDim.x * NW) {
      const ConvTile c = conv_decode(p, l, t);
      conv_wave_tile(c, smw, lane);
    }
    __syncthreads();
  }
  {
    h16* lw = (h16*)(ws + OFF_LRUW);
    for (int i = blockIdx.x * NTHREADS + tidx(); i < 2 * 4 * 64 * 64; i += gridDim.x * NTHREADS) {
      const int d = i & 63, e = (i >> 6) & 63, n = (i >> 12) & 3, mat = i >> 14;
      lw[i] = (h16)p.in[mat ? I_LWX : I_LWA][((size_t)(l * 4 + n) * 64 + d) * 64 + e];
    }
  }
  {
    h16x8 z = {0, 0, 0, 0, 0, 0, 0, 0};
    h16* w = (h16*)(ws + OFF_WIN) + (size_t)NINSRC * 1024;
    for (int i = blockIdx.x * NTHREADS + tidx(); i < (NINP - NINSRC) * 1024 / 8; i += gridDim.x * NTHREADS) *(h16x8*)(w + (size_t)i * 8) = z;
  }
}

__device__ __forceinline__ void phase_prep(const Params& p, float* sm) {
  unsigned char* ws = p.ws;
  const int tid = tidx();
  if (blockIdx.x == 0) {
    for (int i = tid; i < 1024; i += NTHREADS) ((unsigned*)(ws + OFF_CTL))[i] = 0u;
  }
  float* mod = (float*)(ws + OFF_MOD);
  for (int t = blockIdx.x; t < 384; t += gridDim.x) {
    const int l = t / 192, j0 = (t % 192) * 32;
    const int kg = tid >> 3, cq = tid & 7;
    const float* w = p.in[I_ADAW] + (size_t)l * 1024 * 6144 + j0 + 4 * cq;
    const float* c = p.in[I_C];
    float a0[4] = {0, 0, 0, 0}, a1[4] = {0, 0, 0, 0};
#pragma unroll 8
    for (int k = kg * 16; k < kg * 16 + 16; ++k) {
      const float4 wv = *(const float4*)(w + (size_t)k * 6144);
      const float s0 = silu_f(c[k]), s1 = silu_f(c[1024 + k]);
      a0[0] += s0 * wv.x; a0[1] += s0 * wv.y; a0[2] += s0 * wv.z; a0[3] += s0 * wv.w;
      a1[0] += s1 * wv.x; a1[1] += s1 * wv.y; a1[2] += s1 * wv.z; a1[3] += s1 * wv.w;
    }
    float* r = sm + (kg * 8 + cq) * 8;
#pragma unroll
    for (int i = 0; i < 4; ++i) { r[i] = a0[i]; r[4 + i] = a1[i]; }
    __syncthreads();
    if (tid < 64) {
      const int bb = tid >> 5, col = tid & 31, q = col >> 2, ci = col & 3;
      float s = 0.f;
      for (int g = 0; g < 64; ++g) s += sm[(g * 8 + q) * 8 + bb * 4 + ci];
      mod[(size_t)(l * 2 + bb) * 6144 + j0 + col] = s + p.in[I_ADAB][l * 6144 + j0 + col];
    }
    __syncthreads();
  }
  float* rc = (float*)(ws + OFF_ROPE);
  float* rs = rc + (size_t)T * 32;
  const int* pos = (const int*)p.in[I_POS];
  for (int i = blockIdx.x * NTHREADS + tid; i < T * 32; i += gridDim.x * NTHREADS) {
    const int t = i >> 5, f = i & 31;
    const double a = (double)pos[t] * p.inv_freq[f];
    const double n = rint(a * 0.15915494309189535);
    double r = fma(-n, 6.283185307179586, a);
    r = fma(-n, 2.4492935982947064e-16, r);
    const float rf = (float)r;
    rc[i] = cosf(rf);
    rs[i] = sinf(rf);
  }
}

__device__ __forceinline__ void phase_norm1(const Params& p, int mode) {
  unsigned char* ws = p.ws;
  const int lane = tidx() & 63, wave = tidx() >> 6;
  const float* mod = (const float*)(ws + OFF_MOD);
  float* xa = (float*)(ws + OFF_XA);
  const h16* yp = (const h16*)(ws + OFF_YPAIR);
  h16* hout = (h16*)(ws + OFF_H16);
  const int l = (mode == 0) ? 0 : 1;
  for (int row = blockIdx.x * NW + wave; row < T; row += gridDim.x * NW) {
    const int b = row >> 13;
    float4 x[4];
    float ss = 0.f;
#pragma unroll
    for (int i = 0; i < 4; ++i) {
      const int col = lane * 4 + 256 * i;
      if (mode == 0) {
        x[i] = *(const float4*)(p.in[I_X] + (size_t)row * D + col);
      } else {
        const int lp = mode == 1 ? 0 : 1;
        const float4 xv = *(const float4*)(xa + (size_t)row * D + col);
        const float4 g2 = *(const float4*)(mod + (size_t)(lp * 2 + b) * 6144 + 5120 + col);
        const h16x4 y0 = *(const h16x4*)(yp + (size_t)(row * 2) * D + col);
        const h16x4 y1 = *(const h16x4*)(yp + (size_t)(row * 2 + 1) * D + col);
        x[i].x = xv.x + g2.x * ((float)y0[0] + (float)y1[0]);
        x[i].y = xv.y + g2.y * ((float)y0[1] + (float)y1[1]);
        x[i].z = xv.z + g2.z * ((float)y0[2] + (float)y1[2]);
        x[i].w = xv.w + g2.w * ((float)y0[3] + (float)y1[3]);
        if (mode == 1) *(float4*)(xa + (size_t)row * D + col) = x[i];
      }
      ss += x[i].x * x[i].x + x[i].y * x[i].y + x[i].z * x[i].z + x[i].w * x[i].w;
    }
    ss = wsum(ss);
    const float rstd = rsqrtf(ss * (1.f / D) + EPS);
#pragma unroll
    for (int i = 0; i < 4; ++i) {
      const int col = lane * 4 + 256 * i;
      if (mode == 2) {
        const float4 g = *(const float4*)(p.in[I_FNG] + col);
        float4 o;
        o.x = x[i].x * rstd * g.x; o.y = x[i].y * rstd * g.y; o.z = x[i].z * rstd * g.z; o.w = x[i].w * rstd * g.w;
        *(float4*)(p.out + (size_t)row * D + col) = o;
      } else {
        const float4 g = *(const float4*)(p.in[I_N1G] + l * D + col);
        const float4 sh = *(const float4*)(mod + (size_t)(l * 2 + b) * 6144 + col);
        const float4 sc = *(const float4*)(mod + (size_t)(l * 2 + b) * 6144 + 1024 + col);
        *(h16x4*)(hout + (size_t)row * D + col) = pack4(x[i].x * rstd * g.x * (1.f + sc.x) + sh.x, x[i].y * rstd * g.y * (1.f + sc.y) + sh.y,
                                                        x[i].z * rstd * g.z * (1.f + sc.z) + sh.z, x[i].w * rstd * g.w * (1.f + sc.w) + sh.w);
      }
    }
  }
}

template <int BN>
__device__ __forceinline__ void inproj_tile(const Params& p, h16* sm, int mt, int col0) {
  unsigned char* ws = p.ws;
  const h16* Ab = (const h16*)(ws + OFF_H16) + (size_t)mt * 256 * D;
  h16* P = (h16*)(ws + OFF_P16);
  f32x4 acc[8][BN / 64];
  gemm_mainloop<BN>(acc, [&](int r) { return Ab + (size_t)r * D; }, (const h16*)(ws + OFF_WIN) + (size_t)col0 * D, D, D / 64, sm);
  const int tid_e = tidx(), lane = tid_e & 63, wave = tid_e >> 6, wr = wave >> 2, wc = wave & 3, fr = lane & 15, fq = lane >> 4;
  constexpr int LDR = BN + 8;
#pragma unroll
  for (int m = 0; m < 8; ++m)
#pragma unroll
    for (int n = 0; n < BN / 64; ++n)
      *(h16x4*)(sm + (wr * 128 + m * 16 + fr) * LDR + wc * (BN / 4) + n * 16 + 4 * fq) = pack4(acc[m][n][0], acc[m][n][1], acc[m][n][2], acc[m][n][3]);
  __syncthreads();
  constexpr int CH = BN / 8;
#pragma unroll
  for (int i = 0; i < CH / 2; ++i) {
    const int idx = i * NTHREADS + tid_e;
    const int r = idx / CH, c8 = idx % CH;
    *(h16x8*)(P + (size_t)(mt * 256 + r) * NIN + col0 + c8 * 8) = *(const h16x8*)(sm + r * LDR + c8 * 8);
  }
  __syncthreads();
}
__device__ __forceinline__ void phase_inproj(const Params& p, h16* sm) {
  const TileIter tf = xcd_tiles(64 * 8);
  for (int t = tf.cur; t < tf.end; t += tf.step) inproj_tile<256>(p, sm, t >> 3, (t & 7) * 256);
  const TileIter th = xcd_tiles(64 * 3);
  for (int t = th.cur; t < th.end; t += th.step) inproj_tile<128>(p, sm, t / 3, 2048 + (t % 3) * 128);
}

__device__ __forceinline__ int perm_key(int pos) {
  return 32 * (pos >> 5) + 16 * ((pos >> 2) & 1) + 4 * ((pos >> 3) & 3) + (pos & 3);
}
__device__ __forceinline__ void phase_post(const Params& p) {
  unsigned char* ws = p.ws;
  const h16* P = (const h16*)(ws + OFF_P16);
  const float* rc = (const float*)(ws + OFF_ROPE);
  const float* rs = rc + (size_t)T * 32;
  h16* q16 = (h16*)(ws + OFF_Q16);
  float* gates = (float*)(ws + OFF_GATES);
  const int lane = tidx() & 63, wave = tidx() >> 6;
  if (blockIdx.x == 0) {
    const int o = tidx();
    const float* pp = (const float*)(ws + OFF_PBPART) + (size_t)(o >> 8) * 32 * 256 + (o & 255);
    float acc = 0.f;
    for (int k = 0; k < 32; ++k) acc += pp[k * 256];
    ((float*)(ws + OFF_PB))[o] = acc;
  }
  for (int row = blockIdx.x * NW + wave; row < T; row += gridDim.x * NW) {
    const int b = row >> 13, s = row & (S - 1);
    const h16* pr = P + (size_t)row * NIN;
    const int d = (lane & 7) * 4;
    const float4 cs = *(const float4*)(rc + (size_t)row * 32 + d);
    const float4 sn = *(const float4*)(rs + (size_t)row * 32 + d);
    {
      const int hd = lane >> 3;
      const h16x4 a = *(const h16x4*)(pr + C_Q + 64 * hd + d);
      const h16x4 bb = *(const h16x4*)(pr + C_Q + 64 * hd + 32 + d);
      const float a0 = a[0], a1 = a[1], a2 = a[2], a3 = a[3], b0 = bb[0], b1 = bb[1], b2 = bb[2], b3 = bb[3];
      h16* qo = q16 + (size_t)row * 512 + 64 * hd + d;
      constexpr float QS = 0.125f * 1.4426950408889634f;
      *(h16x4*)qo = pack4((a0 * cs.x - b0 * sn.x) * QS, (a1 * cs.y - b1 * sn.y) * QS, (a2 * cs.z - b2 * sn.z) * QS, (a3 * cs.w - b3 * sn.w) * QS);
      *(h16x4*)(qo + 32) = pack4((b0 * cs.x + a0 * sn.x) * QS, (b1 * cs.y + a1 * sn.y) * QS, (b2 * cs.z + a2 * sn.z) * QS, (b3 * cs.w + a3 * sn.w) * QS);
    }
    if (lane < 48) {
      const int tn = lane >> 4, hd = (lane >> 3) & 1;
      const int cb = (tn == 0 ? C_KC : (tn == 1 ? C_KS : C_KW)) + 64 * hd;
      const size_t off = tn == 0 ? OFF_KC : (tn == 1 ? OFF_KS : OFF_KW);
      const h16x4 a = *(const h16x4*)(pr + cb + d);
      const h16x4 bb = *(const h16x4*)(pr + cb + 32 + d);
      const float a0 = a[0], a1 = a[1], a2 = a[2], a3 = a[3], b0 = bb[0], b1 = bb[1], b2 = bb[2], b3 = bb[3];
      h16* ko = (h16*)(ws + off) + ((size_t)(b * 2 + hd) * S + s) * 64 + d;
      *(h16x4*)ko = pack4(a0 * cs.x - b0 * sn.x, a1 * cs.y - b1 * sn.y, a2 * cs.z - b2 * sn.z, a3 * cs.w - b3 * sn.w);
      *(h16x4*)(ko + 32) = pack4(b0 * cs.x + a0 * sn.x, b1 * cs.y + a1 * sn.y, b2 * cs.z + a2 * sn.z, b3 * cs.w + a3 * sn.w);
    }
    if (lane < 32) {
      const int hd = lane >> 4, dd = (lane & 15) * 4;
      *(h16x4*)((h16*)(ws + OFF_VC) + ((size_t)(b * 2 + hd) * S + s) * 64 + dd) = *(const h16x4*)(pr + C_VC + 64 * hd + dd);
    }
    if (lane < 24) gates[(size_t)row * 24 + lane] = sigm((float)pr[C_GATE + lane]);
  }
  for (int task = blockIdx.x; task < 1024; task += gridDim.x) {
    const int tensor = task & 1, kv = (task >> 1) & 1, blk = (task >> 2) & 127, b = task >> 9;
    const int srccol = (tensor ? C_VW : C_VS) + 64 * kv;
    h16* dst = (h16*)(ws + (tensor ? OFF_VWT : OFF_VST)) + ((size_t)((b * 2 + kv) * 128 + blk)) * 4096;
    const int dim = tidx() & 63, kg = tidx() >> 6;
    {
      const int p0 = kg * 8;
      h16x8 v;
#pragma unroll
      for (int j = 0; j < 8; ++j) v[j] = P[(size_t)(b * S + blk * 64 + perm_key(p0 + j)) * NIN + srccol + dim];
      *(h16x8*)(dst + dim * 64 + p0) = v;
    }
  }
}

__device__ __forceinline__ void mixa_compress1(const Params& p, int item, h16* sm) {
  unsigned char* ws = p.ws;
  const int which = item >> 5, mt = (item >> 2) & 7, ks = item & 3;
  const h16* A = (const h16*)(ws + (which ? OFF_VC : OFF_KC)) + (size_t)mt * 256 * 1024 + ks * 512;
  const h16* W = (const h16*)(ws + (which ? OFF_W1V : OFF_W1K)) + ks * 512;
  float* hp = (float*)(ws + OFF_HIDP) + ((size_t)(ks * 2 + which) * 2048) * 256;
  f32x4 acc[8][4];
  gemm_mainloop<256>(acc, [&](int r) { return A + (size_t)r * 1024; }, W, 2048, 8, sm);
  const int tid_e = tidx(), lane = tid_e & 63, wave = tid_e >> 6, wr = wave >> 2, wc = wave & 3, fr = lane & 15, fq = lane >> 4;
#pragma unroll
  for (int m = 0; m < 8; ++m)
#pragma unroll
    for (int n = 0; n < 4; ++n) {
      const int row = mt * 256 + wr * 128 + m * 16 + fr, col = wc * 64 + n * 16 + 4 * fq;
      *(f32x4*)(hp + (size_t)row * 256 + col) = acc[m][n];
    }
}

__device__ __forceinline__ void mixa_lru(const Params& p, int l, int item, float* sm) {
  unsigned char* ws = p.ws;
  const int tid = tidx();
  const int half = tid >> 8;
  item = item * 2 + half;
  sm += half * 14400;
  const int b = item >> 8, ck = item & 255;
  const int c = tid & 255;
  const int nb = c >> 6;
  const int lane = tid & 63, fr = lane & 15, fq = lane >> 4;
  const h16* P = (const h16*)(ws + OFF_P16);
  const float* cw = p.in[I_LCW] + l * 4 * 256;
  const float w0 = cw[c], w1 = cw[256 + c], w2 = cw[512 + c], w3 = cw[768 + c], cb = p.in[I_LCB][l * 256 + c];
  const float ba = p.in[I_LBA][l * 256 + c], bx = p.in[I_LBX][l * 256 + c];
  const float lam = p.in[I_LLAM][l * 256 + c];
  const float ls = -log1pf(expf(-lam));
  h16x8 bw[2][4][2];
  {
    const h16* lw = (const h16*)(ws + OFF_LRUW);
#pragma unroll
    for (int mat = 0; mat < 2; ++mat)
#pragma unroll
      for (int nt = 0; nt < 4; ++nt)
#pragma unroll
        for (int ks = 0; ks < 2; ++ks) bw[mat][nt][ks] = *(const h16x8*)(lw + ((size_t)((mat * 4 + nb) * 64 + nt * 16 + fr)) * 64 + ks * 32 + 8 * fq);
  }
  const int t0 = ck * 32;
  float x0 = 0.f, x1 = 0.f, x2 = 0.f;
  if (t0 >= 3) {
    x0 = (float)P[(size_t)(b * S + t0 - 3) * NIN + C_XL + c];
    x1 = (float)P[(size_t)(b * S + t0 - 2) * NIN + C_XL + c];
    x2 = (float)P[(size_t)(b * S + t0 - 1) * NIN + C_XL + c];
  }
  float h = 0.f, ap = 1.f;
  float* lh = (float*)(ws + OFF_LRUH);
  float* la = (float*)(ws + OFF_LRUA);
  float* sr = sm + 4096;
  float* si = sm + 8192;
  h16* xh = (h16*)(sm + 12288);
#pragma unroll 1
  for (int sub = 0; sub < 2; ++sub) {
    const int tb = t0 + sub * 16;
    {
      h16 xv[16];
      const h16* xp = P + (size_t)(b * S + tb) * NIN + C_XL + c;
#pragma unroll
      for (int tt = 0; tt < 16; ++tt) { xv[tt] = *xp; xp += NIN; asm volatile("" : "+v"(xp)); }
#pragma unroll
      for (int tt = 0; tt < 16; ++tt) {
        const float x3 = (float)xv[tt];
        const float xc = w0 * x0 + w1 * x1 + w2 * x2 + w3 * x3 + cb;
        sm[tt * 256 + c] = xc;
        xh[tt * 264 + c] = (h16)xc;
        x0 = x1; x1 = x2; x2 = x3;
      }
    }
    {
      h16x8 af[2];
#pragma unroll
      for (int ks = 0; ks < 2; ++ks) af[ks] = *(const h16x8*)(xh + fr * 264 + nb * 64 + ks * 32 + 8 * fq);
#pragma unroll
      for (int nt = 0; nt < 4; ++nt) {
        f32x4 ar = {0.f, 0.f, 0.f, 0.f}, ai = {0.f, 0.f, 0.f, 0.f};
#pragma unroll
        for (int ks = 0; ks < 2; ++ks) {
          ar = __builtin_amdgcn_mfma_f32_16x16x32_f16(af[ks], bw[0][nt][ks], ar, 0, 0, 0);
          ai = __builtin_amdgcn_mfma_f32_16x16x32_f16(af[ks], bw[1][nt][ks], ai, 0, 0, 0);
        }
#pragma unroll
        for (int j = 0; j < 4; ++j) {
          sr[(4 * fq + j) * 256 + nb * 64 + nt * 16 + fr] = ar[j];
          si[(4 * fq + j) * 256 + nb * 64 + nt * 16 + fr] = ai[j];
        }
      }
    }
#pragma unroll 4
    for (int tt = 0; tt < 16; ++tt) {
      const float r = sigm(sr[tt * 256 + c] + ba), ig = sigm(si[tt * 256 + c] + bx);
      const float log_a = 8.f * r * ls;
      const float a = __expf(log_a);
      const float mult = sqrtf(-expm1f(2.f * log_a));
      sr[tt * 256 + c] = a;
      si[tt * 256 + c] = mult * ig * sm[tt * 256 + c];
    }
    float* lhp = lh + (size_t)(b * S + tb) * 256 + c;
    float* lap = la + (size_t)(b * S + tb) * 256 + c;
#pragma unroll 4
    for (int tt = 0; tt < 16; ++tt) {
      const float a = sr[tt * 256 + c];
      h = a * h + si[tt * 256 + c];
      ap *= a;
      lhp[tt * 256] = h;
      lap[tt * 256] = ap;
    }
  }
  ((float*)(ws + OFF_HEND))[(size_t)(b * 256 + ck) * 256 + c] = h;
  ((float*)(ws + OFF_AEND))[(size_t)(b * 256 + ck) * 256 + c] = ap;
  __syncthreads();
}

__device__ __forceinline__ void mixa_conv(const Params& p, int l, int item, float* sm) {
  unsigned char* ws = p.ws;
  const int half = tidx() >> 8;
  item = item * 2 + half;
  sm += half * 15872;
  const int b = item >> 8, ck = item & 255;
  const int c = tidx() & 255;
  const h16* P = (const h16*)(ws + OFF_P16);
  const int t0 = ck * 32;
  float col[64];
#pragma unroll
  for (int r0 = 0; r0 < 64; r0 += 16) {
    h16 va[16], vb[16];
#pragma unroll
    for (int q = 0; q < 16; ++q) {
      const int t = t0 - 30 + r0 + q;
      va[q] = (h16)0.f; vb[q] = (h16)0.f;
      if (t >= 0 && r0 + q < 62) {
        const h16* pr = P + (size_t)(b * S + t) * NIN;
        va[q] = pr[C_CVA + c]; vb[q] = pr[C_CVB + c];
      }
    }
#pragma unroll
    for (int q = 0; q < 16; ++q) col[r0 + q] = (float)va[q] * sigm((float)vb[q]);
    asm volatile("" ::: "memory");
  }
  float w[31];
#pragma unroll
  for (int j = 0; j < 31; ++j) w[j] = p.in[I_DWW][(size_t)(l * 31 + j) * 256 + c];
  const float bias = p.in[I_DWB][l * 256 + c];
#pragma unroll
  for (int i = 0; i < 32; ++i) {
    float z = bias;
#pragma unroll
    for (int j = 0; j < 31; ++j) z += w[j] * col[i + j];
    sm[i * 256 + c] = z;
  }
  __syncthreads();
  const int lane = tidx() & 63, wave = (tidx() >> 6) & 3;
  const float4 lg = *(const float4*)(p.in[I_LNG] + l * 256 + lane * 4);
  const float4 lb = *(const float4*)(p.in[I_LNB] + l * 256 + lane * 4);
  const float4 gn = *(const float4*)(p.in[I_ONG] + l * 1024 + 768 + lane * 4);
  h16* yc = (h16*)(ws + OFF_H16);
  for (int i = wave * 8; i < wave * 8 + 8; ++i) {
    const float4 z = *(const float4*)(sm + i * 256 + lane * 4);
    const float mu = wsum(z.x + z.y + z.z + z.w) * (1.f / 256.f);
    const float dx = z.x - mu, dy = z.y - mu, dz = z.z - mu, dw = z.w - mu;
    const float var = wsum(dx * dx + dy * dy + dz * dz + dw * dw) * (1.f / 256.f);
    const float rs = rsqrtf(var + EPS);
    const float y0 = silu_f(dx * rs * lg.x + lb.x), y1 = silu_f(dy * rs * lg.y + lb.y), y2 = silu_f(dz * rs * lg.z + lb.z), y3 = silu_f(dw * rs * lg.w + lb.w);
    const float r2 = rsqrtf(wsum(y0 * y0 + y1 * y1 + y2 * y2 + y3 * y3) * (1.f / 256.f) + EPS);
    *(h16x4*)(yc + (size_t)(b * S + t0 + i) * D + 768 + lane * 4) = pack4(y0 * r2 * gn.x, y1 * r2 * gn.y, y2 * r2 * gn.z, y3 * r2 * gn.w);
  }
  __syncthreads();
}

__device__ __forceinline__ void phase_mixa(const Params& p, int l, void* sm) {
  const int G = gridDim.x;
  for (int it = blockIdx.x; it < 64; it += G) mixa_compress1(p, it, (h16*)sm);
  for (int it = blockIdx.x; it < 256; it += G) mixa_lru(p, l, it, (float*)sm);
  for (int it = (blockIdx.x + G - 64 % G) % G; it < 256; it += G) mixa_conv(p, l, it, (float*)sm);
}

__device__ __forceinline__ void phase_mixb(const Params& p, int l, float* sm) {
  unsigned char* ws = p.ws;
  const int tid = tidx();
  for (int it = blockIdx.x; it < 512; it += gridDim.x) {
    const int which = it >> 8;
    const int row0 = (it & 255) * 8;
    {
      const float* hp = (const float*)(ws + OFF_HIDP) + ((size_t)which * 2048 + row0) * 256;
      const float* pb = (const float*)(ws + OFF_PB) + which * 256;
      const int r = tid >> 6, c4 = (tid & 63) * 4;
      const size_t o = (size_t)r * 256 + c4;
      const float4 a0 = *(const float4*)(hp + o), a1 = *(const float4*)(hp + (size_t)2 * 2048 * 256 + o);
      const float4 a2 = *(const float4*)(hp + (size_t)4 * 2048 * 256 + o), a3 = *(const float4*)(hp + (size_t)6 * 2048 * 256 + o);
      const float4 bb = *(const float4*)(pb + c4);
      float* d = sm + r * 256 + c4;
      d[0] = gelu_tanh(a0.x + a1.x + a2.x + a3.x + bb.x); d[1] = gelu_tanh(a0.y + a1.y + a2.y + a3.y + bb.y);
      d[2] = gelu_tanh(a0.z + a1.z + a2.z + a3.z + bb.z); d[3] = gelu_tanh(a0.w + a1.w + a2.w + a3.w + bb.w);
      const float4* wsrc = (const float4*)(p.in[which ? I_CVW2 : I_CKW2] + (size_t)l * 256 * 64);
      float4* wdst = (float4*)(sm + 2048);
#pragma unroll
      for (int q = 0; q < 8; ++q) wdst[q * NTHREADS + tid] = wsrc[q * NTHREADS + tid];
    }
    __syncthreads();
    const int row = row0 + (tid >> 6), d = tid & 63;
    const float* hr = sm + (tid >> 6) * 256;
    const float* w2 = sm + 2048 + d;
    float s = 0.f;
#pragma unroll 8
    for (int j = 0; j < 256; ++j) s += (float)(h16)hr[j] * w2[j * 64];
    const int bkv = row >> 9, n = row & 511;
    if (n == 511) s = 0.f;
    if (which == 0) {
      ((h16*)(ws + OFF_KCMP))[((size_t)bkv * 512 + n) * 64 + d] = (h16)s;
    } else {
      const int blk = n >> 6, key = n & 63;
      const int pos = 32 * (key >> 5) + 8 * ((key >> 2) & 3) + 4 * ((key >> 4) & 1) + (key & 3);
      ((h16*)(ws + OFF_VCMPT))[((size_t)(bkv * 8 + blk) * 64 + d) * 64 + pos] = (h16)s;
    }
    __syncthreads();
  }
  const int g = blockIdx.x * NTHREADS + tid;
  if (g < 512) {
    const int b = g >> 8, c = g & 255;
    const float* he = (const float*)(ws + OFF_HEND) + (size_t)b * 256 * 256 + c;
    const float* ae = (const float*)(ws + OFF_AEND) + (size_t)b * 256 * 256 + c;
    float* cy = (float*)(ws + OFF_CARRY) + (size_t)b * 256 * 256 + c;
    float carry = 0.f;
#pragma unroll 1
    for (int k0 = 0; k0 < 256; k0 += 32) {
      float hv[32], av[32];
#pragma unroll
      for (int k = 0; k < 32; ++k) { hv[k] = he[(k0 + k) * 256]; av[k] = ae[(k0 + k) * 256]; }
#pragma unroll
      for (int k = 0; k < 32; ++k) {
        cy[(k0 + k) * 256] = carry;
        carry = hv[k] + av[k] * carry;
      }
    }
  }
}

__device__ __forceinline__ void stage8k(const h16* __restrict__ g, h16* l, int tid) {
  const int r = tid >> 3, cl = (tid & 7) ^ ((r >> 1) & 7);
  glds16(g + r * 64 + cl * 8, l + tid * 8);
}
__device__ __forceinline__ h16x8 ldfrag(const h16* l, int row, int chunk) {
  return *(const h16x8*)(l + row * 64 + ((chunk ^ ((row >> 1) & 7)) * 8));
}

template <int MODE>
__device__ __forceinline__ void attn_branch(const h16* __restrict__ Kg, const h16* __restrict__ Vg, int j0, int j1, h16* ring,
                                            const h16x8 (&qf)[2][2], float (&m)[2], float (&l)[2], f32x4 (&o)[2][4],
                                            const int (&tq)[2], const int (&lim)[2], const int (&tlim)[2], const int (&tfl)[2],
                                            const unsigned long long (&mylo)[2], const unsigned long long (&myhi)[2],
                                            const unsigned long long (&ulo)[2], const unsigned long long (&uhi)[2],
                                            const float (&inv)[2], float* impw) {
  int tid = tidx();
  asm volatile("" : "+v"(tid));
  const int lane = tid & 63;
  const int h = lane >> 4, c = lane & 15, qi = c >> 2, g = c & 3;
  constexpr bool PV = MODE != 0;
  constexpr int SS = 3;
  const int n = j1 - j0 + 1;
  if (n <= 0) return;
  const int nss = (n + SS - 1) / SS;
#pragma unroll
  for (int q = 0; q < SS; ++q)
    if (q < n) {
      stage8k(Kg + (size_t)(j0 + q) * 4096, ring + q * 8192, tid);
      if (PV) stage8k(Vg + (size_t)(j0 + q) * 4096, ring + q * 8192 + 4096, tid);
    }
  int sbase = 0;
  for (int ss = 0; ss < nss; ++ss) {
    VMCNT(0);
    __builtin_amdgcn_s_barrier();
    {
      const int sn = SS - sbase;
#pragma unroll
      for (int q = 0; q < SS; ++q) {
        const int jb = SS * (ss + 1) + q;
        if (jb < n) {
          stage8k(Kg + (size_t)(j0 + jb) * 4096, ring + (sn + q) * 8192, tid);
          if (PV) stage8k(Vg + (size_t)(j0 + jb) * 4096, ring + (sn + q) * 8192 + 4096, tid);
        }
      }
    }
#pragma unroll 1
   for (int sub = 0; sub < SS; ++sub) {
    const int it = SS * ss + sub;
    if (it >= n) break;
    const int j = j0 + it;
    const h16* cK = ring + (sbase + sub) * 8192;
    const h16* cV = cK + 4096;
    bool act[2];
#pragma unroll
    for (int mq = 0; mq < 2; ++mq) {
      if (MODE <= 1) act[mq] = j * 64 <= tlim[mq];
      else if (MODE == 2) act[mq] = ((j < 64 ? (ulo[mq] >> j) : (uhi[mq] >> (j - 64))) & 1ull) != 0ull;
      else act[mq] = (j * 64 <= tlim[mq] + 3) && (j * 64 + 63 > tlim[mq] - 512);
    }
    if (act[0] || act[1]) {
      h16x8 pf[2][2];
      h16x8 kf[4][2];
#pragma unroll
      for (int kt = 0; kt < 4; ++kt)
#pragma unroll
        for (int ks = 0; ks < 2; ++ks) kf[kt][ks] = ldfrag(cK, 16 * kt + c, 4 * ks + h);
#pragma unroll
      for (int mq = 0; mq < 2; ++mq)
        if (act[mq]) {
          f32x4 s[1][4];
          {
#pragma unroll
            for (int kt = 0; kt < 4; ++kt) {
              s[0][kt] = (f32x4){0.f, 0.f, 0.f, 0.f};
#pragma unroll
              for (int ks = 0; ks < 2; ++ks) s[0][kt] = __builtin_amdgcn_mfma_f32_16x16x32_f16(kf[kt][ks], qf[mq][ks], s[0][kt], 0, 0, 0);
            }
          }
          const bool selbit = MODE == 2 ? (((j < 64 ? (mylo[mq] >> j) : (myhi[mq] >> (j - 64))) & 1ull) != 0ull) : true;
          bool interior;
          if (MODE <= 1) interior = j * 64 + 63 <= tfl[mq];
          else if (MODE == 2) interior = j * 64 + 63 <= tfl[mq];
          else interior = (j * 64 + 63 <= tfl[mq]) && (j * 64 > tfl[mq] + 3 - 512);
          if (!interior) {
            const int pbase = j * 64 + 4 * h;
#pragma unroll
            for (int kt = 0; kt < 4; ++kt)
#pragma unroll
              for (int i = 0; i < 4; ++i) {
                const int pos = pbase + 16 * kt + i;
                bool v;
                if (MODE <= 1) v = pos <= lim[mq];
                else if (MODE == 2) v = selbit && pos <= tq[mq];
                else v = pos <= tq[mq] && pos > tq[mq] - 512;
                s[0][kt][i] = v ? s[0][kt][i] : -1e30f;
              }
          }
          const bool rowoff = MODE == 2 && interior && !selbit;
          if (MODE == 1) {
#pragma unroll
            for (int kt = 0; kt < 4; ++kt) {
              float ps = 0.f;
#pragma unroll
              for (int i = 0; i < 4; ++i) {
                const float pv = __builtin_amdgcn_exp2f(s[0][kt][i] - m[mq]) * inv[mq];
                s[0][kt][i] = pv;
                ps += pv;
              }
              ps += __shfl_xor(ps, 1);
              ps += __shfl_xor(ps, 2);
              if (g == 0) impw[(4 * mq + qi) * 128 + j * 16 + kt * 4 + h] = ps;
            }
          } else {
            float bm = fmaxf(fmaxf(fmaxf(s[0][0][0], s[0][0][1]), fmaxf(s[0][0][2], s[0][0][3])), fmaxf(fmaxf(s[0][1][0], s[0][1][1]), fmaxf(s[0][1][2], s[0][1][3])));
            bm = fmaxf(bm, fmaxf(fmaxf(fmaxf(s[0][2][0], s[0][2][1]), fmaxf(s[0][2][2], s[0][2][3])), fmaxf(fmaxf(s[0][3][0], s[0][3][1]), fmaxf(s[0][3][2], s[0][3][3]))));
            bm = rowoff ? -1e30f : bm;
            if (__any(bm > m[mq] + 8.f)) {
              bm = fmaxf(bm, __shfl_xor(bm, 16));
              bm = fmaxf(bm, __shfl_xor(bm, 32));
              const float mn = fmaxf(m[mq], bm);
              const float alpha = __builtin_amdgcn_exp2f(m[mq] - mn);
              l[mq] *= alpha;
              m[mq] = mn;
              if (PV) {
#pragma unroll
                for (int mt = 0; mt < 4; ++mt) o[mq][mt] *= alpha;
              }
            }
            const float mref = (m[mq] > -1e29f && !rowoff) ? m[mq] : 1e30f;
            float ps = 0.f;
#pragma unroll
            for (int kt = 0; kt < 4; ++kt)
#pragma unroll
              for (int i = 0; i < 4; ++i) {
                const float pv = __builtin_amdgcn_exp2f(s[0][kt][i] - mref);
                s[0][kt][i] = pv;
                ps += pv;
              }
            l[mq] += ps;
          }
          if (PV) {
#pragma unroll
            for (int s2 = 0; s2 < 2; ++s2)
#pragma unroll
              for (int i = 0; i < 4; ++i) { pf[mq][s2][i] = (h16)s[0][2 * s2][i]; pf[mq][s2][4 + i] = (h16)s[0][2 * s2 + 1][i]; }
          }
        }
      if (PV) {
        h16x8 vf[4][2];
#pragma unroll
        for (int mt = 0; mt < 4; ++mt)
#pragma unroll
          for (int s2 = 0; s2 < 2; ++s2) vf[mt][s2] = ldfrag(cV, 16 * mt + c, 4 * s2 + h);
#pragma unroll
        for (int mq = 0; mq < 2; ++mq)
          if (act[mq]) {
#pragma unroll
            for (int s2 = 0; s2 < 2; ++s2) {
#pragma unroll
              for (int mt = 0; mt < 4; ++mt) o[mq][mt] = __builtin_amdgcn_mfma_f32_16x16x32_f16(vf[mt][s2], pf[mq][s2], o[mq][mt], 0, 0, 0);
            }
          }
      }
    }
   }
    sbase = SS - sbase;
  }
  __builtin_amdgcn_s_barrier();
}

__device__ __forceinline__ void attn_item(const Params& p, int l, int item, float* sm) {
  unsigned char* ws = p.ws;
  int tid = tidx();
  asm volatile("" : "+v"(tid));
  const int lane = tid & 63, wave = tid >> 6;
  const int combo = item & 3, qt = item >> 2;
  const int b = combo >> 1, kv = combo & 1;
  const int t0 = qt * 64, tw0 = t0 + 8 * wave;
  const int h = lane >> 4, c = lane & 15, qi = c >> 2, g = c & 3;
  const int head = kv * 4 + g, bkv = b * 2 + kv;
  h16* ring = (h16*)sm;
  float* impw = sm + 24576 + wave * 1024;
  unsigned long long* selm = (unsigned long long*)(sm + 24576 + 8192) + wave * 16;

  h16x8 qf[2][2];
  int tq[2];
#pragma unroll
  for (int mq = 0; mq < 2; ++mq) {
    tq[mq] = tw0 + 4 * mq + qi;
    const h16* qrow = (const h16*)(ws + OFF_Q16) + (size_t)(b * S + tq[mq]) * 512 + head * 64;
    qf[mq][0] = *(const h16x8*)(qrow + 8 * h);
    qf[mq][1] = *(const h16x8*)(qrow + 32 + 8 * h);
  }
  for (int i = lane; i < 1024; i += 64) impw[i] = 0.f;

  h16x4 ofin[2][4];
  float m[2], ll[2], inv[2];
  f32x4 o[2][4];
  const unsigned long long z2[2] = {0ull, 0ull};
  {
    int lim[2], tlim[2], tflc[2];
#pragma unroll
    for (int mq = 0; mq < 2; ++mq) {
      lim[mq] = tq[mq] >= 31 ? ((tq[mq] - 31) >> 4) : -1;
      const int tl = tw0 + 4 * mq + 3;
      tlim[mq] = tl >= 31 ? ((tl - 31) >> 4) : -1;
      const int tf0 = tw0 + 4 * mq;
      tflc[mq] = tf0 >= 31 ? ((tf0 - 31) >> 4) : -1;
      m[mq] = -1e30f; ll[mq] = 0.f; inv[mq] = 0.f;
#pragma unroll
      for (int mt = 0; mt < 4; ++mt) o[mq][mt] = (f32x4){0.f, 0.f, 0.f, 0.f};
    }
    const int nl = (t0 + 63 - 31) >> 4;
    const int jl = nl >> 6;
    const h16* Kc = (const h16*)(ws + OFF_KCMP) + (size_t)bkv * 512 * 64;
    const h16* Vc = (const h16*)(ws + OFF_VCMPT) + (size_t)bkv * 8 * 4096;
    attn_branch<0>(Kc, Vc, 0, jl, ring, qf, m, ll, o, tq, lim, tlim, tflc, z2, z2, z2, z2, inv, impw);
#pragma unroll
    for (int mq = 0; mq < 2; ++mq) {
      float lt = ll[mq];
      lt += __shfl_xor(lt, 16);
      lt += __shfl_xor(lt, 32);
      inv[mq] = lt > 0.f ? 1.f / lt : 0.f;
    }
    attn_branch<1>(Kc, Vc, 0, jl, ring, qf, m, ll, o, tq, lim, tlim, tflc, z2, z2, z2, z2, inv, impw);
    const float* gt0 = (const float*)(ws + OFF_GATES) + (size_t)(b * S) * 24 + head * 3;
#pragma unroll
    for (int mq = 0; mq < 2; ++mq) {
      const float g0 = gt0[(size_t)tq[mq] * 24] * ASCALE;
#pragma unroll
      for (int mt = 0; mt < 4; ++mt) ofin[mq][mt] = pack4(o[mq][mt][0] * g0, o[mq][mt][1] * g0, o[mq][mt][2] * g0, o[mq][mt][3] * g0);
    }
  }
  for (int q = 0; q < 8; ++q) {
    const int t = tw0 + q, own = t >> 6;
    const float* ir = impw + q * 128;
    const int ja = lane, jb = lane + 64;
    unsigned k0 = 0u, k1 = 0u;
    if (ja <= own) k0 = (ja == 0 || ja == own) ? (0xFFFFFF80u | (unsigned)(127 - ja)) : (((__float_as_uint(ir[ja]) & ~127u) | (unsigned)(127 - ja)) + 1u);
    if (jb <= own) k1 = (jb == own) ? (0xFFFFFF80u | (unsigned)(127 - jb)) : (((__float_as_uint(ir[jb]) & ~127u) | (unsigned)(127 - jb)) + 1u);
    unsigned thr = 0u;
    for (int bit = 31; bit >= 0; --bit) {
      const unsigned cand = thr | (1u << bit);
      const int cnt = __popcll(__ballot(k0 >= cand)) + __popcll(__ballot(k1 >= cand));
      if (cnt >= 16) thr = cand;
    }
    const unsigned long long mlo = __ballot(k0 >= thr && ja <= own);
    const unsigned long long mhi = __ballot(k1 >= thr && jb <= own);
    if (lane == 0) { selm[q * 2] = mlo; selm[q * 2 + 1] = mhi; }
  }
  unsigned long long mylo[2], myhi[2], ulo[2], uhi[2];
#pragma unroll
  for (int mq = 0; mq < 2; ++mq) {
    mylo[mq] = selm[(4 * mq + qi) * 2];
    myhi[mq] = selm[(4 * mq + qi) * 2 + 1];
    unsigned long long a = selm[(4 * mq) * 2] | selm[(4 * mq + 1) * 2] | selm[(4 * mq + 2) * 2] | selm[(4 * mq + 3) * 2];
    unsigned long long bb = selm[(4 * mq) * 2 + 1] | selm[(4 * mq + 1) * 2 + 1] | selm[(4 * mq + 2) * 2 + 1] | selm[(4 * mq + 3) * 2 + 1];
    ulo[mq] = (unsigned long long)__builtin_amdgcn_readfirstlane((unsigned)a) | ((unsigned long long)__builtin_amdgcn_readfirstlane((unsigned)(a >> 32)) << 32);
    uhi[mq] = (unsigned long long)__builtin_amdgcn_readfirstlane((unsigned)bb) | ((unsigned long long)__builtin_amdgcn_readfirstlane((unsigned)(bb >> 32)) << 32);
  }
  const float* gtb = (const float*)(ws + OFF_GATES) + (size_t)(b * S) * 24 + head * 3;
  {
    int tl0[2] = {0, 0};
    const int tfs[2] = {tw0, tw0 + 4};
#pragma unroll
    for (int mq = 0; mq < 2; ++mq) {
      m[mq] = -1e30f; ll[mq] = 0.f;
#pragma unroll
      for (int mt = 0; mt < 4; ++mt) o[mq][mt] = (f32x4){0.f, 0.f, 0.f, 0.f};
    }
    attn_branch<2>((const h16*)(ws + OFF_KS) + (size_t)bkv * S * 64, (const h16*)(ws + OFF_VST) + (size_t)bkv * 128 * 4096, 0, (t0 + 63) >> 6, ring, qf, m, ll, o,
                   tq, tl0, tl0, tfs, mylo, myhi, ulo, uhi, inv, impw);
#pragma unroll
    for (int mq = 0; mq < 2; ++mq) {
      float lt = ll[mq];
      lt += __shfl_xor(lt, 16);
      lt += __shfl_xor(lt, 32);
      const float sc = lt > 0.f ? gtb[(size_t)tq[mq] * 24 + 1] * ASCALE / lt : 0.f;
#pragma unroll
      for (int mt = 0; mt < 4; ++mt)
        ofin[mq][mt] = pack4((float)ofin[mq][mt][0] + o[mq][mt][0] * sc, (float)ofin[mq][mt][1] + o[mq][mt][1] * sc, (float)ofin[mq][mt][2] + o[mq][mt][2] * sc,
                             (float)ofin[mq][mt][3] + o[mq][mt][3] * sc);
    }
  }
  {
    int tl0[2] = {0, 0}, tf[2];
#pragma unroll
    for (int mq = 0; mq < 2; ++mq) {
      tf[mq] = tw0 + 4 * mq;
      m[mq] = -1e30f; ll[mq] = 0.f;
#pragma unroll
      for (int mt = 0; mt < 4; ++mt) o[mq][mt] = (f32x4){0.f, 0.f, 0.f, 0.f};
    }
    const int jlo = t0 >= 511 ? ((t0 - 511) >> 6) : 0;
    attn_branch<3>((const h16*)(ws + OFF_KW) + (size_t)bkv * S * 64, (const h16*)(ws + OFF_VWT) + (size_t)bkv * 128 * 4096, jlo, (t0 + 63) >> 6, ring, qf, m, ll, o,
                   tq, tl0, tf, tf, z2, z2, z2, z2, inv, impw);
#pragma unroll
    for (int mq = 0; mq < 2; ++mq) {
      float lt = ll[mq];
      lt += __shfl_xor(lt, 16);
      lt += __shfl_xor(lt, 32);
      const float sc = lt > 0.f ? gtb[(size_t)tq[mq] * 24 + 2] * ASCALE / lt : 0.f;
#pragma unroll
      for (int mt = 0; mt < 4; ++mt)
        ofin[mq][mt] = pack4((float)ofin[mq][mt][0] + o[mq][mt][0] * sc, (float)ofin[mq][mt][1] + o[mq][mt][1] * sc, (float)ofin[mq][mt][2] + o[mq][mt][2] * sc,
                             (float)ofin[mq][mt][3] + o[mq][mt][3] * sc);
    }
  }
  {
    h16* yc = (h16*)(ws + OFF_H16);
    const float* gn = p.in[I_ONG] + l * 1024 + 256 + head * 64;
    float* ssq = (float*)(ws + OFF_SSQ);
#pragma unroll
    for (int mq = 0; mq < 2; ++mq) {
      float sq = 0.f;
      h16* yr = yc + (size_t)(b * S + tq[mq]) * D + head * 64;
#pragma unroll
      for (int mt = 0; mt < 4; ++mt) {
        const float v[4] = {(float)ofin[mq][mt][0], (float)ofin[mq][mt][1], (float)ofin[mq][mt][2], (float)ofin[mq][mt][3]};
        sq += v[0] * v[0] + v[1] * v[1] + v[2] * v[2] + v[3] * v[3];
        const float4 gg = *(const float4*)(gn + 16 * mt + 4 * h);
        *(h16x4*)(yr + 16 * mt + 4 * h) = pack4(v[0] * gg.x, v[1] * gg.y, v[2] * gg.z, v[3] * gg.w);
      }
      sq += __shfl_xor(sq, 16);
      sq += __shfl_xor(sq, 32);
      sq += __shfl_xor(sq, 1);
      sq += __shfl_xor(sq, 2);
      if (h == 0 && g == 0) ssq[(size_t)(b * S + tq[mq]) * 2 + kv] = sq * (1.f / (ASCALE * ASCALE));
    }
  }
}

__device__ __forceinline__ void lrufix_item(const Params& p, int l, int item) {
  unsigned char* ws = p.ws;
  const int lane = tidx() & 63, wave = tidx() >> 6;
  const int b = item >> 7, ck = item & 127;
  const h16* P = (const h16*)(ws + OFF_P16);
  const float4 cy = *(const float4*)((const float*)(ws + OFF_CARRY) + (size_t)(b * 256 + ck * 2 + (wave >> 2)) * 256 + lane * 4);
  const float4 gn = *(const float4*)(p.in[I_ONG] + l * 1024 + lane * 4);
  h16* yc = (h16*)(ws + OFF_H16);
  for (int tt = wave * 8; tt < wave * 8 + 8; ++tt) {
    const size_t row = (size_t)(b * S + ck * 64 + tt);
    const float4 hl = *(const float4*)((const float*)(ws + OFF_LRUH) + row * 256 + lane * 4);
    const float4 al = *(const float4*)((const float*)(ws + OFF_LRUA) + row * 256 + lane * 4);
    const h16x4 gl = *(const h16x4*)(P + row * NIN + C_GL + lane * 4);
    const float y0 = (hl.x + al.x * cy.x) * gelu_tanh((float)gl[0]);
    const float y1 = (hl.y + al.y * cy.y) * gelu_tanh((float)gl[1]);
    const float y2 = (hl.z + al.z * cy.z) * gelu_tanh((float)gl[2]);
    const float y3 = (hl.w + al.w * cy.w) * gelu_tanh((float)gl[3]);
    const float rstd = rsqrtf(wsum(y0 * y0 + y1 * y1 + y2 * y2 + y3 * y3) * (1.f / 256.f) + EPS);
    *(h16x4*)(yc + row * D + 512 + lane * 4) = pack4(y0 * rstd * gn.x, y1 * rstd * gn.y, y2 * rstd * gn.z, y3 * rstd * gn.w);
  }
}

__device__ __forceinline__ void phase_attn(const Params& p, int l, float* sm) {
  for (int it = blockIdx.x; it < 256; it += gridDim.x) {
#pragma unroll 1
    for (int rep = 0; rep < 2; ++rep) attn_item(p, l, rep ? (127 - (it >> 2)) * 4 + (it & 3) : it, sm);
  }
  for (int it = blockIdx.x; it < 256; it += gridDim.x) lrufix_item(p, l, it);
}

__device__ __forceinline__ void phase_outproj(const Params& p, int l, h16* sm) {
  unsigned char* ws = p.ws;
  const h16* A = (const h16*)(ws + OFF_H16);
  const h16* W = (const h16*)(ws + OFF_WOUT);
  const float* mod = (const float*)(ws + OFF_MOD);
  float* xa = (float*)(ws + OFF_XA);
  const float* xin = l == 0 ? p.in[I_X] : (const float*)xa;
  const TileIter ti = xcd_tiles(64 * 4);
  for (int t = ti.cur; t < ti.end; t += ti.step) {
    const int mt = t >> 2, nt = t & 3;
    f32x4 acc[8][4];
    const h16* Ab = A + (size_t)mt * 256 * D;
    {
      float* sct = (float*)((unsigned char*)sm + SCHED_OFF - 1024);
      const int tq_ = tidx();
      if (tq_ < 256) {
        const float2 q2 = *(const float2*)((const float*)(ws + OFF_SSQ) + (size_t)(mt * 256 + tq_) * 2);
        sct[tq_] = rsqrtf((q2.x + q2.y) * (1.f / 512.f) + EPS) * (1.f / ASCALE);
      }
    }
    gemm_mainloop<256>(acc, [&](int r) { return Ab + (size_t)r * D; }, W + (size_t)nt * 256 * D, D, 8, sm);
    const int tid_e = tidx(), lane = tid_e & 63, wave = tid_e >> 6, wr = wave >> 2, wc = wave & 3, fr = lane & 15, fq = lane >> 4;
    {
      const float* sct = (const float*)((const unsigned char*)sm + SCHED_OFF - 1024) + wr * 128 + fr;
#pragma unroll
      for (int m = 0; m < 8; ++m) {
        const float sc = sct[m * 16];
#pragma unroll
        for (int n = 0; n < 4; ++n) acc[m][n] *= sc;
      }
    }
    gemm_mainloop<256>(acc, [&](int r) { return Ab + (size_t)r * D + 512; }, W + (size_t)nt * 256 * D + 512, D, 8, sm, false);
    {
      float* stf = (float*)sm;
      constexpr int LDF = 260;
#pragma unroll 1
      for (int pass = 0; pass < 2; ++pass) {
        if (wr == pass) {
#pragma unroll
          for (int m = 0; m < 8; ++m)
#pragma unroll
            for (int n = 0; n < 4; ++n) *(f32x4*)(stf + (m * 16 + fr) * LDF + wc * 64 + n * 16 + 4 * fq) = acc[m][n];
        }
        __syncthreads();
#pragma unroll 4
        for (int i = 0; i < 16; ++i) {
          const int idx = i * NTHREADS + tid_e;
          const int r = idx >> 6, c4 = (idx & 63) * 4;
          const int row = mt * 256 + pass * 128 + r, col = nt * 256 + c4;
          const int b = row >> 13;
          const f32x4 a = *(const f32x4*)(stf + r * LDF + c4);
          const float4 g1 = *(const float4*)(mod + (size_t)(l * 2 + b) * 6144 + 2048 + col);
          const float4 xv = *(const float4*)(xin + (size_t)row * D + col);
          float4 o;
          o.x = xv.x + g1.x * a[0]; o.y = xv.y + g1.y * a[1]; o.z = xv.z + g1.z * a[2]; o.w = xv.w + g1.w * a[3];
          *(float4*)(xa + (size_t)row * D + col) = o;
        }
        __syncthreads();
      }
    }
  }
}

__device__ __forceinline__ void phase_router(const Params& p, int l, int* smi) {
  unsigned char* ws = p.ws;
  const int tid = tidx(), lane = tid & 63, wave = tid >> 6;
  const float* mod = (const float*)(ws + OFF_MOD);
  const float* xa = (const float*)(ws + OFF_XA);
  h16* hout = (h16*)(ws + OFF_H16);
  unsigned* cnt = (unsigned*)(ws + OFF_CTL) + 64 + l * 16;
  int* list = (int*)(ws + OFF_LIST);
  float* wpair = (float*)(ws + OFF_WPAIR);
  const float* rgb = p.in[I_RGB] + l * 4;
  int* cntl = smi;
  int* basel = smi + 16;
  int* tok = smi + 32;
  float* wl = (float*)smi + 256;
  {
    const float4* s0 = (const float4*)(p.in[I_RGW] + (size_t)l * 1024 * 4);
    const float4* s1 = (const float4*)(p.in[I_REW] + (size_t)l * 4 * 1024 * 4);
    float4* d = (float4*)wl;
#pragma unroll
    for (int q = 0; q < 2; ++q) d[q * NTHREADS + tid] = s0[q * NTHREADS + tid];
#pragma unroll
    for (int q = 0; q < 8; ++q) d[1024 + q * NTHREADS + tid] = s1[q * NTHREADS + tid];
  }
  const float* rgw = wl;
  for (int chunk = blockIdx.x; chunk < T / 64; chunk += gridDim.x) {
    if (tid < 16) cntl[tid] = 0;
    __syncthreads();
    float4 xn[4];
#pragma unroll
    for (int i = 0; i < 4; ++i) xn[i] = *(const float4*)(xa + (size_t)(chunk * 64 + wave) * D + lane * 4 + 256 * i);
    for (int ti = wave; ti < 64; ti += NW) {
      const int row = chunk * 64 + ti;
      const int b = row >> 13;
      float4 x[4];
      float ss = 0.f;
#pragma unroll
      for (int i = 0; i < 4; ++i) x[i] = xn[i];
      if (ti + NW < 64) {
#pragma unroll
        for (int i = 0; i < 4; ++i) xn[i] = *(const float4*)(xa + (size_t)(row + NW) * D + lane * 4 + 256 * i);
      }
#pragma unroll
      for (int i = 0; i < 4; ++i) ss += x[i].x * x[i].x + x[i].y * x[i].y + x[i].z * x[i].z + x[i].w * x[i].w;
      ss = wsum(ss);
      const float rstd = rsqrtf(ss * (1.f / D) + EPS);
      float lg0 = 0.f, lg1 = 0.f, lg2 = 0.f, lg3 = 0.f;
#pragma unroll
      for (int i = 0; i < 4; ++i) {
        const int col = lane * 4 + 256 * i;
        const float4 g = *(const float4*)(p.in[I_N2G] + l * D + col);
        const float4 sh = *(const float4*)(mod + (size_t)(l * 2 + b) * 6144 + 3072 + col);
        const float4 sc = *(const float4*)(mod + (size_t)(l * 2 + b) * 6144 + 4096 + col);
        x[i].x = x[i].x * rstd * g.x * (1.f + sc.x) + sh.x;
        x[i].y = x[i].y * rstd * g.y * (1.f + sc.y) + sh.y;
        x[i].z = x[i].z * rstd * g.z * (1.f + sc.z) + sh.z;
        x[i].w = x[i].w * rstd * g.w * (1.f + sc.w) + sh.w;
        *(h16x4*)(hout + (size_t)row * D + col) = pack4(x[i].x, x[i].y, x[i].z, x[i].w);
        const float4 w0 = *(const float4*)(rgw + (size_t)(col + 0) * 4), w1 = *(const float4*)(rgw + (size_t)(col + 1) * 4);
        const float4 w2 = *(const float4*)(rgw + (size_t)(col + 2) * 4), w3 = *(const float4*)(rgw + (size_t)(col + 3) * 4);
        lg0 += x[i].x * w0.x + x[i].y * w1.x + x[i].z * w2.x + x[i].w * w3.x;
        lg1 += x[i].x * w0.y + x[i].y * w1.y + x[i].z * w2.y + x[i].w * w3.y;
        lg2 += x[i].x * w0.z + x[i].y * w1.z + x[i].z * w2.z + x[i].w * w3.z;
        lg3 += x[i].x * w0.w + x[i].y * w1.w + x[i].z * w2.w + x[i].w * w3.w;
      }
      lg0 = wsum(lg0) + rgb[0]; lg1 = wsum(lg1) + rgb[1]; lg2 = wsum(lg2) + rgb[2]; lg3 = wsum(lg3) + rgb[3];
      int gs = 0; float gm = lg0;
      if (lg1 > gm) { gm = lg1; gs = 1; }
      if (lg2 > gm) { gm = lg2; gs = 2; }
      if (lg3 > gm) { gm = lg3; gs = 3; }
      const float pg = 1.f / (__expf(lg0 - gm) + __expf(lg1 - gm) + __expf(lg2 - gm) + __expf(lg3 - gm));
      const float* rew = wl + 4096 + gs * 4096;
      const float* reb = p.in[I_REB] + (l * 4 + gs) * 4;
      float e0 = 0.f, e1 = 0.f, e2 = 0.f, e3 = 0.f;
#pragma unroll
      for (int i = 0; i < 4; ++i) {
        const int col = lane * 4 + 256 * i;
        const float4 w0 = *(const float4*)(rew + (size_t)(col + 0) * 4), w1 = *(const float4*)(rew + (size_t)(col + 1) * 4);
        const float4 w2 = *(const float4*)(rew + (size_t)(col + 2) * 4), w3 = *(const float4*)(rew + (size_t)(col + 3) * 4);
        e0 += x[i].x * w0.x + x[i].y * w1.x + x[i].z * w2.x + x[i].w * w3.x;
        e1 += x[i].x * w0.y + x[i].y * w1.y + x[i].z * w2.y + x[i].w * w3.y;
        e2 += x[i].x * w0.z + x[i].y * w1.z + x[i].z * w2.z + x[i].w * w3.z;
        e3 += x[i].x * w0.w + x[i].y * w1.w + x[i].z * w2.w + x[i].w * w3.w;
      }
      float le[4];
      le[0] = wsum(e0) + reb[0]; le[1] = wsum(e1) + reb[1]; le[2] = wsum(e2) + reb[2]; le[3] = wsum(e3) + reb[3];
      int i0 = 0; float v0 = le[0];
      if (le[1] > v0) { v0 = le[1]; i0 = 1; }
      if (le[2] > v0) { v0 = le[2]; i0 = 2; }
      if (le[3] > v0) { v0 = le[3]; i0 = 3; }
      int i1 = -1; float v1 = -3.0e38f;
#pragma unroll
      for (int j = 0; j < 4; ++j) {
        const float vj = (j == 0 ? le[0] : j == 1 ? le[1] : j == 2 ? le[2] : le[3]);
        if (j != i0 && vj > v1) { v1 = vj; i1 = j; }
      }
      const float p0 = 1.f / (1.f + __expf(v1 - v0));
      const float p1 = 1.f - p0;
      if (lane == 0) {
        const int ea = gs * 4 + i0, eb = gs * 4 + i1;
        const int ra = atomicAdd(&cntl[ea], 1);
        const int rb = atomicAdd(&cntl[eb], 1);
        tok[ti * 2] = ea | (ra << 8);
        tok[ti * 2 + 1] = eb | (rb << 8);
        wpair[row * 2] = pg * p0;
        wpair[row * 2 + 1] = pg * p1;
      }
    }
    __syncthreads();
    if (tid < 16) basel[tid] = (int)atomicAdd(&cnt[tid], (unsigned)cntl[tid]);
    __syncthreads();
    if (tid < 128) {
      const int v = tok[tid], e = v & 255, r = v >> 8;
      list[(size_t)e * 16384 + basel[e] + r] = (chunk * 64 + (tid >> 1)) * 2 + (tid & 1);
    }
    __syncthreads();
  }
}

__device__ __forceinline__ void moe_sched(const Params& p, int l, int* sl) {
  if (tidx() == 0) {
    const unsigned* cnt = (const unsigned*)(p.ws + OFF_CTL) + 64 + l * 16;
    int to = 0, ro = 0;
    sl[16] = 0; sl[33] = 0;
    for (int e = 0; e < 16; ++e) {
      const int c = (int)__hip_atomic_load(&cnt[e], __ATOMIC_RELAXED, __HIP_MEMORY_SCOPE_AGENT);
      sl[e] = c;
      to += (c + 255) >> 8; ro += c;
      sl[17 + e] = to; sl[34 + e] = ro;
    }
  }
  __syncthreads();
}
__device__ __forceinline__ void moe_tile(const int* sl, int t, int& e, int& nt, int& mt, int& cnt_e, int& roff_e) {
  int ee = 0;
  for (int k = 0; k < 15; ++k) ee += (t >= sl[17 + k] * 4) ? 1 : 0;
  ee = __builtin_amdgcn_readfirstlane(ee);
  const int t0 = __builtin_amdgcn_readfirstlane(sl[16 + ee]), t1 = __builtin_amdgcn_readfirstlane(sl[17 + ee]);
  const int nte = t1 - t0, rem = t - t0 * 4;
  e = ee; nt = rem / nte; mt = rem % nte;
  cnt_e = __builtin_amdgcn_readfirstlane(sl[ee]);
  roff_e = __builtin_amdgcn_readfirstlane(sl[33 + ee]);
}

template <int BN>
__device__ __forceinline__ void moe1_tile(const Params& p, h16* sm, const int* sl, int t, int half) {
  unsigned char* ws = p.ws;
  const h16* H = (const h16*)(ws + OFF_H16);
  h16* hid = (h16*)(ws + OFF_HID);
  int e, nt, mt, cnt_e, roff_e;
  moe_tile(sl, t, e, nt, mt, cnt_e, roff_e);
  const int* le = (const int*)(ws + OFF_LIST) + (size_t)e * 16384;
  f32x4 acc[8][BN / 64];
  gemm_mainloop<BN>(acc, [&](int r) { int so = mt * 256 + r; so = so < cnt_e ? so : 0; return H + (size_t)(le[so] >> 1) * D; },
                    (const h16*)(ws + OFF_WGU) + ((size_t)e * 1024 + nt * 256 + half * 128) * 1024, 1024, 16, sm);
  const int tid_e = tidx(), lane = tid_e & 63, wave = tid_e >> 6, wr = wave >> 2, wc = wave & 3, fr = lane & 15, fq = lane >> 4;
  constexpr int NC = BN / 2, LDR = NC + 8;
#pragma unroll
  for (int m = 0; m < 8; ++m)
#pragma unroll
    for (int n2 = 0; n2 < BN / 128; ++n2) {
      const f32x4 gt = acc[m][2 * n2], up = acc[m][2 * n2 + 1];
      *(h16x4*)(sm + (wr * 128 + m * 16 + fr) * LDR + wc * (BN / 8) + n2 * 16 + 4 * fq) =
          pack4(silu_f(gt[0]) * up[0], silu_f(gt[1]) * up[1], silu_f(gt[2]) * up[2], silu_f(gt[3]) * up[3]);
    }
  __syncthreads();
  constexpr int CH = NC / 8;
#pragma unroll
  for (int i = 0; i < CH / 2; ++i) {
    const int idx = i * NTHREADS + tid_e;
    const int r = idx / CH, c8 = idx % CH;
    const int so = mt * 256 + r;
    if (so < cnt_e) *(h16x8*)(hid + (size_t)(roff_e + so) * 512 + nt * 128 + half * 64 + c8 * 8) = *(const h16x8*)(sm + r * LDR + c8 * 8);
  }
  __syncthreads();
}
__device__ __forceinline__ void phase_moe1(const Params& p, int l, h16* sm) {
  int* sl = (int*)((unsigned char*)sm + SCHED_OFF);
  moe_sched(p, l, sl);
  const int total = __builtin_amdgcn_readfirstlane(sl[32]) * 4;
  const TileSched ts = xcd_sched(total);
  for (int t = ts.cur; t < ts.end; t += ts.step) moe1_tile<256>(p, sm, sl, t, 0);
  if (ts.tail_tile >= 0) {
    if (ts.tail_half < 0) moe1_tile<256>(p, sm, sl, ts.tail_tile, 0);
    else moe1_tile<128>(p, sm, sl, ts.tail_tile, ts.tail_half);
  }
}

template <int BN>
__device__ __forceinline__ void moe2_tile(const Params& p, h16* sm, const int* sl, int t, int half) {
  unsigned char* ws = p.ws;
  const float* wpair = (const float*)(ws + OFF_WPAIR);
  h16* yp = (h16*)(ws + OFF_YPAIR);
  int e, nt, mt, cnt_e, roff_e;
  moe_tile(sl, t, e, nt, mt, cnt_e, roff_e);
  const int* le = (const int*)(ws + OFF_LIST) + (size_t)e * 16384;
  const h16* Ab = (const h16*)(ws + OFF_HID) + (size_t)(roff_e + mt * 256) * 512;
  f32x4 acc[8][BN / 64];
  gemm_mainloop<BN>(acc, [&](int r) { return Ab + (size_t)r * 512; }, (const h16*)(ws + OFF_WDN) + ((size_t)e * 1024 + nt * 256 + half * 128) * 512, 512, 8, sm);
  const int tid_e = tidx(), lane = tid_e & 63, wave = tid_e >> 6, wr = wave >> 2, wc = wave & 3, fr = lane & 15, fq = lane >> 4;
  constexpr int LDR = BN + 8;
#pragma unroll
  for (int m = 0; m < 8; ++m) {
    const int so = mt * 256 + wr * 128 + m * 16 + fr;
    const float w = so < cnt_e ? wpair[le[so]] : 0.f;
#pragma unroll
    for (int n = 0; n < BN / 64; ++n)
      *(h16x4*)(sm + (wr * 128 + m * 16 + fr) * LDR + wc * (BN / 4) + n * 16 + 4 * fq) = pack4(acc[m][n][0] * w, acc[m][n][1] * w, acc[m][n][2] * w, acc[m][n][3] * w);
  }
  __syncthreads();
  constexpr int CH = BN / 8;
#pragma unroll
  for (int i = 0; i < CH / 2; ++i) {
    const int idx = i * NTHREADS + tid_e;
    const int r = idx / CH, c8 = idx % CH;
    const int so = mt * 256 + r;
    if (so < cnt_e) *(h16x8*)(yp + (size_t)le[so] * D + nt * 256 + half * 128 + c8 * 8) = *(const h16x8*)(sm + r * LDR + c8 * 8);
  }
  __syncthreads();
}
__device__ __forceinline__ void phase_moe2(const Params& p, int l, h16* sm) {
  int* sl = (int*)((unsigned char*)sm + SCHED_OFF);
  moe_sched(p, l, sl);
  const int total = __builtin_amdgcn_readfirstlane(sl[32]) * 4;
  const TileSched ts = xcd_sched(total);
  for (int t = ts.cur; t < ts.end; t += ts.step) moe2_tile<256>(p, sm, sl, t, 0);
  if (ts.tail_tile >= 0) {
    if (ts.tail_half < 0) moe2_tile<256>(p, sm, sl, ts.tail_tile, 0);
    else moe2_tile<128>(p, sm, sl, ts.tail_tile, ts.tail_half);
  }
}

#define XB_TMO      128
#define XB_XCNT(j)  (256  + 64 * (j))
#define XB_XSUB(j)  (1280 + 64 * (j))
#define XB_XGEN(j)  (2304 + 64 * (j))
#define XB_TOP      3328
#define XB_TOPGEN   3392
#define XCD_BAR_WORDS 3456
#define XB_SPIN_CAP (1u << 20)
__device__ __forceinline__ unsigned xb_ld(unsigned* p) { return __hip_atomic_load(p, __ATOMIC_RELAXED, __HIP_MEMORY_SCOPE_AGENT); }
__device__ __forceinline__ unsigned xb_add(unsigned* p, unsigned v) { return __hip_atomic_fetch_add(p, v, __ATOMIC_RELAXED, __HIP_MEMORY_SCOPE_AGENT); }
__device__ __forceinline__ unsigned xb_xcc_id() { return (unsigned)__builtin_amdgcn_s_getreg((3 << 11) | 20) & 0xFu; }
#define XB_SPIN(cond, bar) do { unsigned _sp = 0; while (cond) { __builtin_amdgcn_s_sleep(1); \
    if ((++_sp & 255u) == 0u) { if (xb_ld(&(bar)[XB_TMO])) break; if (_sp > XB_SPIN_CAP) { atomicAdd(&(bar)[XB_TMO], 1u); break; } } } } while (0)
struct XBar { unsigned* bar; unsigned x; volatile unsigned* st; };
__device__ __forceinline__ void xbar_post(XBar& b, unsigned* bar, volatile unsigned* st) {
  b.bar = bar; b.x = xb_xcc_id(); b.st = st;
  if (tidx() == 0) { st[0] = 0u; st[1] = 0u; (void)xb_add(&bar[XB_XCNT(b.x)], 1u); }
}
__device__ __forceinline__ void xbar_census(unsigned* bar, unsigned x, unsigned& nloc, unsigned& nx) {
  const unsigned G = gridDim.x;
  unsigned sum, cnt, mine, sp = 0u;
  for (;;) {
    sum = 0u; cnt = 0u; mine = 0u;
#pragma unroll
    for (unsigned j = 0; j < 16; ++j) { const unsigned c = xb_ld(&bar[XB_XCNT(j)]); sum += c; cnt += (c > 0u) ? 1u : 0u; mine = (j == x) ? c : mine; }
    if (sum == G) break;
    __builtin_amdgcn_s_sleep(1);
    if ((++sp & 255u) == 0u) { if (xb_ld(&bar[XB_TMO])) break; if (sp > XB_SPIN_CAP) { atomicAdd(&bar[XB_TMO], 1u); break; } }
  }
  nloc = mine > 0u ? mine : 1u; nx = cnt > 0u ? cnt : 1u;
}
__device__ __forceinline__ void xbar_sync(XBar& b) {
  asm volatile("s_waitcnt vmcnt(0)" ::: "memory");
  __syncthreads();
  if (tidx() == 0) {
    unsigned* bar = b.bar;
    __builtin_amdgcn_s_waitcnt(0);
    unsigned nloc = b.st[0], nx = b.st[1];
    if (nloc == 0u) { xbar_census(bar, b.x, nloc, nx); b.st[0] = nloc; b.st[1] = nx; }
    const unsigned old = xb_add(&bar[XB_XSUB(b.x)], 1u);
    const unsigned gen = old / nloc;
    if (old + 1u == (gen + 1u) * nloc) {
      __builtin_amdgcn_fence(__ATOMIC_RELEASE, "agent");
      asm volatile("s_waitcnt vmcnt(0)" ::: "memory");
      const unsigned og = xb_add(&bar[XB_TOP], 1u);
      const unsigned tg = og / nx;
      if (og + 1u == (tg + 1u) * nx) xb_add(&bar[XB_TOPGEN], 1u);
      else XB_SPIN(xb_ld(&bar[XB_TOPGEN]) == tg, bar);
      __builtin_amdgcn_fence(__ATOMIC_ACQUIRE, "agent");
      xb_add(&bar[XB_XGEN(b.x)], 1u);
      asm volatile("s_waitcnt vmcnt(0)" ::: "memory");
    } else {
      XB_SPIN(xb_ld(&bar[XB_XGEN(b.x)]) == gen, bar);
      __builtin_amdgcn_fence(__ATOMIC_ACQUIRE, "agent");
      asm volatile("s_waitcnt vmcnt(0)" ::: "memory");
    }
  }
  __syncthreads();
}

constexpr int NSTEPS = 22;
#define STEP(k, body) do { if (s_lo <= (k) && (k) < s_hi) { body; if ((k) + 1 < s_hi) { xbar_sync(xb); } \
    if (PROBE_MASK != 0u) { unsigned long long now_ = __builtin_amdgcn_s_memrealtime(); \
      if ((PROBE_MASK >> (k)) & 1u) { const unsigned long long w_ = (now_ - pt_prev) * PROBE_AMP; \
        while (__builtin_amdgcn_s_memrealtime() - now_ < w_) __builtin_amdgcn_s_sleep(8); now_ = __builtin_amdgcn_s_memrealtime(); } \
      pt_prev = now_; } } } while (0)
#define LAYER_STEPS(l, base) \
  STEP(base + 0, phase_norm1(p, l); if (l == 1) phase_convert(p, 1, (float*)smem)); \
  STEP(base + 1, phase_inproj(p, (h16*)smem)); \
  STEP(base + 2, phase_post(p)); \
  STEP(base + 3, phase_mixa(p, l, smem)); \
  STEP(base + 4, phase_mixb(p, l, (float*)smem)); \
  STEP(base + 5, phase_attn(p, l, (float*)smem)); \
  STEP(base + 6, phase_outproj(p, l, (h16*)smem)); \
  STEP(base + 7, phase_router(p, l, (int*)smem)); \
  STEP(base + 8, phase_moe1(p, l, (h16*)smem)); \
  STEP(base + 9, phase_moe2(p, l, (h16*)smem))

__global__ void __launch_bounds__(NTHREADS, 2) mega(Params p, int s_lo, int s_hi) {
  extern __shared__ __attribute__((aligned(16))) unsigned char smem[];
  unsigned long long pt_prev = PROBE_MASK != 0u ? __builtin_amdgcn_s_memrealtime() : 0ull;
  XBar xb;
  xbar_post(xb, (unsigned*)(p.ws + OFF_BAR), (volatile unsigned*)(smem + LDS_BYTES - 16));
  STEP(0, phase_prep(p, (float*)smem); phase_convert(p, 0, (float*)smem));
  LAYER_STEPS(0, 1);
  LAYER_STEPS(1, 11);
  STEP(21, phase_norm1(p, 2));
}

extern "C" void kernel_launch(void* const* d_in, const int* in_sizes, int n_in, void* d_out, int out_size, void* d_ws, size_t ws_size,
                              hipStream_t stream) {
  static int grid_blocks = 0;
  if (!grid_blocks) {
    if (n_in != 35 || out_size != T * D || ws_size < WS_TOTAL) {
      fprintf(stderr, "kernel_launch: unexpected problem (n_in %d, out %d, ws %zu < %zu)\n", n_in, out_size, ws_size, (size_t)WS_TOTAL);
      grid_blocks = -1;
      return;
    }
    int dev = 0, cus = 0, per_cu = 0;
    hipGetDevice(&dev);
    hipDeviceGetAttribute(&cus, hipDeviceAttributeMultiprocessorCount, dev);
    if (hipFuncSetAttribute((const void*)mega, hipFuncAttributeMaxDynamicSharedMemorySize, LDS_BYTES) != hipSuccess) {
      fprintf(stderr, "kernel_launch: hipFuncSetAttribute(%d B dynamic LDS) failed\n", LDS_BYTES);
      grid_blocks = -1;
      return;
    }
    hipOccupancyMaxActiveBlocksPerMultiprocessor(&per_cu, mega, NTHREADS, LDS_BYTES);
    if (per_cu > 1) per_cu = 1;
    if (per_cu < 1) { fprintf(stderr, "kernel_launch: occupancy query returned %d\n", per_cu); grid_blocks = -1; return; }
    grid_blocks = cus * per_cu;
  }
  if (grid_blocks < 0) return;
  Params p{};
  for (int i = 0; i < 35; ++i) p.in[i] = (const float*)d_in[i];
  p.out = (float*)d_out;
  p.ws = (unsigned char*)d_ws;
  for (int i = 0; i < 32; ++i) p.inv_freq[i] = std::pow(10000.0, -(double)(2 * i) / 64.0);
  if (hipMemsetAsync((char*)d_ws + OFF_BAR, 0, 16384, stream) != hipSuccess) { fprintf(stderr, "kernel_launch: memset of barrier words failed\n"); return; }
#if MEGA
  int lo = 0, hi = NSTEPS;
  void* args[] = {&p, &lo, &hi};
  hipError_t e = hipLaunchCooperativeKernel((void*)mega, dim3(grid_blocks), dim3(NTHREADS), args, LDS_BYTES, stream);
  if (e != hipSuccess) fprintf(stderr, "cooperative launch failed: %s (grid %d)\n", hipGetErrorString(e), grid_blocks);
#else
  for (int s = 0; s < NSTEPS; ++s) {
    int lo = s, hi = s + 1;
    void* args[] = {&p, &lo, &hi};
    hipError_t e = hipLaunchCooperativeKernel((void*)mega, dim3(grid_blocks), dim3(NTHREADS), args, LDS_BYTES, stream);
    if (e != hipSuccess) { fprintf(stderr, "launch %d failed: %s (grid %d)\n", s, hipGetErrorString(e), grid_blocks); break; }
  }
#endif
}
```

```cpp
#include <hip/hip_runtime.h>
#include <hip/hip_cooperative_groups.h>
#include <cstdio>
#include <cstdint>
#include <cmath>
namespace cg = cooperative_groups;

#ifndef MEGA
#define MEGA 1
#endif
#ifndef PROBE_MASK
#define PROBE_MASK 0u
#define PROBE_AMP 3
#endif

typedef _Float16 h16;
typedef _Float16 h16x8 __attribute__((ext_vector_type(8)));
typedef _Float16 h16x4 __attribute__((ext_vector_type(4)));
typedef float f32x4 __attribute__((ext_vector_type(4)));

constexpr int NB = 2, S = 8192, T = NB * S, D = 1024;
constexpr int NIN = 2432;
constexpr int NINSRC = 2328;
constexpr int C_XL = 0, C_GL = 256, C_Q = 512, C_KC = 1024, C_VC = 1152, C_KS = 1280, C_VS = 1408, C_KW = 1536, C_VW = 1664,
              C_CVA = 1792, C_CVB = 2048, C_GATE = 2304;
constexpr float EPS = 1e-6f;
constexpr int NTHREADS = 512, NW = 8;
constexpr int LDS_BYTES = 150528;
constexpr int NINP = 2560;
constexpr int SCHED_OFF = LDS_BYTES - 1024;
constexpr float ASCALE = 16.f;

constexpr size_t al256(size_t x) { return (x + 255) & ~(size_t)255; }
constexpr size_t OFF_CTL = 0;
constexpr size_t OFF_BAR = 4096;
constexpr size_t OFF_MOD = 4096 + 16384;
constexpr size_t OFF_ROPE = al256(OFF_MOD + 2 * 2 * 6144 * 4);
constexpr size_t OFF_PB = al256(OFF_ROPE + (size_t)T * 64 * 4);
constexpr size_t OFF_PBPART = al256(OFF_PB + 2 * 256 * 4);
constexpr size_t OFF_LRUW = al256(OFF_PBPART + 2 * 32 * 256 * 4);
constexpr size_t OFF_GATES = al256(OFF_LRUW + 2 * 4 * 64 * 64 * 2);
constexpr size_t OFF_WIN = al256(OFF_GATES + (size_t)T * 24 * 4);
constexpr size_t OFF_WOUT = al256(OFF_WIN + (size_t)NINP * 1024 * 2);
constexpr size_t OFF_WGU = al256(OFF_WOUT + (size_t)1024 * 1024 * 2);
constexpr size_t OFF_WDN = al256(OFF_WGU + (size_t)16 * 1024 * 1024 * 2);
constexpr size_t OFF_W1K = al256(OFF_WDN + (size_t)16 * 1024 * 512 * 2);
constexpr size_t OFF_W1V = al256(OFF_W1K + (size_t)256 * 2048 * 2);
constexpr size_t OFF_H16 = al256(OFF_W1V + (size_t)256 * 2048 * 2);
constexpr size_t OFF_Q16 = al256(OFF_H16 + (size_t)T * 1024 * 2);
constexpr size_t KVSZ = (size_t)T * 128 * 2;
constexpr size_t OFF_KC = al256(OFF_Q16 + (size_t)T * 512 * 2);
constexpr size_t OFF_VC = al256(OFF_KC + KVSZ + 4096);
constexpr size_t OFF_KS = al256(OFF_VC + KVSZ + 4096);
constexpr size_t OFF_VST = al256(OFF_KS + KVSZ);
constexpr size_t OFF_KW = al256(OFF_VST + KVSZ);
constexpr size_t OFF_VWT = al256(OFF_KW + KVSZ);
constexpr size_t OFF_HIDC = al256(OFF_VWT + KVSZ);
constexpr size_t OFF_KCMP = al256(OFF_HIDC + (size_t)2 * 2048 * 256 * 2);
constexpr size_t OFF_VCMPT = al256(OFF_KCMP + (size_t)4 * 512 * 64 * 2);
constexpr size_t OFF_LRUH = al256(OFF_VCMPT + (size_t)4 * 512 * 64 * 2);
constexpr size_t OFF_LRUA = al256(OFF_LRUH + (size_t)T * 256 * 4);
constexpr size_t OFF_HEND = al256(OFF_LRUA + (size_t)T * 256 * 4);
constexpr size_t OFF_AEND = al256(OFF_HEND + 2 * 256 * 256 * 4);
constexpr size_t OFF_CARRY = al256(OFF_AEND + 2 * 256 * 256 * 4);
constexpr size_t OFF_XA = al256(OFF_CARRY + 2 * 256 * 256 * 4);
constexpr size_t OFF_LIST = al256(OFF_XA + (size_t)T * 1024 * 4);
constexpr size_t OFF_WPAIR = al256(OFF_LIST + (size_t)16 * 16384 * 4);
constexpr size_t OFF_SSQ = al256(OFF_WPAIR + 32768 * 4);
constexpr size_t OFF_R = al256(OFF_SSQ + (size_t)T * 2 * 4);
constexpr size_t OFF_P16 = OFF_R;
constexpr size_t OFF_HID = OFF_R;
constexpr size_t OFF_YPAIR = al256(OFF_HID + (size_t)(32768 + 512) * 512 * 2);
constexpr size_t OFF_HIDP = al256(OFF_P16 + (size_t)T * NIN * 2);
constexpr size_t R_END1 = OFF_HIDP + (size_t)4 * 2 * 2048 * 256 * 4;
constexpr size_t R_END2 = OFF_YPAIR + (size_t)32768 * 1024 * 2;
constexpr size_t WS_TOTAL = al256(R_END1 > R_END2 ? R_END1 : R_END2);

struct Params {
  const float* in[35];
  float* out;
  unsigned char* ws;
  double inv_freq[32];
};
enum { I_X = 0, I_C, I_POS, I_ADAW, I_ADAB, I_N1G, I_N2G, I_WIN, I_LCW, I_LCB, I_LWA, I_LBA, I_LWX, I_LBX, I_LLAM, I_CKW1, I_CKW2,
       I_CVW1, I_CVW2, I_CPK, I_CPV, I_DWW, I_DWB, I_LNG, I_LNB, I_ONG, I_WOUT, I_RGW, I_RGB, I_REW, I_REB, I_MG, I_MU, I_MD, I_FNG };

__device__ __forceinline__ int tidx() { int t = threadIdx.x; asm volatile("" : "+v"(t)); return t; }
__device__ __forceinline__ float wsum(float v) {
#pragma unroll
  for (int o = 32; o > 0; o >>= 1) v += __shfl_xor(v, o);
  return v;
}
__device__ __forceinline__ float sigm(float x) { return 1.f / (1.f + __expf(-x)); }
__device__ __forceinline__ float silu_f(float x) { return x / (1.f + __expf(-x)); }
__device__ __forceinline__ float gelu_tanh(float x) {
  float u = 0.7978845608028654f * (x + 0.044715f * x * x * x);
  float e = __expf(2.f * u);
  float t = 1.f - 2.f / (e + 1.f);
  return 0.5f * x * (1.f + t);
}
__device__ __forceinline__ void glds16(const h16* g, h16* l) {
  __builtin_amdgcn_global_load_lds((const unsigned*)g, (unsigned*)l, 16, 0, 0);
}
__device__ __forceinline__ h16x4 pack4(float a, float b, float c, float d) {
  h16x4 r; r[0] = (h16)a; r[1] = (h16)b; r[2] = (h16)c; r[3] = (h16)d; return r;
}

struct TileIter { int cur, end, step; };
__device__ __forceinline__ TileIter xcd_tiles(int ntiles) {
  const int G = gridDim.x, b = blockIdx.x;
  TileIter it;
  if ((G & 7) == 0) {
    const int x = b & 7;
    it.cur = (int)(((long)ntiles * x) >> 3) + (b >> 3);
    it.end = (int)(((long)ntiles * (x + 1)) >> 3);
    it.step = G >> 3;
  } else { it.cur = b; it.end = ntiles; it.step = G; }
  return it;
}

#define VMCNT(n) asm volatile("s_waitcnt vmcnt(" #n ")" ::: "memory")
template <int BN, class ARowFn>
__device__ __forceinline__ void gemm_mainloop(f32x4 (&acc)[8][BN / 64], ARowFn arow, const h16* __restrict__ Bt, int ldb, int nk, h16* sm, bool zero_init = true) {
  constexpr int NF = BN / 64, NBP = BN / 64;
  constexpr int STAGE = 16384 + BN * 64;
  constexpr int NST = BN == 128 ? 3 : 2;
  const int tid = tidx(), lane = tid & 63, wave = tid >> 6;
  const int wr = wave >> 2, wc = wave & 3, fr = lane & 15, fq = lane >> 4;
  const h16* ap[4];
  const h16* bp[NBP];
#pragma unroll
  for (int i = 0; i < 4; ++i) {
    const int r = (i * 8 + wave) * 8 + (lane >> 3);
    const int c = (lane & 7) ^ ((r >> 1) & 7);
    ap[i] = arow(r) + c * 8;
    if (i < NBP) bp[i] = Bt + (size_t)r * ldb + c * 8;
  }
  if (zero_init) {
#pragma unroll
    for (int m = 0; m < 8; ++m)
#pragma unroll
      for (int n = 0; n < NF; ++n) acc[m][n] = (f32x4){0.f, 0.f, 0.f, 0.f};
  }
  h16* const dA = sm + wave * 512 + lane * 8;
#pragma unroll
  for (int st0 = 0; st0 < NST - 1; ++st0)
    if (st0 < nk) {
#pragma unroll
      for (int i = 0; i < 4; ++i) { glds16(ap[i], dA + st0 * STAGE + i * 4096); ap[i] += 64; }
#pragma unroll
      for (int i = 0; i < NBP; ++i) { glds16(bp[i], dA + st0 * STAGE + 16384 + i * 4096); bp[i] += 64; }
    }
  const int sw = (fr >> 1) & 7;
  const int aoff = (wr * 128 + fr) * 64, boff = 16384 + (wc * (BN / 4) + fr) * 64;
#define SCHED_FENCE() __builtin_amdgcn_sched_barrier(0)
  for (int kt = 0; kt < nk; ++kt) {
    if (NST == 3 && kt + 1 < nk) VMCNT(6); else VMCNT(0);
    __builtin_amdgcn_s_barrier();
    const int sl_ = NST == 3 ? kt % 3 : (kt & 1);
    const h16* st = sm + sl_ * STAGE;
    const bool more = kt + (NST - 1) < nk;
    h16* const dn = dA + (NST == 3 ? (sl_ == 0 ? 2 : sl_ - 1) : (sl_ ^ 1)) * STAGE;
#pragma unroll
    for (int ks = 0; ks < 2; ++ks) {
      const int ch = ((ks * 4 + fq) ^ sw) * 8;
      h16x8 bf[NF];
#pragma unroll
      for (int n = 0; n < NF; ++n) bf[n] = *(const h16x8*)(st + boff + n * 1024 + ch);
#pragma unroll
      for (int mh = 0; mh < 2; ++mh) {
        h16x8 af[4];
#pragma unroll
        for (int m = 0; m < 4; ++m) af[m] = *(const h16x8*)(st + aoff + (mh * 4 + m) * 1024 + ch);
#pragma unroll
        for (int m = 0; m < 4; ++m) {
#pragma unroll
          for (int n = 0; n < NF; ++n) acc[mh * 4 + m][n] = __builtin_amdgcn_mfma_f32_16x16x32_f16(bf[n], af[m], acc[mh * 4 + m][n], 0, 0, 0);
          if (m == 1 || m == 3) {
            const int q = ks * 4 + mh * 2 + (m >> 1);
            SCHED_FENCE();
            if (more) {
              if (q < 4) { glds16(ap[q & 3], dn + (q & 3) * 4096); ap[q & 3] += 64; }
              else if ((q & 3) < NBP) { glds16(bp[(q & 3) < NBP ? (q & 3) : 0], dn + 16384 + (q & 3) * 4096); bp[(q & 3) < NBP ? (q & 3) : 0] += 64; }
            }
            SCHED_FENCE();
          }
        }
      }
    }
  }
#undef SCHED_FENCE
  __builtin_amdgcn_s_barrier();
}

struct TileSched { int cur, end, step, tail_tile, tail_half; };
__device__ __forceinline__ TileSched xcd_sched(int ntiles) {
  const int G = gridDim.x, b = blockIdx.x;
  TileSched s;
  s.tail_tile = -1; s.tail_half = -1;
  if ((G & 7) == 0) {
    const int x = b & 7, nb = G >> 3, si = b >> 3;
    const int lo = (int)(((long)ntiles * x) >> 3), hi = (int)(((long)ntiles * (x + 1)) >> 3);
    const int n = hi - lo, R = n / nb, rem = n - R * nb;
    s.cur = lo + si; s.end = lo + R * nb; s.step = nb;
    if (rem * 2 <= nb) { if (si < 2 * rem) { s.tail_tile = lo + R * nb + (si >> 1); s.tail_half = si & 1; } }
    else if (si < rem) s.tail_tile = lo + R * nb + si;
  } else { s.cur = b; s.end = ntiles; s.step = G; }
  return s;
}

__device__ __forceinline__ int map_row(int mode, int n) {
  if (mode == 1) return n < 1792 ? n : (n < 1816 ? n + 512 : n - 24);
  if (mode == 2) return 32 * (n >> 4) + (n & 15);
  if (mode == 3) return 32 * (n >> 4) + 16 + (n & 15);
  return n;
}
struct ConvTile { const float* src; h16* dst; int K, N, mode, k0, n0; const float* pos; float* pbp; };
__device__ __forceinline__ ConvTile conv_decode(const Params& p, int l, int t) {
  unsigned char* ws = p.ws;
  constexpr int T_WIN = 16 * 37, T_WOUT = 256, T_G = 16 * 128, T_W1 = 128;
  constexpr int E0 = T_WIN, E1 = E0 + T_WOUT, E2 = E1 + T_G, E3 = E2 + T_G, E4 = E3 + T_G, E5 = E4 + T_W1;
  ConvTile c;
  c.pos = nullptr; c.pbp = nullptr;
  int tk, tn;
  if (t < E0) {
    c.src = p.in[I_WIN] + (size_t)l * 1024 * NINSRC; c.K = 1024; c.N = NINSRC; c.dst = (h16*)(ws + OFF_WIN); c.mode = 1; tk = t / 37; tn = t % 37;
  } else if (t < E1) {
    const int u = t - E0;
    c.src = p.in[I_WOUT] + (size_t)l * 1024 * 1024; c.K = 1024; c.N = 1024; c.dst = (h16*)(ws + OFF_WOUT); c.mode = 4; tk = u >> 4; tn = u & 15;
  } else if (t < E3) {
    const int up = t >= E2;
    const int u = t - (up ? E2 : E1);
    const int e = u >> 7, v = u & 127;
    c.src = p.in[up ? I_MU : I_MG] + ((size_t)l * 16 + e) * 1024 * 512; c.K = 1024; c.N = 512; c.dst = (h16*)(ws + OFF_WGU) + (size_t)e * 1024 * 1024;
    c.mode = up ? 3 : 2; tk = v >> 3; tn = v & 7;
  } else if (t < E4) {
    const int u = t - E3;
    const int e = u >> 7, v = u & 127;
    c.src = p.in[I_MD] + ((size_t)l * 16 + e) * 512 * 1024; c.K = 512; c.N = 1024; c.dst = (h16*)(ws + OFF_WDN) + (size_t)e * 1024 * 512; c.mode = 0; tk = v >> 4; tn = v & 15;
  } else {
    const int vv = t >= E5;
    const int u = t - (vv ? E5 : E4);
    c.src = p.in[vv ? I_CVW1 : I_CKW1] + (size_t)l * 2048 * 256; c.K = 2048; c.N = 256; c.dst = (h16*)(ws + (vv ? OFF_W1V : OFF_W1K)); c.mode = 5; tk = u >> 2; tn = u & 3;
    c.pos = p.in[vv ? I_CPV : I_CPK] + (size_t)l * 2048 + tk * 64;
    c.pbp = (float*)(ws + OFF_PBPART) + (size_t)(vv * 32 + tk) * 256 + tn * 64;
  }
  c.k0 = tk * 64; c.n0 = tn * 64;
  return c;
}
__device__ __forceinline__ void conv_wave_tile(const ConvTile& c, float* smw, int lane) {
  float4 v[16];
#pragma unroll
  for (int i = 0; i < 16; ++i) {
    const int idx = i * 64 + lane;
    const int r = idx >> 4, c4 = (idx & 15) * 4;
    v[i] = make_float4(0.f, 0.f, 0.f, 0.f);
    if (c.n0 + c4 < c.N) v[i] = *(const float4*)(c.src + (size_t)(c.k0 + r) * c.N + c.n0 + c4);
  }
#pragma unroll
  for (int i = 0; i < 16; ++i) {
    const int idx = i * 64 + lane;
    const int r = idx >> 4, c4 = (idx & 15) * 4;
    float* d = smw + r * 65 + c4;
    d[0] = v[i].x; d[1] = v[i].y; d[2] = v[i].z; d[3] = v[i].w;
  }
  if (c.mode == 5) {
    float sacc = 0.f;
    for (int k = 0; k < 64; ++k) sacc += c.pos[k] * smw[k * 65 + lane];
    c.pbp[lane] = sacc;
  }
  const int k0d = c.mode == 4 ? (c.k0 < 256 ? c.k0 + 512 : (c.k0 < 768 ? c.k0 - 256 : c.k0)) : c.k0;
#pragma unroll
  for (int j = 0; j < 8; ++j) {
    const int ch = j * 64 + lane;
    const int n = ch >> 3, kc = ch & 7;
    if (c.n0 + n < c.N) {
      h16x8 o;
#pragma unroll
      for (int q = 0; q < 8; ++q) o[q] = (h16)smw[(kc * 8 + q) * 65 + n];
      *(h16x8*)(c.dst + (size_t)map_row(c.mode, c.n0 + n) * c.K + k0d + kc * 8) = o;
    }
  }
}

__device__ __forceinline__ void phase_convert(const Params& p, int l, float* sm) {
  unsigned char* ws = p.ws;
  constexpr int NT_CONV = 16 * 37 + 256 + 3 * 16 * 128 + 2 * 128;
  {
    const int tid = tidx(), lane = tid & 63, wave = tid >> 6;
    float* smw = sm + wave * 4160;
    for (int t = blockIdx.x * NW + wave; t < NT_CONV; t += gridDim.x * NW) {
      const ConvTile c = conv_decode(p, l, t);
      conv_wave_tile(c, smw, lane);
    }
    __syncthreads();
  }
  {
    h16* lw = (h16*)(ws + OFF_LRUW);
    for (int i = blockIdx.x * NTHREADS + tidx(); i < 2 * 4 * 64 * 64; i += gridDim.x * NTHREADS) {
      const int d = i & 63, e = (i >> 6) & 63, n = (i >> 12) & 3, mat = i >> 14;
      lw[i] = (h16)p.in[mat ? I_LWX : I_LWA][((size_t)(l * 4 + n) * 64 + d) * 64 + e];
    }
  }
  {
    h16x8 z = {0, 0, 0, 0, 0, 0, 0, 0};
    h16* w = (h16*)(ws + OFF_WIN) + (size_t)NINSRC * 1024;
    for (int i = blockIdx.x * NTHREADS + tidx(); i < (NINP - NINSRC) * 1024 / 8; i += gridDim.x * NTHREADS) *(h16x8*)(w + (size_t)i * 8) = z;
  }
}

__device__ __forceinline__ void phase_prep(const Params& p, float* sm) {
  unsigned char* ws = p.ws;
  const int tid = tidx();
  if (blockIdx.x == 0) {
    for (int i = tid; i < 1024; i += NTHREADS) ((unsigned*)(ws + OFF_CTL))[i] = 0u;
  }
  float* mod = (float*)(ws + OFF_MOD);
  for (int t = blockIdx.x; t < 384; t += gridDim.x) {
    const int l = t / 192, j0 = (t % 192) * 32;
    const int kg = tid >> 3, cq = tid & 7;
    const float* w = p.in[I_ADAW] + (size_t)l * 1024 * 6144 + j0 + 4 * cq;
    const float* c = p.in[I_C];
    float a0[4] = {0, 0, 0, 0}, a1[4] = {0, 0, 0, 0};
#pragma unroll 8
    for (int k = kg * 16; k < kg * 16 + 16; ++k) {
      const float4 wv = *(const float4*)(w + (size_t)k * 6144);
      const float s0 = silu_f(c[k]), s1 = silu_f(c[1024 + k]);
      a0[0] += s0 * wv.x; a0[1] += s0 * wv.y; a0[2] += s0 * wv.z; a0[3] += s0 * wv.w;
      a1[0] += s1 * wv.x; a1[1] += s1 * wv.y; a1[2] += s1 * wv.z; a1[3] += s1 * wv.w;
    }
    float* r = sm + (kg * 8 + cq) * 8;
#pragma unroll
    for (int i = 0; i < 4; ++i) { r[i] = a0[i]; r[4 + i] = a1[i]; }
    __syncthreads();
    if (tid < 64) {
      const int bb = tid >> 5, col = tid & 31, q = col >> 2, ci = col & 3;
      float s = 0.f;
      for (int g = 0; g < 64; ++g) s += sm[(g * 8 + q) * 8 + bb * 4 + ci];
      mod[(size_t)(l * 2 + bb) * 6144 + j0 + col] = s + p.in[I_ADAB][l * 6144 + j0 + col];
    }
    __syncthreads();
  }
  float* rc = (float*)(ws + OFF_ROPE);
  float* rs = rc + (size_t)T * 32;
  const int* pos = (const int*)p.in[I_POS];
  for (int i = blockIdx.x * NTHREADS + tid; i < T * 32; i += gridDim.x * NTHREADS) {
    const int t = i >> 5, f = i & 31;
    const double a = (double)pos[t] * p.inv_freq[f];
    const double n = rint(a * 0.15915494309189535);
    double r = fma(-n, 6.283185307179586, a);
    r = fma(-n, 2.4492935982947064e-16, r);
    const float rf = (float)r;
    rc[i] = cosf(rf);
    rs[i] = sinf(rf);
  }
}

__device__ __forceinline__ void phase_norm1(const Params& p, int mode) {
  unsigned char* ws = p.ws;
  const int lane = tidx() & 63, wave = tidx() >> 6;
  const float* mod = (const float*)(ws + OFF_MOD);
  float* xa = (float*)(ws + OFF_XA);
  const h16* yp = (const h16*)(ws + OFF_YPAIR);
  h16* hout = (h16*)(ws + OFF_H16);
  const int l = (mode == 0) ? 0 : 1;
  for (int row = blockIdx.x * NW + wave; row < T; row += gridDim.x * NW) {
    const int b = row >> 13;
    float4 x[4];
    float ss = 0.f;
#pragma unroll
    for (int i = 0; i < 4; ++i) {
      const int col = lane * 4 + 256 * i;
      if (mode == 0) {
        x[i] = *(const float4*)(p.in[I_X] + (size_t)row * D + col);
      } else {
        const int lp = mode == 1 ? 0 : 1;
        const float4 xv = *(const float4*)(xa + (size_t)row * D + col);
        const float4 g2 = *(const float4*)(mod + (size_t)(lp * 2 + b) * 6144 + 5120 + col);
        const h16x4 y0 = *(const h16x4*)(yp + (size_t)(row * 2) * D + col);
        const h16x4 y1 = *(const h16x4*)(yp + (size_t)(row * 2 + 1) * D + col);
        x[i].x = xv.x + g2.x * ((float)y0[0] + (float)y1[0]);
        x[i].y = xv.y + g2.y * ((float)y0[1] + (float)y1[1]);
        x[i].z = xv.z + g2.z * ((float)y0[2] + (float)y1[2]);
        x[i].w = xv.w + g2.w * ((float)y0[3] + (float)y1[3]);
        if (mode == 1) *(float4*)(xa + (size_t)row * D + col) = x[i];
      }
      ss += x[i].x * x[i].x + x[i].y * x[i].y + x[i].z * x[i].z + x[i].w * x[i].w;
    }
    ss = wsum(ss);
    const float rstd = rsqrtf(ss * (1.f / D) + EPS);
#pragma unroll
    for (int i = 0; i < 4; ++i) {
      const int col = lane * 4 + 256 * i;
      if (mode == 2) {
        const float4 g = *(const float4*)(p.in[I_FNG] + col);
        float4 o;
        o.x = x[i].x * rstd * g.x; o.y = x[i].y * rstd * g.y; o.z = x[i].z * rstd * g.z; o.w = x[i].w * rstd * g.w;
        *(float4*)(p.out + (size_t)row * D + col) = o;
      } else {
        const float4 g = *(const float4*)(p.in[I_N1G] + l * D + col);
        const float4 sh = *(const float4*)(mod + (size_t)(l * 2 + b) * 6144 + col);
        const float4 sc = *(const float4*)(mod + (size_t)(l * 2 + b) * 6144 + 1024 + col);
        *(h16x4*)(hout + (size_t)row * D + col) = pack4(x[i].x * rstd * g.x * (1.f + sc.x) + sh.x, x[i].y * rstd * g.y * (1.f + sc.y) + sh.y,
                                                        x[i].z * rstd * g.z * (1.f + sc.z) + sh.z, x[i].w * rstd * g.w * (1.f + sc.w) + sh.w);
      }
    }
  }
}

__device__ __forceinline__ int perm_key(int pos) {
  return 32 * (pos >> 5) + 16 * ((pos >> 2) & 1) + 4 * ((pos >> 3) & 3) + (pos & 3);
}
__device__ __forceinline__ void inproj_tile(const Params& p, h16* sm, int mt, int nt) {
  unsigned char* ws = p.ws;
  const h16* Ab = (const h16*)(ws + OFF_H16) + (size_t)mt * 256 * D;
  f32x4 acc[8][2];
  gemm_mainloop<128>(acc, [&](int r) { return Ab + (size_t)r * D; }, (const h16*)(ws + OFF_WIN) + (size_t)nt * 128 * D, D, D / 64, sm);
  const int tid_e = tidx(), lane = tid_e & 63, wave = tid_e >> 6, wr = wave >> 2, wc = wave & 3, fr = lane & 15, fq = lane >> 4;
  constexpr int LDR = 136;
#pragma unroll
  for (int m = 0; m < 8; ++m)
#pragma unroll
    for (int n = 0; n < 2; ++n)
      *(h16x4*)(sm + (wr * 128 + m * 16 + fr) * LDR + wc * 32 + n * 16 + 4 * fq) = pack4(acc[m][n][0], acc[m][n][1], acc[m][n][2], acc[m][n][3]);
  __syncthreads();
  const int row0 = mt * 256, b = mt >> 5, s0 = (mt & 31) * 256;
  if (nt < 4 || (nt >= 14 && nt < 18)) {
    h16* P = (h16*)(ws + OFF_P16);
#pragma unroll
    for (int i = 0; i < 8; ++i) {
      const int idx = i * NTHREADS + tid_e;
      const int r = idx >> 4, c8 = idx & 15;
      *(h16x8*)(P + (size_t)(row0 + r) * NIN + nt * 128 + c8 * 8) = *(const h16x8*)(sm + r * LDR + c8 * 8);
    }
  } else if (nt <= 8 || nt == 10 || nt == 12) {
    const float* rc = (const float*)(ws + OFF_ROPE);
    const float* rs = rc + (size_t)T * 32;
    const bool isq = nt < 8;
    const float scl = isq ? 0.125f * 1.4426950408889634f : 1.f;
    h16* kbase = (h16*)(ws + (nt == 8 ? OFF_KC : (nt == 10 ? OFF_KS : OFF_KW)));
    h16* q16 = (h16*)(ws + OFF_Q16);
#pragma unroll
    for (int i = 0; i < 4; ++i) {
      const int idx = i * NTHREADS + tid_e;
      const int r = idx >> 3, hd = (idx >> 2) & 1, d = (idx & 3) * 8;
      const h16x8 a = *(const h16x8*)(sm + r * LDR + 64 * hd + d);
      const h16x8 bb = *(const h16x8*)(sm + r * LDR + 64 * hd + 32 + d);
      const float* cp = rc + (size_t)(row0 + r) * 32 + d;
      const float* sp = rs + (size_t)(row0 + r) * 32 + d;
      const float4 c0 = *(const float4*)cp, c1 = *(const float4*)(cp + 4), n0 = *(const float4*)sp, n1 = *(const float4*)(sp + 4);
      const float cs[8] = {c0.x, c0.y, c0.z, c0.w, c1.x, c1.y, c1.z, c1.w}, sn[8] = {n0.x, n0.y, n0.z, n0.w, n1.x, n1.y, n1.z, n1.w};
      h16x8 lo, hi;
#pragma unroll
      for (int j = 0; j < 8; ++j) {
        const float av = (float)a[j], bv = (float)bb[j];
        lo[j] = (h16)((av * cs[j] - bv * sn[j]) * scl);
        hi[j] = (h16)((bv * cs[j] + av * sn[j]) * scl);
      }
      h16* dst = isq ? q16 + (size_t)(row0 + r) * 512 + (nt - 4) * 128 + 64 * hd + d : kbase + ((size_t)(b * 2 + hd) * S + s0 + r) * 64 + d;
      *(h16x8*)dst = lo;
      *(h16x8*)(dst + 32) = hi;
    }
  } else if (nt == 9) {
    h16* vc = (h16*)(ws + OFF_VC);
#pragma unroll
    for (int i = 0; i < 8; ++i) {
      const int idx = i * NTHREADS + tid_e;
      const int r = idx >> 4, c8 = idx & 15, hd = c8 >> 3, dd = (c8 & 7) * 8;
      *(h16x8*)(vc + ((size_t)(b * 2 + hd) * S + s0 + r) * 64 + dd) = *(const h16x8*)(sm + r * LDR + c8 * 8);
    }
  } else if (nt == 11 || nt == 13) {
    h16* vt = (h16*)(ws + (nt == 11 ? OFF_VST : OFF_VWT));
#pragma unroll
    for (int i = 0; i < 8; ++i) {
      const int idx = i * NTHREADS + tid_e;
      const int kv = idx >> 11, blk = (idx >> 9) & 3, dim = (idx >> 3) & 63, p0 = (idx & 7) * 8;
      h16x8 v;
#pragma unroll
      for (int j = 0; j < 8; ++j) v[j] = sm[(blk * 64 + perm_key(p0 + j)) * LDR + 64 * kv + dim];
      *(h16x8*)(vt + ((size_t)((b * 2 + kv) * 128 + (s0 >> 6) + blk)) * 4096 + dim * 64 + p0) = v;
    }
  } else {
    float* gates = (float*)(ws + OFF_GATES);
#pragma unroll
    for (int i = 0; i < 12; ++i) {
      const int idx = i * NTHREADS + tid_e;
      const int r = idx / 24, cc = idx % 24;
      gates[(size_t)(row0 + r) * 24 + cc] = sigm((float)sm[r * LDR + cc]);
    }
  }
  __syncthreads();
}
__device__ __forceinline__ void phase_inproj(const Params& p, h16* sm) {
  const TileIter tf = xcd_tiles(64 * 19);
  for (int t = tf.cur; t < tf.end; t += tf.step) inproj_tile(p, sm, t / 19, t % 19);
}

__device__ __forceinline__ void mixa_compress1(const Params& p, int item, h16* sm) {
  unsigned char* ws = p.ws;
  const int which = item >> 5, mt = (item >> 2) & 7, ks = item & 3;
  const h16* A = (const h16*)(ws + (which ? OFF_VC : OFF_KC)) + (size_t)mt * 256 * 1024 + ks * 512;
  const h16* W = (const h16*)(ws + (which ? OFF_W1V : OFF_W1K)) + ks * 512;
  float* hp = (float*)(ws + OFF_HIDP) + ((size_t)(ks * 2 + which) * 2048) * 256;
  f32x4 acc[8][4];
  gemm_mainloop<256>(acc, [&](int r) { return A + (size_t)r * 1024; }, W, 2048, 8, sm);
  const int tid_e = tidx(), lane = tid_e & 63, wave = tid_e >> 6, wr = wave >> 2, wc = wave & 3, fr = lane & 15, fq = lane >> 4;
#pragma unroll
  for (int m = 0; m < 8; ++m)
#pragma unroll
    for (int n = 0; n < 4; ++n) {
      const int row = mt * 256 + wr * 128 + m * 16 + fr, col = wc * 64 + n * 16 + 4 * fq;
      *(f32x4*)(hp + (size_t)row * 256 + col) = acc[m][n];
    }
}

__device__ __forceinline__ void mixa_lru(const Params& p, int l, int item, float* sm) {
  unsigned char* ws = p.ws;
  const int tid = tidx();
  const int half = tid >> 8;
  item = item * 2 + half;
  sm += half * 14400;
  const int b = item >> 8, ck = item & 255;
  const int c = tid & 255;
  const int nb = c >> 6;
  const int lane = tid & 63, fr = lane & 15, fq = lane >> 4;
  const h16* P = (const h16*)(ws + OFF_P16);
  const float* cw = p.in[I_LCW] + l * 4 * 256;
  const float w0 = cw[c], w1 = cw[256 + c], w2 = cw[512 + c], w3 = cw[768 + c], cb = p.in[I_LCB][l * 256 + c];
  const float ba = p.in[I_LBA][l * 256 + c], bx = p.in[I_LBX][l * 256 + c];
  const float lam = p.in[I_LLAM][l * 256 + c];
  const float ls = -log1pf(expf(-lam));
  h16x8 bw[2][4][2];
  {
    const h16* lw = (const h16*)(ws + OFF_LRUW);
#pragma unroll
    for (int mat = 0; mat < 2; ++mat)
#pragma unroll
      for (int nt = 0; nt < 4; ++nt)
#pragma unroll
        for (int ks = 0; ks < 2; ++ks) bw[mat][nt][ks] = *(const h16x8*)(lw + ((size_t)((mat * 4 + nb) * 64 + nt * 16 + fr)) * 64 + ks * 32 + 8 * fq);
  }
  const int t0 = ck * 32;
  float x0 = 0.f, x1 = 0.f, x2 = 0.f;
  if (t0 >= 3) {
    x0 = (float)P[(size_t)(b * S + t0 - 3) * NIN + C_XL + c];
    x1 = (float)P[(size_t)(b * S + t0 - 2) * NIN + C_XL + c];
    x2 = (float)P[(size_t)(b * S + t0 - 1) * NIN + C_XL + c];
  }
  float h = 0.f, ap = 1.f;
  float* lh = (float*)(ws + OFF_LRUH);
  float* la = (float*)(ws + OFF_LRUA);
  float* sr = sm + 4096;
  float* si = sm + 8192;
  h16* xh = (h16*)(sm + 12288);
#pragma unroll 1
  for (int sub = 0; sub < 2; ++sub) {
    const int tb = t0 + sub * 16;
    {
      h16 xv[16];
      const h16* xp = P + (size_t)(b * S + tb) * NIN + C_XL + c;
#pragma unroll
      for (int tt = 0; tt < 16; ++tt) { xv[tt] = *xp; xp += NIN; asm volatile("" : "+v"(xp)); }
#pragma unroll
      for (int tt = 0; tt < 16; ++tt) {
        const float x3 = (float)xv[tt];
        const float xc = w0 * x0 + w1 * x1 + w2 * x2 + w3 * x3 + cb;
        sm[tt * 256 + c] = xc;
        xh[tt * 264 + c] = (h16)xc;
        x0 = x1; x1 = x2; x2 = x3;
      }
    }
    {
      h16x8 af[2];
#pragma unroll
      for (int ks = 0; ks < 2; ++ks) af[ks] = *(const h16x8*)(xh + fr * 264 + nb * 64 + ks * 32 + 8 * fq);
#pragma unroll
      for (int nt = 0; nt < 4; ++nt) {
        f32x4 ar = {0.f, 0.f, 0.f, 0.f}, ai = {0.f, 0.f, 0.f, 0.f};
#pragma unroll
        for (int ks = 0; ks < 2; ++ks) {
          ar = __builtin_amdgcn_mfma_f32_16x16x32_f16(af[ks], bw[0][nt][ks], ar, 0, 0, 0);
          ai = __builtin_amdgcn_mfma_f32_16x16x32_f16(af[ks], bw[1][nt][ks], ai, 0, 0, 0);
        }
#pragma unroll
        for (int j = 0; j < 4; ++j) {
          sr[(4 * fq + j) * 256 + nb * 64 + nt * 16 + fr] = ar[j];
          si[(4 * fq + j) * 256 + nb * 64 + nt * 16 + fr] = ai[j];
        }
      }
    }
#pragma unroll 4
    for (int tt = 0; tt < 16; ++tt) {
      const float r = sigm(sr[tt * 256 + c] + ba), ig = sigm(si[tt * 256 + c] + bx);
      const float log_a = 8.f * r * ls;
      const float a = __expf(log_a);
      const float mult = sqrtf(-expm1f(2.f * log_a));
      sr[tt * 256 + c] = a;
      si[tt * 256 + c] = mult * ig * sm[tt * 256 + c];
    }
    float* lhp = lh + (size_t)(b * S + tb) * 256 + c;
    float* lap = la + (size_t)(b * S + tb) * 256 + c;
#pragma unroll 4
    for (int tt = 0; tt < 16; ++tt) {
      const float a = sr[tt * 256 + c];
      h = a * h + si[tt * 256 + c];
      ap *= a;
      lhp[tt * 256] = h;
      lap[tt * 256] = ap;
    }
  }
  ((float*)(ws + OFF_HEND))[(size_t)(b * 256 + ck) * 256 + c] = h;
  ((float*)(ws + OFF_AEND))[(size_t)(b * 256 + ck) * 256 + c] = ap;
  __syncthreads();
}

__device__ __forceinline__ void mixa_conv(const Params& p, int l, int item, float* sm) {
  unsigned char* ws = p.ws;
  const int half = tidx() >> 8;
  item = item * 2 + half;
  sm += half * 15872;
  const int b = item >> 8, ck = item & 255;
  const int c = tidx() & 255;
  const h16* P = (const h16*)(ws + OFF_P16);
  const int t0 = ck * 32;
  float col[64];
#pragma unroll
  for (int r0 = 0; r0 < 64; r0 += 16) {
    h16 va[16], vb[16];
#pragma unroll
    for (int q = 0; q < 16; ++q) {
      const int t = t0 - 30 + r0 + q;
      va[q] = (h16)0.f; vb[q] = (h16)0.f;
      if (t >= 0 && r0 + q < 62) {
        const h16* pr = P + (size_t)(b * S + t) * NIN;
        va[q] = pr[C_CVA + c]; vb[q] = pr[C_CVB + c];
      }
    }
#pragma unroll
    for (int q = 0; q < 16; ++q) col[r0 + q] = (float)va[q] * sigm((float)vb[q]);
    asm volatile("" ::: "memory");
  }
  float w[31];
#pragma unroll
  for (int j = 0; j < 31; ++j) w[j] = p.in[I_DWW][(size_t)(l * 31 + j) * 256 + c];
  const float bias = p.in[I_DWB][l * 256 + c];
#pragma unroll
  for (int i = 0; i < 32; ++i) {
    float z = bias;
#pragma unroll
    for (int j = 0; j < 31; ++j) z += w[j] * col[i + j];
    sm[i * 256 + c] = z;
  }
  __syncthreads();
  const int lane = tidx() & 63, wave = (tidx() >> 6) & 3;
  const float4 lg = *(const float4*)(p.in[I_LNG] + l * 256 + lane * 4);
  const float4 lb = *(const float4*)(p.in[I_LNB] + l * 256 + lane * 4);
  const float4 gn = *(const float4*)(p.in[I_ONG] + l * 1024 + 768 + lane * 4);
  h16* yc = (h16*)(ws + OFF_H16);
  for (int i = wave * 8; i < wave * 8 + 8; ++i) {
    const float4 z = *(const float4*)(sm + i * 256 + lane * 4);
    const float mu = wsum(z.x + z.y + z.z + z.w) * (1.f / 256.f);
    const float dx = z.x - mu, dy = z.y - mu, dz = z.z - mu, dw = z.w - mu;
    const float var = wsum(dx * dx + dy * dy + dz * dz + dw * dw) * (1.f / 256.f);
    const float rs = rsqrtf(var + EPS);
    const float y0 = silu_f(dx * rs * lg.x + lb.x), y1 = silu_f(dy * rs * lg.y + lb.y), y2 = silu_f(dz * rs * lg.z + lb.z), y3 = silu_f(dw * rs * lg.w + lb.w);
    const float r2 = rsqrtf(wsum(y0 * y0 + y1 * y1 + y2 * y2 + y3 * y3) * (1.f / 256.f) + EPS);
    *(h16x4*)(yc + (size_t)(b * S + t0 + i) * D + 768 + lane * 4) = pack4(y0 * r2 * gn.x, y1 * r2 * gn.y, y2 * r2 * gn.z, y3 * r2 * gn.w);
  }
  __syncthreads();
}

__device__ __forceinline__ void phase_mixa(const Params& p, int l, void* sm) {
  const int G = gridDim.x;
  if (blockIdx.x == 0) {
    const int o = tidx();
    const float* pp = (const float*)(p.ws + OFF_PBPART) + (size_t)(o >> 8) * 32 * 256 + (o & 255);
    float accb = 0.f;
    for (int k = 0; k < 32; ++k) accb += pp[k * 256];
    ((float*)(p.ws + OFF_PB))[o] = accb;
  }
  for (int it = blockIdx.x; it < 64; it += G) mixa_compress1(p, it, (h16*)sm);
  for (int it = blockIdx.x; it < 256; it += G) mixa_lru(p, l, it, (float*)sm);
  for (int it = (blockIdx.x + G - 64 % G) % G; it < 256; it += G) mixa_conv(p, l, it, (float*)sm);
}

__device__ __forceinline__ void phase_mixb(const Params& p, int l, float* sm) {
  unsigned char* ws = p.ws;
  const int tid = tidx();
  for (int it = blockIdx.x; it < 512; it += gridDim.x) {
    const int which = it >> 8;
    const int row0 = (it & 255) * 8;
    {
      const float* hp = (const float*)(ws + OFF_HIDP) + ((size_t)which * 2048 + row0) * 256;
      const float* pb = (const float*)(ws + OFF_PB) + which * 256;
      const int r = tid >> 6, c4 = (tid & 63) * 4;
      const size_t o = (size_t)r * 256 + c4;
      const float4 a0 = *(const float4*)(hp + o), a1 = *(const float4*)(hp + (size_t)2 * 2048 * 256 + o);
      const float4 a2 = *(const float4*)(hp + (size_t)4 * 2048 * 256 + o), a3 = *(const float4*)(hp + (size_t)6 * 2048 * 256 + o);
      const float4 bb = *(const float4*)(pb + c4);
      float* d = sm + r * 256 + c4;
      d[0] = gelu_tanh(a0.x + a1.x + a2.x + a3.x + bb.x); d[1] = gelu_tanh(a0.y + a1.y + a2.y + a3.y + bb.y);
      d[2] = gelu_tanh(a0.z + a1.z + a2.z + a3.z + bb.z); d[3] = gelu_tanh(a0.w + a1.w + a2.w + a3.w + bb.w);
      const float4* wsrc = (const float4*)(p.in[which ? I_CVW2 : I_CKW2] + (size_t)l * 256 * 64);
      float4* wdst = (float4*)(sm + 2048);
#pragma unroll
      for (int q = 0; q < 8; ++q) wdst[q * NTHREADS + tid] = wsrc[q * NTHREADS + tid];
    }
    __syncthreads();
    const int row = row0 + (tid >> 6), d = tid & 63;
    const float* hr = sm + (tid >> 6) * 256;
    const float* w2 = sm + 2048 + d;
    float s = 0.f;
#pragma unroll 8
    for (int j = 0; j < 256; ++j) s += (float)(h16)hr[j] * w2[j * 64];
    const int bkv = row >> 9, n = row & 511;
    if (n == 511) s = 0.f;
    if (which == 0) {
      ((h16*)(ws + OFF_KCMP))[((size_t)bkv * 512 + n) * 64 + d] = (h16)s;
    } else {
      const int blk = n >> 6, key = n & 63;
      const int pos = 32 * (key >> 5) + 8 * ((key >> 2) & 3) + 4 * ((key >> 4) & 1) + (key & 3);
      ((h16*)(ws + OFF_VCMPT))[((size_t)(bkv * 8 + blk) * 64 + d) * 64 + pos] = (h16)s;
    }
    __syncthreads();
  }
  const int g = blockIdx.x * NTHREADS + tid;
  if (g < 512) {
    const int b = g >> 8, c = g & 255;
    const float* he = (const float*)(ws + OFF_HEND) + (size_t)b * 256 * 256 + c;
    const float* ae = (const float*)(ws + OFF_AEND) + (size_t)b * 256 * 256 + c;
    float* cy = (float*)(ws + OFF_CARRY) + (size_t)b * 256 * 256 + c;
    float carry = 0.f;
#pragma unroll 1
    for (int k0 = 0; k0 < 256; k0 += 32) {
      float hv[32], av[32];
#pragma unroll
      for (int k = 0; k < 32; ++k) { hv[k] = he[(k0 + k) * 256]; av[k] = ae[(k0 + k) * 256]; }
#pragma unroll
      for (int k = 0; k < 32; ++k) {
        cy[(k0 + k) * 256] = carry;
        carry = hv[k] + av[k] * carry;
      }
    }
  }
}

__device__ __forceinline__ void stage8k(const h16* __restrict__ g, h16* l, int tid) {
  const int r = tid >> 3, cl = (tid & 7) ^ ((r >> 1) & 7);
  glds16(g + r * 64 + cl * 8, l + tid * 8);
}
__device__ __forceinline__ h16x8 ldfrag(const h16* l, int row, int chunk) {
  return *(const h16x8*)(l + row * 64 + ((chunk ^ ((row >> 1) & 7)) * 8));
}

template <int MODE>
__device__ __forceinline__ void attn_branch(const h16* __restrict__ Kg, const h16* __restrict__ Vg, int j0, int j1, h16* ring,
                                            const h16x8 (&qf)[2][2], float (&m)[2], float (&l)[2], f32x4 (&o)[2][4],
                                            const int (&tq)[2], const int (&lim)[2], const int (&tlim)[2], const int (&tfl)[2],
                                            const unsigned long long (&mylo)[2], const unsigned long long (&myhi)[2],
                                            const unsigned long long (&ulo)[2], const unsigned long long (&uhi)[2],
                                            const float (&inv)[2], float* impw) {
  int tid = tidx();
  asm volatile("" : "+v"(tid));
  const int lane = tid & 63;
  const int h = lane >> 4, c = lane & 15, qi = c >> 2, g = c & 3;
  constexpr bool PV = MODE != 0;
  constexpr int SS = 3;
  const int n = j1 - j0 + 1;
  if (n <= 0) return;
  const int nss = (n + SS - 1) / SS;
#pragma unroll
  for (int q = 0; q < SS; ++q)
    if (q < n) {
      stage8k(Kg + (size_t)(j0 + q) * 4096, ring + q * 8192, tid);
      if (PV) stage8k(Vg + (size_t)(j0 + q) * 4096, ring + q * 8192 + 4096, tid);
    }
  int sbase = 0;
  for (int ss = 0; ss < nss; ++ss) {
    VMCNT(0);
    __builtin_amdgcn_s_barrier();
    {
      const int sn = SS - sbase;
#pragma unroll
      for (int q = 0; q < SS; ++q) {
        const int jb = SS * (ss + 1) + q;
        if (jb < n) {
          stage8k(Kg + (size_t)(j0 + jb) * 4096, ring + (sn + q) * 8192, tid);
          if (PV) stage8k(Vg + (size_t)(j0 + jb) * 4096, ring + (sn + q) * 8192 + 4096, tid);
        }
      }
    }
#pragma unroll 1
   for (int sub = 0; sub < SS; ++sub) {
    const int it = SS * ss + sub;
    if (it >= n) break;
    const int j = j0 + it;
    const h16* cK = ring + (sbase + sub) * 8192;
    const h16* cV = cK + 4096;
    bool act[2];
#pragma unroll
    for (int mq = 0; mq < 2; ++mq) {
      if (MODE <= 1) act[mq] = j * 64 <= tlim[mq];
      else if (MODE == 2) act[mq] = ((j < 64 ? (ulo[mq] >> j) : (uhi[mq] >> (j - 64))) & 1ull) != 0ull;
      else act[mq] = (j * 64 <= tlim[mq] + 3) && (j * 64 + 63 > tlim[mq] - 512);
    }
    if (act[0] || act[1]) {
      h16x8 pf[2][2];
      h16x8 kf[4][2];
#pragma unroll
      for (int kt = 0; kt < 4; ++kt)
#pragma unroll
        for (int ks = 0; ks < 2; ++ks) kf[kt][ks] = ldfrag(cK, 16 * kt + c, 4 * ks + h);
#pragma unroll
      for (int mq = 0; mq < 2; ++mq)
        if (act[mq]) {
          f32x4 s[1][4];
          {
#pragma unroll
            for (int kt = 0; kt < 4; ++kt) {
              s[0][kt] = (f32x4){0.f, 0.f, 0.f, 0.f};
#pragma unroll
              for (int ks = 0; ks < 2; ++ks) s[0][kt] = __builtin_amdgcn_mfma_f32_16x16x32_f16(kf[kt][ks], qf[mq][ks], s[0][kt], 0, 0, 0);
            }
          }
          const bool selbit = MODE == 2 ? (((j < 64 ? (mylo[mq] >> j) : (myhi[mq] >> (j - 64))) & 1ull) != 0ull) : true;
          bool interior;
          if (MODE <= 1) interior = j * 64 + 63 <= tfl[mq];
          else if (MODE == 2) interior = j * 64 + 63 <= tfl[mq];
          else interior = (j * 64 + 63 <= tfl[mq]) && (j * 64 > tfl[mq] + 3 - 512);
          if (!interior) {
            const int pbase = j * 64 + 4 * h;
#pragma unroll
            for (int kt = 0; kt < 4; ++kt)
#pragma unroll
              for (int i = 0; i < 4; ++i) {
                const int pos = pbase + 16 * kt + i;
                bool v;
                if (MODE <= 1) v = pos <= lim[mq];
                else if (MODE == 2) v = selbit && pos <= tq[mq];
                else v = pos <= tq[mq] && pos > tq[mq] - 512;
                s[0][kt][i] = v ? s[0][kt][i] : -1e30f;
              }
          }
          const bool rowoff = MODE == 2 && interior && !selbit;
          if (MODE == 1) {
#pragma unroll
            for (int kt = 0; kt < 4; ++kt) {
              float ps = 0.f;
#pragma unroll
              for (int i = 0; i < 4; ++i) {
                const float pv = __builtin_amdgcn_exp2f(s[0][kt][i] - m[mq]) * inv[mq];
                s[0][kt][i] = pv;
                ps += pv;
              }
              ps += __shfl_xor(ps, 1);
              ps += __shfl_xor(ps, 2);
              if (g == 0) impw[(4 * mq + qi) * 128 + j * 16 + kt * 4 + h] = ps;
            }
          } else {
            float bm = fmaxf(fmaxf(fmaxf(s[0][0][0], s[0][0][1]), fmaxf(s[0][0][2], s[0][0][3])), fmaxf(fmaxf(s[0][1][0], s[0][1][1]), fmaxf(s[0][1][2], s[0][1][3])));
            bm = fmaxf(bm, fmaxf(fmaxf(fmaxf(s[0][2][0], s[0][2][1]), fmaxf(s[0][2][2], s[0][2][3])), fmaxf(fmaxf(s[0][3][0], s[0][3][1]), fmaxf(s[0][3][2], s[0][3][3]))));
            bm = rowoff ? -1e30f : bm;
            if (__any(bm > m[mq] + 8.f)) {
              bm = fmaxf(bm, __shfl_xor(bm, 16));
              bm = fmaxf(bm, __shfl_xor(bm, 32));
              const float mn = fmaxf(m[mq], bm);
              const float alpha = __builtin_amdgcn_exp2f(m[mq] - mn);
              l[mq] *= alpha;
              m[mq] = mn;
              if (PV) {
#pragma unroll
                for (int mt = 0; mt < 4; ++mt) o[mq][mt] *= alpha;
              }
            }
            const float mref = (m[mq] > -1e29f && !rowoff) ? m[mq] : 1e30f;
            float ps = 0.f;
#pragma unroll
            for (int kt = 0; kt < 4; ++kt)
#pragma unroll
              for (int i = 0; i < 4; ++i) {
                const float pv = __builtin_amdgcn_exp2f(s[0][kt][i] - mref);
                s[0][kt][i] = pv;
                ps += pv;
              }
            l[mq] += ps;
          }
          if (PV) {
#pragma unroll
            for (int s2 = 0; s2 < 2; ++s2)
#pragma unroll
              for (int i = 0; i < 4; ++i) { pf[mq][s2][i] = (h16)s[0][2 * s2][i]; pf[mq][s2][4 + i] = (h16)s[0][2 * s2 + 1][i]; }
          }
        }
      if (PV) {
        h16x8 vf[4][2];
#pragma unroll
        for (int mt = 0; mt < 4; ++mt)
#pragma unroll
          for (int s2 = 0; s2 < 2; ++s2) vf[mt][s2] = ldfrag(cV, 16 * mt + c, 4 * s2 + h);
#pragma unroll
        for (int mq = 0; mq < 2; ++mq)
          if (act[mq]) {
#pragma unroll
            for (int s2 = 0; s2 < 2; ++s2) {
#pragma unroll
              for (int mt = 0; mt < 4; ++mt) o[mq][mt] = __builtin_amdgcn_mfma_f32_16x16x32_f16(vf[mt][s2], pf[mq][s2], o[mq][mt], 0, 0, 0);
            }
          }
      }
    }
   }
    sbase = SS - sbase;
  }
  __builtin_amdgcn_s_barrier();
}

__device__ __forceinline__ void attn_item(const Params& p, int l, int item, float* sm) {
  unsigned char* ws = p.ws;
  int tid = tidx();
  asm volatile("" : "+v"(tid));
  const int lane = tid & 63, wave = tid >> 6;
  const int combo = item & 3, qt = item >> 2;
  const int b = combo >> 1, kv = combo & 1;
  const int t0 = qt * 64, tw0 = t0 + 8 * wave;
  const int h = lane >> 4, c = lane & 15, qi = c >> 2, g = c & 3;
  const int head = kv * 4 + g, bkv = b * 2 + kv;
  h16* ring = (h16*)sm;
  float* impw = sm + 24576 + wave * 1024;
  unsigned long long* selm = (unsigned long long*)(sm + 24576 + 8192) + wave * 16;

  h16x8 qf[2][2];
  int tq[2];
#pragma unroll
  for (int mq = 0; mq < 2; ++mq) {
    tq[mq] = tw0 + 4 * mq + qi;
    const h16* qrow = (const h16*)(ws + OFF_Q16) + (size_t)(b * S + tq[mq]) * 512 + head * 64;
    qf[mq][0] = *(const h16x8*)(qrow + 8 * h);
    qf[mq][1] = *(const h16x8*)(qrow + 32 + 8 * h);
  }
  for (int i = lane; i < 1024; i += 64) impw[i] = 0.f;

  h16x4 ofin[2][4];
  float m[2], ll[2], inv[2];
  f32x4 o[2][4];
  const unsigned long long z2[2] = {0ull, 0ull};
  {
    int lim[2], tlim[2], tflc[2];
#pragma unroll
    for (int mq = 0; mq < 2; ++mq) {
      lim[mq] = tq[mq] >= 31 ? ((tq[mq] - 31) >> 4) : -1;
      const int tl = tw0 + 4 * mq + 3;
      tlim[mq] = tl >= 31 ? ((tl - 31) >> 4) : -1;
      const int tf0 = tw0 + 4 * mq;
      tflc[mq] = tf0 >= 31 ? ((tf0 - 31) >> 4) : -1;
      m[mq] = -1e30f; ll[mq] = 0.f; inv[mq] = 0.f;
#pragma unroll
      for (int mt = 0; mt < 4; ++mt) o[mq][mt] = (f32x4){0.f, 0.f, 0.f, 0.f};
    }
    const int nl = (t0 + 63 - 31) >> 4;
    const int jl = nl >> 6;
    const h16* Kc = (const h16*)(ws + OFF_KCMP) + (size_t)bkv * 512 * 64;
    const h16* Vc = (const h16*)(ws + OFF_VCMPT) + (size_t)bkv * 8 * 4096;
    attn_branch<0>(Kc, Vc, 0, jl, ring, qf, m, ll, o, tq, lim, tlim, tflc, z2, z2, z2, z2, inv, impw);
#pragma unroll
    for (int mq = 0; mq < 2; ++mq) {
      float lt = ll[mq];
      lt += __shfl_xor(lt, 16);
      lt += __shfl_xor(lt, 32);
      inv[mq] = lt > 0.f ? 1.f / lt : 0.f;
    }
    attn_branch<1>(Kc, Vc, 0, jl, ring, qf, m, ll, o, tq, lim, tlim, tflc, z2, z2, z2, z2, inv, impw);
    const float* gt0 = (const float*)(ws + OFF_GATES) + (size_t)(b * S) * 24 + head * 3;
#pragma unroll
    for (int mq = 0; mq < 2; ++mq) {
      const float g0 = gt0[(size_t)tq[mq] * 24] * ASCALE;
#pragma unroll
      for (int mt = 0; mt < 4; ++mt) ofin[mq][mt] = pack4(o[mq][mt][0] * g0, o[mq][mt][1] * g0, o[mq][mt][2] * g0, o[mq][mt][3] * g0);
    }
  }
  for (int q = 0; q < 8; ++q) {
    const int t = tw0 + q, own = t >> 6;
    const float* ir = impw + q * 128;
    const int ja = lane, jb = lane + 64;
    unsigned k0 = 0u, k1 = 0u;
    if (ja <= own) k0 = (ja == 0 || ja == own) ? (0xFFFFFF80u | (unsigned)(127 - ja)) : (((__float_as_uint(ir[ja]) & ~127u) | (unsigned)(127 - ja)) + 1u);
    if (jb <= own) k1 = (jb == own) ? (0xFFFFFF80u | (unsigned)(127 - jb)) : (((__float_as_uint(ir[jb]) & ~127u) | (unsigned)(127 - jb)) + 1u);
    unsigned thr = 0u;
    for (int bit = 31; bit >= 0; --bit) {
      const unsigned cand = thr | (1u << bit);
      const int cnt = __popcll(__ballot(k0 >= cand)) + __popcll(__ballot(k1 >= cand));
      if (cnt >= 16) thr = cand;
    }
    const unsigned long long mlo = __ballot(k0 >= thr && ja <= own);
    const unsigned long long mhi = __ballot(k1 >= thr && jb <= own);
    if (lane == 0) { selm[q * 2] = mlo; selm[q * 2 + 1] = mhi; }
  }
  unsigned long long mylo[2], myhi[2], ulo[2], uhi[2];
#pragma unroll
  for (int mq = 0; mq < 2; ++mq) {
    mylo[mq] = selm[(4 * mq + qi) * 2];
    myhi[mq] = selm[(4 * mq + qi) * 2 + 1];
    unsigned long long a = selm[(4 * mq) * 2] | selm[(4 * mq + 1) * 2] | selm[(4 * mq + 2) * 2] | selm[(4 * mq + 3) * 2];
    unsigned long long bb = selm[(4 * mq) * 2 + 1] | selm[(4 * mq + 1) * 2 + 1] | selm[(4 * mq + 2) * 2 + 1] | selm[(4 * mq + 3) * 2 + 1];
    ulo[mq] = (unsigned long long)__builtin_amdgcn_readfirstlane((unsigned)a) | ((unsigned long long)__builtin_amdgcn_readfirstlane((unsigned)(a >> 32)) << 32);
    uhi[mq] = (unsigned long long)__builtin_amdgcn_readfirstlane((unsigned)bb) | ((unsigned long long)__builtin_amdgcn_readfirstlane((unsigned)(bb >> 32)) << 32);
  }
  const float* gtb = (const float*)(ws + OFF_GATES) + (size_t)(b * S) * 24 + head * 3;
  {
    int tl0[2] = {0, 0};
    const int tfs[2] = {tw0, tw0 + 4};
#pragma unroll
    for (int mq = 0; mq < 2; ++mq) {
      m[mq] = -1e30f; ll[mq] = 0.f;
#pragma unroll
      for (int mt = 0; mt < 4; ++mt) o[mq][mt] = (f32x4){0.f, 0.f, 0.f, 0.f};
    }
    attn_branch<2>((const h16*)(ws + OFF_KS) + (size_t)bkv * S * 64, (const h16*)(ws + OFF_VST) + (size_t)bkv * 128 * 4096, 0, (t0 + 63) >> 6, ring, qf, m, ll, o,
                   tq, tl0, tl0, tfs, mylo, myhi, ulo, uhi, inv, impw);
#pragma unroll
    for (int mq = 0; mq < 2; ++mq) {
      float lt = ll[mq];
      lt += __shfl_xor(lt, 16);
      lt += __shfl_xor(lt, 32);
      const float sc = lt > 0.f ? gtb[(size_t)tq[mq] * 24 + 1] * ASCALE / lt : 0.f;
#pragma unroll
      for (int mt = 0; mt < 4; ++mt)
        ofin[mq][mt] = pack4((float)ofin[mq][mt][0] + o[mq][mt][0] * sc, (float)ofin[mq][mt][1] + o[mq][mt][1] * sc, (float)ofin[mq][mt][2] + o[mq][mt][2] * sc,
                             (float)ofin[mq][mt][3] + o[mq][mt][3] * sc);
    }
  }
  {
    int tl0[2] = {0, 0}, tf[2];
#pragma unroll
    for (int mq = 0; mq < 2; ++mq) {
      tf[mq] = tw0 + 4 * mq;
      m[mq] = -1e30f; ll[mq] = 0.f;
#pragma unroll
      for (int mt = 0; mt < 4; ++mt) o[mq][mt] = (f32x4){0.f, 0.f, 0.f, 0.f};
    }
    const int jlo = t0 >= 511 ? ((t0 - 511) >> 6) : 0;
    attn_branch<3>((const h16*)(ws + OFF_KW) + (size_t)bkv * S * 64, (const h16*)(ws + OFF_VWT) + (size_t)bkv * 128 * 4096, jlo, (t0 + 63) >> 6, ring, qf, m, ll, o,
                   tq, tl0, tf, tf, z2, z2, z2, z2, inv, impw);
#pragma unroll
    for (int mq = 0; mq < 2; ++mq) {
      float lt = ll[mq];
      lt += __shfl_xor(lt, 16);
      lt += __shfl_xor(lt, 32);
      const float sc = lt > 0.f ? gtb[(size_t)tq[mq] * 24 + 2] * ASCALE / lt : 0.f;
#pragma unroll
      for (int mt = 0; mt < 4; ++mt)
        ofin[mq][mt] = pack4((float)ofin[mq][mt][0] + o[mq][mt][0] * sc, (float)ofin[mq][mt][1] + o[mq][mt][1] * sc, (float)ofin[mq][mt][2] + o[mq][mt][2] * sc,
                             (float)ofin[mq][mt][3] + o[mq][mt][3] * sc);
    }
  }
  {
    h16* yc = (h16*)(ws + OFF_H16);
    const float* gn = p.in[I_ONG] + l * 1024 + 256 + head * 64;
    float* ssq = (float*)(ws + OFF_SSQ);
#pragma unroll
    for (int mq = 0; mq < 2; ++mq) {
      float sq = 0.f;
      h16* yr = yc + (size_t)(b * S + tq[mq]) * D + head * 64;
#pragma unroll
      for (int mt = 0; mt < 4; ++mt) {
        const float v[4] = {(float)ofin[mq][mt][0], (float)ofin[mq][mt][1], (float)ofin[mq][mt][2], (float)ofin[mq][mt][3]};
        sq += v[0] * v[0] + v[1] * v[1] + v[2] * v[2] + v[3] * v[3];
        const float4 gg = *(const float4*)(gn + 16 * mt + 4 * h);
        *(h16x4*)(yr + 16 * mt + 4 * h) = pack4(v[0] * gg.x, v[1] * gg.y, v[2] * gg.z, v[3] * gg.w);
      }
      sq += __shfl_xor(sq, 16);
      sq += __shfl_xor(sq, 32);
      sq += __shfl_xor(sq, 1);
      sq += __shfl_xor(sq, 2);
      if (h == 0 && g == 0) ssq[(size_t)(b * S + tq[mq]) * 2 + kv] = sq * (1.f / (ASCALE * ASCALE));
    }
  }
}

__device__ __forceinline__ void lrufix_item(const Params& p, int l, int item) {
  unsigned char* ws = p.ws;
  const int lane = tidx() & 63, wave = tidx() >> 6;
  const int b = item >> 7, ck = item & 127;
  const h16* P = (const h16*)(ws + OFF_P16);
  const float4 cy = *(const float4*)((const float*)(ws + OFF_CARRY) + (size_t)(b * 256 + ck * 2 + (wave >> 2)) * 256 + lane * 4);
  const float4 gn = *(const float4*)(p.in[I_ONG] + l * 1024 + lane * 4);
  h16* yc = (h16*)(ws + OFF_H16);
  for (int tt = wave * 8; tt < wave * 8 + 8; ++tt) {
    const size_t row = (size_t)(b * S + ck * 64 + tt);
    const float4 hl = *(const float4*)((const float*)(ws + OFF_LRUH) + row * 256 + lane * 4);
    const float4 al = *(const float4*)((const float*)(ws + OFF_LRUA) + row * 256 + lane * 4);
    const h16x4 gl = *(const h16x4*)(P + row * NIN + C_GL + lane * 4);
    const float y0 = (hl.x + al.x * cy.x) * gelu_tanh((float)gl[0]);
    const float y1 = (hl.y + al.y * cy.y) * gelu_tanh((float)gl[1]);
    const float y2 = (hl.z + al.z * cy.z) * gelu_tanh((float)gl[2]);
    const float y3 = (hl.w + al.w * cy.w) * gelu_tanh((float)gl[3]);
    const float rstd = rsqrtf(wsum(y0 * y0 + y1 * y1 + y2 * y2 + y3 * y3) * (1.f / 256.f) + EPS);
    *(h16x4*)(yc + row * D + 512 + lane * 4) = pack4(y0 * rstd * gn.x, y1 * rstd * gn.y, y2 * rstd * gn.z, y3 * rstd * gn.w);
  }
}

__device__ __forceinline__ void phase_attn(const Params& p, int l, float* sm) {
  for (int it = blockIdx.x; it < 256; it += gridDim.x) {
#pragma unroll 1
    for (int rep = 0; rep < 2; ++rep) attn_item(p, l, rep ? (127 - (it >> 2)) * 4 + (it & 3) : it, sm);
  }
  for (int it = blockIdx.x; it < 256; it += gridDim.x) lrufix_item(p, l, it);
}

__device__ __forceinline__ void phase_outproj(const Params& p, int l, h16* sm) {
  unsigned char* ws = p.ws;
  const h16* A = (const h16*)(ws + OFF_H16);
  const h16* W = (const h16*)(ws + OFF_WOUT);
  const float* mod = (const float*)(ws + OFF_MOD);
  float* xa = (float*)(ws + OFF_XA);
  const float* xin = l == 0 ? p.in[I_X] : (const float*)xa;
  const TileIter ti = xcd_tiles(64 * 4);
  for (int t = ti.cur; t < ti.end; t += ti.step) {
    const int mt = t >> 2, nt = t & 3;
    f32x4 acc[8][4];
    const h16* Ab = A + (size_t)mt * 256 * D;
    {
      float* sct = (float*)((unsigned char*)sm + SCHED_OFF - 1024);
      const int tq_ = tidx();
      if (tq_ < 256) {
        const float2 q2 = *(const float2*)((const float*)(ws + OFF_SSQ) + (size_t)(mt * 256 + tq_) * 2);
        sct[tq_] = rsqrtf((q2.x + q2.y) * (1.f / 512.f) + EPS) * (1.f / ASCALE);
      }
    }
    gemm_mainloop<256>(acc, [&](int r) { return Ab + (size_t)r * D; }, W + (size_t)nt * 256 * D, D, 8, sm);
    const int tid_e = tidx(), lane = tid_e & 63, wave = tid_e >> 6, wr = wave >> 2, wc = wave & 3, fr = lane & 15, fq = lane >> 4;
    {
      const float* sct = (const float*)((const unsigned char*)sm + SCHED_OFF - 1024) + wr * 128 + fr;
#pragma unroll
      for (int m = 0; m < 8; ++m) {
        const float sc = sct[m * 16];
#pragma unroll
        for (int n = 0; n < 4; ++n) acc[m][n] *= sc;
      }
    }
    gemm_mainloop<256>(acc, [&](int r) { return Ab + (size_t)r * D + 512; }, W + (size_t)nt * 256 * D + 512, D, 8, sm, false);
    {
      float* stf = (float*)sm;
      constexpr int LDF = 260;
#pragma unroll 1
      for (int pass = 0; pass < 2; ++pass) {
        if (wr == pass) {
#pragma unroll
          for (int m = 0; m < 8; ++m)
#pragma unroll
            for (int n = 0; n < 4; ++n) *(f32x4*)(stf + (m * 16 + fr) * LDF + wc * 64 + n * 16 + 4 * fq) = acc[m][n];
        }
        __syncthreads();
#pragma unroll 4
        for (int i = 0; i < 16; ++i) {
          const int idx = i * NTHREADS + tid_e;
          const int r = idx >> 6, c4 = (idx & 63) * 4;
          const int row = mt * 256 + pass * 128 + r, col = nt * 256 + c4;
          const int b = row >> 13;
          const f32x4 a = *(const f32x4*)(stf + r * LDF + c4);
          const float4 g1 = *(const float4*)(mod + (size_t)(l * 2 + b) * 6144 + 2048 + col);
          const float4 xv = *(const float4*)(xin + (size_t)row * D + col);
          float4 o;
          o.x = xv.x + g1.x * a[0]; o.y = xv.y + g1.y * a[1]; o.z = xv.z + g1.z * a[2]; o.w = xv.w + g1.w * a[3];
          *(float4*)(xa + (size_t)row * D + col) = o;
        }
        __syncthreads();
      }
    }
  }
}

__device__ __forceinline__ void phase_router(const Params& p, int l, int* smi) {
  unsigned char* ws = p.ws;
  const int tid = tidx(), lane = tid & 63, wave = tid >> 6;
  const float* mod = (const float*)(ws + OFF_MOD);
  const float* xa = (const float*)(ws + OFF_XA);
  h16* hout = (h16*)(ws + OFF_H16);
  unsigned* cnt = (unsigned*)(ws + OFF_CTL) + 64 + l * 16;
  int* list = (int*)(ws + OFF_LIST);
  float* wpair = (float*)(ws + OFF_WPAIR);
  const float* rgb = p.in[I_RGB] + l * 4;
  int* cntl = smi;
  int* basel = smi + 16;
  int* tok = smi + 32;
  float* wl = (float*)smi + 256;
  {
    const float4* s0 = (const float4*)(p.in[I_RGW] + (size_t)l * 1024 * 4);
    const float4* s1 = (const float4*)(p.in[I_REW] + (size_t)l * 4 * 1024 * 4);
    float4* d = (float4*)wl;
#pragma unroll
    for (int q = 0; q < 2; ++q) d[q * NTHREADS + tid] = s0[q * NTHREADS + tid];
#pragma unroll
    for (int q = 0; q < 8; ++q) d[1024 + q * NTHREADS + tid] = s1[q * NTHREADS + tid];
  }
  const float* rgw = wl;
  for (int chunk = blockIdx.x; chunk < T / 64; chunk += gridDim.x) {
    if (tid < 16) cntl[tid] = 0;
    __syncthreads();
    float4 xn[4];
#pragma unroll
    for (int i = 0; i < 4; ++i) xn[i] = *(const float4*)(xa + (size_t)(chunk * 64 + wave) * D + lane * 4 + 256 * i);
    for (int ti = wave; ti < 64; ti += NW) {
      const int row = chunk * 64 + ti;
      const int b = row >> 13;
      float4 x[4];
      float ss = 0.f;
#pragma unroll
      for (int i = 0; i < 4; ++i) x[i] = xn[i];
      if (ti + NW < 64) {
#pragma unroll
        for (int i = 0; i < 4; ++i) xn[i] = *(const float4*)(xa + (size_t)(row + NW) * D + lane * 4 + 256 * i);
      }
#pragma unroll
      for (int i = 0; i < 4; ++i) ss += x[i].x * x[i].x + x[i].y * x[i].y + x[i].z * x[i].z + x[i].w * x[i].w;
      ss = wsum(ss);
      const float rstd = rsqrtf(ss * (1.f / D) + EPS);
      float lg0 = 0.f, lg1 = 0.f, lg2 = 0.f, lg3 = 0.f;
#pragma unroll
      for (int i = 0; i < 4; ++i) {
        const int col = lane * 4 + 256 * i;
        const float4 g = *(const float4*)(p.in[I_N2G] + l * D + col);
        const float4 sh = *(const float4*)(mod + (size_t)(l * 2 + b) * 6144 + 3072 + col);
        const float4 sc = *(const float4*)(mod + (size_t)(l * 2 + b) * 6144 + 4096 + col);
        x[i].x = x[i].x * rstd * g.x * (1.f + sc.x) + sh.x;
        x[i].y = x[i].y * rstd * g.y * (1.f + sc.y) + sh.y;
        x[i].z = x[i].z * rstd * g.z * (1.f + sc.z) + sh.z;
        x[i].w = x[i].w * rstd * g.w * (1.f + sc.w) + sh.w;
        *(h16x4*)(hout + (size_t)row * D + col) = pack4(x[i].x, x[i].y, x[i].z, x[i].w);
        const float4 w0 = *(const float4*)(rgw + (size_t)(col + 0) * 4), w1 = *(const float4*)(rgw + (size_t)(col + 1) * 4);
        const float4 w2 = *(const float4*)(rgw + (size_t)(col + 2) * 4), w3 = *(const float4*)(rgw + (size_t)(col + 3) * 4);
        lg0 += x[i].x * w0.x + x[i].y * w1.x + x[i].z * w2.x + x[i].w * w3.x;
        lg1 += x[i].x * w0.y + x[i].y * w1.y + x[i].z * w2.y + x[i].w * w3.y;
        lg2 += x[i].x * w0.z + x[i].y * w1.z + x[i].z * w2.z + x[i].w * w3.z;
        lg3 += x[i].x * w0.w + x[i].y * w1.w + x[i].z * w2.w + x[i].w * w3.w;
      }
      lg0 = wsum(lg0) + rgb[0]; lg1 = wsum(lg1) + rgb[1]; lg2 = wsum(lg2) + rgb[2]; lg3 = wsum(lg3) + rgb[3];
      int gs = 0; float gm = lg0;
      if (lg1 > gm) { gm = lg1; gs = 1; }
      if (lg2 > gm) { gm = lg2; gs = 2; }
      if (lg3 > gm) { gm = lg3; gs = 3; }
      const float pg = 1.f / (__expf(lg0 - gm) + __expf(lg1 - gm) + __expf(lg2 - gm) + __expf(lg3 - gm));
      const float* rew = wl + 4096 + gs * 4096;
      const float* reb = p.in[I_REB] + (l * 4 + gs) * 4;
      float e0 = 0.f, e1 = 0.f, e2 = 0.f, e3 = 0.f;
#pragma unroll
      for (int i = 0; i < 4; ++i) {
        const int col = lane * 4 + 256 * i;
        const float4 w0 = *(const float4*)(rew + (size_t)(col + 0) * 4), w1 = *(const float4*)(rew + (size_t)(col + 1) * 4);
        const float4 w2 = *(const float4*)(rew + (size_t)(col + 2) * 4), w3 = *(const float4*)(rew + (size_t)(col + 3) * 4);
        e0 += x[i].x * w0.x + x[i].y * w1.x + x[i].z * w2.x + x[i].w * w3.x;
        e1 += x[i].x * w0.y + x[i].y * w1.y + x[i].z * w2.y + x[i].w * w3.y;
        e2 += x[i].x * w0.z + x[i].y * w1.z + x[i].z * w2.z + x[i].w * w3.z;
        e3 += x[i].x * w0.w + x[i].y * w1.w + x[i].z * w2.w + x[i].w * w3.w;
      }
      float le[4];
      le[0] = wsum(e0) + reb[0]; le[1] = wsum(e1) + reb[1]; le[2] = wsum(e2) + reb[2]; le[3] = wsum(e3) + reb[3];
      int i0 = 0; float v0 = le[0];
      if (le[1] > v0) { v0 = le[1]; i0 = 1; }
      if (le[2] > v0) { v0 = le[2]; i0 = 2; }
      if (le[3] > v0) { v0 = le[3]; i0 = 3; }
      int i1 = -1; float v1 = -3.0e38f;
#pragma unroll
      for (int j = 0; j < 4; ++j) {
        const float vj = (j == 0 ? le[0] : j == 1 ? le[1] : j == 2 ? le[2] : le[3]);
        if (j != i0 && vj > v1) { v1 = vj; i1 = j; }
      }
      const float p0 = 1.f / (1.f + __expf(v1 - v0));
      const float p1 = 1.f - p0;
      if (lane == 0) {
        const int ea = gs * 4 + i0, eb = gs * 4 + i1;
        const int ra = atomicAdd(&cntl[ea], 1);
        const int rb = atomicAdd(&cntl[eb], 1);
        tok[ti * 2] = ea | (ra << 8);
        tok[ti * 2 + 1] = eb | (rb << 8);
        wpair[row * 2] = pg * p0;
        wpair[row * 2 + 1] = pg * p1;
      }
    }
    __syncthreads();
    if (tid < 16) basel[tid] = (int)atomicAdd(&cnt[tid], (unsigned)cntl[tid]);
    __syncthreads();
    if (tid < 128) {
      const int v = tok[tid], e = v & 255, r = v >> 8;
      list[(size_t)e * 16384 + basel[e] + r] = (chunk * 64 + (tid >> 1)) * 2 + (tid & 1);
    }
    __syncthreads();
  }
}

__device__ __forceinline__ void moe_sched(const Params& p, int l, int* sl) {
  if (tidx() == 0) {
    const unsigned* cnt = (const unsigned*)(p.ws + OFF_CTL) + 64 + l * 16;
    int to = 0, ro = 0;
    sl[16] = 0; sl[33] = 0;
    for (int e = 0; e < 16; ++e) {
      const int c = (int)__hip_atomic_load(&cnt[e], __ATOMIC_RELAXED, __HIP_MEMORY_SCOPE_AGENT);
      sl[e] = c;
      to += (c + 255) >> 8; ro += c;
      sl[17 + e] = to; sl[34 + e] = ro;
    }
  }
  __syncthreads();
}
__device__ __forceinline__ void moe_tile(const int* sl, int t, int& e, int& nt, int& mt, int& cnt_e, int& roff_e) {
  int ee = 0;
  for (int k = 0; k < 15; ++k) ee += (t >= sl[17 + k] * 4) ? 1 : 0;
  ee = __builtin_amdgcn_readfirstlane(ee);
  const int t0 = __builtin_amdgcn_readfirstlane(sl[16 + ee]), t1 = __builtin_amdgcn_readfirstlane(sl[17 + ee]);
  const int nte = t1 - t0, rem = t - t0 * 4;
  e = ee; nt = rem / nte; mt = rem % nte;
  cnt_e = __builtin_amdgcn_readfirstlane(sl[ee]);
  roff_e = __builtin_amdgcn_readfirstlane(sl[33 + ee]);
}

template <int BN>
__device__ __forceinline__ void moe1_tile(const Params& p, h16* sm, const int* sl, int t, int half) {
  unsigned char* ws = p.ws;
  const h16* H = (const h16*)(ws + OFF_H16);
  h16* hid = (h16*)(ws + OFF_HID);
  int e, nt, mt, cnt_e, roff_e;
  moe_tile(sl, t, e, nt, mt, cnt_e, roff_e);
  const int* le = (const int*)(ws + OFF_LIST) + (size_t)e * 16384;
  f32x4 acc[8][BN / 64];
  gemm_mainloop<BN>(acc, [&](int r) { int so = mt * 256 + r; so = so < cnt_e ? so : 0; return H + (size_t)(le[so] >> 1) * D; },
                    (const h16*)(ws + OFF_WGU) + ((size_t)e * 1024 + nt * 256 + half * 128) * 1024, 1024, 16, sm);
  const int tid_e = tidx(), lane = tid_e & 63, wave = tid_e >> 6, wr = wave >> 2, wc = wave & 3, fr = lane & 15, fq = lane >> 4;
  constexpr int NC = BN / 2, LDR = NC + 8;
#pragma unroll
  for (int m = 0; m < 8; ++m)
#pragma unroll
    for (int n2 = 0; n2 < BN / 128; ++n2) {
      const f32x4 gt = acc[m][2 * n2], up = acc[m][2 * n2 + 1];
      *(h16x4*)(sm + (wr * 128 + m * 16 + fr) * LDR + wc * (BN / 8) + n2 * 16 + 4 * fq) =
          pack4(silu_f(gt[0]) * up[0], silu_f(gt[1]) * up[1], silu_f(gt[2]) * up[2], silu_f(gt[3]) * up[3]);
    }
  __syncthreads();
  constexpr int CH = NC / 8;
#pragma unroll
  for (int i = 0; i < CH / 2; ++i) {
    const int idx = i * NTHREADS + tid_e;
    const int r = idx / CH, c8 = idx % CH;
    const int so = mt * 256 + r;
    if (so < cnt_e) *(h16x8*)(hid + (size_t)(roff_e + so) * 512 + nt * 128 + half * 64 + c8 * 8) = *(const h16x8*)(sm + r * LDR + c8 * 8);
  }
  __syncthreads();
}
__device__ __forceinline__ void phase_moe1(const Params& p, int l, h16* sm) {
  int* sl = (int*)((unsigned char*)sm + SCHED_OFF);
  moe_sched(p, l, sl);
  const int total = __builtin_amdgcn_readfirstlane(sl[32]) * 4;
  const TileSched ts = xcd_sched(total);
  for (int t = ts.cur; t < ts.end; t += ts.step) moe1_tile<256>(p, sm, sl, t, 0);
  if (ts.tail_tile >= 0) {
    if (ts.tail_half < 0) moe1_tile<256>(p, sm, sl, ts.tail_tile, 0);
    else moe1_tile<128>(p, sm, sl, ts.tail_tile, ts.tail_half);
  }
}

template <int BN>
__device__ __forceinline__ void moe2_tile(const Params& p, h16* sm, const int* sl, int t, int half) {
  unsigned char* ws = p.ws;
  const float* wpair = (const float*)(ws + OFF_WPAIR);
  h16* yp = (h16*)(ws + OFF_YPAIR);
  int e, nt, mt, cnt_e, roff_e;
  moe_tile(sl, t, e, nt, mt, cnt_e, roff_e);
  const int* le = (const int*)(ws + OFF_LIST) + (size_t)e * 16384;
  const h16* Ab = (const h16*)(ws + OFF_HID) + (size_t)(roff_e + mt * 256) * 512;
  f32x4 acc[8][BN / 64];
  gemm_mainloop<BN>(acc, [&](int r) { return Ab + (size_t)r * 512; }, (const h16*)(ws + OFF_WDN) + ((size_t)e * 1024 + nt * 256 + half * 128) * 512, 512, 8, sm);
  const int tid_e = tidx(), lane = tid_e & 63, wave = tid_e >> 6, wr = wave >> 2, wc = wave & 3, fr = lane & 15, fq = lane >> 4;
  constexpr int LDR = BN + 8;
#pragma unroll
  for (int m = 0; m < 8; ++m) {
    const int so = mt * 256 + wr * 128 + m * 16 + fr;
    const float w = so < cnt_e ? wpair[le[so]] : 0.f;
#pragma unroll
    for (int n = 0; n < BN / 64; ++n)
      *(h16x4*)(sm + (wr * 128 + m * 16 + fr) * LDR + wc * (BN / 4) + n * 16 + 4 * fq) = pack4(acc[m][n][0] * w, acc[m][n][1] * w, acc[m][n][2] * w, acc[m][n][3] * w);
  }
  __syncthreads();
  constexpr int CH = BN / 8;
#pragma unroll
  for (int i = 0; i < CH / 2; ++i) {
    const int idx = i * NTHREADS + tid_e;
    const int r = idx / CH, c8 = idx % CH;
    const int so = mt * 256 + r;
    if (so < cnt_e) *(h16x8*)(yp + (size_t)le[so] * D + nt * 256 + half * 128 + c8 * 8) = *(const h16x8*)(sm + r * LDR + c8 * 8);
  }
  __syncthreads();
}
__device__ __forceinline__ void phase_moe2(const Params& p, int l, h16* sm) {
  int* sl = (int*)((unsigned char*)sm + SCHED_OFF);
  moe_sched(p, l, sl);
  const int total = __builtin_amdgcn_readfirstlane(sl[32]) * 4;
  const TileSched ts = xcd_sched(total);
  for (int t = ts.cur; t < ts.end; t += ts.step) moe2_tile<256>(p, sm, sl, t, 0);
  if (ts.tail_tile >= 0) {
    if (ts.tail_half < 0) moe2_tile<256>(p, sm, sl, ts.tail_tile, 0);
    else moe2_tile<128>(p, sm, sl, ts.tail_tile, ts.tail_half);
  }
}

#define XB_TMO      128
#define XB_XCNT(j)  (256  + 64 * (j))
#define XB_XSUB(j)  (1280 + 64 * (j))
#define XB_XGEN(j)  (2304 + 64 * (j))
#define XB_TOP      3328
#define XB_TOPGEN   3392
#define XCD_BAR_WORDS 3456
#define XB_SPIN_CAP (1u << 20)
__device__ __forceinline__ unsigned xb_ld(unsigned* p) { return __hip_atomic_load(p, __ATOMIC_RELAXED, __HIP_MEMORY_SCOPE_AGENT); }
__device__ __forceinline__ unsigned xb_add(unsigned* p, unsigned v) { return __hip_atomic_fetch_add(p, v, __ATOMIC_RELAXED, __HIP_MEMORY_SCOPE_AGENT); }
__device__ __forceinline__ unsigned xb_xcc_id() { return (unsigned)__builtin_amdgcn_s_getreg((3 << 11) | 20) & 0xFu; }
#define XB_SPIN(cond, bar) do { unsigned _sp = 0; while (cond) { __builtin_amdgcn_s_sleep(1); \
    if ((++_sp & 255u) == 0u) { if (xb_ld(&(bar)[XB_TMO])) break; if (_sp > XB_SPIN_CAP) { atomicAdd(&(bar)[XB_TMO], 1u); break; } } } } while (0)
struct XBar { unsigned* bar; unsigned x; volatile unsigned* st; };
__device__ __forceinline__ void xbar_post(XBar& b, unsigned* bar, volatile unsigned* st) {
  b.bar = bar; b.x = xb_xcc_id(); b.st = st;
  if (tidx() == 0) { st[0] = 0u; st[1] = 0u; (void)xb_add(&bar[XB_XCNT(b.x)], 1u); }
}
__device__ __forceinline__ void xbar_census(unsigned* bar, unsigned x, unsigned& nloc, unsigned& nx) {
  const unsigned G = gridDim.x;
  unsigned sum, cnt, mine, sp = 0u;
  for (;;) {
    sum = 0u; cnt = 0u; mine = 0u;
#pragma unroll
    for (unsigned j = 0; j < 16; ++j) { const unsigned c = xb_ld(&bar[XB_XCNT(j)]); sum += c; cnt += (c > 0u) ? 1u : 0u; mine = (j == x) ? c : mine; }
    if (sum == G) break;
    __builtin_amdgcn_s_sleep(1);
    if ((++sp & 255u) == 0u) { if (xb_ld(&bar[XB_TMO])) break; if (sp > XB_SPIN_CAP) { atomicAdd(&bar[XB_TMO], 1u); break; } }
  }
  nloc = mine > 0u ? mine : 1u; nx = cnt > 0u ? cnt : 1u;
}
__device__ __forceinline__ void xbar_sync(XBar& b) {
  asm volatile("s_waitcnt vmcnt(0)" ::: "memory");
  __syncthreads();
  if (tidx() == 0) {
    unsigned* bar = b.bar;
    __builtin_amdgcn_s_waitcnt(0);
    unsigned nloc = b.st[0], nx = b.st[1];
    if (nloc == 0u) { xbar_census(bar, b.x, nloc, nx); b.st[0] = nloc; b.st[1] = nx; }
    const unsigned old = xb_add(&bar[XB_XSUB(b.x)], 1u);
    const unsigned gen = old / nloc;
    if (old + 1u == (gen + 1u) * nloc) {
      __builtin_amdgcn_fence(__ATOMIC_RELEASE, "agent");
      asm volatile("s_waitcnt vmcnt(0)" ::: "memory");
      const unsigned og = xb_add(&bar[XB_TOP], 1u);
      const unsigned tg = og / nx;
      if (og + 1u == (tg + 1u) * nx) xb_add(&bar[XB_TOPGEN], 1u);
      else XB_SPIN(xb_ld(&bar[XB_TOPGEN]) == tg, bar);
      __builtin_amdgcn_fence(__ATOMIC_ACQUIRE, "agent");
      xb_add(&bar[XB_XGEN(b.x)], 1u);
      asm volatile("s_waitcnt vmcnt(0)" ::: "memory");
    } else {
      XB_SPIN(xb_ld(&bar[XB_XGEN(b.x)]) == gen, bar);
      __builtin_amdgcn_fence(__ATOMIC_ACQUIRE, "agent");
      asm volatile("s_waitcnt vmcnt(0)" ::: "memory");
    }
  }
  __syncthreads();
}

constexpr int NSTEPS = 20;
#define STEP(k, body) do { if (s_lo <= (k) && (k) < s_hi) { body; if ((k) + 1 < s_hi) { xbar_sync(xb); } \
    if (PROBE_MASK != 0u) { unsigned long long now_ = __builtin_amdgcn_s_memrealtime(); \
      if ((PROBE_MASK >> (k)) & 1u) { const unsigned long long w_ = (now_ - pt_prev) * PROBE_AMP; \
        while (__builtin_amdgcn_s_memrealtime() - now_ < w_) __builtin_amdgcn_s_sleep(8); now_ = __builtin_amdgcn_s_memrealtime(); } \
      pt_prev = now_; } } } while (0)
#define LAYER_STEPS(l, base) \
  STEP(base + 0, phase_norm1(p, l); if (l == 1) phase_convert(p, 1, (float*)smem)); \
  STEP(base + 1, phase_inproj(p, (h16*)smem)); \
  STEP(base + 2, phase_mixa(p, l, smem)); \
  STEP(base + 3, phase_mixb(p, l, (float*)smem)); \
  STEP(base + 4, phase_attn(p, l, (float*)smem)); \
  STEP(base + 5, phase_outproj(p, l, (h16*)smem)); \
  STEP(base + 6, phase_router(p, l, (int*)smem)); \
  STEP(base + 7, phase_moe1(p, l, (h16*)smem)); \
  STEP(base + 8, phase_moe2(p, l, (h16*)smem))

__global__ void __launch_bounds__(NTHREADS, 2) mega(Params p, int s_lo, int s_hi) {
  extern __shared__ __attribute__((aligned(16))) unsigned char smem[];
  unsigned long long pt_prev = PROBE_MASK != 0u ? __builtin_amdgcn_s_memrealtime() : 0ull;
  XBar xb;
  xbar_post(xb, (unsigned*)(p.ws + OFF_BAR), (volatile unsigned*)(smem + LDS_BYTES - 16));
  STEP(0, phase_prep(p, (float*)smem); phase_convert(p, 0, (float*)smem));
  LAYER_STEPS(0, 1);
  LAYER_STEPS(1, 10);
  STEP(19, phase_norm1(p, 2));
}

extern "C" void kernel_launch(void* const* d_in, const int* in_sizes, int n_in, void* d_out, int out_size, void* d_ws, size_t ws_size,
                              hipStream_t stream) {
  static int grid_blocks = 0;
  if (!grid_blocks) {
    if (n_in != 35 || out_size != T * D || ws_size < WS_TOTAL) {
      fprintf(stderr, "kernel_launch: unexpected problem (n_in %d, out %d, ws %zu < %zu)\n", n_in, out_size, ws_size, (size_t)WS_TOTAL);
      grid_blocks = -1;
      return;
    }
    int dev = 0, cus = 0, per_cu = 0;
    hipGetDevice(&dev);
    hipDeviceGetAttribute(&cus, hipDeviceAttributeMultiprocessorCount, dev);
    if (hipFuncSetAttribute((const void*)mega, hipFuncAttributeMaxDynamicSharedMemorySize, LDS_BYTES) != hipSuccess) {
      fprintf(stderr, "kernel_launch: hipFuncSetAttribute(%d B dynamic LDS) failed\n", LDS_BYTES);
      grid_blocks = -1;
      return;
    }
    hipOccupancyMaxActiveBlocksPerMultiprocessor(&per_cu, mega, NTHREADS, LDS_BYTES);
    if (per_cu > 1) per_cu = 1;
    if (per_cu < 1) { fprintf(stderr, "kernel_launch: occupancy query returned %d\n", per_cu); grid_blocks = -1; return; }
    grid_blocks = cus * per_cu;
  }
  if (grid_blocks < 0) return;
  Params p{};
  for (int i = 0; i < 35; ++i) p.in[i] = (const float*)d_in[i];
  p.out = (float*)d_out;
  p.ws = (unsigned char*)d_ws;
  for (int i = 0; i < 32; ++i) p.inv_freq[i] = std::pow(10000.0, -(double)(2 * i) / 64.0);
  if (hipMemsetAsync((char*)d_ws + OFF_BAR, 0, 16384, stream) != hipSuccess) { fprintf(stderr, "kernel_launch: memset of barrier words failed\n"); return; }
#if MEGA
  int lo = 0, hi = NSTEPS;
  void* args[] = {&p, &lo, &hi};
  hipError_t e = hipLaunchCooperativeKernel((void*)mega, dim3(grid_blocks), dim3(NTHREADS), args, LDS_BYTES, stream);
  if (e != hipSuccess) fprintf(stderr, "cooperative launch failed: %s (grid %d)\n", hipGetErrorString(e), grid_blocks);
#else
  for (int s = 0; s < NSTEPS; ++s) {
    int lo = s, hi = s + 1;
    void* args[] = {&p, &lo, &hi};
    hipError_t e = hipLaunchCooperativeKernel((void*)mega, dim3(grid_blocks), dim3(NTHREADS), args, LDS_BYTES, stream);
    if (e != hipSuccess) { fprintf(stderr, "launch %d failed: %s (grid %d)\n", s, hipGetErrorString(e), grid_blocks); break; }
  }
#endif
}
```

```cpp
#include <hip/hip_runtime.h>
#include <hip/hip_cooperative_groups.h>
#include <cstdio>
#include <cstdint>
#include <cmath>
namespace cg = cooperative_groups;

#ifndef MEGA
#define MEGA 1
#endif
#ifndef PROBE_MASK
#define PROBE_MASK 0u
#define PROBE_AMP 3
#endif

typedef _Float16 h16;
typedef _Float16 h16x8 __attribute__((ext_vector_type(8)));
typedef _Float16 h16x4 __attribute__((ext_vector_type(4)));
typedef float f32x4 __attribute__((ext_vector_type(4)));

constexpr int NB = 2, S = 8192, T = NB * S, D = 1024;
constexpr int NIN = 2432;
constexpr int NINSRC = 2328;
constexpr int C_XL = 0, C_GL = 256, C_Q = 512, C_KC = 1024, C_VC = 1152, C_KS = 1280, C_VS = 1408, C_KW = 1536, C_VW = 1664,
              C_CVA = 1792, C_CVB = 2048, C_GATE = 2304;
constexpr float EPS = 1e-6f;
constexpr int NTHREADS = 512, NW = 8;
constexpr int LDS_BYTES = 150528;
constexpr int NINP = 2560;
constexpr int SCHED_OFF = LDS_BYTES - 1024;
constexpr float ASCALE = 16.f;

constexpr size_t al256(size_t x) { return (x + 255) & ~(size_t)255; }
constexpr size_t OFF_CTL = 0;
constexpr size_t OFF_BAR = 4096;
constexpr size_t OFF_MOD = 4096 + 16384;
constexpr size_t OFF_ROPE = al256(OFF_MOD + 2 * 2 * 6144 * 4);
constexpr size_t OFF_PB = al256(OFF_ROPE + (size_t)T * 64 * 4);
constexpr size_t OFF_PBPART = al256(OFF_PB + 2 * 256 * 4);
constexpr size_t OFF_LRUW = al256(OFF_PBPART + 2 * 32 * 256 * 4);
constexpr size_t OFF_GATES = al256(OFF_LRUW + 2 * 4 * 64 * 64 * 2);
constexpr size_t OFF_WIN = al256(OFF_GATES + (size_t)T * 24 * 4);
constexpr size_t OFF_WOUT = al256(OFF_WIN + (size_t)NINP * 1024 * 2);
constexpr size_t OFF_WGU = al256(OFF_WOUT + (size_t)1024 * 1024 * 2);
constexpr size_t OFF_WDN = al256(OFF_WGU + (size_t)16 * 1024 * 1024 * 2);
constexpr size_t OFF_W1K = al256(OFF_WDN + (size_t)16 * 1024 * 512 * 2);
constexpr size_t OFF_W1V = al256(OFF_W1K + (size_t)256 * 2048 * 2);
constexpr size_t OFF_H16 = al256(OFF_W1V + (size_t)256 * 2048 * 2);
constexpr size_t OFF_Q16 = al256(OFF_H16 + (size_t)T * 1024 * 2);
constexpr size_t KVSZ = (size_t)T * 128 * 2;
constexpr size_t OFF_KC = al256(OFF_Q16 + (size_t)T * 512 * 2);
constexpr size_t OFF_VC = al256(OFF_KC + KVSZ + 4096);
constexpr size_t OFF_KS = al256(OFF_VC + KVSZ + 4096);
constexpr size_t OFF_VST = al256(OFF_KS + KVSZ);
constexpr size_t OFF_KW = al256(OFF_VST + KVSZ);
constexpr size_t OFF_VWT = al256(OFF_KW + KVSZ);
constexpr size_t OFF_HIDC = al256(OFF_VWT + KVSZ);
constexpr size_t OFF_KCMP = al256(OFF_HIDC + (size_t)2 * 2048 * 256 * 2);
constexpr size_t OFF_VCMPT = al256(OFF_KCMP + (size_t)4 * 512 * 64 * 2);
constexpr size_t OFF_LRUH = al256(OFF_VCMPT + (size_t)4 * 512 * 64 * 2);
constexpr size_t OFF_LRUA = al256(OFF_LRUH + (size_t)T * 256 * 4);
constexpr size_t OFF_HEND = al256(OFF_LRUA + (size_t)T * 256 * 4);
constexpr size_t OFF_AEND = al256(OFF_HEND + 2 * 256 * 256 * 4);
constexpr size_t OFF_CARRY = al256(OFF_AEND + 2 * 256 * 256 * 4);
constexpr size_t OFF_XA = al256(OFF_CARRY + 2 * 256 * 256 * 4);
constexpr size_t OFF_LIST = al256(OFF_XA + (size_t)T * 1024 * 4);
constexpr size_t OFF_WPAIR = al256(OFF_LIST + (size_t)16 * 16384 * 4);
constexpr size_t OFF_SSQ = al256(OFF_WPAIR + 32768 * 4);
constexpr size_t OFF_R = al256(OFF_SSQ + (size_t)T * 2 * 4);
constexpr size_t OFF_P16 = OFF_R;
constexpr size_t OFF_HID = OFF_R;
constexpr size_t OFF_YPAIR = al256(OFF_HID + (size_t)(32768 + 512) * 512 * 2);
constexpr size_t OFF_HIDP = al256(OFF_P16 + (size_t)T * NIN * 2);
constexpr size_t R_END1 = OFF_HIDP + (size_t)4 * 2 * 2048 * 256 * 4;
constexpr size_t R_END2 = OFF_YPAIR + (size_t)32768 * 1024 * 2;
constexpr size_t WS_TOTAL = al256(R_END1 > R_END2 ? R_END1 : R_END2);

struct Params {
  const float* in[35];
  float* out;
  unsigned char* ws;
  double inv_freq[32];
};
enum { I_X = 0, I_C, I_POS, I_ADAW, I_ADAB, I_N1G, I_N2G, I_WIN, I_LCW, I_LCB, I_LWA, I_LBA, I_LWX, I_LBX, I_LLAM, I_CKW1, I_CKW2,
       I_CVW1, I_CVW2, I_CPK, I_CPV, I_DWW, I_DWB, I_LNG, I_LNB, I_ONG, I_WOUT, I_RGW, I_RGB, I_REW, I_REB, I_MG, I_MU, I_MD, I_FNG };

__device__ __forceinline__ int tidx() { int t = threadIdx.x; asm volatile("" : "+v"(t)); return t; }
__device__ __forceinline__ float wsum(float v) {
#pragma unroll
  for (int o = 32; o > 0; o >>= 1) v += __shfl_xor(v, o);
  return v;
}
__device__ __forceinline__ float sigm(float x) { return 1.f / (1.f + __expf(-x)); }
__device__ __forceinline__ float silu_f(float x) { return x / (1.f + __expf(-x)); }
__device__ __forceinline__ float gelu_tanh(float x) {
  float u = 0.7978845608028654f * (x + 0.044715f * x * x * x);
  float e = __expf(2.f * u);
  float t = 1.f - 2.f / (e + 1.f);
  return 0.5f * x * (1.f + t);
}
__device__ __forceinline__ void glds16(const h16* g, h16* l) {
  __builtin_amdgcn_global_load_lds((const unsigned*)g, (unsigned*)l, 16, 0, 0);
}
__device__ __forceinline__ h16x4 pack4(float a, float b, float c, float d) {
  h16x4 r; r[0] = (h16)a; r[1] = (h16)b; r[2] = (h16)c; r[3] = (h16)d; return r;
}

struct TileIter { int cur, end, step; };
__device__ __forceinline__ TileIter xcd_tiles(int ntiles) {
  const int G = gridDim.x, b = blockIdx.x;
  TileIter it;
  if ((G & 7) == 0) {
    const int x = b & 7;
    it.cur = (int)(((long)ntiles * x) >> 3) + (b >> 3);
    it.end = (int)(((long)ntiles * (x + 1)) >> 3);
    it.step = G >> 3;
  } else { it.cur = b; it.end = ntiles; it.step = G; }
  return it;
}

#define VMCNT(n) asm volatile("s_waitcnt vmcnt(" #n ")" ::: "memory")
template <int BN, class ARowFn>
__device__ __forceinline__ void gemm_mainloop(f32x4 (&acc)[8][BN / 64], ARowFn arow, const h16* __restrict__ Bt, int ldb, int nk, h16* sm, bool zero_init = true) {
  constexpr int NF = BN / 64, NBP = BN / 64;
  constexpr int STAGE = 16384 + BN * 64;
  constexpr int NST = BN == 128 ? 3 : 2;
  const int tid = tidx(), lane = tid & 63, wave = tid >> 6;
  const int wr = wave >> 2, wc = wave & 3, fr = lane & 15, fq = lane >> 4;
  const h16* ap[4];
  const h16* bp[NBP];
#pragma unroll
  for (int i = 0; i < 4; ++i) {
    const int r = (i * 8 + wave) * 8 + (lane >> 3);
    const int c = (lane & 7) ^ ((r >> 1) & 7);
    ap[i] = arow(r) + c * 8;
    if (i < NBP) bp[i] = Bt + (size_t)r * ldb + c * 8;
  }
  if (zero_init) {
#pragma unroll
    for (int m = 0; m < 8; ++m)
#pragma unroll
      for (int n = 0; n < NF; ++n) acc[m][n] = (f32x4){0.f, 0.f, 0.f, 0.f};
  }
  h16* const dA = sm + wave * 512 + lane * 8;
#pragma unroll
  for (int st0 = 0; st0 < NST - 1; ++st0)
    if (st0 < nk) {
#pragma unroll
      for (int i = 0; i < 4; ++i) { glds16(ap[i], dA + st0 * STAGE + i * 4096); ap[i] += 64; }
#pragma unroll
      for (int i = 0; i < NBP; ++i) { glds16(bp[i], dA + st0 * STAGE + 16384 + i * 4096); bp[i] += 64; }
    }
  const int sw = (fr >> 1) & 7;
  const int aoff = (wr * 128 + fr) * 64, boff = 16384 + (wc * (BN / 4) + fr) * 64;
#define SCHED_FENCE() __builtin_amdgcn_sched_barrier(0)
  for (int kt = 0; kt < nk; ++kt) {
    if (NST == 3 && kt + 1 < nk) VMCNT(6); else VMCNT(0);
    __builtin_amdgcn_s_barrier();
    const int sl_ = NST == 3 ? kt % 3 : (kt & 1);
    const h16* st = sm + sl_ * STAGE;
    const bool more = kt + (NST - 1) < nk;
    h16* const dn = dA + (NST == 3 ? (sl_ == 0 ? 2 : sl_ - 1) : (sl_ ^ 1)) * STAGE;
#pragma unroll
    for (int ks = 0; ks < 2; ++ks) {
      const int ch = ((ks * 4 + fq) ^ sw) * 8;
      h16x8 bf[NF];
#pragma unroll
      for (int n = 0; n < NF; ++n) bf[n] = *(const h16x8*)(st + boff + n * 1024 + ch);
#pragma unroll
      for (int mh = 0; mh < 2; ++mh) {
        h16x8 af[4];
#pragma unroll
        for (int m = 0; m < 4; ++m) af[m] = *(const h16x8*)(st + aoff + (mh * 4 + m) * 1024 + ch);
#pragma unroll
        for (int m = 0; m < 4; ++m) {
#pragma unroll
          for (int n = 0; n < NF; ++n) acc[mh * 4 + m][n] = __builtin_amdgcn_mfma_f32_16x16x32_f16(bf[n], af[m], acc[mh * 4 + m][n], 0, 0, 0);
          if (m == 1 || m == 3) {
            const int q = ks * 4 + mh * 2 + (m >> 1);
            SCHED_FENCE();
            if (more) {
              if (q < 4) { glds16(ap[q & 3], dn + (q & 3) * 4096); ap[q & 3] += 64; }
              else if ((q & 3) < NBP) { glds16(bp[(q & 3) < NBP ? (q & 3) : 0], dn + 16384 + (q & 3) * 4096); bp[(q & 3) < NBP ? (q & 3) : 0] += 64; }
            }
            SCHED_FENCE();
          }
        }
      }
    }
  }
#undef SCHED_FENCE
  __builtin_amdgcn_s_barrier();
}

struct TileSched { int cur, end, step, tail_tile, tail_half; };
__device__ __forceinline__ TileSched xcd_sched(int ntiles) {
  const int G = gridDim.x, b = blockIdx.x;
  TileSched s;
  s.tail_tile = -1; s.tail_half = -1;
  if ((G & 7) == 0) {
    const int x = b & 7, nb = G >> 3, si = b >> 3;
    const int lo = (int)(((long)ntiles * x) >> 3), hi = (int)(((long)ntiles * (x + 1)) >> 3);
    const int n = hi - lo, R = n / nb, rem = n - R * nb;
    s.cur = lo + si; s.end = lo + R * nb; s.step = nb;
    if (rem * 2 <= nb) { if (si < 2 * rem) { s.tail_tile = lo + R * nb + (si >> 1); s.tail_half = si & 1; } }
    else if (si < rem) s.tail_tile = lo + R * nb + si;
  } else { s.cur = b; s.end = ntiles; s.step = G; }
  return s;
}

__device__ __forceinline__ int map_row(int mode, int n) {
  if (mode == 1) return n < 1792 ? n : (n < 1816 ? n + 512 : n - 24);
  if (mode == 2) return 32 * (n >> 4) + (n & 15);
  if (mode == 3) return 32 * (n >> 4) + 16 + (n & 15);
  return n;
}
struct ConvTile { const float* src; h16* dst; int K, N, mode, k0, n0; const float* pos; float* pbp; };
__device__ __forceinline__ ConvTile conv_decode(const Params& p, int l, int t) {
  unsigned char* ws = p.ws;
  constexpr int T_WIN = 16 * 37, T_WOUT = 256, T_G = 16 * 128, T_W1 = 128;
  constexpr int E0 = T_WIN, E1 = E0 + T_WOUT, E2 = E1 + T_G, E3 = E2 + T_G, E4 = E3 + T_G, E5 = E4 + T_W1;
  ConvTile c;
  c.pos = nullptr; c.pbp = nullptr;
  int tk, tn;
  if (t < E0) {
    c.src = p.in[I_WIN] + (size_t)l * 1024 * NINSRC; c.K = 1024; c.N = NINSRC; c.dst = (h16*)(ws + OFF_WIN); c.mode = 1; tk = t / 37; tn = t % 37;
  } else if (t < E1) {
    const int u = t - E0;
    c.src = p.in[I_WOUT] + (size_t)l * 1024 * 1024; c.K = 1024; c.N = 1024; c.dst = (h16*)(ws + OFF_WOUT); c.mode = 4; tk = u >> 4; tn = u & 15;
  } else if (t < E3) {
    const int up = t >= E2;
    const int u = t - (up ? E2 : E1);
    const int e = u >> 7, v = u & 127;
    c.src = p.in[up ? I_MU : I_MG] + ((size_t)l * 16 + e) * 1024 * 512; c.K = 1024; c.N = 512; c.dst = (h16*)(ws + OFF_WGU) + (size_t)e * 1024 * 1024;
    c.mode = up ? 3 : 2; tk = v >> 3; tn = v & 7;
  } else if (t < E4) {
    const int u = t - E3;
    const int e = u >> 7, v = u & 127;
    c.src = p.in[I_MD] + ((size_t)l * 16 + e) * 512 * 1024; c.K = 512; c.N = 1024; c.dst = (h16*)(ws + OFF_WDN) + (size_t)e * 1024 * 512; c.mode = 0; tk = v >> 4; tn = v & 15;
  } else {
    const int vv = t >= E5;
    const int u = t - (vv ? E5 : E4);
    c.src = p.in[vv ? I_CVW1 : I_CKW1] + (size_t)l * 2048 * 256; c.K = 2048; c.N = 256; c.dst = (h16*)(ws + (vv ? OFF_W1V : OFF_W1K)); c.mode = 5; tk = u >> 2; tn = u & 3;
    c.pos = p.in[vv ? I_CPV : I_CPK] + (size_t)l * 2048 + tk * 64;
    c.pbp = (float*)(ws + OFF_PBPART) + (size_t)(vv * 32 + tk) * 256 + tn * 64;
  }
  c.k0 = tk * 64; c.n0 = tn * 64;
  return c;
}
__device__ __forceinline__ void conv_wave_tile(const ConvTile& c, float* smw, int lane) {
  float4 v[16];
#pragma unroll
  for (int i = 0; i < 16; ++i) {
    const int idx = i * 64 + lane;
    const int r = idx >> 4, c4 = (idx & 15) * 4;
    v[i] = make_float4(0.f, 0.f, 0.f, 0.f);
    if (c.n0 + c4 < c.N) v[i] = *(const float4*)(c.src + (size_t)(c.k0 + r) * c.N + c.n0 + c4);
  }
#pragma unroll
  for (int i = 0; i < 16; ++i) {
    const int idx = i * 64 + lane;
    const int r = idx >> 4, c4 = (idx & 15) * 4;
    float* d = smw + r * 65 + c4;
    d[0] = v[i].x; d[1] = v[i].y; d[2] = v[i].z; d[3] = v[i].w;
  }
  if (c.mode == 5) {
    float sacc = 0.f;
    for (int k = 0; k < 64; ++k) sacc += c.pos[k] * smw[k * 65 + lane];
    c.pbp[lane] = sacc;
  }
  const int k0d = c.mode == 4 ? (c.k0 < 256 ? c.k0 + 512 : (c.k0 < 768 ? c.k0 - 256 : c.k0)) : c.k0;
#pragma unroll
  for (int j = 0; j < 8; ++j) {
    const int ch = j * 64 + lane;
    const int n = ch >> 3, kc = ch & 7;
    if (c.n0 + n < c.N) {
      h16x8 o;
#pragma unroll
      for (int q = 0; q < 8; ++q) o[q] = (h16)smw[(kc * 8 + q) * 65 + n];
      *(h16x8*)(c.dst + (size_t)map_row(c.mode, c.n0 + n) * c.K + k0d + kc * 8) = o;
    }
  }
}

__device__ __forceinline__ void phase_convert(const Params& p, int l, float* sm) {
  unsigned char* ws = p.ws;
  constexpr int NT_CONV = 16 * 37 + 256 + 3 * 16 * 128 + 2 * 128;
  {
    const int tid = tidx(), lane = tid & 63, wave = tid >> 6;
    float* smw = sm + wave * 4160;
    for (int t = blockIdx.x * NW + wave; t < NT_CONV; t += gridDim.x * NW) {
      const ConvTile c = conv_decode(p, l, t);
      conv_wave_tile(c, smw, lane);
    }
    __syncthreads();
  }
  {
    h16* lw = (h16*)(ws + OFF_LRUW);
    for (int i = blockIdx.x * NTHREADS + tidx(); i < 2 * 4 * 64 * 64; i += gridDim.x * NTHREADS) {
      const int d = i & 63, e = (i >> 6) & 63, n = (i >> 12) & 3, mat = i >> 14;
      lw[i] = (h16)p.in[mat ? I_LWX : I_LWA][((size_t)(l * 4 + n) * 64 + d) * 64 + e];
    }
  }
  {
    h16x8 z = {0, 0, 0, 0, 0, 0, 0, 0};
    h16* w = (h16*)(ws + OFF_WIN) + (size_t)NINSRC * 1024;
    for (int i = blockIdx.x * NTHREADS + tidx(); i < (NINP - NINSRC) * 1024 / 8; i += gridDim.x * NTHREADS) *(h16x8*)(w + (size_t)i * 8) = z;
  }
}

__device__ __forceinline__ void phase_prep(const Params& p, float* sm) {
  unsigned char* ws = p.ws;
  const int tid = tidx();
  if (blockIdx.x == 0) {
    for (int i = tid; i < 1024; i += NTHREADS) ((unsigned*)(ws + OFF_CTL))[i] = 0u;
  }
  float* mod = (float*)(ws + OFF_MOD);
  for (int t = blockIdx.x; t < 384; t += gridDim.x) {
    const int l = t / 192, j0 = (t % 192) * 32;
    const int kg = tid >> 3, cq = tid & 7;
    const float* w = p.in[I_ADAW] + (size_t)l * 1024 * 6144 + j0 + 4 * cq;
    const float* c = p.in[I_C];
    float a0[4] = {0, 0, 0, 0}, a1[4] = {0, 0, 0, 0};
#pragma unroll 8
    for (int k = kg * 16; k < kg * 16 + 16; ++k) {
      const float4 wv = *(const float4*)(w + (size_t)k * 6144);
      const float s0 = silu_f(c[k]), s1 = silu_f(c[1024 + k]);
      a0[0] += s0 * wv.x; a0[1] += s0 * wv.y; a0[2] += s0 * wv.z; a0[3] += s0 * wv.w;
      a1[0] += s1 * wv.x; a1[1] += s1 * wv.y; a1[2] += s1 * wv.z; a1[3] += s1 * wv.w;
    }
    float* r = sm + (kg * 8 + cq) * 8;
#pragma unroll
    for (int i = 0; i < 4; ++i) { r[i] = a0[i]; r[4 + i] = a1[i]; }
    __syncthreads();
    if (tid < 64) {
      const int bb = tid >> 5, col = tid & 31, q = col >> 2, ci = col & 3;
      float s = 0.f;
      for (int g = 0; g < 64; ++g) s += sm[(g * 8 + q) * 8 + bb * 4 + ci];
      mod[(size_t)(l * 2 + bb) * 6144 + j0 + col] = s + p.in[I_ADAB][l * 6144 + j0 + col];
    }
    __syncthreads();
  }
  float* rc = (float*)(ws + OFF_ROPE);
  float* rs = rc + (size_t)T * 32;
  const int* pos = (const int*)p.in[I_POS];
  for (int i = blockIdx.x * NTHREADS + tid; i < T * 32; i += gridDim.x * NTHREADS) {
    const int t = i >> 5, f = i & 31;
    const double a = (double)pos[t] * p.inv_freq[f];
    const double n = rint(a * 0.15915494309189535);
    double r = fma(-n, 6.283185307179586, a);
    r = fma(-n, 2.4492935982947064e-16, r);
    const float rf = (float)r;
    rc[i] = cosf(rf);
    rs[i] = sinf(rf);
  }
}

__device__ __forceinline__ void phase_norm1(const Params& p, int mode) {
  unsigned char* ws = p.ws;
  const int lane = tidx() & 63, wave = tidx() >> 6;
  const float* mod = (const float*)(ws + OFF_MOD);
  float* xa = (float*)(ws + OFF_XA);
  const h16* yp = (const h16*)(ws + OFF_YPAIR);
  h16* hout = (h16*)(ws + OFF_H16);
  const int l = (mode == 0) ? 0 : 1;
  for (int row = blockIdx.x * NW + wave; row < T; row += gridDim.x * NW) {
    const int b = row >> 13;
    float4 x[4];
    float ss = 0.f;
#pragma unroll
    for (int i = 0; i < 4; ++i) {
      const int col = lane * 4 + 256 * i;
      if (mode == 0) {
        x[i] = *(const float4*)(p.in[I_X] + (size_t)row * D + col);
      } else {
        const int lp = mode == 1 ? 0 : 1;
        const float4 xv = *(const float4*)(xa + (size_t)row * D + col);
        const float4 g2 = *(const float4*)(mod + (size_t)(lp * 2 + b) * 6144 + 5120 + col);
        const h16x4 y0 = *(const h16x4*)(yp + (size_t)(row * 2) * D + col);
        const h16x4 y1 = *(const h16x4*)(yp + (size_t)(row * 2 + 1) * D + col);
        x[i].x = xv.x + g2.x * ((float)y0[0] + (float)y1[0]);
        x[i].y = xv.y + g2.y * ((float)y0[1] + (float)y1[1]);
        x[i].z = xv.z + g2.z * ((float)y0[2] + (float)y1[2]);
        x[i].w = xv.w + g2.w * ((float)y0[3] + (float)y1[3]);
        if (mode == 1) *(float4*)(xa + (size_t)row * D + col) = x[i];
      }
      ss += x[i].x * x[i].x + x[i].y * x[i].y + x[i].z * x[i].z + x[i].w * x[i].w;
    }
    ss = wsum(ss);
    const float rstd = rsqrtf(ss * (1.f / D) + EPS);
#pragma unroll
    for (int i = 0; i < 4; ++i) {
      const int col = lane * 4 + 256 * i;
      if (mode == 2) {
        const float4 g = *(const float4*)(p.in[I_FNG] + col);
        float4 o;
        o.x = x[i].x * rstd * g.x; o.y = x[i].y * rstd * g.y; o.z = x[i].z * rstd * g.z; o.w = x[i].w * rstd * g.w;
        *(float4*)(p.out + (size_t)row * D + col) = o;
      } else {
        const float4 g = *(const float4*)(p.in[I_N1G] + l * D + col);
        const float4 sh = *(const float4*)(mod + (size_t)(l * 2 + b) * 6144 + col);
        const float4 sc = *(const float4*)(mod + (size_t)(l * 2 + b) * 6144 + 1024 + col);
        *(h16x4*)(hout + (size_t)row * D + col) = pack4(x[i].x * rstd * g.x * (1.f + sc.x) + sh.x, x[i].y * rstd * g.y * (1.f + sc.y) + sh.y,
                                                        x[i].z * rstd * g.z * (1.f + sc.z) + sh.z, x[i].w * rstd * g.w * (1.f + sc.w) + sh.w);
      }
    }
  }
}

__device__ __forceinline__ int perm_key(int pos) {
  return 32 * (pos >> 5) + 16 * ((pos >> 2) & 1) + 4 * ((pos >> 3) & 3) + (pos & 3);
}
__device__ __forceinline__ void inproj_tile(const Params& p, h16* sm, int mt, int nt) {
  unsigned char* ws = p.ws;
  const h16* Ab = (const h16*)(ws + OFF_H16) + (size_t)mt * 256 * D;
  f32x4 acc[8][2];
  gemm_mainloop<128>(acc, [&](int r) { return Ab + (size_t)r * D; }, (const h16*)(ws + OFF_WIN) + (size_t)nt * 128 * D, D, D / 64, sm);
  const int tid_e = tidx(), lane = tid_e & 63, wave = tid_e >> 6, wr = wave >> 2, wc = wave & 3, fr = lane & 15, fq = lane >> 4;
  constexpr int LDR = 136;
#pragma unroll
  for (int m = 0; m < 8; ++m)
#pragma unroll
    for (int n = 0; n < 2; ++n)
      *(h16x4*)(sm + (wr * 128 + m * 16 + fr) * LDR + wc * 32 + n * 16 + 4 * fq) = pack4(acc[m][n][0], acc[m][n][1], acc[m][n][2], acc[m][n][3]);
  __syncthreads();
  const int row0 = mt * 256, b = mt >> 5, s0 = (mt & 31) * 256;
  if (nt < 4 || (nt >= 14 && nt < 18)) {
    h16* P = (h16*)(ws + OFF_P16);
#pragma unroll
    for (int i = 0; i < 8; ++i) {
      const int idx = i * NTHREADS + tid_e;
      const int r = idx >> 4, c8 = idx & 15;
      *(h16x8*)(P + (size_t)(row0 + r) * NIN + nt * 128 + c8 * 8) = *(const h16x8*)(sm + r * LDR + c8 * 8);
    }
  } else if (nt <= 8 || nt == 10 || nt == 12) {
    const float* rc = (const float*)(ws + OFF_ROPE);
    const float* rs = rc + (size_t)T * 32;
    const bool isq = nt < 8;
    const float scl = isq ? 0.125f * 1.4426950408889634f : 1.f;
    h16* kbase = (h16*)(ws + (nt == 8 ? OFF_KC : (nt == 10 ? OFF_KS : OFF_KW)));
    h16* q16 = (h16*)(ws + OFF_Q16);
#pragma unroll
    for (int i = 0; i < 4; ++i) {
      const int idx = i * NTHREADS + tid_e;
      const int r = idx >> 3, hd = (idx >> 2) & 1, d = (idx & 3) * 8;
      const h16x8 a = *(const h16x8*)(sm + r * LDR + 64 * hd + d);
      const h16x8 bb = *(const h16x8*)(sm + r * LDR + 64 * hd + 32 + d);
      const float* cp = rc + (size_t)(row0 + r) * 32 + d;
      const float* sp = rs + (size_t)(row0 + r) * 32 + d;
      const float4 c0 = *(const float4*)cp, c1 = *(const float4*)(cp + 4), n0 = *(const float4*)sp, n1 = *(const float4*)(sp + 4);
      const float cs[8] = {c0.x, c0.y, c0.z, c0.w, c1.x, c1.y, c1.z, c1.w}, sn[8] = {n0.x, n0.y, n0.z, n0.w, n1.x, n1.y, n1.z, n1.w};
      h16x8 lo, hi;
#pragma unroll
      for (int j = 0; j < 8; ++j) {
        const float av = (float)a[j], bv = (float)bb[j];
        lo[j] = (h16)((av * cs[j] - bv * sn[j]) * scl);
        hi[j] = (h16)((bv * cs[j] + av * sn[j]) * scl);
      }
      h16* dst = isq ? q16 + (size_t)(row0 + r) * 512 + (nt - 4) * 128 + 64 * hd + d : kbase + ((size_t)(b * 2 + hd) * S + s0 + r) * 64 + d;
      *(h16x8*)dst = lo;
      *(h16x8*)(dst + 32) = hi;
    }
  } else if (nt == 9) {
    h16* vc = (h16*)(ws + OFF_VC);
#pragma unroll
    for (int i = 0; i < 8; ++i) {
      const int idx = i * NTHREADS + tid_e;
      const int r = idx >> 4, c8 = idx & 15, hd = c8 >> 3, dd = (c8 & 7) * 8;
      *(h16x8*)(vc + ((size_t)(b * 2 + hd) * S + s0 + r) * 64 + dd) = *(const h16x8*)(sm + r * LDR + c8 * 8);
    }
  } else if (nt == 11 || nt == 13) {
    h16* vt = (h16*)(ws + (nt == 11 ? OFF_VST : OFF_VWT));
#pragma unroll
    for (int i = 0; i < 8; ++i) {
      const int idx = i * NTHREADS + tid_e;
      const int kv = idx >> 11, blk = (idx >> 9) & 3, dim = (idx >> 3) & 63, p0 = (idx & 7) * 8;
      h16x8 v;
#pragma unroll
      for (int j = 0; j < 8; ++j) v[j] = sm[(blk * 64 + perm_key(p0 + j)) * LDR + 64 * kv + dim];
      *(h16x8*)(vt + ((size_t)((b * 2 + kv) * 128 + (s0 >> 6) + blk)) * 4096 + dim * 64 + p0) = v;
    }
  } else {
    float* gates = (float*)(ws + OFF_GATES);
#pragma unroll
    for (int i = 0; i < 12; ++i) {
      const int idx = i * NTHREADS + tid_e;
      const int r = idx / 24, cc = idx % 24;
      gates[(size_t)(row0 + r) * 24 + cc] = sigm((float)sm[r * LDR + cc]);
    }
  }
  __syncthreads();
}
__device__ __forceinline__ void phase_inproj(const Params& p, h16* sm) {
  const TileIter tf = xcd_tiles(64 * 19);
  for (int t = tf.cur; t < tf.end; t += tf.step) inproj_tile(p, sm, t / 19, t % 19);
}

__device__ __forceinline__ void mixa_compress1(const Params& p, int item, h16* sm) {
  unsigned char* ws = p.ws;
  const int which = item >> 5, mt = (item >> 2) & 7, ks = item & 3;
  const h16* A = (const h16*)(ws + (which ? OFF_VC : OFF_KC)) + (size_t)mt * 256 * 1024 + ks * 512;
  const h16* W = (const h16*)(ws + (which ? OFF_W1V : OFF_W1K)) + ks * 512;
  float* hp = (float*)(ws + OFF_HIDP) + ((size_t)(ks * 2 + which) * 2048) * 256;
  f32x4 acc[8][4];
  gemm_mainloop<256>(acc, [&](int r) { return A + (size_t)r * 1024; }, W, 2048, 8, sm);
  const int tid_e = tidx(), lane = tid_e & 63, wave = tid_e >> 6, wr = wave >> 2, wc = wave & 3, fr = lane & 15, fq = lane >> 4;
#pragma unroll
  for (int m = 0; m < 8; ++m)
#pragma unroll
    for (int n = 0; n < 4; ++n) {
      const int row = mt * 256 + wr * 128 + m * 16 + fr, col = wc * 64 + n * 16 + 4 * fq;
      *(f32x4*)(hp + (size_t)row * 256 + col) = acc[m][n];
    }
}

__device__ __forceinline__ void mixa_lru(const Params& p, int l, int item, float* sm) {
  unsigned char* ws = p.ws;
  const int tid = tidx();
  const int half = tid >> 8;
  item = item * 2 + half;
  sm += half * 14400;
  const int b = item >> 8, ck = item & 255;
  const int c = tid & 255;
  const int nb = c >> 6;
  const int lane = tid & 63, fr = lane & 15, fq = lane >> 4;
  const h16* P = (const h16*)(ws + OFF_P16);
  const float* cw = p.in[I_LCW] + l * 4 * 256;
  const float w0 = cw[c], w1 = cw[256 + c], w2 = cw[512 + c], w3 = cw[768 + c], cb = p.in[I_LCB][l * 256 + c];
  const float ba = p.in[I_LBA][l * 256 + c], bx = p.in[I_LBX][l * 256 + c];
  const float lam = p.in[I_LLAM][l * 256 + c];
  const float ls = -log1pf(expf(-lam));
  h16x8 bw[2][4][2];
  {
    const h16* lw = (const h16*)(ws + OFF_LRUW);
#pragma unroll
    for (int mat = 0; mat < 2; ++mat)
#pragma unroll
      for (int nt = 0; nt < 4; ++nt)
#pragma unroll
        for (int ks = 0; ks < 2; ++ks) bw[mat][nt][ks] = *(const h16x8*)(lw + ((size_t)((mat * 4 + nb) * 64 + nt * 16 + fr)) * 64 + ks * 32 + 8 * fq);
  }
  const int t0 = ck * 32;
  float x0 = 0.f, x1 = 0.f, x2 = 0.f;
  if (t0 >= 3) {
    x0 = (float)P[(size_t)(b * S + t0 - 3) * NIN + C_XL + c];
    x1 = (float)P[(size_t)(b * S + t0 - 2) * NIN + C_XL + c];
    x2 = (float)P[(size_t)(b * S + t0 - 1) * NIN + C_XL + c];
  }
  float h = 0.f, ap = 1.f;
  float* lh = (float*)(ws + OFF_LRUH);
  float* la = (float*)(ws + OFF_LRUA);
  float* sr = sm + 4096;
  float* si = sm + 8192;
  h16* xh = (h16*)(sm + 12288);
#pragma unroll 1
  for (int sub = 0; sub < 2; ++sub) {
    const int tb = t0 + sub * 16;
    {
      h16 xv[16];
      const h16* xp = P + (size_t)(b * S + tb) * NIN + C_XL + c;
#pragma unroll
      for (int tt = 0; tt < 16; ++tt) { xv[tt] = *xp; xp += NIN; asm volatile("" : "+v"(xp)); }
#pragma unroll
      for (int tt = 0; tt < 16; ++tt) {
        const float x3 = (float)xv[tt];
        const float xc = w0 * x0 + w1 * x1 + w2 * x2 + w3 * x3 + cb;
        sm[tt * 256 + c] = xc;
        xh[tt * 264 + c] = (h16)xc;
        x0 = x1; x1 = x2; x2 = x3;
      }
    }
    {
      h16x8 af[2];
#pragma unroll
      for (int ks = 0; ks < 2; ++ks) af[ks] = *(const h16x8*)(xh + fr * 264 + nb * 64 + ks * 32 + 8 * fq);
#pragma unroll
      for (int nt = 0; nt < 4; ++nt) {
        f32x4 ar = {0.f, 0.f, 0.f, 0.f}, ai = {0.f, 0.f, 0.f, 0.f};
#pragma unroll
        for (int ks = 0; ks < 2; ++ks) {
          ar = __builtin_amdgcn_mfma_f32_16x16x32_f16(af[ks], bw[0][nt][ks], ar, 0, 0, 0);
          ai = __builtin_amdgcn_mfma_f32_16x16x32_f16(af[ks], bw[1][nt][ks], ai, 0, 0, 0);
        }
#pragma unroll
        for (int j = 0; j < 4; ++j) {
          sr[(4 * fq + j) * 256 + nb * 64 + nt * 16 + fr] = ar[j];
          si[(4 * fq + j) * 256 + nb * 64 + nt * 16 + fr] = ai[j];
        }
      }
    }
#pragma unroll 4
    for (int tt = 0; tt < 16; ++tt) {
      const float r = sigm(sr[tt * 256 + c] + ba), ig = sigm(si[tt * 256 + c] + bx);
      const float log_a = 8.f * r * ls;
      const float a = __expf(log_a);
      const float mult = sqrtf(-expm1f(2.f * log_a));
      sr[tt * 256 + c] = a;
      si[tt * 256 + c] = mult * ig * sm[tt * 256 + c];
    }
    float* lhp = lh + (size_t)(b * S + tb) * 256 + c;
    float* lap = la + (size_t)(b * S + tb) * 256 + c;
#pragma unroll 4
    for (int tt = 0; tt < 16; ++tt) {
      const float a = sr[tt * 256 + c];
      h = a * h + si[tt * 256 + c];
      ap *= a;
      lhp[tt * 256] = h;
      lap[tt * 256] = ap;
    }
  }
  ((float*)(ws + OFF_HEND))[(size_t)(b * 256 + ck) * 256 + c] = h;
  ((float*)(ws + OFF_AEND))[(size_t)(b * 256 + ck) * 256 + c] = ap;
  __syncthreads();
}

__device__ __forceinline__ void mixa_conv(const Params& p, int l, int item, float* sm) {
  unsigned char* ws = p.ws;
  const int half = tidx() >> 8;
  item = item * 2 + half;
  sm += half * 15872;
  const int b = item >> 8, ck = item & 255;
  const int c = tidx() & 255;
  const h16* P = (const h16*)(ws + OFF_P16);
  const int t0 = ck * 32;
  float col[64];
#pragma unroll
  for (int r0 = 0; r0 < 64; r0 += 16) {
    h16 va[16], vb[16];
#pragma unroll
    for (int q = 0; q < 16; ++q) {
      const int t = t0 - 30 + r0 + q;
      va[q] = (h16)0.f; vb[q] = (h16)0.f;
      if (t >= 0 && r0 + q < 62) {
        const h16* pr = P + (size_t)(b * S + t) * NIN;
        va[q] = pr[C_CVA + c]; vb[q] = pr[C_CVB + c];
      }
    }
#pragma unroll
    for (int q = 0; q < 16; ++q) col[r0 + q] = (float)va[q] * sigm((float)vb[q]);
    asm volatile("" ::: "memory");
  }
  float w[31];
#pragma unroll
  for (int j = 0; j < 31; ++j) w[j] = p.in[I_DWW][(size_t)(l * 31 + j) * 256 + c];
  const float bias = p.in[I_DWB][l * 256 + c];
#pragma unroll
  for (int i = 0; i < 32; ++i) {
    float z = bias;
#pragma unroll
    for (int j = 0; j < 31; ++j) z += w[j] * col[i + j];
    sm[i * 256 + c] = z;
  }
  __syncthreads();
  const int lane = tidx() & 63, wave = (tidx() >> 6) & 3;
  const float4 lg = *(const float4*)(p.in[I_LNG] + l * 256 + lane * 4);
  const float4 lb = *(const float4*)(p.in[I_LNB] + l * 256 + lane * 4);
  const float4 gn = *(const float4*)(p.in[I_ONG] + l * 1024 + 768 + lane * 4);
  h16* yc = (h16*)(ws + OFF_H16);
  for (int i = wave * 8; i < wave * 8 + 8; ++i) {
    const float4 z = *(const float4*)(sm + i * 256 + lane * 4);
    const float mu = wsum(z.x + z.y + z.z + z.w) * (1.f / 256.f);
    const float dx = z.x - mu, dy = z.y - mu, dz = z.z - mu, dw = z.w - mu;
    const float var = wsum(dx * dx + dy * dy + dz * dz + dw * dw) * (1.f / 256.f);
    const float rs = rsqrtf(var + EPS);
    const float y0 = silu_f(dx * rs * lg.x + lb.x), y1 = silu_f(dy * rs * lg.y + lb.y), y2 = silu_f(dz * rs * lg.z + lb.z), y3 = silu_f(dw * rs * lg.w + lb.w);
    const float r2 = rsqrtf(wsum(y0 * y0 + y1 * y1 + y2 * y2 + y3 * y3) * (1.f / 256.f) + EPS);
    *(h16x4*)(yc + (size_t)(b * S + t0 + i) * D + 768 + lane * 4) = pack4(y0 * r2 * gn.x, y1 * r2 * gn.y, y2 * r2 * gn.z, y3 * r2 * gn.w);
  }
  __syncthreads();
}

__device__ __forceinline__ void phase_mixa(const Params& p, int l, void* sm) {
  const int G = gridDim.x;
  if (blockIdx.x == 0) {
    const int o = tidx();
    const float* pp = (const float*)(p.ws + OFF_PBPART) + (size_t)(o >> 8) * 32 * 256 + (o & 255);
    float pv[32];
#pragma unroll
    for (int k = 0; k < 32; ++k) pv[k] = pp[k * 256];
    float accb = 0.f;
#pragma unroll
    for (int k = 0; k < 32; ++k) accb += pv[k];
    ((float*)(p.ws + OFF_PB))[o] = accb;
  }
  for (int it = blockIdx.x; it < 64; it += G) mixa_compress1(p, it, (h16*)sm);
  for (int it = blockIdx.x; it < 256; it += G) mixa_lru(p, l, it, (float*)sm);
  for (int it = (blockIdx.x + G - 64 % G) % G; it < 256; it += G) mixa_conv(p, l, it, (float*)sm);
}

__device__ __forceinline__ void phase_mixb(const Params& p, int l, float* sm) {
  unsigned char* ws = p.ws;
  const int tid = tidx();
  for (int it = blockIdx.x; it < 512; it += gridDim.x) {
    const int which = it >> 8;
    const int row0 = (it & 255) * 8;
    {
      const float* hp = (const float*)(ws + OFF_HIDP) + ((size_t)which * 2048 + row0) * 256;
      const float* pb = (const float*)(ws + OFF_PB) + which * 256;
      const int r = tid >> 6, c4 = (tid & 63) * 4;
      const size_t o = (size_t)r * 256 + c4;
      const float4 a0 = *(const float4*)(hp + o), a1 = *(const float4*)(hp + (size_t)2 * 2048 * 256 + o);
      const float4 a2 = *(const float4*)(hp + (size_t)4 * 2048 * 256 + o), a3 = *(const float4*)(hp + (size_t)6 * 2048 * 256 + o);
      const float4 bb = *(const float4*)(pb + c4);
      float* d = sm + r * 256 + c4;
      d[0] = gelu_tanh(a0.x + a1.x + a2.x + a3.x + bb.x); d[1] = gelu_tanh(a0.y + a1.y + a2.y + a3.y + bb.y);
      d[2] = gelu_tanh(a0.z + a1.z + a2.z + a3.z + bb.z); d[3] = gelu_tanh(a0.w + a1.w + a2.w + a3.w + bb.w);
      const float4* wsrc = (const float4*)(p.in[which ? I_CVW2 : I_CKW2] + (size_t)l * 256 * 64);
      float4* wdst = (float4*)(sm + 2048);
#pragma unroll
      for (int q = 0; q < 8; ++q) wdst[q * NTHREADS + tid] = wsrc[q * NTHREADS + tid];
    }
    __syncthreads();
    const int row = row0 + (tid >> 6), d = tid & 63;
    const float* hr = sm + (tid >> 6) * 256;
    const float* w2 = sm + 2048 + d;
    float s = 0.f;
#pragma unroll 8
    for (int j = 0; j < 256; ++j) s += (float)(h16)hr[j] * w2[j * 64];
    const int bkv = row >> 9, n = row & 511;
    if (n == 511) s = 0.f;
    if (which == 0) {
      ((h16*)(ws + OFF_KCMP))[((size_t)bkv * 512 + n) * 64 + d] = (h16)s;
    } else {
      const int blk = n >> 6, key = n & 63;
      const int pos = 32 * (key >> 5) + 8 * ((key >> 2) & 3) + 4 * ((key >> 4) & 1) + (key & 3);
      ((h16*)(ws + OFF_VCMPT))[((size_t)(bkv * 8 + blk) * 64 + d) * 64 + pos] = (h16)s;
    }
    __syncthreads();
  }
  for (int task = (blockIdx.x + gridDim.x - 16 % gridDim.x) % gridDim.x; task < 16; task += gridDim.x) {
    const int b = task >> 3, c = (task & 7) * 32 + (tid & 31), grp = tid >> 5;
    const float* he = (const float*)(ws + OFF_HEND) + ((size_t)b * 256 + grp * 16) * 256 + c;
    const float* ae = (const float*)(ws + OFF_AEND) + ((size_t)b * 256 + grp * 16) * 256 + c;
    float* cy = (float*)(ws + OFF_CARRY) + ((size_t)b * 256 + grp * 16) * 256 + c;
    float hv[16], av[16];
#pragma unroll
    for (int k = 0; k < 16; ++k) { hv[k] = he[k * 256]; av[k] = ae[k * 256]; }
    float ga = 1.f, gh = 0.f;
#pragma unroll
    for (int k = 0; k < 16; ++k) { gh = hv[k] + av[k] * gh; ga *= av[k]; }
    sm[tid] = ga; sm[512 + tid] = gh;
    __syncthreads();
    float carry = 0.f;
    for (int q = 0; q < grp; ++q) carry = sm[512 + q * 32 + (tid & 31)] + sm[q * 32 + (tid & 31)] * carry;
#pragma unroll
    for (int k = 0; k < 16; ++k) {
      cy[k * 256] = carry;
      carry = hv[k] + av[k] * carry;
    }
    __syncthreads();
  }
}

__device__ __forceinline__ void stage8k(const h16* __restrict__ g, h16* l, int tid) {
  const int r = tid >> 3, cl = (tid & 7) ^ ((r >> 1) & 7);
  glds16(g + r * 64 + cl * 8, l + tid * 8);
}
__device__ __forceinline__ h16x8 ldfrag(const h16* l, int row, int chunk) {
  return *(const h16x8*)(l + row * 64 + ((chunk ^ ((row >> 1) & 7)) * 8));
}

template <int MODE>
__device__ __forceinline__ void attn_branch(const h16* __restrict__ Kg, const h16* __restrict__ Vg, int j0, int j1, h16* ring,
                                            const h16x8 (&qf)[2][2], float (&m)[2], float (&l)[2], f32x4 (&o)[2][4],
                                            const int (&tq)[2], const int (&lim)[2], const int (&tlim)[2], const int (&tfl)[2],
                                            const unsigned long long (&mylo)[2], const unsigned long long (&myhi)[2],
                                            const unsigned long long (&ulo)[2], const unsigned long long (&uhi)[2],
                                            const float (&inv)[2], float* impw) {
  int tid = tidx();
  asm volatile("" : "+v"(tid));
  const int lane = tid & 63;
  const int h = lane >> 4, c = lane & 15, qi = c >> 2, g = c & 3;
  constexpr bool PV = MODE != 0;
  constexpr int SS = 3;
  const int n = j1 - j0 + 1;
  if (n <= 0) return;
  const int nss = (n + SS - 1) / SS;
#pragma unroll
  for (int q = 0; q < SS; ++q)
    if (q < n) {
      stage8k(Kg + (size_t)(j0 + q) * 4096, ring + q * 8192, tid);
      if (PV) stage8k(Vg + (size_t)(j0 + q) * 4096, ring + q * 8192 + 4096, tid);
    }
  int sbase = 0;
  for (int ss = 0; ss < nss; ++ss) {
    VMCNT(0);
    __builtin_amdgcn_s_barrier();
    {
      const int sn = SS - sbase;
#pragma unroll
      for (int q = 0; q < SS; ++q) {
        const int jb = SS * (ss + 1) + q;
        if (jb < n) {
          stage8k(Kg + (size_t)(j0 + jb) * 4096, ring + (sn + q) * 8192, tid);
          if (PV) stage8k(Vg + (size_t)(j0 + jb) * 4096, ring + (sn + q) * 8192 + 4096, tid);
        }
      }
    }
#pragma unroll 1
   for (int sub = 0; sub < SS; ++sub) {
    const int it = SS * ss + sub;
    if (it >= n) break;
    const int j = j0 + it;
    const h16* cK = ring + (sbase + sub) * 8192;
    const h16* cV = cK + 4096;
    bool act[2];
#pragma unroll
    for (int mq = 0; mq < 2; ++mq) {
      if (MODE <= 1) act[mq] = j * 64 <= tlim[mq];
      else if (MODE == 2) act[mq] = ((j < 64 ? (ulo[mq] >> j) : (uhi[mq] >> (j - 64))) & 1ull) != 0ull;
      else act[mq] = (j * 64 <= tlim[mq] + 3) && (j * 64 + 63 > tlim[mq] - 512);
    }
    if (act[0] || act[1]) {
      h16x8 pf[2][2];
      h16x8 kf[4][2];
#pragma unroll
      for (int kt = 0; kt < 4; ++kt)
#pragma unroll
        for (int ks = 0; ks < 2; ++ks) kf[kt][ks] = ldfrag(cK, 16 * kt + c, 4 * ks + h);
#pragma unroll
      for (int mq = 0; mq < 2; ++mq)
        if (act[mq]) {
          f32x4 s[1][4];
          {
#pragma unroll
            for (int kt = 0; kt < 4; ++kt) {
              s[0][kt] = (f32x4){0.f, 0.f, 0.f, 0.f};
#pragma unroll
              for (int ks = 0; ks < 2; ++ks) s[0][kt] = __builtin_amdgcn_mfma_f32_16x16x32_f16(kf[kt][ks], qf[mq][ks], s[0][kt], 0, 0, 0);
            }
          }
          const bool selbit = MODE == 2 ? (((j < 64 ? (mylo[mq] >> j) : (myhi[mq] >> (j - 64))) & 1ull) != 0ull) : true;
          bool interior;
          if (MODE <= 1) interior = j * 64 + 63 <= tfl[mq];
          else if (MODE == 2) interior = j * 64 + 63 <= tfl[mq];
          else interior = (j * 64 + 63 <= tfl[mq]) && (j * 64 > tfl[mq] + 3 - 512);
          if (!interior) {
            const int pbase = j * 64 + 4 * h;
#pragma unroll
            for (int kt = 0; kt < 4; ++kt)
#pragma unroll
              for (int i = 0; i < 4; ++i) {
                const int pos = pbase + 16 * kt + i;
                bool v;
                if (MODE <= 1) v = pos <= lim[mq];
                else if (MODE == 2) v = selbit && pos <= tq[mq];
                else v = pos <= tq[mq] && pos > tq[mq] - 512;
                s[0][kt][i] = v ? s[0][kt][i] : -1e30f;
              }
          }
          const bool rowoff = MODE == 2 && interior && !selbit;
          if (MODE == 1) {
#pragma unroll
            for (int kt = 0; kt < 4; ++kt) {
              float ps = 0.f;
#pragma unroll
              for (int i = 0; i < 4; ++i) {
                const float pv = __builtin_amdgcn_exp2f(s[0][kt][i] - m[mq]) * inv[mq];
                s[0][kt][i] = pv;
                ps += pv;
              }
              ps += __shfl_xor(ps, 1);
              ps += __shfl_xor(ps, 2);
              if (g == 0) impw[(4 * mq + qi) * 128 + j * 16 + kt * 4 + h] = ps;
            }
          } else {
            float bm = fmaxf(fmaxf(fmaxf(s[0][0][0], s[0][0][1]), fmaxf(s[0][0][2], s[0][0][3])), fmaxf(fmaxf(s[0][1][0], s[0][1][1]), fmaxf(s[0][1][2], s[0][1][3])));
            bm = fmaxf(bm, fmaxf(fmaxf(fmaxf(s[0][2][0], s[0][2][1]), fmaxf(s[0][2][2], s[0][2][3])), fmaxf(fmaxf(s[0][3][0], s[0][3][1]), fmaxf(s[0][3][2], s[0][3][3]))));
            bm = rowoff ? -1e30f : bm;
            if (__any(bm > m[mq] + 8.f)) {
              bm = fmaxf(bm, __shfl_xor(bm, 16));
              bm = fmaxf(bm, __shfl_xor(bm, 32));
              const float mn = fmaxf(m[mq], bm);
              const float alpha = __builtin_amdgcn_exp2f(m[mq] - mn);
              l[mq] *= alpha;
              m[mq] = mn;
              if (PV) {
#pragma unroll
                for (int mt = 0; mt < 4; ++mt) o[mq][mt] *= alpha;
              }
            }
            const float mref = (m[mq] > -1e29f && !rowoff) ? m[mq] : 1e30f;
            float ps = 0.f;
#pragma unroll
            for (int kt = 0; kt < 4; ++kt)
#pragma unroll
              for (int i = 0; i < 4; ++i) {
                const float pv = __builtin_amdgcn_exp2f(s[0][kt][i] - mref);
                s[0][kt][i] = pv;
                ps += pv;
              }
            l[mq] += ps;
          }
          if (PV) {
#pragma unroll
            for (int s2 = 0; s2 < 2; ++s2)
#pragma unroll
              for (int i = 0; i < 4; ++i) { pf[mq][s2][i] = (h16)s[0][2 * s2][i]; pf[mq][s2][4 + i] = (h16)s[0][2 * s2 + 1][i]; }
          }
        }
      if (PV) {
        h16x8 vf[4][2];
#pragma unroll
        for (int mt = 0; mt < 4; ++mt)
#pragma unroll
          for (int s2 = 0; s2 < 2; ++s2) vf[mt][s2] = ldfrag(cV, 16 * mt + c, 4 * s2 + h);
#pragma unroll
        for (int mq = 0; mq < 2; ++mq)
          if (act[mq]) {
#pragma unroll
            for (int s2 = 0; s2 < 2; ++s2) {
#pragma unroll
              for (int mt = 0; mt < 4; ++mt) o[mq][mt] = __builtin_amdgcn_mfma_f32_16x16x32_f16(vf[mt][s2], pf[mq][s2], o[mq][mt], 0, 0, 0);
            }
          }
      }
    }
   }
    sbase = SS - sbase;
  }
  __builtin_amdgcn_s_barrier();
}

__device__ __forceinline__ void attn_item(const Params& p, int l, int item, float* sm) {
  unsigned char* ws = p.ws;
  int tid = tidx();
  asm volatile("" : "+v"(tid));
  const int lane = tid & 63, wave = tid >> 6;
  const int combo = item & 3, qt = item >> 2;
  const int b = combo >> 1, kv = combo & 1;
  const int t0 = qt * 64, tw0 = t0 + 8 * wave;
  const int h = lane >> 4, c = lane & 15, qi = c >> 2, g = c & 3;
  const int head = kv * 4 + g, bkv = b * 2 + kv;
  h16* ring = (h16*)sm;
  float* impw = sm + 24576 + wave * 1024;
  unsigned long long* selm = (unsigned long long*)(sm + 24576 + 8192) + wave * 16;

  h16x8 qf[2][2];
  int tq[2];
#pragma unroll
  for (int mq = 0; mq < 2; ++mq) {
    tq[mq] = tw0 + 4 * mq + qi;
    const h16* qrow = (const h16*)(ws + OFF_Q16) + (size_t)(b * S + tq[mq]) * 512 + head * 64;
    qf[mq][0] = *(const h16x8*)(qrow + 8 * h);
    qf[mq][1] = *(const h16x8*)(qrow + 32 + 8 * h);
  }
  for (int i = lane; i < 1024; i += 64) impw[i] = 0.f;

  h16x4 ofin[2][4];
  float m[2], ll[2], inv[2];
  f32x4 o[2][4];
  const unsigned long long z2[2] = {0ull, 0ull};
  {
    int lim[2], tlim[2], tflc[2];
#pragma unroll
    for (int mq = 0; mq < 2; ++mq) {
      lim[mq] = tq[mq] >= 31 ? ((tq[mq] - 31) >> 4) : -1;
      const int tl = tw0 + 4 * mq + 3;
      tlim[mq] = tl >= 31 ? ((tl - 31) >> 4) : -1;
      const int tf0 = tw0 + 4 * mq;
      tflc[mq] = tf0 >= 31 ? ((tf0 - 31) >> 4) : -1;
      m[mq] = -1e30f; ll[mq] = 0.f; inv[mq] = 0.f;
#pragma unroll
      for (int mt = 0; mt < 4; ++mt) o[mq][mt] = (f32x4){0.f, 0.f, 0.f, 0.f};
    }
    const int nl = (t0 + 63 - 31) >> 4;
    const int jl = nl >> 6;
    const h16* Kc = (const h16*)(ws + OFF_KCMP) + (size_t)bkv * 512 * 64;
    const h16* Vc = (const h16*)(ws + OFF_VCMPT) + (size_t)bkv * 8 * 4096;
    attn_branch<0>(Kc, Vc, 0, jl, ring, qf, m, ll, o, tq, lim, tlim, tflc, z2, z2, z2, z2, inv, impw);
#pragma unroll
    for (int mq = 0; mq < 2; ++mq) {
      float lt = ll[mq];
      lt += __shfl_xor(lt, 16);
      lt += __shfl_xor(lt, 32);
      inv[mq] = lt > 0.f ? 1.f / lt : 0.f;
    }
    attn_branch<1>(Kc, Vc, 0, jl, ring, qf, m, ll, o, tq, lim, tlim, tflc, z2, z2, z2, z2, inv, impw);
    const float* gt0 = (const float*)(ws + OFF_GATES) + (size_t)(b * S) * 24 + head * 3;
#pragma unroll
    for (int mq = 0; mq < 2; ++mq) {
      const float g0 = gt0[(size_t)tq[mq] * 24] * ASCALE;
#pragma unroll
      for (int mt = 0; mt < 4; ++mt) ofin[mq][mt] = pack4(o[mq][mt][0] * g0, o[mq][mt][1] * g0, o[mq][mt][2] * g0, o[mq][mt][3] * g0);
    }
  }
  for (int q = 0; q < 8; ++q) {
    const int t = tw0 + q, own = t >> 6;
    const float* ir = impw + q * 128;
    const int ja = lane, jb = lane + 64;
    unsigned k0 = 0u, k1 = 0u;
    if (ja <= own) k0 = (ja == 0 || ja == own) ? (0xFFFFFF80u | (unsigned)(127 - ja)) : (((__float_as_uint(ir[ja]) & ~127u) | (unsigned)(127 - ja)) + 1u);
    if (jb <= own) k1 = (jb == own) ? (0xFFFFFF80u | (unsigned)(127 - jb)) : (((__float_as_uint(ir[jb]) & ~127u) | (unsigned)(127 - jb)) + 1u);
    unsigned thr = 0u;
    for (int bit = 31; bit >= 0; --bit) {
      const unsigned cand = thr | (1u << bit);
      const int cnt = __popcll(__ballot(k0 >= cand)) + __popcll(__ballot(k1 >= cand));
      if (cnt >= 16) thr = cand;
    }
    const unsigned long long mlo = __ballot(k0 >= thr && ja <= own);
    const unsigned long long mhi = __ballot(k1 >= thr && jb <= own);
    if (lane == 0) { selm[q * 2] = mlo; selm[q * 2 + 1] = mhi; }
  }
  unsigned long long mylo[2], myhi[2], ulo[2], uhi[2];
#pragma unroll
  for (int mq = 0; mq < 2; ++mq) {
    mylo[mq] = selm[(4 * mq + qi) * 2];
    myhi[mq] = selm[(4 * mq + qi) * 2 + 1];
    unsigned long long a = selm[(4 * mq) * 2] | selm[(4 * mq + 1) * 2] | selm[(4 * mq + 2) * 2] | selm[(4 * mq + 3) * 2];
    unsigned long long bb = selm[(4 * mq) * 2 + 1] | selm[(4 * mq + 1) * 2 + 1] | selm[(4 * mq + 2) * 2 + 1] | selm[(4 * mq + 3) * 2 + 1];
    ulo[mq] = (unsigned long long)__builtin_amdgcn_readfirstlane((unsigned)a) | ((unsigned long long)__builtin_amdgcn_readfirstlane((unsigned)(a >> 32)) << 32);
    uhi[mq] = (unsigned long long)__builtin_amdgcn_readfirstlane((unsigned)bb) | ((unsigned long long)__builtin_amdgcn_readfirstlane((unsigned)(bb >> 32)) << 32);
  }
  const float* gtb = (const float*)(ws + OFF_GATES) + (size_t)(b * S) * 24 + head * 3;
  {
    int tl0[2] = {0, 0};
    const int tfs[2] = {tw0, tw0 + 4};
#pragma unroll
    for (int mq = 0; mq < 2; ++mq) {
      m[mq] = -1e30f; ll[mq] = 0.f;
#pragma unroll
      for (int mt = 0; mt < 4; ++mt) o[mq][mt] = (f32x4){0.f, 0.f, 0.f, 0.f};
    }
    attn_branch<2>((const h16*)(ws + OFF_KS) + (size_t)bkv * S * 64, (const h16*)(ws + OFF_VST) + (size_t)bkv * 128 * 4096, 0, (t0 + 63) >> 6, ring, qf, m, ll, o,
                   tq, tl0, tl0, tfs, mylo, myhi, ulo, uhi, inv, impw);
#pragma unroll
    for (int mq = 0; mq < 2; ++mq) {
      float lt = ll[mq];
      lt += __shfl_xor(lt, 16);
      lt += __shfl_xor(lt, 32);
      const float sc = lt > 0.f ? gtb[(size_t)tq[mq] * 24 + 1] * ASCALE / lt : 0.f;
#pragma unroll
      for (int mt = 0; mt < 4; ++mt)
        ofin[mq][mt] = pack4((float)ofin[mq][mt][0] + o[mq][mt][0] * sc, (float)ofin[mq][mt][1] + o[mq][mt][1] * sc, (float)ofin[mq][mt][2] + o[mq][mt][2] * sc,
                             (float)ofin[mq][mt][3] + o[mq][mt][3] * sc);
    }
  }
  {
    int tl0[2] = {0, 0}, tf[2];
#pragma unroll
    for (int mq = 0; mq < 2; ++mq) {
      tf[mq] = tw0 + 4 * mq;
      m[mq] = -1e30f; ll[mq] = 0.f;
#pragma unroll
      for (int mt = 0; mt < 4; ++mt) o[mq][mt] = (f32x4){0.f, 0.f, 0.f, 0.f};
    }
    const int jlo = t0 >= 511 ? ((t0 - 511) >> 6) : 0;
    attn_branch<3>((const h16*)(ws + OFF_KW) + (size_t)bkv * S * 64, (const h16*)(ws + OFF_VWT) + (size_t)bkv * 128 * 4096, jlo, (t0 + 63) >> 6, ring, qf, m, ll, o,
                   tq, tl0, tf, tf, z2, z2, z2, z2, inv, impw);
#pragma unroll
    for (int mq = 0; mq < 2; ++mq) {
      float lt = ll[mq];
      lt += __shfl_xor(lt, 16);
      lt += __shfl_xor(lt, 32);
      const float sc = lt > 0.f ? gtb[(size_t)tq[mq] * 24 + 2] * ASCALE / lt : 0.f;
#pragma unroll
      for (int mt = 0; mt < 4; ++mt)
        ofin[mq][mt] = pack4((float)ofin[mq][mt][0] + o[mq][mt][0] * sc, (float)ofin[mq][mt][1] + o[mq][mt][1] * sc, (float)ofin[mq][mt][2] + o[mq][mt][2] * sc,
                             (float)ofin[mq][mt][3] + o[mq][mt][3] * sc);
    }
  }
  {
    h16* yc = (h16*)(ws + OFF_H16);
    const float* gn = p.in[I_ONG] + l * 1024 + 256 + head * 64;
    float* ssq = (float*)(ws + OFF_SSQ);
#pragma unroll
    for (int mq = 0; mq < 2; ++mq) {
      float sq = 0.f;
      h16* yr = yc + (size_t)(b * S + tq[mq]) * D + head * 64;
#pragma unroll
      for (int mt = 0; mt < 4; ++mt) {
        const float v[4] = {(float)ofin[mq][mt][0], (float)ofin[mq][mt][1], (float)ofin[mq][mt][2], (float)ofin[mq][mt][3]};
        sq += v[0] * v[0] + v[1] * v[1] + v[2] * v[2] + v[3] * v[3];
        const float4 gg = *(const float4*)(gn + 16 * mt + 4 * h);
        *(h16x4*)(yr + 16 * mt + 4 * h) = pack4(v[0] * gg.x, v[1] * gg.y, v[2] * gg.z, v[3] * gg.w);
      }
      sq += __shfl_xor(sq, 16);
      sq += __shfl_xor(sq, 32);
      sq += __shfl_xor(sq, 1);
      sq += __shfl_xor(sq, 2);
      if (h == 0 && g == 0) ssq[(size_t)(b * S + tq[mq]) * 2 + kv] = sq * (1.f / (ASCALE * ASCALE));
    }
  }
}

__device__ __forceinline__ void lrufix_item(const Params& p, int l, int item) {
  unsigned char* ws = p.ws;
  const int lane = tidx() & 63, wave = tidx() >> 6;
  const int b = item >> 7, ck = item & 127;
  const h16* P = (const h16*)(ws + OFF_P16);
  const float4 cy = *(const float4*)((const float*)(ws + OFF_CARRY) + (size_t)(b * 256 + ck * 2 + (wave >> 2)) * 256 + lane * 4);
  const float4 gn = *(const float4*)(p.in[I_ONG] + l * 1024 + lane * 4);
  h16* yc = (h16*)(ws + OFF_H16);
  float4 hl[8], al[8];
  h16x4 gl[8];
#pragma unroll
  for (int q = 0; q < 8; ++q) {
    const size_t row = (size_t)(b * S + ck * 64 + wave * 8 + q);
    hl[q] = *(const float4*)((const float*)(ws + OFF_LRUH) + row * 256 + lane * 4);
    al[q] = *(const float4*)((const float*)(ws + OFF_LRUA) + row * 256 + lane * 4);
    gl[q] = *(const h16x4*)(P + row * NIN + C_GL + lane * 4);
  }
#pragma unroll
  for (int q = 0; q < 8; ++q) {
    const size_t row = (size_t)(b * S + ck * 64 + wave * 8 + q);
    const float y0 = (hl[q].x + al[q].x * cy.x) * gelu_tanh((float)gl[q][0]);
    const float y1 = (hl[q].y + al[q].y * cy.y) * gelu_tanh((float)gl[q][1]);
    const float y2 = (hl[q].z + al[q].z * cy.z) * gelu_tanh((float)gl[q][2]);
    const float y3 = (hl[q].w + al[q].w * cy.w) * gelu_tanh((float)gl[q][3]);
    const float rstd = rsqrtf(wsum(y0 * y0 + y1 * y1 + y2 * y2 + y3 * y3) * (1.f / 256.f) + EPS);
    *(h16x4*)(yc + row * D + 512 + lane * 4) = pack4(y0 * rstd * gn.x, y1 * rstd * gn.y, y2 * rstd * gn.z, y3 * rstd * gn.w);
  }
}

__device__ __forceinline__ void phase_attn(const Params& p, int l, float* sm) {
  for (int it = blockIdx.x; it < 256; it += gridDim.x) {
#pragma unroll 1
    for (int rep = 0; rep < 2; ++rep) attn_item(p, l, rep ? (127 - (it >> 2)) * 4 + (it & 3) : it, sm);
  }
  for (int it = blockIdx.x; it < 256; it += gridDim.x) lrufix_item(p, l, it);
}

__device__ __forceinline__ void phase_outproj(const Params& p, int l, h16* sm) {
  unsigned char* ws = p.ws;
  const h16* A = (const h16*)(ws + OFF_H16);
  const h16* W = (const h16*)(ws + OFF_WOUT);
  const float* mod = (const float*)(ws + OFF_MOD);
  float* xa = (float*)(ws + OFF_XA);
  const float* xin = l == 0 ? p.in[I_X] : (const float*)xa;
  const TileIter ti = xcd_tiles(64 * 4);
  for (int t = ti.cur; t < ti.end; t += ti.step) {
    const int mt = t >> 2, nt = t & 3;
    f32x4 acc[8][4];
    const h16* Ab = A + (size_t)mt * 256 * D;
    {
      float* sct = (float*)((unsigned char*)sm + SCHED_OFF - 1024);
      const int tq_ = tidx();
      if (tq_ < 256) {
        const float2 q2 = *(const float2*)((const float*)(ws + OFF_SSQ) + (size_t)(mt * 256 + tq_) * 2);
        sct[tq_] = rsqrtf((q2.x + q2.y) * (1.f / 512.f) + EPS) * (1.f / ASCALE);
      }
    }
    gemm_mainloop<256>(acc, [&](int r) { return Ab + (size_t)r * D; }, W + (size_t)nt * 256 * D, D, 8, sm);
    const int tid_e = tidx(), lane = tid_e & 63, wave = tid_e >> 6, wr = wave >> 2, wc = wave & 3, fr = lane & 15, fq = lane >> 4;
    {
      const float* sct = (const float*)((const unsigned char*)sm + SCHED_OFF - 1024) + wr * 128 + fr;
#pragma unroll
      for (int m = 0; m < 8; ++m) {
        const float sc = sct[m * 16];
#pragma unroll
        for (int n = 0; n < 4; ++n) acc[m][n] *= sc;
      }
    }
    gemm_mainloop<256>(acc, [&](int r) { return Ab + (size_t)r * D + 512; }, W + (size_t)nt * 256 * D + 512, D, 8, sm, false);
    {
      float* stf = (float*)sm;
      constexpr int LDF = 260;
#pragma unroll 1
      for (int pass = 0; pass < 2; ++pass) {
        if (wr == pass) {
#pragma unroll
          for (int m = 0; m < 8; ++m)
#pragma unroll
            for (int n = 0; n < 4; ++n) *(f32x4*)(stf + (m * 16 + fr) * LDF + wc * 64 + n * 16 + 4 * fq) = acc[m][n];
        }
        __syncthreads();
#pragma unroll 4
        for (int i = 0; i < 16; ++i) {
          const int idx = i * NTHREADS + tid_e;
          const int r = idx >> 6, c4 = (idx & 63) * 4;
          const int row = mt * 256 + pass * 128 + r, col = nt * 256 + c4;
          const int b = row >> 13;
          const f32x4 a = *(const f32x4*)(stf + r * LDF + c4);
          const float4 g1 = *(const float4*)(mod + (size_t)(l * 2 + b) * 6144 + 2048 + col);
          const float4 xv = *(const float4*)(xin + (size_t)row * D + col);
          float4 o;
          o.x = xv.x + g1.x * a[0]; o.y = xv.y + g1.y * a[1]; o.z = xv.z + g1.z * a[2]; o.w = xv.w + g1.w * a[3];
          *(float4*)(xa + (size_t)row * D + col) = o;
        }
        __syncthreads();
      }
    }
  }
}

__device__ __forceinline__ void phase_router(const Params& p, int l, int* smi) {
  unsigned char* ws = p.ws;
  const int tid = tidx(), lane = tid & 63, wave = tid >> 6;
  const float* mod = (const float*)(ws + OFF_MOD);
  const float* xa = (const float*)(ws + OFF_XA);
  h16* hout = (h16*)(ws + OFF_H16);
  unsigned* cnt = (unsigned*)(ws + OFF_CTL) + 64 + l * 16;
  int* list = (int*)(ws + OFF_LIST);
  float* wpair = (float*)(ws + OFF_WPAIR);
  const float* rgb = p.in[I_RGB] + l * 4;
  int* cntl = smi;
  int* basel = smi + 16;
  int* tok = smi + 32;
  float* wl = (float*)smi + 256;
  {
    const float4* s0 = (const float4*)(p.in[I_RGW] + (size_t)l * 1024 * 4);
    const float4* s1 = (const float4*)(p.in[I_REW] + (size_t)l * 4 * 1024 * 4);
    float4* d = (float4*)wl;
#pragma unroll
    for (int q = 0; q < 2; ++q) d[q * NTHREADS + tid] = s0[q * NTHREADS + tid];
#pragma unroll
    for (int q = 0; q < 8; ++q) d[1024 + q * NTHREADS + tid] = s1[q * NTHREADS + tid];
  }
  const float* rgw = wl;
  for (int chunk = blockIdx.x; chunk < T / 64; chunk += gridDim.x) {
    if (tid < 16) cntl[tid] = 0;
    __syncthreads();
    float4 xn[4];
#pragma unroll
    for (int i = 0; i < 4; ++i) xn[i] = *(const float4*)(xa + (size_t)(chunk * 64 + wave) * D + lane * 4 + 256 * i);
    for (int ti = wave; ti < 64; ti += NW) {
      const int row = chunk * 64 + ti;
      const int b = row >> 13;
      float4 x[4];
      float ss = 0.f;
#pragma unroll
      for (int i = 0; i < 4; ++i) x[i] = xn[i];
      if (ti + NW < 64) {
#pragma unroll
        for (int i = 0; i < 4; ++i) xn[i] = *(const float4*)(xa + (size_t)(row + NW) * D + lane * 4 + 256 * i);
      }
#pragma unroll
      for (int i = 0; i < 4; ++i) ss += x[i].x * x[i].x + x[i].y * x[i].y + x[i].z * x[i].z + x[i].w * x[i].w;
      ss = wsum(ss);
      const float rstd = rsqrtf(ss * (1.f / D) + EPS);
      float lg0 = 0.f, lg1 = 0.f, lg2 = 0.f, lg3 = 0.f;
#pragma unroll
      for (int i = 0; i < 4; ++i) {
        const int col = lane * 4 + 256 * i;
        const float4 g = *(const float4*)(p.in[I_N2G] + l * D + col);
        const float4 sh = *(const float4*)(mod + (size_t)(l * 2 + b) * 6144 + 3072 + col);
        const float4 sc = *(const float4*)(mod + (size_t)(l * 2 + b) * 6144 + 4096 + col);
        x[i].x = x[i].x * rstd * g.x * (1.f + sc.x) + sh.x;
        x[i].y = x[i].y * rstd * g.y * (1.f + sc.y) + sh.y;
        x[i].z = x[i].z * rstd * g.z * (1.f + sc.z) + sh.z;
        x[i].w = x[i].w * rstd * g.w * (1.f + sc.w) + sh.w;
        *(h16x4*)(hout + (size_t)row * D + col) = pack4(x[i].x, x[i].y, x[i].z, x[i].w);
        const float4 w0 = *(const float4*)(rgw + (size_t)(col + 0) * 4), w1 = *(const float4*)(rgw + (size_t)(col + 1) * 4);
        const float4 w2 = *(const float4*)(rgw + (size_t)(col + 2) * 4), w3 = *(const float4*)(rgw + (size_t)(col + 3) * 4);
        lg0 += x[i].x * w0.x + x[i].y * w1.x + x[i].z * w2.x + x[i].w * w3.x;
        lg1 += x[i].x * w0.y + x[i].y * w1.y + x[i].z * w2.y + x[i].w * w3.y;
        lg2 += x[i].x * w0.z + x[i].y * w1.z + x[i].z * w2.z + x[i].w * w3.z;
        lg3 += x[i].x * w0.w + x[i].y * w1.w + x[i].z * w2.w + x[i].w * w3.w;
      }
      lg0 = wsum(lg0) + rgb[0]; lg1 = wsum(lg1) + rgb[1]; lg2 = wsum(lg2) + rgb[2]; lg3 = wsum(lg3) + rgb[3];
      int gs = 0; float gm = lg0;
      if (lg1 > gm) { gm = lg1; gs = 1; }
      if (lg2 > gm) { gm = lg2; gs = 2; }
      if (lg3 > gm) { gm = lg3; gs = 3; }
      const float pg = 1.f / (__expf(lg0 - gm) + __expf(lg1 - gm) + __expf(lg2 - gm) + __expf(lg3 - gm));
      const float* rew = wl + 4096 + gs * 4096;
      const float* reb = p.in[I_REB] + (l * 4 + gs) * 4;
      float e0 = 0.f, e1 = 0.f, e2 = 0.f, e3 = 0.f;
#pragma unroll
      for (int i = 0; i < 4; ++i) {
        const int col = lane * 4 + 256 * i;
        const float4 w0 = *(const float4*)(rew + (size_t)(col + 0) * 4), w1 = *(const float4*)(rew + (size_t)(col + 1) * 4);
        const float4 w2 = *(const float4*)(rew + (size_t)(col + 2) * 4), w3 = *(const float4*)(rew + (size_t)(col + 3) * 4);
        e0 += x[i].x * w0.x + x[i].y * w1.x + x[i].z * w2.x + x[i].w * w3.x;
        e1 += x[i].x * w0.y + x[i].y * w1.y + x[i].z * w2.y + x[i].w * w3.y;
        e2 += x[i].x * w0.z + x[i].y * w1.z + x[i].z * w2.z + x[i].w * w3.z;
        e3 += x[i].x * w0.w + x[i].y * w1.w + x[i].z * w2.w + x[i].w * w3.w;
      }
      float le[4];
      le[0] = wsum(e0) + reb[0]; le[1] = wsum(e1) + reb[1]; le[2] = wsum(e2) + reb[2]; le[3] = wsum(e3) + reb[3];
      int i0 = 0; float v0 = le[0];
      if (le[1] > v0) { v0 = le[1]; i0 = 1; }
      if (le[2] > v0) { v0 = le[2]; i0 = 2; }
      if (le[3] > v0) { v0 = le[3]; i0 = 3; }
      int i1 = -1; float v1 = -3.0e38f;
#pragma unroll
      for (int j = 0; j < 4; ++j) {
        const float vj = (j == 0 ? le[0] : j == 1 ? le[1] : j == 2 ? le[2] : le[3]);
        if (j != i0 && vj > v1) { v1 = vj; i1 = j; }
      }
      const float p0 = 1.f / (1.f + __expf(v1 - v0));
      const float p1 = 1.f - p0;
      if (lane == 0) {
        const int ea = gs * 4 + i0, eb = gs * 4 + i1;
        const int ra = atomicAdd(&cntl[ea], 1);
        const int rb = atomicAdd(&cntl[eb], 1);
        tok[ti * 2] = ea | (ra << 8);
        tok[ti * 2 + 1] = eb | (rb << 8);
        wpair[row * 2] = pg * p0;
        wpair[row * 2 + 1] = pg * p1;
      }
    }
    __syncthreads();
    if (tid < 16) basel[tid] = (int)atomicAdd(&cnt[tid], (unsigned)cntl[tid]);
    __syncthreads();
    if (tid < 128) {
      const int v = tok[tid], e = v & 255, r = v >> 8;
      list[(size_t)e * 16384 + basel[e] + r] = (chunk * 64 + (tid >> 1)) * 2 + (tid & 1);
    }
    __syncthreads();
  }
}

__device__ __forceinline__ void moe_sched(const Params& p, int l, int* sl) {
  const int tid = tidx();
  if (tid < 16) {
    const unsigned* cnt = (const unsigned*)(p.ws + OFF_CTL) + 64 + l * 16;
    sl[tid] = (int)__hip_atomic_load(&cnt[tid], __ATOMIC_RELAXED, __HIP_MEMORY_SCOPE_AGENT);
  }
  __syncthreads();
  if (tid == 0) {
    int to = 0, ro = 0;
    sl[16] = 0; sl[33] = 0;
    for (int e = 0; e < 16; ++e) {
      const int c = sl[e];
      to += (c + 255) >> 8; ro += c;
      sl[17 + e] = to; sl[34 + e] = ro;
    }
  }
  __syncthreads();
}
__device__ __forceinline__ void moe_tile(const int* sl, int t, int& e, int& nt, int& mt, int& cnt_e, int& roff_e) {
  int ee = 0;
  for (int k = 0; k < 15; ++k) ee += (t >= sl[17 + k] * 4) ? 1 : 0;
  ee = __builtin_amdgcn_readfirstlane(ee);
  const int t0 = __builtin_amdgcn_readfirstlane(sl[16 + ee]), t1 = __builtin_amdgcn_readfirstlane(sl[17 + ee]);
  const int nte = t1 - t0, rem = t - t0 * 4;
  e = ee; nt = rem / nte; mt = rem % nte;
  cnt_e = __builtin_amdgcn_readfirstlane(sl[ee]);
  roff_e = __builtin_amdgcn_readfirstlane(sl[33 + ee]);
}

template <int BN>
__device__ __forceinline__ void moe1_tile(const Params& p, h16* sm, const int* sl, int t, int half) {
  unsigned char* ws = p.ws;
  const h16* H = (const h16*)(ws + OFF_H16);
  h16* hid = (h16*)(ws + OFF_HID);
  int e, nt, mt, cnt_e, roff_e;
  moe_tile(sl, t, e, nt, mt, cnt_e, roff_e);
  const int* le = (const int*)(ws + OFF_LIST) + (size_t)e * 16384;
  f32x4 acc[8][BN / 64];
  gemm_mainloop<BN>(acc, [&](int r) { int so = mt * 256 + r; so = so < cnt_e ? so : 0; return H + (size_t)(le[so] >> 1) * D; },
                    (const h16*)(ws + OFF_WGU) + ((size_t)e * 1024 + nt * 256 + half * 128) * 1024, 1024, 16, sm);
  const int tid_e = tidx(), lane = tid_e & 63, wave = tid_e >> 6, wr = wave >> 2, wc = wave & 3, fr = lane & 15, fq = lane >> 4;
  constexpr int NC = BN / 2, LDR = NC + 8;
#pragma unroll
  for (int m = 0; m < 8; ++m)
#pragma unroll
    for (int n2 = 0; n2 < BN / 128; ++n2) {
      const f32x4 gt = acc[m][2 * n2], up = acc[m][2 * n2 + 1];
      *(h16x4*)(sm + (wr * 128 + m * 16 + fr) * LDR + wc * (BN / 8) + n2 * 16 + 4 * fq) =
          pack4(silu_f(gt[0]) * up[0], silu_f(gt[1]) * up[1], silu_f(gt[2]) * up[2], silu_f(gt[3]) * up[3]);
    }
  __syncthreads();
  constexpr int CH = NC / 8;
#pragma unroll
  for (int i = 0; i < CH / 2; ++i) {
    const int idx = i * NTHREADS + tid_e;
    const int r = idx / CH, c8 = idx % CH;
    const int so = mt * 256 + r;
    if (so < cnt_e) *(h16x8*)(hid + (size_t)(roff_e + so) * 512 + nt * 128 + half * 64 + c8 * 8) = *(const h16x8*)(sm + r * LDR + c8 * 8);
  }
  __syncthreads();
}
__device__ __forceinline__ void phase_moe1(const Params& p, int l, h16* sm) {
  int* sl = (int*)((unsigned char*)sm + SCHED_OFF);
  moe_sched(p, l, sl);
  const int total = __builtin_amdgcn_readfirstlane(sl[32]) * 4;
  const TileSched ts = xcd_sched(total);
  for (int t = ts.cur; t < ts.end; t += ts.step) moe1_tile<256>(p, sm, sl, t, 0);
  if (ts.tail_tile >= 0) {
    if (ts.tail_half < 0) moe1_tile<256>(p, sm, sl, ts.tail_tile, 0);
    else moe1_tile<128>(p, sm, sl, ts.tail_tile, ts.tail_half);
  }
}

template <int BN>
__device__ __forceinline__ void moe2_tile(const Params& p, h16* sm, const int* sl, int t, int half) {
  unsigned char* ws = p.ws;
  const float* wpair = (const float*)(ws + OFF_WPAIR);
  h16* yp = (h16*)(ws + OFF_YPAIR);
  int e, nt, mt, cnt_e, roff_e;
  moe_tile(sl, t, e, nt, mt, cnt_e, roff_e);
  const int* le = (const int*)(ws + OFF_LIST) + (size_t)e * 16384;
  const h16* Ab = (const h16*)(ws + OFF_HID) + (size_t)(roff_e + mt * 256) * 512;
  f32x4 acc[8][BN / 64];
  gemm_mainloop<BN>(acc, [&](int r) { return Ab + (size_t)r * 512; }, (const h16*)(ws + OFF_WDN) + ((size_t)e * 1024 + nt * 256 + half * 128) * 512, 512, 8, sm);
  const int tid_e = tidx(), lane = tid_e & 63, wave = tid_e >> 6, wr = wave >> 2, wc = wave & 3, fr = lane & 15, fq = lane >> 4;
  constexpr int LDR = BN + 8;
#pragma unroll
  for (int m = 0; m < 8; ++m) {
    const int so = mt * 256 + wr * 128 + m * 16 + fr;
    const float w = so < cnt_e ? wpair[le[so]] : 0.f;
#pragma unroll
    for (int n = 0; n < BN / 64; ++n)
      *(h16x4*)(sm + (wr * 128 + m * 16 + fr) * LDR + wc * (BN / 4) + n * 16 + 4 * fq) = pack4(acc[m][n][0] * w, acc[m][n][1] * w, acc[m][n][2] * w, acc[m][n][3] * w);
  }
  __syncthreads();
  constexpr int CH = BN / 8;
#pragma unroll
  for (int i = 0; i < CH / 2; ++i) {
    const int idx = i * NTHREADS + tid_e;
    const int r = idx / CH, c8 = idx % CH;
    const int so = mt * 256 + r;
    if (so < cnt_e) *(h16x8*)(yp + (size_t)le[so] * D + nt * 256 + half * 128 + c8 * 8) = *(const h16x8*)(sm + r * LDR + c8 * 8);
  }
  __syncthreads();
}
__device__ __forceinline__ void phase_moe2(const Params& p, int l, h16* sm) {
  int* sl = (int*)((unsigned char*)sm + SCHED_OFF);
  moe_sched(p, l, sl);
  const int total = __builtin_amdgcn_readfirstlane(sl[32]) * 4;
  const TileSched ts = xcd_sched(total);
  for (int t = ts.cur; t < ts.end; t += ts.step) moe2_tile<256>(p, sm, sl, t, 0);
  if (ts.tail_tile >= 0) {
    if (ts.tail_half < 0) moe2_tile<256>(p, sm, sl, ts.tail_tile, 0);
    else moe2_tile<128>(p, sm, sl, ts.tail_tile, ts.tail_half);
  }
}

#define XB_TMO      128
#define XB_XCNT(j)  (256  + 64 * (j))
#define XB_XSUB(j)  (1280 + 64 * (j))
#define XB_XGEN(j)  (2304 + 64 * (j))
#define XB_TOP      3328
#define XB_TOPGEN   3392
#define XCD_BAR_WORDS 3456
#define XB_SPIN_CAP (1u << 20)
__device__ __forceinline__ unsigned xb_ld(unsigned* p) { return __hip_atomic_load(p, __ATOMIC_RELAXED, __HIP_MEMORY_SCOPE_AGENT); }
__device__ __forceinline__ unsigned xb_add(unsigned* p, unsigned v) { return __hip_atomic_fetch_add(p, v, __ATOMIC_RELAXED, __HIP_MEMORY_SCOPE_AGENT); }
__device__ __forceinline__ unsigned xb_xcc_id() { return (unsigned)__builtin_amdgcn_s_getreg((3 << 11) | 20) & 0xFu; }
#define XB_SPIN(cond, bar) do { unsigned _sp = 0; while (cond) { __builtin_amdgcn_s_sleep(1); \
    if ((++_sp & 255u) == 0u) { if (xb_ld(&(bar)[XB_TMO])) break; if (_sp > XB_SPIN_CAP) { atomicAdd(&(bar)[XB_TMO], 1u); break; } } } } while (0)
struct XBar { unsigned* bar; unsigned x; volatile unsigned* st; };
__device__ __forceinline__ void xbar_post(XBar& b, unsigned* bar, volatile unsigned* st) {
  b.bar = bar; b.x = xb_xcc_id(); b.st = st;
  if (tidx() == 0) { st[0] = 0u; st[1] = 0u; (void)xb_add(&bar[XB_XCNT(b.x)], 1u); }
}
__device__ __forceinline__ void xbar_census(unsigned* bar, unsigned x, unsigned& nloc, unsigned& nx) {
  const unsigned G = gridDim.x;
  unsigned sum, cnt, mine, sp = 0u;
  for (;;) {
    sum = 0u; cnt = 0u; mine = 0u;
#pragma unroll
    for (unsigned j = 0; j < 16; ++j) { const unsigned c = xb_ld(&bar[XB_XCNT(j)]); sum += c; cnt += (c > 0u) ? 1u : 0u; mine = (j == x) ? c : mine; }
    if (sum == G) break;
    __builtin_amdgcn_s_sleep(1);
    if ((++sp & 255u) == 0u) { if (xb_ld(&bar[XB_TMO])) break; if (sp > XB_SPIN_CAP) { atomicAdd(&bar[XB_TMO], 1u); break; } }
  }
  nloc = mine > 0u ? mine : 1u; nx = cnt > 0u ? cnt : 1u;
}
__device__ __forceinline__ void xbar_sync(XBar& b) {
  asm volatile("s_waitcnt vmcnt(0)" ::: "memory");
  __syncthreads();
  if (tidx() == 0) {
    unsigned* bar = b.bar;
    __builtin_amdgcn_s_waitcnt(0);
    unsigned nloc = b.st[0], nx = b.st[1];
    if (nloc == 0u) { xbar_census(bar, b.x, nloc, nx); b.st[0] = nloc; b.st[1] = nx; }
    const unsigned old = xb_add(&bar[XB_XSUB(b.x)], 1u);
    const unsigned gen = old / nloc;
    if (old + 1u == (gen + 1u) * nloc) {
      __builtin_amdgcn_fence(__ATOMIC_RELEASE, "agent");
      asm volatile("s_waitcnt vmcnt(0)" ::: "memory");
      const unsigned og = xb_add(&bar[XB_TOP], 1u);
      const unsigned tg = og / nx;
      if (og + 1u == (tg + 1u) * nx) xb_add(&bar[XB_TOPGEN], 1u);
      else XB_SPIN(xb_ld(&bar[XB_TOPGEN]) == tg, bar);
      __builtin_amdgcn_fence(__ATOMIC_ACQUIRE, "agent");
      xb_add(&bar[XB_XGEN(b.x)], 1u);
      asm volatile("s_waitcnt vmcnt(0)" ::: "memory");
    } else {
      XB_SPIN(xb_ld(&bar[XB_XGEN(b.x)]) == gen, bar);
      __builtin_amdgcn_fence(__ATOMIC_ACQUIRE, "agent");
      asm volatile("s_waitcnt vmcnt(0)" ::: "memory");
    }
  }
  __syncthreads();
}

constexpr int NSTEPS = 20;
#define STEP(k, body) do { if (s_lo <= (k) && (k) < s_hi) { body; if ((k) + 1 < s_hi) { xbar_sync(xb); } \
    if (PROBE_MASK != 0u) { unsigned long long now_ = __builtin_amdgcn_s_memrealtime(); \
      if ((PROBE_MASK >> (k)) & 1u) { const unsigned long long w_ = (now_ - pt_prev) * PROBE_AMP; \
        while (__builtin_amdgcn_s_memrealtime() - now_ < w_) __builtin_amdgcn_s_sleep(8); now_ = __builtin_amdgcn_s_memrealtime(); } \
      pt_prev = now_; } } } while (0)
#define LAYER_STEPS(l, base) \
  STEP(base + 0, phase_norm1(p, l); if (l == 1) phase_convert(p, 1, (float*)smem)); \
  STEP(base + 1, phase_inproj(p, (h16*)smem)); \
  STEP(base + 2, phase_mixa(p, l, smem)); \
  STEP(base + 3, phase_mixb(p, l, (float*)smem)); \
  STEP(base + 4, phase_attn(p, l, (float*)smem)); \
  STEP(base + 5, phase_outproj(p, l, (h16*)smem)); \
  STEP(base + 6, phase_router(p, l, (int*)smem)); \
  STEP(base + 7, phase_moe1(p, l, (h16*)smem)); \
  STEP(base + 8, phase_moe2(p, l, (h16*)smem))

__global__ void __launch_bounds__(NTHREADS, 2) mega(Params p, int s_lo, int s_hi) {
  extern __shared__ __attribute__((aligned(16))) unsigned char smem[];
  unsigned long long pt_prev = PROBE_MASK != 0u ? __builtin_amdgcn_s_memrealtime() : 0ull;
  XBar xb;
  xbar_post(xb, (unsigned*)(p.ws + OFF_BAR), (volatile unsigned*)(smem + LDS_BYTES - 16));
  STEP(0, phase_prep(p, (float*)smem); phase_convert(p, 0, (float*)smem));
  LAYER_STEPS(0, 1);
  LAYER_STEPS(1, 10);
  STEP(19, phase_norm1(p, 2));
}

extern "C" void kernel_launch(void* const* d_in, const int* in_sizes, int n_in, void* d_out, int out_size, void* d_ws, size_t ws_size,
                              hipStream_t stream) {
  static int grid_blocks = 0;
  if (!grid_blocks) {
    if (n_in != 35 || out_size != T * D || ws_size < WS_TOTAL) {
      fprintf(stderr, "kernel_launch: unexpected problem (n_in %d, out %d, ws %zu < %zu)\n", n_in, out_size, ws_size, (size_t)WS_TOTAL);
      grid_blocks = -1;
      return;
    }
    int dev = 0, cus = 0, per_cu = 0;
    hipGetDevice(&dev);
    hipDeviceGetAttribute(&cus, hipDeviceAttributeMultiprocessorCount, dev);
    if (hipFuncSetAttribute((const void*)mega, hipFuncAttributeMaxDynamicSharedMemorySize, LDS_BYTES) != hipSuccess) {
      fprintf(stderr, "kernel_launch: hipFuncSetAttribute(%d B dynamic LDS) failed\n", LDS_BYTES);
      grid_blocks = -1;
      return;
    }
    hipOccupancyMaxActiveBlocksPerMultiprocessor(&per_cu, mega, NTHREADS, LDS_BYTES);
    if (per_cu > 1) per_cu = 1;
    if (per_cu < 1) { fprintf(stderr, "kernel_launch: occupancy query returned %d\n", per_cu); grid_blocks = -1; return; }
    grid_blocks = cus * per_cu;
  }
  if (grid_blocks < 0) return;
  Params p{};
  for (int i = 0; i < 35; ++i) p.in[i] = (const float*)d_in[i];
  p.out = (float*)d_out;
  p.ws = (unsigned char*)d_ws;
  for (int i = 0; i < 32; ++i) p.inv_freq[i] = std::pow(10000.0, -(double)(2 * i) / 64.0);
  if (hipMemsetAsync((char*)d_ws + OFF_BAR, 0, 16384, stream) != hipSuccess) { fprintf(stderr, "kernel_launch: memset of barrier words failed\n"); return; }
#if MEGA
  int lo = 0, hi = NSTEPS;
  void* args[] = {&p, &lo, &hi};
  hipError_t e = hipLaunchCooperativeKernel((void*)mega, dim3(grid_blocks), dim3(NTHREADS), args, LDS_BYTES, stream);
  if (e != hipSuccess) fprintf(stderr, "cooperative launch failed: %s (grid %d)\n", hipGetErrorString(e), grid_blocks);
#else
  for (int s = 0; s < NSTEPS; ++s) {
    int lo = s, hi = s + 1;
    void* args[] = {&p, &lo, &hi};
    hipError_t e = hipLaunchCooperativeKernel((void*)mega, dim3(grid_blocks), dim3(NTHREADS), args, LDS_BYTES, stream);
    if (e != hipSuccess) { fprintf(stderr, "launch %d failed: %s (grid %d)\n", s, hipGetErrorString(e), grid_blocks); break; }
  }
#endif
}
```

```cpp
#include <hip/hip_runtime.h>
#include <hip/hip_cooperative_groups.h>
#include <cstdio>
#include <cstdint>
#include <cmath>
namespace cg = cooperative_groups;

#ifndef MEGA
#define MEGA 1
#endif
#ifndef PROBE_MASK
#define PROBE_MASK 0u
#define PROBE_AMP 3
#endif

typedef _Float16 h16;
typedef _Float16 h16x8 __attribute__((ext_vector_type(8)));
typedef _Float16 h16x4 __attribute__((ext_vector_type(4)));
typedef float f32x4 __attribute__((ext_vector_type(4)));

constexpr int NB = 2, S = 8192, T = NB * S, D = 1024;
constexpr int NIN = 2432;
constexpr int NINSRC = 2328;
constexpr int C_XL = 0, C_GL = 256, C_Q = 512, C_KC = 1024, C_VC = 1152, C_KS = 1280, C_VS = 1408, C_KW = 1536, C_VW = 1664,
              C_CVA = 1792, C_CVB = 2048, C_GATE = 2304;
constexpr float EPS = 1e-6f;
constexpr int NTHREADS = 512, NW = 8;
constexpr int LDS_BYTES = 150528;
constexpr int NINP = 2560;
constexpr int SCHED_OFF = LDS_BYTES - 1024;
constexpr float ASCALE = 16.f;

constexpr size_t al256(size_t x) { return (x + 255) & ~(size_t)255; }
constexpr size_t OFF_CTL = 0;
constexpr size_t OFF_BAR = 4096;
constexpr size_t OFF_MOD = 4096 + 16384;
constexpr size_t OFF_ROPE = al256(OFF_MOD + 2 * 2 * 6144 * 4);
constexpr size_t OFF_PB = al256(OFF_ROPE + (size_t)T * 64 * 4);
constexpr size_t OFF_PBPART = al256(OFF_PB + 2 * 256 * 4);
constexpr size_t OFF_LRUW = al256(OFF_PBPART + 2 * 32 * 256 * 4);
constexpr size_t OFF_GATES = al256(OFF_LRUW + 2 * 4 * 64 * 64 * 2);
constexpr size_t OFF_WIN = al256(OFF_GATES + (size_t)T * 24 * 4);
constexpr size_t OFF_WOUT = al256(OFF_WIN + (size_t)NINP * 1024 * 2);
constexpr size_t OFF_WGU = al256(OFF_WOUT + (size_t)1024 * 1024 * 2);
constexpr size_t OFF_WDN = al256(OFF_WGU + (size_t)16 * 1024 * 1024 * 2);
constexpr size_t OFF_W1K = al256(OFF_WDN + (size_t)16 * 1024 * 512 * 2);
constexpr size_t OFF_W1V = al256(OFF_W1K + (size_t)256 * 2048 * 2);
constexpr size_t OFF_H16 = al256(OFF_W1V + (size_t)256 * 2048 * 2);
constexpr size_t OFF_Q16 = al256(OFF_H16 + (size_t)T * 1024 * 2);
constexpr size_t KVSZ = (size_t)T * 128 * 2;
constexpr size_t OFF_KC = al256(OFF_Q16 + (size_t)T * 512 * 2);
constexpr size_t OFF_VC = al256(OFF_KC + KVSZ + 4096);
constexpr size_t OFF_KS = al256(OFF_VC + KVSZ + 4096);
constexpr size_t OFF_VST = al256(OFF_KS + KVSZ);
constexpr size_t OFF_KW = al256(OFF_VST + KVSZ);
constexpr size_t OFF_VWT = al256(OFF_KW + KVSZ);
constexpr size_t OFF_HIDC = al256(OFF_VWT + KVSZ);
constexpr size_t OFF_KCMP = al256(OFF_HIDC + (size_t)2 * 2048 * 256 * 2);
constexpr size_t OFF_VCMPT = al256(OFF_KCMP + (size_t)4 * 512 * 64 * 2);
constexpr size_t OFF_LRUH = al256(OFF_VCMPT + (size_t)4 * 512 * 64 * 2);
constexpr size_t OFF_LRUA = al256(OFF_LRUH + (size_t)T * 256 * 4);
constexpr size_t OFF_HEND = al256(OFF_LRUA + (size_t)T * 256 * 4);
constexpr size_t OFF_AEND = al256(OFF_HEND + 2 * 256 * 256 * 4);
constexpr size_t OFF_CARRY = al256(OFF_AEND + 2 * 256 * 256 * 4);
constexpr size_t OFF_XA = al256(OFF_CARRY + 2 * 256 * 256 * 4);
constexpr size_t OFF_LIST = al256(OFF_XA + (size_t)T * 1024 * 4);
constexpr size_t OFF_WPAIR = al256(OFF_LIST + (size_t)16 * 16384 * 4);
constexpr size_t OFF_SSQ = al256(OFF_WPAIR + 32768 * 4);
constexpr size_t OFF_R = al256(OFF_SSQ + (size_t)T * 2 * 4);
constexpr size_t OFF_P16 = OFF_R;
constexpr size_t OFF_HID = OFF_R;
constexpr size_t OFF_YPAIR = al256(OFF_HID + (size_t)(32768 + 512) * 512 * 2);
constexpr size_t OFF_HIDP = al256(OFF_P16 + (size_t)T * NIN * 2);
constexpr size_t R_END1 = OFF_HIDP + (size_t)4 * 2 * 2048 * 256 * 4;
constexpr size_t R_END2 = OFF_YPAIR + (size_t)32768 * 1024 * 2;
constexpr size_t WS_TOTAL = al256(R_END1 > R_END2 ? R_END1 : R_END2);

struct Params {
  const float* in[35];
  float* out;
  unsigned char* ws;
  double inv_freq[32];
};
enum { I_X = 0, I_C, I_POS, I_ADAW, I_ADAB, I_N1G, I_N2G, I_WIN, I_LCW, I_LCB, I_LWA, I_LBA, I_LWX, I_LBX, I_LLAM, I_CKW1, I_CKW2,
       I_CVW1, I_CVW2, I_CPK, I_CPV, I_DWW, I_DWB, I_LNG, I_LNB, I_ONG, I_WOUT, I_RGW, I_RGB, I_REW, I_REB, I_MG, I_MU, I_MD, I_FNG };

__device__ __forceinline__ int tidx() { int t = threadIdx.x; asm volatile("" : "+v"(t)); return t; }
__device__ __forceinline__ float wsum(float v) {
#pragma unroll
  for (int o = 32; o > 0; o >>= 1) v += __shfl_xor(v, o);
  return v;
}
__device__ __forceinline__ float sigm(float x) { return 1.f / (1.f + __expf(-x)); }
__device__ __forceinline__ float silu_f(float x) { return x / (1.f + __expf(-x)); }
__device__ __forceinline__ float gelu_tanh(float x) {
  float u = 0.7978845608028654f * (x + 0.044715f * x * x * x);
  float e = __expf(2.f * u);
  float t = 1.f - 2.f / (e + 1.f);
  return 0.5f * x * (1.f + t);
}
__device__ __forceinline__ void glds16(const h16* g, h16* l) {
  __builtin_amdgcn_global_load_lds((const unsigned*)g, (unsigned*)l, 16, 0, 0);
}
__device__ __forceinline__ h16x4 pack4(float a, float b, float c, float d) {
  h16x4 r; r[0] = (h16)a; r[1] = (h16)b; r[2] = (h16)c; r[3] = (h16)d; return r;
}

struct TileIter { int cur, end, step; };
__device__ __forceinline__ TileIter xcd_tiles(int ntiles) {
  const int G = gridDim.x, b = blockIdx.x;
  TileIter it;
  if ((G & 7) == 0) {
    const int x = b & 7;
    it.cur = (int)(((long)ntiles * x) >> 3) + (b >> 3);
    it.end = (int)(((long)ntiles * (x + 1)) >> 3);
    it.step = G >> 3;
  } else { it.cur = b; it.end = ntiles; it.step = G; }
  return it;
}

#define VMCNT(n) asm volatile("s_waitcnt vmcnt(" #n ")" ::: "memory")
template <int BN, class ARowFn>
__device__ __forceinline__ void gemm_mainloop(f32x4 (&acc)[8][BN / 64], ARowFn arow, const h16* __restrict__ Bt, int ldb, int nk, h16* sm, bool zero_init = true) {
  constexpr int NF = BN / 64, NBP = BN / 64;
  constexpr int STAGE = 16384 + BN * 64;
  constexpr int NST = BN == 128 ? 3 : 2;
  const int tid = tidx(), lane = tid & 63, wave = tid >> 6;
  const int wr = wave >> 2, wc = wave & 3, fr = lane & 15, fq = lane >> 4;
  const h16* ap[4];
  const h16* bp[NBP];
#pragma unroll
  for (int i = 0; i < 4; ++i) {
    const int r = (i * 8 + wave) * 8 + (lane >> 3);
    const int c = (lane & 7) ^ ((r >> 1) & 7);
    ap[i] = arow(r) + c * 8;
    if (i < NBP) bp[i] = Bt + (size_t)r * ldb + c * 8;
  }
  if (zero_init) {
#pragma unroll
    for (int m = 0; m < 8; ++m)
#pragma unroll
      for (int n = 0; n < NF; ++n) acc[m][n] = (f32x4){0.f, 0.f, 0.f, 0.f};
  }
  h16* const dA = sm + wave * 512 + lane * 8;
#pragma unroll
  for (int st0 = 0; st0 < NST - 1; ++st0)
    if (st0 < nk) {
#pragma unroll
      for (int i = 0; i < 4; ++i) { glds16(ap[i], dA + st0 * STAGE + i * 4096); ap[i] += 64; }
#pragma unroll
      for (int i = 0; i < NBP; ++i) { glds16(bp[i], dA + st0 * STAGE + 16384 + i * 4096); bp[i] += 64; }
    }
  const int sw = (fr >> 1) & 7;
  const int aoff = (wr * 128 + fr) * 64, boff = 16384 + (wc * (BN / 4) + fr) * 64;
#define SCHED_FENCE() __builtin_amdgcn_sched_barrier(0)
  for (int kt = 0; kt < nk; ++kt) {
    if (NST == 3 && kt + 1 < nk) VMCNT(6); else VMCNT(0);
    __builtin_amdgcn_s_barrier();
    const int sl_ = NST == 3 ? kt % 3 : (kt & 1);
    const h16* st = sm + sl_ * STAGE;
    const bool more = kt + (NST - 1) < nk;
    h16* const dn = dA + (NST == 3 ? (sl_ == 0 ? 2 : sl_ - 1) : (sl_ ^ 1)) * STAGE;
#pragma unroll
    for (int ks = 0; ks < 2; ++ks) {
      const int ch = ((ks * 4 + fq) ^ sw) * 8;
      h16x8 bf[NF];
#pragma unroll
      for (int n = 0; n < NF; ++n) bf[n] = *(const h16x8*)(st + boff + n * 1024 + ch);
#pragma unroll
      for (int mh = 0; mh < 2; ++mh) {
        h16x8 af[4];
#pragma unroll
        for (int m = 0; m < 4; ++m) af[m] = *(const h16x8*)(st + aoff + (mh * 4 + m) * 1024 + ch);
#pragma unroll
        for (int m = 0; m < 4; ++m) {
#pragma unroll
          for (int n = 0; n < NF; ++n) acc[mh * 4 + m][n] = __builtin_amdgcn_mfma_f32_16x16x32_f16(bf[n], af[m], acc[mh * 4 + m][n], 0, 0, 0);
          if (m == 1 || m == 3) {
            const int q = ks * 4 + mh * 2 + (m >> 1);
            SCHED_FENCE();
            if (more) {
              if (q < 4) { glds16(ap[q & 3], dn + (q & 3) * 4096); ap[q & 3] += 64; }
              else if ((q & 3) < NBP) { glds16(bp[(q & 3) < NBP ? (q & 3) : 0], dn + 16384 + (q & 3) * 4096); bp[(q & 3) < NBP ? (q & 3) : 0] += 64; }
            }
            SCHED_FENCE();
          }
        }
      }
    }
  }
#undef SCHED_FENCE
  __builtin_amdgcn_s_barrier();
}

struct TileSched { int cur, end, step, tail_tile, tail_half; };
__device__ __forceinline__ TileSched xcd_sched(int ntiles) {
  const int G = gridDim.x, b = blockIdx.x;
  TileSched s;
  s.tail_tile = -1; s.tail_half = -1;
  if ((G & 7) == 0) {
    const int x = b & 7, nb = G >> 3, si = b >> 3;
    const int lo = (int)(((long)ntiles * x) >> 3), hi = (int)(((long)ntiles * (x + 1)) >> 3);
    const int n = hi - lo, R = n / nb, rem = n - R * nb;
    s.cur = lo + si; s.end = lo + R * nb; s.step = nb;
    if (rem * 2 <= nb) { if (si < 2 * rem) { s.tail_tile = lo + R * nb + (si >> 1); s.tail_half = si & 1; } }
    else if (si < rem) s.tail_tile = lo + R * nb + si;
  } else { s.cur = b; s.end = ntiles; s.step = G; }
  return s;
}

__device__ __forceinline__ int map_row(int mode, int n) {
  if (mode == 1) return n < 1792 ? n : (n < 1816 ? n + 512 : n - 24);
  if (mode == 2) return 32 * (n >> 4) + (n & 15);
  if (mode == 3) return 32 * (n >> 4) + 16 + (n & 15);
  return n;
}
struct ConvTile { const float* src; h16* dst; int K, N, mode, k0, n0; const float* pos; float* pbp; };
__device__ __forceinline__ ConvTile conv_decode(const Params& p, int l, int t) {
  unsigned char* ws = p.ws;
  constexpr int T_WIN = 16 * 37, T_WOUT = 256, T_G = 16 * 128, T_W1 = 128;
  constexpr int E0 = T_WIN, E1 = E0 + T_WOUT, E2 = E1 + T_G, E3 = E2 + T_G, E4 = E3 + T_G, E5 = E4 + T_W1;
  ConvTile c;
  c.pos = nullptr; c.pbp = nullptr;
  int tk, tn;
  if (t < E0) {
    c.src = p.in[I_WIN] + (size_t)l * 1024 * NINSRC; c.K = 1024; c.N = NINSRC; c.dst = (h16*)(ws + OFF_WIN); c.mode = 1; tk = t / 37; tn = t % 37;
  } else if (t < E1) {
    const int u = t - E0;
    c.src = p.in[I_WOUT] + (size_t)l * 1024 * 1024; c.K = 1024; c.N = 1024; c.dst = (h16*)(ws + OFF_WOUT); c.mode = 4; tk = u >> 4; tn = u & 15;
  } else if (t < E3) {
    const int up = t >= E2;
    const int u = t - (up ? E2 : E1);
    const int e = u >> 7, v = u & 127;
    c.src = p.in[up ? I_MU : I_MG] + ((size_t)l * 16 + e) * 1024 * 512; c.K = 1024; c.N = 512; c.dst = (h16*)(ws + OFF_WGU) + (size_t)e * 1024 * 1024;
    c.mode = up ? 3 : 2; tk = v >> 3; tn = v & 7;
  } else if (t < E4) {
    const int u = t - E3;
    const int e = u >> 7, v = u & 127;
    c.src = p.in[I_MD] + ((size_t)l * 16 + e) * 512 * 1024; c.K = 512; c.N = 1024; c.dst = (h16*)(ws + OFF_WDN) + (size_t)e * 1024 * 512; c.mode = 0; tk = v >> 4; tn = v & 15;
  } else {
    const int vv = t >= E5;
    const int u = t - (vv ? E5 : E4);
    c.src = p.in[vv ? I_CVW1 : I_CKW1] + (size_t)l * 2048 * 256; c.K = 2048; c.N = 256; c.dst = (h16*)(ws + (vv ? OFF_W1V : OFF_W1K)); c.mode = 5; tk = u >> 2; tn = u & 3;
    c.pos = p.in[vv ? I_CPV : I_CPK] + (size_t)l * 2048 + tk * 64;
    c.pbp = (float*)(ws + OFF_PBPART) + (size_t)(vv * 32 + tk) * 256 + tn * 64;
  }
  c.k0 = tk * 64; c.n0 = tn * 64;
  return c;
}
__device__ __forceinline__ void conv_wave_tile(const ConvTile& c, float* smw, int lane) {
  float4 v[16];
#pragma unroll
  for (int i = 0; i < 16; ++i) {
    const int idx = i * 64 + lane;
    const int r = idx >> 4, c4 = (idx & 15) * 4;
    v[i] = make_float4(0.f, 0.f, 0.f, 0.f);
    if (c.n0 + c4 < c.N) v[i] = *(const float4*)(c.src + (size_t)(c.k0 + r) * c.N + c.n0 + c4);
  }
#pragma unroll
  for (int i = 0; i < 16; ++i) {
    const int idx = i * 64 + lane;
    const int r = idx >> 4, c4 = (idx & 15) * 4;
    float* d = smw + r * 65 + c4;
    d[0] = v[i].x; d[1] = v[i].y; d[2] = v[i].z; d[3] = v[i].w;
  }
  if (c.mode == 5) {
    float sacc = 0.f;
    for (int k = 0; k < 64; ++k) sacc += c.pos[k] * smw[k * 65 + lane];
    c.pbp[lane] = sacc;
  }
  const int k0d = c.mode == 4 ? (c.k0 < 256 ? c.k0 + 512 : (c.k0 < 768 ? c.k0 - 256 : c.k0)) : c.k0;
#pragma unroll
  for (int j = 0; j < 8; ++j) {
    const int ch = j * 64 + lane;
    const int n = ch >> 3, kc = ch & 7;
    if (c.n0 + n < c.N) {
      h16x8 o;
#pragma unroll
      for (int q = 0; q < 8; ++q) o[q] = (h16)smw[(kc * 8 + q) * 65 + n];
      *(h16x8*)(c.dst + (size_t)map_row(c.mode, c.n0 + n) * c.K + k0d + kc * 8) = o;
    }
  }
}

__device__ __forceinline__ void phase_convert(const Params& p, int l, float* sm) {
  unsigned char* ws = p.ws;
  constexpr int NT_CONV = 16 * 37 + 256 + 3 * 16 * 128 + 2 * 128;
  {
    const int tid = tidx(), lane = tid & 63, wave = tid >> 6;
    float* smw = sm + wave * 4160;
    for (int t = blockIdx.x * NW + wave; t < NT_CONV; t += gridDim.x * NW) {
      const ConvTile c = conv_decode(p, l, t);
      conv_wave_tile(c, smw, lane);
    }
    __syncthreads();
  }
  {
    h16* lw = (h16*)(ws + OFF_LRUW);
    for (int i = blockIdx.x * NTHREADS + tidx(); i < 2 * 4 * 64 * 64; i += gridDim.x * NTHREADS) {
      const int d = i & 63, e = (i >> 6) & 63, n = (i >> 12) & 3, mat = i >> 14;
      lw[i] = (h16)p.in[mat ? I_LWX : I_LWA][((size_t)(l * 4 + n) * 64 + d) * 64 + e];
    }
  }
  {
    h16x8 z = {0, 0, 0, 0, 0, 0, 0, 0};
    h16* w = (h16*)(ws + OFF_WIN) + (size_t)NINSRC * 1024;
    for (int i = blockIdx.x * NTHREADS + tidx(); i < (NINP - NINSRC) * 1024 / 8; i += gridDim.x * NTHREADS) *(h16x8*)(w + (size_t)i * 8) = z;
  }
}

__device__ __forceinline__ void phase_prep(const Params& p, float* sm) {
  unsigned char* ws = p.ws;
  const int tid = tidx();
  if (blockIdx.x == 0) {
    for (int i = tid; i < 1024; i += NTHREADS) ((unsigned*)(ws + OFF_CTL))[i] = 0u;
  }
  float* mod = (float*)(ws + OFF_MOD);
  for (int t = blockIdx.x; t < 384; t += gridDim.x) {
    const int l = t / 192, j0 = (t % 192) * 32;
    const int kg = tid >> 3, cq = tid & 7;
    const float* w = p.in[I_ADAW] + (size_t)l * 1024 * 6144 + j0 + 4 * cq;
    const float* c = p.in[I_C];
    float a0[4] = {0, 0, 0, 0}, a1[4] = {0, 0, 0, 0};
#pragma unroll 8
    for (int k = kg * 16; k < kg * 16 + 16; ++k) {
      const float4 wv = *(const float4*)(w + (size_t)k * 6144);
      const float s0 = silu_f(c[k]), s1 = silu_f(c[1024 + k]);
      a0[0] += s0 * wv.x; a0[1] += s0 * wv.y; a0[2] += s0 * wv.z; a0[3] += s0 * wv.w;
      a1[0] += s1 * wv.x; a1[1] += s1 * wv.y; a1[2] += s1 * wv.z; a1[3] += s1 * wv.w;
    }
    float* r = sm + (kg * 8 + cq) * 8;
#pragma unroll
    for (int i = 0; i < 4; ++i) { r[i] = a0[i]; r[4 + i] = a1[i]; }
    __syncthreads();
    if (tid < 64) {
      const int bb = tid >> 5, col = tid & 31, q = col >> 2, ci = col & 3;
      float s = 0.f;
      for (int g = 0; g < 64; ++g) s += sm[(g * 8 + q) * 8 + bb * 4 + ci];
      mod[(size_t)(l * 2 + bb) * 6144 + j0 + col] = s + p.in[I_ADAB][l * 6144 + j0 + col];
    }
    __syncthreads();
  }
  float* rc = (float*)(ws + OFF_ROPE);
  float* rs = rc + (size_t)T * 32;
  const int* pos = (const int*)p.in[I_POS];
  for (int i = blockIdx.x * NTHREADS + tid; i < T * 32; i += gridDim.x * NTHREADS) {
    const int t = i >> 5, f = i & 31;
    const double a = (double)pos[t] * p.inv_freq[f];
    const double n = rint(a * 0.15915494309189535);
    double r = fma(-n, 6.283185307179586, a);
    r = fma(-n, 2.4492935982947064e-16, r);
    const float rf = (float)r;
    rc[i] = cosf(rf);
    rs[i] = sinf(rf);
  }
}

__device__ __forceinline__ void phase_norm1(const Params& p, int mode) {
  unsigned char* ws = p.ws;
  const int lane = tidx() & 63, wave = tidx() >> 6;
  const float* mod = (const float*)(ws + OFF_MOD);
  float* xa = (float*)(ws + OFF_XA);
  const h16* yp = (const h16*)(ws + OFF_YPAIR);
  h16* hout = (h16*)(ws + OFF_H16);
  const int l = (mode == 0) ? 0 : 1;
  for (int row = blockIdx.x * NW + wave; row < T; row += gridDim.x * NW) {
    const int b = row >> 13;
    float4 x[4];
    float ss = 0.f;
#pragma unroll
    for (int i = 0; i < 4; ++i) {
      const int col = lane * 4 + 256 * i;
      if (mode == 0) {
        x[i] = *(const float4*)(p.in[I_X] + (size_t)row * D + col);
      } else {
        const int lp = mode == 1 ? 0 : 1;
        const float4 xv = *(const float4*)(xa + (size_t)row * D + col);
        const float4 g2 = *(const float4*)(mod + (size_t)(lp * 2 + b) * 6144 + 5120 + col);
        const h16x4 y0 = *(const h16x4*)(yp + (size_t)(row * 2) * D + col);
        const h16x4 y1 = *(const h16x4*)(yp + (size_t)(row * 2 + 1) * D + col);
        x[i].x = xv.x + g2.x * ((float)y0[0] + (float)y1[0]);
        x[i].y = xv.y + g2.y * ((float)y0[1] + (float)y1[1]);
        x[i].z = xv.z + g2.z * ((float)y0[2] + (float)y1[2]);
        x[i].w = xv.w + g2.w * ((float)y0[3] + (float)y1[3]);
        if (mode == 1) *(float4*)(xa + (size_t)row * D + col) = x[i];
      }
      ss += x[i].x * x[i].x + x[i].y * x[i].y + x[i].z * x[i].z + x[i].w * x[i].w;
    }
    ss = wsum(ss);
    const float rstd = rsqrtf(ss * (1.f / D) + EPS);
#pragma unroll
    for (int i = 0; i < 4; ++i) {
      const int col = lane * 4 + 256 * i;
      if (mode == 2) {
        const float4 g = *(const float4*)(p.in[I_FNG] + col);
        float4 o;
        o.x = x[i].x * rstd * g.x; o.y = x[i].y * rstd * g.y; o.z = x[i].z * rstd * g.z; o.w = x[i].w * rstd * g.w;
        *(float4*)(p.out + (size_t)row * D + col) = o;
      } else {
        const float4 g = *(const float4*)(p.in[I_N1G] + l * D + col);
        const float4 sh = *(const float4*)(mod + (size_t)(l * 2 + b) * 6144 + col);
        const float4 sc = *(const float4*)(mod + (size_t)(l * 2 + b) * 6144 + 1024 + col);
        *(h16x4*)(hout + (size_t)row * D + col) = pack4(x[i].x * rstd * g.x * (1.f + sc.x) + sh.x, x[i].y * rstd * g.y * (1.f + sc.y) + sh.y,
                                                        x[i].z * rstd * g.z * (1.f + sc.z) + sh.z, x[i].w * rstd * g.w * (1.f + sc.w) + sh.w);
      }
    }
  }
}

__device__ __forceinline__ int perm_key(int pos) {
  return 32 * (pos >> 5) + 16 * ((pos >> 2) & 1) + 4 * ((pos >> 3) & 3) + (pos & 3);
}
__device__ __forceinline__ void inproj_tile(const Params& p, h16* sm, int mt, int nt) {
  unsigned char* ws = p.ws;
  const h16* Ab = (const h16*)(ws + OFF_H16) + (size_t)mt * 256 * D;
  f32x4 acc[8][2];
  gemm_mainloop<128>(acc, [&](int r) { return Ab + (size_t)r * D; }, (const h16*)(ws + OFF_WIN) + (size_t)nt * 128 * D, D, D / 64, sm);
  const int tid_e = tidx(), lane = tid_e & 63, wave = tid_e >> 6, wr = wave >> 2, wc = wave & 3, fr = lane & 15, fq = lane >> 4;
  constexpr int LDR = 136;
#pragma unroll
  for (int m = 0; m < 8; ++m)
#pragma unroll
    for (int n = 0; n < 2; ++n)
      *(h16x4*)(sm + (wr * 128 + m * 16 + fr) * LDR + wc * 32 + n * 16 + 4 * fq) = pack4(acc[m][n][0], acc[m][n][1], acc[m][n][2], acc[m][n][3]);
  __syncthreads();
  const int row0 = mt * 256, b = mt >> 5, s0 = (mt & 31) * 256;
  if (nt < 4 || (nt >= 14 && nt < 18)) {
    h16* P = (h16*)(ws + OFF_P16);
#pragma unroll
    for (int i = 0; i < 8; ++i) {
      const int idx = i * NTHREADS + tid_e;
      const int r = idx >> 4, c8 = idx & 15;
      *(h16x8*)(P + (size_t)(row0 + r) * NIN + nt * 128 + c8 * 8) = *(const h16x8*)(sm + r * LDR + c8 * 8);
    }
  } else if (nt <= 8 || nt == 10 || nt == 12) {
    const float* rc = (const float*)(ws + OFF_ROPE);
    const float* rs = rc + (size_t)T * 32;
    const bool isq = nt < 8;
    const float scl = isq ? 0.125f * 1.4426950408889634f : 1.f;
    h16* kbase = (h16*)(ws + (nt == 8 ? OFF_KC : (nt == 10 ? OFF_KS : OFF_KW)));
    h16* q16 = (h16*)(ws + OFF_Q16);
#pragma unroll
    for (int i = 0; i < 4; ++i) {
      const int idx = i * NTHREADS + tid_e;
      const int r = idx >> 3, hd = (idx >> 2) & 1, d = (idx & 3) * 8;
      const h16x8 a = *(const h16x8*)(sm + r * LDR + 64 * hd + d);
      const h16x8 bb = *(const h16x8*)(sm + r * LDR + 64 * hd + 32 + d);
      const float* cp = rc + (size_t)(row0 + r) * 32 + d;
      const float* sp = rs + (size_t)(row0 + r) * 32 + d;
      const float4 c0 = *(const float4*)cp, c1 = *(const float4*)(cp + 4), n0 = *(const float4*)sp, n1 = *(const float4*)(sp + 4);
      const float cs[8] = {c0.x, c0.y, c0.z, c0.w, c1.x, c1.y, c1.z, c1.w}, sn[8] = {n0.x, n0.y, n0.z, n0.w, n1.x, n1.y, n1.z, n1.w};
      h16x8 lo, hi;
#pragma unroll
      for (int j = 0; j < 8; ++j) {
        const float av = (float)a[j], bv = (float)bb[j];
        lo[j] = (h16)((av * cs[j] - bv * sn[j]) * scl);
        hi[j] = (h16)((bv * cs[j] + av * sn[j]) * scl);
      }
      h16* dst = isq ? q16 + (size_t)(row0 + r) * 512 + (nt - 4) * 128 + 64 * hd + d : kbase + ((size_t)(b * 2 + hd) * S + s0 + r) * 64 + d;
      *(h16x8*)dst = lo;
      *(h16x8*)(dst + 32) = hi;
    }
  } else if (nt == 9) {
    h16* vc = (h16*)(ws + OFF_VC);
#pragma unroll
    for (int i = 0; i < 8; ++i) {
      const int idx = i * NTHREADS + tid_e;
      const int r = idx >> 4, c8 = idx & 15, hd = c8 >> 3, dd = (c8 & 7) * 8;
      *(h16x8*)(vc + ((size_t)(b * 2 + hd) * S + s0 + r) * 64 + dd) = *(const h16x8*)(sm + r * LDR + c8 * 8);
    }
  } else if (nt == 11 || nt == 13) {
    h16* vt = (h16*)(ws + (nt == 11 ? OFF_VST : OFF_VWT));
#pragma unroll
    for (int i = 0; i < 8; ++i) {
      const int idx = i * NTHREADS + tid_e;
      const int kv = idx >> 11, blk = (idx >> 9) & 3, dim = (idx >> 3) & 63, p0 = (idx & 7) * 8;
      h16x8 v;
#pragma unroll
      for (int j = 0; j < 8; ++j) v[j] = sm[(blk * 64 + perm_key(p0 + j)) * LDR + 64 * kv + dim];
      *(h16x8*)(vt + ((size_t)((b * 2 + kv) * 128 + (s0 >> 6) + blk)) * 4096 + dim * 64 + p0) = v;
    }
  } else {
    float* gates = (float*)(ws + OFF_GATES);
#pragma unroll
    for (int i = 0; i < 12; ++i) {
      const int idx = i * NTHREADS + tid_e;
      const int r = idx / 24, cc = idx % 24;
      gates[(size_t)(row0 + r) * 24 + cc] = sigm((float)sm[r * LDR + cc]);
    }
  }
  __syncthreads();
}
__device__ __forceinline__ void phase_inproj(const Params& p, h16* sm) {
  const TileIter tf = xcd_tiles(64 * 19);
  for (int t = tf.cur; t < tf.end; t += tf.step) inproj_tile(p, sm, t / 19, t % 19);
}

__device__ __forceinline__ void mixa_compress1(const Params& p, int item, h16* sm) {
  unsigned char* ws = p.ws;
  const int which = item >> 6, mt = (item >> 3) & 7, ks = (item >> 1) & 3, half = item & 1;
  const h16* A = (const h16*)(ws + (which ? OFF_VC : OFF_KC)) + (size_t)mt * 256 * 1024 + ks * 512;
  const h16* W = (const h16*)(ws + (which ? OFF_W1V : OFF_W1K)) + (size_t)half * 128 * 2048 + ks * 512;
  float* hp = (float*)(ws + OFF_HIDP) + ((size_t)(ks * 2 + which) * 2048) * 256;
  f32x4 acc[8][2];
  gemm_mainloop<128>(acc, [&](int r) { return A + (size_t)r * 1024; }, W, 2048, 8, sm);
  const int tid_e = tidx(), lane = tid_e & 63, wave = tid_e >> 6, wr = wave >> 2, wc = wave & 3, fr = lane & 15, fq = lane >> 4;
#pragma unroll
  for (int m = 0; m < 8; ++m)
#pragma unroll
    for (int n = 0; n < 2; ++n) {
      const int row = mt * 256 + wr * 128 + m * 16 + fr, col = half * 128 + wc * 32 + n * 16 + 4 * fq;
      *(f32x4*)(hp + (size_t)row * 256 + col) = acc[m][n];
    }
}

__device__ __forceinline__ void mixa_lru(const Params& p, int l, int item, float* sm) {
  unsigned char* ws = p.ws;
  const int tid = tidx();
  const int half = tid >> 8;
  item = item * 2 + half;
  sm += half * 14400;
  const int b = item >> 8, ck = item & 255;
  const int c = tid & 255;
  const int nb = c >> 6;
  const int lane = tid & 63, fr = lane & 15, fq = lane >> 4;
  const h16* P = (const h16*)(ws + OFF_P16);
  const float* cw = p.in[I_LCW] + l * 4 * 256;
  const float w0 = cw[c], w1 = cw[256 + c], w2 = cw[512 + c], w3 = cw[768 + c], cb = p.in[I_LCB][l * 256 + c];
  const float ba = p.in[I_LBA][l * 256 + c], bx = p.in[I_LBX][l * 256 + c];
  const float lam = p.in[I_LLAM][l * 256 + c];
  const float ls = -log1pf(expf(-lam));
  h16x8 bw[2][4][2];
  {
    const h16* lw = (const h16*)(ws + OFF_LRUW);
#pragma unroll
    for (int mat = 0; mat < 2; ++mat)
#pragma unroll
      for (int nt = 0; nt < 4; ++nt)
#pragma unroll
        for (int ks = 0; ks < 2; ++ks) bw[mat][nt][ks] = *(const h16x8*)(lw + ((size_t)((mat * 4 + nb) * 64 + nt * 16 + fr)) * 64 + ks * 32 + 8 * fq);
  }
  const int t0 = ck * 32;
  float x0 = 0.f, x1 = 0.f, x2 = 0.f;
  if (t0 >= 3) {
    x0 = (float)P[(size_t)(b * S + t0 - 3) * NIN + C_XL + c];
    x1 = (float)P[(size_t)(b * S + t0 - 2) * NIN + C_XL + c];
    x2 = (float)P[(size_t)(b * S + t0 - 1) * NIN + C_XL + c];
  }
  float h = 0.f, ap = 1.f;
  float* lh = (float*)(ws + OFF_LRUH);
  float* la = (float*)(ws + OFF_LRUA);
  float* sr = sm + 4096;
  float* si = sm + 8192;
  h16* xh = (h16*)(sm + 12288);
#pragma unroll 1
  for (int sub = 0; sub < 2; ++sub) {
    const int tb = t0 + sub * 16;
    {
      h16 xv[16];
      const h16* xp = P + (size_t)(b * S + tb) * NIN + C_XL + c;
#pragma unroll
      for (int tt = 0; tt < 16; ++tt) { xv[tt] = *xp; xp += NIN; asm volatile("" : "+v"(xp)); }
#pragma unroll
      for (int tt = 0; tt < 16; ++tt) {
        const float x3 = (float)xv[tt];
        const float xc = w0 * x0 + w1 * x1 + w2 * x2 + w3 * x3 + cb;
        sm[tt * 256 + c] = xc;
        xh[tt * 264 + c] = (h16)xc;
        x0 = x1; x1 = x2; x2 = x3;
      }
    }
    {
      h16x8 af[2];
#pragma unroll
      for (int ks = 0; ks < 2; ++ks) af[ks] = *(const h16x8*)(xh + fr * 264 + nb * 64 + ks * 32 + 8 * fq);
#pragma unroll
      for (int nt = 0; nt < 4; ++nt) {
        f32x4 ar = {0.f, 0.f, 0.f, 0.f}, ai = {0.f, 0.f, 0.f, 0.f};
#pragma unroll
        for (int ks = 0; ks < 2; ++ks) {
          ar = __builtin_amdgcn_mfma_f32_16x16x32_f16(af[ks], bw[0][nt][ks], ar, 0, 0, 0);
          ai = __builtin_amdgcn_mfma_f32_16x16x32_f16(af[ks], bw[1][nt][ks], ai, 0, 0, 0);
        }
#pragma unroll
        for (int j = 0; j < 4; ++j) {
          sr[(4 * fq + j) * 256 + nb * 64 + nt * 16 + fr] = ar[j];
          si[(4 * fq + j) * 256 + nb * 64 + nt * 16 + fr] = ai[j];
        }
      }
    }
#pragma unroll 4
    for (int tt = 0; tt < 16; ++tt) {
      const float r = sigm(sr[tt * 256 + c] + ba), ig = sigm(si[tt * 256 + c] + bx);
      const float log_a = 8.f * r * ls;
      const float a = __expf(log_a);
      const float mult = sqrtf(-expm1f(2.f * log_a));
      sr[tt * 256 + c] = a;
      si[tt * 256 + c] = mult * ig * sm[tt * 256 + c];
    }
    float* lhp = lh + (size_t)(b * S + tb) * 256 + c;
    float* lap = la + (size_t)(b * S + tb) * 256 + c;
#pragma unroll 4
    for (int tt = 0; tt < 16; ++tt) {
      const float a = sr[tt * 256 + c];
      h = a * h + si[tt * 256 + c];
      ap *= a;
      lhp[tt * 256] = h;
      lap[tt * 256] = ap;
    }
  }
  ((float*)(ws + OFF_HEND))[(size_t)(b * 256 + ck) * 256 + c] = h;
  ((float*)(ws + OFF_AEND))[(size_t)(b * 256 + ck) * 256 + c] = ap;
  __syncthreads();
}

__device__ __forceinline__ void mixa_conv(const Params& p, int l, int item, float* sm) {
  unsigned char* ws = p.ws;
  const int half = tidx() >> 8;
  item = item * 2 + half;
  sm += half * 15872;
  const int b = item >> 8, ck = item & 255;
  const int c = tidx() & 255;
  const h16* P = (const h16*)(ws + OFF_P16);
  const int t0 = ck * 32;
  float col[64];
#pragma unroll
  for (int r0 = 0; r0 < 64; r0 += 16) {
    h16 va[16], vb[16];
#pragma unroll
    for (int q = 0; q < 16; ++q) {
      const int t = t0 - 30 + r0 + q;
      va[q] = (h16)0.f; vb[q] = (h16)0.f;
      if (t >= 0 && r0 + q < 62) {
        const h16* pr = P + (size_t)(b * S + t) * NIN;
        va[q] = pr[C_CVA + c]; vb[q] = pr[C_CVB + c];
      }
    }
#pragma unroll
    for (int q = 0; q < 16; ++q) col[r0 + q] = (float)va[q] * sigm((float)vb[q]);
    asm volatile("" ::: "memory");
  }
  float w[31];
#pragma unroll
  for (int j = 0; j < 31; ++j) w[j] = p.in[I_DWW][(size_t)(l * 31 + j) * 256 + c];
  const float bias = p.in[I_DWB][l * 256 + c];
#pragma unroll
  for (int i = 0; i < 32; ++i) {
    float z = bias;
#pragma unroll
    for (int j = 0; j < 31; ++j) z += w[j] * col[i + j];
    sm[i * 256 + c] = z;
  }
  __syncthreads();
  const int lane = tidx() & 63, wave = (tidx() >> 6) & 3;
  const float4 lg = *(const float4*)(p.in[I_LNG] + l * 256 + lane * 4);
  const float4 lb = *(const float4*)(p.in[I_LNB] + l * 256 + lane * 4);
  const float4 gn = *(const float4*)(p.in[I_ONG] + l * 1024 + 768 + lane * 4);
  h16* yc = (h16*)(ws + OFF_H16);
  for (int i = wave * 8; i < wave * 8 + 8; ++i) {
    const float4 z = *(const float4*)(sm + i * 256 + lane * 4);
    const float mu = wsum(z.x + z.y + z.z + z.w) * (1.f / 256.f);
    const float dx = z.x - mu, dy = z.y - mu, dz = z.z - mu, dw = z.w - mu;
    const float var = wsum(dx * dx + dy * dy + dz * dz + dw * dw) * (1.f / 256.f);
    const float rs = rsqrtf(var + EPS);
    const float y0 = silu_f(dx * rs * lg.x + lb.x), y1 = silu_f(dy * rs * lg.y + lb.y), y2 = silu_f(dz * rs * lg.z + lb.z), y3 = silu_f(dw * rs * lg.w + lb.w);
    const float r2 = rsqrtf(wsum(y0 * y0 + y1 * y1 + y2 * y2 + y3 * y3) * (1.f / 256.f) + EPS);
    *(h16x4*)(yc + (size_t)(b * S + t0 + i) * D + 768 + lane * 4) = pack4(y0 * r2 * gn.x, y1 * r2 * gn.y, y2 * r2 * gn.z, y3 * r2 * gn.w);
  }
  __syncthreads();
}

__device__ __forceinline__ void phase_mixa(const Params& p, int l, void* sm) {
  const int G = gridDim.x;
  if (blockIdx.x == 0) {
    const int o = tidx();
    const float* pp = (const float*)(p.ws + OFF_PBPART) + (size_t)(o >> 8) * 32 * 256 + (o & 255);
    float pv[32];
#pragma unroll
    for (int k = 0; k < 32; ++k) pv[k] = pp[k * 256];
    float accb = 0.f;
#pragma unroll
    for (int k = 0; k < 32; ++k) accb += pv[k];
    ((float*)(p.ws + OFF_PB))[o] = accb;
  }
  for (int it = blockIdx.x; it < 128; it += G) mixa_compress1(p, it, (h16*)sm);
  for (int it = blockIdx.x; it < 256; it += G) mixa_lru(p, l, it, (float*)sm);
  for (int it = (blockIdx.x + G - 64 % G) % G; it < 256; it += G) mixa_conv(p, l, it, (float*)sm);
}

__device__ __forceinline__ void phase_mixb(const Params& p, int l, float* sm) {
  unsigned char* ws = p.ws;
  const int tid = tidx();
  for (int it = blockIdx.x; it < 512; it += gridDim.x) {
    const int which = it >> 8;
    const int row0 = (it & 255) * 8;
    {
      const float* hp = (const float*)(ws + OFF_HIDP) + ((size_t)which * 2048 + row0) * 256;
      const float* pb = (const float*)(ws + OFF_PB) + which * 256;
      const int r = tid >> 6, c4 = (tid & 63) * 4;
      const size_t o = (size_t)r * 256 + c4;
      const float4 a0 = *(const float4*)(hp + o), a1 = *(const float4*)(hp + (size_t)2 * 2048 * 256 + o);
      const float4 a2 = *(const float4*)(hp + (size_t)4 * 2048 * 256 + o), a3 = *(const float4*)(hp + (size_t)6 * 2048 * 256 + o);
      const float4 bb = *(const float4*)(pb + c4);
      float* d = sm + r * 256 + c4;
      d[0] = gelu_tanh(a0.x + a1.x + a2.x + a3.x + bb.x); d[1] = gelu_tanh(a0.y + a1.y + a2.y + a3.y + bb.y);
      d[2] = gelu_tanh(a0.z + a1.z + a2.z + a3.z + bb.z); d[3] = gelu_tanh(a0.w + a1.w + a2.w + a3.w + bb.w);
      const float4* wsrc = (const float4*)(p.in[which ? I_CVW2 : I_CKW2] + (size_t)l * 256 * 64);
      float4* wdst = (float4*)(sm + 2048);
#pragma unroll
      for (int q = 0; q < 8; ++q) wdst[q * NTHREADS + tid] = wsrc[q * NTHREADS + tid];
    }
    __syncthreads();
    const int row = row0 + (tid >> 6), d = tid & 63;
    const float* hr = sm + (tid >> 6) * 256;
    const float* w2 = sm + 2048 + d;
    float s = 0.f;
#pragma unroll 8
    for (int j = 0; j < 256; ++j) s += (float)(h16)hr[j] * w2[j * 64];
    const int bkv = row >> 9, n = row & 511;
    if (n == 511) s = 0.f;
    if (which == 0) {
      ((h16*)(ws + OFF_KCMP))[((size_t)bkv * 512 + n) * 64 + d] = (h16)s;
    } else {
      const int blk = n >> 6, key = n & 63;
      const int pos = 32 * (key >> 5) + 8 * ((key >> 2) & 3) + 4 * ((key >> 4) & 1) + (key & 3);
      ((h16*)(ws + OFF_VCMPT))[((size_t)(bkv * 8 + blk) * 64 + d) * 64 + pos] = (h16)s;
    }
    __syncthreads();
  }
  for (int task = (blockIdx.x + gridDim.x - 16 % gridDim.x) % gridDim.x; task < 16; task += gridDim.x) {
    const int b = task >> 3, c = (task & 7) * 32 + (tid & 31), grp = tid >> 5;
    const float* he = (const float*)(ws + OFF_HEND) + ((size_t)b * 256 + grp * 16) * 256 + c;
    const float* ae = (const float*)(ws + OFF_AEND) + ((size_t)b * 256 + grp * 16) * 256 + c;
    float* cy = (float*)(ws + OFF_CARRY) + ((size_t)b * 256 + grp * 16) * 256 + c;
    float hv[16], av[16];
#pragma unroll
    for (int k = 0; k < 16; ++k) { hv[k] = he[k * 256]; av[k] = ae[k * 256]; }
    float ga = 1.f, gh = 0.f;
#pragma unroll
    for (int k = 0; k < 16; ++k) { gh = hv[k] + av[k] * gh; ga *= av[k]; }
    sm[tid] = ga; sm[512 + tid] = gh;
    __syncthreads();
    float carry = 0.f;
    for (int q = 0; q < grp; ++q) carry = sm[512 + q * 32 + (tid & 31)] + sm[q * 32 + (tid & 31)] * carry;
#pragma unroll
    for (int k = 0; k < 16; ++k) {
      cy[k * 256] = carry;
      carry = hv[k] + av[k] * carry;
    }
    __syncthreads();
  }
}

__device__ __forceinline__ void stage8k(const h16* __restrict__ g, h16* l, int tid) {
  const int r = tid >> 3, cl = (tid & 7) ^ ((r >> 1) & 7);
  glds16(g + r * 64 + cl * 8, l + tid * 8);
}
__device__ __forceinline__ h16x8 ldfrag(const h16* l, int row, int chunk) {
  return *(const h16x8*)(l + row * 64 + ((chunk ^ ((row >> 1) & 7)) * 8));
}

template <int MODE>
__device__ __forceinline__ void attn_branch(const h16* __restrict__ Kg, const h16* __restrict__ Vg, int j0, int j1, h16* ring,
                                            const h16x8 (&qf)[2][2], float (&m)[2], float (&l)[2], f32x4 (&o)[2][4],
                                            const int (&tq)[2], const int (&lim)[2], const int (&tlim)[2], const int (&tfl)[2],
                                            const unsigned long long (&mylo)[2], const unsigned long long (&myhi)[2],
                                            const unsigned long long (&ulo)[2], const unsigned long long (&uhi)[2],
                                            const float (&inv)[2], float* impw) {
  int tid = tidx();
  asm volatile("" : "+v"(tid));
  const int lane = tid & 63;
  const int h = lane >> 4, c = lane & 15, qi = c >> 2, g = c & 3;
  constexpr bool PV = MODE != 0;
  constexpr int SS = 3;
  const int n = j1 - j0 + 1;
  if (n <= 0) return;
  const int nss = (n + SS - 1) / SS;
#pragma unroll
  for (int q = 0; q < SS; ++q)
    if (q < n) {
      stage8k(Kg + (size_t)(j0 + q) * 4096, ring + q * 8192, tid);
      if (PV) stage8k(Vg + (size_t)(j0 + q) * 4096, ring + q * 8192 + 4096, tid);
    }
  int sbase = 0;
  for (int ss = 0; ss < nss; ++ss) {
    VMCNT(0);
    __builtin_amdgcn_s_barrier();
    {
      const int sn = SS - sbase;
#pragma unroll
      for (int q = 0; q < SS; ++q) {
        const int jb = SS * (ss + 1) + q;
        if (jb < n) {
          stage8k(Kg + (size_t)(j0 + jb) * 4096, ring + (sn + q) * 8192, tid);
          if (PV) stage8k(Vg + (size_t)(j0 + jb) * 4096, ring + (sn + q) * 8192 + 4096, tid);
        }
      }
    }
#pragma unroll 1
   for (int sub = 0; sub < SS; ++sub) {
    const int it = SS * ss + sub;
    if (it >= n) break;
    const int j = j0 + it;
    const h16* cK = ring + (sbase + sub) * 8192;
    const h16* cV = cK + 4096;
    bool act[2];
#pragma unroll
    for (int mq = 0; mq < 2; ++mq) {
      if (MODE <= 1) act[mq] = j * 64 <= tlim[mq];
      else if (MODE == 2) act[mq] = ((j < 64 ? (ulo[mq] >> j) : (uhi[mq] >> (j - 64))) & 1ull) != 0ull;
      else act[mq] = (j * 64 <= tlim[mq] + 3) && (j * 64 + 63 > tlim[mq] - 512);
    }
    if (act[0] || act[1]) {
      h16x8 pf[2][2];
      h16x8 kf[4][2];
#pragma unroll
      for (int kt = 0; kt < 4; ++kt)
#pragma unroll
        for (int ks = 0; ks < 2; ++ks) kf[kt][ks] = ldfrag(cK, 16 * kt + c, 4 * ks + h);
#pragma unroll
      for (int mq = 0; mq < 2; ++mq)
        if (act[mq]) {
          f32x4 s[1][4];
          {
#pragma unroll
            for (int kt = 0; kt < 4; ++kt) {
              s[0][kt] = (f32x4){0.f, 0.f, 0.f, 0.f};
#pragma unroll
              for (int ks = 0; ks < 2; ++ks) s[0][kt] = __builtin_amdgcn_mfma_f32_16x16x32_f16(kf[kt][ks], qf[mq][ks], s[0][kt], 0, 0, 0);
            }
          }
          const bool selbit = MODE == 2 ? (((j < 64 ? (mylo[mq] >> j) : (myhi[mq] >> (j - 64))) & 1ull) != 0ull) : true;
          bool interior;
          if (MODE <= 1) interior = j * 64 + 63 <= tfl[mq];
          else if (MODE == 2) interior = j * 64 + 63 <= tfl[mq];
          else interior = (j * 64 + 63 <= tfl[mq]) && (j * 64 > tfl[mq] + 3 - 512);
          if (!interior) {
            const int pbase = j * 64 + 4 * h;
#pragma unroll
            for (int kt = 0; kt < 4; ++kt)
#pragma unroll
              for (int i = 0; i < 4; ++i) {
                const int pos = pbase + 16 * kt + i;
                bool v;
                if (MODE <= 1) v = pos <= lim[mq];
                else if (MODE == 2) v = selbit && pos <= tq[mq];
                else v = pos <= tq[mq] && pos > tq[mq] - 512;
                s[0][kt][i] = v ? s[0][kt][i] : -1e30f;
              }
          }
          const bool rowoff = MODE == 2 && interior && !selbit;
          if (MODE == 1) {
#pragma unroll
            for (int kt = 0; kt < 4; ++kt) {
              float ps = 0.f;
#pragma unroll
              for (int i = 0; i < 4; ++i) {
                const float pv = __builtin_amdgcn_exp2f(s[0][kt][i] - m[mq]) * inv[mq];
                s[0][kt][i] = pv;
                ps += pv;
              }
              ps += __shfl_xor(ps, 1);
              ps += __shfl_xor(ps, 2);
              if (g == 0) impw[(4 * mq + qi) * 128 + j * 16 + kt * 4 + h] = ps;
            }
          } else {
            float bm = fmaxf(fmaxf(fmaxf(s[0][0][0], s[0][0][1]), fmaxf(s[0][0][2], s[0][0][3])), fmaxf(fmaxf(s[0][1][0], s[0][1][1]), fmaxf(s[0][1][2], s[0][1][3])));
            bm = fmaxf(bm, fmaxf(fmaxf(fmaxf(s[0][2][0], s[0][2][1]), fmaxf(s[0][2][2], s[0][2][3])), fmaxf(fmaxf(s[0][3][0], s[0][3][1]), fmaxf(s[0][3][2], s[0][3][3]))));
            bm = rowoff ? -1e30f : bm;
            if (__any(bm > m[mq] + 8.f)) {
              bm = fmaxf(bm, __shfl_xor(bm, 16));
              bm = fmaxf(bm, __shfl_xor(bm, 32));
              const float mn = fmaxf(m[mq], bm);
              const float alpha = __builtin_amdgcn_exp2f(m[mq] - mn);
              l[mq] *= alpha;
              m[mq] = mn;
              if (PV) {
#pragma unroll
                for (int mt = 0; mt < 4; ++mt) o[mq][mt] *= alpha;
              }
            }
            const float mref = (m[mq] > -1e29f && !rowoff) ? m[mq] : 1e30f;
            float ps = 0.f;
#pragma unroll
            for (int kt = 0; kt < 4; ++kt)
#pragma unroll
              for (int i = 0; i < 4; ++i) {
                const float pv = __builtin_amdgcn_exp2f(s[0][kt][i] - mref);
                s[0][kt][i] = pv;
                ps += pv;
              }
            l[mq] += ps;
          }
          if (PV) {
#pragma unroll
            for (int s2 = 0; s2 < 2; ++s2)
#pragma unroll
              for (int i = 0; i < 4; ++i) { pf[mq][s2][i] = (h16)s[0][2 * s2][i]; pf[mq][s2][4 + i] = (h16)s[0][2 * s2 + 1][i]; }
          }
        }
      if (PV) {
        h16x8 vf[4][2];
#pragma unroll
        for (int mt = 0; mt < 4; ++mt)
#pragma unroll
          for (int s2 = 0; s2 < 2; ++s2) vf[mt][s2] = ldfrag(cV, 16 * mt + c, 4 * s2 + h);
#pragma unroll
        for (int mq = 0; mq < 2; ++mq)
          if (act[mq]) {
#pragma unroll
            for (int s2 = 0; s2 < 2; ++s2) {
#pragma unroll
              for (int mt = 0; mt < 4; ++mt) o[mq][mt] = __builtin_amdgcn_mfma_f32_16x16x32_f16(vf[mt][s2], pf[mq][s2], o[mq][mt], 0, 0, 0);
            }
          }
      }
    }
   }
    sbase = SS - sbase;
  }
  __builtin_amdgcn_s_barrier();
}

__device__ __forceinline__ void attn_item(const Params& p, int l, int item, float* sm) {
  unsigned char* ws = p.ws;
  int tid = tidx();
  asm volatile("" : "+v"(tid));
  const int lane = tid & 63, wave = tid >> 6;
  const int combo = item & 3, qt = item >> 2;
  const int b = combo >> 1, kv = combo & 1;
  const int t0 = qt * 64, tw0 = t0 + 8 * wave;
  const int h = lane >> 4, c = lane & 15, qi = c >> 2, g = c & 3;
  const int head = kv * 4 + g, bkv = b * 2 + kv;
  h16* ring = (h16*)sm;
  float* impw = sm + 24576 + wave * 1024;
  unsigned long long* selm = (unsigned long long*)(sm + 24576 + 8192) + wave * 16;

  h16x8 qf[2][2];
  int tq[2];
#pragma unroll
  for (int mq = 0; mq < 2; ++mq) {
    tq[mq] = tw0 + 4 * mq + qi;
    const h16* qrow = (const h16*)(ws + OFF_Q16) + (size_t)(b * S + tq[mq]) * 512 + head * 64;
    qf[mq][0] = *(const h16x8*)(qrow + 8 * h);
    qf[mq][1] = *(const h16x8*)(qrow + 32 + 8 * h);
  }
  for (int i = lane; i < 1024; i += 64) impw[i] = 0.f;

  h16x4 ofin[2][4];
  float m[2], ll[2], inv[2];
  f32x4 o[2][4];
  const unsigned long long z2[2] = {0ull, 0ull};
  {
    int lim[2], tlim[2], tflc[2];
#pragma unroll
    for (int mq = 0; mq < 2; ++mq) {
      lim[mq] = tq[mq] >= 31 ? ((tq[mq] - 31) >> 4) : -1;
      const int tl = tw0 + 4 * mq + 3;
      tlim[mq] = tl >= 31 ? ((tl - 31) >> 4) : -1;
      const int tf0 = tw0 + 4 * mq;
      tflc[mq] = tf0 >= 31 ? ((tf0 - 31) >> 4) : -1;
      m[mq] = -1e30f; ll[mq] = 0.f; inv[mq] = 0.f;
#pragma unroll
      for (int mt = 0; mt < 4; ++mt) o[mq][mt] = (f32x4){0.f, 0.f, 0.f, 0.f};
    }
    const int nl = (t0 + 63 - 31) >> 4;
    const int jl = nl >> 6;
    const h16* Kc = (const h16*)(ws + OFF_KCMP) + (size_t)bkv * 512 * 64;
    const h16* Vc = (const h16*)(ws + OFF_VCMPT) + (size_t)bkv * 8 * 4096;
    attn_branch<0>(Kc, Vc, 0, jl, ring, qf, m, ll, o, tq, lim, tlim, tflc, z2, z2, z2, z2, inv, impw);
#pragma unroll
    for (int mq = 0; mq < 2; ++mq) {
      float lt = ll[mq];
      lt += __shfl_xor(lt, 16);
      lt += __shfl_xor(lt, 32);
      inv[mq] = lt > 0.f ? 1.f / lt : 0.f;
    }
    attn_branch<1>(Kc, Vc, 0, jl, ring, qf, m, ll, o, tq, lim, tlim, tflc, z2, z2, z2, z2, inv, impw);
    const float* gt0 = (const float*)(ws + OFF_GATES) + (size_t)(b * S) * 24 + head * 3;
#pragma unroll
    for (int mq = 0; mq < 2; ++mq) {
      const float g0 = gt0[(size_t)tq[mq] * 24] * ASCALE;
#pragma unroll
      for (int mt = 0; mt < 4; ++mt) ofin[mq][mt] = pack4(o[mq][mt][0] * g0, o[mq][mt][1] * g0, o[mq][mt][2] * g0, o[mq][mt][3] * g0);
    }
  }
  for (int q = 0; q < 8; ++q) {
    const int t = tw0 + q, own = t >> 6;
    const float* ir = impw + q * 128;
    const int ja = lane, jb = lane + 64;
    unsigned k0 = 0u, k1 = 0u;
    if (ja <= own) k0 = (ja == 0 || ja == own) ? (0xFFFFFF80u | (unsigned)(127 - ja)) : (((__float_as_uint(ir[ja]) & ~127u) | (unsigned)(127 - ja)) + 1u);
    if (jb <= own) k1 = (jb == own) ? (0xFFFFFF80u | (unsigned)(127 - jb)) : (((__float_as_uint(ir[jb]) & ~127u) | (unsigned)(127 - jb)) + 1u);
    unsigned thr = 0u;
    for (int bit = 31; bit >= 0; --bit) {
      const unsigned cand = thr | (1u << bit);
      const int cnt = __popcll(__ballot(k0 >= cand)) + __popcll(__ballot(k1 >= cand));
      if (cnt >= 16) thr = cand;
    }
    const unsigned long long mlo = __ballot(k0 >= thr && ja <= own);
    const unsigned long long mhi = __ballot(k1 >= thr && jb <= own);
    if (lane == 0) { selm[q * 2] = mlo; selm[q * 2 + 1] = mhi; }
  }
  unsigned long long mylo[2], myhi[2], ulo[2], uhi[2];
#pragma unroll
  for (int mq = 0; mq < 2; ++mq) {
    mylo[mq] = selm[(4 * mq + qi) * 2];
    myhi[mq] = selm[(4 * mq + qi) * 2 + 1];
    unsigned long long a = selm[(4 * mq) * 2] | selm[(4 * mq + 1) * 2] | selm[(4 * mq + 2) * 2] | selm[(4 * mq + 3) * 2];
    unsigned long long bb = selm[(4 * mq) * 2 + 1] | selm[(4 * mq + 1) * 2 + 1] | selm[(4 * mq + 2) * 2 + 1] | selm[(4 * mq + 3) * 2 + 1];
    ulo[mq] = (unsigned long long)__builtin_amdgcn_readfirstlane((unsigned)a) | ((unsigned long long)__builtin_amdgcn_readfirstlane((unsigned)(a >> 32)) << 32);
    uhi[mq] = (unsigned long long)__builtin_amdgcn_readfirstlane((unsigned)bb) | ((unsigned long long)__builtin_amdgcn_readfirstlane((unsigned)(bb >> 32)) << 32);
  }
  const float* gtb = (const float*)(ws + OFF_GATES) + (size_t)(b * S) * 24 + head * 3;
  {
    int tl0[2] = {0, 0};
    const int tfs[2] = {tw0, tw0 + 4};
#pragma unroll
    for (int mq = 0; mq < 2; ++mq) {
      m[mq] = -1e30f; ll[mq] = 0.f;
#pragma unroll
      for (int mt = 0; mt < 4; ++mt) o[mq][mt] = (f32x4){0.f, 0.f, 0.f, 0.f};
    }
    attn_branch<2>((const h16*)(ws + OFF_KS) + (size_t)bkv * S * 64, (const h16*)(ws + OFF_VST) + (size_t)bkv * 128 * 4096, 0, (t0 + 63) >> 6, ring, qf, m, ll, o,
                   tq, tl0, tl0, tfs, mylo, myhi, ulo, uhi, inv, impw);
#pragma unroll
    for (int mq = 0; mq < 2; ++mq) {
      float lt = ll[mq];
      lt += __shfl_xor(lt, 16);
      lt += __shfl_xor(lt, 32);
      const float sc = lt > 0.f ? gtb[(size_t)tq[mq] * 24 + 1] * ASCALE / lt : 0.f;
#pragma unroll
      for (int mt = 0; mt < 4; ++mt)
        ofin[mq][mt] = pack4((float)ofin[mq][mt][0] + o[mq][mt][0] * sc, (float)ofin[mq][mt][1] + o[mq][mt][1] * sc, (float)ofin[mq][mt][2] + o[mq][mt][2] * sc,
                             (float)ofin[mq][mt][3] + o[mq][mt][3] * sc);
    }
  }
  {
    int tl0[2] = {0, 0}, tf[2];
#pragma unroll
    for (int mq = 0; mq < 2; ++mq) {
      tf[mq] = tw0 + 4 * mq;
      m[mq] = -1e30f; ll[mq] = 0.f;
#pragma unroll
      for (int mt = 0; mt < 4; ++mt) o[mq][mt] = (f32x4){0.f, 0.f, 0.f, 0.f};
    }
    const int jlo = t0 >= 511 ? ((t0 - 511) >> 6) : 0;
    attn_branch<3>((const h16*)(ws + OFF_KW) + (size_t)bkv * S * 64, (const h16*)(ws + OFF_VWT) + (size_t)bkv * 128 * 4096, jlo, (t0 + 63) >> 6, ring, qf, m, ll, o,
                   tq, tl0, tf, tf, z2, z2, z2, z2, inv, impw);
#pragma unroll
    for (int mq = 0; mq < 2; ++mq) {
      float lt = ll[mq];
      lt += __shfl_xor(lt, 16);
      lt += __shfl_xor(lt, 32);
      const float sc = lt > 0.f ? gtb[(size_t)tq[mq] * 24 + 2] * ASCALE / lt : 0.f;
#pragma unroll
      for (int mt = 0; mt < 4; ++mt)
        ofin[mq][mt] = pack4((float)ofin[mq][mt][0] + o[mq][mt][0] * sc, (float)ofin[mq][mt][1] + o[mq][mt][1] * sc, (float)ofin[mq][mt][2] + o[mq][mt][2] * sc,
                             (float)ofin[mq][mt][3] + o[mq][mt][3] * sc);
    }
  }
  {
    h16* yc = (h16*)(ws + OFF_H16);
    const float* gn = p.in[I_ONG] + l * 1024 + 256 + head * 64;
    float* ssq = (float*)(ws + OFF_SSQ);
#pragma unroll
    for (int mq = 0; mq < 2; ++mq) {
      float sq = 0.f;
      h16* yr = yc + (size_t)(b * S + tq[mq]) * D + head * 64;
#pragma unroll
      for (int mt = 0; mt < 4; ++mt) {
        const float v[4] = {(float)ofin[mq][mt][0], (float)ofin[mq][mt][1], (float)ofin[mq][mt][2], (float)ofin[mq][mt][3]};
        sq += v[0] * v[0] + v[1] * v[1] + v[2] * v[2] + v[3] * v[3];
        const float4 gg = *(const float4*)(gn + 16 * mt + 4 * h);
        *(h16x4*)(yr + 16 * mt + 4 * h) = pack4(v[0] * gg.x, v[1] * gg.y, v[2] * gg.z, v[3] * gg.w);
      }
      sq += __shfl_xor(sq, 16);
      sq += __shfl_xor(sq, 32);
      sq += __shfl_xor(sq, 1);
      sq += __shfl_xor(sq, 2);
      if (h == 0 && g == 0) ssq[(size_t)(b * S + tq[mq]) * 2 + kv] = sq * (1.f / (ASCALE * ASCALE));
    }
  }
}

__device__ __forceinline__ void lrufix_item(const Params& p, int l, int item) {
  unsigned char* ws = p.ws;
  const int lane = tidx() & 63, wave = tidx() >> 6;
  const int b = item >> 7, ck = item & 127;
  const h16* P = (const h16*)(ws + OFF_P16);
  const float4 cy = *(const float4*)((const float*)(ws + OFF_CARRY) + (size_t)(b * 256 + ck * 2 + (wave >> 2)) * 256 + lane * 4);
  const float4 gn = *(const float4*)(p.in[I_ONG] + l * 1024 + lane * 4);
  h16* yc = (h16*)(ws + OFF_H16);
  float4 hl[8], al[8];
  h16x4 gl[8];
#pragma unroll
  for (int q = 0; q < 8; ++q) {
    const size_t row = (size_t)(b * S + ck * 64 + wave * 8 + q);
    hl[q] = *(const float4*)((const float*)(ws + OFF_LRUH) + row * 256 + lane * 4);
    al[q] = *(const float4*)((const float*)(ws + OFF_LRUA) + row * 256 + lane * 4);
    gl[q] = *(const h16x4*)(P + row * NIN + C_GL + lane * 4);
  }
#pragma unroll
  for (int q = 0; q < 8; ++q) {
    const size_t row = (size_t)(b * S + ck * 64 + wave * 8 + q);
    const float y0 = (hl[q].x + al[q].x * cy.x) * gelu_tanh((float)gl[q][0]);
    const float y1 = (hl[q].y + al[q].y * cy.y) * gelu_tanh((float)gl[q][1]);
    const float y2 = (hl[q].z + al[q].z * cy.z) * gelu_tanh((float)gl[q][2]);
    const float y3 = (hl[q].w + al[q].w * cy.w) * gelu_tanh((float)gl[q][3]);
    const float rstd = rsqrtf(wsum(y0 * y0 + y1 * y1 + y2 * y2 + y3 * y3) * (1.f / 256.f) + EPS);
    *(h16x4*)(yc + row * D + 512 + lane * 4) = pack4(y0 * rstd * gn.x, y1 * rstd * gn.y, y2 * rstd * gn.z, y3 * rstd * gn.w);
  }
}

__device__ __forceinline__ void phase_attn(const Params& p, int l, float* sm) {
  for (int it = blockIdx.x; it < 256; it += gridDim.x) {
#pragma unroll 1
    for (int rep = 0; rep < 2; ++rep) attn_item(p, l, rep ? (127 - (it >> 2)) * 4 + (it & 3) : it, sm);
  }
  for (int it = blockIdx.x; it < 256; it += gridDim.x) lrufix_item(p, l, it);
}

__device__ __forceinline__ void phase_outproj(const Params& p, int l, h16* sm) {
  unsigned char* ws = p.ws;
  const h16* A = (const h16*)(ws + OFF_H16);
  const h16* W = (const h16*)(ws + OFF_WOUT);
  const float* mod = (const float*)(ws + OFF_MOD);
  float* xa = (float*)(ws + OFF_XA);
  const float* xin = l == 0 ? p.in[I_X] : (const float*)xa;
  const TileIter ti = xcd_tiles(64 * 4);
  for (int t = ti.cur; t < ti.end; t += ti.step) {
    const int mt = t >> 2, nt = t & 3;
    f32x4 acc[8][4];
    const h16* Ab = A + (size_t)mt * 256 * D;
    {
      float* sct = (float*)((unsigned char*)sm + SCHED_OFF - 1024);
      const int tq_ = tidx();
      if (tq_ < 256) {
        const float2 q2 = *(const float2*)((const float*)(ws + OFF_SSQ) + (size_t)(mt * 256 + tq_) * 2);
        sct[tq_] = rsqrtf((q2.x + q2.y) * (1.f / 512.f) + EPS) * (1.f / ASCALE);
      }
    }
    gemm_mainloop<256>(acc, [&](int r) { return Ab + (size_t)r * D; }, W + (size_t)nt * 256 * D, D, 8, sm);
    const int tid_e = tidx(), lane = tid_e & 63, wave = tid_e >> 6, wr = wave >> 2, wc = wave & 3, fr = lane & 15, fq = lane >> 4;
    {
      const float* sct = (const float*)((const unsigned char*)sm + SCHED_OFF - 1024) + wr * 128 + fr;
#pragma unroll
      for (int m = 0; m < 8; ++m) {
        const float sc = sct[m * 16];
#pragma unroll
        for (int n = 0; n < 4; ++n) acc[m][n] *= sc;
      }
    }
    gemm_mainloop<256>(acc, [&](int r) { return Ab + (size_t)r * D + 512; }, W + (size_t)nt * 256 * D + 512, D, 8, sm, false);
    {
      float* stf = (float*)sm;
      constexpr int LDF = 260;
#pragma unroll 1
      for (int pass = 0; pass < 2; ++pass) {
        if (wr == pass) {
#pragma unroll
          for (int m = 0; m < 8; ++m)
#pragma unroll
            for (int n = 0; n < 4; ++n) *(f32x4*)(stf + (m * 16 + fr) * LDF + wc * 64 + n * 16 + 4 * fq) = acc[m][n];
        }
        __syncthreads();
#pragma unroll 4
        for (int i = 0; i < 16; ++i) {
          const int idx = i * NTHREADS + tid_e;
          const int r = idx >> 6, c4 = (idx & 63) * 4;
          const int row = mt * 256 + pass * 128 + r, col = nt * 256 + c4;
          const int b = row >> 13;
          const f32x4 a = *(const f32x4*)(stf + r * LDF + c4);
          const float4 g1 = *(const float4*)(mod + (size_t)(l * 2 + b) * 6144 + 2048 + col);
          const float4 xv = *(const float4*)(xin + (size_t)row * D + col);
          float4 o;
          o.x = xv.x + g1.x * a[0]; o.y = xv.y + g1.y * a[1]; o.z = xv.z + g1.z * a[2]; o.w = xv.w + g1.w * a[3];
          *(float4*)(xa + (size_t)row * D + col) = o;
        }
        __syncthreads();
      }
    }
  }
}

__device__ __forceinline__ void phase_router(const Params& p, int l, int* smi) {
  unsigned char* ws = p.ws;
  const int tid = tidx(), lane = tid & 63, wave = tid >> 6;
  const float* mod = (const float*)(ws + OFF_MOD);
  const float* xa = (const float*)(ws + OFF_XA);
  h16* hout = (h16*)(ws + OFF_H16);
  unsigned* cnt = (unsigned*)(ws + OFF_CTL) + 64 + l * 16;
  int* list = (int*)(ws + OFF_LIST);
  float* wpair = (float*)(ws + OFF_WPAIR);
  const float* rgb = p.in[I_RGB] + l * 4;
  int* cntl = smi;
  int* basel = smi + 16;
  int* tok = smi + 32;
  float* wl = (float*)smi + 256;
  {
    const float4* s0 = (const float4*)(p.in[I_RGW] + (size_t)l * 1024 * 4);
    const float4* s1 = (const float4*)(p.in[I_REW] + (size_t)l * 4 * 1024 * 4);
    float4* d = (float4*)wl;
#pragma unroll
    for (int q = 0; q < 2; ++q) d[q * NTHREADS + tid] = s0[q * NTHREADS + tid];
#pragma unroll
    for (int q = 0; q < 8; ++q) d[1024 + q * NTHREADS + tid] = s1[q * NTHREADS + tid];
  }
  const float* rgw = wl;
  for (int chunk = blockIdx.x; chunk < T / 64; chunk += gridDim.x) {
    if (tid < 16) cntl[tid] = 0;
    __syncthreads();
    float4 xn[4];
#pragma unroll
    for (int i = 0; i < 4; ++i) xn[i] = *(const float4*)(xa + (size_t)(chunk * 64 + wave) * D + lane * 4 + 256 * i);
    for (int ti = wave; ti < 64; ti += NW) {
      const int row = chunk * 64 + ti;
      const int b = row >> 13;
      float4 x[4];
      float ss = 0.f;
#pragma unroll
      for (int i = 0; i < 4; ++i) x[i] = xn[i];
      if (ti + NW < 64) {
#pragma unroll
        for (int i = 0; i < 4; ++i) xn[i] = *(const float4*)(xa + (size_t)(row + NW) * D + lane * 4 + 256 * i);
      }
#pragma unroll
      for (int i = 0; i < 4; ++i) ss += x[i].x * x[i].x + x[i].y * x[i].y + x[i].z * x[i].z + x[i].w * x[i].w;
      ss = wsum(ss);
      const float rstd = rsqrtf(ss * (1.f / D) + EPS);
      float lg0 = 0.f, lg1 = 0.f, lg2 = 0.f, lg3 = 0.f;
#pragma unroll
      for (int i = 0; i < 4; ++i) {
        const int col = lane * 4 + 256 * i;
        const float4 g = *(const float4*)(p.in[I_N2G] + l * D + col);
        const float4 sh = *(const float4*)(mod + (size_t)(l * 2 + b) * 6144 + 3072 + col);
        const float4 sc = *(const float4*)(mod + (size_t)(l * 2 + b) * 6144 + 4096 + col);
        x[i].x = x[i].x * rstd * g.x * (1.f + sc.x) + sh.x;
        x[i].y = x[i].y * rstd * g.y * (1.f + sc.y) + sh.y;
        x[i].z = x[i].z * rstd * g.z * (1.f + sc.z) + sh.z;
        x[i].w = x[i].w * rstd * g.w * (1.f + sc.w) + sh.w;
        *(h16x4*)(hout + (size_t)row * D + col) = pack4(x[i].x, x[i].y, x[i].z, x[i].w);
        const float4 w0 = *(const float4*)(rgw + (size_t)(col + 0) * 4), w1 = *(const float4*)(rgw + (size_t)(col + 1) * 4);
        const float4 w2 = *(const float4*)(rgw + (size_t)(col + 2) * 4), w3 = *(const float4*)(rgw + (size_t)(col + 3) * 4);
        lg0 += x[i].x * w0.x + x[i].y * w1.x + x[i].z * w2.x + x[i].w * w3.x;
        lg1 += x[i].x * w0.y + x[i].y * w1.y + x[i].z * w2.y + x[i].w * w3.y;
        lg2 += x[i].x * w0.z + x[i].y * w1.z + x[i].z * w2.z + x[i].w * w3.z;
        lg3 += x[i].x * w0.w + x[i].y * w1.w + x[i].z * w2.w + x[i].w * w3.w;
      }
      lg0 = wsum(lg0) + rgb[0]; lg1 = wsum(lg1) + rgb[1]; lg2 = wsum(lg2) + rgb[2]; lg3 = wsum(lg3) + rgb[3];
      int gs = 0; float gm = lg0;
      if (lg1 > gm) { gm = lg1; gs = 1; }
      if (lg2 > gm) { gm = lg2; gs = 2; }
      if (lg3 > gm) { gm = lg3; gs = 3; }
      const float pg = 1.f / (__expf(lg0 - gm) + __expf(lg1 - gm) + __expf(lg2 - gm) + __expf(lg3 - gm));
      const float* rew = wl + 4096 + gs * 4096;
      const float* reb = p.in[I_REB] + (l * 4 + gs) * 4;
      float e0 = 0.f, e1 = 0.f, e2 = 0.f, e3 = 0.f;
#pragma unroll
      for (int i = 0; i < 4; ++i) {
        const int col = lane * 4 + 256 * i;
        const float4 w0 = *(const float4*)(rew + (size_t)(col + 0) * 4), w1 = *(const float4*)(rew + (size_t)(col + 1) * 4);
        const float4 w2 = *(const float4*)(rew + (size_t)(col + 2) * 4), w3 = *(const float4*)(rew + (size_t)(col + 3) * 4);
        e0 += x[i].x * w0.x + x[i].y * w1.x + x[i].z * w2.x + x[i].w * w3.x;
        e1 += x[i].x * w0.y + x[i].y * w1.y + x[i].z * w2.y + x[i].w * w3.y;
        e2 += x[i].x * w0.z + x[i].y * w1.z + x[i].z * w2.z + x[i].w * w3.z;
        e3 += x[i].x * w0.w + x[i].y * w1.w + x[i].z * w2.w + x[i].w * w3.w;
      }
      float le[4];
      le[0] = wsum(e0) + reb[0]; le[1] = wsum(e1) + reb[1]; le[2] = wsum(e2) + reb[2]; le[3] = wsum(e3) + reb[3];
      int i0 = 0; float v0 = le[0];
      if (le[1] > v0) { v0 = le[1]; i0 = 1; }
      if (le[2] > v0) { v0 = le[2]; i0 = 2; }
      if (le[3] > v0) { v0 = le[3]; i0 = 3; }
      int i1 = -1; float v1 = -3.0e38f;
#pragma unroll
      for (int j = 0; j < 4; ++j) {
        const float vj = (j == 0 ? le[0] : j == 1 ? le[1] : j == 2 ? le[2] : le[3]);
        if (j != i0 && vj > v1) { v1 = vj; i1 = j; }
      }
      const float p0 = 1.f / (1.f + __expf(v1 - v0));
      const float p1 = 1.f - p0;
      if (lane == 0) {
        const int ea = gs * 4 + i0, eb = gs * 4 + i1;
        const int ra = atomicAdd(&cntl[ea], 1);
        const int rb = atomicAdd(&cntl[eb], 1);
        tok[ti * 2] = ea | (ra << 8);
        tok[ti * 2 + 1] = eb | (rb << 8);
        wpair[row * 2] = pg * p0;
        wpair[row * 2 + 1] = pg * p1;
      }
    }
    __syncthreads();
    if (tid < 16) basel[tid] = (int)atomicAdd(&cnt[tid], (unsigned)cntl[tid]);
    __syncthreads();
    if (tid < 128) {
      const int v = tok[tid], e = v & 255, r = v >> 8;
      list[(size_t)e * 16384 + basel[e] + r] = (chunk * 64 + (tid >> 1)) * 2 + (tid & 1);
    }
    __syncthreads();
  }
}

__device__ __forceinline__ void moe_sched(const Params& p, int l, int* sl) {
  const int tid = tidx();
  if (tid < 16) {
    const unsigned* cnt = (const unsigned*)(p.ws + OFF_CTL) + 64 + l * 16;
    sl[tid] = (int)__hip_atomic_load(&cnt[tid], __ATOMIC_RELAXED, __HIP_MEMORY_SCOPE_AGENT);
  }
  __syncthreads();
  if (tid == 0) {
    int to = 0, ro = 0;
    sl[16] = 0; sl[33] = 0;
    for (int e = 0; e < 16; ++e) {
      const int c = sl[e];
      to += (c + 255) >> 8; ro += c;
      sl[17 + e] = to; sl[34 + e] = ro;
    }
  }
  __syncthreads();
}
__device__ __forceinline__ void moe_tile(const int* sl, int t, int& e, int& nt, int& mt, int& cnt_e, int& roff_e) {
  int ee = 0;
  for (int k = 0; k < 15; ++k) ee += (t >= sl[17 + k] * 4) ? 1 : 0;
  ee = __builtin_amdgcn_readfirstlane(ee);
  const int t0 = __builtin_amdgcn_readfirstlane(sl[16 + ee]), t1 = __builtin_amdgcn_readfirstlane(sl[17 + ee]);
  const int nte = t1 - t0, rem = t - t0 * 4;
  e = ee; nt = rem / nte; mt = rem % nte;
  cnt_e = __builtin_amdgcn_readfirstlane(sl[ee]);
  roff_e = __builtin_amdgcn_readfirstlane(sl[33 + ee]);
}

template <int BN>
__device__ __forceinline__ void moe1_tile(const Params& p, h16* sm, const int* sl, int t, int half) {
  unsigned char* ws = p.ws;
  const h16* H = (const h16*)(ws + OFF_H16);
  h16* hid = (h16*)(ws + OFF_HID);
  int e, nt, mt, cnt_e, roff_e;
  moe_tile(sl, t, e, nt, mt, cnt_e, roff_e);
  const int* le = (const int*)(ws + OFF_LIST) + (size_t)e * 16384;
  f32x4 acc[8][BN / 64];
  gemm_mainloop<BN>(acc, [&](int r) { int so = mt * 256 + r; so = so < cnt_e ? so : 0; return H + (size_t)(le[so] >> 1) * D; },
                    (const h16*)(ws + OFF_WGU) + ((size_t)e * 1024 + nt * 256 + half * 128) * 1024, 1024, 16, sm);
  const int tid_e = tidx(), lane = tid_e & 63, wave = tid_e >> 6, wr = wave >> 2, wc = wave & 3, fr = lane & 15, fq = lane >> 4;
  constexpr int NC = BN / 2, LDR = NC + 8;
#pragma unroll
  for (int m = 0; m < 8; ++m)
#pragma unroll
    for (int n2 = 0; n2 < BN / 128; ++n2) {
      const f32x4 gt = acc[m][2 * n2], up = acc[m][2 * n2 + 1];
      *(h16x4*)(sm + (wr * 128 + m * 16 + fr) * LDR + wc * (BN / 8) + n2 * 16 + 4 * fq) =
          pack4(silu_f(gt[0]) * up[0], silu_f(gt[1]) * up[1], silu_f(gt[2]) * up[2], silu_f(gt[3]) * up[3]);
    }
  __syncthreads();
  constexpr int CH = NC / 8;
#pragma unroll
  for (int i = 0; i < CH / 2; ++i) {
    const int idx = i * NTHREADS + tid_e;
    const int r = idx / CH, c8 = idx % CH;
    const int so = mt * 256 + r;
    if (so < cnt_e) *(h16x8*)(hid + (size_t)(roff_e + so) * 512 + nt * 128 + half * 64 + c8 * 8) = *(const h16x8*)(sm + r * LDR + c8 * 8);
  }
  __syncthreads();
}
__device__ __forceinline__ void phase_moe1(const Params& p, int l, h16* sm) {
  int* sl = (int*)((unsigned char*)sm + SCHED_OFF);
  moe_sched(p, l, sl);
  const int total = __builtin_amdgcn_readfirstlane(sl[32]) * 4;
  const TileSched ts = xcd_sched(total);
  for (int t = ts.cur; t < ts.end; t += ts.step) moe1_tile<256>(p, sm, sl, t, 0);
  if (ts.tail_tile >= 0) {
    if (ts.tail_half < 0) moe1_tile<256>(p, sm, sl, ts.tail_tile, 0);
    else moe1_tile<128>(p, sm, sl, ts.tail_tile, ts.tail_half);
  }
}

template <int BN>
__device__ __forceinline__ void moe2_tile(const Params& p, h16* sm, const int* sl, int t, int half) {
  unsigned char* ws = p.ws;
  const float* wpair = (const float*)(ws + OFF_WPAIR);
  h16* yp = (h16*)(ws + OFF_YPAIR);
  int e, nt, mt, cnt_e, roff_e;
  moe_tile(sl, t, e, nt, mt, cnt_e, roff_e);
  const int* le = (const int*)(ws + OFF_LIST) + (size_t)e * 16384;
  const h16* Ab = (const h16*)(ws + OFF_HID) + (size_t)(roff_e + mt * 256) * 512;
  f32x4 acc[8][BN / 64];
  gemm_mainloop<BN>(acc, [&](int r) { return Ab + (size_t)r * 512; }, (const h16*)(ws + OFF_WDN) + ((size_t)e * 1024 + nt * 256 + half * 128) * 512, 512, 8, sm);
  const int tid_e = tidx(), lane = tid_e & 63, wave = tid_e >> 6, wr = wave >> 2, wc = wave & 3, fr = lane & 15, fq = lane >> 4;
  constexpr int LDR = BN + 8;
#pragma unroll
  for (int m = 0; m < 8; ++m) {
    const int so = mt * 256 + wr * 128 + m * 16 + fr;
    const float w = so < cnt_e ? wpair[le[so]] : 0.f;
#pragma unroll
    for (int n = 0; n < BN / 64; ++n)
      *(h16x4*)(sm + (wr * 128 + m * 16 + fr) * LDR + wc * (BN / 4) + n * 16 + 4 * fq) = pack4(acc[m][n][0] * w, acc[m][n][1] * w, acc[m][n][2] * w, acc[m][n][3] * w);
  }
  __syncthreads();
  constexpr int CH = BN / 8;
#pragma unroll
  for (int i = 0; i < CH / 2; ++i) {
    const int idx = i * NTHREADS + tid_e;
    const int r = idx / CH, c8 = idx % CH;
    const int so = mt * 256 + r;
    if (so < cnt_e) *(h16x8*)(yp + (size_t)le[so] * D + nt * 256 + half * 128 + c8 * 8) = *(const h16x8*)(sm + r * LDR + c8 * 8);
  }
  __syncthreads();
}
__device__ __forceinline__ void phase_moe2(const Params& p, int l, h16* sm) {
  int* sl = (int*)((unsigned char*)sm + SCHED_OFF);
  moe_sched(p, l, sl);
  const int total = __builtin_amdgcn_readfirstlane(sl[32]) * 4;
  const TileSched ts = xcd_sched(total);
  for (int t = ts.cur; t < ts.end; t += ts.step) moe2_tile<256>(p, sm, sl, t, 0);
  if (ts.tail_tile >= 0) {
    if (ts.tail_half < 0) moe2_tile<256>(p, sm, sl, ts.tail_tile, 0);
    else moe2_tile<128>(p, sm, sl, ts.tail_tile, ts.tail_half);
  }
}

#define XB_TMO      128
#define XB_XCNT(j)  (256  + 64 * (j))
#define XB_XSUB(j)  (1280 + 64 * (j))
#define XB_XGEN(j)  (2304 + 64 * (j))
#define XB_TOP      3328
#define XB_TOPGEN   3392
#define XCD_BAR_WORDS 3456
#define XB_SPIN_CAP (1u << 20)
__device__ __forceinline__ unsigned xb_ld(unsigned* p) { return __hip_atomic_load(p, __ATOMIC_RELAXED, __HIP_MEMORY_SCOPE_AGENT); }
__device__ __forceinline__ unsigned xb_add(unsigned* p, unsigned v) { return __hip_atomic_fetch_add(p, v, __ATOMIC_RELAXED, __HIP_MEMORY_SCOPE_AGENT); }
__device__ __forceinline__ unsigned xb_xcc_id() { return (unsigned)__builtin_amdgcn_s_getreg((3 << 11) | 20) & 0xFu; }
#define XB_SPIN(cond, bar) do { unsigned _sp = 0; while (cond) { __builtin_amdgcn_s_sleep(1); \
    if ((++_sp & 255u) == 0u) { if (xb_ld(&(bar)[XB_TMO])) break; if (_sp > XB_SPIN_CAP) { atomicAdd(&(bar)[XB_TMO], 1u); break; } } } } while (0)
struct XBar { unsigned* bar; unsigned x; volatile unsigned* st; };
__device__ __forceinline__ void xbar_post(XBar& b, unsigned* bar, volatile unsigned* st) {
  b.bar = bar; b.x = xb_xcc_id(); b.st = st;
  if (tidx() == 0) { st[0] = 0u; st[1] = 0u; (void)xb_add(&bar[XB_XCNT(b.x)], 1u); }
}
__device__ __forceinline__ void xbar_census(unsigned* bar, unsigned x, unsigned& nloc, unsigned& nx) {
  const unsigned G = gridDim.x;
  unsigned sum, cnt, mine, sp = 0u;
  for (;;) {
    sum = 0u; cnt = 0u; mine = 0u;
#pragma unroll
    for (unsigned j = 0; j < 16; ++j) { const unsigned c = xb_ld(&bar[XB_XCNT(j)]); sum += c; cnt += (c > 0u) ? 1u : 0u; mine = (j == x) ? c : mine; }
    if (sum == G) break;
    __builtin_amdgcn_s_sleep(1);
    if ((++sp & 255u) == 0u) { if (xb_ld(&bar[XB_TMO])) break; if (sp > XB_SPIN_CAP) { atomicAdd(&bar[XB_TMO], 1u); break; } }
  }
  nloc = mine > 0u ? mine : 1u; nx = cnt > 0u ? cnt : 1u;
}
__device__ __forceinline__ void xbar_sync(XBar& b) {
  asm volatile("s_waitcnt vmcnt(0)" ::: "memory");
  __syncthreads();
  if (tidx() == 0) {
    unsigned* bar = b.bar;
    __builtin_amdgcn_s_waitcnt(0);
    unsigned nloc = b.st[0], nx = b.st[1];
    if (nloc == 0u) { xbar_census(bar, b.x, nloc, nx); b.st[0] = nloc; b.st[1] = nx; }
    const unsigned old = xb_add(&bar[XB_XSUB(b.x)], 1u);
    const unsigned gen = old / nloc;
    if (old + 1u == (gen + 1u) * nloc) {
      __builtin_amdgcn_fence(__ATOMIC_RELEASE, "agent");
      asm volatile("s_waitcnt vmcnt(0)" ::: "memory");
      const unsigned og = xb_add(&bar[XB_TOP], 1u);
      const unsigned tg = og / nx;
      if (og + 1u == (tg + 1u) * nx) xb_add(&bar[XB_TOPGEN], 1u);
      else XB_SPIN(xb_ld(&bar[XB_TOPGEN]) == tg, bar);
      __builtin_amdgcn_fence(__ATOMIC_ACQUIRE, "agent");
      xb_add(&bar[XB_XGEN(b.x)], 1u);
      asm volatile("s_waitcnt vmcnt(0)" ::: "memory");
    } else {
      XB_SPIN(xb_ld(&bar[XB_XGEN(b.x)]) == gen, bar);
      __builtin_amdgcn_fence(__ATOMIC_ACQUIRE, "agent");
      asm volatile("s_waitcnt vmcnt(0)" ::: "memory");
    }
  }
  __syncthreads();
}

constexpr int NSTEPS = 20;
#define STEP(k, body) do { if (s_lo <= (k) && (k) < s_hi) { body; if ((k) + 1 < s_hi) { xbar_sync(xb); } \
    if (PROBE_MASK != 0u) { unsigned long long now_ = __builtin_amdgcn_s_memrealtime(); \
      if ((PROBE_MASK >> (k)) & 1u) { const unsigned long long w_ = (now_ - pt_prev) * PROBE_AMP; \
        while (__builtin_amdgcn_s_memrealtime() - now_ < w_) __builtin_amdgcn_s_sleep(8); now_ = __builtin_amdgcn_s_memrealtime(); } \
      pt_prev = now_; } } } while (0)
#define LAYER_STEPS(l, base) \
  STEP(base + 0, phase_norm1(p, l); if (l == 1) phase_convert(p, 1, (float*)smem)); \
  STEP(base + 1, phase_inproj(p, (h16*)smem)); \
  STEP(base + 2, phase_mixa(p, l, smem)); \
  STEP(base + 3, phase_mixb(p, l, (float*)smem)); \
  STEP(base + 4, phase_attn(p, l, (float*)smem)); \
  STEP(base + 5, phase_outproj(p, l, (h16*)smem)); \
  STEP(base + 6, phase_router(p, l, (int*)smem)); \
  STEP(base + 7, phase_moe1(p, l, (h16*)smem)); \
  STEP(base + 8, phase_moe2(p, l, (h16*)smem))

__global__ void __launch_bounds__(NTHREADS, 2) mega(Params p, int s_lo, int s_hi) {
  extern __shared__ __attribute__((aligned(16))) unsigned char smem[];
  unsigned long long pt_prev = PROBE_MASK != 0u ? __builtin_amdgcn_s_memrealtime() : 0ull;
  XBar xb;
  xbar_post(xb, (unsigned*)(p.ws + OFF_BAR), (volatile unsigned*)(smem + LDS_BYTES - 16));
  STEP(0, phase_prep(p, (float*)smem); phase_convert(p, 0, (float*)smem));
  LAYER_STEPS(0, 1);
  LAYER_STEPS(1, 10);
  STEP(19, phase_norm1(p, 2));
}

extern "C" void kernel_launch(void* const* d_in, const int* in_sizes, int n_in, void* d_out, int out_size, void* d_ws, size_t ws_size,
                              hipStream_t stream) {
  static int grid_blocks = 0;
  if (!grid_blocks) {
    if (n_in != 35 || out_size != T * D || ws_size < WS_TOTAL) {
      fprintf(stderr, "kernel_launch: unexpected problem (n_in %d, out %d, ws %zu < %zu)\n", n_in, out_size, ws_size, (size_t)WS_TOTAL);
      grid_blocks = -1;
      return;
    }
    int dev = 0, cus = 0, per_cu = 0;
    hipGetDevice(&dev);
    hipDeviceGetAttribute(&cus, hipDeviceAttributeMultiprocessorCount, dev);
    if (hipFuncSetAttribute((const void*)mega, hipFuncAttributeMaxDynamicSharedMemorySize, LDS_BYTES) != hipSuccess) {
      fprintf(stderr, "kernel_launch: hipFuncSetAttribute(%d B dynamic LDS) failed\n", LDS_BYTES);
      grid_blocks = -1;
      return;
    }
    hipOccupancyMaxActiveBlocksPerMultiprocessor(&per_cu, mega, NTHREADS, LDS_BYTES);
    if (per_cu > 1) per_cu = 1;
    if (per_cu < 1) { fprintf(stderr, "kernel_launch: occupancy query returned %d\n", per_cu); grid_blocks = -1; return; }
    grid_blocks = cus * per_cu;
  }
  if (grid_blocks < 0) return;
  Params p{};
  for (int i = 0; i < 35; ++i) p.in[i] = (const float*)d_in[i];
  p.out = (float*)d_out;
  p.ws = (unsigned char*)d_ws;
  for (int i = 0; i < 32; ++i) p.inv_freq[i] = std::pow(10000.0, -(double)(2 * i) / 64.0);
  if (hipMemsetAsync((char*)d_ws + OFF_BAR, 0, 16384, stream) != hipSuccess) { fprintf(stderr, "kernel_launch: memset of barrier words failed\n"); return; }
#if MEGA
  int lo = 0, hi = NSTEPS;
  void* args[] = {&p, &lo, &hi};
  hipError_t e = hipLaunchCooperativeKernel((void*)mega, dim3(grid_blocks), dim3(NTHREADS), args, LDS_BYTES, stream);
  if (e != hipSuccess) fprintf(stderr, "cooperative launch failed: %s (grid %d)\n", hipGetErrorString(e), grid_blocks);
#else
  for (int s = 0; s < NSTEPS; ++s) {
    int lo = s, hi = s + 1;
    void* args[] = {&p, &lo, &hi};
    hipError_t e = hipLaunchCooperativeKernel((void*)mega, dim3(grid_blocks), dim3(NTHREADS), args, LDS_BYTES, stream);
    if (e != hipSuccess) { fprintf(stderr, "launch %d failed: %s (grid %d)\n", s, hipGetErrorString(e), grid_blocks); break; }
  }
#endif
}
```

```cpp
#include <hip/hip_runtime.h>
#include <hip/hip_cooperative_groups.h>
#include <cstdio>
#include <cstdint>
#include <cmath>
namespace cg = cooperative_groups;

#ifndef MEGA
#define MEGA 1
#endif
#ifndef PROBE_MASK
#define PROBE_MASK 0u
#define PROBE_AMP 3
#endif

typedef _Float16 h16;
typedef _Float16 h16x8 __attribute__((ext_vector_type(8)));
typedef _Float16 h16x4 __attribute__((ext_vector_type(4)));
typedef float f32x4 __attribute__((ext_vector_type(4)));

constexpr int NB = 2, S = 8192, T = NB * S, D = 1024;
constexpr int NIN = 2432;
constexpr int NINSRC = 2328;
constexpr int C_XL = 0, C_GL = 256, C_Q = 512, C_KC = 1024, C_VC = 1152, C_KS = 1280, C_VS = 1408, C_KW = 1536, C_VW = 1664,
              C_CVA = 1792, C_CVB = 2048, C_GATE = 2304;
constexpr float EPS = 1e-6f;
constexpr int NTHREADS = 512, NW = 8;
constexpr int LDS_BYTES = 150528;
constexpr int NINP = 2560;
constexpr int SCHED_OFF = LDS_BYTES - 1024;
constexpr float ASCALE = 16.f;

constexpr size_t al256(size_t x) { return (x + 255) & ~(size_t)255; }
constexpr size_t OFF_CTL = 0;
constexpr size_t OFF_BAR = 4096;
constexpr size_t OFF_MOD = 4096 + 16384;
constexpr size_t OFF_ROPE = al256(OFF_MOD + 2 * 2 * 6144 * 4);
constexpr size_t OFF_PB = al256(OFF_ROPE + (size_t)T * 64 * 4);
constexpr size_t OFF_PBPART = al256(OFF_PB + 2 * 256 * 4);
constexpr size_t OFF_LRUW = al256(OFF_PBPART + 2 * 32 * 256 * 4);
constexpr size_t OFF_GATES = al256(OFF_LRUW + 2 * 4 * 64 * 64 * 2);
constexpr size_t OFF_WIN = al256(OFF_GATES + (size_t)T * 24 * 4);
constexpr size_t OFF_WOUT = al256(OFF_WIN + (size_t)NINP * 1024 * 2);
constexpr size_t OFF_WGU = al256(OFF_WOUT + (size_t)1024 * 1024 * 2);
constexpr size_t OFF_WDN = al256(OFF_WGU + (size_t)16 * 1024 * 1024 * 2);
constexpr size_t OFF_W1K = al256(OFF_WDN + (size_t)16 * 1024 * 512 * 2);
constexpr size_t OFF_W1V = al256(OFF_W1K + (size_t)256 * 2048 * 2);
constexpr size_t OFF_H16 = al256(OFF_W1V + (size_t)256 * 2048 * 2);
constexpr size_t OFF_Q16 = al256(OFF_H16 + (size_t)T * 1024 * 2);
constexpr size_t KVSZ = (size_t)T * 128 * 2;
constexpr size_t OFF_KC = al256(OFF_Q16 + (size_t)T * 512 * 2);
constexpr size_t OFF_VC = al256(OFF_KC + KVSZ + 4096);
constexpr size_t OFF_KS = al256(OFF_VC + KVSZ + 4096);
constexpr size_t OFF_VST = al256(OFF_KS + KVSZ);
constexpr size_t OFF_KW = al256(OFF_VST + KVSZ);
constexpr size_t OFF_VWT = al256(OFF_KW + KVSZ);
constexpr size_t OFF_HIDC = al256(OFF_VWT + KVSZ);
constexpr size_t OFF_KCMP = al256(OFF_HIDC + (size_t)2 * 2048 * 256 * 2);
constexpr size_t OFF_VCMPT = al256(OFF_KCMP + (size_t)4 * 512 * 64 * 2);
constexpr size_t OFF_LRUH = al256(OFF_VCMPT + (size_t)4 * 512 * 64 * 2);
constexpr size_t OFF_LRUA = al256(OFF_LRUH + (size_t)T * 256 * 4);
constexpr size_t OFF_HEND = al256(OFF_LRUA + (size_t)T * 256 * 4);
constexpr size_t OFF_AEND = al256(OFF_HEND + 2 * 256 * 256 * 4);
constexpr size_t OFF_CARRY = al256(OFF_AEND + 2 * 256 * 256 * 4);
constexpr size_t OFF_XA = al256(OFF_CARRY + 2 * 256 * 256 * 4);
constexpr size_t OFF_LIST = al256(OFF_XA + (size_t)T * 1024 * 4);
constexpr size_t OFF_WPAIR = al256(OFF_LIST + (size_t)16 * 16384 * 4);
constexpr size_t OFF_SSQ = al256(OFF_WPAIR + 32768 * 4);
constexpr size_t OFF_R = al256(OFF_SSQ + (size_t)T * 2 * 4);
constexpr size_t OFF_P16 = OFF_R;
constexpr size_t OFF_HID = OFF_R;
constexpr size_t OFF_YPAIR = al256(OFF_HID + (size_t)(32768 + 512) * 512 * 2);
constexpr size_t OFF_HIDP = al256(OFF_P16 + (size_t)T * NIN * 2);
constexpr size_t OFF_MODP = OFF_HIDP;
constexpr size_t R_END1 = OFF_HIDP + (size_t)4 * 2 * 2048 * 256 * 4;
constexpr size_t R_END2 = OFF_YPAIR + (size_t)32768 * 1024 * 2;
constexpr size_t WS_TOTAL = al256(R_END1 > R_END2 ? R_END1 : R_END2);

struct Params {
  const float* in[35];
  float* out;
  unsigned char* ws;
  double inv_freq[32];
};
enum { I_X = 0, I_C, I_POS, I_ADAW, I_ADAB, I_N1G, I_N2G, I_WIN, I_LCW, I_LCB, I_LWA, I_LBA, I_LWX, I_LBX, I_LLAM, I_CKW1, I_CKW2,
       I_CVW1, I_CVW2, I_CPK, I_CPV, I_DWW, I_DWB, I_LNG, I_LNB, I_ONG, I_WOUT, I_RGW, I_RGB, I_REW, I_REB, I_MG, I_MU, I_MD, I_FNG };

__device__ __forceinline__ int tidx() { int t = threadIdx.x; asm volatile("" : "+v"(t)); return t; }
__device__ __forceinline__ float wsum(float v) {
#pragma unroll
  for (int o = 32; o > 0; o >>= 1) v += __shfl_xor(v, o);
  return v;
}
__device__ __forceinline__ float sigm(float x) { return 1.f / (1.f + __expf(-x)); }
__device__ __forceinline__ float silu_f(float x) { return x / (1.f + __expf(-x)); }
__device__ __forceinline__ float gelu_tanh(float x) {
  float u = 0.7978845608028654f * (x + 0.044715f * x * x * x);
  float e = __expf(2.f * u);
  float t = 1.f - 2.f / (e + 1.f);
  return 0.5f * x * (1.f + t);
}
__device__ __forceinline__ void glds16(const h16* g, h16* l) {
  __builtin_amdgcn_global_load_lds((const unsigned*)g, (unsigned*)l, 16, 0, 0);
}
__device__ __forceinline__ h16x4 pack4(float a, float b, float c, float d) {
  h16x4 r; r[0] = (h16)a; r[1] = (h16)b; r[2] = (h16)c; r[3] = (h16)d; return r;
}

struct TileIter { int cur, end, step; };
__device__ __forceinline__ TileIter xcd_tiles(int ntiles) {
  const int G = gridDim.x, b = blockIdx.x;
  TileIter it;
  if ((G & 7) == 0) {
    const int x = b & 7;
    it.cur = (int)(((long)ntiles * x) >> 3) + (b >> 3);
    it.end = (int)(((long)ntiles * (x + 1)) >> 3);
    it.step = G >> 3;
  } else { it.cur = b; it.end = ntiles; it.step = G; }
  return it;
}

#define VMCNT(n) asm volatile("s_waitcnt vmcnt(" #n ")" ::: "memory")
template <int BN, class ARowFn>
__device__ __forceinline__ void gemm_mainloop(f32x4 (&acc)[8][BN / 64], ARowFn arow, const h16* __restrict__ Bt, int ldb, int nk, h16* sm, bool zero_init = true) {
  constexpr int NF = BN / 64, NBP = BN / 64;
  constexpr int STAGE = 16384 + BN * 64;
  constexpr int NST = BN == 128 ? 3 : 2;
  const int tid = tidx(), lane = tid & 63, wave = tid >> 6;
  const int wr = wave >> 2, wc = wave & 3, fr = lane & 15, fq = lane >> 4;
  const h16* ap[4];
  const h16* bp[NBP];
#pragma unroll
  for (int i = 0; i < 4; ++i) {
    const int r = (i * 8 + wave) * 8 + (lane >> 3);
    const int c = (lane & 7) ^ ((r >> 1) & 7);
    ap[i] = arow(r) + c * 8;
    if (i < NBP) bp[i] = Bt + (size_t)r * ldb + c * 8;
  }
  if (zero_init) {
#pragma unroll
    for (int m = 0; m < 8; ++m)
#pragma unroll
      for (int n = 0; n < NF; ++n) acc[m][n] = (f32x4){0.f, 0.f, 0.f, 0.f};
  }
  h16* const dA = sm + wave * 512 + lane * 8;
#pragma unroll
  for (int st0 = 0; st0 < NST - 1; ++st0)
    if (st0 < nk) {
#pragma unroll
      for (int i = 0; i < 4; ++i) { glds16(ap[i], dA + st0 * STAGE + i * 4096); ap[i] += 64; }
#pragma unroll
      for (int i = 0; i < NBP; ++i) { glds16(bp[i], dA + st0 * STAGE + 16384 + i * 4096); bp[i] += 64; }
    }
  const int sw = (fr >> 1) & 7;
  const int aoff = (wr * 128 + fr) * 64, boff = 16384 + (wc * (BN / 4) + fr) * 64;
#define SCHED_FENCE() __builtin_amdgcn_sched_barrier(0)
  for (int kt = 0; kt < nk; ++kt) {
    if (NST == 3 && kt + 1 < nk) VMCNT(6); else VMCNT(0);
    __builtin_amdgcn_s_barrier();
    const int sl_ = NST == 3 ? kt % 3 : (kt & 1);
    const h16* st = sm + sl_ * STAGE;
    const bool more = kt + (NST - 1) < nk;
    h16* const dn = dA + (NST == 3 ? (sl_ == 0 ? 2 : sl_ - 1) : (sl_ ^ 1)) * STAGE;
#pragma unroll
    for (int ks = 0; ks < 2; ++ks) {
      const int ch = ((ks * 4 + fq) ^ sw) * 8;
      h16x8 bf[NF];
#pragma unroll
      for (int n = 0; n < NF; ++n) bf[n] = *(const h16x8*)(st + boff + n * 1024 + ch);
#pragma unroll
      for (int mh = 0; mh < 2; ++mh) {
        h16x8 af[4];
#pragma unroll
        for (int m = 0; m < 4; ++m) af[m] = *(const h16x8*)(st + aoff + (mh * 4 + m) * 1024 + ch);
#pragma unroll
        for (int m = 0; m < 4; ++m) {
#pragma unroll
          for (int n = 0; n < NF; ++n) acc[mh * 4 + m][n] = __builtin_amdgcn_mfma_f32_16x16x32_f16(bf[n], af[m], acc[mh * 4 + m][n], 0, 0, 0);
          if (m == 1 || m == 3) {
            const int q = ks * 4 + mh * 2 + (m >> 1);
            SCHED_FENCE();
            if (more) {
              if (q < 4) { glds16(ap[q & 3], dn + (q & 3) * 4096); ap[q & 3] += 64; }
              else if ((q & 3) < NBP) { glds16(bp[(q & 3) < NBP ? (q & 3) : 0], dn + 16384 + (q & 3) * 4096); bp[(q & 3) < NBP ? (q & 3) : 0] += 64; }
            }
            SCHED_FENCE();
          }
        }
      }
    }
  }
#undef SCHED_FENCE
  __builtin_amdgcn_s_barrier();
}

struct TileSched { int cur, end, step, tail_tile, tail_half, nbusy; };
__device__ __forceinline__ TileSched xcd_sched(int ntiles) {
  const int G = gridDim.x, b = blockIdx.x;
  TileSched s;
  s.tail_tile = -1; s.tail_half = -1; s.nbusy = 0;
  if ((G & 7) == 0) {
    const int x = b & 7, nb = G >> 3, si = b >> 3;
    const int lo = (int)(((long)ntiles * x) >> 3), hi = (int)(((long)ntiles * (x + 1)) >> 3);
    const int n = hi - lo, R = n / nb, rem = n - R * nb;
    s.cur = lo + si; s.end = lo + R * nb; s.step = nb;
    if (rem * 2 <= nb) { s.nbusy = 2 * rem; if (si < 2 * rem) { s.tail_tile = lo + R * nb + (si >> 1); s.tail_half = si & 1; } }
    else { s.nbusy = rem; if (si < rem) s.tail_tile = lo + R * nb + si; }
  } else { s.cur = b; s.end = ntiles; s.step = G; }
  return s;
}

__device__ __forceinline__ h16* wgu_buf(const Params& p, int l) { return l ? (h16*)p.out : (h16*)(p.ws + OFF_WGU); }
__device__ __forceinline__ h16* wdn_buf(const Params& p, int l) { return l ? (h16*)p.out + (size_t)16 * 1024 * 1024 : (h16*)(p.ws + OFF_WDN); }
constexpr int NT_CONV = 16 * 37 + 256 + 3 * 16 * 128 + 2 * 128;
__device__ __forceinline__ int map_row(int mode, int n) {
  if (mode == 1) return n < 1792 ? n : (n < 1816 ? n + 512 : n - 24);
  if (mode == 2) return 32 * (n >> 4) + (n & 15);
  if (mode == 3) return 32 * (n >> 4) + 16 + (n & 15);
  return n;
}
struct ConvTile { const float* src; h16* dst; int K, N, mode, k0, n0; const float* pos; float* pbp; };
__device__ __forceinline__ ConvTile conv_decode(const Params& p, int l, int t) {
  unsigned char* ws = p.ws;
  constexpr int T_WIN = 16 * 37, T_WOUT = 256, T_G = 16 * 128, T_W1 = 128;
  constexpr int E0 = T_WIN, E1 = E0 + T_WOUT, E2 = E1 + T_G, E3 = E2 + T_G, E4 = E3 + T_G, E5 = E4 + T_W1;
  ConvTile c;
  c.pos = nullptr; c.pbp = nullptr;
  int tk, tn;
  if (t < E0) {
    c.src = p.in[I_WIN] + (size_t)l * 1024 * NINSRC; c.K = 1024; c.N = NINSRC; c.dst = (h16*)(ws + OFF_WIN); c.mode = 1; tk = t / 37; tn = t % 37;
  } else if (t < E1) {
    const int u = t - E0;
    c.src = p.in[I_WOUT] + (size_t)l * 1024 * 1024; c.K = 1024; c.N = 1024; c.dst = (h16*)(ws + OFF_WOUT); c.mode = 4; tk = u >> 4; tn = u & 15;
  } else if (t < E3) {
    const int up = t >= E2;
    const int u = t - (up ? E2 : E1);
    const int e = u >> 7, v = u & 127;
    c.src = p.in[up ? I_MU : I_MG] + ((size_t)l * 16 + e) * 1024 * 512; c.K = 1024; c.N = 512; c.dst = wgu_buf(p, l) + (size_t)e * 1024 * 1024;
    c.mode = up ? 3 : 2; tk = v >> 3; tn = v & 7;
  } else if (t < E4) {
    const int u = t - E3;
    const int e = u >> 7, v = u & 127;
    c.src = p.in[I_MD] + ((size_t)l * 16 + e) * 512 * 1024; c.K = 512; c.N = 1024; c.dst = wdn_buf(p, l) + (size_t)e * 1024 * 512; c.mode = 0; tk = v >> 4; tn = v & 15;
  } else {
    const int vv = t >= E5;
    const int u = t - (vv ? E5 : E4);
    c.src = p.in[vv ? I_CVW1 : I_CKW1] + (size_t)l * 2048 * 256; c.K = 2048; c.N = 256; c.dst = (h16*)(ws + (vv ? OFF_W1V : OFF_W1K)); c.mode = 5; tk = u >> 2; tn = u & 3;
    c.pos = p.in[vv ? I_CPV : I_CPK] + (size_t)l * 2048 + tk * 64;
    c.pbp = (float*)(ws + OFF_PBPART) + (size_t)(vv * 32 + tk) * 256 + tn * 64;
  }
  c.k0 = tk * 64; c.n0 = tn * 64;
  return c;
}
__device__ __forceinline__ void conv_wave_tile(const ConvTile& c, float* smw, int lane) {
  float4 v[16];
#pragma unroll
  for (int i = 0; i < 16; ++i) {
    const int idx = i * 64 + lane;
    const int r = idx >> 4, c4 = (idx & 15) * 4;
    v[i] = make_float4(0.f, 0.f, 0.f, 0.f);
    if (c.n0 + c4 < c.N) v[i] = *(const float4*)(c.src + (size_t)(c.k0 + r) * c.N + c.n0 + c4);
  }
#pragma unroll
  for (int i = 0; i < 16; ++i) {
    const int idx = i * 64 + lane;
    const int r = idx >> 4, c4 = (idx & 15) * 4;
    float* d = smw + r * 65 + c4;
    d[0] = v[i].x; d[1] = v[i].y; d[2] = v[i].z; d[3] = v[i].w;
  }
  if (c.mode == 5) {
    float sacc = 0.f;
    for (int k = 0; k < 64; ++k) sacc += c.pos[k] * smw[k * 65 + lane];
    c.pbp[lane] = sacc;
  }
  const int k0d = c.mode == 4 ? (c.k0 < 256 ? c.k0 + 512 : (c.k0 < 768 ? c.k0 - 256 : c.k0)) : c.k0;
#pragma unroll
  for (int j = 0; j < 8; ++j) {
    const int ch = j * 64 + lane;
    const int n = ch >> 3, kc = ch & 7;
    if (c.n0 + n < c.N) {
      h16x8 o;
#pragma unroll
      for (int q = 0; q < 8; ++q) o[q] = (h16)smw[(kc * 8 + q) * 65 + n];
      *(h16x8*)(c.dst + (size_t)map_row(c.mode, c.n0 + n) * c.K + k0d + kc * 8) = o;
    }
  }
}

__device__ __forceinline__ void conv_share(const Params& p, int l, int t0, int t1, int nbusy, float* sm) {
  const int tid = tidx(), lane = tid & 63, wave = tid >> 6;
  float* smw = sm + wave * 4160;
  const int G = gridDim.x, b = blockIdx.x;
  int lo = t0, hi = t1, me = b, n = G;
  if ((G & 7) == 0) {
    const int x = b & 7, nb = G >> 3, si = b >> 3;
    lo = t0 + (int)(((long)(t1 - t0) * x) >> 3); hi = t0 + (int)(((long)(t1 - t0) * (x + 1)) >> 3);
    if (nbusy < nb) { me = si - nbusy; n = nb - nbusy; } else { me = si; n = nb; }
  }
  if (me < 0) return;
  for (int t = lo + me * NW + wave; t < hi; t += n * NW) {
    const ConvTile c = conv_decode(p, l, t);
    conv_wave_tile(c, smw, lane);
  }
}
__device__ __forceinline__ void phase_convert_tiles(const Params& p, int l, float* sm) {
  const int tid = tidx(), lane = tid & 63, wave = tid >> 6;
  float* smw = sm + wave * 4160;
  for (int t = blockIdx.x * NW + wave; t < NT_CONV; t += gridDim.x * NW) {
    const ConvTile c = conv_decode(p, l, t);
    conv_wave_tile(c, smw, lane);
  }
  __syncthreads();
}
__device__ __forceinline__ void phase_convert_misc(const Params& p, int l) {
  unsigned char* ws = p.ws;
  {
    h16* lw = (h16*)(ws + OFF_LRUW);
    for (int i = blockIdx.x * NTHREADS + tidx(); i < 2 * 4 * 64 * 64; i += gridDim.x * NTHREADS) {
      const int d = i & 63, e = (i >> 6) & 63, n = (i >> 12) & 3, mat = i >> 14;
      lw[i] = (h16)p.in[mat ? I_LWX : I_LWA][((size_t)(l * 4 + n) * 64 + d) * 64 + e];
    }
  }
  {
    h16x8 z = {0, 0, 0, 0, 0, 0, 0, 0};
    h16* w = (h16*)(ws + OFF_WIN) + (size_t)NINSRC * 1024;
    for (int i = blockIdx.x * NTHREADS + tidx(); i < (NINP - NINSRC) * 1024 / 8; i += gridDim.x * NTHREADS) *(h16x8*)(w + (size_t)i * 8) = z;
  }
}

__device__ __forceinline__ void phase_prep(const Params& p, float* sm) {
  unsigned char* ws = p.ws;
  const int tid = tidx();
  if (blockIdx.x == 0) {
    for (int i = tid; i < 1024; i += NTHREADS) ((unsigned*)(ws + OFF_CTL))[i] = 0u;
  }
  float* part = (float*)(ws + OFF_MODP);
  for (int it = blockIdx.x; it < 192; it += gridDim.x) {
    const int l = it / 96, r = it % 96, cg = r >> 2, ks = r & 3;
    const int lane = tid & 63, wave = tid >> 6;
    const int k0 = ks * 256 + wave * 32;
    const float* w = p.in[I_ADAW] + ((size_t)l * 1024 + k0) * 6144 + cg * 256 + lane * 4;
    const float* c = p.in[I_C] + k0;
    float a0[4] = {0, 0, 0, 0}, a1[4] = {0, 0, 0, 0};
#pragma unroll 16
    for (int k = 0; k < 32; ++k) {
      const float4 wv = *(const float4*)(w + (size_t)k * 6144);
      const float s0 = silu_f(c[k]), s1 = silu_f(c[1024 + k]);
      a0[0] += s0 * wv.x; a0[1] += s0 * wv.y; a0[2] += s0 * wv.z; a0[3] += s0 * wv.w;
      a1[0] += s1 * wv.x; a1[1] += s1 * wv.y; a1[2] += s1 * wv.z; a1[3] += s1 * wv.w;
    }
    float* rr = sm + (wave * 64 + lane) * 8;
#pragma unroll
    for (int i = 0; i < 4; ++i) { rr[i] = a0[i]; rr[4 + i] = a1[i]; }
    __syncthreads();
    {
      const int bb = tid >> 8, col = tid & 255;
      float sacc = 0.f;
#pragma unroll
      for (int g = 0; g < 8; ++g) sacc += sm[(g * 64 + (col >> 2)) * 8 + bb * 4 + (col & 3)];
      part[((size_t)(ks * 2 + l) * 2 + bb) * 6144 + cg * 256 + col] = sacc;
    }
    __syncthreads();
  }
  float* rc = (float*)(ws + OFF_ROPE);
  float* rs = rc + (size_t)T * 32;
  const int* pos = (const int*)p.in[I_POS];
  for (int i = blockIdx.x * NTHREADS + tid; i < T * 32; i += gridDim.x * NTHREADS) {
    const int t = i >> 5, f = i & 31;
    const double a = (double)pos[t] * p.inv_freq[f];
    const double n = rint(a * 0.15915494309189535);
    double r = fma(-n, 6.283185307179586, a);
    r = fma(-n, 2.4492935982947064e-16, r);
    const float rf = (float)r;
    rc[i] = cosf(rf);
    rs[i] = sinf(rf);
  }
}

__device__ __forceinline__ void phase_norm1(const Params& p, int mode, float* sm) {
  unsigned char* ws = p.ws;
  const int lane = tidx() & 63, wave = tidx() >> 6;
  const float* mod = (const float*)(ws + OFF_MOD);
  float* xa = (float*)(ws + OFF_XA);
  const h16* yp = (const h16*)(ws + OFF_YPAIR);
  h16* hout = (h16*)(ws + OFF_H16);
  const int l = (mode == 0) ? 0 : 1;
  if (mode == 0) {
    const float* part = (const float*)(ws + OFF_MODP);
    const int tid = tidx();
    for (int i = tid; i < 1024; i += NTHREADS) {
      const int b = i >> 9, j4 = (i & 511) * 4;
      float4 a = *(const float4*)(p.in[I_ADAB] + j4);
#pragma unroll
      for (int ks = 0; ks < 4; ++ks) {
        const float4 v = *(const float4*)(part + ((size_t)(ks * 2) * 2 + b) * 6144 + j4);
        a.x += v.x; a.y += v.y; a.z += v.z; a.w += v.w;
      }
      *(float4*)(sm + b * 2048 + j4) = a;
    }
    for (int o = blockIdx.x * NTHREADS + tid; o < 4 * 6144; o += gridDim.x * NTHREADS) {
      const int lb = o / 6144, j = o - lb * 6144;
      float a = p.in[I_ADAB][(lb >> 1) * 6144 + j];
#pragma unroll
      for (int ks = 0; ks < 4; ++ks) a += part[((size_t)(ks * 2 + (lb >> 1)) * 2 + (lb & 1)) * 6144 + j];
      ((float*)(ws + OFF_MOD))[o] = a;
    }
    __syncthreads();
  }
  for (int row = blockIdx.x * NW + wave; row < T; row += gridDim.x * NW) {
    const int b = row >> 13;
    float4 x[4];
    float ss = 0.f;
#pragma unroll
    for (int i = 0; i < 4; ++i) {
      const int col = lane * 4 + 256 * i;
      if (mode == 0) {
        x[i] = *(const float4*)(p.in[I_X] + (size_t)row * D + col);
      } else {
        const int lp = mode == 1 ? 0 : 1;
        const float4 xv = *(const float4*)(xa + (size_t)row * D + col);
        const float4 g2 = *(const float4*)(mod + (size_t)(lp * 2 + b) * 6144 + 5120 + col);
        const h16x4 y0 = *(const h16x4*)(yp + (size_t)(row * 2) * D + col);
        const h16x4 y1 = *(const h16x4*)(yp + (size_t)(row * 2 + 1) * D + col);
        x[i].x = xv.x + g2.x * ((float)y0[0] + (float)y1[0]);
        x[i].y = xv.y + g2.y * ((float)y0[1] + (float)y1[1]);
        x[i].z = xv.z + g2.z * ((float)y0[2] + (float)y1[2]);
        x[i].w = xv.w + g2.w * ((float)y0[3] + (float)y1[3]);
        if (mode == 1) *(float4*)(xa + (size_t)row * D + col) = x[i];
      }
      ss += x[i].x * x[i].x + x[i].y * x[i].y + x[i].z * x[i].z + x[i].w * x[i].w;
    }
    ss = wsum(ss);
    const float rstd = rsqrtf(ss * (1.f / D) + EPS);
#pragma unroll
    for (int i = 0; i < 4; ++i) {
      const int col = lane * 4 + 256 * i;
      if (mode == 2) {
        const float4 g = *(const float4*)(p.in[I_FNG] + col);
        float4 o;
        o.x = x[i].x * rstd * g.x; o.y = x[i].y * rstd * g.y; o.z = x[i].z * rstd * g.z; o.w = x[i].w * rstd * g.w;
        *(float4*)(p.out + (size_t)row * D + col) = o;
      } else {
        const float4 g = *(const float4*)(p.in[I_N1G] + l * D + col);
        const float4 sh = mode == 0 ? *(const float4*)(sm + b * 2048 + col) : *(const float4*)(mod + (size_t)(l * 2 + b) * 6144 + col);
        const float4 sc = mode == 0 ? *(const float4*)(sm + b * 2048 + 1024 + col) : *(const float4*)(mod + (size_t)(l * 2 + b) * 6144 + 1024 + col);
        *(h16x4*)(hout + (size_t)row * D + col) = pack4(x[i].x * rstd * g.x * (1.f + sc.x) + sh.x, x[i].y * rstd * g.y * (1.f + sc.y) + sh.y,
                                                        x[i].z * rstd * g.z * (1.f + sc.z) + sh.z, x[i].w * rstd * g.w * (1.f + sc.w) + sh.w);
      }
    }
  }
}

__device__ __forceinline__ int perm_key(int pos) {
  return 32 * (pos >> 5) + 16 * ((pos >> 2) & 1) + 4 * ((pos >> 3) & 3) + (pos & 3);
}
__device__ __forceinline__ void inproj_tile(const Params& p, h16* sm, int mt, int nt) {
  unsigned char* ws = p.ws;
  const h16* Ab = (const h16*)(ws + OFF_H16) + (size_t)mt * 256 * D;
  f32x4 acc[8][2];
  gemm_mainloop<128>(acc, [&](int r) { return Ab + (size_t)r * D; }, (const h16*)(ws + OFF_WIN) + (size_t)nt * 128 * D, D, D / 64, sm);
  const int tid_e = tidx(), lane = tid_e & 63, wave = tid_e >> 6, wr = wave >> 2, wc = wave & 3, fr = lane & 15, fq = lane >> 4;
  constexpr int LDR = 136;
#pragma unroll
  for (int m = 0; m < 8; ++m)
#pragma unroll
    for (int n = 0; n < 2; ++n)
      *(h16x4*)(sm + (wr * 128 + m * 16 + fr) * LDR + wc * 32 + n * 16 + 4 * fq) = pack4(acc[m][n][0], acc[m][n][1], acc[m][n][2], acc[m][n][3]);
  __syncthreads();
  const int row0 = mt * 256, b = mt >> 5, s0 = (mt & 31) * 256;
  if (nt < 4 || (nt >= 14 && nt < 18)) {
    h16* P = (h16*)(ws + OFF_P16);
#pragma unroll
    for (int i = 0; i < 8; ++i) {
      const int idx = i * NTHREADS + tid_e;
      const int r = idx >> 4, c8 = idx & 15;
      *(h16x8*)(P + (size_t)(row0 + r) * NIN + nt * 128 + c8 * 8) = *(const h16x8*)(sm + r * LDR + c8 * 8);
    }
  } else if (nt <= 8 || nt == 10 || nt == 12) {
    const float* rc = (const float*)(ws + OFF_ROPE);
    const float* rs = rc + (size_t)T * 32;
    const bool isq = nt < 8;
    const float scl = isq ? 0.125f * 1.4426950408889634f : 1.f;
    h16* kbase = (h16*)(ws + (nt == 8 ? OFF_KC : (nt == 10 ? OFF_KS : OFF_KW)));
    h16* q16 = (h16*)(ws + OFF_Q16);
#pragma unroll
    for (int i = 0; i < 4; ++i) {
      const int idx = i * NTHREADS + tid_e;
      const int r = idx >> 3, hd = (idx >> 2) & 1, d = (idx & 3) * 8;
      const h16x8 a = *(const h16x8*)(sm + r * LDR + 64 * hd + d);
      const h16x8 bb = *(const h16x8*)(sm + r * LDR + 64 * hd + 32 + d);
      const float* cp = rc + (size_t)(row0 + r) * 32 + d;
      const float* sp = rs + (size_t)(row0 + r) * 32 + d;
      const float4 c0 = *(const float4*)cp, c1 = *(const float4*)(cp + 4), n0 = *(const float4*)sp, n1 = *(const float4*)(sp + 4);
      const float cs[8] = {c0.x, c0.y, c0.z, c0.w, c1.x, c1.y, c1.z, c1.w}, sn[8] = {n0.x, n0.y, n0.z, n0.w, n1.x, n1.y, n1.z, n1.w};
      h16x8 lo, hi;
#pragma unroll
      for (int j = 0; j < 8; ++j) {
        const float av = (float)a[j], bv = (float)bb[j];
        lo[j] = (h16)((av * cs[j] - bv * sn[j]) * scl);
        hi[j] = (h16)((bv * cs[j] + av * sn[j]) * scl);
      }
      h16* dst = isq ? q16 + (size_t)(row0 + r) * 512 + (nt - 4) * 128 + 64 * hd + d : kbase + ((size_t)(b * 2 + hd) * S + s0 + r) * 64 + d;
      *(h16x8*)dst = lo;
      *(h16x8*)(dst + 32) = hi;
    }
  } else if (nt == 9) {
    h16* vc = (h16*)(ws + OFF_VC);
#pragma unroll
    for (int i = 0; i < 8; ++i) {
      const int idx = i * NTHREADS + tid_e;
      const int r = idx >> 4, c8 = idx & 15, hd = c8 >> 3, dd = (c8 & 7) * 8;
      *(h16x8*)(vc + ((size_t)(b * 2 + hd) * S + s0 + r) * 64 + dd) = *(const h16x8*)(sm + r * LDR + c8 * 8);
    }
  } else if (nt == 11 || nt == 13) {
    h16* vt = (h16*)(ws + (nt == 11 ? OFF_VST : OFF_VWT));
#pragma unroll
    for (int i = 0; i < 8; ++i) {
      const int idx = i * NTHREADS + tid_e;
      const int kv = idx >> 11, blk = (idx >> 9) & 3, dim = (idx >> 3) & 63, p0 = (idx & 7) * 8;
      h16x8 v;
#pragma unroll
      for (int j = 0; j < 8; ++j) v[j] = sm[(blk * 64 + perm_key(p0 + j)) * LDR + 64 * kv + dim];
      *(h16x8*)(vt + ((size_t)((b * 2 + kv) * 128 + (s0 >> 6) + blk)) * 4096 + dim * 64 + p0) = v;
    }
  } else {
    float* gates = (float*)(ws + OFF_GATES);
#pragma unroll
    for (int i = 0; i < 12; ++i) {
      const int idx = i * NTHREADS + tid_e;
      const int r = idx / 24, cc = idx % 24;
      gates[(size_t)(row0 + r) * 24 + cc] = sigm((float)sm[r * LDR + cc]);
    }
  }
  __syncthreads();
}
__device__ __forceinline__ void phase_inproj(const Params& p, h16* sm) {
  const TileIter tf = xcd_tiles(64 * 19);
  for (int t = tf.cur; t < tf.end; t += tf.step) inproj_tile(p, sm, t / 19, t % 19);
}

__device__ __forceinline__ void mixa_compress1(const Params& p, int item, h16* sm) {
  unsigned char* ws = p.ws;
  const int which = item >> 6, mt = (item >> 3) & 7, ks = (item >> 1) & 3, half = item & 1;
  const h16* A = (const h16*)(ws + (which ? OFF_VC : OFF_KC)) + (size_t)mt * 256 * 1024 + ks * 512;
  const h16* W = (const h16*)(ws + (which ? OFF_W1V : OFF_W1K)) + (size_t)half * 128 * 2048 + ks * 512;
  float* hp = (float*)(ws + OFF_HIDP) + ((size_t)(ks * 2 + which) * 2048) * 256;
  f32x4 acc[8][2];
  gemm_mainloop<128>(acc, [&](int r) { return A + (size_t)r * 1024; }, W, 2048, 8, sm);
  const int tid_e = tidx(), lane = tid_e & 63, wave = tid_e >> 6, wr = wave >> 2, wc = wave & 3, fr = lane & 15, fq = lane >> 4;
#pragma unroll
  for (int m = 0; m < 8; ++m)
#pragma unroll
    for (int n = 0; n < 2; ++n) {
      const int row = mt * 256 + wr * 128 + m * 16 + fr, col = half * 128 + wc * 32 + n * 16 + 4 * fq;
      *(f32x4*)(hp + (size_t)row * 256 + col) = acc[m][n];
    }
}

__device__ __forceinline__ void mixa_lru(const Params& p, int l, int item, float* sm) {
  unsigned char* ws = p.ws;
  const int tid = tidx();
  const int half = tid >> 8;
  item = item * 2 + half;
  sm += half * 14400;
  const int b = item >> 8, ck = item & 255;
  const int c = tid & 255;
  const int nb = c >> 6;
  const int lane = tid & 63, fr = lane & 15, fq = lane >> 4;
  const h16* P = (const h16*)(ws + OFF_P16);
  const float* cw = p.in[I_LCW] + l * 4 * 256;
  const float w0 = cw[c], w1 = cw[256 + c], w2 = cw[512 + c], w3 = cw[768 + c], cb = p.in[I_LCB][l * 256 + c];
  const float ba = p.in[I_LBA][l * 256 + c], bx = p.in[I_LBX][l * 256 + c];
  const float lam = p.in[I_LLAM][l * 256 + c];
  const float ls = -log1pf(expf(-lam));
  h16x8 bw[2][4][2];
  {
    const h16* lw = (const h16*)(ws + OFF_LRUW);
#pragma unroll
    for (int mat = 0; mat < 2; ++mat)
#pragma unroll
      for (int nt = 0; nt < 4; ++nt)
#pragma unroll
        for (int ks = 0; ks < 2; ++ks) bw[mat][nt][ks] = *(const h16x8*)(lw + ((size_t)((mat * 4 + nb) * 64 + nt * 16 + fr)) * 64 + ks * 32 + 8 * fq);
  }
  const int t0 = ck * 32;
  float x0 = 0.f, x1 = 0.f, x2 = 0.f;
  if (t0 >= 3) {
    x0 = (float)P[(size_t)(b * S + t0 - 3) * NIN + C_XL + c];
    x1 = (float)P[(size_t)(b * S + t0 - 2) * NIN + C_XL + c];
    x2 = (float)P[(size_t)(b * S + t0 - 1) * NIN + C_XL + c];
  }
  float h = 0.f, ap = 1.f;
  float* lh = (float*)(ws + OFF_LRUH);
  float* la = (float*)(ws + OFF_LRUA);
  float* sr = sm + 4096;
  float* si = sm + 8192;
  h16* xh = (h16*)(sm + 12288);
#pragma unroll 1
  for (int sub = 0; sub < 2; ++sub) {
    const int tb = t0 + sub * 16;
    {
      h16 xv[16];
      const h16* xp = P + (size_t)(b * S + tb) * NIN + C_XL + c;
#pragma unroll
      for (int tt = 0; tt < 16; ++tt) { xv[tt] = *xp; xp += NIN; asm volatile("" : "+v"(xp)); }
#pragma unroll
      for (int tt = 0; tt < 16; ++tt) {
        const float x3 = (float)xv[tt];
        const float xc = w0 * x0 + w1 * x1 + w2 * x2 + w3 * x3 + cb;
        sm[tt * 256 + c] = xc;
        xh[tt * 264 + c] = (h16)xc;
        x0 = x1; x1 = x2; x2 = x3;
      }
    }
    {
      h16x8 af[2];
#pragma unroll
      for (int ks = 0; ks < 2; ++ks) af[ks] = *(const h16x8*)(xh + fr * 264 + nb * 64 + ks * 32 + 8 * fq);
#pragma unroll
      for (int nt = 0; nt < 4; ++nt) {
        f32x4 ar = {0.f, 0.f, 0.f, 0.f}, ai = {0.f, 0.f, 0.f, 0.f};
#pragma unroll
        for (int ks = 0; ks < 2; ++ks) {
          ar = __builtin_amdgcn_mfma_f32_16x16x32_f16(af[ks], bw[0][nt][ks], ar, 0, 0, 0);
          ai = __builtin_amdgcn_mfma_f32_16x16x32_f16(af[ks], bw[1][nt][ks], ai, 0, 0, 0);
        }
#pragma unroll
        for (int j = 0; j < 4; ++j) {
          sr[(4 * fq + j) * 256 + nb * 64 + nt * 16 + fr] = ar[j];
          si[(4 * fq + j) * 256 + nb * 64 + nt * 16 + fr] = ai[j];
        }
      }
    }
#pragma unroll 4
    for (int tt = 0; tt < 16; ++tt) {
      const float r = sigm(sr[tt * 256 + c] + ba), ig = sigm(si[tt * 256 + c] + bx);
      const float log_a = 8.f * r * ls;
      const float a = __expf(log_a);
      const float mult = sqrtf(-expm1f(2.f * log_a));
      sr[tt * 256 + c] = a;
      si[tt * 256 + c] = mult * ig * sm[tt * 256 + c];
    }
    float* lhp = lh + (size_t)(b * S + tb) * 256 + c;
    float* lap = la + (size_t)(b * S + tb) * 256 + c;
#pragma unroll 4
    for (int tt = 0; tt < 16; ++tt) {
      const float a = sr[tt * 256 + c];
      h = a * h + si[tt * 256 + c];
      ap *= a;
      lhp[tt * 256] = h;
      lap[tt * 256] = ap;
    }
  }
  ((float*)(ws + OFF_HEND))[(size_t)(b * 256 + ck) * 256 + c] = h;
  ((float*)(ws + OFF_AEND))[(size_t)(b * 256 + ck) * 256 + c] = ap;
  __syncthreads();
}

__device__ __forceinline__ void mixa_conv(const Params& p, int l, int item, float* sm) {
  unsigned char* ws = p.ws;
  const int half = tidx() >> 8;
  item = item * 2 + half;
  sm += half * 15872;
  const int b = item >> 8, ck = item & 255;
  const int c = tidx() & 255;
  const h16* P = (const h16*)(ws + OFF_P16);
  const int t0 = ck * 32;
  float col[64];
#pragma unroll
  for (int r0 = 0; r0 < 64; r0 += 16) {
    h16 va[16], vb[16];
#pragma unroll
    for (int q = 0; q < 16; ++q) {
      const int t = t0 - 30 + r0 + q;
      va[q] = (h16)0.f; vb[q] = (h16)0.f;
      if (t >= 0 && r0 + q < 62) {
        const h16* pr = P + (size_t)(b * S + t) * NIN;
        va[q] = pr[C_CVA + c]; vb[q] = pr[C_CVB + c];
      }
    }
#pragma unroll
    for (int q = 0; q < 16; ++q) col[r0 + q] = (float)va[q] * sigm((float)vb[q]);
    asm volatile("" ::: "memory");
  }
  float w[31];
#pragma unroll
  for (int j = 0; j < 31; ++j) w[j] = p.in[I_DWW][(size_t)(l * 31 + j) * 256 + c];
  const float bias = p.in[I_DWB][l * 256 + c];
#pragma unroll
  for (int i = 0; i < 32; ++i) {
    float z = bias;
#pragma unroll
    for (int j = 0; j < 31; ++j) z += w[j] * col[i + j];
    sm[i * 256 + c] = z;
  }
  __syncthreads();
  const int lane = tidx() & 63, wave = (tidx() >> 6) & 3;
  const float4 lg = *(const float4*)(p.in[I_LNG] + l * 256 + lane * 4);
  const float4 lb = *(const float4*)(p.in[I_LNB] + l * 256 + lane * 4);
  const float4 gn = *(const float4*)(p.in[I_ONG] + l * 1024 + 768 + lane * 4);
  h16* yc = (h16*)(ws + OFF_H16);
  for (int i = wave * 8; i < wave * 8 + 8; ++i) {
    const float4 z = *(const float4*)(sm + i * 256 + lane * 4);
    const float mu = wsum(z.x + z.y + z.z + z.w) * (1.f / 256.f);
    const float dx = z.x - mu, dy = z.y - mu, dz = z.z - mu, dw = z.w - mu;
    const float var = wsum(dx * dx + dy * dy + dz * dz + dw * dw) * (1.f / 256.f);
    const float rs = rsqrtf(var + EPS);
    const float y0 = silu_f(dx * rs * lg.x + lb.x), y1 = silu_f(dy * rs * lg.y + lb.y), y2 = silu_f(dz * rs * lg.z + lb.z), y3 = silu_f(dw * rs * lg.w + lb.w);
    const float r2 = rsqrtf(wsum(y0 * y0 + y1 * y1 + y2 * y2 + y3 * y3) * (1.f / 256.f) + EPS);
    *(h16x4*)(yc + (size_t)(b * S + t0 + i) * D + 768 + lane * 4) = pack4(y0 * r2 * gn.x, y1 * r2 * gn.y, y2 * r2 * gn.z, y3 * r2 * gn.w);
  }
  __syncthreads();
}

__device__ __forceinline__ void phase_mixa(const Params& p, int l, void* sm) {
  const int G = gridDim.x;
  if (blockIdx.x == 0) {
    const int o = tidx();
    const float* pp = (const float*)(p.ws + OFF_PBPART) + (size_t)(o >> 8) * 32 * 256 + (o & 255);
    float pv[32];
#pragma unroll
    for (int k = 0; k < 32; ++k) pv[k] = pp[k * 256];
    float accb = 0.f;
#pragma unroll
    for (int k = 0; k < 32; ++k) accb += pv[k];
    ((float*)(p.ws + OFF_PB))[o] = accb;
  }
  for (int it = blockIdx.x; it < 128; it += G) mixa_compress1(p, it, (h16*)sm);
  for (int it = blockIdx.x; it < 256; it += G) mixa_lru(p, l, it, (float*)sm);
  for (int it = (blockIdx.x + G - 64 % G) % G; it < 256; it += G) mixa_conv(p, l, it, (float*)sm);
}

__device__ __forceinline__ void phase_mixb(const Params& p, int l, float* sm) {
  unsigned char* ws = p.ws;
  const int tid = tidx();
  for (int it = blockIdx.x; it < 512; it += gridDim.x) {
    const int which = it >> 8;
    const int row0 = (it & 255) * 8;
    {
      const float* hp = (const float*)(ws + OFF_HIDP) + ((size_t)which * 2048 + row0) * 256;
      const float* pb = (const float*)(ws + OFF_PB) + which * 256;
      const int r = tid >> 6, c4 = (tid & 63) * 4;
      const size_t o = (size_t)r * 256 + c4;
      const float4 a0 = *(const float4*)(hp + o), a1 = *(const float4*)(hp + (size_t)2 * 2048 * 256 + o);
      const float4 a2 = *(const float4*)(hp + (size_t)4 * 2048 * 256 + o), a3 = *(const float4*)(hp + (size_t)6 * 2048 * 256 + o);
      const float4 bb = *(const float4*)(pb + c4);
      float* d = sm + r * 256 + c4;
      d[0] = gelu_tanh(a0.x + a1.x + a2.x + a3.x + bb.x); d[1] = gelu_tanh(a0.y + a1.y + a2.y + a3.y + bb.y);
      d[2] = gelu_tanh(a0.z + a1.z + a2.z + a3.z + bb.z); d[3] = gelu_tanh(a0.w + a1.w + a2.w + a3.w + bb.w);
      const float4* wsrc = (const float4*)(p.in[which ? I_CVW2 : I_CKW2] + (size_t)l * 256 * 64);
      float4* wdst = (float4*)(sm + 2048);
#pragma unroll
      for (int q = 0; q < 8; ++q) wdst[q * NTHREADS + tid] = wsrc[q * NTHREADS + tid];
    }
    __syncthreads();
    const int row = row0 + (tid >> 6), d = tid & 63;
    const float* hr = sm + (tid >> 6) * 256;
    const float* w2 = sm + 2048 + d;
    float s = 0.f;
#pragma unroll 8
    for (int j = 0; j < 256; ++j) s += (float)(h16)hr[j] * w2[j * 64];
    const int bkv = row >> 9, n = row & 511;
    if (n == 511) s = 0.f;
    if (which == 0) {
      ((h16*)(ws + OFF_KCMP))[((size_t)bkv * 512 + n) * 64 + d] = (h16)s;
    } else {
      const int blk = n >> 6, key = n & 63;
      const int pos = 32 * (key >> 5) + 8 * ((key >> 2) & 3) + 4 * ((key >> 4) & 1) + (key & 3);
      ((h16*)(ws + OFF_VCMPT))[((size_t)(bkv * 8 + blk) * 64 + d) * 64 + pos] = (h16)s;
    }
    __syncthreads();
  }
  for (int task = (blockIdx.x + gridDim.x - 16 % gridDim.x) % gridDim.x; task < 16; task += gridDim.x) {
    const int b = task >> 3, c = (task & 7) * 32 + (tid & 31), grp = tid >> 5;
    const float* he = (const float*)(ws + OFF_HEND) + ((size_t)b * 256 + grp * 16) * 256 + c;
    const float* ae = (const float*)(ws + OFF_AEND) + ((size_t)b * 256 + grp * 16) * 256 + c;
    float* cy = (float*)(ws + OFF_CARRY) + ((size_t)b * 256 + grp * 16) * 256 + c;
    float hv[16], av[16];
#pragma unroll
    for (int k = 0; k < 16; ++k) { hv[k] = he[k * 256]; av[k] = ae[k * 256]; }
    float ga = 1.f, gh = 0.f;
#pragma unroll
    for (int k = 0; k < 16; ++k) { gh = hv[k] + av[k] * gh; ga *= av[k]; }
    sm[tid] = ga; sm[512 + tid] = gh;
    __syncthreads();
    float carry = 0.f;
    for (int q = 0; q < grp; ++q) carry = sm[512 + q * 32 + (tid & 31)] + sm[q * 32 + (tid & 31)] * carry;
#pragma unroll
    for (int k = 0; k < 16; ++k) {
      cy[k * 256] = carry;
      carry = hv[k] + av[k] * carry;
    }
    __syncthreads();
  }
}

__device__ __forceinline__ void stage8k(const h16* __restrict__ g, h16* l, int tid) {
  const int r = tid >> 3, cl = (tid & 7) ^ ((r >> 1) & 7);
  glds16(g + r * 64 + cl * 8, l + tid * 8);
}
__device__ __forceinline__ h16x8 ldfrag(const h16* l, int row, int chunk) {
  return *(const h16x8*)(l + row * 64 + ((chunk ^ ((row >> 1) & 7)) * 8));
}

template <int MODE>
__device__ __forceinline__ void attn_branch(const h16* __restrict__ Kg, const h16* __restrict__ Vg, int j0, int j1, h16* ring,
                                            const h16x8 (&qf)[2][2], float (&m)[2], float (&l)[2], f32x4 (&o)[2][4],
                                            const int (&tq)[2], const int (&lim)[2], const int (&tlim)[2], const int (&tfl)[2],
                                            const unsigned long long (&mylo)[2], const unsigned long long (&myhi)[2],
                                            const unsigned long long (&ulo)[2], const unsigned long long (&uhi)[2],
                                            const float (&inv)[2], float* impw) {
  int tid = tidx();
  asm volatile("" : "+v"(tid));
  const int lane = tid & 63;
  const int h = lane >> 4, c = lane & 15, qi = c >> 2, g = c & 3;
  constexpr bool PV = MODE != 0;
  constexpr int SS = 3;
  const int n = j1 - j0 + 1;
  if (n <= 0) return;
  const int nss = (n + SS - 1) / SS;
#pragma unroll
  for (int q = 0; q < SS; ++q)
    if (q < n) {
      stage8k(Kg + (size_t)(j0 + q) * 4096, ring + q * 8192, tid);
      if (PV) stage8k(Vg + (size_t)(j0 + q) * 4096, ring + q * 8192 + 4096, tid);
    }
  int sbase = 0;
  for (int ss = 0; ss < nss; ++ss) {
    VMCNT(0);
    __builtin_amdgcn_s_barrier();
    {
      const int sn = SS - sbase;
#pragma unroll
      for (int q = 0; q < SS; ++q) {
        const int jb = SS * (ss + 1) + q;
        if (jb < n) {
          stage8k(Kg + (size_t)(j0 + jb) * 4096, ring + (sn + q) * 8192, tid);
          if (PV) stage8k(Vg + (size_t)(j0 + jb) * 4096, ring + (sn + q) * 8192 + 4096, tid);
        }
      }
    }
#pragma unroll 1
   for (int sub = 0; sub < SS; ++sub) {
    const int it = SS * ss + sub;
    if (it >= n) break;
    const int j = j0 + it;
    const h16* cK = ring + (sbase + sub) * 8192;
    const h16* cV = cK + 4096;
    bool act[2];
#pragma unroll
    for (int mq = 0; mq < 2; ++mq) {
      if (MODE <= 1) act[mq] = j * 64 <= tlim[mq];
      else if (MODE == 2) act[mq] = ((j < 64 ? (ulo[mq] >> j) : (uhi[mq] >> (j - 64))) & 1ull) != 0ull;
      else act[mq] = (j * 64 <= tlim[mq] + 3) && (j * 64 + 63 > tlim[mq] - 512);
    }
    if (act[0] || act[1]) {
      h16x8 pf[2][2];
      h16x8 kf[4][2];
#pragma unroll
      for (int kt = 0; kt < 4; ++kt)
#pragma unroll
        for (int ks = 0; ks < 2; ++ks) kf[kt][ks] = ldfrag(cK, 16 * kt + c, 4 * ks + h);
#pragma unroll
      for (int mq = 0; mq < 2; ++mq)
        if (act[mq]) {
          f32x4 s[1][4];
          {
#pragma unroll
            for (int kt = 0; kt < 4; ++kt) {
              s[0][kt] = (f32x4){0.f, 0.f, 0.f, 0.f};
#pragma unroll
              for (int ks = 0; ks < 2; ++ks) s[0][kt] = __builtin_amdgcn_mfma_f32_16x16x32_f16(kf[kt][ks], qf[mq][ks], s[0][kt], 0, 0, 0);
            }
          }
          const bool selbit = MODE == 2 ? (((j < 64 ? (mylo[mq] >> j) : (myhi[mq] >> (j - 64))) & 1ull) != 0ull) : true;
          bool interior;
          if (MODE <= 1) interior = j * 64 + 63 <= tfl[mq];
          else if (MODE == 2) interior = j * 64 + 63 <= tfl[mq];
          else interior = (j * 64 + 63 <= tfl[mq]) && (j * 64 > tfl[mq] + 3 - 512);
          if (!interior) {
            const int pbase = j * 64 + 4 * h;
#pragma unroll
            for (int kt = 0; kt < 4; ++kt)
#pragma unroll
              for (int i = 0; i < 4; ++i) {
                const int pos = pbase + 16 * kt + i;
                bool v;
                if (MODE <= 1) v = pos <= lim[mq];
                else if (MODE == 2) v = selbit && pos <= tq[mq];
                else v = pos <= tq[mq] && pos > tq[mq] - 512;
                s[0][kt][i] = v ? s[0][kt][i] : -1e30f;
              }
          }
          const bool rowoff = MODE == 2 && interior && !selbit;
          if (MODE == 1) {
#pragma unroll
            for (int kt = 0; kt < 4; ++kt) {
              float ps = 0.f;
#pragma unroll
              for (int i = 0; i < 4; ++i) {
                const float pv = __builtin_amdgcn_exp2f(s[0][kt][i] - m[mq]) * inv[mq];
                s[0][kt][i] = pv;
                ps += pv;
              }
              ps += __shfl_xor(ps, 1);
              ps += __shfl_xor(ps, 2);
              if (g == 0) impw[(4 * mq + qi) * 128 + j * 16 + kt * 4 + h] = ps;
            }
          } else {
            float bm = fmaxf(fmaxf(fmaxf(s[0][0][0], s[0][0][1]), fmaxf(s[0][0][2], s[0][0][3])), fmaxf(fmaxf(s[0][1][0], s[0][1][1]), fmaxf(s[0][1][2], s[0][1][3])));
            bm = fmaxf(bm, fmaxf(fmaxf(fmaxf(s[0][2][0], s[0][2][1]), fmaxf(s[0][2][2], s[0][2][3])), fmaxf(fmaxf(s[0][3][0], s[0][3][1]), fmaxf(s[0][3][2], s[0][3][3]))));
            bm = rowoff ? -1e30f : bm;
            if (__any(bm > m[mq] + 8.f)) {
              bm = fmaxf(bm, __shfl_xor(bm, 16));
              bm = fmaxf(bm, __shfl_xor(bm, 32));
              const float mn = fmaxf(m[mq], bm);
              const float alpha = __builtin_amdgcn_exp2f(m[mq] - mn);
              l[mq] *= alpha;
              m[mq] = mn;
              if (PV) {
#pragma unroll
                for (int mt = 0; mt < 4; ++mt) o[mq][mt] *= alpha;
              }
            }
            const float mref = (m[mq] > -1e29f && !rowoff) ? m[mq] : 1e30f;
            float ps = 0.f;
#pragma unroll
            for (int kt = 0; kt < 4; ++kt)
#pragma unroll
              for (int i = 0; i < 4; ++i) {
                const float pv = __builtin_amdgcn_exp2f(s[0][kt][i] - mref);
                s[0][kt][i] = pv;
                ps += pv;
              }
            l[mq] += ps;
          }
          if (PV) {
#pragma unroll
            for (int s2 = 0; s2 < 2; ++s2)
#pragma unroll
              for (int i = 0; i < 4; ++i) { pf[mq][s2][i] = (h16)s[0][2 * s2][i]; pf[mq][s2][4 + i] = (h16)s[0][2 * s2 + 1][i]; }
          }
        }
      if (PV) {
        h16x8 vf[4][2];
#pragma unroll
        for (int mt = 0; mt < 4; ++mt)
#pragma unroll
          for (int s2 = 0; s2 < 2; ++s2) vf[mt][s2] = ldfrag(cV, 16 * mt + c, 4 * s2 + h);
#pragma unroll
        for (int mq = 0; mq < 2; ++mq)
          if (act[mq]) {
#pragma unroll
            for (int s2 = 0; s2 < 2; ++s2) {
#pragma unroll
              for (int mt = 0; mt < 4; ++mt) o[mq][mt] = __builtin_amdgcn_mfma_f32_16x16x32_f16(vf[mt][s2], pf[mq][s2], o[mq][mt], 0, 0, 0);
            }
          }
      }
    }
   }
    sbase = SS - sbase;
  }
  __builtin_amdgcn_s_barrier();
}

__device__ __forceinline__ void attn_item(const Params& p, int l, int item, float* sm) {
  unsigned char* ws = p.ws;
  int tid = tidx();
  asm volatile("" : "+v"(tid));
  const int lane = tid & 63, wave = tid >> 6;
  const int combo = item & 3, qt = item >> 2;
  const int b = combo >> 1, kv = combo & 1;
  const int t0 = qt * 64, tw0 = t0 + 8 * wave;
  const int h = lane >> 4, c = lane & 15, qi = c >> 2, g = c & 3;
  const int head = kv * 4 + g, bkv = b * 2 + kv;
  h16* ring = (h16*)sm;
  float* impw = sm + 24576 + wave * 1024;
  unsigned long long* selm = (unsigned long long*)(sm + 24576 + 8192) + wave * 16;

  h16x8 qf[2][2];
  int tq[2];
#pragma unroll
  for (int mq = 0; mq < 2; ++mq) {
    tq[mq] = tw0 + 4 * mq + qi;
    const h16* qrow = (const h16*)(ws + OFF_Q16) + (size_t)(b * S + tq[mq]) * 512 + head * 64;
    qf[mq][0] = *(const h16x8*)(qrow + 8 * h);
    qf[mq][1] = *(const h16x8*)(qrow + 32 + 8 * h);
  }
  for (int i = lane; i < 1024; i += 64) impw[i] = 0.f;

  h16x4 ofin[2][4];
  float m[2], ll[2], inv[2];
  f32x4 o[2][4];
  const unsigned long long z2[2] = {0ull, 0ull};
  {
    int lim[2], tlim[2], tflc[2];
#pragma unroll
    for (int mq = 0; mq < 2; ++mq) {
      lim[mq] = tq[mq] >= 31 ? ((tq[mq] - 31) >> 4) : -1;
      const int tl = tw0 + 4 * mq + 3;
      tlim[mq] = tl >= 31 ? ((tl - 31) >> 4) : -1;
      const int tf0 = tw0 + 4 * mq;
      tflc[mq] = tf0 >= 31 ? ((tf0 - 31) >> 4) : -1;
      m[mq] = -1e30f; ll[mq] = 0.f; inv[mq] = 0.f;
#pragma unroll
      for (int mt = 0; mt < 4; ++mt) o[mq][mt] = (f32x4){0.f, 0.f, 0.f, 0.f};
    }
    const int nl = (t0 + 63 - 31) >> 4;
    const int jl = nl >> 6;
    const h16* Kc = (const h16*)(ws + OFF_KCMP) + (size_t)bkv * 512 * 64;
    const h16* Vc = (const h16*)(ws + OFF_VCMPT) + (size_t)bkv * 8 * 4096;
    attn_branch<0>(Kc, Vc, 0, jl, ring, qf, m, ll, o, tq, lim, tlim, tflc, z2, z2, z2, z2, inv, impw);
#pragma unroll
    for (int mq = 0; mq < 2; ++mq) {
      float lt = ll[mq];
      lt += __shfl_xor(lt, 16);
      lt += __shfl_xor(lt, 32);
      inv[mq] = lt > 0.f ? 1.f / lt : 0.f;
    }
    attn_branch<1>(Kc, Vc, 0, jl, ring, qf, m, ll, o, tq, lim, tlim, tflc, z2, z2, z2, z2, inv, impw);
    const float* gt0 = (const float*)(ws + OFF_GATES) + (size_t)(b * S) * 24 + head * 3;
#pragma unroll
    for (int mq = 0; mq < 2; ++mq) {
      const float g0 = gt0[(size_t)tq[mq] * 24] * ASCALE;
#pragma unroll
      for (int mt = 0; mt < 4; ++mt) ofin[mq][mt] = pack4(o[mq][mt][0] * g0, o[mq][mt][1] * g0, o[mq][mt][2] * g0, o[mq][mt][3] * g0);
    }
  }
  for (int q = 0; q < 8; ++q) {
    const int t = tw0 + q, own = t >> 6;
    const float* ir = impw + q * 128;
    const int ja = lane, jb = lane + 64;
    unsigned k0 = 0u, k1 = 0u;
    if (ja <= own) k0 = (ja == 0 || ja == own) ? (0xFFFFFF80u | (unsigned)(127 - ja)) : (((__float_as_uint(ir[ja]) & ~127u) | (unsigned)(127 - ja)) + 1u);
    if (jb <= own) k1 = (jb == own) ? (0xFFFFFF80u | (unsigned)(127 - jb)) : (((__float_as_uint(ir[jb]) & ~127u) | (unsigned)(127 - jb)) + 1u);
    unsigned thr = 0u;
    for (int bit = 31; bit >= 0; --bit) {
      const unsigned cand = thr | (1u << bit);
      const int cnt = __popcll(__ballot(k0 >= cand)) + __popcll(__ballot(k1 >= cand));
      if (cnt >= 16) thr = cand;
    }
    const unsigned long long mlo = __ballot(k0 >= thr && ja <= own);
    const unsigned long long mhi = __ballot(k1 >= thr && jb <= own);
    if (lane == 0) { selm[q * 2] = mlo; selm[q * 2 + 1] = mhi; }
  }
  unsigned long long mylo[2], myhi[2], ulo[2], uhi[2];
#pragma unroll
  for (int mq = 0; mq < 2; ++mq) {
    mylo[mq] = selm[(4 * mq + qi) * 2];
    myhi[mq] = selm[(4 * mq + qi) * 2 + 1];
    unsigned long long a = selm[(4 * mq) * 2] | selm[(4 * mq + 1) * 2] | selm[(4 * mq + 2) * 2] | selm[(4 * mq + 3) * 2];
    unsigned long long bb = selm[(4 * mq) * 2 + 1] | selm[(4 * mq + 1) * 2 + 1] | selm[(4 * mq + 2) * 2 + 1] | selm[(4 * mq + 3) * 2 + 1];
    ulo[mq] = (unsigned long long)__builtin_amdgcn_readfirstlane((unsigned)a) | ((unsigned long long)__builtin_amdgcn_readfirstlane((unsigned)(a >> 32)) << 32);
    uhi[mq] = (unsigned long long)__builtin_amdgcn_readfirstlane((unsigned)bb) | ((unsigned long long)__builtin_amdgcn_readfirstlane((unsigned)(bb >> 32)) << 32);
  }
  const float* gtb = (const float*)(ws + OFF_GATES) + (size_t)(b * S) * 24 + head * 3;
  {
    int tl0[2] = {0, 0};
    const int tfs[2] = {tw0, tw0 + 4};
#pragma unroll
    for (int mq = 0; mq < 2; ++mq) {
      m[mq] = -1e30f; ll[mq] = 0.f;
#pragma unroll
      for (int mt = 0; mt < 4; ++mt) o[mq][mt] = (f32x4){0.f, 0.f, 0.f, 0.f};
    }
    attn_branch<2>((const h16*)(ws + OFF_KS) + (size_t)bkv * S * 64, (const h16*)(ws + OFF_VST) + (size_t)bkv * 128 * 4096, 0, (t0 + 63) >> 6, ring, qf, m, ll, o,
                   tq, tl0, tl0, tfs, mylo, myhi, ulo, uhi, inv, impw);
#pragma unroll
    for (int mq = 0; mq < 2; ++mq) {
      float lt = ll[mq];
      lt += __shfl_xor(lt, 16);
      lt += __shfl_xor(lt, 32);
      const float sc = lt > 0.f ? gtb[(size_t)tq[mq] * 24 + 1] * ASCALE / lt : 0.f;
#pragma unroll
      for (int mt = 0; mt < 4; ++mt)
        ofin[mq][mt] = pack4((float)ofin[mq][mt][0] + o[mq][mt][0] * sc, (float)ofin[mq][mt][1] + o[mq][mt][1] * sc, (float)ofin[mq][mt][2] + o[mq][mt][2] * sc,
                             (float)ofin[mq][mt][3] + o[mq][mt][3] * sc);
    }
  }
  {
    int tl0[2] = {0, 0}, tf[2];
#pragma unroll
    for (int mq = 0; mq < 2; ++mq) {
      tf[mq] = tw0 + 4 * mq;
      m[mq] = -1e30f; ll[mq] = 0.f;
#pragma unroll
      for (int mt = 0; mt < 4; ++mt) o[mq][mt] = (f32x4){0.f, 0.f, 0.f, 0.f};
    }
    const int jlo = t0 >= 511 ? ((t0 - 511) >> 6) : 0;
    attn_branch<3>((const h16*)(ws + OFF_KW) + (size_t)bkv * S * 64, (const h16*)(ws + OFF_VWT) + (size_t)bkv * 128 * 4096, jlo, (t0 + 63) >> 6, ring, qf, m, ll, o,
                   tq, tl0, tf, tf, z2, z2, z2, z2, inv, impw);
#pragma unroll
    for (int mq = 0; mq < 2; ++mq) {
      float lt = ll[mq];
      lt += __shfl_xor(lt, 16);
      lt += __shfl_xor(lt, 32);
      const float sc = lt > 0.f ? gtb[(size_t)tq[mq] * 24 + 2] * ASCALE / lt : 0.f;
#pragma unroll
      for (int mt = 0; mt < 4; ++mt)
        ofin[mq][mt] = pack4((float)ofin[mq][mt][0] + o[mq][mt][0] * sc, (float)ofin[mq][mt][1] + o[mq][mt][1] * sc, (float)ofin[mq][mt][2] + o[mq][mt][2] * sc,
                             (float)ofin[mq][mt][3] + o[mq][mt][3] * sc);
    }
  }
  {
    h16* yc = (h16*)(ws + OFF_H16);
    const float* gn = p.in[I_ONG] + l * 1024 + 256 + head * 64;
    float* ssq = (float*)(ws + OFF_SSQ);
#pragma unroll
    for (int mq = 0; mq < 2; ++mq) {
      float sq = 0.f;
      h16* yr = yc + (size_t)(b * S + tq[mq]) * D + head * 64;
#pragma unroll
      for (int mt = 0; mt < 4; ++mt) {
        const float v[4] = {(float)ofin[mq][mt][0], (float)ofin[mq][mt][1], (float)ofin[mq][mt][2], (float)ofin[mq][mt][3]};
        sq += v[0] * v[0] + v[1] * v[1] + v[2] * v[2] + v[3] * v[3];
        const float4 gg = *(const float4*)(gn + 16 * mt + 4 * h);
        *(h16x4*)(yr + 16 * mt + 4 * h) = pack4(v[0] * gg.x, v[1] * gg.y, v[2] * gg.z, v[3] * gg.w);
      }
      sq += __shfl_xor(sq, 16);
      sq += __shfl_xor(sq, 32);
      sq += __shfl_xor(sq, 1);
      sq += __shfl_xor(sq, 2);
      if (h == 0 && g == 0) ssq[(size_t)(b * S + tq[mq]) * 2 + kv] = sq * (1.f / (ASCALE * ASCALE));
    }
  }
}

__device__ __forceinline__ void lrufix_item(const Params& p, int l, int item) {
  unsigned char* ws = p.ws;
  const int lane = tidx() & 63, wave = tidx() >> 6;
  const int b = item >> 7, ck = item & 127;
  const h16* P = (const h16*)(ws + OFF_P16);
  const float4 cy = *(const float4*)((const float*)(ws + OFF_CARRY) + (size_t)(b * 256 + ck * 2 + (wave >> 2)) * 256 + lane * 4);
  const float4 gn = *(const float4*)(p.in[I_ONG] + l * 1024 + lane * 4);
  h16* yc = (h16*)(ws + OFF_H16);
  float4 hl[8], al[8];
  h16x4 gl[8];
#pragma unroll
  for (int q = 0; q < 8; ++q) {
    const size_t row = (size_t)(b * S + ck * 64 + wave * 8 + q);
    hl[q] = *(const float4*)((const float*)(ws + OFF_LRUH) + row * 256 + lane * 4);
    al[q] = *(const float4*)((const float*)(ws + OFF_LRUA) + row * 256 + lane * 4);
    gl[q] = *(const h16x4*)(P + row * NIN + C_GL + lane * 4);
  }
#pragma unroll
  for (int q = 0; q < 8; ++q) {
    const size_t row = (size_t)(b * S + ck * 64 + wave * 8 + q);
    const float y0 = (hl[q].x + al[q].x * cy.x) * gelu_tanh((float)gl[q][0]);
    const float y1 = (hl[q].y + al[q].y * cy.y) * gelu_tanh((float)gl[q][1]);
    const float y2 = (hl[q].z + al[q].z * cy.z) * gelu_tanh((float)gl[q][2]);
    const float y3 = (hl[q].w + al[q].w * cy.w) * gelu_tanh((float)gl[q][3]);
    const float rstd = rsqrtf(wsum(y0 * y0 + y1 * y1 + y2 * y2 + y3 * y3) * (1.f / 256.f) + EPS);
    *(h16x4*)(yc + row * D + 512 + lane * 4) = pack4(y0 * rstd * gn.x, y1 * rstd * gn.y, y2 * rstd * gn.z, y3 * rstd * gn.w);
  }
}

__device__ __forceinline__ void phase_attn(const Params& p, int l, float* sm) {
  for (int it = blockIdx.x; it < 256; it += gridDim.x) {
#pragma unroll 1
    for (int rep = 0; rep < 2; ++rep) attn_item(p, l, rep ? (127 - (it >> 2)) * 4 + (it & 3) : it, sm);
  }
  for (int it = blockIdx.x; it < 256; it += gridDim.x) lrufix_item(p, l, it);
}

__device__ __forceinline__ void phase_outproj(const Params& p, int l, h16* sm) {
  unsigned char* ws = p.ws;
  const h16* A = (const h16*)(ws + OFF_H16);
  const h16* W = (const h16*)(ws + OFF_WOUT);
  const float* mod = (const float*)(ws + OFF_MOD);
  float* xa = (float*)(ws + OFF_XA);
  const float* xin = l == 0 ? p.in[I_X] : (const float*)xa;
  const TileIter ti = xcd_tiles(64 * 4);
  for (int t = ti.cur; t < ti.end; t += ti.step) {
    const int mt = t >> 2, nt = t & 3;
    f32x4 acc[8][4];
    const h16* Ab = A + (size_t)mt * 256 * D;
    {
      float* sct = (float*)((unsigned char*)sm + SCHED_OFF - 1024);
      const int tq_ = tidx();
      if (tq_ < 256) {
        const float2 q2 = *(const float2*)((const float*)(ws + OFF_SSQ) + (size_t)(mt * 256 + tq_) * 2);
        sct[tq_] = rsqrtf((q2.x + q2.y) * (1.f / 512.f) + EPS) * (1.f / ASCALE);
      }
    }
    gemm_mainloop<256>(acc, [&](int r) { return Ab + (size_t)r * D; }, W + (size_t)nt * 256 * D, D, 8, sm);
    const int tid_e = tidx(), lane = tid_e & 63, wave = tid_e >> 6, wr = wave >> 2, wc = wave & 3, fr = lane & 15, fq = lane >> 4;
    {
      const float* sct = (const float*)((const unsigned char*)sm + SCHED_OFF - 1024) + wr * 128 + fr;
#pragma unroll
      for (int m = 0; m < 8; ++m) {
        const float sc = sct[m * 16];
#pragma unroll
        for (int n = 0; n < 4; ++n) acc[m][n] *= sc;
      }
    }
    gemm_mainloop<256>(acc, [&](int r) { return Ab + (size_t)r * D + 512; }, W + (size_t)nt * 256 * D + 512, D, 8, sm, false);
    {
      float* stf = (float*)sm;
      constexpr int LDF = 260;
#pragma unroll 1
      for (int pass = 0; pass < 2; ++pass) {
        if (wr == pass) {
#pragma unroll
          for (int m = 0; m < 8; ++m)
#pragma unroll
            for (int n = 0; n < 4; ++n) *(f32x4*)(stf + (m * 16 + fr) * LDF + wc * 64 + n * 16 + 4 * fq) = acc[m][n];
        }
        __syncthreads();
#pragma unroll 4
        for (int i = 0; i < 16; ++i) {
          const int idx = i * NTHREADS + tid_e;
          const int r = idx >> 6, c4 = (idx & 63) * 4;
          const int row = mt * 256 + pass * 128 + r, col = nt * 256 + c4;
          const int b = row >> 13;
          const f32x4 a = *(const f32x4*)(stf + r * LDF + c4);
          const float4 g1 = *(const float4*)(mod + (size_t)(l * 2 + b) * 6144 + 2048 + col);
          const float4 xv = *(const float4*)(xin + (size_t)row * D + col);
          float4 o;
          o.x = xv.x + g1.x * a[0]; o.y = xv.y + g1.y * a[1]; o.z = xv.z + g1.z * a[2]; o.w = xv.w + g1.w * a[3];
          *(float4*)(xa + (size_t)row * D + col) = o;
        }
        __syncthreads();
      }
    }
  }
}

__device__ __forceinline__ void phase_router(const Params& p, int l, int* smi) {
  unsigned char* ws = p.ws;
  const int tid = tidx(), lane = tid & 63, wave = tid >> 6;
  const float* mod = (const float*)(ws + OFF_MOD);
  const float* xa = (const float*)(ws + OFF_XA);
  h16* hout = (h16*)(ws + OFF_H16);
  unsigned* cnt = (unsigned*)(ws + OFF_CTL) + 64 + l * 16;
  int* list = (int*)(ws + OFF_LIST);
  float* wpair = (float*)(ws + OFF_WPAIR);
  const float* rgb = p.in[I_RGB] + l * 4;
  int* cntl = smi;
  int* basel = smi + 16;
  int* tok = smi + 32;
  float* wl = (float*)smi + 256;
  {
    const float4* s0 = (const float4*)(p.in[I_RGW] + (size_t)l * 1024 * 4);
    const float4* s1 = (const float4*)(p.in[I_REW] + (size_t)l * 4 * 1024 * 4);
    float4* d = (float4*)wl;
#pragma unroll
    for (int q = 0; q < 2; ++q) d[q * NTHREADS + tid] = s0[q * NTHREADS + tid];
#pragma unroll
    for (int q = 0; q < 8; ++q) d[1024 + q * NTHREADS + tid] = s1[q * NTHREADS + tid];
  }
  const float* rgw = wl;
  for (int chunk = blockIdx.x; chunk < T / 64; chunk += gridDim.x) {
    if (tid < 16) cntl[tid] = 0;
    __syncthreads();
    float4 xn[4];
#pragma unroll
    for (int i = 0; i < 4; ++i) xn[i] = *(const float4*)(xa + (size_t)(chunk * 64 + wave) * D + lane * 4 + 256 * i);
    for (int ti = wave; ti < 64; ti += NW) {
      const int row = chunk * 64 + ti;
      const int b = row >> 13;
      float4 x[4];
      float ss = 0.f;
#pragma unroll
      for (int i = 0; i < 4; ++i) x[i] = xn[i];
      if (ti + NW < 64) {
#pragma unroll
        for (int i = 0; i < 4; ++i) xn[i] = *(const float4*)(xa + (size_t)(row + NW) * D + lane * 4 + 256 * i);
      }
#pragma unroll
      for (int i = 0; i < 4; ++i) ss += x[i].x * x[i].x + x[i].y * x[i].y + x[i].z * x[i].z + x[i].w * x[i].w;
      ss = wsum(ss);
      const float rstd = rsqrtf(ss * (1.f / D) + EPS);
      float lg0 = 0.f, lg1 = 0.f, lg2 = 0.f, lg3 = 0.f;
#pragma unroll
      for (int i = 0; i < 4; ++i) {
        const int col = lane * 4 + 256 * i;
        const float4 g = *(const float4*)(p.in[I_N2G] + l * D + col);
        const float4 sh = *(const float4*)(mod + (size_t)(l * 2 + b) * 6144 + 3072 + col);
        const float4 sc = *(const float4*)(mod + (size_t)(l * 2 + b) * 6144 + 4096 + col);
        x[i].x = x[i].x * rstd * g.x * (1.f + sc.x) + sh.x;
        x[i].y = x[i].y * rstd * g.y * (1.f + sc.y) + sh.y;
        x[i].z = x[i].z * rstd * g.z * (1.f + sc.z) + sh.z;
        x[i].w = x[i].w * rstd * g.w * (1.f + sc.w) + sh.w;
        *(h16x4*)(hout + (size_t)row * D + col) = pack4(x[i].x, x[i].y, x[i].z, x[i].w);
        const float4 w0 = *(const float4*)(rgw + (size_t)(col + 0) * 4), w1 = *(const float4*)(rgw + (size_t)(col + 1) * 4);
        const float4 w2 = *(const float4*)(rgw + (size_t)(col + 2) * 4), w3 = *(const float4*)(rgw + (size_t)(col + 3) * 4);
        lg0 += x[i].x * w0.x + x[i].y * w1.x + x[i].z * w2.x + x[i].w * w3.x;
        lg1 += x[i].x * w0.y + x[i].y * w1.y + x[i].z * w2.y + x[i].w * w3.y;
        lg2 += x[i].x * w0.z + x[i].y * w1.z + x[i].z * w2.z + x[i].w * w3.z;
        lg3 += x[i].x * w0.w + x[i].y * w1.w + x[i].z * w2.w + x[i].w * w3.w;
      }
      lg0 = wsum(lg0) + rgb[0]; lg1 = wsum(lg1) + rgb[1]; lg2 = wsum(lg2) + rgb[2]; lg3 = wsum(lg3) + rgb[3];
      int gs = 0; float gm = lg0;
      if (lg1 > gm) { gm = lg1; gs = 1; }
      if (lg2 > gm) { gm = lg2; gs = 2; }
      if (lg3 > gm) { gm = lg3; gs = 3; }
      const float pg = 1.f / (__expf(lg0 - gm) + __expf(lg1 - gm) + __expf(lg2 - gm) + __expf(lg3 - gm));
      const float* rew = wl + 4096 + gs * 4096;
      const float* reb = p.in[I_REB] + (l * 4 + gs) * 4;
      float e0 = 0.f, e1 = 0.f, e2 = 0.f, e3 = 0.f;
#pragma unroll
      for (int i = 0; i < 4; ++i) {
        const int col = lane * 4 + 256 * i;
        const float4 w0 = *(const float4*)(rew + (size_t)(col + 0) * 4), w1 = *(const float4*)(rew + (size_t)(col + 1) * 4);
        const float4 w2 = *(const float4*)(rew + (size_t)(col + 2) * 4), w3 = *(const float4*)(rew + (size_t)(col + 3) * 4);
        e0 += x[i].x * w0.x + x[i].y * w1.x + x[i].z * w2.x + x[i].w * w3.x;
        e1 += x[i].x * w0.y + x[i].y * w1.y + x[i].z * w2.y + x[i].w * w3.y;
        e2 += x[i].x * w0.z + x[i].y * w1.z + x[i].z * w2.z + x[i].w * w3.z;
        e3 += x[i].x * w0.w + x[i].y * w1.w + x[i].z * w2.w + x[i].w * w3.w;
      }
      float le[4];
      le[0] = wsum(e0) + reb[0]; le[1] = wsum(e1) + reb[1]; le[2] = wsum(e2) + reb[2]; le[3] = wsum(e3) + reb[3];
      int i0 = 0; float v0 = le[0];
      if (le[1] > v0) { v0 = le[1]; i0 = 1; }
      if (le[2] > v0) { v0 = le[2]; i0 = 2; }
      if (le[3] > v0) { v0 = le[3]; i0 = 3; }
      int i1 = -1; float v1 = -3.0e38f;
#pragma unroll
      for (int j = 0; j < 4; ++j) {
        const float vj = (j == 0 ? le[0] : j == 1 ? le[1] : j == 2 ? le[2] : le[3]);
        if (j != i0 && vj > v1) { v1 = vj; i1 = j; }
      }
      const float p0 = 1.f / (1.f + __expf(v1 - v0));
      const float p1 = 1.f - p0;
      if (lane == 0) {
        const int ea = gs * 4 + i0, eb = gs * 4 + i1;
        const int ra = atomicAdd(&cntl[ea], 1);
        const int rb = atomicAdd(&cntl[eb], 1);
        tok[ti * 2] = ea | (ra << 8);
        tok[ti * 2 + 1] = eb | (rb << 8);
        wpair[row * 2] = pg * p0;
        wpair[row * 2 + 1] = pg * p1;
      }
    }
    __syncthreads();
    if (tid < 16) basel[tid] = (int)atomicAdd(&cnt[tid], (unsigned)cntl[tid]);
    __syncthreads();
    if (tid < 128) {
      const int v = tok[tid], e = v & 255, r = v >> 8;
      list[(size_t)e * 16384 + basel[e] + r] = (chunk * 64 + (tid >> 1)) * 2 + (tid & 1);
    }
    __syncthreads();
  }
}

__device__ __forceinline__ void moe_sched(const Params& p, int l, int* sl) {
  const int tid = tidx();
  if (tid < 16) {
    const unsigned* cnt = (const unsigned*)(p.ws + OFF_CTL) + 64 + l * 16;
    sl[tid] = (int)__hip_atomic_load(&cnt[tid], __ATOMIC_RELAXED, __HIP_MEMORY_SCOPE_AGENT);
  }
  __syncthreads();
  if (tid == 0) {
    int to = 0, ro = 0;
    sl[16] = 0; sl[33] = 0;
    for (int e = 0; e < 16; ++e) {
      const int c = sl[e];
      to += (c + 255) >> 8; ro += c;
      sl[17 + e] = to; sl[34 + e] = ro;
    }
  }
  __syncthreads();
}
__device__ __forceinline__ void moe_tile(const int* sl, int t, int& e, int& nt, int& mt, int& cnt_e, int& roff_e) {
  int ee = 0;
  for (int k = 0; k < 15; ++k) ee += (t >= sl[17 + k] * 4) ? 1 : 0;
  ee = __builtin_amdgcn_readfirstlane(ee);
  const int t0 = __builtin_amdgcn_readfirstlane(sl[16 + ee]), t1 = __builtin_amdgcn_readfirstlane(sl[17 + ee]);
  const int nte = t1 - t0, rem = t - t0 * 4;
  e = ee; nt = rem / nte; mt = rem % nte;
  cnt_e = __builtin_amdgcn_readfirstlane(sl[ee]);
  roff_e = __builtin_amdgcn_readfirstlane(sl[33 + ee]);
}

template <int BN>
__device__ __forceinline__ void moe1_tile(const Params& p, int l, h16* sm, const int* sl, int t, int half) {
  unsigned char* ws = p.ws;
  const h16* H = (const h16*)(ws + OFF_H16);
  h16* hid = (h16*)(ws + OFF_HID);
  int e, nt, mt, cnt_e, roff_e;
  moe_tile(sl, t, e, nt, mt, cnt_e, roff_e);
  const int* le = (const int*)(ws + OFF_LIST) + (size_t)e * 16384;
  f32x4 acc[8][BN / 64];
  gemm_mainloop<BN>(acc, [&](int r) { int so = mt * 256 + r; so = so < cnt_e ? so : 0; return H + (size_t)(le[so] >> 1) * D; },
                    (const h16*)wgu_buf(p, l) + ((size_t)e * 1024 + nt * 256 + half * 128) * 1024, 1024, 16, sm);
  const int tid_e = tidx(), lane = tid_e & 63, wave = tid_e >> 6, wr = wave >> 2, wc = wave & 3, fr = lane & 15, fq = lane >> 4;
  constexpr int NC = BN / 2, LDR = NC + 8;
#pragma unroll
  for (int m = 0; m < 8; ++m)
#pragma unroll
    for (int n2 = 0; n2 < BN / 128; ++n2) {
      const f32x4 gt = acc[m][2 * n2], up = acc[m][2 * n2 + 1];
      *(h16x4*)(sm + (wr * 128 + m * 16 + fr) * LDR + wc * (BN / 8) + n2 * 16 + 4 * fq) =
          pack4(silu_f(gt[0]) * up[0], silu_f(gt[1]) * up[1], silu_f(gt[2]) * up[2], silu_f(gt[3]) * up[3]);
    }
  __syncthreads();
  constexpr int CH = NC / 8;
#pragma unroll
  for (int i = 0; i < CH / 2; ++i) {
    const int idx = i * NTHREADS + tid_e;
    const int r = idx / CH, c8 = idx % CH;
    const int so = mt * 256 + r;
    if (so < cnt_e) *(h16x8*)(hid + (size_t)(roff_e + so) * 512 + nt * 128 + half * 64 + c8 * 8) = *(const h16x8*)(sm + r * LDR + c8 * 8);
  }
  __syncthreads();
}
__device__ __forceinline__ void phase_moe1(const Params& p, int l, h16* sm) {
  int* sl = (int*)((unsigned char*)sm + SCHED_OFF);
  moe_sched(p, l, sl);
  const int total = __builtin_amdgcn_readfirstlane(sl[32]) * 4;
  const TileSched ts = xcd_sched(total);
  for (int t = ts.cur; t < ts.end; t += ts.step) moe1_tile<256>(p, l, sm, sl, t, 0);
  if (ts.tail_tile >= 0) {
    if (ts.tail_half < 0) moe1_tile<256>(p, l, sm, sl, ts.tail_tile, 0);
    else moe1_tile<128>(p, l, sm, sl, ts.tail_tile, ts.tail_half);
  }
  if (l == 0) conv_share(p, 1, 0, NT_CONV / 2, ts.nbusy, (float*)sm);
}

template <int BN>
__device__ __forceinline__ void moe2_tile(const Params& p, int l, h16* sm, const int* sl, int t, int half) {
  unsigned char* ws = p.ws;
  const float* wpair = (const float*)(ws + OFF_WPAIR);
  h16* yp = (h16*)(ws + OFF_YPAIR);
  int e, nt, mt, cnt_e, roff_e;
  moe_tile(sl, t, e, nt, mt, cnt_e, roff_e);
  const int* le = (const int*)(ws + OFF_LIST) + (size_t)e * 16384;
  const h16* Ab = (const h16*)(ws + OFF_HID) + (size_t)(roff_e + mt * 256) * 512;
  f32x4 acc[8][BN / 64];
  gemm_mainloop<BN>(acc, [&](int r) { return Ab + (size_t)r * 512; }, (const h16*)wdn_buf(p, l) + ((size_t)e * 1024 + nt * 256 + half * 128) * 512, 512, 8, sm);
  const int tid_e = tidx(), lane = tid_e & 63, wave = tid_e >> 6, wr = wave >> 2, wc = wave & 3, fr = lane & 15, fq = lane >> 4;
  constexpr int LDR = BN + 8;
#pragma unroll
  for (int m = 0; m < 8; ++m) {
    const int so = mt * 256 + wr * 128 + m * 16 + fr;
    const float w = so < cnt_e ? wpair[le[so]] : 0.f;
#pragma unroll
    for (int n = 0; n < BN / 64; ++n)
      *(h16x4*)(sm + (wr * 128 + m * 16 + fr) * LDR + wc * (BN / 4) + n * 16 + 4 * fq) = pack4(acc[m][n][0] * w, acc[m][n][1] * w, acc[m][n][2] * w, acc[m][n][3] * w);
  }
  __syncthreads();
  constexpr int CH = BN / 8;
#pragma unroll
  for (int i = 0; i < CH / 2; ++i) {
    const int idx = i * NTHREADS + tid_e;
    const int r = idx / CH, c8 = idx % CH;
    const int so = mt * 256 + r;
    if (so < cnt_e) *(h16x8*)(yp + (size_t)le[so] * D + nt * 256 + half * 128 + c8 * 8) = *(const h16x8*)(sm + r * LDR + c8 * 8);
  }
  __syncthreads();
}
__device__ __forceinline__ void phase_moe2(const Params& p, int l, h16* sm) {
  int* sl = (int*)((unsigned char*)sm + SCHED_OFF);
  moe_sched(p, l, sl);
  const int total = __builtin_amdgcn_readfirstlane(sl[32]) * 4;
  const TileSched ts = xcd_sched(total);
  for (int t = ts.cur; t < ts.end; t += ts.step) moe2_tile<256>(p, l, sm, sl, t, 0);
  if (ts.tail_tile >= 0) {
    if (ts.tail_half < 0) moe2_tile<256>(p, l, sm, sl, ts.tail_tile, 0);
    else moe2_tile<128>(p, l, sm, sl, ts.tail_tile, ts.tail_half);
  }
  if (l == 0) conv_share(p, 1, NT_CONV / 2, NT_CONV, ts.nbusy, (float*)sm);
}

#define XB_TMO      128
#define XB_XCNT(j)  (256  + 64 * (j))
#define XB_XSUB(j)  (1280 + 64 * (j))
#define XB_XGEN(j)  (2304 + 64 * (j))
#define XB_TOP      3328
#define XB_TOPGEN   3392
#define XCD_BAR_WORDS 3456
#define XB_SPIN_CAP (1u << 20)
__device__ __forceinline__ unsigned xb_ld(unsigned* p) { return __hip_atomic_load(p, __ATOMIC_RELAXED, __HIP_MEMORY_SCOPE_AGENT); }
__device__ __forceinline__ unsigned xb_add(unsigned* p, unsigned v) { return __hip_atomic_fetch_add(p, v, __ATOMIC_RELAXED, __HIP_MEMORY_SCOPE_AGENT); }
__device__ __forceinline__ unsigned xb_xcc_id() { return (unsigned)__builtin_amdgcn_s_getreg((3 << 11) | 20) & 0xFu; }
#define XB_SPIN(cond, bar) do { unsigned _sp = 0; while (cond) { __builtin_amdgcn_s_sleep(1); \
    if ((++_sp & 255u) == 0u) { if (xb_ld(&(bar)[XB_TMO])) break; if (_sp > XB_SPIN_CAP) { atomicAdd(&(bar)[XB_TMO], 1u); break; } } } } while (0)
struct XBar { unsigned* bar; unsigned x; volatile unsigned* st; };
__device__ __forceinline__ void xbar_post(XBar& b, unsigned* bar, volatile unsigned* st) {
  b.bar = bar; b.x = xb_xcc_id(); b.st = st;
  if (tidx() == 0) { st[0] = 0u; st[1] = 0u; (void)xb_add(&bar[XB_XCNT(b.x)], 1u); }
}
__device__ __forceinline__ void xbar_census(unsigned* bar, unsigned x, unsigned& nloc, unsigned& nx) {
  const unsigned G = gridDim.x;
  unsigned sum, cnt, mine, sp = 0u;
  for (;;) {
    sum = 0u; cnt = 0u; mine = 0u;
#pragma unroll
    for (unsigned j = 0; j < 16; ++j) { const unsigned c = xb_ld(&bar[XB_XCNT(j)]); sum += c; cnt += (c > 0u) ? 1u : 0u; mine = (j == x) ? c : mine; }
    if (sum == G) break;
    __builtin_amdgcn_s_sleep(1);
    if ((++sp & 255u) == 0u) { if (xb_ld(&bar[XB_TMO])) break; if (sp > XB_SPIN_CAP) { atomicAdd(&bar[XB_TMO], 1u); break; } }
  }
  nloc = mine > 0u ? mine : 1u; nx = cnt > 0u ? cnt : 1u;
}
__device__ __forceinline__ void xbar_sync(XBar& b) {
  asm volatile("s_waitcnt vmcnt(0)" ::: "memory");
  __syncthreads();
  if (tidx() == 0) {
    unsigned* bar = b.bar;
    __builtin_amdgcn_s_waitcnt(0);
    unsigned nloc = b.st[0], nx = b.st[1];
    if (nloc == 0u) { xbar_census(bar, b.x, nloc, nx); b.st[0] = nloc; b.st[1] = nx; }
    const unsigned old = xb_add(&bar[XB_XSUB(b.x)], 1u);
    const unsigned gen = old / nloc;
    if (old + 1u == (gen + 1u) * nloc) {
      __builtin_amdgcn_fence(__ATOMIC_RELEASE, "agent");
      asm volatile("s_waitcnt vmcnt(0)" ::: "memory");
      const unsigned og = xb_add(&bar[XB_TOP], 1u);
      const unsigned tg = og / nx;
      if (og + 1u == (tg + 1u) * nx) xb_add(&bar[XB_TOPGEN], 1u);
      else XB_SPIN(xb_ld(&bar[XB_TOPGEN]) == tg, bar);
      __builtin_amdgcn_fence(__ATOMIC_ACQUIRE, "agent");
      xb_add(&bar[XB_XGEN(b.x)], 1u);
      asm volatile("s_waitcnt vmcnt(0)" ::: "memory");
    } else {
      XB_SPIN(xb_ld(&bar[XB_XGEN(b.x)]) == gen, bar);
      __builtin_amdgcn_fence(__ATOMIC_ACQUIRE, "agent");
      asm volatile("s_waitcnt vmcnt(0)" ::: "memory");
    }
  }
  __syncthreads();
}

constexpr int NSTEPS = 20;
#define STEP(k, body) do { if (s_lo <= (k) && (k) < s_hi) { body; if ((k) + 1 < s_hi) { xbar_sync(xb); } \
    if (PROBE_MASK != 0u) { unsigned long long now_ = __builtin_amdgcn_s_memrealtime(); \
      if ((PROBE_MASK >> (k)) & 1u) { const unsigned long long w_ = (now_ - pt_prev) * PROBE_AMP; \
        while (__builtin_amdgcn_s_memrealtime() - now_ < w_) __builtin_amdgcn_s_sleep(8); now_ = __builtin_amdgcn_s_memrealtime(); } \
      pt_prev = now_; } } } while (0)
#define LAYER_STEPS(l, base) \
  STEP(base + 0, phase_norm1(p, l, (float*)smem); if (l == 1) phase_convert_misc(p, 1)); \
  STEP(base + 1, phase_inproj(p, (h16*)smem)); \
  STEP(base + 2, phase_mixa(p, l, smem)); \
  STEP(base + 3, phase_mixb(p, l, (float*)smem)); \
  STEP(base + 4, phase_attn(p, l, (float*)smem)); \
  STEP(base + 5, phase_outproj(p, l, (h16*)smem)); \
  STEP(base + 6, phase_router(p, l, (int*)smem)); \
  STEP(base + 7, phase_moe1(p, l, (h16*)smem)); \
  STEP(base + 8, phase_moe2(p, l, (h16*)smem))

__global__ void __launch_bounds__(NTHREADS, 2) mega(Params p, int s_lo, int s_hi) {
  extern __shared__ __attribute__((aligned(16))) unsigned char smem[];
  unsigned long long pt_prev = PROBE_MASK != 0u ? __builtin_amdgcn_s_memrealtime() : 0ull;
  XBar xb;
  xbar_post(xb, (unsigned*)(p.ws + OFF_BAR), (volatile unsigned*)(smem + LDS_BYTES - 16));
  STEP(0, phase_prep(p, (float*)smem); phase_convert_tiles(p, 0, (float*)smem); phase_convert_misc(p, 0));
  LAYER_STEPS(0, 1);
  LAYER_STEPS(1, 10);
  STEP(19, phase_norm1(p, 2, (float*)smem));
}

extern "C" void kernel_launch(void* const* d_in, const int* in_sizes, int n_in, void* d_out, int out_size, void* d_ws, size_t ws_size,
                              hipStream_t stream) {
  static int grid_blocks = 0;
  if (!grid_blocks) {
    if (n_in != 35 || out_size != T * D || ws_size < WS_TOTAL) {
      fprintf(stderr, "kernel_launch: unexpected problem (n_in %d, out %d, ws %zu < %zu)\n", n_in, out_size, ws_size, (size_t)WS_TOTAL);
      grid_blocks = -1;
      return;
    }
    int dev = 0, cus = 0, per_cu = 0;
    hipGetDevice(&dev);
    hipDeviceGetAttribute(&cus, hipDeviceAttributeMultiprocessorCount, dev);
    if (hipFuncSetAttribute((const void*)mega, hipFuncAttributeMaxDynamicSharedMemorySize, LDS_BYTES) != hipSuccess) {
      fprintf(stderr, "kernel_launch: hipFuncSetAttribute(%d B dynamic LDS) failed\n", LDS_BYTES);
      grid_blocks = -1;
      return;
    }
    hipOccupancyMaxActiveBlocksPerMultiprocessor(&per_cu, mega, NTHREADS, LDS_BYTES);
    if (per_cu > 1) per_cu = 1;
    if (per_cu < 1) { fprintf(stderr, "kernel_launch: occupancy query returned %d\n", per_cu); grid_blocks = -1; return; }
    grid_blocks = cus * per_cu;
  }
  if (grid_blocks < 0) return;
  Params p{};
  for (int i = 0; i < 35; ++i) p.in[i] = (const float*)d_in[i];
  p.out = (float*)d_out;
  p.ws = (unsigned char*)d_ws;
  for (int i = 0; i < 32; ++i) p.inv_freq[i] = std::pow(10000.0, -(double)(2 * i) / 64.0);
  if (hipMemsetAsync((char*)d_ws + OFF_BAR, 0, 16384, stream) != hipSuccess) { fprintf(stderr, "kernel_launch: memset of barrier words failed\n"); return; }
#if MEGA
  int lo = 0, hi = NSTEPS;
  void* args[] = {&p, &lo, &hi};
  hipError_t e = hipLaunchCooperativeKernel((void*)mega, dim3(grid_blocks), dim3(NTHREADS), args, LDS_BYTES, stream);
  if (e != hipSuccess) fprintf(stderr, "cooperative launch failed: %s (grid %d)\n", hipGetErrorString(e), grid_blocks);
#else
  for (int s = 0; s < NSTEPS; ++s) {
    int lo = s, hi = s + 1;
    void* args[] = {&p, &lo, &hi};
    hipError_t e = hipLaunchCooperativeKernel((void*)mega, dim3(grid_blocks), dim3(NTHREADS), args, LDS_BYTES, stream);
    if (e != hipSuccess) { fprintf(stderr, "launch %d failed: %s (grid %d)\n", s, hipGetErrorString(e), grid_blocks); break; }
  }
#endif
}
```

```cpp
#include <hip/hip_runtime.h>
#include <hip/hip_cooperative_groups.h>
#include <cstdio>
#include <cstdint>
#include <cmath>
namespace cg = cooperative_groups;

#ifndef MEGA
#define MEGA 1
#endif
#ifndef PROBE_MASK
#define PROBE_MASK 0u
#define PROBE_AMP 3
#endif

typedef _Float16 h16;
typedef _Float16 h16x8 __attribute__((ext_vector_type(8)));
typedef _Float16 h16x4 __attribute__((ext_vector_type(4)));
typedef float f32x4 __attribute__((ext_vector_type(4)));

constexpr int NB = 2, S = 8192, T = NB * S, D = 1024;
constexpr int NIN = 2432;
constexpr int NINSRC = 2328;
constexpr int C_XL = 0, C_GL = 256, C_Q = 512, C_KC = 1024, C_VC = 1152, C_KS = 1280, C_VS = 1408, C_KW = 1536, C_VW = 1664,
              C_CVA = 1792, C_CVB = 2048, C_GATE = 2304;
constexpr float EPS = 1e-6f;
constexpr int NTHREADS = 512, NW = 8;
constexpr int LDS_BYTES = 150528;
constexpr int NINP = 2560;
constexpr int SCHED_OFF = LDS_BYTES - 1024;
constexpr float ASCALE = 16.f;

constexpr size_t al256(size_t x) { return (x + 255) & ~(size_t)255; }
constexpr size_t OFF_CTL = 0;
constexpr size_t OFF_BAR = 4096;
constexpr size_t OFF_MOD = 4096 + 16384;
constexpr size_t OFF_ROPE = al256(OFF_MOD + 2 * 2 * 6144 * 4);
constexpr size_t OFF_PB = al256(OFF_ROPE + (size_t)T * 64 * 4);
constexpr size_t OFF_PBPART = al256(OFF_PB + 2 * 256 * 4);
constexpr size_t OFF_LRUW = al256(OFF_PBPART + 2 * 32 * 256 * 4);
constexpr size_t OFF_GATES = al256(OFF_LRUW + 2 * 4 * 64 * 64 * 2);
constexpr size_t OFF_WIN = al256(OFF_GATES + (size_t)T * 24 * 4);
constexpr size_t OFF_WOUT = al256(OFF_WIN + (size_t)NINP * 1024 * 2);
constexpr size_t OFF_WGU = al256(OFF_WOUT + (size_t)1024 * 1024 * 2);
constexpr size_t OFF_WDN = al256(OFF_WGU + (size_t)16 * 1024 * 1024 * 2);
constexpr size_t OFF_W1K = al256(OFF_WDN + (size_t)16 * 1024 * 512 * 2);
constexpr size_t OFF_W1V = al256(OFF_W1K + (size_t)256 * 2048 * 2);
constexpr size_t OFF_H16 = al256(OFF_W1V + (size_t)256 * 2048 * 2);
constexpr size_t OFF_Q16 = al256(OFF_H16 + (size_t)T * 1024 * 2);
constexpr size_t KVSZ = (size_t)T * 128 * 2;
constexpr size_t OFF_KC = al256(OFF_Q16 + (size_t)T * 512 * 2);
constexpr size_t OFF_VC = al256(OFF_KC + KVSZ + 4096);
constexpr size_t OFF_KS = al256(OFF_VC + KVSZ + 4096);
constexpr size_t OFF_VST = al256(OFF_KS + KVSZ);
constexpr size_t OFF_KW = al256(OFF_VST + KVSZ);
constexpr size_t OFF_VWT = al256(OFF_KW + KVSZ);
constexpr size_t OFF_HIDC = al256(OFF_VWT + KVSZ);
constexpr size_t OFF_KCMP = al256(OFF_HIDC + (size_t)2 * 2048 * 256 * 2);
constexpr size_t OFF_VCMPT = al256(OFF_KCMP + (size_t)4 * 512 * 64 * 2);
constexpr size_t OFF_LRUH = al256(OFF_VCMPT + (size_t)4 * 512 * 64 * 2);
constexpr size_t OFF_LRUA = al256(OFF_LRUH + (size_t)T * 256 * 4);
constexpr size_t OFF_HEND = al256(OFF_LRUA + (size_t)T * 256 * 4);
constexpr size_t OFF_AEND = al256(OFF_HEND + 2 * 256 * 256 * 4);
constexpr size_t OFF_CARRY = al256(OFF_AEND + 2 * 256 * 256 * 4);
constexpr size_t OFF_XA = al256(OFF_CARRY + 2 * 256 * 256 * 4);
constexpr size_t OFF_LIST = al256(OFF_XA + (size_t)T * 1024 * 4);
constexpr size_t OFF_WPAIR = al256(OFF_LIST + (size_t)16 * 16384 * 4);
constexpr size_t OFF_SSQ = al256(OFF_WPAIR + 32768 * 4);
constexpr size_t OFF_R = al256(OFF_SSQ + (size_t)T * 2 * 4);
constexpr size_t OFF_P16 = OFF_R;
constexpr size_t OFF_HID = OFF_R;
constexpr size_t OFF_YPAIR = al256(OFF_HID + (size_t)(32768 + 512) * 512 * 2);
constexpr size_t OFF_HIDP = al256(OFF_P16 + (size_t)T * NIN * 2);
constexpr size_t OFF_MODP = OFF_HIDP;
constexpr size_t R_END1 = OFF_HIDP + (size_t)4 * 2 * 2048 * 256 * 4;
constexpr size_t R_END2 = OFF_YPAIR + (size_t)32768 * 1024 * 2;
constexpr size_t WS_TOTAL = al256(R_END1 > R_END2 ? R_END1 : R_END2);

struct Params {
  const float* in[35];
  float* out;
  unsigned char* ws;
  double inv_freq[32];
};
enum { I_X = 0, I_C, I_POS, I_ADAW, I_ADAB, I_N1G, I_N2G, I_WIN, I_LCW, I_LCB, I_LWA, I_LBA, I_LWX, I_LBX, I_LLAM, I_CKW1, I_CKW2,
       I_CVW1, I_CVW2, I_CPK, I_CPV, I_DWW, I_DWB, I_LNG, I_LNB, I_ONG, I_WOUT, I_RGW, I_RGB, I_REW, I_REB, I_MG, I_MU, I_MD, I_FNG };

__device__ __forceinline__ int tidx() { int t = threadIdx.x; asm volatile("" : "+v"(t)); return t; }
__device__ __forceinline__ float wsum(float v) {
#pragma unroll
  for (int o = 32; o > 0; o >>= 1) v += __shfl_xor(v, o);
  return v;
}
__device__ __forceinline__ float sigm(float x) { return 1.f / (1.f + __expf(-x)); }
__device__ __forceinline__ float silu_f(float x) { return x / (1.f + __expf(-x)); }
__device__ __forceinline__ float gelu_tanh(float x) {
  float u = 0.7978845608028654f * (x + 0.044715f * x * x * x);
  float e = __expf(2.f * u);
  float t = 1.f - 2.f / (e + 1.f);
  return 0.5f * x * (1.f + t);
}
__device__ __forceinline__ void glds16(const h16* g, h16* l) {
  __builtin_amdgcn_global_load_lds((const unsigned*)g, (unsigned*)l, 16, 0, 0);
}
__device__ __forceinline__ h16x4 pack4(float a, float b, float c, float d) {
  h16x4 r; r[0] = (h16)a; r[1] = (h16)b; r[2] = (h16)c; r[3] = (h16)d; return r;
}

struct TileIter { int cur, end, step; };
__device__ __forceinline__ TileIter xcd_tiles(int ntiles) {
  const int G = gridDim.x, b = blockIdx.x;
  TileIter it;
  if ((G & 7) == 0) {
    const int x = b & 7;
    it.cur = (int)(((long)ntiles * x) >> 3) + (b >> 3);
    it.end = (int)(((long)ntiles * (x + 1)) >> 3);
    it.step = G >> 3;
  } else { it.cur = b; it.end = ntiles; it.step = G; }
  return it;
}

#define VMCNT(n) asm volatile("s_waitcnt vmcnt(" #n ")" ::: "memory")
template <int BN, class ARowFn>
__device__ __forceinline__ void gemm_mainloop(f32x4 (&acc)[8][BN / 64], ARowFn arow, const h16* __restrict__ Bt, int ldb, int nk, h16* sm, bool zero_init = true) {
  constexpr int NF = BN / 64, NBP = BN / 64;
  constexpr int STAGE = 16384 + BN * 64;
  constexpr int NST = BN == 128 ? 3 : 2;
  const int tid = tidx(), lane = tid & 63, wave = tid >> 6;
  const int wr = wave >> 2, wc = wave & 3, fr = lane & 15, fq = lane >> 4;
  const h16* ap[4];
  const h16* bp[NBP];
#pragma unroll
  for (int i = 0; i < 4; ++i) {
    const int r = (i * 8 + wave) * 8 + (lane >> 3);
    const int c = (lane & 7) ^ ((r >> 1) & 7);
    ap[i] = arow(r) + c * 8;
    if (i < NBP) bp[i] = Bt + (size_t)r * ldb + c * 8;
  }
  if (zero_init) {
#pragma unroll
    for (int m = 0; m < 8; ++m)
#pragma unroll
      for (int n = 0; n < NF; ++n) acc[m][n] = (f32x4){0.f, 0.f, 0.f, 0.f};
  }
  h16* const dA = sm + wave * 512 + lane * 8;
#pragma unroll
  for (int st0 = 0; st0 < NST - 1; ++st0)
    if (st0 < nk) {
#pragma unroll
      for (int i = 0; i < 4; ++i) { glds16(ap[i], dA + st0 * STAGE + i * 4096); ap[i] += 64; }
#pragma unroll
      for (int i = 0; i < NBP; ++i) { glds16(bp[i], dA + st0 * STAGE + 16384 + i * 4096); bp[i] += 64; }
    }
  const int sw = (fr >> 1) & 7;
  const int aoff = (wr * 128 + fr) * 64, boff = 16384 + (wc * (BN / 4) + fr) * 64;
#define SCHED_FENCE() __builtin_amdgcn_sched_barrier(0)
  for (int kt = 0; kt < nk; ++kt) {
    if (NST == 3 && kt + 1 < nk) VMCNT(6); else VMCNT(0);
    __builtin_amdgcn_s_barrier();
    const int sl_ = NST == 3 ? kt % 3 : (kt & 1);
    const h16* st = sm + sl_ * STAGE;
    const bool more = kt + (NST - 1) < nk;
    h16* const dn = dA + (NST == 3 ? (sl_ == 0 ? 2 : sl_ - 1) : (sl_ ^ 1)) * STAGE;
#pragma unroll
    for (int ks = 0; ks < 2; ++ks) {
      const int ch = ((ks * 4 + fq) ^ sw) * 8;
      h16x8 bf[NF];
#pragma unroll
      for (int n = 0; n < NF; ++n) bf[n] = *(const h16x8*)(st + boff + n * 1024 + ch);
#pragma unroll
      for (int mh = 0; mh < 2; ++mh) {
        h16x8 af[4];
#pragma unroll
        for (int m = 0; m < 4; ++m) af[m] = *(const h16x8*)(st + aoff + (mh * 4 + m) * 1024 + ch);
#pragma unroll
        for (int m = 0; m < 4; ++m) {
#pragma unroll
          for (int n = 0; n < NF; ++n) acc[mh * 4 + m][n] = __builtin_amdgcn_mfma_f32_16x16x32_f16(bf[n], af[m], acc[mh * 4 + m][n], 0, 0, 0);
          if (m == 1 || m == 3) {
            const int q = ks * 4 + mh * 2 + (m >> 1);
            SCHED_FENCE();
            if (more) {
              if (q < 4) { glds16(ap[q & 3], dn + (q & 3) * 4096); ap[q & 3] += 64; }
              else if ((q & 3) < NBP) { glds16(bp[(q & 3) < NBP ? (q & 3) : 0], dn + 16384 + (q & 3) * 4096); bp[(q & 3) < NBP ? (q & 3) : 0] += 64; }
            }
            SCHED_FENCE();
          }
        }
      }
    }
  }
#undef SCHED_FENCE
  __builtin_amdgcn_s_barrier();
}

struct TileSched { int cur, end, step, tail_tile, tail_half, nbusy; };
__device__ __forceinline__ TileSched xcd_sched(int ntiles) {
  const int G = gridDim.x, b = blockIdx.x;
  TileSched s;
  s.tail_tile = -1; s.tail_half = -1; s.nbusy = 0;
  if ((G & 7) == 0) {
    const int x = b & 7, nb = G >> 3, si = b >> 3;
    const int lo = (int)(((long)ntiles * x) >> 3), hi = (int)(((long)ntiles * (x + 1)) >> 3);
    const int n = hi - lo, R = n / nb, rem = n - R * nb;
    s.cur = lo + si; s.end = lo + R * nb; s.step = nb;
    if (rem * 2 <= nb) { s.nbusy = 2 * rem; if (si < 2 * rem) { s.tail_tile = lo + R * nb + (si >> 1); s.tail_half = si & 1; } }
    else { s.nbusy = rem; if (si < rem) s.tail_tile = lo + R * nb + si; }
  } else { s.cur = b; s.end = ntiles; s.step = G; }
  return s;
}

__device__ __forceinline__ h16* wgu_buf(const Params& p, int l) { return l ? (h16*)p.out : (h16*)(p.ws + OFF_WGU); }
__device__ __forceinline__ h16* wdn_buf(const Params& p, int l) { return l ? (h16*)p.out + (size_t)16 * 1024 * 1024 : (h16*)(p.ws + OFF_WDN); }
constexpr int NT_CONV = 16 * 37 + 256 + 3 * 16 * 128 + 2 * 128;
__device__ __forceinline__ int map_row(int mode, int n) {
  if (mode == 1) return n < 1792 ? n : (n < 1816 ? n + 512 : n - 24);
  if (mode == 2) return 32 * (n >> 4) + (n & 15);
  if (mode == 3) return 32 * (n >> 4) + 16 + (n & 15);
  return n;
}
struct ConvTile { const float* src; h16* dst; int K, N, mode, k0, n0; const float* pos; float* pbp; };
__device__ __forceinline__ ConvTile conv_decode(const Params& p, int l, int t) {
  unsigned char* ws = p.ws;
  constexpr int T_WIN = 16 * 37, T_WOUT = 256, T_G = 16 * 128, T_W1 = 128;
  constexpr int E0 = T_WIN, E1 = E0 + T_WOUT, E2 = E1 + T_G, E3 = E2 + T_G, E4 = E3 + T_G, E5 = E4 + T_W1;
  ConvTile c;
  c.pos = nullptr; c.pbp = nullptr;
  int tk, tn;
  if (t < E0) {
    c.src = p.in[I_WIN] + (size_t)l * 1024 * NINSRC; c.K = 1024; c.N = NINSRC; c.dst = (h16*)(ws + OFF_WIN); c.mode = 1; tk = t / 37; tn = t % 37;
  } else if (t < E1) {
    const int u = t - E0;
    c.src = p.in[I_WOUT] + (size_t)l * 1024 * 1024; c.K = 1024; c.N = 1024; c.dst = (h16*)(ws + OFF_WOUT); c.mode = 4; tk = u >> 4; tn = u & 15;
  } else if (t < E3) {
    const int up = t >= E2;
    const int u = t - (up ? E2 : E1);
    const int e = u >> 7, v = u & 127;
    c.src = p.in[up ? I_MU : I_MG] + ((size_t)l * 16 + e) * 1024 * 512; c.K = 1024; c.N = 512; c.dst = wgu_buf(p, l) + (size_t)e * 1024 * 1024;
    c.mode = up ? 3 : 2; tk = v >> 3; tn = v & 7;
  } else if (t < E4) {
    const int u = t - E3;
    const int e = u >> 7, v = u & 127;
    c.src = p.in[I_MD] + ((size_t)l * 16 + e) * 512 * 1024; c.K = 512; c.N = 1024; c.dst = wdn_buf(p, l) + (size_t)e * 1024 * 512; c.mode = 0; tk = v >> 4; tn = v & 15;
  } else {
    const int vv = t >= E5;
    const int u = t - (vv ? E5 : E4);
    c.src = p.in[vv ? I_CVW1 : I_CKW1] + (size_t)l * 2048 * 256; c.K = 2048; c.N = 256; c.dst = (h16*)(ws + (vv ? OFF_W1V : OFF_W1K)); c.mode = 5; tk = u >> 2; tn = u & 3;
    c.pos = p.in[vv ? I_CPV : I_CPK] + (size_t)l * 2048 + tk * 64;
    c.pbp = (float*)(ws + OFF_PBPART) + (size_t)(vv * 32 + tk) * 256 + tn * 64;
  }
  c.k0 = tk * 64; c.n0 = tn * 64;
  return c;
}
__device__ __forceinline__ void conv_wave_tile(const ConvTile& c, float* smw, int lane) {
  float4 v[16];
#pragma unroll
  for (int i = 0; i < 16; ++i) {
    const int idx = i * 64 + lane;
    const int r = idx >> 4, c4 = (idx & 15) * 4;
    v[i] = make_float4(0.f, 0.f, 0.f, 0.f);
    if (c.n0 + c4 < c.N) v[i] = *(const float4*)(c.src + (size_t)(c.k0 + r) * c.N + c.n0 + c4);
  }
#pragma unroll
  for (int i = 0; i < 16; ++i) {
    const int idx = i * 64 + lane;
    const int r = idx >> 4, c4 = (idx & 15) * 4;
    float* d = smw + r * 65 + c4;
    d[0] = v[i].x; d[1] = v[i].y; d[2] = v[i].z; d[3] = v[i].w;
  }
  if (c.mode == 5) {
    float sacc = 0.f;
    for (int k = 0; k < 64; ++k) sacc += c.pos[k] * smw[k * 65 + lane];
    c.pbp[lane] = sacc;
  }
  const int k0d = c.mode == 4 ? (c.k0 < 256 ? c.k0 + 512 : (c.k0 < 768 ? c.k0 - 256 : c.k0)) : c.k0;
#pragma unroll
  for (int j = 0; j < 8; ++j) {
    const int ch = j * 64 + lane;
    const int n = ch >> 3, kc = ch & 7;
    if (c.n0 + n < c.N) {
      h16x8 o;
#pragma unroll
      for (int q = 0; q < 8; ++q) o[q] = (h16)smw[(kc * 8 + q) * 65 + n];
      *(h16x8*)(c.dst + (size_t)map_row(c.mode, c.n0 + n) * c.K + k0d + kc * 8) = o;
    }
  }
}

constexpr int CV_MOE0 = 16 * 37 + 256, CV_MOE1 = CV_MOE0 + 3 * 16 * 128;
constexpr int CV_Q1 = CV_MOE0 + 1536, CV_Q2 = CV_Q1 + 2048;
__device__ __forceinline__ void conv_share(const Params& p, int l, int t0, int t1, int busy_lo, int busy_hi, float* sm) {
  const int tid = tidx(), lane = tid & 63, wave = tid >> 6;
  float* smw = sm + wave * 4160;
  const int G = gridDim.x, b = blockIdx.x;
  int lo = t0, hi = t1, me = b, n = G;
  if ((G & 7) == 0) {
    const int x = b & 7, nb = G >> 3, si = b >> 3, nbusy = busy_hi - busy_lo;
    lo = t0 + (int)(((long)(t1 - t0) * x) >> 3); hi = t0 + (int)(((long)(t1 - t0) * (x + 1)) >> 3);
    if (nbusy > 0 && nbusy < nb) { n = nb - nbusy; me = si < busy_lo ? si : (si >= busy_hi ? si - nbusy : -1); } else { me = si; n = nb; }
  }
  __syncthreads();
  if (me < 0) return;
  for (int t = lo + me * NW + wave; t < hi; t += n * NW) {
    const ConvTile c = conv_decode(p, l, t);
    conv_wave_tile(c, smw, lane);
  }
}
__device__ __forceinline__ void phase_convert_tiles(const Params& p, int l, float* sm) {
  const int tid = tidx(), lane = tid & 63, wave = tid >> 6;
  float* smw = sm + wave * 4160;
  for (int u = blockIdx.x * NW + wave; u < NT_CONV - (CV_MOE1 - CV_MOE0); u += gridDim.x * NW) {
    const ConvTile c = conv_decode(p, l, u < CV_MOE0 ? u : u + (CV_MOE1 - CV_MOE0));
    conv_wave_tile(c, smw, lane);
  }
  __syncthreads();
}
__device__ __forceinline__ void phase_convert_misc(const Params& p, int l) {
  unsigned char* ws = p.ws;
  {
    h16* lw = (h16*)(ws + OFF_LRUW);
    for (int i = blockIdx.x * NTHREADS + tidx(); i < 2 * 4 * 64 * 64; i += gridDim.x * NTHREADS) {
      const int d = i & 63, e = (i >> 6) & 63, n = (i >> 12) & 3, mat = i >> 14;
      lw[i] = (h16)p.in[mat ? I_LWX : I_LWA][((size_t)(l * 4 + n) * 64 + d) * 64 + e];
    }
  }
  {
    h16x8 z = {0, 0, 0, 0, 0, 0, 0, 0};
    h16* w = (h16*)(ws + OFF_WIN) + (size_t)NINSRC * 1024;
    for (int i = blockIdx.x * NTHREADS + tidx(); i < (NINP - NINSRC) * 1024 / 8; i += gridDim.x * NTHREADS) *(h16x8*)(w + (size_t)i * 8) = z;
  }
}

__device__ __forceinline__ void phase_prep(const Params& p, float* sm) {
  unsigned char* ws = p.ws;
  const int tid = tidx();
  if (blockIdx.x == 0) {
    for (int i = tid; i < 1024; i += NTHREADS) ((unsigned*)(ws + OFF_CTL))[i] = 0u;
  }
  float* part = (float*)(ws + OFF_MODP);
  for (int it = blockIdx.x; it < 192; it += gridDim.x) {
    const int l = it / 96, r = it % 96, cg = r >> 2, ks = r & 3;
    const int lane = tid & 63, wave = tid >> 6;
    const int k0 = ks * 256 + wave * 32;
    const float* w = p.in[I_ADAW] + ((size_t)l * 1024 + k0) * 6144 + cg * 256 + lane * 4;
    const float* c = p.in[I_C] + k0;
    float a0[4] = {0, 0, 0, 0}, a1[4] = {0, 0, 0, 0};
#pragma unroll 16
    for (int k = 0; k < 32; ++k) {
      const float4 wv = *(const float4*)(w + (size_t)k * 6144);
      const float s0 = silu_f(c[k]), s1 = silu_f(c[1024 + k]);
      a0[0] += s0 * wv.x; a0[1] += s0 * wv.y; a0[2] += s0 * wv.z; a0[3] += s0 * wv.w;
      a1[0] += s1 * wv.x; a1[1] += s1 * wv.y; a1[2] += s1 * wv.z; a1[3] += s1 * wv.w;
    }
    float* rr = sm + (wave * 64 + lane) * 8;
#pragma unroll
    for (int i = 0; i < 4; ++i) { rr[i] = a0[i]; rr[4 + i] = a1[i]; }
    __syncthreads();
    {
      const int bb = tid >> 8, col = tid & 255;
      float sacc = 0.f;
#pragma unroll
      for (int g = 0; g < 8; ++g) sacc += sm[(g * 64 + (col >> 2)) * 8 + bb * 4 + (col & 3)];
      part[((size_t)(ks * 2 + l) * 2 + bb) * 6144 + cg * 256 + col] = sacc;
    }
    __syncthreads();
  }
  float* rc = (float*)(ws + OFF_ROPE);
  float* rs = rc + (size_t)T * 32;
  const int* pos = (const int*)p.in[I_POS];
  for (int i = blockIdx.x * NTHREADS + tid; i < T * 32; i += gridDim.x * NTHREADS) {
    const int t = i >> 5, f = i & 31;
    const double a = (double)pos[t] * p.inv_freq[f];
    const double n = rint(a * 0.15915494309189535);
    double r = fma(-n, 6.283185307179586, a);
    r = fma(-n, 2.4492935982947064e-16, r);
    const float rf = (float)r;
    rc[i] = cosf(rf);
    rs[i] = sinf(rf);
  }
}

__device__ __forceinline__ void phase_norm1(const Params& p, int mode, float* sm) {
  unsigned char* ws = p.ws;
  const int lane = tidx() & 63, wave = tidx() >> 6;
  const float* mod = (const float*)(ws + OFF_MOD);
  float* xa = (float*)(ws + OFF_XA);
  const h16* yp = (const h16*)(ws + OFF_YPAIR);
  h16* hout = (h16*)(ws + OFF_H16);
  const int l = (mode == 0) ? 0 : 1;
  if (mode == 0) {
    const float* part = (const float*)(ws + OFF_MODP);
    const int tid = tidx();
    for (int i = tid; i < 1024; i += NTHREADS) {
      const int b = i >> 9, j4 = (i & 511) * 4;
      float4 a = *(const float4*)(p.in[I_ADAB] + j4);
#pragma unroll
      for (int ks = 0; ks < 4; ++ks) {
        const float4 v = *(const float4*)(part + ((size_t)(ks * 2) * 2 + b) * 6144 + j4);
        a.x += v.x; a.y += v.y; a.z += v.z; a.w += v.w;
      }
      *(float4*)(sm + b * 2048 + j4) = a;
    }
    for (int o = blockIdx.x * NTHREADS + tid; o < 4 * 6144; o += gridDim.x * NTHREADS) {
      const int lb = o / 6144, j = o - lb * 6144;
      float a = p.in[I_ADAB][(lb >> 1) * 6144 + j];
#pragma unroll
      for (int ks = 0; ks < 4; ++ks) a += part[((size_t)(ks * 2 + (lb >> 1)) * 2 + (lb & 1)) * 6144 + j];
      ((float*)(ws + OFF_MOD))[o] = a;
    }
    __syncthreads();
  }
  const int lp = mode == 1 ? 0 : 1;
  const int stride = gridDim.x * NW;
  int row = blockIdx.x * NW + wave;
  float4 xn[4], gsv[4], shv[4], g2v[4];
  h16x4 y0n[4], y1n[4];
#pragma unroll
  for (int i = 0; i < 4; ++i) {
    const int col = lane * 4 + 256 * i;
    if (row < T) {
      if (mode == 0) xn[i] = *(const float4*)(p.in[I_X] + (size_t)row * D + col);
      else {
        xn[i] = *(const float4*)(xa + (size_t)row * D + col);
        y0n[i] = *(const h16x4*)(yp + (size_t)(row * 2) * D + col);
        y1n[i] = *(const h16x4*)(yp + (size_t)(row * 2 + 1) * D + col);
      }
    }
  }
  int bcur = -1;
  for (; row < T; row += stride) {
    const int b = row >> 13;
    if (b != bcur) {
      bcur = b;
#pragma unroll
      for (int i = 0; i < 4; ++i) {
        const int col = lane * 4 + 256 * i;
        if (mode == 2) gsv[i] = *(const float4*)(p.in[I_FNG] + col);
        else {
          const float4 g = *(const float4*)(p.in[I_N1G] + l * D + col);
          const float4 sh = mode == 0 ? *(const float4*)(sm + b * 2048 + col) : *(const float4*)(mod + (size_t)(l * 2 + b) * 6144 + col);
          const float4 sc = mode == 0 ? *(const float4*)(sm + b * 2048 + 1024 + col) : *(const float4*)(mod + (size_t)(l * 2 + b) * 6144 + 1024 + col);
          gsv[i] = make_float4(g.x * (1.f + sc.x), g.y * (1.f + sc.y), g.z * (1.f + sc.z), g.w * (1.f + sc.w));
          shv[i] = sh;
        }
        if (mode != 0) g2v[i] = *(const float4*)(mod + (size_t)(lp * 2 + b) * 6144 + 5120 + col);
      }
    }
    float4 x[4];
    float ss = 0.f;
#pragma unroll
    for (int i = 0; i < 4; ++i) {
      if (mode == 0) x[i] = xn[i];
      else {
        x[i].x = xn[i].x + g2v[i].x * ((float)y0n[i][0] + (float)y1n[i][0]);
        x[i].y = xn[i].y + g2v[i].y * ((float)y0n[i][1] + (float)y1n[i][1]);
        x[i].z = xn[i].z + g2v[i].z * ((float)y0n[i][2] + (float)y1n[i][2]);
        x[i].w = xn[i].w + g2v[i].w * ((float)y0n[i][3] + (float)y1n[i][3]);
      }
    }
    if (row + stride < T) {
      const int rn = row + stride;
#pragma unroll
      for (int i = 0; i < 4; ++i) {
        const int col = lane * 4 + 256 * i;
        if (mode == 0) xn[i] = *(const float4*)(p.in[I_X] + (size_t)rn * D + col);
        else {
          xn[i] = *(const float4*)(xa + (size_t)rn * D + col);
          y0n[i] = *(const h16x4*)(yp + (size_t)(rn * 2) * D + col);
          y1n[i] = *(const h16x4*)(yp + (size_t)(rn * 2 + 1) * D + col);
        }
      }
    }
#pragma unroll
    for (int i = 0; i < 4; ++i) {
      const int col = lane * 4 + 256 * i;
      if (mode == 1) *(float4*)(xa + (size_t)row * D + col) = x[i];
      ss += x[i].x * x[i].x + x[i].y * x[i].y + x[i].z * x[i].z + x[i].w * x[i].w;
    }
    ss = wsum(ss);
    const float rstd = rsqrtf(ss * (1.f / D) + EPS);
#pragma unroll
    for (int i = 0; i < 4; ++i) {
      const int col = lane * 4 + 256 * i;
      if (mode == 2) {
        float4 o;
        o.x = x[i].x * rstd * gsv[i].x; o.y = x[i].y * rstd * gsv[i].y; o.z = x[i].z * rstd * gsv[i].z; o.w = x[i].w * rstd * gsv[i].w;
        *(float4*)(p.out + (size_t)row * D + col) = o;
      } else {
        *(h16x4*)(hout + (size_t)row * D + col) = pack4(x[i].x * rstd * gsv[i].x + shv[i].x, x[i].y * rstd * gsv[i].y + shv[i].y,
                                                        x[i].z * rstd * gsv[i].z + shv[i].z, x[i].w * rstd * gsv[i].w + shv[i].w);
      }
    }
  }
}

__device__ __forceinline__ int perm_key(int pos) {
  return 32 * (pos >> 5) + 16 * ((pos >> 2) & 1) + 4 * ((pos >> 3) & 3) + (pos & 3);
}
__device__ __forceinline__ void inproj_tile(const Params& p, h16* sm, int mt, int nt) {
  unsigned char* ws = p.ws;
  const h16* Ab = (const h16*)(ws + OFF_H16) + (size_t)mt * 256 * D;
  f32x4 acc[8][2];
  gemm_mainloop<128>(acc, [&](int r) { return Ab + (size_t)r * D; }, (const h16*)(ws + OFF_WIN) + (size_t)nt * 128 * D, D, D / 64, sm);
  const int tid_e = tidx(), lane = tid_e & 63, wave = tid_e >> 6, wr = wave >> 2, wc = wave & 3, fr = lane & 15, fq = lane >> 4;
  constexpr int LDR = 136;
#pragma unroll
  for (int m = 0; m < 8; ++m)
#pragma unroll
    for (int n = 0; n < 2; ++n)
      *(h16x4*)(sm + (wr * 128 + m * 16 + fr) * LDR + wc * 32 + n * 16 + 4 * fq) = pack4(acc[m][n][0], acc[m][n][1], acc[m][n][2], acc[m][n][3]);
  __syncthreads();
  const int row0 = mt * 256, b = mt >> 5, s0 = (mt & 31) * 256;
  if (nt < 4 || (nt >= 14 && nt < 18)) {
    h16* P = (h16*)(ws + OFF_P16);
#pragma unroll
    for (int i = 0; i < 8; ++i) {
      const int idx = i * NTHREADS + tid_e;
      const int r = idx >> 4, c8 = idx & 15;
      *(h16x8*)(P + (size_t)(row0 + r) * NIN + nt * 128 + c8 * 8) = *(const h16x8*)(sm + r * LDR + c8 * 8);
    }
  } else if (nt <= 8 || nt == 10 || nt == 12) {
    const float* rc = (const float*)(ws + OFF_ROPE);
    const float* rs = rc + (size_t)T * 32;
    const bool isq = nt < 8;
    const float scl = isq ? 0.125f * 1.4426950408889634f : 1.f;
    h16* kbase = (h16*)(ws + (nt == 8 ? OFF_KC : (nt == 10 ? OFF_KS : OFF_KW)));
    h16* q16 = (h16*)(ws + OFF_Q16);
#pragma unroll
    for (int i = 0; i < 4; ++i) {
      const int idx = i * NTHREADS + tid_e;
      const int r = idx >> 3, hd = (idx >> 2) & 1, d = (idx & 3) * 8;
      const h16x8 a = *(const h16x8*)(sm + r * LDR + 64 * hd + d);
      const h16x8 bb = *(const h16x8*)(sm + r * LDR + 64 * hd + 32 + d);
      const float* cp = rc + (size_t)(row0 + r) * 32 + d;
      const float* sp = rs + (size_t)(row0 + r) * 32 + d;
      const float4 c0 = *(const float4*)cp, c1 = *(const float4*)(cp + 4), n0 = *(const float4*)sp, n1 = *(const float4*)(sp + 4);
      const float cs[8] = {c0.x, c0.y, c0.z, c0.w, c1.x, c1.y, c1.z, c1.w}, sn[8] = {n0.x, n0.y, n0.z, n0.w, n1.x, n1.y, n1.z, n1.w};
      h16x8 lo, hi;
#pragma unroll
      for (int j = 0; j < 8; ++j) {
        const float av = (float)a[j], bv = (float)bb[j];
        lo[j] = (h16)((av * cs[j] - bv * sn[j]) * scl);
        hi[j] = (h16)((bv * cs[j] + av * sn[j]) * scl);
      }
      h16* dst = isq ? q16 + (size_t)(row0 + r) * 512 + (nt - 4) * 128 + 64 * hd + d : kbase + ((size_t)(b * 2 + hd) * S + s0 + r) * 64 + d;
      *(h16x8*)dst = lo;
      *(h16x8*)(dst + 32) = hi;
    }
  } else if (nt == 9) {
    h16* vc = (h16*)(ws + OFF_VC);
#pragma unroll
    for (int i = 0; i < 8; ++i) {
      const int idx = i * NTHREADS + tid_e;
      const int r = idx >> 4, c8 = idx & 15, hd = c8 >> 3, dd = (c8 & 7) * 8;
      *(h16x8*)(vc + ((size_t)(b * 2 + hd) * S + s0 + r) * 64 + dd) = *(const h16x8*)(sm + r * LDR + c8 * 8);
    }
  } else if (nt == 11 || nt == 13) {
    h16* vt = (h16*)(ws + (nt == 11 ? OFF_VST : OFF_VWT));
#pragma unroll
    for (int i = 0; i < 8; ++i) {
      const int idx = i * NTHREADS + tid_e;
      const int kv = idx >> 11, blk = (idx >> 9) & 3, dim = (idx >> 3) & 63, p0 = (idx & 7) * 8;
      h16x8 v;
#pragma unroll
      for (int j = 0; j < 8; ++j) v[j] = sm[(blk * 64 + perm_key(p0 + j)) * LDR + 64 * kv + dim];
      *(h16x8*)(vt + ((size_t)((b * 2 + kv) * 128 + (s0 >> 6) + blk)) * 4096 + dim * 64 + p0) = v;
    }
  } else {
    float* gates = (float*)(ws + OFF_GATES);
#pragma unroll
    for (int i = 0; i < 12; ++i) {
      const int idx = i * NTHREADS + tid_e;
      const int r = idx / 24, cc = idx % 24;
      gates[(size_t)(row0 + r) * 24 + cc] = sigm((float)sm[r * LDR + cc]);
    }
  }
  __syncthreads();
}
__device__ __forceinline__ void phase_inproj(const Params& p, int l, h16* sm) {
  const TileIter tf = xcd_tiles(64 * 19);
  for (int t = tf.cur; t < tf.end; t += tf.step) inproj_tile(p, sm, t / 19, t % 19);
  if (l == 0) conv_share(p, 0, CV_MOE0, CV_Q1, 0, (64 * 19 / 8) % (gridDim.x >> 3), (float*)sm);
}

__device__ __forceinline__ void mixa_compress1(const Params& p, int item, h16* sm) {
  unsigned char* ws = p.ws;
  const int which = item >> 6, mt = (item >> 3) & 7, ks = (item >> 1) & 3, half = item & 1;
  const h16* A = (const h16*)(ws + (which ? OFF_VC : OFF_KC)) + (size_t)mt * 256 * 1024 + ks * 512;
  const h16* W = (const h16*)(ws + (which ? OFF_W1V : OFF_W1K)) + (size_t)half * 128 * 2048 + ks * 512;
  float* hp = (float*)(ws + OFF_HIDP) + ((size_t)(ks * 2 + which) * 2048) * 256;
  f32x4 acc[8][2];
  gemm_mainloop<128>(acc, [&](int r) { return A + (size_t)r * 1024; }, W, 2048, 8, sm);
  const int tid_e = tidx(), lane = tid_e & 63, wave = tid_e >> 6, wr = wave >> 2, wc = wave & 3, fr = lane & 15, fq = lane >> 4;
#pragma unroll
  for (int m = 0; m < 8; ++m)
#pragma unroll
    for (int n = 0; n < 2; ++n) {
      const int row = mt * 256 + wr * 128 + m * 16 + fr, col = half * 128 + wc * 32 + n * 16 + 4 * fq;
      *(f32x4*)(hp + (size_t)row * 256 + col) = acc[m][n];
    }
}

__device__ __forceinline__ void mixa_lru(const Params& p, int l, int item, float* sm) {
  unsigned char* ws = p.ws;
  const int tid = tidx();
  const int half = tid >> 8;
  item = item * 2 + half;
  sm += half * 14400;
  const int b = item >> 8, ck = item & 255;
  const int c = tid & 255;
  const int nb = c >> 6;
  const int lane = tid & 63, fr = lane & 15, fq = lane >> 4;
  const h16* P = (const h16*)(ws + OFF_P16);
  const float* cw = p.in[I_LCW] + l * 4 * 256;
  const float w0 = cw[c], w1 = cw[256 + c], w2 = cw[512 + c], w3 = cw[768 + c], cb = p.in[I_LCB][l * 256 + c];
  const float ba = p.in[I_LBA][l * 256 + c], bx = p.in[I_LBX][l * 256 + c];
  const float lam = p.in[I_LLAM][l * 256 + c];
  const float ls = -log1pf(expf(-lam));
  h16x8 bw[2][4][2];
  {
    const h16* lw = (const h16*)(ws + OFF_LRUW);
#pragma unroll
    for (int mat = 0; mat < 2; ++mat)
#pragma unroll
      for (int nt = 0; nt < 4; ++nt)
#pragma unroll
        for (int ks = 0; ks < 2; ++ks) bw[mat][nt][ks] = *(const h16x8*)(lw + ((size_t)((mat * 4 + nb) * 64 + nt * 16 + fr)) * 64 + ks * 32 + 8 * fq);
  }
  const int t0 = ck * 32;
  float x0 = 0.f, x1 = 0.f, x2 = 0.f;
  if (t0 >= 3) {
    x0 = (float)P[(size_t)(b * S + t0 - 3) * NIN + C_XL + c];
    x1 = (float)P[(size_t)(b * S + t0 - 2) * NIN + C_XL + c];
    x2 = (float)P[(size_t)(b * S + t0 - 1) * NIN + C_XL + c];
  }
  float h = 0.f, ap = 1.f;
  float* lh = (float*)(ws + OFF_LRUH);
  float* la = (float*)(ws + OFF_LRUA);
  float* sr = sm + 4096;
  float* si = sm + 8192;
  h16* xh = (h16*)(sm + 12288);
#pragma unroll 1
  for (int sub = 0; sub < 2; ++sub) {
    const int tb = t0 + sub * 16;
    {
      h16 xv[16];
      const h16* xp = P + (size_t)(b * S + tb) * NIN + C_XL + c;
#pragma unroll
      for (int tt = 0; tt < 16; ++tt) { xv[tt] = *xp; xp += NIN; asm volatile("" : "+v"(xp)); }
#pragma unroll
      for (int tt = 0; tt < 16; ++tt) {
        const float x3 = (float)xv[tt];
        const float xc = w0 * x0 + w1 * x1 + w2 * x2 + w3 * x3 + cb;
        sm[tt * 256 + c] = xc;
        xh[tt * 264 + c] = (h16)xc;
        x0 = x1; x1 = x2; x2 = x3;
      }
    }
    {
      h16x8 af[2];
#pragma unroll
      for (int ks = 0; ks < 2; ++ks) af[ks] = *(const h16x8*)(xh + fr * 264 + nb * 64 + ks * 32 + 8 * fq);
#pragma unroll
      for (int nt = 0; nt < 4; ++nt) {
        f32x4 ar = {0.f, 0.f, 0.f, 0.f}, ai = {0.f, 0.f, 0.f, 0.f};
#pragma unroll
        for (int ks = 0; ks < 2; ++ks) {
          ar = __builtin_amdgcn_mfma_f32_16x16x32_f16(af[ks], bw[0][nt][ks], ar, 0, 0, 0);
          ai = __builtin_amdgcn_mfma_f32_16x16x32_f16(af[ks], bw[1][nt][ks], ai, 0, 0, 0);
        }
#pragma unroll
        for (int j = 0; j < 4; ++j) {
          sr[(4 * fq + j) * 256 + nb * 64 + nt * 16 + fr] = ar[j];
          si[(4 * fq + j) * 256 + nb * 64 + nt * 16 + fr] = ai[j];
        }
      }
    }
#pragma unroll 4
    for (int tt = 0; tt < 16; ++tt) {
      const float r = sigm(sr[tt * 256 + c] + ba), ig = sigm(si[tt * 256 + c] + bx);
      const float log_a = 8.f * r * ls;
      const float a = __expf(log_a);
      const float mult = sqrtf(-expm1f(2.f * log_a));
      sr[tt * 256 + c] = a;
      si[tt * 256 + c] = mult * ig * sm[tt * 256 + c];
    }
    float* lhp = lh + (size_t)(b * S + tb) * 256 + c;
    float* lap = la + (size_t)(b * S + tb) * 256 + c;
#pragma unroll 4
    for (int tt = 0; tt < 16; ++tt) {
      const float a = sr[tt * 256 + c];
      h = a * h + si[tt * 256 + c];
      ap *= a;
      lhp[tt * 256] = h;
      lap[tt * 256] = ap;
    }
  }
  ((float*)(ws + OFF_HEND))[(size_t)(b * 256 + ck) * 256 + c] = h;
  ((float*)(ws + OFF_AEND))[(size_t)(b * 256 + ck) * 256 + c] = ap;
  __syncthreads();
}

__device__ __forceinline__ void mixa_conv(const Params& p, int l, int item, float* sm) {
  unsigned char* ws = p.ws;
  const int half = tidx() >> 8;
  item = item * 2 + half;
  sm += half * 15872;
  const int b = item >> 8, ck = item & 255;
  const int c = tidx() & 255;
  const h16* P = (const h16*)(ws + OFF_P16);
  const int t0 = ck * 32;
  float col[64];
#pragma unroll
  for (int r0 = 0; r0 < 64; r0 += 16) {
    h16 va[16], vb[16];
#pragma unroll
    for (int q = 0; q < 16; ++q) {
      const int t = t0 - 30 + r0 + q;
      va[q] = (h16)0.f; vb[q] = (h16)0.f;
      if (t >= 0 && r0 + q < 62) {
        const h16* pr = P + (size_t)(b * S + t) * NIN;
        va[q] = pr[C_CVA + c]; vb[q] = pr[C_CVB + c];
      }
    }
#pragma unroll
    for (int q = 0; q < 16; ++q) col[r0 + q] = (float)va[q] * sigm((float)vb[q]);
    asm volatile("" ::: "memory");
  }
  float w[31];
#pragma unroll
  for (int j = 0; j < 31; ++j) w[j] = p.in[I_DWW][(size_t)(l * 31 + j) * 256 + c];
  const float bias = p.in[I_DWB][l * 256 + c];
#pragma unroll
  for (int i = 0; i < 32; ++i) {
    float z = bias;
#pragma unroll
    for (int j = 0; j < 31; ++j) z += w[j] * col[i + j];
    sm[i * 256 + c] = z;
  }
  __syncthreads();
  const int lane = tidx() & 63, wave = (tidx() >> 6) & 3;
  const float4 lg = *(const float4*)(p.in[I_LNG] + l * 256 + lane * 4);
  const float4 lb = *(const float4*)(p.in[I_LNB] + l * 256 + lane * 4);
  const float4 gn = *(const float4*)(p.in[I_ONG] + l * 1024 + 768 + lane * 4);
  h16* yc = (h16*)(ws + OFF_H16);
  for (int i = wave * 8; i < wave * 8 + 8; ++i) {
    const float4 z = *(const float4*)(sm + i * 256 + lane * 4);
    const float mu = wsum(z.x + z.y + z.z + z.w) * (1.f / 256.f);
    const float dx = z.x - mu, dy = z.y - mu, dz = z.z - mu, dw = z.w - mu;
    const float var = wsum(dx * dx + dy * dy + dz * dz + dw * dw) * (1.f / 256.f);
    const float rs = rsqrtf(var + EPS);
    const float y0 = silu_f(dx * rs * lg.x + lb.x), y1 = silu_f(dy * rs * lg.y + lb.y), y2 = silu_f(dz * rs * lg.z + lb.z), y3 = silu_f(dw * rs * lg.w + lb.w);
    const float r2 = rsqrtf(wsum(y0 * y0 + y1 * y1 + y2 * y2 + y3 * y3) * (1.f / 256.f) + EPS);
    *(h16x4*)(yc + (size_t)(b * S + t0 + i) * D + 768 + lane * 4) = pack4(y0 * r2 * gn.x, y1 * r2 * gn.y, y2 * r2 * gn.z, y3 * r2 * gn.w);
  }
  __syncthreads();
}

__device__ __forceinline__ void phase_mixa(const Params& p, int l, void* sm) {
  const int G = gridDim.x;
  if (blockIdx.x == 0) {
    const int o = tidx();
    const float* pp = (const float*)(p.ws + OFF_PBPART) + (size_t)(o >> 8) * 32 * 256 + (o & 255);
    float pv[32];
#pragma unroll
    for (int k = 0; k < 32; ++k) pv[k] = pp[k * 256];
    float accb = 0.f;
#pragma unroll
    for (int k = 0; k < 32; ++k) accb += pv[k];
    ((float*)(p.ws + OFF_PB))[o] = accb;
  }
  for (int it = blockIdx.x; it < 128; it += G) mixa_compress1(p, it, (h16*)sm);
  for (int it = blockIdx.x; it < 256; it += G) mixa_lru(p, l, it, (float*)sm);
  for (int it = (blockIdx.x + G - 64 % G) % G; it < 256; it += G) mixa_conv(p, l, it, (float*)sm);
  if (l == 0) conv_share(p, 0, CV_Q1, CV_Q2, 0, 16, (float*)sm);
}

__device__ __forceinline__ void phase_mixb(const Params& p, int l, float* sm) {
  unsigned char* ws = p.ws;
  const int tid = tidx();
  for (int it = blockIdx.x; it < 512; it += gridDim.x) {
    const int which = it >> 8;
    const int row0 = (it & 255) * 8;
    {
      const float* hp = (const float*)(ws + OFF_HIDP) + ((size_t)which * 2048 + row0) * 256;
      const float* pb = (const float*)(ws + OFF_PB) + which * 256;
      const int r = tid >> 6, c4 = (tid & 63) * 4;
      const size_t o = (size_t)r * 256 + c4;
      const float4 a0 = *(const float4*)(hp + o), a1 = *(const float4*)(hp + (size_t)2 * 2048 * 256 + o);
      const float4 a2 = *(const float4*)(hp + (size_t)4 * 2048 * 256 + o), a3 = *(const float4*)(hp + (size_t)6 * 2048 * 256 + o);
      const float4 bb = *(const float4*)(pb + c4);
      float* d = sm + r * 256 + c4;
      d[0] = gelu_tanh(a0.x + a1.x + a2.x + a3.x + bb.x); d[1] = gelu_tanh(a0.y + a1.y + a2.y + a3.y + bb.y);
      d[2] = gelu_tanh(a0.z + a1.z + a2.z + a3.z + bb.z); d[3] = gelu_tanh(a0.w + a1.w + a2.w + a3.w + bb.w);
      const float4* wsrc = (const float4*)(p.in[which ? I_CVW2 : I_CKW2] + (size_t)l * 256 * 64);
      float4* wdst = (float4*)(sm + 2048);
#pragma unroll
      for (int q = 0; q < 8; ++q) wdst[q * NTHREADS + tid] = wsrc[q * NTHREADS + tid];
    }
    __syncthreads();
    const int row = row0 + (tid >> 6), d = tid & 63;
    const float* hr = sm + (tid >> 6) * 256;
    const float* w2 = sm + 2048 + d;
    float s = 0.f;
#pragma unroll 8
    for (int j = 0; j < 256; ++j) s += (float)(h16)hr[j] * w2[j * 64];
    const int bkv = row >> 9, n = row & 511;
    if (n == 511) s = 0.f;
    if (which == 0) {
      ((h16*)(ws + OFF_KCMP))[((size_t)bkv * 512 + n) * 64 + d] = (h16)s;
    } else {
      const int blk = n >> 6, key = n & 63;
      const int pos = 32 * (key >> 5) + 8 * ((key >> 2) & 3) + 4 * ((key >> 4) & 1) + (key & 3);
      ((h16*)(ws + OFF_VCMPT))[((size_t)(bkv * 8 + blk) * 64 + d) * 64 + pos] = (h16)s;
    }
    __syncthreads();
  }
  for (int task = (blockIdx.x + gridDim.x - 16 % gridDim.x) % gridDim.x; task < 16; task += gridDim.x) {
    const int b = task >> 3, c = (task & 7) * 32 + (tid & 31), grp = tid >> 5;
    const float* he = (const float*)(ws + OFF_HEND) + ((size_t)b * 256 + grp * 16) * 256 + c;
    const float* ae = (const float*)(ws + OFF_AEND) + ((size_t)b * 256 + grp * 16) * 256 + c;
    float* cy = (float*)(ws + OFF_CARRY) + ((size_t)b * 256 + grp * 16) * 256 + c;
    float hv[16], av[16];
#pragma unroll
    for (int k = 0; k < 16; ++k) { hv[k] = he[k * 256]; av[k] = ae[k * 256]; }
    float ga = 1.f, gh = 0.f;
#pragma unroll
    for (int k = 0; k < 16; ++k) { gh = hv[k] + av[k] * gh; ga *= av[k]; }
    sm[tid] = ga; sm[512 + tid] = gh;
    __syncthreads();
    float carry = 0.f;
    for (int q = 0; q < grp; ++q) carry = sm[512 + q * 32 + (tid & 31)] + sm[q * 32 + (tid & 31)] * carry;
#pragma unroll
    for (int k = 0; k < 16; ++k) {
      cy[k * 256] = carry;
      carry = hv[k] + av[k] * carry;
    }
    __syncthreads();
  }
  if (l == 0) conv_share(p, 0, CV_Q2, CV_MOE1, (int)(gridDim.x >> 3) - 2, (int)(gridDim.x >> 3), sm);
}

__device__ __forceinline__ void stage8k(const h16* __restrict__ g, h16* l, int tid) {
  const int r = tid >> 3, cl = (tid & 7) ^ ((r >> 1) & 7);
  glds16(g + r * 64 + cl * 8, l + tid * 8);
}
__device__ __forceinline__ h16x8 ldfrag(const h16* l, int row, int chunk) {
  return *(const h16x8*)(l + row * 64 + ((chunk ^ ((row >> 1) & 7)) * 8));
}

template <int MODE>
__device__ __forceinline__ void attn_branch(const h16* __restrict__ Kg, const h16* __restrict__ Vg, int j0, int j1, h16* ring,
                                            const h16x8 (&qf)[2][2], float (&m)[2], float (&l)[2], f32x4 (&o)[2][4],
                                            const int (&tq)[2], const int (&lim)[2], const int (&tlim)[2], const int (&tfl)[2],
                                            const unsigned long long (&mylo)[2], const unsigned long long (&myhi)[2],
                                            const unsigned long long (&ulo)[2], const unsigned long long (&uhi)[2],
                                            const float (&inv)[2], float* impw) {
  int tid = tidx();
  asm volatile("" : "+v"(tid));
  const int lane = tid & 63;
  const int h = lane >> 4, c = lane & 15, qi = c >> 2, g = c & 3;
  constexpr bool PV = MODE != 0;
  constexpr int SS = 3;
  const int n = j1 - j0 + 1;
  if (n <= 0) return;
  const int nss = (n + SS - 1) / SS;
#pragma unroll
  for (int q = 0; q < SS; ++q)
    if (q < n) {
      stage8k(Kg + (size_t)(j0 + q) * 4096, ring + q * 8192, tid);
      if (PV) stage8k(Vg + (size_t)(j0 + q) * 4096, ring + q * 8192 + 4096, tid);
    }
  int sbase = 0;
  for (int ss = 0; ss < nss; ++ss) {
    VMCNT(0);
    __builtin_amdgcn_s_barrier();
    {
      const int sn = SS - sbase;
#pragma unroll
      for (int q = 0; q < SS; ++q) {
        const int jb = SS * (ss + 1) + q;
        if (jb < n) {
          stage8k(Kg + (size_t)(j0 + jb) * 4096, ring + (sn + q) * 8192, tid);
          if (PV) stage8k(Vg + (size_t)(j0 + jb) * 4096, ring + (sn + q) * 8192 + 4096, tid);
        }
      }
    }
#pragma unroll 1
   for (int sub = 0; sub < SS; ++sub) {
    const int it = SS * ss + sub;
    if (it >= n) break;
    const int j = j0 + it;
    const h16* cK = ring + (sbase + sub) * 8192;
    const h16* cV = cK + 4096;
    bool act[2];
#pragma unroll
    for (int mq = 0; mq < 2; ++mq) {
      if (MODE <= 1) act[mq] = j * 64 <= tlim[mq];
      else if (MODE == 2) act[mq] = ((j < 64 ? (ulo[mq] >> j) : (uhi[mq] >> (j - 64))) & 1ull) != 0ull;
      else act[mq] = (j * 64 <= tlim[mq] + 3) && (j * 64 + 63 > tlim[mq] - 512);
    }
    if (act[0] || act[1]) {
      h16x8 pf[2][2];
      h16x8 kf[4][2];
#pragma unroll
      for (int kt = 0; kt < 4; ++kt)
#pragma unroll
        for (int ks = 0; ks < 2; ++ks) kf[kt][ks] = ldfrag(cK, 16 * kt + c, 4 * ks + h);
#pragma unroll
      for (int mq = 0; mq < 2; ++mq)
        if (act[mq]) {
          f32x4 s[1][4];
          {
#pragma unroll
            for (int kt = 0; kt < 4; ++kt) {
              s[0][kt] = (f32x4){0.f, 0.f, 0.f, 0.f};
#pragma unroll
              for (int ks = 0; ks < 2; ++ks) s[0][kt] = __builtin_amdgcn_mfma_f32_16x16x32_f16(kf[kt][ks], qf[mq][ks], s[0][kt], 0, 0, 0);
            }
          }
          const bool selbit = MODE == 2 ? (((j < 64 ? (mylo[mq] >> j) : (myhi[mq] >> (j - 64))) & 1ull) != 0ull) : true;
          bool interior;
          if (MODE <= 1) interior = j * 64 + 63 <= tfl[mq];
          else if (MODE == 2) interior = j * 64 + 63 <= tfl[mq];
          else interior = (j * 64 + 63 <= tfl[mq]) && (j * 64 > tfl[mq] + 3 - 512);
          if (!interior) {
            const int pbase = j * 64 + 4 * h;
#pragma unroll
            for (int kt = 0; kt < 4; ++kt)
#pragma unroll
              for (int i = 0; i < 4; ++i) {
                const int pos = pbase + 16 * kt + i;
                bool v;
                if (MODE <= 1) v = pos <= lim[mq];
                else if (MODE == 2) v = selbit && pos <= tq[mq];
                else v = pos <= tq[mq] && pos > tq[mq] - 512;
                s[0][kt][i] = v ? s[0][kt][i] : -1e30f;
              }
          }
          const bool rowoff = MODE == 2 && interior && !selbit;
          if (MODE == 1) {
#pragma unroll
            for (int kt = 0; kt < 4; ++kt) {
              float ps = 0.f;
#pragma unroll
              for (int i = 0; i < 4; ++i) {
                const float pv = __builtin_amdgcn_exp2f(s[0][kt][i] - m[mq]) * inv[mq];
                s[0][kt][i] = pv;
                ps += pv;
              }
              ps += __shfl_xor(ps, 1);
              ps += __shfl_xor(ps, 2);
              if (g == 0) impw[(4 * mq + qi) * 128 + j * 16 + kt * 4 + h] = ps;
            }
          } else {
            float bm = fmaxf(fmaxf(fmaxf(s[0][0][0], s[0][0][1]), fmaxf(s[0][0][2], s[0][0][3])), fmaxf(fmaxf(s[0][1][0], s[0][1][1]), fmaxf(s[0][1][2], s[0][1][3])));
            bm = fmaxf(bm, fmaxf(fmaxf(fmaxf(s[0][2][0], s[0][2][1]), fmaxf(s[0][2][2], s[0][2][3])), fmaxf(fmaxf(s[0][3][0], s[0][3][1]), fmaxf(s[0][3][2], s[0][3][3]))));
            bm = rowoff ? -1e30f : bm;
            if (__any(bm > m[mq] + 8.f)) {
              bm = fmaxf(bm, __shfl_xor(bm, 16));
              bm = fmaxf(bm, __shfl_xor(bm, 32));
              const float mn = fmaxf(m[mq], bm);
              const float alpha = __builtin_amdgcn_exp2f(m[mq] - mn);
              l[mq] *= alpha;
              m[mq] = mn;
              if (PV) {
#pragma unroll
                for (int mt = 0; mt < 4; ++mt) o[mq][mt] *= alpha;
              }
            }
            const float mref = (m[mq] > -1e29f && !rowoff) ? m[mq] : 1e30f;
            float ps = 0.f;
#pragma unroll
            for (int kt = 0; kt < 4; ++kt)
#pragma unroll
              for (int i = 0; i < 4; ++i) {
                const float pv = __builtin_amdgcn_exp2f(s[0][kt][i] - mref);
                s[0][kt][i] = pv;
                ps += pv;
              }
            l[mq] += ps;
          }
          if (PV) {
#pragma unroll
            for (int s2 = 0; s2 < 2; ++s2)
#pragma unroll
              for (int i = 0; i < 4; ++i) { pf[mq][s2][i] = (h16)s[0][2 * s2][i]; pf[mq][s2][4 + i] = (h16)s[0][2 * s2 + 1][i]; }
          }
        }
      if (PV) {
        h16x8 vf[4][2];
#pragma unroll
        for (int mt = 0; mt < 4; ++mt)
#pragma unroll
          for (int s2 = 0; s2 < 2; ++s2) vf[mt][s2] = ldfrag(cV, 16 * mt + c, 4 * s2 + h);
#pragma unroll
        for (int mq = 0; mq < 2; ++mq)
          if (act[mq]) {
#pragma unroll
            for (int s2 = 0; s2 < 2; ++s2) {
#pragma unroll
              for (int mt = 0; mt < 4; ++mt) o[mq][mt] = __builtin_amdgcn_mfma_f32_16x16x32_f16(vf[mt][s2], pf[mq][s2], o[mq][mt], 0, 0, 0);
            }
          }
      }
    }
   }
    sbase = SS - sbase;
  }
  __builtin_amdgcn_s_barrier();
}

__device__ __forceinline__ void attn_item(const Params& p, int l, int item, float* sm) {
  unsigned char* ws = p.ws;
  int tid = tidx();
  asm volatile("" : "+v"(tid));
  const int lane = tid & 63, wave = tid >> 6;
  const int combo = item & 3, qt = item >> 2;
  const int b = combo >> 1, kv = combo & 1;
  const int t0 = qt * 64, tw0 = t0 + 8 * wave;
  const int h = lane >> 4, c = lane & 15, qi = c >> 2, g = c & 3;
  const int head = kv * 4 + g, bkv = b * 2 + kv;
  h16* ring = (h16*)sm;
  float* impw = sm + 24576 + wave * 1024;
  unsigned long long* selm = (unsigned long long*)(sm + 24576 + 8192) + wave * 16;

  h16x8 qf[2][2];
  int tq[2];
#pragma unroll
  for (int mq = 0; mq < 2; ++mq) {
    tq[mq] = tw0 + 4 * mq + qi;
    const h16* qrow = (const h16*)(ws + OFF_Q16) + (size_t)(b * S + tq[mq]) * 512 + head * 64;
    qf[mq][0] = *(const h16x8*)(qrow + 8 * h);
    qf[mq][1] = *(const h16x8*)(qrow + 32 + 8 * h);
  }
  for (int i = lane; i < 1024; i += 64) impw[i] = 0.f;

  h16x4 ofin[2][4];
  float m[2], ll[2], inv[2];
  f32x4 o[2][4];
  const unsigned long long z2[2] = {0ull, 0ull};
  {
    int lim[2], tlim[2], tflc[2];
#pragma unroll
    for (int mq = 0; mq < 2; ++mq) {
      lim[mq] = tq[mq] >= 31 ? ((tq[mq] - 31) >> 4) : -1;
      const int tl = tw0 + 4 * mq + 3;
      tlim[mq] = tl >= 31 ? ((tl - 31) >> 4) : -1;
      const int tf0 = tw0 + 4 * mq;
      tflc[mq] = tf0 >= 31 ? ((tf0 - 31) >> 4) : -1;
      m[mq] = -1e30f; ll[mq] = 0.f; inv[mq] = 0.f;
#pragma unroll
      for (int mt = 0; mt < 4; ++mt) o[mq][mt] = (f32x4){0.f, 0.f, 0.f, 0.f};
    }
    const int nl = (t0 + 63 - 31) >> 4;
    const int jl = nl >> 6;
    const h16* Kc = (const h16*)(ws + OFF_KCMP) + (size_t)bkv * 512 * 64;
    const h16* Vc = (const h16*)(ws + OFF_VCMPT) + (size_t)bkv * 8 * 4096;
    attn_branch<0>(Kc, Vc, 0, jl, ring, qf, m, ll, o, tq, lim, tlim, tflc, z2, z2, z2, z2, inv, impw);
#pragma unroll
    for (int mq = 0; mq < 2; ++mq) {
      float lt = ll[mq];
      lt += __shfl_xor(lt, 16);
      lt += __shfl_xor(lt, 32);
      inv[mq] = lt > 0.f ? 1.f / lt : 0.f;
    }
    attn_branch<1>(Kc, Vc, 0, jl, ring, qf, m, ll, o, tq, lim, tlim, tflc, z2, z2, z2, z2, inv, impw);
    const float* gt0 = (const float*)(ws + OFF_GATES) + (size_t)(b * S) * 24 + head * 3;
#pragma unroll
    for (int mq = 0; mq < 2; ++mq) {
      const float g0 = gt0[(size_t)tq[mq] * 24] * ASCALE;
#pragma unroll
      for (int mt = 0; mt < 4; ++mt) ofin[mq][mt] = pack4(o[mq][mt][0] * g0, o[mq][mt][1] * g0, o[mq][mt][2] * g0, o[mq][mt][3] * g0);
    }
  }
  for (int q = 0; q < 8; ++q) {
    const int t = tw0 + q, own = t >> 6;
    const float* ir = impw + q * 128;
    const int ja = lane, jb = lane + 64;
    unsigned k0 = 0u, k1 = 0u;
    if (ja <= own) k0 = (ja == 0 || ja == own) ? (0xFFFFFF80u | (unsigned)(127 - ja)) : (((__float_as_uint(ir[ja]) & ~127u) | (unsigned)(127 - ja)) + 1u);
    if (jb <= own) k1 = (jb == own) ? (0xFFFFFF80u | (unsigned)(127 - jb)) : (((__float_as_uint(ir[jb]) & ~127u) | (unsigned)(127 - jb)) + 1u);
    unsigned thr = 0u;
    for (int bit = 31; bit >= 0; --bit) {
      const unsigned cand = thr | (1u << bit);
      const int cnt = __popcll(__ballot(k0 >= cand)) + __popcll(__ballot(k1 >= cand));
      if (cnt >= 16) thr = cand;
    }
    const unsigned long long mlo = __ballot(k0 >= thr && ja <= own);
    const unsigned long long mhi = __ballot(k1 >= thr && jb <= own);
    if (lane == 0) { selm[q * 2] = mlo; selm[q * 2 + 1] = mhi; }
  }
  unsigned long long mylo[2], myhi[2], ulo[2], uhi[2];
#pragma unroll
  for (int mq = 0; mq < 2; ++mq) {
    mylo[mq] = selm[(4 * mq + qi) * 2];
    myhi[mq] = selm[(4 * mq + qi) * 2 + 1];
    unsigned long long a = selm[(4 * mq) * 2] | selm[(4 * mq + 1) * 2] | selm[(4 * mq + 2) * 2] | selm[(4 * mq + 3) * 2];
    unsigned long long bb = selm[(4 * mq) * 2 + 1] | selm[(4 * mq + 1) * 2 + 1] | selm[(4 * mq + 2) * 2 + 1] | selm[(4 * mq + 3) * 2 + 1];
    ulo[mq] = (unsigned long long)__builtin_amdgcn_readfirstlane((unsigned)a) | ((unsigned long long)__builtin_amdgcn_readfirstlane((unsigned)(a >> 32)) << 32);
    uhi[mq] = (unsigned long long)__builtin_amdgcn_readfirstlane((unsigned)bb) | ((unsigned long long)__builtin_amdgcn_readfirstlane((unsigned)(bb >> 32)) << 32);
  }
  const float* gtb = (const float*)(ws + OFF_GATES) + (size_t)(b * S) * 24 + head * 3;
  {
    int tl0[2] = {0, 0};
    const int tfs[2] = {tw0, tw0 + 4};
#pragma unroll
    for (int mq = 0; mq < 2; ++mq) {
      m[mq] = -1e30f; ll[mq] = 0.f;
#pragma unroll
      for (int mt = 0; mt < 4; ++mt) o[mq][mt] = (f32x4){0.f, 0.f, 0.f, 0.f};
    }
    attn_branch<2>((const h16*)(ws + OFF_KS) + (size_t)bkv * S * 64, (const h16*)(ws + OFF_VST) + (size_t)bkv * 128 * 4096, 0, (t0 + 63) >> 6, ring, qf, m, ll, o,
                   tq, tl0, tl0, tfs, mylo, myhi, ulo, uhi, inv, impw);
#pragma unroll
    for (int mq = 0; mq < 2; ++mq) {
      float lt = ll[mq];
      lt += __shfl_xor(lt, 16);
      lt += __shfl_xor(lt, 32);
      const float sc = lt > 0.f ? gtb[(size_t)tq[mq] * 24 + 1] * ASCALE / lt : 0.f;
#pragma unroll
      for (int mt = 0; mt < 4; ++mt)
        ofin[mq][mt] = pack4((float)ofin[mq][mt][0] + o[mq][mt][0] * sc, (float)ofin[mq][mt][1] + o[mq][mt][1] * sc, (float)ofin[mq][mt][2] + o[mq][mt][2] * sc,
                             (float)ofin[mq][mt][3] + o[mq][mt][3] * sc);
    }
  }
  {
    int tl0[2] = {0, 0}, tf[2];
#pragma unroll
    for (int mq = 0; mq < 2; ++mq) {
      tf[mq] = tw0 + 4 * mq;
      m[mq] = -1e30f; ll[mq] = 0.f;
#pragma unroll
      for (int mt = 0; mt < 4; ++mt) o[mq][mt] = (f32x4){0.f, 0.f, 0.f, 0.f};
    }
    const int jlo = t0 >= 511 ? ((t0 - 511) >> 6) : 0;
    attn_branch<3>((const h16*)(ws + OFF_KW) + (size_t)bkv * S * 64, (const h16*)(ws + OFF_VWT) + (size_t)bkv * 128 * 4096, jlo, (t0 + 63) >> 6, ring, qf, m, ll, o,
                   tq, tl0, tf, tf, z2, z2, z2, z2, inv, impw);
#pragma unroll
    for (int mq = 0; mq < 2; ++mq) {
      float lt = ll[mq];
      lt += __shfl_xor(lt, 16);
      lt += __shfl_xor(lt, 32);
      const float sc = lt > 0.f ? gtb[(size_t)tq[mq] * 24 + 2] * ASCALE / lt : 0.f;
#pragma unroll
      for (int mt = 0; mt < 4; ++mt)
        ofin[mq][mt] = pack4((float)ofin[mq][mt][0] + o[mq][mt][0] * sc, (float)ofin[mq][mt][1] + o[mq][mt][1] * sc, (float)ofin[mq][mt][2] + o[mq][mt][2] * sc,
                             (float)ofin[mq][mt][3] + o[mq][mt][3] * sc);
    }
  }
  {
    h16* yc = (h16*)(ws + OFF_H16);
    const float* gn = p.in[I_ONG] + l * 1024 + 256 + head * 64;
    float* ssq = (float*)(ws + OFF_SSQ);
#pragma unroll
    for (int mq = 0; mq < 2; ++mq) {
      float sq = 0.f;
      h16* yr = yc + (size_t)(b * S + tq[mq]) * D + head * 64;
#pragma unroll
      for (int mt = 0; mt < 4; ++mt) {
        const float v[4] = {(float)ofin[mq][mt][0], (float)ofin[mq][mt][1], (float)ofin[mq][mt][2], (float)ofin[mq][mt][3]};
        sq += v[0] * v[0] + v[1] * v[1] + v[2] * v[2] + v[3] * v[3];
        const float4 gg = *(const float4*)(gn + 16 * mt + 4 * h);
        *(h16x4*)(yr + 16 * mt + 4 * h) = pack4(v[0] * gg.x, v[1] * gg.y, v[2] * gg.z, v[3] * gg.w);
      }
      sq += __shfl_xor(sq, 16);
      sq += __shfl_xor(sq, 32);
      sq += __shfl_xor(sq, 1);
      sq += __shfl_xor(sq, 2);
      if (h == 0 && g == 0) ssq[(size_t)(b * S + tq[mq]) * 2 + kv] = sq * (1.f / (ASCALE * ASCALE));
    }
  }
}

__device__ __forceinline__ void lrufix_item(const Params& p, int l, int item) {
  unsigned char* ws = p.ws;
  const int lane = tidx() & 63, wave = tidx() >> 6;
  const int b = item >> 7, ck = item & 127;
  const h16* P = (const h16*)(ws + OFF_P16);
  const float4 cy = *(const float4*)((const float*)(ws + OFF_CARRY) + (size_t)(b * 256 + ck * 2 + (wave >> 2)) * 256 + lane * 4);
  const float4 gn = *(const float4*)(p.in[I_ONG] + l * 1024 + lane * 4);
  h16* yc = (h16*)(ws + OFF_H16);
  float4 hl[8], al[8];
  h16x4 gl[8];
#pragma unroll
  for (int q = 0; q < 8; ++q) {
    const size_t row = (size_t)(b * S + ck * 64 + wave * 8 + q);
    hl[q] = *(const float4*)((const float*)(ws + OFF_LRUH) + row * 256 + lane * 4);
    al[q] = *(const float4*)((const float*)(ws + OFF_LRUA) + row * 256 + lane * 4);
    gl[q] = *(const h16x4*)(P + row * NIN + C_GL + lane * 4);
  }
#pragma unroll
  for (int q = 0; q < 8; ++q) {
    const size_t row = (size_t)(b * S + ck * 64 + wave * 8 + q);
    const float y0 = (hl[q].x + al[q].x * cy.x) * gelu_tanh((float)gl[q][0]);
    const float y1 = (hl[q].y + al[q].y * cy.y) * gelu_tanh((float)gl[q][1]);
    const float y2 = (hl[q].z + al[q].z * cy.z) * gelu_tanh((float)gl[q][2]);
    const float y3 = (hl[q].w + al[q].w * cy.w) * gelu_tanh((float)gl[q][3]);
    const float rstd = rsqrtf(wsum(y0 * y0 + y1 * y1 + y2 * y2 + y3 * y3) * (1.f / 256.f) + EPS);
    *(h16x4*)(yc + row * D + 512 + lane * 4) = pack4(y0 * rstd * gn.x, y1 * rstd * gn.y, y2 * rstd * gn.z, y3 * rstd * gn.w);
  }
}

__device__ __forceinline__ void phase_attn(const Params& p, int l, float* sm) {
  for (int it = blockIdx.x; it < 256; it += gridDim.x) {
#pragma unroll 1
    for (int rep = 0; rep < 2; ++rep) attn_item(p, l, rep ? (127 - (it >> 2)) * 4 + (it & 3) : it, sm);
  }
  for (int it = blockIdx.x; it < 256; it += gridDim.x) lrufix_item(p, l, it);
}

__device__ __forceinline__ void phase_outproj(const Params& p, int l, h16* sm) {
  unsigned char* ws = p.ws;
  const h16* A = (const h16*)(ws + OFF_H16);
  const h16* W = (const h16*)(ws + OFF_WOUT);
  const float* mod = (const float*)(ws + OFF_MOD);
  float* xa = (float*)(ws + OFF_XA);
  const float* xin = l == 0 ? p.in[I_X] : (const float*)xa;
  const TileIter ti = xcd_tiles(64 * 4);
  for (int t = ti.cur; t < ti.end; t += ti.step) {
    const int mt = t >> 2, nt = t & 3;
    f32x4 acc[8][4];
    const h16* Ab = A + (size_t)mt * 256 * D;
    {
      float* sct = (float*)((unsigned char*)sm + SCHED_OFF - 1024);
      const int tq_ = tidx();
      if (tq_ < 256) {
        const float2 q2 = *(const float2*)((const float*)(ws + OFF_SSQ) + (size_t)(mt * 256 + tq_) * 2);
        sct[tq_] = rsqrtf((q2.x + q2.y) * (1.f / 512.f) + EPS) * (1.f / ASCALE);
      }
    }
    gemm_mainloop<256>(acc, [&](int r) { return Ab + (size_t)r * D; }, W + (size_t)nt * 256 * D, D, 8, sm);
    const int tid_e = tidx(), lane = tid_e & 63, wave = tid_e >> 6, wr = wave >> 2, wc = wave & 3, fr = lane & 15, fq = lane >> 4;
    {
      const float* sct = (const float*)((const unsigned char*)sm + SCHED_OFF - 1024) + wr * 128 + fr;
#pragma unroll
      for (int m = 0; m < 8; ++m) {
        const float sc = sct[m * 16];
#pragma unroll
        for (int n = 0; n < 4; ++n) acc[m][n] *= sc;
      }
    }
    gemm_mainloop<256>(acc, [&](int r) { return Ab + (size_t)r * D + 512; }, W + (size_t)nt * 256 * D + 512, D, 8, sm, false);
    {
      float* stf = (float*)sm;
      constexpr int LDF = 260;
#pragma unroll 1
      for (int pass = 0; pass < 2; ++pass) {
        if (wr == pass) {
#pragma unroll
          for (int m = 0; m < 8; ++m)
#pragma unroll
            for (int n = 0; n < 4; ++n) *(f32x4*)(stf + (m * 16 + fr) * LDF + wc * 64 + n * 16 + 4 * fq) = acc[m][n];
        }
        __syncthreads();
#pragma unroll 4
        for (int i = 0; i < 16; ++i) {
          const int idx = i * NTHREADS + tid_e;
          const int r = idx >> 6, c4 = (idx & 63) * 4;
          const int row = mt * 256 + pass * 128 + r, col = nt * 256 + c4;
          const int b = row >> 13;
          const f32x4 a = *(const f32x4*)(stf + r * LDF + c4);
          const float4 g1 = *(const float4*)(mod + (size_t)(l * 2 + b) * 6144 + 2048 + col);
          const float4 xv = *(const float4*)(xin + (size_t)row * D + col);
          float4 o;
          o.x = xv.x + g1.x * a[0]; o.y = xv.y + g1.y * a[1]; o.z = xv.z + g1.z * a[2]; o.w = xv.w + g1.w * a[3];
          *(float4*)(xa + (size_t)row * D + col) = o;
        }
        __syncthreads();
      }
    }
  }
}

__device__ __forceinline__ void phase_router(const Params& p, int l, int* smi) {
  unsigned char* ws = p.ws;
  const int tid = tidx(), lane = tid & 63, wave = tid >> 6;
  const float* mod = (const float*)(ws + OFF_MOD);
  const float* xa = (const float*)(ws + OFF_XA);
  h16* hout = (h16*)(ws + OFF_H16);
  unsigned* cnt = (unsigned*)(ws + OFF_CTL) + 64 + l * 16;
  int* list = (int*)(ws + OFF_LIST);
  float* wpair = (float*)(ws + OFF_WPAIR);
  const float* rgb = p.in[I_RGB] + l * 4;
  int* cntl = smi;
  int* basel = smi + 16;
  int* tok = smi + 32;
  float* wl = (float*)smi + 256;
  {
    const float4* s0 = (const float4*)(p.in[I_RGW] + (size_t)l * 1024 * 4);
    const float4* s1 = (const float4*)(p.in[I_REW] + (size_t)l * 4 * 1024 * 4);
    float4* d = (float4*)wl;
#pragma unroll
    for (int q = 0; q < 2; ++q) d[q * NTHREADS + tid] = s0[q * NTHREADS + tid];
#pragma unroll
    for (int q = 0; q < 8; ++q) d[1024 + q * NTHREADS + tid] = s1[q * NTHREADS + tid];
  }
  const float* rgw = wl;
  for (int chunk = blockIdx.x; chunk < T / 64; chunk += gridDim.x) {
    if (tid < 16) cntl[tid] = 0;
    __syncthreads();
    float4 xn[4];
#pragma unroll
    for (int i = 0; i < 4; ++i) xn[i] = *(const float4*)(xa + (size_t)(chunk * 64 + wave) * D + lane * 4 + 256 * i);
    float4 gsv[4], shv[4];
    {
      const int b = (chunk * 64) >> 13;
#pragma unroll
      for (int i = 0; i < 4; ++i) {
        const int col = lane * 4 + 256 * i;
        const float4 g = *(const float4*)(p.in[I_N2G] + l * D + col);
        const float4 sc = *(const float4*)(mod + (size_t)(l * 2 + b) * 6144 + 4096 + col);
        shv[i] = *(const float4*)(mod + (size_t)(l * 2 + b) * 6144 + 3072 + col);
        gsv[i] = make_float4(g.x * (1.f + sc.x), g.y * (1.f + sc.y), g.z * (1.f + sc.z), g.w * (1.f + sc.w));
      }
    }
    for (int ti = wave; ti < 64; ti += NW) {
      const int row = chunk * 64 + ti;
      float4 x[4];
      float ss = 0.f;
#pragma unroll
      for (int i = 0; i < 4; ++i) x[i] = xn[i];
      if (ti + NW < 64) {
#pragma unroll
        for (int i = 0; i < 4; ++i) xn[i] = *(const float4*)(xa + (size_t)(row + NW) * D + lane * 4 + 256 * i);
      }
#pragma unroll
      for (int i = 0; i < 4; ++i) ss += x[i].x * x[i].x + x[i].y * x[i].y + x[i].z * x[i].z + x[i].w * x[i].w;
      ss = wsum(ss);
      const float rstd = rsqrtf(ss * (1.f / D) + EPS);
      float lg0 = 0.f, lg1 = 0.f, lg2 = 0.f, lg3 = 0.f;
#pragma unroll
      for (int i = 0; i < 4; ++i) {
        const int col = lane * 4 + 256 * i;
        x[i].x = x[i].x * rstd * gsv[i].x + shv[i].x;
        x[i].y = x[i].y * rstd * gsv[i].y + shv[i].y;
        x[i].z = x[i].z * rstd * gsv[i].z + shv[i].z;
        x[i].w = x[i].w * rstd * gsv[i].w + shv[i].w;
        *(h16x4*)(hout + (size_t)row * D + col) = pack4(x[i].x, x[i].y, x[i].z, x[i].w);
        const float4 w0 = *(const float4*)(rgw + (size_t)(col + 0) * 4), w1 = *(const float4*)(rgw + (size_t)(col + 1) * 4);
        const float4 w2 = *(const float4*)(rgw + (size_t)(col + 2) * 4), w3 = *(const float4*)(rgw + (size_t)(col + 3) * 4);
        lg0 += x[i].x * w0.x + x[i].y * w1.x + x[i].z * w2.x + x[i].w * w3.x;
        lg1 += x[i].x * w0.y + x[i].y * w1.y + x[i].z * w2.y + x[i].w * w3.y;
        lg2 += x[i].x * w0.z + x[i].y * w1.z + x[i].z * w2.z + x[i].w * w3.z;
        lg3 += x[i].x * w0.w + x[i].y * w1.w + x[i].z * w2.w + x[i].w * w3.w;
      }
      lg0 = wsum(lg0) + rgb[0]; lg1 = wsum(lg1) + rgb[1]; lg2 = wsum(lg2) + rgb[2]; lg3 = wsum(lg3) + rgb[3];
      int gs = 0; float gm = lg0;
      if (lg1 > gm) { gm = lg1; gs = 1; }
      if (lg2 > gm) { gm = lg2; gs = 2; }
      if (lg3 > gm) { gm = lg3; gs = 3; }
      const float pg = 1.f / (__expf(lg0 - gm) + __expf(lg1 - gm) + __expf(lg2 - gm) + __expf(lg3 - gm));
      const float* rew = wl + 4096 + gs * 4096;
      const float* reb = p.in[I_REB] + (l * 4 + gs) * 4;
      float e0 = 0.f, e1 = 0.f, e2 = 0.f, e3 = 0.f;
#pragma unroll
      for (int i = 0; i < 4; ++i) {
        const int col = lane * 4 + 256 * i;
        const float4 w0 = *(const float4*)(rew + (size_t)(col + 0) * 4), w1 = *(const float4*)(rew + (size_t)(col + 1) * 4);
        const float4 w2 = *(const float4*)(rew + (size_t)(col + 2) * 4), w3 = *(const float4*)(rew + (size_t)(col + 3) * 4);
        e0 += x[i].x * w0.x + x[i].y * w1.x + x[i].z * w2.x + x[i].w * w3.x;
        e1 += x[i].x * w0.y + x[i].y * w1.y + x[i].z * w2.y + x[i].w * w3.y;
        e2 += x[i].x * w0.z + x[i].y * w1.z + x[i].z * w2.z + x[i].w * w3.z;
        e3 += x[i].x * w0.w + x[i].y * w1.w + x[i].z * w2.w + x[i].w * w3.w;
      }
      float le[4];
      le[0] = wsum(e0) + reb[0]; le[1] = wsum(e1) + reb[1]; le[2] = wsum(e2) + reb[2]; le[3] = wsum(e3) + reb[3];
      int i0 = 0; float v0 = le[0];
      if (le[1] > v0) { v0 = le[1]; i0 = 1; }
      if (le[2] > v0) { v0 = le[2]; i0 = 2; }
      if (le[3] > v0) { v0 = le[3]; i0 = 3; }
      int i1 = -1; float v1 = -3.0e38f;
#pragma unroll
      for (int j = 0; j < 4; ++j) {
        const float vj = (j == 0 ? le[0] : j == 1 ? le[1] : j == 2 ? le[2] : le[3]);
        if (j != i0 && vj > v1) { v1 = vj; i1 = j; }
      }
      const float p0 = 1.f / (1.f + __expf(v1 - v0));
      const float p1 = 1.f - p0;
      if (lane == 0) {
        const int ea = gs * 4 + i0, eb = gs * 4 + i1;
        const int ra = atomicAdd(&cntl[ea], 1);
        const int rb = atomicAdd(&cntl[eb], 1);
        tok[ti * 2] = ea | (ra << 8);
        tok[ti * 2 + 1] = eb | (rb << 8);
        wpair[row * 2] = pg * p0;
        wpair[row * 2 + 1] = pg * p1;
      }
    }
    __syncthreads();
    if (tid < 16) basel[tid] = (int)atomicAdd(&cnt[tid], (unsigned)cntl[tid]);
    __syncthreads();
    if (tid < 128) {
      const int v = tok[tid], e = v & 255, r = v >> 8;
      list[(size_t)e * 16384 + basel[e] + r] = (chunk * 64 + (tid >> 1)) * 2 + (tid & 1);
    }
    __syncthreads();
  }
}

__device__ __forceinline__ void moe_sched(const Params& p, int l, int* sl) {
  const int tid = tidx();
  if (tid < 16) {
    const unsigned* cnt = (const unsigned*)(p.ws + OFF_CTL) + 64 + l * 16;
    sl[tid] = (int)__hip_atomic_load(&cnt[tid], __ATOMIC_RELAXED, __HIP_MEMORY_SCOPE_AGENT);
  }
  __syncthreads();
  if (tid == 0) {
    int to = 0, ro = 0;
    sl[16] = 0; sl[33] = 0;
    for (int e = 0; e < 16; ++e) {
      const int c = sl[e];
      to += (c + 255) >> 8; ro += c;
      sl[17 + e] = to; sl[34 + e] = ro;
    }
  }
  __syncthreads();
}
__device__ __forceinline__ void moe_tile(const int* sl, int t, int& e, int& nt, int& mt, int& cnt_e, int& roff_e) {
  int ee = 0;
  for (int k = 0; k < 15; ++k) ee += (t >= sl[17 + k] * 4) ? 1 : 0;
  ee = __builtin_amdgcn_readfirstlane(ee);
  const int t0 = __builtin_amdgcn_readfirstlane(sl[16 + ee]), t1 = __builtin_amdgcn_readfirstlane(sl[17 + ee]);
  const int nte = t1 - t0, rem = t - t0 * 4;
  e = ee; nt = rem / nte; mt = rem % nte;
  cnt_e = __builtin_amdgcn_readfirstlane(sl[ee]);
  roff_e = __builtin_amdgcn_readfirstlane(sl[33 + ee]);
}

template <int BN>
__device__ __forceinline__ void moe1_tile(const Params& p, int l, h16* sm, const int* sl, int t, int half) {
  unsigned char* ws = p.ws;
  const h16* H = (const h16*)(ws + OFF_H16);
  h16* hid = (h16*)(ws + OFF_HID);
  int e, nt, mt, cnt_e, roff_e;
  moe_tile(sl, t, e, nt, mt, cnt_e, roff_e);
  const int* le = (const int*)(ws + OFF_LIST) + (size_t)e * 16384;
  f32x4 acc[8][BN / 64];
  gemm_mainloop<BN>(acc, [&](int r) { int so = mt * 256 + r; so = so < cnt_e ? so : 0; return H + (size_t)(le[so] >> 1) * D; },
                    (const h16*)wgu_buf(p, l) + ((size_t)e * 1024 + nt * 256 + half * 128) * 1024, 1024, 16, sm);
  const int tid_e = tidx(), lane = tid_e & 63, wave = tid_e >> 6, wr = wave >> 2, wc = wave & 3, fr = lane & 15, fq = lane >> 4;
  constexpr int NC = BN / 2, LDR = NC + 8;
#pragma unroll
  for (int m = 0; m < 8; ++m)
#pragma unroll
    for (int n2 = 0; n2 < BN / 128; ++n2) {
      const f32x4 gt = acc[m][2 * n2], up = acc[m][2 * n2 + 1];
      *(h16x4*)(sm + (wr * 128 + m * 16 + fr) * LDR + wc * (BN / 8) + n2 * 16 + 4 * fq) =
          pack4(silu_f(gt[0]) * up[0], silu_f(gt[1]) * up[1], silu_f(gt[2]) * up[2], silu_f(gt[3]) * up[3]);
    }
  __syncthreads();
  constexpr int CH = NC / 8;
#pragma unroll
  for (int i = 0; i < CH / 2; ++i) {
    const int idx = i * NTHREADS + tid_e;
    const int r = idx / CH, c8 = idx % CH;
    const int so = mt * 256 + r;
    if (so < cnt_e) *(h16x8*)(hid + (size_t)(roff_e + so) * 512 + nt * 128 + half * 64 + c8 * 8) = *(const h16x8*)(sm + r * LDR + c8 * 8);
  }
  __syncthreads();
}
__device__ __forceinline__ void phase_moe1(const Params& p, int l, h16* sm) {
  int* sl = (int*)((unsigned char*)sm + SCHED_OFF);
  moe_sched(p, l, sl);
  const int total = __builtin_amdgcn_readfirstlane(sl[32]) * 4;
  const TileSched ts = xcd_sched(total);
  for (int t = ts.cur; t < ts.end; t += ts.step) moe1_tile<256>(p, l, sm, sl, t, 0);
  if (ts.tail_tile >= 0) {
    if (ts.tail_half < 0) moe1_tile<256>(p, l, sm, sl, ts.tail_tile, 0);
    else moe1_tile<128>(p, l, sm, sl, ts.tail_tile, ts.tail_half);
  }
  if (l == 0) conv_share(p, 1, 0, NT_CONV / 2, 0, ts.nbusy, (float*)sm);
}

template <int BN>
__device__ __forceinline__ void moe2_tile(const Params& p, int l, h16* sm, const int* sl, int t, int half) {
  unsigned char* ws = p.ws;
  const float* wpair = (const float*)(ws + OFF_WPAIR);
  h16* yp = (h16*)(ws + OFF_YPAIR);
  int e, nt, mt, cnt_e, roff_e;
  moe_tile(sl, t, e, nt, mt, cnt_e, roff_e);
  const int* le = (const int*)(ws + OFF_LIST) + (size_t)e * 16384;
  const h16* Ab = (const h16*)(ws + OFF_HID) + (size_t)(roff_e + mt * 256) * 512;
  f32x4 acc[8][BN / 64];
  gemm_mainloop<BN>(acc, [&](int r) { return Ab + (size_t)r * 512; }, (const h16*)wdn_buf(p, l) + ((size_t)e * 1024 + nt * 256 + half * 128) * 512, 512, 8, sm);
  const int tid_e = tidx(), lane = tid_e & 63, wave = tid_e >> 6, wr = wave >> 2, wc = wave & 3, fr = lane & 15, fq = lane >> 4;
  constexpr int LDR = BN + 8;
#pragma unroll
  for (int m = 0; m < 8; ++m) {
    const int so = mt * 256 + wr * 128 + m * 16 + fr;
    const float w = so < cnt_e ? wpair[le[so]] : 0.f;
#pragma unroll
    for (int n = 0; n < BN / 64; ++n)
      *(h16x4*)(sm + (wr * 128 + m * 16 + fr) * LDR + wc * (BN / 4) + n * 16 + 4 * fq) = pack4(acc[m][n][0] * w, acc[m][n][1] * w, acc[m][n][2] * w, acc[m][n][3] * w);
  }
  __syncthreads();
  constexpr int CH = BN / 8;
#pragma unroll
  for (int i = 0; i < CH / 2; ++i) {
    const int idx = i * NTHREADS + tid_e;
    const int r = idx / CH, c8 = idx % CH;
    const int so = mt * 256 + r;
    if (so < cnt_e) *(h16x8*)(yp + (size_t)le[so] * D + nt * 256 + half * 128 + c8 * 8) = *(const h16x8*)(sm + r * LDR + c8 * 8);
  }
  __syncthreads();
}
__device__ __forceinline__ void phase_moe2(const Params& p, int l, h16* sm) {
  int* sl = (int*)((unsigned char*)sm + SCHED_OFF);
  moe_sched(p, l, sl);
  const int total = __builtin_amdgcn_readfirstlane(sl[32]) * 4;
  const TileSched ts = xcd_sched(total);
  for (int t = ts.cur; t < ts.end; t += ts.step) moe2_tile<256>(p, l, sm, sl, t, 0);
  if (ts.tail_tile >= 0) {
    if (ts.tail_half < 0) moe2_tile<256>(p, l, sm, sl, ts.tail_tile, 0);
    else moe2_tile<128>(p, l, sm, sl, ts.tail_tile, ts.tail_half);
  }
  if (l == 0) conv_share(p, 1, NT_CONV / 2, NT_CONV, 0, ts.nbusy, (float*)sm);
}

#define XB_TMO      128
#define XB_XCNT(j)  (256  + 64 * (j))
#define XB_XSUB(j)  (1280 + 64 * (j))
#define XB_XGEN(j)  (2304 + 64 * (j))
#define XB_TOP      3328
#define XB_TOPGEN   3392
#define XCD_BAR_WORDS 3456
#define XB_SPIN_CAP (1u << 20)
__device__ __forceinline__ unsigned xb_ld(unsigned* p) { return __hip_atomic_load(p, __ATOMIC_RELAXED, __HIP_MEMORY_SCOPE_AGENT); }
__device__ __forceinline__ unsigned xb_add(unsigned* p, unsigned v) { return __hip_atomic_fetch_add(p, v, __ATOMIC_RELAXED, __HIP_MEMORY_SCOPE_AGENT); }
__device__ __forceinline__ unsigned xb_xcc_id() { return (unsigned)__builtin_amdgcn_s_getreg((3 << 11) | 20) & 0xFu; }
#define XB_SPIN(cond, bar) do { unsigned _sp = 0; while (cond) { __builtin_amdgcn_s_sleep(1); \
    if ((++_sp & 255u) == 0u) { if (xb_ld(&(bar)[XB_TMO])) break; if (_sp > XB_SPIN_CAP) { atomicAdd(&(bar)[XB_TMO], 1u); break; } } } } while (0)
struct XBar { unsigned* bar; unsigned x; volatile unsigned* st; };
__device__ __forceinline__ void xbar_post(XBar& b, unsigned* bar, volatile unsigned* st) {
  b.bar = bar; b.x = xb_xcc_id(); b.st = st;
  if (tidx() == 0) { st[0] = 0u; st[1] = 0u; (void)xb_add(&bar[XB_XCNT(b.x)], 1u); }
}
__device__ __forceinline__ void xbar_census(unsigned* bar, unsigned x, unsigned& nloc, unsigned& nx) {
  const unsigned G = gridDim.x;
  unsigned sum, cnt, mine, sp = 0u;
  for (;;) {
    sum = 0u; cnt = 0u; mine = 0u;
#pragma unroll
    for (unsigned j = 0; j < 16; ++j) { const unsigned c = xb_ld(&bar[XB_XCNT(j)]); sum += c; cnt += (c > 0u) ? 1u : 0u; mine = (j == x) ? c : mine; }
    if (sum == G) break;
    __builtin_amdgcn_s_sleep(1);
    if ((++sp & 255u) == 0u) { if (xb_ld(&bar[XB_TMO])) break; if (sp > XB_SPIN_CAP) { atomicAdd(&bar[XB_TMO], 1u); break; } }
  }
  nloc = mine > 0u ? mine : 1u; nx = cnt > 0u ? cnt : 1u;
}
__device__ __forceinline__ void xbar_sync(XBar& b) {
  asm volatile("s_waitcnt vmcnt(0)" ::: "memory");
  __syncthreads();
  if (tidx() == 0) {
    unsigned* bar = b.bar;
    __builtin_amdgcn_s_waitcnt(0);
    unsigned nloc = b.st[0], nx = b.st[1];
    if (nloc == 0u) { xbar_census(bar, b.x, nloc, nx); b.st[0] = nloc; b.st[1] = nx; }
    const unsigned old = xb_add(&bar[XB_XSUB(b.x)], 1u);
    const unsigned gen = old / nloc;
    if (old + 1u == (gen + 1u) * nloc) {
      __builtin_amdgcn_fence(__ATOMIC_RELEASE, "agent");
      asm volatile("s_waitcnt vmcnt(0)" ::: "memory");
      const unsigned og = xb_add(&bar[XB_TOP], 1u);
      const unsigned tg = og / nx;
      if (og + 1u == (tg + 1u) * nx) xb_add(&bar[XB_TOPGEN], 1u);
      else XB_SPIN(xb_ld(&bar[XB_TOPGEN]) == tg, bar);
      __builtin_amdgcn_fence(__ATOMIC_ACQUIRE, "agent");
      xb_add(&bar[XB_XGEN(b.x)], 1u);
      asm volatile("s_waitcnt vmcnt(0)" ::: "memory");
    } else {
      XB_SPIN(xb_ld(&bar[XB_XGEN(b.x)]) == gen, bar);
      __builtin_amdgcn_fence(__ATOMIC_ACQUIRE, "agent");
      asm volatile("s_waitcnt vmcnt(0)" ::: "memory");
    }
  }
  __syncthreads();
}

constexpr int NSTEPS = 20;
#define STEP(k, body) do { if (s_lo <= (k) && (k) < s_hi) { body; if ((k) + 1 < s_hi) { xbar_sync(xb); } \
    if (PROBE_MASK != 0u) { unsigned long long now_ = __builtin_amdgcn_s_memrealtime(); \
      if ((PROBE_MASK >> (k)) & 1u) { const unsigned long long w_ = (now_ - pt_prev) * PROBE_AMP; \
        while (__builtin_amdgcn_s_memrealtime() - now_ < w_) __builtin_amdgcn_s_sleep(8); now_ = __builtin_amdgcn_s_memrealtime(); } \
      pt_prev = now_; } } } while (0)
#define LAYER_STEPS(l, base) \
  STEP(base + 0, phase_norm1(p, l, (float*)smem); if (l == 1) phase_convert_misc(p, 1)); \
  STEP(base + 1, phase_inproj(p, l, (h16*)smem)); \
  STEP(base + 2, phase_mixa(p, l, smem)); \
  STEP(base + 3, phase_mixb(p, l, (float*)smem)); \
  STEP(base + 4, phase_attn(p, l, (float*)smem)); \
  STEP(base + 5, phase_outproj(p, l, (h16*)smem)); \
  STEP(base + 6, phase_router(p, l, (int*)smem)); \
  STEP(base + 7, phase_moe1(p, l, (h16*)smem)); \
  STEP(base + 8, phase_moe2(p, l, (h16*)smem))

__global__ void __launch_bounds__(NTHREADS, 2) mega(Params p, int s_lo, int s_hi) {
  extern __shared__ __attribute__((aligned(16))) unsigned char smem[];
  unsigned long long pt_prev = PROBE_MASK != 0u ? __builtin_amdgcn_s_memrealtime() : 0ull;
  XBar xb;
  xbar_post(xb, (unsigned*)(p.ws + OFF_BAR), (volatile unsigned*)(smem + LDS_BYTES - 16));
  STEP(0, phase_prep(p, (float*)smem); phase_convert_tiles(p, 0, (float*)smem); phase_convert_misc(p, 0));
  LAYER_STEPS(0, 1);
  LAYER_STEPS(1, 10);
  STEP(19, phase_norm1(p, 2, (float*)smem));
}

extern "C" void kernel_launch(void* const* d_in, const int* in_sizes, int n_in, void* d_out, int out_size, void* d_ws, size_t ws_size,
                              hipStream_t stream) {
  static int grid_blocks = 0;
  if (!grid_blocks) {
    if (n_in != 35 || out_size != T * D || ws_size < WS_TOTAL) {
      fprintf(stderr, "kernel_launch: unexpected problem (n_in %d, out %d, ws %zu < %zu)\n", n_in, out_size, ws_size, (size_t)WS_TOTAL);
      grid_blocks = -1;
      return;
    }
    int dev = 0, cus = 0, per_cu = 0;
    hipGetDevice(&dev);
    hipDeviceGetAttribute(&cus, hipDeviceAttributeMultiprocessorCount, dev);
    if (hipFuncSetAttribute((const void*)mega, hipFuncAttributeMaxDynamicSharedMemorySize, LDS_BYTES) != hipSuccess) {
      fprintf(stderr, "kernel_launch: hipFuncSetAttribute(%d B dynamic LDS) failed\n", LDS_BYTES);
      grid_blocks = -1;
      return;
    }
    hipOccupancyMaxActiveBlocksPerMultiprocessor(&per_cu, mega, NTHREADS, LDS_BYTES);
    if (per_cu > 1) per_cu = 1;
    if (per_cu < 1) { fprintf(stderr, "kernel_launch: occupancy query returned %d\n", per_cu); grid_blocks = -1; return; }
    grid_blocks = cus * per_cu;
  }
  if (grid_blocks < 0) return;
  Params p{};
  for (int i = 0; i < 35; ++i) p.in[i] = (const float*)d_in[i];
  p.out = (float*)d_out;
  p.ws = (unsigned char*)d_ws;
  for (int i = 0; i < 32; ++i) p.inv_freq[i] = std::pow(10000.0, -(double)(2 * i) / 64.0);
  if (hipMemsetAsync((char*)d_ws + OFF_BAR, 0, 16384, stream) != hipSuccess) { fprintf(stderr, "kernel_launch: memset of barrier words failed\n"); return; }
#if MEGA
  int lo = 0, hi = NSTEPS;
  void* args[] = {&p, &lo, &hi};
  hipError_t e = hipLaunchCooperativeKernel((void*)mega, dim3(grid_blocks), dim3(NTHREADS), args, LDS_BYTES, stream);
  if (e != hipSuccess) fprintf(stderr, "cooperative launch failed: %s (grid %d)\n", hipGetErrorString(e), grid_blocks);
#else
  for (int s = 0; s < NSTEPS; ++s) {
    int lo = s, hi = s + 1;
    void* args[] = {&p, &lo, &hi};
    hipError_t e = hipLaunchCooperativeKernel((void*)mega, dim3(grid_blocks), dim3(NTHREADS), args, LDS_BYTES, stream);
    if (e != hipSuccess) { fprintf(stderr, "launch %d failed: %s (grid %d)\n", s, hipGetErrorString(e), grid_blocks); break; }
  }
#endif
}
```

```cpp
#include <hip/hip_runtime.h>
#include <hip/hip_cooperative_groups.h>
#include <cstdio>
#include <cstdint>
#include <cmath>
namespace cg = cooperative_groups;

#ifndef MEGA
#define MEGA 1
#endif
#ifndef PROBE_MASK
#define PROBE_MASK 0u
#define PROBE_AMP 3
#endif

typedef _Float16 h16;
typedef _Float16 h16x8 __attribute__((ext_vector_type(8)));
typedef _Float16 h16x4 __attribute__((ext_vector_type(4)));
typedef float f32x4 __attribute__((ext_vector_type(4)));

constexpr int NB = 2, S = 8192, T = NB * S, D = 1024;
constexpr int NIN = 2432;
constexpr int NINSRC = 2328;
constexpr int C_XL = 0, C_GL = 256, C_Q = 512, C_KC = 1024, C_VC = 1152, C_KS = 1280, C_VS = 1408, C_KW = 1536, C_VW = 1664,
              C_CVA = 1792, C_CVB = 2048, C_GATE = 2304;
constexpr float EPS = 1e-6f;
constexpr int NTHREADS = 512, NW = 8;
constexpr int LDS_BYTES = 150528;
constexpr int NINP = 2560;
constexpr int SCHED_OFF = LDS_BYTES - 1024;
constexpr float ASCALE = 16.f;

constexpr size_t al256(size_t x) { return (x + 255) & ~(size_t)255; }
constexpr size_t OFF_CTL = 0;
constexpr size_t OFF_BAR = 4096;
constexpr size_t OFF_MOD = 4096 + 16384;
constexpr size_t OFF_ROPE = al256(OFF_MOD + 2 * 2 * 6144 * 4);
constexpr size_t OFF_PB = al256(OFF_ROPE + (size_t)T * 64 * 4);
constexpr size_t OFF_PBPART = al256(OFF_PB + 2 * 256 * 4);
constexpr size_t OFF_LRUW = al256(OFF_PBPART + 2 * 32 * 256 * 4);
constexpr size_t OFF_GATES = al256(OFF_LRUW + 2 * 4 * 64 * 64 * 2);
constexpr size_t OFF_WIN = al256(OFF_GATES + (size_t)T * 24 * 4);
constexpr size_t OFF_WOUT = al256(OFF_WIN + (size_t)NINP * 1024 * 2);
constexpr size_t OFF_WGU = al256(OFF_WOUT + (size_t)1024 * 1024 * 2);
constexpr size_t OFF_WDN = al256(OFF_WGU + (size_t)16 * 1024 * 1024 * 2);
constexpr size_t OFF_W1K = al256(OFF_WDN + (size_t)16 * 1024 * 512 * 2);
constexpr size_t OFF_W1V = al256(OFF_W1K + (size_t)256 * 2048 * 2);
constexpr size_t OFF_H16 = al256(OFF_W1V + (size_t)256 * 2048 * 2);
constexpr size_t OFF_Q16 = al256(OFF_H16 + (size_t)T * 1024 * 2);
constexpr size_t KVSZ = (size_t)T * 128 * 2;
constexpr size_t OFF_KC = al256(OFF_Q16 + (size_t)T * 512 * 2);
constexpr size_t OFF_VC = al256(OFF_KC + KVSZ + 4096);
constexpr size_t OFF_KS = al256(OFF_VC + KVSZ + 4096);
constexpr size_t OFF_VST = al256(OFF_KS + KVSZ);
constexpr size_t OFF_KW = al256(OFF_VST + KVSZ);
constexpr size_t OFF_VWT = al256(OFF_KW + KVSZ);
constexpr size_t OFF_HIDC = al256(OFF_VWT + KVSZ);
constexpr size_t OFF_KCMP = al256(OFF_HIDC + (size_t)2 * 2048 * 256 * 2);
constexpr size_t OFF_VCMPT = al256(OFF_KCMP + (size_t)4 * 512 * 64 * 2);
constexpr size_t OFF_LRUH = al256(OFF_VCMPT + (size_t)4 * 512 * 64 * 2);
constexpr size_t OFF_LRUA = al256(OFF_LRUH + (size_t)T * 256 * 4);
constexpr size_t OFF_HEND = al256(OFF_LRUA + (size_t)T * 256 * 4);
constexpr size_t OFF_AEND = al256(OFF_HEND + 2 * 256 * 256 * 4);
constexpr size_t OFF_CARRY = al256(OFF_AEND + 2 * 256 * 256 * 4);
constexpr size_t OFF_XA = al256(OFF_CARRY + 2 * 256 * 256 * 4);
constexpr size_t OFF_LIST = al256(OFF_XA + (size_t)T * 1024 * 4);
constexpr size_t OFF_WPAIR = al256(OFF_LIST + (size_t)16 * 16384 * 4);
constexpr size_t OFF_SSQ = al256(OFF_WPAIR + 32768 * 4);
constexpr size_t OFF_R = al256(OFF_SSQ + (size_t)T * 2 * 4);
constexpr size_t OFF_P16 = OFF_R;
constexpr size_t OFF_HID = OFF_R;
constexpr size_t OFF_YPAIR = al256(OFF_HID + (size_t)(32768 + 512) * 512 * 2);
constexpr size_t OFF_HIDP = al256(OFF_P16 + (size_t)T * NIN * 2);
constexpr size_t OFF_MODP = OFF_HIDP;
constexpr size_t R_END1 = OFF_HIDP + (size_t)4 * 2 * 2048 * 256 * 4;
constexpr size_t R_END2 = OFF_YPAIR + (size_t)32768 * 1024 * 2;
constexpr size_t WS_TOTAL = al256(R_END1 > R_END2 ? R_END1 : R_END2);

struct Params {
  const float* in[35];
  float* out;
  unsigned char* ws;
  double inv_freq[32];
};
enum { I_X = 0, I_C, I_POS, I_ADAW, I_ADAB, I_N1G, I_N2G, I_WIN, I_LCW, I_LCB, I_LWA, I_LBA, I_LWX, I_LBX, I_LLAM, I_CKW1, I_CKW2,
       I_CVW1, I_CVW2, I_CPK, I_CPV, I_DWW, I_DWB, I_LNG, I_LNB, I_ONG, I_WOUT, I_RGW, I_RGB, I_REW, I_REB, I_MG, I_MU, I_MD, I_FNG };

__device__ __forceinline__ int tidx() { int t = threadIdx.x; asm volatile("" : "+v"(t)); return t; }
template <int CTRL> __device__ __forceinline__ float dppf(float v) {
  return __builtin_bit_cast(float, __builtin_amdgcn_update_dpp(0, __builtin_bit_cast(int, v), CTRL, 0xF, 0xF, true));
}
__device__ __forceinline__ float wsum(float v) {
  v += dppf<0xB1>(v);
  v += dppf<0x4E>(v);
  v += dppf<0x141>(v);
  v += dppf<0x140>(v);
  const int vi = __builtin_bit_cast(int, v);
  const float r0 = __builtin_bit_cast(float, __builtin_amdgcn_readlane(vi, 0)), r1 = __builtin_bit_cast(float, __builtin_amdgcn_readlane(vi, 16));
  const float r2 = __builtin_bit_cast(float, __builtin_amdgcn_readlane(vi, 32)), r3 = __builtin_bit_cast(float, __builtin_amdgcn_readlane(vi, 48));
  return (r0 + r1) + (r2 + r3);
}
__device__ __forceinline__ float sigm(float x) { return 1.f / (1.f + __expf(-x)); }
__device__ __forceinline__ float silu_f(float x) { return x / (1.f + __expf(-x)); }
__device__ __forceinline__ float gelu_tanh(float x) {
  float u = 0.7978845608028654f * (x + 0.044715f * x * x * x);
  float e = __expf(2.f * u);
  float t = 1.f - 2.f / (e + 1.f);
  return 0.5f * x * (1.f + t);
}
__device__ __forceinline__ void glds16(const h16* g, h16* l) {
  __builtin_amdgcn_global_load_lds((const unsigned*)g, (unsigned*)l, 16, 0, 0);
}
__device__ __forceinline__ h16x4 pack4(float a, float b, float c, float d) {
  h16x4 r; r[0] = (h16)a; r[1] = (h16)b; r[2] = (h16)c; r[3] = (h16)d; return r;
}

struct TileIter { int cur, end, step; };
__device__ __forceinline__ TileIter xcd_tiles(int ntiles) {
  const int G = gridDim.x, b = blockIdx.x;
  TileIter it;
  if ((G & 7) == 0) {
    const int x = b & 7;
    it.cur = (int)(((long)ntiles * x) >> 3) + (b >> 3);
    it.end = (int)(((long)ntiles * (x + 1)) >> 3);
    it.step = G >> 3;
  } else { it.cur = b; it.end = ntiles; it.step = G; }
  return it;
}

#define VMCNT(n) asm volatile("s_waitcnt vmcnt(" #n ")" ::: "memory")
template <int BN, class ARowFn>
__device__ __forceinline__ void gemm_mainloop(f32x4 (&acc)[8][BN / 64], ARowFn arow, const h16* __restrict__ Bt, int ldb, int nk, h16* sm, bool zero_init = true) {
  constexpr int NF = BN / 64, NBP = BN / 64;
  constexpr int STAGE = 16384 + BN * 64;
  constexpr int NST = BN == 128 ? 3 : 2;
  const int tid = tidx(), lane = tid & 63, wave = tid >> 6;
  const int wr = wave >> 2, wc = wave & 3, fr = lane & 15, fq = lane >> 4;
  const h16* ap[4];
  const h16* bp[NBP];
#pragma unroll
  for (int i = 0; i < 4; ++i) {
    const int r = (i * 8 + wave) * 8 + (lane >> 3);
    const int c = (lane & 7) ^ ((r >> 1) & 7);
    ap[i] = arow(r) + c * 8;
    if (i < NBP) bp[i] = Bt + (size_t)r * ldb + c * 8;
  }
  if (zero_init) {
#pragma unroll
    for (int m = 0; m < 8; ++m)
#pragma unroll
      for (int n = 0; n < NF; ++n) acc[m][n] = (f32x4){0.f, 0.f, 0.f, 0.f};
  }
  h16* const dA = sm + wave * 512 + lane * 8;
#pragma unroll
  for (int st0 = 0; st0 < NST - 1; ++st0)
    if (st0 < nk) {
#pragma unroll
      for (int i = 0; i < 4; ++i) { glds16(ap[i], dA + st0 * STAGE + i * 4096); ap[i] += 64; }
#pragma unroll
      for (int i = 0; i < NBP; ++i) { glds16(bp[i], dA + st0 * STAGE + 16384 + i * 4096); bp[i] += 64; }
    }
  const int sw = (fr >> 1) & 7;
  const int aoff = (wr * 128 + fr) * 64, boff = 16384 + (wc * (BN / 4) + fr) * 64;
#define SCHED_FENCE() __builtin_amdgcn_sched_barrier(0)
  for (int kt = 0; kt < nk; ++kt) {
    if (NST == 3 && kt + 1 < nk) VMCNT(6); else VMCNT(0);
    __builtin_amdgcn_s_barrier();
    const int sl_ = NST == 3 ? kt % 3 : (kt & 1);
    const h16* st = sm + sl_ * STAGE;
    const bool more = kt + (NST - 1) < nk;
    h16* const dn = dA + (NST == 3 ? (sl_ == 0 ? 2 : sl_ - 1) : (sl_ ^ 1)) * STAGE;
#pragma unroll
    for (int ks = 0; ks < 2; ++ks) {
      const int ch = ((ks * 4 + fq) ^ sw) * 8;
      h16x8 bf[NF];
#pragma unroll
      for (int n = 0; n < NF; ++n) bf[n] = *(const h16x8*)(st + boff + n * 1024 + ch);
#pragma unroll
      for (int mh = 0; mh < 2; ++mh) {
        h16x8 af[4];
#pragma unroll
        for (int m = 0; m < 4; ++m) af[m] = *(const h16x8*)(st + aoff + (mh * 4 + m) * 1024 + ch);
#pragma unroll
        for (int m = 0; m < 4; ++m) {
#pragma unroll
          for (int n = 0; n < NF; ++n) acc[mh * 4 + m][n] = __builtin_amdgcn_mfma_f32_16x16x32_f16(bf[n], af[m], acc[mh * 4 + m][n], 0, 0, 0);
          if (m == 1 || m == 3) {
            const int q = ks * 4 + mh * 2 + (m >> 1);
            SCHED_FENCE();
            if (more) {
              if (q < 4) { glds16(ap[q & 3], dn + (q & 3) * 4096); ap[q & 3] += 64; }
              else if ((q & 3) < NBP) { glds16(bp[(q & 3) < NBP ? (q & 3) : 0], dn + 16384 + (q & 3) * 4096); bp[(q & 3) < NBP ? (q & 3) : 0] += 64; }
            }
            SCHED_FENCE();
          }
        }
      }
    }
  }
#undef SCHED_FENCE
  __builtin_amdgcn_s_barrier();
}

struct TileSched { int cur, end, step, tail_tile, tail_half, nbusy; };
__device__ __forceinline__ TileSched xcd_sched(int ntiles) {
  const int G = gridDim.x, b = blockIdx.x;
  TileSched s;
  s.tail_tile = -1; s.tail_half = -1; s.nbusy = 0;
  if ((G & 7) == 0) {
    const int x = b & 7, nb = G >> 3, si = b >> 3;
    const int lo = (int)(((long)ntiles * x) >> 3), hi = (int)(((long)ntiles * (x + 1)) >> 3);
    const int n = hi - lo, R = n / nb, rem = n - R * nb;
    s.cur = lo + si; s.end = lo + R * nb; s.step = nb;
    if (rem * 2 <= nb) { s.nbusy = 2 * rem; if (si < 2 * rem) { s.tail_tile = lo + R * nb + (si >> 1); s.tail_half = si & 1; } }
    else { s.nbusy = rem; if (si < rem) s.tail_tile = lo + R * nb + si; }
  } else { s.cur = b; s.end = ntiles; s.step = G; }
  return s;
}

__device__ __forceinline__ h16* wgu_buf(const Params& p, int l) { return l ? (h16*)p.out : (h16*)(p.ws + OFF_WGU); }
__device__ __forceinline__ h16* wdn_buf(const Params& p, int l) { return l ? (h16*)p.out + (size_t)16 * 1024 * 1024 : (h16*)(p.ws + OFF_WDN); }
constexpr int NT_CONV = 16 * 37 + 256 + 3 * 16 * 128 + 2 * 128;
__device__ __forceinline__ int map_row(int mode, int n) {
  if (mode == 1) return n < 1792 ? n : (n < 1816 ? n + 512 : n - 24);
  if (mode == 2) return 32 * (n >> 4) + (n & 15);
  if (mode == 3) return 32 * (n >> 4) + 16 + (n & 15);
  return n;
}
struct ConvTile { const float* src; h16* dst; int K, N, mode, k0, n0; const float* pos; float* pbp; };
__device__ __forceinline__ ConvTile conv_decode(const Params& p, int l, int t) {
  unsigned char* ws = p.ws;
  constexpr int T_WIN = 16 * 37, T_WOUT = 256, T_G = 16 * 128, T_W1 = 128;
  constexpr int E0 = T_WIN, E1 = E0 + T_WOUT, E2 = E1 + T_G, E3 = E2 + T_G, E4 = E3 + T_G, E5 = E4 + T_W1;
  ConvTile c;
  c.pos = nullptr; c.pbp = nullptr;
  int tk, tn;
  if (t < E0) {
    c.src = p.in[I_WIN] + (size_t)l * 1024 * NINSRC; c.K = 1024; c.N = NINSRC; c.dst = (h16*)(ws + OFF_WIN); c.mode = 1; tk = t / 37; tn = t % 37;
  } else if (t < E1) {
    const int u = t - E0;
    c.src = p.in[I_WOUT] + (size_t)l * 1024 * 1024; c.K = 1024; c.N = 1024; c.dst = (h16*)(ws + OFF_WOUT); c.mode = 4; tk = u >> 4; tn = u & 15;
  } else if (t < E3) {
    const int up = t >= E2;
    const int u = t - (up ? E2 : E1);
    const int e = u >> 7, v = u & 127;
    c.src = p.in[up ? I_MU : I_MG] + ((size_t)l * 16 + e) * 1024 * 512; c.K = 1024; c.N = 512; c.dst = wgu_buf(p, l) + (size_t)e * 1024 * 1024;
    c.mode = up ? 3 : 2; tk = v >> 3; tn = v & 7;
  } else if (t < E4) {
    const int u = t - E3;
    const int e = u >> 7, v = u & 127;
    c.src = p.in[I_MD] + ((size_t)l * 16 + e) * 512 * 1024; c.K = 512; c.N = 1024; c.dst = wdn_buf(p, l) + (size_t)e * 1024 * 512; c.mode = 0; tk = v >> 4; tn = v & 15;
  } else {
    const int vv = t >= E5;
    const int u = t - (vv ? E5 : E4);
    c.src = p.in[vv ? I_CVW1 : I_CKW1] + (size_t)l * 2048 * 256; c.K = 2048; c.N = 256; c.dst = (h16*)(ws + (vv ? OFF_W1V : OFF_W1K)); c.mode = 5; tk = u >> 2; tn = u & 3;
    c.pos = p.in[vv ? I_CPV : I_CPK] + (size_t)l * 2048 + tk * 64;
    c.pbp = (float*)(ws + OFF_PBPART) + (size_t)(vv * 32 + tk) * 256 + tn * 64;
  }
  c.k0 = tk * 64; c.n0 = tn * 64;
  return c;
}
__device__ __forceinline__ void conv_wave_tile(const ConvTile& c, float* smw, int lane) {
  float4 v[16];
#pragma unroll
  for (int i = 0; i < 16; ++i) {
    const int idx = i * 64 + lane;
    const int r = idx >> 4, c4 = (idx & 15) * 4;
    v[i] = make_float4(0.f, 0.f, 0.f, 0.f);
    if (c.n0 + c4 < c.N) v[i] = *(const float4*)(c.src + (size_t)(c.k0 + r) * c.N + c.n0 + c4);
  }
#pragma unroll
  for (int i = 0; i < 16; ++i) {
    const int idx = i * 64 + lane;
    const int r = idx >> 4, c4 = (idx & 15) * 4;
    float* d = smw + r * 65 + c4;
    d[0] = v[i].x; d[1] = v[i].y; d[2] = v[i].z; d[3] = v[i].w;
  }
  if (c.mode == 5) {
    float sacc = 0.f;
    for (int k = 0; k < 64; ++k) sacc += c.pos[k] * smw[k * 65 + lane];
    c.pbp[lane] = sacc;
  }
  const int k0d = c.mode == 4 ? (c.k0 < 256 ? c.k0 + 512 : (c.k0 < 768 ? c.k0 - 256 : c.k0)) : c.k0;
#pragma unroll
  for (int j = 0; j < 8; ++j) {
    const int ch = j * 64 + lane;
    const int n = ch >> 3, kc = ch & 7;
    if (c.n0 + n < c.N) {
      h16x8 o;
#pragma unroll
      for (int q = 0; q < 8; ++q) o[q] = (h16)smw[(kc * 8 + q) * 65 + n];
      *(h16x8*)(c.dst + (size_t)map_row(c.mode, c.n0 + n) * c.K + k0d + kc * 8) = o;
    }
  }
}

constexpr int CV_MOE0 = 16 * 37 + 256, CV_MOE1 = CV_MOE0 + 3 * 16 * 128;
constexpr int CV_Q1 = CV_MOE0 + 1536, CV_Q2 = CV_Q1 + 2048;
__device__ __forceinline__ void conv_share(const Params& p, int l, int t0, int t1, int busy_lo, int busy_hi, float* sm) {
  const int tid = tidx(), lane = tid & 63, wave = tid >> 6;
  float* smw = sm + wave * 4160;
  const int G = gridDim.x, b = blockIdx.x;
  int lo = t0, hi = t1, me = b, n = G;
  if ((G & 7) == 0) {
    const int x = b & 7, nb = G >> 3, si = b >> 3, nbusy = busy_hi - busy_lo;
    lo = t0 + (int)(((long)(t1 - t0) * x) >> 3); hi = t0 + (int)(((long)(t1 - t0) * (x + 1)) >> 3);
    if (nbusy > 0 && nbusy < nb) { n = nb - nbusy; me = si < busy_lo ? si : (si >= busy_hi ? si - nbusy : -1); } else { me = si; n = nb; }
  }
  __syncthreads();
  if (me < 0) return;
  for (int t = lo + me * NW + wave; t < hi; t += n * NW) {
    const ConvTile c = conv_decode(p, l, t);
    conv_wave_tile(c, smw, lane);
  }
}
__device__ __forceinline__ void phase_convert_tiles(const Params& p, int l, float* sm) {
  const int tid = tidx(), lane = tid & 63, wave = tid >> 6;
  float* smw = sm + wave * 4160;
  for (int u = blockIdx.x * NW + wave; u < NT_CONV - (CV_MOE1 - CV_MOE0); u += gridDim.x * NW) {
    const ConvTile c = conv_decode(p, l, u < CV_MOE0 ? u : u + (CV_MOE1 - CV_MOE0));
    conv_wave_tile(c, smw, lane);
  }
  __syncthreads();
}
__device__ __forceinline__ void phase_convert_misc(const Params& p, int l) {
  unsigned char* ws = p.ws;
  {
    h16* lw = (h16*)(ws + OFF_LRUW);
    for (int i = blockIdx.x * NTHREADS + tidx(); i < 2 * 4 * 64 * 64; i += gridDim.x * NTHREADS) {
      const int d = i & 63, e = (i >> 6) & 63, n = (i >> 12) & 3, mat = i >> 14;
      lw[i] = (h16)p.in[mat ? I_LWX : I_LWA][((size_t)(l * 4 + n) * 64 + d) * 64 + e];
    }
  }
  {
    h16x8 z = {0, 0, 0, 0, 0, 0, 0, 0};
    h16* w = (h16*)(ws + OFF_WIN) + (size_t)NINSRC * 1024;
    for (int i = blockIdx.x * NTHREADS + tidx(); i < (NINP - NINSRC) * 1024 / 8; i += gridDim.x * NTHREADS) *(h16x8*)(w + (size_t)i * 8) = z;
  }
}

__device__ __forceinline__ void phase_prep(const Params& p, float* sm) {
  unsigned char* ws = p.ws;
  const int tid = tidx();
  if (blockIdx.x == 0) {
    for (int i = tid; i < 1024; i += NTHREADS) ((unsigned*)(ws + OFF_CTL))[i] = 0u;
  }
  float* part = (float*)(ws + OFF_MODP);
  for (int it = blockIdx.x; it < 192; it += gridDim.x) {
    const int l = it / 96, r = it % 96, cg = r >> 2, ks = r & 3;
    const int lane = tid & 63, wave = tid >> 6;
    const int k0 = ks * 256 + wave * 32;
    const float* w = p.in[I_ADAW] + ((size_t)l * 1024 + k0) * 6144 + cg * 256 + lane * 4;
    const float* c = p.in[I_C] + k0;
    float a0[4] = {0, 0, 0, 0}, a1[4] = {0, 0, 0, 0};
#pragma unroll 16
    for (int k = 0; k < 32; ++k) {
      const float4 wv = *(const float4*)(w + (size_t)k * 6144);
      const float s0 = silu_f(c[k]), s1 = silu_f(c[1024 + k]);
      a0[0] += s0 * wv.x; a0[1] += s0 * wv.y; a0[2] += s0 * wv.z; a0[3] += s0 * wv.w;
      a1[0] += s1 * wv.x; a1[1] += s1 * wv.y; a1[2] += s1 * wv.z; a1[3] += s1 * wv.w;
    }
    float* rr = sm + (wave * 64 + lane) * 8;
#pragma unroll
    for (int i = 0; i < 4; ++i) { rr[i] = a0[i]; rr[4 + i] = a1[i]; }
    __syncthreads();
    {
      const int bb = tid >> 8, col = tid & 255;
      float sacc = 0.f;
#pragma unroll
      for (int g = 0; g < 8; ++g) sacc += sm[(g * 64 + (col >> 2)) * 8 + bb * 4 + (col & 3)];
      part[((size_t)(ks * 2 + l) * 2 + bb) * 6144 + cg * 256 + col] = sacc;
    }
    __syncthreads();
  }
  float* rc = (float*)(ws + OFF_ROPE);
  float* rs = rc + (size_t)T * 32;
  const int* pos = (const int*)p.in[I_POS];
  for (int i = blockIdx.x * NTHREADS + tid; i < T * 32; i += gridDim.x * NTHREADS) {
    const int t = i >> 5, f = i & 31;
    const double a = (double)pos[t] * p.inv_freq[f];
    const double n = rint(a * 0.15915494309189535);
    double r = fma(-n, 6.283185307179586, a);
    r = fma(-n, 2.4492935982947064e-16, r);
    const float rf = (float)r;
    rc[i] = cosf(rf);
    rs[i] = sinf(rf);
  }
}

__device__ __forceinline__ void phase_norm1(const Params& p, int mode, float* sm) {
  unsigned char* ws = p.ws;
  const int lane = tidx() & 63, wave = tidx() >> 6;
  const float* mod = (const float*)(ws + OFF_MOD);
  float* xa = (float*)(ws + OFF_XA);
  const h16* yp = (const h16*)(ws + OFF_YPAIR);
  h16* hout = (h16*)(ws + OFF_H16);
  const int l = (mode == 0) ? 0 : 1;
  if (mode == 0) {
    const float* part = (const float*)(ws + OFF_MODP);
    const int tid = tidx();
    for (int i = tid; i < 1024; i += NTHREADS) {
      const int b = i >> 9, j4 = (i & 511) * 4;
      float4 a = *(const float4*)(p.in[I_ADAB] + j4);
#pragma unroll
      for (int ks = 0; ks < 4; ++ks) {
        const float4 v = *(const float4*)(part + ((size_t)(ks * 2) * 2 + b) * 6144 + j4);
        a.x += v.x; a.y += v.y; a.z += v.z; a.w += v.w;
      }
      *(float4*)(sm + b * 2048 + j4) = a;
    }
    for (int o = blockIdx.x * NTHREADS + tid; o < 4 * 6144; o += gridDim.x * NTHREADS) {
      const int lb = o / 6144, j = o - lb * 6144;
      float a = p.in[I_ADAB][(lb >> 1) * 6144 + j];
#pragma unroll
      for (int ks = 0; ks < 4; ++ks) a += part[((size_t)(ks * 2 + (lb >> 1)) * 2 + (lb & 1)) * 6144 + j];
      ((float*)(ws + OFF_MOD))[o] = a;
    }
    __syncthreads();
  }
  const int lp = mode == 1 ? 0 : 1;
  const int stride = gridDim.x * NW;
  int row = blockIdx.x * NW + wave;
  float4 xn[4], gsv[4], shv[4], g2v[4];
  h16x4 y0n[4], y1n[4];
#pragma unroll
  for (int i = 0; i < 4; ++i) {
    const int col = lane * 4 + 256 * i;
    if (row < T) {
      if (mode == 0) xn[i] = *(const float4*)(p.in[I_X] + (size_t)row * D + col);
      else {
        xn[i] = *(const float4*)(xa + (size_t)row * D + col);
        y0n[i] = *(const h16x4*)(yp + (size_t)(row * 2) * D + col);
        y1n[i] = *(const h16x4*)(yp + (size_t)(row * 2 + 1) * D + col);
      }
    }
  }
  int bcur = -1;
  for (; row < T; row += stride) {
    const int b = row >> 13;
    if (b != bcur) {
      bcur = b;
#pragma unroll
      for (int i = 0; i < 4; ++i) {
        const int col = lane * 4 + 256 * i;
        if (mode == 2) gsv[i] = *(const float4*)(p.in[I_FNG] + col);
        else {
          const float4 g = *(const float4*)(p.in[I_N1G] + l * D + col);
          const float4 sh = mode == 0 ? *(const float4*)(sm + b * 2048 + col) : *(const float4*)(mod + (size_t)(l * 2 + b) * 6144 + col);
          const float4 sc = mode == 0 ? *(const float4*)(sm + b * 2048 + 1024 + col) : *(const float4*)(mod + (size_t)(l * 2 + b) * 6144 + 1024 + col);
          gsv[i] = make_float4(g.x * (1.f + sc.x), g.y * (1.f + sc.y), g.z * (1.f + sc.z), g.w * (1.f + sc.w));
          shv[i] = sh;
        }
        if (mode != 0) g2v[i] = *(const float4*)(mod + (size_t)(lp * 2 + b) * 6144 + 5120 + col);
      }
    }
    float4 x[4];
    float ss = 0.f;
#pragma unroll
    for (int i = 0; i < 4; ++i) {
      if (mode == 0) x[i] = xn[i];
      else {
        x[i].x = xn[i].x + g2v[i].x * ((float)y0n[i][0] + (float)y1n[i][0]);
        x[i].y = xn[i].y + g2v[i].y * ((float)y0n[i][1] + (float)y1n[i][1]);
        x[i].z = xn[i].z + g2v[i].z * ((float)y0n[i][2] + (float)y1n[i][2]);
        x[i].w = xn[i].w + g2v[i].w * ((float)y0n[i][3] + (float)y1n[i][3]);
      }
    }
    if (row + stride < T) {
      const int rn = row + stride;
#pragma unroll
      for (int i = 0; i < 4; ++i) {
        const int col = lane * 4 + 256 * i;
        if (mode == 0) xn[i] = *(const float4*)(p.in[I_X] + (size_t)rn * D + col);
        else {
          xn[i] = *(const float4*)(xa + (size_t)rn * D + col);
          y0n[i] = *(const h16x4*)(yp + (size_t)(rn * 2) * D + col);
          y1n[i] = *(const h16x4*)(yp + (size_t)(rn * 2 + 1) * D + col);
        }
      }
    }
#pragma unroll
    for (int i = 0; i < 4; ++i) {
      const int col = lane * 4 + 256 * i;
      if (mode == 1) *(float4*)(xa + (size_t)row * D + col) = x[i];
      ss += x[i].x * x[i].x + x[i].y * x[i].y + x[i].z * x[i].z + x[i].w * x[i].w;
    }
    ss = wsum(ss);
    const float rstd = rsqrtf(ss * (1.f / D) + EPS);
#pragma unroll
    for (int i = 0; i < 4; ++i) {
      const int col = lane * 4 + 256 * i;
      if (mode == 2) {
        float4 o;
        o.x = x[i].x * rstd * gsv[i].x; o.y = x[i].y * rstd * gsv[i].y; o.z = x[i].z * rstd * gsv[i].z; o.w = x[i].w * rstd * gsv[i].w;
        *(float4*)(p.out + (size_t)row * D + col) = o;
      } else {
        *(h16x4*)(hout + (size_t)row * D + col) = pack4(x[i].x * rstd * gsv[i].x + shv[i].x, x[i].y * rstd * gsv[i].y + shv[i].y,
                                                        x[i].z * rstd * gsv[i].z + shv[i].z, x[i].w * rstd * gsv[i].w + shv[i].w);
      }
    }
  }
}

__device__ __forceinline__ int perm_key(int pos) {
  return 32 * (pos >> 5) + 16 * ((pos >> 2) & 1) + 4 * ((pos >> 3) & 3) + (pos & 3);
}
__device__ __forceinline__ void inproj_tile(const Params& p, h16* sm, int mt, int nt) {
  unsigned char* ws = p.ws;
  const h16* Ab = (const h16*)(ws + OFF_H16) + (size_t)mt * 256 * D;
  f32x4 acc[8][2];
  gemm_mainloop<128>(acc, [&](int r) { return Ab + (size_t)r * D; }, (const h16*)(ws + OFF_WIN) + (size_t)nt * 128 * D, D, D / 64, sm);
  const int tid_e = tidx(), lane = tid_e & 63, wave = tid_e >> 6, wr = wave >> 2, wc = wave & 3, fr = lane & 15, fq = lane >> 4;
  constexpr int LDR = 136;
#pragma unroll
  for (int m = 0; m < 8; ++m)
#pragma unroll
    for (int n = 0; n < 2; ++n)
      *(h16x4*)(sm + (wr * 128 + m * 16 + fr) * LDR + wc * 32 + n * 16 + 4 * fq) = pack4(acc[m][n][0], acc[m][n][1], acc[m][n][2], acc[m][n][3]);
  __syncthreads();
  const int row0 = mt * 256, b = mt >> 5, s0 = (mt & 31) * 256;
  if (nt < 4 || (nt >= 14 && nt < 18)) {
    h16* P = (h16*)(ws + OFF_P16);
#pragma unroll
    for (int i = 0; i < 8; ++i) {
      const int idx = i * NTHREADS + tid_e;
      const int r = idx >> 4, c8 = idx & 15;
      *(h16x8*)(P + (size_t)(row0 + r) * NIN + nt * 128 + c8 * 8) = *(const h16x8*)(sm + r * LDR + c8 * 8);
    }
  } else if (nt <= 8 || nt == 10 || nt == 12) {
    const float* rc = (const float*)(ws + OFF_ROPE);
    const float* rs = rc + (size_t)T * 32;
    const bool isq = nt < 8;
    const float scl = isq ? 0.125f * 1.4426950408889634f : 1.f;
    h16* kbase = (h16*)(ws + (nt == 8 ? OFF_KC : (nt == 10 ? OFF_KS : OFF_KW)));
    h16* q16 = (h16*)(ws + OFF_Q16);
#pragma unroll
    for (int i = 0; i < 4; ++i) {
      const int idx = i * NTHREADS + tid_e;
      const int r = idx >> 3, hd = (idx >> 2) & 1, d = (idx & 3) * 8;
      const h16x8 a = *(const h16x8*)(sm + r * LDR + 64 * hd + d);
      const h16x8 bb = *(const h16x8*)(sm + r * LDR + 64 * hd + 32 + d);
      const float* cp = rc + (size_t)(row0 + r) * 32 + d;
      const float* sp = rs + (size_t)(row0 + r) * 32 + d;
      const float4 c0 = *(const float4*)cp, c1 = *(const float4*)(cp + 4), n0 = *(const float4*)sp, n1 = *(const float4*)(sp + 4);
      const float cs[8] = {c0.x, c0.y, c0.z, c0.w, c1.x, c1.y, c1.z, c1.w}, sn[8] = {n0.x, n0.y, n0.z, n0.w, n1.x, n1.y, n1.z, n1.w};
      h16x8 lo, hi;
#pragma unroll
      for (int j = 0; j < 8; ++j) {
        const float av = (float)a[j], bv = (float)bb[j];
        lo[j] = (h16)((av * cs[j] - bv * sn[j]) * scl);
        hi[j] = (h16)((bv * cs[j] + av * sn[j]) * scl);
      }
      h16* dst = isq ? q16 + (size_t)(row0 + r) * 512 + (nt - 4) * 128 + 64 * hd + d : kbase + ((size_t)(b * 2 + hd) * S + s0 + r) * 64 + d;
      *(h16x8*)dst = lo;
      *(h16x8*)(dst + 32) = hi;
    }
  } else if (nt == 9) {
    h16* vc = (h16*)(ws + OFF_VC);
#pragma unroll
    for (int i = 0; i < 8; ++i) {
      const int idx = i * NTHREADS + tid_e;
      const int r = idx >> 4, c8 = idx & 15, hd = c8 >> 3, dd = (c8 & 7) * 8;
      *(h16x8*)(vc + ((size_t)(b * 2 + hd) * S + s0 + r) * 64 + dd) = *(const h16x8*)(sm + r * LDR + c8 * 8);
    }
  } else if (nt == 11 || nt == 13) {
    h16* vt = (h16*)(ws + (nt == 11 ? OFF_VST : OFF_VWT));
#pragma unroll
    for (int i = 0; i < 8; ++i) {
      const int idx = i * NTHREADS + tid_e;
      const int kv = idx >> 11, blk = (idx >> 9) & 3, dim = (idx >> 3) & 63, p0 = (idx & 7) * 8;
      h16x8 v;
#pragma unroll
      for (int j = 0; j < 8; ++j) v[j] = sm[(blk * 64 + perm_key(p0 + j)) * LDR + 64 * kv + dim];
      *(h16x8*)(vt + ((size_t)((b * 2 + kv) * 128 + (s0 >> 6) + blk)) * 4096 + dim * 64 + p0) = v;
    }
  } else {
    float* gates = (float*)(ws + OFF_GATES);
#pragma unroll
    for (int i = 0; i < 12; ++i) {
      const int idx = i * NTHREADS + tid_e;
      const int r = idx / 24, cc = idx % 24;
      gates[(size_t)(row0 + r) * 24 + cc] = sigm((float)sm[r * LDR + cc]);
    }
  }
  __syncthreads();
}
__device__ __forceinline__ void phase_inproj(const Params& p, int l, h16* sm) {
  const TileIter tf = xcd_tiles(64 * 19);
  for (int t = tf.cur; t < tf.end; t += tf.step) inproj_tile(p, sm, t / 19, t % 19);
  if (l == 0) conv_share(p, 0, CV_MOE0, CV_Q1, 0, (64 * 19 / 8) % (gridDim.x >> 3), (float*)sm);
}

__device__ __forceinline__ void mixa_compress1(const Params& p, int item, h16* sm) {
  unsigned char* ws = p.ws;
  const int which = item >> 6, mt = (item >> 3) & 7, ks = (item >> 1) & 3, half = item & 1;
  const h16* A = (const h16*)(ws + (which ? OFF_VC : OFF_KC)) + (size_t)mt * 256 * 1024 + ks * 512;
  const h16* W = (const h16*)(ws + (which ? OFF_W1V : OFF_W1K)) + (size_t)half * 128 * 2048 + ks * 512;
  float* hp = (float*)(ws + OFF_HIDP) + ((size_t)(ks * 2 + which) * 2048) * 256;
  f32x4 acc[8][2];
  gemm_mainloop<128>(acc, [&](int r) { return A + (size_t)r * 1024; }, W, 2048, 8, sm);
  const int tid_e = tidx(), lane = tid_e & 63, wave = tid_e >> 6, wr = wave >> 2, wc = wave & 3, fr = lane & 15, fq = lane >> 4;
#pragma unroll
  for (int m = 0; m < 8; ++m)
#pragma unroll
    for (int n = 0; n < 2; ++n) {
      const int row = mt * 256 + wr * 128 + m * 16 + fr, col = half * 128 + wc * 32 + n * 16 + 4 * fq;
      *(f32x4*)(hp + (size_t)row * 256 + col) = acc[m][n];
    }
}

__device__ __forceinline__ void mixa_lru(const Params& p, int l, int item, float* sm) {
  unsigned char* ws = p.ws;
  const int tid = tidx();
  const int half = tid >> 8;
  item = item * 2 + half;
  sm += half * 14400;
  const int b = item >> 8, ck = item & 255;
  const int c = tid & 255;
  const int nb = c >> 6;
  const int lane = tid & 63, fr = lane & 15, fq = lane >> 4;
  const h16* P = (const h16*)(ws + OFF_P16);
  const float* cw = p.in[I_LCW] + l * 4 * 256;
  const float w0 = cw[c], w1 = cw[256 + c], w2 = cw[512 + c], w3 = cw[768 + c], cb = p.in[I_LCB][l * 256 + c];
  const float ba = p.in[I_LBA][l * 256 + c], bx = p.in[I_LBX][l * 256 + c];
  const float lam = p.in[I_LLAM][l * 256 + c];
  const float ls = -log1pf(expf(-lam));
  h16x8 bw[2][4][2];
  {
    const h16* lw = (const h16*)(ws + OFF_LRUW);
#pragma unroll
    for (int mat = 0; mat < 2; ++mat)
#pragma unroll
      for (int nt = 0; nt < 4; ++nt)
#pragma unroll
        for (int ks = 0; ks < 2; ++ks) bw[mat][nt][ks] = *(const h16x8*)(lw + ((size_t)((mat * 4 + nb) * 64 + nt * 16 + fr)) * 64 + ks * 32 + 8 * fq);
  }
  const int t0 = ck * 32;
  float x0 = 0.f, x1 = 0.f, x2 = 0.f;
  if (t0 >= 3) {
    x0 = (float)P[(size_t)(b * S + t0 - 3) * NIN + C_XL + c];
    x1 = (float)P[(size_t)(b * S + t0 - 2) * NIN + C_XL + c];
    x2 = (float)P[(size_t)(b * S + t0 - 1) * NIN + C_XL + c];
  }
  float h = 0.f, ap = 1.f;
  float* lh = (float*)(ws + OFF_LRUH);
  float* la = (float*)(ws + OFF_LRUA);
  float* sr = sm + 4096;
  float* si = sm + 8192;
  h16* xh = (h16*)(sm + 12288);
#pragma unroll 1
  for (int sub = 0; sub < 2; ++sub) {
    const int tb = t0 + sub * 16;
    {
      h16 xv[16];
      const h16* xp = P + (size_t)(b * S + tb) * NIN + C_XL + c;
#pragma unroll
      for (int tt = 0; tt < 16; ++tt) { xv[tt] = *xp; xp += NIN; asm volatile("" : "+v"(xp)); }
#pragma unroll
      for (int tt = 0; tt < 16; ++tt) {
        const float x3 = (float)xv[tt];
        const float xc = w0 * x0 + w1 * x1 + w2 * x2 + w3 * x3 + cb;
        sm[tt * 256 + c] = xc;
        xh[tt * 264 + c] = (h16)xc;
        x0 = x1; x1 = x2; x2 = x3;
      }
    }
    {
      h16x8 af[2];
#pragma unroll
      for (int ks = 0; ks < 2; ++ks) af[ks] = *(const h16x8*)(xh + fr * 264 + nb * 64 + ks * 32 + 8 * fq);
#pragma unroll
      for (int nt = 0; nt < 4; ++nt) {
        f32x4 ar = {0.f, 0.f, 0.f, 0.f}, ai = {0.f, 0.f, 0.f, 0.f};
#pragma unroll
        for (int ks = 0; ks < 2; ++ks) {
          ar = __builtin_amdgcn_mfma_f32_16x16x32_f16(af[ks], bw[0][nt][ks], ar, 0, 0, 0);
          ai = __builtin_amdgcn_mfma_f32_16x16x32_f16(af[ks], bw[1][nt][ks], ai, 0, 0, 0);
        }
#pragma unroll
        for (int j = 0; j < 4; ++j) {
          sr[(4 * fq + j) * 256 + nb * 64 + nt * 16 + fr] = ar[j];
          si[(4 * fq + j) * 256 + nb * 64 + nt * 16 + fr] = ai[j];
        }
      }
    }
#pragma unroll 4
    for (int tt = 0; tt < 16; ++tt) {
      const float r = sigm(sr[tt * 256 + c] + ba), ig = sigm(si[tt * 256 + c] + bx);
      const float log_a = 8.f * r * ls;
      const float a = __expf(log_a);
      const float mult = sqrtf(-expm1f(2.f * log_a));
      sr[tt * 256 + c] = a;
      si[tt * 256 + c] = mult * ig * sm[tt * 256 + c];
    }
    float* lhp = lh + (size_t)(b * S + tb) * 256 + c;
    float* lap = la + (size_t)(b * S + tb) * 256 + c;
#pragma unroll 4
    for (int tt = 0; tt < 16; ++tt) {
      const float a = sr[tt * 256 + c];
      h = a * h + si[tt * 256 + c];
      ap *= a;
      lhp[tt * 256] = h;
      lap[tt * 256] = ap;
    }
  }
  ((float*)(ws + OFF_HEND))[(size_t)(b * 256 + ck) * 256 + c] = h;
  ((float*)(ws + OFF_AEND))[(size_t)(b * 256 + ck) * 256 + c] = ap;
  __syncthreads();
}

__device__ __forceinline__ void mixa_conv(const Params& p, int l, int item, float* sm) {
  unsigned char* ws = p.ws;
  const int half = tidx() >> 8;
  item = item * 2 + half;
  sm += half * 15872;
  const int b = item >> 8, ck = item & 255;
  const int c = tidx() & 255;
  const h16* P = (const h16*)(ws + OFF_P16);
  const int t0 = ck * 32;
  float col[64];
#pragma unroll
  for (int r0 = 0; r0 < 64; r0 += 16) {
    h16 va[16], vb[16];
#pragma unroll
    for (int q = 0; q < 16; ++q) {
      const int t = t0 - 30 + r0 + q;
      va[q] = (h16)0.f; vb[q] = (h16)0.f;
      if (t >= 0 && r0 + q < 62) {
        const h16* pr = P + (size_t)(b * S + t) * NIN;
        va[q] = pr[C_CVA + c]; vb[q] = pr[C_CVB + c];
      }
    }
#pragma unroll
    for (int q = 0; q < 16; ++q) col[r0 + q] = (float)va[q] * sigm((float)vb[q]);
    asm volatile("" ::: "memory");
  }
  float w[31];
#pragma unroll
  for (int j = 0; j < 31; ++j) w[j] = p.in[I_DWW][(size_t)(l * 31 + j) * 256 + c];
  const float bias = p.in[I_DWB][l * 256 + c];
#pragma unroll
  for (int i = 0; i < 32; ++i) {
    float z = bias;
#pragma unroll
    for (int j = 0; j < 31; ++j) z += w[j] * col[i + j];
    sm[i * 256 + c] = z;
  }
  __syncthreads();
  const int lane = tidx() & 63, wave = (tidx() >> 6) & 3;
  const float4 lg = *(const float4*)(p.in[I_LNG] + l * 256 + lane * 4);
  const float4 lb = *(const float4*)(p.in[I_LNB] + l * 256 + lane * 4);
  const float4 gn = *(const float4*)(p.in[I_ONG] + l * 1024 + 768 + lane * 4);
  h16* yc = (h16*)(ws + OFF_H16);
  for (int i = wave * 8; i < wave * 8 + 8; ++i) {
    const float4 z = *(const float4*)(sm + i * 256 + lane * 4);
    const float mu = wsum(z.x + z.y + z.z + z.w) * (1.f / 256.f);
    const float dx = z.x - mu, dy = z.y - mu, dz = z.z - mu, dw = z.w - mu;
    const float var = wsum(dx * dx + dy * dy + dz * dz + dw * dw) * (1.f / 256.f);
    const float rs = rsqrtf(var + EPS);
    const float y0 = silu_f(dx * rs * lg.x + lb.x), y1 = silu_f(dy * rs * lg.y + lb.y), y2 = silu_f(dz * rs * lg.z + lb.z), y3 = silu_f(dw * rs * lg.w + lb.w);
    const float r2 = rsqrtf(wsum(y0 * y0 + y1 * y1 + y2 * y2 + y3 * y3) * (1.f / 256.f) + EPS);
    *(h16x4*)(yc + (size_t)(b * S + t0 + i) * D + 768 + lane * 4) = pack4(y0 * r2 * gn.x, y1 * r2 * gn.y, y2 * r2 * gn.z, y3 * r2 * gn.w);
  }
  __syncthreads();
}

__device__ __forceinline__ void phase_mixa(const Params& p, int l, void* sm) {
  const int G = gridDim.x;
  if (blockIdx.x == 0) {
    const int o = tidx();
    const float* pp = (const float*)(p.ws + OFF_PBPART) + (size_t)(o >> 8) * 32 * 256 + (o & 255);
    float pv[32];
#pragma unroll
    for (int k = 0; k < 32; ++k) pv[k] = pp[k * 256];
    float accb = 0.f;
#pragma unroll
    for (int k = 0; k < 32; ++k) accb += pv[k];
    ((float*)(p.ws + OFF_PB))[o] = accb;
  }
  for (int it = blockIdx.x; it < 128; it += G) mixa_compress1(p, it, (h16*)sm);
  for (int it = blockIdx.x; it < 256; it += G) mixa_lru(p, l, it, (float*)sm);
  for (int it = (blockIdx.x + G - 64 % G) % G; it < 256; it += G) mixa_conv(p, l, it, (float*)sm);
  if (l == 0) conv_share(p, 0, CV_Q1, CV_Q2, 0, 16, (float*)sm);
}

__device__ __forceinline__ void phase_mixb(const Params& p, int l, float* sm) {
  unsigned char* ws = p.ws;
  const int tid = tidx();
  for (int it = blockIdx.x; it < 512; it += gridDim.x) {
    const int which = it >> 8;
    const int row0 = (it & 255) * 8;
    {
      const float* hp = (const float*)(ws + OFF_HIDP) + ((size_t)which * 2048 + row0) * 256;
      const float* pb = (const float*)(ws + OFF_PB) + which * 256;
      const int r = tid >> 6, c4 = (tid & 63) * 4;
      const size_t o = (size_t)r * 256 + c4;
      const float4 a0 = *(const float4*)(hp + o), a1 = *(const float4*)(hp + (size_t)2 * 2048 * 256 + o);
      const float4 a2 = *(const float4*)(hp + (size_t)4 * 2048 * 256 + o), a3 = *(const float4*)(hp + (size_t)6 * 2048 * 256 + o);
      const float4 bb = *(const float4*)(pb + c4);
      float* d = sm + r * 256 + c4;
      d[0] = gelu_tanh(a0.x + a1.x + a2.x + a3.x + bb.x); d[1] = gelu_tanh(a0.y + a1.y + a2.y + a3.y + bb.y);
      d[2] = gelu_tanh(a0.z + a1.z + a2.z + a3.z + bb.z); d[3] = gelu_tanh(a0.w + a1.w + a2.w + a3.w + bb.w);
      const float4* wsrc = (const float4*)(p.in[which ? I_CVW2 : I_CKW2] + (size_t)l * 256 * 64);
      float4* wdst = (float4*)(sm + 2048);
#pragma unroll
      for (int q = 0; q < 8; ++q) wdst[q * NTHREADS + tid] = wsrc[q * NTHREADS + tid];
    }
    __syncthreads();
    const int row = row0 + (tid >> 6), d = tid & 63;
    const float* hr = sm + (tid >> 6) * 256;
    const float* w2 = sm + 2048 + d;
    float s = 0.f;
#pragma unroll 8
    for (int j = 0; j < 256; ++j) s += (float)(h16)hr[j] * w2[j * 64];
    const int bkv = row >> 9, n = row & 511;
    if (n == 511) s = 0.f;
    if (which == 0) {
      ((h16*)(ws + OFF_KCMP))[((size_t)bkv * 512 + n) * 64 + d] = (h16)s;
    } else {
      const int blk = n >> 6, key = n & 63;
      const int pos = 32 * (key >> 5) + 8 * ((key >> 2) & 3) + 4 * ((key >> 4) & 1) + (key & 3);
      ((h16*)(ws + OFF_VCMPT))[((size_t)(bkv * 8 + blk) * 64 + d) * 64 + pos] = (h16)s;
    }
    __syncthreads();
  }
  for (int task = (blockIdx.x + gridDim.x - 16 % gridDim.x) % gridDim.x; task < 16; task += gridDim.x) {
    const int b = task >> 3, c = (task & 7) * 32 + (tid & 31), grp = tid >> 5;
    const float* he = (const float*)(ws + OFF_HEND) + ((size_t)b * 256 + grp * 16) * 256 + c;
    const float* ae = (const float*)(ws + OFF_AEND) + ((size_t)b * 256 + grp * 16) * 256 + c;
    float* cy = (float*)(ws + OFF_CARRY) + ((size_t)b * 256 + grp * 16) * 256 + c;
    float hv[16], av[16];
#pragma unroll
    for (int k = 0; k < 16; ++k) { hv[k] = he[k * 256]; av[k] = ae[k * 256]; }
    float ga = 1.f, gh = 0.f;
#pragma unroll
    for (int k = 0; k < 16; ++k) { gh = hv[k] + av[k] * gh; ga *= av[k]; }
    sm[tid] = ga; sm[512 + tid] = gh;
    __syncthreads();
    float carry = 0.f;
    for (int q = 0; q < grp; ++q) carry = sm[512 + q * 32 + (tid & 31)] + sm[q * 32 + (tid & 31)] * carry;
#pragma unroll
    for (int k = 0; k < 16; ++k) {
      cy[k * 256] = carry;
      carry = hv[k] + av[k] * carry;
    }
    __syncthreads();
  }
  if (l == 0) conv_share(p, 0, CV_Q2, CV_MOE1, (int)(gridDim.x >> 3) - 2, (int)(gridDim.x >> 3), sm);
}

__device__ __forceinline__ void stage8k(const h16* __restrict__ g, h16* l, int tid) {
  const int r = tid >> 3, cl = (tid & 7) ^ ((r >> 1) & 7);
  glds16(g + r * 64 + cl * 8, l + tid * 8);
}
__device__ __forceinline__ h16x8 ldfrag(const h16* l, int row, int chunk) {
  return *(const h16x8*)(l + row * 64 + ((chunk ^ ((row >> 1) & 7)) * 8));
}

template <int MODE>
__device__ __forceinline__ void attn_branch(const h16* __restrict__ Kg, const h16* __restrict__ Vg, int j0, int j1, h16* ring,
                                            const h16x8 (&qf)[2][2], float (&m)[2], float (&l)[2], f32x4 (&o)[2][4],
                                            const int (&tq)[2], const int (&lim)[2], const int (&tlim)[2], const int (&tfl)[2],
                                            const unsigned long long (&mylo)[2], const unsigned long long (&myhi)[2],
                                            const unsigned long long (&ulo)[2], const unsigned long long (&uhi)[2],
                                            const float (&inv)[2], float* impw) {
  int tid = tidx();
  asm volatile("" : "+v"(tid));
  const int lane = tid & 63;
  const int h = lane >> 4, c = lane & 15, qi = c >> 2, g = c & 3;
  constexpr bool PV = MODE != 0;
  constexpr int SS = 3;
  const int n = j1 - j0 + 1;
  if (n <= 0) return;
  const int nss = (n + SS - 1) / SS;
#pragma unroll
  for (int q = 0; q < SS; ++q)
    if (q < n) {
      stage8k(Kg + (size_t)(j0 + q) * 4096, ring + q * 8192, tid);
      if (PV) stage8k(Vg + (size_t)(j0 + q) * 4096, ring + q * 8192 + 4096, tid);
    }
  int sbase = 0;
  for (int ss = 0; ss < nss; ++ss) {
    VMCNT(0);
    __builtin_amdgcn_s_barrier();
    {
      const int sn = SS - sbase;
#pragma unroll
      for (int q = 0; q < SS; ++q) {
        const int jb = SS * (ss + 1) + q;
        if (jb < n) {
          stage8k(Kg + (size_t)(j0 + jb) * 4096, ring + (sn + q) * 8192, tid);
          if (PV) stage8k(Vg + (size_t)(j0 + jb) * 4096, ring + (sn + q) * 8192 + 4096, tid);
        }
      }
    }
#pragma unroll 1
   for (int sub = 0; sub < SS; ++sub) {
    const int it = SS * ss + sub;
    if (it >= n) break;
    const int j = j0 + it;
    const h16* cK = ring + (sbase + sub) * 8192;
    const h16* cV = cK + 4096;
    bool act[2];
#pragma unroll
    for (int mq = 0; mq < 2; ++mq) {
      if (MODE <= 1) act[mq] = j * 64 <= tlim[mq];
      else if (MODE == 2) act[mq] = ((j < 64 ? (ulo[mq] >> j) : (uhi[mq] >> (j - 64))) & 1ull) != 0ull;
      else act[mq] = (j * 64 <= tlim[mq] + 3) && (j * 64 + 63 > tlim[mq] - 512);
    }
    if (act[0] || act[1]) {
      h16x8 pf[2][2];
      h16x8 kf[4][2];
#pragma unroll
      for (int kt = 0; kt < 4; ++kt)
#pragma unroll
        for (int ks = 0; ks < 2; ++ks) kf[kt][ks] = ldfrag(cK, 16 * kt + c, 4 * ks + h);
#pragma unroll
      for (int mq = 0; mq < 2; ++mq)
        if (act[mq]) {
          f32x4 s[1][4];
          {
#pragma unroll
            for (int kt = 0; kt < 4; ++kt) {
              s[0][kt] = (f32x4){0.f, 0.f, 0.f, 0.f};
#pragma unroll
              for (int ks = 0; ks < 2; ++ks) s[0][kt] = __builtin_amdgcn_mfma_f32_16x16x32_f16(kf[kt][ks], qf[mq][ks], s[0][kt], 0, 0, 0);
            }
          }
          const bool selbit = MODE == 2 ? (((j < 64 ? (mylo[mq] >> j) : (myhi[mq] >> (j - 64))) & 1ull) != 0ull) : true;
          bool interior;
          if (MODE <= 1) interior = j * 64 + 63 <= tfl[mq];
          else if (MODE == 2) interior = j * 64 + 63 <= tfl[mq];
          else interior = (j * 64 + 63 <= tfl[mq]) && (j * 64 > tfl[mq] + 3 - 512);
          if (!interior) {
            const int pbase = j * 64 + 4 * h;
#pragma unroll
            for (int kt = 0; kt < 4; ++kt)
#pragma unroll
              for (int i = 0; i < 4; ++i) {
                const int pos = pbase + 16 * kt + i;
                bool v;
                if (MODE <= 1) v = pos <= lim[mq];
                else if (MODE == 2) v = selbit && pos <= tq[mq];
                else v = pos <= tq[mq] && pos > tq[mq] - 512;
                s[0][kt][i] = v ? s[0][kt][i] : -1e30f;
              }
          }
          const bool rowoff = MODE == 2 && interior && !selbit;
          if (MODE == 1) {
#pragma unroll
            for (int kt = 0; kt < 4; ++kt) {
              float ps = 0.f;
#pragma unroll
              for (int i = 0; i < 4; ++i) {
                const float pv = __builtin_amdgcn_exp2f(s[0][kt][i] - m[mq]) * inv[mq];
                s[0][kt][i] = pv;
                ps += pv;
              }
              ps += dppf<0xB1>(ps);
              ps += dppf<0x4E>(ps);
              if (g == 0) impw[(4 * mq + qi) * 128 + j * 16 + kt * 4 + h] = ps;
            }
          } else {
            float bm = fmaxf(fmaxf(fmaxf(s[0][0][0], s[0][0][1]), fmaxf(s[0][0][2], s[0][0][3])), fmaxf(fmaxf(s[0][1][0], s[0][1][1]), fmaxf(s[0][1][2], s[0][1][3])));
            bm = fmaxf(bm, fmaxf(fmaxf(fmaxf(s[0][2][0], s[0][2][1]), fmaxf(s[0][2][2], s[0][2][3])), fmaxf(fmaxf(s[0][3][0], s[0][3][1]), fmaxf(s[0][3][2], s[0][3][3]))));
            bm = rowoff ? -1e30f : bm;
            if (__any(bm > m[mq] + 8.f)) {
              bm = fmaxf(bm, __shfl_xor(bm, 16));
              bm = fmaxf(bm, __shfl_xor(bm, 32));
              const float mn = fmaxf(m[mq], bm);
              const float alpha = __builtin_amdgcn_exp2f(m[mq] - mn);
              l[mq] *= alpha;
              m[mq] = mn;
              if (PV) {
#pragma unroll
                for (int mt = 0; mt < 4; ++mt) o[mq][mt] *= alpha;
              }
            }
            const float mref = (m[mq] > -1e29f && !rowoff) ? m[mq] : 1e30f;
            float ps = 0.f;
#pragma unroll
            for (int kt = 0; kt < 4; ++kt)
#pragma unroll
              for (int i = 0; i < 4; ++i) {
                const float pv = __builtin_amdgcn_exp2f(s[0][kt][i] - mref);
                s[0][kt][i] = pv;
                ps += pv;
              }
            l[mq] += ps;
          }
          if (PV) {
#pragma unroll
            for (int s2 = 0; s2 < 2; ++s2)
#pragma unroll
              for (int i = 0; i < 4; ++i) { pf[mq][s2][i] = (h16)s[0][2 * s2][i]; pf[mq][s2][4 + i] = (h16)s[0][2 * s2 + 1][i]; }
          }
        }
      if (PV) {
        h16x8 vf[4][2];
#pragma unroll
        for (int mt = 0; mt < 4; ++mt)
#pragma unroll
          for (int s2 = 0; s2 < 2; ++s2) vf[mt][s2] = ldfrag(cV, 16 * mt + c, 4 * s2 + h);
#pragma unroll
        for (int mq = 0; mq < 2; ++mq)
          if (act[mq]) {
#pragma unroll
            for (int s2 = 0; s2 < 2; ++s2) {
#pragma unroll
              for (int mt = 0; mt < 4; ++mt) o[mq][mt] = __builtin_amdgcn_mfma_f32_16x16x32_f16(vf[mt][s2], pf[mq][s2], o[mq][mt], 0, 0, 0);
            }
          }
      }
    }
   }
    sbase = SS - sbase;
  }
  __builtin_amdgcn_s_barrier();
}

__device__ __forceinline__ void attn_item(const Params& p, int l, int item, float* sm) {
  unsigned char* ws = p.ws;
  int tid = tidx();
  asm volatile("" : "+v"(tid));
  const int lane = tid & 63, wave = tid >> 6;
  const int combo = item & 3, qt = item >> 2;
  const int b = combo >> 1, kv = combo & 1;
  const int t0 = qt * 64, tw0 = t0 + 8 * wave;
  const int h = lane >> 4, c = lane & 15, qi = c >> 2, g = c & 3;
  const int head = kv * 4 + g, bkv = b * 2 + kv;
  h16* ring = (h16*)sm;
  float* impw = sm + 24576 + wave * 1024;
  unsigned long long* selm = (unsigned long long*)(sm + 24576 + 8192) + wave * 16;

  h16x8 qf[2][2];
  int tq[2];
#pragma unroll
  for (int mq = 0; mq < 2; ++mq) {
    tq[mq] = tw0 + 4 * mq + qi;
    const h16* qrow = (const h16*)(ws + OFF_Q16) + (size_t)(b * S + tq[mq]) * 512 + head * 64;
    qf[mq][0] = *(const h16x8*)(qrow + 8 * h);
    qf[mq][1] = *(const h16x8*)(qrow + 32 + 8 * h);
  }
  for (int i = lane; i < 1024; i += 64) impw[i] = 0.f;

  h16x4 ofin[2][4];
  float m[2], ll[2], inv[2];
  f32x4 o[2][4];
  const unsigned long long z2[2] = {0ull, 0ull};
  {
    int lim[2], tlim[2], tflc[2];
#pragma unroll
    for (int mq = 0; mq < 2; ++mq) {
      lim[mq] = tq[mq] >= 31 ? ((tq[mq] - 31) >> 4) : -1;
      const int tl = tw0 + 4 * mq + 3;
      tlim[mq] = tl >= 31 ? ((tl - 31) >> 4) : -1;
      const int tf0 = tw0 + 4 * mq;
      tflc[mq] = tf0 >= 31 ? ((tf0 - 31) >> 4) : -1;
      m[mq] = -1e30f; ll[mq] = 0.f; inv[mq] = 0.f;
#pragma unroll
      for (int mt = 0; mt < 4; ++mt) o[mq][mt] = (f32x4){0.f, 0.f, 0.f, 0.f};
    }
    const int nl = (t0 + 63 - 31) >> 4;
    const int jl = nl >> 6;
    const h16* Kc = (const h16*)(ws + OFF_KCMP) + (size_t)bkv * 512 * 64;
    const h16* Vc = (const h16*)(ws + OFF_VCMPT) + (size_t)bkv * 8 * 4096;
    attn_branch<0>(Kc, Vc, 0, jl, ring, qf, m, ll, o, tq, lim, tlim, tflc, z2, z2, z2, z2, inv, impw);
#pragma unroll
    for (int mq = 0; mq < 2; ++mq) {
      float lt = ll[mq];
      lt += __shfl_xor(lt, 16);
      lt += __shfl_xor(lt, 32);
      inv[mq] = lt > 0.f ? 1.f / lt : 0.f;
    }
    attn_branch<1>(Kc, Vc, 0, jl, ring, qf, m, ll, o, tq, lim, tlim, tflc, z2, z2, z2, z2, inv, impw);
    const float* gt0 = (const float*)(ws + OFF_GATES) + (size_t)(b * S) * 24 + head * 3;
#pragma unroll
    for (int mq = 0; mq < 2; ++mq) {
      const float g0 = gt0[(size_t)tq[mq] * 24] * ASCALE;
#pragma unroll
      for (int mt = 0; mt < 4; ++mt) ofin[mq][mt] = pack4(o[mq][mt][0] * g0, o[mq][mt][1] * g0, o[mq][mt][2] * g0, o[mq][mt][3] * g0);
    }
  }
  for (int q = 0; q < 8; ++q) {
    const int t = tw0 + q, own = t >> 6;
    const float* ir = impw + q * 128;
    const int ja = lane, jb = lane + 64;
    unsigned k0 = 0u, k1 = 0u;
    if (ja <= own) k0 = (ja == 0 || ja == own) ? (0xFFFFFF80u | (unsigned)(127 - ja)) : (((__float_as_uint(ir[ja]) & ~127u) | (unsigned)(127 - ja)) + 1u);
    if (jb <= own) k1 = (jb == own) ? (0xFFFFFF80u | (unsigned)(127 - jb)) : (((__float_as_uint(ir[jb]) & ~127u) | (unsigned)(127 - jb)) + 1u);
    unsigned thr = 0u;
    for (int bit = 31; bit >= 0; --bit) {
      const unsigned cand = thr | (1u << bit);
      const int cnt = __popcll(__ballot(k0 >= cand)) + __popcll(__ballot(k1 >= cand));
      if (cnt >= 16) thr = cand;
    }
    const unsigned long long mlo = __ballot(k0 >= thr && ja <= own);
    const unsigned long long mhi = __ballot(k1 >= thr && jb <= own);
    if (lane == 0) { selm[q * 2] = mlo; selm[q * 2 + 1] = mhi; }
  }
  unsigned long long mylo[2], myhi[2], ulo[2], uhi[2];
#pragma unroll
  for (int mq = 0; mq < 2; ++mq) {
    mylo[mq] = selm[(4 * mq + qi) * 2];
    myhi[mq] = selm[(4 * mq + qi) * 2 + 1];
    unsigned long long a = selm[(4 * mq) * 2] | selm[(4 * mq + 1) * 2] | selm[(4 * mq + 2) * 2] | selm[(4 * mq + 3) * 2];
    unsigned long long bb = selm[(4 * mq) * 2 + 1] | selm[(4 * mq + 1) * 2 + 1] | selm[(4 * mq + 2) * 2 + 1] | selm[(4 * mq + 3) * 2 + 1];
    ulo[mq] = (unsigned long long)__builtin_amdgcn_readfirstlane((unsigned)a) | ((unsigned long long)__builtin_amdgcn_readfirstlane((unsigned)(a >> 32)) << 32);
    uhi[mq] = (unsigned long long)__builtin_amdgcn_readfirstlane((unsigned)bb) | ((unsigned long long)__builtin_amdgcn_readfirstlane((unsigned)(bb >> 32)) << 32);
  }
  const float* gtb = (const float*)(ws + OFF_GATES) + (size_t)(b * S) * 24 + head * 3;
  {
    int tl0[2] = {0, 0};
    const int tfs[2] = {tw0, tw0 + 4};
#pragma unroll
    for (int mq = 0; mq < 2; ++mq) {
      m[mq] = -1e30f; ll[mq] = 0.f;
#pragma unroll
      for (int mt = 0; mt < 4; ++mt) o[mq][mt] = (f32x4){0.f, 0.f, 0.f, 0.f};
    }
    attn_branch<2>((const h16*)(ws + OFF_KS) + (size_t)bkv * S * 64, (const h16*)(ws + OFF_VST) + (size_t)bkv * 128 * 4096, 0, (t0 + 63) >> 6, ring, qf, m, ll, o,
                   tq, tl0, tl0, tfs, mylo, myhi, ulo, uhi, inv, impw);
#pragma unroll
    for (int mq = 0; mq < 2; ++mq) {
      float lt = ll[mq];
      lt += __shfl_xor(lt, 16);
      lt += __shfl_xor(lt, 32);
      const float sc = lt > 0.f ? gtb[(size_t)tq[mq] * 24 + 1] * ASCALE / lt : 0.f;
#pragma unroll
      for (int mt = 0; mt < 4; ++mt)
        ofin[mq][mt] = pack4((float)ofin[mq][mt][0] + o[mq][mt][0] * sc, (float)ofin[mq][mt][1] + o[mq][mt][1] * sc, (float)ofin[mq][mt][2] + o[mq][mt][2] * sc,
                             (float)ofin[mq][mt][3] + o[mq][mt][3] * sc);
    }
  }
  {
    int tl0[2] = {0, 0}, tf[2];
#pragma unroll
    for (int mq = 0; mq < 2; ++mq) {
      tf[mq] = tw0 + 4 * mq;
      m[mq] = -1e30f; ll[mq] = 0.f;
#pragma unroll
      for (int mt = 0; mt < 4; ++mt) o[mq][mt] = (f32x4){0.f, 0.f, 0.f, 0.f};
    }
    const int jlo = t0 >= 511 ? ((t0 - 511) >> 6) : 0;
    attn_branch<3>((const h16*)(ws + OFF_KW) + (size_t)bkv * S * 64, (const h16*)(ws + OFF_VWT) + (size_t)bkv * 128 * 4096, jlo, (t0 + 63) >> 6, ring, qf, m, ll, o,
                   tq, tl0, tf, tf, z2, z2, z2, z2, inv, impw);
#pragma unroll
    for (int mq = 0; mq < 2; ++mq) {
      float lt = ll[mq];
      lt += __shfl_xor(lt, 16);
      lt += __shfl_xor(lt, 32);
      const float sc = lt > 0.f ? gtb[(size_t)tq[mq] * 24 + 2] * ASCALE / lt : 0.f;
#pragma unroll
      for (int mt = 0; mt < 4; ++mt)
        ofin[mq][mt] = pack4((float)ofin[mq][mt][0] + o[mq][mt][0] * sc, (float)ofin[mq][mt][1] + o[mq][mt][1] * sc, (float)ofin[mq][mt][2] + o[mq][mt][2] * sc,
                             (float)ofin[mq][mt][3] + o[mq][mt][3] * sc);
    }
  }
  {
    h16* yc = (h16*)(ws + OFF_H16);
    const float* gn = p.in[I_ONG] + l * 1024 + 256 + head * 64;
    float* ssq = (float*)(ws + OFF_SSQ);
#pragma unroll
    for (int mq = 0; mq < 2; ++mq) {
      float sq = 0.f;
      h16* yr = yc + (size_t)(b * S + tq[mq]) * D + head * 64;
#pragma unroll
      for (int mt = 0; mt < 4; ++mt) {
        const float v[4] = {(float)ofin[mq][mt][0], (float)ofin[mq][mt][1], (float)ofin[mq][mt][2], (float)ofin[mq][mt][3]};
        sq += v[0] * v[0] + v[1] * v[1] + v[2] * v[2] + v[3] * v[3];
        const float4 gg = *(const float4*)(gn + 16 * mt + 4 * h);
        *(h16x4*)(yr + 16 * mt + 4 * h) = pack4(v[0] * gg.x, v[1] * gg.y, v[2] * gg.z, v[3] * gg.w);
      }
      sq += __shfl_xor(sq, 16);
      sq += __shfl_xor(sq, 32);
      sq += dppf<0xB1>(sq);
      sq += dppf<0x4E>(sq);
      if (h == 0 && g == 0) ssq[(size_t)(b * S + tq[mq]) * 2 + kv] = sq * (1.f / (ASCALE * ASCALE));
    }
  }
}

__device__ __forceinline__ void lrufix_item(const Params& p, int l, int item) {
  unsigned char* ws = p.ws;
  const int lane = tidx() & 63, wave = tidx() >> 6;
  const int b = item >> 7, ck = item & 127;
  const h16* P = (const h16*)(ws + OFF_P16);
  const float4 cy = *(const float4*)((const float*)(ws + OFF_CARRY) + (size_t)(b * 256 + ck * 2 + (wave >> 2)) * 256 + lane * 4);
  const float4 gn = *(const float4*)(p.in[I_ONG] + l * 1024 + lane * 4);
  h16* yc = (h16*)(ws + OFF_H16);
  float4 hl[8], al[8];
  h16x4 gl[8];
#pragma unroll
  for (int q = 0; q < 8; ++q) {
    const size_t row = (size_t)(b * S + ck * 64 + wave * 8 + q);
    hl[q] = *(const float4*)((const float*)(ws + OFF_LRUH) + row * 256 + lane * 4);
    al[q] = *(const float4*)((const float*)(ws + OFF_LRUA) + row * 256 + lane * 4);
    gl[q] = *(const h16x4*)(P + row * NIN + C_GL + lane * 4);
  }
#pragma unroll
  for (int q = 0; q < 8; ++q) {
    const size_t row = (size_t)(b * S + ck * 64 + wave * 8 + q);
    const float y0 = (hl[q].x + al[q].x * cy.x) * gelu_tanh((float)gl[q][0]);
    const float y1 = (hl[q].y + al[q].y * cy.y) * gelu_tanh((float)gl[q][1]);
    const float y2 = (hl[q].z + al[q].z * cy.z) * gelu_tanh((float)gl[q][2]);
    const float y3 = (hl[q].w + al[q].w * cy.w) * gelu_tanh((float)gl[q][3]);
    const float rstd = rsqrtf(wsum(y0 * y0 + y1 * y1 + y2 * y2 + y3 * y3) * (1.f / 256.f) + EPS);
    *(h16x4*)(yc + row * D + 512 + lane * 4) = pack4(y0 * rstd * gn.x, y1 * rstd * gn.y, y2 * rstd * gn.z, y3 * rstd * gn.w);
  }
}

__device__ __forceinline__ void phase_attn(const Params& p, int l, float* sm) {
  for (int it = blockIdx.x; it < 256; it += gridDim.x) {
#pragma unroll 1
    for (int rep = 0; rep < 2; ++rep) attn_item(p, l, rep ? (127 - (it >> 2)) * 4 + (it & 3) : it, sm);
  }
  for (int it = blockIdx.x; it < 256; it += gridDim.x) lrufix_item(p, l, it);
}

__device__ __forceinline__ void phase_outproj(const Params& p, int l, h16* sm) {
  unsigned char* ws = p.ws;
  const h16* A = (const h16*)(ws + OFF_H16);
  const h16* W = (const h16*)(ws + OFF_WOUT);
  const float* mod = (const float*)(ws + OFF_MOD);
  float* xa = (float*)(ws + OFF_XA);
  const float* xin = l == 0 ? p.in[I_X] : (const float*)xa;
  const TileIter ti = xcd_tiles(64 * 4);
  for (int t = ti.cur; t < ti.end; t += ti.step) {
    const int mt = t >> 2, nt = t & 3;
    f32x4 acc[8][4];
    const h16* Ab = A + (size_t)mt * 256 * D;
    {
      float* sct = (float*)((unsigned char*)sm + SCHED_OFF - 1024);
      const int tq_ = tidx();
      if (tq_ < 256) {
        const float2 q2 = *(const float2*)((const float*)(ws + OFF_SSQ) + (size_t)(mt * 256 + tq_) * 2);
        sct[tq_] = rsqrtf((q2.x + q2.y) * (1.f / 512.f) + EPS) * (1.f / ASCALE);
      }
    }
    gemm_mainloop<256>(acc, [&](int r) { return Ab + (size_t)r * D; }, W + (size_t)nt * 256 * D, D, 8, sm);
    const int tid_e = tidx(), lane = tid_e & 63, wave = tid_e >> 6, wr = wave >> 2, wc = wave & 3, fr = lane & 15, fq = lane >> 4;
    {
      const float* sct = (const float*)((const unsigned char*)sm + SCHED_OFF - 1024) + wr * 128 + fr;
#pragma unroll
      for (int m = 0; m < 8; ++m) {
        const float sc = sct[m * 16];
#pragma unroll
        for (int n = 0; n < 4; ++n) acc[m][n] *= sc;
      }
    }
    gemm_mainloop<256>(acc, [&](int r) { return Ab + (size_t)r * D + 512; }, W + (size_t)nt * 256 * D + 512, D, 8, sm, false);
    {
      float* stf = (float*)sm;
      constexpr int LDF = 260;
#pragma unroll 1
      for (int pass = 0; pass < 2; ++pass) {
        if (wr == pass) {
#pragma unroll
          for (int m = 0; m < 8; ++m)
#pragma unroll
            for (int n = 0; n < 4; ++n) *(f32x4*)(stf + (m * 16 + fr) * LDF + wc * 64 + n * 16 + 4 * fq) = acc[m][n];
        }
        __syncthreads();
#pragma unroll 4
        for (int i = 0; i < 16; ++i) {
          const int idx = i * NTHREADS + tid_e;
          const int r = idx >> 6, c4 = (idx & 63) * 4;
          const int row = mt * 256 + pass * 128 + r, col = nt * 256 + c4;
          const int b = row >> 13;
          const f32x4 a = *(const f32x4*)(stf + r * LDF + c4);
          const float4 g1 = *(const float4*)(mod + (size_t)(l * 2 + b) * 6144 + 2048 + col);
          const float4 xv = *(const float4*)(xin + (size_t)row * D + col);
          float4 o;
          o.x = xv.x + g1.x * a[0]; o.y = xv.y + g1.y * a[1]; o.z = xv.z + g1.z * a[2]; o.w = xv.w + g1.w * a[3];
          *(float4*)(xa + (size_t)row * D + col) = o;
        }
        __syncthreads();
      }
    }
  }
}

__device__ __forceinline__ void phase_router(const Params& p, int l, int* smi) {
  unsigned char* ws = p.ws;
  const int tid = tidx(), lane = tid & 63, wave = tid >> 6;
  const float* mod = (const float*)(ws + OFF_MOD);
  const float* xa = (const float*)(ws + OFF_XA);
  h16* hout = (h16*)(ws + OFF_H16);
  unsigned* cnt = (unsigned*)(ws + OFF_CTL) + 64 + l * 16;
  int* list = (int*)(ws + OFF_LIST);
  float* wpair = (float*)(ws + OFF_WPAIR);
  const float* rgb = p.in[I_RGB] + l * 4;
  int* cntl = smi;
  int* basel = smi + 16;
  int* tok = smi + 32;
  float* wl = (float*)smi + 256;
  {
    const float4* s0 = (const float4*)(p.in[I_RGW] + (size_t)l * 1024 * 4);
    const float4* s1 = (const float4*)(p.in[I_REW] + (size_t)l * 4 * 1024 * 4);
    float4* d = (float4*)wl;
#pragma unroll
    for (int q = 0; q < 2; ++q) d[q * NTHREADS + tid] = s0[q * NTHREADS + tid];
#pragma unroll
    for (int q = 0; q < 8; ++q) d[1024 + q * NTHREADS + tid] = s1[q * NTHREADS + tid];
  }
  const float* rgw = wl;
  for (int chunk = blockIdx.x; chunk < T / 64; chunk += gridDim.x) {
    if (tid < 16) cntl[tid] = 0;
    __syncthreads();
    float4 xn[4];
#pragma unroll
    for (int i = 0; i < 4; ++i) xn[i] = *(const float4*)(xa + (size_t)(chunk * 64 + wave) * D + lane * 4 + 256 * i);
    float4 gsv[4], shv[4];
    {
      const int b = (chunk * 64) >> 13;
#pragma unroll
      for (int i = 0; i < 4; ++i) {
        const int col = lane * 4 + 256 * i;
        const float4 g = *(const float4*)(p.in[I_N2G] + l * D + col);
        const float4 sc = *(const float4*)(mod + (size_t)(l * 2 + b) * 6144 + 4096 + col);
        shv[i] = *(const float4*)(mod + (size_t)(l * 2 + b) * 6144 + 3072 + col);
        gsv[i] = make_float4(g.x * (1.f + sc.x), g.y * (1.f + sc.y), g.z * (1.f + sc.z), g.w * (1.f + sc.w));
      }
    }
    for (int ti = wave; ti < 64; ti += NW) {
      const int row = chunk * 64 + ti;
      float4 x[4];
      float ss = 0.f;
#pragma unroll
      for (int i = 0; i < 4; ++i) x[i] = xn[i];
      if (ti + NW < 64) {
#pragma unroll
        for (int i = 0; i < 4; ++i) xn[i] = *(const float4*)(xa + (size_t)(row + NW) * D + lane * 4 + 256 * i);
      }
#pragma unroll
      for (int i = 0; i < 4; ++i) ss += x[i].x * x[i].x + x[i].y * x[i].y + x[i].z * x[i].z + x[i].w * x[i].w;
      ss = wsum(ss);
      const float rstd = rsqrtf(ss * (1.f / D) + EPS);
      float lg0 = 0.f, lg1 = 0.f, lg2 = 0.f, lg3 = 0.f;
#pragma unroll
      for (int i = 0; i < 4; ++i) {
        const int col = lane * 4 + 256 * i;
        x[i].x = x[i].x * rstd * gsv[i].x + shv[i].x;
        x[i].y = x[i].y * rstd * gsv[i].y + shv[i].y;
        x[i].z = x[i].z * rstd * gsv[i].z + shv[i].z;
        x[i].w = x[i].w * rstd * gsv[i].w + shv[i].w;
        *(h16x4*)(hout + (size_t)row * D + col) = pack4(x[i].x, x[i].y, x[i].z, x[i].w);
        const float4 w0 = *(const float4*)(rgw + (size_t)(col + 0) * 4), w1 = *(const float4*)(rgw + (size_t)(col + 1) * 4);
        const float4 w2 = *(const float4*)(rgw + (size_t)(col + 2) * 4), w3 = *(const float4*)(rgw + (size_t)(col + 3) * 4);
        lg0 += x[i].x * w0.x + x[i].y * w1.x + x[i].z * w2.x + x[i].w * w3.x;
        lg1 += x[i].x * w0.y + x[i].y * w1.y + x[i].z * w2.y + x[i].w * w3.y;
        lg2 += x[i].x * w0.z + x[i].y * w1.z + x[i].z * w2.z + x[i].w * w3.z;
        lg3 += x[i].x * w0.w + x[i].y * w1.w + x[i].z * w2.w + x[i].w * w3.w;
      }
      lg0 = wsum(lg0) + rgb[0]; lg1 = wsum(lg1) + rgb[1]; lg2 = wsum(lg2) + rgb[2]; lg3 = wsum(lg3) + rgb[3];
      int gs = 0; float gm = lg0;
      if (lg1 > gm) { gm = lg1; gs = 1; }
      if (lg2 > gm) { gm = lg2; gs = 2; }
      if (lg3 > gm) { gm = lg3; gs = 3; }
      const float pg = 1.f / (__expf(lg0 - gm) + __expf(lg1 - gm) + __expf(lg2 - gm) + __expf(lg3 - gm));
      const float* rew = wl + 4096 + gs * 4096;
      const float* reb = p.in[I_REB] + (l * 4 + gs) * 4;
      float e0 = 0.f, e1 = 0.f, e2 = 0.f, e3 = 0.f;
#pragma unroll
      for (int i = 0; i < 4; ++i) {
        const int col = lane * 4 + 256 * i;
        const float4 w0 = *(const float4*)(rew + (size_t)(col + 0) * 4), w1 = *(const float4*)(rew + (size_t)(col + 1) * 4);
        const float4 w2 = *(const float4*)(rew + (size_t)(col + 2) * 4), w3 = *(const float4*)(rew + (size_t)(col + 3) * 4);
        e0 += x[i].x * w0.x + x[i].y * w1.x + x[i].z * w2.x + x[i].w * w3.x;
        e1 += x[i].x * w0.y + x[i].y * w1.y + x[i].z * w2.y + x[i].w * w3.y;
        e2 += x[i].x * w0.z + x[i].y * w1.z + x[i].z * w2.z + x[i].w * w3.z;
        e3 += x[i].x * w0.w + x[i].y * w1.w + x[i].z * w2.w + x[i].w * w3.w;
      }
      float le[4];
      le[0] = wsum(e0) + reb[0]; le[1] = wsum(e1) + reb[1]; le[2] = wsum(e2) + reb[2]; le[3] = wsum(e3) + reb[3];
      int i0 = 0; float v0 = le[0];
      if (le[1] > v0) { v0 = le[1]; i0 = 1; }
      if (le[2] > v0) { v0 = le[2]; i0 = 2; }
      if (le[3] > v0) { v0 = le[3]; i0 = 3; }
      int i1 = -1; float v1 = -3.0e38f;
#pragma unroll
      for (int j = 0; j < 4; ++j) {
        const float vj = (j == 0 ? le[0] : j == 1 ? le[1] : j == 2 ? le[2] : le[3]);
        if (j != i0 && vj > v1) { v1 = vj; i1 = j; }
      }
      const float p0 = 1.f / (1.f + __expf(v1 - v0));
      const float p1 = 1.f - p0;
      if (lane == 0) {
        const int ea = gs * 4 + i0, eb = gs * 4 + i1;
        const int ra = atomicAdd(&cntl[ea], 1);
        const int rb = atomicAdd(&cntl[eb], 1);
        tok[ti * 2] = ea | (ra << 8);
        tok[ti * 2 + 1] = eb | (rb << 8);
        wpair[row * 2] = pg * p0;
        wpair[row * 2 + 1] = pg * p1;
      }
    }
    __syncthreads();
    if (tid < 16) basel[tid] = (int)atomicAdd(&cnt[tid], (unsigned)cntl[tid]);
    __syncthreads();
    if (tid < 128) {
      const int v = tok[tid], e = v & 255, r = v >> 8;
      list[(size_t)e * 16384 + basel[e] + r] = (chunk * 64 + (tid >> 1)) * 2 + (tid & 1);
    }
    __syncthreads();
  }
}

__device__ __forceinline__ void moe_sched(const Params& p, int l, int* sl) {
  const int tid = tidx();
  if (tid < 16) {
    const unsigned* cnt = (const unsigned*)(p.ws + OFF_CTL) + 64 + l * 16;
    sl[tid] = (int)__hip_atomic_load(&cnt[tid], __ATOMIC_RELAXED, __HIP_MEMORY_SCOPE_AGENT);
  }
  __syncthreads();
  if (tid == 0) {
    int to = 0, ro = 0;
    sl[16] = 0; sl[33] = 0;
    for (int e = 0; e < 16; ++e) {
      const int c = sl[e];
      to += (c + 255) >> 8; ro += c;
      sl[17 + e] = to; sl[34 + e] = ro;
    }
  }
  __syncthreads();
}
__device__ __forceinline__ void moe_tile(const int* sl, int t, int& e, int& nt, int& mt, int& cnt_e, int& roff_e) {
  int ee = 0;
  for (int k = 0; k < 15; ++k) ee += (t >= sl[17 + k] * 4) ? 1 : 0;
  ee = __builtin_amdgcn_readfirstlane(ee);
  const int t0 = __builtin_amdgcn_readfirstlane(sl[16 + ee]), t1 = __builtin_amdgcn_readfirstlane(sl[17 + ee]);
  const int nte = t1 - t0, rem = t - t0 * 4;
  e = ee; nt = rem / nte; mt = rem % nte;
  cnt_e = __builtin_amdgcn_readfirstlane(sl[ee]);
  roff_e = __builtin_amdgcn_readfirstlane(sl[33 + ee]);
}

template <int BN>
__device__ __forceinline__ void moe1_tile(const Params& p, int l, h16* sm, const int* sl, int t, int half) {
  unsigned char* ws = p.ws;
  const h16* H = (const h16*)(ws + OFF_H16);
  h16* hid = (h16*)(ws + OFF_HID);
  int e, nt, mt, cnt_e, roff_e;
  moe_tile(sl, t, e, nt, mt, cnt_e, roff_e);
  const int* le = (const int*)(ws + OFF_LIST) + (size_t)e * 16384;
  f32x4 acc[8][BN / 64];
  gemm_mainloop<BN>(acc, [&](int r) { int so = mt * 256 + r; so = so < cnt_e ? so : 0; return H + (size_t)(le[so] >> 1) * D; },
                    (const h16*)wgu_buf(p, l) + ((size_t)e * 1024 + nt * 256 + half * 128) * 1024, 1024, 16, sm);
  const int tid_e = tidx(), lane = tid_e & 63, wave = tid_e >> 6, wr = wave >> 2, wc = wave & 3, fr = lane & 15, fq = lane >> 4;
  constexpr int NC = BN / 2, LDR = NC + 8;
#pragma unroll
  for (int m = 0; m < 8; ++m)
#pragma unroll
    for (int n2 = 0; n2 < BN / 128; ++n2) {
      const f32x4 gt = acc[m][2 * n2], up = acc[m][2 * n2 + 1];
      *(h16x4*)(sm + (wr * 128 + m * 16 + fr) * LDR + wc * (BN / 8) + n2 * 16 + 4 * fq) =
          pack4(silu_f(gt[0]) * up[0], silu_f(gt[1]) * up[1], silu_f(gt[2]) * up[2], silu_f(gt[3]) * up[3]);
    }
  __syncthreads();
  constexpr int CH = NC / 8;
#pragma unroll
  for (int i = 0; i < CH / 2; ++i) {
    const int idx = i * NTHREADS + tid_e;
    const int r = idx / CH, c8 = idx % CH;
    const int so = mt * 256 + r;
    if (so < cnt_e) *(h16x8*)(hid + (size_t)(roff_e + so) * 512 + nt * 128 + half * 64 + c8 * 8) = *(const h16x8*)(sm + r * LDR + c8 * 8);
  }
  __syncthreads();
}
__device__ __forceinline__ void phase_moe1(const Params& p, int l, h16* sm) {
  int* sl = (int*)((unsigned char*)sm + SCHED_OFF);
  moe_sched(p, l, sl);
  const int total = __builtin_amdgcn_readfirstlane(sl[32]) * 4;
  const TileSched ts = xcd_sched(total);
  for (int t = ts.cur; t < ts.end; t += ts.step) moe1_tile<256>(p, l, sm, sl, t, 0);
  if (ts.tail_tile >= 0) {
    if (ts.tail_half < 0) moe1_tile<256>(p, l, sm, sl, ts.tail_tile, 0);
    else moe1_tile<128>(p, l, sm, sl, ts.tail_tile, ts.tail_half);
  }
  if (l == 0) conv_share(p, 1, 0, NT_CONV / 2, 0, ts.nbusy, (float*)sm);
}

template <int BN>
__device__ __forceinline__ void moe2_tile(const Params& p, int l, h16* sm, const int* sl, int t, int half) {
  unsigned char* ws = p.ws;
  const float* wpair = (const float*)(ws + OFF_WPAIR);
  h16* yp = (h16*)(ws + OFF_YPAIR);
  int e, nt, mt, cnt_e, roff_e;
  moe_tile(sl, t, e, nt, mt, cnt_e, roff_e);
  const int* le = (const int*)(ws + OFF_LIST) + (size_t)e * 16384;
  const h16* Ab = (const h16*)(ws + OFF_HID) + (size_t)(roff_e + mt * 256) * 512;
  f32x4 acc[8][BN / 64];
  gemm_mainloop<BN>(acc, [&](int r) { return Ab + (size_t)r * 512; }, (const h16*)wdn_buf(p, l) + ((size_t)e * 1024 + nt * 256 + half * 128) * 512, 512, 8, sm);
  const int tid_e = tidx(), lane = tid_e & 63, wave = tid_e >> 6, wr = wave >> 2, wc = wave & 3, fr = lane & 15, fq = lane >> 4;
  constexpr int LDR = BN + 8;
#pragma unroll
  for (int m = 0; m < 8; ++m) {
    const int so = mt * 256 + wr * 128 + m * 16 + fr;
    const float w = so < cnt_e ? wpair[le[so]] : 0.f;
#pragma unroll
    for (int n = 0; n < BN / 64; ++n)
      *(h16x4*)(sm + (wr * 128 + m * 16 + fr) * LDR + wc * (BN / 4) + n * 16 + 4 * fq) = pack4(acc[m][n][0] * w, acc[m][n][1] * w, acc[m][n][2] * w, acc[m][n][3] * w);
  }
  __syncthreads();
  constexpr int CH = BN / 8;
#pragma unroll
  for (int i = 0; i < CH / 2; ++i) {
    const int idx = i * NTHREADS + tid_e;
    const int r = idx / CH, c8 = idx % CH;
    const int so = mt * 256 + r;
    if (so < cnt_e) *(h16x8*)(yp + (size_t)le[so] * D + nt * 256 + half * 128 + c8 * 8) = *(const h16x8*)(sm + r * LDR + c8 * 8);
  }
  __syncthreads();
}
__device__ __forceinline__ void phase_moe2(const Params& p, int l, h16* sm) {
  int* sl = (int*)((unsigned char*)sm + SCHED_OFF);
  moe_sched(p, l, sl);
  const int total = __builtin_amdgcn_readfirstlane(sl[32]) * 4;
  const TileSched ts = xcd_sched(total);
  for (int t = ts.cur; t < ts.end; t += ts.step) moe2_tile<256>(p, l, sm, sl, t, 0);
  if (ts.tail_tile >= 0) {
    if (ts.tail_half < 0) moe2_tile<256>(p, l, sm, sl, ts.tail_tile, 0);
    else moe2_tile<128>(p, l, sm, sl, ts.tail_tile, ts.tail_half);
  }
  if (l == 0) conv_share(p, 1, NT_CONV / 2, NT_CONV, 0, ts.nbusy, (float*)sm);
}

#define XB_TMO      128
#define XB_XCNT(j)  (256  + 64 * (j))
#define XB_XSUB(j)  (1280 + 64 * (j))
#define XB_XGEN(j)  (2304 + 64 * (j))
#define XB_TOP      3328
#define XB_TOPGEN   3392
#define XCD_BAR_WORDS 3456
#define XB_SPIN_CAP (1u << 20)
__device__ __forceinline__ unsigned xb_ld(unsigned* p) { return __hip_atomic_load(p, __ATOMIC_RELAXED, __HIP_MEMORY_SCOPE_AGENT); }
__device__ __forceinline__ unsigned xb_add(unsigned* p, unsigned v) { return __hip_atomic_fetch_add(p, v, __ATOMIC_RELAXED, __HIP_MEMORY_SCOPE_AGENT); }
__device__ __forceinline__ unsigned xb_xcc_id() { return (unsigned)__builtin_amdgcn_s_getreg((3 << 11) | 20) & 0xFu; }
#define XB_SPIN(cond, bar) do { unsigned _sp = 0; while (cond) { __builtin_amdgcn_s_sleep(1); \
    if ((++_sp & 255u) == 0u) { if (xb_ld(&(bar)[XB_TMO])) break; if (_sp > XB_SPIN_CAP) { atomicAdd(&(bar)[XB_TMO], 1u); break; } } } } while (0)
struct XBar { unsigned* bar; unsigned x; volatile unsigned* st; };
__device__ __forceinline__ void xbar_post(XBar& b, unsigned* bar, volatile unsigned* st) {
  b.bar = bar; b.x = xb_xcc_id(); b.st = st;
  if (tidx() == 0) { st[0] = 0u; st[1] = 0u; (void)xb_add(&bar[XB_XCNT(b.x)], 1u); }
}
__device__ __forceinline__ void xbar_census(unsigned* bar, unsigned x, unsigned& nloc, unsigned& nx) {
  const unsigned G = gridDim.x;
  unsigned sum, cnt, mine, sp = 0u;
  for (;;) {
    sum = 0u; cnt = 0u; mine = 0u;
#pragma unroll
    for (unsigned j = 0; j < 16; ++j) { const unsigned c = xb_ld(&bar[XB_XCNT(j)]); sum += c; cnt += (c > 0u) ? 1u : 0u; mine = (j == x) ? c : mine; }
    if (sum == G) break;
    __builtin_amdgcn_s_sleep(1);
    if ((++sp & 255u) == 0u) { if (xb_ld(&bar[XB_TMO])) break; if (sp > XB_SPIN_CAP) { atomicAdd(&bar[XB_TMO], 1u); break; } }
  }
  nloc = mine > 0u ? mine : 1u; nx = cnt > 0u ? cnt : 1u;
}
__device__ __forceinline__ void xbar_sync(XBar& b) {
  asm volatile("s_waitcnt vmcnt(0)" ::: "memory");
  __syncthreads();
  if (tidx() == 0) {
    unsigned* bar = b.bar;
    __builtin_amdgcn_s_waitcnt(0);
    unsigned nloc = b.st[0], nx = b.st[1];
    if (nloc == 0u) { xbar_census(bar, b.x, nloc, nx); b.st[0] = nloc; b.st[1] = nx; }
    const unsigned old = xb_add(&bar[XB_XSUB(b.x)], 1u);
    const unsigned gen = old / nloc;
    if (old + 1u == (gen + 1u) * nloc) {
      __builtin_amdgcn_fence(__ATOMIC_RELEASE, "agent");
      asm volatile("s_waitcnt vmcnt(0)" ::: "memory");
      const unsigned og = xb_add(&bar[XB_TOP], 1u);
      const unsigned tg = og / nx;
      if (og + 1u == (tg + 1u) * nx) xb_add(&bar[XB_TOPGEN], 1u);
      else XB_SPIN(xb_ld(&bar[XB_TOPGEN]) == tg, bar);
      __builtin_amdgcn_fence(__ATOMIC_ACQUIRE, "agent");
      xb_add(&bar[XB_XGEN(b.x)], 1u);
      asm volatile("s_waitcnt vmcnt(0)" ::: "memory");
    } else {
      XB_SPIN(xb_ld(&bar[XB_XGEN(b.x)]) == gen, bar);
      __builtin_amdgcn_fence(__ATOMIC_ACQUIRE, "agent");
      asm volatile("s_waitcnt vmcnt(0)" ::: "memory");
    }
  }
  __syncthreads();
}

constexpr int NSTEPS = 20;
#define STEP(k, body) do { if (s_lo <= (k) && (k) < s_hi) { body; if ((k) + 1 < s_hi) { xbar_sync(xb); } \
    if (PROBE_MASK != 0u) { unsigned long long now_ = __builtin_amdgcn_s_memrealtime(); \
      if ((PROBE_MASK >> (k)) & 1u) { const unsigned long long w_ = (now_ - pt_prev) * PROBE_AMP; \
        while (__builtin_amdgcn_s_memrealtime() - now_ < w_) __builtin_amdgcn_s_sleep(8); now_ = __builtin_amdgcn_s_memrealtime(); } \
      pt_prev = now_; } } } while (0)
#define LAYER_STEPS(l, base) \
  STEP(base + 0, phase_norm1(p, l, (float*)smem); if (l == 1) phase_convert_misc(p, 1)); \
  STEP(base + 1, phase_inproj(p, l, (h16*)smem)); \
  STEP(base + 2, phase_mixa(p, l, smem)); \
  STEP(base + 3, phase_mixb(p, l, (float*)smem)); \
  STEP(base + 4, phase_attn(p, l, (float*)smem)); \
  STEP(base + 5, phase_outproj(p, l, (h16*)smem)); \
  STEP(base + 6, phase_router(p, l, (int*)smem)); \
  STEP(base + 7, phase_moe1(p, l, (h16*)smem)); \
  STEP(base + 8, phase_moe2(p, l, (h16*)smem))

__global__ void __launch_bounds__(NTHREADS, 2) mega(Params p, int s_lo, int s_hi) {
  extern __shared__ __attribute__((aligned(16))) unsigned char smem[];
  unsigned long long pt_prev = PROBE_MASK != 0u ? __builtin_amdgcn_s_memrealtime() : 0ull;
  XBar xb;
  xbar_post(xb, (unsigned*)(p.ws + OFF_BAR), (volatile unsigned*)(smem + LDS_BYTES - 16));
  STEP(0, phase_prep(p, (float*)smem); phase_convert_tiles(p, 0, (float*)smem); phase_convert_misc(p, 0));
  LAYER_STEPS(0, 1);
  LAYER_STEPS(1, 10);
  STEP(19, phase_norm1(p, 2, (float*)smem));
}

extern "C" void kernel_launch(void* const* d_in, const int* in_sizes, int n_in, void* d_out, int out_size, void* d_ws, size_t ws_size,
                              hipStream_t stream) {
  static int grid_blocks = 0;
  if (!grid_blocks) {
    if (n_in != 35 || out_size != T * D || ws_size < WS_TOTAL) {
      fprintf(stderr, "kernel_launch: unexpected problem (n_in %d, out %d, ws %zu < %zu)\n", n_in, out_size, ws_size, (size_t)WS_TOTAL);
      grid_blocks = -1;
      return;
    }
    int dev = 0, cus = 0, per_cu = 0;
    hipGetDevice(&dev);
    hipDeviceGetAttribute(&cus, hipDeviceAttributeMultiprocessorCount, dev);
    if (hipFuncSetAttribute((const void*)mega, hipFuncAttributeMaxDynamicSharedMemorySize, LDS_BYTES) != hipSuccess) {
      fprintf(stderr, "kernel_launch: hipFuncSetAttribute(%d B dynamic LDS) failed\n", LDS_BYTES);
      grid_blocks = -1;
      return;
    }
    hipOccupancyMaxActiveBlocksPerMultiprocessor(&per_cu, mega, NTHREADS, LDS_BYTES);
    if (per_cu > 1) per_cu = 1;
    if (per_cu < 1) { fprintf(stderr, "kernel_launch: occupancy query returned %d\n", per_cu); grid_blocks = -1; return; }
    grid_blocks = cus * per_cu;
  }
  if (grid_blocks < 0) return;
  Params p{};
  for (int i = 0; i < 35; ++i) p.in[i] = (const float*)d_in[i];
  p.out = (float*)d_out;
  p.ws = (unsigned char*)d_ws;
  for (int i = 0; i < 32; ++i) p.inv_freq[i] = std::pow(10000.0, -(double)(2 * i) / 64.0);
  if (hipMemsetAsync((char*)d_ws + OFF_BAR, 0, 16384, stream) != hipSuccess) { fprintf(stderr, "kernel_launch: memset of barrier words failed\n"); return; }
#if MEGA
  int lo = 0, hi = NSTEPS;
  void* args[] = {&p, &lo, &hi};
  hipError_t e = hipLaunchCooperativeKernel((void*)mega, dim3(grid_blocks), dim3(NTHREADS), args, LDS_BYTES, stream);
  if (e != hipSuccess) fprintf(stderr, "cooperative launch failed: %s (grid %d)\n", hipGetErrorString(e), grid_blocks);
#else
  for (int s = 0; s < NSTEPS; ++s) {
    int lo = s, hi = s + 1;
    void* args[] = {&p, &lo, &hi};
    hipError_t e = hipLaunchCooperativeKernel((void*)mega, dim3(grid_blocks), dim3(NTHREADS), args, LDS_BYTES, stream);
    if (e != hipSuccess) { fprintf(stderr, "launch %d failed: %s (grid %d)\n", s, hipGetErrorString(e), grid_blocks); break; }
  }
#endif
}
```

```cpp
#include <hip/hip_runtime.h>
#include <hip/hip_cooperative_groups.h>
#include <cstdio>
#include <cstdint>
#include <cmath>
namespace cg = cooperative_groups;

#ifndef MEGA
#define MEGA 1
#endif
#ifndef PROBE_MASK
#define PROBE_MASK 0u
#define PROBE_AMP 3
#endif

typedef _Float16 h16;
typedef _Float16 h16x8 __attribute__((ext_vector_type(8)));
typedef _Float16 h16x4 __attribute__((ext_vector_type(4)));
typedef float f32x4 __attribute__((ext_vector_type(4)));

constexpr int NB = 2, S = 8192, T = NB * S, D = 1024;
constexpr int NIN = 2432;
constexpr int NINSRC = 2328;
constexpr int C_XL = 0, C_GL = 256, C_Q = 512, C_KC = 1024, C_VC = 1152, C_KS = 1280, C_VS = 1408, C_KW = 1536, C_VW = 1664,
              C_CVA = 1792, C_CVB = 2048, C_GATE = 2304;
constexpr float EPS = 1e-6f;
constexpr int NTHREADS = 512, NW = 8;
constexpr int LDS_BYTES = 150528;
constexpr int NINP = 2560;
constexpr int SCHED_OFF = LDS_BYTES - 1024;
constexpr float ASCALE = 16.f;

constexpr size_t al256(size_t x) { return (x + 255) & ~(size_t)255; }
constexpr size_t OFF_CTL = 0;
constexpr size_t OFF_BAR = 4096;
constexpr size_t OFF_MOD = 4096 + 16384;
constexpr size_t OFF_ROPE = al256(OFF_MOD + 2 * 2 * 6144 * 4);
constexpr size_t OFF_PB = al256(OFF_ROPE + (size_t)T * 64 * 4);
constexpr size_t OFF_PBPART = al256(OFF_PB + 2 * 256 * 4);
constexpr size_t OFF_LRUW = al256(OFF_PBPART + 2 * 32 * 256 * 4);
constexpr size_t OFF_GATES = al256(OFF_LRUW + 2 * 4 * 64 * 64 * 2);
constexpr size_t OFF_WIN = al256(OFF_GATES + (size_t)T * 24 * 4);
constexpr size_t OFF_WOUT = al256(OFF_WIN + (size_t)NINP * 1024 * 2);
constexpr size_t OFF_WGU = al256(OFF_WOUT + (size_t)1024 * 1024 * 2);
constexpr size_t OFF_WDN = al256(OFF_WGU + (size_t)16 * 1024 * 1024 * 2);
constexpr size_t OFF_W1K = al256(OFF_WDN + (size_t)16 * 1024 * 512 * 2);
constexpr size_t OFF_W1V = al256(OFF_W1K + (size_t)256 * 2048 * 2);
constexpr size_t OFF_H16 = al256(OFF_W1V + (size_t)256 * 2048 * 2);
constexpr size_t OFF_Q16 = al256(OFF_H16 + (size_t)T * 1024 * 2);
constexpr size_t KVSZ = (size_t)T * 128 * 2;
constexpr size_t OFF_KC = al256(OFF_Q16 + (size_t)T * 512 * 2);
constexpr size_t OFF_VC = al256(OFF_KC + KVSZ + 4096);
constexpr size_t OFF_KS = al256(OFF_VC + KVSZ + 4096);
constexpr size_t OFF_VST = al256(OFF_KS + KVSZ);
constexpr size_t OFF_KW = al256(OFF_VST + KVSZ);
constexpr size_t OFF_VWT = al256(OFF_KW + KVSZ);
constexpr size_t OFF_HIDC = al256(OFF_VWT + KVSZ);
constexpr size_t OFF_KCMP = al256(OFF_HIDC + (size_t)2 * 2048 * 256 * 2);
constexpr size_t OFF_VCMPT = al256(OFF_KCMP + (size_t)4 * 512 * 64 * 2);
constexpr size_t OFF_LRUH = al256(OFF_VCMPT + (size_t)4 * 512 * 64 * 2);
constexpr size_t OFF_LRUA = al256(OFF_LRUH + (size_t)T * 256 * 4);
constexpr size_t OFF_Y16 = OFF_LRUH;
constexpr size_t OFF_HEND = al256(OFF_LRUA + (size_t)T * 256 * 4);
constexpr size_t OFF_AEND = al256(OFF_HEND + 2 * 256 * 256 * 4);
constexpr size_t OFF_CARRY = al256(OFF_AEND + 2 * 256 * 256 * 4);
constexpr size_t OFF_XA = al256(OFF_CARRY + 2 * 256 * 256 * 4);
constexpr size_t OFF_LIST = al256(OFF_XA + (size_t)T * 1024 * 4);
constexpr size_t OFF_WPAIR = al256(OFF_LIST + (size_t)16 * 16384 * 4);
constexpr size_t OFF_SSQ = al256(OFF_WPAIR + 32768 * 4);
constexpr size_t OFF_R = al256(OFF_SSQ + (size_t)T * 2 * 4);
constexpr size_t OFF_P16 = OFF_R;
constexpr size_t OFF_HID = OFF_R;
constexpr size_t OFF_YPAIR = al256(OFF_HID + (size_t)(32768 + 512) * 512 * 2);
constexpr size_t OFF_HIDP = al256(OFF_P16 + (size_t)T * NIN * 2);
constexpr size_t OFF_MODP = OFF_HIDP;
constexpr size_t R_END1 = OFF_HIDP + (size_t)4 * 2 * 2048 * 256 * 4;
constexpr size_t R_END2 = OFF_YPAIR + (size_t)32768 * 1024 * 2;
constexpr size_t WS_TOTAL = al256(R_END1 > R_END2 ? R_END1 : R_END2);

struct Params {
  const float* in[35];
  float* out;
  unsigned char* ws;
  double inv_freq[32];
};
enum { I_X = 0, I_C, I_POS, I_ADAW, I_ADAB, I_N1G, I_N2G, I_WIN, I_LCW, I_LCB, I_LWA, I_LBA, I_LWX, I_LBX, I_LLAM, I_CKW1, I_CKW2,
       I_CVW1, I_CVW2, I_CPK, I_CPV, I_DWW, I_DWB, I_LNG, I_LNB, I_ONG, I_WOUT, I_RGW, I_RGB, I_REW, I_REB, I_MG, I_MU, I_MD, I_FNG };

__device__ __forceinline__ int tidx() { int t = threadIdx.x; asm volatile("" : "+v"(t)); return t; }
template <int CTRL> __device__ __forceinline__ float dppf(float v) {
  return __builtin_bit_cast(float, __builtin_amdgcn_update_dpp(0, __builtin_bit_cast(int, v), CTRL, 0xF, 0xF, true));
}
__device__ __forceinline__ float wsum(float v) {
  v += dppf<0xB1>(v);
  v += dppf<0x4E>(v);
  v += dppf<0x141>(v);
  v += dppf<0x140>(v);
  v += dppf<0x142>(v);
  v += dppf<0x143>(v);
  return __builtin_bit_cast(float, __builtin_amdgcn_readlane(__builtin_bit_cast(int, v), 63));
}
__device__ __forceinline__ float sigm(float x) { return __builtin_amdgcn_rcpf(1.f + __expf(-x)); }
__device__ __forceinline__ float silu_f(float x) { return x * __builtin_amdgcn_rcpf(1.f + __expf(-x)); }
__device__ __forceinline__ float gelu_tanh(float x) {
  float u = 0.7978845608028654f * (x + 0.044715f * x * x * x);
  float e = __expf(2.f * u);
  float t = 1.f - 2.f * __builtin_amdgcn_rcpf(e + 1.f);
  return 0.5f * x * (1.f + t);
}
__device__ __forceinline__ void glds16(const h16* g, h16* l) {
  __builtin_amdgcn_global_load_lds((const unsigned*)g, (unsigned*)l, 16, 0, 0);
}
__device__ __forceinline__ float4 ldx4(const void* base, bool half, size_t idx) {
  if (half) { const h16x4 v = *(const h16x4*)((const h16*)base + idx); return make_float4((float)v[0], (float)v[1], (float)v[2], (float)v[3]); }
  return *(const float4*)((const float*)base + idx);
}
__device__ __forceinline__ h16x4 pack4(float a, float b, float c, float d) {
  h16x4 r; r[0] = (h16)a; r[1] = (h16)b; r[2] = (h16)c; r[3] = (h16)d; return r;
}

struct TileIter { int cur, end, step; };
__device__ __forceinline__ TileIter xcd_tiles(int ntiles) {
  const int G = gridDim.x, b = blockIdx.x;
  TileIter it;
  if ((G & 7) == 0) {
    const int x = b & 7;
    it.cur = (int)(((long)ntiles * x) >> 3) + (b >> 3);
    it.end = (int)(((long)ntiles * (x + 1)) >> 3);
    it.step = G >> 3;
  } else { it.cur = b; it.end = ntiles; it.step = G; }
  return it;
}

#define VMCNT(n) asm volatile("s_waitcnt vmcnt(" #n ")" ::: "memory")
template <int BN, class ARowFn>
__device__ __forceinline__ void gemm_mainloop(f32x4 (&acc)[8][BN / 64], ARowFn arow, const h16* __restrict__ Bt, int ldb, int nk, h16* sm, bool zero_init = true) {
  constexpr int NF = BN / 64, NBP = BN / 64;
  constexpr int STAGE = 16384 + BN * 64;
  constexpr int NST = BN == 128 ? 3 : 2;
  const int tid = tidx(), lane = tid & 63, wave = tid >> 6;
  const int wr = wave >> 2, wc = wave & 3, fr = lane & 15, fq = lane >> 4;
  const h16* ap[4];
  const h16* bp[NBP];
#pragma unroll
  for (int i = 0; i < 4; ++i) {
    const int r = (i * 8 + wave) * 8 + (lane >> 3);
    const int c = (lane & 7) ^ ((r >> 1) & 7);
    ap[i] = arow(r) + c * 8;
    if (i < NBP) bp[i] = Bt + (size_t)r * ldb + c * 8;
  }
  if (zero_init) {
#pragma unroll
    for (int m = 0; m < 8; ++m)
#pragma unroll
      for (int n = 0; n < NF; ++n) acc[m][n] = (f32x4){0.f, 0.f, 0.f, 0.f};
  }
  h16* const dA = sm + wave * 512 + lane * 8;
#pragma unroll
  for (int st0 = 0; st0 < NST - 1; ++st0)
    if (st0 < nk) {
#pragma unroll
      for (int i = 0; i < 4; ++i) { glds16(ap[i], dA + st0 * STAGE + i * 4096); ap[i] += 64; }
#pragma unroll
      for (int i = 0; i < NBP; ++i) { glds16(bp[i], dA + st0 * STAGE + 16384 + i * 4096); bp[i] += 64; }
    }
  const int sw = (fr >> 1) & 7;
  const int aoff = (wr * 128 + fr) * 64, boff = 16384 + (wc * (BN / 4) + fr) * 64;
#define SCHED_FENCE() __builtin_amdgcn_sched_barrier(0)
  for (int kt = 0; kt < nk; ++kt) {
    if (NST == 3 && kt + 1 < nk) VMCNT(6); else VMCNT(0);
    __builtin_amdgcn_s_barrier();
    const int sl_ = NST == 3 ? kt % 3 : (kt & 1);
    const h16* st = sm + sl_ * STAGE;
    const bool more = kt + (NST - 1) < nk;
    h16* const dn = dA + (NST == 3 ? (sl_ == 0 ? 2 : sl_ - 1) : (sl_ ^ 1)) * STAGE;
#pragma unroll
    for (int ks = 0; ks < 2; ++ks) {
      const int ch = ((ks * 4 + fq) ^ sw) * 8;
      h16x8 bf[NF];
#pragma unroll
      for (int n = 0; n < NF; ++n) bf[n] = *(const h16x8*)(st + boff + n * 1024 + ch);
#pragma unroll
      for (int mh = 0; mh < 2; ++mh) {
        h16x8 af[4];
#pragma unroll
        for (int m = 0; m < 4; ++m) af[m] = *(const h16x8*)(st + aoff + (mh * 4 + m) * 1024 + ch);
#pragma unroll
        for (int m = 0; m < 4; ++m) {
#pragma unroll
          for (int n = 0; n < NF; ++n) acc[mh * 4 + m][n] = __builtin_amdgcn_mfma_f32_16x16x32_f16(bf[n], af[m], acc[mh * 4 + m][n], 0, 0, 0);
          if (m == 1 || m == 3) {
            const int q = ks * 4 + mh * 2 + (m >> 1);
            SCHED_FENCE();
            if (more) {
              if (q < 4) { glds16(ap[q & 3], dn + (q & 3) * 4096); ap[q & 3] += 64; }
              else if ((q & 3) < NBP) { glds16(bp[(q & 3) < NBP ? (q & 3) : 0], dn + 16384 + (q & 3) * 4096); bp[(q & 3) < NBP ? (q & 3) : 0] += 64; }
            }
            SCHED_FENCE();
          }
        }
      }
    }
  }
#undef SCHED_FENCE
  __builtin_amdgcn_s_barrier();
}

__device__ __forceinline__ int g8_lds_byte(int r, int c) {
  const int st = (r >> 4) * 2 + (c >> 5), rr = r & 15, cc = c & 31, ob = rr * 64 + cc * 2;
  return st * 1024 + (ob ^ (((ob >> 9) & 1) << 5));
}
__device__ __forceinline__ void g8_stage_rc(int b, int& R, int& C) {
  const int st = b / 1024, sb = b % 1024, swz = sb ^ (((sb >> 9) & 1) << 5);
  R = (st >> 1) * 16 + swz / 64; C = (st & 1) * 32 + (swz % 64) / 2;
}
struct G8NoMid { __device__ __forceinline__ void operator()() const {} };
template <bool ZERO = true, class AOffFn, class MidFn = G8NoMid>
__device__ __forceinline__ void gemm8_mainloop(f32x4 (&acc)[2][2][4][2], const h16* __restrict__ Ag, AOffFn aoff, const h16* __restrict__ Bt, int ldb, int nt, h16* shm,
                                               int tmid = -1, MidFn mid = MidFn()) {
  constexpr int HT = 128 * 64;
  const int tid = tidx(), lane = tid & 63, wid = tid >> 6, wr = wid >> 2, wc = wid & 3, fr = lane & 15, fq = lane >> 4;
  int offa[2][2], offb[2];
#pragma unroll
  for (int i = 0; i < 2; ++i) {
    int r_, c_;
    g8_stage_rc(tid * 16 + i * 8192, r_, c_);
    offa[0][i] = aoff(r_) + c_;
    offa[1][i] = aoff(128 + r_) + c_;
    offb[i] = r_ * ldb + c_;
  }
#define G8_SA(b, h) (shm + ((b) * 2 + (h)) * HT)
#define G8_SB(b, h) (shm + (4 + (b) * 2 + (h)) * HT)
#define G8_STAGE_A(P, hh, kt) do { _Pragma("unroll") for (int i_ = 0; i_ < 2; ++i_) \
    __builtin_amdgcn_global_load_lds((const unsigned*)(Ag + (kt) * 64 + offa[hh][i_]), (unsigned*)((char*)(P) + tid * 16 + i_ * 8192), 16, 0, 0); } while (0)
#define G8_STAGE_B(P, hh, kt) do { _Pragma("unroll") for (int i_ = 0; i_ < 2; ++i_) \
    __builtin_amdgcn_global_load_lds((const unsigned*)(Bt + (hh) * 128 * ldb + (kt) * 64 + offb[i_]), (unsigned*)((char*)(P) + tid * 16 + i_ * 8192), 16, 0, 0); } while (0)
  int lterm = fr * 64 + fq * 16;
  lterm ^= ((lterm >> 9) & 1) << 5;
  const char* const abase = (const char*)shm + wr * 8192 + lterm;
  const char* const bbase = (const char*)shm + 4 * HT * 2 + wc * 4096 + lterm;
#define G8_LDA(dst, b, h) do { _Pragma("unroll") for (int m_ = 0; m_ < 4; ++m_) _Pragma("unroll") for (int k_ = 0; k_ < 2; ++k_) \
    dst[m_][k_] = *reinterpret_cast<const h16x8*>(abase + ((b) * 2 + (h)) * HT * 2 + m_ * 2048 + k_ * 1024); } while (0)
#define G8_LDB(dst, b, h) do { _Pragma("unroll") for (int n_ = 0; n_ < 2; ++n_) _Pragma("unroll") for (int k_ = 0; k_ < 2; ++k_) \
    dst[n_][k_] = *reinterpret_cast<const h16x8*>(bbase + ((b) * 2 + (h)) * HT * 2 + n_ * 2048 + k_ * 1024); } while (0)
#define G8_MMA(ai, bj, A_, B_) do { __builtin_amdgcn_s_setprio(1); \
    _Pragma("unroll") for (int m_ = 0; m_ < 4; ++m_) _Pragma("unroll") for (int n_ = 0; n_ < 2; ++n_) _Pragma("unroll") for (int k_ = 0; k_ < 2; ++k_) \
      acc[ai][bj][m_][n_] = __builtin_amdgcn_mfma_f32_16x16x32_f16(B_[n_][k_], A_[m_][k_], acc[ai][bj][m_][n_], 0, 0, 0); \
    __builtin_amdgcn_s_setprio(0); } while (0)
#define G8_WV(n) asm volatile("s_waitcnt vmcnt(" #n ")" ::: "memory")
#define G8_WL(n) asm volatile("s_waitcnt lgkmcnt(" #n ")" ::: "memory")
#define G8_BAR __builtin_amdgcn_s_barrier()
#define G8_SCHED __builtin_amdgcn_sched_barrier(0)
  if (ZERO) {
#pragma unroll
    for (int a_ = 0; a_ < 2; ++a_)
#pragma unroll
      for (int b_ = 0; b_ < 2; ++b_)
#pragma unroll
        for (int m_ = 0; m_ < 4; ++m_)
#pragma unroll
          for (int n_ = 0; n_ < 2; ++n_) acc[a_][b_][m_][n_] = (f32x4){0.f, 0.f, 0.f, 0.f};
  }
  h16x8 At[4][2], B0[2][2], B1[2][2];
  G8_STAGE_B(G8_SB(0, 0), 0, 0); G8_STAGE_A(G8_SA(0, 0), 0, 0);
  G8_STAGE_B(G8_SB(0, 1), 1, 0); G8_STAGE_A(G8_SA(0, 1), 1, 0);
  if (wr == 1) G8_BAR;
  G8_WV(4); G8_BAR;
  G8_STAGE_B(G8_SB(1, 0), 0, 1); G8_STAGE_A(G8_SA(1, 0), 0, 1); G8_STAGE_B(G8_SB(1, 1), 1, 1);
  G8_WV(6); G8_BAR;
  for (int t = 0; t < nt - 2; t += 2) {
    if (t == tmid) mid();
    G8_LDB(B0, 0, 0); G8_SCHED; G8_LDA(At, 0, 0); G8_STAGE_A(G8_SA(1, 1), 1, t + 1);
    G8_WL(8); G8_BAR; G8_WL(0); G8_MMA(0, 0, At, B0); G8_BAR; G8_SCHED;
    G8_LDB(B1, 0, 1); G8_STAGE_B(G8_SB(0, 0), 0, t + 2);
    G8_BAR; G8_WL(0); G8_MMA(0, 1, At, B1); G8_BAR;
    G8_LDA(At, 0, 1); G8_STAGE_A(G8_SA(0, 0), 0, t + 2);
    G8_BAR; G8_WL(0); G8_MMA(1, 0, At, B0); G8_BAR; G8_SCHED;
    G8_STAGE_B(G8_SB(0, 1), 1, t + 2);
    G8_WV(6); G8_BAR; G8_MMA(1, 1, At, B1); G8_BAR;
    G8_LDB(B0, 1, 0); G8_SCHED; G8_LDA(At, 1, 0); G8_STAGE_A(G8_SA(0, 1), 1, t + 2);
    G8_WL(8); G8_BAR; G8_WL(0); G8_MMA(0, 0, At, B0); G8_BAR; G8_SCHED;
    G8_LDB(B1, 1, 1); G8_STAGE_B(G8_SB(1, 0), 0, t + 3);
    G8_BAR; G8_WL(0); G8_MMA(0, 1, At, B1); G8_BAR;
    G8_LDA(At, 1, 1); G8_STAGE_A(G8_SA(1, 0), 0, t + 3);
    G8_BAR; G8_WL(0); G8_MMA(1, 0, At, B0); G8_BAR; G8_SCHED;
    G8_STAGE_B(G8_SB(1, 1), 1, t + 3);
    G8_WV(6); G8_BAR; G8_MMA(1, 1, At, B1); G8_BAR;
  }
  { G8_LDB(B0, 0, 0); G8_LDA(At, 0, 0); G8_STAGE_A(G8_SA(1, 1), 1, nt - 1);
    G8_BAR; G8_WL(0); G8_MMA(0, 0, At, B0); G8_BAR;
    G8_LDB(B1, 0, 1); G8_BAR; G8_WL(0); G8_MMA(0, 1, At, B1); G8_BAR;
    G8_LDA(At, 0, 1); G8_WV(4); G8_BAR; G8_WL(0); G8_MMA(1, 0, At, B0); G8_MMA(1, 1, At, B1); G8_BAR; }
  { G8_LDB(B0, 1, 0); G8_LDA(At, 1, 0); G8_WV(2); G8_BAR; G8_WL(0); G8_MMA(0, 0, At, B0); G8_BAR;
    G8_LDB(B1, 1, 1); G8_WV(0); G8_BAR; G8_WL(0); G8_MMA(0, 1, At, B1); G8_BAR;
    G8_LDA(At, 1, 1); G8_BAR; G8_WL(0); G8_MMA(1, 0, At, B0); G8_MMA(1, 1, At, B1); G8_BAR; }
  if (wr == 0) G8_BAR;
  __syncthreads();
}

struct TileSched { int cur, end, step, tail_tile, tail_half, nbusy; };
__device__ __forceinline__ TileSched xcd_sched(int ntiles) {
  const int G = gridDim.x, b = blockIdx.x;
  TileSched s;
  s.tail_tile = -1; s.tail_half = -1; s.nbusy = 0;
  if ((G & 7) == 0) {
    const int x = b & 7, nb = G >> 3, si = b >> 3;
    const int lo = (int)(((long)ntiles * x) >> 3), hi = (int)(((long)ntiles * (x + 1)) >> 3);
    const int n = hi - lo, R = n / nb, rem = n - R * nb;
    s.cur = lo + si; s.end = lo + R * nb; s.step = nb;
    if (rem * 2 <= nb) { s.nbusy = 2 * rem; if (si < 2 * rem) { s.tail_tile = lo + R * nb + (si >> 1); s.tail_half = si & 1; } }
    else { s.nbusy = rem; if (si < rem) s.tail_tile = lo + R * nb + si; }
  } else { s.cur = b; s.end = ntiles; s.step = G; }
  return s;
}

__device__ __forceinline__ h16* wgu_buf(const Params& p, int l) { return l ? (h16*)p.out : (h16*)(p.ws + OFF_WGU); }
__device__ __forceinline__ h16* wdn_buf(const Params& p, int l) { return l ? (h16*)p.out + (size_t)16 * 1024 * 1024 : (h16*)(p.ws + OFF_WDN); }
constexpr int NT_CONV = 16 * 37 + 256 + 3 * 16 * 128 + 2 * 128;
__device__ __forceinline__ int map_row(int mode, int n) {
  if (mode == 1) return n < 1792 ? n : (n < 1816 ? n + 512 : n - 24);
  if (mode == 2) return 32 * (n >> 4) + (n & 15);
  if (mode == 3) return 32 * (n >> 4) + 16 + (n & 15);
  return n;
}
struct ConvTile { const float* src; h16* dst; int K, N, mode, k0, n0; const float* pos; float* pbp; };
__device__ __forceinline__ ConvTile conv_decode(const Params& p, int l, int t) {
  unsigned char* ws = p.ws;
  constexpr int T_WIN = 16 * 37, T_WOUT = 256, T_G = 16 * 128, T_W1 = 128;
  constexpr int E0 = T_WIN, E1 = E0 + T_WOUT, E2 = E1 + T_G, E3 = E2 + T_G, E4 = E3 + T_G, E5 = E4 + T_W1;
  ConvTile c;
  c.pos = nullptr; c.pbp = nullptr;
  int tk, tn;
  if (t < E0) {
    c.src = p.in[I_WIN] + (size_t)l * 1024 * NINSRC; c.K = 1024; c.N = NINSRC; c.dst = (h16*)(ws + OFF_WIN); c.mode = 1; tk = t / 37; tn = t % 37;
  } else if (t < E1) {
    const int u = t - E0;
    c.src = p.in[I_WOUT] + (size_t)l * 1024 * 1024; c.K = 1024; c.N = 1024; c.dst = (h16*)(ws + OFF_WOUT); c.mode = 4; tk = u >> 4; tn = u & 15;
  } else if (t < E3) {
    const int up = t >= E2;
    const int u = t - (up ? E2 : E1);
    const int e = u >> 7, v = u & 127;
    c.src = p.in[up ? I_MU : I_MG] + ((size_t)l * 16 + e) * 1024 * 512; c.K = 1024; c.N = 512; c.dst = wgu_buf(p, l) + (size_t)e * 1024 * 1024;
    c.mode = up ? 3 : 2; tk = v >> 3; tn = v & 7;
  } else if (t < E4) {
    const int u = t - E3;
    const int e = u >> 7, v = u & 127;
    c.src = p.in[I_MD] + ((size_t)l * 16 + e) * 512 * 1024; c.K = 512; c.N = 1024; c.dst = wdn_buf(p, l) + (size_t)e * 1024 * 512; c.mode = 0; tk = v >> 4; tn = v & 15;
  } else {
    const int vv = t >= E5;
    const int u = t - (vv ? E5 : E4);
    c.src = p.in[vv ? I_CVW1 : I_CKW1] + (size_t)l * 2048 * 256; c.K = 2048; c.N = 256; c.dst = (h16*)(ws + (vv ? OFF_W1V : OFF_W1K)); c.mode = 5; tk = u >> 2; tn = u & 3;
    c.pos = p.in[vv ? I_CPV : I_CPK] + (size_t)l * 2048 + tk * 64;
    c.pbp = (float*)(ws + OFF_PBPART) + (size_t)(vv * 32 + tk) * 256 + tn * 64;
  }
  c.k0 = tk * 64; c.n0 = tn * 64;
  return c;
}
__device__ __forceinline__ void conv_wave_tile(const ConvTile& c, float* smw, int lane) {
  float4 v[16];
#pragma unroll
  for (int i = 0; i < 16; ++i) {
    const int idx = i * 64 + lane;
    const int r = idx >> 4, c4 = (idx & 15) * 4;
    v[i] = make_float4(0.f, 0.f, 0.f, 0.f);
    if (c.n0 + c4 < c.N) v[i] = *(const float4*)(c.src + (size_t)(c.k0 + r) * c.N + c.n0 + c4);
  }
#pragma unroll
  for (int i = 0; i < 16; ++i) {
    const int idx = i * 64 + lane;
    const int r = idx >> 4, c4 = (idx & 15) * 4;
    float* d = smw + r * 65 + c4;
    d[0] = v[i].x; d[1] = v[i].y; d[2] = v[i].z; d[3] = v[i].w;
  }
  if (c.mode == 5) {
    float sacc = 0.f;
    for (int k = 0; k < 64; ++k) sacc += c.pos[k] * smw[k * 65 + lane];
    c.pbp[lane] = sacc;
  }
  const int k0d = c.mode == 4 ? (c.k0 < 256 ? c.k0 + 512 : (c.k0 < 768 ? c.k0 - 256 : c.k0)) : c.k0;
#pragma unroll
  for (int j = 0; j < 8; ++j) {
    const int ch = j * 64 + lane;
    const int n = ch >> 3, kc = ch & 7;
    if (c.n0 + n < c.N) {
      h16x8 o;
#pragma unroll
      for (int q = 0; q < 8; ++q) o[q] = (h16)smw[(kc * 8 + q) * 65 + n];
      *(h16x8*)(c.dst + (size_t)map_row(c.mode, c.n0 + n) * c.K + k0d + kc * 8) = o;
    }
  }
}

constexpr int CV_MOE0 = 16 * 37 + 256, CV_MOE1 = CV_MOE0 + 3 * 16 * 128;
constexpr int CV_L1SPLIT = 4352;
constexpr int CV_Q1 = CV_MOE0 + 1536, CV_Q2 = CV_Q1 + 3072;
__device__ __forceinline__ void conv_share(const Params& p, int l, int t0, int t1, int busy_lo, int busy_hi, float* sm) {
  const int tid = tidx(), lane = tid & 63, wave = tid >> 6;
  float* smw = sm + wave * 4160;
  const int G = gridDim.x, b = blockIdx.x;
  int lo = t0, hi = t1, me = b, n = G;
  if ((G & 7) == 0) {
    const int x = b & 7, nb = G >> 3, si = b >> 3, nbusy = busy_hi - busy_lo;
    lo = t0 + (int)(((long)(t1 - t0) * x) >> 3); hi = t0 + (int)(((long)(t1 - t0) * (x + 1)) >> 3);
    if (nbusy > 0 && nbusy < nb) { n = nb - nbusy; me = si < busy_lo ? si : (si >= busy_hi ? si - nbusy : -1); } else { me = si; n = nb; }
  }
  __syncthreads();
  if (me < 0) return;
  for (int t = lo + me * NW + wave; t < hi; t += n * NW) {
    const ConvTile c = conv_decode(p, l, t);
    conv_wave_tile(c, smw, lane);
  }
}
__device__ __forceinline__ void phase_convert_tiles(const Params& p, int l, float* sm) {
  const int tid = tidx(), lane = tid & 63, wave = tid >> 6;
  float* smw = sm + wave * 4160;
  for (int u = blockIdx.x * NW + wave; u < NT_CONV - (CV_MOE1 - CV_MOE0); u += gridDim.x * NW) {
    const ConvTile c = conv_decode(p, l, u < CV_MOE0 ? u : u + (CV_MOE1 - CV_MOE0));
    conv_wave_tile(c, smw, lane);
  }
  __syncthreads();
}
__device__ __forceinline__ void phase_convert_misc(const Params& p, int l) {
  unsigned char* ws = p.ws;
  {
    h16* lw = (h16*)(ws + OFF_LRUW);
    for (int i = blockIdx.x * NTHREADS + tidx(); i < 2 * 4 * 64 * 64; i += gridDim.x * NTHREADS) {
      const int d = i & 63, e = (i >> 6) & 63, n = (i >> 12) & 3, mat = i >> 14;
      lw[i] = (h16)p.in[mat ? I_LWX : I_LWA][((size_t)(l * 4 + n) * 64 + d) * 64 + e];
    }
  }
  {
    h16x8 z = {0, 0, 0, 0, 0, 0, 0, 0};
    h16* w = (h16*)(ws + OFF_WIN) + (size_t)NINSRC * 1024;
    for (int i = blockIdx.x * NTHREADS + tidx(); i < (NINP - NINSRC) * 1024 / 8; i += gridDim.x * NTHREADS) *(h16x8*)(w + (size_t)i * 8) = z;
  }
}

__device__ __forceinline__ void phase_prep(const Params& p, float* sm) {
  unsigned char* ws = p.ws;
  const int tid = tidx();
  if (blockIdx.x == 0) {
    for (int i = tid; i < 1024; i += NTHREADS) ((unsigned*)(ws + OFF_CTL))[i] = 0u;
  }
  float* part = (float*)(ws + OFF_MODP);
  for (int it = blockIdx.x; it < 256; it += gridDim.x) {
    const int l = it >> 7, r = it & 127, cg = r >> 2, ks = r & 3;
    const int lane = tid & 63, wave = tid >> 6;
    const int k0 = ks * 256 + wave * 32;
    const float* w = p.in[I_ADAW] + ((size_t)l * 1024 + k0) * 6144 + cg * 192 + (lane < 48 ? lane : 0) * 4;
    const float* c = p.in[I_C] + k0;
    float a0[4] = {0, 0, 0, 0}, a1[4] = {0, 0, 0, 0};
#pragma unroll 16
    for (int k = 0; k < 32; ++k) {
      float4 wv = make_float4(0.f, 0.f, 0.f, 0.f);
      if (lane < 48) wv = *(const float4*)(w + (size_t)k * 6144);
      const float s0 = silu_f(c[k]), s1 = silu_f(c[1024 + k]);
      a0[0] += s0 * wv.x; a0[1] += s0 * wv.y; a0[2] += s0 * wv.z; a0[3] += s0 * wv.w;
      a1[0] += s1 * wv.x; a1[1] += s1 * wv.y; a1[2] += s1 * wv.z; a1[3] += s1 * wv.w;
    }
    float* rr = sm + (wave * 64 + lane) * 8;
#pragma unroll
    for (int i = 0; i < 4; ++i) { rr[i] = a0[i]; rr[4 + i] = a1[i]; }
    __syncthreads();
    {
      const int bb = tid >> 8, col = tid & 255;
      float sacc = 0.f;
#pragma unroll
      for (int g = 0; g < 8; ++g) sacc += sm[(g * 64 + (col >> 2)) * 8 + bb * 4 + (col & 3)];
      if (col < 192) part[((size_t)(ks * 2 + l) * 2 + bb) * 6144 + cg * 192 + col] = sacc;
    }
    __syncthreads();
  }
  float* rc = (float*)(ws + OFF_ROPE);
  float* rs = rc + (size_t)T * 32;
  const int* pos = (const int*)p.in[I_POS];
  for (int i = blockIdx.x * NTHREADS + tid; i < T * 32; i += gridDim.x * NTHREADS) {
    const int t = i >> 5, f = i & 31;
    const double a = (double)pos[t] * p.inv_freq[f];
    const double n = rint(a * 0.15915494309189535);
    double r = fma(-n, 6.283185307179586, a);
    r = fma(-n, 2.4492935982947064e-16, r);
    const float rf = (float)r;
    rc[i] = __cosf(rf);
    rs[i] = __sinf(rf);
  }
}

__device__ __forceinline__ void phase_norm1(const Params& p, int mode, float* sm) {
  unsigned char* ws = p.ws;
  const int lane = tidx() & 63, wave = tidx() >> 6;
  const float* mod = (const float*)(ws + OFF_MOD);
  h16* xa = (h16*)(ws + OFF_XA);
  const void* xsrc = (const void*)(ws + OFF_XA + (size_t)T * D * 2);
  const bool xhalf = true;
  const h16* y16 = (const h16*)(ws + OFF_Y16);
  const h16* yp = (const h16*)(ws + OFF_YPAIR);
  h16* hout = (h16*)(ws + OFF_H16);
  const int l = (mode == 0) ? 0 : 1;
  if (mode == 0) {
    const float* part = (const float*)(ws + OFF_MODP);
    const int tid = tidx();
    for (int i = tid; i < 1024; i += NTHREADS) {
      const int b = i >> 9, j4 = (i & 511) * 4;
      float4 a = *(const float4*)(p.in[I_ADAB] + j4);
#pragma unroll
      for (int ks = 0; ks < 4; ++ks) {
        const float4 v = *(const float4*)(part + ((size_t)(ks * 2) * 2 + b) * 6144 + j4);
        a.x += v.x; a.y += v.y; a.z += v.z; a.w += v.w;
      }
      *(float4*)(sm + b * 2048 + j4) = a;
    }
    for (int o = blockIdx.x * NTHREADS + tid; o < 4 * 6144; o += gridDim.x * NTHREADS) {
      const int lb = o / 6144, j = o - lb * 6144;
      float a = p.in[I_ADAB][(lb >> 1) * 6144 + j];
#pragma unroll
      for (int ks = 0; ks < 4; ++ks) a += part[((size_t)(ks * 2 + (lb >> 1)) * 2 + (lb & 1)) * 6144 + j];
      ((float*)(ws + OFF_MOD))[o] = a;
    }
    __syncthreads();
  }
  const int lp = mode == 1 ? 0 : 1;
  const int stride = gridDim.x * NW;
  int row = blockIdx.x * NW + wave;
  float4 xn[4], gsv[4], shv[4], g2v[4];
  h16x4 y0n[4], y1n[4];
#pragma unroll
  for (int i = 0; i < 4; ++i) {
    const int col = lane * 4 + 256 * i;
    if (row < T) {
      if (mode == 0) xn[i] = *(const float4*)(p.in[I_X] + (size_t)row * D + col);
      else {
        xn[i] = ldx4(xsrc, xhalf, (size_t)row * D + col);
        y0n[i] = *(const h16x4*)(yp + (size_t)(row * 2) * D + col);
        y1n[i] = *(const h16x4*)(yp + (size_t)(row * 2 + 1) * D + col);
      }
    }
  }
  int bcur = -1;
  for (; row < T; row += stride) {
    const int b = row >> 13;
    if (b != bcur) {
      bcur = b;
#pragma unroll
      for (int i = 0; i < 4; ++i) {
        const int col = lane * 4 + 256 * i;
        if (mode == 2) gsv[i] = *(const float4*)(p.in[I_FNG] + col);
        else {
          const float4 g = *(const float4*)(p.in[I_N1G] + l * D + col);
          const float4 sh = mode == 0 ? *(const float4*)(sm + b * 2048 + col) : *(const float4*)(mod + (size_t)(l * 2 + b) * 6144 + col);
          const float4 sc = mode == 0 ? *(const float4*)(sm + b * 2048 + 1024 + col) : *(const float4*)(mod + (size_t)(l * 2 + b) * 6144 + 1024 + col);
          gsv[i] = make_float4(g.x * (1.f + sc.x), g.y * (1.f + sc.y), g.z * (1.f + sc.z), g.w * (1.f + sc.w));
          shv[i] = sh;
        }
        if (mode != 0) g2v[i] = *(const float4*)(mod + (size_t)(lp * 2 + b) * 6144 + 5120 + col);
      }
    }
    float4 x[4];
    float ss = 0.f;
#pragma unroll
    for (int i = 0; i < 4; ++i) {
      if (mode == 0) x[i] = xn[i];
      else {
        x[i].x = xn[i].x + g2v[i].x * ((float)y0n[i][0] + (float)y1n[i][0]);
        x[i].y = xn[i].y + g2v[i].y * ((float)y0n[i][1] + (float)y1n[i][1]);
        x[i].z = xn[i].z + g2v[i].z * ((float)y0n[i][2] + (float)y1n[i][2]);
        x[i].w = xn[i].w + g2v[i].w * ((float)y0n[i][3] + (float)y1n[i][3]);
      }
    }
    if (row + stride < T) {
      const int rn = row + stride;
#pragma unroll
      for (int i = 0; i < 4; ++i) {
        const int col = lane * 4 + 256 * i;
        if (mode == 0) xn[i] = *(const float4*)(p.in[I_X] + (size_t)rn * D + col);
        else {
          xn[i] = ldx4(xsrc, xhalf, (size_t)rn * D + col);
          y0n[i] = *(const h16x4*)(yp + (size_t)(rn * 2) * D + col);
          y1n[i] = *(const h16x4*)(yp + (size_t)(rn * 2 + 1) * D + col);
        }
      }
    }
#pragma unroll
    for (int i = 0; i < 4; ++i) {
      const int col = lane * 4 + 256 * i;
      if (mode == 1) *(h16x4*)(xa + (size_t)row * D + col) = pack4(x[i].x, x[i].y, x[i].z, x[i].w);
      ss += x[i].x * x[i].x + x[i].y * x[i].y + x[i].z * x[i].z + x[i].w * x[i].w;
    }
    ss = wsum(ss);
    const float rstd = rsqrtf(ss * (1.f / D) + EPS);
#pragma unroll
    for (int i = 0; i < 4; ++i) {
      const int col = lane * 4 + 256 * i;
      if (mode == 2) {
        float4 o;
        o.x = x[i].x * rstd * gsv[i].x; o.y = x[i].y * rstd * gsv[i].y; o.z = x[i].z * rstd * gsv[i].z; o.w = x[i].w * rstd * gsv[i].w;
        *(float4*)(p.out + (size_t)row * D + col) = o;
      } else {
        *(h16x4*)(hout + (size_t)row * D + col) = pack4(x[i].x * rstd * gsv[i].x + shv[i].x, x[i].y * rstd * gsv[i].y + shv[i].y,
                                                        x[i].z * rstd * gsv[i].z + shv[i].z, x[i].w * rstd * gsv[i].w + shv[i].w);
      }
    }
  }
}

__device__ __forceinline__ int perm_key(int pos) {
  return 32 * (pos >> 5) + 16 * ((pos >> 2) & 1) + 4 * ((pos >> 3) & 3) + (pos & 3);
}
__device__ __forceinline__ void inproj_post(const Params& p, h16* sm, int mt, int nt) {
  unsigned char* ws = p.ws;
  const int tid_e = tidx();
  constexpr int LDR = 136;
  const int row0 = mt * 256, b = mt >> 5, s0 = (mt & 31) * 256;
  if (nt < 4 || (nt >= 14 && nt < 18)) {
    h16* P = (h16*)(ws + OFF_P16);
#pragma unroll
    for (int i = 0; i < 8; ++i) {
      const int idx = i * NTHREADS + tid_e;
      const int r = idx >> 4, c8 = idx & 15;
      *(h16x8*)(P + (size_t)(row0 + r) * NIN + nt * 128 + c8 * 8) = *(const h16x8*)(sm + r * LDR + c8 * 8);
    }
  } else if (nt <= 8 || nt == 10 || nt == 12) {
    const float* rc = (const float*)(ws + OFF_ROPE);
    const float* rs = rc + (size_t)T * 32;
    const bool isq = nt < 8;
    const float scl = isq ? 0.125f * 1.4426950408889634f : 1.f;
    h16* kbase = (h16*)(ws + (nt == 8 ? OFF_KC : (nt == 10 ? OFF_KS : OFF_KW)));
    h16* q16 = (h16*)(ws + OFF_Q16);
#pragma unroll
    for (int i = 0; i < 4; ++i) {
      const int idx = i * NTHREADS + tid_e;
      const int r = idx >> 3, hd = (idx >> 2) & 1, d = (idx & 3) * 8;
      const h16x8 a = *(const h16x8*)(sm + r * LDR + 64 * hd + d);
      const h16x8 bb = *(const h16x8*)(sm + r * LDR + 64 * hd + 32 + d);
      const float* cp = rc + (size_t)(row0 + r) * 32 + d;
      const float* sp = rs + (size_t)(row0 + r) * 32 + d;
      const float4 c0 = *(const float4*)cp, c1 = *(const float4*)(cp + 4), n0 = *(const float4*)sp, n1 = *(const float4*)(sp + 4);
      const float cs[8] = {c0.x, c0.y, c0.z, c0.w, c1.x, c1.y, c1.z, c1.w}, sn[8] = {n0.x, n0.y, n0.z, n0.w, n1.x, n1.y, n1.z, n1.w};
      h16x8 lo, hi;
#pragma unroll
      for (int j = 0; j < 8; ++j) {
        const float av = (float)a[j], bv = (float)bb[j];
        lo[j] = (h16)((av * cs[j] - bv * sn[j]) * scl);
        hi[j] = (h16)((bv * cs[j] + av * sn[j]) * scl);
      }
      h16* dst = isq ? q16 + (size_t)(row0 + r) * 512 + (nt - 4) * 128 + 64 * hd + d : kbase + ((size_t)(b * 2 + hd) * S + s0 + r) * 64 + d;
      *(h16x8*)dst = lo;
      *(h16x8*)(dst + 32) = hi;
    }
  } else if (nt == 9) {
    h16* vc = (h16*)(ws + OFF_VC);
#pragma unroll
    for (int i = 0; i < 8; ++i) {
      const int idx = i * NTHREADS + tid_e;
      const int r = idx >> 4, c8 = idx & 15, hd = c8 >> 3, dd = (c8 & 7) * 8;
      *(h16x8*)(vc + ((size_t)(b * 2 + hd) * S + s0 + r) * 64 + dd) = *(const h16x8*)(sm + r * LDR + c8 * 8);
    }
  } else if (nt == 11 || nt == 13) {
    h16* vt = (h16*)(ws + (nt == 11 ? OFF_VST : OFF_VWT));
#pragma unroll
    for (int i = 0; i < 8; ++i) {
      const int idx = i * NTHREADS + tid_e;
      const int kv = idx >> 11, blk = (idx >> 9) & 3, dim = (idx >> 3) & 63, p0 = (idx & 7) * 8;
      h16x8 v;
#pragma unroll
      for (int j = 0; j < 8; ++j) v[j] = sm[(blk * 64 + perm_key(p0 + j)) * LDR + 64 * kv + dim];
      *(h16x8*)(vt + ((size_t)((b * 2 + kv) * 128 + (s0 >> 6) + blk)) * 4096 + dim * 64 + p0) = v;
    }
  } else {
    float* gates = (float*)(ws + OFF_GATES);
#pragma unroll
    for (int i = 0; i < 12; ++i) {
      const int idx = i * NTHREADS + tid_e;
      const int r = idx / 24, cc = idx % 24;
      gates[(size_t)(row0 + r) * 24 + cc] = sigm((float)sm[r * LDR + cc]);
    }
  }
  __syncthreads();
}
__device__ __forceinline__ void inproj_tile(const Params& p, h16* sm, int mt, int nt) {
  unsigned char* ws = p.ws;
  const h16* Ab = (const h16*)(ws + OFF_H16) + (size_t)mt * 256 * D;
  f32x4 acc[8][2];
  gemm_mainloop<128>(acc, [&](int r) { return Ab + (size_t)r * D; }, (const h16*)(ws + OFF_WIN) + (size_t)nt * 128 * D, D, D / 64, sm);
  const int tid_e = tidx(), lane = tid_e & 63, wave = tid_e >> 6, wr = wave >> 2, wc = wave & 3, fr = lane & 15, fq = lane >> 4;
  constexpr int LDR = 136;
#pragma unroll
  for (int m = 0; m < 8; ++m)
#pragma unroll
    for (int n = 0; n < 2; ++n)
      *(h16x4*)(sm + (wr * 128 + m * 16 + fr) * LDR + wc * 32 + n * 16 + 4 * fq) = pack4(acc[m][n][0], acc[m][n][1], acc[m][n][2], acc[m][n][3]);
  __syncthreads();
  inproj_post(p, sm, mt, nt);
}
__device__ __forceinline__ void inproj_tile8(const Params& p, h16* sm, int mt, int ct) {
  unsigned char* ws = p.ws;
  const h16* Ab = (const h16*)(ws + OFF_H16) + (size_t)mt * 256 * D;
  f32x4 acc[2][2][4][2];
  gemm8_mainloop<true>(acc, Ab, [&](int r) { return r * D; }, (const h16*)(ws + OFF_WIN) + (size_t)ct * 256 * D, D, D / 64, sm);
  const int tid_e = tidx(), lane = tid_e & 63, wave = tid_e >> 6, wr = wave >> 2, wc = wave & 3, fr = lane & 15, fq = lane >> 4;
  constexpr int LDR = 136;
#pragma unroll 1
  for (int bj = 0; bj < 2; ++bj) {
#pragma unroll
    for (int ai = 0; ai < 2; ++ai)
#pragma unroll
      for (int m = 0; m < 4; ++m)
#pragma unroll
        for (int n = 0; n < 2; ++n) {
          const f32x4 v = bj == 0 ? acc[ai][0][m][n] : acc[ai][1][m][n];
          *(h16x4*)(sm + (ai * 128 + wr * 64 + m * 16 + fr) * LDR + wc * 32 + n * 16 + 4 * fq) = pack4(v[0], v[1], v[2], v[3]);
        }
    __syncthreads();
    inproj_post(p, sm, mt, 2 * ct + bj);
  }
}
__device__ __forceinline__ void phase_inproj(const Params& p, int l, h16* sm) {
  const int G = gridDim.x;
  if ((G & 7) == 0) {
    const int x = blockIdx.x & 7, nb = G >> 3, si = blockIdx.x >> 3;
    const int R = 72 / nb, left = 72 - R * nb, H = 2 * left + 8;
    for (int k = 0; k < R; ++k) { const int f = si + k * nb; inproj_tile8(p, sm, 8 * x + f / 9, f % 9); }
    for (int hh = si; hh < H; hh += nb) {
      if (hh < 2 * left) { const int f = R * nb + (hh >> 1); inproj_tile(p, sm, 8 * x + f / 9, 2 * (f % 9) + (hh & 1)); }
      else inproj_tile(p, sm, 8 * x + (hh - 2 * left), 18);
    }
    if (l == 0) conv_share(p, 0, CV_MOE0, CV_Q1, 0, H % nb, (float*)sm);
  } else {
    const TileIter tf = xcd_tiles(64 * 19);
    for (int t = tf.cur; t < tf.end; t += tf.step) inproj_tile(p, sm, t / 19, t % 19);
    if (l == 0) conv_share(p, 0, CV_MOE0, CV_Q1, 0, 0, (float*)sm);
  }
}

__device__ __forceinline__ void mixa_compress1(const Params& p, int item, h16* sm) {
  unsigned char* ws = p.ws;
  const int which = item >> 6, mt = (item >> 3) & 7, ks = (item >> 1) & 3, half = item & 1;
  const h16* A = (const h16*)(ws + (which ? OFF_VC : OFF_KC)) + (size_t)mt * 256 * 1024 + ks * 512;
  const h16* W = (const h16*)(ws + (which ? OFF_W1V : OFF_W1K)) + (size_t)half * 128 * 2048 + ks * 512;
  float* hp = (float*)(ws + OFF_HIDP) + ((size_t)(ks * 2 + which) * 2048) * 256;
  f32x4 acc[8][2];
  gemm_mainloop<128>(acc, [&](int r) { return A + (size_t)r * 1024; }, W, 2048, 8, sm);
  const int tid_e = tidx(), lane = tid_e & 63, wave = tid_e >> 6, wr = wave >> 2, wc = wave & 3, fr = lane & 15, fq = lane >> 4;
#pragma unroll
  for (int m = 0; m < 8; ++m)
#pragma unroll
    for (int n = 0; n < 2; ++n) {
      const int row = mt * 256 + wr * 128 + m * 16 + fr, col = half * 128 + wc * 32 + n * 16 + 4 * fq;
      *(f32x4*)(hp + (size_t)row * 256 + col) = acc[m][n];
    }
}

__device__ __forceinline__ void mixa_lru(const Params& p, int l, int item, float* sm) {
  unsigned char* ws = p.ws;
  const int tid = tidx();
  const int half = tid >> 8;
  item = item * 2 + half;
  sm += half * 14400;
  const int b = item >> 8, ck = item & 255;
  const int c = tid & 255;
  const int nb = c >> 6;
  const int lane = tid & 63, fr = lane & 15, fq = lane >> 4;
  const h16* P = (const h16*)(ws + OFF_P16);
  const float* cw = p.in[I_LCW] + l * 4 * 256;
  const float w0 = cw[c], w1 = cw[256 + c], w2 = cw[512 + c], w3 = cw[768 + c], cb = p.in[I_LCB][l * 256 + c];
  const float ba = p.in[I_LBA][l * 256 + c], bx = p.in[I_LBX][l * 256 + c];
  const float lam = p.in[I_LLAM][l * 256 + c];
  const float ls = -log1pf(expf(-lam));
  h16x8 bw[2][4][2];
  {
    const h16* lw = (const h16*)(ws + OFF_LRUW);
#pragma unroll
    for (int mat = 0; mat < 2; ++mat)
#pragma unroll
      for (int nt = 0; nt < 4; ++nt)
#pragma unroll
        for (int ks = 0; ks < 2; ++ks) bw[mat][nt][ks] = *(const h16x8*)(lw + ((size_t)((mat * 4 + nb) * 64 + nt * 16 + fr)) * 64 + ks * 32 + 8 * fq);
  }
  const int t0 = ck * 32;
  float x0 = 0.f, x1 = 0.f, x2 = 0.f;
  if (t0 >= 3) {
    x0 = (float)P[(size_t)(b * S + t0 - 3) * NIN + C_XL + c];
    x1 = (float)P[(size_t)(b * S + t0 - 2) * NIN + C_XL + c];
    x2 = (float)P[(size_t)(b * S + t0 - 1) * NIN + C_XL + c];
  }
  float h = 0.f, ap = 1.f;
  float* lh = (float*)(ws + OFF_LRUH);
  float* la = (float*)(ws + OFF_LRUA);
  float* sr = sm + 4096;
  float* si = sm + 8192;
  h16* xh = (h16*)(sm + 12288);
#pragma unroll 1
  for (int sub = 0; sub < 2; ++sub) {
    const int tb = t0 + sub * 16;
    {
      h16 xv[16];
      const h16* xp = P + (size_t)(b * S + tb) * NIN + C_XL + c;
#pragma unroll
      for (int tt = 0; tt < 16; ++tt) { xv[tt] = *xp; xp += NIN; asm volatile("" : "+v"(xp)); }
#pragma unroll
      for (int tt = 0; tt < 16; ++tt) {
        const float x3 = (float)xv[tt];
        const float xc = w0 * x0 + w1 * x1 + w2 * x2 + w3 * x3 + cb;
        sm[tt * 256 + c] = xc;
        xh[tt * 264 + c] = (h16)xc;
        x0 = x1; x1 = x2; x2 = x3;
      }
    }
    {
      h16x8 af[2];
#pragma unroll
      for (int ks = 0; ks < 2; ++ks) af[ks] = *(const h16x8*)(xh + fr * 264 + nb * 64 + ks * 32 + 8 * fq);
#pragma unroll
      for (int nt = 0; nt < 4; ++nt) {
        f32x4 ar = {0.f, 0.f, 0.f, 0.f}, ai = {0.f, 0.f, 0.f, 0.f};
#pragma unroll
        for (int ks = 0; ks < 2; ++ks) {
          ar = __builtin_amdgcn_mfma_f32_16x16x32_f16(af[ks], bw[0][nt][ks], ar, 0, 0, 0);
          ai = __builtin_amdgcn_mfma_f32_16x16x32_f16(af[ks], bw[1][nt][ks], ai, 0, 0, 0);
        }
#pragma unroll
        for (int j = 0; j < 4; ++j) {
          sr[(4 * fq + j) * 256 + nb * 64 + nt * 16 + fr] = ar[j];
          si[(4 * fq + j) * 256 + nb * 64 + nt * 16 + fr] = ai[j];
        }
      }
    }
#pragma unroll 4
    for (int tt = 0; tt < 16; ++tt) {
      const float r = sigm(sr[tt * 256 + c] + ba), ig = sigm(si[tt * 256 + c] + bx);
      const float log_a = 8.f * r * ls;
      const float a = __expf(log_a);
      const float x2 = 2.f * log_a;
      const float om = x2 > -0.1f ? -x2 * (1.f + x2 * (0.5f + x2 * (0.16666667f + x2 * (0.041666668f + x2 * 0.0083333338f)))) : 1.f - a * a;
      const float mult = __builtin_amdgcn_sqrtf(om);
      sr[tt * 256 + c] = a;
      si[tt * 256 + c] = mult * ig * sm[tt * 256 + c];
    }
    float* lhp = lh + (size_t)(b * S + tb) * 256 + c;
    float* lap = la + (size_t)(b * S + tb) * 256 + c;
#pragma unroll 4
    for (int tt = 0; tt < 16; ++tt) {
      const float a = sr[tt * 256 + c];
      h = a * h + si[tt * 256 + c];
      ap *= a;
      lhp[tt * 256] = h;
      lap[tt * 256] = ap;
    }
  }
  ((float*)(ws + OFF_HEND))[(size_t)(b * 256 + ck) * 256 + c] = h;
  ((float*)(ws + OFF_AEND))[(size_t)(b * 256 + ck) * 256 + c] = ap;
  __syncthreads();
}

__device__ __forceinline__ void mixa_conv(const Params& p, int l, int item, float* sm) {
  unsigned char* ws = p.ws;
  const int half = tidx() >> 8;
  item = item * 2 + half;
  sm += half * 15872;
  const int b = item >> 8, ck = item & 255;
  const int c = tidx() & 255;
  const h16* P = (const h16*)(ws + OFF_P16);
  const int t0 = ck * 32;
  float col[64];
#pragma unroll
  for (int r0 = 0; r0 < 64; r0 += 16) {
    h16 va[16], vb[16];
#pragma unroll
    for (int q = 0; q < 16; ++q) {
      const int t = t0 - 30 + r0 + q;
      va[q] = (h16)0.f; vb[q] = (h16)0.f;
      if (t >= 0 && r0 + q < 62) {
        const h16* pr = P + (size_t)(b * S + t) * NIN;
        va[q] = pr[C_CVA + c]; vb[q] = pr[C_CVB + c];
      }
    }
#pragma unroll
    for (int q = 0; q < 16; ++q) col[r0 + q] = (float)va[q] * sigm((float)vb[q]);
    asm volatile("" ::: "memory");
  }
  float w[31];
#pragma unroll
  for (int j = 0; j < 31; ++j) w[j] = p.in[I_DWW][(size_t)(l * 31 + j) * 256 + c];
  const float bias = p.in[I_DWB][l * 256 + c];
#pragma unroll
  for (int i = 0; i < 32; ++i) {
    float z = bias;
#pragma unroll
    for (int j = 0; j < 31; ++j) z += w[j] * col[i + j];
    sm[i * 256 + c] = z;
  }
  __syncthreads();
  const int lane = tidx() & 63, wave = (tidx() >> 6) & 3;
  const float4 lg = *(const float4*)(p.in[I_LNG] + l * 256 + lane * 4);
  const float4 lb = *(const float4*)(p.in[I_LNB] + l * 256 + lane * 4);
  const float4 gn = *(const float4*)(p.in[I_ONG] + l * 1024 + 768 + lane * 4);
  h16* yc = (h16*)(ws + OFF_H16);
  for (int i = wave * 8; i < wave * 8 + 8; ++i) {
    const float4 z = *(const float4*)(sm + i * 256 + lane * 4);
    const float mu = wsum(z.x + z.y + z.z + z.w) * (1.f / 256.f);
    const float dx = z.x - mu, dy = z.y - mu, dz = z.z - mu, dw = z.w - mu;
    const float var = wsum(dx * dx + dy * dy + dz * dz + dw * dw) * (1.f / 256.f);
    const float rs = rsqrtf(var + EPS);
    const float y0 = silu_f(dx * rs * lg.x + lb.x), y1 = silu_f(dy * rs * lg.y + lb.y), y2 = silu_f(dz * rs * lg.z + lb.z), y3 = silu_f(dw * rs * lg.w + lb.w);
    const float r2 = rsqrtf(wsum(y0 * y0 + y1 * y1 + y2 * y2 + y3 * y3) * (1.f / 256.f) + EPS);
    *(h16x4*)(yc + (size_t)(b * S + t0 + i) * D + 768 + lane * 4) = pack4(y0 * r2 * gn.x, y1 * r2 * gn.y, y2 * r2 * gn.z, y3 * r2 * gn.w);
  }
  __syncthreads();
}

__device__ __forceinline__ void phase_mixa(const Params& p, int l, void* sm) {
  const int G = gridDim.x;
  if (blockIdx.x == 0) {
    const int o = tidx();
    const float* pp = (const float*)(p.ws + OFF_PBPART) + (size_t)(o >> 8) * 32 * 256 + (o & 255);
    float pv[32];
#pragma unroll
    for (int k = 0; k < 32; ++k) pv[k] = pp[k * 256];
    float accb = 0.f;
#pragma unroll
    for (int k = 0; k < 32; ++k) accb += pv[k];
    ((float*)(p.ws + OFF_PB))[o] = accb;
  }
  for (int it = blockIdx.x; it < 128; it += G) mixa_compress1(p, it, (h16*)sm);
  for (int it = blockIdx.x; it < 256; it += G) mixa_lru(p, l, it, (float*)sm);
  for (int it = (blockIdx.x + G - 64 % G) % G; it < 256; it += G) mixa_conv(p, l, it, (float*)sm);
  if (l == 0) conv_share(p, 0, CV_Q1, CV_Q2, 0, 16, (float*)sm);
}

__device__ __forceinline__ void phase_mixb(const Params& p, int l, float* sm) {
  unsigned char* ws = p.ws;
  const int tid = tidx();
  for (int it = blockIdx.x; it < 512; it += gridDim.x) {
    const int which = it >> 8;
    const int row0 = (it & 255) * 8;
    {
      const float* hp = (const float*)(ws + OFF_HIDP) + ((size_t)which * 2048 + row0) * 256;
      const float* pb = (const float*)(ws + OFF_PB) + which * 256;
      const int r = tid >> 6, c4 = (tid & 63) * 4;
      const size_t o = (size_t)r * 256 + c4;
      const float4 a0 = *(const float4*)(hp + o), a1 = *(const float4*)(hp + (size_t)2 * 2048 * 256 + o);
      const float4 a2 = *(const float4*)(hp + (size_t)4 * 2048 * 256 + o), a3 = *(const float4*)(hp + (size_t)6 * 2048 * 256 + o);
      const float4 bb = *(const float4*)(pb + c4);
      float* d = sm + r * 256 + c4;
      d[0] = gelu_tanh(a0.x + a1.x + a2.x + a3.x + bb.x); d[1] = gelu_tanh(a0.y + a1.y + a2.y + a3.y + bb.y);
      d[2] = gelu_tanh(a0.z + a1.z + a2.z + a3.z + bb.z); d[3] = gelu_tanh(a0.w + a1.w + a2.w + a3.w + bb.w);
      const float4* wsrc = (const float4*)(p.in[which ? I_CVW2 : I_CKW2] + (size_t)l * 256 * 64);
      float4* wdst = (float4*)(sm + 2048);
#pragma unroll
      for (int q = 0; q < 8; ++q) wdst[q * NTHREADS + tid] = wsrc[q * NTHREADS + tid];
    }
    __syncthreads();
    const int row = row0 + (tid >> 6), d = tid & 63;
    const float* hr = sm + (tid >> 6) * 256;
    const float* w2 = sm + 2048 + d;
    float s = 0.f;
#pragma unroll 8
    for (int j = 0; j < 256; ++j) s += (float)(h16)hr[j] * w2[j * 64];
    const int bkv = row >> 9, n = row & 511;
    if (n == 511) s = 0.f;
    if (which == 0) {
      ((h16*)(ws + OFF_KCMP))[((size_t)bkv * 512 + n) * 64 + d] = (h16)s;
    } else {
      const int blk = n >> 6, key = n & 63;
      const int pos = 32 * (key >> 5) + 8 * ((key >> 2) & 3) + 4 * ((key >> 4) & 1) + (key & 3);
      ((h16*)(ws + OFF_VCMPT))[((size_t)(bkv * 8 + blk) * 64 + d) * 64 + pos] = (h16)s;
    }
    __syncthreads();
  }
  for (int task = (blockIdx.x + gridDim.x - 16 % gridDim.x) % gridDim.x; task < 16; task += gridDim.x) {
    const int b = task >> 3, c = (task & 7) * 32 + (tid & 31), grp = tid >> 5;
    const float* he = (const float*)(ws + OFF_HEND) + ((size_t)b * 256 + grp * 16) * 256 + c;
    const float* ae = (const float*)(ws + OFF_AEND) + ((size_t)b * 256 + grp * 16) * 256 + c;
    float* cy = (float*)(ws + OFF_CARRY) + ((size_t)b * 256 + grp * 16) * 256 + c;
    float hv[16], av[16];
#pragma unroll
    for (int k = 0; k < 16; ++k) { hv[k] = he[k * 256]; av[k] = ae[k * 256]; }
    float ga = 1.f, gh = 0.f;
#pragma unroll
    for (int k = 0; k < 16; ++k) { gh = hv[k] + av[k] * gh; ga *= av[k]; }
    sm[tid] = ga; sm[512 + tid] = gh;
    __syncthreads();
    float carry = 0.f;
    for (int q = 0; q < grp; ++q) carry = sm[512 + q * 32 + (tid & 31)] + sm[q * 32 + (tid & 31)] * carry;
#pragma unroll
    for (int k = 0; k < 16; ++k) {
      cy[k * 256] = carry;
      carry = hv[k] + av[k] * carry;
    }
    __syncthreads();
  }
  if (l == 0) conv_share(p, 0, CV_Q2, CV_MOE1, (int)(gridDim.x >> 3) - 2, (int)(gridDim.x >> 3), sm);
}

__device__ __forceinline__ void stage8k(const h16* __restrict__ g, h16* l, int tid) {
  const int r = tid >> 3, cl = (tid & 7) ^ ((r >> 1) & 7);
  glds16(g + r * 64 + cl * 8, l + tid * 8);
}
__device__ __forceinline__ h16x8 ldfrag(const h16* l, int row, int chunk) {
  return *(const h16x8*)(l + row * 64 + ((chunk ^ ((row >> 1) & 7)) * 8));
}

template <int MODE>
__device__ __forceinline__ void attn_branch(const h16* __restrict__ Kg, const h16* __restrict__ Vg, int j0, int j1, h16* ring,
                                            const h16x8 (&qf)[2][2], float (&m)[2], float (&l)[2], f32x4 (&o)[2][4],
                                            const int (&tq)[2], const int (&lim)[2], const int (&tlim)[2], const int (&tfl)[2],
                                            const unsigned long long (&mylo)[2], const unsigned long long (&myhi)[2],
                                            const unsigned long long (&ulo)[2], const unsigned long long (&uhi)[2],
                                            const float (&inv)[2], float* impw) {
  int tid = tidx();
  asm volatile("" : "+v"(tid));
  const int lane = tid & 63;
  const int h = lane >> 4, c = lane & 15, qi = c >> 2, g = c & 3;
  constexpr bool PV = MODE != 0;
  constexpr int SS = 3;
  const int n = j1 - j0 + 1;
  if (n <= 0) return;
  const int nss = (n + SS - 1) / SS;
#pragma unroll
  for (int q = 0; q < SS; ++q)
    if (q < n) {
      stage8k(Kg + (size_t)(j0 + q) * 4096, ring + q * 8192, tid);
      if (PV) stage8k(Vg + (size_t)(j0 + q) * 4096, ring + q * 8192 + 4096, tid);
    }
  int sbase = 0;
  for (int ss = 0; ss < nss; ++ss) {
    VMCNT(0);
    __builtin_amdgcn_s_barrier();
    {
      const int sn = SS - sbase;
#pragma unroll
      for (int q = 0; q < SS; ++q) {
        const int jb = SS * (ss + 1) + q;
        if (jb < n) {
          stage8k(Kg + (size_t)(j0 + jb) * 4096, ring + (sn + q) * 8192, tid);
          if (PV) stage8k(Vg + (size_t)(j0 + jb) * 4096, ring + (sn + q) * 8192 + 4096, tid);
        }
      }
    }
#pragma unroll 1
   for (int sub = 0; sub < SS; ++sub) {
    const int it = SS * ss + sub;
    if (it >= n) break;
    const int j = j0 + it;
    const h16* cK = ring + (sbase + sub) * 8192;
    const h16* cV = cK + 4096;
    bool act[2];
#pragma unroll
    for (int mq = 0; mq < 2; ++mq) {
      if (MODE <= 1) act[mq] = j * 64 <= tlim[mq];
      else if (MODE == 2) act[mq] = ((j < 64 ? (ulo[mq] >> j) : (uhi[mq] >> (j - 64))) & 1ull) != 0ull;
      else act[mq] = (j * 64 <= tlim[mq] + 3) && (j * 64 + 63 > tlim[mq] - 512);
    }
    if (act[0] || act[1]) {
      h16x8 pf[2][2];
      h16x8 kf[4][2];
#pragma unroll
      for (int kt = 0; kt < 4; ++kt)
#pragma unroll
        for (int ks = 0; ks < 2; ++ks) kf[kt][ks] = ldfrag(cK, 16 * kt + c, 4 * ks + h);
#pragma unroll
      for (int mq = 0; mq < 2; ++mq)
        if (act[mq]) {
          f32x4 s[1][4];
          const bool selbit = MODE == 2 ? (((j < 64 ? (mylo[mq] >> j) : (myhi[mq] >> (j - 64))) & 1ull) != 0ull) : true;
          bool interior;
          if (MODE <= 1) interior = j * 64 + 63 <= tfl[mq];
          else if (MODE == 2) interior = j * 64 + 63 <= tfl[mq];
          else interior = (j * 64 + 63 <= tfl[mq]) && (j * 64 > tfl[mq] + 3 - 512);
          const bool rowoff = MODE == 2 && interior && !selbit;
          const bool mvalid = m[mq] > -1e29f;
          const float mb = mvalid ? m[mq] : 0.f;
          {
            const float init = MODE == 1 ? inv[mq] - mb : (rowoff ? -1e30f : -mb);
#pragma unroll
            for (int kt = 0; kt < 4; ++kt) {
              s[0][kt] = (f32x4){init, init, init, init};
#pragma unroll
              for (int ks = 0; ks < 2; ++ks) s[0][kt] = __builtin_amdgcn_mfma_f32_16x16x32_f16(kf[kt][ks], qf[mq][ks], s[0][kt], 0, 0, 0);
            }
          }
          if (!interior) {
            const int pbase = j * 64 + 4 * h;
            int dhi, dlo = -1;
            if (MODE <= 1) dhi = lim[mq] - pbase;
            else if (MODE == 2) dhi = selbit ? tq[mq] - pbase : -1;
            else { dhi = tq[mq] - pbase; dlo = dhi - 512; }
#pragma unroll
            for (int kt = 0; kt < 4; ++kt)
#pragma unroll
              for (int i = 0; i < 4; ++i) {
                const int e = 16 * kt + i;
                const bool v = MODE == 3 ? (e <= dhi && e > dlo) : e <= dhi;
                s[0][kt][i] = v ? s[0][kt][i] : -1e30f;
              }
          }
          if (MODE == 1) {
#pragma unroll
            for (int kt = 0; kt < 4; ++kt) {
              float ps = 0.f;
#pragma unroll
              for (int i = 0; i < 4; ++i) {
                const float pv = __builtin_amdgcn_exp2f(s[0][kt][i]);
                s[0][kt][i] = pv;
                ps += pv;
              }
              ps += dppf<0xB1>(ps);
              ps += dppf<0x4E>(ps);
              if (g == 0) impw[(4 * mq + qi) * 128 + j * 16 + kt * 4 + h] = ps;
            }
          } else {
            float ps = 0.f;
#pragma unroll
            for (int kt = 0; kt < 4; ++kt)
#pragma unroll
              for (int i = 0; i < 4; ++i) {
                const float pv = __builtin_amdgcn_exp2f(s[0][kt][i]);
                s[0][kt][i] = pv;
                ps += pv;
              }
            if (__any(ps > (mvalid ? 4096.f : (rowoff ? 3.0e38f : -1.f)))) {
              {
                const float init = rowoff ? -1e30f : -mb;
#pragma unroll
                for (int kt = 0; kt < 4; ++kt) {
                  s[0][kt] = (f32x4){init, init, init, init};
#pragma unroll
                  for (int ks = 0; ks < 2; ++ks) s[0][kt] = __builtin_amdgcn_mfma_f32_16x16x32_f16(kf[kt][ks], qf[mq][ks], s[0][kt], 0, 0, 0);
                }
                if (!interior) {
                  const int pbase = j * 64 + 4 * h;
                  int dhi, dlo = -1;
                  if (MODE <= 1) dhi = lim[mq] - pbase;
                  else if (MODE == 2) dhi = selbit ? tq[mq] - pbase : -1;
                  else { dhi = tq[mq] - pbase; dlo = dhi - 512; }
#pragma unroll
                  for (int kt = 0; kt < 4; ++kt)
#pragma unroll
                    for (int i = 0; i < 4; ++i) {
                      const int e = 16 * kt + i;
                      const bool v = MODE == 3 ? (e <= dhi && e > dlo) : e <= dhi;
                      s[0][kt][i] = v ? s[0][kt][i] : -1e30f;
                    }
                }
              }
              float pinf = __builtin_inff();
              asm volatile("" : "+v"(pinf));
              float bq[4];
#pragma unroll
              for (int kt = 0; kt < 4; ++kt)
                bq[kt] = __builtin_amdgcn_fmed3f(__builtin_amdgcn_fmed3f(s[0][kt][0], s[0][kt][1], pinf), __builtin_amdgcn_fmed3f(s[0][kt][2], s[0][kt][3], pinf), pinf);
              float bm = __builtin_amdgcn_fmed3f(__builtin_amdgcn_fmed3f(bq[0], bq[1], pinf), __builtin_amdgcn_fmed3f(bq[2], bq[3], pinf), pinf);
              bm = fmaxf(bm, __shfl_xor(bm, 16));
              bm = fmaxf(bm, __shfl_xor(bm, 32));
              const float mn = fmaxf(m[mq], bm + mb);
              const float alpha = __builtin_amdgcn_exp2f(m[mq] - mn);
              l[mq] *= alpha;
              m[mq] = mn;
              if (PV) {
#pragma unroll
                for (int mt = 0; mt < 4; ++mt) o[mq][mt] *= alpha;
              }
              const float dsh = mn > -1e29f ? mn - mb : 0.f;
              ps = 0.f;
#pragma unroll
              for (int kt = 0; kt < 4; ++kt)
#pragma unroll
                for (int i = 0; i < 4; ++i) {
                  const float pv = __builtin_amdgcn_exp2f(s[0][kt][i] - dsh);
                  s[0][kt][i] = pv;
                  ps += pv;
                }
            }
            l[mq] += ps;
          }
          if (PV) {
#pragma unroll
            for (int s2 = 0; s2 < 2; ++s2)
#pragma unroll
              for (int i = 0; i < 4; ++i) { pf[mq][s2][i] = (h16)s[0][2 * s2][i]; pf[mq][s2][4 + i] = (h16)s[0][2 * s2 + 1][i]; }
          }
        }
      if (PV) {
        h16x8 vf[4][2];
#pragma unroll
        for (int mt = 0; mt < 4; ++mt)
#pragma unroll
          for (int s2 = 0; s2 < 2; ++s2) vf[mt][s2] = ldfrag(cV, 16 * mt + c, 4 * s2 + h);
#pragma unroll
        for (int mq = 0; mq < 2; ++mq)
          if (act[mq]) {
#pragma unroll
            for (int s2 = 0; s2 < 2; ++s2) {
#pragma unroll
              for (int mt = 0; mt < 4; ++mt) o[mq][mt] = __builtin_amdgcn_mfma_f32_16x16x32_f16(vf[mt][s2], pf[mq][s2], o[mq][mt], 0, 0, 0);
            }
          }
      }
    }
   }
    sbase = SS - sbase;
  }
  __builtin_amdgcn_s_barrier();
}

__device__ __forceinline__ void attn_item(const Params& p, int l, int item, float* sm) {
  unsigned char* ws = p.ws;
  int tid = tidx();
  asm volatile("" : "+v"(tid));
  const int lane = tid & 63, wave = tid >> 6;
  const int combo = item & 3, qt = item >> 2;
  const int b = combo >> 1, kv = combo & 1;
  const int t0 = qt * 64, tw0 = t0 + 8 * wave;
  const int h = lane >> 4, c = lane & 15, qi = c >> 2, g = c & 3;
  const int head = kv * 4 + g, bkv = b * 2 + kv;
  h16* ring = (h16*)sm;
  float* impw = sm + 24576 + wave * 1024;
  unsigned long long* selm = (unsigned long long*)(sm + 24576 + 8192) + wave * 16;

  h16x8 qf[2][2];
  int tq[2];
#pragma unroll
  for (int mq = 0; mq < 2; ++mq) {
    tq[mq] = tw0 + 4 * mq + qi;
    const h16* qrow = (const h16*)(ws + OFF_Q16) + (size_t)(b * S + tq[mq]) * 512 + head * 64;
    qf[mq][0] = *(const h16x8*)(qrow + 8 * h);
    qf[mq][1] = *(const h16x8*)(qrow + 32 + 8 * h);
  }
  for (int i = lane; i < 1024; i += 64) impw[i] = 0.f;
  float gate3[2][3];
  {
    const float* gt = (const float*)(ws + OFF_GATES) + (size_t)(b * S) * 24 + head * 3;
#pragma unroll
    for (int mq = 0; mq < 2; ++mq) {
      gate3[mq][0] = gt[(size_t)tq[mq] * 24]; gate3[mq][1] = gt[(size_t)tq[mq] * 24 + 1]; gate3[mq][2] = gt[(size_t)tq[mq] * 24 + 2];
    }
  }

  h16x4 ofin[2][4];
  float m[2], ll[2], inv[2];
  f32x4 o[2][4];
  const unsigned long long z2[2] = {0ull, 0ull};
  {
    int lim[2], tlim[2], tflc[2];
#pragma unroll
    for (int mq = 0; mq < 2; ++mq) {
      lim[mq] = tq[mq] >= 31 ? ((tq[mq] - 31) >> 4) : -1;
      const int tl = tw0 + 4 * mq + 3;
      tlim[mq] = tl >= 31 ? ((tl - 31) >> 4) : -1;
      const int tf0 = tw0 + 4 * mq;
      tflc[mq] = tf0 >= 31 ? ((tf0 - 31) >> 4) : -1;
      m[mq] = -1e30f; ll[mq] = 0.f; inv[mq] = 0.f;
#pragma unroll
      for (int mt = 0; mt < 4; ++mt) o[mq][mt] = (f32x4){0.f, 0.f, 0.f, 0.f};
    }
    const int nl = (t0 + 63 - 31) >> 4;
    const int jl = nl >> 6;
    const h16* Kc = (const h16*)(ws + OFF_KCMP) + (size_t)bkv * 512 * 64;
    const h16* Vc = (const h16*)(ws + OFF_VCMPT) + (size_t)bkv * 8 * 4096;
    attn_branch<0>(Kc, Vc, 0, jl, ring, qf, m, ll, o, tq, lim, tlim, tflc, z2, z2, z2, z2, inv, impw);
#pragma unroll
    for (int mq = 0; mq < 2; ++mq) {
      float lt = ll[mq];
      lt += __shfl_xor(lt, 16);
      lt += __shfl_xor(lt, 32);
      inv[mq] = lt > 0.f ? -__log2f(lt) : -1e30f;
    }
    attn_branch<1>(Kc, Vc, 0, jl, ring, qf, m, ll, o, tq, lim, tlim, tflc, z2, z2, z2, z2, inv, impw);
#pragma unroll
    for (int mq = 0; mq < 2; ++mq) {
      const float g0 = gate3[mq][0] * ASCALE;
#pragma unroll
      for (int mt = 0; mt < 4; ++mt) ofin[mq][mt] = pack4(o[mq][mt][0] * g0, o[mq][mt][1] * g0, o[mq][mt][2] * g0, o[mq][mt][3] * g0);
    }
  }
#pragma unroll 1
  for (int q = 0; q < 8; ++q) {
    const int t = tw0 + q, own = t >> 6;
    const float* ir = impw + q * 128;
    const int ja = lane, jb = lane + 64;
    unsigned k0 = 0u, k1 = 0u;
    if (ja <= own) k0 = (ja == 0 || ja == own) ? (0xFFFFFF80u | (unsigned)(127 - ja)) : (((__float_as_uint(ir[ja]) & ~127u) | (unsigned)(127 - ja)) + 1u);
    if (jb <= own) k1 = (jb == own) ? (0xFFFFFF80u | (unsigned)(127 - jb)) : (((__float_as_uint(ir[jb]) & ~127u) | (unsigned)(127 - jb)) + 1u);
    unsigned thr = 0u;
    int lastcnt = 0;
#pragma unroll
    for (int grp = 0; grp < 8; ++grp) {
      if (lastcnt != 16) {
#pragma unroll
        for (int bb = (grp == 0 ? 1 : 0); bb < 4; ++bb) {
          const int bit = 31 - (grp * 4 + bb);
          const unsigned cand = thr | (1u << bit);
          const int cnt = __popcll(__ballot(k0 >= cand)) + __popcll(__ballot(k1 >= cand));
          if (cnt >= 16) { thr = cand; lastcnt = cnt; }
        }
      }
    }
    const unsigned long long mlo = __ballot(k0 >= thr && ja <= own);
    const unsigned long long mhi = __ballot(k1 >= thr && jb <= own);
    if (lane == 0) { selm[q * 2] = mlo; selm[q * 2 + 1] = mhi; }
  }
  unsigned long long mylo[2], myhi[2], ulo[2], uhi[2];
#pragma unroll
  for (int mq = 0; mq < 2; ++mq) {
    mylo[mq] = selm[(4 * mq + qi) * 2];
    myhi[mq] = selm[(4 * mq + qi) * 2 + 1];
    unsigned long long a = selm[(4 * mq) * 2] | selm[(4 * mq + 1) * 2] | selm[(4 * mq + 2) * 2] | selm[(4 * mq + 3) * 2];
    unsigned long long bb = selm[(4 * mq) * 2 + 1] | selm[(4 * mq + 1) * 2 + 1] | selm[(4 * mq + 2) * 2 + 1] | selm[(4 * mq + 3) * 2 + 1];
    ulo[mq] = (unsigned long long)__builtin_amdgcn_readfirstlane((unsigned)a) | ((unsigned long long)__builtin_amdgcn_readfirstlane((unsigned)(a >> 32)) << 32);
    uhi[mq] = (unsigned long long)__builtin_amdgcn_readfirstlane((unsigned)bb) | ((unsigned long long)__builtin_amdgcn_readfirstlane((unsigned)(bb >> 32)) << 32);
  }
  {
    int tl0[2] = {0, 0};
    const int tfs[2] = {tw0, tw0 + 4};
#pragma unroll
    for (int mq = 0; mq < 2; ++mq) {
      m[mq] = -1e30f; ll[mq] = 0.f;
#pragma unroll
      for (int mt = 0; mt < 4; ++mt) o[mq][mt] = (f32x4){0.f, 0.f, 0.f, 0.f};
    }
    attn_branch<2>((const h16*)(ws + OFF_KS) + (size_t)bkv * S * 64, (const h16*)(ws + OFF_VST) + (size_t)bkv * 128 * 4096, 0, (t0 + 63) >> 6, ring, qf, m, ll, o,
                   tq, tl0, tl0, tfs, mylo, myhi, ulo, uhi, inv, impw);
#pragma unroll
    for (int mq = 0; mq < 2; ++mq) {
      float lt = ll[mq];
      lt += __shfl_xor(lt, 16);
      lt += __shfl_xor(lt, 32);
      const float sc = lt > 0.f ? gate3[mq][1] * ASCALE * __builtin_amdgcn_rcpf(lt) : 0.f;
#pragma unroll
      for (int mt = 0; mt < 4; ++mt)
        ofin[mq][mt] = pack4((float)ofin[mq][mt][0] + o[mq][mt][0] * sc, (float)ofin[mq][mt][1] + o[mq][mt][1] * sc, (float)ofin[mq][mt][2] + o[mq][mt][2] * sc,
                             (float)ofin[mq][mt][3] + o[mq][mt][3] * sc);
    }
  }
  {
    int tl0[2] = {0, 0}, tf[2];
#pragma unroll
    for (int mq = 0; mq < 2; ++mq) {
      tf[mq] = tw0 + 4 * mq;
      m[mq] = -1e30f; ll[mq] = 0.f;
#pragma unroll
      for (int mt = 0; mt < 4; ++mt) o[mq][mt] = (f32x4){0.f, 0.f, 0.f, 0.f};
    }
    const int jlo = t0 >= 511 ? ((t0 - 511) >> 6) : 0;
    attn_branch<3>((const h16*)(ws + OFF_KW) + (size_t)bkv * S * 64, (const h16*)(ws + OFF_VWT) + (size_t)bkv * 128 * 4096, jlo, (t0 + 63) >> 6, ring, qf, m, ll, o,
                   tq, tl0, tf, tf, z2, z2, z2, z2, inv, impw);
#pragma unroll
    for (int mq = 0; mq < 2; ++mq) {
      float lt = ll[mq];
      lt += __shfl_xor(lt, 16);
      lt += __shfl_xor(lt, 32);
      const float sc = lt > 0.f ? gate3[mq][2] * ASCALE * __builtin_amdgcn_rcpf(lt) : 0.f;
#pragma unroll
      for (int mt = 0; mt < 4; ++mt)
        ofin[mq][mt] = pack4((float)ofin[mq][mt][0] + o[mq][mt][0] * sc, (float)ofin[mq][mt][1] + o[mq][mt][1] * sc, (float)ofin[mq][mt][2] + o[mq][mt][2] * sc,
                             (float)ofin[mq][mt][3] + o[mq][mt][3] * sc);
    }
  }
  {
    h16* yc = (h16*)(ws + OFF_H16);
    const float* gn = p.in[I_ONG] + l * 1024 + 256 + head * 64;
    float* ssq = (float*)(ws + OFF_SSQ);
#pragma unroll
    for (int mq = 0; mq < 2; ++mq) {
      float sq = 0.f;
      h16* yr = yc + (size_t)(b * S + tq[mq]) * D + head * 64;
#pragma unroll
      for (int mt = 0; mt < 4; ++mt) {
        const float v[4] = {(float)ofin[mq][mt][0], (float)ofin[mq][mt][1], (float)ofin[mq][mt][2], (float)ofin[mq][mt][3]};
        sq += v[0] * v[0] + v[1] * v[1] + v[2] * v[2] + v[3] * v[3];
        const float4 gg = *(const float4*)(gn + 16 * mt + 4 * h);
        *(h16x4*)(yr + 16 * mt + 4 * h) = pack4(v[0] * gg.x, v[1] * gg.y, v[2] * gg.z, v[3] * gg.w);
      }
      sq += __shfl_xor(sq, 16);
      sq += __shfl_xor(sq, 32);
      sq += dppf<0xB1>(sq);
      sq += dppf<0x4E>(sq);
      if (h == 0 && g == 0) ssq[(size_t)(b * S + tq[mq]) * 2 + kv] = sq * (1.f / (ASCALE * ASCALE));
    }
  }
}

__device__ __forceinline__ void lrufix_item(const Params& p, int l, int item) {
  unsigned char* ws = p.ws;
  const int lane = tidx() & 63, wave = tidx() >> 6;
  const int b = item >> 7, ck = item & 127;
  const h16* P = (const h16*)(ws + OFF_P16);
  const float4 cy = *(const float4*)((const float*)(ws + OFF_CARRY) + (size_t)(b * 256 + ck * 2 + (wave >> 2)) * 256 + lane * 4);
  const float4 gn = *(const float4*)(p.in[I_ONG] + l * 1024 + lane * 4);
  h16* yc = (h16*)(ws + OFF_H16);
  float4 hl[8], al[8];
  h16x4 gl[8];
#pragma unroll
  for (int q = 0; q < 8; ++q) {
    const size_t row = (size_t)(b * S + ck * 64 + wave * 8 + q);
    hl[q] = *(const float4*)((const float*)(ws + OFF_LRUH) + row * 256 + lane * 4);
    al[q] = *(const float4*)((const float*)(ws + OFF_LRUA) + row * 256 + lane * 4);
    gl[q] = *(const h16x4*)(P + row * NIN + C_GL + lane * 4);
  }
#pragma unroll
  for (int q = 0; q < 8; ++q) {
    const size_t row = (size_t)(b * S + ck * 64 + wave * 8 + q);
    const float y0 = (hl[q].x + al[q].x * cy.x) * gelu_tanh((float)gl[q][0]);
    const float y1 = (hl[q].y + al[q].y * cy.y) * gelu_tanh((float)gl[q][1]);
    const float y2 = (hl[q].z + al[q].z * cy.z) * gelu_tanh((float)gl[q][2]);
    const float y3 = (hl[q].w + al[q].w * cy.w) * gelu_tanh((float)gl[q][3]);
    const float rstd = rsqrtf(wsum(y0 * y0 + y1 * y1 + y2 * y2 + y3 * y3) * (1.f / 256.f) + EPS);
    *(h16x4*)(yc + row * D + 512 + lane * 4) = pack4(y0 * rstd * gn.x, y1 * rstd * gn.y, y2 * rstd * gn.z, y3 * rstd * gn.w);
  }
}

__device__ __forceinline__ void phase_attn(const Params& p, int l, float* sm) {
  for (int it = blockIdx.x; it < 256; it += gridDim.x) {
#pragma unroll 1
    for (int rep = 0; rep < 2; ++rep) attn_item(p, l, rep ? (127 - (it >> 2)) * 4 + (it & 3) : it, sm);
  }
  if (gridDim.x == 256) {
    if (blockIdx.x < 128) { lrufix_item(p, l, blockIdx.x); lrufix_item(p, l, blockIdx.x + 128); }
  } else {
    for (int it = blockIdx.x; it < 256; it += gridDim.x) lrufix_item(p, l, it);
  }
}

__device__ __forceinline__ void phase_outproj(const Params& p, int l, h16* sm) {
  unsigned char* ws = p.ws;
  const h16* A = (const h16*)(ws + OFF_H16);
  const h16* W = (const h16*)(ws + OFF_WOUT);
  const float* mod = (const float*)(ws + OFF_MOD);
  const TileIter ti = xcd_tiles(64 * 4);
  for (int t = ti.cur; t < ti.end; t += ti.step) {
    const int mt = t >> 2, nt = t & 3;
    f32x4 acc[2][2][4][2];
    const h16* Ab = A + (size_t)mt * 256 * D;
    {
      float* sct = (float*)((unsigned char*)sm + SCHED_OFF - 1024);
      const int tq_ = tidx();
      if (tq_ < 256) {
        const float2 q2 = *(const float2*)((const float*)(ws + OFF_SSQ) + (size_t)(mt * 256 + tq_) * 2);
        sct[tq_] = rsqrtf((q2.x + q2.y) * (1.f / 512.f) + EPS) * (1.f / ASCALE);
      }
    }
    gemm8_mainloop<true>(acc, Ab, [&](int r) { return r * D; }, W + (size_t)nt * 256 * D, D, 16, sm, 8, [&]() {
      const int tid_m = tidx(), lane_m = tid_m & 63, wave_m = tid_m >> 6;
      const float* sct = (const float*)((const unsigned char*)sm + SCHED_OFF - 1024) + (wave_m >> 2) * 64 + (lane_m & 15);
#pragma unroll
      for (int ai = 0; ai < 2; ++ai)
#pragma unroll
        for (int m = 0; m < 4; ++m) {
          const float sc = sct[ai * 128 + m * 16];
#pragma unroll
          for (int bj = 0; bj < 2; ++bj)
#pragma unroll
            for (int n = 0; n < 2; ++n) acc[ai][bj][m][n] *= sc;
        }
    });
    const int tid_e = tidx(), lane = tid_e & 63, wave = tid_e >> 6, wr = wave >> 2, wc = wave & 3, fr = lane & 15, fq = lane >> 4;
    {
      constexpr int LDR = 264;
      const int b = (mt * 256) >> 13;
      h16* y16 = (h16*)(ws + OFF_Y16);
#pragma unroll
      for (int bj = 0; bj < 2; ++bj)
#pragma unroll
        for (int n = 0; n < 2; ++n) {
          const float4 g1 = *(const float4*)(mod + (size_t)(l * 2 + b) * 6144 + 2048 + nt * 256 + bj * 128 + wc * 32 + n * 16 + 4 * fq);
#pragma unroll
          for (int ai = 0; ai < 2; ++ai)
#pragma unroll
            for (int m = 0; m < 4; ++m)
              *(h16x4*)(sm + (ai * 128 + wr * 64 + m * 16 + fr) * LDR + bj * 128 + wc * 32 + n * 16 + 4 * fq) =
                  pack4(acc[ai][bj][m][n][0] * g1.x, acc[ai][bj][m][n][1] * g1.y, acc[ai][bj][m][n][2] * g1.z, acc[ai][bj][m][n][3] * g1.w);
        }
      __syncthreads();
#pragma unroll
      for (int i = 0; i < 16; ++i) {
        const int idx = i * NTHREADS + tid_e;
        const int r = idx >> 5, c8 = idx & 31;
        *(h16x8*)(y16 + (size_t)(mt * 256 + r) * D + nt * 256 + c8 * 8) = *(const h16x8*)(sm + r * LDR + c8 * 8);
      }
      __syncthreads();
    }
  }
}

__device__ __forceinline__ void phase_router(const Params& p, int l, int* smi) {
  unsigned char* ws = p.ws;
  const int tid = tidx(), lane = tid & 63, wave = tid >> 6;
  const float* mod = (const float*)(ws + OFF_MOD);
  const void* xa = l == 0 ? (const void*)p.in[I_X] : (const void*)(ws + OFF_XA);
  const bool xhalf = l != 0;
  const h16* y16 = (const h16*)(ws + OFF_Y16);
  h16* hout = (h16*)(ws + OFF_H16);
  unsigned* cnt = (unsigned*)(ws + OFF_CTL) + 64 + l * 16;
  int* list = (int*)(ws + OFF_LIST);
  float* wpair = (float*)(ws + OFF_WPAIR);
  const float* rgb = p.in[I_RGB] + l * 4;
  int* cntl = smi;
  int* basel = smi + 16;
  int* tok = smi + 32;
  float* wl = (float*)smi + 256;
  {
    const float4* s0 = (const float4*)(p.in[I_RGW] + (size_t)l * 1024 * 4);
    const float4* s1 = (const float4*)(p.in[I_REW] + (size_t)l * 4 * 1024 * 4);
    float4* d = (float4*)wl;
#pragma unroll
    for (int q = 0; q < 2; ++q) d[q * NTHREADS + tid] = s0[q * NTHREADS + tid];
#pragma unroll
    for (int q = 0; q < 8; ++q) d[1024 + q * NTHREADS + tid] = s1[q * NTHREADS + tid];
  }
  const float* rgw = wl;
  for (int chunk = blockIdx.x; chunk < T / 64; chunk += gridDim.x) {
    if (tid < 16) cntl[tid] = 0;
    __syncthreads();
    float4 xn[4];
    h16x4 yn[4];
#pragma unroll
    for (int i = 0; i < 4; ++i) {
      xn[i] = ldx4(xa, xhalf, (size_t)(chunk * 64 + wave) * D + lane * 4 + 256 * i);
      yn[i] = *(const h16x4*)(y16 + (size_t)(chunk * 64 + wave) * D + lane * 4 + 256 * i);
    }
    float4 gsv[4], shv[4];
    const float4 rgbv = *(const float4*)rgb;
    const float4 rb0 = *(const float4*)(p.in[I_REB] + l * 16), rb1 = *(const float4*)(p.in[I_REB] + l * 16 + 4);
    const float4 rb2 = *(const float4*)(p.in[I_REB] + l * 16 + 8), rb3 = *(const float4*)(p.in[I_REB] + l * 16 + 12);
    {
      const int b = (chunk * 64) >> 13;
#pragma unroll
      for (int i = 0; i < 4; ++i) {
        const int col = lane * 4 + 256 * i;
        const float4 g = *(const float4*)(p.in[I_N2G] + l * D + col);
        const float4 sc = *(const float4*)(mod + (size_t)(l * 2 + b) * 6144 + 4096 + col);
        shv[i] = *(const float4*)(mod + (size_t)(l * 2 + b) * 6144 + 3072 + col);
        gsv[i] = make_float4(g.x * (1.f + sc.x), g.y * (1.f + sc.y), g.z * (1.f + sc.z), g.w * (1.f + sc.w));
      }
    }
    for (int ti = wave; ti < 64; ti += NW) {
      const int row = chunk * 64 + ti;
      float4 x[4];
      float ss = 0.f;
#pragma unroll
      for (int i = 0; i < 4; ++i) {
        x[i] = make_float4(xn[i].x + (float)yn[i][0], xn[i].y + (float)yn[i][1], xn[i].z + (float)yn[i][2], xn[i].w + (float)yn[i][3]);
        *(h16x4*)((h16*)(ws + OFF_XA) + (size_t)T * D + (size_t)row * D + lane * 4 + 256 * i) = pack4(x[i].x, x[i].y, x[i].z, x[i].w);
      }
      if (ti + NW < 64) {
#pragma unroll
        for (int i = 0; i < 4; ++i) {
          xn[i] = ldx4(xa, xhalf, (size_t)(row + NW) * D + lane * 4 + 256 * i);
          yn[i] = *(const h16x4*)(y16 + (size_t)(row + NW) * D + lane * 4 + 256 * i);
        }
      }
#pragma unroll
      for (int i = 0; i < 4; ++i) ss += x[i].x * x[i].x + x[i].y * x[i].y + x[i].z * x[i].z + x[i].w * x[i].w;
      ss = wsum(ss);
      const float rstd = rsqrtf(ss * (1.f / D) + EPS);
      float lg0 = 0.f, lg1 = 0.f, lg2 = 0.f, lg3 = 0.f;
#pragma unroll
      for (int i = 0; i < 4; ++i) {
        const int col = lane * 4 + 256 * i;
        x[i].x = x[i].x * rstd * gsv[i].x + shv[i].x;
        x[i].y = x[i].y * rstd * gsv[i].y + shv[i].y;
        x[i].z = x[i].z * rstd * gsv[i].z + shv[i].z;
        x[i].w = x[i].w * rstd * gsv[i].w + shv[i].w;
        *(h16x4*)(hout + (size_t)row * D + col) = pack4(x[i].x, x[i].y, x[i].z, x[i].w);
        const float4 w0 = *(const float4*)(rgw + (size_t)(col + 0) * 4), w1 = *(const float4*)(rgw + (size_t)(col + 1) * 4);
        const float4 w2 = *(const float4*)(rgw + (size_t)(col + 2) * 4), w3 = *(const float4*)(rgw + (size_t)(col + 3) * 4);
        lg0 += x[i].x * w0.x + x[i].y * w1.x + x[i].z * w2.x + x[i].w * w3.x;
        lg1 += x[i].x * w0.y + x[i].y * w1.y + x[i].z * w2.y + x[i].w * w3.y;
        lg2 += x[i].x * w0.z + x[i].y * w1.z + x[i].z * w2.z + x[i].w * w3.z;
        lg3 += x[i].x * w0.w + x[i].y * w1.w + x[i].z * w2.w + x[i].w * w3.w;
      }
      lg0 = wsum(lg0) + rgbv.x; lg1 = wsum(lg1) + rgbv.y; lg2 = wsum(lg2) + rgbv.z; lg3 = wsum(lg3) + rgbv.w;
      int gs = 0; float gm = lg0;
      if (lg1 > gm) { gm = lg1; gs = 1; }
      if (lg2 > gm) { gm = lg2; gs = 2; }
      if (lg3 > gm) { gm = lg3; gs = 3; }
      const float pg = __builtin_amdgcn_rcpf(__expf(lg0 - gm) + __expf(lg1 - gm) + __expf(lg2 - gm) + __expf(lg3 - gm));
      const float* rew = wl + 4096 + gs * 4096;
      const float4 reb = gs == 0 ? rb0 : gs == 1 ? rb1 : gs == 2 ? rb2 : rb3;
      float e0 = 0.f, e1 = 0.f, e2 = 0.f, e3 = 0.f;
#pragma unroll
      for (int i = 0; i < 4; ++i) {
        const int col = lane * 4 + 256 * i;
        const float4 w0 = *(const float4*)(rew + (size_t)(col + 0) * 4), w1 = *(const float4*)(rew + (size_t)(col + 1) * 4);
        const float4 w2 = *(const float4*)(rew + (size_t)(col + 2) * 4), w3 = *(const float4*)(rew + (size_t)(col + 3) * 4);
        e0 += x[i].x * w0.x + x[i].y * w1.x + x[i].z * w2.x + x[i].w * w3.x;
        e1 += x[i].x * w0.y + x[i].y * w1.y + x[i].z * w2.y + x[i].w * w3.y;
        e2 += x[i].x * w0.z + x[i].y * w1.z + x[i].z * w2.z + x[i].w * w3.z;
        e3 += x[i].x * w0.w + x[i].y * w1.w + x[i].z * w2.w + x[i].w * w3.w;
      }
      float le[4];
      le[0] = wsum(e0) + reb.x; le[1] = wsum(e1) + reb.y; le[2] = wsum(e2) + reb.z; le[3] = wsum(e3) + reb.w;
      int i0 = 0; float v0 = le[0];
      if (le[1] > v0) { v0 = le[1]; i0 = 1; }
      if (le[2] > v0) { v0 = le[2]; i0 = 2; }
      if (le[3] > v0) { v0 = le[3]; i0 = 3; }
      int i1 = -1; float v1 = -3.0e38f;
#pragma unroll
      for (int j = 0; j < 4; ++j) {
        const float vj = (j == 0 ? le[0] : j == 1 ? le[1] : j == 2 ? le[2] : le[3]);
        if (j != i0 && vj > v1) { v1 = vj; i1 = j; }
      }
      const float p0 = __builtin_amdgcn_rcpf(1.f + __expf(v1 - v0));
      const float p1 = 1.f - p0;
      if (lane == 0) {
        const int ea = gs * 4 + i0, eb = gs * 4 + i1;
        const int ra = atomicAdd(&cntl[ea], 1);
        const int rb = atomicAdd(&cntl[eb], 1);
        tok[ti * 2] = ea | (ra << 8);
        tok[ti * 2 + 1] = eb | (rb << 8);
        wpair[row * 2] = pg * p0;
        wpair[row * 2 + 1] = pg * p1;
      }
    }
    __syncthreads();
    if (tid < 16) basel[tid] = (int)atomicAdd(&cnt[tid], (unsigned)cntl[tid]);
    __syncthreads();
    if (tid < 128) {
      const int v = tok[tid], e = v & 255, r = v >> 8;
      list[(size_t)e * 16384 + basel[e] + r] = (chunk * 64 + (tid >> 1)) * 2 + (tid & 1);
    }
    __syncthreads();
  }
}

__device__ __forceinline__ void moe_sched(const Params& p, int l, int* sl) {
  const int tid = tidx();
  if (tid < 16) {
    const unsigned* cnt = (const unsigned*)(p.ws + OFF_CTL) + 64 + l * 16;
    sl[tid] = (int)__hip_atomic_load(&cnt[tid], __ATOMIC_RELAXED, __HIP_MEMORY_SCOPE_AGENT);
  }
  __syncthreads();
  if (tid == 0) {
    int to = 0, ro = 0;
    sl[16] = 0; sl[33] = 0;
    for (int e = 0; e < 16; ++e) {
      const int c = sl[e];
      to += (c + 255) >> 8; ro += c;
      sl[17 + e] = to; sl[34 + e] = ro;
    }
  }
  __syncthreads();
}
__device__ __forceinline__ void moe_tile(const int* sl, int t, int& e, int& nt, int& mt, int& cnt_e, int& roff_e) {
  int ee = 0;
  for (int k = 0; k < 15; ++k) ee += (t >= sl[17 + k] * 4) ? 1 : 0;
  ee = __builtin_amdgcn_readfirstlane(ee);
  const int t0 = __builtin_amdgcn_readfirstlane(sl[16 + ee]), t1 = __builtin_amdgcn_readfirstlane(sl[17 + ee]);
  const int nte = t1 - t0, rem = t - t0 * 4;
  e = ee; nt = rem / nte; mt = rem % nte;
  cnt_e = __builtin_amdgcn_readfirstlane(sl[ee]);
  roff_e = __builtin_amdgcn_readfirstlane(sl[33 + ee]);
}

template <int BN>
__device__ __forceinline__ void moe1_tile(const Params& p, int l, h16* sm, const int* sl, int t, int half) {
  unsigned char* ws = p.ws;
  const h16* H = (const h16*)(ws + OFF_H16);
  h16* hid = (h16*)(ws + OFF_HID);
  int e, nt, mt, cnt_e, roff_e;
  moe_tile(sl, t, e, nt, mt, cnt_e, roff_e);
  const int* le = (const int*)(ws + OFF_LIST) + (size_t)e * 16384;
  f32x4 acc[8][BN / 64];
  gemm_mainloop<BN>(acc, [&](int r) { int so = mt * 256 + r; so = so < cnt_e ? so : 0; return H + (size_t)(le[so] >> 1) * D; },
                    (const h16*)wgu_buf(p, l) + ((size_t)e * 1024 + nt * 256 + half * 128) * 1024, 1024, 16, sm);
  const int tid_e = tidx(), lane = tid_e & 63, wave = tid_e >> 6, wr = wave >> 2, wc = wave & 3, fr = lane & 15, fq = lane >> 4;
  constexpr int NC = BN / 2, LDR = NC + 8;
#pragma unroll
  for (int m = 0; m < 8; ++m)
#pragma unroll
    for (int n2 = 0; n2 < BN / 128; ++n2) {
      const f32x4 gt = acc[m][2 * n2], up = acc[m][2 * n2 + 1];
      *(h16x4*)(sm + (wr * 128 + m * 16 + fr) * LDR + wc * (BN / 8) + n2 * 16 + 4 * fq) =
          pack4(silu_f(gt[0]) * up[0], silu_f(gt[1]) * up[1], silu_f(gt[2]) * up[2], silu_f(gt[3]) * up[3]);
    }
  __syncthreads();
  constexpr int CH = NC / 8;
#pragma unroll
  for (int i = 0; i < CH / 2; ++i) {
    const int idx = i * NTHREADS + tid_e;
    const int r = idx / CH, c8 = idx % CH;
    const int so = mt * 256 + r;
    if (so < cnt_e) *(h16x8*)(hid + (size_t)(roff_e + so) * 512 + nt * 128 + half * 64 + c8 * 8) = *(const h16x8*)(sm + r * LDR + c8 * 8);
  }
  __syncthreads();
}
__device__ __forceinline__ void moe1_tile8(const Params& p, int l, h16* sm, const int* sl, int t) {
  unsigned char* ws = p.ws;
  const h16* H = (const h16*)(ws + OFF_H16);
  h16* hid = (h16*)(ws + OFF_HID);
  int e, nt, mt, cnt_e, roff_e;
  moe_tile(sl, t, e, nt, mt, cnt_e, roff_e);
  const int* le = (const int*)(ws + OFF_LIST) + (size_t)e * 16384;
  f32x4 acc[2][2][4][2];
  gemm8_mainloop(acc, H, [&](int r) { int so = mt * 256 + r; so = so < cnt_e ? so : 0; return (le[so] >> 1) * D; },
                 (const h16*)wgu_buf(p, l) + ((size_t)e * 1024 + nt * 256) * 1024, 1024, 16, sm);
  const int tid_e = tidx(), lane = tid_e & 63, wave = tid_e >> 6, wr = wave >> 2, wc = wave & 3, fr = lane & 15, fq = lane >> 4;
  constexpr int LDR = 136;
#pragma unroll
  for (int ai = 0; ai < 2; ++ai)
#pragma unroll
    for (int m = 0; m < 4; ++m)
#pragma unroll
      for (int bj = 0; bj < 2; ++bj) {
        const f32x4 gt = acc[ai][bj][m][0], up = acc[ai][bj][m][1];
        *(h16x4*)(sm + (ai * 128 + wr * 64 + m * 16 + fr) * LDR + bj * 64 + wc * 16 + 4 * fq) =
            pack4(silu_f(gt[0]) * up[0], silu_f(gt[1]) * up[1], silu_f(gt[2]) * up[2], silu_f(gt[3]) * up[3]);
      }
  __syncthreads();
#pragma unroll
  for (int i = 0; i < 8; ++i) {
    const int idx = i * NTHREADS + tid_e;
    const int r = idx >> 4, c8 = idx & 15;
    const int so = mt * 256 + r;
    if (so < cnt_e) *(h16x8*)(hid + (size_t)(roff_e + so) * 512 + nt * 128 + c8 * 8) = *(const h16x8*)(sm + r * LDR + c8 * 8);
  }
  __syncthreads();
}
__device__ __forceinline__ void phase_moe1(const Params& p, int l, h16* sm) {
  int* sl = (int*)((unsigned char*)sm + SCHED_OFF);
  moe_sched(p, l, sl);
  const int total = __builtin_amdgcn_readfirstlane(sl[32]) * 4;
  const TileSched ts = xcd_sched(total);
  for (int t = ts.cur; t < ts.end; t += ts.step) moe1_tile8(p, l, sm, sl, t);
  if (ts.tail_tile >= 0) {
    if (ts.tail_half < 0) moe1_tile8(p, l, sm, sl, ts.tail_tile);
    else moe1_tile<128>(p, l, sm, sl, ts.tail_tile, ts.tail_half);
  }
  if (l == 0) conv_share(p, 1, 0, CV_L1SPLIT, 0, ts.nbusy, (float*)sm);
}

template <int BN>
__device__ __forceinline__ void moe2_tile(const Params& p, int l, h16* sm, const int* sl, int t, int half) {
  unsigned char* ws = p.ws;
  const float* wpair = (const float*)(ws + OFF_WPAIR);
  h16* yp = (h16*)(ws + OFF_YPAIR);
  int e, nt, mt, cnt_e, roff_e;
  moe_tile(sl, t, e, nt, mt, cnt_e, roff_e);
  const int* le = (const int*)(ws + OFF_LIST) + (size_t)e * 16384;
  const h16* Ab = (const h16*)(ws + OFF_HID) + (size_t)(roff_e + mt * 256) * 512;
  float wrow[8];
  int* lrow = (int*)((unsigned char*)sm + SCHED_OFF - 1024);
  {
    const int tid0 = tidx(), lane0 = tid0 & 63, wave0 = tid0 >> 6;
#pragma unroll
    for (int m = 0; m < 8; ++m) {
      const int so = mt * 256 + (wave0 >> 2) * 128 + m * 16 + (lane0 & 15);
      wrow[m] = so < cnt_e ? wpair[le[so]] : 0.f;
    }
    if (tid0 < 256) { const int so = mt * 256 + tid0; lrow[tid0] = so < cnt_e ? le[so] : 0; }
  }
  f32x4 acc[8][BN / 64];
  gemm_mainloop<BN>(acc, [&](int r) { return Ab + (size_t)r * 512; }, (const h16*)wdn_buf(p, l) + ((size_t)e * 1024 + nt * 256 + half * 128) * 512, 512, 8, sm);
  const int tid_e = tidx(), lane = tid_e & 63, wave = tid_e >> 6, wr = wave >> 2, wc = wave & 3, fr = lane & 15, fq = lane >> 4;
  constexpr int LDR = BN + 8;
#pragma unroll
  for (int m = 0; m < 8; ++m) {
    const float w = wrow[m];
#pragma unroll
    for (int n = 0; n < BN / 64; ++n)
      *(h16x4*)(sm + (wr * 128 + m * 16 + fr) * LDR + wc * (BN / 4) + n * 16 + 4 * fq) = pack4(acc[m][n][0] * w, acc[m][n][1] * w, acc[m][n][2] * w, acc[m][n][3] * w);
  }
  __syncthreads();
  constexpr int CH = BN / 8;
#pragma unroll
  for (int i = 0; i < CH / 2; ++i) {
    const int idx = i * NTHREADS + tid_e;
    const int r = idx / CH, c8 = idx % CH;
    const int so = mt * 256 + r;
    if (so < cnt_e) *(h16x8*)(yp + (size_t)lrow[r] * D + nt * 256 + half * 128 + c8 * 8) = *(const h16x8*)(sm + r * LDR + c8 * 8);
  }
  __syncthreads();
}
__device__ __forceinline__ void moe2_tile8(const Params& p, int l, h16* sm, const int* sl, int t) {
  unsigned char* ws = p.ws;
  const float* wpair = (const float*)(ws + OFF_WPAIR);
  h16* yp = (h16*)(ws + OFF_YPAIR);
  int e, nt, mt, cnt_e, roff_e;
  moe_tile(sl, t, e, nt, mt, cnt_e, roff_e);
  const int* le = (const int*)(ws + OFF_LIST) + (size_t)e * 16384;
  const h16* Ab = (const h16*)(ws + OFF_HID) + (size_t)(roff_e + mt * 256) * 512;
  int* lrow = (int*)((unsigned char*)sm + SCHED_OFF - 1024);
  float* wtab = (float*)((unsigned char*)sm + 139264);
  {
    const int tid0 = tidx();
    if (tid0 < 256) { const int so = mt * 256 + tid0; const int li = so < cnt_e ? le[so] : 0; lrow[tid0] = li; wtab[tid0] = so < cnt_e ? wpair[li] : 0.f; }
  }
  f32x4 acc[2][2][4][2];
  gemm8_mainloop(acc, Ab, [&](int r) { return r * 512; }, (const h16*)wdn_buf(p, l) + ((size_t)e * 1024 + nt * 256) * 512, 512, 8, sm);
  const int tid_e = tidx(), lane = tid_e & 63, wave = tid_e >> 6, wr = wave >> 2, wc = wave & 3, fr = lane & 15, fq = lane >> 4;
  constexpr int LDR = 264;
#pragma unroll
  for (int ai = 0; ai < 2; ++ai)
#pragma unroll
    for (int m = 0; m < 4; ++m) {
      const float w = wtab[ai * 128 + wr * 64 + m * 16 + fr];
#pragma unroll
      for (int bj = 0; bj < 2; ++bj)
#pragma unroll
        for (int n = 0; n < 2; ++n)
          *(h16x4*)(sm + (ai * 128 + wr * 64 + m * 16 + fr) * LDR + bj * 128 + wc * 32 + n * 16 + 4 * fq) =
              pack4(acc[ai][bj][m][n][0] * w, acc[ai][bj][m][n][1] * w, acc[ai][bj][m][n][2] * w, acc[ai][bj][m][n][3] * w);
    }
  __syncthreads();
#pragma unroll
  for (int i = 0; i < 16; ++i) {
    const int idx = i * NTHREADS + tid_e;
    const int r = idx >> 5, c8 = idx & 31;
    const int so = mt * 256 + r;
    if (so < cnt_e) *(h16x8*)(yp + (size_t)lrow[r] * D + nt * 256 + c8 * 8) = *(const h16x8*)(sm + r * LDR + c8 * 8);
  }
  __syncthreads();
}
__device__ __forceinline__ void phase_moe2(const Params& p, int l, h16* sm) {
  int* sl = (int*)((unsigned char*)sm + SCHED_OFF);
  moe_sched(p, l, sl);
  const int total = __builtin_amdgcn_readfirstlane(sl[32]) * 4;
  const TileSched ts = xcd_sched(total);
  for (int t = ts.cur; t < ts.end; t += ts.step) moe2_tile8(p, l, sm, sl, t);
  if (ts.tail_tile >= 0) {
    if (ts.tail_half < 0) moe2_tile8(p, l, sm, sl, ts.tail_tile);
    else moe2_tile<128>(p, l, sm, sl, ts.tail_tile, ts.tail_half);
  }
  if (l == 0) conv_share(p, 1, CV_L1SPLIT, NT_CONV, 0, ts.nbusy, (float*)sm);
}

#define XB_TMO      128
#define XB_XCNT(j)  (256  + 64 * (j))
#define XB_XSUB(j)  (1280 + 64 * (j))
#define XB_XGEN(j)  (2304 + 64 * (j))
#define XB_TOP      3328
#define XB_TOPGEN   3392
#define XCD_BAR_WORDS 3456
#define XB_SPIN_CAP (1u << 20)
__device__ __forceinline__ unsigned xb_ld(unsigned* p) { return __hip_atomic_load(p, __ATOMIC_RELAXED, __HIP_MEMORY_SCOPE_AGENT); }
__device__ __forceinline__ unsigned xb_add(unsigned* p, unsigned v) { return __hip_atomic_fetch_add(p, v, __ATOMIC_RELAXED, __HIP_MEMORY_SCOPE_AGENT); }
__device__ __forceinline__ unsigned xb_xcc_id() { return (unsigned)__builtin_amdgcn_s_getreg((3 << 11) | 20) & 0xFu; }
#define XB_SPIN(cond, bar) do { unsigned _sp = 0; while (cond) { __builtin_amdgcn_s_sleep(1); \
    if ((++_sp & 255u) == 0u) { if (xb_ld(&(bar)[XB_TMO])) break; if (_sp > XB_SPIN_CAP) { atomicAdd(&(bar)[XB_TMO], 1u); break; } } } } while (0)
struct XBar { unsigned* bar; unsigned x; volatile unsigned* st; };
__device__ __forceinline__ void xbar_post(XBar& b, unsigned* bar, volatile unsigned* st) {
  b.bar = bar; b.x = xb_xcc_id(); b.st = st;
  if (tidx() == 0) { st[0] = 0u; st[1] = 0u; (void)xb_add(&bar[XB_XCNT(b.x)], 1u); }
}
__device__ __forceinline__ void xbar_census(unsigned* bar, unsigned x, unsigned& nloc, unsigned& nx) {
  const unsigned G = gridDim.x;
  unsigned sum, cnt, mine, sp = 0u;
  for (;;) {
    sum = 0u; cnt = 0u; mine = 0u;
#pragma unroll
    for (unsigned j = 0; j < 16; ++j) { const unsigned c = xb_ld(&bar[XB_XCNT(j)]); sum += c; cnt += (c > 0u) ? 1u : 0u; mine = (j == x) ? c : mine; }
    if (sum == G) break;
    __builtin_amdgcn_s_sleep(1);
    if ((++sp & 255u) == 0u) { if (xb_ld(&bar[XB_TMO])) break; if (sp > XB_SPIN_CAP) { atomicAdd(&bar[XB_TMO], 1u); break; } }
  }
  nloc = mine > 0u ? mine : 1u; nx = cnt > 0u ? cnt : 1u;
}
__device__ __forceinline__ void xbar_sync(XBar& b) {
  asm volatile("s_waitcnt vmcnt(0)" ::: "memory");
  __syncthreads();
  if (tidx() == 0) {
    unsigned* bar = b.bar;
    __builtin_amdgcn_s_waitcnt(0);
    unsigned nloc = b.st[0], nx = b.st[1];
    if (nloc == 0u) { xbar_census(bar, b.x, nloc, nx); b.st[0] = nloc; b.st[1] = nx; }
    const unsigned old = xb_add(&bar[XB_XSUB(b.x)], 1u);
    const unsigned gen = old / nloc;
    if (old + 1u == (gen + 1u) * nloc) {
      __builtin_amdgcn_fence(__ATOMIC_RELEASE, "agent");
      asm volatile("s_waitcnt vmcnt(0)" ::: "memory");
      const unsigned og = xb_add(&bar[XB_TOP], 1u);
      const unsigned tg = og / nx;
      if (og + 1u == (tg + 1u) * nx) xb_add(&bar[XB_TOPGEN], 1u);
      else XB_SPIN(xb_ld(&bar[XB_TOPGEN]) == tg, bar);
      __builtin_amdgcn_fence(__ATOMIC_ACQUIRE, "agent");
      xb_add(&bar[XB_XGEN(b.x)], 1u);
      asm volatile("s_waitcnt vmcnt(0)" ::: "memory");
    } else {
      XB_SPIN(xb_ld(&bar[XB_XGEN(b.x)]) == gen, bar);
      asm volatile("buffer_inv sc0\n\ts_waitcnt vmcnt(0)" ::: "memory");
    }
  }
  __syncthreads();
}

constexpr int NSTEPS = 20;
#define STEP(k, body) do { if (s_lo <= (k) && (k) < s_hi) { body; if ((k) + 1 < s_hi) { xbar_sync(xb); } \
    if (PROBE_MASK != 0u) { unsigned long long now_ = __builtin_amdgcn_s_memrealtime(); \
      if ((PROBE_MASK >> (k)) & 1u) { const unsigned long long w_ = (now_ - pt_prev) * PROBE_AMP; \
        while (__builtin_amdgcn_s_memrealtime() - now_ < w_) __builtin_amdgcn_s_sleep(8); now_ = __builtin_amdgcn_s_memrealtime(); } \
      pt_prev = now_; } } } while (0)
#define LAYER_STEPS(l, base) \
  STEP(base + 0, phase_norm1(p, l, (float*)smem); if (l == 1) phase_convert_misc(p, 1)); \
  STEP(base + 1, phase_inproj(p, l, (h16*)smem)); \
  STEP(base + 2, phase_mixa(p, l, smem)); \
  STEP(base + 3, phase_mixb(p, l, (float*)smem)); \
  STEP(base + 4, phase_attn(p, l, (float*)smem)); \
  STEP(base + 5, phase_outproj(p, l, (h16*)smem)); \
  STEP(base + 6, phase_router(p, l, (int*)smem)); \
  STEP(base + 7, phase_moe1(p, l, (h16*)smem)); \
  STEP(base + 8, phase_moe2(p, l, (h16*)smem))

__global__ void __launch_bounds__(NTHREADS, 2) mega(Params p, int s_lo, int s_hi) {
  extern __shared__ __attribute__((aligned(16))) unsigned char smem[];
  unsigned long long pt_prev = PROBE_MASK != 0u ? __builtin_amdgcn_s_memrealtime() : 0ull;
  XBar xb;
  xbar_post(xb, (unsigned*)(p.ws + OFF_BAR), (volatile unsigned*)(smem + LDS_BYTES - 16));
  STEP(0, phase_prep(p, (float*)smem); phase_convert_tiles(p, 0, (float*)smem); phase_convert_misc(p, 0));
  LAYER_STEPS(0, 1);
  LAYER_STEPS(1, 10);
  STEP(19, phase_norm1(p, 2, (float*)smem));
}

extern "C" void kernel_launch(void* const* d_in, const int* in_sizes, int n_in, void* d_out, int out_size, void* d_ws, size_t ws_size,
                              hipStream_t stream) {
  static int grid_blocks = 0;
  if (!grid_blocks) {
    if (n_in != 35 || out_size != T * D || ws_size < WS_TOTAL) {
      fprintf(stderr, "kernel_launch: unexpected problem (n_in %d, out %d, ws %zu < %zu)\n", n_in, out_size, ws_size, (size_t)WS_TOTAL);
      grid_blocks = -1;
      return;
    }
    int dev = 0, cus = 0, per_cu = 0;
    hipGetDevice(&dev);
    hipDeviceGetAttribute(&cus, hipDeviceAttributeMultiprocessorCount, dev);
    if (hipFuncSetAttribute((const void*)mega, hipFuncAttributeMaxDynamicSharedMemorySize, LDS_BYTES) != hipSuccess) {
      fprintf(stderr, "kernel_launch: hipFuncSetAttribute(%d B dynamic LDS) failed\n", LDS_BYTES);
      grid_blocks = -1;
      return;
    }
    hipOccupancyMaxActiveBlocksPerMultiprocessor(&per_cu, mega, NTHREADS, LDS_BYTES);
    if (per_cu > 1) per_cu = 1;
    if (per_cu < 1) { fprintf(stderr, "kernel_launch: occupancy query returned %d\n", per_cu); grid_blocks = -1; return; }
    grid_blocks = cus * per_cu;
  }
  if (grid_blocks < 0) return;
  Params p{};
  for (int i = 0; i < 35; ++i) p.in[i] = (const float*)d_in[i];
  p.out = (float*)d_out;
  p.ws = (unsigned char*)d_ws;
  for (int i = 0; i < 32; ++i) p.inv_freq[i] = std::pow(10000.0, -(double)(2 * i) / 64.0);
  if (hipMemsetAsync((char*)d_ws + OFF_BAR, 0, 16384, stream) != hipSuccess) { fprintf(stderr, "kernel_launch: memset of barrier words failed\n"); return; }
#if MEGA
  int lo = 0, hi = NSTEPS;
  void* args[] = {&p, &lo, &hi};
  hipError_t e = hipLaunchCooperativeKernel((void*)mega, dim3(grid_blocks), dim3(NTHREADS), args, LDS_BYTES, stream);
  if (e != hipSuccess) fprintf(stderr, "cooperative launch failed: %s (grid %d)\n", hipGetErrorString(e), grid_blocks);
#else
  for (int s = 0; s < NSTEPS; ++s) {
    int lo = s, hi = s + 1;
    void* args[] = {&p, &lo, &hi};
    hipError_t e = hipLaunchCooperativeKernel((void*)mega, dim3(grid_blocks), dim3(NTHREADS), args, LDS_BYTES, stream);
    if (e != hipSuccess) { fprintf(stderr, "launch %d failed: %s (grid %d)\n", s, hipGetErrorString(e), grid_blocks); break; }
  }
#endif
}
```
